# Optimizing an MI355X kernel written in HIP

```python
import math
import jax, jax.numpy as jnp
from jax import lax
import numpy as np

D_MODEL = 1024
BATCH = 2
SEQ = 8192
DEPTH = 2

N_EVEN = (DEPTH + 1) // 2
N_ODD = DEPTH // 2

S5_WIDTH = D_MODEL // 2
S5_GROUP = 16
S5_GROUPS = S5_WIDTH // S5_GROUP
S5_STATE = 64
S5_MIN_STEP = 0.001
S5_MAX_STEP = 0.1
SB_HEAD_DIM = 64
SB_HEADS = (D_MODEL // 2) // SB_HEAD_DIM
SB_WIDTH = SB_HEADS * SB_HEAD_DIM
EVEN_IN = S5_WIDTH + 3 * SB_WIDTH
EVEN_MIX = S5_WIDTH + SB_WIDTH
FOX_HEAD_DIM = 64
FOX_HEADS = D_MODEL // FOX_HEAD_DIM
FOX_WIDTH = FOX_HEADS * FOX_HEAD_DIM
ODD_IN = 3 * FOX_WIDTH + FOX_HEADS
D_FF = 2816
N_EXPERTS = 8
TOP_K = 2
D_FF_EXPERT = 3584
Q_BLOCK = 128
RMS_EPS = 1e-6

kernel_name = "hybrid_s5_stickbreak_fox_moe"

F32 = jnp.float32


def rmsnorm(x, g):
    xf = x.astype(F32)
    y = xf * lax.rsqrt(jnp.mean(xf * xf, axis=-1, keepdims=True) + RMS_EPS)
    return (y * g.astype(F32)).astype(x.dtype)


def to_heads(t, n_heads, head_dim):
    b, l, _ = t.shape
    return t.reshape(b, l, n_heads, head_dim).transpose(0, 2, 1, 3)


def from_heads(t):
    b, h, l, d = t.shape
    return t.transpose(0, 2, 1, 3).reshape(b, l, h * d)


def s5_mixer(u, a_re, a_im, b_re, b_im, c_re, c_im, d_skip, log_step, w_glu, b_glu):
    bsz, seqlen, _ = u.shape
    uf = u.astype(F32).reshape(bsz, seqlen, S5_GROUPS, S5_GROUP)
    lam = lax.complex(a_re.astype(F32), a_im.astype(F32))
    step = jnp.exp(log_step.astype(F32))[:, None]
    lam_bar = jnp.exp(lam * step)
    b_cplx = lax.complex(b_re.astype(F32), b_im.astype(F32))
    b_bar = ((lam_bar - 1.0) / lam)[..., None] * b_cplx
    bu = jnp.einsum('gph,blgh->blgp', b_bar, uf.astype(jnp.complex64))
    a_seq = jnp.broadcast_to(lam_bar, bu.shape)

    def combine(left, right):
        a_l, s_l = left
        a_r, s_r = right
        return a_r * a_l, a_r * s_l + s_r

    _, states = lax.associative_scan(combine, (a_seq, bu), axis=1)
    c_cplx = lax.complex(c_re.astype(F32), c_im.astype(F32))
    y = jnp.einsum('ghp,blgp->blgh', c_cplx, states).real + d_skip.astype(F32) * uf
    y = jax.nn.gelu(y.reshape(bsz, seqlen, S5_WIDTH))
    out = y * jax.nn.sigmoid(y @ w_glu.astype(F32) + b_glu.astype(F32))
    return out.astype(u.dtype)


def stick_breaking_attention(q, k, v):
    bsz, nh, seqlen, dh = q.shape
    nblk = seqlen // Q_BLOCK
    scale = 1.0 / math.sqrt(dh)
    qb = q.reshape(bsz, nh, nblk, Q_BLOCK, dh).transpose(2, 0, 1, 3, 4)
    kpos = jnp.arange(seqlen)

    def block(args):
        qi, blk = args
        qpos = blk * Q_BLOCK + jnp.arange(Q_BLOCK)
        z = jnp.einsum('bhqd,bhkd->bhqk', qi, k).astype(F32) * scale
        strict = kpos[None, :] < qpos[:, None]
        log_keep = jnp.where(strict, jax.nn.log_sigmoid(-z), 0.0)
        after = lax.cumsum(log_keep, axis=3, reverse=True) - log_keep
        w = jnp.where(strict, jnp.exp(jax.nn.log_sigmoid(z) + after), 0.0)
        return jnp.einsum('bhqk,bhkd->bhqd', w.astype(v.dtype), v)

    out = lax.map(block, (qb, jnp.arange(nblk)))
    return out.transpose(1, 2, 0, 3, 4).reshape(bsz, nh, seqlen, dh)


def forgetting_attention(q, k, v, log_f):
    bsz, nh, seqlen, dh = q.shape
    nblk = seqlen // Q_BLOCK
    scale = 1.0 / math.sqrt(dh)
    cum = lax.cumsum(log_f, axis=2)
    qb = q.reshape(bsz, nh, nblk, Q_BLOCK, dh).transpose(2, 0, 1, 3, 4)
    cb = cum.reshape(bsz, nh, nblk, Q_BLOCK).transpose(2, 0, 1, 3)
    kpos = jnp.arange(seqlen)

    def block(args):
        qi, ci, blk = args
        qpos = blk * Q_BLOCK + jnp.arange(Q_BLOCK)
        s = jnp.einsum('bhqd,bhkd->bhqk', qi, k).astype(F32) * scale
        s = s + ci[..., None] - cum[:, :, None, :]
        causal = kpos[None, :] <= qpos[:, None]
        p = jax.nn.softmax(jnp.where(causal, s, -jnp.inf), axis=-1)
        return jnp.einsum('bhqk,bhkd->bhqd', p.astype(v.dtype), v)

    out = lax.map(block, (qb, cb, jnp.arange(nblk)))
    return out.transpose(1, 2, 0, 3, 4).reshape(bsz, nh, seqlen, dh)


def swiglu(h, w_gate, w_up, w_down):
    return (jax.nn.silu(h @ w_gate) * (h @ w_up)) @ w_down


def moe_swiglu(h, w_router, w_gate, w_up, w_down):
    logits = (h @ w_router).astype(F32)
    top_val, top_idx = lax.top_k(logits, TOP_K)
    gates = jax.nn.softmax(top_val, axis=-1)
    combine = jnp.sum(jax.nn.one_hot(top_idx, N_EXPERTS, dtype=F32) * gates[..., None], axis=-2)
    out = jnp.zeros_like(h)
    for e in range(N_EXPERTS):
        y_e = swiglu(h, w_gate[e], w_up[e], w_down[e])
        out = out + combine[..., e:e + 1].astype(h.dtype) * y_e
    return out


def setup_inputs(seed: int = 0) -> dict:
    key = jax.random.key(seed)
    ks = iter(jax.random.split(key, 40))

    def nrm(shape, scale):
        return jax.random.normal(next(ks), shape, F32) * scale

    def gain(shape):
        return 1.0 + 0.02 * jax.random.normal(next(ks), shape, F32)

    E, O = N_EVEN, N_ODD
    G, H, P = S5_GROUPS, S5_GROUP, S5_STATE
    n_idx = jnp.arange(P, dtype=F32)
    inp = {}
    inp["x"] = nrm((BATCH, SEQ, D_MODEL), 1.0)
    inp["ev_norm_mix"] = gain((E, D_MODEL))
    inp["ev_w_in"] = nrm((E, D_MODEL, EVEN_IN), D_MODEL ** -0.5)
    inp["s5_a_re"] = -0.5 + 0.01 * jax.random.normal(next(ks), (E, G, P), F32)
    inp["s5_a_im"] = math.pi * n_idx + 0.01 * jax.random.normal(next(ks), (E, G, P), F32)
    inp["s5_b_re"] = nrm((E, G, P, H), (2.0 * H) ** -0.5)
    inp["s5_b_im"] = nrm((E, G, P, H), (2.0 * H) ** -0.5)
    inp["s5_c_re"] = nrm((E, G, H, P), P ** -0.5)
    inp["s5_c_im"] = nrm((E, G, H, P), P ** -0.5)
    inp["s5_d"] = nrm((E, G, H), 1.0)
    inp["s5_log_step"] = jax.random.uniform(next(ks), (E, G), F32, math.log(S5_MIN_STEP), math.log(S5_MAX_STEP))
    inp["s5_w_glu"] = nrm((E, S5_WIDTH, S5_WIDTH), S5_WIDTH ** -0.5)
    inp["s5_b_glu"] = nrm((E, S5_WIDTH), 0.01)
    inp["ev_w_out"] = nrm((E, EVEN_MIX, D_MODEL), EVEN_MIX ** -0.5)
    inp["ev_norm_ffn"] = gain((E, D_MODEL))
    inp["ffn_w_gate"] = nrm((E, D_MODEL, D_FF), D_MODEL ** -0.5)
    inp["ffn_w_up"] = nrm((E, D_MODEL, D_FF), D_MODEL ** -0.5)
    inp["ffn_w_down"] = nrm((E, D_FF, D_MODEL), D_FF ** -0.5)
    inp["od_norm_mix"] = gain((O, D_MODEL))
    inp["od_w_in"] = nrm((O, D_MODEL, ODD_IN), D_MODEL ** -0.5)
    inp["fox_b_f"] = jax.random.uniform(next(ks), (O, FOX_HEADS), F32, 1.0, 6.0)
    inp["od_w_out"] = nrm((O, FOX_WIDTH, D_MODEL), FOX_WIDTH ** -0.5)
    inp["od_norm_ffn"] = gain((O, D_MODEL))
    inp["moe_w_router"] = nrm((O, D_MODEL, N_EXPERTS), D_MODEL ** -0.5)
    inp["moe_w_gate"] = nrm((O, N_EXPERTS, D_MODEL, D_FF_EXPERT), D_MODEL ** -0.5)
    inp["moe_w_up"] = nrm((O, N_EXPERTS, D_MODEL, D_FF_EXPERT), D_MODEL ** -0.5)
    inp["moe_w_down"] = nrm((O, N_EXPERTS, D_FF_EXPERT, D_MODEL), D_FF_EXPERT ** -0.5)
    inp["final_norm"] = gain((D_MODEL,))
    return inp


def reference(x, ev_norm_mix, ev_w_in, s5_a_re, s5_a_im, s5_b_re, s5_b_im, s5_c_re, s5_c_im,
              s5_d, s5_log_step, s5_w_glu, s5_b_glu, ev_w_out, ev_norm_ffn, ffn_w_gate, ffn_w_up,
              ffn_w_down, od_norm_mix, od_w_in, fox_b_f, od_w_out, od_norm_ffn, moe_w_router,
              moe_w_gate, moe_w_up, moe_w_down, final_norm):
    for layer in range(DEPTH):
        i = layer // 2
        if layer % 2 == 0:
            h = rmsnorm(x, ev_norm_mix[i])
            proj = h @ ev_w_in[i]
            u, q, k, v = jnp.split(proj, [S5_WIDTH, S5_WIDTH + SB_WIDTH, S5_WIDTH + 2 * SB_WIDTH], axis=-1)
            a_out = s5_mixer(u, s5_a_re[i], s5_a_im[i], s5_b_re[i], s5_b_im[i], s5_c_re[i],
                             s5_c_im[i], s5_d[i], s5_log_step[i], s5_w_glu[i], s5_b_glu[i])
            b_out = from_heads(stick_breaking_attention(to_heads(q, SB_HEADS, SB_HEAD_DIM),
                                                        to_heads(k, SB_HEADS, SB_HEAD_DIM),
                                                        to_heads(v, SB_HEADS, SB_HEAD_DIM)))
            x = x + jnp.concatenate([a_out, b_out], axis=-1) @ ev_w_out[i]
            h = rmsnorm(x, ev_norm_ffn[i])
            x = x + swiglu(h, ffn_w_gate[i], ffn_w_up[i], ffn_w_down[i])
        else:
            h = rmsnorm(x, od_norm_mix[i])
            proj = h @ od_w_in[i]
            q, k, v, f_logit = jnp.split(proj, [FOX_WIDTH, 2 * FOX_WIDTH, 3 * FOX_WIDTH], axis=-1)
            log_f = jax.nn.log_sigmoid(f_logit.astype(F32) + fox_b_f[i].astype(F32))
            c_out = from_heads(forgetting_attention(to_heads(q, FOX_HEADS, FOX_HEAD_DIM),
                                                    to_heads(k, FOX_HEADS, FOX_HEAD_DIM),
                                                    to_heads(v, FOX_HEADS, FOX_HEAD_DIM),
                                                    log_f.transpose(0, 2, 1)))
            x = x + c_out @ od_w_out[i]
            h = rmsnorm(x, od_norm_ffn[i])
            x = x + moe_swiglu(h, moe_w_router[i], moe_w_gate[i], moe_w_up[i], moe_w_down[i])
    return rmsnorm(x, final_norm)
```

```cpp
#include <hip/hip_runtime.h>
#include <cstdint>
#include <cstdio>

namespace nv {
constexpr int BATCH = 2, SEQ = 8192, D = 1024, M = BATCH * SEQ;
constexpr int S5W = 512, S5G = 32, S5H = 16, S5P = 64;
constexpr int SBH = 8, HD = 64;
constexpr int EVEN_IN = 2048;
constexpr int FOXH = 16, ODD_IN = 3088;
constexpr int DFF = 2816, NEXP = 8, DFE = 3584;
constexpr float EPS = 1e-6f;

__global__ void __launch_bounds__(256) k_rmsnorm(const float* x, const float* __restrict__ g, float* y) {
    const int row = blockIdx.x, t = threadIdx.x;
    const float4 v = ((const float4*)(x + (size_t)row * D))[t];
    float s = v.x * v.x + v.y * v.y + v.z * v.z + v.w * v.w;
    for (int o = 32; o > 0; o >>= 1) s += __shfl_xor(s, o);
    __shared__ float red[4];
    if ((t & 63) == 0) red[t >> 6] = s;
    __syncthreads();
    const float tot = red[0] + red[1] + red[2] + red[3];
    const float r = rsqrtf(tot * (1.0f / D) + EPS);
    const float4 gg = ((const float4*)g)[t];
    float4 o; o.x = v.x * r * gg.x; o.y = v.y * r * gg.y; o.z = v.z * r * gg.z; o.w = v.w * r * gg.w;
    ((float4*)(y + (size_t)row * D))[t] = o;
}

template <int MODE, bool GATHER_A>
__global__ void __launch_bounds__(256) k_gemm(const float* __restrict__ A, int lda, const float* __restrict__ B, const float* __restrict__ B2, int ldb,
                                              float* C, int ldc, const float* R, int ldr, const float* __restrict__ bias,
                                              int Mrows, const int* __restrict__ Mdev, int N, int K, const int* __restrict__ arow, const float* __restrict__ gate) {
    const int Mr = Mdev ? *Mdev : Mrows;
    const int m0 = blockIdx.y * 64, n0 = blockIdx.x * 64;
    if (m0 >= Mr) return;
    __shared__ float sA[16][65];
    __shared__ float sB[16][64];
    __shared__ float sB2[MODE == 2 ? 16 : 1][64];
    const int t = threadIdx.x, tx = t & 15, ty = t >> 4;
    float acc[4][4], acc2[4][4];
#pragma unroll
    for (int i = 0; i < 4; ++i)
#pragma unroll
        for (int j = 0; j < 4; ++j) { acc[i][j] = 0.f; acc2[i][j] = 0.f; }
    const int ar = t >> 2, ak = (t & 3) * 4;
    int arow_g = m0 + ar; bool avalid = arow_g < Mr;
    size_t aoff = 0;
    if (avalid) aoff = (size_t)(GATHER_A ? arow[arow_g] : arow_g) * lda;
    const int bk = t >> 4, bn = (t & 15) * 4;
    for (int k0 = 0; k0 < K; k0 += 16) {
        float4 av = avalid ? *(const float4*)(A + aoff + k0 + ak) : make_float4(0.f, 0.f, 0.f, 0.f);
        sA[ak + 0][ar] = av.x; sA[ak + 1][ar] = av.y; sA[ak + 2][ar] = av.z; sA[ak + 3][ar] = av.w;
#pragma unroll
        for (int j = 0; j < 4; ++j) {
            const int n = n0 + bn + j;
            sB[bk][bn + j] = (n < N) ? B[(size_t)(k0 + bk) * ldb + n] : 0.f;
            if (MODE == 2) sB2[bk][bn + j] = (n < N) ? B2[(size_t)(k0 + bk) * ldb + n] : 0.f;
        }
        __syncthreads();
#pragma unroll
        for (int kk = 0; kk < 16; ++kk) {
            float a[4], b[4], b2[4];
#pragma unroll
            for (int i = 0; i < 4; ++i) a[i] = sA[kk][ty * 4 + i];
#pragma unroll
            for (int j = 0; j < 4; ++j) { b[j] = sB[kk][tx * 4 + j]; if (MODE == 2) b2[j] = sB2[kk][tx * 4 + j]; }
#pragma unroll
            for (int i = 0; i < 4; ++i)
#pragma unroll
                for (int j = 0; j < 4; ++j) { acc[i][j] = fmaf(a[i], b[j], acc[i][j]); if (MODE == 2) acc2[i][j] = fmaf(a[i], b2[j], acc2[i][j]); }
        }
        __syncthreads();
    }
#pragma unroll
    for (int i = 0; i < 4; ++i) {
        const int r = m0 + ty * 4 + i; if (r >= Mr) continue;
#pragma unroll
        for (int j = 0; j < 4; ++j) {
            const int n = n0 + tx * 4 + j; if (n >= N) continue;
            const float v = acc[i][j];
            if (MODE == 0) C[(size_t)r * ldc + n] = v;
            else if (MODE == 1) C[(size_t)r * ldc + n] = R[(size_t)r * ldr + n] + v;
            else if (MODE == 2) { const float sg = v / (1.f + expf(-v)); C[(size_t)r * ldc + n] = sg * acc2[i][j]; }
            else if (MODE == 3) { const float y = R[(size_t)r * ldr + n]; const float z = v + bias[n]; C[(size_t)r * ldc + n] = y / (1.f + expf(-z)); }
            else if (MODE == 4) { const int tok = arow[r]; C[(size_t)tok * ldc + n] += gate[r] * v; }
        }
    }
}

__global__ void __launch_bounds__(64) k_s5(const float* __restrict__ proj  , const float* __restrict__ a_re, const float* __restrict__ a_im,
                                           const float* __restrict__ b_re, const float* __restrict__ b_im, const float* __restrict__ c_re, const float* __restrict__ c_im,
                                           const float* __restrict__ dsk, const float* __restrict__ log_step, float* ypre  ) {
    const int b = blockIdx.x / S5G, g = blockIdx.x % S5G, p = threadIdx.x;
    const float step = expf(log_step[g]);
    const float lr = a_re[g * S5P + p], li = a_im[g * S5P + p];
    const float er = expf(lr * step); float sn, cs; sincosf(li * step, &sn, &cs);
    const float lbr = er * cs, lbi = er * sn;
    const float nr = lbr - 1.f, ni = lbi, den = lr * lr + li * li;
    const float fr = (nr * lr + ni * li) / den, fi = (ni * lr - nr * li) / den;
    float bbr[S5H], bbi[S5H], cr[S5H], ci[S5H], dd[S5H];
#pragma unroll
    for (int h = 0; h < S5H; ++h) {
        const float br = b_re[(g * S5P + p) * S5H + h], bi = b_im[(g * S5P + p) * S5H + h];
        bbr[h] = fr * br - fi * bi; bbi[h] = fr * bi + fi * br;
        cr[h] = c_re[(g * S5H + h) * S5P + p]; ci[h] = c_im[(g * S5H + h) * S5P + p];
        dd[h] = dsk[g * S5H + h];
    }
    float sr = 0.f, si = 0.f;
    for (int t = 0; t < SEQ; ++t) {
        const size_t row = (size_t)b * SEQ + t;
        const float4* up = (const float4*)(proj + row * EVEN_IN + g * S5H);
        float u[S5H];
#pragma unroll
        for (int q = 0; q < 4; ++q) { const float4 v = up[q]; u[4 * q] = v.x; u[4 * q + 1] = v.y; u[4 * q + 2] = v.z; u[4 * q + 3] = v.w; }
        float bur = 0.f, bui = 0.f;
#pragma unroll
        for (int h = 0; h < S5H; ++h) { bur = fmaf(bbr[h], u[h], bur); bui = fmaf(bbi[h], u[h], bui); }
        const float nsr = lbr * sr - lbi * si + bur, nsi = lbr * si + lbi * sr + bui;
        sr = nsr; si = nsi;
        float myy = 0.f;
#pragma unroll
        for (int h = 0; h < S5H; ++h) {
            float v = cr[h] * sr - ci[h] * si;
            for (int o = 32; o > 0; o >>= 1) v += __shfl_xor(v, o);
            if (p == h) myy = v + dd[h] * u[h];
        }
        if (p < S5H) {
            const float x = myy;
            const float y = 0.5f * x * (1.f + tanhf(0.7978845608028654f * (x + 0.044715f * x * x * x)));
            ypre[row * S5W + g * S5H + p] = y;
        }
    }
}

__device__ __forceinline__ float softplusf(float z) { return fmaxf(z, 0.f) + log1pf(expf(-fabsf(z))); }

__global__ void __launch_bounds__(128) k_sb(const float* __restrict__ proj  , float* mix  ) {
    const int qb = blockIdx.x, h = blockIdx.y, b = blockIdx.z;
    const int t = qb * 128 + threadIdx.x;
    const size_t rb = (size_t)b * SEQ;
    float q[HD], acc[HD];
    {
        const float4* qp = (const float4*)(proj + (rb + t) * EVEN_IN + 512 + h * HD);
#pragma unroll
        for (int i = 0; i < 16; ++i) { const float4 v = qp[i]; q[4 * i] = v.x * 0.125f; q[4 * i + 1] = v.y * 0.125f; q[4 * i + 2] = v.z * 0.125f; q[4 * i + 3] = v.w * 0.125f; }
#pragma unroll
        for (int i = 0; i < HD; ++i) acc[i] = 0.f;
    }
    float carry = 0.f;
    __shared__ float sK[32][HD];
    __shared__ float sV[32][HD];
    const int kend = qb * 128 + 128;
    for (int c0 = kend - 32; c0 >= 0; c0 -= 32) {
        __syncthreads();
        for (int e = threadIdx.x; e < 32 * 16; e += 128) {
            const int r = e >> 4, c = e & 15;
            ((float4*)&sK[r][0])[c] = ((const float4*)(proj + (rb + c0 + r) * EVEN_IN + 1024 + h * HD))[c];
            ((float4*)&sV[r][0])[c] = ((const float4*)(proj + (rb + c0 + r) * EVEN_IN + 1536 + h * HD))[c];
        }
        __syncthreads();
        for (int r = 31; r >= 0; --r) {
            const int s = c0 + r;
            if (s < t) {
                float z = 0.f;
#pragma unroll
                for (int i = 0; i < HD; ++i) z = fmaf(q[i], sK[r][i], z);
                const float sp = softplusf(z);
                const float w = expf(z - sp + carry);
                carry -= sp;
#pragma unroll
                for (int i = 0; i < HD; ++i) acc[i] = fmaf(w, sV[r][i], acc[i]);
            }
        }
    }
    float4* op = (float4*)(mix + (rb + t) * D + 512 + h * HD);
#pragma unroll
    for (int i = 0; i < 16; ++i) op[i] = make_float4(acc[4 * i], acc[4 * i + 1], acc[4 * i + 2], acc[4 * i + 3]);
}

__global__ void __launch_bounds__(256) k_cum(const float* __restrict__ proj  , const float* __restrict__ bf, float* cum  ) {
    const int h = blockIdx.x, b = blockIdx.y, t = threadIdx.x;
    const float bias = bf[h];
    float loc[32]; float s = 0.f;
#pragma unroll
    for (int i = 0; i < 32; ++i) {
        const float z = proj[((size_t)b * SEQ + t * 32 + i) * ODD_IN + 3072 + h] + bias;
        const float lf = -softplusf(-z);
        s += lf; loc[i] = s;
    }
    __shared__ float tot[256];
    tot[t] = s; __syncthreads();
    if (t == 0) { float r = 0.f; for (int i = 0; i < 256; ++i) { const float v = tot[i]; tot[i] = r; r += v; } }
    __syncthreads();
    const float base = tot[t];
#pragma unroll
    for (int i = 0; i < 32; ++i) cum[((size_t)b * FOXH + h) * SEQ + t * 32 + i] = base + loc[i];
}

__global__ void __launch_bounds__(128) k_fox(const float* __restrict__ proj  , const float* __restrict__ cum, float* o  ) {
    const int qb = blockIdx.x, h = blockIdx.y, b = blockIdx.z;
    const int t = qb * 128 + threadIdx.x;
    const size_t rb = (size_t)b * SEQ;
    const float* cm = cum + ((size_t)b * FOXH + h) * SEQ;
    float q[HD], acc[HD];
    {
        const float4* qp = (const float4*)(proj + (rb + t) * ODD_IN + h * HD);
#pragma unroll
        for (int i = 0; i < 16; ++i) { const float4 v = qp[i]; q[4 * i] = v.x * 0.125f; q[4 * i + 1] = v.y * 0.125f; q[4 * i + 2] = v.z * 0.125f; q[4 * i + 3] = v.w * 0.125f; }
#pragma unroll
        for (int i = 0; i < HD; ++i) acc[i] = 0.f;
    }
    const float ct = cm[t];
    float mx = -INFINITY, l = 0.f;
    __shared__ float sK[32][HD];
    __shared__ float sV[32][HD];
    __shared__ float sC[32];
    const int kend = qb * 128 + 128;
    for (int c0 = kend - 32; c0 >= 0; c0 -= 32) {
        __syncthreads();
        for (int e = threadIdx.x; e < 32 * 16; e += 128) {
            const int r = e >> 4, c = e & 15;
            ((float4*)&sK[r][0])[c] = ((const float4*)(proj + (rb + c0 + r) * ODD_IN + 1024 + h * HD))[c];
            ((float4*)&sV[r][0])[c] = ((const float4*)(proj + (rb + c0 + r) * ODD_IN + 2048 + h * HD))[c];
        }
        if (threadIdx.x < 32) sC[threadIdx.x] = cm[c0 + threadIdx.x];
        __syncthreads();
        for (int r = 31; r >= 0; --r) {
            const int s = c0 + r;
            if (s <= t) {
                float z = 0.f;
#pragma unroll
                for (int i = 0; i < HD; ++i) z = fmaf(q[i], sK[r][i], z);
                z += ct - sC[r];
                if (z > mx) {
                    const float f = expf(mx - z);
                    l *= f;
#pragma unroll
                    for (int i = 0; i < HD; ++i) acc[i] *= f;
                    mx = z;
                }
                const float w = expf(z - mx);
                l += w;
#pragma unroll
                for (int i = 0; i < HD; ++i) acc[i] = fmaf(w, sV[r][i], acc[i]);
            }
        }
    }
    const float il = 1.f / l;
    float4* op = (float4*)(o + (rb + t) * D + h * HD);
#pragma unroll
    for (int i = 0; i < 16; ++i) op[i] = make_float4(acc[4 * i] * il, acc[4 * i + 1] * il, acc[4 * i + 2] * il, acc[4 * i + 3] * il);
}

__global__ void __launch_bounds__(256) k_router(const float* __restrict__ hn  , const float* __restrict__ wr  , int* cnt  , int* list  , float* glist  ) {
    const int tok = blockIdx.x * 4 + (threadIdx.x >> 6), lane = threadIdx.x & 63;
    float lg[NEXP];
#pragma unroll
    for (int e = 0; e < NEXP; ++e) lg[e] = 0.f;
    for (int k = lane; k < D; k += 64) {
        const float x = hn[(size_t)tok * D + k];
        const float4 w0 = ((const float4*)(wr + (size_t)k * NEXP))[0], w1 = ((const float4*)(wr + (size_t)k * NEXP))[1];
        lg[0] = fmaf(x, w0.x, lg[0]); lg[1] = fmaf(x, w0.y, lg[1]); lg[2] = fmaf(x, w0.z, lg[2]); lg[3] = fmaf(x, w0.w, lg[3]);
        lg[4] = fmaf(x, w1.x, lg[4]); lg[5] = fmaf(x, w1.y, lg[5]); lg[6] = fmaf(x, w1.z, lg[6]); lg[7] = fmaf(x, w1.w, lg[7]);
    }
#pragma unroll
    for (int e = 0; e < NEXP; ++e) for (int o = 32; o > 0; o >>= 1) lg[e] += __shfl_xor(lg[e], o);
    if (lane == 0) {
        int i1 = 0; float v1 = lg[0];
#pragma unroll
        for (int e = 1; e < NEXP; ++e) if (lg[e] > v1) { v1 = lg[e]; i1 = e; }
        int i2 = -1; float v2 = -INFINITY;
#pragma unroll
        for (int e = 0; e < NEXP; ++e) if (e != i1 && lg[e] > v2) { v2 = lg[e]; i2 = e; }
        const float g1 = 1.f / (1.f + expf(v2 - v1)), g2 = 1.f - g1;
        const int p1 = atomicAdd(&cnt[i1], 1); list[i1 * M + p1] = tok; glist[i1 * M + p1] = g1;
        const int p2 = atomicAdd(&cnt[i2], 1); list[i2 * M + p2] = tok; glist[i2 * M + p2] = g2;
    }
}
}

extern "C" void kernel_launch(void* const* d_in, const int* in_sizes, int n_in, void* d_out, int out_size, void* d_ws, size_t ws_size, hipStream_t stream) {
    using namespace nv;
    const float* const* in = (const float* const*)d_in;
    const float* x = in[0];
    float* X = (float*)d_out;
    char* ws = (char*)d_ws;
    const size_t MB = 1u << 20;
    float* Hn = (float*)(ws + 0);
    float* MIX = (float*)(ws + 64 * MB);
    float* BIG = (float*)(ws + 128 * MB);
    float* YPRE = (float*)(ws + 352 * MB);
    float* CUM = (float*)(ws + 384 * MB);
    int* CNT = (int*)(ws + 386 * MB);
    int* LIST = (int*)(ws + 387 * MB);
    float* GL = (float*)(ws + 388 * MB);
    if (ws_size < 390 * MB) { fprintf(stderr, "ws too small: %zu\n", ws_size); return; }

    k_rmsnorm<<<M, 256, 0, stream>>>(x, in[1], Hn);
    k_gemm<0, false><<<dim3(EVEN_IN / 64, M / 64), 256, 0, stream>>>(Hn, D, in[2], nullptr, EVEN_IN, BIG, EVEN_IN, nullptr, 0, nullptr, M, nullptr, EVEN_IN, D, nullptr, nullptr);
    k_s5<<<BATCH * S5G, 64, 0, stream>>>(BIG, in[3], in[4], in[5], in[6], in[7], in[8], in[9], in[10], YPRE);
    k_gemm<3, false><<<dim3(S5W / 64, M / 64), 256, 0, stream>>>(YPRE, S5W, in[11], nullptr, S5W, MIX, D, YPRE, S5W, in[12], M, nullptr, S5W, S5W, nullptr, nullptr);
    k_sb<<<dim3(SEQ / 128, SBH, BATCH), 128, 0, stream>>>(BIG, MIX);
    k_gemm<1, false><<<dim3(D / 64, M / 64), 256, 0, stream>>>(MIX, D, in[13], nullptr, D, X, D, x, D, nullptr, M, nullptr, D, D, nullptr, nullptr);
    k_rmsnorm<<<M, 256, 0, stream>>>(X, in[14], Hn);
    k_gemm<2, false><<<dim3(DFF / 64, M / 64), 256, 0, stream>>>(Hn, D, in[15], in[16], DFF, BIG, DFF, nullptr, 0, nullptr, M, nullptr, DFF, D, nullptr, nullptr);
    k_gemm<1, false><<<dim3(D / 64, M / 64), 256, 0, stream>>>(BIG, DFF, in[17], nullptr, D, X, D, X, D, nullptr, M, nullptr, D, DFF, nullptr, nullptr);
    k_rmsnorm<<<M, 256, 0, stream>>>(X, in[18], Hn);
    k_gemm<0, false><<<dim3((ODD_IN + 63) / 64, M / 64), 256, 0, stream>>>(Hn, D, in[19], nullptr, ODD_IN, BIG, ODD_IN, nullptr, 0, nullptr, M, nullptr, ODD_IN, D, nullptr, nullptr);
    k_cum<<<dim3(FOXH, BATCH), 256, 0, stream>>>(BIG, in[20], CUM);
    k_fox<<<dim3(SEQ / 128, FOXH, BATCH), 128, 0, stream>>>(BIG, CUM, MIX);
    k_gemm<1, false><<<dim3(D / 64, M / 64), 256, 0, stream>>>(MIX, D, in[21], nullptr, D, X, D, X, D, nullptr, M, nullptr, D, D, nullptr, nullptr);
    k_rmsnorm<<<M, 256, 0, stream>>>(X, in[22], Hn);
    hipMemsetAsync(CNT, 0, 64, stream);
    k_router<<<M / 4, 256, 0, stream>>>(Hn, in[23], CNT, LIST, GL);
    for (int e = 0; e < NEXP; ++e) {
        const float* wg = in[24] + (size_t)e * D * DFE; const float* wu = in[25] + (size_t)e * D * DFE; const float* wd = in[26] + (size_t)e * DFE * D;
        k_gemm<2, true><<<dim3(DFE / 64, M / 64), 256, 0, stream>>>(Hn, D, wg, wu, DFE, BIG, DFE, nullptr, 0, nullptr, M, CNT + e, DFE, D, LIST + e * M, nullptr);
        k_gemm<4, false><<<dim3(D / 64, M / 64), 256, 0, stream>>>(BIG, DFE, wd, nullptr, D, X, D, nullptr, 0, nullptr, M, CNT + e, D, DFE, LIST + e * M, GL + e * M);
    }
    k_rmsnorm<<<M, 256, 0, stream>>>(X, in[27], X);
}
```

```cpp
#include <hip/hip_runtime.h>
#include <cstdio>
#include <cstdint>

namespace pg8 {
#define PG8_LAS __attribute__((address_space(3)))
typedef unsigned short bf16_t;
typedef short bf16x8 __attribute__((ext_vector_type(8)));
typedef float f32x4 __attribute__((ext_vector_type(4)));
typedef unsigned u32x4 __attribute__((ext_vector_type(4)));
typedef unsigned u32x2 __attribute__((ext_vector_type(2)));
constexpr int BM = 256, BK = 64, HALF = 128, HTB = HALF * BK * 2  , STAGE_BYTES = 8 * HTB, NXCD = 8, WGM = 8;

__host__ __device__ __forceinline__ int lds_byte(int r, int c) { const int st = (r >> 4) * 2 + (c >> 5), rr = r & 15, cc = c & 31, ob = rr * 64 + cc * 2; return st * 1024 + (ob ^ (((ob >> 9) & 1) << 5)); }
__host__ __device__ __forceinline__ void stage_rc(int b, int& R, int& C) { const int st = b / 1024, sb = b % 1024, swz = sb ^ (((sb >> 9) & 1) << 5); R = (st >> 1) * 16 + swz / 64; C = (st & 1) * 32 + (swz % 64) / 2; }
__host__ __device__ __forceinline__ int perm32(int rho) { const int n = rho >> 4, i = rho & 15; return 8 * (i >> 2) + 4 * n + (i & 3); }

struct Unit { int pm, pn, zb; };
struct Gemm { const bf16_t* A; const bf16_t* Bt; int lda, ldb, K; size_t zA, zB; };

struct StaticOrder {
    int nM, nN, nZ, nwg, G, c;
    __host__ __device__ void init(int M, int N, int Z, int G_, int c_) { nM = M / BM; nN = N / BM; nZ = Z; nwg = nM * nN * nZ; G = G_; c = c_; }
    __host__ __device__ bool next(int i, Unit& u) const {
        const long L = (long)i * G + c; if (L >= nwg) return false;
        int wgid = (int)L; { const int q = nwg / NXCD, r = nwg % NXCD, xcd = wgid % NXCD, off = wgid / NXCD; wgid = (xcd < r ? xcd * (q + 1) : r * (q + 1) + (xcd - r) * q) + off; }
        const int per = nM * nN; u.zb = wgid / per; wgid -= u.zb * per;
        const int nig = WGM * nN, gid = wgid / nig, fm = gid * WGM, gsz = (nM - fm) < WGM ? (nM - fm) : WGM;
        u.pm = fm + ((wgid % nig) % gsz); u.pn = (wgid % nig) / gsz; return true;
    }
    __device__ __forceinline__ void a_ready(const Unit&) const {}
    __device__ __forceinline__ void done(const Unit&) const {}
};

__device__ __forceinline__ unsigned cvt_pk_bf16(float lo, float hi) { unsigned r; asm volatile("v_cvt_pk_bf16_f32 %0, %1, %2" : "=v"(r) : "v"(lo), "v"(hi)); return r; }
__device__ __forceinline__ float bf_lo(unsigned w) { return __uint_as_float(w << 16); }
__device__ __forceinline__ float bf_hi(unsigned w) { return __uint_as_float(w & 0xffff0000u); }
__device__ __forceinline__ float fast_sigmoid(float z) { return __builtin_amdgcn_rcpf(1.0f + __builtin_amdgcn_exp2f(-1.4426950408889634f * z)); }
constexpr float RMS_EPS = 1e-6f;
__device__ __forceinline__ float rstd16(const float* ssp, int row) { const f32x4* p = (const f32x4*)(ssp + (size_t)row * 16); const f32x4 a = p[0], b = p[1], c = p[2], d = p[3];
    const float s = (((a[0] + a[1]) + (a[2] + a[3])) + ((b[0] + b[1]) + (b[2] + b[3]))) + (((c[0] + c[1]) + (c[2] + c[3])) + ((d[0] + d[1]) + (d[2] + d[3])));
    return __builtin_amdgcn_rsqf(s * (1.0f / 1024.0f) + RMS_EPS); }

__device__ __forceinline__ u32x4 pack8(const f32x4 v0, const f32x4 v1) { u32x4 w; w.x = cvt_pk_bf16(v0[0], v0[1]); w.y = cvt_pk_bf16(v0[2], v0[3]); w.z = cvt_pk_bf16(v1[0], v1[1]); w.w = cvt_pk_bf16(v1[2], v1[3]); return w; }

struct EpiInProj0 {
    static constexpr bool PERM = true, AFTER_DRAIN = false;
    const float* ss; bf16_t* uext; bf16_t* qkv; float qscale;
    __device__ __forceinline__ void operator()(const f32x4 (&acc)[2][2][4][2], const Unit& u, int wr, int wc, int fr, int fq) const {
        const int row0 = u.pm * BM + wr * 64 + fr;
#pragma unroll
        for (int ai = 0; ai < 2; ++ai)
#pragma unroll
            for (int m = 0; m < 4; ++m) { const int row = row0 + ai * HALF + m * 16; const float rs = rstd16(ss, row);
#pragma unroll
                for (int bj = 0; bj < 2; ++bj) { const int col0 = u.pn * BM + bj * HALF + wc * 32 + 8 * fq;
                    float sc = rs; bf16_t* dst;
                    if (u.pn < 2) dst = uext + ((size_t)(col0 >> 4) * 512 + (row >> 5)) * 640 + (row & 31) * 16 + (col0 & 15);
                    else { const int c = col0 - 512; if (c < 512) sc *= qscale; dst = qkv + (size_t)row * 1536 + c; }
                    *(u32x4*)dst = pack8(acc[ai][bj][m][0] * sc, acc[ai][bj][m][1] * sc); } }
    }
};
struct EpiS5State {
    static constexpr bool PERM = false, AFTER_DRAIN = false;
    float* sloc;
    __device__ __forceinline__ void operator()(const f32x4 (&acc)[2][2][4][2], const Unit& u, int wr, int wc, int fr, int fq) const {
        const int row0 = u.pm * BM + wr * 64 + fr, col0 = wc * 32 + 4 * fq;
#pragma unroll
        for (int ai = 0; ai < 2; ++ai)
#pragma unroll
            for (int m = 0; m < 4; ++m) { float* rowp = sloc + ((size_t)u.zb * 512 + row0 + ai * HALF + m * 16) * 128 + col0;
#pragma unroll
                for (int n = 0; n < 2; ++n) *(f32x4*)(rowp + n * 16) = acc[ai][0][m][n]; }
    }
};
__device__ __forceinline__ float gelu_tanh(float x) { const float a = x * (1.0f + 0.044715f * x * x); return x * __builtin_amdgcn_rcpf(1.0f + __builtin_amdgcn_exp2f(-2.302208198f * a)); }
struct EpiS5Y {
    static constexpr bool PERM = true, AFTER_DRAIN = false;
    bf16_t* yg;
    __device__ __forceinline__ void operator()(const f32x4 (&acc)[2][2][4][2], const Unit& u, int wr, int wc, int fr, int fq) const {
        const int row0 = u.pm * BM + wr * 64 + fr;
#pragma unroll
        for (int ai = 0; ai < 2; ++ai)
#pragma unroll
            for (int m = 0; m < 4; ++m) { const int chunk = row0 + ai * HALF + m * 16;
#pragma unroll
                for (int bj = 0; bj < 2; ++bj) { const int col0 = u.pn * BM + bj * HALF + wc * 32 + 8 * fq; const int i = col0 >> 4, h0 = col0 & 15;
                    f32x4 v0 = acc[ai][bj][m][0], v1 = acc[ai][bj][m][1];
#pragma unroll
                    for (int e = 0; e < 4; ++e) { v0[e] = gelu_tanh(v0[e]); v1[e] = gelu_tanh(v1[e]); }
                    *(u32x4*)(yg + ((size_t)chunk * 32 + i) * 512 + u.zb * 16 + h0) = pack8(v0, v1); } }
    }
};
struct EpiGlu {
    static constexpr bool PERM = true, AFTER_DRAIN = false;
    const bf16_t* yg; const float* bias; bf16_t* mix;
    __device__ __forceinline__ void operator()(const f32x4 (&acc)[2][2][4][2], const Unit& u, int wr, int wc, int fr, int fq) const {
        const int row0 = u.pm * BM + wr * 64 + fr;
#pragma unroll
        for (int bj = 0; bj < 2; ++bj) { const int col0 = u.pn * BM + bj * HALF + wc * 32 + 8 * fq;
            const f32x4 b0 = *(const f32x4*)(bias + col0), b1 = *(const f32x4*)(bias + col0 + 4);
#pragma unroll
            for (int ai = 0; ai < 2; ++ai)
#pragma unroll
                for (int m = 0; m < 4; ++m) { const int row = row0 + ai * HALF + m * 16;
                    const u32x4 yw = *(const u32x4*)(yg + (size_t)row * 512 + col0);
                    f32x4 z0 = acc[ai][bj][m][0] + b0, z1 = acc[ai][bj][m][1] + b1, o0, o1;
                    o0[0] = bf_lo(yw.x) * fast_sigmoid(z0[0]); o0[1] = bf_hi(yw.x) * fast_sigmoid(z0[1]); o0[2] = bf_lo(yw.y) * fast_sigmoid(z0[2]); o0[3] = bf_hi(yw.y) * fast_sigmoid(z0[3]);
                    o1[0] = bf_lo(yw.z) * fast_sigmoid(z1[0]); o1[1] = bf_hi(yw.z) * fast_sigmoid(z1[1]); o1[2] = bf_lo(yw.w) * fast_sigmoid(z1[2]); o1[3] = bf_hi(yw.w) * fast_sigmoid(z1[3]);
                    *(u32x4*)(mix + (size_t)row * 1024 + col0) = pack8(o0, o1); } }
    }
};
struct EpiResid {
    static constexpr bool PERM = false, AFTER_DRAIN = false;
    const float* R; float* X; bf16_t* xb; float* ssq;
    __device__ __forceinline__ void operator()(const f32x4 (&acc)[2][2][4][2], const Unit& u, int wr, int wc, int fr, int fq) const {
        const int row0 = u.pm * BM + wr * 64 + fr, col0 = u.pn * BM + wc * 32 + 4 * fq;
#pragma unroll
        for (int ai = 0; ai < 2; ++ai)
#pragma unroll
            for (int m = 0; m < 4; ++m) { const int row = row0 + ai * HALF + m * 16; const size_t off = (size_t)row * 1024 + col0; float s = 0.f;
#pragma unroll
                for (int bj = 0; bj < 2; ++bj)
#pragma unroll
                    for (int n = 0; n < 2; ++n) { const f32x4 x = *(const f32x4*)(R + off + bj * HALF + n * 16) + acc[ai][bj][m][n];
                        *(f32x4*)(X + off + bj * HALF + n * 16) = x; s += (x[0] * x[0] + x[1] * x[1]) + (x[2] * x[2] + x[3] * x[3]);
                        u32x2 w; w.x = cvt_pk_bf16(x[0], x[1]); w.y = cvt_pk_bf16(x[2], x[3]); *(u32x2*)(xb + off + bj * HALF + n * 16) = w; }
                s += __shfl_xor(s, 16); s += __shfl_xor(s, 32);
                if (fq == 0) ssq[(size_t)row * 16 + u.pn * 4 + wc] = s; }
    }
};
template <bool RS_IS_SSQ> struct EpiSwiGlu {
    static constexpr bool PERM = true, AFTER_DRAIN = false;
    const float* rsv; bf16_t* H; int ldh;
    __device__ __forceinline__ void operator()(const f32x4 (&acc)[2][2][4][2], const Unit& u, int wr, int wc, int fr, int fq) const {
        const int row0 = u.pm * BM + wr * 64 + fr, col0 = u.pn * HALF + wc * 32 + 8 * fq;
#pragma unroll
        for (int ai = 0; ai < 2; ++ai)
#pragma unroll
            for (int m = 0; m < 4; ++m) { const int row = row0 + ai * HALF + m * 16; const float rs = RS_IS_SSQ ? rstd16(rsv, row) : rsv[row];
                f32x4 o[2];
#pragma unroll
                for (int n = 0; n < 2; ++n)
#pragma unroll
                    for (int e = 0; e < 4; ++e) { const float g = acc[ai][0][m][n][e] * rs, up = acc[ai][1][m][n][e] * rs; o[n][e] = g * fast_sigmoid(g) * up; }
                *(u32x4*)(H + (size_t)row * ldh + col0) = pack8(o[0], o[1]); }
    }
};
struct EpiInProj1 {
    static constexpr bool PERM = true, AFTER_DRAIN = false;
    const float* ss; bf16_t* qkv; float qscale;
    __device__ __forceinline__ void operator()(const f32x4 (&acc)[2][2][4][2], const Unit& u, int wr, int wc, int fr, int fq) const {
        const int row0 = u.pm * BM + wr * 64 + fr; const float qs = (u.pn < 4) ? qscale : 1.0f;
#pragma unroll
        for (int ai = 0; ai < 2; ++ai)
#pragma unroll
            for (int m = 0; m < 4; ++m) { const int row = row0 + ai * HALF + m * 16; const float sc = rstd16(ss, row) * qs;
#pragma unroll
                for (int bj = 0; bj < 2; ++bj) { const int col0 = u.pn * BM + bj * HALF + wc * 32 + 8 * fq;
                    *(u32x4*)(qkv + (size_t)row * 3072 + col0) = pack8(acc[ai][bj][m][0] * sc, acc[ai][bj][m][1] * sc); } }
    }
};
struct EpiStoreBf16 {
    static constexpr bool PERM = true, AFTER_DRAIN = false;
    bf16_t* O; int ldc;
    __device__ __forceinline__ void operator()(const f32x4 (&acc)[2][2][4][2], const Unit& u, int wr, int wc, int fr, int fq) const {
        const int row0 = u.pm * BM + wr * 64 + fr;
#pragma unroll
        for (int ai = 0; ai < 2; ++ai)
#pragma unroll
            for (int m = 0; m < 4; ++m) { const int row = row0 + ai * HALF + m * 16;
#pragma unroll
                for (int bj = 0; bj < 2; ++bj) { const int col0 = u.pn * BM + bj * HALF + wc * 32 + 8 * fq;
                    *(u32x4*)(O + (size_t)row * ldc + col0) = pack8(acc[ai][bj][m][0], acc[ai][bj][m][1]); } }
    }
};

template <class Epi, class Sched, bool ALIGN_EPI = false, bool SP2 = false>
__device__ __forceinline__ void gemm_phase(PG8_LAS unsigned char* lds, const Gemm g, const Sched& S, const Epi& E) {
    const int tid = threadIdx.x, wid = __builtin_amdgcn_readfirstlane(tid >> 6), lane = tid & 63, wr = wid >> 2, wc = wid & 3, fr = lane & 15, fq = lane >> 4;
    const int K = g.K, nt = K / BK;
    unsigned voffA[2], voffB[2];
#pragma unroll
    for (int i = 0; i < 2; ++i) { int R, C; stage_rc(tid * 16 + i * 8192, R, C); const int Rb = Epi::PERM ? ((R & ~31) + perm32(R & 31)) : R;
        voffA[i] = (unsigned)(R * g.lda + C) * 2u; voffB[i] = (unsigned)(Rb * g.ldb + C) * 2u; }
    const size_t kstep = (size_t)(BK * 2);
    const size_t hstepA = (size_t)HALF * g.lda * 2, hstepB = (size_t)HALF * g.ldb * 2;
    const size_t tstepA = 2 * hstepA, tstepB = 2 * hstepB;
    const unsigned ldsw = (unsigned)wid * 1024u;
    const int aoff = lds_byte(wr * 64 + fr, fq * 8), boff = lds_byte(wc * 32 + fr, fq * 8);
#define PG8_SA(b, h) (((b) * 2 + (h)) * HTB)
#define PG8_SB(b, h) ((4 + (b) * 2 + (h)) * HTB)
#define PG8_STAGE(bufoff, gbase, voff) do { _Pragma("unroll") for (int _i = 0; _i < 2; ++_i) \
        __builtin_amdgcn_global_load_lds((const unsigned*)((const char*)(gbase) + (voff)[_i]), (PG8_LAS unsigned*)(lds + (bufoff) + ldsw + _i * 8192), 16, 0, 0); } while (0)
#define PG8_LDA(dst, b, h) do { _Pragma("unroll") for (int m = 0; m < 4; ++m) _Pragma("unroll") for (int k = 0; k < 2; ++k) dst[m][k] = *(const PG8_LAS bf16x8*)(lds + PG8_SA(b, h) + aoff + m * 2048 + k * 1024); } while (0)
#define PG8_LDB(dst, b, h) do { _Pragma("unroll") for (int n = 0; n < 2; ++n) _Pragma("unroll") for (int k = 0; k < 2; ++k) dst[n][k] = *(const PG8_LAS bf16x8*)(lds + PG8_SB(b, h) + boff + n * 2048 + k * 1024); } while (0)
#define PG8_MMA(ai, bj, At, Bt) do { __builtin_amdgcn_s_setprio(1); _Pragma("unroll") for (int m = 0; m < 4; ++m) _Pragma("unroll") for (int n = 0; n < 2; ++n) _Pragma("unroll") for (int k = 0; k < 2; ++k) \
        acc[ai][bj][m][n] = __builtin_amdgcn_mfma_f32_16x16x32_bf16(Bt[n][k], At[m][k], acc[ai][bj][m][n], 0, 0, 0); __builtin_amdgcn_s_setprio(0); } while (0)
#define PG8_WAIT_V(n) asm volatile("s_waitcnt vmcnt(" #n ")" ::: "memory")
#define PG8_WAIT_L(n) asm volatile("s_waitcnt lgkmcnt(" #n ")" ::: "memory")
#define PG8_BAR __builtin_amdgcn_s_barrier()
#define PG8_SCHED __builtin_amdgcn_sched_barrier(0)
    Unit cur, nxt; int ui = 0;
    if (!S.next(0, cur)) return;
    f32x4 acc[2][2][4][2];
#pragma unroll
    for (int a = 0; a < 2; ++a)
#pragma unroll
        for (int b = 0; b < 2; ++b)
#pragma unroll
            for (int m = 0; m < 4; ++m)
#pragma unroll
                for (int n = 0; n < 2; ++n) acc[a][b][m][n] = (f32x4){0.f, 0.f, 0.f, 0.f};
    bf16x8 At[4][2], B0[2][2], B1[2][2];
    const char* cA = (const char*)g.A + (size_t)cur.zb * g.zA + (size_t)cur.pm * tstepA; const char* cB = (const char*)g.Bt + (size_t)cur.zb * g.zB + (size_t)cur.pn * tstepB;
    S.a_ready(cur);
    if constexpr (SP2) {
        PG8_STAGE(PG8_SB(0, 0), cB, voffB); PG8_STAGE(PG8_SB(0, 1), cB + hstepB, voffB); PG8_STAGE(PG8_SA(0, 0), cA, voffA); PG8_STAGE(PG8_SA(0, 1), cA + hstepA, voffA);
        if (wr == 1) PG8_BAR;
        PG8_WAIT_V(2); PG8_BAR;
        PG8_STAGE(PG8_SB(1, 0), cB + kstep, voffB); PG8_STAGE(PG8_SA(1, 0), cA + kstep, voffA); PG8_STAGE(PG8_SB(1, 1), cB + hstepB + kstep, voffB);
        PG8_WAIT_V(6); PG8_BAR;
    } else {
        PG8_STAGE(PG8_SB(0, 0), cB, voffB); PG8_STAGE(PG8_SA(0, 0), cA, voffA); PG8_STAGE(PG8_SB(0, 1), cB + hstepB, voffB); PG8_STAGE(PG8_SA(0, 1), cA + hstepA, voffA);
        if (wr == 1) PG8_BAR;
        PG8_WAIT_V(4); PG8_BAR;
        PG8_STAGE(PG8_SB(1, 0), cB + kstep, voffB); PG8_STAGE(PG8_SA(1, 0), cA + kstep, voffA); PG8_STAGE(PG8_SB(1, 1), cB + hstepB + kstep, voffB);
        PG8_WAIT_V(6); PG8_BAR;
    }
    for (;;) {
        const bool has_next = S.next(ui + 1, nxt);
        const char* nA = has_next ? (const char*)g.A + (size_t)nxt.zb * g.zA + (size_t)nxt.pm * tstepA : cA; const char* nB = has_next ? (const char*)g.Bt + (size_t)nxt.zb * g.zB + (size_t)nxt.pn * tstepB : cB;
        for (int t = 0; t < nt; t += 2) {
            const bool last = (t == nt - 2);
            const char* a1 = cA + (size_t)(t + 1) * kstep;
            const char* a2 = last ? nA : cA + (size_t)(t + 2) * kstep; const char* b2 = last ? nB : cB + (size_t)(t + 2) * kstep;
            const char* a3 = a2 + kstep; const char* b3 = b2 + kstep;
            if (last && has_next) S.a_ready(nxt);
            if constexpr (SP2) {
            PG8_LDB(B0, 0, 0); PG8_LDB(B1, 0, 1); PG8_SCHED; PG8_LDA(At, 0, 0); PG8_STAGE(PG8_SA(1, 1), a1 + hstepA, voffA);
            PG8_WAIT_V(8); PG8_WAIT_L(0); PG8_BAR; PG8_MMA(0, 0, At, B0); PG8_MMA(0, 1, At, B1); PG8_BAR; PG8_SCHED;
            PG8_LDA(At, 0, 1); PG8_STAGE(PG8_SB(0, 0), b2, voffB); PG8_STAGE(PG8_SB(0, 1), b2 + hstepB, voffB); PG8_STAGE(PG8_SA(0, 0), a2, voffA);
            PG8_WAIT_V(8); PG8_WAIT_L(0); PG8_BAR; PG8_MMA(1, 0, At, B0); PG8_MMA(1, 1, At, B1); PG8_BAR; PG8_SCHED;
            PG8_LDB(B0, 1, 0); PG8_LDB(B1, 1, 1); PG8_SCHED; PG8_LDA(At, 1, 0); PG8_STAGE(PG8_SA(0, 1), a2 + hstepA, voffA);
            PG8_WAIT_V(8); PG8_WAIT_L(0); PG8_BAR; PG8_MMA(0, 0, At, B0); PG8_MMA(0, 1, At, B1); PG8_BAR; PG8_SCHED;
            PG8_LDA(At, 1, 1); PG8_STAGE(PG8_SB(1, 0), b3, voffB); PG8_STAGE(PG8_SB(1, 1), b3 + hstepB, voffB); PG8_STAGE(PG8_SA(1, 0), a3, voffA);
            PG8_WAIT_V(8); PG8_WAIT_L(0); PG8_BAR; PG8_MMA(1, 0, At, B0); PG8_MMA(1, 1, At, B1); PG8_BAR; PG8_SCHED;
            } else {
            PG8_LDB(B0, 0, 0); PG8_SCHED; PG8_LDA(At, 0, 0); PG8_STAGE(PG8_SA(1, 1), a1 + hstepA, voffA);
            PG8_WAIT_L(8); PG8_BAR; PG8_WAIT_L(0); PG8_MMA(0, 0, At, B0); PG8_BAR; PG8_SCHED;
            PG8_LDB(B1, 0, 1); PG8_STAGE(PG8_SB(0, 0), b2, voffB);
            PG8_BAR; PG8_WAIT_L(0); PG8_MMA(0, 1, At, B1); PG8_BAR;
            PG8_LDA(At, 0, 1); PG8_STAGE(PG8_SA(0, 0), a2, voffA);
            PG8_BAR; PG8_WAIT_L(0); PG8_MMA(1, 0, At, B0); PG8_BAR; PG8_SCHED;
            PG8_STAGE(PG8_SB(0, 1), b2 + hstepB, voffB);
            PG8_WAIT_V(6); PG8_BAR; PG8_MMA(1, 1, At, B1); PG8_BAR;
            PG8_LDB(B0, 1, 0); PG8_SCHED; PG8_LDA(At, 1, 0); PG8_STAGE(PG8_SA(0, 1), a2 + hstepA, voffA);
            PG8_WAIT_L(8); PG8_BAR; PG8_WAIT_L(0); PG8_MMA(0, 0, At, B0); PG8_BAR; PG8_SCHED;
            PG8_LDB(B1, 1, 1); PG8_STAGE(PG8_SB(1, 0), b3, voffB);
            PG8_BAR; PG8_WAIT_L(0); PG8_MMA(0, 1, At, B1); PG8_BAR;
            PG8_LDA(At, 1, 1); PG8_STAGE(PG8_SA(1, 0), a3, voffA);
            PG8_BAR; PG8_WAIT_L(0); PG8_MMA(1, 0, At, B0); PG8_BAR; PG8_SCHED;
            PG8_STAGE(PG8_SB(1, 1), b3 + hstepB, voffB);
            PG8_WAIT_V(6); PG8_BAR; PG8_MMA(1, 1, At, B1); PG8_BAR;
            }
        }
        if constexpr (ALIGN_EPI) { if (wr == 0) PG8_BAR; }
        if constexpr (!Epi::AFTER_DRAIN) { E(acc, cur, wr, wc, fr, fq); S.done(cur); }
        if (!has_next) break;
#pragma unroll
        for (int a = 0; a < 2; ++a)
#pragma unroll
            for (int b = 0; b < 2; ++b)
#pragma unroll
                for (int m = 0; m < 4; ++m)
#pragma unroll
                    for (int n = 0; n < 2; ++n) acc[a][b][m][n] = (f32x4){0.f, 0.f, 0.f, 0.f};
        cur = nxt; cA = nA; cB = nB; ++ui;
        if constexpr (ALIGN_EPI) { if (wr == 1) PG8_BAR; }
    }
    PG8_WAIT_V(0);
    if constexpr (!ALIGN_EPI) { if (wr == 0) PG8_BAR; }
    PG8_BAR;
    if constexpr (Epi::AFTER_DRAIN) { E.fused(acc, cur, wr, wc, fr, fq, lds, wid, lane); S.done(cur); }
#undef PG8_SA
#undef PG8_SB
#undef PG8_STAGE
#undef PG8_LDA
#undef PG8_LDB
#undef PG8_MMA
#undef PG8_WAIT_V
#undef PG8_WAIT_L
#undef PG8_BAR
#undef PG8_SCHED
}
}

constexpr int NWAVES = 8, NTHREADS = NWAVES * 64;
constexpr int BATCH = 2, SEQ = 8192, D = 1024, M = BATCH * SEQ;
constexpr int S5G = 32, S5H = 16, S5P = 64, S5T = 32  , S5NC = M / S5T  , S5KX = 640  ;
constexpr int SBH = 8, FOXH = 16, HD = 64;
constexpr int EVEN_IN = 2048, ODD_IN = 3088, DFF = 2816, NEXP = 8, DFE = 3584;
constexpr float C2 = 0.125f * 1.4426950408889634f;
constexpr int MOE_CHUNK_PANELS = 68, MOE_MAX_PANELS = 136, MOE_MAX_SLOTS = MOE_MAX_PANELS * 256;

constexpr size_t MiB = 1u << 20;
constexpr size_t WS_CTL = 0, CTL_ZERO_BYTES = 1 * MiB;
constexpr size_t WS_WMOE_GU = 1 * MiB;
constexpr size_t WS_WMOE_D = 113 * MiB;
constexpr size_t WS_WIN0 = 169 * MiB;
constexpr size_t WS_WGLU = 173 * MiB;
constexpr size_t WS_WOUT0 = 174 * MiB;
constexpr size_t WS_WGU0 = 176 * MiB;
constexpr size_t WS_WD0 = 187 * MiB;
constexpr size_t WS_WIN1 = 193 * MiB;
constexpr size_t WS_WF1 = 199 * MiB;
constexpr size_t WS_WOUT1 = 200 * MiB;
constexpr size_t WS_S5WA = 202 * MiB;
constexpr size_t WS_S5WC = 210 * MiB;
constexpr size_t WS_XB = 230 * MiB;
constexpr size_t WS_QKV0 = 262 * MiB;
constexpr size_t WS_UEXT = 310 * MiB;
constexpr size_t WS_SLOC = 330 * MiB;
constexpr size_t WS_YG = 338 * MiB;
constexpr size_t WS_MIXB = 354 * MiB;
constexpr size_t WS_HID0 = 262 * MiB;
constexpr size_t WS_QKV1 = 262 * MiB;
constexpr size_t WS_LOGF = 358 * MiB;
constexpr size_t WS_O1 = 359 * MiB;
constexpr size_t WS_META = 356 * MiB;
constexpr size_t WS_XG = 288 * MiB;
constexpr size_t WS_HMOE = 169 * MiB;
constexpr size_t WS_SSP = 392 * MiB;
constexpr size_t WS_END = 396 * MiB;
static_assert(WS_HMOE + (size_t)MOE_CHUNK_PANELS * 256 * DFE * 2 <= WS_XG && WS_XG + (size_t)MOE_MAX_SLOTS * 1024 * 2 <= WS_META && WS_O1 + (size_t)M * 1024 * 2 <= WS_END, "ws map");
constexpr size_t MT_RSTD = 0, MT_TOKE = 65536, MT_TOKP = 131072, MT_TOKG = 262144, MT_TOKSLOT = 393216, MT_RSS = 524288;
constexpr int CW_TMO = 0, CW_CODE = 1, CW_BAR = 4096, CW_CNT = 8192  , CW_SS = 32768  ;

constexpr int RING_OFF = 0, RING_BYTES = 131072;
constexpr int LDSCTL_OFF = RING_BYTES, MISC_OFF = LDSCTL_OFF + 320;
constexpr int LDS_BYTES = 147456;

#define GAS __attribute__((address_space(1)))
#define LAS __attribute__((address_space(3)))
typedef unsigned short bf16;
typedef unsigned v4u __attribute__((ext_vector_type(4)));
typedef unsigned v2u __attribute__((ext_vector_type(2)));
typedef float f32x4 __attribute__((ext_vector_type(4)));
typedef short bf16x8 __attribute__((ext_vector_type(8)));
typedef GAS unsigned gu32;
#define RLX_AGENT __ATOMIC_RELAXED, __HIP_MEMORY_SCOPE_AGENT
#define LDS_WAIT() asm volatile("s_waitcnt lgkmcnt(0)" ::: "memory")
#define VM_WAIT() asm volatile("s_waitcnt vmcnt(0)" ::: "memory")
__device__ __forceinline__ unsigned f2bf(float f) { unsigned u = __builtin_bit_cast(unsigned, f); return (u + 0x7fffu + ((u >> 16) & 1u)) >> 16; }
__device__ __forceinline__ unsigned pk2(float lo, float hi) { return f2bf(lo) | (f2bf(hi) << 16); }
__device__ __forceinline__ float bflo(unsigned w) { return __uint_as_float(w << 16); }
__device__ __forceinline__ float bfhi(unsigned w) { return __uint_as_float(w & 0xffff0000u); }

#define XB_TMO      128
#define XB_XCNT(j)  (256  + 64 * (j))
#define XB_XSUB(j)  (1280 + 64 * (j))
#define XB_XGEN(j)  (2304 + 64 * (j))
#define XB_TOP      3328
#define XB_TOPGEN   3392
#define XCD_BAR_WORDS 3456
#define XB_SPIN_CAP (1u << 18)
__device__ __forceinline__ unsigned xb_ld(unsigned* p)              { return __hip_atomic_load(p, __ATOMIC_RELAXED, __HIP_MEMORY_SCOPE_AGENT); }
__device__ __forceinline__ unsigned xb_add(unsigned* p, unsigned v) { return __hip_atomic_fetch_add(p, v, __ATOMIC_RELAXED, __HIP_MEMORY_SCOPE_AGENT); }
__device__ __forceinline__ unsigned xb_xcc_id() { return (unsigned)__builtin_amdgcn_s_getreg((3 << 11) | 20) & 0xFu; }
#define XB_SPIN(cond, bar) do { unsigned _sp = 0; while (cond) { __builtin_amdgcn_s_sleep(1); \
    if ((++_sp & 255u) == 0u) { if (xb_ld(&(bar)[XB_TMO])) break; if (_sp > XB_SPIN_CAP) { atomicAdd(&(bar)[XB_TMO], 1u); break; } } } } while (0)
struct XcdBarrier { unsigned* bar; unsigned x; volatile LAS unsigned* st; };
__device__ __forceinline__ XcdBarrier xcd_barrier_post(unsigned* bar, volatile LAS unsigned* st) {
    XcdBarrier b; b.bar = bar; b.x = xb_xcc_id(); b.st = st;
    if (threadIdx.x == 0) (void)xb_add(&bar[XB_XCNT(b.x)], 1u);
    return b;
}
__device__ __forceinline__ void xcd_barrier_complete(unsigned* bar, unsigned x, unsigned& nloc, unsigned& nx) {
    const unsigned G = gridDim.x * gridDim.y * gridDim.z;
    unsigned sum, cnt, mine, sp = 0u;
    for (;;) {
        sum = 0u; cnt = 0u; mine = 0u;
#pragma unroll
        for (unsigned j = 0; j < 16; ++j) { const unsigned c = xb_ld(&bar[XB_XCNT(j)]); sum += c; cnt += (c > 0u) ? 1u : 0u; mine = (j == x) ? c : mine; }
        if (sum == G) break;
        __builtin_amdgcn_s_sleep(1);
        if ((++sp & 255u) == 0u) { if (xb_ld(&bar[XB_TMO])) break; if (sp > XB_SPIN_CAP) { atomicAdd(&bar[XB_TMO], 1u); break; } }
    }
    nloc = mine > 0u ? mine : 1u; nx = cnt > 0u ? cnt : 1u;
}
__device__ __forceinline__ void xcd_barrier(const XcdBarrier& b) {
    asm volatile("s_waitcnt vmcnt(0)" ::: "memory");
    __syncthreads();
    if (threadIdx.x == 0) {
        unsigned* bar = b.bar;
        __builtin_amdgcn_s_waitcnt(0);
        unsigned nloc = b.st[0], nx = b.st[1];
        if (nloc == 0u) { xcd_barrier_complete(bar, b.x, nloc, nx); b.st[0] = nloc; b.st[1] = nx; }
        const unsigned old = xb_add(&bar[XB_XSUB(b.x)], 1u);
        const unsigned gen = old / nloc;
        if (old + 1u == (gen + 1u) * nloc) {
            __builtin_amdgcn_fence(__ATOMIC_RELEASE, "agent");
            asm volatile("s_waitcnt vmcnt(0)" ::: "memory");
            const unsigned og = xb_add(&bar[XB_TOP], 1u);
            const unsigned tg = og / nx;
            if (og + 1u == (tg + 1u) * nx) xb_add(&bar[XB_TOPGEN], 1u);
            else XB_SPIN(xb_ld(&bar[XB_TOPGEN]) == tg, bar);
            __builtin_amdgcn_fence(__ATOMIC_ACQUIRE, "agent");
            xb_add(&bar[XB_XGEN(b.x)], 1u);
            asm volatile("s_waitcnt vmcnt(0)" ::: "memory");
        } else {
            XB_SPIN(xb_ld(&bar[XB_XGEN(b.x)]) == gen, bar);
            __builtin_amdgcn_fence(__ATOMIC_ACQUIRE, "agent");
            asm volatile("s_waitcnt vmcnt(0)" ::: "memory");
        }
    }
    __syncthreads();
}

__device__ __forceinline__ float wave_sum(float v) {
#pragma unroll
    for (int o = 1; o < 64; o <<= 1) v += __shfl_xor(v, o);
    return v;
}
__device__ __forceinline__ void p0_transpose_item(const float* W, int ldw, int k0, int n0, const float* gs, bf16* dst, int ldd, LAS float* scr, int lane) {
#pragma unroll 8
    for (int i = 0; i < 32; ++i) { const int kk = 2 * i + (lane >> 5); float v = W[(size_t)(k0 + kk) * ldw + n0 + (lane & 31)]; if (gs) v *= gs[k0 + kk]; scr[kk * 33 + (lane & 31)] = v; }
    LDS_WAIT(); asm volatile("" ::: "memory");
    const int c = lane & 7;
#pragma unroll
    for (int j = 0; j < 4; ++j) { const int n = (lane >> 3) + 8 * j; const LAS float* s = scr + (8 * c) * 33 + n;
        v4u o; o.x = pk2(s[0 * 33], s[1 * 33]); o.y = pk2(s[2 * 33], s[3 * 33]); o.z = pk2(s[4 * 33], s[5 * 33]); o.w = pk2(s[6 * 33], s[7 * 33]);
        *(GAS v4u*)(dst + (size_t)n * ldd + k0 + 8 * c) = o; }
    LDS_WAIT(); asm volatile("" ::: "memory");
}
__device__ __forceinline__ void xpose_mat(int item, const float* W, int ldw, int N, const float* gs, bf16* dst, int ldd, int mode, LAS float* scr, int lane) {
    const int nblk = N / 32, kb = item / nblk, nb = item % nblk, n0 = 32 * nb;
    const int row = mode == 0 ? n0 : ((n0 >> 7) * 256 + (n0 & 127) + (mode == 2 ? 128 : 0));
    p0_transpose_item(W, ldw, 64 * kb, n0, gs, dst + (size_t)row * ldd, ldd, scr, lane);
}

struct Args { const float* in[28]; float* out; unsigned char* ws; };

__device__ __forceinline__ void s5_tables(const Args& a, int g, LAS unsigned char* lds, int tid) {
    LAS float* POWr = (LAS float*)lds;
    LAS float* POWi = POWr + 33 * 64;
    LAS float* BBr = POWi + 33 * 64;
    LAS float* BBi = BBr + 1024;
    LAS float* CCr = BBi + 1024;
    LAS float* CCi = CCr + 1024;
    LAS float* KT = CCi + 1024;
    LAS float* DD = KT + 8192;
    const float* a_re = a.in[3]; const float* a_im = a.in[4]; const float* b_re = a.in[5]; const float* b_im = a.in[6];
    const float* c_re = a.in[7]; const float* c_im = a.in[8]; const float* dsk = a.in[9]; const float* log_step = a.in[10];
    const float step = expf(log_step[g]);
    __syncthreads();
    for (int e = tid; e < 33 * 64; e += NTHREADS) { const int n = e >> 6, p = e & 63; const float lr = a_re[g * 64 + p], li = a_im[g * 64 + p];
        const float mag = expf((float)n * step * lr); float sn, cs; sincosf((float)n * (step * li), &sn, &cs); POWr[e] = mag * cs; POWi[e] = mag * sn; }
    for (int e = tid; e < 1024; e += NTHREADS) { const int p = e >> 4, h = e & 15; const float lr = a_re[g * 64 + p], li = a_im[g * 64 + p];
        const float er = expf(lr * step); float sn, cs; sincosf(li * step, &sn, &cs); const float nr = er * cs - 1.f, ni = er * sn, den = lr * lr + li * li;
        const float fr = (nr * lr + ni * li) / den, fi = (ni * lr - nr * li) / den;
        const float br = b_re[(g * 64 + p) * 16 + h], bi = b_im[(g * 64 + p) * 16 + h];
        BBr[e] = fr * br - fi * bi; BBi[e] = fr * bi + fi * br;
        CCr[e] = c_re[g * 1024 + e]; CCi[e] = c_im[g * 1024 + e]; }
    if (tid < 16) DD[tid] = dsk[g * 16 + tid];
    __syncthreads();
    for (int e = tid; e < 8192; e += NTHREADS) { const int tau = e >> 8, ho = (e >> 4) & 15, hi = e & 15; float s = 0.f;
        for (int p = 0; p < 64; ++p) { const float cr = CCr[ho * 64 + p], ci = CCi[ho * 64 + p], pr = POWr[tau * 64 + p], pi = POWi[tau * 64 + p];
            const float xr = cr * pr - ci * pi, xi = cr * pi + ci * pr; s += xr * BBr[p * 16 + hi] - xi * BBi[p * 16 + hi]; }
        if (tau == 0 && ho == hi) s += DD[ho];
        KT[e] = s; }
    __syncthreads();
    bf16* WA = (bf16*)(a.ws + WS_S5WA) + (size_t)g * 256 * 512;
    for (int pc = tid; pc < 256 * 64; pc += NTHREADS) { const int n = pc >> 6, k0 = (pc & 63) * 8; v4u o = (v4u){0u, 0u, 0u, 0u};
        if (n < 128) { const int p = n & 63, j = k0 >> 4, h0 = k0 & 15; const float pr = POWr[(31 - j) * 64 + p], pi = POWi[(31 - j) * 64 + p]; float v[8];
#pragma unroll
            for (int q = 0; q < 8; ++q) { const float br = BBr[p * 16 + h0 + q], bi = BBi[p * 16 + h0 + q]; v[q] = (n < 64) ? (pr * br - pi * bi) : (pr * bi + pi * br); }
            o.x = pk2(v[0], v[1]); o.y = pk2(v[2], v[3]); o.z = pk2(v[4], v[5]); o.w = pk2(v[6], v[7]); }
        *(GAS v4u*)(WA + (size_t)n * 512 + k0) = o; }
    bf16* WC = (bf16*)(a.ws + WS_S5WC) + (size_t)g * 512 * 640;
    for (int pc = tid; pc < 512 * 80; pc += NTHREADS) { const int n = pc / 80, k0 = (pc % 80) * 8, i = n >> 4, ho = n & 15; float v[8];
        if (k0 < 512) { const int j = k0 >> 4, h0 = k0 & 15;
#pragma unroll
            for (int q = 0; q < 8; ++q) v[q] = (j <= i) ? KT[((i - j) * 16 + ho) * 16 + h0 + q] : 0.f; }
        else { const int p0 = (k0 - 512) & 63; const bool im = k0 >= 576;
#pragma unroll
            for (int q = 0; q < 8; ++q) { const int p = p0 + q; const float cr = CCr[ho * 64 + p], ci = CCi[ho * 64 + p], pr = POWr[(i + 1) * 64 + p], pi = POWi[(i + 1) * 64 + p];
                v[q] = im ? -(cr * pi + ci * pr) : (cr * pr - ci * pi); } }
        v4u o; o.x = pk2(v[0], v[1]); o.y = pk2(v[2], v[3]); o.z = pk2(v[4], v[5]); o.w = pk2(v[6], v[7]);
        *(GAS v4u*)(WC + (size_t)n * 640 + k0) = o; }
    __syncthreads();
}

__device__ __forceinline__ void p0_prologue(const Args& a, LAS unsigned char* lds, int tid, int lane, int wave, int vcu, int G) {
    for (int g = vcu; g < S5G; g += G) s5_tables(a, g, lds, tid);
    LAS float* scr = (LAS float*)(lds + wave * 16384);
    const int gw = vcu * NWAVES + wave, NGW = G * NWAVES;
    constexpr int I_IN0 = 16 * 64, I_GLU = 8 * 16, I_OUT = 16 * 32, I_GU0 = 16 * 88, I_D0 = 44 * 32, I_IN1 = 16 * 96, I_MOE = 1792;
    constexpr int NITEMS = I_IN0 + I_GLU + I_OUT + 2 * I_GU0 + I_D0 + I_IN1 + I_OUT + 24 * I_MOE;
    unsigned char* ws = a.ws;
    for (int it = NITEMS - 1 - gw; it >= 0; it -= NGW) {
        int r = it;
        if (r < I_IN0) { xpose_mat(r, a.in[2], EVEN_IN, EVEN_IN, a.in[1], (bf16*)(ws + WS_WIN0), D, 0, scr, lane); continue; } r -= I_IN0;
        if (r < I_GLU) { xpose_mat(r, a.in[11], 512, 512, nullptr, (bf16*)(ws + WS_WGLU), 512, 0, scr, lane); continue; } r -= I_GLU;
        if (r < I_OUT) { xpose_mat(r, a.in[13], D, D, nullptr, (bf16*)(ws + WS_WOUT0), D, 0, scr, lane); continue; } r -= I_OUT;
        if (r < I_GU0) { xpose_mat(r, a.in[15], DFF, DFF, a.in[14], (bf16*)(ws + WS_WGU0), D, 1, scr, lane); continue; } r -= I_GU0;
        if (r < I_GU0) { xpose_mat(r, a.in[16], DFF, DFF, a.in[14], (bf16*)(ws + WS_WGU0), D, 2, scr, lane); continue; } r -= I_GU0;
        if (r < I_D0) { xpose_mat(r, a.in[17], D, D, nullptr, (bf16*)(ws + WS_WD0), DFF, 0, scr, lane); continue; } r -= I_D0;
        if (r < I_IN1) { xpose_mat(r, a.in[19], ODD_IN, 3072, a.in[18], (bf16*)(ws + WS_WIN1), D, 0, scr, lane); continue; } r -= I_IN1;
        if (r < I_OUT) { xpose_mat(r, a.in[21], D, D, nullptr, (bf16*)(ws + WS_WOUT1), D, 0, scr, lane); continue; } r -= I_OUT;
        const int mat = r / I_MOE, e = mat / 3, which = mat % 3; r -= mat * I_MOE;
        if (which == 0) xpose_mat(r, a.in[24] + (size_t)e * D * DFE, DFE, DFE, a.in[22], (bf16*)(ws + WS_WMOE_GU) + (size_t)e * 7168 * 1024, D, 1, scr, lane);
        else if (which == 1) xpose_mat(r, a.in[25] + (size_t)e * D * DFE, DFE, DFE, a.in[22], (bf16*)(ws + WS_WMOE_GU) + (size_t)e * 7168 * 1024, D, 2, scr, lane);
        else xpose_mat(r, a.in[26] + (size_t)e * DFE * D, D, D, nullptr, (bf16*)(ws + WS_WMOE_D) + (size_t)e * 1024 * 3584, DFE, 0, scr, lane);
    }
    { const int gt = vcu * NTHREADS + tid; if (gt < 16 * 1024) { const int h = gt >> 10, k = gt & 1023; ((bf16*)(ws + WS_WF1))[gt] = (bf16)f2bf(a.in[19][(size_t)k * ODD_IN + 3072 + h] * a.in[18][k]); } }
    float* ss0 = (float*)(ws + WS_SSP);
    for (int m = gw; m < M; m += NGW) {
        const GAS f32x4* xr = (const GAS f32x4*)(a.in[0] + (size_t)m * D) + lane; GAS v2u* o8 = (GAS v2u*)((bf16*)(ws + WS_XB) + (size_t)m * D) + lane; float s = 0.f;
#pragma unroll
        for (int j = 0; j < 4; ++j) { const f32x4 v = xr[64 * j]; s += (v.x * v.x + v.y * v.y) + (v.z * v.z + v.w * v.w); v2u w; w.x = pk2(v.x, v.y); w.y = pk2(v.z, v.w); o8[64 * j] = w; }
        s = wave_sum(s); if (lane < 16) ss0[(size_t)m * 16 + lane] = (lane == 0) ? s : 0.f;
    }
}

__device__ __forceinline__ void s5_scan(const Args& a, int gt  ) {
    if (gt >= BATCH * S5G * S5P) return;
    const int b = gt / (S5G * S5P), g = (gt / S5P) % S5G, p = gt % S5P;
    const float step = expf(a.in[10][g]); const float lr = a.in[3][g * 64 + p], li = a.in[4][g * 64 + p];
    const float mag = expf((float)S5T * step * lr); float sn, cs; sincosf((float)S5T * (step * li), &sn, &cs); const float ar = mag * cs, ai = mag * sn;
    const float* sl = (const float*)(a.ws + WS_SLOC) + ((size_t)g * S5NC + b * 256) * 128 + p;
    bf16* ue = (bf16*)(a.ws + WS_UEXT) + ((size_t)g * S5NC + b * 256) * S5KX + 512 + p;
    float sr = 0.f, si = 0.f;
#pragma unroll 8
    for (int c = 0; c < 256; ++c) {
        ue[(size_t)c * S5KX] = (bf16)f2bf(sr); ue[(size_t)c * S5KX + 64] = (bf16)f2bf(si);
        const float lr_ = sl[(size_t)c * 128], li_ = sl[(size_t)c * 128 + 64];
        const float nr = ar * sr - ai * si + lr_, ni = ar * si + ai * sr + li_; sr = nr; si = ni;
    }
}

__device__ __forceinline__ float softplus2(float z) { return fmaxf(z, 0.f) + __builtin_amdgcn_logf(1.0f + __builtin_amdgcn_exp2f(-fabsf(z))); }
__device__ __forceinline__ void stage_kv32(const bf16* kp, const bf16* vp, size_t pitch, LAS float* sK, LAS float* sV, int tid) {
    const int r = tid >> 4, c = (tid & 15) * 4;
    const v2u kw = *(const v2u*)(kp + (size_t)r * pitch + c), vw = *(const v2u*)(vp + (size_t)r * pitch + c);
    *(LAS f32x4*)(sK + r * 64 + c) = (f32x4){bflo(kw.x), bfhi(kw.x), bflo(kw.y), bfhi(kw.y)};
    *(LAS f32x4*)(sV + r * 64 + c) = (f32x4){bflo(vw.x), bfhi(vw.x), bflo(vw.y), bfhi(vw.y)};
}
__device__ __forceinline__ void sb_simple_unit(const bf16* qkv  , bf16* mix  , int b, int h, int blk, LAS unsigned char* lds, int tid) {
    const int lane = tid & 63, wave_ = tid >> 6;
    LAS float* sK = (LAS float*)lds; LAS float* sV = sK + 32 * 64;
    const int t = blk * 512 + tid; const size_t rb = (size_t)b * SEQ;
    float q[HD], acc[HD];
    { const v4u* qp = (const v4u*)(qkv + (rb + t) * 1536 + h * HD);
#pragma unroll
      for (int i = 0; i < 8; ++i) { const v4u w = qp[i]; q[8 * i] = bflo(w.x); q[8 * i + 1] = bfhi(w.x); q[8 * i + 2] = bflo(w.y); q[8 * i + 3] = bfhi(w.y); q[8 * i + 4] = bflo(w.z); q[8 * i + 5] = bfhi(w.z); q[8 * i + 6] = bflo(w.w); q[8 * i + 7] = bfhi(w.w); }
#pragma unroll
      for (int i = 0; i < HD; ++i) acc[i] = 0.f; }
    float carry = 0.f;
    for (int c0 = blk * 512 + 480; c0 >= 0; c0 -= 32) {
        __syncthreads();
        stage_kv32(qkv + (rb + c0) * 1536 + 512 + h * HD, qkv + (rb + c0) * 1536 + 1024 + h * HD, 1536, sK, sV, tid);
        __syncthreads();
        for (int r = 31; r >= 0; --r) { const int s = c0 + r;
            if (s < t) { float z = 0.f;
#pragma unroll
                for (int i = 0; i < HD; ++i) z = fmaf(q[i], sK[r * 64 + i], z);
                const float sp = softplus2(z); const float w = __builtin_amdgcn_exp2f(z - sp + carry); carry -= sp;
#pragma unroll
                for (int i = 0; i < HD; ++i) acc[i] = fmaf(w, sV[r * 64 + i], acc[i]); } }
        { LAS unsigned* fl = (LAS unsigned*)(lds + 16384); if (lane == 0) fl[wave_] = __all(carry < -150.f) ? 1u : 0u; __syncthreads();
          if ((fl[0] & fl[1] & fl[2] & fl[3] & fl[4] & fl[5] & fl[6] & fl[7]) != 0u) break; }
    }
    v4u* op = (v4u*)(mix + (rb + t) * 1024 + 512 + h * HD);
#pragma unroll
    for (int i = 0; i < 8; ++i) { v4u w; w.x = pk2(acc[8 * i], acc[8 * i + 1]); w.y = pk2(acc[8 * i + 2], acc[8 * i + 3]); w.z = pk2(acc[8 * i + 4], acc[8 * i + 5]); w.w = pk2(acc[8 * i + 6], acc[8 * i + 7]); op[i] = w; }
}
__device__ __forceinline__ void fox_cumsum(const float* logf  , LAS float* cum, LAS float* wtot  , int tid) {
    float loc[16]; float s = 0.f;
    const f32x4* lp = (const f32x4*)(logf + tid * 16);
#pragma unroll
    for (int j = 0; j < 4; ++j) { const f32x4 v = lp[j]; s += v.x; loc[4 * j] = s; s += v.y; loc[4 * j + 1] = s; s += v.z; loc[4 * j + 2] = s; s += v.w; loc[4 * j + 3] = s; }
    float inc = s;
#pragma unroll
    for (int o = 1; o < 64; o <<= 1) { const float v = __shfl_up(inc, o); if ((tid & 63) >= o) inc += v; }
    __syncthreads();
    if ((tid & 63) == 63) wtot[tid >> 6] = inc;
    __syncthreads();
    float base = inc - s;
    for (int w = 0; w < (tid >> 6); ++w) base += wtot[w];
#pragma unroll
    for (int j = 0; j < 16; ++j) cum[tid * 16 + j] = base + loc[j];
    __syncthreads();
}
__device__ __forceinline__ void fox_simple_unit(const bf16* qkv  , const float* logf_bh  , bf16* o  , int b, int h, int blk, LAS unsigned char* lds, int tid) {
    LAS float* sK = (LAS float*)lds; LAS float* sV = sK + 32 * 64; LAS float* wtot = sV + 32 * 64; LAS float* cum = (LAS float*)(lds + 32768);
    fox_cumsum(logf_bh, cum, wtot, tid);
    const int t = blk * 512 + tid; const size_t rb = (size_t)b * SEQ;
    float q[HD], acc[HD];
    { const v4u* qp = (const v4u*)(qkv + (rb + t) * 3072 + h * HD);
#pragma unroll
      for (int i = 0; i < 8; ++i) { const v4u w = qp[i]; q[8 * i] = bflo(w.x); q[8 * i + 1] = bfhi(w.x); q[8 * i + 2] = bflo(w.y); q[8 * i + 3] = bfhi(w.y); q[8 * i + 4] = bflo(w.z); q[8 * i + 5] = bfhi(w.z); q[8 * i + 6] = bflo(w.w); q[8 * i + 7] = bfhi(w.w); }
#pragma unroll
      for (int i = 0; i < HD; ++i) acc[i] = 0.f; }
    const float ct = cum[t]; float mx = -INFINITY, l = 0.f;
    for (int c0 = blk * 512 + 480; c0 >= 0; c0 -= 32) {
        __syncthreads();
        stage_kv32(qkv + (rb + c0) * 3072 + 1024 + h * HD, qkv + (rb + c0) * 3072 + 2048 + h * HD, 3072, sK, sV, tid);
        __syncthreads();
        for (int r = 31; r >= 0; --r) { const int s = c0 + r;
            if (s <= t) { float z = 0.f;
#pragma unroll
                for (int i = 0; i < HD; ++i) z = fmaf(q[i], sK[r * 64 + i], z);
                z += ct - cum[s];
                if (z > mx) { const float f = __builtin_amdgcn_exp2f(mx - z); l *= f;
#pragma unroll
                    for (int i = 0; i < HD; ++i) acc[i] *= f;
                    mx = z; }
                const float w = __builtin_amdgcn_exp2f(z - mx); l += w;
#pragma unroll
                for (int i = 0; i < HD; ++i) acc[i] = fmaf(w, sV[r * 64 + i], acc[i]); } }
    }
    const float il = 1.f / l;
    v4u* op = (v4u*)(o + (rb + t) * 1024 + h * HD);
#pragma unroll
    for (int i = 0; i < 8; ++i) { v4u w; w.x = pk2(acc[8 * i] * il, acc[8 * i + 1] * il); w.y = pk2(acc[8 * i + 2] * il, acc[8 * i + 3] * il); w.z = pk2(acc[8 * i + 4] * il, acc[8 * i + 5] * il); w.w = pk2(acc[8 * i + 6] * il, acc[8 * i + 7] * il); op[i] = w; }
    __syncthreads();
}

__device__ __forceinline__ void fgate_rows16(const bf16* xb, const bf16* wf, const float* ss, const float* bfv, float* logf, int r0, int lane) {
    const int fr = lane & 15, fq = lane >> 4;
    const bf16x8* ap = (const bf16x8*)(xb + (size_t)(r0 + fr) * D + fq * 8);
    const bf16x8* bp = (const bf16x8*)(wf + (size_t)fr * D + fq * 8);
    f32x4 acc = (f32x4){0.f, 0.f, 0.f, 0.f};
#pragma unroll 8
    for (int kk = 0; kk < 32; ++kk) acc = __builtin_amdgcn_mfma_f32_16x16x32_bf16(ap[kk * 4], bp[kk * 4], acc, 0, 0, 0);
    const float bias = bfv[fr];
#pragma unroll
    for (int j = 0; j < 4; ++j) { const int row = r0 + fq * 4 + j; const float rs = pg8::rstd16(ss, row);
        const float z = acc[j] * rs + bias;
        const float lf = -(fmaxf(-z, 0.f) + log1pf(expf(-fabsf(z)))) * 1.4426950408889634f;
        const int b = row >> 13, t = row & 8191; logf[((size_t)b * FOXH + fr) * SEQ + t] = lf; }
}

struct MoeOrder {
    pg8::StaticOrder S; int lo; int pref[NEXP + 1];
    __device__ __forceinline__ bool next(int i, pg8::Unit& u) const {
        if (!S.next(i, u)) return false;
        u.pm += lo; int e = 0;
#pragma unroll
        for (int k = 1; k < NEXP; ++k) e += (u.pm >= pref[k]) ? 1 : 0;
        u.zb = e; return true;
    }
    __device__ __forceinline__ void a_ready(const pg8::Unit&) const {}
    __device__ __forceinline__ void done(const pg8::Unit&) const {}
};

__global__ void __launch_bounds__(NTHREADS, 2) mk_fwd(Args args) {
    extern __shared__ __attribute__((aligned(16))) unsigned char lds_raw[];
    LAS unsigned char* lds = (LAS unsigned char*)lds_raw;
    volatile LAS unsigned* MISC = (volatile LAS unsigned*)(lds + MISC_OFF);
    const int tid = threadIdx.x, lane = tid & 63, wave = __builtin_amdgcn_readfirstlane(tid >> 6);
    const int G = gridDim.x; const int bx = blockIdx.x; const int vcu = (G % 8 == 0) ? (bx % 8) * (G / 8) + bx / 8 : bx;
    unsigned char* ws = args.ws;
    gu32* ctl = (gu32*)(ws + WS_CTL);
    for (int u = tid; u < (LDS_BYTES - LDSCTL_OFF) / 4; u += NTHREADS) ((LAS unsigned*)(lds + LDSCTL_OFF))[u] = 0u;
    __syncthreads();
    XcdBarrier bar = xcd_barrier_post((unsigned*)(ctl + CW_BAR), MISC + 8);
    const int gw = vcu * NWAVES + wave, NGW = G * NWAVES;
    float* SS = (float*)(ws + WS_SSP);
    float* X = args.out;
    bf16* XB = (bf16*)(ws + WS_XB);
#define GRID_BAR() xcd_barrier(bar)
#define GEMM_PHASE(EPI, SCHED, lds_, g_, S_, E_) pg8::gemm_phase<EPI, SCHED, true, true>(lds_, g_, S_, E_)

    p0_prologue(args, lds, tid, lane, wave, vcu, G);
    GRID_BAR();
    { pg8::Gemm g{XB, (const bf16*)(ws + WS_WIN0), D, D, D, 0, 0}; pg8::StaticOrder S; S.init(M, EVEN_IN, 1, G, bx);
      pg8::EpiInProj0 E{SS, (bf16*)(ws + WS_UEXT), (bf16*)(ws + WS_QKV0), C2};
      GEMM_PHASE(pg8::EpiInProj0, pg8::StaticOrder, lds + RING_OFF, g, S, E); }
    GRID_BAR();
    { pg8::Gemm g{(const bf16*)(ws + WS_UEXT), (const bf16*)(ws + WS_S5WA), S5KX, 512, 512, (size_t)S5NC * S5KX * 2, (size_t)256 * 512 * 2}; pg8::StaticOrder S; S.init(S5NC, 256, S5G, G, bx);
      pg8::EpiS5State E{(float*)(ws + WS_SLOC)};
      GEMM_PHASE(pg8::EpiS5State, pg8::StaticOrder, lds + RING_OFF, g, S, E); }
    GRID_BAR();
    s5_scan(args, vcu * NTHREADS + tid);
    GRID_BAR();
    { pg8::Gemm g{(const bf16*)(ws + WS_UEXT), (const bf16*)(ws + WS_S5WC), S5KX, S5KX, S5KX, (size_t)S5NC * S5KX * 2, (size_t)512 * S5KX * 2}; pg8::StaticOrder S; S.init(S5NC, 512, S5G, G, bx);
      pg8::EpiS5Y E{(bf16*)(ws + WS_YG)};
      GEMM_PHASE(pg8::EpiS5Y, pg8::StaticOrder, lds + RING_OFF, g, S, E); }
    GRID_BAR();
    { pg8::Gemm g{(const bf16*)(ws + WS_YG), (const bf16*)(ws + WS_WGLU), 512, 512, 512, 0, 0}; pg8::StaticOrder S; S.init(M, 512, 1, G, bx);
      pg8::EpiGlu E{(const bf16*)(ws + WS_YG), args.in[12], (bf16*)(ws + WS_MIXB)};
      GEMM_PHASE(pg8::EpiGlu, pg8::StaticOrder, lds + RING_OFF, g, S, E); }
    __syncthreads();
    for (int L = vcu; L < BATCH * SBH * 16; L += G) sb_simple_unit((const bf16*)(ws + WS_QKV0), (bf16*)(ws + WS_MIXB), L / (SBH * 16), (L / 16) % SBH, L % 16, lds, tid);
    GRID_BAR();
    { pg8::Gemm g{(const bf16*)(ws + WS_MIXB), (const bf16*)(ws + WS_WOUT0), D, D, D, 0, 0}; pg8::StaticOrder S; S.init(M, D, 1, G, bx);
      pg8::EpiResid E{args.in[0], X, XB, SS + 16 * M};
      GEMM_PHASE(pg8::EpiResid, pg8::StaticOrder, lds + RING_OFF, g, S, E); }
    GRID_BAR();
    { pg8::Gemm g{XB, (const bf16*)(ws + WS_WGU0), D, D, D, 0, 0}; pg8::StaticOrder S; S.init(M, 2 * DFF, 1, G, bx);
      pg8::EpiSwiGlu<true> E{SS + 16 * M, (bf16*)(ws + WS_HID0), DFF};
      GEMM_PHASE(pg8::EpiSwiGlu<true>, pg8::StaticOrder, lds + RING_OFF, g, S, E); }
    GRID_BAR();
    { pg8::Gemm g{(const bf16*)(ws + WS_HID0), (const bf16*)(ws + WS_WD0), DFF, DFF, DFF, 0, 0}; pg8::StaticOrder S; S.init(M, D, 1, G, bx);
      pg8::EpiResid E{X, X, XB, SS + 32 * M};
      GEMM_PHASE(pg8::EpiResid, pg8::StaticOrder, lds + RING_OFF, g, S, E); }
    GRID_BAR();
    { pg8::Gemm g{XB, (const bf16*)(ws + WS_WIN1), D, D, D, 0, 0}; pg8::StaticOrder S; S.init(M, 3072, 1, G, bx);
      pg8::EpiInProj1 E{SS + 32 * M, (bf16*)(ws + WS_QKV1), C2};
      GEMM_PHASE(pg8::EpiInProj1, pg8::StaticOrder, lds + RING_OFF, g, S, E); }
    for (int r = gw; r < M / 16; r += NGW) fgate_rows16(XB, (const bf16*)(ws + WS_WF1), SS + 32 * M, args.in[20], (float*)(ws + WS_LOGF), r * 16, lane);
    GRID_BAR();
    for (int L = vcu; L < 256; L += G) { const int bh = L >> 3, j = L & 7;
        fox_simple_unit((const bf16*)(ws + WS_QKV1), (const float*)(ws + WS_LOGF) + (size_t)bh * SEQ, (bf16*)(ws + WS_O1), bh >> 4, bh & 15, j, lds, tid);
        fox_simple_unit((const bf16*)(ws + WS_QKV1), (const float*)(ws + WS_LOGF) + (size_t)bh * SEQ, (bf16*)(ws + WS_O1), bh >> 4, bh & 15, 15 - j, lds, tid); }
    GRID_BAR();
    { pg8::Gemm g{(const bf16*)(ws + WS_O1), (const bf16*)(ws + WS_WOUT1), D, D, D, 0, 0}; pg8::StaticOrder S; S.init(M, D, 1, G, bx);
      pg8::EpiResid E{X, X, XB, SS + 48 * M};
      GEMM_PHASE(pg8::EpiResid, pg8::StaticOrder, lds + RING_OFF, g, S, E); }
    GRID_BAR();
    unsigned char* meta = ws + WS_META;
    {
        const float* wr = args.in[23]; const float* gn = args.in[22];
        for (int tok = gw; tok < M; tok += NGW) {
            const GAS f32x4* xr = (const GAS f32x4*)(X + (size_t)tok * D) + lane; float lg[NEXP]; float s = 0.f;
#pragma unroll
            for (int e = 0; e < NEXP; ++e) lg[e] = 0.f;
#pragma unroll
            for (int j = 0; j < 4; ++j) { const f32x4 v = xr[64 * j]; s += (v.x * v.x + v.y * v.y) + (v.z * v.z + v.w * v.w); const int k0 = 4 * lane + 256 * j; const f32x4 gv = *(const f32x4*)(gn + k0);
#pragma unroll
                for (int q = 0; q < 4; ++q) { const float xv = v[q] * gv[q]; const f32x4 w0 = *(const f32x4*)(wr + (size_t)(k0 + q) * NEXP), w1 = *(const f32x4*)(wr + (size_t)(k0 + q) * NEXP + 4);
                    lg[0] = fmaf(xv, w0.x, lg[0]); lg[1] = fmaf(xv, w0.y, lg[1]); lg[2] = fmaf(xv, w0.z, lg[2]); lg[3] = fmaf(xv, w0.w, lg[3]);
                    lg[4] = fmaf(xv, w1.x, lg[4]); lg[5] = fmaf(xv, w1.y, lg[5]); lg[6] = fmaf(xv, w1.z, lg[6]); lg[7] = fmaf(xv, w1.w, lg[7]); } }
            s = wave_sum(s);
#pragma unroll
            for (int e = 0; e < NEXP; ++e) lg[e] = wave_sum(lg[e]);
            if (lane == 0) {
                const float rs = 1.0f / sqrtf(s * (1.0f / 1024.0f) + pg8::RMS_EPS);
                int i1 = 0; float v1 = lg[0];
#pragma unroll
                for (int e = 1; e < NEXP; ++e) if (lg[e] > v1) { v1 = lg[e]; i1 = e; }
                int i2 = -1; float v2 = -INFINITY;
#pragma unroll
                for (int e = 0; e < NEXP; ++e) if (e != i1 && lg[e] > v2) { v2 = lg[e]; i2 = e; }
                const float g1 = 1.f / (1.f + expf((v2 - v1) * rs)), g2 = 1.f - g1;
                const unsigned p1 = __hip_atomic_fetch_add(ctl + CW_CNT + 64 * i1, 1u, RLX_AGENT), p2 = __hip_atomic_fetch_add(ctl + CW_CNT + 64 * i2, 1u, RLX_AGENT);
                ((float*)(meta + MT_RSTD))[tok] = rs; ((unsigned*)(meta + MT_TOKE))[tok] = (unsigned)i1 | ((unsigned)i2 << 8);
                ((unsigned*)(meta + MT_TOKP))[2 * tok] = p1; ((unsigned*)(meta + MT_TOKP))[2 * tok + 1] = p2;
                ((float*)(meta + MT_TOKG))[2 * tok] = g1; ((float*)(meta + MT_TOKG))[2 * tok + 1] = g2;
            }
        }
    }
    GRID_BAR();
    int pref[NEXP + 1], cnt[NEXP];
    { pref[0] = 0;
#pragma unroll
      for (int e = 0; e < NEXP; ++e) { cnt[e] = (int)__builtin_amdgcn_readfirstlane(__hip_atomic_load(ctl + CW_CNT + 64 * e, RLX_AGENT)); pref[e + 1] = pref[e] + (cnt[e] + 255) / 256; } }
    const int NP = pref[NEXP];
    bf16* XG = (bf16*)(ws + WS_XG); float* RSS = (float*)(meta + MT_RSS);
    {
        for (int tok = gw; tok < M; tok += NGW) {
            const unsigned ee = ((const unsigned*)(meta + MT_TOKE))[tok]; const float rs = ((const float*)(meta + MT_RSTD))[tok];
            const v4u r0 = *(const v4u*)(XB + (size_t)tok * D + lane * 8), r1 = *(const v4u*)(XB + (size_t)tok * D + 512 + lane * 8);
#pragma unroll
            for (int k = 0; k < 2; ++k) { const int e = (ee >> (8 * k)) & 0xff; int pe = 0;
#pragma unroll
                for (int q = 0; q < NEXP; ++q) pe = (q == e) ? pref[q] : pe;
                const int slot = pe * 256 + (int)((const unsigned*)(meta + MT_TOKP))[2 * tok + k];
                *(v4u*)(XG + (size_t)slot * D + lane * 8) = r0; *(v4u*)(XG + (size_t)slot * D + 512 + lane * 8) = r1;
                if (lane == 0) { RSS[slot] = rs; ((unsigned*)(meta + MT_TOKSLOT))[2 * tok + k] = (unsigned)slot; } }
        }
#pragma unroll
        for (int e = 0; e < NEXP; ++e) for (int r = pref[e] * 256 + cnt[e] + gw; r < pref[e + 1] * 256; r += NGW) {
            *(v4u*)(XG + (size_t)r * D + lane * 8) = (v4u){0u, 0u, 0u, 0u}; *(v4u*)(XG + (size_t)r * D + 512 + lane * 8) = (v4u){0u, 0u, 0u, 0u}; if (lane == 0) RSS[r] = 0.f; }
    }
    GRID_BAR();
#pragma unroll
    for (int ch = 0; ch < 2; ++ch) {
        const int lo = ch * MOE_CHUNK_PANELS, hi = NP < (ch + 1) * MOE_CHUNK_PANELS ? NP : (ch + 1) * MOE_CHUNK_PANELS, np = hi > lo ? hi - lo : 0;
        bf16* Hc = (bf16*)(ws + WS_HMOE) - (size_t)lo * 256 * DFE;
        { pg8::Gemm g{XG, (const bf16*)(ws + WS_WMOE_GU), D, D, D, 0, (size_t)7168 * 1024 * 2}; MoeOrder S; S.S.nM = np; S.S.nN = 28; S.S.nZ = 1; S.S.nwg = np * 28; S.S.G = G; S.S.c = bx; S.lo = lo;
#pragma unroll
          for (int e = 0; e <= NEXP; ++e) S.pref[e] = pref[e];
          pg8::EpiSwiGlu<false> E{RSS, Hc, DFE};
          GEMM_PHASE(pg8::EpiSwiGlu<false>, MoeOrder, lds + RING_OFF, g, S, E); }
        GRID_BAR();
        { pg8::Gemm g{Hc, (const bf16*)(ws + WS_WMOE_D), DFE, DFE, DFE, 0, (size_t)1024 * 3584 * 2}; MoeOrder S; S.S.nM = np; S.S.nN = 4; S.S.nZ = 1; S.S.nwg = np * 4; S.S.G = G; S.S.c = bx; S.lo = lo;
#pragma unroll
          for (int e = 0; e <= NEXP; ++e) S.pref[e] = pref[e];
          pg8::EpiStoreBf16 E{XG, D};
          GEMM_PHASE(pg8::EpiStoreBf16, MoeOrder, lds + RING_OFF, g, S, E); }
        GRID_BAR();
    }
    {
        const float* gf = args.in[27];
        for (int tok = gw; tok < M; tok += NGW) {
            const unsigned s0 = ((const unsigned*)(meta + MT_TOKSLOT))[2 * tok], s1 = ((const unsigned*)(meta + MT_TOKSLOT))[2 * tok + 1];
            const float g0 = ((const float*)(meta + MT_TOKG))[2 * tok], g1 = ((const float*)(meta + MT_TOKG))[2 * tok + 1];
            GAS f32x4* xr = (GAS f32x4*)(X + (size_t)tok * D) + lane; f32x4 v[4]; float s = 0.f;
#pragma unroll
            for (int j = 0; j < 4; ++j) { v[j] = xr[64 * j]; const int k0 = 4 * lane + 256 * j;
                const v2u a = *(const v2u*)(XG + (size_t)s0 * D + k0), b2 = *(const v2u*)(XG + (size_t)s1 * D + k0);
                v[j].x += g0 * bflo(a.x) + g1 * bflo(b2.x); v[j].y += g0 * bfhi(a.x) + g1 * bfhi(b2.x); v[j].z += g0 * bflo(a.y) + g1 * bflo(b2.y); v[j].w += g0 * bfhi(a.y) + g1 * bfhi(b2.y);
                s += (v[j].x * v[j].x + v[j].y * v[j].y) + (v[j].z * v[j].z + v[j].w * v[j].w); }
            s = wave_sum(s); const float rs = 1.0f / sqrtf(s * (1.0f / 1024.0f) + pg8::RMS_EPS);
#pragma unroll
            for (int j = 0; j < 4; ++j) { const f32x4 gv = *(const f32x4*)(gf + 4 * lane + 256 * j); xr[64 * j] = v[j] * rs * gv; }
        }
    }
}

extern "C" void kernel_launch(void* const* d_in, const int* in_sizes, int n_in, void* d_out, int out_size, void* d_ws, size_t ws_size, hipStream_t stream) {
    static int grid = 0;
    if (grid == 0) {
        if (n_in != 28 || in_sizes[0] != M * D || out_size != M * D || ws_size < WS_END) { fprintf(stderr, "kernel_launch: unexpected problem: n_in %d in0 %d out %d ws %zu (need %zu)\n", n_in, n_in > 0 ? in_sizes[0] : -1, out_size, ws_size, (size_t)WS_END); grid = -1; return; }
        int dev = 0, cus = 0, per_cu = 0;
        if (hipGetDevice(&dev) != hipSuccess || hipDeviceGetAttribute(&cus, hipDeviceAttributeMultiprocessorCount, dev) != hipSuccess) { grid = -1; return; }
        if (hipFuncSetAttribute((const void*)mk_fwd, hipFuncAttributeMaxDynamicSharedMemorySize, LDS_BYTES) != hipSuccess) { fprintf(stderr, "kernel_launch: hipFuncSetAttribute failed\n"); grid = -1; return; }
        if (hipOccupancyMaxActiveBlocksPerMultiprocessor(&per_cu, (const void*)mk_fwd, NTHREADS, LDS_BYTES) != hipSuccess || per_cu < 1) fprintf(stderr, "kernel_launch: occupancy query says %d\n", per_cu);
        (void)hipGetLastError();
        grid = cus;
    }
    if (grid < 0) return;
    if (hipMemsetAsync((char*)d_ws + WS_CTL, 0, CTL_ZERO_BYTES, stream) != hipSuccess) return;
    Args a{};
    for (int i = 0; i < 28; ++i) a.in[i] = (const float*)d_in[i];
    a.out = (float*)d_out; a.ws = (unsigned char*)d_ws;
    hipLaunchKernelGGL(mk_fwd, dim3(grid), dim3(NTHREADS), LDS_BYTES, stream, a);
}
```

```cpp
#include <hip/hip_runtime.h>
#include <cstdio>
#include <cstdint>

namespace pg8 {
#define PG8_LAS __attribute__((address_space(3)))
typedef unsigned short bf16_t;
typedef short bf16x8 __attribute__((ext_vector_type(8)));
typedef float f32x4 __attribute__((ext_vector_type(4)));
typedef unsigned u32x4 __attribute__((ext_vector_type(4)));
typedef unsigned u32x2 __attribute__((ext_vector_type(2)));
constexpr int BM = 256, BK = 64, HALF = 128, HTB = HALF * BK * 2  , STAGE_BYTES = 8 * HTB, NXCD = 8, WGM = 8;

__host__ __device__ __forceinline__ int lds_byte(int r, int c) { const int st = (r >> 4) * 2 + (c >> 5), rr = r & 15, cc = c & 31, ob = rr * 64 + cc * 2; return st * 1024 + (ob ^ (((ob >> 9) & 1) << 5)); }
__host__ __device__ __forceinline__ void stage_rc(int b, int& R, int& C) { const int st = b / 1024, sb = b % 1024, swz = sb ^ (((sb >> 9) & 1) << 5); R = (st >> 1) * 16 + swz / 64; C = (st & 1) * 32 + (swz % 64) / 2; }
__host__ __device__ __forceinline__ int perm32(int rho) { const int n = rho >> 4, i = rho & 15; return 8 * (i >> 2) + 4 * n + (i & 3); }

struct Unit { int pm, pn, zb; };
struct Gemm { const bf16_t* A; const bf16_t* Bt; int lda, ldb, K; size_t zA, zB; };

struct StaticOrder {
    int nM, nN, nZ, nwg, G, c;
    __host__ __device__ void init(int M, int N, int Z, int G_, int c_) { nM = M / BM; nN = N / BM; nZ = Z; nwg = nM * nN * nZ; G = G_; c = c_; }
    __host__ __device__ bool next(int i, Unit& u) const {
        const long L = (long)i * G + c; if (L >= nwg) return false;
        int wgid = (int)L; { const int q = nwg / NXCD, r = nwg % NXCD, xcd = wgid % NXCD, off = wgid / NXCD; wgid = (xcd < r ? xcd * (q + 1) : r * (q + 1) + (xcd - r) * q) + off; }
        const int per = nM * nN; u.zb = wgid / per; wgid -= u.zb * per;
        const int nig = WGM * nN, gid = wgid / nig, fm = gid * WGM, gsz = (nM - fm) < WGM ? (nM - fm) : WGM;
        u.pm = fm + ((wgid % nig) % gsz); u.pn = (wgid % nig) / gsz; return true;
    }
    __device__ __forceinline__ void a_ready(const Unit&) const {}
    __device__ __forceinline__ void done(const Unit&) const {}
};

__device__ __forceinline__ unsigned cvt_pk_bf16(float lo, float hi) { unsigned r; asm volatile("v_cvt_pk_bf16_f32 %0, %1, %2" : "=v"(r) : "v"(lo), "v"(hi)); return r; }
__device__ __forceinline__ float bf_lo(unsigned w) { return __uint_as_float(w << 16); }
__device__ __forceinline__ float bf_hi(unsigned w) { return __uint_as_float(w & 0xffff0000u); }
__device__ __forceinline__ float fast_sigmoid(float z) { return __builtin_amdgcn_rcpf(1.0f + __builtin_amdgcn_exp2f(-1.4426950408889634f * z)); }
constexpr float RMS_EPS = 1e-6f;
__device__ __forceinline__ float rstd16(const float* ssp, int row) { const f32x4* p = (const f32x4*)(ssp + (size_t)row * 16); const f32x4 a = p[0], b = p[1], c = p[2], d = p[3];
    const float s = (((a[0] + a[1]) + (a[2] + a[3])) + ((b[0] + b[1]) + (b[2] + b[3]))) + (((c[0] + c[1]) + (c[2] + c[3])) + ((d[0] + d[1]) + (d[2] + d[3])));
    return __builtin_amdgcn_rsqf(s * (1.0f / 1024.0f) + RMS_EPS); }

__device__ __forceinline__ u32x4 pack8(const f32x4 v0, const f32x4 v1) { u32x4 w; w.x = cvt_pk_bf16(v0[0], v0[1]); w.y = cvt_pk_bf16(v0[2], v0[3]); w.z = cvt_pk_bf16(v1[0], v1[1]); w.w = cvt_pk_bf16(v1[2], v1[3]); return w; }

struct EpiInProj0 {
    static constexpr bool PERM = true, AFTER_DRAIN = false;
    const float* ss; bf16_t* uext; bf16_t* qkv; float qscale;
    __device__ __forceinline__ void operator()(const f32x4 (&acc)[2][2][4][2], const Unit& u, int wr, int wc, int fr, int fq) const {
        const int row0 = u.pm * BM + wr * 64 + fr;
#pragma unroll
        for (int ai = 0; ai < 2; ++ai)
#pragma unroll
            for (int m = 0; m < 4; ++m) { const int row = row0 + ai * HALF + m * 16; const float rs = rstd16(ss, row);
#pragma unroll
                for (int bj = 0; bj < 2; ++bj) { const int col0 = u.pn * BM + bj * HALF + wc * 32 + 8 * fq;
                    float sc = rs; bf16_t* dst;
                    if (u.pn < 2) dst = uext + ((size_t)(col0 >> 4) * 512 + (row >> 5)) * 640 + (row & 31) * 16 + (col0 & 15);
                    else { const int c = col0 - 512; if (c < 512) sc *= qscale; dst = qkv + (size_t)row * 1536 + c; }
                    *(u32x4*)dst = pack8(acc[ai][bj][m][0] * sc, acc[ai][bj][m][1] * sc); } }
    }
};
struct EpiS5State {
    static constexpr bool PERM = false, AFTER_DRAIN = false;
    float* sloc;
    __device__ __forceinline__ void operator()(const f32x4 (&acc)[2][2][4][2], const Unit& u, int wr, int wc, int fr, int fq) const {
        const int row0 = u.pm * BM + wr * 64 + fr, col0 = wc * 32 + 4 * fq;
#pragma unroll
        for (int ai = 0; ai < 2; ++ai)
#pragma unroll
            for (int m = 0; m < 4; ++m) { float* rowp = sloc + ((size_t)u.zb * 512 + row0 + ai * HALF + m * 16) * 128 + col0;
#pragma unroll
                for (int n = 0; n < 2; ++n) *(f32x4*)(rowp + n * 16) = acc[ai][0][m][n]; }
    }
};
__device__ __forceinline__ float gelu_tanh(float x) { const float a = x * (1.0f + 0.044715f * x * x); return x * __builtin_amdgcn_rcpf(1.0f + __builtin_amdgcn_exp2f(-2.302208198f * a)); }
struct EpiS5Y {
    static constexpr bool PERM = true, AFTER_DRAIN = false;
    bf16_t* yg;
    __device__ __forceinline__ void operator()(const f32x4 (&acc)[2][2][4][2], const Unit& u, int wr, int wc, int fr, int fq) const {
        const int row0 = u.pm * BM + wr * 64 + fr;
#pragma unroll
        for (int ai = 0; ai < 2; ++ai)
#pragma unroll
            for (int m = 0; m < 4; ++m) { const int chunk = row0 + ai * HALF + m * 16;
#pragma unroll
                for (int bj = 0; bj < 2; ++bj) { const int col0 = u.pn * BM + bj * HALF + wc * 32 + 8 * fq; const int i = col0 >> 4, h0 = col0 & 15;
                    f32x4 v0 = acc[ai][bj][m][0], v1 = acc[ai][bj][m][1];
#pragma unroll
                    for (int e = 0; e < 4; ++e) { v0[e] = gelu_tanh(v0[e]); v1[e] = gelu_tanh(v1[e]); }
                    *(u32x4*)(yg + ((size_t)chunk * 32 + i) * 512 + u.zb * 16 + h0) = pack8(v0, v1); } }
    }
};
struct EpiGlu {
    static constexpr bool PERM = true, AFTER_DRAIN = false;
    const bf16_t* yg; const float* bias; bf16_t* mix;
    __device__ __forceinline__ void operator()(const f32x4 (&acc)[2][2][4][2], const Unit& u, int wr, int wc, int fr, int fq) const {
        const int row0 = u.pm * BM + wr * 64 + fr;
#pragma unroll
        for (int bj = 0; bj < 2; ++bj) { const int col0 = u.pn * BM + bj * HALF + wc * 32 + 8 * fq;
            const f32x4 b0 = *(const f32x4*)(bias + col0), b1 = *(const f32x4*)(bias + col0 + 4);
#pragma unroll
            for (int ai = 0; ai < 2; ++ai)
#pragma unroll
                for (int m = 0; m < 4; ++m) { const int row = row0 + ai * HALF + m * 16;
                    const u32x4 yw = *(const u32x4*)(yg + (size_t)row * 512 + col0);
                    f32x4 z0 = acc[ai][bj][m][0] + b0, z1 = acc[ai][bj][m][1] + b1, o0, o1;
                    o0[0] = bf_lo(yw.x) * fast_sigmoid(z0[0]); o0[1] = bf_hi(yw.x) * fast_sigmoid(z0[1]); o0[2] = bf_lo(yw.y) * fast_sigmoid(z0[2]); o0[3] = bf_hi(yw.y) * fast_sigmoid(z0[3]);
                    o1[0] = bf_lo(yw.z) * fast_sigmoid(z1[0]); o1[1] = bf_hi(yw.z) * fast_sigmoid(z1[1]); o1[2] = bf_lo(yw.w) * fast_sigmoid(z1[2]); o1[3] = bf_hi(yw.w) * fast_sigmoid(z1[3]);
                    *(u32x4*)(mix + (size_t)row * 1024 + col0) = pack8(o0, o1); } }
    }
};
struct EpiResid {
    static constexpr bool PERM = false, AFTER_DRAIN = false;
    const float* R; float* X; bf16_t* xb; float* ssq;
    __device__ __forceinline__ void operator()(const f32x4 (&acc)[2][2][4][2], const Unit& u, int wr, int wc, int fr, int fq) const {
        const int row0 = u.pm * BM + wr * 64 + fr, col0 = u.pn * BM + wc * 32 + 4 * fq;
#pragma unroll
        for (int ai = 0; ai < 2; ++ai)
#pragma unroll
            for (int m = 0; m < 4; ++m) { const int row = row0 + ai * HALF + m * 16; const size_t off = (size_t)row * 1024 + col0; float s = 0.f;
#pragma unroll
                for (int bj = 0; bj < 2; ++bj)
#pragma unroll
                    for (int n = 0; n < 2; ++n) { const f32x4 x = *(const f32x4*)(R + off + bj * HALF + n * 16) + acc[ai][bj][m][n];
                        *(f32x4*)(X + off + bj * HALF + n * 16) = x; s += (x[0] * x[0] + x[1] * x[1]) + (x[2] * x[2] + x[3] * x[3]);
                        u32x2 w; w.x = cvt_pk_bf16(x[0], x[1]); w.y = cvt_pk_bf16(x[2], x[3]); *(u32x2*)(xb + off + bj * HALF + n * 16) = w; }
                s += __shfl_xor(s, 16); s += __shfl_xor(s, 32);
                if (fq == 0) ssq[(size_t)row * 16 + u.pn * 4 + wc] = s; }
    }
};
template <bool RS_IS_SSQ> struct EpiSwiGlu {
    static constexpr bool PERM = true, AFTER_DRAIN = false;
    const float* rsv; bf16_t* H; int ldh;
    __device__ __forceinline__ void operator()(const f32x4 (&acc)[2][2][4][2], const Unit& u, int wr, int wc, int fr, int fq) const {
        const int row0 = u.pm * BM + wr * 64 + fr, col0 = u.pn * HALF + wc * 32 + 8 * fq;
#pragma unroll
        for (int ai = 0; ai < 2; ++ai)
#pragma unroll
            for (int m = 0; m < 4; ++m) { const int row = row0 + ai * HALF + m * 16; const float rs = RS_IS_SSQ ? rstd16(rsv, row) : rsv[row];
                f32x4 o[2];
#pragma unroll
                for (int n = 0; n < 2; ++n)
#pragma unroll
                    for (int e = 0; e < 4; ++e) { const float g = acc[ai][0][m][n][e] * rs, up = acc[ai][1][m][n][e] * rs; o[n][e] = g * fast_sigmoid(g) * up; }
                *(u32x4*)(H + (size_t)row * ldh + col0) = pack8(o[0], o[1]); }
    }
};
struct EpiInProj1 {
    static constexpr bool PERM = true, AFTER_DRAIN = false;
    const float* ss; bf16_t* qkv; float qscale;
    __device__ __forceinline__ void operator()(const f32x4 (&acc)[2][2][4][2], const Unit& u, int wr, int wc, int fr, int fq) const {
        const int row0 = u.pm * BM + wr * 64 + fr; const float qs = (u.pn < 4) ? qscale : 1.0f;
#pragma unroll
        for (int ai = 0; ai < 2; ++ai)
#pragma unroll
            for (int m = 0; m < 4; ++m) { const int row = row0 + ai * HALF + m * 16; const float sc = rstd16(ss, row) * qs;
#pragma unroll
                for (int bj = 0; bj < 2; ++bj) { const int col0 = (u.pn & 3) * BM + bj * HALF + wc * 32 + 8 * fq;
                    *(u32x4*)(qkv + (size_t)(u.pn >> 2) * (16384 * 1024) + (size_t)row * 1024 + col0) = pack8(acc[ai][bj][m][0] * sc, acc[ai][bj][m][1] * sc); } }
    }
};
struct EpiStoreBf16 {
    static constexpr bool PERM = true, AFTER_DRAIN = false;
    bf16_t* O; int ldc;
    __device__ __forceinline__ void operator()(const f32x4 (&acc)[2][2][4][2], const Unit& u, int wr, int wc, int fr, int fq) const {
        const int row0 = u.pm * BM + wr * 64 + fr;
#pragma unroll
        for (int ai = 0; ai < 2; ++ai)
#pragma unroll
            for (int m = 0; m < 4; ++m) { const int row = row0 + ai * HALF + m * 16;
#pragma unroll
                for (int bj = 0; bj < 2; ++bj) { const int col0 = u.pn * BM + bj * HALF + wc * 32 + 8 * fq;
                    *(u32x4*)(O + (size_t)row * ldc + col0) = pack8(acc[ai][bj][m][0], acc[ai][bj][m][1]); } }
    }
};

template <class Epi, class Sched, bool ALIGN_EPI = false, bool SP2 = false>
__device__ __forceinline__ void gemm_phase(PG8_LAS unsigned char* lds, const Gemm g, const Sched& S, const Epi& E) {
    int tid_ = threadIdx.x; asm volatile("" : "+v"(tid_));
    const int tid = tid_, wid = __builtin_amdgcn_readfirstlane(tid >> 6), lane = tid & 63, wr = wid >> 2, wc = wid & 3, fr = lane & 15, fq = lane >> 4;
    const int K = g.K, nt = K / BK;
    unsigned voffA[2], voffB[2];
#pragma unroll
    for (int i = 0; i < 2; ++i) { int R, C; stage_rc(tid * 16 + i * 8192, R, C); const int Rb = Epi::PERM ? ((R & ~31) + perm32(R & 31)) : R;
        voffA[i] = (unsigned)(R * g.lda + C) * 2u; voffB[i] = (unsigned)(Rb * g.ldb + C) * 2u; }
    const size_t kstep = (size_t)(BK * 2);
    const size_t hstepA = (size_t)HALF * g.lda * 2, hstepB = (size_t)HALF * g.ldb * 2;
    const size_t tstepA = 2 * hstepA, tstepB = 2 * hstepB;
    const unsigned ldsw = (unsigned)wid * 1024u;
    const int aoff = lds_byte(wr * 64 + fr, fq * 8), boff = lds_byte(wc * 32 + fr, fq * 8);
#define PG8_SA(b, h) (((b) * 2 + (h)) * HTB)
#define PG8_SB(b, h) ((4 + (b) * 2 + (h)) * HTB)
#define PG8_STAGE(bufoff, gbase, voff) do { _Pragma("unroll") for (int _i = 0; _i < 2; ++_i) \
        __builtin_amdgcn_global_load_lds((const unsigned*)((const char*)(gbase) + (voff)[_i]), (PG8_LAS unsigned*)(lds + (bufoff) + ldsw + _i * 8192), 16, 0, 0); } while (0)
#define PG8_LDA(dst, b, h) do { _Pragma("unroll") for (int m = 0; m < 4; ++m) _Pragma("unroll") for (int k = 0; k < 2; ++k) dst[m][k] = *(const PG8_LAS bf16x8*)(lds + PG8_SA(b, h) + aoff + m * 2048 + k * 1024); } while (0)
#define PG8_LDB(dst, b, h) do { _Pragma("unroll") for (int n = 0; n < 2; ++n) _Pragma("unroll") for (int k = 0; k < 2; ++k) dst[n][k] = *(const PG8_LAS bf16x8*)(lds + PG8_SB(b, h) + boff + n * 2048 + k * 1024); } while (0)
#define PG8_MMA(ai, bj, At, Bt) do { __builtin_amdgcn_s_setprio(1); _Pragma("unroll") for (int m = 0; m < 4; ++m) _Pragma("unroll") for (int n = 0; n < 2; ++n) _Pragma("unroll") for (int k = 0; k < 2; ++k) \
        acc[ai][bj][m][n] = __builtin_amdgcn_mfma_f32_16x16x32_bf16(Bt[n][k], At[m][k], acc[ai][bj][m][n], 0, 0, 0); __builtin_amdgcn_s_setprio(0); } while (0)
#define PG8_WAIT_V(n) asm volatile("s_waitcnt vmcnt(" #n ")" ::: "memory")
#define PG8_WAIT_L(n) asm volatile("s_waitcnt lgkmcnt(" #n ")" ::: "memory")
#define PG8_BAR __builtin_amdgcn_s_barrier()
#define PG8_SCHED __builtin_amdgcn_sched_barrier(0)
    Unit cur, nxt; int ui = 0;
    if (!S.next(0, cur)) return;
    f32x4 acc[2][2][4][2];
#pragma unroll
    for (int a = 0; a < 2; ++a)
#pragma unroll
        for (int b = 0; b < 2; ++b)
#pragma unroll
            for (int m = 0; m < 4; ++m)
#pragma unroll
                for (int n = 0; n < 2; ++n) acc[a][b][m][n] = (f32x4){0.f, 0.f, 0.f, 0.f};
    bf16x8 At[4][2], B0[2][2], B1[2][2];
    const char* cA = (const char*)g.A + (size_t)cur.zb * g.zA + (size_t)cur.pm * tstepA; const char* cB = (const char*)g.Bt + (size_t)cur.zb * g.zB + (size_t)cur.pn * tstepB;
    S.a_ready(cur);
    if constexpr (SP2) {
        PG8_STAGE(PG8_SB(0, 0), cB, voffB); PG8_STAGE(PG8_SB(0, 1), cB + hstepB, voffB); PG8_STAGE(PG8_SA(0, 0), cA, voffA); PG8_STAGE(PG8_SA(0, 1), cA + hstepA, voffA);
        if (wr == 1) PG8_BAR;
        PG8_WAIT_V(2); PG8_BAR;
        PG8_STAGE(PG8_SB(1, 0), cB + kstep, voffB); PG8_STAGE(PG8_SA(1, 0), cA + kstep, voffA); PG8_STAGE(PG8_SB(1, 1), cB + hstepB + kstep, voffB);
        PG8_WAIT_V(6); PG8_BAR;
    } else {
        PG8_STAGE(PG8_SB(0, 0), cB, voffB); PG8_STAGE(PG8_SA(0, 0), cA, voffA); PG8_STAGE(PG8_SB(0, 1), cB + hstepB, voffB); PG8_STAGE(PG8_SA(0, 1), cA + hstepA, voffA);
        if (wr == 1) PG8_BAR;
        PG8_WAIT_V(4); PG8_BAR;
        PG8_STAGE(PG8_SB(1, 0), cB + kstep, voffB); PG8_STAGE(PG8_SA(1, 0), cA + kstep, voffA); PG8_STAGE(PG8_SB(1, 1), cB + hstepB + kstep, voffB);
        PG8_WAIT_V(6); PG8_BAR;
    }
    for (;;) {
        const bool has_next = S.next(ui + 1, nxt);
        const char* nA = has_next ? (const char*)g.A + (size_t)nxt.zb * g.zA + (size_t)nxt.pm * tstepA : cA; const char* nB = has_next ? (const char*)g.Bt + (size_t)nxt.zb * g.zB + (size_t)nxt.pn * tstepB : cB;
        for (int t = 0; t < nt; t += 2) {
            const bool last = (t == nt - 2);
            const char* a1 = cA + (size_t)(t + 1) * kstep;
            const char* a2 = last ? nA : cA + (size_t)(t + 2) * kstep; const char* b2 = last ? nB : cB + (size_t)(t + 2) * kstep;
            const char* a3 = a2 + kstep; const char* b3 = b2 + kstep;
            if (last && has_next) S.a_ready(nxt);
            if constexpr (SP2) {
            PG8_LDB(B0, 0, 0); PG8_LDB(B1, 0, 1); PG8_SCHED; PG8_LDA(At, 0, 0); PG8_STAGE(PG8_SA(1, 1), a1 + hstepA, voffA);
            PG8_WAIT_V(8); PG8_WAIT_L(0); PG8_BAR; PG8_MMA(0, 0, At, B0); PG8_MMA(0, 1, At, B1); PG8_BAR; PG8_SCHED;
            PG8_LDA(At, 0, 1); PG8_STAGE(PG8_SB(0, 0), b2, voffB); PG8_STAGE(PG8_SB(0, 1), b2 + hstepB, voffB); PG8_STAGE(PG8_SA(0, 0), a2, voffA);
            PG8_WAIT_V(8); PG8_WAIT_L(0); PG8_BAR; PG8_MMA(1, 0, At, B0); PG8_MMA(1, 1, At, B1); PG8_BAR; PG8_SCHED;
            PG8_LDB(B0, 1, 0); PG8_LDB(B1, 1, 1); PG8_SCHED; PG8_LDA(At, 1, 0); PG8_STAGE(PG8_SA(0, 1), a2 + hstepA, voffA);
            PG8_WAIT_V(8); PG8_WAIT_L(0); PG8_BAR; PG8_MMA(0, 0, At, B0); PG8_MMA(0, 1, At, B1); PG8_BAR; PG8_SCHED;
            PG8_LDA(At, 1, 1); PG8_STAGE(PG8_SB(1, 0), b3, voffB); PG8_STAGE(PG8_SB(1, 1), b3 + hstepB, voffB); PG8_STAGE(PG8_SA(1, 0), a3, voffA);
            PG8_WAIT_V(8); PG8_WAIT_L(0); PG8_BAR; PG8_MMA(1, 0, At, B0); PG8_MMA(1, 1, At, B1); PG8_BAR; PG8_SCHED;
            } else {
            PG8_LDB(B0, 0, 0); PG8_SCHED; PG8_LDA(At, 0, 0); PG8_STAGE(PG8_SA(1, 1), a1 + hstepA, voffA);
            PG8_WAIT_L(8); PG8_BAR; PG8_WAIT_L(0); PG8_MMA(0, 0, At, B0); PG8_BAR; PG8_SCHED;
            PG8_LDB(B1, 0, 1); PG8_STAGE(PG8_SB(0, 0), b2, voffB);
            PG8_BAR; PG8_WAIT_L(0); PG8_MMA(0, 1, At, B1); PG8_BAR;
            PG8_LDA(At, 0, 1); PG8_STAGE(PG8_SA(0, 0), a2, voffA);
            PG8_BAR; PG8_WAIT_L(0); PG8_MMA(1, 0, At, B0); PG8_BAR; PG8_SCHED;
            PG8_STAGE(PG8_SB(0, 1), b2 + hstepB, voffB);
            PG8_WAIT_V(6); PG8_BAR; PG8_MMA(1, 1, At, B1); PG8_BAR;
            PG8_LDB(B0, 1, 0); PG8_SCHED; PG8_LDA(At, 1, 0); PG8_STAGE(PG8_SA(0, 1), a2 + hstepA, voffA);
            PG8_WAIT_L(8); PG8_BAR; PG8_WAIT_L(0); PG8_MMA(0, 0, At, B0); PG8_BAR; PG8_SCHED;
            PG8_LDB(B1, 1, 1); PG8_STAGE(PG8_SB(1, 0), b3, voffB);
            PG8_BAR; PG8_WAIT_L(0); PG8_MMA(0, 1, At, B1); PG8_BAR;
            PG8_LDA(At, 1, 1); PG8_STAGE(PG8_SA(1, 0), a3, voffA);
            PG8_BAR; PG8_WAIT_L(0); PG8_MMA(1, 0, At, B0); PG8_BAR; PG8_SCHED;
            PG8_STAGE(PG8_SB(1, 1), b3 + hstepB, voffB);
            PG8_WAIT_V(6); PG8_BAR; PG8_MMA(1, 1, At, B1); PG8_BAR;
            }
        }
        if constexpr (ALIGN_EPI) { if (wr == 0) PG8_BAR; }
        if constexpr (!Epi::AFTER_DRAIN) { E(acc, cur, wr, wc, fr, fq); S.done(cur); }
        if (!has_next) break;
#pragma unroll
        for (int a = 0; a < 2; ++a)
#pragma unroll
            for (int b = 0; b < 2; ++b)
#pragma unroll
                for (int m = 0; m < 4; ++m)
#pragma unroll
                    for (int n = 0; n < 2; ++n) acc[a][b][m][n] = (f32x4){0.f, 0.f, 0.f, 0.f};
        cur = nxt; cA = nA; cB = nB; ++ui;
        if constexpr (ALIGN_EPI) { if (wr == 1) PG8_BAR; }
    }
    PG8_WAIT_V(0);
    if constexpr (!ALIGN_EPI) { if (wr == 0) PG8_BAR; }
    PG8_BAR;
    if constexpr (Epi::AFTER_DRAIN) { E.fused(acc, cur, wr, wc, fr, fq, lds, wid, lane); S.done(cur); }
#undef PG8_SA
#undef PG8_SB
#undef PG8_STAGE
#undef PG8_LDA
#undef PG8_LDB
#undef PG8_MMA
#undef PG8_WAIT_V
#undef PG8_WAIT_L
#undef PG8_BAR
#undef PG8_SCHED
}
}

#include <hip/hip_bf16.h>
#include <cmath>
namespace attn_body {
using bf16=__hip_bfloat16;
using bf16x8=__attribute__((ext_vector_type(8)))short;
using s16x4=__attribute__((ext_vector_type(4)))short;
using f32x16=__attribute__((ext_vector_type(16)))float;
using u32x4=__attribute__((ext_vector_type(4)))unsigned;
constexpr int BATCH=2,NHEAD=16,SEQ=8192,D=64,DM=NHEAD*D;
constexpr int NW=8,QBLK=32,QB=QBLK*NW,KVBLK=64,NQB=SEQ/QB;
constexpr int ATTN_PITCH=DM, ATTN_UNIT_ROWS=QB;
__device__ __forceinline__ int crow(int r,int hi){return (r&3)+8*(r>>2)+4*hi;}
#define SBAR() __builtin_amdgcn_sched_barrier(0)
__device__ __forceinline__ void cmask(f32x16&p0,f32x16&p1,int jb,int qrel,int hi){
  const float NEG=-INFINITY; int kb=64*jb+4*hi;
  #pragma unroll
  for(int r=0;r<16;++r){int kv=kb+(r&3)+8*(r>>2); if(kv>qrel)p0[r]=NEG; if(kv+32>qrel)p1[r]=NEG;}
}

constexpr int NSLOT=3, SLOTB=8192;
constexpr int LDS_K=0, LDS_V=NSLOT*SLOTB, LDS_WS=2*NSLOT*SLOTB, LDS_OST=LDS_WS+NW*64*4, LDS_NB=LDS_OST+NW*4096  , LDS_BYTES=LDS_NB+32768+64;
constexpr float C2=0.125f*1.4426950408889634f;
__device__ __forceinline__ void glds16(const void*gsrc,unsigned lds_dst){unsigned keep;
  asm volatile("s_mov_b32 %0, m0\n\ts_mov_b32 m0, %2\n\ts_nop 0\n\tglobal_load_lds_dwordx4 %1, off\n\ts_mov_b32 m0, %0":"=&s"(keep):"v"(gsrc),"s"(lds_dst):"memory");}
__device__ __forceinline__ float max3f(float a,float b,float c){float r;asm("v_max3_f32 %0, %1, %2, %3":"=v"(r):"v"(a),"v"(b),"v"(c));return r;}
__device__ __forceinline__ float max2f(float a,float b){float r;asm("v_max_f32_e32 %0, %1, %2":"=v"(r):"v"(a),"v"(b));return r;}
__device__ __forceinline__ float fadd_s(float a,float b){float r;asm("v_add_f32_e32 %0, %1, %2":"=v"(r):"v"(a),"v"(b));return r;}
__device__ __forceinline__ float fsub_s(float a,float b){float r;asm("v_sub_f32_e32 %0, %1, %2":"=v"(r):"v"(a),"v"(b));return r;}
typedef float f32x2_t __attribute__((ext_vector_type(2))); typedef __bf16 bf16x2_t __attribute__((ext_vector_type(2)));
__device__ __forceinline__ unsigned cvtpk_s(float lo,float hi){f32x2_t v={lo,hi};bf16x2_t b=__builtin_convertvector(v,bf16x2_t);return __builtin_bit_cast(unsigned,b);}
#define WAIT_BAR(N) asm volatile("s_waitcnt vmcnt(" #N ") lgkmcnt(0)\n\ts_barrier":::"memory")

__device__ __forceinline__ void qkt(f32x16&p0,f32x16&p1,const char*Kslot,const bf16x8*qr,const f32x16&negm,int r32,int hi){
  const char*kb=Kslot+hi*1024+r32*16;
  #pragma unroll
  for(int d0=0;d0<4;++d0){
    const bf16x8 b0=*reinterpret_cast<const bf16x8*>(kb+d0*2048);
    const bf16x8 b1=*reinterpret_cast<const bf16x8*>(kb+d0*2048+512);
    if(d0==0){p0=__builtin_amdgcn_mfma_f32_32x32x16_bf16(b0,qr[0],negm,0,0,0);p1=__builtin_amdgcn_mfma_f32_32x32x16_bf16(b1,qr[0],negm,0,0,0);}
    else{p0=__builtin_amdgcn_mfma_f32_32x32x16_bf16(b0,qr[d0],p0,0,0,0);p1=__builtin_amdgcn_mfma_f32_32x32x16_bf16(b1,qr[d0],p1,0,0,0);}}
}
typedef __attribute__((address_space(3))) const char* lds_cptr;
typedef short v4i16_t __attribute__((ext_vector_type(4)));
__device__ __forceinline__ void kload8(bf16x8*kf,lds_cptr kp){
  kf[0]=*(const __attribute__((address_space(3))) bf16x8*)(kp);      kf[1]=*(const __attribute__((address_space(3))) bf16x8*)(kp+512);
  kf[2]=*(const __attribute__((address_space(3))) bf16x8*)(kp+2048); kf[3]=*(const __attribute__((address_space(3))) bf16x8*)(kp+2560);
  kf[4]=*(const __attribute__((address_space(3))) bf16x8*)(kp+4096); kf[5]=*(const __attribute__((address_space(3))) bf16x8*)(kp+4608);
  kf[6]=*(const __attribute__((address_space(3))) bf16x8*)(kp+6144); kf[7]=*(const __attribute__((address_space(3))) bf16x8*)(kp+6656);
}
__device__ __forceinline__ void kload2(bf16x8*kf,lds_cptr kp,int j){ kf[2*j]=*(const __attribute__((address_space(3))) bf16x8*)(kp+j*2048); kf[2*j+1]=*(const __attribute__((address_space(3))) bf16x8*)(kp+j*2048+512); }
__device__ __forceinline__ s16x4 vtr(lds_cptr p){ return __builtin_bit_cast(s16x4,__builtin_amdgcn_ds_read_tr16_b64_v4i16((__attribute__((address_space(3))) v4i16_t*)p)); }
__device__ __forceinline__ float rowmax(const f32x16&p0,const f32x16&p1){
  float a=max3f(p0[0],p0[1],p1[0]),b=max3f(p0[2],p0[3],p1[1]);a=max3f(a,p1[2],p1[3]);
  #pragma unroll
  for(int r=4;r<16;r+=4){a=max3f(a,p0[r],p0[r+1]);b=max3f(b,p0[r+2],p0[r+3]);a=max3f(a,p1[r],p1[r+1]);b=max3f(b,p1[r+2],p1[r+3]);}
  const float m=max2f(a,b);
  auto rr=__builtin_amdgcn_permlane32_swap(__float_as_uint(m),__float_as_uint(m),false,false);
  return max2f(__uint_as_float(rr[0]),__uint_as_float(rr[1]));
}
__device__ __forceinline__ void pv(f32x16*o,int vb,bf16x8 pa0,bf16x8 pa1,bf16x8 pa2,bf16x8 pa3){
  #pragma unroll
  for(int d0=0;d0<2;++d0){s16x4 lo[4],hi[4];
    #pragma unroll
    for(int ks=0;ks<4;++ks){
      asm volatile("ds_read_b64_tr_b16 %0,%1 offset:%c2":"=&v"(lo[ks]):"v"(vb),"i"(d0*4096+ks*1024):"memory");
      asm volatile("ds_read_b64_tr_b16 %0,%1 offset:%c2":"=&v"(hi[ks]):"v"(vb),"i"(d0*4096+ks*1024+512):"memory");}
    asm volatile("s_waitcnt lgkmcnt(0)":::"memory");SBAR();
    #define PK(k) (bf16x8){lo[k][0],lo[k][1],lo[k][2],lo[k][3],hi[k][0],hi[k][1],hi[k][2],hi[k][3]}
    o[d0]=__builtin_amdgcn_mfma_f32_32x32x16_bf16(pa0,PK(0),o[d0],0,0,0);
    o[d0]=__builtin_amdgcn_mfma_f32_32x32x16_bf16(pa1,PK(1),o[d0],0,0,0);
    o[d0]=__builtin_amdgcn_mfma_f32_32x32x16_bf16(pa2,PK(2),o[d0],0,0,0);
    o[d0]=__builtin_amdgcn_mfma_f32_32x32x16_bf16(pa3,PK(3),o[d0],0,0,0);
    #undef PK
  }
}

typedef float f32x4_t __attribute__((ext_vector_type(4)));
__device__ __forceinline__ void fox_negcum(const float*logf,__attribute__((address_space(3))) float*ncum,__attribute__((address_space(3))) float*wtot,int tid){
  float loc[16];float s=0.f; const f32x4_t*lp=(const f32x4_t*)(logf+tid*16);
  #pragma unroll
  for(int j=0;j<4;++j){const f32x4_t v=lp[j]; s+=v[0];loc[4*j]=s; s+=v[1];loc[4*j+1]=s; s+=v[2];loc[4*j+2]=s; s+=v[3];loc[4*j+3]=s;}
  float inc=s;
  #pragma unroll
  for(int o=1;o<64;o<<=1){const float v=__shfl_up(inc,o); if((tid&63)>=o)inc+=v;}
  if((tid&63)==63)wtot[tid>>6]=inc;
  __syncthreads();
  float base=inc-s; for(int w=0;w<(tid>>6);++w)base+=wtot[w];
  #pragma unroll
  for(int j=0;j<4;++j){ f32x4_t o4; o4[0]=-(base+loc[4*j]);o4[1]=-(base+loc[4*j+1]);o4[2]=-(base+loc[4*j+2]);o4[3]=-(base+loc[4*j+3]); *(__attribute__((address_space(3))) f32x4_t*)(ncum+tid*16+4*j)=o4; }
  __syncthreads();
}
#ifndef ATTN_STORE16
#define ATTN_STORE16(p,v) (*(u32x4*)(p)=(v))
#endif
template<int THRL> __device__ __forceinline__ void attn_unit(int b,int h,int qb,const bf16*Q,const bf16*__restrict__ K,const bf16*__restrict__ V,bf16*O,char*shm,const float*logf_bh){
  int tid_=threadIdx.x; asm volatile("":"+v"(tid_)); const int tid=tid_,lane=tid&63,r32=lane&31,hi=lane>>5; const int wid=__builtin_amdgcn_readfirstlane(tid>>6);
  const long rowbase=(long)b*SEQ; const int q0=qb*QB;
  const bf16*Qw=Q+(rowbase+q0+wid*QBLK)*DM+h*D;
  const bf16*Kh=K+rowbase*DM+h*D,*Vh=V+rowbase*DM+h*D;
  const unsigned lds0=(unsigned)(uintptr_t)shm;
  float*wsf=(float*)(shm+LDS_WS)+wid*64;
  const bf16*ksrc=Kh+(long)lane*DM+wid*8;
  const bf16*vsrc=Vh+(long)(16*(wid&3)+(lane>>2))*DM+(wid>>2)*32+(lane&3)*8;
  const unsigned kdst=lds0+LDS_K+wid*1024, vdst=lds0+LDS_V+wid*1024;
  #define DMA_K(t,slot) glds16(ksrc+(long)(t)*KVBLK*DM,(unsigned)__builtin_amdgcn_readfirstlane(kdst+(slot)))
  #define DMA_V(t,slot) glds16(vsrc+(long)(t)*KVBLK*DM,(unsigned)__builtin_amdgcn_readfirstlane(vdst+(slot)))
  const int vb0=(int)(lds0+LDS_V)+((lane>>4)&1)*32+(lane&3)*8+(4*hi+((lane&15)>>2))*64;
  const char*Kbase=shm+LDS_K; bf16x8 kf[8];
  const lds_cptr shm3=(lds_cptr)shm; const lds_cptr kp0=shm3+LDS_K+hi*1024+r32*16; const lds_cptr vp0=shm3+LDS_V+((lane>>4)&1)*32+(lane&3)*8+(4*hi+((lane&15)>>2))*64;
  const int NT=(q0+QB)/KVBLK;
  const lds_cptr shm3b=(lds_cptr)shm;
  const __attribute__((address_space(3))) float* nb3=(const __attribute__((address_space(3))) float*)(shm3b+LDS_NB);
  fox_negcum(logf_bh,(__attribute__((address_space(3))) float*)(shm3b+LDS_NB),(__attribute__((address_space(3))) float*)(shm3b+LDS_NB+32768),tid);
  #define BIASADD(P0,P1,t) do{ const __attribute__((address_space(3))) f32x4_t* bp_=(const __attribute__((address_space(3))) f32x4_t*)(nb3+(t)*64+4*hi); \
    const f32x4_t nm4_={-mhat,-mhat,-mhat,-mhat}; \
    _Pragma("unroll") for(int g_=0;g_<4;++g_){ const f32x4_t b0_=bp_[2*g_]+nm4_,b1_=bp_[2*g_+8]+nm4_; \
      P0[4*g_]+=b0_[0];P0[4*g_+1]+=b0_[1];P0[4*g_+2]+=b0_[2];P0[4*g_+3]+=b0_[3]; P1[4*g_]+=b1_[0];P1[4*g_+1]+=b1_[1];P1[4*g_+2]+=b1_[2];P1[4*g_+3]+=b1_[3]; } }while(0)
  DMA_K(0,0);DMA_V(0,0);DMA_K(1,SLOTB);
  bf16x8 qr[4];
  #pragma unroll
  for(int d0=0;d0<4;++d0)qr[d0]=*reinterpret_cast<const bf16x8*>(&Qw[(long)r32*DM+d0*16+hi*8]);
  float mhat=0.f,l_reg=0.f;f32x16 o[2];o[0]=f32x16{};o[1]=f32x16{};const f32x16 negm=f32x16{};
  const int qrel=wid*QBLK+r32;
  #define CMASK(P0,P1,t) do{int jb_=(t)-(NT-4); if(jb_>=0)cmask(P0,P1,jb_,qrel,hi);}while(0)
  bool resc=false;
  #define START(P0,P1) do{ const float rm=rowmax(P0,P1); resc=false; \
    { const float dl=rm; mhat=fadd_s(mhat,dl); \
      _Pragma("unroll") for(int r=0;r<16;++r){P0[r]=fsub_s(P0[r],dl);P1[r]=fsub_s(P1[r],dl);} \
      } \
    _Pragma("unroll") for(int r=0;r<16;++r)P0[r]=__builtin_amdgcn_exp2f(P0[r]); }while(0)
  #define RESC() do{ if(resc){ asm volatile("s_waitcnt lgkmcnt(0)":::"memory"); \
      _Pragma("unroll") for(int d_=0;d_<2;++d_) _Pragma("unroll") for(int r=0;r<16;++r)o[d_][r]*=wsf[crow(r,hi)]; } }while(0)
  f32x16 pA0,pA1,pB0,pB1;
  int sl_prev=0,sl_cur=0,sl_next=SLOTB;
  #define ROT() do{sl_prev=sl_cur;sl_cur=sl_next;sl_next=(sl_next==(NSLOT-1)*SLOTB)?0:sl_next+SLOTB;}while(0)
  DMA_K(2,2*SLOTB);
  WAIT_BAR(3);
  qkt(pA0,pA1,Kbase,qr,negm,r32,hi);asm volatile("s_nop 15\n\ts_nop 7":"+v"(pA0),"+v"(pA1));BIASADD(pA0,pA1,0);CMASK(pA0,pA1,0);
  START(pA0,pA1);
  _Pragma("unroll") for(int r=0;r<16;++r)pA1[r]=__builtin_amdgcn_exp2f(pA1[r]);
  WAIT_BAR(0);
  DMA_K(3,0);DMA_V(1,SLOTB);
  ROT();
  kload8(kf,kp0+sl_cur);
  WAIT_BAR(2);
  s16x4 vlo[8],vhi[8]; u32x4 pw0,pw1,pw2,pw3;
  #define PKW(P,B) cvtpk_s(P[B],P[B+1])
  #define PAF(k) __builtin_bit_cast(bf16x8,pw##k)
  #define VFR(i) (bf16x8){vlo[i][0],vlo[i][1],vlo[i][2],vlo[i][3],vhi[i][0],vhi[i][1],vhi[i][2],vhi[i][3]}
  #define PIN(x) asm volatile("":"+v"(x))
  #define MX3(a,b,c) __builtin_fmaxf(__builtin_fmaxf((a),(b)),(c))
  #define GAPA(MF,A0,A1,A2,A3,W0,W1,PW) do{ MF; sacc+=A0; sacc+=A1; sacc+=A2; sacc+=A3; PIN(sacc); W0; W1; PIN(PW); SBAR(); }while(0)
  #define EX(v) __builtin_amdgcn_exp2f(v)
  #define GAPB(MF,X,B) do{ MF; X[B]=EX(X[B]); X[B+1]=EX(X[B+1]); X[B+2]=EX(X[B+2]); X[B+3]=EX(X[B+3]); PIN(X); SBAR(); }while(0)
  #define VRD(i) do{ vlo[i]=vtr(vp_+(((i)>>2)*4096+((i)&3)*1024)); vhi[i]=vtr(vp_+(((i)>>2)*4096+((i)&3)*1024+512)); }while(0)
  #define KRD(G,j) do{ if(G){ kload2(kf,kp0+sl_next,j); SBAR(); } }while(0)
  #define STEP(C0,C1,P0,P1,t,GK,GV,GL) do{ SBAR(); \
    const lds_cptr vp_=vp0+sl_prev; \
    VRD(0); SBAR(); float sacc=(P0[0]+P0[1]); \
    GAPA(C0=__builtin_amdgcn_mfma_f32_32x32x16_bf16(kf[0],qr[0],negm,0,0,0), P0[2],P0[3],P0[4],P0[5],     pw0[0]=PKW(P0,0), pw0[1]=PKW(P0,2), pw0); \
    VRD(4); SBAR(); GAPA(C1=__builtin_amdgcn_mfma_f32_32x32x16_bf16(kf[1],qr[0],negm,0,0,0), P0[6],P0[7],P0[8],P0[9],     pw0[2]=PKW(P0,4), pw0[3]=PKW(P0,6), pw0); \
    VRD(1); SBAR(); GAPA(C0=__builtin_amdgcn_mfma_f32_32x32x16_bf16(kf[2],qr[1],C0,0,0,0),   P0[10],P0[11],P0[12],P0[13], pw1[0]=PKW(P0,8), pw1[1]=PKW(P0,10), pw1); \
    VRD(5); SBAR(); GAPA(C1=__builtin_amdgcn_mfma_f32_32x32x16_bf16(kf[3],qr[1],C1,0,0,0),   P0[14],P0[15],P1[0],P1[1],   pw1[2]=PKW(P0,12),pw1[3]=PKW(P0,14), pw1); \
    VRD(2); SBAR(); GAPA(C0=__builtin_amdgcn_mfma_f32_32x32x16_bf16(kf[4],qr[2],C0,0,0,0),   P1[2],P1[3],P1[4],P1[5],     pw2[0]=PKW(P1,0), pw2[1]=PKW(P1,2), pw2); \
    VRD(6); SBAR(); GAPA(C1=__builtin_amdgcn_mfma_f32_32x32x16_bf16(kf[5],qr[2],C1,0,0,0),   P1[6],P1[7],P1[8],P1[9],     pw2[2]=PKW(P1,4), pw2[3]=PKW(P1,6), pw2); \
    VRD(3); SBAR(); GAPA(C0=__builtin_amdgcn_mfma_f32_32x32x16_bf16(kf[6],qr[3],C0,0,0,0),   P1[10],P1[11],P1[12],P1[13], pw3[0]=PKW(P1,8), pw3[1]=PKW(P1,10), pw3); \
    VRD(7); SBAR(); GAPA(C1=__builtin_amdgcn_mfma_f32_32x32x16_bf16(kf[7],qr[3],C1,0,0,0),   P1[14],P1[15],0.f,0.f,       pw3[2]=PKW(P1,12),pw3[3]=PKW(P1,14), pw3); \
    l_reg+=sacc; \
    if(GK){DMA_K((t)+3,sl_cur);} if(GV){DMA_V((t)+1,sl_next);} \
    BIASADD(C0,C1,t); CMASK(C0,C1,t); \
    { float a=MX3(C0[0],C0[1],C1[0]),b=MX3(C0[2],C0[3],C1[1]); a=MX3(a,C1[2],C1[3]); \
      _Pragma("unroll") for(int r=4;r<16;r+=4){a=MX3(a,C0[r],C0[r+1]);b=MX3(b,C0[r+2],C0[r+3]);a=MX3(a,C1[r],C1[r+1]);b=MX3(b,C1[r+2],C1[r+3]);} \
      float rm=__builtin_fmaxf(a,b); { auto rr=__builtin_amdgcn_permlane32_swap(__float_as_uint(rm),__float_as_uint(rm),false,false); rm=__builtin_fmaxf(__uint_as_float(rr[0]),__uint_as_float(rr[1])); } \
      resc=false; \
      if(__builtin_expect(__any(rm>(float)THRL),0)){ const float dl=__builtin_fmaxf(rm,0.f); mhat+=dl; \
        _Pragma("unroll") for(int r=0;r<16;++r){C0[r]-=dl;C1[r]-=dl;} \
        const float f=__builtin_amdgcn_exp2f(-dl); l_reg*=f; if(hi==0)wsf[r32]=f; resc=true; } } \
    SBAR(); \
    GAPB(o[0]=__builtin_amdgcn_mfma_f32_32x32x16_bf16(PAF(0),VFR(0),o[0],0,0,0), C0,0); \
    GAPB(o[1]=__builtin_amdgcn_mfma_f32_32x32x16_bf16(PAF(0),VFR(4),o[1],0,0,0), C0,4); \
    KRD(GL,0); GAPB(o[0]=__builtin_amdgcn_mfma_f32_32x32x16_bf16(PAF(1),VFR(1),o[0],0,0,0), C0,8); \
    KRD(GL,1); GAPB(o[1]=__builtin_amdgcn_mfma_f32_32x32x16_bf16(PAF(1),VFR(5),o[1],0,0,0), C0,12); \
    KRD(GL,2); GAPB(o[0]=__builtin_amdgcn_mfma_f32_32x32x16_bf16(PAF(2),VFR(2),o[0],0,0,0), C1,0); \
    KRD(GL,3); GAPB(o[1]=__builtin_amdgcn_mfma_f32_32x32x16_bf16(PAF(2),VFR(6),o[1],0,0,0), C1,4); \
    GAPB(o[0]=__builtin_amdgcn_mfma_f32_32x32x16_bf16(PAF(3),VFR(3),o[0],0,0,0), C1,8); \
    GAPB(o[1]=__builtin_amdgcn_mfma_f32_32x32x16_bf16(PAF(3),VFR(7),o[1],0,0,0), C1,12); \
    }while(0)
  int t=1;
  #undef CMASK
  #define CMASK(P0,P1,t) do{}while(0)
  for(;t+5<NT;t+=2){
    STEP(pB0,pB1,pA0,pA1,t,true,true,true);     WAIT_BAR(2); RESC(); ROT();
    STEP(pA0,pA1,pB0,pB1,t+1,true,true,true);   WAIT_BAR(2); RESC(); ROT();
  }
  #undef CMASK
  #define CMASK(P0,P1,t) do{int jb_=(t)-(NT-4); if(jb_>=0)cmask(P0,P1,jb_,qrel,hi);}while(0)
  #define ENDW(tt) do{ if((tt)+3<NT){WAIT_BAR(2);} else if((tt)+2<NT){WAIT_BAR(1);} else {WAIT_BAR(0);} }while(0)
  for(;t+1<NT;t+=2){
    STEP(pB0,pB1,pA0,pA1,t,(t+3<NT),(t+1<NT),(t+1<NT));       ENDW(t);   RESC(); ROT();
    STEP(pA0,pA1,pB0,pB1,t+1,(t+4<NT),(t+2<NT),(t+2<NT));     ENDW(t+1); RESC(); ROT();
  }
  STEP(pB0,pB1,pA0,pA1,NT-1,false,false,false); RESC();
  { float sacc=pB0[0]+pB0[1]; _Pragma("unroll") for(int r=2;r<16;++r)sacc+=pB0[r]; _Pragma("unroll") for(int r=0;r<16;++r)sacc+=pB1[r]; l_reg+=sacc;
    pw0=(u32x4){PKW(pB0,0),PKW(pB0,2),PKW(pB0,4),PKW(pB0,6)};pw1=(u32x4){PKW(pB0,8),PKW(pB0,10),PKW(pB0,12),PKW(pB0,14)};pw2=(u32x4){PKW(pB1,0),PKW(pB1,2),PKW(pB1,4),PKW(pB1,6)};pw3=(u32x4){PKW(pB1,8),PKW(pB1,10),PKW(pB1,12),PKW(pB1,14)};
    SBAR(); pv(o,vb0+sl_cur,PAF(0),PAF(1),PAF(2),PAF(3)); }
  #undef PKW
  #undef PAF
  #undef VFR
  #undef PIN
  #undef MX3
  #undef GAPA
  #undef GAPB
  #undef EX
  #undef VRD
  #undef KRD
  #undef STEP
  #undef ENDW
  {auto rr=__builtin_amdgcn_permlane32_swap(__float_as_uint(l_reg),__float_as_uint(l_reg),false,false);l_reg=__uint_as_float(rr[0])+__uint_as_float(rr[1]);}
  if(hi==0)wsf[32+r32]=l_reg;asm volatile("s_waitcnt lgkmcnt(0)":::"memory");
  float rli[16];
  #pragma unroll
  for(int r=0;r<16;++r)rli[r]=__builtin_amdgcn_rcpf(wsf[32+crow(r,hi)]);
  bf16*Ow=O+(rowbase+q0+wid*QBLK)*DM+h*D;
  { bf16*stg=(bf16*)(shm+LDS_OST)+wid*2048;
    #pragma unroll
    for(int r=0;r<16;++r){const int orow=crow(r,hi);
      #pragma unroll
      for(int d0=0;d0<2;++d0)stg[orow*64+d0*32+r32]=__float2bfloat16(o[d0][r]*rli[r]);}
    asm volatile("s_waitcnt lgkmcnt(0)":::"memory");
    #pragma unroll
    for(int i=0;i<4;++i){const int row=i*8+(lane>>3),ch=lane&7; const u32x4 v=*(const u32x4*)(stg+row*64+ch*8); ATTN_STORE16(Ow+(long)row*DM+ch*8,v);} }
  asm volatile("s_waitcnt lgkmcnt(0)\n\ts_barrier":::"memory");
  #undef BIASADD
  #undef DMA_K
  #undef DMA_V
  #undef CMASK
  #undef START
  #undef RESC
  #undef ROT
}
constexpr int ATTN_LDS_BYTES=LDS_BYTES;
struct AttnTensors { const bf16* Q; const bf16* K; const bf16* V; bf16* O; const float* logf;   };
struct AttnUnit { int bh; int qb; };
struct StaticOrder {
  int vcu;
  __device__ __forceinline__ explicit StaticOrder(int grid,int block):vcu((block%8)*(grid/8)+block/8){}
  __device__ __forceinline__ bool next(int i,AttnUnit&u)const{ if(i>=4)return false; const int s=vcu&7; u.bh=vcu>>3; u.qb=(i==0)?s:(i==1)?15-s:(i==2)?16+s:31-s; return true; }
  __device__ __forceinline__ void a_ready(const AttnUnit&)const{}
  __device__ __forceinline__ void done(const AttnUnit&)const{}
};
template<class Sched,int THRL=8> __device__ __forceinline__ void attn_phase(char*lds,const AttnTensors&T,const Sched&S){
  AttnUnit u;
  for(int i=0;S.next(i,u);++i){ S.a_ready(u); attn_unit<THRL>(u.bh/NHEAD,u.bh%NHEAD,u.qb,T.Q,T.K,T.V,T.O,lds,T.logf+(size_t)u.bh*SEQ); S.done(u); }
}
#undef SBAR
#undef WAIT_BAR
}
constexpr int NWAVES = 8, NTHREADS = NWAVES * 64;
constexpr int BATCH = 2, SEQ = 8192, D = 1024, M = BATCH * SEQ;
constexpr int S5G = 32, S5H = 16, S5P = 64, S5T = 32  , S5NC = M / S5T  , S5KX = 640  ;
constexpr int SBH = 8, FOXH = 16, HD = 64;
constexpr int EVEN_IN = 2048, ODD_IN = 3088, DFF = 2816, NEXP = 8, DFE = 3584;
constexpr float C2 = 0.125f * 1.4426950408889634f;
constexpr int MOE_CHUNK_PANELS = 68, MOE_MAX_PANELS = 136, MOE_MAX_SLOTS = MOE_MAX_PANELS * 256;

constexpr size_t MiB = 1u << 20;
constexpr size_t WS_CTL = 0, CTL_ZERO_BYTES = 1 * MiB;
constexpr size_t WS_WMOE_GU = 1 * MiB;
constexpr size_t WS_WMOE_D = 113 * MiB;
constexpr size_t WS_WIN0 = 169 * MiB;
constexpr size_t WS_WGLU = 173 * MiB;
constexpr size_t WS_WOUT0 = 174 * MiB;
constexpr size_t WS_WGU0 = 176 * MiB;
constexpr size_t WS_WD0 = 187 * MiB;
constexpr size_t WS_WIN1 = 193 * MiB;
constexpr size_t WS_WF1 = 199 * MiB;
constexpr size_t WS_WOUT1 = 200 * MiB;
constexpr size_t WS_S5WA = 202 * MiB;
constexpr size_t WS_S5WC = 210 * MiB;
constexpr size_t WS_XB = 230 * MiB;
constexpr size_t WS_QKV0 = 262 * MiB;
constexpr size_t WS_UEXT = 310 * MiB;
constexpr size_t WS_SLOC = 330 * MiB;
constexpr size_t WS_YG = 338 * MiB;
constexpr size_t WS_MIXB = 354 * MiB;
constexpr size_t WS_HID0 = 262 * MiB;
constexpr size_t WS_QKV1 = 262 * MiB;
constexpr size_t WS_LOGF = 358 * MiB;
constexpr size_t WS_O1 = 359 * MiB;
constexpr size_t WS_META = 356 * MiB;
constexpr size_t WS_XG = 288 * MiB;
constexpr size_t WS_HMOE = 169 * MiB;
constexpr size_t WS_SSP = 392 * MiB;
constexpr size_t WS_END = 396 * MiB;
static_assert(WS_HMOE + (size_t)MOE_CHUNK_PANELS * 256 * DFE * 2 <= WS_XG && WS_XG + (size_t)MOE_MAX_SLOTS * 1024 * 2 <= WS_META && WS_O1 + (size_t)M * 1024 * 2 <= WS_END, "ws map");
constexpr size_t MT_RSTD = 0, MT_TOKE = 65536, MT_TOKP = 131072, MT_TOKG = 262144, MT_TOKSLOT = 393216, MT_RSS = 524288;
constexpr int CW_TMO = 0, CW_CODE = 1, CW_BAR = 4096, CW_CNT = 8192  , CW_SS = 32768  ;

constexpr int RING_OFF = 0, RING_BYTES = 131072;
constexpr int LDSCTL_OFF = RING_BYTES, MISC_OFF = LDSCTL_OFF + 320;
constexpr int LDS_BYTES = 147456;

#define GAS __attribute__((address_space(1)))
#define LAS __attribute__((address_space(3)))
typedef unsigned short bf16;
typedef unsigned v4u __attribute__((ext_vector_type(4)));
typedef unsigned v2u __attribute__((ext_vector_type(2)));
typedef float f32x4 __attribute__((ext_vector_type(4)));
typedef short bf16x8 __attribute__((ext_vector_type(8)));
typedef GAS unsigned gu32;
#define RLX_AGENT __ATOMIC_RELAXED, __HIP_MEMORY_SCOPE_AGENT
#define LDS_WAIT() asm volatile("s_waitcnt lgkmcnt(0)" ::: "memory")
#define VM_WAIT() asm volatile("s_waitcnt vmcnt(0)" ::: "memory")
__device__ __forceinline__ unsigned f2bf(float f) { unsigned u = __builtin_bit_cast(unsigned, f); return (u + 0x7fffu + ((u >> 16) & 1u)) >> 16; }
__device__ __forceinline__ unsigned pk2(float lo, float hi) { return f2bf(lo) | (f2bf(hi) << 16); }
__device__ __forceinline__ float bflo(unsigned w) { return __uint_as_float(w << 16); }
__device__ __forceinline__ float bfhi(unsigned w) { return __uint_as_float(w & 0xffff0000u); }

#define XB_TMO      128
#define XB_XCNT(j)  (256  + 64 * (j))
#define XB_XSUB(j)  (1280 + 64 * (j))
#define XB_XGEN(j)  (2304 + 64 * (j))
#define XB_TOP      3328
#define XB_TOPGEN   3392
#define XCD_BAR_WORDS 3456
#define XB_SPIN_CAP (1u << 18)
__device__ __forceinline__ unsigned xb_ld(unsigned* p)              { return __hip_atomic_load(p, __ATOMIC_RELAXED, __HIP_MEMORY_SCOPE_AGENT); }
__device__ __forceinline__ unsigned xb_add(unsigned* p, unsigned v) { return __hip_atomic_fetch_add(p, v, __ATOMIC_RELAXED, __HIP_MEMORY_SCOPE_AGENT); }
__device__ __forceinline__ unsigned xb_xcc_id() { return (unsigned)__builtin_amdgcn_s_getreg((3 << 11) | 20) & 0xFu; }
#define XB_SPIN(cond, bar) do { unsigned _sp = 0; while (cond) { __builtin_amdgcn_s_sleep(1); \
    if ((++_sp & 255u) == 0u) { if (xb_ld(&(bar)[XB_TMO])) break; if (_sp > XB_SPIN_CAP) { atomicAdd(&(bar)[XB_TMO], 1u); break; } } } } while (0)
struct XcdBarrier { unsigned* bar; unsigned x; volatile LAS unsigned* st; };
__device__ __forceinline__ XcdBarrier xcd_barrier_post(unsigned* bar, volatile LAS unsigned* st) {
    XcdBarrier b; b.bar = bar; b.x = xb_xcc_id(); b.st = st;
    if (threadIdx.x == 0) (void)xb_add(&bar[XB_XCNT(b.x)], 1u);
    return b;
}
__device__ __forceinline__ void xcd_barrier_complete(unsigned* bar, unsigned x, unsigned& nloc, unsigned& nx) {
    const unsigned G = gridDim.x * gridDim.y * gridDim.z;
    unsigned sum, cnt, mine, sp = 0u;
    for (;;) {
        sum = 0u; cnt = 0u; mine = 0u;
#pragma unroll
        for (unsigned j = 0; j < 16; ++j) { const unsigned c = xb_ld(&bar[XB_XCNT(j)]); sum += c; cnt += (c > 0u) ? 1u : 0u; mine = (j == x) ? c : mine; }
        if (sum == G) break;
        __builtin_amdgcn_s_sleep(1);
        if ((++sp & 255u) == 0u) { if (xb_ld(&bar[XB_TMO])) break; if (sp > XB_SPIN_CAP) { atomicAdd(&bar[XB_TMO], 1u); break; } }
    }
    nloc = mine > 0u ? mine : 1u; nx = cnt > 0u ? cnt : 1u;
}
__device__ __forceinline__ void xcd_barrier(const XcdBarrier& b) {
    asm volatile("s_waitcnt vmcnt(0)" ::: "memory");
    __syncthreads();
    if (threadIdx.x == 0) {
        unsigned* bar = b.bar;
        __builtin_amdgcn_s_waitcnt(0);
        unsigned nloc = b.st[0], nx = b.st[1];
        if (nloc == 0u) { xcd_barrier_complete(bar, b.x, nloc, nx); b.st[0] = nloc; b.st[1] = nx; }
        const unsigned old = xb_add(&bar[XB_XSUB(b.x)], 1u);
        const unsigned gen = old / nloc;
        if (old + 1u == (gen + 1u) * nloc) {
            __builtin_amdgcn_fence(__ATOMIC_RELEASE, "agent");
            asm volatile("s_waitcnt vmcnt(0)" ::: "memory");
            const unsigned og = xb_add(&bar[XB_TOP], 1u);
            const unsigned tg = og / nx;
            if (og + 1u == (tg + 1u) * nx) xb_add(&bar[XB_TOPGEN], 1u);
            else XB_SPIN(xb_ld(&bar[XB_TOPGEN]) == tg, bar);
            __builtin_amdgcn_fence(__ATOMIC_ACQUIRE, "agent");
            xb_add(&bar[XB_XGEN(b.x)], 1u);
            asm volatile("s_waitcnt vmcnt(0)" ::: "memory");
        } else {
            XB_SPIN(xb_ld(&bar[XB_XGEN(b.x)]) == gen, bar);
            __builtin_amdgcn_fence(__ATOMIC_ACQUIRE, "agent");
            asm volatile("s_waitcnt vmcnt(0)" ::: "memory");
        }
    }
    __syncthreads();
}

__device__ __forceinline__ float wave_sum(float v) {
#pragma unroll
    for (int o = 1; o < 64; o <<= 1) v += __shfl_xor(v, o);
    return v;
}
__device__ __forceinline__ void p0_transpose_item(const float* W, int ldw, int k0, int n0, const float* gs, bf16* dst, int ldd, LAS float* scr, int lane) {
#pragma unroll 8
    for (int i = 0; i < 32; ++i) { const int kk = 2 * i + (lane >> 5); float v = W[(size_t)(k0 + kk) * ldw + n0 + (lane & 31)]; if (gs) v *= gs[k0 + kk]; scr[kk * 33 + (lane & 31)] = v; }
    LDS_WAIT(); asm volatile("" ::: "memory");
    const int c = lane & 7;
#pragma unroll
    for (int j = 0; j < 4; ++j) { const int n = (lane >> 3) + 8 * j; const LAS float* s = scr + (8 * c) * 33 + n;
        v4u o; o.x = pk2(s[0 * 33], s[1 * 33]); o.y = pk2(s[2 * 33], s[3 * 33]); o.z = pk2(s[4 * 33], s[5 * 33]); o.w = pk2(s[6 * 33], s[7 * 33]);
        *(GAS v4u*)(dst + (size_t)n * ldd + k0 + 8 * c) = o; }
    LDS_WAIT(); asm volatile("" ::: "memory");
}
__device__ __forceinline__ void xpose_mat(int item, const float* W, int ldw, int N, const float* gs, bf16* dst, int ldd, int mode, LAS float* scr, int lane) {
    const int nblk = N / 32, kb = item / nblk, nb = item % nblk, n0 = 32 * nb;
    const int row = mode == 0 ? n0 : ((n0 >> 7) * 256 + (n0 & 127) + (mode == 2 ? 128 : 0));
    p0_transpose_item(W, ldw, 64 * kb, n0, gs, dst + (size_t)row * ldd, ldd, scr, lane);
}

struct Args { const float* in[28]; float* out; unsigned char* ws; };

__device__ __forceinline__ void s5_tables(const Args& a, int g, LAS unsigned char* lds, int tid) {
    LAS float* POWr = (LAS float*)lds;
    LAS float* POWi = POWr + 33 * 64;
    LAS float* BBr = POWi + 33 * 64;
    LAS float* BBi = BBr + 1024;
    LAS float* CCr = BBi + 1024;
    LAS float* CCi = CCr + 1024;
    LAS float* KT = CCi + 1024;
    LAS float* DD = KT + 8192;
    const float* a_re = a.in[3]; const float* a_im = a.in[4]; const float* b_re = a.in[5]; const float* b_im = a.in[6];
    const float* c_re = a.in[7]; const float* c_im = a.in[8]; const float* dsk = a.in[9]; const float* log_step = a.in[10];
    const float step = expf(log_step[g]);
    __syncthreads();
    for (int e = tid; e < 33 * 64; e += NTHREADS) { const int n = e >> 6, p = e & 63; const float lr = a_re[g * 64 + p], li = a_im[g * 64 + p];
        const float mag = expf((float)n * step * lr); float sn, cs; sincosf((float)n * (step * li), &sn, &cs); POWr[e] = mag * cs; POWi[e] = mag * sn; }
    for (int e = tid; e < 1024; e += NTHREADS) { const int p = e >> 4, h = e & 15; const float lr = a_re[g * 64 + p], li = a_im[g * 64 + p];
        const float er = expf(lr * step); float sn, cs; sincosf(li * step, &sn, &cs); const float nr = er * cs - 1.f, ni = er * sn, den = lr * lr + li * li;
        const float fr = (nr * lr + ni * li) / den, fi = (ni * lr - nr * li) / den;
        const float br = b_re[(g * 64 + p) * 16 + h], bi = b_im[(g * 64 + p) * 16 + h];
        BBr[e] = fr * br - fi * bi; BBi[e] = fr * bi + fi * br;
        CCr[e] = c_re[g * 1024 + e]; CCi[e] = c_im[g * 1024 + e]; }
    if (tid < 16) DD[tid] = dsk[g * 16 + tid];
    __syncthreads();
    for (int e = tid; e < 8192; e += NTHREADS) { const int tau = e >> 8, ho = (e >> 4) & 15, hi = e & 15; float s = 0.f;
        for (int p = 0; p < 64; ++p) { const float cr = CCr[ho * 64 + p], ci = CCi[ho * 64 + p], pr = POWr[tau * 64 + p], pi = POWi[tau * 64 + p];
            const float xr = cr * pr - ci * pi, xi = cr * pi + ci * pr; s += xr * BBr[p * 16 + hi] - xi * BBi[p * 16 + hi]; }
        if (tau == 0 && ho == hi) s += DD[ho];
        KT[e] = s; }
    __syncthreads();
    bf16* WA = (bf16*)(a.ws + WS_S5WA) + (size_t)g * 256 * 512;
    for (int pc = tid; pc < 256 * 64; pc += NTHREADS) { const int n = pc >> 6, k0 = (pc & 63) * 8; v4u o = (v4u){0u, 0u, 0u, 0u};
        if (n < 128) { const int p = n & 63, j = k0 >> 4, h0 = k0 & 15; const float pr = POWr[(31 - j) * 64 + p], pi = POWi[(31 - j) * 64 + p]; float v[8];
#pragma unroll
            for (int q = 0; q < 8; ++q) { const float br = BBr[p * 16 + h0 + q], bi = BBi[p * 16 + h0 + q]; v[q] = (n < 64) ? (pr * br - pi * bi) : (pr * bi + pi * br); }
            o.x = pk2(v[0], v[1]); o.y = pk2(v[2], v[3]); o.z = pk2(v[4], v[5]); o.w = pk2(v[6], v[7]); }
        *(GAS v4u*)(WA + (size_t)n * 512 + k0) = o; }
    bf16* WC = (bf16*)(a.ws + WS_S5WC) + (size_t)g * 512 * 640;
    for (int pc = tid; pc < 512 * 80; pc += NTHREADS) { const int n = pc / 80, k0 = (pc % 80) * 8, i = n >> 4, ho = n & 15; float v[8];
        if (k0 < 512) { const int j = k0 >> 4, h0 = k0 & 15;
#pragma unroll
            for (int q = 0; q < 8; ++q) v[q] = (j <= i) ? KT[((i - j) * 16 + ho) * 16 + h0 + q] : 0.f; }
        else { const int p0 = (k0 - 512) & 63; const bool im = k0 >= 576;
#pragma unroll
            for (int q = 0; q < 8; ++q) { const int p = p0 + q; const float cr = CCr[ho * 64 + p], ci = CCi[ho * 64 + p], pr = POWr[(i + 1) * 64 + p], pi = POWi[(i + 1) * 64 + p];
                v[q] = im ? -(cr * pi + ci * pr) : (cr * pr - ci * pi); } }
        v4u o; o.x = pk2(v[0], v[1]); o.y = pk2(v[2], v[3]); o.z = pk2(v[4], v[5]); o.w = pk2(v[6], v[7]);
        *(GAS v4u*)(WC + (size_t)n * 640 + k0) = o; }
    __syncthreads();
}

__device__ __forceinline__ void p0_prologue(const Args& a, LAS unsigned char* lds, int tid, int lane, int wave, int vcu, int G) {
    for (int g = vcu; g < S5G; g += G) s5_tables(a, g, lds, tid);
    LAS float* scr = (LAS float*)(lds + wave * 16384);
    const int gw = vcu * NWAVES + wave, NGW = G * NWAVES;
    constexpr int I_IN0 = 16 * 64, I_GLU = 8 * 16, I_OUT = 16 * 32, I_GU0 = 16 * 88, I_D0 = 44 * 32, I_IN1 = 16 * 96, I_MOE = 1792;
    constexpr int NITEMS = I_IN0 + I_GLU + I_OUT + 2 * I_GU0 + I_D0 + I_IN1 + I_OUT + 24 * I_MOE;
    unsigned char* ws = a.ws;
    for (int it = NITEMS - 1 - gw; it >= 0; it -= NGW) {
        int r = it;
        if (r < I_IN0) { xpose_mat(r, a.in[2], EVEN_IN, EVEN_IN, a.in[1], (bf16*)(ws + WS_WIN0), D, 0, scr, lane); continue; } r -= I_IN0;
        if (r < I_GLU) { xpose_mat(r, a.in[11], 512, 512, nullptr, (bf16*)(ws + WS_WGLU), 512, 0, scr, lane); continue; } r -= I_GLU;
        if (r < I_OUT) { xpose_mat(r, a.in[13], D, D, nullptr, (bf16*)(ws + WS_WOUT0), D, 0, scr, lane); continue; } r -= I_OUT;
        if (r < I_GU0) { xpose_mat(r, a.in[15], DFF, DFF, a.in[14], (bf16*)(ws + WS_WGU0), D, 1, scr, lane); continue; } r -= I_GU0;
        if (r < I_GU0) { xpose_mat(r, a.in[16], DFF, DFF, a.in[14], (bf16*)(ws + WS_WGU0), D, 2, scr, lane); continue; } r -= I_GU0;
        if (r < I_D0) { xpose_mat(r, a.in[17], D, D, nullptr, (bf16*)(ws + WS_WD0), DFF, 0, scr, lane); continue; } r -= I_D0;
        if (r < I_IN1) { xpose_mat(r, a.in[19], ODD_IN, 3072, a.in[18], (bf16*)(ws + WS_WIN1), D, 0, scr, lane); continue; } r -= I_IN1;
        if (r < I_OUT) { xpose_mat(r, a.in[21], D, D, nullptr, (bf16*)(ws + WS_WOUT1), D, 0, scr, lane); continue; } r -= I_OUT;
        const int mat = r / I_MOE, e = mat / 3, which = mat % 3; r -= mat * I_MOE;
        if (which == 0) xpose_mat(r, a.in[24] + (size_t)e * D * DFE, DFE, DFE, a.in[22], (bf16*)(ws + WS_WMOE_GU) + (size_t)e * 7168 * 1024, D, 1, scr, lane);
        else if (which == 1) xpose_mat(r, a.in[25] + (size_t)e * D * DFE, DFE, DFE, a.in[22], (bf16*)(ws + WS_WMOE_GU) + (size_t)e * 7168 * 1024, D, 2, scr, lane);
        else xpose_mat(r, a.in[26] + (size_t)e * DFE * D, D, D, nullptr, (bf16*)(ws + WS_WMOE_D) + (size_t)e * 1024 * 3584, DFE, 0, scr, lane);
    }
    { const int gt = vcu * NTHREADS + tid; if (gt < 16 * 1024) { const int h = gt >> 10, k = gt & 1023; ((bf16*)(ws + WS_WF1))[gt] = (bf16)f2bf(a.in[19][(size_t)k * ODD_IN + 3072 + h] * a.in[18][k]); } }
    float* ss0 = (float*)(ws + WS_SSP);
    for (int m = gw; m < M; m += NGW) {
        const GAS f32x4* xr = (const GAS f32x4*)(a.in[0] + (size_t)m * D) + lane; GAS v2u* o8 = (GAS v2u*)((bf16*)(ws + WS_XB) + (size_t)m * D) + lane; float s = 0.f;
#pragma unroll
        for (int j = 0; j < 4; ++j) { const f32x4 v = xr[64 * j]; s += (v.x * v.x + v.y * v.y) + (v.z * v.z + v.w * v.w); v2u w; w.x = pk2(v.x, v.y); w.y = pk2(v.z, v.w); o8[64 * j] = w; }
        s = wave_sum(s); if (lane < 16) ss0[(size_t)m * 16 + lane] = (lane == 0) ? s : 0.f;
    }
}

__device__ __forceinline__ void s5_scan(const Args& a, int gt  ) {
    if (gt >= BATCH * S5G * S5P) return;
    const int b = gt / (S5G * S5P), g = (gt / S5P) % S5G, p = gt % S5P;
    const float step = expf(a.in[10][g]); const float lr = a.in[3][g * 64 + p], li = a.in[4][g * 64 + p];
    const float mag = expf((float)S5T * step * lr); float sn, cs; sincosf((float)S5T * (step * li), &sn, &cs); const float ar = mag * cs, ai = mag * sn;
    const float* sl = (const float*)(a.ws + WS_SLOC) + ((size_t)g * S5NC + b * 256) * 128 + p;
    bf16* ue = (bf16*)(a.ws + WS_UEXT) + ((size_t)g * S5NC + b * 256) * S5KX + 512 + p;
    float sr = 0.f, si = 0.f;
#pragma unroll 8
    for (int c = 0; c < 256; ++c) {
        ue[(size_t)c * S5KX] = (bf16)f2bf(sr); ue[(size_t)c * S5KX + 64] = (bf16)f2bf(si);
        const float lr_ = sl[(size_t)c * 128], li_ = sl[(size_t)c * 128 + 64];
        const float nr = ar * sr - ai * si + lr_, ni = ar * si + ai * sr + li_; sr = nr; si = ni;
    }
}

__device__ __forceinline__ float softplus2(float z) { return fmaxf(z, 0.f) + __builtin_amdgcn_logf(1.0f + __builtin_amdgcn_exp2f(-fabsf(z))); }
__device__ __forceinline__ void stage_kv32(const bf16* kp, const bf16* vp, size_t pitch, LAS float* sK, LAS float* sV, int tid) {
    const int r = tid >> 4, c = (tid & 15) * 4;
    const v2u kw = *(const v2u*)(kp + (size_t)r * pitch + c), vw = *(const v2u*)(vp + (size_t)r * pitch + c);
    *(LAS f32x4*)(sK + r * 64 + c) = (f32x4){bflo(kw.x), bfhi(kw.x), bflo(kw.y), bfhi(kw.y)};
    *(LAS f32x4*)(sV + r * 64 + c) = (f32x4){bflo(vw.x), bfhi(vw.x), bflo(vw.y), bfhi(vw.y)};
}
__device__ __forceinline__ void sb_simple_unit(const bf16* qkv  , bf16* mix  , int b, int h, int blk, LAS unsigned char* lds, int tid) {
    const int lane = tid & 63, wave_ = tid >> 6;
    LAS float* sK = (LAS float*)lds; LAS float* sV = sK + 32 * 64;
    const int t = blk * 512 + tid; const size_t rb = (size_t)b * SEQ;
    float q[HD], acc[HD];
    { const v4u* qp = (const v4u*)(qkv + (rb + t) * 1536 + h * HD);
#pragma unroll
      for (int i = 0; i < 8; ++i) { const v4u w = qp[i]; q[8 * i] = bflo(w.x); q[8 * i + 1] = bfhi(w.x); q[8 * i + 2] = bflo(w.y); q[8 * i + 3] = bfhi(w.y); q[8 * i + 4] = bflo(w.z); q[8 * i + 5] = bfhi(w.z); q[8 * i + 6] = bflo(w.w); q[8 * i + 7] = bfhi(w.w); }
#pragma unroll
      for (int i = 0; i < HD; ++i) acc[i] = 0.f; }
    float carry = 0.f;
    for (int c0 = blk * 512 + 480; c0 >= 0; c0 -= 32) {
        __syncthreads();
        stage_kv32(qkv + (rb + c0) * 1536 + 512 + h * HD, qkv + (rb + c0) * 1536 + 1024 + h * HD, 1536, sK, sV, tid);
        __syncthreads();
        for (int r = 31; r >= 0; --r) { const int s = c0 + r;
            if (s < t) { float z = 0.f;
#pragma unroll
                for (int i = 0; i < HD; ++i) z = fmaf(q[i], sK[r * 64 + i], z);
                const float sp = softplus2(z); const float w = __builtin_amdgcn_exp2f(z - sp + carry); carry -= sp;
#pragma unroll
                for (int i = 0; i < HD; ++i) acc[i] = fmaf(w, sV[r * 64 + i], acc[i]); } }
        { LAS unsigned* fl = (LAS unsigned*)(lds + 16384); if (lane == 0) fl[wave_] = __all(carry < -150.f) ? 1u : 0u; __syncthreads();
          if ((fl[0] & fl[1] & fl[2] & fl[3] & fl[4] & fl[5] & fl[6] & fl[7]) != 0u) break; }
    }
    v4u* op = (v4u*)(mix + (rb + t) * 1024 + 512 + h * HD);
#pragma unroll
    for (int i = 0; i < 8; ++i) { v4u w; w.x = pk2(acc[8 * i], acc[8 * i + 1]); w.y = pk2(acc[8 * i + 2], acc[8 * i + 3]); w.z = pk2(acc[8 * i + 4], acc[8 * i + 5]); w.w = pk2(acc[8 * i + 6], acc[8 * i + 7]); op[i] = w; }
}
__device__ __forceinline__ void fgate_rows16(const bf16* xb, const bf16* wf, const float* ss, const float* bfv, float* logf, int r0, int lane) {
    const int fr = lane & 15, fq = lane >> 4;
    const bf16x8* ap = (const bf16x8*)(xb + (size_t)(r0 + fr) * D + fq * 8);
    const bf16x8* bp = (const bf16x8*)(wf + (size_t)fr * D + fq * 8);
    f32x4 acc = (f32x4){0.f, 0.f, 0.f, 0.f};
#pragma unroll 8
    for (int kk = 0; kk < 32; ++kk) acc = __builtin_amdgcn_mfma_f32_16x16x32_bf16(ap[kk * 4], bp[kk * 4], acc, 0, 0, 0);
    const float bias = bfv[fr];
#pragma unroll
    for (int j = 0; j < 4; ++j) { const int row = r0 + fq * 4 + j; const float rs = pg8::rstd16(ss, row);
        const float z = acc[j] * rs + bias;
        const float lf = -(fmaxf(-z, 0.f) + log1pf(expf(-fabsf(z)))) * 1.4426950408889634f;
        const int b = row >> 13, t = row & 8191; logf[((size_t)b * FOXH + fr) * SEQ + t] = lf; }
}

struct MoeOrder {
    pg8::StaticOrder S; int lo; int pref[NEXP + 1];
    __device__ __forceinline__ bool next(int i, pg8::Unit& u) const {
        if (!S.next(i, u)) return false;
        u.pm += lo; int e = 0;
#pragma unroll
        for (int k = 1; k < NEXP; ++k) e += (u.pm >= pref[k]) ? 1 : 0;
        u.zb = e; return true;
    }
    __device__ __forceinline__ void a_ready(const pg8::Unit&) const {}
    __device__ __forceinline__ void done(const pg8::Unit&) const {}
};

__global__ void __launch_bounds__(NTHREADS, 2) mk_fwd(Args args) {
    extern __shared__ __attribute__((aligned(16))) unsigned char lds_raw[];
    LAS unsigned char* lds = (LAS unsigned char*)lds_raw;
    volatile LAS unsigned* MISC = (volatile LAS unsigned*)(lds + MISC_OFF);
    const int tid = threadIdx.x, lane = tid & 63, wave = __builtin_amdgcn_readfirstlane(tid >> 6);
    const int G = gridDim.x; const int bx = blockIdx.x; const int vcu = (G % 8 == 0) ? (bx % 8) * (G / 8) + bx / 8 : bx;
    unsigned char* ws = args.ws;
    gu32* ctl = (gu32*)(ws + WS_CTL);
    for (int u = tid; u < (LDS_BYTES - LDSCTL_OFF) / 4; u += NTHREADS) ((LAS unsigned*)(lds + LDSCTL_OFF))[u] = 0u;
    __syncthreads();
    XcdBarrier bar = xcd_barrier_post((unsigned*)(ctl + CW_BAR), MISC + 8);
    const int gw = vcu * NWAVES + wave, NGW = G * NWAVES;
    float* SS = (float*)(ws + WS_SSP);
    float* X = args.out;
    bf16* XB = (bf16*)(ws + WS_XB);
#define GRID_BAR() xcd_barrier(bar)
#define GEMM_PHASE(EPI, SCHED, lds_, g_, S_, E_) pg8::gemm_phase<EPI, SCHED, true, true>(lds_, g_, S_, E_)

    p0_prologue(args, lds, tid, lane, wave, vcu, G);
    GRID_BAR();
    { pg8::Gemm g{XB, (const bf16*)(ws + WS_WIN0), D, D, D, 0, 0}; pg8::StaticOrder S; S.init(M, EVEN_IN, 1, G, bx);
      pg8::EpiInProj0 E{SS, (bf16*)(ws + WS_UEXT), (bf16*)(ws + WS_QKV0), C2};
      GEMM_PHASE(pg8::EpiInProj0, pg8::StaticOrder, lds + RING_OFF, g, S, E); }
    GRID_BAR();
    { pg8::Gemm g{(const bf16*)(ws + WS_UEXT), (const bf16*)(ws + WS_S5WA), S5KX, 512, 512, (size_t)S5NC * S5KX * 2, (size_t)256 * 512 * 2}; pg8::StaticOrder S; S.init(S5NC, 256, S5G, G, bx);
      pg8::EpiS5State E{(float*)(ws + WS_SLOC)};
      GEMM_PHASE(pg8::EpiS5State, pg8::StaticOrder, lds + RING_OFF, g, S, E); }
    GRID_BAR();
    s5_scan(args, vcu * NTHREADS + tid);
    GRID_BAR();
    { pg8::Gemm g{(const bf16*)(ws + WS_UEXT), (const bf16*)(ws + WS_S5WC), S5KX, S5KX, S5KX, (size_t)S5NC * S5KX * 2, (size_t)512 * S5KX * 2}; pg8::StaticOrder S; S.init(S5NC, 512, S5G, G, bx);
      pg8::EpiS5Y E{(bf16*)(ws + WS_YG)};
      GEMM_PHASE(pg8::EpiS5Y, pg8::StaticOrder, lds + RING_OFF, g, S, E); }
    GRID_BAR();
    { pg8::Gemm g{(const bf16*)(ws + WS_YG), (const bf16*)(ws + WS_WGLU), 512, 512, 512, 0, 0}; pg8::StaticOrder S; S.init(M, 512, 1, G, bx);
      pg8::EpiGlu E{(const bf16*)(ws + WS_YG), args.in[12], (bf16*)(ws + WS_MIXB)};
      GEMM_PHASE(pg8::EpiGlu, pg8::StaticOrder, lds + RING_OFF, g, S, E); }
    __syncthreads();
    for (int L = vcu; L < BATCH * SBH * 16; L += G) sb_simple_unit((const bf16*)(ws + WS_QKV0), (bf16*)(ws + WS_MIXB), L / (SBH * 16), (L / 16) % SBH, L % 16, lds, tid);
    GRID_BAR();
    { pg8::Gemm g{(const bf16*)(ws + WS_MIXB), (const bf16*)(ws + WS_WOUT0), D, D, D, 0, 0}; pg8::StaticOrder S; S.init(M, D, 1, G, bx);
      pg8::EpiResid E{args.in[0], X, XB, SS + 16 * M};
      GEMM_PHASE(pg8::EpiResid, pg8::StaticOrder, lds + RING_OFF, g, S, E); }
    GRID_BAR();
    { pg8::Gemm g{XB, (const bf16*)(ws + WS_WGU0), D, D, D, 0, 0}; pg8::StaticOrder S; S.init(M, 2 * DFF, 1, G, bx);
      pg8::EpiSwiGlu<true> E{SS + 16 * M, (bf16*)(ws + WS_HID0), DFF};
      GEMM_PHASE(pg8::EpiSwiGlu<true>, pg8::StaticOrder, lds + RING_OFF, g, S, E); }
    GRID_BAR();
    { pg8::Gemm g{(const bf16*)(ws + WS_HID0), (const bf16*)(ws + WS_WD0), DFF, DFF, DFF, 0, 0}; pg8::StaticOrder S; S.init(M, D, 1, G, bx);
      pg8::EpiResid E{X, X, XB, SS + 32 * M};
      GEMM_PHASE(pg8::EpiResid, pg8::StaticOrder, lds + RING_OFF, g, S, E); }
    GRID_BAR();
    { pg8::Gemm g{XB, (const bf16*)(ws + WS_WIN1), D, D, D, 0, 0}; pg8::StaticOrder S; S.init(M, 3072, 1, G, bx);
      pg8::EpiInProj1 E{SS + 32 * M, (bf16*)(ws + WS_QKV1), C2};
      GEMM_PHASE(pg8::EpiInProj1, pg8::StaticOrder, lds + RING_OFF, g, S, E); }
    for (int r = gw; r < M / 16; r += NGW) fgate_rows16(XB, (const bf16*)(ws + WS_WF1), SS + 32 * M, args.in[20], (float*)(ws + WS_LOGF), r * 16, lane);
    GRID_BAR();
    { const attn_body::AttnTensors AT{(const attn_body::bf16*)(ws + WS_QKV1), (const attn_body::bf16*)(ws + WS_QKV1 + 32 * MiB), (const attn_body::bf16*)(ws + WS_QKV1 + 64 * MiB), (attn_body::bf16*)(ws + WS_QKV1), (const float*)(ws + WS_LOGF)};
      if (bx < 256) { const attn_body::StaticOrder S(256, bx); attn_body::attn_phase<attn_body::StaticOrder>((char*)lds_raw + RING_OFF, AT, S); } }
    GRID_BAR();
    { pg8::Gemm g{(const bf16*)(ws + WS_QKV1), (const bf16*)(ws + WS_WOUT1), D, D, D, 0, 0}; pg8::StaticOrder S; S.init(M, D, 1, G, bx);
      pg8::EpiResid E{X, X, XB, SS + 48 * M};
      GEMM_PHASE(pg8::EpiResid, pg8::StaticOrder, lds + RING_OFF, g, S, E); }
    GRID_BAR();
    unsigned char* meta = ws + WS_META;
    {
        const float* wr = args.in[23]; const float* gn = args.in[22];
        for (int tok = gw; tok < M; tok += NGW) {
            const GAS f32x4* xr = (const GAS f32x4*)(X + (size_t)tok * D) + lane; float lg[NEXP]; float s = 0.f;
#pragma unroll
            for (int e = 0; e < NEXP; ++e) lg[e] = 0.f;
#pragma unroll
            for (int j = 0; j < 4; ++j) { const f32x4 v = xr[64 * j]; s += (v.x * v.x + v.y * v.y) + (v.z * v.z + v.w * v.w); const int k0 = 4 * lane + 256 * j; const f32x4 gv = *(const f32x4*)(gn + k0);
#pragma unroll
                for (int q = 0; q < 4; ++q) { const float xv = v[q] * gv[q]; const f32x4 w0 = *(const f32x4*)(wr + (size_t)(k0 + q) * NEXP), w1 = *(const f32x4*)(wr + (size_t)(k0 + q) * NEXP + 4);
                    lg[0] = fmaf(xv, w0.x, lg[0]); lg[1] = fmaf(xv, w0.y, lg[1]); lg[2] = fmaf(xv, w0.z, lg[2]); lg[3] = fmaf(xv, w0.w, lg[3]);
                    lg[4] = fmaf(xv, w1.x, lg[4]); lg[5] = fmaf(xv, w1.y, lg[5]); lg[6] = fmaf(xv, w1.z, lg[6]); lg[7] = fmaf(xv, w1.w, lg[7]); } }
            s = wave_sum(s);
#pragma unroll
            for (int e = 0; e < NEXP; ++e) lg[e] = wave_sum(lg[e]);
            if (lane == 0) {
                const float rs = 1.0f / sqrtf(s * (1.0f / 1024.0f) + pg8::RMS_EPS);
                int i1 = 0; float v1 = lg[0];
#pragma unroll
                for (int e = 1; e < NEXP; ++e) if (lg[e] > v1) { v1 = lg[e]; i1 = e; }
                int i2 = -1; float v2 = -INFINITY;
#pragma unroll
                for (int e = 0; e < NEXP; ++e) if (e != i1 && lg[e] > v2) { v2 = lg[e]; i2 = e; }
                const float g1 = 1.f / (1.f + expf((v2 - v1) * rs)), g2 = 1.f - g1;
                const unsigned p1 = __hip_atomic_fetch_add(ctl + CW_CNT + 64 * i1, 1u, RLX_AGENT), p2 = __hip_atomic_fetch_add(ctl + CW_CNT + 64 * i2, 1u, RLX_AGENT);
                ((float*)(meta + MT_RSTD))[tok] = rs; ((unsigned*)(meta + MT_TOKE))[tok] = (unsigned)i1 | ((unsigned)i2 << 8);
                ((unsigned*)(meta + MT_TOKP))[2 * tok] = p1; ((unsigned*)(meta + MT_TOKP))[2 * tok + 1] = p2;
                ((float*)(meta + MT_TOKG))[2 * tok] = g1; ((float*)(meta + MT_TOKG))[2 * tok + 1] = g2;
            }
        }
    }
    GRID_BAR();
    int pref[NEXP + 1], cnt[NEXP];
    { pref[0] = 0;
#pragma unroll
      for (int e = 0; e < NEXP; ++e) { cnt[e] = (int)__builtin_amdgcn_readfirstlane(__hip_atomic_load(ctl + CW_CNT + 64 * e, RLX_AGENT)); pref[e + 1] = pref[e] + (cnt[e] + 255) / 256; } }
    const int NP = pref[NEXP];
    bf16* XG = (bf16*)(ws + WS_XG); float* RSS = (float*)(meta + MT_RSS);
    {
        for (int tok = gw; tok < M; tok += NGW) {
            const unsigned ee = ((const unsigned*)(meta + MT_TOKE))[tok]; const float rs = ((const float*)(meta + MT_RSTD))[tok];
            const v4u r0 = *(const v4u*)(XB + (size_t)tok * D + lane * 8), r1 = *(const v4u*)(XB + (size_t)tok * D + 512 + lane * 8);
#pragma unroll
            for (int k = 0; k < 2; ++k) { const int e = (ee >> (8 * k)) & 0xff; int pe = 0;
#pragma unroll
                for (int q = 0; q < NEXP; ++q) pe = (q == e) ? pref[q] : pe;
                const int slot = pe * 256 + (int)((const unsigned*)(meta + MT_TOKP))[2 * tok + k];
                *(v4u*)(XG + (size_t)slot * D + lane * 8) = r0; *(v4u*)(XG + (size_t)slot * D + 512 + lane * 8) = r1;
                if (lane == 0) { RSS[slot] = rs; ((unsigned*)(meta + MT_TOKSLOT))[2 * tok + k] = (unsigned)slot; } }
        }
#pragma unroll
        for (int e = 0; e < NEXP; ++e) for (int r = pref[e] * 256 + cnt[e] + gw; r < pref[e + 1] * 256; r += NGW) {
            *(v4u*)(XG + (size_t)r * D + lane * 8) = (v4u){0u, 0u, 0u, 0u}; *(v4u*)(XG + (size_t)r * D + 512 + lane * 8) = (v4u){0u, 0u, 0u, 0u}; if (lane == 0) RSS[r] = 0.f; }
    }
    GRID_BAR();
#pragma unroll
    for (int ch = 0; ch < 2; ++ch) {
        const int lo = ch * MOE_CHUNK_PANELS, hi = NP < (ch + 1) * MOE_CHUNK_PANELS ? NP : (ch + 1) * MOE_CHUNK_PANELS, np = hi > lo ? hi - lo : 0;
        bf16* Hc = (bf16*)(ws + WS_HMOE) - (size_t)lo * 256 * DFE;
        { pg8::Gemm g{XG, (const bf16*)(ws + WS_WMOE_GU), D, D, D, 0, (size_t)7168 * 1024 * 2}; MoeOrder S; S.S.nM = np; S.S.nN = 28; S.S.nZ = 1; S.S.nwg = np * 28; S.S.G = G; S.S.c = bx; S.lo = lo;
#pragma unroll
          for (int e = 0; e <= NEXP; ++e) S.pref[e] = pref[e];
          pg8::EpiSwiGlu<false> E{RSS, Hc, DFE};
          GEMM_PHASE(pg8::EpiSwiGlu<false>, MoeOrder, lds + RING_OFF, g, S, E); }
        GRID_BAR();
        { pg8::Gemm g{Hc, (const bf16*)(ws + WS_WMOE_D), DFE, DFE, DFE, 0, (size_t)1024 * 3584 * 2}; MoeOrder S; S.S.nM = np; S.S.nN = 4; S.S.nZ = 1; S.S.nwg = np * 4; S.S.G = G; S.S.c = bx; S.lo = lo;
#pragma unroll
          for (int e = 0; e <= NEXP; ++e) S.pref[e] = pref[e];
          pg8::EpiStoreBf16 E{XG, D};
          GEMM_PHASE(pg8::EpiStoreBf16, MoeOrder, lds + RING_OFF, g, S, E); }
        GRID_BAR();
    }
    {
        const float* gf = args.in[27];
        for (int tok = gw; tok < M; tok += NGW) {
            const unsigned s0 = ((const unsigned*)(meta + MT_TOKSLOT))[2 * tok], s1 = ((const unsigned*)(meta + MT_TOKSLOT))[2 * tok + 1];
            const float g0 = ((const float*)(meta + MT_TOKG))[2 * tok], g1 = ((const float*)(meta + MT_TOKG))[2 * tok + 1];
            GAS f32x4* xr = (GAS f32x4*)(X + (size_t)tok * D) + lane; f32x4 v[4]; float s = 0.f;
#pragma unroll
            for (int j = 0; j < 4; ++j) { v[j] = xr[64 * j]; const int k0 = 4 * lane + 256 * j;
                const v2u a = *(const v2u*)(XG + (size_t)s0 * D + k0), b2 = *(const v2u*)(XG + (size_t)s1 * D + k0);
                v[j].x += g0 * bflo(a.x) + g1 * bflo(b2.x); v[j].y += g0 * bfhi(a.x) + g1 * bfhi(b2.x); v[j].z += g0 * bflo(a.y) + g1 * bflo(b2.y); v[j].w += g0 * bfhi(a.y) + g1 * bfhi(b2.y);
                s += (v[j].x * v[j].x + v[j].y * v[j].y) + (v[j].z * v[j].z + v[j].w * v[j].w); }
            s = wave_sum(s); const float rs = 1.0f / sqrtf(s * (1.0f / 1024.0f) + pg8::RMS_EPS);
#pragma unroll
            for (int j = 0; j < 4; ++j) { const f32x4 gv = *(const f32x4*)(gf + 4 * lane + 256 * j); xr[64 * j] = v[j] * rs * gv; }
        }
    }
}

extern "C" void kernel_launch(void* const* d_in, const int* in_sizes, int n_in, void* d_out, int out_size, void* d_ws, size_t ws_size, hipStream_t stream) {
    static int grid = 0;
    if (grid == 0) {
        if (n_in != 28 || in_sizes[0] != M * D || out_size != M * D || ws_size < WS_END) { fprintf(stderr, "kernel_launch: unexpected problem: n_in %d in0 %d out %d ws %zu (need %zu)\n", n_in, n_in > 0 ? in_sizes[0] : -1, out_size, ws_size, (size_t)WS_END); grid = -1; return; }
        int dev = 0, cus = 0, per_cu = 0;
        if (hipGetDevice(&dev) != hipSuccess || hipDeviceGetAttribute(&cus, hipDeviceAttributeMultiprocessorCount, dev) != hipSuccess) { grid = -1; return; }
        if (hipFuncSetAttribute((const void*)mk_fwd, hipFuncAttributeMaxDynamicSharedMemorySize, LDS_BYTES) != hipSuccess) { fprintf(stderr, "kernel_launch: hipFuncSetAttribute failed\n"); grid = -1; return; }
        if (hipOccupancyMaxActiveBlocksPerMultiprocessor(&per_cu, (const void*)mk_fwd, NTHREADS, LDS_BYTES) != hipSuccess || per_cu < 1) fprintf(stderr, "kernel_launch: occupancy query says %d\n", per_cu);
        (void)hipGetLastError();
        grid = cus;
        if (grid != 256) fprintf(stderr, "kernel_launch: built for the 256-CU MI355X; device reports %d CUs\n", cus);
    }
    if (grid < 0) return;
    if (hipMemsetAsync((char*)d_ws + WS_CTL, 0, CTL_ZERO_BYTES, stream) != hipSuccess) return;
    Args a{};
    for (int i = 0; i < 28; ++i) a.in[i] = (const float*)d_in[i];
    a.out = (float*)d_out; a.ws = (unsigned char*)d_ws;
    hipLaunchKernelGGL(mk_fwd, dim3(grid), dim3(NTHREADS), LDS_BYTES, stream, a);
}
```

```cpp
#include <hip/hip_runtime.h>
#include <cstdio>
#include <cstdint>

namespace pg8 {
#define PG8_LAS __attribute__((address_space(3)))
typedef unsigned short bf16_t;
typedef short bf16x8 __attribute__((ext_vector_type(8)));
typedef float f32x4 __attribute__((ext_vector_type(4)));
typedef unsigned u32x4 __attribute__((ext_vector_type(4)));
typedef unsigned u32x2 __attribute__((ext_vector_type(2)));
constexpr int BM = 256, BK = 64, HALF = 128, HTB = HALF * BK * 2  , STAGE_BYTES = 8 * HTB, NXCD = 8, WGM = 8;

__host__ __device__ __forceinline__ int lds_byte(int r, int c) { const int st = (r >> 4) * 2 + (c >> 5), rr = r & 15, cc = c & 31, ob = rr * 64 + cc * 2; return st * 1024 + (ob ^ (((ob >> 9) & 1) << 5)); }
__host__ __device__ __forceinline__ void stage_rc(int b, int& R, int& C) { const int st = b / 1024, sb = b % 1024, swz = sb ^ (((sb >> 9) & 1) << 5); R = (st >> 1) * 16 + swz / 64; C = (st & 1) * 32 + (swz % 64) / 2; }
__host__ __device__ __forceinline__ int perm32(int rho) { const int n = rho >> 4, i = rho & 15; return 8 * (i >> 2) + 4 * n + (i & 3); }

struct Unit { int pm, pn, zb; };
struct Gemm { const bf16_t* A; const bf16_t* Bt; int lda, ldb, K; size_t zA, zB; };

struct StaticOrder {
    int nM, nN, nZ, nwg, G, c;
    __host__ __device__ void init(int M, int N, int Z, int G_, int c_) { nM = M / BM; nN = N / BM; nZ = Z; nwg = nM * nN * nZ; G = G_; c = c_; }
    __host__ __device__ bool next(int i, Unit& u) const {
        const long L = (long)i * G + c; if (L >= nwg) return false;
        int wgid = (int)L; { const int q = nwg / NXCD, r = nwg % NXCD, xcd = wgid % NXCD, off = wgid / NXCD; wgid = (xcd < r ? xcd * (q + 1) : r * (q + 1) + (xcd - r) * q) + off; }
        const int per = nM * nN; u.zb = wgid / per; wgid -= u.zb * per;
        const int nig = WGM * nN, gid = wgid / nig, fm = gid * WGM, gsz = (nM - fm) < WGM ? (nM - fm) : WGM;
        u.pm = fm + ((wgid % nig) % gsz); u.pn = (wgid % nig) / gsz; return true;
    }
    __device__ __forceinline__ void a_ready(const Unit&) const {}
    __device__ __forceinline__ void done(const Unit&) const {}
};

__device__ __forceinline__ unsigned cvt_pk_bf16(float lo, float hi) { unsigned r; asm volatile("v_cvt_pk_bf16_f32 %0, %1, %2" : "=v"(r) : "v"(lo), "v"(hi)); return r; }
__device__ __forceinline__ float bf_lo(unsigned w) { return __uint_as_float(w << 16); }
__device__ __forceinline__ float bf_hi(unsigned w) { return __uint_as_float(w & 0xffff0000u); }
__device__ __forceinline__ float fast_sigmoid(float z) { return __builtin_amdgcn_rcpf(1.0f + __builtin_amdgcn_exp2f(-1.4426950408889634f * z)); }
constexpr float RMS_EPS = 1e-6f;
__device__ __forceinline__ float rstd16(const float* ssp, int row) { const f32x4* p = (const f32x4*)(ssp + (size_t)row * 16); const f32x4 a = p[0], b = p[1], c = p[2], d = p[3];
    const float s = (((a[0] + a[1]) + (a[2] + a[3])) + ((b[0] + b[1]) + (b[2] + b[3]))) + (((c[0] + c[1]) + (c[2] + c[3])) + ((d[0] + d[1]) + (d[2] + d[3])));
    return __builtin_amdgcn_rsqf(s * (1.0f / 1024.0f) + RMS_EPS); }

__device__ __forceinline__ u32x4 pack8(const f32x4 v0, const f32x4 v1) { u32x4 w; w.x = cvt_pk_bf16(v0[0], v0[1]); w.y = cvt_pk_bf16(v0[2], v0[3]); w.z = cvt_pk_bf16(v1[0], v1[1]); w.w = cvt_pk_bf16(v1[2], v1[3]); return w; }

struct EpiInProj0 {
    static constexpr bool PERM = true, AFTER_DRAIN = false;
    const float* ss; bf16_t* uext; bf16_t* qkv; float qscale;
    __device__ __forceinline__ void operator()(const f32x4 (&acc)[2][2][4][2], const Unit& u, int wr, int wc, int fr, int fq) const {
        const int row0 = u.pm * BM + wr * 64 + fr;
#pragma unroll
        for (int ai = 0; ai < 2; ++ai)
#pragma unroll
            for (int m = 0; m < 4; ++m) { const int row = row0 + ai * HALF + m * 16; const float rs = rstd16(ss, row);
#pragma unroll
                for (int bj = 0; bj < 2; ++bj) { const int col0 = u.pn * BM + bj * HALF + wc * 32 + 8 * fq;
                    float sc = rs; bf16_t* dst;
                    if (u.pn < 2) dst = uext + ((size_t)(col0 >> 4) * 512 + (row >> 5)) * 640 + (row & 31) * 16 + (col0 & 15);
                    else { const int c = col0 - 512; if (c < 512) sc *= qscale; dst = qkv + (size_t)row * 1536 + c; }
                    *(u32x4*)dst = pack8(acc[ai][bj][m][0] * sc, acc[ai][bj][m][1] * sc); } }
    }
};
struct EpiS5State {
    static constexpr bool PERM = false, AFTER_DRAIN = false;
    float* sloc;
    __device__ __forceinline__ void operator()(const f32x4 (&acc)[2][2][4][2], const Unit& u, int wr, int wc, int fr, int fq) const {
        const int row0 = u.pm * BM + wr * 64 + fr, col0 = wc * 32 + 4 * fq;
#pragma unroll
        for (int ai = 0; ai < 2; ++ai)
#pragma unroll
            for (int m = 0; m < 4; ++m) { float* rowp = sloc + ((size_t)u.zb * 512 + row0 + ai * HALF + m * 16) * 128 + col0;
#pragma unroll
                for (int n = 0; n < 2; ++n) *(f32x4*)(rowp + n * 16) = acc[ai][0][m][n]; }
    }
};
__device__ __forceinline__ float gelu_tanh(float x) { const float a = x * (1.0f + 0.044715f * x * x); return x * __builtin_amdgcn_rcpf(1.0f + __builtin_amdgcn_exp2f(-2.302208198f * a)); }
struct EpiS5Y {
    static constexpr bool PERM = true, AFTER_DRAIN = false;
    bf16_t* yg;
    __device__ __forceinline__ void operator()(const f32x4 (&acc)[2][2][4][2], const Unit& u, int wr, int wc, int fr, int fq) const {
        const int row0 = u.pm * BM + wr * 64 + fr;
#pragma unroll
        for (int ai = 0; ai < 2; ++ai)
#pragma unroll
            for (int m = 0; m < 4; ++m) { const int chunk = row0 + ai * HALF + m * 16;
#pragma unroll
                for (int bj = 0; bj < 2; ++bj) { const int col0 = u.pn * BM + bj * HALF + wc * 32 + 8 * fq; const int i = col0 >> 4, h0 = col0 & 15;
                    f32x4 v0 = acc[ai][bj][m][0], v1 = acc[ai][bj][m][1];
#pragma unroll
                    for (int e = 0; e < 4; ++e) { v0[e] = gelu_tanh(v0[e]); v1[e] = gelu_tanh(v1[e]); }
                    *(u32x4*)(yg + ((size_t)chunk * 32 + i) * 512 + u.zb * 16 + h0) = pack8(v0, v1); } }
    }
};
struct EpiGlu {
    static constexpr bool PERM = true, AFTER_DRAIN = false;
    const bf16_t* yg; const float* bias; bf16_t* mix;
    __device__ __forceinline__ void operator()(const f32x4 (&acc)[2][2][4][2], const Unit& u, int wr, int wc, int fr, int fq) const {
        const int row0 = u.pm * BM + wr * 64 + fr;
#pragma unroll
        for (int bj = 0; bj < 2; ++bj) { const int col0 = u.pn * BM + bj * HALF + wc * 32 + 8 * fq;
            const f32x4 b0 = *(const f32x4*)(bias + col0), b1 = *(const f32x4*)(bias + col0 + 4);
#pragma unroll
            for (int ai = 0; ai < 2; ++ai)
#pragma unroll
                for (int m = 0; m < 4; ++m) { const int row = row0 + ai * HALF + m * 16;
                    const u32x4 yw = *(const u32x4*)(yg + (size_t)row * 512 + col0);
                    f32x4 z0 = acc[ai][bj][m][0] + b0, z1 = acc[ai][bj][m][1] + b1, o0, o1;
                    o0[0] = bf_lo(yw.x) * fast_sigmoid(z0[0]); o0[1] = bf_hi(yw.x) * fast_sigmoid(z0[1]); o0[2] = bf_lo(yw.y) * fast_sigmoid(z0[2]); o0[3] = bf_hi(yw.y) * fast_sigmoid(z0[3]);
                    o1[0] = bf_lo(yw.z) * fast_sigmoid(z1[0]); o1[1] = bf_hi(yw.z) * fast_sigmoid(z1[1]); o1[2] = bf_lo(yw.w) * fast_sigmoid(z1[2]); o1[3] = bf_hi(yw.w) * fast_sigmoid(z1[3]);
                    *(u32x4*)(mix + (size_t)row * 1024 + col0) = pack8(o0, o1); } }
    }
};
struct EpiResid {
    static constexpr bool PERM = false, AFTER_DRAIN = false;
    const float* R; float* X; bf16_t* xb; float* ssq;
    __device__ __forceinline__ void operator()(const f32x4 (&acc)[2][2][4][2], const Unit& u, int wr, int wc, int fr, int fq) const {
        const int row0 = u.pm * BM + wr * 64 + fr, col0 = u.pn * BM + wc * 32 + 4 * fq;
#pragma unroll
        for (int ai = 0; ai < 2; ++ai)
#pragma unroll
            for (int m = 0; m < 4; ++m) { const int row = row0 + ai * HALF + m * 16; const size_t off = (size_t)row * 1024 + col0; float s = 0.f;
#pragma unroll
                for (int bj = 0; bj < 2; ++bj)
#pragma unroll
                    for (int n = 0; n < 2; ++n) { const f32x4 x = *(const f32x4*)(R + off + bj * HALF + n * 16) + acc[ai][bj][m][n];
                        *(f32x4*)(X + off + bj * HALF + n * 16) = x; s += (x[0] * x[0] + x[1] * x[1]) + (x[2] * x[2] + x[3] * x[3]);
                        u32x2 w; w.x = cvt_pk_bf16(x[0], x[1]); w.y = cvt_pk_bf16(x[2], x[3]); *(u32x2*)(xb + off + bj * HALF + n * 16) = w; }
                s += __shfl_xor(s, 16); s += __shfl_xor(s, 32);
                if (fq == 0) ssq[(size_t)row * 16 + u.pn * 4 + wc] = s; }
    }
};
template <bool RS_IS_SSQ> struct EpiSwiGlu {
    static constexpr bool PERM = true, AFTER_DRAIN = false;
    const float* rsv; bf16_t* H; int ldh;
    __device__ __forceinline__ void operator()(const f32x4 (&acc)[2][2][4][2], const Unit& u, int wr, int wc, int fr, int fq) const {
        const int row0 = u.pm * BM + wr * 64 + fr, col0 = u.pn * HALF + wc * 32 + 8 * fq;
#pragma unroll
        for (int ai = 0; ai < 2; ++ai)
#pragma unroll
            for (int m = 0; m < 4; ++m) { const int row = row0 + ai * HALF + m * 16; const float rs = RS_IS_SSQ ? rstd16(rsv, row) : rsv[row];
                f32x4 o[2];
#pragma unroll
                for (int n = 0; n < 2; ++n)
#pragma unroll
                    for (int e = 0; e < 4; ++e) { const float g = acc[ai][0][m][n][e] * rs, up = acc[ai][1][m][n][e] * rs; o[n][e] = g * fast_sigmoid(g) * up; }
                *(u32x4*)(H + (size_t)row * ldh + col0) = pack8(o[0], o[1]); }
    }
};
struct EpiInProj1 {
    static constexpr bool PERM = true, AFTER_DRAIN = false;
    const float* ss; bf16_t* qkv; float qscale;
    __device__ __forceinline__ void operator()(const f32x4 (&acc)[2][2][4][2], const Unit& u, int wr, int wc, int fr, int fq) const {
        const int row0 = u.pm * BM + wr * 64 + fr; const float qs = (u.pn < 4) ? qscale : 1.0f;
#pragma unroll
        for (int ai = 0; ai < 2; ++ai)
#pragma unroll
            for (int m = 0; m < 4; ++m) { const int row = row0 + ai * HALF + m * 16; const float sc = rstd16(ss, row) * qs;
#pragma unroll
                for (int bj = 0; bj < 2; ++bj) { const int col0 = (u.pn & 3) * BM + bj * HALF + wc * 32 + 8 * fq;
                    *(u32x4*)(qkv + (size_t)(u.pn >> 2) * (16384 * 1024) + (size_t)row * 1024 + col0) = pack8(acc[ai][bj][m][0] * sc, acc[ai][bj][m][1] * sc); } }
    }
};
struct EpiStoreBf16 {
    static constexpr bool PERM = true, AFTER_DRAIN = false;
    bf16_t* O; int ldc;
    __device__ __forceinline__ void operator()(const f32x4 (&acc)[2][2][4][2], const Unit& u, int wr, int wc, int fr, int fq) const {
        const int row0 = u.pm * BM + wr * 64 + fr;
#pragma unroll
        for (int ai = 0; ai < 2; ++ai)
#pragma unroll
            for (int m = 0; m < 4; ++m) { const int row = row0 + ai * HALF + m * 16;
#pragma unroll
                for (int bj = 0; bj < 2; ++bj) { const int col0 = u.pn * BM + bj * HALF + wc * 32 + 8 * fq;
                    *(u32x4*)(O + (size_t)row * ldc + col0) = pack8(acc[ai][bj][m][0], acc[ai][bj][m][1]); } }
    }
};

template <class Epi, class Sched, bool ALIGN_EPI = false, bool SP2 = false>
__device__ __forceinline__ void gemm_phase(PG8_LAS unsigned char* lds, const Gemm g, const Sched& S, const Epi& E) {
    int tid_ = threadIdx.x; asm volatile("" : "+v"(tid_));
    const int tid = tid_, wid = __builtin_amdgcn_readfirstlane(tid >> 6), lane = tid & 63, wr = wid >> 2, wc = wid & 3, fr = lane & 15, fq = lane >> 4;
    const int K = g.K, nt = K / BK;
    unsigned voffA[2], voffB[2];
#pragma unroll
    for (int i = 0; i < 2; ++i) { int R, C; stage_rc(tid * 16 + i * 8192, R, C); const int Rb = Epi::PERM ? ((R & ~31) + perm32(R & 31)) : R;
        voffA[i] = (unsigned)(R * g.lda + C) * 2u; voffB[i] = (unsigned)(Rb * g.ldb + C) * 2u; }
    const size_t kstep = (size_t)(BK * 2);
    const size_t hstepA = (size_t)HALF * g.lda * 2, hstepB = (size_t)HALF * g.ldb * 2;
    const size_t tstepA = 2 * hstepA, tstepB = 2 * hstepB;
    const unsigned ldsw = (unsigned)wid * 1024u;
    const int aoff = lds_byte(wr * 64 + fr, fq * 8), boff = lds_byte(wc * 32 + fr, fq * 8);
#define PG8_SA(b, h) (((b) * 2 + (h)) * HTB)
#define PG8_SB(b, h) ((4 + (b) * 2 + (h)) * HTB)
#define PG8_STAGE(bufoff, gbase, voff) do { _Pragma("unroll") for (int _i = 0; _i < 2; ++_i) \
        __builtin_amdgcn_global_load_lds((const unsigned*)((const char*)(gbase) + (voff)[_i]), (PG8_LAS unsigned*)(lds + (bufoff) + ldsw + _i * 8192), 16, 0, 0); } while (0)
#define PG8_LDA(dst, b, h) do { _Pragma("unroll") for (int m = 0; m < 4; ++m) _Pragma("unroll") for (int k = 0; k < 2; ++k) dst[m][k] = *(const PG8_LAS bf16x8*)(lds + PG8_SA(b, h) + aoff + m * 2048 + k * 1024); } while (0)
#define PG8_LDB(dst, b, h) do { _Pragma("unroll") for (int n = 0; n < 2; ++n) _Pragma("unroll") for (int k = 0; k < 2; ++k) dst[n][k] = *(const PG8_LAS bf16x8*)(lds + PG8_SB(b, h) + boff + n * 2048 + k * 1024); } while (0)
#define PG8_MMA(ai, bj, At, Bt) do { __builtin_amdgcn_s_setprio(1); _Pragma("unroll") for (int m = 0; m < 4; ++m) _Pragma("unroll") for (int n = 0; n < 2; ++n) _Pragma("unroll") for (int k = 0; k < 2; ++k) \
        acc[ai][bj][m][n] = __builtin_amdgcn_mfma_f32_16x16x32_bf16(Bt[n][k], At[m][k], acc[ai][bj][m][n], 0, 0, 0); __builtin_amdgcn_s_setprio(0); } while (0)
#define PG8_WAIT_V(n) asm volatile("s_waitcnt vmcnt(" #n ")" ::: "memory")
#define PG8_WAIT_L(n) asm volatile("s_waitcnt lgkmcnt(" #n ")" ::: "memory")
#define PG8_BAR __builtin_amdgcn_s_barrier()
#define PG8_SCHED __builtin_amdgcn_sched_barrier(0)
    Unit cur, nxt; int ui = 0;
    if (!S.next(0, cur)) return;
    f32x4 acc[2][2][4][2];
#pragma unroll
    for (int a = 0; a < 2; ++a)
#pragma unroll
        for (int b = 0; b < 2; ++b)
#pragma unroll
            for (int m = 0; m < 4; ++m)
#pragma unroll
                for (int n = 0; n < 2; ++n) acc[a][b][m][n] = (f32x4){0.f, 0.f, 0.f, 0.f};
    bf16x8 At[4][2], B0[2][2], B1[2][2];
    const char* cA = (const char*)g.A + (size_t)cur.zb * g.zA + (size_t)cur.pm * tstepA; const char* cB = (const char*)g.Bt + (size_t)cur.zb * g.zB + (size_t)cur.pn * tstepB;
    S.a_ready(cur);
    if constexpr (SP2) {
        PG8_STAGE(PG8_SB(0, 0), cB, voffB); PG8_STAGE(PG8_SB(0, 1), cB + hstepB, voffB); PG8_STAGE(PG8_SA(0, 0), cA, voffA); PG8_STAGE(PG8_SA(0, 1), cA + hstepA, voffA);
        if (wr == 1) PG8_BAR;
        PG8_WAIT_V(2); PG8_BAR;
        PG8_STAGE(PG8_SB(1, 0), cB + kstep, voffB); PG8_STAGE(PG8_SA(1, 0), cA + kstep, voffA); PG8_STAGE(PG8_SB(1, 1), cB + hstepB + kstep, voffB);
        PG8_WAIT_V(6); PG8_BAR;
    } else {
        PG8_STAGE(PG8_SB(0, 0), cB, voffB); PG8_STAGE(PG8_SA(0, 0), cA, voffA); PG8_STAGE(PG8_SB(0, 1), cB + hstepB, voffB); PG8_STAGE(PG8_SA(0, 1), cA + hstepA, voffA);
        if (wr == 1) PG8_BAR;
        PG8_WAIT_V(4); PG8_BAR;
        PG8_STAGE(PG8_SB(1, 0), cB + kstep, voffB); PG8_STAGE(PG8_SA(1, 0), cA + kstep, voffA); PG8_STAGE(PG8_SB(1, 1), cB + hstepB + kstep, voffB);
        PG8_WAIT_V(6); PG8_BAR;
    }
    for (;;) {
        const bool has_next = S.next(ui + 1, nxt);
        const char* nA = has_next ? (const char*)g.A + (size_t)nxt.zb * g.zA + (size_t)nxt.pm * tstepA : cA; const char* nB = has_next ? (const char*)g.Bt + (size_t)nxt.zb * g.zB + (size_t)nxt.pn * tstepB : cB;
        for (int t = 0; t < nt; t += 2) {
            const bool last = (t == nt - 2);
            const char* a1 = cA + (size_t)(t + 1) * kstep;
            const char* a2 = last ? nA : cA + (size_t)(t + 2) * kstep; const char* b2 = last ? nB : cB + (size_t)(t + 2) * kstep;
            const char* a3 = a2 + kstep; const char* b3 = b2 + kstep;
            if (last && has_next) S.a_ready(nxt);
            if constexpr (SP2) {
            PG8_LDB(B0, 0, 0); PG8_LDB(B1, 0, 1); PG8_SCHED; PG8_LDA(At, 0, 0); PG8_STAGE(PG8_SA(1, 1), a1 + hstepA, voffA);
            PG8_WAIT_V(8); PG8_WAIT_L(0); PG8_BAR; PG8_MMA(0, 0, At, B0); PG8_MMA(0, 1, At, B1); PG8_BAR; PG8_SCHED;
            PG8_LDA(At, 0, 1); PG8_STAGE(PG8_SB(0, 0), b2, voffB); PG8_STAGE(PG8_SB(0, 1), b2 + hstepB, voffB); PG8_STAGE(PG8_SA(0, 0), a2, voffA);
            PG8_WAIT_V(8); PG8_WAIT_L(0); PG8_BAR; PG8_MMA(1, 0, At, B0); PG8_MMA(1, 1, At, B1); PG8_BAR; PG8_SCHED;
            PG8_LDB(B0, 1, 0); PG8_LDB(B1, 1, 1); PG8_SCHED; PG8_LDA(At, 1, 0); PG8_STAGE(PG8_SA(0, 1), a2 + hstepA, voffA);
            PG8_WAIT_V(8); PG8_WAIT_L(0); PG8_BAR; PG8_MMA(0, 0, At, B0); PG8_MMA(0, 1, At, B1); PG8_BAR; PG8_SCHED;
            PG8_LDA(At, 1, 1); PG8_STAGE(PG8_SB(1, 0), b3, voffB); PG8_STAGE(PG8_SB(1, 1), b3 + hstepB, voffB); PG8_STAGE(PG8_SA(1, 0), a3, voffA);
            PG8_WAIT_V(8); PG8_WAIT_L(0); PG8_BAR; PG8_MMA(1, 0, At, B0); PG8_MMA(1, 1, At, B1); PG8_BAR; PG8_SCHED;
            } else {
            PG8_LDB(B0, 0, 0); PG8_SCHED; PG8_LDA(At, 0, 0); PG8_STAGE(PG8_SA(1, 1), a1 + hstepA, voffA);
            PG8_WAIT_L(8); PG8_BAR; PG8_WAIT_L(0); PG8_MMA(0, 0, At, B0); PG8_BAR; PG8_SCHED;
            PG8_LDB(B1, 0, 1); PG8_STAGE(PG8_SB(0, 0), b2, voffB);
            PG8_BAR; PG8_WAIT_L(0); PG8_MMA(0, 1, At, B1); PG8_BAR;
            PG8_LDA(At, 0, 1); PG8_STAGE(PG8_SA(0, 0), a2, voffA);
            PG8_BAR; PG8_WAIT_L(0); PG8_MMA(1, 0, At, B0); PG8_BAR; PG8_SCHED;
            PG8_STAGE(PG8_SB(0, 1), b2 + hstepB, voffB);
            PG8_WAIT_V(6); PG8_BAR; PG8_MMA(1, 1, At, B1); PG8_BAR;
            PG8_LDB(B0, 1, 0); PG8_SCHED; PG8_LDA(At, 1, 0); PG8_STAGE(PG8_SA(0, 1), a2 + hstepA, voffA);
            PG8_WAIT_L(8); PG8_BAR; PG8_WAIT_L(0); PG8_MMA(0, 0, At, B0); PG8_BAR; PG8_SCHED;
            PG8_LDB(B1, 1, 1); PG8_STAGE(PG8_SB(1, 0), b3, voffB);
            PG8_BAR; PG8_WAIT_L(0); PG8_MMA(0, 1, At, B1); PG8_BAR;
            PG8_LDA(At, 1, 1); PG8_STAGE(PG8_SA(1, 0), a3, voffA);
            PG8_BAR; PG8_WAIT_L(0); PG8_MMA(1, 0, At, B0); PG8_BAR; PG8_SCHED;
            PG8_STAGE(PG8_SB(1, 1), b3 + hstepB, voffB);
            PG8_WAIT_V(6); PG8_BAR; PG8_MMA(1, 1, At, B1); PG8_BAR;
            }
        }
        if constexpr (ALIGN_EPI) { if (wr == 0) PG8_BAR; }
        if constexpr (!Epi::AFTER_DRAIN) { E(acc, cur, wr, wc, fr, fq); S.done(cur); }
        if (!has_next) break;
#pragma unroll
        for (int a = 0; a < 2; ++a)
#pragma unroll
            for (int b = 0; b < 2; ++b)
#pragma unroll
                for (int m = 0; m < 4; ++m)
#pragma unroll
                    for (int n = 0; n < 2; ++n) acc[a][b][m][n] = (f32x4){0.f, 0.f, 0.f, 0.f};
        cur = nxt; cA = nA; cB = nB; ++ui;
        if constexpr (ALIGN_EPI) { if (wr == 1) PG8_BAR; }
    }
    PG8_WAIT_V(0);
    if constexpr (!ALIGN_EPI) { if (wr == 0) PG8_BAR; }
    PG8_BAR;
    if constexpr (Epi::AFTER_DRAIN) { E.fused(acc, cur, wr, wc, fr, fq, lds, wid, lane); S.done(cur); }
#undef PG8_SA
#undef PG8_SB
#undef PG8_STAGE
#undef PG8_LDA
#undef PG8_LDB
#undef PG8_MMA
#undef PG8_WAIT_V
#undef PG8_WAIT_L
#undef PG8_BAR
#undef PG8_SCHED
}
}

#include <hip/hip_bf16.h>
#include <cmath>
namespace attn_body {
using bf16=__hip_bfloat16;
using bf16x8=__attribute__((ext_vector_type(8)))short;
using s16x4=__attribute__((ext_vector_type(4)))short;
using f32x16=__attribute__((ext_vector_type(16)))float;
using u32x4=__attribute__((ext_vector_type(4)))unsigned;
constexpr int BATCH=2,NHEAD=16,SEQ=8192,D=64,DM=NHEAD*D;
constexpr int NW=8,QBLK=32,QB=QBLK*NW,KVBLK=64,NQB=SEQ/QB;
constexpr int ATTN_PITCH=DM, ATTN_UNIT_ROWS=QB;
__device__ __forceinline__ int crow(int r,int hi){return (r&3)+8*(r>>2)+4*hi;}
#define SBAR() __builtin_amdgcn_sched_barrier(0)
__device__ __forceinline__ void cmask(f32x16&p0,f32x16&p1,int jb,int qrel,int hi){
  const float NEG=-INFINITY; int kb=64*jb+4*hi;
  #pragma unroll
  for(int r=0;r<16;++r){int kv=kb+(r&3)+8*(r>>2); if(kv>qrel)p0[r]=NEG; if(kv+32>qrel)p1[r]=NEG;}
}

constexpr int NSLOT=3, SLOTB=8192;
constexpr int LDS_K=0, LDS_V=NSLOT*SLOTB, LDS_WS=2*NSLOT*SLOTB, LDS_OST=LDS_WS+NW*64*4, LDS_NB=LDS_OST+NW*4096  , LDS_BYTES=LDS_NB+32768+64;
constexpr float C2=0.125f*1.4426950408889634f;
__device__ __forceinline__ void glds16(const void*gsrc,unsigned lds_dst){unsigned keep;
  asm volatile("s_mov_b32 %0, m0\n\ts_mov_b32 m0, %2\n\ts_nop 0\n\tglobal_load_lds_dwordx4 %1, off\n\ts_mov_b32 m0, %0":"=&s"(keep):"v"(gsrc),"s"(lds_dst):"memory");}
__device__ __forceinline__ float max3f(float a,float b,float c){float r;asm("v_max3_f32 %0, %1, %2, %3":"=v"(r):"v"(a),"v"(b),"v"(c));return r;}
__device__ __forceinline__ float max2f(float a,float b){float r;asm("v_max_f32_e32 %0, %1, %2":"=v"(r):"v"(a),"v"(b));return r;}
__device__ __forceinline__ float fadd_s(float a,float b){float r;asm("v_add_f32_e32 %0, %1, %2":"=v"(r):"v"(a),"v"(b));return r;}
__device__ __forceinline__ float fsub_s(float a,float b){float r;asm("v_sub_f32_e32 %0, %1, %2":"=v"(r):"v"(a),"v"(b));return r;}
typedef float f32x2_t __attribute__((ext_vector_type(2))); typedef __bf16 bf16x2_t __attribute__((ext_vector_type(2)));
__device__ __forceinline__ unsigned cvtpk_s(float lo,float hi){f32x2_t v={lo,hi};bf16x2_t b=__builtin_convertvector(v,bf16x2_t);return __builtin_bit_cast(unsigned,b);}
#define WAIT_BAR(N) asm volatile("s_waitcnt vmcnt(" #N ") lgkmcnt(0)\n\ts_barrier":::"memory")

__device__ __forceinline__ void qkt(f32x16&p0,f32x16&p1,const char*Kslot,const bf16x8*qr,const f32x16&negm,int r32,int hi){
  const char*kb=Kslot+hi*1024+r32*16;
  #pragma unroll
  for(int d0=0;d0<4;++d0){
    const bf16x8 b0=*reinterpret_cast<const bf16x8*>(kb+d0*2048);
    const bf16x8 b1=*reinterpret_cast<const bf16x8*>(kb+d0*2048+512);
    if(d0==0){p0=__builtin_amdgcn_mfma_f32_32x32x16_bf16(b0,qr[0],negm,0,0,0);p1=__builtin_amdgcn_mfma_f32_32x32x16_bf16(b1,qr[0],negm,0,0,0);}
    else{p0=__builtin_amdgcn_mfma_f32_32x32x16_bf16(b0,qr[d0],p0,0,0,0);p1=__builtin_amdgcn_mfma_f32_32x32x16_bf16(b1,qr[d0],p1,0,0,0);}}
}
typedef __attribute__((address_space(3))) const char* lds_cptr;
typedef short v4i16_t __attribute__((ext_vector_type(4)));
__device__ __forceinline__ void kload8(bf16x8*kf,lds_cptr kp){
  kf[0]=*(const __attribute__((address_space(3))) bf16x8*)(kp);      kf[1]=*(const __attribute__((address_space(3))) bf16x8*)(kp+512);
  kf[2]=*(const __attribute__((address_space(3))) bf16x8*)(kp+2048); kf[3]=*(const __attribute__((address_space(3))) bf16x8*)(kp+2560);
  kf[4]=*(const __attribute__((address_space(3))) bf16x8*)(kp+4096); kf[5]=*(const __attribute__((address_space(3))) bf16x8*)(kp+4608);
  kf[6]=*(const __attribute__((address_space(3))) bf16x8*)(kp+6144); kf[7]=*(const __attribute__((address_space(3))) bf16x8*)(kp+6656);
}
__device__ __forceinline__ void kload2(bf16x8*kf,lds_cptr kp,int j){ kf[2*j]=*(const __attribute__((address_space(3))) bf16x8*)(kp+j*2048); kf[2*j+1]=*(const __attribute__((address_space(3))) bf16x8*)(kp+j*2048+512); }
__device__ __forceinline__ s16x4 vtr(lds_cptr p){ return __builtin_bit_cast(s16x4,__builtin_amdgcn_ds_read_tr16_b64_v4i16((__attribute__((address_space(3))) v4i16_t*)p)); }
__device__ __forceinline__ float rowmax(const f32x16&p0,const f32x16&p1){
  float a=max3f(p0[0],p0[1],p1[0]),b=max3f(p0[2],p0[3],p1[1]);a=max3f(a,p1[2],p1[3]);
  #pragma unroll
  for(int r=4;r<16;r+=4){a=max3f(a,p0[r],p0[r+1]);b=max3f(b,p0[r+2],p0[r+3]);a=max3f(a,p1[r],p1[r+1]);b=max3f(b,p1[r+2],p1[r+3]);}
  const float m=max2f(a,b);
  auto rr=__builtin_amdgcn_permlane32_swap(__float_as_uint(m),__float_as_uint(m),false,false);
  return max2f(__uint_as_float(rr[0]),__uint_as_float(rr[1]));
}
__device__ __forceinline__ void pv(f32x16*o,int vb,bf16x8 pa0,bf16x8 pa1,bf16x8 pa2,bf16x8 pa3){
  #pragma unroll
  for(int d0=0;d0<2;++d0){s16x4 lo[4],hi[4];
    #pragma unroll
    for(int ks=0;ks<4;++ks){
      asm volatile("ds_read_b64_tr_b16 %0,%1 offset:%c2":"=&v"(lo[ks]):"v"(vb),"i"(d0*4096+ks*1024):"memory");
      asm volatile("ds_read_b64_tr_b16 %0,%1 offset:%c2":"=&v"(hi[ks]):"v"(vb),"i"(d0*4096+ks*1024+512):"memory");}
    asm volatile("s_waitcnt lgkmcnt(0)":::"memory");SBAR();
    #define PK(k) (bf16x8){lo[k][0],lo[k][1],lo[k][2],lo[k][3],hi[k][0],hi[k][1],hi[k][2],hi[k][3]}
    o[d0]=__builtin_amdgcn_mfma_f32_32x32x16_bf16(pa0,PK(0),o[d0],0,0,0);
    o[d0]=__builtin_amdgcn_mfma_f32_32x32x16_bf16(pa1,PK(1),o[d0],0,0,0);
    o[d0]=__builtin_amdgcn_mfma_f32_32x32x16_bf16(pa2,PK(2),o[d0],0,0,0);
    o[d0]=__builtin_amdgcn_mfma_f32_32x32x16_bf16(pa3,PK(3),o[d0],0,0,0);
    #undef PK
  }
}

typedef float f32x4_t __attribute__((ext_vector_type(4)));
__device__ __forceinline__ void fox_negcum(const float*logf,__attribute__((address_space(3))) float*ncum,__attribute__((address_space(3))) float*wtot,int tid){
  float loc[16];float s=0.f; const f32x4_t*lp=(const f32x4_t*)(logf+tid*16);
  #pragma unroll
  for(int j=0;j<4;++j){const f32x4_t v=lp[j]; s+=v[0];loc[4*j]=s; s+=v[1];loc[4*j+1]=s; s+=v[2];loc[4*j+2]=s; s+=v[3];loc[4*j+3]=s;}
  float inc=s;
  #pragma unroll
  for(int o=1;o<64;o<<=1){const float v=__shfl_up(inc,o); if((tid&63)>=o)inc+=v;}
  if((tid&63)==63)wtot[tid>>6]=inc;
  __syncthreads();
  float base=inc-s; for(int w=0;w<(tid>>6);++w)base+=wtot[w];
  #pragma unroll
  for(int j=0;j<4;++j){ f32x4_t o4; o4[0]=-(base+loc[4*j]);o4[1]=-(base+loc[4*j+1]);o4[2]=-(base+loc[4*j+2]);o4[3]=-(base+loc[4*j+3]); *(__attribute__((address_space(3))) f32x4_t*)(ncum+tid*16+4*j)=o4; }
  __syncthreads();
}
#ifndef ATTN_STORE16
#define ATTN_STORE16(p,v) (*(u32x4*)(p)=(v))
#endif
template<int THRL> __device__ __forceinline__ void attn_unit(int b,int h,int qb,const bf16*Q,const bf16*__restrict__ K,const bf16*__restrict__ V,bf16*O,char*shm,const float*logf_bh){
  int tid_=threadIdx.x; asm volatile("":"+v"(tid_)); const int tid=tid_,lane=tid&63,r32=lane&31,hi=lane>>5; const int wid=__builtin_amdgcn_readfirstlane(tid>>6);
  const long rowbase=(long)b*SEQ; const int q0=qb*QB;
  const bf16*Qw=Q+(rowbase+q0+wid*QBLK)*DM+h*D;
  const bf16*Kh=K+rowbase*DM+h*D,*Vh=V+rowbase*DM+h*D;
  const unsigned lds0=(unsigned)(uintptr_t)shm;
  float*wsf=(float*)(shm+LDS_WS)+wid*64;
  const bf16*ksrc=Kh+(long)lane*DM+wid*8;
  const bf16*vsrc=Vh+(long)(16*(wid&3)+(lane>>2))*DM+(wid>>2)*32+(lane&3)*8;
  const unsigned kdst=lds0+LDS_K+wid*1024, vdst=lds0+LDS_V+wid*1024;
  #define DMA_K(t,slot) glds16(ksrc+(long)(t)*KVBLK*DM,(unsigned)__builtin_amdgcn_readfirstlane(kdst+(slot)))
  #define DMA_V(t,slot) glds16(vsrc+(long)(t)*KVBLK*DM,(unsigned)__builtin_amdgcn_readfirstlane(vdst+(slot)))
  const int vb0=(int)(lds0+LDS_V)+((lane>>4)&1)*32+(lane&3)*8+(4*hi+((lane&15)>>2))*64;
  const char*Kbase=shm+LDS_K; bf16x8 kf[8];
  const lds_cptr shm3=(lds_cptr)shm; const lds_cptr kp0=shm3+LDS_K+hi*1024+r32*16; const lds_cptr vp0=shm3+LDS_V+((lane>>4)&1)*32+(lane&3)*8+(4*hi+((lane&15)>>2))*64;
  const int NT=(q0+QB)/KVBLK;
  const lds_cptr shm3b=(lds_cptr)shm;
  const __attribute__((address_space(3))) float* nb3=(const __attribute__((address_space(3))) float*)(shm3b+LDS_NB);
  fox_negcum(logf_bh,(__attribute__((address_space(3))) float*)(shm3b+LDS_NB),(__attribute__((address_space(3))) float*)(shm3b+LDS_NB+32768),tid);
  #define BIASADD(P0,P1,t) do{ const __attribute__((address_space(3))) f32x4_t* bp_=(const __attribute__((address_space(3))) f32x4_t*)(nb3+(t)*64+4*hi); \
    const f32x4_t nm4_={-mhat,-mhat,-mhat,-mhat}; \
    _Pragma("unroll") for(int g_=0;g_<4;++g_){ const f32x4_t b0_=bp_[2*g_]+nm4_,b1_=bp_[2*g_+8]+nm4_; \
      P0[4*g_]+=b0_[0];P0[4*g_+1]+=b0_[1];P0[4*g_+2]+=b0_[2];P0[4*g_+3]+=b0_[3]; P1[4*g_]+=b1_[0];P1[4*g_+1]+=b1_[1];P1[4*g_+2]+=b1_[2];P1[4*g_+3]+=b1_[3]; } }while(0)
  DMA_K(0,0);DMA_V(0,0);DMA_K(1,SLOTB);
  bf16x8 qr[4];
  #pragma unroll
  for(int d0=0;d0<4;++d0)qr[d0]=*reinterpret_cast<const bf16x8*>(&Qw[(long)r32*DM+d0*16+hi*8]);
  float mhat=0.f,l_reg=0.f;f32x16 o[2];o[0]=f32x16{};o[1]=f32x16{};const f32x16 negm=f32x16{};
  const int qrel=wid*QBLK+r32;
  #define CMASK(P0,P1,t) do{int jb_=(t)-(NT-4); if(jb_>=0)cmask(P0,P1,jb_,qrel,hi);}while(0)
  bool resc=false;
  #define START(P0,P1) do{ const float rm=rowmax(P0,P1); resc=false; \
    { const float dl=rm; mhat=fadd_s(mhat,dl); \
      _Pragma("unroll") for(int r=0;r<16;++r){P0[r]=fsub_s(P0[r],dl);P1[r]=fsub_s(P1[r],dl);} \
      } \
    _Pragma("unroll") for(int r=0;r<16;++r)P0[r]=__builtin_amdgcn_exp2f(P0[r]); }while(0)
  #define RESC() do{ if(resc){ asm volatile("s_waitcnt lgkmcnt(0)":::"memory"); \
      _Pragma("unroll") for(int d_=0;d_<2;++d_) _Pragma("unroll") for(int r=0;r<16;++r)o[d_][r]*=wsf[crow(r,hi)]; } }while(0)
  f32x16 pA0,pA1,pB0,pB1;
  int sl_prev=0,sl_cur=0,sl_next=SLOTB;
  #define ROT() do{sl_prev=sl_cur;sl_cur=sl_next;sl_next=(sl_next==(NSLOT-1)*SLOTB)?0:sl_next+SLOTB;}while(0)
  DMA_K(2,2*SLOTB);
  WAIT_BAR(3);
  qkt(pA0,pA1,Kbase,qr,negm,r32,hi);asm volatile("s_nop 15\n\ts_nop 7":"+v"(pA0),"+v"(pA1));BIASADD(pA0,pA1,0);CMASK(pA0,pA1,0);
  START(pA0,pA1);
  _Pragma("unroll") for(int r=0;r<16;++r)pA1[r]=__builtin_amdgcn_exp2f(pA1[r]);
  WAIT_BAR(0);
  DMA_K(3,0);DMA_V(1,SLOTB);
  ROT();
  kload8(kf,kp0+sl_cur);
  WAIT_BAR(2);
  s16x4 vlo[8],vhi[8]; u32x4 pw0,pw1,pw2,pw3;
  #define PKW(P,B) cvtpk_s(P[B],P[B+1])
  #define PAF(k) __builtin_bit_cast(bf16x8,pw##k)
  #define VFR(i) (bf16x8){vlo[i][0],vlo[i][1],vlo[i][2],vlo[i][3],vhi[i][0],vhi[i][1],vhi[i][2],vhi[i][3]}
  #define PIN(x) asm volatile("":"+v"(x))
  #define MX3(a,b,c) __builtin_fmaxf(__builtin_fmaxf((a),(b)),(c))
  #define GAPA(MF,A0,A1,A2,A3,W0,W1,PW) do{ MF; sacc+=A0; sacc+=A1; sacc+=A2; sacc+=A3; PIN(sacc); W0; W1; PIN(PW); SBAR(); }while(0)
  #define EX(v) __builtin_amdgcn_exp2f(v)
  #define GAPB(MF,X,B) do{ MF; X[B]=EX(X[B]); X[B+1]=EX(X[B+1]); X[B+2]=EX(X[B+2]); X[B+3]=EX(X[B+3]); PIN(X); SBAR(); }while(0)
  #define VRD(i) do{ vlo[i]=vtr(vp_+(((i)>>2)*4096+((i)&3)*1024)); vhi[i]=vtr(vp_+(((i)>>2)*4096+((i)&3)*1024+512)); }while(0)
  #define KRD(G,j) do{ if(G){ kload2(kf,kp0+sl_next,j); SBAR(); } }while(0)
  #define STEP(C0,C1,P0,P1,t,GK,GV,GL) do{ SBAR(); \
    const lds_cptr vp_=vp0+sl_prev; \
    VRD(0); SBAR(); float sacc=(P0[0]+P0[1]); \
    GAPA(C0=__builtin_amdgcn_mfma_f32_32x32x16_bf16(kf[0],qr[0],negm,0,0,0), P0[2],P0[3],P0[4],P0[5],     pw0[0]=PKW(P0,0), pw0[1]=PKW(P0,2), pw0); \
    VRD(4); SBAR(); GAPA(C1=__builtin_amdgcn_mfma_f32_32x32x16_bf16(kf[1],qr[0],negm,0,0,0), P0[6],P0[7],P0[8],P0[9],     pw0[2]=PKW(P0,4), pw0[3]=PKW(P0,6), pw0); \
    VRD(1); SBAR(); GAPA(C0=__builtin_amdgcn_mfma_f32_32x32x16_bf16(kf[2],qr[1],C0,0,0,0),   P0[10],P0[11],P0[12],P0[13], pw1[0]=PKW(P0,8), pw1[1]=PKW(P0,10), pw1); \
    VRD(5); SBAR(); GAPA(C1=__builtin_amdgcn_mfma_f32_32x32x16_bf16(kf[3],qr[1],C1,0,0,0),   P0[14],P0[15],P1[0],P1[1],   pw1[2]=PKW(P0,12),pw1[3]=PKW(P0,14), pw1); \
    VRD(2); SBAR(); GAPA(C0=__builtin_amdgcn_mfma_f32_32x32x16_bf16(kf[4],qr[2],C0,0,0,0),   P1[2],P1[3],P1[4],P1[5],     pw2[0]=PKW(P1,0), pw2[1]=PKW(P1,2), pw2); \
    VRD(6); SBAR(); GAPA(C1=__builtin_amdgcn_mfma_f32_32x32x16_bf16(kf[5],qr[2],C1,0,0,0),   P1[6],P1[7],P1[8],P1[9],     pw2[2]=PKW(P1,4), pw2[3]=PKW(P1,6), pw2); \
    VRD(3); SBAR(); GAPA(C0=__builtin_amdgcn_mfma_f32_32x32x16_bf16(kf[6],qr[3],C0,0,0,0),   P1[10],P1[11],P1[12],P1[13], pw3[0]=PKW(P1,8), pw3[1]=PKW(P1,10), pw3); \
    VRD(7); SBAR(); GAPA(C1=__builtin_amdgcn_mfma_f32_32x32x16_bf16(kf[7],qr[3],C1,0,0,0),   P1[14],P1[15],0.f,0.f,       pw3[2]=PKW(P1,12),pw3[3]=PKW(P1,14), pw3); \
    l_reg+=sacc; \
    if(GK){DMA_K((t)+3,sl_cur);} if(GV){DMA_V((t)+1,sl_next);} \
    BIASADD(C0,C1,t); CMASK(C0,C1,t); \
    { float a=MX3(C0[0],C0[1],C1[0]),b=MX3(C0[2],C0[3],C1[1]); a=MX3(a,C1[2],C1[3]); \
      _Pragma("unroll") for(int r=4;r<16;r+=4){a=MX3(a,C0[r],C0[r+1]);b=MX3(b,C0[r+2],C0[r+3]);a=MX3(a,C1[r],C1[r+1]);b=MX3(b,C1[r+2],C1[r+3]);} \
      float rm=__builtin_fmaxf(a,b); { auto rr=__builtin_amdgcn_permlane32_swap(__float_as_uint(rm),__float_as_uint(rm),false,false); rm=__builtin_fmaxf(__uint_as_float(rr[0]),__uint_as_float(rr[1])); } \
      resc=false; \
      if(__builtin_expect(__any(rm>(float)THRL),0)){ const float dl=__builtin_fmaxf(rm,0.f); mhat+=dl; \
        _Pragma("unroll") for(int r=0;r<16;++r){C0[r]-=dl;C1[r]-=dl;} \
        const float f=__builtin_amdgcn_exp2f(-dl); l_reg*=f; if(hi==0)wsf[r32]=f; resc=true; } } \
    SBAR(); \
    GAPB(o[0]=__builtin_amdgcn_mfma_f32_32x32x16_bf16(PAF(0),VFR(0),o[0],0,0,0), C0,0); \
    GAPB(o[1]=__builtin_amdgcn_mfma_f32_32x32x16_bf16(PAF(0),VFR(4),o[1],0,0,0), C0,4); \
    KRD(GL,0); GAPB(o[0]=__builtin_amdgcn_mfma_f32_32x32x16_bf16(PAF(1),VFR(1),o[0],0,0,0), C0,8); \
    KRD(GL,1); GAPB(o[1]=__builtin_amdgcn_mfma_f32_32x32x16_bf16(PAF(1),VFR(5),o[1],0,0,0), C0,12); \
    KRD(GL,2); GAPB(o[0]=__builtin_amdgcn_mfma_f32_32x32x16_bf16(PAF(2),VFR(2),o[0],0,0,0), C1,0); \
    KRD(GL,3); GAPB(o[1]=__builtin_amdgcn_mfma_f32_32x32x16_bf16(PAF(2),VFR(6),o[1],0,0,0), C1,4); \
    GAPB(o[0]=__builtin_amdgcn_mfma_f32_32x32x16_bf16(PAF(3),VFR(3),o[0],0,0,0), C1,8); \
    GAPB(o[1]=__builtin_amdgcn_mfma_f32_32x32x16_bf16(PAF(3),VFR(7),o[1],0,0,0), C1,12); \
    }while(0)
  int t=1;
  #undef CMASK
  #define CMASK(P0,P1,t) do{}while(0)
  for(;t+5<NT;t+=2){
    STEP(pB0,pB1,pA0,pA1,t,true,true,true);     WAIT_BAR(2); RESC(); ROT();
    STEP(pA0,pA1,pB0,pB1,t+1,true,true,true);   WAIT_BAR(2); RESC(); ROT();
  }
  #undef CMASK
  #define CMASK(P0,P1,t) do{int jb_=(t)-(NT-4); if(jb_>=0)cmask(P0,P1,jb_,qrel,hi);}while(0)
  #define ENDW(tt) do{ if((tt)+3<NT){WAIT_BAR(2);} else if((tt)+2<NT){WAIT_BAR(1);} else {WAIT_BAR(0);} }while(0)
  for(;t+1<NT;t+=2){
    STEP(pB0,pB1,pA0,pA1,t,(t+3<NT),(t+1<NT),(t+1<NT));       ENDW(t);   RESC(); ROT();
    STEP(pA0,pA1,pB0,pB1,t+1,(t+4<NT),(t+2<NT),(t+2<NT));     ENDW(t+1); RESC(); ROT();
  }
  STEP(pB0,pB1,pA0,pA1,NT-1,false,false,false); RESC();
  { float sacc=pB0[0]+pB0[1]; _Pragma("unroll") for(int r=2;r<16;++r)sacc+=pB0[r]; _Pragma("unroll") for(int r=0;r<16;++r)sacc+=pB1[r]; l_reg+=sacc;
    pw0=(u32x4){PKW(pB0,0),PKW(pB0,2),PKW(pB0,4),PKW(pB0,6)};pw1=(u32x4){PKW(pB0,8),PKW(pB0,10),PKW(pB0,12),PKW(pB0,14)};pw2=(u32x4){PKW(pB1,0),PKW(pB1,2),PKW(pB1,4),PKW(pB1,6)};pw3=(u32x4){PKW(pB1,8),PKW(pB1,10),PKW(pB1,12),PKW(pB1,14)};
    SBAR(); pv(o,vb0+sl_cur,PAF(0),PAF(1),PAF(2),PAF(3)); }
  #undef PKW
  #undef PAF
  #undef VFR
  #undef PIN
  #undef MX3
  #undef GAPA
  #undef GAPB
  #undef EX
  #undef VRD
  #undef KRD
  #undef STEP
  #undef ENDW
  {auto rr=__builtin_amdgcn_permlane32_swap(__float_as_uint(l_reg),__float_as_uint(l_reg),false,false);l_reg=__uint_as_float(rr[0])+__uint_as_float(rr[1]);}
  if(hi==0)wsf[32+r32]=l_reg;asm volatile("s_waitcnt lgkmcnt(0)":::"memory");
  float rli[16];
  #pragma unroll
  for(int r=0;r<16;++r)rli[r]=__builtin_amdgcn_rcpf(wsf[32+crow(r,hi)]);
  bf16*Ow=O+(rowbase+q0+wid*QBLK)*DM+h*D;
  { bf16*stg=(bf16*)(shm+LDS_OST)+wid*2048;
    #pragma unroll
    for(int r=0;r<16;++r){const int orow=crow(r,hi);
      #pragma unroll
      for(int d0=0;d0<2;++d0)stg[orow*64+d0*32+r32]=__float2bfloat16(o[d0][r]*rli[r]);}
    asm volatile("s_waitcnt lgkmcnt(0)":::"memory");
    #pragma unroll
    for(int i=0;i<4;++i){const int row=i*8+(lane>>3),ch=lane&7; const u32x4 v=*(const u32x4*)(stg+row*64+ch*8); ATTN_STORE16(Ow+(long)row*DM+ch*8,v);} }
  asm volatile("s_waitcnt lgkmcnt(0)\n\ts_barrier":::"memory");
  #undef BIASADD
  #undef DMA_K
  #undef DMA_V
  #undef CMASK
  #undef START
  #undef RESC
  #undef ROT
}

template<int PITCH> __device__ __forceinline__ void sb_unit(int b,int h,int qb,const bf16*Q,const bf16*__restrict__ K,const bf16*__restrict__ V,bf16*O  ,char*shm){
  int tid_=threadIdx.x; asm volatile("":"+v"(tid_)); const int tid=tid_,lane=tid&63,r32=lane&31,hi=lane>>5; const int wid=__builtin_amdgcn_readfirstlane(tid>>6);
  const long rowbase=(long)b*SEQ; const int q0=qb*QB;
  const bf16*Qw=Q+(rowbase+q0+wid*QBLK)*PITCH+h*D;
  const bf16*Kh=K+rowbase*PITCH+h*D,*Vh=V+rowbase*PITCH+h*D;
  const unsigned lds0=(unsigned)(uintptr_t)shm;
  const bf16*ksrc=Kh+(long)lane*PITCH+wid*8;
  const bf16*vsrc=Vh+(long)(16*(wid&3)+(lane>>2))*PITCH+(wid>>2)*32+(lane&3)*8;
  const unsigned kdst=lds0+LDS_K+wid*1024, vdst=lds0+LDS_V+wid*1024;
  #define SB_DMA(t,slot) do{ glds16(ksrc+(long)(t)*KVBLK*PITCH,(unsigned)__builtin_amdgcn_readfirstlane(kdst+(slot))); glds16(vsrc+(long)(t)*KVBLK*PITCH,(unsigned)__builtin_amdgcn_readfirstlane(vdst+(slot))); }while(0)
  const int vb0=(int)(lds0+LDS_V)+((lane>>4)&1)*32+(lane&3)*8+(4*hi+((lane&15)>>2))*64;
  volatile __attribute__((address_space(3))) unsigned* fl=(volatile __attribute__((address_space(3))) unsigned*)((lds_cptr)shm+LDS_WS);
  const int NT=(q0+QB)/KVBLK; const int qrel=wid*QBLK+r32;
  SB_DMA(NT-1,0);
  bf16x8 qr[4];
  #pragma unroll
  for(int d0=0;d0<4;++d0)qr[d0]=*reinterpret_cast<const bf16x8*>(&Qw[(long)r32*PITCH+d0*16+hi*8]);
  f32x16 o[2];o[0]=f32x16{};o[1]=f32x16{}; const f32x16 zero16=f32x16{};
  float carry=0.f; const float m0=(hi==0)?1.f:0.f;
  int slot=0;
  for(int t=NT-1;t>=0;--t){
    WAIT_BAR(0);
    if(t<NT-1){ const int pb=((t+1)&1)*8; const unsigned a=fl[pb]&fl[pb+1]&fl[pb+2]&fl[pb+3]&fl[pb+4]&fl[pb+5]&fl[pb+6]&fl[pb+7]; if(__builtin_amdgcn_readfirstlane(a)!=0u)break; }
    if(t>0)SB_DMA(t-1,slot^SLOTB);
    f32x16 p0,p1; qkt(p0,p1,shm+LDS_K+slot,qr,zero16,r32,hi);
    if(t>=NT-4){ const int kb=64*(t-(NT-4))+4*hi;
      #pragma unroll
      for(int r=0;r<16;++r){const int kv=kb+(r&3)+8*(r>>2); if(kv>=qrel)p0[r]=-INFINITY; if(kv+32>=qrel)p1[r]=-INFINITY;} }
    f32x16 s0,s1;
    #pragma unroll
    for(int r=0;r<16;++r){ const float z=p0[r]; const float sp=__builtin_fmaxf(z,0.f)+__builtin_amdgcn_logf(1.f+__builtin_amdgcn_exp2f(-__builtin_fabsf(z))); s0[r]=sp; p0[r]=z-sp;
                           const float y=p1[r]; const float sq=__builtin_fmaxf(y,0.f)+__builtin_amdgcn_logf(1.f+__builtin_amdgcn_exp2f(-__builtin_fabsf(y))); s1[r]=sq; p1[r]=y-sq; }
    float lo[8],hv[8];
    #pragma unroll
    for(int i=0;i<8;++i){ const float mine=(i<4)?((s0[4*i]+s0[4*i+1])+(s0[4*i+2]+s0[4*i+3])):((s1[4*i-16]+s1[4*i-15])+(s1[4*i-14]+s1[4*i-13]));
      auto rr=__builtin_amdgcn_permlane32_swap(__float_as_uint(mine),__float_as_uint(mine),false,false); lo[i]=__uint_as_float(rr[0]); hv[i]=__uint_as_float(rr[1]); }
    float sp_=0.f;
    #pragma unroll
    for(int i=7;i>=0;--i){ const float base=carry-(sp_+m0*hv[i]);
      if(i<4){ float a=base; p0[4*i+3]=__builtin_amdgcn_exp2f(p0[4*i+3]+a); a-=s0[4*i+3]; p0[4*i+2]=__builtin_amdgcn_exp2f(p0[4*i+2]+a); a-=s0[4*i+2]; p0[4*i+1]=__builtin_amdgcn_exp2f(p0[4*i+1]+a); a-=s0[4*i+1]; p0[4*i]=__builtin_amdgcn_exp2f(p0[4*i]+a); }
      else   { const int j=4*i-16; float a=base; p1[j+3]=__builtin_amdgcn_exp2f(p1[j+3]+a); a-=s1[j+3]; p1[j+2]=__builtin_amdgcn_exp2f(p1[j+2]+a); a-=s1[j+2]; p1[j+1]=__builtin_amdgcn_exp2f(p1[j+1]+a); a-=s1[j+1]; p1[j]=__builtin_amdgcn_exp2f(p1[j]+a); }
      sp_+=lo[i]+hv[i]; }
    carry-=sp_;
    { u32x4 pw0,pw1,pw2,pw3;
      pw0=(u32x4){cvtpk_s(p0[0],p0[1]),cvtpk_s(p0[2],p0[3]),cvtpk_s(p0[4],p0[5]),cvtpk_s(p0[6],p0[7])}; pw1=(u32x4){cvtpk_s(p0[8],p0[9]),cvtpk_s(p0[10],p0[11]),cvtpk_s(p0[12],p0[13]),cvtpk_s(p0[14],p0[15])};
      pw2=(u32x4){cvtpk_s(p1[0],p1[1]),cvtpk_s(p1[2],p1[3]),cvtpk_s(p1[4],p1[5]),cvtpk_s(p1[6],p1[7])}; pw3=(u32x4){cvtpk_s(p1[8],p1[9]),cvtpk_s(p1[10],p1[11]),cvtpk_s(p1[12],p1[13]),cvtpk_s(p1[14],p1[15])};
      pv(o,vb0+slot,__builtin_bit_cast(bf16x8,pw0),__builtin_bit_cast(bf16x8,pw1),__builtin_bit_cast(bf16x8,pw2),__builtin_bit_cast(bf16x8,pw3)); }
    { const bool done_=__all(carry<-150.f); if(lane==0)fl[(t&1)*8+wid]=done_?1u:0u; }
    slot^=SLOTB;
  }
  asm volatile("s_waitcnt vmcnt(0) lgkmcnt(0)":::"memory");
  bf16*Ow=O+(rowbase+q0+wid*QBLK)*1024+h*D;
  { bf16*stg=(bf16*)(shm+LDS_OST)+wid*2048;
    #pragma unroll
    for(int r=0;r<16;++r){const int orow=crow(r,hi);
      #pragma unroll
      for(int d0=0;d0<2;++d0)stg[orow*64+d0*32+r32]=__float2bfloat16(o[d0][r]);}
    asm volatile("s_waitcnt lgkmcnt(0)":::"memory");
    #pragma unroll
    for(int i=0;i<4;++i){const int row=i*8+(lane>>3),ch=lane&7; const u32x4 v=*(const u32x4*)(stg+row*64+ch*8); ATTN_STORE16(Ow+(long)row*1024+ch*8,v);} }
  asm volatile("s_waitcnt vmcnt(0) lgkmcnt(0)\n\ts_barrier":::"memory");
  #undef SB_DMA
}
constexpr int ATTN_LDS_BYTES=LDS_BYTES;
struct AttnTensors { const bf16* Q; const bf16* K; const bf16* V; bf16* O; const float* logf;   };
struct AttnUnit { int bh; int qb; };
struct StaticOrder {
  int vcu;
  __device__ __forceinline__ explicit StaticOrder(int grid,int block):vcu((block%8)*(grid/8)+block/8){}
  __device__ __forceinline__ bool next(int i,AttnUnit&u)const{ if(i>=4)return false; const int s=vcu&7; u.bh=vcu>>3; u.qb=(i==0)?s:(i==1)?15-s:(i==2)?16+s:31-s; return true; }
  __device__ __forceinline__ void a_ready(const AttnUnit&)const{}
  __device__ __forceinline__ void done(const AttnUnit&)const{}
};
template<class Sched,int THRL=8> __device__ __forceinline__ void attn_phase(char*lds,const AttnTensors&T,const Sched&S){
  AttnUnit u;
  for(int i=0;S.next(i,u);++i){ S.a_ready(u); attn_unit<THRL>(u.bh/NHEAD,u.bh%NHEAD,u.qb,T.Q,T.K,T.V,T.O,lds,T.logf+(size_t)u.bh*SEQ); S.done(u); }
}
#undef SBAR
#undef WAIT_BAR
}
constexpr int NWAVES = 8, NTHREADS = NWAVES * 64;
constexpr int BATCH = 2, SEQ = 8192, D = 1024, M = BATCH * SEQ;
constexpr int S5G = 32, S5H = 16, S5P = 64, S5T = 32  , S5NC = M / S5T  , S5KX = 640  ;
constexpr int SBH = 8, FOXH = 16, HD = 64;
constexpr int EVEN_IN = 2048, ODD_IN = 3088, DFF = 2816, NEXP = 8, DFE = 3584;
constexpr float C2 = 0.125f * 1.4426950408889634f;
constexpr int MOE_CHUNK_PANELS = 68, MOE_MAX_PANELS = 136, MOE_MAX_SLOTS = MOE_MAX_PANELS * 256;

constexpr size_t MiB = 1u << 20;
constexpr size_t WS_CTL = 0, CTL_ZERO_BYTES = 1 * MiB;
constexpr size_t WS_WMOE_GU = 1 * MiB;
constexpr size_t WS_WMOE_D = 113 * MiB;
constexpr size_t WS_WIN0 = 169 * MiB;
constexpr size_t WS_WGLU = 173 * MiB;
constexpr size_t WS_WOUT0 = 174 * MiB;
constexpr size_t WS_WGU0 = 176 * MiB;
constexpr size_t WS_WD0 = 187 * MiB;
constexpr size_t WS_WIN1 = 193 * MiB;
constexpr size_t WS_WF1 = 199 * MiB;
constexpr size_t WS_WOUT1 = 200 * MiB;
constexpr size_t WS_S5WA = 202 * MiB;
constexpr size_t WS_S5WC = 210 * MiB;
constexpr size_t WS_XB = 230 * MiB;
constexpr size_t WS_QKV0 = 262 * MiB;
constexpr size_t WS_UEXT = 310 * MiB;
constexpr size_t WS_SLOC = 330 * MiB;
constexpr size_t WS_YG = 338 * MiB;
constexpr size_t WS_MIXB = 354 * MiB;
constexpr size_t WS_HID0 = 262 * MiB;
constexpr size_t WS_QKV1 = 262 * MiB;
constexpr size_t WS_LOGF = 358 * MiB;
constexpr size_t WS_O1 = 359 * MiB;
constexpr size_t WS_META = 356 * MiB;
constexpr size_t WS_XG = 288 * MiB;
constexpr size_t WS_HMOE = 169 * MiB;
constexpr size_t WS_SSP = 392 * MiB;
constexpr size_t WS_END = 396 * MiB;
static_assert(WS_HMOE + (size_t)MOE_CHUNK_PANELS * 256 * DFE * 2 <= WS_XG && WS_XG + (size_t)MOE_MAX_SLOTS * 1024 * 2 <= WS_META && WS_O1 + (size_t)M * 1024 * 2 <= WS_END, "ws map");
constexpr size_t MT_RSTD = 0, MT_TOKE = 65536, MT_TOKP = 131072, MT_TOKG = 262144, MT_TOKSLOT = 393216, MT_RSS = 524288;
constexpr int CW_TMO = 0, CW_CODE = 1, CW_BAR = 4096, CW_CNT = 8192  , CW_SS = 32768  ;

constexpr int RING_OFF = 0, RING_BYTES = 131072;
constexpr int LDSCTL_OFF = RING_BYTES, MISC_OFF = LDSCTL_OFF + 320;
constexpr int LDS_BYTES = 147456;

#define GAS __attribute__((address_space(1)))
#define LAS __attribute__((address_space(3)))
typedef unsigned short bf16;
typedef unsigned v4u __attribute__((ext_vector_type(4)));
typedef unsigned v2u __attribute__((ext_vector_type(2)));
typedef float f32x4 __attribute__((ext_vector_type(4)));
typedef short bf16x8 __attribute__((ext_vector_type(8)));
typedef GAS unsigned gu32;
#define RLX_AGENT __ATOMIC_RELAXED, __HIP_MEMORY_SCOPE_AGENT
#define LDS_WAIT() asm volatile("s_waitcnt lgkmcnt(0)" ::: "memory")
#define VM_WAIT() asm volatile("s_waitcnt vmcnt(0)" ::: "memory")
__device__ __forceinline__ unsigned f2bf(float f) { unsigned u = __builtin_bit_cast(unsigned, f); return (u + 0x7fffu + ((u >> 16) & 1u)) >> 16; }
__device__ __forceinline__ unsigned pk2(float lo, float hi) { return f2bf(lo) | (f2bf(hi) << 16); }
__device__ __forceinline__ float bflo(unsigned w) { return __uint_as_float(w << 16); }
__device__ __forceinline__ float bfhi(unsigned w) { return __uint_as_float(w & 0xffff0000u); }

#define XB_TMO      128
#define XB_XCNT(j)  (256  + 64 * (j))
#define XB_XSUB(j)  (1280 + 64 * (j))
#define XB_XGEN(j)  (2304 + 64 * (j))
#define XB_TOP      3328
#define XB_TOPGEN   3392
#define XCD_BAR_WORDS 3456
#define XB_SPIN_CAP (1u << 18)
__device__ __forceinline__ unsigned xb_ld(unsigned* p)              { return __hip_atomic_load(p, __ATOMIC_RELAXED, __HIP_MEMORY_SCOPE_AGENT); }
__device__ __forceinline__ unsigned xb_add(unsigned* p, unsigned v) { return __hip_atomic_fetch_add(p, v, __ATOMIC_RELAXED, __HIP_MEMORY_SCOPE_AGENT); }
__device__ __forceinline__ unsigned xb_xcc_id() { return (unsigned)__builtin_amdgcn_s_getreg((3 << 11) | 20) & 0xFu; }
#define XB_SPIN(cond, bar) do { unsigned _sp = 0; while (cond) { __builtin_amdgcn_s_sleep(1); \
    if ((++_sp & 255u) == 0u) { if (xb_ld(&(bar)[XB_TMO])) break; if (_sp > XB_SPIN_CAP) { atomicAdd(&(bar)[XB_TMO], 1u); break; } } } } while (0)
struct XcdBarrier { unsigned* bar; unsigned x; volatile LAS unsigned* st; };
__device__ __forceinline__ XcdBarrier xcd_barrier_post(unsigned* bar, volatile LAS unsigned* st) {
    XcdBarrier b; b.bar = bar; b.x = xb_xcc_id(); b.st = st;
    if (threadIdx.x == 0) (void)xb_add(&bar[XB_XCNT(b.x)], 1u);
    return b;
}
__device__ __forceinline__ void xcd_barrier_complete(unsigned* bar, unsigned x, unsigned& nloc, unsigned& nx) {
    const unsigned G = gridDim.x * gridDim.y * gridDim.z;
    unsigned sum, cnt, mine, sp = 0u;
    for (;;) {
        sum = 0u; cnt = 0u; mine = 0u;
#pragma unroll
        for (unsigned j = 0; j < 16; ++j) { const unsigned c = xb_ld(&bar[XB_XCNT(j)]); sum += c; cnt += (c > 0u) ? 1u : 0u; mine = (j == x) ? c : mine; }
        if (sum == G) break;
        __builtin_amdgcn_s_sleep(1);
        if ((++sp & 255u) == 0u) { if (xb_ld(&bar[XB_TMO])) break; if (sp > XB_SPIN_CAP) { atomicAdd(&bar[XB_TMO], 1u); break; } }
    }
    nloc = mine > 0u ? mine : 1u; nx = cnt > 0u ? cnt : 1u;
}
__device__ __forceinline__ void xcd_barrier(const XcdBarrier& b) {
    asm volatile("s_waitcnt vmcnt(0)" ::: "memory");
    __syncthreads();
    if (threadIdx.x == 0) {
        unsigned* bar = b.bar;
        __builtin_amdgcn_s_waitcnt(0);
        unsigned nloc = b.st[0], nx = b.st[1];
        if (nloc == 0u) { xcd_barrier_complete(bar, b.x, nloc, nx); b.st[0] = nloc; b.st[1] = nx; }
        const unsigned old = xb_add(&bar[XB_XSUB(b.x)], 1u);
        const unsigned gen = old / nloc;
        if (old + 1u == (gen + 1u) * nloc) {
            __builtin_amdgcn_fence(__ATOMIC_RELEASE, "agent");
            asm volatile("s_waitcnt vmcnt(0)" ::: "memory");
            const unsigned og = xb_add(&bar[XB_TOP], 1u);
            const unsigned tg = og / nx;
            if (og + 1u == (tg + 1u) * nx) xb_add(&bar[XB_TOPGEN], 1u);
            else XB_SPIN(xb_ld(&bar[XB_TOPGEN]) == tg, bar);
            __builtin_amdgcn_fence(__ATOMIC_ACQUIRE, "agent");
            xb_add(&bar[XB_XGEN(b.x)], 1u);
            asm volatile("s_waitcnt vmcnt(0)" ::: "memory");
        } else {
            XB_SPIN(xb_ld(&bar[XB_XGEN(b.x)]) == gen, bar);
            __builtin_amdgcn_fence(__ATOMIC_ACQUIRE, "agent");
            asm volatile("s_waitcnt vmcnt(0)" ::: "memory");
        }
    }
    __syncthreads();
}

__device__ __forceinline__ float wave_sum(float v) {
#pragma unroll
    for (int o = 1; o < 64; o <<= 1) v += __shfl_xor(v, o);
    return v;
}
__device__ __forceinline__ void p0_transpose_item(const float* W, int ldw, int k0, int n0, const float* gs, bf16* dst, int ldd, LAS float* scr, int lane) {
#pragma unroll 8
    for (int i = 0; i < 32; ++i) { const int kk = 2 * i + (lane >> 5); float v = W[(size_t)(k0 + kk) * ldw + n0 + (lane & 31)]; if (gs) v *= gs[k0 + kk]; scr[kk * 33 + (lane & 31)] = v; }
    LDS_WAIT(); asm volatile("" ::: "memory");
    const int c = lane & 7;
#pragma unroll
    for (int j = 0; j < 4; ++j) { const int n = (lane >> 3) + 8 * j; const LAS float* s = scr + (8 * c) * 33 + n;
        v4u o; o.x = pk2(s[0 * 33], s[1 * 33]); o.y = pk2(s[2 * 33], s[3 * 33]); o.z = pk2(s[4 * 33], s[5 * 33]); o.w = pk2(s[6 * 33], s[7 * 33]);
        *(GAS v4u*)(dst + (size_t)n * ldd + k0 + 8 * c) = o; }
    LDS_WAIT(); asm volatile("" ::: "memory");
}
__device__ __forceinline__ void xpose_mat(int item, const float* W, int ldw, int N, const float* gs, bf16* dst, int ldd, int mode, LAS float* scr, int lane) {
    const int nblk = N / 32, kb = item / nblk, nb = item % nblk, n0 = 32 * nb;
    const int row = mode == 0 ? n0 : ((n0 >> 7) * 256 + (n0 & 127) + (mode == 2 ? 128 : 0));
    p0_transpose_item(W, ldw, 64 * kb, n0, gs, dst + (size_t)row * ldd, ldd, scr, lane);
}

struct Args { const float* in[28]; float* out; unsigned char* ws; };

__device__ __forceinline__ void s5_tables(const Args& a, int g, LAS unsigned char* lds, int tid) {
    LAS float* POWr = (LAS float*)lds;
    LAS float* POWi = POWr + 33 * 64;
    LAS float* BBr = POWi + 33 * 64;
    LAS float* BBi = BBr + 1024;
    LAS float* CCr = BBi + 1024;
    LAS float* CCi = CCr + 1024;
    LAS float* KT = CCi + 1024;
    LAS float* DD = KT + 8192;
    const float* a_re = a.in[3]; const float* a_im = a.in[4]; const float* b_re = a.in[5]; const float* b_im = a.in[6];
    const float* c_re = a.in[7]; const float* c_im = a.in[8]; const float* dsk = a.in[9]; const float* log_step = a.in[10];
    const float step = expf(log_step[g]);
    __syncthreads();
    for (int e = tid; e < 33 * 64; e += NTHREADS) { const int n = e >> 6, p = e & 63; const float lr = a_re[g * 64 + p], li = a_im[g * 64 + p];
        const float mag = expf((float)n * step * lr); float sn, cs; sincosf((float)n * (step * li), &sn, &cs); POWr[e] = mag * cs; POWi[e] = mag * sn; }
    for (int e = tid; e < 1024; e += NTHREADS) { const int p = e >> 4, h = e & 15; const float lr = a_re[g * 64 + p], li = a_im[g * 64 + p];
        const float er = expf(lr * step); float sn, cs; sincosf(li * step, &sn, &cs); const float nr = er * cs - 1.f, ni = er * sn, den = lr * lr + li * li;
        const float fr = (nr * lr + ni * li) / den, fi = (ni * lr - nr * li) / den;
        const float br = b_re[(g * 64 + p) * 16 + h], bi = b_im[(g * 64 + p) * 16 + h];
        BBr[e] = fr * br - fi * bi; BBi[e] = fr * bi + fi * br;
        CCr[e] = c_re[g * 1024 + e]; CCi[e] = c_im[g * 1024 + e]; }
    if (tid < 16) DD[tid] = dsk[g * 16 + tid];
    __syncthreads();
    for (int e = tid; e < 8192; e += NTHREADS) { const int tau = e >> 8, ho = (e >> 4) & 15, hi = e & 15; float s = 0.f;
        for (int p = 0; p < 64; ++p) { const float cr = CCr[ho * 64 + p], ci = CCi[ho * 64 + p], pr = POWr[tau * 64 + p], pi = POWi[tau * 64 + p];
            const float xr = cr * pr - ci * pi, xi = cr * pi + ci * pr; s += xr * BBr[p * 16 + hi] - xi * BBi[p * 16 + hi]; }
        if (tau == 0 && ho == hi) s += DD[ho];
        KT[e] = s; }
    __syncthreads();
    bf16* WA = (bf16*)(a.ws + WS_S5WA) + (size_t)g * 256 * 512;
    for (int pc = tid; pc < 256 * 64; pc += NTHREADS) { const int n = pc >> 6, k0 = (pc & 63) * 8; v4u o = (v4u){0u, 0u, 0u, 0u};
        if (n < 128) { const int p = n & 63, j = k0 >> 4, h0 = k0 & 15; const float pr = POWr[(31 - j) * 64 + p], pi = POWi[(31 - j) * 64 + p]; float v[8];
#pragma unroll
            for (int q = 0; q < 8; ++q) { const float br = BBr[p * 16 + h0 + q], bi = BBi[p * 16 + h0 + q]; v[q] = (n < 64) ? (pr * br - pi * bi) : (pr * bi + pi * br); }
            o.x = pk2(v[0], v[1]); o.y = pk2(v[2], v[3]); o.z = pk2(v[4], v[5]); o.w = pk2(v[6], v[7]); }
        *(GAS v4u*)(WA + (size_t)n * 512 + k0) = o; }
    bf16* WC = (bf16*)(a.ws + WS_S5WC) + (size_t)g * 512 * 640;
    for (int pc = tid; pc < 512 * 80; pc += NTHREADS) { const int n = pc / 80, k0 = (pc % 80) * 8, i = n >> 4, ho = n & 15; float v[8];
        if (k0 < 512) { const int j = k0 >> 4, h0 = k0 & 15;
#pragma unroll
            for (int q = 0; q < 8; ++q) v[q] = (j <= i) ? KT[((i - j) * 16 + ho) * 16 + h0 + q] : 0.f; }
        else { const int p0 = (k0 - 512) & 63; const bool im = k0 >= 576;
#pragma unroll
            for (int q = 0; q < 8; ++q) { const int p = p0 + q; const float cr = CCr[ho * 64 + p], ci = CCi[ho * 64 + p], pr = POWr[(i + 1) * 64 + p], pi = POWi[(i + 1) * 64 + p];
                v[q] = im ? -(cr * pi + ci * pr) : (cr * pr - ci * pi); } }
        v4u o; o.x = pk2(v[0], v[1]); o.y = pk2(v[2], v[3]); o.z = pk2(v[4], v[5]); o.w = pk2(v[6], v[7]);
        *(GAS v4u*)(WC + (size_t)n * 640 + k0) = o; }
    __syncthreads();
}

__device__ __forceinline__ void p0_prologue(const Args& a, LAS unsigned char* lds, int tid, int lane, int wave, int vcu, int G) {
    for (int g = vcu; g < S5G; g += G) s5_tables(a, g, lds, tid);
    LAS float* scr = (LAS float*)(lds + wave * 16384);
    const int gw = vcu * NWAVES + wave, NGW = G * NWAVES;
    constexpr int I_IN0 = 16 * 64, I_GLU = 8 * 16, I_OUT = 16 * 32, I_GU0 = 16 * 88, I_D0 = 44 * 32, I_IN1 = 16 * 96, I_MOE = 1792;
    constexpr int NITEMS = I_IN0 + I_GLU + I_OUT + 2 * I_GU0 + I_D0 + I_IN1 + I_OUT + 24 * I_MOE;
    unsigned char* ws = a.ws;
    for (int it = NITEMS - 1 - gw; it >= 0; it -= NGW) {
        int r = it;
        if (r < I_IN0) { xpose_mat(r, a.in[2], EVEN_IN, EVEN_IN, a.in[1], (bf16*)(ws + WS_WIN0), D, 0, scr, lane); continue; } r -= I_IN0;
        if (r < I_GLU) { xpose_mat(r, a.in[11], 512, 512, nullptr, (bf16*)(ws + WS_WGLU), 512, 0, scr, lane); continue; } r -= I_GLU;
        if (r < I_OUT) { xpose_mat(r, a.in[13], D, D, nullptr, (bf16*)(ws + WS_WOUT0), D, 0, scr, lane); continue; } r -= I_OUT;
        if (r < I_GU0) { xpose_mat(r, a.in[15], DFF, DFF, a.in[14], (bf16*)(ws + WS_WGU0), D, 1, scr, lane); continue; } r -= I_GU0;
        if (r < I_GU0) { xpose_mat(r, a.in[16], DFF, DFF, a.in[14], (bf16*)(ws + WS_WGU0), D, 2, scr, lane); continue; } r -= I_GU0;
        if (r < I_D0) { xpose_mat(r, a.in[17], D, D, nullptr, (bf16*)(ws + WS_WD0), DFF, 0, scr, lane); continue; } r -= I_D0;
        if (r < I_IN1) { xpose_mat(r, a.in[19], ODD_IN, 3072, a.in[18], (bf16*)(ws + WS_WIN1), D, 0, scr, lane); continue; } r -= I_IN1;
        if (r < I_OUT) { xpose_mat(r, a.in[21], D, D, nullptr, (bf16*)(ws + WS_WOUT1), D, 0, scr, lane); continue; } r -= I_OUT;
        const int mat = r / I_MOE, e = mat / 3, which = mat % 3; r -= mat * I_MOE;
        if (which == 0) xpose_mat(r, a.in[24] + (size_t)e * D * DFE, DFE, DFE, a.in[22], (bf16*)(ws + WS_WMOE_GU) + (size_t)e * 7168 * 1024, D, 1, scr, lane);
        else if (which == 1) xpose_mat(r, a.in[25] + (size_t)e * D * DFE, DFE, DFE, a.in[22], (bf16*)(ws + WS_WMOE_GU) + (size_t)e * 7168 * 1024, D, 2, scr, lane);
        else xpose_mat(r, a.in[26] + (size_t)e * DFE * D, D, D, nullptr, (bf16*)(ws + WS_WMOE_D) + (size_t)e * 1024 * 3584, DFE, 0, scr, lane);
    }
    { const int gt = vcu * NTHREADS + tid; if (gt < 16 * 1024) { const int h = gt >> 10, k = gt & 1023; ((bf16*)(ws + WS_WF1))[gt] = (bf16)f2bf(a.in[19][(size_t)k * ODD_IN + 3072 + h] * a.in[18][k]); } }
    float* ss0 = (float*)(ws + WS_SSP);
    for (int m = gw; m < M; m += NGW) {
        const GAS f32x4* xr = (const GAS f32x4*)(a.in[0] + (size_t)m * D) + lane; GAS v2u* o8 = (GAS v2u*)((bf16*)(ws + WS_XB) + (size_t)m * D) + lane; float s = 0.f;
#pragma unroll
        for (int j = 0; j < 4; ++j) { const f32x4 v = xr[64 * j]; s += (v.x * v.x + v.y * v.y) + (v.z * v.z + v.w * v.w); v2u w; w.x = pk2(v.x, v.y); w.y = pk2(v.z, v.w); o8[64 * j] = w; }
        s = wave_sum(s); if (lane < 16) ss0[(size_t)m * 16 + lane] = (lane == 0) ? s : 0.f;
    }
}

__device__ __forceinline__ void s5_scan(const Args& a, int gt  ) {
    if (gt >= BATCH * S5G * S5P) return;
    const int b = gt / (S5G * S5P), g = (gt / S5P) % S5G, p = gt % S5P;
    const float step = expf(a.in[10][g]); const float lr = a.in[3][g * 64 + p], li = a.in[4][g * 64 + p];
    const float mag = expf((float)S5T * step * lr); float sn, cs; sincosf((float)S5T * (step * li), &sn, &cs); const float ar = mag * cs, ai = mag * sn;
    const float* sl = (const float*)(a.ws + WS_SLOC) + ((size_t)g * S5NC + b * 256) * 128 + p;
    bf16* ue = (bf16*)(a.ws + WS_UEXT) + ((size_t)g * S5NC + b * 256) * S5KX + 512 + p;
    float sr = 0.f, si = 0.f;
#pragma unroll 8
    for (int c = 0; c < 256; ++c) {
        ue[(size_t)c * S5KX] = (bf16)f2bf(sr); ue[(size_t)c * S5KX + 64] = (bf16)f2bf(si);
        const float lr_ = sl[(size_t)c * 128], li_ = sl[(size_t)c * 128 + 64];
        const float nr = ar * sr - ai * si + lr_, ni = ar * si + ai * sr + li_; sr = nr; si = ni;
    }
}

__device__ __forceinline__ float softplus2(float z) { return fmaxf(z, 0.f) + __builtin_amdgcn_logf(1.0f + __builtin_amdgcn_exp2f(-fabsf(z))); }
__device__ __forceinline__ void stage_kv32(const bf16* kp, const bf16* vp, size_t pitch, LAS float* sK, LAS float* sV, int tid) {
    const int r = tid >> 4, c = (tid & 15) * 4;
    const v2u kw = *(const v2u*)(kp + (size_t)r * pitch + c), vw = *(const v2u*)(vp + (size_t)r * pitch + c);
    *(LAS f32x4*)(sK + r * 64 + c) = (f32x4){bflo(kw.x), bfhi(kw.x), bflo(kw.y), bfhi(kw.y)};
    *(LAS f32x4*)(sV + r * 64 + c) = (f32x4){bflo(vw.x), bfhi(vw.x), bflo(vw.y), bfhi(vw.y)};
}
__device__ __forceinline__ void sb_simple_unit(const bf16* qkv  , bf16* mix  , int b, int h, int blk, LAS unsigned char* lds, int tid) {
    const int lane = tid & 63, wave_ = tid >> 6;
    LAS float* sK = (LAS float*)lds; LAS float* sV = sK + 32 * 64;
    const int t = blk * 512 + tid; const size_t rb = (size_t)b * SEQ;
    float q[HD], acc[HD];
    { const v4u* qp = (const v4u*)(qkv + (rb + t) * 1536 + h * HD);
#pragma unroll
      for (int i = 0; i < 8; ++i) { const v4u w = qp[i]; q[8 * i] = bflo(w.x); q[8 * i + 1] = bfhi(w.x); q[8 * i + 2] = bflo(w.y); q[8 * i + 3] = bfhi(w.y); q[8 * i + 4] = bflo(w.z); q[8 * i + 5] = bfhi(w.z); q[8 * i + 6] = bflo(w.w); q[8 * i + 7] = bfhi(w.w); }
#pragma unroll
      for (int i = 0; i < HD; ++i) acc[i] = 0.f; }
    float carry = 0.f;
    for (int c0 = blk * 512 + 480; c0 >= 0; c0 -= 32) {
        __syncthreads();
        stage_kv32(qkv + (rb + c0) * 1536 + 512 + h * HD, qkv + (rb + c0) * 1536 + 1024 + h * HD, 1536, sK, sV, tid);
        __syncthreads();
        for (int r = 31; r >= 0; --r) { const int s = c0 + r;
            if (s < t) { float z = 0.f;
#pragma unroll
                for (int i = 0; i < HD; ++i) z = fmaf(q[i], sK[r * 64 + i], z);
                const float sp = softplus2(z); const float w = __builtin_amdgcn_exp2f(z - sp + carry); carry -= sp;
#pragma unroll
                for (int i = 0; i < HD; ++i) acc[i] = fmaf(w, sV[r * 64 + i], acc[i]); } }
        { LAS unsigned* fl = (LAS unsigned*)(lds + 16384); if (lane == 0) fl[wave_] = __all(carry < -150.f) ? 1u : 0u; __syncthreads();
          if ((fl[0] & fl[1] & fl[2] & fl[3] & fl[4] & fl[5] & fl[6] & fl[7]) != 0u) break; }
    }
    v4u* op = (v4u*)(mix + (rb + t) * 1024 + 512 + h * HD);
#pragma unroll
    for (int i = 0; i < 8; ++i) { v4u w; w.x = pk2(acc[8 * i], acc[8 * i + 1]); w.y = pk2(acc[8 * i + 2], acc[8 * i + 3]); w.z = pk2(acc[8 * i + 4], acc[8 * i + 5]); w.w = pk2(acc[8 * i + 6], acc[8 * i + 7]); op[i] = w; }
}
__device__ __forceinline__ void fgate_rows16(const bf16* xb, const bf16* wf, const float* ss, const float* bfv, float* logf, int r0, int lane) {
    const int fr = lane & 15, fq = lane >> 4;
    const bf16x8* ap = (const bf16x8*)(xb + (size_t)(r0 + fr) * D + fq * 8);
    const bf16x8* bp = (const bf16x8*)(wf + (size_t)fr * D + fq * 8);
    f32x4 acc = (f32x4){0.f, 0.f, 0.f, 0.f};
#pragma unroll 8
    for (int kk = 0; kk < 32; ++kk) acc = __builtin_amdgcn_mfma_f32_16x16x32_bf16(ap[kk * 4], bp[kk * 4], acc, 0, 0, 0);
    const float bias = bfv[fr];
#pragma unroll
    for (int j = 0; j < 4; ++j) { const int row = r0 + fq * 4 + j; const float rs = pg8::rstd16(ss, row);
        const float z = acc[j] * rs + bias;
        const float lf = -(fmaxf(-z, 0.f) + log1pf(expf(-fabsf(z)))) * 1.4426950408889634f;
        const int b = row >> 13, t = row & 8191; logf[((size_t)b * FOXH + fr) * SEQ + t] = lf; }
}

struct MoeOrder {
    pg8::StaticOrder S; int lo; int pref[NEXP + 1];
    __device__ __forceinline__ bool next(int i, pg8::Unit& u) const {
        if (!S.next(i, u)) return false;
        u.pm += lo; int e = 0;
#pragma unroll
        for (int k = 1; k < NEXP; ++k) e += (u.pm >= pref[k]) ? 1 : 0;
        u.zb = e; return true;
    }
    __device__ __forceinline__ void a_ready(const pg8::Unit&) const {}
    __device__ __forceinline__ void done(const pg8::Unit&) const {}
};

__global__ void __launch_bounds__(NTHREADS, 2) mk_fwd(Args args) {
    extern __shared__ __attribute__((aligned(16))) unsigned char lds_raw[];
    LAS unsigned char* lds = (LAS unsigned char*)lds_raw;
    volatile LAS unsigned* MISC = (volatile LAS unsigned*)(lds + MISC_OFF);
    const int tid = threadIdx.x, lane = tid & 63, wave = __builtin_amdgcn_readfirstlane(tid >> 6);
    const int G = gridDim.x; const int bx = blockIdx.x; const int vcu = (G % 8 == 0) ? (bx % 8) * (G / 8) + bx / 8 : bx;
    unsigned char* ws = args.ws;
    gu32* ctl = (gu32*)(ws + WS_CTL);
    for (int u = tid; u < (LDS_BYTES - LDSCTL_OFF) / 4; u += NTHREADS) ((LAS unsigned*)(lds + LDSCTL_OFF))[u] = 0u;
    __syncthreads();
    XcdBarrier bar = xcd_barrier_post((unsigned*)(ctl + CW_BAR), MISC + 8);
    const int gw = vcu * NWAVES + wave, NGW = G * NWAVES;
    float* SS = (float*)(ws + WS_SSP);
    float* X = args.out;
    bf16* XB = (bf16*)(ws + WS_XB);
#define GRID_BAR() xcd_barrier(bar)
#define GEMM_PHASE(EPI, SCHED, lds_, g_, S_, E_) pg8::gemm_phase<EPI, SCHED, true, true>(lds_, g_, S_, E_)

    p0_prologue(args, lds, tid, lane, wave, vcu, G);
    GRID_BAR();
    { pg8::Gemm g{XB, (const bf16*)(ws + WS_WIN0), D, D, D, 0, 0}; pg8::StaticOrder S; S.init(M, EVEN_IN, 1, G, bx);
      pg8::EpiInProj0 E{SS, (bf16*)(ws + WS_UEXT), (bf16*)(ws + WS_QKV0), C2};
      GEMM_PHASE(pg8::EpiInProj0, pg8::StaticOrder, lds + RING_OFF, g, S, E); }
    GRID_BAR();
    { pg8::Gemm g{(const bf16*)(ws + WS_UEXT), (const bf16*)(ws + WS_S5WA), S5KX, 512, 512, (size_t)S5NC * S5KX * 2, (size_t)256 * 512 * 2}; pg8::StaticOrder S; S.init(S5NC, 256, S5G, G, bx);
      pg8::EpiS5State E{(float*)(ws + WS_SLOC)};
      GEMM_PHASE(pg8::EpiS5State, pg8::StaticOrder, lds + RING_OFF, g, S, E); }
    GRID_BAR();
    s5_scan(args, vcu * NTHREADS + tid);
    GRID_BAR();
    { pg8::Gemm g{(const bf16*)(ws + WS_UEXT), (const bf16*)(ws + WS_S5WC), S5KX, S5KX, S5KX, (size_t)S5NC * S5KX * 2, (size_t)512 * S5KX * 2}; pg8::StaticOrder S; S.init(S5NC, 512, S5G, G, bx);
      pg8::EpiS5Y E{(bf16*)(ws + WS_YG)};
      GEMM_PHASE(pg8::EpiS5Y, pg8::StaticOrder, lds + RING_OFF, g, S, E); }
    GRID_BAR();
    { pg8::Gemm g{(const bf16*)(ws + WS_YG), (const bf16*)(ws + WS_WGLU), 512, 512, 512, 0, 0}; pg8::StaticOrder S; S.init(M, 512, 1, G, bx);
      pg8::EpiGlu E{(const bf16*)(ws + WS_YG), args.in[12], (bf16*)(ws + WS_MIXB)};
      GEMM_PHASE(pg8::EpiGlu, pg8::StaticOrder, lds + RING_OFF, g, S, E); }
    __syncthreads();
    for (int L = vcu; L < BATCH * SBH * 32; L += G) { const int bh = L >> 5, qb = (L & 256) ? (L & 31) : 31 - (L & 31);
        attn_body::sb_unit<1536>(bh >> 3, bh & 7, qb, (const attn_body::bf16*)(ws + WS_QKV0), (const attn_body::bf16*)(ws + WS_QKV0) + 512, (const attn_body::bf16*)(ws + WS_QKV0) + 1024, (attn_body::bf16*)(ws + WS_MIXB) + 512, (char*)lds_raw + RING_OFF); }
    GRID_BAR();
    { pg8::Gemm g{(const bf16*)(ws + WS_MIXB), (const bf16*)(ws + WS_WOUT0), D, D, D, 0, 0}; pg8::StaticOrder S; S.init(M, D, 1, G, bx);
      pg8::EpiResid E{args.in[0], X, XB, SS + 16 * M};
      GEMM_PHASE(pg8::EpiResid, pg8::StaticOrder, lds + RING_OFF, g, S, E); }
    GRID_BAR();
    { pg8::Gemm g{XB, (const bf16*)(ws + WS_WGU0), D, D, D, 0, 0}; pg8::StaticOrder S; S.init(M, 2 * DFF, 1, G, bx);
      pg8::EpiSwiGlu<true> E{SS + 16 * M, (bf16*)(ws + WS_HID0), DFF};
      GEMM_PHASE(pg8::EpiSwiGlu<true>, pg8::StaticOrder, lds + RING_OFF, g, S, E); }
    GRID_BAR();
    { pg8::Gemm g{(const bf16*)(ws + WS_HID0), (const bf16*)(ws + WS_WD0), DFF, DFF, DFF, 0, 0}; pg8::StaticOrder S; S.init(M, D, 1, G, bx);
      pg8::EpiResid E{X, X, XB, SS + 32 * M};
      GEMM_PHASE(pg8::EpiResid, pg8::StaticOrder, lds + RING_OFF, g, S, E); }
    GRID_BAR();
    { pg8::Gemm g{XB, (const bf16*)(ws + WS_WIN1), D, D, D, 0, 0}; pg8::StaticOrder S; S.init(M, 3072, 1, G, bx);
      pg8::EpiInProj1 E{SS + 32 * M, (bf16*)(ws + WS_QKV1), C2};
      GEMM_PHASE(pg8::EpiInProj1, pg8::StaticOrder, lds + RING_OFF, g, S, E); }
    for (int r = gw; r < M / 16; r += NGW) fgate_rows16(XB, (const bf16*)(ws + WS_WF1), SS + 32 * M, args.in[20], (float*)(ws + WS_LOGF), r * 16, lane);
    GRID_BAR();
    { const attn_body::AttnTensors AT{(const attn_body::bf16*)(ws + WS_QKV1), (const attn_body::bf16*)(ws + WS_QKV1 + 32 * MiB), (const attn_body::bf16*)(ws + WS_QKV1 + 64 * MiB), (attn_body::bf16*)(ws + WS_QKV1), (const float*)(ws + WS_LOGF)};
      if (bx < 256) { const attn_body::StaticOrder S(256, bx); attn_body::attn_phase<attn_body::StaticOrder>((char*)lds_raw + RING_OFF, AT, S); } }
    GRID_BAR();
    { pg8::Gemm g{(const bf16*)(ws + WS_QKV1), (const bf16*)(ws + WS_WOUT1), D, D, D, 0, 0}; pg8::StaticOrder S; S.init(M, D, 1, G, bx);
      pg8::EpiResid E{X, X, XB, SS + 48 * M};
      GEMM_PHASE(pg8::EpiResid, pg8::StaticOrder, lds + RING_OFF, g, S, E); }
    GRID_BAR();
    unsigned char* meta = ws + WS_META;
    {
        const float* wr = args.in[23]; const float* gn = args.in[22];
        for (int tok = gw; tok < M; tok += NGW) {
            const GAS f32x4* xr = (const GAS f32x4*)(X + (size_t)tok * D) + lane; float lg[NEXP]; float s = 0.f;
#pragma unroll
            for (int e = 0; e < NEXP; ++e) lg[e] = 0.f;
#pragma unroll
            for (int j = 0; j < 4; ++j) { const f32x4 v = xr[64 * j]; s += (v.x * v.x + v.y * v.y) + (v.z * v.z + v.w * v.w); const int k0 = 4 * lane + 256 * j; const f32x4 gv = *(const f32x4*)(gn + k0);
#pragma unroll
                for (int q = 0; q < 4; ++q) { const float xv = v[q] * gv[q]; const f32x4 w0 = *(const f32x4*)(wr + (size_t)(k0 + q) * NEXP), w1 = *(const f32x4*)(wr + (size_t)(k0 + q) * NEXP + 4);
                    lg[0] = fmaf(xv, w0.x, lg[0]); lg[1] = fmaf(xv, w0.y, lg[1]); lg[2] = fmaf(xv, w0.z, lg[2]); lg[3] = fmaf(xv, w0.w, lg[3]);
                    lg[4] = fmaf(xv, w1.x, lg[4]); lg[5] = fmaf(xv, w1.y, lg[5]); lg[6] = fmaf(xv, w1.z, lg[6]); lg[7] = fmaf(xv, w1.w, lg[7]); } }
            s = wave_sum(s);
#pragma unroll
            for (int e = 0; e < NEXP; ++e) lg[e] = wave_sum(lg[e]);
            if (lane == 0) {
                const float rs = 1.0f / sqrtf(s * (1.0f / 1024.0f) + pg8::RMS_EPS);
                int i1 = 0; float v1 = lg[0];
#pragma unroll
                for (int e = 1; e < NEXP; ++e) if (lg[e] > v1) { v1 = lg[e]; i1 = e; }
                int i2 = -1; float v2 = -INFINITY;
#pragma unroll
                for (int e = 0; e < NEXP; ++e) if (e != i1 && lg[e] > v2) { v2 = lg[e]; i2 = e; }
                const float g1 = 1.f / (1.f + expf((v2 - v1) * rs)), g2 = 1.f - g1;
                const unsigned p1 = __hip_atomic_fetch_add(ctl + CW_CNT + 64 * i1, 1u, RLX_AGENT), p2 = __hip_atomic_fetch_add(ctl + CW_CNT + 64 * i2, 1u, RLX_AGENT);
                ((float*)(meta + MT_RSTD))[tok] = rs; ((unsigned*)(meta + MT_TOKE))[tok] = (unsigned)i1 | ((unsigned)i2 << 8);
                ((unsigned*)(meta + MT_TOKP))[2 * tok] = p1; ((unsigned*)(meta + MT_TOKP))[2 * tok + 1] = p2;
                ((float*)(meta + MT_TOKG))[2 * tok] = g1; ((float*)(meta + MT_TOKG))[2 * tok + 1] = g2;
            }
        }
    }
    GRID_BAR();
    int pref[NEXP + 1], cnt[NEXP];
    { pref[0] = 0;
#pragma unroll
      for (int e = 0; e < NEXP; ++e) { cnt[e] = (int)__builtin_amdgcn_readfirstlane(__hip_atomic_load(ctl + CW_CNT + 64 * e, RLX_AGENT)); pref[e + 1] = pref[e] + (cnt[e] + 255) / 256; } }
    const int NP = pref[NEXP];
    bf16* XG = (bf16*)(ws + WS_XG); float* RSS = (float*)(meta + MT_RSS);
    {
        for (int tok = gw; tok < M; tok += NGW) {
            const unsigned ee = ((const unsigned*)(meta + MT_TOKE))[tok]; const float rs = ((const float*)(meta + MT_RSTD))[tok];
            const v4u r0 = *(const v4u*)(XB + (size_t)tok * D + lane * 8), r1 = *(const v4u*)(XB + (size_t)tok * D + 512 + lane * 8);
#pragma unroll
            for (int k = 0; k < 2; ++k) { const int e = (ee >> (8 * k)) & 0xff; int pe = 0;
#pragma unroll
                for (int q = 0; q < NEXP; ++q) pe = (q == e) ? pref[q] : pe;
                const int slot = pe * 256 + (int)((const unsigned*)(meta + MT_TOKP))[2 * tok + k];
                *(v4u*)(XG + (size_t)slot * D + lane * 8) = r0; *(v4u*)(XG + (size_t)slot * D + 512 + lane * 8) = r1;
                if (lane == 0) { RSS[slot] = rs; ((unsigned*)(meta + MT_TOKSLOT))[2 * tok + k] = (unsigned)slot; } }
        }
#pragma unroll
        for (int e = 0; e < NEXP; ++e) for (int r = pref[e] * 256 + cnt[e] + gw; r < pref[e + 1] * 256; r += NGW) {
            *(v4u*)(XG + (size_t)r * D + lane * 8) = (v4u){0u, 0u, 0u, 0u}; *(v4u*)(XG + (size_t)r * D + 512 + lane * 8) = (v4u){0u, 0u, 0u, 0u}; if (lane == 0) RSS[r] = 0.f; }
    }
    GRID_BAR();
#pragma unroll
    for (int ch = 0; ch < 2; ++ch) {
        const int lo = ch * MOE_CHUNK_PANELS, hi = NP < (ch + 1) * MOE_CHUNK_PANELS ? NP : (ch + 1) * MOE_CHUNK_PANELS, np = hi > lo ? hi - lo : 0;
        bf16* Hc = (bf16*)(ws + WS_HMOE) - (size_t)lo * 256 * DFE;
        { pg8::Gemm g{XG, (const bf16*)(ws + WS_WMOE_GU), D, D, D, 0, (size_t)7168 * 1024 * 2}; MoeOrder S; S.S.nM = np; S.S.nN = 28; S.S.nZ = 1; S.S.nwg = np * 28; S.S.G = G; S.S.c = bx; S.lo = lo;
#pragma unroll
          for (int e = 0; e <= NEXP; ++e) S.pref[e] = pref[e];
          pg8::EpiSwiGlu<false> E{RSS, Hc, DFE};
          GEMM_PHASE(pg8::EpiSwiGlu<false>, MoeOrder, lds + RING_OFF, g, S, E); }
        GRID_BAR();
        { pg8::Gemm g{Hc, (const bf16*)(ws + WS_WMOE_D), DFE, DFE, DFE, 0, (size_t)1024 * 3584 * 2}; MoeOrder S; S.S.nM = np; S.S.nN = 4; S.S.nZ = 1; S.S.nwg = np * 4; S.S.G = G; S.S.c = bx; S.lo = lo;
#pragma unroll
          for (int e = 0; e <= NEXP; ++e) S.pref[e] = pref[e];
          pg8::EpiStoreBf16 E{XG, D};
          GEMM_PHASE(pg8::EpiStoreBf16, MoeOrder, lds + RING_OFF, g, S, E); }
        GRID_BAR();
    }
    {
        const float* gf = args.in[27];
        for (int tok = gw; tok < M; tok += NGW) {
            const unsigned s0 = ((const unsigned*)(meta + MT_TOKSLOT))[2 * tok], s1 = ((const unsigned*)(meta + MT_TOKSLOT))[2 * tok + 1];
            const float g0 = ((const float*)(meta + MT_TOKG))[2 * tok], g1 = ((const float*)(meta + MT_TOKG))[2 * tok + 1];
            GAS f32x4* xr = (GAS f32x4*)(X + (size_t)tok * D) + lane; f32x4 v[4]; float s = 0.f;
#pragma unroll
            for (int j = 0; j < 4; ++j) { v[j] = xr[64 * j]; const int k0 = 4 * lane + 256 * j;
                const v2u a = *(const v2u*)(XG + (size_t)s0 * D + k0), b2 = *(const v2u*)(XG + (size_t)s1 * D + k0);
                v[j].x += g0 * bflo(a.x) + g1 * bflo(b2.x); v[j].y += g0 * bfhi(a.x) + g1 * bfhi(b2.x); v[j].z += g0 * bflo(a.y) + g1 * bflo(b2.y); v[j].w += g0 * bfhi(a.y) + g1 * bfhi(b2.y);
                s += (v[j].x * v[j].x + v[j].y * v[j].y) + (v[j].z * v[j].z + v[j].w * v[j].w); }
            s = wave_sum(s); const float rs = 1.0f / sqrtf(s * (1.0f / 1024.0f) + pg8::RMS_EPS);
#pragma unroll
            for (int j = 0; j < 4; ++j) { const f32x4 gv = *(const f32x4*)(gf + 4 * lane + 256 * j); xr[64 * j] = v[j] * rs * gv; }
        }
    }
}

extern "C" void kernel_launch(void* const* d_in, const int* in_sizes, int n_in, void* d_out, int out_size, void* d_ws, size_t ws_size, hipStream_t stream) {
    static int grid = 0;
    if (grid == 0) {
        if (n_in != 28 || in_sizes[0] != M * D || out_size != M * D || ws_size < WS_END) { fprintf(stderr, "kernel_launch: unexpected problem: n_in %d in0 %d out %d ws %zu (need %zu)\n", n_in, n_in > 0 ? in_sizes[0] : -1, out_size, ws_size, (size_t)WS_END); grid = -1; return; }
        int dev = 0, cus = 0, per_cu = 0;
        if (hipGetDevice(&dev) != hipSuccess || hipDeviceGetAttribute(&cus, hipDeviceAttributeMultiprocessorCount, dev) != hipSuccess) { grid = -1; return; }
        if (hipFuncSetAttribute((const void*)mk_fwd, hipFuncAttributeMaxDynamicSharedMemorySize, LDS_BYTES) != hipSuccess) { fprintf(stderr, "kernel_launch: hipFuncSetAttribute failed\n"); grid = -1; return; }
        if (hipOccupancyMaxActiveBlocksPerMultiprocessor(&per_cu, (const void*)mk_fwd, NTHREADS, LDS_BYTES) != hipSuccess || per_cu < 1) fprintf(stderr, "kernel_launch: occupancy query says %d\n", per_cu);
        (void)hipGetLastError();
        grid = cus;
        if (grid != 256) fprintf(stderr, "kernel_launch: built for the 256-CU MI355X; device reports %d CUs\n", cus);
    }
    if (grid < 0) return;
    if (hipMemsetAsync((char*)d_ws + WS_CTL, 0, CTL_ZERO_BYTES, stream) != hipSuccess) return;
    Args a{};
    for (int i = 0; i < 28; ++i) a.in[i] = (const float*)d_in[i];
    a.out = (float*)d_out; a.ws = (unsigned char*)d_ws;
    hipLaunchKernelGGL(mk_fwd, dim3(grid), dim3(NTHREADS), LDS_BYTES, stream, a);
}
```

```cpp
#include <hip/hip_runtime.h>
#include <cstdio>
#include <cstdint>

namespace pg8 {
#define PG8_LAS __attribute__((address_space(3)))
typedef unsigned short bf16_t;
typedef short bf16x8 __attribute__((ext_vector_type(8)));
typedef float f32x4 __attribute__((ext_vector_type(4)));
typedef unsigned u32x4 __attribute__((ext_vector_type(4)));
typedef unsigned u32x2 __attribute__((ext_vector_type(2)));
constexpr int BM = 256, BK = 64, HALF = 128, HTB = HALF * BK * 2  , STAGE_BYTES = 8 * HTB, NXCD = 8, WGM = 8;

__host__ __device__ __forceinline__ int lds_byte(int r, int c) { const int st = (r >> 4) * 2 + (c >> 5), rr = r & 15, cc = c & 31, ob = rr * 64 + cc * 2; return st * 1024 + (ob ^ (((ob >> 9) & 1) << 5)); }
__host__ __device__ __forceinline__ void stage_rc(int b, int& R, int& C) { const int st = b / 1024, sb = b % 1024, swz = sb ^ (((sb >> 9) & 1) << 5); R = (st >> 1) * 16 + swz / 64; C = (st & 1) * 32 + (swz % 64) / 2; }
__host__ __device__ __forceinline__ int perm32(int rho) { const int n = rho >> 4, i = rho & 15; return 8 * (i >> 2) + 4 * n + (i & 3); }

struct Unit { int pm, pn, zb; };
struct Gemm { const bf16_t* A; const bf16_t* Bt; int lda, ldb, K; size_t zA, zB; };

struct StaticOrder {
    int nM, nN, nZ, nwg, G, c;
    __host__ __device__ void init(int M, int N, int Z, int G_, int c_) { nM = M / BM; nN = N / BM; nZ = Z; nwg = nM * nN * nZ; G = G_; c = c_; }
    __host__ __device__ bool next(int i, Unit& u) const {
        const long L = (long)i * G + c; if (L >= nwg) return false;
        int wgid = (int)L; { const int q = nwg / NXCD, r = nwg % NXCD, xcd = wgid % NXCD, off = wgid / NXCD; wgid = (xcd < r ? xcd * (q + 1) : r * (q + 1) + (xcd - r) * q) + off; }
        const int per = nM * nN; u.zb = wgid / per; wgid -= u.zb * per;
        const int nig = WGM * nN, gid = wgid / nig, fm = gid * WGM, gsz = (nM - fm) < WGM ? (nM - fm) : WGM;
        u.pm = fm + ((wgid % nig) % gsz); u.pn = (wgid % nig) / gsz; return true;
    }
    __device__ __forceinline__ void a_ready(const Unit&) const {}
    __device__ __forceinline__ void done(const Unit&) const {}
};

__device__ __forceinline__ unsigned cvt_pk_bf16(float lo, float hi) { unsigned r; asm volatile("v_cvt_pk_bf16_f32 %0, %1, %2" : "=v"(r) : "v"(lo), "v"(hi)); return r; }
__device__ __forceinline__ float bf_lo(unsigned w) { return __uint_as_float(w << 16); }
__device__ __forceinline__ float bf_hi(unsigned w) { return __uint_as_float(w & 0xffff0000u); }
__device__ __forceinline__ float fast_sigmoid(float z) { return __builtin_amdgcn_rcpf(1.0f + __builtin_amdgcn_exp2f(-1.4426950408889634f * z)); }
constexpr float RMS_EPS = 1e-6f;
__device__ __forceinline__ float rstd16(const float* ssp, int row) { const f32x4* p = (const f32x4*)(ssp + (size_t)row * 16); const f32x4 a = p[0], b = p[1], c = p[2], d = p[3];
    const float s = (((a[0] + a[1]) + (a[2] + a[3])) + ((b[0] + b[1]) + (b[2] + b[3]))) + (((c[0] + c[1]) + (c[2] + c[3])) + ((d[0] + d[1]) + (d[2] + d[3])));
    return __builtin_amdgcn_rsqf(s * (1.0f / 1024.0f) + RMS_EPS); }

__device__ __forceinline__ u32x4 pack8(const f32x4 v0, const f32x4 v1) { u32x4 w; w.x = cvt_pk_bf16(v0[0], v0[1]); w.y = cvt_pk_bf16(v0[2], v0[3]); w.z = cvt_pk_bf16(v1[0], v1[1]); w.w = cvt_pk_bf16(v1[2], v1[3]); return w; }

struct EpiInProj0 {
    static constexpr bool PERM = true, AFTER_DRAIN = false;
    const float* ss; bf16_t* uext; bf16_t* qkv; float qscale;
    __device__ __forceinline__ void operator()(const f32x4 (&acc)[2][2][4][2], const Unit& u, int wr, int wc, int fr, int fq) const {
        const int row0 = u.pm * BM + wr * 64 + fr;
#pragma unroll
        for (int ai = 0; ai < 2; ++ai)
#pragma unroll
            for (int m = 0; m < 4; ++m) { const int row = row0 + ai * HALF + m * 16; const float rs = rstd16(ss, row);
#pragma unroll
                for (int bj = 0; bj < 2; ++bj) { const int col0 = u.pn * BM + bj * HALF + wc * 32 + 8 * fq;
                    float sc = rs; bf16_t* dst;
                    if (u.pn < 2) dst = uext + ((size_t)(col0 >> 4) * 512 + (row >> 5)) * 640 + (row & 31) * 16 + (col0 & 15);
                    else { const int c = col0 - 512; if (c < 512) sc *= qscale; dst = qkv + (size_t)row * 1536 + c; }
                    *(u32x4*)dst = pack8(acc[ai][bj][m][0] * sc, acc[ai][bj][m][1] * sc); } }
    }
};
struct EpiS5State {
    static constexpr bool PERM = false, AFTER_DRAIN = false;
    float* sloc;
    __device__ __forceinline__ void operator()(const f32x4 (&acc)[2][2][4][2], const Unit& u, int wr, int wc, int fr, int fq) const {
        const int row0 = u.pm * BM + wr * 64 + fr, col0 = wc * 32 + 4 * fq;
#pragma unroll
        for (int ai = 0; ai < 2; ++ai)
#pragma unroll
            for (int m = 0; m < 4; ++m) { float* rowp = sloc + ((size_t)u.zb * 512 + row0 + ai * HALF + m * 16) * 128 + col0;
#pragma unroll
                for (int n = 0; n < 2; ++n) *(f32x4*)(rowp + n * 16) = acc[ai][0][m][n]; }
    }
};
__device__ __forceinline__ float gelu_tanh(float x) { const float a = x * (1.0f + 0.044715f * x * x); return x * __builtin_amdgcn_rcpf(1.0f + __builtin_amdgcn_exp2f(-2.302208198f * a)); }
struct EpiS5Y {
    static constexpr bool PERM = true, AFTER_DRAIN = false;
    bf16_t* yg;
    __device__ __forceinline__ void operator()(const f32x4 (&acc)[2][2][4][2], const Unit& u, int wr, int wc, int fr, int fq) const {
        const int row0 = u.pm * BM + wr * 64 + fr;
#pragma unroll
        for (int ai = 0; ai < 2; ++ai)
#pragma unroll
            for (int m = 0; m < 4; ++m) { const int chunk = row0 + ai * HALF + m * 16;
#pragma unroll
                for (int bj = 0; bj < 2; ++bj) { const int col0 = u.pn * BM + bj * HALF + wc * 32 + 8 * fq; const int i = col0 >> 4, h0 = col0 & 15;
                    f32x4 v0 = acc[ai][bj][m][0], v1 = acc[ai][bj][m][1];
#pragma unroll
                    for (int e = 0; e < 4; ++e) { v0[e] = gelu_tanh(v0[e]); v1[e] = gelu_tanh(v1[e]); }
                    *(u32x4*)(yg + ((size_t)chunk * 32 + i) * 512 + u.zb * 16 + h0) = pack8(v0, v1); } }
    }
};
struct EpiGlu {
    static constexpr bool PERM = true, AFTER_DRAIN = false;
    const bf16_t* yg; const float* bias; bf16_t* mix;
    __device__ __forceinline__ void operator()(const f32x4 (&acc)[2][2][4][2], const Unit& u, int wr, int wc, int fr, int fq) const {
        const int row0 = u.pm * BM + wr * 64 + fr;
#pragma unroll
        for (int bj = 0; bj < 2; ++bj) { const int col0 = u.pn * BM + bj * HALF + wc * 32 + 8 * fq;
            const f32x4 b0 = *(const f32x4*)(bias + col0), b1 = *(const f32x4*)(bias + col0 + 4);
#pragma unroll
            for (int ai = 0; ai < 2; ++ai)
#pragma unroll
                for (int m = 0; m < 4; ++m) { const int row = row0 + ai * HALF + m * 16;
                    const u32x4 yw = *(const u32x4*)(yg + (size_t)row * 512 + col0);
                    f32x4 z0 = acc[ai][bj][m][0] + b0, z1 = acc[ai][bj][m][1] + b1, o0, o1;
                    o0[0] = bf_lo(yw.x) * fast_sigmoid(z0[0]); o0[1] = bf_hi(yw.x) * fast_sigmoid(z0[1]); o0[2] = bf_lo(yw.y) * fast_sigmoid(z0[2]); o0[3] = bf_hi(yw.y) * fast_sigmoid(z0[3]);
                    o1[0] = bf_lo(yw.z) * fast_sigmoid(z1[0]); o1[1] = bf_hi(yw.z) * fast_sigmoid(z1[1]); o1[2] = bf_lo(yw.w) * fast_sigmoid(z1[2]); o1[3] = bf_hi(yw.w) * fast_sigmoid(z1[3]);
                    *(u32x4*)(mix + (size_t)row * 1024 + col0) = pack8(o0, o1); } }
    }
};
struct EpiResid {
    static constexpr bool PERM = false, AFTER_DRAIN = false;
    const float* R; float* X; bf16_t* xb; float* ssq;
    __device__ __forceinline__ void operator()(const f32x4 (&acc)[2][2][4][2], const Unit& u, int wr, int wc, int fr, int fq) const {
        const int row0 = u.pm * BM + wr * 64 + fr, col0 = u.pn * BM + wc * 32 + 4 * fq;
#pragma unroll
        for (int ai = 0; ai < 2; ++ai)
#pragma unroll
            for (int m = 0; m < 4; ++m) { const int row = row0 + ai * HALF + m * 16; const size_t off = (size_t)row * 1024 + col0; float s = 0.f;
#pragma unroll
                for (int bj = 0; bj < 2; ++bj)
#pragma unroll
                    for (int n = 0; n < 2; ++n) { const f32x4 x = *(const f32x4*)(R + off + bj * HALF + n * 16) + acc[ai][bj][m][n];
                        *(f32x4*)(X + off + bj * HALF + n * 16) = x; s += (x[0] * x[0] + x[1] * x[1]) + (x[2] * x[2] + x[3] * x[3]);
                        u32x2 w; w.x = cvt_pk_bf16(x[0], x[1]); w.y = cvt_pk_bf16(x[2], x[3]); *(u32x2*)(xb + off + bj * HALF + n * 16) = w; }
                s += __shfl_xor(s, 16); s += __shfl_xor(s, 32);
                if (fq == 0) ssq[(size_t)row * 16 + u.pn * 4 + wc] = s; }
    }
};
template <bool RS_IS_SSQ> struct EpiSwiGlu {
    static constexpr bool PERM = true, AFTER_DRAIN = false;
    const float* rsv; bf16_t* H; int ldh;
    __device__ __forceinline__ void operator()(const f32x4 (&acc)[2][2][4][2], const Unit& u, int wr, int wc, int fr, int fq) const {
        const int row0 = u.pm * BM + wr * 64 + fr, col0 = u.pn * HALF + wc * 32 + 8 * fq;
#pragma unroll
        for (int ai = 0; ai < 2; ++ai)
#pragma unroll
            for (int m = 0; m < 4; ++m) { const int row = row0 + ai * HALF + m * 16; const float rs = RS_IS_SSQ ? rstd16(rsv, row) : rsv[row];
                f32x4 o[2];
#pragma unroll
                for (int n = 0; n < 2; ++n)
#pragma unroll
                    for (int e = 0; e < 4; ++e) { const float g = acc[ai][0][m][n][e] * rs, up = acc[ai][1][m][n][e] * rs; o[n][e] = g * fast_sigmoid(g) * up; }
                *(u32x4*)(H + (size_t)row * ldh + col0) = pack8(o[0], o[1]); }
    }
};
struct EpiInProj1 {
    static constexpr bool PERM = true, AFTER_DRAIN = false;
    const float* ss; bf16_t* qkv; float qscale;
    __device__ __forceinline__ void operator()(const f32x4 (&acc)[2][2][4][2], const Unit& u, int wr, int wc, int fr, int fq) const {
        const int row0 = u.pm * BM + wr * 64 + fr; const float qs = (u.pn < 4) ? qscale : 1.0f;
#pragma unroll
        for (int ai = 0; ai < 2; ++ai)
#pragma unroll
            for (int m = 0; m < 4; ++m) { const int row = row0 + ai * HALF + m * 16; const float sc = rstd16(ss, row) * qs;
#pragma unroll
                for (int bj = 0; bj < 2; ++bj) { const int col0 = (u.pn & 3) * BM + bj * HALF + wc * 32 + 8 * fq;
                    *(u32x4*)(qkv + (size_t)(u.pn >> 2) * (16384 * 1024) + (size_t)row * 1024 + col0) = pack8(acc[ai][bj][m][0] * sc, acc[ai][bj][m][1] * sc); } }
    }
};
struct EpiStoreBf16 {
    static constexpr bool PERM = true, AFTER_DRAIN = false;
    bf16_t* O; int ldc;
    __device__ __forceinline__ void operator()(const f32x4 (&acc)[2][2][4][2], const Unit& u, int wr, int wc, int fr, int fq) const {
        const int row0 = u.pm * BM + wr * 64 + fr;
#pragma unroll
        for (int ai = 0; ai < 2; ++ai)
#pragma unroll
            for (int m = 0; m < 4; ++m) { const int row = row0 + ai * HALF + m * 16;
#pragma unroll
                for (int bj = 0; bj < 2; ++bj) { const int col0 = u.pn * BM + bj * HALF + wc * 32 + 8 * fq;
                    *(u32x4*)(O + (size_t)row * ldc + col0) = pack8(acc[ai][bj][m][0], acc[ai][bj][m][1]); } }
    }
};

template <class Epi, class Sched, bool ALIGN_EPI = false, bool SP2 = false>
__device__ __forceinline__ void gemm_phase(PG8_LAS unsigned char* lds, const Gemm g, const Sched& S, const Epi& E) {
    int tid_ = threadIdx.x; asm volatile("" : "+v"(tid_));
    const int tid = tid_, wid = __builtin_amdgcn_readfirstlane(tid >> 6), lane = tid & 63, wr = wid >> 2, wc = wid & 3, fr = lane & 15, fq = lane >> 4;
    const int K = g.K, nt = K / BK;
    unsigned voffA[2], voffB[2];
#pragma unroll
    for (int i = 0; i < 2; ++i) { int R, C; stage_rc(tid * 16 + i * 8192, R, C); const int Rb = Epi::PERM ? ((R & ~31) + perm32(R & 31)) : R;
        voffA[i] = (unsigned)(R * g.lda + C) * 2u; voffB[i] = (unsigned)(Rb * g.ldb + C) * 2u; }
    const size_t kstep = (size_t)(BK * 2);
    const size_t hstepA = (size_t)HALF * g.lda * 2, hstepB = (size_t)HALF * g.ldb * 2;
    const size_t tstepA = 2 * hstepA, tstepB = 2 * hstepB;
    const unsigned ldsw = (unsigned)wid * 1024u;
    const int aoff = lds_byte(wr * 64 + fr, fq * 8), boff = lds_byte(wc * 32 + fr, fq * 8);
#define PG8_SA(b, h) (((b) * 2 + (h)) * HTB)
#define PG8_SB(b, h) ((4 + (b) * 2 + (h)) * HTB)
#define PG8_STAGE(bufoff, gbase, voff) do { _Pragma("unroll") for (int _i = 0; _i < 2; ++_i) \
        __builtin_amdgcn_global_load_lds((const unsigned*)((const char*)(gbase) + (voff)[_i]), (PG8_LAS unsigned*)(lds + (bufoff) + ldsw + _i * 8192), 16, 0, 0); } while (0)
#define PG8_LDA(dst, b, h) do { _Pragma("unroll") for (int m = 0; m < 4; ++m) _Pragma("unroll") for (int k = 0; k < 2; ++k) dst[m][k] = *(const PG8_LAS bf16x8*)(lds + PG8_SA(b, h) + aoff + m * 2048 + k * 1024); } while (0)
#define PG8_LDB(dst, b, h) do { _Pragma("unroll") for (int n = 0; n < 2; ++n) _Pragma("unroll") for (int k = 0; k < 2; ++k) dst[n][k] = *(const PG8_LAS bf16x8*)(lds + PG8_SB(b, h) + boff + n * 2048 + k * 1024); } while (0)
#define PG8_MMA(ai, bj, At, Bt) do { __builtin_amdgcn_s_setprio(1); _Pragma("unroll") for (int m = 0; m < 4; ++m) _Pragma("unroll") for (int n = 0; n < 2; ++n) _Pragma("unroll") for (int k = 0; k < 2; ++k) \
        acc[ai][bj][m][n] = __builtin_amdgcn_mfma_f32_16x16x32_bf16(Bt[n][k], At[m][k], acc[ai][bj][m][n], 0, 0, 0); __builtin_amdgcn_s_setprio(0); } while (0)
#define PG8_WAIT_V(n) asm volatile("s_waitcnt vmcnt(" #n ")" ::: "memory")
#define PG8_WAIT_L(n) asm volatile("s_waitcnt lgkmcnt(" #n ")" ::: "memory")
#define PG8_BAR __builtin_amdgcn_s_barrier()
#define PG8_SCHED __builtin_amdgcn_sched_barrier(0)
    Unit cur, nxt; int ui = 0;
    if (!S.next(0, cur)) return;
    f32x4 acc[2][2][4][2];
#pragma unroll
    for (int a = 0; a < 2; ++a)
#pragma unroll
        for (int b = 0; b < 2; ++b)
#pragma unroll
            for (int m = 0; m < 4; ++m)
#pragma unroll
                for (int n = 0; n < 2; ++n) acc[a][b][m][n] = (f32x4){0.f, 0.f, 0.f, 0.f};
    bf16x8 At[4][2], B0[2][2], B1[2][2];
    const char* cA = (const char*)g.A + (size_t)cur.zb * g.zA + (size_t)cur.pm * tstepA; const char* cB = (const char*)g.Bt + (size_t)cur.zb * g.zB + (size_t)cur.pn * tstepB;
    S.a_ready(cur);
    if constexpr (SP2) {
        PG8_STAGE(PG8_SB(0, 0), cB, voffB); PG8_STAGE(PG8_SB(0, 1), cB + hstepB, voffB); PG8_STAGE(PG8_SA(0, 0), cA, voffA); PG8_STAGE(PG8_SA(0, 1), cA + hstepA, voffA);
        if (wr == 1) PG8_BAR;
        PG8_WAIT_V(2); PG8_BAR;
        PG8_STAGE(PG8_SB(1, 0), cB + kstep, voffB); PG8_STAGE(PG8_SA(1, 0), cA + kstep, voffA); PG8_STAGE(PG8_SB(1, 1), cB + hstepB + kstep, voffB);
        PG8_WAIT_V(6); PG8_BAR;
    } else {
        PG8_STAGE(PG8_SB(0, 0), cB, voffB); PG8_STAGE(PG8_SA(0, 0), cA, voffA); PG8_STAGE(PG8_SB(0, 1), cB + hstepB, voffB); PG8_STAGE(PG8_SA(0, 1), cA + hstepA, voffA);
        if (wr == 1) PG8_BAR;
        PG8_WAIT_V(4); PG8_BAR;
        PG8_STAGE(PG8_SB(1, 0), cB + kstep, voffB); PG8_STAGE(PG8_SA(1, 0), cA + kstep, voffA); PG8_STAGE(PG8_SB(1, 1), cB + hstepB + kstep, voffB);
        PG8_WAIT_V(6); PG8_BAR;
    }
    for (;;) {
        const bool has_next = S.next(ui + 1, nxt);
        const char* nA = has_next ? (const char*)g.A + (size_t)nxt.zb * g.zA + (size_t)nxt.pm * tstepA : cA; const char* nB = has_next ? (const char*)g.Bt + (size_t)nxt.zb * g.zB + (size_t)nxt.pn * tstepB : cB;
        for (int t = 0; t < nt; t += 2) {
            const bool last = (t == nt - 2);
            const char* a1 = cA + (size_t)(t + 1) * kstep;
            const char* a2 = last ? nA : cA + (size_t)(t + 2) * kstep; const char* b2 = last ? nB : cB + (size_t)(t + 2) * kstep;
            const char* a3 = a2 + kstep; const char* b3 = b2 + kstep;
            if (last && has_next) S.a_ready(nxt);
            if constexpr (SP2) {
            PG8_LDB(B0, 0, 0); PG8_LDB(B1, 0, 1); PG8_SCHED; PG8_LDA(At, 0, 0); PG8_STAGE(PG8_SA(1, 1), a1 + hstepA, voffA);
            PG8_WAIT_V(8); PG8_WAIT_L(0); PG8_BAR; PG8_MMA(0, 0, At, B0); PG8_MMA(0, 1, At, B1); PG8_BAR; PG8_SCHED;
            PG8_LDA(At, 0, 1); PG8_STAGE(PG8_SB(0, 0), b2, voffB); PG8_STAGE(PG8_SB(0, 1), b2 + hstepB, voffB); PG8_STAGE(PG8_SA(0, 0), a2, voffA);
            PG8_WAIT_V(8); PG8_WAIT_L(0); PG8_BAR; PG8_MMA(1, 0, At, B0); PG8_MMA(1, 1, At, B1); PG8_BAR; PG8_SCHED;
            PG8_LDB(B0, 1, 0); PG8_LDB(B1, 1, 1); PG8_SCHED; PG8_LDA(At, 1, 0); PG8_STAGE(PG8_SA(0, 1), a2 + hstepA, voffA);
            PG8_WAIT_V(8); PG8_WAIT_L(0); PG8_BAR; PG8_MMA(0, 0, At, B0); PG8_MMA(0, 1, At, B1); PG8_BAR; PG8_SCHED;
            PG8_LDA(At, 1, 1); PG8_STAGE(PG8_SB(1, 0), b3, voffB); PG8_STAGE(PG8_SB(1, 1), b3 + hstepB, voffB); PG8_STAGE(PG8_SA(1, 0), a3, voffA);
            PG8_WAIT_V(8); PG8_WAIT_L(0); PG8_BAR; PG8_MMA(1, 0, At, B0); PG8_MMA(1, 1, At, B1); PG8_BAR; PG8_SCHED;
            } else {
            PG8_LDB(B0, 0, 0); PG8_SCHED; PG8_LDA(At, 0, 0); PG8_STAGE(PG8_SA(1, 1), a1 + hstepA, voffA);
            PG8_WAIT_L(8); PG8_BAR; PG8_WAIT_L(0); PG8_MMA(0, 0, At, B0); PG8_BAR; PG8_SCHED;
            PG8_LDB(B1, 0, 1); PG8_STAGE(PG8_SB(0, 0), b2, voffB);
            PG8_BAR; PG8_WAIT_L(0); PG8_MMA(0, 1, At, B1); PG8_BAR;
            PG8_LDA(At, 0, 1); PG8_STAGE(PG8_SA(0, 0), a2, voffA);
            PG8_BAR; PG8_WAIT_L(0); PG8_MMA(1, 0, At, B0); PG8_BAR; PG8_SCHED;
            PG8_STAGE(PG8_SB(0, 1), b2 + hstepB, voffB);
            PG8_WAIT_V(6); PG8_BAR; PG8_MMA(1, 1, At, B1); PG8_BAR;
            PG8_LDB(B0, 1, 0); PG8_SCHED; PG8_LDA(At, 1, 0); PG8_STAGE(PG8_SA(0, 1), a2 + hstepA, voffA);
            PG8_WAIT_L(8); PG8_BAR; PG8_WAIT_L(0); PG8_MMA(0, 0, At, B0); PG8_BAR; PG8_SCHED;
            PG8_LDB(B1, 1, 1); PG8_STAGE(PG8_SB(1, 0), b3, voffB);
            PG8_BAR; PG8_WAIT_L(0); PG8_MMA(0, 1, At, B1); PG8_BAR;
            PG8_LDA(At, 1, 1); PG8_STAGE(PG8_SA(1, 0), a3, voffA);
            PG8_BAR; PG8_WAIT_L(0); PG8_MMA(1, 0, At, B0); PG8_BAR; PG8_SCHED;
            PG8_STAGE(PG8_SB(1, 1), b3 + hstepB, voffB);
            PG8_WAIT_V(6); PG8_BAR; PG8_MMA(1, 1, At, B1); PG8_BAR;
            }
        }
        if constexpr (ALIGN_EPI) { if (wr == 0) PG8_BAR; }
        if constexpr (!Epi::AFTER_DRAIN) { E(acc, cur, wr, wc, fr, fq); S.done(cur); }
        if (!has_next) break;
#pragma unroll
        for (int a = 0; a < 2; ++a)
#pragma unroll
            for (int b = 0; b < 2; ++b)
#pragma unroll
                for (int m = 0; m < 4; ++m)
#pragma unroll
                    for (int n = 0; n < 2; ++n) acc[a][b][m][n] = (f32x4){0.f, 0.f, 0.f, 0.f};
        cur = nxt; cA = nA; cB = nB; ++ui;
        if constexpr (ALIGN_EPI) { if (wr == 1) PG8_BAR; }
    }
    PG8_WAIT_V(0);
    if constexpr (!ALIGN_EPI) { if (wr == 0) PG8_BAR; }
    PG8_BAR;
    if constexpr (Epi::AFTER_DRAIN) { E.fused(acc, cur, wr, wc, fr, fq, lds, wid, lane); S.done(cur); }
#undef PG8_SA
#undef PG8_SB
#undef PG8_STAGE
#undef PG8_LDA
#undef PG8_LDB
#undef PG8_MMA
#undef PG8_WAIT_V
#undef PG8_WAIT_L
#undef PG8_BAR
#undef PG8_SCHED
}
}

#include <hip/hip_bf16.h>
#include <cmath>
namespace attn_body {
using bf16=__hip_bfloat16;
using bf16x8=__attribute__((ext_vector_type(8)))short;
using s16x4=__attribute__((ext_vector_type(4)))short;
using f32x16=__attribute__((ext_vector_type(16)))float;
using u32x4=__attribute__((ext_vector_type(4)))unsigned;
constexpr int BATCH=2,NHEAD=16,SEQ=8192,D=64,DM=NHEAD*D;
constexpr int NW=8,QBLK=32,QB=QBLK*NW,KVBLK=64,NQB=SEQ/QB;
constexpr int ATTN_PITCH=DM, ATTN_UNIT_ROWS=QB;
__device__ __forceinline__ int crow(int r,int hi){return (r&3)+8*(r>>2)+4*hi;}
#define SBAR() __builtin_amdgcn_sched_barrier(0)
__device__ __forceinline__ void cmask(f32x16&p0,f32x16&p1,int jb,int qrel,int hi){
  const float NEG=-INFINITY; int kb=64*jb+4*hi;
  #pragma unroll
  for(int r=0;r<16;++r){int kv=kb+(r&3)+8*(r>>2); if(kv>qrel)p0[r]=NEG; if(kv+32>qrel)p1[r]=NEG;}
}

constexpr int NSLOT=3, SLOTB=8192;
constexpr int LDS_K=0, LDS_V=NSLOT*SLOTB, LDS_WS=2*NSLOT*SLOTB, LDS_OST=LDS_WS+NW*64*4, LDS_NB=LDS_OST+NW*4096  , LDS_BYTES=LDS_NB+32768+64;
constexpr float C2=0.125f*1.4426950408889634f;
__device__ __forceinline__ void glds16(const void*gsrc,unsigned lds_dst){unsigned keep;
  asm volatile("s_mov_b32 %0, m0\n\ts_mov_b32 m0, %2\n\ts_nop 0\n\tglobal_load_lds_dwordx4 %1, off\n\ts_mov_b32 m0, %0":"=&s"(keep):"v"(gsrc),"s"(lds_dst):"memory");}
__device__ __forceinline__ float max3f(float a,float b,float c){float r;asm("v_max3_f32 %0, %1, %2, %3":"=v"(r):"v"(a),"v"(b),"v"(c));return r;}
__device__ __forceinline__ float max2f(float a,float b){float r;asm("v_max_f32_e32 %0, %1, %2":"=v"(r):"v"(a),"v"(b));return r;}
__device__ __forceinline__ float fadd_s(float a,float b){float r;asm("v_add_f32_e32 %0, %1, %2":"=v"(r):"v"(a),"v"(b));return r;}
__device__ __forceinline__ float fsub_s(float a,float b){float r;asm("v_sub_f32_e32 %0, %1, %2":"=v"(r):"v"(a),"v"(b));return r;}
typedef float f32x2_t __attribute__((ext_vector_type(2))); typedef __bf16 bf16x2_t __attribute__((ext_vector_type(2)));
__device__ __forceinline__ unsigned cvtpk_s(float lo,float hi){f32x2_t v={lo,hi};bf16x2_t b=__builtin_convertvector(v,bf16x2_t);return __builtin_bit_cast(unsigned,b);}
#define WAIT_BAR(N) asm volatile("s_waitcnt vmcnt(" #N ") lgkmcnt(0)\n\ts_barrier":::"memory")

__device__ __forceinline__ void qkt(f32x16&p0,f32x16&p1,const char*Kslot,const bf16x8*qr,const f32x16&negm,int r32,int hi){
  const char*kb=Kslot+hi*1024+r32*16;
  #pragma unroll
  for(int d0=0;d0<4;++d0){
    const bf16x8 b0=*reinterpret_cast<const bf16x8*>(kb+d0*2048);
    const bf16x8 b1=*reinterpret_cast<const bf16x8*>(kb+d0*2048+512);
    if(d0==0){p0=__builtin_amdgcn_mfma_f32_32x32x16_bf16(b0,qr[0],negm,0,0,0);p1=__builtin_amdgcn_mfma_f32_32x32x16_bf16(b1,qr[0],negm,0,0,0);}
    else{p0=__builtin_amdgcn_mfma_f32_32x32x16_bf16(b0,qr[d0],p0,0,0,0);p1=__builtin_amdgcn_mfma_f32_32x32x16_bf16(b1,qr[d0],p1,0,0,0);}}
}
typedef __attribute__((address_space(3))) const char* lds_cptr;
typedef short v4i16_t __attribute__((ext_vector_type(4)));
__device__ __forceinline__ void kload8(bf16x8*kf,lds_cptr kp){
  kf[0]=*(const __attribute__((address_space(3))) bf16x8*)(kp);      kf[1]=*(const __attribute__((address_space(3))) bf16x8*)(kp+512);
  kf[2]=*(const __attribute__((address_space(3))) bf16x8*)(kp+2048); kf[3]=*(const __attribute__((address_space(3))) bf16x8*)(kp+2560);
  kf[4]=*(const __attribute__((address_space(3))) bf16x8*)(kp+4096); kf[5]=*(const __attribute__((address_space(3))) bf16x8*)(kp+4608);
  kf[6]=*(const __attribute__((address_space(3))) bf16x8*)(kp+6144); kf[7]=*(const __attribute__((address_space(3))) bf16x8*)(kp+6656);
}
__device__ __forceinline__ void kload2(bf16x8*kf,lds_cptr kp,int j){ kf[2*j]=*(const __attribute__((address_space(3))) bf16x8*)(kp+j*2048); kf[2*j+1]=*(const __attribute__((address_space(3))) bf16x8*)(kp+j*2048+512); }
__device__ __forceinline__ s16x4 vtr(lds_cptr p){ return __builtin_bit_cast(s16x4,__builtin_amdgcn_ds_read_tr16_b64_v4i16((__attribute__((address_space(3))) v4i16_t*)p)); }
__device__ __forceinline__ float rowmax(const f32x16&p0,const f32x16&p1){
  float a=max3f(p0[0],p0[1],p1[0]),b=max3f(p0[2],p0[3],p1[1]);a=max3f(a,p1[2],p1[3]);
  #pragma unroll
  for(int r=4;r<16;r+=4){a=max3f(a,p0[r],p0[r+1]);b=max3f(b,p0[r+2],p0[r+3]);a=max3f(a,p1[r],p1[r+1]);b=max3f(b,p1[r+2],p1[r+3]);}
  const float m=max2f(a,b);
  auto rr=__builtin_amdgcn_permlane32_swap(__float_as_uint(m),__float_as_uint(m),false,false);
  return max2f(__uint_as_float(rr[0]),__uint_as_float(rr[1]));
}
__device__ __forceinline__ void pv(f32x16*o,int vb,bf16x8 pa0,bf16x8 pa1,bf16x8 pa2,bf16x8 pa3){
  #pragma unroll
  for(int d0=0;d0<2;++d0){s16x4 lo[4],hi[4];
    #pragma unroll
    for(int ks=0;ks<4;++ks){
      asm volatile("ds_read_b64_tr_b16 %0,%1 offset:%c2":"=&v"(lo[ks]):"v"(vb),"i"(d0*4096+ks*1024):"memory");
      asm volatile("ds_read_b64_tr_b16 %0,%1 offset:%c2":"=&v"(hi[ks]):"v"(vb),"i"(d0*4096+ks*1024+512):"memory");}
    asm volatile("s_waitcnt lgkmcnt(0)":::"memory");SBAR();
    #define PK(k) (bf16x8){lo[k][0],lo[k][1],lo[k][2],lo[k][3],hi[k][0],hi[k][1],hi[k][2],hi[k][3]}
    o[d0]=__builtin_amdgcn_mfma_f32_32x32x16_bf16(pa0,PK(0),o[d0],0,0,0);
    o[d0]=__builtin_amdgcn_mfma_f32_32x32x16_bf16(pa1,PK(1),o[d0],0,0,0);
    o[d0]=__builtin_amdgcn_mfma_f32_32x32x16_bf16(pa2,PK(2),o[d0],0,0,0);
    o[d0]=__builtin_amdgcn_mfma_f32_32x32x16_bf16(pa3,PK(3),o[d0],0,0,0);
    #undef PK
  }
}

typedef float f32x4_t __attribute__((ext_vector_type(4)));
__device__ __forceinline__ void fox_negcum(const float*logf,__attribute__((address_space(3))) float*ncum,__attribute__((address_space(3))) float*wtot,int tid){
  float loc[16];float s=0.f; const f32x4_t*lp=(const f32x4_t*)(logf+tid*16);
  #pragma unroll
  for(int j=0;j<4;++j){const f32x4_t v=lp[j]; s+=v[0];loc[4*j]=s; s+=v[1];loc[4*j+1]=s; s+=v[2];loc[4*j+2]=s; s+=v[3];loc[4*j+3]=s;}
  float inc=s;
  #pragma unroll
  for(int o=1;o<64;o<<=1){const float v=__shfl_up(inc,o); if((tid&63)>=o)inc+=v;}
  if((tid&63)==63)wtot[tid>>6]=inc;
  __syncthreads();
  float base=inc-s; for(int w=0;w<(tid>>6);++w)base+=wtot[w];
  #pragma unroll
  for(int j=0;j<4;++j){ f32x4_t o4; o4[0]=-(base+loc[4*j]);o4[1]=-(base+loc[4*j+1]);o4[2]=-(base+loc[4*j+2]);o4[3]=-(base+loc[4*j+3]); *(__attribute__((address_space(3))) f32x4_t*)(ncum+tid*16+4*j)=o4; }
  __syncthreads();
}
#ifndef ATTN_STORE16
#define ATTN_STORE16(p,v) (*(u32x4*)(p)=(v))
#endif
template<int THRL> __device__ __forceinline__ void attn_unit(int b,int h,int qb,const bf16*Q,const bf16*__restrict__ K,const bf16*__restrict__ V,bf16*O,char*shm,const float*logf_bh){
  int tid_=threadIdx.x; asm volatile("":"+v"(tid_)); const int tid=tid_,lane=tid&63,r32=lane&31,hi=lane>>5; const int wid=__builtin_amdgcn_readfirstlane(tid>>6);
  const long rowbase=(long)b*SEQ; const int q0=qb*QB;
  const bf16*Qw=Q+(rowbase+q0+wid*QBLK)*DM+h*D;
  const bf16*Kh=K+rowbase*DM+h*D,*Vh=V+rowbase*DM+h*D;
  const unsigned lds0=(unsigned)(uintptr_t)shm;
  float*wsf=(float*)(shm+LDS_WS)+wid*64;
  const bf16*ksrc=Kh+(long)lane*DM+wid*8;
  const bf16*vsrc=Vh+(long)(16*(wid&3)+(lane>>2))*DM+(wid>>2)*32+(lane&3)*8;
  const unsigned kdst=lds0+LDS_K+wid*1024, vdst=lds0+LDS_V+wid*1024;
  #define DMA_K(t,slot) glds16(ksrc+(long)(t)*KVBLK*DM,(unsigned)__builtin_amdgcn_readfirstlane(kdst+(slot)))
  #define DMA_V(t,slot) glds16(vsrc+(long)(t)*KVBLK*DM,(unsigned)__builtin_amdgcn_readfirstlane(vdst+(slot)))
  const int vb0=(int)(lds0+LDS_V)+((lane>>4)&1)*32+(lane&3)*8+(4*hi+((lane&15)>>2))*64;
  const char*Kbase=shm+LDS_K; bf16x8 kf[8];
  const lds_cptr shm3=(lds_cptr)shm; const lds_cptr kp0=shm3+LDS_K+hi*1024+r32*16; const lds_cptr vp0=shm3+LDS_V+((lane>>4)&1)*32+(lane&3)*8+(4*hi+((lane&15)>>2))*64;
  const int NT=(q0+QB)/KVBLK;
  const lds_cptr shm3b=(lds_cptr)shm;
  const __attribute__((address_space(3))) float* nb3=(const __attribute__((address_space(3))) float*)(shm3b+LDS_NB);
  fox_negcum(logf_bh,(__attribute__((address_space(3))) float*)(shm3b+LDS_NB),(__attribute__((address_space(3))) float*)(shm3b+LDS_NB+32768),tid);
  #define BIASADD(P0,P1,t) do{ const __attribute__((address_space(3))) f32x4_t* bp_=(const __attribute__((address_space(3))) f32x4_t*)(nb3+(t)*64+4*hi); \
    const f32x4_t nm4_={-mhat,-mhat,-mhat,-mhat}; \
    _Pragma("unroll") for(int g_=0;g_<4;++g_){ const f32x4_t b0_=bp_[2*g_]+nm4_,b1_=bp_[2*g_+8]+nm4_; \
      P0[4*g_]+=b0_[0];P0[4*g_+1]+=b0_[1];P0[4*g_+2]+=b0_[2];P0[4*g_+3]+=b0_[3]; P1[4*g_]+=b1_[0];P1[4*g_+1]+=b1_[1];P1[4*g_+2]+=b1_[2];P1[4*g_+3]+=b1_[3]; } }while(0)
  DMA_K(0,0);DMA_V(0,0);DMA_K(1,SLOTB);
  bf16x8 qr[4];
  #pragma unroll
  for(int d0=0;d0<4;++d0)qr[d0]=*reinterpret_cast<const bf16x8*>(&Qw[(long)r32*DM+d0*16+hi*8]);
  float mhat=0.f,l_reg=0.f;f32x16 o[2];o[0]=f32x16{};o[1]=f32x16{};const f32x16 negm=f32x16{};
  const int qrel=wid*QBLK+r32;
  #define CMASK(P0,P1,t) do{int jb_=(t)-(NT-4); if(jb_>=0)cmask(P0,P1,jb_,qrel,hi);}while(0)
  bool resc=false;
  #define START(P0,P1) do{ const float rm=rowmax(P0,P1); resc=false; \
    { const float dl=rm; mhat=fadd_s(mhat,dl); \
      _Pragma("unroll") for(int r=0;r<16;++r){P0[r]=fsub_s(P0[r],dl);P1[r]=fsub_s(P1[r],dl);} \
      } \
    _Pragma("unroll") for(int r=0;r<16;++r)P0[r]=__builtin_amdgcn_exp2f(P0[r]); }while(0)
  #define RESC() do{ if(resc){ asm volatile("s_waitcnt lgkmcnt(0)":::"memory"); \
      _Pragma("unroll") for(int d_=0;d_<2;++d_) _Pragma("unroll") for(int r=0;r<16;++r)o[d_][r]*=wsf[crow(r,hi)]; } }while(0)
  f32x16 pA0,pA1,pB0,pB1;
  int sl_prev=0,sl_cur=0,sl_next=SLOTB;
  #define ROT() do{sl_prev=sl_cur;sl_cur=sl_next;sl_next=(sl_next==(NSLOT-1)*SLOTB)?0:sl_next+SLOTB;}while(0)
  DMA_K(2,2*SLOTB);
  WAIT_BAR(3);
  qkt(pA0,pA1,Kbase,qr,negm,r32,hi);asm volatile("s_nop 15\n\ts_nop 7":"+v"(pA0),"+v"(pA1));BIASADD(pA0,pA1,0);CMASK(pA0,pA1,0);
  START(pA0,pA1);
  _Pragma("unroll") for(int r=0;r<16;++r)pA1[r]=__builtin_amdgcn_exp2f(pA1[r]);
  WAIT_BAR(0);
  DMA_K(3,0);DMA_V(1,SLOTB);
  ROT();
  kload8(kf,kp0+sl_cur);
  WAIT_BAR(2);
  s16x4 vlo[8],vhi[8]; u32x4 pw0,pw1,pw2,pw3;
  #define PKW(P,B) cvtpk_s(P[B],P[B+1])
  #define PAF(k) __builtin_bit_cast(bf16x8,pw##k)
  #define VFR(i) (bf16x8){vlo[i][0],vlo[i][1],vlo[i][2],vlo[i][3],vhi[i][0],vhi[i][1],vhi[i][2],vhi[i][3]}
  #define PIN(x) asm volatile("":"+v"(x))
  #define MX3(a,b,c) __builtin_fmaxf(__builtin_fmaxf((a),(b)),(c))
  #define GAPA(MF,A0,A1,A2,A3,W0,W1,PW) do{ MF; sacc+=A0; sacc+=A1; sacc+=A2; sacc+=A3; PIN(sacc); W0; W1; PIN(PW); SBAR(); }while(0)
  #define EX(v) __builtin_amdgcn_exp2f(v)
  #define GAPB(MF,X,B) do{ MF; X[B]=EX(X[B]); X[B+1]=EX(X[B+1]); X[B+2]=EX(X[B+2]); X[B+3]=EX(X[B+3]); PIN(X); SBAR(); }while(0)
  #define VRD(i) do{ vlo[i]=vtr(vp_+(((i)>>2)*4096+((i)&3)*1024)); vhi[i]=vtr(vp_+(((i)>>2)*4096+((i)&3)*1024+512)); }while(0)
  #define KRD(G,j) do{ if(G){ kload2(kf,kp0+sl_next,j); SBAR(); } }while(0)
  #define STEP(C0,C1,P0,P1,t,GK,GV,GL) do{ SBAR(); \
    const lds_cptr vp_=vp0+sl_prev; \
    VRD(0); SBAR(); float sacc=(P0[0]+P0[1]); \
    GAPA(C0=__builtin_amdgcn_mfma_f32_32x32x16_bf16(kf[0],qr[0],negm,0,0,0), P0[2],P0[3],P0[4],P0[5],     pw0[0]=PKW(P0,0), pw0[1]=PKW(P0,2), pw0); \
    VRD(4); SBAR(); GAPA(C1=__builtin_amdgcn_mfma_f32_32x32x16_bf16(kf[1],qr[0],negm,0,0,0), P0[6],P0[7],P0[8],P0[9],     pw0[2]=PKW(P0,4), pw0[3]=PKW(P0,6), pw0); \
    VRD(1); SBAR(); GAPA(C0=__builtin_amdgcn_mfma_f32_32x32x16_bf16(kf[2],qr[1],C0,0,0,0),   P0[10],P0[11],P0[12],P0[13], pw1[0]=PKW(P0,8), pw1[1]=PKW(P0,10), pw1); \
    VRD(5); SBAR(); GAPA(C1=__builtin_amdgcn_mfma_f32_32x32x16_bf16(kf[3],qr[1],C1,0,0,0),   P0[14],P0[15],P1[0],P1[1],   pw1[2]=PKW(P0,12),pw1[3]=PKW(P0,14), pw1); \
    VRD(2); SBAR(); GAPA(C0=__builtin_amdgcn_mfma_f32_32x32x16_bf16(kf[4],qr[2],C0,0,0,0),   P1[2],P1[3],P1[4],P1[5],     pw2[0]=PKW(P1,0), pw2[1]=PKW(P1,2), pw2); \
    VRD(6); SBAR(); GAPA(C1=__builtin_amdgcn_mfma_f32_32x32x16_bf16(kf[5],qr[2],C1,0,0,0),   P1[6],P1[7],P1[8],P1[9],     pw2[2]=PKW(P1,4), pw2[3]=PKW(P1,6), pw2); \
    VRD(3); SBAR(); GAPA(C0=__builtin_amdgcn_mfma_f32_32x32x16_bf16(kf[6],qr[3],C0,0,0,0),   P1[10],P1[11],P1[12],P1[13], pw3[0]=PKW(P1,8), pw3[1]=PKW(P1,10), pw3); \
    VRD(7); SBAR(); GAPA(C1=__builtin_amdgcn_mfma_f32_32x32x16_bf16(kf[7],qr[3],C1,0,0,0),   P1[14],P1[15],0.f,0.f,       pw3[2]=PKW(P1,12),pw3[3]=PKW(P1,14), pw3); \
    l_reg+=sacc; \
    if(GK){DMA_K((t)+3,sl_cur);} if(GV){DMA_V((t)+1,sl_next);} \
    BIASADD(C0,C1,t); CMASK(C0,C1,t); \
    { float a=MX3(C0[0],C0[1],C1[0]),b=MX3(C0[2],C0[3],C1[1]); a=MX3(a,C1[2],C1[3]); \
      _Pragma("unroll") for(int r=4;r<16;r+=4){a=MX3(a,C0[r],C0[r+1]);b=MX3(b,C0[r+2],C0[r+3]);a=MX3(a,C1[r],C1[r+1]);b=MX3(b,C1[r+2],C1[r+3]);} \
      float rm=__builtin_fmaxf(a,b); { auto rr=__builtin_amdgcn_permlane32_swap(__float_as_uint(rm),__float_as_uint(rm),false,false); rm=__builtin_fmaxf(__uint_as_float(rr[0]),__uint_as_float(rr[1])); } \
      resc=false; \
      if(__builtin_expect(__any(rm>(float)THRL),0)){ const float dl=__builtin_fmaxf(rm,0.f); mhat+=dl; \
        _Pragma("unroll") for(int r=0;r<16;++r){C0[r]-=dl;C1[r]-=dl;} \
        const float f=__builtin_amdgcn_exp2f(-dl); l_reg*=f; if(hi==0)wsf[r32]=f; resc=true; } } \
    SBAR(); \
    GAPB(o[0]=__builtin_amdgcn_mfma_f32_32x32x16_bf16(PAF(0),VFR(0),o[0],0,0,0), C0,0); \
    GAPB(o[1]=__builtin_amdgcn_mfma_f32_32x32x16_bf16(PAF(0),VFR(4),o[1],0,0,0), C0,4); \
    KRD(GL,0); GAPB(o[0]=__builtin_amdgcn_mfma_f32_32x32x16_bf16(PAF(1),VFR(1),o[0],0,0,0), C0,8); \
    KRD(GL,1); GAPB(o[1]=__builtin_amdgcn_mfma_f32_32x32x16_bf16(PAF(1),VFR(5),o[1],0,0,0), C0,12); \
    KRD(GL,2); GAPB(o[0]=__builtin_amdgcn_mfma_f32_32x32x16_bf16(PAF(2),VFR(2),o[0],0,0,0), C1,0); \
    KRD(GL,3); GAPB(o[1]=__builtin_amdgcn_mfma_f32_32x32x16_bf16(PAF(2),VFR(6),o[1],0,0,0), C1,4); \
    GAPB(o[0]=__builtin_amdgcn_mfma_f32_32x32x16_bf16(PAF(3),VFR(3),o[0],0,0,0), C1,8); \
    GAPB(o[1]=__builtin_amdgcn_mfma_f32_32x32x16_bf16(PAF(3),VFR(7),o[1],0,0,0), C1,12); \
    }while(0)
  int t=1;
  #undef CMASK
  #define CMASK(P0,P1,t) do{}while(0)
  for(;t+5<NT;t+=2){
    STEP(pB0,pB1,pA0,pA1,t,true,true,true);     WAIT_BAR(2); RESC(); ROT();
    STEP(pA0,pA1,pB0,pB1,t+1,true,true,true);   WAIT_BAR(2); RESC(); ROT();
  }
  #undef CMASK
  #define CMASK(P0,P1,t) do{int jb_=(t)-(NT-4); if(jb_>=0)cmask(P0,P1,jb_,qrel,hi);}while(0)
  #define ENDW(tt) do{ if((tt)+3<NT){WAIT_BAR(2);} else if((tt)+2<NT){WAIT_BAR(1);} else {WAIT_BAR(0);} }while(0)
  for(;t+1<NT;t+=2){
    STEP(pB0,pB1,pA0,pA1,t,(t+3<NT),(t+1<NT),(t+1<NT));       ENDW(t);   RESC(); ROT();
    STEP(pA0,pA1,pB0,pB1,t+1,(t+4<NT),(t+2<NT),(t+2<NT));     ENDW(t+1); RESC(); ROT();
  }
  STEP(pB0,pB1,pA0,pA1,NT-1,false,false,false); RESC();
  { float sacc=pB0[0]+pB0[1]; _Pragma("unroll") for(int r=2;r<16;++r)sacc+=pB0[r]; _Pragma("unroll") for(int r=0;r<16;++r)sacc+=pB1[r]; l_reg+=sacc;
    pw0=(u32x4){PKW(pB0,0),PKW(pB0,2),PKW(pB0,4),PKW(pB0,6)};pw1=(u32x4){PKW(pB0,8),PKW(pB0,10),PKW(pB0,12),PKW(pB0,14)};pw2=(u32x4){PKW(pB1,0),PKW(pB1,2),PKW(pB1,4),PKW(pB1,6)};pw3=(u32x4){PKW(pB1,8),PKW(pB1,10),PKW(pB1,12),PKW(pB1,14)};
    SBAR(); pv(o,vb0+sl_cur,PAF(0),PAF(1),PAF(2),PAF(3)); }
  #undef PKW
  #undef PAF
  #undef VFR
  #undef PIN
  #undef MX3
  #undef GAPA
  #undef GAPB
  #undef EX
  #undef VRD
  #undef KRD
  #undef STEP
  #undef ENDW
  {auto rr=__builtin_amdgcn_permlane32_swap(__float_as_uint(l_reg),__float_as_uint(l_reg),false,false);l_reg=__uint_as_float(rr[0])+__uint_as_float(rr[1]);}
  if(hi==0)wsf[32+r32]=l_reg;asm volatile("s_waitcnt lgkmcnt(0)":::"memory");
  float rli[16];
  #pragma unroll
  for(int r=0;r<16;++r)rli[r]=__builtin_amdgcn_rcpf(wsf[32+crow(r,hi)]);
  bf16*Ow=O+(rowbase+q0+wid*QBLK)*DM+h*D;
  { bf16*stg=(bf16*)(shm+LDS_OST)+wid*2048;
    #pragma unroll
    for(int r=0;r<16;++r){const int orow=crow(r,hi);
      #pragma unroll
      for(int d0=0;d0<2;++d0)stg[orow*64+d0*32+r32]=__float2bfloat16(o[d0][r]*rli[r]);}
    asm volatile("s_waitcnt lgkmcnt(0)":::"memory");
    #pragma unroll
    for(int i=0;i<4;++i){const int row=i*8+(lane>>3),ch=lane&7; const u32x4 v=*(const u32x4*)(stg+row*64+ch*8); ATTN_STORE16(Ow+(long)row*DM+ch*8,v);} }
  asm volatile("s_waitcnt lgkmcnt(0)\n\ts_barrier":::"memory");
  #undef BIASADD
  #undef DMA_K
  #undef DMA_V
  #undef CMASK
  #undef START
  #undef RESC
  #undef ROT
}

template<int PITCH> __device__ __forceinline__ void sb_unit(int b,int h,int qb,const bf16*Q,const bf16*__restrict__ K,const bf16*__restrict__ V,bf16*O  ,char*shm){
  int tid_=threadIdx.x; asm volatile("":"+v"(tid_)); const int tid=tid_,lane=tid&63,r32=lane&31,hi=lane>>5; const int wid=__builtin_amdgcn_readfirstlane(tid>>6);
  const long rowbase=(long)b*SEQ; const int q0=qb*QB;
  const bf16*Qw=Q+(rowbase+q0+wid*QBLK)*PITCH+h*D;
  const bf16*Kh=K+rowbase*PITCH+h*D,*Vh=V+rowbase*PITCH+h*D;
  const unsigned lds0=(unsigned)(uintptr_t)shm;
  const bf16*ksrc=Kh+(long)lane*PITCH+wid*8;
  const bf16*vsrc=Vh+(long)(16*(wid&3)+(lane>>2))*PITCH+(wid>>2)*32+(lane&3)*8;
  const unsigned kdst=lds0+LDS_K+wid*1024, vdst=lds0+LDS_V+wid*1024;
  #define SB_DMA(t,slot) do{ glds16(ksrc+(long)(t)*KVBLK*PITCH,(unsigned)__builtin_amdgcn_readfirstlane(kdst+(slot))); glds16(vsrc+(long)(t)*KVBLK*PITCH,(unsigned)__builtin_amdgcn_readfirstlane(vdst+(slot))); }while(0)
  const int vb0=(int)(lds0+LDS_V)+((lane>>4)&1)*32+(lane&3)*8+(4*hi+((lane&15)>>2))*64;
  volatile __attribute__((address_space(3))) unsigned* fl=(volatile __attribute__((address_space(3))) unsigned*)((lds_cptr)shm+LDS_WS);
  const int NT=(q0+QB)/KVBLK; const int qrel=wid*QBLK+r32;
  SB_DMA(NT-1,0);
  bf16x8 qr[4];
  #pragma unroll
  for(int d0=0;d0<4;++d0)qr[d0]=*reinterpret_cast<const bf16x8*>(&Qw[(long)r32*PITCH+d0*16+hi*8]);
  f32x16 o[2];o[0]=f32x16{};o[1]=f32x16{}; const f32x16 zero16=f32x16{};
  float carry=0.f; const float m0=(hi==0)?1.f:0.f;
  int slot=0;
  for(int t=NT-1;t>=0;--t){
    WAIT_BAR(0);
    if(t<NT-1){ const int pb=((t+1)&1)*8; const unsigned a=fl[pb]&fl[pb+1]&fl[pb+2]&fl[pb+3]&fl[pb+4]&fl[pb+5]&fl[pb+6]&fl[pb+7]; if(__builtin_amdgcn_readfirstlane(a)!=0u)break; }
    if(t>0)SB_DMA(t-1,slot^SLOTB);
    f32x16 p0,p1; qkt(p0,p1,shm+LDS_K+slot,qr,zero16,r32,hi);
    if(t>=NT-4){ const int kb=64*(t-(NT-4))+4*hi;
      #pragma unroll
      for(int r=0;r<16;++r){const int kv=kb+(r&3)+8*(r>>2); if(kv>=qrel)p0[r]=-INFINITY; if(kv+32>=qrel)p1[r]=-INFINITY;} }
    f32x16 s0,s1;
    #pragma unroll
    for(int r=0;r<16;++r){ const float z=p0[r]; const float sp=__builtin_fmaxf(z,0.f)+__builtin_amdgcn_logf(1.f+__builtin_amdgcn_exp2f(-__builtin_fabsf(z))); s0[r]=sp; p0[r]=z-sp;
                           const float y=p1[r]; const float sq=__builtin_fmaxf(y,0.f)+__builtin_amdgcn_logf(1.f+__builtin_amdgcn_exp2f(-__builtin_fabsf(y))); s1[r]=sq; p1[r]=y-sq; }
    float lo[8],hv[8];
    #pragma unroll
    for(int i=0;i<8;++i){ const float mine=(i<4)?((s0[4*i]+s0[4*i+1])+(s0[4*i+2]+s0[4*i+3])):((s1[4*i-16]+s1[4*i-15])+(s1[4*i-14]+s1[4*i-13]));
      auto rr=__builtin_amdgcn_permlane32_swap(__float_as_uint(mine),__float_as_uint(mine),false,false); lo[i]=__uint_as_float(rr[0]); hv[i]=__uint_as_float(rr[1]); }
    float sp_=0.f;
    #pragma unroll
    for(int i=7;i>=0;--i){ const float base=carry-(sp_+m0*hv[i]);
      if(i<4){ float a=base; p0[4*i+3]=__builtin_amdgcn_exp2f(p0[4*i+3]+a); a-=s0[4*i+3]; p0[4*i+2]=__builtin_amdgcn_exp2f(p0[4*i+2]+a); a-=s0[4*i+2]; p0[4*i+1]=__builtin_amdgcn_exp2f(p0[4*i+1]+a); a-=s0[4*i+1]; p0[4*i]=__builtin_amdgcn_exp2f(p0[4*i]+a); }
      else   { const int j=4*i-16; float a=base; p1[j+3]=__builtin_amdgcn_exp2f(p1[j+3]+a); a-=s1[j+3]; p1[j+2]=__builtin_amdgcn_exp2f(p1[j+2]+a); a-=s1[j+2]; p1[j+1]=__builtin_amdgcn_exp2f(p1[j+1]+a); a-=s1[j+1]; p1[j]=__builtin_amdgcn_exp2f(p1[j]+a); }
      sp_+=lo[i]+hv[i]; }
    carry-=sp_;
    { u32x4 pw0,pw1,pw2,pw3;
      pw0=(u32x4){cvtpk_s(p0[0],p0[1]),cvtpk_s(p0[2],p0[3]),cvtpk_s(p0[4],p0[5]),cvtpk_s(p0[6],p0[7])}; pw1=(u32x4){cvtpk_s(p0[8],p0[9]),cvtpk_s(p0[10],p0[11]),cvtpk_s(p0[12],p0[13]),cvtpk_s(p0[14],p0[15])};
      pw2=(u32x4){cvtpk_s(p1[0],p1[1]),cvtpk_s(p1[2],p1[3]),cvtpk_s(p1[4],p1[5]),cvtpk_s(p1[6],p1[7])}; pw3=(u32x4){cvtpk_s(p1[8],p1[9]),cvtpk_s(p1[10],p1[11]),cvtpk_s(p1[12],p1[13]),cvtpk_s(p1[14],p1[15])};
      pv(o,vb0+slot,__builtin_bit_cast(bf16x8,pw0),__builtin_bit_cast(bf16x8,pw1),__builtin_bit_cast(bf16x8,pw2),__builtin_bit_cast(bf16x8,pw3)); }
    { const bool done_=__all(carry<-150.f); if(lane==0)fl[(t&1)*8+wid]=done_?1u:0u; }
    slot^=SLOTB;
  }
  asm volatile("s_waitcnt vmcnt(0) lgkmcnt(0)":::"memory");
  bf16*Ow=O+(rowbase+q0+wid*QBLK)*1024+h*D;
  { bf16*stg=(bf16*)(shm+LDS_OST)+wid*2048;
    #pragma unroll
    for(int r=0;r<16;++r){const int orow=crow(r,hi);
      #pragma unroll
      for(int d0=0;d0<2;++d0)stg[orow*64+d0*32+r32]=__float2bfloat16(o[d0][r]);}
    asm volatile("s_waitcnt lgkmcnt(0)":::"memory");
    #pragma unroll
    for(int i=0;i<4;++i){const int row=i*8+(lane>>3),ch=lane&7; const u32x4 v=*(const u32x4*)(stg+row*64+ch*8); ATTN_STORE16(Ow+(long)row*1024+ch*8,v);} }
  asm volatile("s_waitcnt vmcnt(0) lgkmcnt(0)\n\ts_barrier":::"memory");
  #undef SB_DMA
}
constexpr int ATTN_LDS_BYTES=LDS_BYTES;
struct AttnTensors { const bf16* Q; const bf16* K; const bf16* V; bf16* O; const float* logf;   };
struct AttnUnit { int bh; int qb; };
struct StaticOrder {
  int vcu;
  __device__ __forceinline__ explicit StaticOrder(int grid,int block):vcu((block%8)*(grid/8)+block/8){}
  __device__ __forceinline__ bool next(int i,AttnUnit&u)const{ if(i>=4)return false; const int s=vcu&7; u.bh=vcu>>3; u.qb=(i==0)?s:(i==1)?15-s:(i==2)?16+s:31-s; return true; }
  __device__ __forceinline__ void a_ready(const AttnUnit&)const{}
  __device__ __forceinline__ void done(const AttnUnit&)const{}
};
template<class Sched,int THRL=8> __device__ __forceinline__ void attn_phase(char*lds,const AttnTensors&T,const Sched&S){
  AttnUnit u;
  for(int i=0;S.next(i,u);++i){ S.a_ready(u); attn_unit<THRL>(u.bh/NHEAD,u.bh%NHEAD,u.qb,T.Q,T.K,T.V,T.O,lds,T.logf+(size_t)u.bh*SEQ); S.done(u); }
}
#undef SBAR
#undef WAIT_BAR
}
constexpr int NWAVES = 8, NTHREADS = NWAVES * 64;
constexpr int BATCH = 2, SEQ = 8192, D = 1024, M = BATCH * SEQ;
constexpr int S5G = 32, S5H = 16, S5P = 64, S5T = 32  , S5NC = M / S5T  , S5KX = 640  ;
constexpr int SBH = 8, FOXH = 16, HD = 64;
constexpr int EVEN_IN = 2048, ODD_IN = 3088, DFF = 2816, NEXP = 8, DFE = 3584;
constexpr float C2 = 0.125f * 1.4426950408889634f;
constexpr int MOE_CHUNK_PANELS = 68, MOE_MAX_PANELS = 136, MOE_MAX_SLOTS = MOE_MAX_PANELS * 256;

constexpr size_t MiB = 1u << 20;
constexpr size_t WS_CTL = 0, CTL_ZERO_BYTES = 1 * MiB;
constexpr size_t WS_WMOE_GU = 1 * MiB;
constexpr size_t WS_WMOE_D = 113 * MiB;
constexpr size_t WS_WIN0 = 169 * MiB;
constexpr size_t WS_WGLU = 173 * MiB;
constexpr size_t WS_WOUT0 = 174 * MiB;
constexpr size_t WS_WGU0 = 176 * MiB;
constexpr size_t WS_WD0 = 187 * MiB;
constexpr size_t WS_WIN1 = 193 * MiB;
constexpr size_t WS_WF1 = 199 * MiB;
constexpr size_t WS_WOUT1 = 200 * MiB;
constexpr size_t WS_S5WA = 202 * MiB;
constexpr size_t WS_S5WC = 210 * MiB;
constexpr size_t WS_XB = 230 * MiB;
constexpr size_t WS_QKV0 = 262 * MiB;
constexpr size_t WS_UEXT = 310 * MiB;
constexpr size_t WS_SLOC = 330 * MiB;
constexpr size_t WS_YG = 338 * MiB;
constexpr size_t WS_MIXB = 354 * MiB;
constexpr size_t WS_HID0 = 262 * MiB;
constexpr size_t WS_QKV1 = 262 * MiB;
constexpr size_t WS_LOGF = 358 * MiB;
constexpr size_t WS_O1 = 359 * MiB;
constexpr size_t WS_META = 356 * MiB;
constexpr size_t WS_XG = 288 * MiB;
constexpr size_t WS_HMOE = 169 * MiB;
constexpr size_t WS_SSP = 392 * MiB;
constexpr size_t WS_END = 396 * MiB;
static_assert(WS_HMOE + (size_t)MOE_CHUNK_PANELS * 256 * DFE * 2 <= WS_XG && WS_XG + (size_t)MOE_MAX_SLOTS * 1024 * 2 <= WS_META && WS_O1 + (size_t)M * 1024 * 2 <= WS_END, "ws map");
constexpr size_t MT_RSTD = 0, MT_TOKE = 65536, MT_TOKP = 131072, MT_TOKG = 262144, MT_TOKSLOT = 393216, MT_RSS = 524288;
constexpr int CW_TMO = 0, CW_CODE = 1, CW_BAR = 4096, CW_CNT = 8192  , CW_SS = 32768  ;

constexpr int RING_OFF = 0, RING_BYTES = 131072;
constexpr int LDSCTL_OFF = 133120  , MISC_OFF = LDSCTL_OFF + 320;
constexpr int LDS_BYTES = 147456;

#define GAS __attribute__((address_space(1)))
#define LAS __attribute__((address_space(3)))
typedef unsigned short bf16;
typedef unsigned v4u __attribute__((ext_vector_type(4)));
typedef unsigned v2u __attribute__((ext_vector_type(2)));
typedef float f32x4 __attribute__((ext_vector_type(4)));
typedef short bf16x8 __attribute__((ext_vector_type(8)));
typedef GAS unsigned gu32;
#define RLX_AGENT __ATOMIC_RELAXED, __HIP_MEMORY_SCOPE_AGENT
#define LDS_WAIT() asm volatile("s_waitcnt lgkmcnt(0)" ::: "memory")
#define VM_WAIT() asm volatile("s_waitcnt vmcnt(0)" ::: "memory")
__device__ __forceinline__ unsigned f2bf(float f) { unsigned u = __builtin_bit_cast(unsigned, f); return (u + 0x7fffu + ((u >> 16) & 1u)) >> 16; }
__device__ __forceinline__ unsigned pk2(float lo, float hi) { return f2bf(lo) | (f2bf(hi) << 16); }
__device__ __forceinline__ float bflo(unsigned w) { return __uint_as_float(w << 16); }
__device__ __forceinline__ float bfhi(unsigned w) { return __uint_as_float(w & 0xffff0000u); }

#define XB_TMO      128
#define XB_XCNT(j)  (256  + 64 * (j))
#define XB_XSUB(j)  (1280 + 64 * (j))
#define XB_XGEN(j)  (2304 + 64 * (j))
#define XB_TOP      3328
#define XB_TOPGEN   3392
#define XCD_BAR_WORDS 3456
#define XB_SPIN_CAP (1u << 18)
__device__ __forceinline__ unsigned xb_ld(unsigned* p)              { return __hip_atomic_load(p, __ATOMIC_RELAXED, __HIP_MEMORY_SCOPE_AGENT); }
__device__ __forceinline__ unsigned xb_add(unsigned* p, unsigned v) { return __hip_atomic_fetch_add(p, v, __ATOMIC_RELAXED, __HIP_MEMORY_SCOPE_AGENT); }
__device__ __forceinline__ unsigned xb_xcc_id() { return (unsigned)__builtin_amdgcn_s_getreg((3 << 11) | 20) & 0xFu; }
#define XB_SPIN(cond, bar) do { unsigned _sp = 0; while (cond) { __builtin_amdgcn_s_sleep(1); \
    if ((++_sp & 255u) == 0u) { if (xb_ld(&(bar)[XB_TMO])) break; if (_sp > XB_SPIN_CAP) { atomicAdd(&(bar)[XB_TMO], 1u); break; } } } } while (0)
struct XcdBarrier { unsigned* bar; unsigned x; volatile LAS unsigned* st; };
__device__ __forceinline__ XcdBarrier xcd_barrier_post(unsigned* bar, volatile LAS unsigned* st) {
    XcdBarrier b; b.bar = bar; b.x = xb_xcc_id(); b.st = st;
    if (threadIdx.x == 0) (void)xb_add(&bar[XB_XCNT(b.x)], 1u);
    return b;
}
__device__ __forceinline__ void xcd_barrier_complete(unsigned* bar, unsigned x, unsigned& nloc, unsigned& nx) {
    const unsigned G = gridDim.x * gridDim.y * gridDim.z;
    unsigned sum, cnt, mine, sp = 0u;
    for (;;) {
        sum = 0u; cnt = 0u; mine = 0u;
#pragma unroll
        for (unsigned j = 0; j < 16; ++j) { const unsigned c = xb_ld(&bar[XB_XCNT(j)]); sum += c; cnt += (c > 0u) ? 1u : 0u; mine = (j == x) ? c : mine; }
        if (sum == G) break;
        __builtin_amdgcn_s_sleep(1);
        if ((++sp & 255u) == 0u) { if (xb_ld(&bar[XB_TMO])) break; if (sp > XB_SPIN_CAP) { atomicAdd(&bar[XB_TMO], 1u); break; } }
    }
    nloc = mine > 0u ? mine : 1u; nx = cnt > 0u ? cnt : 1u;
}
__device__ __forceinline__ void xcd_barrier(const XcdBarrier& b) {
    asm volatile("s_waitcnt vmcnt(0)" ::: "memory");
    __syncthreads();
    if (threadIdx.x == 0) {
        unsigned* bar = b.bar;
        __builtin_amdgcn_s_waitcnt(0);
        unsigned nloc = b.st[0], nx = b.st[1];
        if (nloc == 0u) { xcd_barrier_complete(bar, b.x, nloc, nx); b.st[0] = nloc; b.st[1] = nx; }
        const unsigned old = xb_add(&bar[XB_XSUB(b.x)], 1u);
        const unsigned gen = old / nloc;
        if (old + 1u == (gen + 1u) * nloc) {
            __builtin_amdgcn_fence(__ATOMIC_RELEASE, "agent");
            asm volatile("s_waitcnt vmcnt(0)" ::: "memory");
            const unsigned og = xb_add(&bar[XB_TOP], 1u);
            const unsigned tg = og / nx;
            if (og + 1u == (tg + 1u) * nx) xb_add(&bar[XB_TOPGEN], 1u);
            else XB_SPIN(xb_ld(&bar[XB_TOPGEN]) == tg, bar);
            __builtin_amdgcn_fence(__ATOMIC_ACQUIRE, "agent");
            xb_add(&bar[XB_XGEN(b.x)], 1u);
            asm volatile("s_waitcnt vmcnt(0)" ::: "memory");
        } else {
            XB_SPIN(xb_ld(&bar[XB_XGEN(b.x)]) == gen, bar);
            __builtin_amdgcn_fence(__ATOMIC_ACQUIRE, "agent");
            asm volatile("s_waitcnt vmcnt(0)" ::: "memory");
        }
    }
    __syncthreads();
}

__device__ __forceinline__ float wave_sum(float v) {
#pragma unroll
    for (int o = 1; o < 64; o <<= 1) v += __shfl_xor(v, o);
    return v;
}
constexpr int XP = 65, XSCR_BYTES = 64 * XP * 4;
__device__ __forceinline__ unsigned cvtpk(float lo, float hi) { unsigned r; asm volatile("v_cvt_pk_bf16_f32 %0, %1, %2" : "=v"(r) : "v"(lo), "v"(hi)); return r; }
__device__ __forceinline__ void p0_transpose_item(const float* W, int ldw, int k0, int n0, const float* gs, bf16* dst, int ldd, LAS float* scr, int lane) {
    const int lr = lane >> 4, lc = (lane & 15) * 4;
    const float* src = W + (size_t)(k0 + lr) * ldw + n0 + lc;
    f32x4 v[16];
#pragma unroll
    for (int i = 0; i < 16; ++i) v[i] = *(const GAS f32x4*)(src + (size_t)(4 * i) * ldw);
    if (gs) {
#pragma unroll
        for (int i = 0; i < 16; ++i) v[i] = v[i] * gs[k0 + 4 * i + lr]; }
#pragma unroll
    for (int i = 0; i < 16; ++i) { LAS float* p = scr + (4 * i + lr) * XP + lc; p[0] = v[i][0]; p[1] = v[i][1]; p[2] = v[i][2]; p[3] = v[i][3]; }
    LDS_WAIT(); asm volatile("" ::: "memory");
    const int c = lane & 7, nn = lane >> 3;
#pragma unroll
    for (int j = 0; j < 8; ++j) { const int n = nn + 8 * j; const LAS float* sp = scr + (8 * c) * XP + n;
        v4u o; o.x = cvtpk(sp[0 * XP], sp[1 * XP]); o.y = cvtpk(sp[2 * XP], sp[3 * XP]); o.z = cvtpk(sp[4 * XP], sp[5 * XP]); o.w = cvtpk(sp[6 * XP], sp[7 * XP]);
        *(GAS v4u*)(dst + (size_t)n * ldd + k0 + 8 * c) = o; }
    LDS_WAIT(); asm volatile("" ::: "memory");
}
__device__ __forceinline__ void xpose_mat(int item, const float* W, int ldw, int N, const float* gs, bf16* dst, int ldd, int mode, LAS float* scr, int lane) {
    const int nblk = N / 64, kb = item / nblk, nb = item % nblk, n0 = 64 * nb;
    const int row = mode == 0 ? n0 : ((n0 >> 7) * 256 + (n0 & 127) + (mode == 2 ? 128 : 0));
    p0_transpose_item(W, ldw, 64 * kb, n0, gs, dst + (size_t)row * ldd, ldd, scr, lane);
}

struct Args { const float* in[28]; float* out; unsigned char* ws; };

__device__ __forceinline__ void s5_tables(const Args& a, int g, int q, LAS unsigned char* lds, int tid) {
    LAS float* POWr = (LAS float*)lds;
    LAS float* POWi = POWr + 33 * 64;
    LAS float* BBr = POWi + 33 * 64;
    LAS float* BBi = BBr + 1024;
    LAS float* CCr = BBi + 1024;
    LAS float* CCi = CCr + 1024;
    LAS float* KT = CCi + 1024;
    LAS float* DD = KT + 2048;
    const float* a_re = a.in[3]; const float* a_im = a.in[4]; const float* b_re = a.in[5]; const float* b_im = a.in[6];
    const float* c_re = a.in[7]; const float* c_im = a.in[8]; const float* dsk = a.in[9]; const float* log_step = a.in[10];
    const float step = expf(log_step[g]);
    __syncthreads();
    for (int e = tid; e < 33 * 64; e += NTHREADS) { const int n = e >> 6, p = e & 63; const float lr = a_re[g * 64 + p], li = a_im[g * 64 + p];
        const float mag = expf((float)n * step * lr); float sn, cs; sincosf((float)n * (step * li), &sn, &cs); POWr[e] = mag * cs; POWi[e] = mag * sn; }
    for (int e = tid; e < 1024; e += NTHREADS) { const int p = e >> 4, h = e & 15; const float lr = a_re[g * 64 + p], li = a_im[g * 64 + p];
        const float er = expf(lr * step); float sn, cs; sincosf(li * step, &sn, &cs); const float nr = er * cs - 1.f, ni = er * sn, den = lr * lr + li * li;
        const float fr = (nr * lr + ni * li) / den, fi = (ni * lr - nr * li) / den;
        const float br = b_re[(g * 64 + p) * 16 + h], bi = b_im[(g * 64 + p) * 16 + h];
        BBr[e] = fr * br - fi * bi; BBi[e] = fr * bi + fi * br;
        CCr[e] = c_re[g * 1024 + e]; CCi[e] = c_im[g * 1024 + e]; }
    if (tid < 16) DD[tid] = dsk[g * 16 + tid];
    __syncthreads();
    for (int e = tid; e < 2048; e += NTHREADS) { const int tau = e >> 6, hl = (e >> 4) & 3, hi = e & 15, ho = 4 * q + hl; float sacc = 0.f;
        for (int p = 0; p < 64; ++p) { const float cr = CCr[ho * 64 + p], ci = CCi[ho * 64 + p], pr = POWr[tau * 64 + p], pi = POWi[tau * 64 + p];
            const float xr = cr * pr - ci * pi, xi = cr * pi + ci * pr; sacc += xr * BBr[p * 16 + hi] - xi * BBi[p * 16 + hi]; }
        if (tau == 0 && ho == hi) sacc += DD[ho];
        KT[e] = sacc; }
    __syncthreads();
    bf16* WA = (bf16*)(a.ws + WS_S5WA) + (size_t)g * 256 * 512;
    for (int pc = tid; pc < 64 * 64; pc += NTHREADS) { const int p = pc >> 6, k0 = (pc & 63) * 8; v4u o = (v4u){0u, 0u, 0u, 0u};
        if (q < 2) { const int j = k0 >> 4, h0 = k0 & 15; const float pr = POWr[(31 - j) * 64 + p], pi = POWi[(31 - j) * 64 + p]; float v[8];
#pragma unroll
            for (int w = 0; w < 8; ++w) { const float br = BBr[p * 16 + h0 + w], bi = BBi[p * 16 + h0 + w]; v[w] = (q == 0) ? (pr * br - pi * bi) : (pr * bi + pi * br); }
            o.x = cvtpk(v[0], v[1]); o.y = cvtpk(v[2], v[3]); o.z = cvtpk(v[4], v[5]); o.w = cvtpk(v[6], v[7]); }
        *(GAS v4u*)(WA + (size_t)(64 * q + p) * 512 + k0) = o; }
    bf16* WC = (bf16*)(a.ws + WS_S5WC) + (size_t)g * 512 * 640;
    for (int pc = tid; pc < 128 * 80; pc += NTHREADS) { const int rl = pc / 80, k0 = (pc % 80) * 8, i = rl >> 2, hl = rl & 3, ho = 4 * q + hl; float v[8];
        if (k0 < 512) { const int j = k0 >> 4, h0 = k0 & 15;
#pragma unroll
            for (int w = 0; w < 8; ++w) v[w] = (j <= i) ? KT[((i - j) * 4 + hl) * 16 + h0 + w] : 0.f; }
        else { const int p0 = (k0 - 512) & 63; const bool im = k0 >= 576;
#pragma unroll
            for (int w = 0; w < 8; ++w) { const int p = p0 + w; const float cr = CCr[ho * 64 + p], ci = CCi[ho * 64 + p], pr = POWr[(i + 1) * 64 + p], pi = POWi[(i + 1) * 64 + p];
                v[w] = im ? -(cr * pi + ci * pr) : (cr * pr - ci * pi); } }
        v4u o; o.x = cvtpk(v[0], v[1]); o.y = cvtpk(v[2], v[3]); o.z = cvtpk(v[4], v[5]); o.w = cvtpk(v[6], v[7]);
        *(GAS v4u*)(WC + (size_t)(i * 16 + ho) * 640 + k0) = o; }
    __syncthreads();
}

__device__ __forceinline__ void p0_prologue(const Args& a, LAS unsigned char* lds, int tid, int lane, int wave, int vcu, int G) {
    for (int it = vcu; it < 4 * S5G; it += G) s5_tables(a, it >> 2, it & 3, lds, tid);
    LAS float* scr = (LAS float*)(lds + wave * XSCR_BYTES);
    const int gw = vcu * NWAVES + wave, NGW = G * NWAVES;
    constexpr int I_IN0 = 16 * 32, I_GLU = 8 * 8, I_OUT = 16 * 16, I_GU0 = 16 * 44, I_D0 = 44 * 16, I_IN1 = 16 * 48, I_MOE = 896;
    constexpr int NITEMS = I_IN0 + I_GLU + I_OUT + 2 * I_GU0 + I_D0 + I_IN1 + I_OUT + 24 * I_MOE;
    unsigned char* ws = a.ws;
    for (int it = NITEMS - 1 - gw; it >= 0; it -= NGW) {
        int r = it;
        if (r < I_IN0) { xpose_mat(r, a.in[2], EVEN_IN, EVEN_IN, a.in[1], (bf16*)(ws + WS_WIN0), D, 0, scr, lane); continue; } r -= I_IN0;
        if (r < I_GLU) { xpose_mat(r, a.in[11], 512, 512, nullptr, (bf16*)(ws + WS_WGLU), 512, 0, scr, lane); continue; } r -= I_GLU;
        if (r < I_OUT) { xpose_mat(r, a.in[13], D, D, nullptr, (bf16*)(ws + WS_WOUT0), D, 0, scr, lane); continue; } r -= I_OUT;
        if (r < I_GU0) { xpose_mat(r, a.in[15], DFF, DFF, a.in[14], (bf16*)(ws + WS_WGU0), D, 1, scr, lane); continue; } r -= I_GU0;
        if (r < I_GU0) { xpose_mat(r, a.in[16], DFF, DFF, a.in[14], (bf16*)(ws + WS_WGU0), D, 2, scr, lane); continue; } r -= I_GU0;
        if (r < I_D0) { xpose_mat(r, a.in[17], D, D, nullptr, (bf16*)(ws + WS_WD0), DFF, 0, scr, lane); continue; } r -= I_D0;
        if (r < I_IN1) { xpose_mat(r, a.in[19], ODD_IN, 3072, a.in[18], (bf16*)(ws + WS_WIN1), D, 0, scr, lane); continue; } r -= I_IN1;
        if (r < I_OUT) { xpose_mat(r, a.in[21], D, D, nullptr, (bf16*)(ws + WS_WOUT1), D, 0, scr, lane); continue; } r -= I_OUT;
        const int mat = r / I_MOE, e = mat / 3, which = mat % 3; r -= mat * I_MOE;
        if (which == 0) xpose_mat(r, a.in[24] + (size_t)e * D * DFE, DFE, DFE, a.in[22], (bf16*)(ws + WS_WMOE_GU) + (size_t)e * 7168 * 1024, D, 1, scr, lane);
        else if (which == 1) xpose_mat(r, a.in[25] + (size_t)e * D * DFE, DFE, DFE, a.in[22], (bf16*)(ws + WS_WMOE_GU) + (size_t)e * 7168 * 1024, D, 2, scr, lane);
        else xpose_mat(r, a.in[26] + (size_t)e * DFE * D, D, D, nullptr, (bf16*)(ws + WS_WMOE_D) + (size_t)e * 1024 * 3584, DFE, 0, scr, lane);
    }
    { const int gt = vcu * NTHREADS + tid; if (gt < 16 * 1024) { const int h = gt >> 10, k = gt & 1023; ((bf16*)(ws + WS_WF1))[gt] = (bf16)f2bf(a.in[19][(size_t)k * ODD_IN + 3072 + h] * a.in[18][k]); } }
    float* ss0 = (float*)(ws + WS_SSP);
    for (int m = gw; m < M; m += NGW) {
        const GAS f32x4* xr = (const GAS f32x4*)(a.in[0] + (size_t)m * D) + lane; GAS v2u* o8 = (GAS v2u*)((bf16*)(ws + WS_XB) + (size_t)m * D) + lane; float s = 0.f;
#pragma unroll
        for (int j = 0; j < 4; ++j) { const f32x4 v = xr[64 * j]; s += (v.x * v.x + v.y * v.y) + (v.z * v.z + v.w * v.w); v2u w; w.x = pk2(v.x, v.y); w.y = pk2(v.z, v.w); o8[64 * j] = w; }
        s = wave_sum(s); if (lane < 16) ss0[(size_t)m * 16 + lane] = (lane == 0) ? s : 0.f;
    }
}

__device__ __forceinline__ void s5_scan(const Args& a, int gt  ) {
    if (gt >= BATCH * S5G * S5P) return;
    const int b = gt / (S5G * S5P), g = (gt / S5P) % S5G, p = gt % S5P;
    const float step = expf(a.in[10][g]); const float lr = a.in[3][g * 64 + p], li = a.in[4][g * 64 + p];
    const float mag = expf((float)S5T * step * lr); float sn, cs; sincosf((float)S5T * (step * li), &sn, &cs); const float ar = mag * cs, ai = mag * sn;
    const float* sl = (const float*)(a.ws + WS_SLOC) + ((size_t)g * S5NC + b * 256) * 128 + p;
    bf16* ue = (bf16*)(a.ws + WS_UEXT) + ((size_t)g * S5NC + b * 256) * S5KX + 512 + p;
    float sr = 0.f, si = 0.f;
#pragma unroll 8
    for (int c = 0; c < 256; ++c) {
        ue[(size_t)c * S5KX] = (bf16)f2bf(sr); ue[(size_t)c * S5KX + 64] = (bf16)f2bf(si);
        const float lr_ = sl[(size_t)c * 128], li_ = sl[(size_t)c * 128 + 64];
        const float nr = ar * sr - ai * si + lr_, ni = ar * si + ai * sr + li_; sr = nr; si = ni;
    }
}

__device__ __forceinline__ float softplus2(float z) { return fmaxf(z, 0.f) + __builtin_amdgcn_logf(1.0f + __builtin_amdgcn_exp2f(-fabsf(z))); }
__device__ __forceinline__ void stage_kv32(const bf16* kp, const bf16* vp, size_t pitch, LAS float* sK, LAS float* sV, int tid) {
    const int r = tid >> 4, c = (tid & 15) * 4;
    const v2u kw = *(const v2u*)(kp + (size_t)r * pitch + c), vw = *(const v2u*)(vp + (size_t)r * pitch + c);
    *(LAS f32x4*)(sK + r * 64 + c) = (f32x4){bflo(kw.x), bfhi(kw.x), bflo(kw.y), bfhi(kw.y)};
    *(LAS f32x4*)(sV + r * 64 + c) = (f32x4){bflo(vw.x), bfhi(vw.x), bflo(vw.y), bfhi(vw.y)};
}
__device__ __forceinline__ void sb_simple_unit(const bf16* qkv  , bf16* mix  , int b, int h, int blk, LAS unsigned char* lds, int tid) {
    const int lane = tid & 63, wave_ = tid >> 6;
    LAS float* sK = (LAS float*)lds; LAS float* sV = sK + 32 * 64;
    const int t = blk * 512 + tid; const size_t rb = (size_t)b * SEQ;
    float q[HD], acc[HD];
    { const v4u* qp = (const v4u*)(qkv + (rb + t) * 1536 + h * HD);
#pragma unroll
      for (int i = 0; i < 8; ++i) { const v4u w = qp[i]; q[8 * i] = bflo(w.x); q[8 * i + 1] = bfhi(w.x); q[8 * i + 2] = bflo(w.y); q[8 * i + 3] = bfhi(w.y); q[8 * i + 4] = bflo(w.z); q[8 * i + 5] = bfhi(w.z); q[8 * i + 6] = bflo(w.w); q[8 * i + 7] = bfhi(w.w); }
#pragma unroll
      for (int i = 0; i < HD; ++i) acc[i] = 0.f; }
    float carry = 0.f;
    for (int c0 = blk * 512 + 480; c0 >= 0; c0 -= 32) {
        __syncthreads();
        stage_kv32(qkv + (rb + c0) * 1536 + 512 + h * HD, qkv + (rb + c0) * 1536 + 1024 + h * HD, 1536, sK, sV, tid);
        __syncthreads();
        for (int r = 31; r >= 0; --r) { const int s = c0 + r;
            if (s < t) { float z = 0.f;
#pragma unroll
                for (int i = 0; i < HD; ++i) z = fmaf(q[i], sK[r * 64 + i], z);
                const float sp = softplus2(z); const float w = __builtin_amdgcn_exp2f(z - sp + carry); carry -= sp;
#pragma unroll
                for (int i = 0; i < HD; ++i) acc[i] = fmaf(w, sV[r * 64 + i], acc[i]); } }
        { LAS unsigned* fl = (LAS unsigned*)(lds + 16384); if (lane == 0) fl[wave_] = __all(carry < -150.f) ? 1u : 0u; __syncthreads();
          if ((fl[0] & fl[1] & fl[2] & fl[3] & fl[4] & fl[5] & fl[6] & fl[7]) != 0u) break; }
    }
    v4u* op = (v4u*)(mix + (rb + t) * 1024 + 512 + h * HD);
#pragma unroll
    for (int i = 0; i < 8; ++i) { v4u w; w.x = pk2(acc[8 * i], acc[8 * i + 1]); w.y = pk2(acc[8 * i + 2], acc[8 * i + 3]); w.z = pk2(acc[8 * i + 4], acc[8 * i + 5]); w.w = pk2(acc[8 * i + 6], acc[8 * i + 7]); op[i] = w; }
}
__device__ __forceinline__ void fgate_rows16(const bf16* xb, const bf16* wf, const float* ss, const float* bfv, float* logf, int r0, int lane) {
    const int fr = lane & 15, fq = lane >> 4;
    const bf16x8* ap = (const bf16x8*)(xb + (size_t)(r0 + fr) * D + fq * 8);
    const bf16x8* bp = (const bf16x8*)(wf + (size_t)fr * D + fq * 8);
    f32x4 acc = (f32x4){0.f, 0.f, 0.f, 0.f};
#pragma unroll 8
    for (int kk = 0; kk < 32; ++kk) acc = __builtin_amdgcn_mfma_f32_16x16x32_bf16(ap[kk * 4], bp[kk * 4], acc, 0, 0, 0);
    const float bias = bfv[fr];
#pragma unroll
    for (int j = 0; j < 4; ++j) { const int row = r0 + fq * 4 + j; const float rs = pg8::rstd16(ss, row);
        const float z = acc[j] * rs + bias;
        const float lf = -(fmaxf(-z, 0.f) + log1pf(expf(-fabsf(z)))) * 1.4426950408889634f;
        const int b = row >> 13, t = row & 8191; logf[((size_t)b * FOXH + fr) * SEQ + t] = lf; }
}

struct MoeOrder {
    pg8::StaticOrder S; int lo; int pref[NEXP + 1];
    __device__ __forceinline__ bool next(int i, pg8::Unit& u) const {
        if (!S.next(i, u)) return false;
        u.pm += lo; int e = 0;
#pragma unroll
        for (int k = 1; k < NEXP; ++k) e += (u.pm >= pref[k]) ? 1 : 0;
        u.zb = e; return true;
    }
    __device__ __forceinline__ void a_ready(const pg8::Unit&) const {}
    __device__ __forceinline__ void done(const pg8::Unit&) const {}
};

__global__ void __launch_bounds__(NTHREADS, 2) mk_fwd(Args args) {
    extern __shared__ __attribute__((aligned(16))) unsigned char lds_raw[];
    LAS unsigned char* lds = (LAS unsigned char*)lds_raw;
    volatile LAS unsigned* MISC = (volatile LAS unsigned*)(lds + MISC_OFF);
    const int tid = threadIdx.x, lane = tid & 63, wave = __builtin_amdgcn_readfirstlane(tid >> 6);
    const int G = gridDim.x; const int bx = blockIdx.x; const int vcu = (G % 8 == 0) ? (bx % 8) * (G / 8) + bx / 8 : bx;
    unsigned char* ws = args.ws;
    gu32* ctl = (gu32*)(ws + WS_CTL);
    for (int u = tid; u < (LDS_BYTES - LDSCTL_OFF) / 4; u += NTHREADS) ((LAS unsigned*)(lds + LDSCTL_OFF))[u] = 0u;
    __syncthreads();
    XcdBarrier bar = xcd_barrier_post((unsigned*)(ctl + CW_BAR), MISC + 8);
    const int gw = vcu * NWAVES + wave, NGW = G * NWAVES;
    float* SS = (float*)(ws + WS_SSP);
    float* X = args.out;
    bf16* XB = (bf16*)(ws + WS_XB);
#define GRID_BAR() xcd_barrier(bar)
#define GEMM_PHASE(EPI, SCHED, lds_, g_, S_, E_) pg8::gemm_phase<EPI, SCHED, true, true>(lds_, g_, S_, E_)

    p0_prologue(args, lds, tid, lane, wave, vcu, G);
    GRID_BAR();
    { pg8::Gemm g{XB, (const bf16*)(ws + WS_WIN0), D, D, D, 0, 0}; pg8::StaticOrder S; S.init(M, EVEN_IN, 1, G, bx);
      pg8::EpiInProj0 E{SS, (bf16*)(ws + WS_UEXT), (bf16*)(ws + WS_QKV0), C2};
      GEMM_PHASE(pg8::EpiInProj0, pg8::StaticOrder, lds + RING_OFF, g, S, E); }
    GRID_BAR();
    { pg8::Gemm g{(const bf16*)(ws + WS_UEXT), (const bf16*)(ws + WS_S5WA), S5KX, 512, 512, (size_t)S5NC * S5KX * 2, (size_t)256 * 512 * 2}; pg8::StaticOrder S; S.init(S5NC, 256, S5G, G, bx);
      pg8::EpiS5State E{(float*)(ws + WS_SLOC)};
      GEMM_PHASE(pg8::EpiS5State, pg8::StaticOrder, lds + RING_OFF, g, S, E); }
    GRID_BAR();
    s5_scan(args, vcu * NTHREADS + tid);
    GRID_BAR();
    { pg8::Gemm g{(const bf16*)(ws + WS_UEXT), (const bf16*)(ws + WS_S5WC), S5KX, S5KX, S5KX, (size_t)S5NC * S5KX * 2, (size_t)512 * S5KX * 2}; pg8::StaticOrder S; S.init(S5NC, 512, S5G, G, bx);
      pg8::EpiS5Y E{(bf16*)(ws + WS_YG)};
      GEMM_PHASE(pg8::EpiS5Y, pg8::StaticOrder, lds + RING_OFF, g, S, E); }
    GRID_BAR();
    { pg8::Gemm g{(const bf16*)(ws + WS_YG), (const bf16*)(ws + WS_WGLU), 512, 512, 512, 0, 0}; pg8::StaticOrder S; S.init(M, 512, 1, G, bx);
      pg8::EpiGlu E{(const bf16*)(ws + WS_YG), args.in[12], (bf16*)(ws + WS_MIXB)};
      GEMM_PHASE(pg8::EpiGlu, pg8::StaticOrder, lds + RING_OFF, g, S, E); }
    __syncthreads();
    for (int L = vcu; L < BATCH * SBH * 32; L += G) { const int bh = L >> 5, qb = (L & 256) ? (L & 31) : 31 - (L & 31);
        attn_body::sb_unit<1536>(bh >> 3, bh & 7, qb, (const attn_body::bf16*)(ws + WS_QKV0), (const attn_body::bf16*)(ws + WS_QKV0) + 512, (const attn_body::bf16*)(ws + WS_QKV0) + 1024, (attn_body::bf16*)(ws + WS_MIXB) + 512, (char*)lds_raw + RING_OFF); }
    GRID_BAR();
    { pg8::Gemm g{(const bf16*)(ws + WS_MIXB), (const bf16*)(ws + WS_WOUT0), D, D, D, 0, 0}; pg8::StaticOrder S; S.init(M, D, 1, G, bx);
      pg8::EpiResid E{args.in[0], X, XB, SS + 16 * M};
      GEMM_PHASE(pg8::EpiResid, pg8::StaticOrder, lds + RING_OFF, g, S, E); }
    GRID_BAR();
    { pg8::Gemm g{XB, (const bf16*)(ws + WS_WGU0), D, D, D, 0, 0}; pg8::StaticOrder S; S.init(M, 2 * DFF, 1, G, bx);
      pg8::EpiSwiGlu<true> E{SS + 16 * M, (bf16*)(ws + WS_HID0), DFF};
      GEMM_PHASE(pg8::EpiSwiGlu<true>, pg8::StaticOrder, lds + RING_OFF, g, S, E); }
    GRID_BAR();
    { pg8::Gemm g{(const bf16*)(ws + WS_HID0), (const bf16*)(ws + WS_WD0), DFF, DFF, DFF, 0, 0}; pg8::StaticOrder S; S.init(M, D, 1, G, bx);
      pg8::EpiResid E{X, X, XB, SS + 32 * M};
      GEMM_PHASE(pg8::EpiResid, pg8::StaticOrder, lds + RING_OFF, g, S, E); }
    GRID_BAR();
    { pg8::Gemm g{XB, (const bf16*)(ws + WS_WIN1), D, D, D, 0, 0}; pg8::StaticOrder S; S.init(M, 3072, 1, G, bx);
      pg8::EpiInProj1 E{SS + 32 * M, (bf16*)(ws + WS_QKV1), C2};
      GEMM_PHASE(pg8::EpiInProj1, pg8::StaticOrder, lds + RING_OFF, g, S, E); }
    for (int r = gw; r < M / 16; r += NGW) fgate_rows16(XB, (const bf16*)(ws + WS_WF1), SS + 32 * M, args.in[20], (float*)(ws + WS_LOGF), r * 16, lane);
    GRID_BAR();
    { const attn_body::AttnTensors AT{(const attn_body::bf16*)(ws + WS_QKV1), (const attn_body::bf16*)(ws + WS_QKV1 + 32 * MiB), (const attn_body::bf16*)(ws + WS_QKV1 + 64 * MiB), (attn_body::bf16*)(ws + WS_QKV1), (const float*)(ws + WS_LOGF)};
      if (bx < 256) { const attn_body::StaticOrder S(256, bx); attn_body::attn_phase<attn_body::StaticOrder>((char*)lds_raw + RING_OFF, AT, S); } }
    GRID_BAR();
    { pg8::Gemm g{(const bf16*)(ws + WS_QKV1), (const bf16*)(ws + WS_WOUT1), D, D, D, 0, 0}; pg8::StaticOrder S; S.init(M, D, 1, G, bx);
      pg8::EpiResid E{X, X, XB, SS + 48 * M};
      GEMM_PHASE(pg8::EpiResid, pg8::StaticOrder, lds + RING_OFF, g, S, E); }
    GRID_BAR();
    unsigned char* meta = ws + WS_META;
    {
        const float* wr = args.in[23]; const float* gn = args.in[22];
        for (int tok = gw; tok < M; tok += NGW) {
            const GAS f32x4* xr = (const GAS f32x4*)(X + (size_t)tok * D) + lane; float lg[NEXP]; float s = 0.f;
#pragma unroll
            for (int e = 0; e < NEXP; ++e) lg[e] = 0.f;
#pragma unroll
            for (int j = 0; j < 4; ++j) { const f32x4 v = xr[64 * j]; s += (v.x * v.x + v.y * v.y) + (v.z * v.z + v.w * v.w); const int k0 = 4 * lane + 256 * j; const f32x4 gv = *(const f32x4*)(gn + k0);
#pragma unroll
                for (int q = 0; q < 4; ++q) { const float xv = v[q] * gv[q]; const f32x4 w0 = *(const f32x4*)(wr + (size_t)(k0 + q) * NEXP), w1 = *(const f32x4*)(wr + (size_t)(k0 + q) * NEXP + 4);
                    lg[0] = fmaf(xv, w0.x, lg[0]); lg[1] = fmaf(xv, w0.y, lg[1]); lg[2] = fmaf(xv, w0.z, lg[2]); lg[3] = fmaf(xv, w0.w, lg[3]);
                    lg[4] = fmaf(xv, w1.x, lg[4]); lg[5] = fmaf(xv, w1.y, lg[5]); lg[6] = fmaf(xv, w1.z, lg[6]); lg[7] = fmaf(xv, w1.w, lg[7]); } }
            s = wave_sum(s);
#pragma unroll
            for (int e = 0; e < NEXP; ++e) lg[e] = wave_sum(lg[e]);
            if (lane == 0) {
                const float rs = 1.0f / sqrtf(s * (1.0f / 1024.0f) + pg8::RMS_EPS);
                int i1 = 0; float v1 = lg[0];
#pragma unroll
                for (int e = 1; e < NEXP; ++e) if (lg[e] > v1) { v1 = lg[e]; i1 = e; }
                int i2 = -1; float v2 = -INFINITY;
#pragma unroll
                for (int e = 0; e < NEXP; ++e) if (e != i1 && lg[e] > v2) { v2 = lg[e]; i2 = e; }
                const float g1 = 1.f / (1.f + expf((v2 - v1) * rs)), g2 = 1.f - g1;
                const unsigned p1 = __hip_atomic_fetch_add(ctl + CW_CNT + 64 * i1, 1u, RLX_AGENT), p2 = __hip_atomic_fetch_add(ctl + CW_CNT + 64 * i2, 1u, RLX_AGENT);
                ((float*)(meta + MT_RSTD))[tok] = rs; ((unsigned*)(meta + MT_TOKE))[tok] = (unsigned)i1 | ((unsigned)i2 << 8);
                ((unsigned*)(meta + MT_TOKP))[2 * tok] = p1; ((unsigned*)(meta + MT_TOKP))[2 * tok + 1] = p2;
                ((float*)(meta + MT_TOKG))[2 * tok] = g1; ((float*)(meta + MT_TOKG))[2 * tok + 1] = g2;
            }
        }
    }
    GRID_BAR();
    int pref[NEXP + 1], cnt[NEXP];
    { pref[0] = 0;
#pragma unroll
      for (int e = 0; e < NEXP; ++e) { cnt[e] = (int)__builtin_amdgcn_readfirstlane(__hip_atomic_load(ctl + CW_CNT + 64 * e, RLX_AGENT)); pref[e + 1] = pref[e] + (cnt[e] + 255) / 256; } }
    const int NP = pref[NEXP];
    bf16* XG = (bf16*)(ws + WS_XG); float* RSS = (float*)(meta + MT_RSS);
    {
        for (int tok = gw; tok < M; tok += NGW) {
            const unsigned ee = ((const unsigned*)(meta + MT_TOKE))[tok]; const float rs = ((const float*)(meta + MT_RSTD))[tok];
            const v4u r0 = *(const v4u*)(XB + (size_t)tok * D + lane * 8), r1 = *(const v4u*)(XB + (size_t)tok * D + 512 + lane * 8);
#pragma unroll
            for (int k = 0; k < 2; ++k) { const int e = (ee >> (8 * k)) & 0xff; int pe = 0;
#pragma unroll
                for (int q = 0; q < NEXP; ++q) pe = (q == e) ? pref[q] : pe;
                const int slot = pe * 256 + (int)((const unsigned*)(meta + MT_TOKP))[2 * tok + k];
                *(v4u*)(XG + (size_t)slot * D + lane * 8) = r0; *(v4u*)(XG + (size_t)slot * D + 512 + lane * 8) = r1;
                if (lane == 0) { RSS[slot] = rs; ((unsigned*)(meta + MT_TOKSLOT))[2 * tok + k] = (unsigned)slot; } }
        }
#pragma unroll
        for (int e = 0; e < NEXP; ++e) for (int r = pref[e] * 256 + cnt[e] + gw; r < pref[e + 1] * 256; r += NGW) {
            *(v4u*)(XG + (size_t)r * D + lane * 8) = (v4u){0u, 0u, 0u, 0u}; *(v4u*)(XG + (size_t)r * D + 512 + lane * 8) = (v4u){0u, 0u, 0u, 0u}; if (lane == 0) RSS[r] = 0.f; }
    }
    GRID_BAR();
#pragma unroll
    for (int ch = 0; ch < 2; ++ch) {
        const int lo = ch * MOE_CHUNK_PANELS, hi = NP < (ch + 1) * MOE_CHUNK_PANELS ? NP : (ch + 1) * MOE_CHUNK_PANELS, np = hi > lo ? hi - lo : 0;
        bf16* Hc = (bf16*)(ws + WS_HMOE) - (size_t)lo * 256 * DFE;
        { pg8::Gemm g{XG, (const bf16*)(ws + WS_WMOE_GU), D, D, D, 0, (size_t)7168 * 1024 * 2}; MoeOrder S; S.S.nM = np; S.S.nN = 28; S.S.nZ = 1; S.S.nwg = np * 28; S.S.G = G; S.S.c = bx; S.lo = lo;
#pragma unroll
          for (int e = 0; e <= NEXP; ++e) S.pref[e] = pref[e];
          pg8::EpiSwiGlu<false> E{RSS, Hc, DFE};
          GEMM_PHASE(pg8::EpiSwiGlu<false>, MoeOrder, lds + RING_OFF, g, S, E); }
        GRID_BAR();
        { pg8::Gemm g{Hc, (const bf16*)(ws + WS_WMOE_D), DFE, DFE, DFE, 0, (size_t)1024 * 3584 * 2}; MoeOrder S; S.S.nM = np; S.S.nN = 4; S.S.nZ = 1; S.S.nwg = np * 4; S.S.G = G; S.S.c = bx; S.lo = lo;
#pragma unroll
          for (int e = 0; e <= NEXP; ++e) S.pref[e] = pref[e];
          pg8::EpiStoreBf16 E{XG, D};
          GEMM_PHASE(pg8::EpiStoreBf16, MoeOrder, lds + RING_OFF, g, S, E); }
        GRID_BAR();
    }
    {
        const float* gf = args.in[27];
        for (int tok = gw; tok < M; tok += NGW) {
            const unsigned s0 = ((const unsigned*)(meta + MT_TOKSLOT))[2 * tok], s1 = ((const unsigned*)(meta + MT_TOKSLOT))[2 * tok + 1];
            const float g0 = ((const float*)(meta + MT_TOKG))[2 * tok], g1 = ((const float*)(meta + MT_TOKG))[2 * tok + 1];
            GAS f32x4* xr = (GAS f32x4*)(X + (size_t)tok * D) + lane; f32x4 v[4]; float s = 0.f;
#pragma unroll
            for (int j = 0; j < 4; ++j) { v[j] = xr[64 * j]; const int k0 = 4 * lane + 256 * j;
                const v2u a = *(const v2u*)(XG + (size_t)s0 * D + k0), b2 = *(const v2u*)(XG + (size_t)s1 * D + k0);
                v[j].x += g0 * bflo(a.x) + g1 * bflo(b2.x); v[j].y += g0 * bfhi(a.x) + g1 * bfhi(b2.x); v[j].z += g0 * bflo(a.y) + g1 * bflo(b2.y); v[j].w += g0 * bfhi(a.y) + g1 * bfhi(b2.y);
                s += (v[j].x * v[j].x + v[j].y * v[j].y) + (v[j].z * v[j].z + v[j].w * v[j].w); }
            s = wave_sum(s); const float rs = 1.0f / sqrtf(s * (1.0f / 1024.0f) + pg8::RMS_EPS);
#pragma unroll
            for (int j = 0; j < 4; ++j) { const f32x4 gv = *(const f32x4*)(gf + 4 * lane + 256 * j); xr[64 * j] = v[j] * rs * gv; }
        }
    }
}

extern "C" void kernel_launch(void* const* d_in, const int* in_sizes, int n_in, void* d_out, int out_size, void* d_ws, size_t ws_size, hipStream_t stream) {
    static int grid = 0;
    if (grid == 0) {
        if (n_in != 28 || in_sizes[0] != M * D || out_size != M * D || ws_size < WS_END) { fprintf(stderr, "kernel_launch: unexpected problem: n_in %d in0 %d out %d ws %zu (need %zu)\n", n_in, n_in > 0 ? in_sizes[0] : -1, out_size, ws_size, (size_t)WS_END); grid = -1; return; }
        int dev = 0, cus = 0, per_cu = 0;
        if (hipGetDevice(&dev) != hipSuccess || hipDeviceGetAttribute(&cus, hipDeviceAttributeMultiprocessorCount, dev) != hipSuccess) { grid = -1; return; }
        if (hipFuncSetAttribute((const void*)mk_fwd, hipFuncAttributeMaxDynamicSharedMemorySize, LDS_BYTES) != hipSuccess) { fprintf(stderr, "kernel_launch: hipFuncSetAttribute failed\n"); grid = -1; return; }
        if (hipOccupancyMaxActiveBlocksPerMultiprocessor(&per_cu, (const void*)mk_fwd, NTHREADS, LDS_BYTES) != hipSuccess || per_cu < 1) fprintf(stderr, "kernel_launch: occupancy query says %d\n", per_cu);
        (void)hipGetLastError();
        grid = cus;
        if (grid != 256) fprintf(stderr, "kernel_launch: built for the 256-CU MI355X; device reports %d CUs\n", cus);
    }
    if (grid < 0) return;
    if (hipMemsetAsync((char*)d_ws + WS_CTL, 0, CTL_ZERO_BYTES, stream) != hipSuccess) return;
    Args a{};
    for (int i = 0; i < 28; ++i) a.in[i] = (const float*)d_in[i];
    a.out = (float*)d_out; a.ws = (unsigned char*)d_ws;
    hipLaunchKernelGGL(mk_fwd, dim3(grid), dim3(NTHREADS), LDS_BYTES, stream, a);
}
```

```cpp
#include <hip/hip_runtime.h>
#include <cstdio>
#include <cstdint>

namespace pg8 {
#define PG8_LAS __attribute__((address_space(3)))
typedef unsigned short bf16_t;
typedef short bf16x8 __attribute__((ext_vector_type(8)));
typedef float f32x4 __attribute__((ext_vector_type(4)));
typedef unsigned u32x4 __attribute__((ext_vector_type(4)));
typedef unsigned u32x2 __attribute__((ext_vector_type(2)));
constexpr int BM = 256, BK = 64, HALF = 128, HTB = HALF * BK * 2  , STAGE_BYTES = 8 * HTB, NXCD = 8, WGM = 8;

__host__ __device__ __forceinline__ int lds_byte(int r, int c) { const int st = (r >> 4) * 2 + (c >> 5), rr = r & 15, cc = c & 31, ob = rr * 64 + cc * 2; return st * 1024 + (ob ^ (((ob >> 9) & 1) << 5)); }
__host__ __device__ __forceinline__ void stage_rc(int b, int& R, int& C) { const int st = b / 1024, sb = b % 1024, swz = sb ^ (((sb >> 9) & 1) << 5); R = (st >> 1) * 16 + swz / 64; C = (st & 1) * 32 + (swz % 64) / 2; }
__host__ __device__ __forceinline__ int perm32(int rho) { const int n = rho >> 4, i = rho & 15; return 8 * (i >> 2) + 4 * n + (i & 3); }

struct Unit { int pm, pn, zb; };
struct Gemm { const bf16_t* A; const bf16_t* Bt; int lda, ldb, K; size_t zA, zB; };

struct StaticOrder {
    int nM, nN, nZ, nwg, G, c;
    __host__ __device__ void init(int M, int N, int Z, int G_, int c_) { nM = M / BM; nN = N / BM; nZ = Z; nwg = nM * nN * nZ; G = G_; c = c_; }
    __host__ __device__ bool next(int i, Unit& u) const {
        const long L = (long)i * G + c; if (L >= nwg) return false;
        int wgid = (int)L; { const int q = nwg / NXCD, r = nwg % NXCD, xcd = wgid % NXCD, off = wgid / NXCD; wgid = (xcd < r ? xcd * (q + 1) : r * (q + 1) + (xcd - r) * q) + off; }
        const int per = nM * nN; u.zb = wgid / per; wgid -= u.zb * per;
        const int nig = WGM * nN, gid = wgid / nig, fm = gid * WGM, gsz = (nM - fm) < WGM ? (nM - fm) : WGM;
        u.pm = fm + ((wgid % nig) % gsz); u.pn = (wgid % nig) / gsz; return true;
    }
    __device__ __forceinline__ void a_ready(const Unit&) const {}
    __device__ __forceinline__ void done(const Unit&) const {}
};

__device__ __forceinline__ unsigned cvt_pk_bf16(float lo, float hi) { unsigned r; asm volatile("v_cvt_pk_bf16_f32 %0, %1, %2" : "=v"(r) : "v"(lo), "v"(hi)); return r; }
typedef int v4i_t __attribute__((ext_vector_type(4))); typedef int v8i_t __attribute__((ext_vector_type(8)));
__device__ __forceinline__ v8i_t cat8(bf16x8 a, bf16x8 b) { return __builtin_shufflevector(__builtin_bit_cast(v4i_t, a), __builtin_bit_cast(v4i_t, b), 0, 1, 2, 3, 4, 5, 6, 7); }
__device__ __forceinline__ unsigned pk_fp8x4(float a, float b, float c, float d) { int r = 0; r = __builtin_amdgcn_cvt_pk_fp8_f32(a, b, r, false); r = __builtin_amdgcn_cvt_pk_fp8_f32(c, d, r, true); return (unsigned)r; }
__device__ __forceinline__ float bf_lo(unsigned w) { return __uint_as_float(w << 16); }
__device__ __forceinline__ float bf_hi(unsigned w) { return __uint_as_float(w & 0xffff0000u); }
__device__ __forceinline__ float fast_sigmoid(float z) { return __builtin_amdgcn_rcpf(1.0f + __builtin_amdgcn_exp2f(-1.4426950408889634f * z)); }
constexpr float RMS_EPS = 1e-6f;
__device__ __forceinline__ float rstd16(const float* ssp, int row) { const f32x4* p = (const f32x4*)(ssp + (size_t)row * 16); const f32x4 a = p[0], b = p[1], c = p[2], d = p[3];
    const float s = (((a[0] + a[1]) + (a[2] + a[3])) + ((b[0] + b[1]) + (b[2] + b[3]))) + (((c[0] + c[1]) + (c[2] + c[3])) + ((d[0] + d[1]) + (d[2] + d[3])));
    return __builtin_amdgcn_rsqf(s * (1.0f / 1024.0f) + RMS_EPS); }

__device__ __forceinline__ u32x4 pack8(const f32x4 v0, const f32x4 v1) { u32x4 w; w.x = cvt_pk_bf16(v0[0], v0[1]); w.y = cvt_pk_bf16(v0[2], v0[3]); w.z = cvt_pk_bf16(v1[0], v1[1]); w.w = cvt_pk_bf16(v1[2], v1[3]); return w; }

struct EpiInProj0 {
    static constexpr bool PERM = true, AFTER_DRAIN = false;
    const float* ss; bf16_t* uext; bf16_t* qkv; float qscale;
    __device__ __forceinline__ void operator()(const f32x4 (&acc)[2][2][4][2], const Unit& u, int wr, int wc, int fr, int fq) const {
        const int row0 = u.pm * BM + wr * 64 + fr;
#pragma unroll
        for (int ai = 0; ai < 2; ++ai)
#pragma unroll
            for (int m = 0; m < 4; ++m) { const int row = row0 + ai * HALF + m * 16; const float rs = rstd16(ss, row);
#pragma unroll
                for (int bj = 0; bj < 2; ++bj) { const int col0 = u.pn * BM + bj * HALF + wc * 32 + 8 * fq;
                    float sc = rs; bf16_t* dst;
                    if (u.pn < 2) dst = uext + ((size_t)(col0 >> 4) * 512 + (row >> 5)) * 640 + (row & 31) * 16 + (col0 & 15);
                    else { const int c = col0 - 512; if (c < 512) sc *= qscale; dst = qkv + (size_t)row * 1536 + c; }
                    *(u32x4*)dst = pack8(acc[ai][bj][m][0] * sc, acc[ai][bj][m][1] * sc); } }
    }
};
struct EpiS5State {
    static constexpr bool PERM = false, AFTER_DRAIN = false;
    float* sloc;
    __device__ __forceinline__ void operator()(const f32x4 (&acc)[2][2][4][2], const Unit& u, int wr, int wc, int fr, int fq) const {
        const int row0 = u.pm * BM + wr * 64 + fr, col0 = wc * 32 + 4 * fq;
#pragma unroll
        for (int ai = 0; ai < 2; ++ai)
#pragma unroll
            for (int m = 0; m < 4; ++m) { float* rowp = sloc + ((size_t)u.zb * 512 + row0 + ai * HALF + m * 16) * 128 + col0;
#pragma unroll
                for (int n = 0; n < 2; ++n) *(f32x4*)(rowp + n * 16) = acc[ai][0][m][n]; }
    }
};
__device__ __forceinline__ float gelu_tanh(float x) { const float a = x * (1.0f + 0.044715f * x * x); return x * __builtin_amdgcn_rcpf(1.0f + __builtin_amdgcn_exp2f(-2.302208198f * a)); }
struct EpiS5Y {
    static constexpr bool PERM = true, AFTER_DRAIN = false;
    bf16_t* yg;
    __device__ __forceinline__ void operator()(const f32x4 (&acc)[2][2][4][2], const Unit& u, int wr, int wc, int fr, int fq) const {
        const int row0 = u.pm * BM + wr * 64 + fr;
#pragma unroll
        for (int ai = 0; ai < 2; ++ai)
#pragma unroll
            for (int m = 0; m < 4; ++m) { const int chunk = row0 + ai * HALF + m * 16;
#pragma unroll
                for (int bj = 0; bj < 2; ++bj) { const int col0 = u.pn * BM + bj * HALF + wc * 32 + 8 * fq; const int i = col0 >> 4, h0 = col0 & 15;
                    f32x4 v0 = acc[ai][bj][m][0], v1 = acc[ai][bj][m][1];
#pragma unroll
                    for (int e = 0; e < 4; ++e) { v0[e] = gelu_tanh(v0[e]); v1[e] = gelu_tanh(v1[e]); }
                    *(u32x4*)(yg + ((size_t)chunk * 32 + i) * 512 + u.zb * 16 + h0) = pack8(v0, v1); } }
    }
};
struct EpiGlu {
    static constexpr bool PERM = true, AFTER_DRAIN = false;
    const bf16_t* yg; const float* bias; bf16_t* mix;
    __device__ __forceinline__ void operator()(const f32x4 (&acc)[2][2][4][2], const Unit& u, int wr, int wc, int fr, int fq) const {
        const int row0 = u.pm * BM + wr * 64 + fr;
#pragma unroll
        for (int bj = 0; bj < 2; ++bj) { const int col0 = u.pn * BM + bj * HALF + wc * 32 + 8 * fq;
            const f32x4 b0 = *(const f32x4*)(bias + col0), b1 = *(const f32x4*)(bias + col0 + 4);
#pragma unroll
            for (int ai = 0; ai < 2; ++ai)
#pragma unroll
                for (int m = 0; m < 4; ++m) { const int row = row0 + ai * HALF + m * 16;
                    const u32x4 yw = *(const u32x4*)(yg + (size_t)row * 512 + col0);
                    f32x4 z0 = acc[ai][bj][m][0] + b0, z1 = acc[ai][bj][m][1] + b1, o0, o1;
                    o0[0] = bf_lo(yw.x) * fast_sigmoid(z0[0]); o0[1] = bf_hi(yw.x) * fast_sigmoid(z0[1]); o0[2] = bf_lo(yw.y) * fast_sigmoid(z0[2]); o0[3] = bf_hi(yw.y) * fast_sigmoid(z0[3]);
                    o1[0] = bf_lo(yw.z) * fast_sigmoid(z1[0]); o1[1] = bf_hi(yw.z) * fast_sigmoid(z1[1]); o1[2] = bf_lo(yw.w) * fast_sigmoid(z1[2]); o1[3] = bf_hi(yw.w) * fast_sigmoid(z1[3]);
                    *(u32x4*)(mix + (size_t)row * 1024 + col0) = pack8(o0, o1); } }
    }
};
struct EpiResid {
    static constexpr bool PERM = false, AFTER_DRAIN = false;
    const float* R; float* X; bf16_t* xb; float* ssq;
    __device__ __forceinline__ void operator()(const f32x4 (&acc)[2][2][4][2], const Unit& u, int wr, int wc, int fr, int fq) const {
        const int row0 = u.pm * BM + wr * 64 + fr, col0 = u.pn * BM + wc * 32 + 4 * fq;
#pragma unroll
        for (int ai = 0; ai < 2; ++ai)
#pragma unroll
            for (int m = 0; m < 4; ++m) { const int row = row0 + ai * HALF + m * 16; const size_t off = (size_t)row * 1024 + col0; float s = 0.f;
#pragma unroll
                for (int bj = 0; bj < 2; ++bj)
#pragma unroll
                    for (int n = 0; n < 2; ++n) { const f32x4 x = *(const f32x4*)(R + off + bj * HALF + n * 16) + acc[ai][bj][m][n];
                        *(f32x4*)(X + off + bj * HALF + n * 16) = x; s += (x[0] * x[0] + x[1] * x[1]) + (x[2] * x[2] + x[3] * x[3]);
                        u32x2 w; w.x = cvt_pk_bf16(x[0], x[1]); w.y = cvt_pk_bf16(x[2], x[3]); *(u32x2*)(xb + off + bj * HALF + n * 16) = w; }
                s += __shfl_xor(s, 16); s += __shfl_xor(s, 32);
                if (fq == 0) ssq[(size_t)row * 16 + u.pn * 4 + wc] = s; }
    }
};
template <bool RS_IS_SSQ> struct EpiSwiGlu {
    static constexpr bool PERM = true, AFTER_DRAIN = false;
    const float* rsv; bf16_t* H; int ldh;
    __device__ __forceinline__ void operator()(const f32x4 (&acc)[2][2][4][2], const Unit& u, int wr, int wc, int fr, int fq) const {
        const int row0 = u.pm * BM + wr * 64 + fr, col0 = u.pn * HALF + wc * 32 + 8 * fq;
#pragma unroll
        for (int ai = 0; ai < 2; ++ai)
#pragma unroll
            for (int m = 0; m < 4; ++m) { const int row = row0 + ai * HALF + m * 16; const float rs = RS_IS_SSQ ? rstd16(rsv, row) : rsv[row];
                f32x4 o[2];
#pragma unroll
                for (int n = 0; n < 2; ++n)
#pragma unroll
                    for (int e = 0; e < 4; ++e) { const float g = acc[ai][0][m][n][e] * rs, up = acc[ai][1][m][n][e] * rs; o[n][e] = g * fast_sigmoid(g) * up; }
                *(u32x4*)(H + (size_t)row * ldh + col0) = pack8(o[0], o[1]); }
    }
};
struct EpiSwiGluFp8 {
    static constexpr bool PERM = true, AFTER_DRAIN = false;
    const float* rsv; unsigned char* H; int ldh;
    __device__ __forceinline__ void operator()(const f32x4 (&acc)[2][2][4][2], const Unit& u, int wr, int wc, int fr, int fq) const {
        const int row0 = u.pm * BM + wr * 64 + fr, col0 = u.pn * HALF + wc * 32 + 8 * fq;
#pragma unroll
        for (int ai = 0; ai < 2; ++ai)
#pragma unroll
            for (int m = 0; m < 4; ++m) { const int row = row0 + ai * HALF + m * 16; const float rs = rsv[row];
                f32x4 o[2];
#pragma unroll
                for (int n = 0; n < 2; ++n)
#pragma unroll
                    for (int e = 0; e < 4; ++e) { const float g = acc[ai][0][m][n][e] * rs, up = acc[ai][1][m][n][e] * rs; o[n][e] = g * fast_sigmoid(g) * up; }
                u32x2 w; w.x = pk_fp8x4(o[0][0], o[0][1], o[0][2], o[0][3]); w.y = pk_fp8x4(o[1][0], o[1][1], o[1][2], o[1][3]);
                *(u32x2*)(H + (size_t)row * ldh + col0) = w; }
    }
};
struct EpiInProj1 {
    static constexpr bool PERM = true, AFTER_DRAIN = false;
    const float* ss; bf16_t* qkv; float qscale;
    unsigned* kn;
    __device__ __forceinline__ void operator()(const f32x4 (&acc)[2][2][4][2], const Unit& u, int wr, int wc, int fr, int fq) const {
        const int row0 = u.pm * BM + wr * 64 + fr; const float qs = (u.pn < 4) ? qscale : 1.0f;
#pragma unroll
        for (int ai = 0; ai < 2; ++ai)
#pragma unroll
            for (int m = 0; m < 4; ++m) { const int row = row0 + ai * HALF + m * 16; const float sc = rstd16(ss, row) * qs;
#pragma unroll
                for (int bj = 0; bj < 2; ++bj) { const int col0 = (u.pn & 3) * BM + bj * HALF + wc * 32 + 8 * fq;
                    const f32x4 v0 = acc[ai][bj][m][0] * sc, v1 = acc[ai][bj][m][1] * sc;
                    *(u32x4*)(qkv + (size_t)(u.pn >> 2) * (16384 * 1024) + (size_t)row * 1024 + col0) = pack8(v0, v1);
                    if ((u.pn >> 2) == 1) {
                        float q = ((v0[0] * v0[0] + v0[1] * v0[1]) + (v0[2] * v0[2] + v0[3] * v0[3])) + ((v1[0] * v1[0] + v1[1] * v1[1]) + (v1[2] * v1[2] + v1[3] * v1[3]));
                        q += __shfl_xor(q, 16); q += __shfl_xor(q, 32);
                        q = fmaxf(q, __shfl_xor(q, 1)); q = fmaxf(q, __shfl_xor(q, 2)); q = fmaxf(q, __shfl_xor(q, 4)); q = fmaxf(q, __shfl_xor(q, 8));
                        if (fr == 0 && fq == 0) { const int head = (u.pn & 3) * 4 + bj * 2 + (wc >> 1), bb = row >> 13, tile = (row & 8191) >> 6;
                            atomicMax(kn + ((size_t)(bb * 16 + head) * 128 + tile) * 2 + (wc & 1), __float_as_uint(q * 1.01f)); } } } }
    }
};
struct EpiStoreBf16 {
    static constexpr bool PERM = true, AFTER_DRAIN = false;
    bf16_t* O; int ldc;
    __device__ __forceinline__ void operator()(const f32x4 (&acc)[2][2][4][2], const Unit& u, int wr, int wc, int fr, int fq) const {
        const int row0 = u.pm * BM + wr * 64 + fr;
#pragma unroll
        for (int ai = 0; ai < 2; ++ai)
#pragma unroll
            for (int m = 0; m < 4; ++m) { const int row = row0 + ai * HALF + m * 16;
#pragma unroll
                for (int bj = 0; bj < 2; ++bj) { const int col0 = u.pn * BM + bj * HALF + wc * 32 + 8 * fq;
                    *(u32x4*)(O + (size_t)row * ldc + col0) = pack8(acc[ai][bj][m][0], acc[ai][bj][m][1]); } }
    }
};

template <bool F8> struct Frag { bf16x8 k[2]; };
template <> struct Frag<true> { v8i_t v; };
template <class Epi, class Sched, bool ALIGN_EPI = false, bool SP2 = false, bool FP8 = false>
__device__ __forceinline__ void gemm_phase(PG8_LAS unsigned char* lds, const Gemm g, const Sched& S, const Epi& E) {
    int tid_ = threadIdx.x; asm volatile("" : "+v"(tid_));
    const int tid = tid_, wid = __builtin_amdgcn_readfirstlane(tid >> 6), lane = tid & 63, wr = wid >> 2, wc = wid & 3, fr = lane & 15, fq = lane >> 4;
    const int K = g.K, nt = K / BK;
    unsigned voffA[2], voffB[2];
#pragma unroll
    for (int i = 0; i < 2; ++i) { int R, C; stage_rc(tid * 16 + i * 8192, R, C); const int Rb = Epi::PERM ? ((R & ~31) + perm32(R & 31)) : R;
        voffA[i] = (unsigned)(R * g.lda + C) * 2u; voffB[i] = (unsigned)(Rb * g.ldb + C) * 2u; }
    const size_t kstep = (size_t)(BK * 2);
    const size_t hstepA = (size_t)HALF * g.lda * 2, hstepB = (size_t)HALF * g.ldb * 2;
    const size_t tstepA = 2 * hstepA, tstepB = 2 * hstepB;
    const unsigned ldsw = (unsigned)wid * 1024u;
    const int aoff = lds_byte(wr * 64 + fr, fq * 8), boff = lds_byte(wc * 32 + fr, fq * 8);
#define PG8_SA(b, h) (((b) * 2 + (h)) * HTB)
#define PG8_SB(b, h) ((4 + (b) * 2 + (h)) * HTB)
#define PG8_STAGE(bufoff, gbase, voff) do { _Pragma("unroll") for (int _i = 0; _i < 2; ++_i) \
        __builtin_amdgcn_global_load_lds((const unsigned*)((const char*)(gbase) + (voff)[_i]), (PG8_LAS unsigned*)(lds + (bufoff) + ldsw + _i * 8192), 16, 0, 0); } while (0)
    const PG8_LAS unsigned char* ldsA_ = lds + aoff; const PG8_LAS unsigned char* ldsB_ = lds + 4 * HTB + boff; asm volatile("" : "+v"(ldsA_), "+v"(ldsB_));
#define PG8_RDA(off) (*(const PG8_LAS bf16x8*)(ldsA_ + (off)))
#define PG8_RDB(off) (*(const PG8_LAS bf16x8*)(ldsB_ + (off)))
#define PG8_LDA(dst, b, h) do { _Pragma("unroll") for (int m = 0; m < 4; ++m) { if constexpr (FP8) dst[m].v = cat8(PG8_RDA(PG8_SA(b, h) + m * 2048), PG8_RDA(PG8_SA(b, h) + m * 2048 + 1024)); \
        else { dst[m].k[0] = PG8_RDA(PG8_SA(b, h) + m * 2048); dst[m].k[1] = PG8_RDA(PG8_SA(b, h) + m * 2048 + 1024); } } } while (0)
#define PG8_LDB(dst, b, h) do { _Pragma("unroll") for (int n = 0; n < 2; ++n) { if constexpr (FP8) dst[n].v = cat8(PG8_RDB(PG8_SB(b, h) - 4 * HTB + n * 2048), PG8_RDB(PG8_SB(b, h) - 4 * HTB + n * 2048 + 1024)); \
        else { dst[n].k[0] = PG8_RDB(PG8_SB(b, h) - 4 * HTB + n * 2048); dst[n].k[1] = PG8_RDB(PG8_SB(b, h) - 4 * HTB + n * 2048 + 1024); } } } while (0)
#define PG8_MMA(ai, bj, At, Bt) do { __builtin_amdgcn_s_setprio(1); _Pragma("unroll") for (int m = 0; m < 4; ++m) _Pragma("unroll") for (int n = 0; n < 2; ++n) { \
        if constexpr (FP8) { asm volatile("v_mfma_scale_f32_16x16x128_f8f6f4 %0, %1, %2, %0, %3, %4 op_sel_hi:[0,0,0]" : "+v"(acc[ai][bj][m][n]) : "v"(Bt[n].v), "v"(At[m].v), "v"(sclB_), "v"(sclA_)); } \
        else { _Pragma("unroll") for (int k = 0; k < 2; ++k) acc[ai][bj][m][n] = __builtin_amdgcn_mfma_f32_16x16x32_bf16(Bt[n].k[k], At[m].k[k], acc[ai][bj][m][n], 0, 0, 0); } } __builtin_amdgcn_s_setprio(0); } while (0)
#define PG8_WAIT_V(n) asm volatile("s_waitcnt vmcnt(" #n ")" ::: "memory")
#define PG8_WAIT_L(n) asm volatile("s_waitcnt lgkmcnt(" #n ")" ::: "memory")
#define PG8_BAR __builtin_amdgcn_s_barrier()
#define PG8_SCHED __builtin_amdgcn_sched_barrier(0)
    Unit cur, nxt; int ui = 0;
    if (!S.next(0, cur)) return;
    f32x4 acc[2][2][4][2];
#pragma unroll
    for (int a = 0; a < 2; ++a)
#pragma unroll
        for (int b = 0; b < 2; ++b)
#pragma unroll
            for (int m = 0; m < 4; ++m)
#pragma unroll
                for (int n = 0; n < 2; ++n) acc[a][b][m][n] = (f32x4){0.f, 0.f, 0.f, 0.f};
    Frag<FP8> At[4], B0[2], B1[2];
    int sclB_ = 0x79797979, sclA_ = 0x7f7f7f7f; asm volatile("" : "+v"(sclB_), "+v"(sclA_));
    const char* cA = (const char*)g.A + (size_t)cur.zb * g.zA + (size_t)cur.pm * tstepA; const char* cB = (const char*)g.Bt + (size_t)cur.zb * g.zB + (size_t)cur.pn * tstepB;
    S.a_ready(cur);
    if constexpr (SP2) {
        PG8_STAGE(PG8_SB(0, 0), cB, voffB); PG8_STAGE(PG8_SB(0, 1), cB + hstepB, voffB); PG8_STAGE(PG8_SA(0, 0), cA, voffA); PG8_STAGE(PG8_SA(0, 1), cA + hstepA, voffA);
        if (wr == 1) PG8_BAR;
        PG8_WAIT_V(2); PG8_BAR;
        PG8_STAGE(PG8_SB(1, 0), cB + kstep, voffB); PG8_STAGE(PG8_SA(1, 0), cA + kstep, voffA); PG8_STAGE(PG8_SB(1, 1), cB + hstepB + kstep, voffB);
        PG8_WAIT_V(6); PG8_BAR;
    } else {
        PG8_STAGE(PG8_SB(0, 0), cB, voffB); PG8_STAGE(PG8_SA(0, 0), cA, voffA); PG8_STAGE(PG8_SB(0, 1), cB + hstepB, voffB); PG8_STAGE(PG8_SA(0, 1), cA + hstepA, voffA);
        if (wr == 1) PG8_BAR;
        PG8_WAIT_V(4); PG8_BAR;
        PG8_STAGE(PG8_SB(1, 0), cB + kstep, voffB); PG8_STAGE(PG8_SA(1, 0), cA + kstep, voffA); PG8_STAGE(PG8_SB(1, 1), cB + hstepB + kstep, voffB);
        PG8_WAIT_V(6); PG8_BAR;
    }
    for (;;) {
        const bool has_next = S.next(ui + 1, nxt);
        const char* nA = has_next ? (const char*)g.A + (size_t)nxt.zb * g.zA + (size_t)nxt.pm * tstepA : cA; const char* nB = has_next ? (const char*)g.Bt + (size_t)nxt.zb * g.zB + (size_t)nxt.pn * tstepB : cB;
#pragma unroll 1
        for (int t = 0; t < nt; t += 2) {
            const bool last = (t == nt - 2);
            const char* a1 = cA + (size_t)(t + 1) * kstep;
            const char* a2 = last ? nA : cA + (size_t)(t + 2) * kstep; const char* b2 = last ? nB : cB + (size_t)(t + 2) * kstep;
            const char* a3 = a2 + kstep; const char* b3 = b2 + kstep;
            if (last && has_next) S.a_ready(nxt);
            if constexpr (SP2) {
            PG8_LDB(B0, 0, 0); PG8_LDB(B1, 0, 1); PG8_SCHED; PG8_LDA(At, 0, 0); PG8_STAGE(PG8_SA(1, 1), a1 + hstepA, voffA);
            PG8_WAIT_V(8); PG8_WAIT_L(0); PG8_BAR; PG8_MMA(0, 0, At, B0); PG8_MMA(0, 1, At, B1); PG8_BAR; PG8_SCHED;
            PG8_LDA(At, 0, 1); PG8_STAGE(PG8_SB(0, 0), b2, voffB); PG8_STAGE(PG8_SB(0, 1), b2 + hstepB, voffB); PG8_STAGE(PG8_SA(0, 0), a2, voffA);
            PG8_WAIT_V(8); PG8_WAIT_L(0); PG8_BAR; PG8_MMA(1, 0, At, B0); PG8_MMA(1, 1, At, B1); PG8_BAR; PG8_SCHED;
            PG8_LDB(B0, 1, 0); PG8_LDB(B1, 1, 1); PG8_SCHED; PG8_LDA(At, 1, 0); PG8_STAGE(PG8_SA(0, 1), a2 + hstepA, voffA);
            PG8_WAIT_V(8); PG8_WAIT_L(0); PG8_BAR; PG8_MMA(0, 0, At, B0); PG8_MMA(0, 1, At, B1); PG8_BAR; PG8_SCHED;
            PG8_LDA(At, 1, 1); PG8_STAGE(PG8_SB(1, 0), b3, voffB); PG8_STAGE(PG8_SB(1, 1), b3 + hstepB, voffB); PG8_STAGE(PG8_SA(1, 0), a3, voffA);
            PG8_WAIT_V(8); PG8_WAIT_L(0); PG8_BAR; PG8_MMA(1, 0, At, B0); PG8_MMA(1, 1, At, B1); PG8_BAR; PG8_SCHED;
            } else {
            PG8_LDB(B0, 0, 0); PG8_SCHED; PG8_LDA(At, 0, 0); PG8_STAGE(PG8_SA(1, 1), a1 + hstepA, voffA);
            PG8_WAIT_L(8); PG8_BAR; PG8_WAIT_L(0); PG8_MMA(0, 0, At, B0); PG8_BAR; PG8_SCHED;
            PG8_LDB(B1, 0, 1); PG8_STAGE(PG8_SB(0, 0), b2, voffB);
            PG8_BAR; PG8_WAIT_L(0); PG8_MMA(0, 1, At, B1); PG8_BAR;
            PG8_LDA(At, 0, 1); PG8_STAGE(PG8_SA(0, 0), a2, voffA);
            PG8_BAR; PG8_WAIT_L(0); PG8_MMA(1, 0, At, B0); PG8_BAR; PG8_SCHED;
            PG8_STAGE(PG8_SB(0, 1), b2 + hstepB, voffB);
            PG8_WAIT_V(6); PG8_BAR; PG8_MMA(1, 1, At, B1); PG8_BAR;
            PG8_LDB(B0, 1, 0); PG8_SCHED; PG8_LDA(At, 1, 0); PG8_STAGE(PG8_SA(0, 1), a2 + hstepA, voffA);
            PG8_WAIT_L(8); PG8_BAR; PG8_WAIT_L(0); PG8_MMA(0, 0, At, B0); PG8_BAR; PG8_SCHED;
            PG8_LDB(B1, 1, 1); PG8_STAGE(PG8_SB(1, 0), b3, voffB);
            PG8_BAR; PG8_WAIT_L(0); PG8_MMA(0, 1, At, B1); PG8_BAR;
            PG8_LDA(At, 1, 1); PG8_STAGE(PG8_SA(1, 0), a3, voffA);
            PG8_BAR; PG8_WAIT_L(0); PG8_MMA(1, 0, At, B0); PG8_BAR; PG8_SCHED;
            PG8_STAGE(PG8_SB(1, 1), b3 + hstepB, voffB);
            PG8_WAIT_V(6); PG8_BAR; PG8_MMA(1, 1, At, B1); PG8_BAR;
            }
        }
        if constexpr (ALIGN_EPI) { if (wr == 0) PG8_BAR; }
        if constexpr (FP8) asm volatile("s_nop 15\n\ts_nop 15" ::: "memory");
        if constexpr (!Epi::AFTER_DRAIN) { int fr_ = fr, fq_ = fq; asm volatile("" : "+v"(fr_), "+v"(fq_));
            E(acc, cur, wr, wc, fr_, fq_); S.done(cur); }
        if (!has_next) break;
#pragma unroll
        for (int a = 0; a < 2; ++a)
#pragma unroll
            for (int b = 0; b < 2; ++b)
#pragma unroll
                for (int m = 0; m < 4; ++m)
#pragma unroll
                    for (int n = 0; n < 2; ++n) acc[a][b][m][n] = (f32x4){0.f, 0.f, 0.f, 0.f};
        cur = nxt; cA = nA; cB = nB; ++ui;
        if constexpr (ALIGN_EPI) { if (wr == 1) PG8_BAR; }
    }
    PG8_WAIT_V(0);
    if constexpr (!ALIGN_EPI) { if (wr == 0) PG8_BAR; }
    PG8_BAR;
    if constexpr (Epi::AFTER_DRAIN) { E.fused(acc, cur, wr, wc, fr, fq, lds, wid, lane); S.done(cur); }
#undef PG8_SA
#undef PG8_SB
#undef PG8_STAGE
#undef PG8_LDA
#undef PG8_RDA
#undef PG8_RDB
#undef PG8_LDB
#undef PG8_MMA
#undef PG8_WAIT_V
#undef PG8_WAIT_L
#undef PG8_BAR
#undef PG8_SCHED
}
}

#include <hip/hip_bf16.h>
#include <cmath>
namespace attn_body {
using bf16=__hip_bfloat16;
using bf16x8=__attribute__((ext_vector_type(8)))short;
using s16x4=__attribute__((ext_vector_type(4)))short;
using f32x16=__attribute__((ext_vector_type(16)))float;
using u32x4=__attribute__((ext_vector_type(4)))unsigned;
constexpr int BATCH=2,NHEAD=16,SEQ=8192,D=64,DM=NHEAD*D;
constexpr int NW=8,QBLK=32,QB=QBLK*NW,KVBLK=64,NQB=SEQ/QB;
constexpr int ATTN_PITCH=DM, ATTN_UNIT_ROWS=QB;
__device__ __forceinline__ int crow(int r,int hi){return (r&3)+8*(r>>2)+4*hi;}
#define SBAR() __builtin_amdgcn_sched_barrier(0)
__device__ __forceinline__ void cmask(f32x16&p0,f32x16&p1,int jb,int qrel,int hi){
  const float NEG=-INFINITY; int kb=64*jb+4*hi;
  #pragma unroll
  for(int r=0;r<16;++r){int kv=kb+(r&3)+8*(r>>2); if(kv>qrel)p0[r]=NEG; if(kv+32>qrel)p1[r]=NEG;}
}

constexpr int NSLOT=3, SLOTB=8192;
constexpr int LDS_K=0, LDS_V=NSLOT*SLOTB, LDS_WS=2*NSLOT*SLOTB, LDS_OST=LDS_WS+NW*64*4, LDS_NB=LDS_OST+NW*4096  , LDS_PK=LDS_NB+32768+64  , LDS_BYTES=LDS_PK+1024;
constexpr float C2=0.125f*1.4426950408889634f;
__device__ __forceinline__ void glds16(const void*gsrc,unsigned lds_dst){unsigned keep;
  asm volatile("s_mov_b32 %0, m0\n\ts_mov_b32 m0, %2\n\ts_nop 0\n\tglobal_load_lds_dwordx4 %1, off\n\ts_mov_b32 m0, %0":"=&s"(keep):"v"(gsrc),"s"(lds_dst):"memory");}
__device__ __forceinline__ float max3f(float a,float b,float c){float r;asm("v_max3_f32 %0, %1, %2, %3":"=v"(r):"v"(a),"v"(b),"v"(c));return r;}
__device__ __forceinline__ float max2f(float a,float b){float r;asm("v_max_f32_e32 %0, %1, %2":"=v"(r):"v"(a),"v"(b));return r;}
__device__ __forceinline__ float fadd_s(float a,float b){float r;asm("v_add_f32_e32 %0, %1, %2":"=v"(r):"v"(a),"v"(b));return r;}
__device__ __forceinline__ float fsub_s(float a,float b){float r;asm("v_sub_f32_e32 %0, %1, %2":"=v"(r):"v"(a),"v"(b));return r;}
typedef float f32x2_t __attribute__((ext_vector_type(2))); typedef __bf16 bf16x2_t __attribute__((ext_vector_type(2)));
__device__ __forceinline__ unsigned cvtpk_s(float lo,float hi){f32x2_t v={lo,hi};bf16x2_t b=__builtin_convertvector(v,bf16x2_t);return __builtin_bit_cast(unsigned,b);}
#define WAIT_BAR(N) asm volatile("s_waitcnt vmcnt(" #N ") lgkmcnt(0)\n\ts_barrier":::"memory")

__device__ __forceinline__ void qkt(f32x16&p0,f32x16&p1,const char*Kslot,const bf16x8*qr,const f32x16&negm,int r32,int hi){
  const char*kb=Kslot+hi*1024+r32*16;
  #pragma unroll
  for(int d0=0;d0<4;++d0){
    const bf16x8 b0=*reinterpret_cast<const bf16x8*>(kb+d0*2048);
    const bf16x8 b1=*reinterpret_cast<const bf16x8*>(kb+d0*2048+512);
    if(d0==0){p0=__builtin_amdgcn_mfma_f32_32x32x16_bf16(b0,qr[0],negm,0,0,0);p1=__builtin_amdgcn_mfma_f32_32x32x16_bf16(b1,qr[0],negm,0,0,0);}
    else{p0=__builtin_amdgcn_mfma_f32_32x32x16_bf16(b0,qr[d0],p0,0,0,0);p1=__builtin_amdgcn_mfma_f32_32x32x16_bf16(b1,qr[d0],p1,0,0,0);}}
}
typedef __attribute__((address_space(3))) const char* lds_cptr;
typedef short v4i16_t __attribute__((ext_vector_type(4)));
__device__ __forceinline__ void kload8(bf16x8*kf,lds_cptr kp){
  kf[0]=*(const __attribute__((address_space(3))) bf16x8*)(kp);      kf[1]=*(const __attribute__((address_space(3))) bf16x8*)(kp+512);
  kf[2]=*(const __attribute__((address_space(3))) bf16x8*)(kp+2048); kf[3]=*(const __attribute__((address_space(3))) bf16x8*)(kp+2560);
  kf[4]=*(const __attribute__((address_space(3))) bf16x8*)(kp+4096); kf[5]=*(const __attribute__((address_space(3))) bf16x8*)(kp+4608);
  kf[6]=*(const __attribute__((address_space(3))) bf16x8*)(kp+6144); kf[7]=*(const __attribute__((address_space(3))) bf16x8*)(kp+6656);
}
__device__ __forceinline__ void kload2(bf16x8*kf,lds_cptr kp,int j){ kf[2*j]=*(const __attribute__((address_space(3))) bf16x8*)(kp+j*2048); kf[2*j+1]=*(const __attribute__((address_space(3))) bf16x8*)(kp+j*2048+512); }
__device__ __forceinline__ s16x4 vtr(lds_cptr p){ return __builtin_bit_cast(s16x4,__builtin_amdgcn_ds_read_tr16_b64_v4i16((__attribute__((address_space(3))) v4i16_t*)p)); }
__device__ __forceinline__ float rowmax(const f32x16&p0,const f32x16&p1){
  float a=max3f(p0[0],p0[1],p1[0]),b=max3f(p0[2],p0[3],p1[1]);a=max3f(a,p1[2],p1[3]);
  #pragma unroll
  for(int r=4;r<16;r+=4){a=max3f(a,p0[r],p0[r+1]);b=max3f(b,p0[r+2],p0[r+3]);a=max3f(a,p1[r],p1[r+1]);b=max3f(b,p1[r+2],p1[r+3]);}
  const float m=max2f(a,b);
  auto rr=__builtin_amdgcn_permlane32_swap(__float_as_uint(m),__float_as_uint(m),false,false);
  return max2f(__uint_as_float(rr[0]),__uint_as_float(rr[1]));
}
__device__ __forceinline__ void pv(f32x16*o,int vb,bf16x8 pa0,bf16x8 pa1,bf16x8 pa2,bf16x8 pa3){
  #pragma unroll
  for(int d0=0;d0<2;++d0){s16x4 lo[4],hi[4];
    #pragma unroll
    for(int ks=0;ks<4;++ks){
      asm volatile("ds_read_b64_tr_b16 %0,%1 offset:%c2":"=&v"(lo[ks]):"v"(vb),"i"(d0*4096+ks*1024):"memory");
      asm volatile("ds_read_b64_tr_b16 %0,%1 offset:%c2":"=&v"(hi[ks]):"v"(vb),"i"(d0*4096+ks*1024+512):"memory");}
    asm volatile("s_waitcnt lgkmcnt(0)":::"memory");SBAR();
    #define PK(k) (bf16x8){lo[k][0],lo[k][1],lo[k][2],lo[k][3],hi[k][0],hi[k][1],hi[k][2],hi[k][3]}
    o[d0]=__builtin_amdgcn_mfma_f32_32x32x16_bf16(pa0,PK(0),o[d0],0,0,0);
    o[d0]=__builtin_amdgcn_mfma_f32_32x32x16_bf16(pa1,PK(1),o[d0],0,0,0);
    o[d0]=__builtin_amdgcn_mfma_f32_32x32x16_bf16(pa2,PK(2),o[d0],0,0,0);
    o[d0]=__builtin_amdgcn_mfma_f32_32x32x16_bf16(pa3,PK(3),o[d0],0,0,0);
    #undef PK
  }
}

typedef float f32x4_t __attribute__((ext_vector_type(4)));
__device__ __forceinline__ void fox_negcum(const float*logf,__attribute__((address_space(3))) float*ncum,__attribute__((address_space(3))) float*wtot,int tid){
  float loc[16];float s=0.f; const f32x4_t*lp=(const f32x4_t*)(logf+tid*16);
  #pragma unroll
  for(int j=0;j<4;++j){const f32x4_t v=lp[j]; s+=v[0];loc[4*j]=s; s+=v[1];loc[4*j+1]=s; s+=v[2];loc[4*j+2]=s; s+=v[3];loc[4*j+3]=s;}
  float inc=s;
  #pragma unroll
  for(int o=1;o<64;o<<=1){const float v=__shfl_up(inc,o); if((tid&63)>=o)inc+=v;}
  if((tid&63)==63)wtot[tid>>6]=inc;
  __syncthreads();
  float base=inc-s; for(int w=0;w<(tid>>6);++w)base+=wtot[w];
  #pragma unroll
  for(int j=0;j<4;++j){ f32x4_t o4; o4[0]=-(base+loc[4*j]);o4[1]=-(base+loc[4*j+1]);o4[2]=-(base+loc[4*j+2]);o4[3]=-(base+loc[4*j+3]); *(__attribute__((address_space(3))) f32x4_t*)(ncum+tid*16+4*j)=o4; }
  __syncthreads();
}
#ifndef ATTN_STORE16
#define ATTN_STORE16(p,v) (*(u32x4*)(p)=(v))
#endif
template<int THRL> __device__ __forceinline__ void attn_unit(int b,int h,int qb,const bf16*Q,const bf16*__restrict__ K,const bf16*__restrict__ V,bf16*O,char*shm,const float*logf_bh,const unsigned*kn_bh){
  int tid_=threadIdx.x; asm volatile("":"+v"(tid_)); const int tid=tid_,lane=tid&63,r32=lane&31,hi=lane>>5; const int wid=__builtin_amdgcn_readfirstlane(tid>>6);
  const long rowbase=(long)b*SEQ; const int q0=qb*QB;
  const bf16*Qw=Q+(rowbase+q0+wid*QBLK)*DM+h*D;
  const bf16*Kh=K+rowbase*DM+h*D,*Vh=V+rowbase*DM+h*D;
  const unsigned lds0=(unsigned)(uintptr_t)shm;
  float*wsf=(float*)(shm+LDS_WS)+wid*64;
  const bf16*ksrc=Kh+(long)lane*DM+wid*8;
  const bf16*vsrc=Vh+(long)(16*(wid&3)+(lane>>2))*DM+(wid>>2)*32+(lane&3)*8;
  const unsigned kdst=lds0+LDS_K+wid*1024, vdst=lds0+LDS_V+wid*1024;
  #define TIDX(t) (NTR-1-(t))
  #define DMA_K(t,slot) glds16(ksrc+(long)TIDX(t)*KVBLK*DM,(unsigned)__builtin_amdgcn_readfirstlane(kdst+(slot)))
  #define DMA_V(t,slot) glds16(vsrc+(long)TIDX(t)*KVBLK*DM,(unsigned)__builtin_amdgcn_readfirstlane(vdst+(slot)))
  const int vb0=(int)(lds0+LDS_V)+((lane>>4)&1)*32+(lane&3)*8+(4*hi+((lane&15)>>2))*64;
  const char*Kbase=shm+LDS_K; bf16x8 kf[8];
  const lds_cptr shm3=(lds_cptr)shm; const lds_cptr kp0=shm3+LDS_K+hi*1024+r32*16; const lds_cptr vp0=shm3+LDS_V+((lane>>4)&1)*32+(lane&3)*8+(4*hi+((lane&15)>>2))*64;
  const int NTR=(q0+QB)/KVBLK;
  const lds_cptr shm3b=(lds_cptr)shm;
  const __attribute__((address_space(3))) float* nb3=(const __attribute__((address_space(3))) float*)(shm3b+LDS_NB);
  fox_negcum(logf_bh,(__attribute__((address_space(3))) float*)(shm3b+LDS_NB),(__attribute__((address_space(3))) float*)(shm3b+LDS_NB+32768),tid);
  int NT;
  { __attribute__((address_space(3))) float* PK=(__attribute__((address_space(3))) float*)(shm3b+LDS_PK);
    __attribute__((address_space(3))) int* JX=(__attribute__((address_space(3))) int*)(shm3b+LDS_PK+512);
    float pk=0.f;
    if(tid<128){ const float a=__uint_as_float(kn_bh[2*tid]),c=__uint_as_float(kn_bh[2*tid+1]); pk=__builtin_sqrtf(a+c)*1.001f; }
    #pragma unroll
    for(int o_=1;o_<64;o_<<=1){const float v=__shfl_up(pk,o_); if((tid&63)>=o_)pk=__builtin_fmaxf(pk,v);}
    if(tid==63)PK[128]=pk;
    __syncthreads();
    if(tid>=64&&tid<128)pk=__builtin_fmaxf(pk,PK[128]);
    if(tid<128)PK[tid]=pk;
    const bf16*Krow=Kh+(long)(q0+wid*QBLK+r32)*DM+hi*8; const bf16*Qrow=Qw+(long)r32*DM+hi*8; float qq=0.f,qk=0.f;
    #pragma unroll
    for(int d0=0;d0<4;++d0){ const u32x4 qa=*reinterpret_cast<const u32x4*>(Qrow+d0*16), ka=*reinterpret_cast<const u32x4*>(Krow+d0*16);
      #pragma unroll
      for(int e=0;e<4;++e){ const float q0f=__uint_as_float(qa[e]<<16),q1f=__uint_as_float(qa[e]&0xffff0000u),k0f=__uint_as_float(ka[e]<<16),k1f=__uint_as_float(ka[e]&0xffff0000u);
        qq+=q0f*q0f+q1f*q1f; qk+=q0f*k0f+q1f*k1f; } }
    { auto r1=__builtin_amdgcn_permlane32_swap(__float_as_uint(qq),__float_as_uint(qq),false,false); qq=__uint_as_float(r1[0])+__uint_as_float(r1[1]);
      auto r2=__builtin_amdgcn_permlane32_swap(__float_as_uint(qk),__float_as_uint(qk),false,false); qk=__uint_as_float(r2[0])+__uint_as_float(r2[1]); }
    __syncthreads();
    const float qn=__builtin_sqrtf(qq)*1.001f, thr=qk+nb3[q0+wid*QBLK+r32]-152.f;
    int lo_=0,hi_=NTR;
    #pragma unroll 1
    for(int it=0;it<8;++it){ if(lo_<hi_){ const int mid=(lo_+hi_)>>1; const float f=qn*PK[mid]+nb3[64*mid+63]; if(f>=thr)hi_=mid; else lo_=mid+1; } }
    #pragma unroll
    for(int o_=1;o_<64;o_<<=1){const int v=__shfl_xor(lo_,o_); lo_=v<lo_?v:lo_;}
    if(lane==0)JX[wid]=lo_;
    __syncthreads();
    int j0=JX[0];
    #pragma unroll
    for(int w=1;w<8;++w){const int v=JX[w]; j0=v<j0?v:j0;}
    j0=__builtin_amdgcn_readfirstlane(j0);
    int nte=(NTR-j0+1)&~1; NT=nte<4?4:nte;
    __syncthreads();
  }
  #define BIASADD(P0,P1,t) do{ const __attribute__((address_space(3))) f32x4_t* bp_=(const __attribute__((address_space(3))) f32x4_t*)(nb3+TIDX(t)*64+4*hi); \
    const f32x4_t nm4_={-mhat,-mhat,-mhat,-mhat}; \
    _Pragma("unroll") for(int g_=0;g_<4;++g_){ const f32x4_t b0_=bp_[2*g_]+nm4_,b1_=bp_[2*g_+8]+nm4_; \
      P0[4*g_]+=b0_[0];P0[4*g_+1]+=b0_[1];P0[4*g_+2]+=b0_[2];P0[4*g_+3]+=b0_[3]; P1[4*g_]+=b1_[0];P1[4*g_+1]+=b1_[1];P1[4*g_+2]+=b1_[2];P1[4*g_+3]+=b1_[3]; } }while(0)
  DMA_K(0,0);DMA_V(0,0);DMA_K(1,SLOTB);
  bf16x8 qr[4];
  #pragma unroll
  for(int d0=0;d0<4;++d0)qr[d0]=*reinterpret_cast<const bf16x8*>(&Qw[(long)r32*DM+d0*16+hi*8]);
  float mhat=0.f,l_reg=0.f;f32x16 o[2];o[0]=f32x16{};o[1]=f32x16{};const f32x16 negm=f32x16{};
  const int qrel=wid*QBLK+r32;
  #define CMASK(P0,P1,t) do{ if((t)<4){ cmask(P0,P1,3-(t),qrel,hi); } }while(0)
  bool resc=false;
  #define START(P0,P1) do{ const float rm=rowmax(P0,P1); resc=false; \
    { const float dl=(rm>-3.0e38f)?rm:0.f; mhat=fadd_s(mhat,dl);     \
      _Pragma("unroll") for(int r=0;r<16;++r){P0[r]=fsub_s(P0[r],dl);P1[r]=fsub_s(P1[r],dl);} \
      } \
    _Pragma("unroll") for(int r=0;r<16;++r)P0[r]=__builtin_amdgcn_exp2f(P0[r]); }while(0)
  #define RESC() do{ if(resc){ asm volatile("s_waitcnt lgkmcnt(0)":::"memory"); \
      _Pragma("unroll") for(int d_=0;d_<2;++d_) _Pragma("unroll") for(int r=0;r<16;++r)o[d_][r]*=wsf[crow(r,hi)]; } }while(0)
  f32x16 pA0,pA1,pB0,pB1;
  int sl_prev=0,sl_cur=0,sl_next=SLOTB;
  #define ROT() do{sl_prev=sl_cur;sl_cur=sl_next;sl_next=(sl_next==(NSLOT-1)*SLOTB)?0:sl_next+SLOTB;}while(0)
  DMA_K(2,2*SLOTB);
  WAIT_BAR(3);
  qkt(pA0,pA1,Kbase,qr,negm,r32,hi);asm volatile("s_nop 15\n\ts_nop 7":"+v"(pA0),"+v"(pA1));BIASADD(pA0,pA1,0);CMASK(pA0,pA1,0);
  START(pA0,pA1);
  _Pragma("unroll") for(int r=0;r<16;++r)pA1[r]=__builtin_amdgcn_exp2f(pA1[r]);
  WAIT_BAR(0);
  DMA_K(3,0);DMA_V(1,SLOTB);
  ROT();
  kload8(kf,kp0+sl_cur);
  WAIT_BAR(2);
  s16x4 vlo[8],vhi[8]; u32x4 pw0,pw1,pw2,pw3;
  #define PKW(P,B) cvtpk_s(P[B],P[B+1])
  #define PAF(k) __builtin_bit_cast(bf16x8,pw##k)
  #define VFR(i) (bf16x8){vlo[i][0],vlo[i][1],vlo[i][2],vlo[i][3],vhi[i][0],vhi[i][1],vhi[i][2],vhi[i][3]}
  #define PIN(x) asm volatile("":"+v"(x))
  #define MX3(a,b,c) __builtin_fmaxf(__builtin_fmaxf((a),(b)),(c))
  #define GAPA(MF,A0,A1,A2,A3,W0,W1,PW) do{ MF; sacc+=A0; sacc+=A1; sacc+=A2; sacc+=A3; PIN(sacc); W0; W1; PIN(PW); SBAR(); }while(0)
  #define EX(v) __builtin_amdgcn_exp2f(v)
  #define GAPB(MF,X,B) do{ MF; X[B]=EX(X[B]); X[B+1]=EX(X[B+1]); X[B+2]=EX(X[B+2]); X[B+3]=EX(X[B+3]); PIN(X); SBAR(); }while(0)
  #define VRD(i) do{ vlo[i]=vtr(vp_+(((i)>>2)*4096+((i)&3)*1024)); vhi[i]=vtr(vp_+(((i)>>2)*4096+((i)&3)*1024+512)); }while(0)
  #define KRD(G,j) do{ if(G){ kload2(kf,kp0+sl_next,j); SBAR(); } }while(0)
  #define STEP(C0,C1,P0,P1,t,GK,GV,GL) do{ SBAR(); \
    const lds_cptr vp_=vp0+sl_prev; \
    VRD(0); SBAR(); float sacc=(P0[0]+P0[1]); \
    GAPA(C0=__builtin_amdgcn_mfma_f32_32x32x16_bf16(kf[0],qr[0],negm,0,0,0), P0[2],P0[3],P0[4],P0[5],     pw0[0]=PKW(P0,0), pw0[1]=PKW(P0,2), pw0); \
    VRD(4); SBAR(); GAPA(C1=__builtin_amdgcn_mfma_f32_32x32x16_bf16(kf[1],qr[0],negm,0,0,0), P0[6],P0[7],P0[8],P0[9],     pw0[2]=PKW(P0,4), pw0[3]=PKW(P0,6), pw0); \
    VRD(1); SBAR(); GAPA(C0=__builtin_amdgcn_mfma_f32_32x32x16_bf16(kf[2],qr[1],C0,0,0,0),   P0[10],P0[11],P0[12],P0[13], pw1[0]=PKW(P0,8), pw1[1]=PKW(P0,10), pw1); \
    VRD(5); SBAR(); GAPA(C1=__builtin_amdgcn_mfma_f32_32x32x16_bf16(kf[3],qr[1],C1,0,0,0),   P0[14],P0[15],P1[0],P1[1],   pw1[2]=PKW(P0,12),pw1[3]=PKW(P0,14), pw1); \
    VRD(2); SBAR(); GAPA(C0=__builtin_amdgcn_mfma_f32_32x32x16_bf16(kf[4],qr[2],C0,0,0,0),   P1[2],P1[3],P1[4],P1[5],     pw2[0]=PKW(P1,0), pw2[1]=PKW(P1,2), pw2); \
    VRD(6); SBAR(); GAPA(C1=__builtin_amdgcn_mfma_f32_32x32x16_bf16(kf[5],qr[2],C1,0,0,0),   P1[6],P1[7],P1[8],P1[9],     pw2[2]=PKW(P1,4), pw2[3]=PKW(P1,6), pw2); \
    VRD(3); SBAR(); GAPA(C0=__builtin_amdgcn_mfma_f32_32x32x16_bf16(kf[6],qr[3],C0,0,0,0),   P1[10],P1[11],P1[12],P1[13], pw3[0]=PKW(P1,8), pw3[1]=PKW(P1,10), pw3); \
    VRD(7); SBAR(); GAPA(C1=__builtin_amdgcn_mfma_f32_32x32x16_bf16(kf[7],qr[3],C1,0,0,0),   P1[14],P1[15],0.f,0.f,       pw3[2]=PKW(P1,12),pw3[3]=PKW(P1,14), pw3); \
    l_reg+=sacc; \
    if(GK){DMA_K((t)+3,sl_cur);} if(GV){DMA_V((t)+1,sl_next);} \
    BIASADD(C0,C1,t); CMASK(C0,C1,t); \
    { float a=MX3(C0[0],C0[1],C1[0]),b=MX3(C0[2],C0[3],C1[1]); a=MX3(a,C1[2],C1[3]); \
      _Pragma("unroll") for(int r=4;r<16;r+=4){a=MX3(a,C0[r],C0[r+1]);b=MX3(b,C0[r+2],C0[r+3]);a=MX3(a,C1[r],C1[r+1]);b=MX3(b,C1[r+2],C1[r+3]);} \
      float rm=__builtin_fmaxf(a,b); { auto rr=__builtin_amdgcn_permlane32_swap(__float_as_uint(rm),__float_as_uint(rm),false,false); rm=__builtin_fmaxf(__uint_as_float(rr[0]),__uint_as_float(rr[1])); } \
      resc=false; \
      if(__builtin_expect(__any(rm>(float)THRL),0)){ const float dl=__builtin_fmaxf(rm,0.f); mhat+=dl; \
        _Pragma("unroll") for(int r=0;r<16;++r){C0[r]-=dl;C1[r]-=dl;} \
        const float f=__builtin_amdgcn_exp2f(-dl); l_reg*=f; if(hi==0)wsf[r32]=f; resc=true; } } \
    SBAR(); \
    GAPB(o[0]=__builtin_amdgcn_mfma_f32_32x32x16_bf16(PAF(0),VFR(0),o[0],0,0,0), C0,0); \
    GAPB(o[1]=__builtin_amdgcn_mfma_f32_32x32x16_bf16(PAF(0),VFR(4),o[1],0,0,0), C0,4); \
    KRD(GL,0); GAPB(o[0]=__builtin_amdgcn_mfma_f32_32x32x16_bf16(PAF(1),VFR(1),o[0],0,0,0), C0,8); \
    KRD(GL,1); GAPB(o[1]=__builtin_amdgcn_mfma_f32_32x32x16_bf16(PAF(1),VFR(5),o[1],0,0,0), C0,12); \
    KRD(GL,2); GAPB(o[0]=__builtin_amdgcn_mfma_f32_32x32x16_bf16(PAF(2),VFR(2),o[0],0,0,0), C1,0); \
    KRD(GL,3); GAPB(o[1]=__builtin_amdgcn_mfma_f32_32x32x16_bf16(PAF(2),VFR(6),o[1],0,0,0), C1,4); \
    GAPB(o[0]=__builtin_amdgcn_mfma_f32_32x32x16_bf16(PAF(3),VFR(3),o[0],0,0,0), C1,8); \
    GAPB(o[1]=__builtin_amdgcn_mfma_f32_32x32x16_bf16(PAF(3),VFR(7),o[1],0,0,0), C1,12); \
    }while(0)
  int t=1;
  for(int it_=0;it_<2&&t+5<NT;++it_,t+=2){
    STEP(pB0,pB1,pA0,pA1,t,true,true,true);     WAIT_BAR(2); RESC(); ROT();
    STEP(pA0,pA1,pB0,pB1,t+1,true,true,true);   WAIT_BAR(2); RESC(); ROT();
  }
  #undef CMASK
  #define CMASK(P0,P1,t) do{}while(0)
  for(;t+5<NT;t+=2){
    STEP(pB0,pB1,pA0,pA1,t,true,true,true);     WAIT_BAR(2); RESC(); ROT();
    STEP(pA0,pA1,pB0,pB1,t+1,true,true,true);   WAIT_BAR(2); RESC(); ROT();
  }
  #undef CMASK
  #define CMASK(P0,P1,t) do{ if((t)<4){ cmask(P0,P1,3-(t),qrel,hi); } }while(0)
  #define ENDW(tt) do{ if((tt)+3<NT){WAIT_BAR(2);} else if((tt)+2<NT){WAIT_BAR(1);} else {WAIT_BAR(0);} }while(0)
  for(;t+1<NT;t+=2){
    STEP(pB0,pB1,pA0,pA1,t,(t+3<NT),(t+1<NT),(t+1<NT));       ENDW(t);   RESC(); ROT();
    STEP(pA0,pA1,pB0,pB1,t+1,(t+4<NT),(t+2<NT),(t+2<NT));     ENDW(t+1); RESC(); ROT();
  }
  STEP(pB0,pB1,pA0,pA1,NT-1,false,false,false); RESC();
  { float sacc=pB0[0]+pB0[1]; _Pragma("unroll") for(int r=2;r<16;++r)sacc+=pB0[r]; _Pragma("unroll") for(int r=0;r<16;++r)sacc+=pB1[r]; l_reg+=sacc;
    pw0=(u32x4){PKW(pB0,0),PKW(pB0,2),PKW(pB0,4),PKW(pB0,6)};pw1=(u32x4){PKW(pB0,8),PKW(pB0,10),PKW(pB0,12),PKW(pB0,14)};pw2=(u32x4){PKW(pB1,0),PKW(pB1,2),PKW(pB1,4),PKW(pB1,6)};pw3=(u32x4){PKW(pB1,8),PKW(pB1,10),PKW(pB1,12),PKW(pB1,14)};
    SBAR(); pv(o,vb0+sl_cur,PAF(0),PAF(1),PAF(2),PAF(3)); }
  #undef PKW
  #undef PAF
  #undef VFR
  #undef PIN
  #undef MX3
  #undef GAPA
  #undef GAPB
  #undef EX
  #undef VRD
  #undef KRD
  #undef STEP
  #undef ENDW
  {auto rr=__builtin_amdgcn_permlane32_swap(__float_as_uint(l_reg),__float_as_uint(l_reg),false,false);l_reg=__uint_as_float(rr[0])+__uint_as_float(rr[1]);}
  if(hi==0)wsf[32+r32]=l_reg;asm volatile("s_waitcnt lgkmcnt(0)":::"memory");
  float rli[16];
  #pragma unroll
  for(int r=0;r<16;++r)rli[r]=__builtin_amdgcn_rcpf(wsf[32+crow(r,hi)]);
  bf16*Ow=O+(rowbase+q0+wid*QBLK)*DM+h*D;
  { bf16*stg=(bf16*)(shm+LDS_OST)+wid*2048;
    #pragma unroll
    for(int r=0;r<16;++r){const int orow=crow(r,hi);
      #pragma unroll
      for(int d0=0;d0<2;++d0)stg[orow*64+d0*32+r32]=__float2bfloat16(o[d0][r]*rli[r]);}
    asm volatile("s_waitcnt lgkmcnt(0)":::"memory");
    #pragma unroll
    for(int i=0;i<4;++i){const int row=i*8+(lane>>3),ch=lane&7; const u32x4 v=*(const u32x4*)(stg+row*64+ch*8); ATTN_STORE16(Ow+(long)row*DM+ch*8,v);} }
  asm volatile("s_waitcnt lgkmcnt(0)\n\ts_barrier":::"memory");
  #undef BIASADD
  #undef TIDX
  #undef DMA_K
  #undef DMA_V
  #undef CMASK
  #undef START
  #undef RESC
  #undef ROT
}

template<int PITCH> __device__ __forceinline__ void sb_unit(int b,int h,int qb,const bf16*Q,const bf16*__restrict__ K,const bf16*__restrict__ V,bf16*O  ,char*shm){
  int tid_=threadIdx.x; asm volatile("":"+v"(tid_)); const int tid=tid_,lane=tid&63,r32=lane&31,hi=lane>>5; const int wid=__builtin_amdgcn_readfirstlane(tid>>6);
  const long rowbase=(long)b*SEQ; const int q0=qb*QB;
  const bf16*Qw=Q+(rowbase+q0+wid*QBLK)*PITCH+h*D;
  const bf16*Kh=K+rowbase*PITCH+h*D,*Vh=V+rowbase*PITCH+h*D;
  const unsigned lds0=(unsigned)(uintptr_t)shm;
  const bf16*ksrc=Kh+(long)lane*PITCH+wid*8;
  const bf16*vsrc=Vh+(long)(16*(wid&3)+(lane>>2))*PITCH+(wid>>2)*32+(lane&3)*8;
  const unsigned kdst=lds0+LDS_K+wid*1024, vdst=lds0+LDS_V+wid*1024;
  #define SB_DMA(t,slot) do{ glds16(ksrc+(long)(t)*KVBLK*PITCH,(unsigned)__builtin_amdgcn_readfirstlane(kdst+(slot))); glds16(vsrc+(long)(t)*KVBLK*PITCH,(unsigned)__builtin_amdgcn_readfirstlane(vdst+(slot))); }while(0)
  const int vb0=(int)(lds0+LDS_V)+((lane>>4)&1)*32+(lane&3)*8+(4*hi+((lane&15)>>2))*64;
  volatile __attribute__((address_space(3))) unsigned* fl=(volatile __attribute__((address_space(3))) unsigned*)((lds_cptr)shm+LDS_WS);
  const int NT=(q0+QB)/KVBLK; const int qrel=wid*QBLK+r32;
  SB_DMA(NT-1,0);
  bf16x8 qr[4];
  #pragma unroll
  for(int d0=0;d0<4;++d0)qr[d0]=*reinterpret_cast<const bf16x8*>(&Qw[(long)r32*PITCH+d0*16+hi*8]);
  f32x16 o[2];o[0]=f32x16{};o[1]=f32x16{}; const f32x16 zero16=f32x16{};
  float carry=0.f; const float m0=(hi==0)?1.f:0.f;
  int slot=0;
  for(int t=NT-1;t>=0;--t){
    WAIT_BAR(0);
    if(t<NT-1){ const int pb=((t+1)&1)*8; const unsigned a=fl[pb]&fl[pb+1]&fl[pb+2]&fl[pb+3]&fl[pb+4]&fl[pb+5]&fl[pb+6]&fl[pb+7]; if(__builtin_amdgcn_readfirstlane(a)!=0u)break; }
    if(t>0)SB_DMA(t-1,slot^SLOTB);
    f32x16 p0,p1; qkt(p0,p1,shm+LDS_K+slot,qr,zero16,r32,hi);
    if(t>=NT-4){ const int kb=64*(t-(NT-4))+4*hi;
      #pragma unroll
      for(int r=0;r<16;++r){const int kv=kb+(r&3)+8*(r>>2); if(kv>=qrel)p0[r]=-INFINITY; if(kv+32>=qrel)p1[r]=-INFINITY;} }
    f32x16 s0,s1;
    #pragma unroll
    for(int r=0;r<16;++r){ const float z=p0[r]; const float sp=__builtin_fmaxf(z,0.f)+__builtin_amdgcn_logf(1.f+__builtin_amdgcn_exp2f(-__builtin_fabsf(z))); s0[r]=sp; p0[r]=z-sp;
                           const float y=p1[r]; const float sq=__builtin_fmaxf(y,0.f)+__builtin_amdgcn_logf(1.f+__builtin_amdgcn_exp2f(-__builtin_fabsf(y))); s1[r]=sq; p1[r]=y-sq; }
    float lo[8],hv[8];
    #pragma unroll
    for(int i=0;i<8;++i){ const float mine=(i<4)?((s0[4*i]+s0[4*i+1])+(s0[4*i+2]+s0[4*i+3])):((s1[4*i-16]+s1[4*i-15])+(s1[4*i-14]+s1[4*i-13]));
      auto rr=__builtin_amdgcn_permlane32_swap(__float_as_uint(mine),__float_as_uint(mine),false,false); lo[i]=__uint_as_float(rr[0]); hv[i]=__uint_as_float(rr[1]); }
    float sp_=0.f;
    #pragma unroll
    for(int i=7;i>=0;--i){ const float base=carry-(sp_+m0*hv[i]);
      if(i<4){ float a=base; p0[4*i+3]=__builtin_amdgcn_exp2f(p0[4*i+3]+a); a-=s0[4*i+3]; p0[4*i+2]=__builtin_amdgcn_exp2f(p0[4*i+2]+a); a-=s0[4*i+2]; p0[4*i+1]=__builtin_amdgcn_exp2f(p0[4*i+1]+a); a-=s0[4*i+1]; p0[4*i]=__builtin_amdgcn_exp2f(p0[4*i]+a); }
      else   { const int j=4*i-16; float a=base; p1[j+3]=__builtin_amdgcn_exp2f(p1[j+3]+a); a-=s1[j+3]; p1[j+2]=__builtin_amdgcn_exp2f(p1[j+2]+a); a-=s1[j+2]; p1[j+1]=__builtin_amdgcn_exp2f(p1[j+1]+a); a-=s1[j+1]; p1[j]=__builtin_amdgcn_exp2f(p1[j]+a); }
      sp_+=lo[i]+hv[i]; }
    carry-=sp_;
    { u32x4 pw0,pw1,pw2,pw3;
      pw0=(u32x4){cvtpk_s(p0[0],p0[1]),cvtpk_s(p0[2],p0[3]),cvtpk_s(p0[4],p0[5]),cvtpk_s(p0[6],p0[7])}; pw1=(u32x4){cvtpk_s(p0[8],p0[9]),cvtpk_s(p0[10],p0[11]),cvtpk_s(p0[12],p0[13]),cvtpk_s(p0[14],p0[15])};
      pw2=(u32x4){cvtpk_s(p1[0],p1[1]),cvtpk_s(p1[2],p1[3]),cvtpk_s(p1[4],p1[5]),cvtpk_s(p1[6],p1[7])}; pw3=(u32x4){cvtpk_s(p1[8],p1[9]),cvtpk_s(p1[10],p1[11]),cvtpk_s(p1[12],p1[13]),cvtpk_s(p1[14],p1[15])};
      pv(o,vb0+slot,__builtin_bit_cast(bf16x8,pw0),__builtin_bit_cast(bf16x8,pw1),__builtin_bit_cast(bf16x8,pw2),__builtin_bit_cast(bf16x8,pw3)); }
    { const bool done_=__all(carry<-150.f); if(lane==0)fl[(t&1)*8+wid]=done_?1u:0u; }
    slot^=SLOTB;
  }
  asm volatile("s_waitcnt vmcnt(0) lgkmcnt(0)":::"memory");
  bf16*Ow=O+(rowbase+q0+wid*QBLK)*1024+h*D;
  { bf16*stg=(bf16*)(shm+LDS_OST)+wid*2048;
    #pragma unroll
    for(int r=0;r<16;++r){const int orow=crow(r,hi);
      #pragma unroll
      for(int d0=0;d0<2;++d0)stg[orow*64+d0*32+r32]=__float2bfloat16(o[d0][r]);}
    asm volatile("s_waitcnt lgkmcnt(0)":::"memory");
    #pragma unroll
    for(int i=0;i<4;++i){const int row=i*8+(lane>>3),ch=lane&7; const u32x4 v=*(const u32x4*)(stg+row*64+ch*8); ATTN_STORE16(Ow+(long)row*1024+ch*8,v);} }
  asm volatile("s_waitcnt vmcnt(0) lgkmcnt(0)\n\ts_barrier":::"memory");
  #undef SB_DMA
}
constexpr int ATTN_LDS_BYTES=LDS_BYTES;
struct AttnTensors { const bf16* Q; const bf16* K; const bf16* V; bf16* O; const float* logf;   const unsigned* kn;   };
struct AttnUnit { int bh; int qb; };
struct StaticOrder {
  int vcu;
  __device__ __forceinline__ explicit StaticOrder(int grid,int block):vcu((block%8)*(grid/8)+block/8){}
  __device__ __forceinline__ bool next(int i,AttnUnit&u)const{ if(i>=4)return false; const int s=vcu&7; u.bh=vcu>>3; u.qb=(i==0)?s:(i==1)?15-s:(i==2)?16+s:31-s; return true; }
  __device__ __forceinline__ void a_ready(const AttnUnit&)const{}
  __device__ __forceinline__ void done(const AttnUnit&)const{}
};
template<class Sched,int THRL=8> __device__ __forceinline__ void attn_phase(char*lds,const AttnTensors&T,const Sched&S){
  AttnUnit u;
  for(int i=0;S.next(i,u);++i){ S.a_ready(u); attn_unit<THRL>(u.bh/NHEAD,u.bh%NHEAD,u.qb,T.Q,T.K,T.V,T.O,lds,T.logf+(size_t)u.bh*SEQ,T.kn+(size_t)u.bh*256); S.done(u); }
}
#undef SBAR
#undef WAIT_BAR
}
constexpr int NWAVES = 8, NTHREADS = NWAVES * 64;
constexpr int BATCH = 2, SEQ = 8192, D = 1024, M = BATCH * SEQ;
constexpr int S5G = 32, S5H = 16, S5P = 64, S5T = 32  , S5NC = M / S5T  , S5KX = 640  ;
constexpr int SBH = 8, FOXH = 16, HD = 64;
constexpr int EVEN_IN = 2048, ODD_IN = 3088, DFF = 2816, NEXP = 8, DFE = 3584;
constexpr float C2 = 0.125f * 1.4426950408889634f;
constexpr int MOE_CHUNK_PANELS = 68, MOE_MAX_PANELS = 136, MOE_MAX_SLOTS = MOE_MAX_PANELS * 256;

constexpr size_t MiB = 1u << 20;
constexpr size_t WS_CTL = 0, CTL_ZERO_BYTES = 1 * MiB;
constexpr size_t WS_WMOE_GU = 1 * MiB;
constexpr size_t WS_WMOE_D = 57 * MiB;
constexpr size_t WS_WIN0 = 85 * MiB;
constexpr size_t WS_WGLU = 89 * MiB;
constexpr size_t WS_WOUT0 = 90 * MiB;
constexpr size_t WS_WGU0 = 92 * MiB;
constexpr size_t WS_WD0 = 103 * MiB;
constexpr size_t WS_WIN1 = 109 * MiB;
constexpr size_t WS_WF1 = 115 * MiB;
constexpr size_t WS_WOUT1 = 116 * MiB;
constexpr size_t WS_S5WA = 118 * MiB;
constexpr size_t WS_S5WC = 126 * MiB;
constexpr size_t WS_XB = 146 * MiB;
constexpr size_t WS_SSP = 178 * MiB;
constexpr size_t WS_META = 182 * MiB;
constexpr size_t WS_LOGF = 183 * MiB;
constexpr size_t WS_QKV0 = 184 * MiB;
constexpr size_t WS_UEXT = 232 * MiB;
constexpr size_t WS_SLOC = 252 * MiB;
constexpr size_t WS_YG = 260 * MiB;
constexpr size_t WS_MIXB = 276 * MiB;
constexpr size_t WS_HID0 = 184 * MiB;
constexpr size_t WS_QKV1 = 184 * MiB;
constexpr size_t WS_XG = 184 * MiB;
constexpr size_t WS_HMOE = 218 * MiB;
constexpr size_t WS_Y = 85 * MiB;
constexpr size_t WS_END = 337 * MiB;
static_assert(WS_XG + (size_t)MOE_MAX_SLOTS * 1024 <= WS_HMOE && WS_HMOE + (size_t)MOE_MAX_SLOTS * DFE <= WS_END && WS_Y + (size_t)MOE_MAX_SLOTS * 1024 * 2 <= WS_XB + 32 * MiB && WS_MIXB + 32 * MiB <= WS_END, "ws map");
constexpr size_t MT_RSTD = 0, MT_TOKE = 65536, MT_TOKP = 131072, MT_TOKG = 262144, MT_TOKSLOT = 393216, MT_RSS = 524288;
constexpr int CW_TMO = 0, CW_CODE = 1, CW_BAR = 4096, CW_CNT = 8192  , CW_QUEUE = 12288  , CW_KN = 16384  , CW_SS = 32768  ;

constexpr int RING_OFF = 0, RING_BYTES = 131072;
constexpr int LDSCTL_OFF = 133120  , MISC_OFF = LDSCTL_OFF + 320;
constexpr int LDS_BYTES = 147456;

#define GAS __attribute__((address_space(1)))
#define LAS __attribute__((address_space(3)))
typedef unsigned short bf16;
typedef unsigned v4u __attribute__((ext_vector_type(4)));
typedef unsigned v2u __attribute__((ext_vector_type(2)));
typedef float f32x4 __attribute__((ext_vector_type(4)));
typedef short bf16x8 __attribute__((ext_vector_type(8)));
typedef GAS unsigned gu32;
#define RLX_AGENT __ATOMIC_RELAXED, __HIP_MEMORY_SCOPE_AGENT
#define LDS_WAIT() asm volatile("s_waitcnt lgkmcnt(0)" ::: "memory")
#define VM_WAIT() asm volatile("s_waitcnt vmcnt(0)" ::: "memory")
__device__ __forceinline__ unsigned f2bf(float f) { unsigned u = __builtin_bit_cast(unsigned, f); return (u + 0x7fffu + ((u >> 16) & 1u)) >> 16; }
__device__ __forceinline__ unsigned pk2(float lo, float hi) { return f2bf(lo) | (f2bf(hi) << 16); }
__device__ __forceinline__ float bflo(unsigned w) { return __uint_as_float(w << 16); }
__device__ __forceinline__ float bfhi(unsigned w) { return __uint_as_float(w & 0xffff0000u); }

#define XB_TMO      128
#define XB_XCNT(j)  (256  + 64 * (j))
#define XB_XSUB(j)  (1280 + 64 * (j))
#define XB_XGEN(j)  (2304 + 64 * (j))
#define XB_TOP      3328
#define XB_TOPGEN   3392
#define XCD_BAR_WORDS 3456
#define XB_SPIN_CAP (1u << 18)
__device__ __forceinline__ unsigned xb_ld(unsigned* p)              { return __hip_atomic_load(p, __ATOMIC_RELAXED, __HIP_MEMORY_SCOPE_AGENT); }
__device__ __forceinline__ unsigned xb_add(unsigned* p, unsigned v) { return __hip_atomic_fetch_add(p, v, __ATOMIC_RELAXED, __HIP_MEMORY_SCOPE_AGENT); }
__device__ __forceinline__ unsigned xb_xcc_id() { return (unsigned)__builtin_amdgcn_s_getreg((3 << 11) | 20) & 0xFu; }
#define XB_SPIN(cond, bar) do { unsigned _sp = 0; while (cond) { __builtin_amdgcn_s_sleep(1); \
    if ((++_sp & 255u) == 0u) { if (xb_ld(&(bar)[XB_TMO])) break; if (_sp > XB_SPIN_CAP) { atomicAdd(&(bar)[XB_TMO], 1u); break; } } } } while (0)
struct XcdBarrier { unsigned* bar; unsigned x; volatile LAS unsigned* st; };
__device__ __forceinline__ XcdBarrier xcd_barrier_post(unsigned* bar, volatile LAS unsigned* st) {
    XcdBarrier b; b.bar = bar; b.x = xb_xcc_id(); b.st = st;
    if (threadIdx.x == 0) (void)xb_add(&bar[XB_XCNT(b.x)], 1u);
    return b;
}
__device__ __forceinline__ void xcd_barrier_complete(unsigned* bar, unsigned x, unsigned& nloc, unsigned& nx) {
    const unsigned G = gridDim.x * gridDim.y * gridDim.z;
    unsigned sum, cnt, mine, sp = 0u;
    for (;;) {
        sum = 0u; cnt = 0u; mine = 0u;
#pragma unroll
        for (unsigned j = 0; j < 16; ++j) { const unsigned c = xb_ld(&bar[XB_XCNT(j)]); sum += c; cnt += (c > 0u) ? 1u : 0u; mine = (j == x) ? c : mine; }
        if (sum == G) break;
        __builtin_amdgcn_s_sleep(1);
        if ((++sp & 255u) == 0u) { if (xb_ld(&bar[XB_TMO])) break; if (sp > XB_SPIN_CAP) { atomicAdd(&bar[XB_TMO], 1u); break; } }
    }
    nloc = mine > 0u ? mine : 1u; nx = cnt > 0u ? cnt : 1u;
}
__device__ __forceinline__ void xcd_barrier(const XcdBarrier& b) {
    asm volatile("s_waitcnt vmcnt(0)" ::: "memory");
    __syncthreads();
    if (threadIdx.x == 0) {
        unsigned* bar = b.bar;
        __builtin_amdgcn_s_waitcnt(0);
        unsigned nloc = b.st[0], nx = b.st[1];
        if (nloc == 0u) { xcd_barrier_complete(bar, b.x, nloc, nx); b.st[0] = nloc; b.st[1] = nx; }
        const unsigned old = xb_add(&bar[XB_XSUB(b.x)], 1u);
        const unsigned gen = old / nloc;
        if (old + 1u == (gen + 1u) * nloc) {
            __builtin_amdgcn_fence(__ATOMIC_RELEASE, "agent");
            asm volatile("s_waitcnt vmcnt(0)" ::: "memory");
            const unsigned og = xb_add(&bar[XB_TOP], 1u);
            const unsigned tg = og / nx;
            if (og + 1u == (tg + 1u) * nx) xb_add(&bar[XB_TOPGEN], 1u);
            else XB_SPIN(xb_ld(&bar[XB_TOPGEN]) == tg, bar);
            __builtin_amdgcn_fence(__ATOMIC_ACQUIRE, "agent");
            xb_add(&bar[XB_XGEN(b.x)], 1u);
            asm volatile("s_waitcnt vmcnt(0)" ::: "memory");
        } else {
            XB_SPIN(xb_ld(&bar[XB_XGEN(b.x)]) == gen, bar);
            __builtin_amdgcn_fence(__ATOMIC_ACQUIRE, "agent");
            asm volatile("s_waitcnt vmcnt(0)" ::: "memory");
        }
    }
    __syncthreads();
}

__device__ __forceinline__ float wave_sum(float v) {
#pragma unroll
    for (int o = 1; o < 64; o <<= 1) v += __shfl_xor(v, o);
    return v;
}
constexpr int XP = 65, XSCR_BYTES = 64 * XP * 4;
__device__ __forceinline__ unsigned cvtpk(float lo, float hi) { unsigned r; asm volatile("v_cvt_pk_bf16_f32 %0, %1, %2" : "=v"(r) : "v"(lo), "v"(hi)); return r; }
__device__ __forceinline__ void p0_transpose_item(const float* W, int ldw, int k0, int n0, const float* gs, bf16* dst, int ldd, LAS float* scr, int lane) {
    const int lr = lane >> 4, lc = (lane & 15) * 4;
    const float* src = W + (size_t)(k0 + lr) * ldw + n0 + lc;
    f32x4 v[16];
#pragma unroll
    for (int i = 0; i < 16; ++i) v[i] = *(const GAS f32x4*)(src + (size_t)(4 * i) * ldw);
    if (gs) {
#pragma unroll
        for (int i = 0; i < 16; ++i) v[i] = v[i] * gs[k0 + 4 * i + lr]; }
#pragma unroll
    for (int i = 0; i < 16; ++i) { LAS float* p = scr + (4 * i + lr) * XP + lc; p[0] = v[i][0]; p[1] = v[i][1]; p[2] = v[i][2]; p[3] = v[i][3]; }
    LDS_WAIT(); asm volatile("" ::: "memory");
    const int c = lane & 7, nn = lane >> 3;
#pragma unroll
    for (int j = 0; j < 8; ++j) { const int n = nn + 8 * j; const LAS float* sp = scr + (8 * c) * XP + n;
        v4u o; o.x = cvtpk(sp[0 * XP], sp[1 * XP]); o.y = cvtpk(sp[2 * XP], sp[3 * XP]); o.z = cvtpk(sp[4 * XP], sp[5 * XP]); o.w = cvtpk(sp[6 * XP], sp[7 * XP]);
        *(GAS v4u*)(dst + (size_t)n * ldd + k0 + 8 * c) = o; }
    LDS_WAIT(); asm volatile("" ::: "memory");
}
__device__ __forceinline__ void p0_transpose_item_fp8(const float* W, int ldw, int k0, int n0, const float* gs, float wscale, unsigned char* dst, int ldd, LAS float* scr, int lane) {
    const int lr = lane >> 4, lc = (lane & 15) * 4;
    const float* src = W + (size_t)(k0 + lr) * ldw + n0 + lc;
    f32x4 v[16];
#pragma unroll
    for (int i = 0; i < 16; ++i) v[i] = *(const GAS f32x4*)(src + (size_t)(4 * i) * ldw);
#pragma unroll
    for (int i = 0; i < 16; ++i) v[i] = v[i] * (gs ? gs[k0 + 4 * i + lr] * wscale : wscale);
#pragma unroll
    for (int i = 0; i < 16; ++i) { LAS float* p = scr + (4 * i + lr) * XP + lc; p[0] = v[i][0]; p[1] = v[i][1]; p[2] = v[i][2]; p[3] = v[i][3]; }
    LDS_WAIT(); asm volatile("" ::: "memory");
    const int c = lane & 3, nn = lane >> 2;
#pragma unroll
    for (int j = 0; j < 4; ++j) { const int n = nn + 16 * j; const LAS float* sp = scr + (16 * c) * XP + n;
        v4u o; o.x = pg8::pk_fp8x4(sp[0 * XP], sp[1 * XP], sp[2 * XP], sp[3 * XP]); o.y = pg8::pk_fp8x4(sp[4 * XP], sp[5 * XP], sp[6 * XP], sp[7 * XP]);
        o.z = pg8::pk_fp8x4(sp[8 * XP], sp[9 * XP], sp[10 * XP], sp[11 * XP]); o.w = pg8::pk_fp8x4(sp[12 * XP], sp[13 * XP], sp[14 * XP], sp[15 * XP]);
        *(GAS v4u*)(dst + (size_t)n * ldd + k0 + 16 * c) = o; }
    LDS_WAIT(); asm volatile("" ::: "memory");
}
__device__ __forceinline__ void xpose_mat_fp8(int item, const float* W, int ldw, int N, const float* gs, float wscale, unsigned char* dst, int ldd, int mode, LAS float* scr, int lane) {
    const int nblk = N / 64, kb = item / nblk, nb = item % nblk, n0 = 64 * nb;
    const int row = mode == 0 ? n0 : ((n0 >> 7) * 256 + (n0 & 127) + (mode == 2 ? 128 : 0));
    p0_transpose_item_fp8(W, ldw, 64 * kb, n0, gs, wscale, dst + (size_t)row * ldd, ldd, scr, lane);
}
__device__ __forceinline__ void xpose_mat(int item, const float* W, int ldw, int N, const float* gs, bf16* dst, int ldd, int mode, LAS float* scr, int lane) {
    const int nblk = N / 64, kb = item / nblk, nb = item % nblk, n0 = 64 * nb;
    const int row = mode == 0 ? n0 : ((n0 >> 7) * 256 + (n0 & 127) + (mode == 2 ? 128 : 0));
    p0_transpose_item(W, ldw, 64 * kb, n0, gs, dst + (size_t)row * ldd, ldd, scr, lane);
}

struct Args { const float* in[28]; float* out; unsigned char* ws; };

__device__ __forceinline__ void s5_tables(const Args& a, int g, int q, LAS unsigned char* lds, int tid) {
    LAS float* POWr = (LAS float*)lds;
    LAS float* POWi = POWr + 33 * 64;
    LAS float* BBr = POWi + 33 * 64;
    LAS float* BBi = BBr + 1024;
    LAS float* CCr = BBi + 1024;
    LAS float* CCi = CCr + 1024;
    LAS float* KT = CCi + 1024;
    LAS float* DD = KT + 2048;
    const float* a_re = a.in[3]; const float* a_im = a.in[4]; const float* b_re = a.in[5]; const float* b_im = a.in[6];
    const float* c_re = a.in[7]; const float* c_im = a.in[8]; const float* dsk = a.in[9]; const float* log_step = a.in[10];
    const float step = expf(log_step[g]);
    __syncthreads();
    for (int e = tid; e < 33 * 64; e += NTHREADS) { const int n = e >> 6, p = e & 63; const float lr = a_re[g * 64 + p], li = a_im[g * 64 + p];
        const float mag = expf((float)n * step * lr); float sn, cs; sincosf((float)n * (step * li), &sn, &cs); POWr[e] = mag * cs; POWi[e] = mag * sn; }
    for (int e = tid; e < 1024; e += NTHREADS) { const int p = e >> 4, h = e & 15; const float lr = a_re[g * 64 + p], li = a_im[g * 64 + p];
        const float er = expf(lr * step); float sn, cs; sincosf(li * step, &sn, &cs); const float nr = er * cs - 1.f, ni = er * sn, den = lr * lr + li * li;
        const float fr = (nr * lr + ni * li) / den, fi = (ni * lr - nr * li) / den;
        const float br = b_re[(g * 64 + p) * 16 + h], bi = b_im[(g * 64 + p) * 16 + h];
        BBr[e] = fr * br - fi * bi; BBi[e] = fr * bi + fi * br;
        CCr[e] = c_re[g * 1024 + e]; CCi[e] = c_im[g * 1024 + e]; }
    if (tid < 16) DD[tid] = dsk[g * 16 + tid];
    __syncthreads();
    for (int e = tid; e < 2048; e += NTHREADS) { const int tau = e >> 6, hl = (e >> 4) & 3, hi = e & 15, ho = 4 * q + hl; float sacc = 0.f;
        for (int p = 0; p < 64; ++p) { const float cr = CCr[ho * 64 + p], ci = CCi[ho * 64 + p], pr = POWr[tau * 64 + p], pi = POWi[tau * 64 + p];
            const float xr = cr * pr - ci * pi, xi = cr * pi + ci * pr; sacc += xr * BBr[p * 16 + hi] - xi * BBi[p * 16 + hi]; }
        if (tau == 0 && ho == hi) sacc += DD[ho];
        KT[e] = sacc; }
    __syncthreads();
    bf16* WA = (bf16*)(a.ws + WS_S5WA) + (size_t)g * 256 * 512;
    for (int pc = tid; pc < 64 * 64; pc += NTHREADS) { const int p = pc >> 6, k0 = (pc & 63) * 8; v4u o = (v4u){0u, 0u, 0u, 0u};
        if (q < 2) { const int j = k0 >> 4, h0 = k0 & 15; const float pr = POWr[(31 - j) * 64 + p], pi = POWi[(31 - j) * 64 + p]; float v[8];
#pragma unroll
            for (int w = 0; w < 8; ++w) { const float br = BBr[p * 16 + h0 + w], bi = BBi[p * 16 + h0 + w]; v[w] = (q == 0) ? (pr * br - pi * bi) : (pr * bi + pi * br); }
            o.x = cvtpk(v[0], v[1]); o.y = cvtpk(v[2], v[3]); o.z = cvtpk(v[4], v[5]); o.w = cvtpk(v[6], v[7]); }
        *(GAS v4u*)(WA + (size_t)(64 * q + p) * 512 + k0) = o; }
    bf16* WC = (bf16*)(a.ws + WS_S5WC) + (size_t)g * 512 * 640;
    for (int pc = tid; pc < 128 * 80; pc += NTHREADS) { const int rl = pc / 80, k0 = (pc % 80) * 8, i = rl >> 2, hl = rl & 3, ho = 4 * q + hl; float v[8];
        if (k0 < 512) { const int j = k0 >> 4, h0 = k0 & 15;
#pragma unroll
            for (int w = 0; w < 8; ++w) v[w] = (j <= i) ? KT[((i - j) * 4 + hl) * 16 + h0 + w] : 0.f; }
        else { const int p0 = (k0 - 512) & 63; const bool im = k0 >= 576;
#pragma unroll
            for (int w = 0; w < 8; ++w) { const int p = p0 + w; const float cr = CCr[ho * 64 + p], ci = CCi[ho * 64 + p], pr = POWr[(i + 1) * 64 + p], pi = POWi[(i + 1) * 64 + p];
                v[w] = im ? -(cr * pi + ci * pr) : (cr * pr - ci * pi); } }
        v4u o; o.x = cvtpk(v[0], v[1]); o.y = cvtpk(v[2], v[3]); o.z = cvtpk(v[4], v[5]); o.w = cvtpk(v[6], v[7]);
        *(GAS v4u*)(WC + (size_t)(i * 16 + ho) * 640 + k0) = o; }
    __syncthreads();
}

__device__ __forceinline__ void p0_prologue(const Args& a, LAS unsigned char* lds, int tid, int lane, int wave, int vcu, int G) {
    for (int it = vcu; it < 4 * S5G; it += G) s5_tables(a, it >> 2, it & 3, lds, tid);
    LAS float* scr = (LAS float*)(lds + wave * XSCR_BYTES);
    const int gw = vcu * NWAVES + wave, NGW = G * NWAVES;
    constexpr int I_IN0 = 16 * 32, I_GLU = 8 * 8, I_OUT = 16 * 16, I_GU0 = 16 * 44, I_D0 = 44 * 16, I_IN1 = 16 * 48, I_MOE = 896;
    constexpr int NITEMS = I_IN0 + I_GLU + I_OUT + 2 * I_GU0 + I_D0 + I_IN1 + I_OUT + 24 * I_MOE;
    unsigned char* ws = a.ws;
    for (int it = NITEMS - 1 - gw; it >= 0; it -= NGW) {
        int r = it;
        if (r < I_IN0) { xpose_mat(r, a.in[2], EVEN_IN, EVEN_IN, a.in[1], (bf16*)(ws + WS_WIN0), D, 0, scr, lane); continue; } r -= I_IN0;
        if (r < I_GLU) { xpose_mat(r, a.in[11], 512, 512, nullptr, (bf16*)(ws + WS_WGLU), 512, 0, scr, lane); continue; } r -= I_GLU;
        if (r < I_OUT) { xpose_mat(r, a.in[13], D, D, nullptr, (bf16*)(ws + WS_WOUT0), D, 0, scr, lane); continue; } r -= I_OUT;
        if (r < I_GU0) { xpose_mat(r, a.in[15], DFF, DFF, a.in[14], (bf16*)(ws + WS_WGU0), D, 1, scr, lane); continue; } r -= I_GU0;
        if (r < I_GU0) { xpose_mat(r, a.in[16], DFF, DFF, a.in[14], (bf16*)(ws + WS_WGU0), D, 2, scr, lane); continue; } r -= I_GU0;
        if (r < I_D0) { xpose_mat(r, a.in[17], D, D, nullptr, (bf16*)(ws + WS_WD0), DFF, 0, scr, lane); continue; } r -= I_D0;
        if (r < I_IN1) { xpose_mat(r, a.in[19], ODD_IN, 3072, a.in[18], (bf16*)(ws + WS_WIN1), D, 0, scr, lane); continue; } r -= I_IN1;
        if (r < I_OUT) { xpose_mat(r, a.in[21], D, D, nullptr, (bf16*)(ws + WS_WOUT1), D, 0, scr, lane); continue; } r -= I_OUT;
        const int mat = r / I_MOE, e = mat / 3, which = mat % 3; r -= mat * I_MOE;
        if (which == 0) xpose_mat_fp8(r, a.in[24] + (size_t)e * D * DFE, DFE, DFE, a.in[22], 64.f, ws + WS_WMOE_GU + (size_t)e * 7168 * 1024, D, 1, scr, lane);
        else if (which == 1) xpose_mat_fp8(r, a.in[25] + (size_t)e * D * DFE, DFE, DFE, a.in[22], 64.f, ws + WS_WMOE_GU + (size_t)e * 7168 * 1024, D, 2, scr, lane);
        else xpose_mat_fp8(r, a.in[26] + (size_t)e * DFE * D, D, D, nullptr, 64.f, ws + WS_WMOE_D + (size_t)e * 1024 * 3584, DFE, 0, scr, lane);
    }
    { const int gt = vcu * NTHREADS + tid; if (gt < 16 * 1024) { const int h = gt >> 10, k = gt & 1023; ((bf16*)(ws + WS_WF1))[gt] = (bf16)f2bf(a.in[19][(size_t)k * ODD_IN + 3072 + h] * a.in[18][k]); } }
    float* ss0 = (float*)(ws + WS_SSP);
    for (int m = gw; m < M; m += NGW) {
        const GAS f32x4* xr = (const GAS f32x4*)(a.in[0] + (size_t)m * D) + lane; GAS v2u* o8 = (GAS v2u*)((bf16*)(ws + WS_XB) + (size_t)m * D) + lane; float s = 0.f;
#pragma unroll
        for (int j = 0; j < 4; ++j) { const f32x4 v = xr[64 * j]; s += (v.x * v.x + v.y * v.y) + (v.z * v.z + v.w * v.w); v2u w; w.x = pk2(v.x, v.y); w.y = pk2(v.z, v.w); o8[64 * j] = w; }
        s = wave_sum(s); if (lane < 16) ss0[(size_t)m * 16 + lane] = (lane == 0) ? s : 0.f;
    }
}

__device__ __forceinline__ void s5_scan(const Args& a, int gt  ) {
    if (gt >= BATCH * S5G * S5P) return;
    const int b = gt / (S5G * S5P), g = (gt / S5P) % S5G, p = gt % S5P;
    const float step = expf(a.in[10][g]); const float lr = a.in[3][g * 64 + p], li = a.in[4][g * 64 + p];
    const float mag = expf((float)S5T * step * lr); float sn, cs; sincosf((float)S5T * (step * li), &sn, &cs); const float ar = mag * cs, ai = mag * sn;
    const float* sl = (const float*)(a.ws + WS_SLOC) + ((size_t)g * S5NC + b * 256) * 128 + p;
    bf16* ue = (bf16*)(a.ws + WS_UEXT) + ((size_t)g * S5NC + b * 256) * S5KX + 512 + p;
    float sr = 0.f, si = 0.f;
#pragma unroll 8
    for (int c = 0; c < 256; ++c) {
        ue[(size_t)c * S5KX] = (bf16)f2bf(sr); ue[(size_t)c * S5KX + 64] = (bf16)f2bf(si);
        const float lr_ = sl[(size_t)c * 128], li_ = sl[(size_t)c * 128 + 64];
        const float nr = ar * sr - ai * si + lr_, ni = ar * si + ai * sr + li_; sr = nr; si = ni;
    }
}

__device__ __forceinline__ float softplus2(float z) { return fmaxf(z, 0.f) + __builtin_amdgcn_logf(1.0f + __builtin_amdgcn_exp2f(-fabsf(z))); }
__device__ __forceinline__ void stage_kv32(const bf16* kp, const bf16* vp, size_t pitch, LAS float* sK, LAS float* sV, int tid) {
    const int r = tid >> 4, c = (tid & 15) * 4;
    const v2u kw = *(const v2u*)(kp + (size_t)r * pitch + c), vw = *(const v2u*)(vp + (size_t)r * pitch + c);
    *(LAS f32x4*)(sK + r * 64 + c) = (f32x4){bflo(kw.x), bfhi(kw.x), bflo(kw.y), bfhi(kw.y)};
    *(LAS f32x4*)(sV + r * 64 + c) = (f32x4){bflo(vw.x), bfhi(vw.x), bflo(vw.y), bfhi(vw.y)};
}
__device__ __forceinline__ void sb_simple_unit(const bf16* qkv  , bf16* mix  , int b, int h, int blk, LAS unsigned char* lds, int tid) {
    const int lane = tid & 63, wave_ = tid >> 6;
    LAS float* sK = (LAS float*)lds; LAS float* sV = sK + 32 * 64;
    const int t = blk * 512 + tid; const size_t rb = (size_t)b * SEQ;
    float q[HD], acc[HD];
    { const v4u* qp = (const v4u*)(qkv + (rb + t) * 1536 + h * HD);
#pragma unroll
      for (int i = 0; i < 8; ++i) { const v4u w = qp[i]; q[8 * i] = bflo(w.x); q[8 * i + 1] = bfhi(w.x); q[8 * i + 2] = bflo(w.y); q[8 * i + 3] = bfhi(w.y); q[8 * i + 4] = bflo(w.z); q[8 * i + 5] = bfhi(w.z); q[8 * i + 6] = bflo(w.w); q[8 * i + 7] = bfhi(w.w); }
#pragma unroll
      for (int i = 0; i < HD; ++i) acc[i] = 0.f; }
    float carry = 0.f;
    for (int c0 = blk * 512 + 480; c0 >= 0; c0 -= 32) {
        __syncthreads();
        stage_kv32(qkv + (rb + c0) * 1536 + 512 + h * HD, qkv + (rb + c0) * 1536 + 1024 + h * HD, 1536, sK, sV, tid);
        __syncthreads();
        for (int r = 31; r >= 0; --r) { const int s = c0 + r;
            if (s < t) { float z = 0.f;
#pragma unroll
                for (int i = 0; i < HD; ++i) z = fmaf(q[i], sK[r * 64 + i], z);
                const float sp = softplus2(z); const float w = __builtin_amdgcn_exp2f(z - sp + carry); carry -= sp;
#pragma unroll
                for (int i = 0; i < HD; ++i) acc[i] = fmaf(w, sV[r * 64 + i], acc[i]); } }
        { LAS unsigned* fl = (LAS unsigned*)(lds + 16384); if (lane == 0) fl[wave_] = __all(carry < -150.f) ? 1u : 0u; __syncthreads();
          if ((fl[0] & fl[1] & fl[2] & fl[3] & fl[4] & fl[5] & fl[6] & fl[7]) != 0u) break; }
    }
    v4u* op = (v4u*)(mix + (rb + t) * 1024 + 512 + h * HD);
#pragma unroll
    for (int i = 0; i < 8; ++i) { v4u w; w.x = pk2(acc[8 * i], acc[8 * i + 1]); w.y = pk2(acc[8 * i + 2], acc[8 * i + 3]); w.z = pk2(acc[8 * i + 4], acc[8 * i + 5]); w.w = pk2(acc[8 * i + 6], acc[8 * i + 7]); op[i] = w; }
}
__device__ __forceinline__ void fgate_rows16(const bf16* xb, const bf16* wf, const float* ss, const float* bfv, float* logf, int r0, int lane) {
    const int fr = lane & 15, fq = lane >> 4;
    const bf16x8* ap = (const bf16x8*)(xb + (size_t)(r0 + fr) * D + fq * 8);
    const bf16x8* bp = (const bf16x8*)(wf + (size_t)fr * D + fq * 8);
    f32x4 acc = (f32x4){0.f, 0.f, 0.f, 0.f};
#pragma unroll 8
    for (int kk = 0; kk < 32; ++kk) acc = __builtin_amdgcn_mfma_f32_16x16x32_bf16(ap[kk * 4], bp[kk * 4], acc, 0, 0, 0);
    const float bias = bfv[fr];
#pragma unroll
    for (int j = 0; j < 4; ++j) { const int row = r0 + fq * 4 + j; const float rs = pg8::rstd16(ss, row);
        const float z = acc[j] * rs + bias;
        const float lf = -(fmaxf(-z, 0.f) + log1pf(expf(-fabsf(z)))) * 1.4426950408889634f;
        const int b = row >> 13, t = row & 8191; logf[((size_t)b * FOXH + fr) * SEQ + t] = lf; }
}

struct MoeOrder {
    pg8::StaticOrder S; int lo; int pref[NEXP + 1];
    __device__ __forceinline__ bool next(int i, pg8::Unit& u) const {
        if (!S.next(i, u)) return false;
        u.pm += lo; int e = 0;
#pragma unroll
        for (int k = 1; k < NEXP; ++k) e += (u.pm >= pref[k]) ? 1 : 0;
        u.zb = e; return true;
    }
    __device__ __forceinline__ void a_ready(const pg8::Unit&) const {}
    __device__ __forceinline__ void done(const pg8::Unit&) const {}
};

__global__ void __launch_bounds__(NTHREADS, 2) mk_fwd(Args args) {
    extern __shared__ __attribute__((aligned(16))) unsigned char lds_raw[];
    LAS unsigned char* lds = (LAS unsigned char*)lds_raw;
    volatile LAS unsigned* MISC = (volatile LAS unsigned*)(lds + MISC_OFF);
    const int tid = threadIdx.x, lane = tid & 63, wave = __builtin_amdgcn_readfirstlane(tid >> 6);
    const int G = gridDim.x; const int bx = blockIdx.x; const int vcu = (G % 8 == 0) ? (bx % 8) * (G / 8) + bx / 8 : bx;
    unsigned char* ws = args.ws;
    gu32* ctl = (gu32*)(ws + WS_CTL);
    for (int u = tid; u < (LDS_BYTES - LDSCTL_OFF) / 4; u += NTHREADS) ((LAS unsigned*)(lds + LDSCTL_OFF))[u] = 0u;
    __syncthreads();
    XcdBarrier bar = xcd_barrier_post((unsigned*)(ctl + CW_BAR), MISC + 8);
    const int gw = vcu * NWAVES + wave, NGW = G * NWAVES;
    float* SS = (float*)(ws + WS_SSP);
    float* X = args.out;
    bf16* XB = (bf16*)(ws + WS_XB);
#define GRID_BAR() xcd_barrier(bar)
#define GEMM_PHASE(EPI, SCHED, lds_, g_, S_, E_) pg8::gemm_phase<EPI, SCHED, true, true>(lds_, g_, S_, E_)

    p0_prologue(args, lds, tid, lane, wave, vcu, G);
    GRID_BAR();
    { pg8::Gemm g{XB, (const bf16*)(ws + WS_WIN0), D, D, D, 0, 0}; pg8::StaticOrder S; S.init(M, EVEN_IN, 1, G, bx);
      pg8::EpiInProj0 E{SS, (bf16*)(ws + WS_UEXT), (bf16*)(ws + WS_QKV0), C2};
      GEMM_PHASE(pg8::EpiInProj0, pg8::StaticOrder, lds + RING_OFF, g, S, E); }
    GRID_BAR();
    { pg8::Gemm g{(const bf16*)(ws + WS_UEXT), (const bf16*)(ws + WS_S5WA), S5KX, 512, 512, (size_t)S5NC * S5KX * 2, (size_t)256 * 512 * 2}; pg8::StaticOrder S; S.init(S5NC, 256, S5G, G, bx);
      pg8::EpiS5State E{(float*)(ws + WS_SLOC)};
      GEMM_PHASE(pg8::EpiS5State, pg8::StaticOrder, lds + RING_OFF, g, S, E); }
    GRID_BAR();
    s5_scan(args, vcu * NTHREADS + tid);
    GRID_BAR();
    { pg8::Gemm g{(const bf16*)(ws + WS_UEXT), (const bf16*)(ws + WS_S5WC), S5KX, S5KX, S5KX, (size_t)S5NC * S5KX * 2, (size_t)512 * S5KX * 2}; pg8::StaticOrder S; S.init(S5NC, 512, S5G, G, bx);
      pg8::EpiS5Y E{(bf16*)(ws + WS_YG)};
      GEMM_PHASE(pg8::EpiS5Y, pg8::StaticOrder, lds + RING_OFF, g, S, E); }
    GRID_BAR();
    { pg8::Gemm g{(const bf16*)(ws + WS_YG), (const bf16*)(ws + WS_WGLU), 512, 512, 512, 0, 0}; pg8::StaticOrder S; S.init(M, 512, 1, G, bx);
      pg8::EpiGlu E{(const bf16*)(ws + WS_YG), args.in[12], (bf16*)(ws + WS_MIXB)};
      GEMM_PHASE(pg8::EpiGlu, pg8::StaticOrder, lds + RING_OFF, g, S, E); }
    __syncthreads();
    for (int L = vcu; L < BATCH * SBH * 32; L += G) { const int bh = L >> 5, qb = (L & 256) ? (L & 31) : 31 - (L & 31);
        attn_body::sb_unit<1536>(bh >> 3, bh & 7, qb, (const attn_body::bf16*)(ws + WS_QKV0), (const attn_body::bf16*)(ws + WS_QKV0) + 512, (const attn_body::bf16*)(ws + WS_QKV0) + 1024, (attn_body::bf16*)(ws + WS_MIXB) + 512, (char*)lds_raw + RING_OFF); }
    GRID_BAR();
    { pg8::Gemm g{(const bf16*)(ws + WS_MIXB), (const bf16*)(ws + WS_WOUT0), D, D, D, 0, 0}; pg8::StaticOrder S; S.init(M, D, 1, G, bx);
      pg8::EpiResid E{args.in[0], X, XB, SS + 16 * M};
      GEMM_PHASE(pg8::EpiResid, pg8::StaticOrder, lds + RING_OFF, g, S, E); }
    GRID_BAR();
    { pg8::Gemm g{XB, (const bf16*)(ws + WS_WGU0), D, D, D, 0, 0}; pg8::StaticOrder S; S.init(M, 2 * DFF, 1, G, bx);
      pg8::EpiSwiGlu<true> E{SS + 16 * M, (bf16*)(ws + WS_HID0), DFF};
      GEMM_PHASE(pg8::EpiSwiGlu<true>, pg8::StaticOrder, lds + RING_OFF, g, S, E); }
    GRID_BAR();
    { pg8::Gemm g{(const bf16*)(ws + WS_HID0), (const bf16*)(ws + WS_WD0), DFF, DFF, DFF, 0, 0}; pg8::StaticOrder S; S.init(M, D, 1, G, bx);
      pg8::EpiResid E{X, X, XB, SS + 32 * M};
      GEMM_PHASE(pg8::EpiResid, pg8::StaticOrder, lds + RING_OFF, g, S, E); }
    GRID_BAR();
    { pg8::Gemm g{XB, (const bf16*)(ws + WS_WIN1), D, D, D, 0, 0}; pg8::StaticOrder S; S.init(M, 3072, 1, G, bx);
      pg8::EpiInProj1 E{SS + 32 * M, (bf16*)(ws + WS_QKV1), C2, (unsigned*)(ctl + CW_KN)};
      GEMM_PHASE(pg8::EpiInProj1, pg8::StaticOrder, lds + RING_OFF, g, S, E); }
    for (int r = gw; r < M / 16; r += NGW) fgate_rows16(XB, (const bf16*)(ws + WS_WF1), SS + 32 * M, args.in[20], (float*)(ws + WS_LOGF), r * 16, lane);
    GRID_BAR();
    { const attn_body::AttnTensors AT{(const attn_body::bf16*)(ws + WS_QKV1), (const attn_body::bf16*)(ws + WS_QKV1 + 32 * MiB), (const attn_body::bf16*)(ws + WS_QKV1 + 64 * MiB), (attn_body::bf16*)(ws + WS_QKV1), (const float*)(ws + WS_LOGF), (const unsigned*)(ctl + CW_KN)};
      for (;;) {
          if (tid == 0) MISC[16] = __hip_atomic_fetch_add(ctl + CW_QUEUE, 1u, RLX_AGENT);
          __syncthreads();
          const unsigned uq = __builtin_amdgcn_readfirstlane(MISC[16]);
          __syncthreads();
          if (uq >= 1024u) break;
          const int bh = (int)(uq & 31u), qb = 31 - (int)(uq >> 5);
          attn_body::attn_unit<8>(bh >> 4, bh & 15, qb, AT.Q, AT.K, AT.V, AT.O, (char*)lds_raw + RING_OFF, AT.logf + (size_t)bh * SEQ, AT.kn + (size_t)bh * 256);
      } }
    GRID_BAR();
    { pg8::Gemm g{(const bf16*)(ws + WS_QKV1), (const bf16*)(ws + WS_WOUT1), D, D, D, 0, 0}; pg8::StaticOrder S; S.init(M, D, 1, G, bx);
      pg8::EpiResid E{X, X, XB, SS + 48 * M};
      GEMM_PHASE(pg8::EpiResid, pg8::StaticOrder, lds + RING_OFF, g, S, E); }
    GRID_BAR();
    unsigned char* meta = ws + WS_META;
    {
        const float* wr = args.in[23]; const float* gn = args.in[22];
        for (int tok = gw; tok < M; tok += NGW) {
            const GAS f32x4* xr = (const GAS f32x4*)(X + (size_t)tok * D) + lane; float lg[NEXP]; float s = 0.f;
#pragma unroll
            for (int e = 0; e < NEXP; ++e) lg[e] = 0.f;
#pragma unroll
            for (int j = 0; j < 4; ++j) { const f32x4 v = xr[64 * j]; s += (v.x * v.x + v.y * v.y) + (v.z * v.z + v.w * v.w); const int k0 = 4 * lane + 256 * j; const f32x4 gv = *(const f32x4*)(gn + k0);
#pragma unroll
                for (int q = 0; q < 4; ++q) { const float xv = v[q] * gv[q]; const f32x4 w0 = *(const f32x4*)(wr + (size_t)(k0 + q) * NEXP), w1 = *(const f32x4*)(wr + (size_t)(k0 + q) * NEXP + 4);
                    lg[0] = fmaf(xv, w0.x, lg[0]); lg[1] = fmaf(xv, w0.y, lg[1]); lg[2] = fmaf(xv, w0.z, lg[2]); lg[3] = fmaf(xv, w0.w, lg[3]);
                    lg[4] = fmaf(xv, w1.x, lg[4]); lg[5] = fmaf(xv, w1.y, lg[5]); lg[6] = fmaf(xv, w1.z, lg[6]); lg[7] = fmaf(xv, w1.w, lg[7]); } }
            s = wave_sum(s);
#pragma unroll
            for (int e = 0; e < NEXP; ++e) lg[e] = wave_sum(lg[e]);
            if (lane == 0) {
                const float rs = 1.0f / sqrtf(s * (1.0f / 1024.0f) + pg8::RMS_EPS);
                int i1 = 0; float v1 = lg[0];
#pragma unroll
                for (int e = 1; e < NEXP; ++e) if (lg[e] > v1) { v1 = lg[e]; i1 = e; }
                int i2 = -1; float v2 = -INFINITY;
#pragma unroll
                for (int e = 0; e < NEXP; ++e) if (e != i1 && lg[e] > v2) { v2 = lg[e]; i2 = e; }
                const float g1 = 1.f / (1.f + expf((v2 - v1) * rs)), g2 = 1.f - g1;
                const unsigned p1 = __hip_atomic_fetch_add(ctl + CW_CNT + 64 * i1, 1u, RLX_AGENT), p2 = __hip_atomic_fetch_add(ctl + CW_CNT + 64 * i2, 1u, RLX_AGENT);
                ((float*)(meta + MT_RSTD))[tok] = rs; ((unsigned*)(meta + MT_TOKE))[tok] = (unsigned)i1 | ((unsigned)i2 << 8);
                ((unsigned*)(meta + MT_TOKP))[2 * tok] = p1; ((unsigned*)(meta + MT_TOKP))[2 * tok + 1] = p2;
                ((float*)(meta + MT_TOKG))[2 * tok] = g1; ((float*)(meta + MT_TOKG))[2 * tok + 1] = g2;
            }
        }
    }
    GRID_BAR();
    int pref[NEXP + 1], cnt[NEXP];
    { pref[0] = 0;
#pragma unroll
      for (int e = 0; e < NEXP; ++e) { cnt[e] = (int)__builtin_amdgcn_readfirstlane(__hip_atomic_load(ctl + CW_CNT + 64 * e, RLX_AGENT)); pref[e + 1] = pref[e] + (cnt[e] + 255) / 256; } }
    const int NP = pref[NEXP];
    unsigned char* XG = ws + WS_XG; float* RSS = (float*)(meta + MT_RSS);
    {
        for (int tok = gw; tok < M; tok += NGW) {
            const unsigned ee = ((const unsigned*)(meta + MT_TOKE))[tok]; const float rs = ((const float*)(meta + MT_RSTD))[tok];
            const GAS f32x4* xr = (const GAS f32x4*)(X + (size_t)tok * D) + lane; unsigned w[4];
#pragma unroll
            for (int j = 0; j < 4; ++j) { const f32x4 v = xr[64 * j]; w[j] = pg8::pk_fp8x4(v.x, v.y, v.z, v.w); }
#pragma unroll
            for (int k = 0; k < 2; ++k) { const int e = (ee >> (8 * k)) & 0xff; int pe = 0;
#pragma unroll
                for (int q = 0; q < NEXP; ++q) pe = (q == e) ? pref[q] : pe;
                const int slot = pe * 256 + (int)((const unsigned*)(meta + MT_TOKP))[2 * tok + k];
#pragma unroll
                for (int j = 0; j < 4; ++j) *(unsigned*)(XG + (size_t)slot * D + 4 * lane + 256 * j) = w[j];
                if (lane == 0) { RSS[slot] = rs; ((unsigned*)(meta + MT_TOKSLOT))[2 * tok + k] = (unsigned)slot; } }
        }
#pragma unroll
        for (int e = 0; e < NEXP; ++e) for (int r = pref[e] * 256 + cnt[e] + gw; r < pref[e + 1] * 256; r += NGW) {
            *(v4u*)(XG + (size_t)r * D + lane * 16) = (v4u){0u, 0u, 0u, 0u}; if (lane == 0) RSS[r] = 0.f; }
    }
    GRID_BAR();
    bf16* YS = (bf16*)(ws + WS_Y);
    { pg8::Gemm g{(const bf16*)XG, (const bf16*)(ws + WS_WMOE_GU), D / 2, D / 2, D / 2, 0, (size_t)7168 * 1024}; MoeOrder S; S.S.nM = NP; S.S.nN = 28; S.S.nZ = 1; S.S.nwg = NP * 28; S.S.G = G; S.S.c = bx; S.lo = 0;
#pragma unroll
      for (int e = 0; e <= NEXP; ++e) S.pref[e] = pref[e];
      pg8::EpiSwiGluFp8 E{RSS, ws + WS_HMOE, DFE};
      pg8::gemm_phase<pg8::EpiSwiGluFp8, MoeOrder, true, true, true>(lds + RING_OFF, g, S, E); }
    GRID_BAR();
    { pg8::Gemm g{(const bf16*)(ws + WS_HMOE), (const bf16*)(ws + WS_WMOE_D), DFE / 2, DFE / 2, DFE / 2, 0, (size_t)1024 * 3584}; MoeOrder S; S.S.nM = NP; S.S.nN = 4; S.S.nZ = 1; S.S.nwg = NP * 4; S.S.G = G; S.S.c = bx; S.lo = 0;
#pragma unroll
      for (int e = 0; e <= NEXP; ++e) S.pref[e] = pref[e];
      pg8::EpiStoreBf16 E{YS, D};
      pg8::gemm_phase<pg8::EpiStoreBf16, MoeOrder, true, true, true>(lds + RING_OFF, g, S, E); }
    GRID_BAR();
    {
        const float* gf = args.in[27];
        for (int tok = gw; tok < M; tok += NGW) {
            const unsigned s0 = ((const unsigned*)(meta + MT_TOKSLOT))[2 * tok], s1 = ((const unsigned*)(meta + MT_TOKSLOT))[2 * tok + 1];
            const float g0 = ((const float*)(meta + MT_TOKG))[2 * tok], g1 = ((const float*)(meta + MT_TOKG))[2 * tok + 1];
            GAS f32x4* xr = (GAS f32x4*)(X + (size_t)tok * D) + lane; f32x4 v[4]; float s = 0.f;
#pragma unroll
            for (int j = 0; j < 4; ++j) { v[j] = xr[64 * j]; const int k0 = 4 * lane + 256 * j;
                const v2u a = *(const v2u*)(YS + (size_t)s0 * D + k0), b2 = *(const v2u*)(YS + (size_t)s1 * D + k0);
                v[j].x += g0 * bflo(a.x) + g1 * bflo(b2.x); v[j].y += g0 * bfhi(a.x) + g1 * bfhi(b2.x); v[j].z += g0 * bflo(a.y) + g1 * bflo(b2.y); v[j].w += g0 * bfhi(a.y) + g1 * bfhi(b2.y);
                s += (v[j].x * v[j].x + v[j].y * v[j].y) + (v[j].z * v[j].z + v[j].w * v[j].w); }
            s = wave_sum(s); const float rs = 1.0f / sqrtf(s * (1.0f / 1024.0f) + pg8::RMS_EPS);
#pragma unroll
            for (int j = 0; j < 4; ++j) { const f32x4 gv = *(const f32x4*)(gf + 4 * lane + 256 * j); xr[64 * j] = v[j] * rs * gv; }
        }
    }
}

extern "C" void kernel_launch(void* const* d_in, const int* in_sizes, int n_in, void* d_out, int out_size, void* d_ws, size_t ws_size, hipStream_t stream) {
    static int grid = 0;
    if (grid == 0) {
        if (n_in != 28 || in_sizes[0] != M * D || out_size != M * D || ws_size < WS_END) { fprintf(stderr, "kernel_launch: unexpected problem: n_in %d in0 %d out %d ws %zu (need %zu)\n", n_in, n_in > 0 ? in_sizes[0] : -1, out_size, ws_size, (size_t)WS_END); grid = -1; return; }
        int dev = 0, cus = 0, per_cu = 0;
        if (hipGetDevice(&dev) != hipSuccess || hipDeviceGetAttribute(&cus, hipDeviceAttributeMultiprocessorCount, dev) != hipSuccess) { grid = -1; return; }
        if (hipFuncSetAttribute((const void*)mk_fwd, hipFuncAttributeMaxDynamicSharedMemorySize, LDS_BYTES) != hipSuccess) { fprintf(stderr, "kernel_launch: hipFuncSetAttribute failed\n"); grid = -1; return; }
        if (hipOccupancyMaxActiveBlocksPerMultiprocessor(&per_cu, (const void*)mk_fwd, NTHREADS, LDS_BYTES) != hipSuccess || per_cu < 1) fprintf(stderr, "kernel_launch: occupancy query says %d\n", per_cu);
        (void)hipGetLastError();
        grid = cus;
        if (grid != 256) fprintf(stderr, "kernel_launch: built for the 256-CU MI355X; device reports %d CUs\n", cus);
    }
    if (grid < 0) return;
    if (hipMemsetAsync((char*)d_ws + WS_CTL, 0, CTL_ZERO_BYTES, stream) != hipSuccess) return;
    Args a{};
    for (int i = 0; i < 28; ++i) a.in[i] = (const float*)d_in[i];
    a.out = (float*)d_out; a.ws = (unsigned char*)d_ws;
    hipLaunchKernelGGL(mk_fwd, dim3(grid), dim3(NTHREADS), LDS_BYTES, stream, a);
}
```

```cpp
#include <hip/hip_runtime.h>
#include <cstdio>
#include <cstdint>

namespace pg8 {
#define PG8_LAS __attribute__((address_space(3)))
typedef unsigned short bf16_t;
typedef short bf16x8 __attribute__((ext_vector_type(8)));
typedef float f32x4 __attribute__((ext_vector_type(4)));
typedef unsigned u32x4 __attribute__((ext_vector_type(4)));
typedef unsigned u32x2 __attribute__((ext_vector_type(2)));
constexpr int BM = 256, BK = 64, HALF = 128, HTB = HALF * BK * 2  , STAGE_BYTES = 8 * HTB, NXCD = 8, WGM = 8;

__host__ __device__ __forceinline__ int lds_byte(int r, int c) { const int st = (r >> 4) * 2 + (c >> 5), rr = r & 15, cc = c & 31, ob = rr * 64 + cc * 2; return st * 1024 + (ob ^ (((ob >> 9) & 1) << 5)); }
__host__ __device__ __forceinline__ void stage_rc(int b, int& R, int& C) { const int st = b / 1024, sb = b % 1024, swz = sb ^ (((sb >> 9) & 1) << 5); R = (st >> 1) * 16 + swz / 64; C = (st & 1) * 32 + (swz % 64) / 2; }
__host__ __device__ __forceinline__ int perm32(int rho) { const int n = rho >> 4, i = rho & 15; return 8 * (i >> 2) + 4 * n + (i & 3); }

struct Unit { int pm, pn, zb; };
struct Gemm { const bf16_t* A; const bf16_t* Bt; int lda, ldb, K; size_t zA, zB; };

struct StaticOrder {
    int nM, nN, nZ, nwg, G, c;
    __host__ __device__ void init(int M, int N, int Z, int G_, int c_) { nM = M / BM; nN = N / BM; nZ = Z; nwg = nM * nN * nZ; G = G_; c = c_; }
    __host__ __device__ bool next(int i, Unit& u) const {
        const long L = (long)i * G + c; if (L >= nwg) return false;
        int wgid = (int)L; { const int q = nwg / NXCD, r = nwg % NXCD, xcd = wgid % NXCD, off = wgid / NXCD; wgid = (xcd < r ? xcd * (q + 1) : r * (q + 1) + (xcd - r) * q) + off; }
        const int per = nM * nN; u.zb = wgid / per; wgid -= u.zb * per;
        const int nig = WGM * nN, gid = wgid / nig, fm = gid * WGM, gsz = (nM - fm) < WGM ? (nM - fm) : WGM;
        u.pm = fm + ((wgid % nig) % gsz); u.pn = (wgid % nig) / gsz; return true;
    }
    __device__ __forceinline__ void a_ready(const Unit&) const {}
    __device__ __forceinline__ void done(const Unit&) const {}
};

__device__ __forceinline__ unsigned cvt_pk_bf16(float lo, float hi) { unsigned r; asm volatile("v_cvt_pk_bf16_f32 %0, %1, %2" : "=v"(r) : "v"(lo), "v"(hi)); return r; }
typedef int v4i_t __attribute__((ext_vector_type(4))); typedef int v8i_t __attribute__((ext_vector_type(8)));
__device__ __forceinline__ v8i_t cat8(bf16x8 a, bf16x8 b) { return __builtin_shufflevector(__builtin_bit_cast(v4i_t, a), __builtin_bit_cast(v4i_t, b), 0, 1, 2, 3, 4, 5, 6, 7); }
__device__ __forceinline__ unsigned pk_fp8x4(float a, float b, float c, float d) { int r = 0; r = __builtin_amdgcn_cvt_pk_fp8_f32(a, b, r, false); r = __builtin_amdgcn_cvt_pk_fp8_f32(c, d, r, true); return (unsigned)r; }
__device__ __forceinline__ float bf_lo(unsigned w) { return __uint_as_float(w << 16); }
__device__ __forceinline__ float bf_hi(unsigned w) { return __uint_as_float(w & 0xffff0000u); }
__device__ __forceinline__ float fast_sigmoid(float z) { return __builtin_amdgcn_rcpf(1.0f + __builtin_amdgcn_exp2f(-1.4426950408889634f * z)); }
constexpr float RMS_EPS = 1e-6f;
__device__ __forceinline__ float rstd16(const float* ssp, int row) { const f32x4* p = (const f32x4*)(ssp + (size_t)row * 16); const f32x4 a = p[0], b = p[1], c = p[2], d = p[3];
    const float s = (((a[0] + a[1]) + (a[2] + a[3])) + ((b[0] + b[1]) + (b[2] + b[3]))) + (((c[0] + c[1]) + (c[2] + c[3])) + ((d[0] + d[1]) + (d[2] + d[3])));
    return __builtin_amdgcn_rsqf(s * (1.0f / 1024.0f) + RMS_EPS); }

__device__ __forceinline__ u32x4 pack8(const f32x4 v0, const f32x4 v1) { u32x4 w; w.x = cvt_pk_bf16(v0[0], v0[1]); w.y = cvt_pk_bf16(v0[2], v0[3]); w.z = cvt_pk_bf16(v1[0], v1[1]); w.w = cvt_pk_bf16(v1[2], v1[3]); return w; }

struct EpiInProj0 {
    static constexpr bool PERM = true, AFTER_DRAIN = false;
    const float* ss; bf16_t* uext; bf16_t* qkv; float qscale;
    __device__ __forceinline__ void operator()(const f32x4 (&acc)[2][2][4][2], const Unit& u, int wr, int wc, int fr, int fq) const {
        const int row0 = u.pm * BM + wr * 64 + fr;
#pragma unroll
        for (int ai = 0; ai < 2; ++ai)
#pragma unroll
            for (int m = 0; m < 4; ++m) { const int row = row0 + ai * HALF + m * 16; const float rs = rstd16(ss, row);
#pragma unroll
                for (int bj = 0; bj < 2; ++bj) { const int col0 = u.pn * BM + bj * HALF + wc * 32 + 8 * fq;
                    float sc = rs; bf16_t* dst;
                    if (u.pn < 2) dst = uext + ((size_t)(col0 >> 4) * 512 + (row >> 5)) * 640 + (row & 31) * 16 + (col0 & 15);
                    else { const int c = col0 - 512; if (c < 512) sc *= qscale; dst = qkv + (size_t)row * 1536 + c; }
                    *(u32x4*)dst = pack8(acc[ai][bj][m][0] * sc, acc[ai][bj][m][1] * sc); } }
    }
};
struct EpiS5State {
    static constexpr bool PERM = false, AFTER_DRAIN = false;
    float* sloc;
    __device__ __forceinline__ void operator()(const f32x4 (&acc)[2][2][4][2], const Unit& u, int wr, int wc, int fr, int fq) const {
        const int row0 = u.pm * BM + wr * 64 + fr, col0 = wc * 32 + 4 * fq;
#pragma unroll
        for (int ai = 0; ai < 2; ++ai)
#pragma unroll
            for (int m = 0; m < 4; ++m) { float* rowp = sloc + ((size_t)u.zb * 512 + row0 + ai * HALF + m * 16) * 128 + col0;
#pragma unroll
                for (int n = 0; n < 2; ++n) *(f32x4*)(rowp + n * 16) = acc[ai][0][m][n]; }
    }
};
__device__ __forceinline__ float gelu_tanh(float x) { const float a = x * (1.0f + 0.044715f * x * x); return x * __builtin_amdgcn_rcpf(1.0f + __builtin_amdgcn_exp2f(-2.302208198f * a)); }
struct EpiS5Y {
    static constexpr bool PERM = true, AFTER_DRAIN = false;
    bf16_t* yg;
    __device__ __forceinline__ void operator()(const f32x4 (&acc)[2][2][4][2], const Unit& u, int wr, int wc, int fr, int fq) const {
        const int row0 = u.pm * BM + wr * 64 + fr;
#pragma unroll
        for (int ai = 0; ai < 2; ++ai)
#pragma unroll
            for (int m = 0; m < 4; ++m) { const int chunk = row0 + ai * HALF + m * 16;
#pragma unroll
                for (int bj = 0; bj < 2; ++bj) { const int col0 = u.pn * BM + bj * HALF + wc * 32 + 8 * fq; const int i = col0 >> 4, h0 = col0 & 15;
                    f32x4 v0 = acc[ai][bj][m][0], v1 = acc[ai][bj][m][1];
#pragma unroll
                    for (int e = 0; e < 4; ++e) { v0[e] = gelu_tanh(v0[e]); v1[e] = gelu_tanh(v1[e]); }
                    *(u32x4*)(yg + ((size_t)chunk * 32 + i) * 512 + u.zb * 16 + h0) = pack8(v0, v1); } }
    }
};
struct EpiGlu {
    static constexpr bool PERM = true, AFTER_DRAIN = false;
    const bf16_t* yg; const float* bias; bf16_t* mix;
    __device__ __forceinline__ void operator()(const f32x4 (&acc)[2][2][4][2], const Unit& u, int wr, int wc, int fr, int fq) const {
        const int row0 = u.pm * BM + wr * 64 + fr;
#pragma unroll
        for (int bj = 0; bj < 2; ++bj) { const int col0 = u.pn * BM + bj * HALF + wc * 32 + 8 * fq;
            const f32x4 b0 = *(const f32x4*)(bias + col0), b1 = *(const f32x4*)(bias + col0 + 4);
#pragma unroll
            for (int ai = 0; ai < 2; ++ai)
#pragma unroll
                for (int m = 0; m < 4; ++m) { const int row = row0 + ai * HALF + m * 16;
                    const u32x4 yw = *(const u32x4*)(yg + (size_t)row * 512 + col0);
                    f32x4 z0 = acc[ai][bj][m][0] + b0, z1 = acc[ai][bj][m][1] + b1, o0, o1;
                    o0[0] = bf_lo(yw.x) * fast_sigmoid(z0[0]); o0[1] = bf_hi(yw.x) * fast_sigmoid(z0[1]); o0[2] = bf_lo(yw.y) * fast_sigmoid(z0[2]); o0[3] = bf_hi(yw.y) * fast_sigmoid(z0[3]);
                    o1[0] = bf_lo(yw.z) * fast_sigmoid(z1[0]); o1[1] = bf_hi(yw.z) * fast_sigmoid(z1[1]); o1[2] = bf_lo(yw.w) * fast_sigmoid(z1[2]); o1[3] = bf_hi(yw.w) * fast_sigmoid(z1[3]);
                    *(u32x4*)(mix + (size_t)row * 1024 + col0) = pack8(o0, o1); } }
    }
};
struct EpiResid {
    static constexpr bool PERM = false, AFTER_DRAIN = false;
    const float* R; float* X; bf16_t* xb; float* ssq;
    __device__ __forceinline__ void operator()(const f32x4 (&acc)[2][2][4][2], const Unit& u, int wr, int wc, int fr, int fq) const {
        const int row0 = u.pm * BM + wr * 64 + fr, col0 = u.pn * BM + wc * 32 + 4 * fq;
#pragma unroll
        for (int ai = 0; ai < 2; ++ai)
#pragma unroll
            for (int m = 0; m < 4; ++m) { const int row = row0 + ai * HALF + m * 16; const size_t off = (size_t)row * 1024 + col0; float s = 0.f;
#pragma unroll
                for (int bj = 0; bj < 2; ++bj)
#pragma unroll
                    for (int n = 0; n < 2; ++n) { const f32x4 x = *(const f32x4*)(R + off + bj * HALF + n * 16) + acc[ai][bj][m][n];
                        *(f32x4*)(X + off + bj * HALF + n * 16) = x; s += (x[0] * x[0] + x[1] * x[1]) + (x[2] * x[2] + x[3] * x[3]);
                        u32x2 w; w.x = cvt_pk_bf16(x[0], x[1]); w.y = cvt_pk_bf16(x[2], x[3]); *(u32x2*)(xb + off + bj * HALF + n * 16) = w; }
                s += __shfl_xor(s, 16); s += __shfl_xor(s, 32);
                if (fq == 0) ssq[(size_t)row * 16 + u.pn * 4 + wc] = s; }
    }
};
template <bool RS_IS_SSQ> struct EpiSwiGlu {
    static constexpr bool PERM = true, AFTER_DRAIN = false;
    const float* rsv; bf16_t* H; int ldh;
    __device__ __forceinline__ void operator()(const f32x4 (&acc)[2][2][4][2], const Unit& u, int wr, int wc, int fr, int fq) const {
        const int row0 = u.pm * BM + wr * 64 + fr, col0 = u.pn * HALF + wc * 32 + 8 * fq;
#pragma unroll
        for (int ai = 0; ai < 2; ++ai)
#pragma unroll
            for (int m = 0; m < 4; ++m) { const int row = row0 + ai * HALF + m * 16; const float rs = RS_IS_SSQ ? rstd16(rsv, row) : rsv[row];
                f32x4 o[2];
#pragma unroll
                for (int n = 0; n < 2; ++n)
#pragma unroll
                    for (int e = 0; e < 4; ++e) { const float g = acc[ai][0][m][n][e] * rs, up = acc[ai][1][m][n][e] * rs; o[n][e] = g * fast_sigmoid(g) * up; }
                *(u32x4*)(H + (size_t)row * ldh + col0) = pack8(o[0], o[1]); }
    }
};
struct EpiSwiGluFp8 {
    static constexpr bool PERM = true, AFTER_DRAIN = false;
    const float* rsv; unsigned char* H; int ldh;
    __device__ __forceinline__ void operator()(const f32x4 (&acc)[2][2][4][2], const Unit& u, int wr, int wc, int fr, int fq) const {
        const int row0 = u.pm * BM + wr * 64 + fr, col0 = u.pn * HALF + wc * 32 + 8 * fq;
#pragma unroll
        for (int ai = 0; ai < 2; ++ai)
#pragma unroll
            for (int m = 0; m < 4; ++m) { const int row = row0 + ai * HALF + m * 16; const float rs = rsv[row];
                f32x4 o[2];
#pragma unroll
                for (int n = 0; n < 2; ++n)
#pragma unroll
                    for (int e = 0; e < 4; ++e) { const float g = acc[ai][0][m][n][e] * rs, up = acc[ai][1][m][n][e] * rs; o[n][e] = g * fast_sigmoid(g) * up; }
                u32x2 w; w.x = pk_fp8x4(o[0][0], o[0][1], o[0][2], o[0][3]); w.y = pk_fp8x4(o[1][0], o[1][1], o[1][2], o[1][3]);
                *(u32x2*)(H + (size_t)row * ldh + col0) = w; }
    }
};
struct EpiInProj1 {
    static constexpr bool PERM = true, AFTER_DRAIN = false;
    const float* ss; bf16_t* qkv; float qscale;
    unsigned* kn;
    __device__ __forceinline__ void operator()(const f32x4 (&acc)[2][2][4][2], const Unit& u, int wr, int wc, int fr, int fq) const {
        const int row0 = u.pm * BM + wr * 64 + fr; const float qs = (u.pn < 4) ? qscale : 1.0f;
#pragma unroll
        for (int ai = 0; ai < 2; ++ai)
#pragma unroll
            for (int m = 0; m < 4; ++m) { const int row = row0 + ai * HALF + m * 16; const float sc = rstd16(ss, row) * qs;
#pragma unroll
                for (int bj = 0; bj < 2; ++bj) { const int col0 = (u.pn & 3) * BM + bj * HALF + wc * 32 + 8 * fq;
                    const f32x4 v0 = acc[ai][bj][m][0] * sc, v1 = acc[ai][bj][m][1] * sc;
                    *(u32x4*)(qkv + (size_t)(u.pn >> 2) * (16384 * 1024) + (size_t)row * 1024 + col0) = pack8(v0, v1);
                    if ((u.pn >> 2) == 1) {
                        float q = ((v0[0] * v0[0] + v0[1] * v0[1]) + (v0[2] * v0[2] + v0[3] * v0[3])) + ((v1[0] * v1[0] + v1[1] * v1[1]) + (v1[2] * v1[2] + v1[3] * v1[3]));
                        q += __shfl_xor(q, 16); q += __shfl_xor(q, 32);
                        q = fmaxf(q, __shfl_xor(q, 1)); q = fmaxf(q, __shfl_xor(q, 2)); q = fmaxf(q, __shfl_xor(q, 4)); q = fmaxf(q, __shfl_xor(q, 8));
                        if (fr == 0 && fq == 0) { const int head = (u.pn & 3) * 4 + bj * 2 + (wc >> 1), bb = row >> 13, tile = (row & 8191) >> 6;
                            atomicMax(kn + ((size_t)(bb * 16 + head) * 128 + tile) * 2 + (wc & 1), __float_as_uint(q * 1.01f)); } } } }
    }
};
struct EpiStoreBf16 {
    static constexpr bool PERM = true, AFTER_DRAIN = false;
    bf16_t* O; int ldc;
    __device__ __forceinline__ void operator()(const f32x4 (&acc)[2][2][4][2], const Unit& u, int wr, int wc, int fr, int fq) const {
        const int row0 = u.pm * BM + wr * 64 + fr;
#pragma unroll
        for (int ai = 0; ai < 2; ++ai)
#pragma unroll
            for (int m = 0; m < 4; ++m) { const int row = row0 + ai * HALF + m * 16;
#pragma unroll
                for (int bj = 0; bj < 2; ++bj) { const int col0 = u.pn * BM + bj * HALF + wc * 32 + 8 * fq;
                    *(u32x4*)(O + (size_t)row * ldc + col0) = pack8(acc[ai][bj][m][0], acc[ai][bj][m][1]); } }
    }
};

template <bool F8> struct Frag { bf16x8 k[2]; };
template <> struct Frag<true> { v8i_t v; };
template <class Epi, class Sched, bool ALIGN_EPI = false, bool SP2 = false, bool FP8 = false>
__device__ __forceinline__ void gemm_phase(PG8_LAS unsigned char* lds, const Gemm g, const Sched& S, const Epi& E) {
    int tid_ = threadIdx.x; asm volatile("" : "+v"(tid_));
    const int tid = tid_, wid = __builtin_amdgcn_readfirstlane(tid >> 6), lane = tid & 63, wr = wid >> 2, wc = wid & 3, fr = lane & 15, fq = lane >> 4;
    const int K = g.K, nt = K / BK;
    unsigned voffA[2], voffB[2];
#pragma unroll
    for (int i = 0; i < 2; ++i) { int R, C; stage_rc(tid * 16 + i * 8192, R, C); const int Rb = Epi::PERM ? ((R & ~31) + perm32(R & 31)) : R;
        voffA[i] = (unsigned)(R * g.lda + C) * 2u; voffB[i] = (unsigned)(Rb * g.ldb + C) * 2u; }
    const size_t kstep = (size_t)(BK * 2);
    const size_t hstepA = (size_t)HALF * g.lda * 2, hstepB = (size_t)HALF * g.ldb * 2;
    const size_t tstepA = 2 * hstepA, tstepB = 2 * hstepB;
    const unsigned ldsw = (unsigned)wid * 1024u;
    const int aoff = lds_byte(wr * 64 + fr, fq * 8), boff = lds_byte(wc * 32 + fr, fq * 8);
#define PG8_SA(b, h) (((b) * 2 + (h)) * HTB)
#define PG8_SB(b, h) ((4 + (b) * 2 + (h)) * HTB)
#define PG8_STAGE(bufoff, gbase, voff) do { _Pragma("unroll") for (int _i = 0; _i < 2; ++_i) \
        __builtin_amdgcn_global_load_lds((const unsigned*)((const char*)(gbase) + (voff)[_i]), (PG8_LAS unsigned*)(lds + (bufoff) + ldsw + _i * 8192), 16, 0, 0); } while (0)
    const PG8_LAS unsigned char* ldsA_ = lds + aoff; const PG8_LAS unsigned char* ldsB_ = lds + 4 * HTB + boff; asm volatile("" : "+v"(ldsA_), "+v"(ldsB_));
#define PG8_RDA(off) (*(const PG8_LAS bf16x8*)(ldsA_ + (off)))
#define PG8_RDB(off) (*(const PG8_LAS bf16x8*)(ldsB_ + (off)))
#define PG8_LDA(dst, b, h) do { _Pragma("unroll") for (int m = 0; m < 4; ++m) { if constexpr (FP8) dst[m].v = cat8(PG8_RDA(PG8_SA(b, h) + m * 2048), PG8_RDA(PG8_SA(b, h) + m * 2048 + 1024)); \
        else { dst[m].k[0] = PG8_RDA(PG8_SA(b, h) + m * 2048); dst[m].k[1] = PG8_RDA(PG8_SA(b, h) + m * 2048 + 1024); } } } while (0)
#define PG8_LDB(dst, b, h) do { _Pragma("unroll") for (int n = 0; n < 2; ++n) { if constexpr (FP8) dst[n].v = cat8(PG8_RDB(PG8_SB(b, h) - 4 * HTB + n * 2048), PG8_RDB(PG8_SB(b, h) - 4 * HTB + n * 2048 + 1024)); \
        else { dst[n].k[0] = PG8_RDB(PG8_SB(b, h) - 4 * HTB + n * 2048); dst[n].k[1] = PG8_RDB(PG8_SB(b, h) - 4 * HTB + n * 2048 + 1024); } } } while (0)
#define PG8_MMA(ai, bj, At, Bt) do { __builtin_amdgcn_s_setprio(1); _Pragma("unroll") for (int m = 0; m < 4; ++m) _Pragma("unroll") for (int n = 0; n < 2; ++n) { \
        if constexpr (FP8) { asm volatile("v_mfma_scale_f32_16x16x128_f8f6f4 %0, %1, %2, %0, %3, %4 op_sel_hi:[0,0,0]" : "+v"(acc[ai][bj][m][n]) : "v"(Bt[n].v), "v"(At[m].v), "v"(sclB_), "v"(sclA_)); } \
        else { _Pragma("unroll") for (int k = 0; k < 2; ++k) acc[ai][bj][m][n] = __builtin_amdgcn_mfma_f32_16x16x32_bf16(Bt[n].k[k], At[m].k[k], acc[ai][bj][m][n], 0, 0, 0); } } __builtin_amdgcn_s_setprio(0); } while (0)
#define PG8_WAIT_V(n) asm volatile("s_waitcnt vmcnt(" #n ")" ::: "memory")
#define PG8_WAIT_L(n) asm volatile("s_waitcnt lgkmcnt(" #n ")" ::: "memory")
#define PG8_BAR __builtin_amdgcn_s_barrier()
#define PG8_SCHED __builtin_amdgcn_sched_barrier(0)
    Unit cur, nxt; int ui = 0;
    if (!S.next(0, cur)) return;
    f32x4 acc[2][2][4][2];
#pragma unroll
    for (int a = 0; a < 2; ++a)
#pragma unroll
        for (int b = 0; b < 2; ++b)
#pragma unroll
            for (int m = 0; m < 4; ++m)
#pragma unroll
                for (int n = 0; n < 2; ++n) acc[a][b][m][n] = (f32x4){0.f, 0.f, 0.f, 0.f};
    Frag<FP8> At[4], B0[2], B1[2];
    int sclB_ = 0x79797979, sclA_ = 0x7f7f7f7f; asm volatile("" : "+v"(sclB_), "+v"(sclA_));
    const char* cA = (const char*)g.A + (size_t)cur.zb * g.zA + (size_t)cur.pm * tstepA; const char* cB = (const char*)g.Bt + (size_t)cur.zb * g.zB + (size_t)cur.pn * tstepB;
    S.a_ready(cur);
    if constexpr (SP2) {
        PG8_STAGE(PG8_SB(0, 0), cB, voffB); PG8_STAGE(PG8_SB(0, 1), cB + hstepB, voffB); PG8_STAGE(PG8_SA(0, 0), cA, voffA); PG8_STAGE(PG8_SA(0, 1), cA + hstepA, voffA);
        if (wr == 1) PG8_BAR;
        PG8_WAIT_V(2); PG8_BAR;
        PG8_STAGE(PG8_SB(1, 0), cB + kstep, voffB); PG8_STAGE(PG8_SA(1, 0), cA + kstep, voffA); PG8_STAGE(PG8_SB(1, 1), cB + hstepB + kstep, voffB);
        PG8_WAIT_V(6); PG8_BAR;
    } else {
        PG8_STAGE(PG8_SB(0, 0), cB, voffB); PG8_STAGE(PG8_SA(0, 0), cA, voffA); PG8_STAGE(PG8_SB(0, 1), cB + hstepB, voffB); PG8_STAGE(PG8_SA(0, 1), cA + hstepA, voffA);
        if (wr == 1) PG8_BAR;
        PG8_WAIT_V(4); PG8_BAR;
        PG8_STAGE(PG8_SB(1, 0), cB + kstep, voffB); PG8_STAGE(PG8_SA(1, 0), cA + kstep, voffA); PG8_STAGE(PG8_SB(1, 1), cB + hstepB + kstep, voffB);
        PG8_WAIT_V(6); PG8_BAR;
    }
    for (;;) {
        const bool has_next = S.next(ui + 1, nxt);
        const char* nA = has_next ? (const char*)g.A + (size_t)nxt.zb * g.zA + (size_t)nxt.pm * tstepA : cA; const char* nB = has_next ? (const char*)g.Bt + (size_t)nxt.zb * g.zB + (size_t)nxt.pn * tstepB : cB;
#pragma unroll 1
        for (int t = 0; t < nt; t += 2) {
            const bool last = (t == nt - 2);
            const char* a1 = cA + (size_t)(t + 1) * kstep;
            const char* a2 = last ? nA : cA + (size_t)(t + 2) * kstep; const char* b2 = last ? nB : cB + (size_t)(t + 2) * kstep;
            const char* a3 = a2 + kstep; const char* b3 = b2 + kstep;
            if (last && has_next) S.a_ready(nxt);
            if constexpr (SP2) {
            PG8_LDB(B0, 0, 0); PG8_LDB(B1, 0, 1); PG8_SCHED; PG8_LDA(At, 0, 0); PG8_STAGE(PG8_SA(1, 1), a1 + hstepA, voffA);
            PG8_WAIT_V(8); PG8_WAIT_L(0); PG8_BAR; PG8_MMA(0, 0, At, B0); PG8_MMA(0, 1, At, B1); PG8_BAR; PG8_SCHED;
            PG8_LDA(At, 0, 1); PG8_STAGE(PG8_SB(0, 0), b2, voffB); PG8_STAGE(PG8_SB(0, 1), b2 + hstepB, voffB); PG8_STAGE(PG8_SA(0, 0), a2, voffA);
            PG8_WAIT_V(8); PG8_WAIT_L(0); PG8_BAR; PG8_MMA(1, 0, At, B0); PG8_MMA(1, 1, At, B1); PG8_BAR; PG8_SCHED;
            PG8_LDB(B0, 1, 0); PG8_LDB(B1, 1, 1); PG8_SCHED; PG8_LDA(At, 1, 0); PG8_STAGE(PG8_SA(0, 1), a2 + hstepA, voffA);
            PG8_WAIT_V(8); PG8_WAIT_L(0); PG8_BAR; PG8_MMA(0, 0, At, B0); PG8_MMA(0, 1, At, B1); PG8_BAR; PG8_SCHED;
            PG8_LDA(At, 1, 1); PG8_STAGE(PG8_SB(1, 0), b3, voffB); PG8_STAGE(PG8_SB(1, 1), b3 + hstepB, voffB); PG8_STAGE(PG8_SA(1, 0), a3, voffA);
            PG8_WAIT_V(8); PG8_WAIT_L(0); PG8_BAR; PG8_MMA(1, 0, At, B0); PG8_MMA(1, 1, At, B1); PG8_BAR; PG8_SCHED;
            } else {
            PG8_LDB(B0, 0, 0); PG8_SCHED; PG8_LDA(At, 0, 0); PG8_STAGE(PG8_SA(1, 1), a1 + hstepA, voffA);
            PG8_WAIT_L(8); PG8_BAR; PG8_WAIT_L(0); PG8_MMA(0, 0, At, B0); PG8_BAR; PG8_SCHED;
            PG8_LDB(B1, 0, 1); PG8_STAGE(PG8_SB(0, 0), b2, voffB);
            PG8_BAR; PG8_WAIT_L(0); PG8_MMA(0, 1, At, B1); PG8_BAR;
            PG8_LDA(At, 0, 1); PG8_STAGE(PG8_SA(0, 0), a2, voffA);
            PG8_BAR; PG8_WAIT_L(0); PG8_MMA(1, 0, At, B0); PG8_BAR; PG8_SCHED;
            PG8_STAGE(PG8_SB(0, 1), b2 + hstepB, voffB);
            PG8_WAIT_V(6); PG8_BAR; PG8_MMA(1, 1, At, B1); PG8_BAR;
            PG8_LDB(B0, 1, 0); PG8_SCHED; PG8_LDA(At, 1, 0); PG8_STAGE(PG8_SA(0, 1), a2 + hstepA, voffA);
            PG8_WAIT_L(8); PG8_BAR; PG8_WAIT_L(0); PG8_MMA(0, 0, At, B0); PG8_BAR; PG8_SCHED;
            PG8_LDB(B1, 1, 1); PG8_STAGE(PG8_SB(1, 0), b3, voffB);
            PG8_BAR; PG8_WAIT_L(0); PG8_MMA(0, 1, At, B1); PG8_BAR;
            PG8_LDA(At, 1, 1); PG8_STAGE(PG8_SA(1, 0), a3, voffA);
            PG8_BAR; PG8_WAIT_L(0); PG8_MMA(1, 0, At, B0); PG8_BAR; PG8_SCHED;
            PG8_STAGE(PG8_SB(1, 1), b3 + hstepB, voffB);
            PG8_WAIT_V(6); PG8_BAR; PG8_MMA(1, 1, At, B1); PG8_BAR;
            }
        }
        if constexpr (ALIGN_EPI) { if (wr == 0) PG8_BAR; }
        if constexpr (FP8) asm volatile("s_nop 15\n\ts_nop 15" ::: "memory");
        if constexpr (!Epi::AFTER_DRAIN) { int fr_ = fr, fq_ = fq; asm volatile("" : "+v"(fr_), "+v"(fq_));
            E(acc, cur, wr, wc, fr_, fq_); S.done(cur); }
        if (!has_next) break;
#pragma unroll
        for (int a = 0; a < 2; ++a)
#pragma unroll
            for (int b = 0; b < 2; ++b)
#pragma unroll
                for (int m = 0; m < 4; ++m)
#pragma unroll
                    for (int n = 0; n < 2; ++n) acc[a][b][m][n] = (f32x4){0.f, 0.f, 0.f, 0.f};
        cur = nxt; cA = nA; cB = nB; ++ui;
        if constexpr (ALIGN_EPI) { if (wr == 1) PG8_BAR; }
    }
    PG8_WAIT_V(0);
    if constexpr (!ALIGN_EPI) { if (wr == 0) PG8_BAR; }
    PG8_BAR;
    if constexpr (Epi::AFTER_DRAIN) { E.fused(acc, cur, wr, wc, fr, fq, lds, wid, lane); S.done(cur); }
#undef PG8_SA
#undef PG8_SB
#undef PG8_STAGE
#undef PG8_LDA
#undef PG8_RDA
#undef PG8_RDB
#undef PG8_LDB
#undef PG8_MMA
#undef PG8_WAIT_V
#undef PG8_WAIT_L
#undef PG8_BAR
#undef PG8_SCHED
}
}

#include <hip/hip_bf16.h>
#include <cmath>
namespace attn_body {
using bf16=__hip_bfloat16;
using bf16x8=__attribute__((ext_vector_type(8)))short;
using s16x4=__attribute__((ext_vector_type(4)))short;
using f32x16=__attribute__((ext_vector_type(16)))float;
using u32x4=__attribute__((ext_vector_type(4)))unsigned;
constexpr int BATCH=2,NHEAD=16,SEQ=8192,D=64,DM=NHEAD*D;
constexpr int NW=8,QBLK=32,QB=QBLK*NW,KVBLK=64,NQB=SEQ/QB;
constexpr int ATTN_PITCH=DM, ATTN_UNIT_ROWS=QB;
__device__ __forceinline__ int crow(int r,int hi){return (r&3)+8*(r>>2)+4*hi;}
#define SBAR() __builtin_amdgcn_sched_barrier(0)
__device__ __forceinline__ void cmask(f32x16&p0,f32x16&p1,int jb,int qrel,int hi){
  const float NEG=-INFINITY; int kb=64*jb+4*hi;
  #pragma unroll
  for(int r=0;r<16;++r){int kv=kb+(r&3)+8*(r>>2); if(kv>qrel)p0[r]=NEG; if(kv+32>qrel)p1[r]=NEG;}
}

constexpr int NSLOT=3, SLOTB=8192;
constexpr int LDS_K=0, LDS_V=NSLOT*SLOTB, LDS_WS=2*NSLOT*SLOTB, LDS_OST=LDS_WS+NW*64*4, LDS_NB=LDS_OST+NW*4096  , LDS_PK=LDS_NB+32768+64  , LDS_BYTES=LDS_PK+1024;
constexpr float C2=0.125f*1.4426950408889634f;
__device__ __forceinline__ void glds16(const void*gsrc,unsigned lds_dst){unsigned keep;
  asm volatile("s_mov_b32 %0, m0\n\ts_mov_b32 m0, %2\n\ts_nop 0\n\tglobal_load_lds_dwordx4 %1, off\n\ts_mov_b32 m0, %0":"=&s"(keep):"v"(gsrc),"s"(lds_dst):"memory");}
__device__ __forceinline__ float max3f(float a,float b,float c){float r;asm("v_max3_f32 %0, %1, %2, %3":"=v"(r):"v"(a),"v"(b),"v"(c));return r;}
__device__ __forceinline__ float max2f(float a,float b){float r;asm("v_max_f32_e32 %0, %1, %2":"=v"(r):"v"(a),"v"(b));return r;}
__device__ __forceinline__ float fadd_s(float a,float b){float r;asm("v_add_f32_e32 %0, %1, %2":"=v"(r):"v"(a),"v"(b));return r;}
__device__ __forceinline__ float fsub_s(float a,float b){float r;asm("v_sub_f32_e32 %0, %1, %2":"=v"(r):"v"(a),"v"(b));return r;}
typedef float f32x2_t __attribute__((ext_vector_type(2))); typedef __bf16 bf16x2_t __attribute__((ext_vector_type(2)));
__device__ __forceinline__ unsigned cvtpk_s(float lo,float hi){f32x2_t v={lo,hi};bf16x2_t b=__builtin_convertvector(v,bf16x2_t);return __builtin_bit_cast(unsigned,b);}
#define WAIT_BAR(N) asm volatile("s_waitcnt vmcnt(" #N ") lgkmcnt(0)\n\ts_barrier":::"memory")

__device__ __forceinline__ void qkt(f32x16&p0,f32x16&p1,const char*Kslot,const bf16x8*qr,const f32x16&negm,int r32,int hi){
  const char*kb=Kslot+hi*1024+r32*16;
  #pragma unroll
  for(int d0=0;d0<4;++d0){
    const bf16x8 b0=*reinterpret_cast<const bf16x8*>(kb+d0*2048);
    const bf16x8 b1=*reinterpret_cast<const bf16x8*>(kb+d0*2048+512);
    if(d0==0){p0=__builtin_amdgcn_mfma_f32_32x32x16_bf16(b0,qr[0],negm,0,0,0);p1=__builtin_amdgcn_mfma_f32_32x32x16_bf16(b1,qr[0],negm,0,0,0);}
    else{p0=__builtin_amdgcn_mfma_f32_32x32x16_bf16(b0,qr[d0],p0,0,0,0);p1=__builtin_amdgcn_mfma_f32_32x32x16_bf16(b1,qr[d0],p1,0,0,0);}}
}
typedef __attribute__((address_space(3))) const char* lds_cptr;
typedef short v4i16_t __attribute__((ext_vector_type(4)));
__device__ __forceinline__ void kload8(bf16x8*kf,lds_cptr kp){
  kf[0]=*(const __attribute__((address_space(3))) bf16x8*)(kp);      kf[1]=*(const __attribute__((address_space(3))) bf16x8*)(kp+512);
  kf[2]=*(const __attribute__((address_space(3))) bf16x8*)(kp+2048); kf[3]=*(const __attribute__((address_space(3))) bf16x8*)(kp+2560);
  kf[4]=*(const __attribute__((address_space(3))) bf16x8*)(kp+4096); kf[5]=*(const __attribute__((address_space(3))) bf16x8*)(kp+4608);
  kf[6]=*(const __attribute__((address_space(3))) bf16x8*)(kp+6144); kf[7]=*(const __attribute__((address_space(3))) bf16x8*)(kp+6656);
}
__device__ __forceinline__ void kload2(bf16x8*kf,lds_cptr kp,int j){ kf[2*j]=*(const __attribute__((address_space(3))) bf16x8*)(kp+j*2048); kf[2*j+1]=*(const __attribute__((address_space(3))) bf16x8*)(kp+j*2048+512); }
__device__ __forceinline__ s16x4 vtr(lds_cptr p){ return __builtin_bit_cast(s16x4,__builtin_amdgcn_ds_read_tr16_b64_v4i16((__attribute__((address_space(3))) v4i16_t*)p)); }
__device__ __forceinline__ float rowmax(const f32x16&p0,const f32x16&p1){
  float a=max3f(p0[0],p0[1],p1[0]),b=max3f(p0[2],p0[3],p1[1]);a=max3f(a,p1[2],p1[3]);
  #pragma unroll
  for(int r=4;r<16;r+=4){a=max3f(a,p0[r],p0[r+1]);b=max3f(b,p0[r+2],p0[r+3]);a=max3f(a,p1[r],p1[r+1]);b=max3f(b,p1[r+2],p1[r+3]);}
  const float m=max2f(a,b);
  auto rr=__builtin_amdgcn_permlane32_swap(__float_as_uint(m),__float_as_uint(m),false,false);
  return max2f(__uint_as_float(rr[0]),__uint_as_float(rr[1]));
}
__device__ __forceinline__ void pv(f32x16*o,int vb,bf16x8 pa0,bf16x8 pa1,bf16x8 pa2,bf16x8 pa3){
  #pragma unroll
  for(int d0=0;d0<2;++d0){s16x4 lo[4],hi[4];
    #pragma unroll
    for(int ks=0;ks<4;++ks){
      asm volatile("ds_read_b64_tr_b16 %0,%1 offset:%c2":"=&v"(lo[ks]):"v"(vb),"i"(d0*4096+ks*1024):"memory");
      asm volatile("ds_read_b64_tr_b16 %0,%1 offset:%c2":"=&v"(hi[ks]):"v"(vb),"i"(d0*4096+ks*1024+512):"memory");}
    asm volatile("s_waitcnt lgkmcnt(0)":::"memory");SBAR();
    #define PK(k) (bf16x8){lo[k][0],lo[k][1],lo[k][2],lo[k][3],hi[k][0],hi[k][1],hi[k][2],hi[k][3]}
    o[d0]=__builtin_amdgcn_mfma_f32_32x32x16_bf16(pa0,PK(0),o[d0],0,0,0);
    o[d0]=__builtin_amdgcn_mfma_f32_32x32x16_bf16(pa1,PK(1),o[d0],0,0,0);
    o[d0]=__builtin_amdgcn_mfma_f32_32x32x16_bf16(pa2,PK(2),o[d0],0,0,0);
    o[d0]=__builtin_amdgcn_mfma_f32_32x32x16_bf16(pa3,PK(3),o[d0],0,0,0);
    #undef PK
  }
}

typedef float f32x4_t __attribute__((ext_vector_type(4)));
__device__ __forceinline__ void fox_negcum(const float*logf,__attribute__((address_space(3))) float*ncum,__attribute__((address_space(3))) float*wtot,int tid){
  float loc[16];float s=0.f; const f32x4_t*lp=(const f32x4_t*)(logf+tid*16);
  #pragma unroll
  for(int j=0;j<4;++j){const f32x4_t v=lp[j]; s+=v[0];loc[4*j]=s; s+=v[1];loc[4*j+1]=s; s+=v[2];loc[4*j+2]=s; s+=v[3];loc[4*j+3]=s;}
  float inc=s;
  #pragma unroll
  for(int o=1;o<64;o<<=1){const float v=__shfl_up(inc,o); if((tid&63)>=o)inc+=v;}
  if((tid&63)==63)wtot[tid>>6]=inc;
  __syncthreads();
  float base=inc-s; for(int w=0;w<(tid>>6);++w)base+=wtot[w];
  #pragma unroll
  for(int j=0;j<4;++j){ f32x4_t o4; o4[0]=-(base+loc[4*j]);o4[1]=-(base+loc[4*j+1]);o4[2]=-(base+loc[4*j+2]);o4[3]=-(base+loc[4*j+3]); *(__attribute__((address_space(3))) f32x4_t*)(ncum+tid*16+4*j)=o4; }
  __syncthreads();
}
#ifndef ATTN_STORE16
#define ATTN_STORE16(p,v) (*(u32x4*)(p)=(v))
#endif
template<int THRL> __device__ __forceinline__ void attn_unit(int b,int h,int qb,const bf16*Q,const bf16*__restrict__ K,const bf16*__restrict__ V,bf16*O,char*shm,const float*logf_bh,const unsigned*kn_bh){
  int tid_=threadIdx.x; asm volatile("":"+v"(tid_)); const int tid=tid_,lane=tid&63,r32=lane&31,hi=lane>>5; const int wid=__builtin_amdgcn_readfirstlane(tid>>6);
  const long rowbase=(long)b*SEQ; const int q0=qb*QB;
  const bf16*Qw=Q+(rowbase+q0+wid*QBLK)*DM+h*D;
  const bf16*Kh=K+rowbase*DM+h*D,*Vh=V+rowbase*DM+h*D;
  const unsigned lds0=(unsigned)(uintptr_t)shm;
  float*wsf=(float*)(shm+LDS_WS)+wid*64;
  const bf16*ksrc=Kh+(long)lane*DM+wid*8;
  const bf16*vsrc=Vh+(long)(16*(wid&3)+(lane>>2))*DM+(wid>>2)*32+(lane&3)*8;
  const unsigned kdst=lds0+LDS_K+wid*1024, vdst=lds0+LDS_V+wid*1024;
  #define TIDX(t) (NTR-1-(t))
  #define DMA_K(t,slot) glds16(ksrc+(long)TIDX(t)*KVBLK*DM,(unsigned)__builtin_amdgcn_readfirstlane(kdst+(slot)))
  #define DMA_V(t,slot) glds16(vsrc+(long)TIDX(t)*KVBLK*DM,(unsigned)__builtin_amdgcn_readfirstlane(vdst+(slot)))
  const int vb0=(int)(lds0+LDS_V)+((lane>>4)&1)*32+(lane&3)*8+(4*hi+((lane&15)>>2))*64;
  const char*Kbase=shm+LDS_K; bf16x8 kf[8];
  const lds_cptr shm3=(lds_cptr)shm; const lds_cptr kp0=shm3+LDS_K+hi*1024+r32*16; const lds_cptr vp0=shm3+LDS_V+((lane>>4)&1)*32+(lane&3)*8+(4*hi+((lane&15)>>2))*64;
  const int NTR=(q0+QB)/KVBLK;
  const lds_cptr shm3b=(lds_cptr)shm;
  const __attribute__((address_space(3))) float* nb3=(const __attribute__((address_space(3))) float*)(shm3b+LDS_NB);
  fox_negcum(logf_bh,(__attribute__((address_space(3))) float*)(shm3b+LDS_NB),(__attribute__((address_space(3))) float*)(shm3b+LDS_NB+32768),tid);
  int NT;
  { __attribute__((address_space(3))) float* PK=(__attribute__((address_space(3))) float*)(shm3b+LDS_PK);
    __attribute__((address_space(3))) int* JX=(__attribute__((address_space(3))) int*)(shm3b+LDS_PK+512);
    float pk=0.f;
    if(tid<128){ const float a=__uint_as_float(kn_bh[2*tid]),c=__uint_as_float(kn_bh[2*tid+1]); pk=__builtin_sqrtf(a+c)*1.001f; }
    #pragma unroll
    for(int o_=1;o_<64;o_<<=1){const float v=__shfl_up(pk,o_); if((tid&63)>=o_)pk=__builtin_fmaxf(pk,v);}
    if(tid==63)PK[128]=pk;
    __syncthreads();
    if(tid>=64&&tid<128)pk=__builtin_fmaxf(pk,PK[128]);
    if(tid<128)PK[tid]=pk;
    const bf16*Krow=Kh+(long)(q0+wid*QBLK+r32)*DM+hi*8; const bf16*Qrow=Qw+(long)r32*DM+hi*8; float qq=0.f,qk=0.f;
    #pragma unroll
    for(int d0=0;d0<4;++d0){ const u32x4 qa=*reinterpret_cast<const u32x4*>(Qrow+d0*16), ka=*reinterpret_cast<const u32x4*>(Krow+d0*16);
      #pragma unroll
      for(int e=0;e<4;++e){ const float q0f=__uint_as_float(qa[e]<<16),q1f=__uint_as_float(qa[e]&0xffff0000u),k0f=__uint_as_float(ka[e]<<16),k1f=__uint_as_float(ka[e]&0xffff0000u);
        qq+=q0f*q0f+q1f*q1f; qk+=q0f*k0f+q1f*k1f; } }
    { auto r1=__builtin_amdgcn_permlane32_swap(__float_as_uint(qq),__float_as_uint(qq),false,false); qq=__uint_as_float(r1[0])+__uint_as_float(r1[1]);
      auto r2=__builtin_amdgcn_permlane32_swap(__float_as_uint(qk),__float_as_uint(qk),false,false); qk=__uint_as_float(r2[0])+__uint_as_float(r2[1]); }
    __syncthreads();
    const float qn=__builtin_sqrtf(qq)*1.001f, thr=qk+nb3[q0+wid*QBLK+r32]-152.f;
    int lo_=0,hi_=NTR;
    #pragma unroll 1
    for(int it=0;it<8;++it){ if(lo_<hi_){ const int mid=(lo_+hi_)>>1; const float f=qn*PK[mid]+nb3[64*mid+63]; if(f>=thr)hi_=mid; else lo_=mid+1; } }
    #pragma unroll
    for(int o_=1;o_<64;o_<<=1){const int v=__shfl_xor(lo_,o_); lo_=v<lo_?v:lo_;}
    if(lane==0)JX[wid]=lo_;
    __syncthreads();
    int j0=JX[0];
    #pragma unroll
    for(int w=1;w<8;++w){const int v=JX[w]; j0=v<j0?v:j0;}
    j0=__builtin_amdgcn_readfirstlane(j0);
    int nte=(NTR-j0+1)&~1; NT=nte<4?4:nte;
    __syncthreads();
  }
  #define BIASADD(P0,P1,t) do{ const __attribute__((address_space(3))) f32x4_t* bp_=(const __attribute__((address_space(3))) f32x4_t*)(nb3+TIDX(t)*64+4*hi); \
    const f32x4_t nm4_={-mhat,-mhat,-mhat,-mhat}; \
    _Pragma("unroll") for(int g_=0;g_<4;++g_){ const f32x4_t b0_=bp_[2*g_]+nm4_,b1_=bp_[2*g_+8]+nm4_; \
      P0[4*g_]+=b0_[0];P0[4*g_+1]+=b0_[1];P0[4*g_+2]+=b0_[2];P0[4*g_+3]+=b0_[3]; P1[4*g_]+=b1_[0];P1[4*g_+1]+=b1_[1];P1[4*g_+2]+=b1_[2];P1[4*g_+3]+=b1_[3]; } }while(0)
  DMA_K(0,0);DMA_V(0,0);DMA_K(1,SLOTB);
  bf16x8 qr[4];
  #pragma unroll
  for(int d0=0;d0<4;++d0)qr[d0]=*reinterpret_cast<const bf16x8*>(&Qw[(long)r32*DM+d0*16+hi*8]);
  float mhat=0.f,l_reg=0.f;f32x16 o[2];o[0]=f32x16{};o[1]=f32x16{};const f32x16 negm=f32x16{};
  const int qrel=wid*QBLK+r32;
  #define CMASK(P0,P1,t) do{ if((t)<4){ cmask(P0,P1,3-(t),qrel,hi); } }while(0)
  bool resc=false;
  #define START(P0,P1) do{ const float rm=rowmax(P0,P1); resc=false; \
    { const float dl=(rm>-3.0e38f)?rm:0.f; mhat=fadd_s(mhat,dl);     \
      _Pragma("unroll") for(int r=0;r<16;++r){P0[r]=fsub_s(P0[r],dl);P1[r]=fsub_s(P1[r],dl);} \
      } \
    _Pragma("unroll") for(int r=0;r<16;++r)P0[r]=__builtin_amdgcn_exp2f(P0[r]); }while(0)
  #define RESC() do{ if(resc){ asm volatile("s_waitcnt lgkmcnt(0)":::"memory"); \
      _Pragma("unroll") for(int d_=0;d_<2;++d_) _Pragma("unroll") for(int r=0;r<16;++r)o[d_][r]*=wsf[crow(r,hi)]; } }while(0)
  f32x16 pA0,pA1,pB0,pB1;
  int sl_prev=0,sl_cur=0,sl_next=SLOTB;
  #define ROT() do{sl_prev=sl_cur;sl_cur=sl_next;sl_next=(sl_next==(NSLOT-1)*SLOTB)?0:sl_next+SLOTB;}while(0)
  DMA_K(2,2*SLOTB);
  WAIT_BAR(3);
  qkt(pA0,pA1,Kbase,qr,negm,r32,hi);asm volatile("s_nop 15\n\ts_nop 7":"+v"(pA0),"+v"(pA1));BIASADD(pA0,pA1,0);CMASK(pA0,pA1,0);
  START(pA0,pA1);
  _Pragma("unroll") for(int r=0;r<16;++r)pA1[r]=__builtin_amdgcn_exp2f(pA1[r]);
  WAIT_BAR(0);
  DMA_K(3,0);DMA_V(1,SLOTB);
  ROT();
  kload8(kf,kp0+sl_cur);
  WAIT_BAR(2);
  s16x4 vlo[8],vhi[8]; u32x4 pw0,pw1,pw2,pw3;
  #define PKW(P,B) cvtpk_s(P[B],P[B+1])
  #define PAF(k) __builtin_bit_cast(bf16x8,pw##k)
  #define VFR(i) (bf16x8){vlo[i][0],vlo[i][1],vlo[i][2],vlo[i][3],vhi[i][0],vhi[i][1],vhi[i][2],vhi[i][3]}
  #define PIN(x) asm volatile("":"+v"(x))
  #define MX3(a,b,c) __builtin_fmaxf(__builtin_fmaxf((a),(b)),(c))
  #define GAPA(MF,A0,A1,A2,A3,W0,W1,PW) do{ MF; sacc+=A0; sacc+=A1; sacc+=A2; sacc+=A3; PIN(sacc); W0; W1; PIN(PW); SBAR(); }while(0)
  #define EX(v) __builtin_amdgcn_exp2f(v)
  #define GAPB(MF,X,B) do{ MF; X[B]=EX(X[B]); X[B+1]=EX(X[B+1]); X[B+2]=EX(X[B+2]); X[B+3]=EX(X[B+3]); PIN(X); SBAR(); }while(0)
  #define VRD(i) do{ vlo[i]=vtr(vp_+(((i)>>2)*4096+((i)&3)*1024)); vhi[i]=vtr(vp_+(((i)>>2)*4096+((i)&3)*1024+512)); }while(0)
  #define KRD(G,j) do{ if(G){ kload2(kf,kp0+sl_next,j); SBAR(); } }while(0)
  #define STEP(C0,C1,P0,P1,t,GK,GV,GL) do{ SBAR(); \
    const lds_cptr vp_=vp0+sl_prev; \
    VRD(0); SBAR(); float sacc=(P0[0]+P0[1]); \
    GAPA(C0=__builtin_amdgcn_mfma_f32_32x32x16_bf16(kf[0],qr[0],negm,0,0,0), P0[2],P0[3],P0[4],P0[5],     pw0[0]=PKW(P0,0), pw0[1]=PKW(P0,2), pw0); \
    VRD(4); SBAR(); GAPA(C1=__builtin_amdgcn_mfma_f32_32x32x16_bf16(kf[1],qr[0],negm,0,0,0), P0[6],P0[7],P0[8],P0[9],     pw0[2]=PKW(P0,4), pw0[3]=PKW(P0,6), pw0); \
    VRD(1); SBAR(); GAPA(C0=__builtin_amdgcn_mfma_f32_32x32x16_bf16(kf[2],qr[1],C0,0,0,0),   P0[10],P0[11],P0[12],P0[13], pw1[0]=PKW(P0,8), pw1[1]=PKW(P0,10), pw1); \
    VRD(5); SBAR(); GAPA(C1=__builtin_amdgcn_mfma_f32_32x32x16_bf16(kf[3],qr[1],C1,0,0,0),   P0[14],P0[15],P1[0],P1[1],   pw1[2]=PKW(P0,12),pw1[3]=PKW(P0,14), pw1); \
    VRD(2); SBAR(); GAPA(C0=__builtin_amdgcn_mfma_f32_32x32x16_bf16(kf[4],qr[2],C0,0,0,0),   P1[2],P1[3],P1[4],P1[5],     pw2[0]=PKW(P1,0), pw2[1]=PKW(P1,2), pw2); \
    VRD(6); SBAR(); GAPA(C1=__builtin_amdgcn_mfma_f32_32x32x16_bf16(kf[5],qr[2],C1,0,0,0),   P1[6],P1[7],P1[8],P1[9],     pw2[2]=PKW(P1,4), pw2[3]=PKW(P1,6), pw2); \
    VRD(3); SBAR(); GAPA(C0=__builtin_amdgcn_mfma_f32_32x32x16_bf16(kf[6],qr[3],C0,0,0,0),   P1[10],P1[11],P1[12],P1[13], pw3[0]=PKW(P1,8), pw3[1]=PKW(P1,10), pw3); \
    VRD(7); SBAR(); GAPA(C1=__builtin_amdgcn_mfma_f32_32x32x16_bf16(kf[7],qr[3],C1,0,0,0),   P1[14],P1[15],0.f,0.f,       pw3[2]=PKW(P1,12),pw3[3]=PKW(P1,14), pw3); \
    l_reg+=sacc; \
    if(GK){DMA_K((t)+3,sl_cur);} if(GV){DMA_V((t)+1,sl_next);} \
    BIASADD(C0,C1,t); CMASK(C0,C1,t); \
    { float a=MX3(C0[0],C0[1],C1[0]),b=MX3(C0[2],C0[3],C1[1]); a=MX3(a,C1[2],C1[3]); \
      _Pragma("unroll") for(int r=4;r<16;r+=4){a=MX3(a,C0[r],C0[r+1]);b=MX3(b,C0[r+2],C0[r+3]);a=MX3(a,C1[r],C1[r+1]);b=MX3(b,C1[r+2],C1[r+3]);} \
      float rm=__builtin_fmaxf(a,b); { auto rr=__builtin_amdgcn_permlane32_swap(__float_as_uint(rm),__float_as_uint(rm),false,false); rm=__builtin_fmaxf(__uint_as_float(rr[0]),__uint_as_float(rr[1])); } \
      resc=false; \
      if(__builtin_expect(__any(rm>(float)THRL),0)){ const float dl=__builtin_fmaxf(rm,0.f); mhat+=dl; \
        _Pragma("unroll") for(int r=0;r<16;++r){C0[r]-=dl;C1[r]-=dl;} \
        const float f=__builtin_amdgcn_exp2f(-dl); l_reg*=f; if(hi==0)wsf[r32]=f; resc=true; } } \
    SBAR(); \
    GAPB(o[0]=__builtin_amdgcn_mfma_f32_32x32x16_bf16(PAF(0),VFR(0),o[0],0,0,0), C0,0); \
    GAPB(o[1]=__builtin_amdgcn_mfma_f32_32x32x16_bf16(PAF(0),VFR(4),o[1],0,0,0), C0,4); \
    KRD(GL,0); GAPB(o[0]=__builtin_amdgcn_mfma_f32_32x32x16_bf16(PAF(1),VFR(1),o[0],0,0,0), C0,8); \
    KRD(GL,1); GAPB(o[1]=__builtin_amdgcn_mfma_f32_32x32x16_bf16(PAF(1),VFR(5),o[1],0,0,0), C0,12); \
    KRD(GL,2); GAPB(o[0]=__builtin_amdgcn_mfma_f32_32x32x16_bf16(PAF(2),VFR(2),o[0],0,0,0), C1,0); \
    KRD(GL,3); GAPB(o[1]=__builtin_amdgcn_mfma_f32_32x32x16_bf16(PAF(2),VFR(6),o[1],0,0,0), C1,4); \
    GAPB(o[0]=__builtin_amdgcn_mfma_f32_32x32x16_bf16(PAF(3),VFR(3),o[0],0,0,0), C1,8); \
    GAPB(o[1]=__builtin_amdgcn_mfma_f32_32x32x16_bf16(PAF(3),VFR(7),o[1],0,0,0), C1,12); \
    }while(0)
  int t=1;
  for(int it_=0;it_<2&&t+5<NT;++it_,t+=2){
    STEP(pB0,pB1,pA0,pA1,t,true,true,true);     WAIT_BAR(2); RESC(); ROT();
    STEP(pA0,pA1,pB0,pB1,t+1,true,true,true);   WAIT_BAR(2); RESC(); ROT();
  }
  #undef CMASK
  #define CMASK(P0,P1,t) do{}while(0)
  for(;t+5<NT;t+=2){
    STEP(pB0,pB1,pA0,pA1,t,true,true,true);     WAIT_BAR(2); RESC(); ROT();
    STEP(pA0,pA1,pB0,pB1,t+1,true,true,true);   WAIT_BAR(2); RESC(); ROT();
  }
  #undef CMASK
  #define CMASK(P0,P1,t) do{ if((t)<4){ cmask(P0,P1,3-(t),qrel,hi); } }while(0)
  #define ENDW(tt) do{ if((tt)+3<NT){WAIT_BAR(2);} else if((tt)+2<NT){WAIT_BAR(1);} else {WAIT_BAR(0);} }while(0)
  for(;t+1<NT;t+=2){
    STEP(pB0,pB1,pA0,pA1,t,(t+3<NT),(t+1<NT),(t+1<NT));       ENDW(t);   RESC(); ROT();
    STEP(pA0,pA1,pB0,pB1,t+1,(t+4<NT),(t+2<NT),(t+2<NT));     ENDW(t+1); RESC(); ROT();
  }
  STEP(pB0,pB1,pA0,pA1,NT-1,false,false,false); RESC();
  { float sacc=pB0[0]+pB0[1]; _Pragma("unroll") for(int r=2;r<16;++r)sacc+=pB0[r]; _Pragma("unroll") for(int r=0;r<16;++r)sacc+=pB1[r]; l_reg+=sacc;
    pw0=(u32x4){PKW(pB0,0),PKW(pB0,2),PKW(pB0,4),PKW(pB0,6)};pw1=(u32x4){PKW(pB0,8),PKW(pB0,10),PKW(pB0,12),PKW(pB0,14)};pw2=(u32x4){PKW(pB1,0),PKW(pB1,2),PKW(pB1,4),PKW(pB1,6)};pw3=(u32x4){PKW(pB1,8),PKW(pB1,10),PKW(pB1,12),PKW(pB1,14)};
    SBAR(); pv(o,vb0+sl_cur,PAF(0),PAF(1),PAF(2),PAF(3)); }
  #undef PKW
  #undef PAF
  #undef VFR
  #undef PIN
  #undef MX3
  #undef GAPA
  #undef GAPB
  #undef EX
  #undef VRD
  #undef KRD
  #undef STEP
  #undef ENDW
  {auto rr=__builtin_amdgcn_permlane32_swap(__float_as_uint(l_reg),__float_as_uint(l_reg),false,false);l_reg=__uint_as_float(rr[0])+__uint_as_float(rr[1]);}
  if(hi==0)wsf[32+r32]=l_reg;asm volatile("s_waitcnt lgkmcnt(0)":::"memory");
  float rli[16];
  #pragma unroll
  for(int r=0;r<16;++r)rli[r]=__builtin_amdgcn_rcpf(wsf[32+crow(r,hi)]);
  bf16*Ow=O+(rowbase+q0+wid*QBLK)*DM+h*D;
  { bf16*stg=(bf16*)(shm+LDS_OST)+wid*2048;
    #pragma unroll
    for(int r=0;r<16;++r){const int orow=crow(r,hi);
      #pragma unroll
      for(int d0=0;d0<2;++d0)stg[orow*64+d0*32+r32]=__float2bfloat16(o[d0][r]*rli[r]);}
    asm volatile("s_waitcnt lgkmcnt(0)":::"memory");
    #pragma unroll
    for(int i=0;i<4;++i){const int row=i*8+(lane>>3),ch=lane&7; const u32x4 v=*(const u32x4*)(stg+row*64+ch*8); ATTN_STORE16(Ow+(long)row*DM+ch*8,v);} }
  asm volatile("s_waitcnt lgkmcnt(0)\n\ts_barrier":::"memory");
  #undef BIASADD
  #undef TIDX
  #undef DMA_K
  #undef DMA_V
  #undef CMASK
  #undef START
  #undef RESC
  #undef ROT
}

template<int PITCH> __device__ __forceinline__ void sb_unit(int b,int h,int qb,const bf16*Q,const bf16*__restrict__ K,const bf16*__restrict__ V,bf16*O  ,char*shm){
  int tid_=threadIdx.x; asm volatile("":"+v"(tid_)); const int tid=tid_,lane=tid&63,r32=lane&31,hi=lane>>5; const int wid=__builtin_amdgcn_readfirstlane(tid>>6);
  const long rowbase=(long)b*SEQ; const int q0=qb*QB;
  const bf16*Qw=Q+(rowbase+q0+wid*QBLK)*PITCH+h*D;
  const bf16*Kh=K+rowbase*PITCH+h*D,*Vh=V+rowbase*PITCH+h*D;
  const unsigned lds0=(unsigned)(uintptr_t)shm;
  const bf16*ksrc=Kh+(long)lane*PITCH+wid*8;
  const bf16*vsrc=Vh+(long)(16*(wid&3)+(lane>>2))*PITCH+(wid>>2)*32+(lane&3)*8;
  const unsigned kdst=lds0+LDS_K+wid*1024, vdst=lds0+LDS_V+wid*1024;
  #define SB_DMA(t,slot) do{ glds16(ksrc+(long)(t)*KVBLK*PITCH,(unsigned)__builtin_amdgcn_readfirstlane(kdst+(slot))); glds16(vsrc+(long)(t)*KVBLK*PITCH,(unsigned)__builtin_amdgcn_readfirstlane(vdst+(slot))); }while(0)
  const int vb0=(int)(lds0+LDS_V)+((lane>>4)&1)*32+(lane&3)*8+(4*hi+((lane&15)>>2))*64;
  volatile __attribute__((address_space(3))) unsigned* fl=(volatile __attribute__((address_space(3))) unsigned*)((lds_cptr)shm+LDS_WS);
  const int NT=(q0+QB)/KVBLK; const int qrel=wid*QBLK+r32;
  SB_DMA(NT-1,0);
  bf16x8 qr[4];
  #pragma unroll
  for(int d0=0;d0<4;++d0)qr[d0]=*reinterpret_cast<const bf16x8*>(&Qw[(long)r32*PITCH+d0*16+hi*8]);
  f32x16 o[2];o[0]=f32x16{};o[1]=f32x16{}; const f32x16 zero16=f32x16{};
  float carry=0.f; const float m0=(hi==0)?1.f:0.f;
  int slot=0;
  for(int t=NT-1;t>=0;--t){
    WAIT_BAR(0);
    if(t<NT-1){ const int pb=((t+1)&1)*8; const unsigned a=fl[pb]&fl[pb+1]&fl[pb+2]&fl[pb+3]&fl[pb+4]&fl[pb+5]&fl[pb+6]&fl[pb+7]; if(__builtin_amdgcn_readfirstlane(a)!=0u)break; }
    if(t>0)SB_DMA(t-1,slot^SLOTB);
    f32x16 p0,p1; qkt(p0,p1,shm+LDS_K+slot,qr,zero16,r32,hi);
    if(t>=NT-4){ const int kb=64*(t-(NT-4))+4*hi;
      #pragma unroll
      for(int r=0;r<16;++r){const int kv=kb+(r&3)+8*(r>>2); if(kv>=qrel)p0[r]=-INFINITY; if(kv+32>=qrel)p1[r]=-INFINITY;} }
    f32x16 s0,s1;
    #pragma unroll
    for(int r=0;r<16;++r){ const float z=p0[r]; const float sp=__builtin_fmaxf(z,0.f)+__builtin_amdgcn_logf(1.f+__builtin_amdgcn_exp2f(-__builtin_fabsf(z))); s0[r]=sp; p0[r]=z-sp;
                           const float y=p1[r]; const float sq=__builtin_fmaxf(y,0.f)+__builtin_amdgcn_logf(1.f+__builtin_amdgcn_exp2f(-__builtin_fabsf(y))); s1[r]=sq; p1[r]=y-sq; }
    float lo[8],hv[8];
    #pragma unroll
    for(int i=0;i<8;++i){ const float mine=(i<4)?((s0[4*i]+s0[4*i+1])+(s0[4*i+2]+s0[4*i+3])):((s1[4*i-16]+s1[4*i-15])+(s1[4*i-14]+s1[4*i-13]));
      auto rr=__builtin_amdgcn_permlane32_swap(__float_as_uint(mine),__float_as_uint(mine),false,false); lo[i]=__uint_as_float(rr[0]); hv[i]=__uint_as_float(rr[1]); }
    float sp_=0.f;
    #pragma unroll
    for(int i=7;i>=0;--i){ const float base=carry-(sp_+m0*hv[i]);
      if(i<4){ float a=base; p0[4*i+3]=__builtin_amdgcn_exp2f(p0[4*i+3]+a); a-=s0[4*i+3]; p0[4*i+2]=__builtin_amdgcn_exp2f(p0[4*i+2]+a); a-=s0[4*i+2]; p0[4*i+1]=__builtin_amdgcn_exp2f(p0[4*i+1]+a); a-=s0[4*i+1]; p0[4*i]=__builtin_amdgcn_exp2f(p0[4*i]+a); }
      else   { const int j=4*i-16; float a=base; p1[j+3]=__builtin_amdgcn_exp2f(p1[j+3]+a); a-=s1[j+3]; p1[j+2]=__builtin_amdgcn_exp2f(p1[j+2]+a); a-=s1[j+2]; p1[j+1]=__builtin_amdgcn_exp2f(p1[j+1]+a); a-=s1[j+1]; p1[j]=__builtin_amdgcn_exp2f(p1[j]+a); }
      sp_+=lo[i]+hv[i]; }
    carry-=sp_;
    { u32x4 pw0,pw1,pw2,pw3;
      pw0=(u32x4){cvtpk_s(p0[0],p0[1]),cvtpk_s(p0[2],p0[3]),cvtpk_s(p0[4],p0[5]),cvtpk_s(p0[6],p0[7])}; pw1=(u32x4){cvtpk_s(p0[8],p0[9]),cvtpk_s(p0[10],p0[11]),cvtpk_s(p0[12],p0[13]),cvtpk_s(p0[14],p0[15])};
      pw2=(u32x4){cvtpk_s(p1[0],p1[1]),cvtpk_s(p1[2],p1[3]),cvtpk_s(p1[4],p1[5]),cvtpk_s(p1[6],p1[7])}; pw3=(u32x4){cvtpk_s(p1[8],p1[9]),cvtpk_s(p1[10],p1[11]),cvtpk_s(p1[12],p1[13]),cvtpk_s(p1[14],p1[15])};
      pv(o,vb0+slot,__builtin_bit_cast(bf16x8,pw0),__builtin_bit_cast(bf16x8,pw1),__builtin_bit_cast(bf16x8,pw2),__builtin_bit_cast(bf16x8,pw3)); }
    { const bool done_=__all(carry<-150.f); if(lane==0)fl[(t&1)*8+wid]=done_?1u:0u; }
    slot^=SLOTB;
  }
  asm volatile("s_waitcnt vmcnt(0) lgkmcnt(0)":::"memory");
  bf16*Ow=O+(rowbase+q0+wid*QBLK)*1024+h*D;
  { bf16*stg=(bf16*)(shm+LDS_OST)+wid*2048;
    #pragma unroll
    for(int r=0;r<16;++r){const int orow=crow(r,hi);
      #pragma unroll
      for(int d0=0;d0<2;++d0)stg[orow*64+d0*32+r32]=__float2bfloat16(o[d0][r]);}
    asm volatile("s_waitcnt lgkmcnt(0)":::"memory");
    #pragma unroll
    for(int i=0;i<4;++i){const int row=i*8+(lane>>3),ch=lane&7; const u32x4 v=*(const u32x4*)(stg+row*64+ch*8); ATTN_STORE16(Ow+(long)row*1024+ch*8,v);} }
  asm volatile("s_waitcnt vmcnt(0) lgkmcnt(0)\n\ts_barrier":::"memory");
  #undef SB_DMA
}
constexpr int ATTN_LDS_BYTES=LDS_BYTES;
struct AttnTensors { const bf16* Q; const bf16* K; const bf16* V; bf16* O; const float* logf;   const unsigned* kn;   };
struct AttnUnit { int bh; int qb; };
struct StaticOrder {
  int vcu;
  __device__ __forceinline__ explicit StaticOrder(int grid,int block):vcu((block%8)*(grid/8)+block/8){}
  __device__ __forceinline__ bool next(int i,AttnUnit&u)const{ if(i>=4)return false; const int s=vcu&7; u.bh=vcu>>3; u.qb=(i==0)?s:(i==1)?15-s:(i==2)?16+s:31-s; return true; }
  __device__ __forceinline__ void a_ready(const AttnUnit&)const{}
  __device__ __forceinline__ void done(const AttnUnit&)const{}
};
template<class Sched,int THRL=8> __device__ __forceinline__ void attn_phase(char*lds,const AttnTensors&T,const Sched&S){
  AttnUnit u;
  for(int i=0;S.next(i,u);++i){ S.a_ready(u); attn_unit<THRL>(u.bh/NHEAD,u.bh%NHEAD,u.qb,T.Q,T.K,T.V,T.O,lds,T.logf+(size_t)u.bh*SEQ,T.kn+(size_t)u.bh*256); S.done(u); }
}
#undef SBAR
#undef WAIT_BAR
}
constexpr int NWAVES = 8, NTHREADS = NWAVES * 64;
constexpr int BATCH = 2, SEQ = 8192, D = 1024, M = BATCH * SEQ;
constexpr int S5G = 32, S5H = 16, S5P = 64, S5T = 32  , S5NC = M / S5T  , S5KX = 640  ;
constexpr int SBH = 8, FOXH = 16, HD = 64;
constexpr int EVEN_IN = 2048, ODD_IN = 3088, DFF = 2816, NEXP = 8, DFE = 3584;
constexpr float C2 = 0.125f * 1.4426950408889634f;
constexpr int MOE_CHUNK_PANELS = 68, MOE_MAX_PANELS = 136, MOE_MAX_SLOTS = MOE_MAX_PANELS * 256;

constexpr size_t MiB = 1u << 20;
constexpr size_t WS_CTL = 0, CTL_ZERO_BYTES = 1 * MiB;
constexpr size_t WS_WMOE_GU = 1 * MiB;
constexpr size_t WS_WMOE_D = 57 * MiB;
constexpr size_t WS_WIN0 = 85 * MiB;
constexpr size_t WS_WGLU = 89 * MiB;
constexpr size_t WS_WOUT0 = 90 * MiB;
constexpr size_t WS_WGU0 = 92 * MiB;
constexpr size_t WS_WD0 = 103 * MiB;
constexpr size_t WS_WIN1 = 109 * MiB;
constexpr size_t WS_WF1 = 115 * MiB;
constexpr size_t WS_WOUT1 = 116 * MiB;
constexpr size_t WS_S5WA = 118 * MiB;
constexpr size_t WS_S5WC = 126 * MiB;
constexpr size_t WS_XB = 146 * MiB;
constexpr size_t WS_SSP = 178 * MiB;
constexpr size_t WS_META = 182 * MiB;
constexpr size_t WS_LOGF = 183 * MiB;
constexpr size_t WS_QKV0 = 184 * MiB;
constexpr size_t WS_UEXT = 232 * MiB;
constexpr size_t WS_SLOC = 252 * MiB;
constexpr size_t WS_YG = 260 * MiB;
constexpr size_t WS_MIXB = 276 * MiB;
constexpr size_t WS_HID0 = 184 * MiB;
constexpr size_t WS_QKV1 = 184 * MiB;
constexpr size_t WS_XG = 184 * MiB;
constexpr size_t WS_HMOE = 218 * MiB;
constexpr size_t WS_Y = 85 * MiB;
constexpr size_t WS_END = 337 * MiB;
static_assert(WS_XG + (size_t)MOE_MAX_SLOTS * 1024 <= WS_HMOE && WS_HMOE + (size_t)MOE_MAX_SLOTS * DFE <= WS_END && WS_Y + (size_t)MOE_MAX_SLOTS * 1024 * 2 <= WS_XB + 32 * MiB && WS_MIXB + 32 * MiB <= WS_END, "ws map");
constexpr size_t MT_RSTD = 0, MT_TOKE = 65536, MT_TOKP = 131072, MT_TOKG = 262144, MT_TOKSLOT = 393216, MT_RSS = 524288;
constexpr int CW_TMO = 0, CW_CODE = 1, CW_BAR = 4096, CW_CNT = 8192  , CW_QUEUE = 12288  , CW_QUEUE2 = 12352  , CW_KN = 16384  , CW_SS = 32768  ;

constexpr int RING_OFF = 0, RING_BYTES = 131072;
constexpr int LDSCTL_OFF = 133120  , MISC_OFF = LDSCTL_OFF + 320;
constexpr int LDS_BYTES = 147456;

#define GAS __attribute__((address_space(1)))
#define LAS __attribute__((address_space(3)))
typedef unsigned short bf16;
typedef unsigned v4u __attribute__((ext_vector_type(4)));
typedef unsigned v2u __attribute__((ext_vector_type(2)));
typedef float f32x4 __attribute__((ext_vector_type(4)));
typedef short bf16x8 __attribute__((ext_vector_type(8)));
typedef GAS unsigned gu32;
#define RLX_AGENT __ATOMIC_RELAXED, __HIP_MEMORY_SCOPE_AGENT
#define LDS_WAIT() asm volatile("s_waitcnt lgkmcnt(0)" ::: "memory")
#define VM_WAIT() asm volatile("s_waitcnt vmcnt(0)" ::: "memory")
__device__ __forceinline__ unsigned f2bf(float f) { unsigned u = __builtin_bit_cast(unsigned, f); return (u + 0x7fffu + ((u >> 16) & 1u)) >> 16; }
__device__ __forceinline__ unsigned pk2(float lo, float hi) { return f2bf(lo) | (f2bf(hi) << 16); }
__device__ __forceinline__ float bflo(unsigned w) { return __uint_as_float(w << 16); }
__device__ __forceinline__ float bfhi(unsigned w) { return __uint_as_float(w & 0xffff0000u); }

#define XB_TMO      128
#define XB_XCNT(j)  (256  + 64 * (j))
#define XB_XSUB(j)  (1280 + 64 * (j))
#define XB_XGEN(j)  (2304 + 64 * (j))
#define XB_TOP      3328
#define XB_TOPGEN   3392
#define XCD_BAR_WORDS 3456
#define XB_SPIN_CAP (1u << 18)
__device__ __forceinline__ unsigned xb_ld(unsigned* p)              { return __hip_atomic_load(p, __ATOMIC_RELAXED, __HIP_MEMORY_SCOPE_AGENT); }
__device__ __forceinline__ unsigned xb_add(unsigned* p, unsigned v) { return __hip_atomic_fetch_add(p, v, __ATOMIC_RELAXED, __HIP_MEMORY_SCOPE_AGENT); }
__device__ __forceinline__ unsigned xb_xcc_id() { return (unsigned)__builtin_amdgcn_s_getreg((3 << 11) | 20) & 0xFu; }
#define XB_SPIN(cond, bar) do { unsigned _sp = 0; while (cond) { __builtin_amdgcn_s_sleep(1); \
    if ((++_sp & 255u) == 0u) { if (xb_ld(&(bar)[XB_TMO])) break; if (_sp > XB_SPIN_CAP) { atomicAdd(&(bar)[XB_TMO], 1u); break; } } } } while (0)
struct XcdBarrier { unsigned* bar; unsigned x; volatile LAS unsigned* st; };
__device__ __forceinline__ XcdBarrier xcd_barrier_post(unsigned* bar, volatile LAS unsigned* st) {
    XcdBarrier b; b.bar = bar; b.x = xb_xcc_id(); b.st = st;
    if (threadIdx.x == 0) (void)xb_add(&bar[XB_XCNT(b.x)], 1u);
    return b;
}
__device__ __forceinline__ void xcd_barrier_complete(unsigned* bar, unsigned x, unsigned& nloc, unsigned& nx) {
    const unsigned G = gridDim.x * gridDim.y * gridDim.z;
    unsigned sum, cnt, mine, sp = 0u;
    for (;;) {
        sum = 0u; cnt = 0u; mine = 0u;
#pragma unroll
        for (unsigned j = 0; j < 16; ++j) { const unsigned c = xb_ld(&bar[XB_XCNT(j)]); sum += c; cnt += (c > 0u) ? 1u : 0u; mine = (j == x) ? c : mine; }
        if (sum == G) break;
        __builtin_amdgcn_s_sleep(1);
        if ((++sp & 255u) == 0u) { if (xb_ld(&bar[XB_TMO])) break; if (sp > XB_SPIN_CAP) { atomicAdd(&bar[XB_TMO], 1u); break; } }
    }
    nloc = mine > 0u ? mine : 1u; nx = cnt > 0u ? cnt : 1u;
}
__device__ __forceinline__ void xcd_barrier(const XcdBarrier& b) {
    asm volatile("s_waitcnt vmcnt(0)" ::: "memory");
    __syncthreads();
    if (threadIdx.x == 0) {
        unsigned* bar = b.bar;
        __builtin_amdgcn_s_waitcnt(0);
        unsigned nloc = b.st[0], nx = b.st[1];
        if (nloc == 0u) { xcd_barrier_complete(bar, b.x, nloc, nx); b.st[0] = nloc; b.st[1] = nx; }
        const unsigned old = xb_add(&bar[XB_XSUB(b.x)], 1u);
        const unsigned gen = old / nloc;
        if (old + 1u == (gen + 1u) * nloc) {
            __builtin_amdgcn_fence(__ATOMIC_RELEASE, "agent");
            asm volatile("s_waitcnt vmcnt(0)" ::: "memory");
            const unsigned og = xb_add(&bar[XB_TOP], 1u);
            const unsigned tg = og / nx;
            if (og + 1u == (tg + 1u) * nx) xb_add(&bar[XB_TOPGEN], 1u);
            else XB_SPIN(xb_ld(&bar[XB_TOPGEN]) == tg, bar);
            __builtin_amdgcn_fence(__ATOMIC_ACQUIRE, "agent");
            xb_add(&bar[XB_XGEN(b.x)], 1u);
            asm volatile("s_waitcnt vmcnt(0)" ::: "memory");
        } else {
            XB_SPIN(xb_ld(&bar[XB_XGEN(b.x)]) == gen, bar);
            __builtin_amdgcn_fence(__ATOMIC_ACQUIRE, "agent");
            asm volatile("s_waitcnt vmcnt(0)" ::: "memory");
        }
    }
    __syncthreads();
}

__device__ __forceinline__ float wave_sum(float v) {
#pragma unroll
    for (int o = 1; o < 64; o <<= 1) v += __shfl_xor(v, o);
    return v;
}
constexpr int XP = 65, XSCR_BYTES = 64 * XP * 4;
__device__ __forceinline__ unsigned cvtpk(float lo, float hi) { unsigned r; asm volatile("v_cvt_pk_bf16_f32 %0, %1, %2" : "=v"(r) : "v"(lo), "v"(hi)); return r; }
__device__ __forceinline__ void p0_transpose_item(const float* W, int ldw, int k0, int n0, const float* gs, bf16* dst, int ldd, LAS float* scr, int lane) {
    const int lr = lane >> 4, lc = (lane & 15) * 4;
    const float* src = W + (size_t)(k0 + lr) * ldw + n0 + lc;
    f32x4 v[16];
#pragma unroll
    for (int i = 0; i < 16; ++i) v[i] = *(const GAS f32x4*)(src + (size_t)(4 * i) * ldw);
    if (gs) {
#pragma unroll
        for (int i = 0; i < 16; ++i) v[i] = v[i] * gs[k0 + 4 * i + lr]; }
#pragma unroll
    for (int i = 0; i < 16; ++i) { LAS float* p = scr + (4 * i + lr) * XP + lc; p[0] = v[i][0]; p[1] = v[i][1]; p[2] = v[i][2]; p[3] = v[i][3]; }
    LDS_WAIT(); asm volatile("" ::: "memory");
    const int c = lane & 7, nn = lane >> 3;
#pragma unroll
    for (int j = 0; j < 8; ++j) { const int n = nn + 8 * j; const LAS float* sp = scr + (8 * c) * XP + n;
        v4u o; o.x = cvtpk(sp[0 * XP], sp[1 * XP]); o.y = cvtpk(sp[2 * XP], sp[3 * XP]); o.z = cvtpk(sp[4 * XP], sp[5 * XP]); o.w = cvtpk(sp[6 * XP], sp[7 * XP]);
        *(GAS v4u*)(dst + (size_t)n * ldd + k0 + 8 * c) = o; }
    LDS_WAIT(); asm volatile("" ::: "memory");
}
struct XTile { const float* src; const float* gs; unsigned char* dst; int ldw, ldd, k0; };
__device__ __forceinline__ XTile xtile_fp8(int item, const float* W, int ldw, int N, const float* gs, unsigned char* dst, int ldd, int mode, int lane) {
    const int nblk = N / 64, kb = item / nblk, nb = item % nblk, n0 = 64 * nb, k0 = 64 * kb;
    const int row = mode == 0 ? n0 : ((n0 >> 7) * 256 + (n0 & 127) + (mode == 2 ? 128 : 0));
    XTile t; t.src = W + (size_t)(k0 + (lane >> 4)) * ldw + n0 + (lane & 15) * 4; t.gs = gs; t.dst = dst + (size_t)row * ldd; t.ldw = ldw; t.ldd = ldd; t.k0 = k0; return t;
}
__device__ __forceinline__ void xtile_load(const XTile& t, f32x4 (&v)[16]) {
#pragma unroll
    for (int i = 0; i < 16; ++i) v[i] = *(const GAS f32x4*)(t.src + (size_t)(4 * i) * t.ldw);
}
__device__ __forceinline__ void xtile_finish_fp8(const XTile& t, f32x4 (&v)[16], float wscale, LAS float* scr, int lane) {
    const int lr = lane >> 4, lc = (lane & 15) * 4;
#pragma unroll
    for (int i = 0; i < 16; ++i) v[i] = v[i] * (t.gs ? t.gs[t.k0 + 4 * i + lr] * wscale : wscale);
#pragma unroll
    for (int i = 0; i < 16; ++i) { LAS float* p = scr + (4 * i + lr) * XP + lc; p[0] = v[i][0]; p[1] = v[i][1]; p[2] = v[i][2]; p[3] = v[i][3]; }
    LDS_WAIT(); asm volatile("" ::: "memory");
    const int c = lane & 3, nn = lane >> 2;
#pragma unroll
    for (int j = 0; j < 4; ++j) { const int n = nn + 16 * j; const LAS float* sp = scr + (16 * c) * XP + n;
        v4u o; o.x = pg8::pk_fp8x4(sp[0 * XP], sp[1 * XP], sp[2 * XP], sp[3 * XP]); o.y = pg8::pk_fp8x4(sp[4 * XP], sp[5 * XP], sp[6 * XP], sp[7 * XP]);
        o.z = pg8::pk_fp8x4(sp[8 * XP], sp[9 * XP], sp[10 * XP], sp[11 * XP]); o.w = pg8::pk_fp8x4(sp[12 * XP], sp[13 * XP], sp[14 * XP], sp[15 * XP]);
        *(GAS v4u*)(t.dst + (size_t)n * t.ldd + t.k0 + 16 * c) = o; }
    LDS_WAIT(); asm volatile("" ::: "memory");
}
__device__ __forceinline__ void xpose_mat(int item, const float* W, int ldw, int N, const float* gs, bf16* dst, int ldd, int mode, LAS float* scr, int lane) {
    const int nblk = N / 64, kb = item / nblk, nb = item % nblk, n0 = 64 * nb;
    const int row = mode == 0 ? n0 : ((n0 >> 7) * 256 + (n0 & 127) + (mode == 2 ? 128 : 0));
    p0_transpose_item(W, ldw, 64 * kb, n0, gs, dst + (size_t)row * ldd, ldd, scr, lane);
}

struct Args { const float* in[28]; float* out; unsigned char* ws; };

__device__ __forceinline__ void s5_tables(const Args& a, int g, int q, LAS unsigned char* lds, int tid) {
    LAS float* POWr = (LAS float*)lds;
    LAS float* POWi = POWr + 33 * 64;
    LAS float* BBr = POWi + 33 * 64;
    LAS float* BBi = BBr + 1024;
    LAS float* CCr = BBi + 1024;
    LAS float* CCi = CCr + 1024;
    LAS float* KT = CCi + 1024;
    LAS float* DD = KT + 2048;
    const float* a_re = a.in[3]; const float* a_im = a.in[4]; const float* b_re = a.in[5]; const float* b_im = a.in[6];
    const float* c_re = a.in[7]; const float* c_im = a.in[8]; const float* dsk = a.in[9]; const float* log_step = a.in[10];
    const float step = expf(log_step[g]);
    __syncthreads();
    for (int e = tid; e < 33 * 64; e += NTHREADS) { const int n = e >> 6, p = e & 63; const float lr = a_re[g * 64 + p], li = a_im[g * 64 + p];
        const float mag = expf((float)n * step * lr); float sn, cs; sincosf((float)n * (step * li), &sn, &cs); POWr[e] = mag * cs; POWi[e] = mag * sn; }
    for (int e = tid; e < 1024; e += NTHREADS) { const int p = e >> 4, h = e & 15; const float lr = a_re[g * 64 + p], li = a_im[g * 64 + p];
        const float er = expf(lr * step); float sn, cs; sincosf(li * step, &sn, &cs); const float nr = er * cs - 1.f, ni = er * sn, den = lr * lr + li * li;
        const float fr = (nr * lr + ni * li) / den, fi = (ni * lr - nr * li) / den;
        const float br = b_re[(g * 64 + p) * 16 + h], bi = b_im[(g * 64 + p) * 16 + h];
        BBr[e] = fr * br - fi * bi; BBi[e] = fr * bi + fi * br;
        CCr[e] = c_re[g * 1024 + e]; CCi[e] = c_im[g * 1024 + e]; }
    if (tid < 16) DD[tid] = dsk[g * 16 + tid];
    __syncthreads();
    for (int e = tid; e < 2048; e += NTHREADS) { const int tau = e >> 6, hl = (e >> 4) & 3, hi = e & 15, ho = 4 * q + hl; float sacc = 0.f;
        for (int p = 0; p < 64; ++p) { const float cr = CCr[ho * 64 + p], ci = CCi[ho * 64 + p], pr = POWr[tau * 64 + p], pi = POWi[tau * 64 + p];
            const float xr = cr * pr - ci * pi, xi = cr * pi + ci * pr; sacc += xr * BBr[p * 16 + hi] - xi * BBi[p * 16 + hi]; }
        if (tau == 0 && ho == hi) sacc += DD[ho];
        KT[e] = sacc; }
    __syncthreads();
    bf16* WA = (bf16*)(a.ws + WS_S5WA) + (size_t)g * 256 * 512;
    for (int pc = tid; pc < 64 * 64; pc += NTHREADS) { const int p = pc >> 6, k0 = (pc & 63) * 8; v4u o = (v4u){0u, 0u, 0u, 0u};
        if (q < 2) { const int j = k0 >> 4, h0 = k0 & 15; const float pr = POWr[(31 - j) * 64 + p], pi = POWi[(31 - j) * 64 + p]; float v[8];
#pragma unroll
            for (int w = 0; w < 8; ++w) { const float br = BBr[p * 16 + h0 + w], bi = BBi[p * 16 + h0 + w]; v[w] = (q == 0) ? (pr * br - pi * bi) : (pr * bi + pi * br); }
            o.x = cvtpk(v[0], v[1]); o.y = cvtpk(v[2], v[3]); o.z = cvtpk(v[4], v[5]); o.w = cvtpk(v[6], v[7]); }
        *(GAS v4u*)(WA + (size_t)(64 * q + p) * 512 + k0) = o; }
    bf16* WC = (bf16*)(a.ws + WS_S5WC) + (size_t)g * 512 * 640;
    for (int pc = tid; pc < 128 * 80; pc += NTHREADS) { const int rl = pc / 80, k0 = (pc % 80) * 8, i = rl >> 2, hl = rl & 3, ho = 4 * q + hl; float v[8];
        if (k0 < 512) { const int j = k0 >> 4, h0 = k0 & 15;
#pragma unroll
            for (int w = 0; w < 8; ++w) v[w] = (j <= i) ? KT[((i - j) * 4 + hl) * 16 + h0 + w] : 0.f; }
        else { const int p0 = (k0 - 512) & 63; const bool im = k0 >= 576;
#pragma unroll
            for (int w = 0; w < 8; ++w) { const int p = p0 + w; const float cr = CCr[ho * 64 + p], ci = CCi[ho * 64 + p], pr = POWr[(i + 1) * 64 + p], pi = POWi[(i + 1) * 64 + p];
                v[w] = im ? -(cr * pi + ci * pr) : (cr * pr - ci * pi); } }
        v4u o; o.x = cvtpk(v[0], v[1]); o.y = cvtpk(v[2], v[3]); o.z = cvtpk(v[4], v[5]); o.w = cvtpk(v[6], v[7]);
        *(GAS v4u*)(WC + (size_t)(i * 16 + ho) * 640 + k0) = o; }
    __syncthreads();
}

constexpr int MOE_XITEMS = 24 * 896;
__device__ __forceinline__ XTile moe_xtile(const Args& a, int r, int lane) {
    unsigned char* ws = a.ws;
    const int mat = r / 896, e = mat / 3, which = mat % 3; r -= mat * 896;
    if (which == 0) return xtile_fp8(r, a.in[24] + (size_t)e * D * DFE, DFE, DFE, a.in[22], ws + WS_WMOE_GU + (size_t)e * 7168 * 1024, D, 1, lane);
    if (which == 1) return xtile_fp8(r, a.in[25] + (size_t)e * D * DFE, DFE, DFE, a.in[22], ws + WS_WMOE_GU + (size_t)e * 7168 * 1024, D, 2, lane);
    return xtile_fp8(r, a.in[26] + (size_t)e * DFE * D, D, D, nullptr, ws + WS_WMOE_D + (size_t)e * 1024 * 3584, DFE, 0, lane);
}
__device__ __forceinline__ void p0_prologue(const Args& a, LAS unsigned char* lds, int tid, int lane, int wave, int vcu, int G) {
    for (int it = vcu; it < 4 * S5G; it += G) s5_tables(a, it >> 2, it & 3, lds, tid);
    LAS float* scr = (LAS float*)(lds + wave * XSCR_BYTES);
    const int gw = vcu * NWAVES + wave, NGW = G * NWAVES;
    constexpr int I_IN0 = 16 * 32, I_GLU = 8 * 8, I_OUT = 16 * 16, I_GU0 = 16 * 44, I_D0 = 44 * 16, I_IN1 = 16 * 48, I_MOE = 896;
    constexpr int NITEMS = I_IN0 + I_GLU + I_OUT + 2 * I_GU0 + I_D0 + I_IN1 + I_OUT;
    unsigned char* ws = a.ws;
    for (int it = NITEMS - 1 - gw; it >= 0; it -= NGW) {
        int r = it;
        if (r < I_IN0) { xpose_mat(r, a.in[2], EVEN_IN, EVEN_IN, a.in[1], (bf16*)(ws + WS_WIN0), D, 0, scr, lane); continue; } r -= I_IN0;
        if (r < I_GLU) { xpose_mat(r, a.in[11], 512, 512, nullptr, (bf16*)(ws + WS_WGLU), 512, 0, scr, lane); continue; } r -= I_GLU;
        if (r < I_OUT) { xpose_mat(r, a.in[13], D, D, nullptr, (bf16*)(ws + WS_WOUT0), D, 0, scr, lane); continue; } r -= I_OUT;
        if (r < I_GU0) { xpose_mat(r, a.in[15], DFF, DFF, a.in[14], (bf16*)(ws + WS_WGU0), D, 1, scr, lane); continue; } r -= I_GU0;
        if (r < I_GU0) { xpose_mat(r, a.in[16], DFF, DFF, a.in[14], (bf16*)(ws + WS_WGU0), D, 2, scr, lane); continue; } r -= I_GU0;
        if (r < I_D0) { xpose_mat(r, a.in[17], D, D, nullptr, (bf16*)(ws + WS_WD0), DFF, 0, scr, lane); continue; } r -= I_D0;
        if (r < I_IN1) { xpose_mat(r, a.in[19], ODD_IN, 3072, a.in[18], (bf16*)(ws + WS_WIN1), D, 0, scr, lane); continue; } r -= I_IN1;
        xpose_mat(r, a.in[21], D, D, nullptr, (bf16*)(ws + WS_WOUT1), D, 0, scr, lane);
    }
    { const int gt = vcu * NTHREADS + tid; if (gt < 16 * 1024) { const int h = gt >> 10, k = gt & 1023; ((bf16*)(ws + WS_WF1))[gt] = (bf16)f2bf(a.in[19][(size_t)k * ODD_IN + 3072 + h] * a.in[18][k]); } }
    float* ss0 = (float*)(ws + WS_SSP);
    for (int m = gw; m < M; m += NGW) {
        const GAS f32x4* xr = (const GAS f32x4*)(a.in[0] + (size_t)m * D) + lane; GAS v2u* o8 = (GAS v2u*)((bf16*)(ws + WS_XB) + (size_t)m * D) + lane; float s = 0.f;
#pragma unroll
        for (int j = 0; j < 4; ++j) { const f32x4 v = xr[64 * j]; s += (v.x * v.x + v.y * v.y) + (v.z * v.z + v.w * v.w); v2u w; w.x = pk2(v.x, v.y); w.y = pk2(v.z, v.w); o8[64 * j] = w; }
        s = wave_sum(s); if (lane < 16) ss0[(size_t)m * 16 + lane] = (lane == 0) ? s : 0.f;
    }
}

__device__ __forceinline__ void s5_scan(const Args& a, int gt  ) {
    if (gt >= BATCH * S5G * S5P) return;
    const int b = gt / (S5G * S5P), g = (gt / S5P) % S5G, p = gt % S5P;
    const float step = expf(a.in[10][g]); const float lr = a.in[3][g * 64 + p], li = a.in[4][g * 64 + p];
    const float mag = expf((float)S5T * step * lr); float sn, cs; sincosf((float)S5T * (step * li), &sn, &cs); const float ar = mag * cs, ai = mag * sn;
    const float* sl = (const float*)(a.ws + WS_SLOC) + ((size_t)g * S5NC + b * 256) * 128 + p;
    bf16* ue = (bf16*)(a.ws + WS_UEXT) + ((size_t)g * S5NC + b * 256) * S5KX + 512 + p;
    float sr = 0.f, si = 0.f;
#pragma unroll 8
    for (int c = 0; c < 256; ++c) {
        ue[(size_t)c * S5KX] = (bf16)f2bf(sr); ue[(size_t)c * S5KX + 64] = (bf16)f2bf(si);
        const float lr_ = sl[(size_t)c * 128], li_ = sl[(size_t)c * 128 + 64];
        const float nr = ar * sr - ai * si + lr_, ni = ar * si + ai * sr + li_; sr = nr; si = ni;
    }
}

__device__ __forceinline__ float softplus2(float z) { return fmaxf(z, 0.f) + __builtin_amdgcn_logf(1.0f + __builtin_amdgcn_exp2f(-fabsf(z))); }
__device__ __forceinline__ void stage_kv32(const bf16* kp, const bf16* vp, size_t pitch, LAS float* sK, LAS float* sV, int tid) {
    const int r = tid >> 4, c = (tid & 15) * 4;
    const v2u kw = *(const v2u*)(kp + (size_t)r * pitch + c), vw = *(const v2u*)(vp + (size_t)r * pitch + c);
    *(LAS f32x4*)(sK + r * 64 + c) = (f32x4){bflo(kw.x), bfhi(kw.x), bflo(kw.y), bfhi(kw.y)};
    *(LAS f32x4*)(sV + r * 64 + c) = (f32x4){bflo(vw.x), bfhi(vw.x), bflo(vw.y), bfhi(vw.y)};
}
__device__ __forceinline__ void sb_simple_unit(const bf16* qkv  , bf16* mix  , int b, int h, int blk, LAS unsigned char* lds, int tid) {
    const int lane = tid & 63, wave_ = tid >> 6;
    LAS float* sK = (LAS float*)lds; LAS float* sV = sK + 32 * 64;
    const int t = blk * 512 + tid; const size_t rb = (size_t)b * SEQ;
    float q[HD], acc[HD];
    { const v4u* qp = (const v4u*)(qkv + (rb + t) * 1536 + h * HD);
#pragma unroll
      for (int i = 0; i < 8; ++i) { const v4u w = qp[i]; q[8 * i] = bflo(w.x); q[8 * i + 1] = bfhi(w.x); q[8 * i + 2] = bflo(w.y); q[8 * i + 3] = bfhi(w.y); q[8 * i + 4] = bflo(w.z); q[8 * i + 5] = bfhi(w.z); q[8 * i + 6] = bflo(w.w); q[8 * i + 7] = bfhi(w.w); }
#pragma unroll
      for (int i = 0; i < HD; ++i) acc[i] = 0.f; }
    float carry = 0.f;
    for (int c0 = blk * 512 + 480; c0 >= 0; c0 -= 32) {
        __syncthreads();
        stage_kv32(qkv + (rb + c0) * 1536 + 512 + h * HD, qkv + (rb + c0) * 1536 + 1024 + h * HD, 1536, sK, sV, tid);
        __syncthreads();
        for (int r = 31; r >= 0; --r) { const int s = c0 + r;
            if (s < t) { float z = 0.f;
#pragma unroll
                for (int i = 0; i < HD; ++i) z = fmaf(q[i], sK[r * 64 + i], z);
                const float sp = softplus2(z); const float w = __builtin_amdgcn_exp2f(z - sp + carry); carry -= sp;
#pragma unroll
                for (int i = 0; i < HD; ++i) acc[i] = fmaf(w, sV[r * 64 + i], acc[i]); } }
        { LAS unsigned* fl = (LAS unsigned*)(lds + 16384); if (lane == 0) fl[wave_] = __all(carry < -150.f) ? 1u : 0u; __syncthreads();
          if ((fl[0] & fl[1] & fl[2] & fl[3] & fl[4] & fl[5] & fl[6] & fl[7]) != 0u) break; }
    }
    v4u* op = (v4u*)(mix + (rb + t) * 1024 + 512 + h * HD);
#pragma unroll
    for (int i = 0; i < 8; ++i) { v4u w; w.x = pk2(acc[8 * i], acc[8 * i + 1]); w.y = pk2(acc[8 * i + 2], acc[8 * i + 3]); w.z = pk2(acc[8 * i + 4], acc[8 * i + 5]); w.w = pk2(acc[8 * i + 6], acc[8 * i + 7]); op[i] = w; }
}
__device__ __forceinline__ void fgate_rows16(const bf16* xb, const bf16* wf, const float* ss, const float* bfv, float* logf, int r0, int lane) {
    const int fr = lane & 15, fq = lane >> 4;
    const bf16x8* ap = (const bf16x8*)(xb + (size_t)(r0 + fr) * D + fq * 8);
    const bf16x8* bp = (const bf16x8*)(wf + (size_t)fr * D + fq * 8);
    f32x4 acc = (f32x4){0.f, 0.f, 0.f, 0.f};
#pragma unroll 8
    for (int kk = 0; kk < 32; ++kk) acc = __builtin_amdgcn_mfma_f32_16x16x32_bf16(ap[kk * 4], bp[kk * 4], acc, 0, 0, 0);
    const float bias = bfv[fr];
#pragma unroll
    for (int j = 0; j < 4; ++j) { const int row = r0 + fq * 4 + j; const float rs = pg8::rstd16(ss, row);
        const float z = acc[j] * rs + bias;
        const float lf = -(fmaxf(-z, 0.f) + log1pf(expf(-fabsf(z)))) * 1.4426950408889634f;
        const int b = row >> 13, t = row & 8191; logf[((size_t)b * FOXH + fr) * SEQ + t] = lf; }
}

struct MoeOrder {
    pg8::StaticOrder S; int lo; int pref[NEXP + 1];
    __device__ __forceinline__ bool next(int i, pg8::Unit& u) const {
        if (!S.next(i, u)) return false;
        u.pm += lo; int e = 0;
#pragma unroll
        for (int k = 1; k < NEXP; ++k) e += (u.pm >= pref[k]) ? 1 : 0;
        u.zb = e; return true;
    }
    __device__ __forceinline__ void a_ready(const pg8::Unit&) const {}
    __device__ __forceinline__ void done(const pg8::Unit&) const {}
};

__global__ void __launch_bounds__(NTHREADS, 2) mk_fwd(Args args) {
    extern __shared__ __attribute__((aligned(16))) unsigned char lds_raw[];
    LAS unsigned char* lds = (LAS unsigned char*)lds_raw;
    volatile LAS unsigned* MISC = (volatile LAS unsigned*)(lds + MISC_OFF);
    const int tid = threadIdx.x, lane = tid & 63, wave = __builtin_amdgcn_readfirstlane(tid >> 6);
    const int G = gridDim.x; const int bx = blockIdx.x; const int vcu = (G % 8 == 0) ? (bx % 8) * (G / 8) + bx / 8 : bx;
    unsigned char* ws = args.ws;
    gu32* ctl = (gu32*)(ws + WS_CTL);
    for (int u = tid; u < (LDS_BYTES - LDSCTL_OFF) / 4; u += NTHREADS) ((LAS unsigned*)(lds + LDSCTL_OFF))[u] = 0u;
    __syncthreads();
    XcdBarrier bar = xcd_barrier_post((unsigned*)(ctl + CW_BAR), MISC + 8);
    const int gw = vcu * NWAVES + wave, NGW = G * NWAVES;
    float* SS = (float*)(ws + WS_SSP);
    float* X = args.out;
    bf16* XB = (bf16*)(ws + WS_XB);
#define GRID_BAR() xcd_barrier(bar)
#define GEMM_PHASE(EPI, SCHED, lds_, g_, S_, E_) pg8::gemm_phase<EPI, SCHED, true, true>(lds_, g_, S_, E_)

    p0_prologue(args, lds, tid, lane, wave, vcu, G);
    GRID_BAR();
    { pg8::Gemm g{XB, (const bf16*)(ws + WS_WIN0), D, D, D, 0, 0}; pg8::StaticOrder S; S.init(M, EVEN_IN, 1, G, bx);
      pg8::EpiInProj0 E{SS, (bf16*)(ws + WS_UEXT), (bf16*)(ws + WS_QKV0), C2};
      GEMM_PHASE(pg8::EpiInProj0, pg8::StaticOrder, lds + RING_OFF, g, S, E); }
    GRID_BAR();
#define SB_PULL_ONE(more_) do { if (tid == 0) MISC[17] = __hip_atomic_fetch_add(ctl + CW_QUEUE2, 1u, RLX_AGENT); __syncthreads(); const unsigned uq_ = __builtin_amdgcn_readfirstlane(MISC[17]); __syncthreads(); \
        more_ = uq_ < (unsigned)(BATCH * SBH * 32); if (more_) { const int bh_ = (int)(uq_ >> 5), qb_ = (int)(uq_ & 31u); \
            attn_body::sb_unit<1536>(bh_ >> 3, bh_ & 7, qb_, (const attn_body::bf16*)(ws + WS_QKV0), (const attn_body::bf16*)(ws + WS_QKV0) + 512, (const attn_body::bf16*)(ws + WS_QKV0) + 1024, (attn_body::bf16*)(ws + WS_MIXB) + 512, (char*)lds_raw + RING_OFF); } } while (0)
    bool sb_more = true;
    { pg8::Gemm g{(const bf16*)(ws + WS_UEXT), (const bf16*)(ws + WS_S5WA), S5KX, 512, 512, (size_t)S5NC * S5KX * 2, (size_t)256 * 512 * 2}; pg8::StaticOrder S; S.init(S5NC, 256, S5G, G, bx);
      pg8::EpiS5State E{(float*)(ws + WS_SLOC)};
      GEMM_PHASE(pg8::EpiS5State, pg8::StaticOrder, lds + RING_OFF, g, S, E);
      if (bx >= S.nwg) SB_PULL_ONE(sb_more); }
    GRID_BAR();
    s5_scan(args, vcu * NTHREADS + tid);
    if (vcu * NTHREADS >= BATCH * S5G * S5P) SB_PULL_ONE(sb_more);
    GRID_BAR();
    { pg8::Gemm g{(const bf16*)(ws + WS_UEXT), (const bf16*)(ws + WS_S5WC), S5KX, S5KX, S5KX, (size_t)S5NC * S5KX * 2, (size_t)512 * S5KX * 2}; pg8::StaticOrder S; S.init(S5NC, 512, S5G, G, bx);
      pg8::EpiS5Y E{(bf16*)(ws + WS_YG)};
      GEMM_PHASE(pg8::EpiS5Y, pg8::StaticOrder, lds + RING_OFF, g, S, E);
      if (bx >= S.nwg) SB_PULL_ONE(sb_more); }
    GRID_BAR();
    { pg8::Gemm g{(const bf16*)(ws + WS_YG), (const bf16*)(ws + WS_WGLU), 512, 512, 512, 0, 0}; pg8::StaticOrder S; S.init(M, 512, 1, G, bx);
      pg8::EpiGlu E{(const bf16*)(ws + WS_YG), args.in[12], (bf16*)(ws + WS_MIXB)};
      GEMM_PHASE(pg8::EpiGlu, pg8::StaticOrder, lds + RING_OFF, g, S, E); }
    __syncthreads();
    sb_more = true;
#pragma unroll 1
    while (sb_more) SB_PULL_ONE(sb_more);
    GRID_BAR();
#undef SB_PULL_ONE
    { pg8::Gemm g{(const bf16*)(ws + WS_MIXB), (const bf16*)(ws + WS_WOUT0), D, D, D, 0, 0}; pg8::StaticOrder S; S.init(M, D, 1, G, bx);
      pg8::EpiResid E{args.in[0], X, XB, SS + 16 * M};
      GEMM_PHASE(pg8::EpiResid, pg8::StaticOrder, lds + RING_OFF, g, S, E); }
    GRID_BAR();
    { pg8::Gemm g{XB, (const bf16*)(ws + WS_WGU0), D, D, D, 0, 0}; pg8::StaticOrder S; S.init(M, 2 * DFF, 1, G, bx);
      pg8::EpiSwiGlu<true> E{SS + 16 * M, (bf16*)(ws + WS_HID0), DFF};
      GEMM_PHASE(pg8::EpiSwiGlu<true>, pg8::StaticOrder, lds + RING_OFF, g, S, E); }
    GRID_BAR();
    { pg8::Gemm g{(const bf16*)(ws + WS_HID0), (const bf16*)(ws + WS_WD0), DFF, DFF, DFF, 0, 0}; pg8::StaticOrder S; S.init(M, D, 1, G, bx);
      pg8::EpiResid E{X, X, XB, SS + 32 * M};
      GEMM_PHASE(pg8::EpiResid, pg8::StaticOrder, lds + RING_OFF, g, S, E); }
    GRID_BAR();
    { pg8::Gemm g{XB, (const bf16*)(ws + WS_WIN1), D, D, D, 0, 0}; pg8::StaticOrder S; S.init(M, 3072, 1, G, bx);
      pg8::EpiInProj1 E{SS + 32 * M, (bf16*)(ws + WS_QKV1), C2, (unsigned*)(ctl + CW_KN)};
      GEMM_PHASE(pg8::EpiInProj1, pg8::StaticOrder, lds + RING_OFF, g, S, E); }
    for (int r = gw; r < M / 16; r += NGW) fgate_rows16(XB, (const bf16*)(ws + WS_WF1), SS + 32 * M, args.in[20], (float*)(ws + WS_LOGF), r * 16, lane);
    GRID_BAR();
    { const attn_body::AttnTensors AT{(const attn_body::bf16*)(ws + WS_QKV1), (const attn_body::bf16*)(ws + WS_QKV1 + 32 * MiB), (const attn_body::bf16*)(ws + WS_QKV1 + 64 * MiB), (attn_body::bf16*)(ws + WS_QKV1), (const float*)(ws + WS_LOGF), (const unsigned*)(ctl + CW_KN)};
      constexpr int N_ATT = 1024, N_CVB = MOE_XITEMS / 32, N_GRP = (N_ATT + 2) / 3 > (N_CVB + 1) / 2 ? (N_ATT + 2) / 3 : (N_CVB + 1) / 2;
      for (;;) {
          if (tid == 0) MISC[16] = __hip_atomic_fetch_add(ctl + CW_QUEUE, 1u, RLX_AGENT);
          __syncthreads();
          const unsigned uq = __builtin_amdgcn_readfirstlane(MISC[16]);
          __syncthreads();
          if (uq >= 5u * N_GRP) break;
          const int grp = (int)(uq / 5u), rr = (int)(uq % 5u);
          if (rr & 1) { const int cb = 2 * grp + (rr >> 1);
              if (cb < N_CVB) { int lane_ = threadIdx.x & 63; asm volatile("" : "+v"(lane_));
                  LAS float* scr = (LAS float*)(lds + wave * XSCR_BYTES);
#pragma unroll 1
                  for (int j = 0; j < 4; j += 2) { const XTile t0 = moe_xtile(args, cb * 32 + wave * 4 + j, lane_), t1 = moe_xtile(args, cb * 32 + wave * 4 + j + 1, lane_);
                      f32x4 v0[16], v1[16]; xtile_load(t0, v0); xtile_load(t1, v1);
                      xtile_finish_fp8(t0, v0, 64.f, scr, lane_); xtile_finish_fp8(t1, v1, 64.f, scr, lane_); } }
          } else { const int au = 3 * grp + (rr >> 1);
              if (au < N_ATT) { const int bh = au & 31, qb = 31 - (au >> 5);
                  attn_body::attn_unit<8>(bh >> 4, bh & 15, qb, AT.Q, AT.K, AT.V, AT.O, (char*)lds_raw + RING_OFF, AT.logf + (size_t)bh * SEQ, AT.kn + (size_t)bh * 256); } }
      } }
    GRID_BAR();
    { pg8::Gemm g{(const bf16*)(ws + WS_QKV1), (const bf16*)(ws + WS_WOUT1), D, D, D, 0, 0}; pg8::StaticOrder S; S.init(M, D, 1, G, bx);
      pg8::EpiResid E{X, X, XB, SS + 48 * M};
      GEMM_PHASE(pg8::EpiResid, pg8::StaticOrder, lds + RING_OFF, g, S, E); }
    GRID_BAR();
    unsigned char* meta = ws + WS_META;
    {
        const float* wr = args.in[23]; const float* gn = args.in[22];
        for (int tok = gw; tok < M; tok += NGW) {
            const GAS f32x4* xr = (const GAS f32x4*)(X + (size_t)tok * D) + lane; float lg[NEXP]; float s = 0.f;
#pragma unroll
            for (int e = 0; e < NEXP; ++e) lg[e] = 0.f;
#pragma unroll
            for (int j = 0; j < 4; ++j) { const f32x4 v = xr[64 * j]; s += (v.x * v.x + v.y * v.y) + (v.z * v.z + v.w * v.w); const int k0 = 4 * lane + 256 * j; const f32x4 gv = *(const f32x4*)(gn + k0);
#pragma unroll
                for (int q = 0; q < 4; ++q) { const float xv = v[q] * gv[q]; const f32x4 w0 = *(const f32x4*)(wr + (size_t)(k0 + q) * NEXP), w1 = *(const f32x4*)(wr + (size_t)(k0 + q) * NEXP + 4);
                    lg[0] = fmaf(xv, w0.x, lg[0]); lg[1] = fmaf(xv, w0.y, lg[1]); lg[2] = fmaf(xv, w0.z, lg[2]); lg[3] = fmaf(xv, w0.w, lg[3]);
                    lg[4] = fmaf(xv, w1.x, lg[4]); lg[5] = fmaf(xv, w1.y, lg[5]); lg[6] = fmaf(xv, w1.z, lg[6]); lg[7] = fmaf(xv, w1.w, lg[7]); } }
            s = wave_sum(s);
#pragma unroll
            for (int e = 0; e < NEXP; ++e) lg[e] = wave_sum(lg[e]);
            if (lane == 0) {
                const float rs = 1.0f / sqrtf(s * (1.0f / 1024.0f) + pg8::RMS_EPS);
                int i1 = 0; float v1 = lg[0];
#pragma unroll
                for (int e = 1; e < NEXP; ++e) if (lg[e] > v1) { v1 = lg[e]; i1 = e; }
                int i2 = -1; float v2 = -INFINITY;
#pragma unroll
                for (int e = 0; e < NEXP; ++e) if (e != i1 && lg[e] > v2) { v2 = lg[e]; i2 = e; }
                const float g1 = 1.f / (1.f + expf((v2 - v1) * rs)), g2 = 1.f - g1;
                const unsigned p1 = __hip_atomic_fetch_add(ctl + CW_CNT + 64 * i1, 1u, RLX_AGENT), p2 = __hip_atomic_fetch_add(ctl + CW_CNT + 64 * i2, 1u, RLX_AGENT);
                ((float*)(meta + MT_RSTD))[tok] = rs; ((unsigned*)(meta + MT_TOKE))[tok] = (unsigned)i1 | ((unsigned)i2 << 8);
                ((unsigned*)(meta + MT_TOKP))[2 * tok] = p1; ((unsigned*)(meta + MT_TOKP))[2 * tok + 1] = p2;
                ((float*)(meta + MT_TOKG))[2 * tok] = g1; ((float*)(meta + MT_TOKG))[2 * tok + 1] = g2;
            }
        }
    }
    GRID_BAR();
    int pref[NEXP + 1], cnt[NEXP];
    { pref[0] = 0;
#pragma unroll
      for (int e = 0; e < NEXP; ++e) { cnt[e] = (int)__builtin_amdgcn_readfirstlane(__hip_atomic_load(ctl + CW_CNT + 64 * e, RLX_AGENT)); pref[e + 1] = pref[e] + (cnt[e] + 255) / 256; } }
    const int NP = pref[NEXP];
    unsigned char* XG = ws + WS_XG; float* RSS = (float*)(meta + MT_RSS);
    {
        for (int tok = gw; tok < M; tok += NGW) {
            const unsigned ee = ((const unsigned*)(meta + MT_TOKE))[tok]; const float rs = ((const float*)(meta + MT_RSTD))[tok];
            const GAS f32x4* xr = (const GAS f32x4*)(X + (size_t)tok * D) + lane; unsigned w[4];
#pragma unroll
            for (int j = 0; j < 4; ++j) { const f32x4 v = xr[64 * j]; w[j] = pg8::pk_fp8x4(v.x, v.y, v.z, v.w); }
#pragma unroll
            for (int k = 0; k < 2; ++k) { const int e = (ee >> (8 * k)) & 0xff; int pe = 0;
#pragma unroll
                for (int q = 0; q < NEXP; ++q) pe = (q == e) ? pref[q] : pe;
                const int slot = pe * 256 + (int)((const unsigned*)(meta + MT_TOKP))[2 * tok + k];
#pragma unroll
                for (int j = 0; j < 4; ++j) *(unsigned*)(XG + (size_t)slot * D + 4 * lane + 256 * j) = w[j];
                if (lane == 0) { RSS[slot] = rs; ((unsigned*)(meta + MT_TOKSLOT))[2 * tok + k] = (unsigned)slot; } }
        }
#pragma unroll
        for (int e = 0; e < NEXP; ++e) for (int r = pref[e] * 256 + cnt[e] + gw; r < pref[e + 1] * 256; r += NGW) {
            *(v4u*)(XG + (size_t)r * D + lane * 16) = (v4u){0u, 0u, 0u, 0u}; if (lane == 0) RSS[r] = 0.f; }
    }
    GRID_BAR();
    bf16* YS = (bf16*)(ws + WS_Y);
    { pg8::Gemm g{(const bf16*)XG, (const bf16*)(ws + WS_WMOE_GU), D / 2, D / 2, D / 2, 0, (size_t)7168 * 1024}; MoeOrder S; S.S.nM = NP; S.S.nN = 28; S.S.nZ = 1; S.S.nwg = NP * 28; S.S.G = G; S.S.c = bx; S.lo = 0;
#pragma unroll
      for (int e = 0; e <= NEXP; ++e) S.pref[e] = pref[e];
      pg8::EpiSwiGluFp8 E{RSS, ws + WS_HMOE, DFE};
      pg8::gemm_phase<pg8::EpiSwiGluFp8, MoeOrder, true, true, true>(lds + RING_OFF, g, S, E); }
    GRID_BAR();
    { pg8::Gemm g{(const bf16*)(ws + WS_HMOE), (const bf16*)(ws + WS_WMOE_D), DFE / 2, DFE / 2, DFE / 2, 0, (size_t)1024 * 3584}; MoeOrder S; S.S.nM = NP; S.S.nN = 4; S.S.nZ = 1; S.S.nwg = NP * 4; S.S.G = G; S.S.c = bx; S.lo = 0;
#pragma unroll
      for (int e = 0; e <= NEXP; ++e) S.pref[e] = pref[e];
      pg8::EpiStoreBf16 E{YS, D};
      pg8::gemm_phase<pg8::EpiStoreBf16, MoeOrder, true, true, true>(lds + RING_OFF, g, S, E); }
    GRID_BAR();
    {
        const float* gf = args.in[27];
        for (int tok = gw; tok < M; tok += NGW) {
            const unsigned s0 = ((const unsigned*)(meta + MT_TOKSLOT))[2 * tok], s1 = ((const unsigned*)(meta + MT_TOKSLOT))[2 * tok + 1];
            const float g0 = ((const float*)(meta + MT_TOKG))[2 * tok], g1 = ((const float*)(meta + MT_TOKG))[2 * tok + 1];
            GAS f32x4* xr = (GAS f32x4*)(X + (size_t)tok * D) + lane; f32x4 v[4]; float s = 0.f;
#pragma unroll
            for (int j = 0; j < 4; ++j) { v[j] = xr[64 * j]; const int k0 = 4 * lane + 256 * j;
                const v2u a = *(const v2u*)(YS + (size_t)s0 * D + k0), b2 = *(const v2u*)(YS + (size_t)s1 * D + k0);
                v[j].x += g0 * bflo(a.x) + g1 * bflo(b2.x); v[j].y += g0 * bfhi(a.x) + g1 * bfhi(b2.x); v[j].z += g0 * bflo(a.y) + g1 * bflo(b2.y); v[j].w += g0 * bfhi(a.y) + g1 * bfhi(b2.y);
                s += (v[j].x * v[j].x + v[j].y * v[j].y) + (v[j].z * v[j].z + v[j].w * v[j].w); }
            s = wave_sum(s); const float rs = 1.0f / sqrtf(s * (1.0f / 1024.0f) + pg8::RMS_EPS);
#pragma unroll
            for (int j = 0; j < 4; ++j) { const f32x4 gv = *(const f32x4*)(gf + 4 * lane + 256 * j); xr[64 * j] = v[j] * rs * gv; }
        }
    }
}

extern "C" void kernel_launch(void* const* d_in, const int* in_sizes, int n_in, void* d_out, int out_size, void* d_ws, size_t ws_size, hipStream_t stream) {
    static int grid = 0;
    if (grid == 0) {
        if (n_in != 28 || in_sizes[0] != M * D || out_size != M * D || ws_size < WS_END) { fprintf(stderr, "kernel_launch: unexpected problem: n_in %d in0 %d out %d ws %zu (need %zu)\n", n_in, n_in > 0 ? in_sizes[0] : -1, out_size, ws_size, (size_t)WS_END); grid = -1; return; }
        int dev = 0, cus = 0, per_cu = 0;
        if (hipGetDevice(&dev) != hipSuccess || hipDeviceGetAttribute(&cus, hipDeviceAttributeMultiprocessorCount, dev) != hipSuccess) { grid = -1; return; }
        if (hipFuncSetAttribute((const void*)mk_fwd, hipFuncAttributeMaxDynamicSharedMemorySize, LDS_BYTES) != hipSuccess) { fprintf(stderr, "kernel_launch: hipFuncSetAttribute failed\n"); grid = -1; return; }
        if (hipOccupancyMaxActiveBlocksPerMultiprocessor(&per_cu, (const void*)mk_fwd, NTHREADS, LDS_BYTES) != hipSuccess || per_cu < 1) fprintf(stderr, "kernel_launch: occupancy query says %d\n", per_cu);
        (void)hipGetLastError();
        grid = cus;
        if (grid != 256) fprintf(stderr, "kernel_launch: built for the 256-CU MI355X; device reports %d CUs\n", cus);
    }
    if (grid < 0) return;
    if (hipMemsetAsync((char*)d_ws + WS_CTL, 0, CTL_ZERO_BYTES, stream) != hipSuccess) return;
    Args a{};
    for (int i = 0; i < 28; ++i) a.in[i] = (const float*)d_in[i];
    a.out = (float*)d_out; a.ws = (unsigned char*)d_ws;
    hipLaunchKernelGGL(mk_fwd, dim3(grid), dim3(NTHREADS), LDS_BYTES, stream, a);
}
```

```cpp
#include <hip/hip_runtime.h>
#include <cstdio>
#include <cstdint>

namespace pg8 {
#define PG8_LAS __attribute__((address_space(3)))
typedef unsigned short bf16_t;
typedef short bf16x8 __attribute__((ext_vector_type(8)));
typedef float f32x4 __attribute__((ext_vector_type(4)));
typedef unsigned u32x4 __attribute__((ext_vector_type(4)));
typedef unsigned u32x2 __attribute__((ext_vector_type(2)));
constexpr int BM = 256, BK = 64, HALF = 128, HTB = HALF * BK * 2  , STAGE_BYTES = 8 * HTB, NXCD = 8, WGM = 8;

__host__ __device__ __forceinline__ int lds_byte(int r, int c) { const int st = (r >> 4) * 2 + (c >> 5), rr = r & 15, cc = c & 31, ob = rr * 64 + cc * 2; return st * 1024 + (ob ^ (((ob >> 9) & 1) << 5)); }
__host__ __device__ __forceinline__ void stage_rc(int b, int& R, int& C) { const int st = b / 1024, sb = b % 1024, swz = sb ^ (((sb >> 9) & 1) << 5); R = (st >> 1) * 16 + swz / 64; C = (st & 1) * 32 + (swz % 64) / 2; }
__host__ __device__ __forceinline__ int perm32(int rho) { const int n = rho >> 4, i = rho & 15; return 8 * (i >> 2) + 4 * n + (i & 3); }

struct Unit { int pm, pn, zb; };
struct Gemm { const bf16_t* A; const bf16_t* Bt; int lda, ldb, K; size_t zA, zB; };

struct StaticOrder {
    int nM, nN, nZ, nwg, G, c;
    __host__ __device__ void init(int M, int N, int Z, int G_, int c_) { nM = M / BM; nN = N / BM; nZ = Z; nwg = nM * nN * nZ; G = G_; c = c_; }
    __host__ __device__ bool next(int i, Unit& u) const {
        const long L = (long)i * G + c; if (L >= nwg) return false;
        int wgid = (int)L; { const int q = nwg / NXCD, r = nwg % NXCD, xcd = wgid % NXCD, off = wgid / NXCD; wgid = (xcd < r ? xcd * (q + 1) : r * (q + 1) + (xcd - r) * q) + off; }
        const int per = nM * nN; u.zb = wgid / per; wgid -= u.zb * per;
        const int nig = WGM * nN, gid = wgid / nig, fm = gid * WGM, gsz = (nM - fm) < WGM ? (nM - fm) : WGM;
        u.pm = fm + ((wgid % nig) % gsz); u.pn = (wgid % nig) / gsz; return true;
    }
    __device__ __forceinline__ void a_ready(const Unit&) const {}
    __device__ __forceinline__ void done(const Unit&) const {}
};

__device__ __forceinline__ unsigned cvt_pk_bf16(float lo, float hi) { unsigned r; asm volatile("v_cvt_pk_bf16_f32 %0, %1, %2" : "=v"(r) : "v"(lo), "v"(hi)); return r; }
typedef int v4i_t __attribute__((ext_vector_type(4))); typedef int v8i_t __attribute__((ext_vector_type(8)));
__device__ __forceinline__ v8i_t cat8(bf16x8 a, bf16x8 b) { return __builtin_shufflevector(__builtin_bit_cast(v4i_t, a), __builtin_bit_cast(v4i_t, b), 0, 1, 2, 3, 4, 5, 6, 7); }
__device__ __forceinline__ unsigned pk_fp8x4(float a, float b, float c, float d) { int r = 0; r = __builtin_amdgcn_cvt_pk_fp8_f32(a, b, r, false); r = __builtin_amdgcn_cvt_pk_fp8_f32(c, d, r, true); return (unsigned)r; }
__device__ __forceinline__ float bf_lo(unsigned w) { return __uint_as_float(w << 16); }
__device__ __forceinline__ float bf_hi(unsigned w) { return __uint_as_float(w & 0xffff0000u); }
__device__ __forceinline__ float fast_sigmoid(float z) { return __builtin_amdgcn_rcpf(1.0f + __builtin_amdgcn_exp2f(-1.4426950408889634f * z)); }
constexpr float RMS_EPS = 1e-6f;
__device__ __forceinline__ float rstd16(const float* ssp, int row) { const f32x4* p = (const f32x4*)(ssp + (size_t)row * 16); const f32x4 a = p[0], b = p[1], c = p[2], d = p[3];
    const float s = (((a[0] + a[1]) + (a[2] + a[3])) + ((b[0] + b[1]) + (b[2] + b[3]))) + (((c[0] + c[1]) + (c[2] + c[3])) + ((d[0] + d[1]) + (d[2] + d[3])));
    return __builtin_amdgcn_rsqf(s * (1.0f / 1024.0f) + RMS_EPS); }

__device__ __forceinline__ void rstd8(const float* ssp, int row0, int fq, float (&rs)[8]) {
    f32x4 p[8];
#pragma unroll
    for (int i = 0; i < 8; ++i) p[i] = *(const f32x4*)(ssp + (size_t)(row0 + (i >> 2) * HALF + (i & 3) * 16) * 16 + 4 * fq);
#pragma unroll
    for (int i = 0; i < 8; ++i) { float q = (p[i][0] + p[i][1]) + (p[i][2] + p[i][3]); q += __shfl_xor(q, 16); q += __shfl_xor(q, 32); rs[i] = __builtin_amdgcn_rsqf(q * (1.0f / 1024.0f) + RMS_EPS); }
}
__device__ __forceinline__ u32x4 pack8(const f32x4 v0, const f32x4 v1) { u32x4 w; w.x = cvt_pk_bf16(v0[0], v0[1]); w.y = cvt_pk_bf16(v0[2], v0[3]); w.z = cvt_pk_bf16(v1[0], v1[1]); w.w = cvt_pk_bf16(v1[2], v1[3]); return w; }

struct EpiInProj0 {
    static constexpr bool PERM = true, AFTER_DRAIN = false;
    const float* ss; bf16_t* uext; bf16_t* qkv; float qscale;
    __device__ __forceinline__ void operator()(const f32x4 (&acc)[2][2][4][2], const Unit& u, int wr, int wc, int fr, int fq) const {
        const int row0 = u.pm * BM + wr * 64 + fr; float rsa[8]; rstd8(ss, row0, fq, rsa);
#pragma unroll
        for (int ai = 0; ai < 2; ++ai)
#pragma unroll
            for (int m = 0; m < 4; ++m) { const int row = row0 + ai * HALF + m * 16; const float rs = rsa[ai * 4 + m];
#pragma unroll
                for (int bj = 0; bj < 2; ++bj) { const int col0 = u.pn * BM + bj * HALF + wc * 32 + 8 * fq;
                    float sc = rs; bf16_t* dst;
                    if (u.pn < 2) dst = uext + ((size_t)(col0 >> 4) * 512 + (row >> 5)) * 640 + (row & 31) * 16 + (col0 & 15);
                    else { const int c = col0 - 512; if (c < 512) sc *= qscale; dst = qkv + (size_t)row * 1536 + c; }
                    *(u32x4*)dst = pack8(acc[ai][bj][m][0] * sc, acc[ai][bj][m][1] * sc); } }
    }
};
struct EpiS5State {
    static constexpr bool PERM = false, AFTER_DRAIN = false;
    float* sloc;
    __device__ __forceinline__ void operator()(const f32x4 (&acc)[2][2][4][2], const Unit& u, int wr, int wc, int fr, int fq) const {
        const int row0 = u.pm * BM + wr * 64 + fr, col0 = wc * 32 + 4 * fq;
#pragma unroll
        for (int ai = 0; ai < 2; ++ai)
#pragma unroll
            for (int m = 0; m < 4; ++m) { float* rowp = sloc + ((size_t)u.zb * 512 + row0 + ai * HALF + m * 16) * 128 + col0;
#pragma unroll
                for (int n = 0; n < 2; ++n) *(f32x4*)(rowp + n * 16) = acc[ai][0][m][n]; }
    }
};
__device__ __forceinline__ float gelu_tanh(float x) { const float a = x * (1.0f + 0.044715f * x * x); return x * __builtin_amdgcn_rcpf(1.0f + __builtin_amdgcn_exp2f(-2.302208198f * a)); }
struct EpiS5Y {
    static constexpr bool PERM = true, AFTER_DRAIN = false;
    bf16_t* yg;
    __device__ __forceinline__ void operator()(const f32x4 (&acc)[2][2][4][2], const Unit& u, int wr, int wc, int fr, int fq) const {
        const int row0 = u.pm * BM + wr * 64 + fr;
#pragma unroll
        for (int ai = 0; ai < 2; ++ai)
#pragma unroll
            for (int m = 0; m < 4; ++m) { const int chunk = row0 + ai * HALF + m * 16;
#pragma unroll
                for (int bj = 0; bj < 2; ++bj) { const int col0 = u.pn * BM + bj * HALF + wc * 32 + 8 * fq; const int i = col0 >> 4, h0 = col0 & 15;
                    f32x4 v0 = acc[ai][bj][m][0], v1 = acc[ai][bj][m][1];
#pragma unroll
                    for (int e = 0; e < 4; ++e) { v0[e] = gelu_tanh(v0[e]); v1[e] = gelu_tanh(v1[e]); }
                    *(u32x4*)(yg + ((size_t)chunk * 32 + i) * 512 + u.zb * 16 + h0) = pack8(v0, v1); } }
    }
};
struct EpiGlu {
    static constexpr bool PERM = true, AFTER_DRAIN = false;
    const bf16_t* yg; const float* bias; bf16_t* mix;
    __device__ __forceinline__ void operator()(const f32x4 (&acc)[2][2][4][2], const Unit& u, int wr, int wc, int fr, int fq) const {
        const int row0 = u.pm * BM + wr * 64 + fr; u32x4 ywa[2][8];
#pragma unroll
        for (int bj = 0; bj < 2; ++bj)
#pragma unroll
            for (int i = 0; i < 8; ++i) ywa[bj][i] = *(const u32x4*)(yg + (size_t)(row0 + (i >> 2) * HALF + (i & 3) * 16) * 512 + u.pn * BM + bj * HALF + wc * 32 + 8 * fq);
#pragma unroll
        for (int bj = 0; bj < 2; ++bj) { const int col0 = u.pn * BM + bj * HALF + wc * 32 + 8 * fq;
            const f32x4 b0 = *(const f32x4*)(bias + col0), b1 = *(const f32x4*)(bias + col0 + 4);
#pragma unroll
            for (int ai = 0; ai < 2; ++ai)
#pragma unroll
                for (int m = 0; m < 4; ++m) { const int row = row0 + ai * HALF + m * 16;
                    const u32x4 yw = ywa[bj][ai * 4 + m];
                    f32x4 z0 = acc[ai][bj][m][0] + b0, z1 = acc[ai][bj][m][1] + b1, o0, o1;
                    o0[0] = bf_lo(yw.x) * fast_sigmoid(z0[0]); o0[1] = bf_hi(yw.x) * fast_sigmoid(z0[1]); o0[2] = bf_lo(yw.y) * fast_sigmoid(z0[2]); o0[3] = bf_hi(yw.y) * fast_sigmoid(z0[3]);
                    o1[0] = bf_lo(yw.z) * fast_sigmoid(z1[0]); o1[1] = bf_hi(yw.z) * fast_sigmoid(z1[1]); o1[2] = bf_lo(yw.w) * fast_sigmoid(z1[2]); o1[3] = bf_hi(yw.w) * fast_sigmoid(z1[3]);
                    *(u32x4*)(mix + (size_t)row * 1024 + col0) = pack8(o0, o1); } }
    }
};
struct EpiResid {
    static constexpr bool PERM = false, AFTER_DRAIN = false;
    const float* R; float* X; bf16_t* xb; float* ssq;
    __device__ __forceinline__ void operator()(const f32x4 (&acc)[2][2][4][2], const Unit& u, int wr, int wc, int fr, int fq) const {
        const int row0 = u.pm * BM + wr * 64 + fr, col0 = u.pn * BM + wc * 32 + 4 * fq;
#pragma unroll
        for (int ai = 0; ai < 2; ++ai) {
            f32x4 rv[4][2][2];
#pragma unroll
            for (int m = 0; m < 4; ++m)
#pragma unroll
                for (int bj = 0; bj < 2; ++bj)
#pragma unroll
                    for (int n = 0; n < 2; ++n) rv[m][bj][n] = *(const f32x4*)(R + (size_t)(row0 + ai * HALF + m * 16) * 1024 + col0 + bj * HALF + n * 16);
            asm volatile("" ::: "memory");
#pragma unroll
            for (int m = 0; m < 4; ++m) { const int row = row0 + ai * HALF + m * 16; const size_t off = (size_t)row * 1024 + col0; float s = 0.f;
#pragma unroll
                for (int bj = 0; bj < 2; ++bj)
#pragma unroll
                    for (int n = 0; n < 2; ++n) { const f32x4 x = rv[m][bj][n] + acc[ai][bj][m][n];
                        *(f32x4*)(X + off + bj * HALF + n * 16) = x; s += (x[0] * x[0] + x[1] * x[1]) + (x[2] * x[2] + x[3] * x[3]);
                        u32x2 w; w.x = cvt_pk_bf16(x[0], x[1]); w.y = cvt_pk_bf16(x[2], x[3]); *(u32x2*)(xb + off + bj * HALF + n * 16) = w; }
                s += __shfl_xor(s, 16); s += __shfl_xor(s, 32);
                if (fq == 0) ssq[(size_t)row * 16 + u.pn * 4 + wc] = s; }
            asm volatile("" ::: "memory"); }
    }
};
template <bool RS_IS_SSQ> struct EpiSwiGlu {
    static constexpr bool PERM = true, AFTER_DRAIN = false;
    const float* rsv; bf16_t* H; int ldh;
    __device__ __forceinline__ void operator()(const f32x4 (&acc)[2][2][4][2], const Unit& u, int wr, int wc, int fr, int fq) const {
        const int row0 = u.pm * BM + wr * 64 + fr, col0 = u.pn * HALF + wc * 32 + 8 * fq; float rsa[8];
        if (RS_IS_SSQ) rstd8(rsv, row0, fq, rsa);
        else {
#pragma unroll
            for (int i = 0; i < 8; ++i) rsa[i] = rsv[row0 + (i >> 2) * HALF + (i & 3) * 16]; }
#pragma unroll
        for (int ai = 0; ai < 2; ++ai)
#pragma unroll
            for (int m = 0; m < 4; ++m) { const int row = row0 + ai * HALF + m * 16; const float rs = rsa[ai * 4 + m];
                f32x4 o[2];
#pragma unroll
                for (int n = 0; n < 2; ++n)
#pragma unroll
                    for (int e = 0; e < 4; ++e) { const float g = acc[ai][0][m][n][e] * rs, up = acc[ai][1][m][n][e] * rs; o[n][e] = g * fast_sigmoid(g) * up; }
                *(u32x4*)(H + (size_t)row * ldh + col0) = pack8(o[0], o[1]); }
    }
};
struct EpiSwiGluFp8 {
    static constexpr bool PERM = true, AFTER_DRAIN = false;
    const float* rsv; unsigned char* H; int ldh;
    __device__ __forceinline__ void operator()(const f32x4 (&acc)[2][2][4][2], const Unit& u, int wr, int wc, int fr, int fq) const {
        const int row0 = u.pm * BM + wr * 64 + fr, col0 = u.pn * HALF + wc * 32 + 8 * fq; float rsa[8];
#pragma unroll
        for (int i = 0; i < 8; ++i) rsa[i] = rsv[row0 + (i >> 2) * HALF + (i & 3) * 16];
#pragma unroll
        for (int ai = 0; ai < 2; ++ai)
#pragma unroll
            for (int m = 0; m < 4; ++m) { const int row = row0 + ai * HALF + m * 16; const float rs = rsa[ai * 4 + m];
                f32x4 o[2];
#pragma unroll
                for (int n = 0; n < 2; ++n)
#pragma unroll
                    for (int e = 0; e < 4; ++e) { const float g = acc[ai][0][m][n][e] * rs, up = acc[ai][1][m][n][e] * rs; o[n][e] = g * fast_sigmoid(g) * up; }
                u32x2 w; w.x = pk_fp8x4(o[0][0], o[0][1], o[0][2], o[0][3]); w.y = pk_fp8x4(o[1][0], o[1][1], o[1][2], o[1][3]);
                *(u32x2*)(H + (size_t)row * ldh + col0) = w; }
    }
};
struct EpiInProj1 {
    static constexpr bool PERM = true, AFTER_DRAIN = false;
    const float* ss; bf16_t* qkv; float qscale;
    unsigned* kn;
    __device__ __forceinline__ void operator()(const f32x4 (&acc)[2][2][4][2], const Unit& u, int wr, int wc, int fr, int fq) const {
        const int row0 = u.pm * BM + wr * 64 + fr; const float qs = (u.pn < 4) ? qscale : 1.0f; float rsa[8]; rstd8(ss, row0, fq, rsa);
#pragma unroll
        for (int ai = 0; ai < 2; ++ai)
#pragma unroll
            for (int m = 0; m < 4; ++m) { const int row = row0 + ai * HALF + m * 16; const float sc = rsa[ai * 4 + m] * qs;
#pragma unroll
                for (int bj = 0; bj < 2; ++bj) { const int col0 = (u.pn & 3) * BM + bj * HALF + wc * 32 + 8 * fq;
                    const f32x4 v0 = acc[ai][bj][m][0] * sc, v1 = acc[ai][bj][m][1] * sc;
                    *(u32x4*)(qkv + (size_t)(u.pn >> 2) * (16384 * 1024) + (size_t)row * 1024 + col0) = pack8(v0, v1);
                    if ((u.pn >> 2) == 1) {
                        float q = ((v0[0] * v0[0] + v0[1] * v0[1]) + (v0[2] * v0[2] + v0[3] * v0[3])) + ((v1[0] * v1[0] + v1[1] * v1[1]) + (v1[2] * v1[2] + v1[3] * v1[3]));
                        q += __shfl_xor(q, 16); q += __shfl_xor(q, 32);
                        q = fmaxf(q, __shfl_xor(q, 1)); q = fmaxf(q, __shfl_xor(q, 2)); q = fmaxf(q, __shfl_xor(q, 4)); q = fmaxf(q, __shfl_xor(q, 8));
                        if (fr == 0 && fq == 0) { const int head = (u.pn & 3) * 4 + bj * 2 + (wc >> 1), bb = row >> 13, tile = (row & 8191) >> 6;
                            atomicMax(kn + ((size_t)(bb * 16 + head) * 128 + tile) * 2 + (wc & 1), __float_as_uint(q * 1.01f)); } } } }
    }
};
struct EpiStoreBf16 {
    static constexpr bool PERM = true, AFTER_DRAIN = false;
    bf16_t* O; int ldc;
    __device__ __forceinline__ void operator()(const f32x4 (&acc)[2][2][4][2], const Unit& u, int wr, int wc, int fr, int fq) const {
        const int row0 = u.pm * BM + wr * 64 + fr;
#pragma unroll
        for (int ai = 0; ai < 2; ++ai)
#pragma unroll
            for (int m = 0; m < 4; ++m) { const int row = row0 + ai * HALF + m * 16;
#pragma unroll
                for (int bj = 0; bj < 2; ++bj) { const int col0 = u.pn * BM + bj * HALF + wc * 32 + 8 * fq;
                    *(u32x4*)(O + (size_t)row * ldc + col0) = pack8(acc[ai][bj][m][0], acc[ai][bj][m][1]); } }
    }
};

template <bool F8> struct Frag { bf16x8 k[2]; };
template <> struct Frag<true> { v8i_t v; };
template <class Epi, class Sched, bool ALIGN_EPI = false, bool SP2 = false, bool FP8 = false>
__device__ __forceinline__ void gemm_phase(PG8_LAS unsigned char* lds, const Gemm g, const Sched& S, const Epi& E) {
    int tid_ = threadIdx.x; asm volatile("" : "+v"(tid_));
    const int tid = tid_, wid = __builtin_amdgcn_readfirstlane(tid >> 6), lane = tid & 63, wr = wid >> 2, wc = wid & 3, fr = lane & 15, fq = lane >> 4;
    const int K = g.K, nt = K / BK;
    unsigned voffA[2], voffB[2];
#pragma unroll
    for (int i = 0; i < 2; ++i) { int R, C; stage_rc(tid * 16 + i * 8192, R, C); const int Rb = Epi::PERM ? ((R & ~31) + perm32(R & 31)) : R;
        voffA[i] = (unsigned)(R * g.lda + C) * 2u; voffB[i] = (unsigned)(Rb * g.ldb + C) * 2u; }
    const size_t kstep = (size_t)(BK * 2);
    const size_t hstepA = (size_t)HALF * g.lda * 2, hstepB = (size_t)HALF * g.ldb * 2;
    const size_t tstepA = 2 * hstepA, tstepB = 2 * hstepB;
    const unsigned ldsw = (unsigned)wid * 1024u;
    const int aoff = lds_byte(wr * 64 + fr, fq * 8), boff = lds_byte(wc * 32 + fr, fq * 8);
#define PG8_SA(b, h) (((b) * 2 + (h)) * HTB)
#define PG8_SB(b, h) ((4 + (b) * 2 + (h)) * HTB)
#define PG8_STAGE(bufoff, gbase, voff) do { _Pragma("unroll") for (int _i = 0; _i < 2; ++_i) \
        __builtin_amdgcn_global_load_lds((const unsigned*)((const char*)(gbase) + (voff)[_i]), (PG8_LAS unsigned*)(lds + (bufoff) + ldsw + _i * 8192), 16, 0, 0); } while (0)
    const PG8_LAS unsigned char* ldsA_ = lds + aoff; const PG8_LAS unsigned char* ldsB_ = lds + 4 * HTB + boff; asm volatile("" : "+v"(ldsA_), "+v"(ldsB_));
#define PG8_RDA(off) (*(const PG8_LAS bf16x8*)(ldsA_ + (off)))
#define PG8_RDB(off) (*(const PG8_LAS bf16x8*)(ldsB_ + (off)))
#define PG8_LDA(dst, b, h) do { _Pragma("unroll") for (int m = 0; m < 4; ++m) { if constexpr (FP8) dst[m].v = cat8(PG8_RDA(PG8_SA(b, h) + m * 2048), PG8_RDA(PG8_SA(b, h) + m * 2048 + 1024)); \
        else { dst[m].k[0] = PG8_RDA(PG8_SA(b, h) + m * 2048); dst[m].k[1] = PG8_RDA(PG8_SA(b, h) + m * 2048 + 1024); } } } while (0)
#define PG8_LDB(dst, b, h) do { _Pragma("unroll") for (int n = 0; n < 2; ++n) { if constexpr (FP8) dst[n].v = cat8(PG8_RDB(PG8_SB(b, h) - 4 * HTB + n * 2048), PG8_RDB(PG8_SB(b, h) - 4 * HTB + n * 2048 + 1024)); \
        else { dst[n].k[0] = PG8_RDB(PG8_SB(b, h) - 4 * HTB + n * 2048); dst[n].k[1] = PG8_RDB(PG8_SB(b, h) - 4 * HTB + n * 2048 + 1024); } } } while (0)
#define PG8_MMA(ai, bj, At, Bt) do { __builtin_amdgcn_s_setprio(1); _Pragma("unroll") for (int m = 0; m < 4; ++m) _Pragma("unroll") for (int n = 0; n < 2; ++n) { \
        if constexpr (FP8) { asm volatile("v_mfma_scale_f32_16x16x128_f8f6f4 %0, %1, %2, %0, %3, %4 op_sel_hi:[0,0,0]" : "+v"(acc[ai][bj][m][n]) : "v"(Bt[n].v), "v"(At[m].v), "v"(sclB_), "v"(sclA_)); } \
        else { _Pragma("unroll") for (int k = 0; k < 2; ++k) acc[ai][bj][m][n] = __builtin_amdgcn_mfma_f32_16x16x32_bf16(Bt[n].k[k], At[m].k[k], acc[ai][bj][m][n], 0, 0, 0); } } __builtin_amdgcn_s_setprio(0); } while (0)
#define PG8_WAIT_V(n) asm volatile("s_waitcnt vmcnt(" #n ")" ::: "memory")
#define PG8_WAIT_L(n) asm volatile("s_waitcnt lgkmcnt(" #n ")" ::: "memory")
#define PG8_BAR __builtin_amdgcn_s_barrier()
#define PG8_SCHED __builtin_amdgcn_sched_barrier(0)
    Unit cur, nxt; int ui = 0;
    if (!S.next(0, cur)) return;
    f32x4 acc[2][2][4][2];
#pragma unroll
    for (int a = 0; a < 2; ++a)
#pragma unroll
        for (int b = 0; b < 2; ++b)
#pragma unroll
            for (int m = 0; m < 4; ++m)
#pragma unroll
                for (int n = 0; n < 2; ++n) acc[a][b][m][n] = (f32x4){0.f, 0.f, 0.f, 0.f};
    Frag<FP8> At[4], B0[2], B1[2];
    int sclB_ = 0x79797979, sclA_ = 0x7f7f7f7f; asm volatile("" : "+v"(sclB_), "+v"(sclA_));
    const char* cA = (const char*)g.A + (size_t)cur.zb * g.zA + (size_t)cur.pm * tstepA; const char* cB = (const char*)g.Bt + (size_t)cur.zb * g.zB + (size_t)cur.pn * tstepB;
    S.a_ready(cur);
    if constexpr (SP2) {
        PG8_STAGE(PG8_SB(0, 0), cB, voffB); PG8_STAGE(PG8_SB(0, 1), cB + hstepB, voffB); PG8_STAGE(PG8_SA(0, 0), cA, voffA); PG8_STAGE(PG8_SA(0, 1), cA + hstepA, voffA);
        if (wr == 1) PG8_BAR;
        PG8_WAIT_V(2); PG8_BAR;
        PG8_STAGE(PG8_SB(1, 0), cB + kstep, voffB); PG8_STAGE(PG8_SA(1, 0), cA + kstep, voffA); PG8_STAGE(PG8_SB(1, 1), cB + hstepB + kstep, voffB);
        PG8_WAIT_V(6); PG8_BAR;
    } else {
        PG8_STAGE(PG8_SB(0, 0), cB, voffB); PG8_STAGE(PG8_SA(0, 0), cA, voffA); PG8_STAGE(PG8_SB(0, 1), cB + hstepB, voffB); PG8_STAGE(PG8_SA(0, 1), cA + hstepA, voffA);
        if (wr == 1) PG8_BAR;
        PG8_WAIT_V(4); PG8_BAR;
        PG8_STAGE(PG8_SB(1, 0), cB + kstep, voffB); PG8_STAGE(PG8_SA(1, 0), cA + kstep, voffA); PG8_STAGE(PG8_SB(1, 1), cB + hstepB + kstep, voffB);
        PG8_WAIT_V(6); PG8_BAR;
    }
    for (;;) {
        const bool has_next = S.next(ui + 1, nxt);
        const char* nA = has_next ? (const char*)g.A + (size_t)nxt.zb * g.zA + (size_t)nxt.pm * tstepA : cA; const char* nB = has_next ? (const char*)g.Bt + (size_t)nxt.zb * g.zB + (size_t)nxt.pn * tstepB : cB;
#pragma unroll 1
        for (int t = 0; t < nt; t += 2) {
            const bool last = (t == nt - 2);
            const char* a1 = cA + (size_t)(t + 1) * kstep;
            const char* a2 = last ? nA : cA + (size_t)(t + 2) * kstep; const char* b2 = last ? nB : cB + (size_t)(t + 2) * kstep;
            const char* a3 = a2 + kstep; const char* b3 = b2 + kstep;
            if (last && has_next) S.a_ready(nxt);
            if constexpr (SP2) {
            PG8_LDB(B0, 0, 0); PG8_LDB(B1, 0, 1); PG8_SCHED; PG8_LDA(At, 0, 0); PG8_STAGE(PG8_SA(1, 1), a1 + hstepA, voffA);
            PG8_WAIT_V(8); PG8_WAIT_L(0); PG8_BAR; PG8_MMA(0, 0, At, B0); PG8_MMA(0, 1, At, B1); PG8_BAR; PG8_SCHED;
            PG8_LDA(At, 0, 1); PG8_STAGE(PG8_SB(0, 0), b2, voffB); PG8_STAGE(PG8_SB(0, 1), b2 + hstepB, voffB); PG8_STAGE(PG8_SA(0, 0), a2, voffA);
            PG8_WAIT_V(8); PG8_WAIT_L(0); PG8_BAR; PG8_MMA(1, 0, At, B0); PG8_MMA(1, 1, At, B1); PG8_BAR; PG8_SCHED;
            PG8_LDB(B0, 1, 0); PG8_LDB(B1, 1, 1); PG8_SCHED; PG8_LDA(At, 1, 0); PG8_STAGE(PG8_SA(0, 1), a2 + hstepA, voffA);
            PG8_WAIT_V(8); PG8_WAIT_L(0); PG8_BAR; PG8_MMA(0, 0, At, B0); PG8_MMA(0, 1, At, B1); PG8_BAR; PG8_SCHED;
            PG8_LDA(At, 1, 1); PG8_STAGE(PG8_SB(1, 0), b3, voffB); PG8_STAGE(PG8_SB(1, 1), b3 + hstepB, voffB); PG8_STAGE(PG8_SA(1, 0), a3, voffA);
            PG8_WAIT_V(8); PG8_WAIT_L(0); PG8_BAR; PG8_MMA(1, 0, At, B0); PG8_MMA(1, 1, At, B1); PG8_BAR; PG8_SCHED;
            } else {
            PG8_LDB(B0, 0, 0); PG8_SCHED; PG8_LDA(At, 0, 0); PG8_STAGE(PG8_SA(1, 1), a1 + hstepA, voffA);
            PG8_WAIT_L(8); PG8_BAR; PG8_WAIT_L(0); PG8_MMA(0, 0, At, B0); PG8_BAR; PG8_SCHED;
            PG8_LDB(B1, 0, 1); PG8_STAGE(PG8_SB(0, 0), b2, voffB);
            PG8_BAR; PG8_WAIT_L(0); PG8_MMA(0, 1, At, B1); PG8_BAR;
            PG8_LDA(At, 0, 1); PG8_STAGE(PG8_SA(0, 0), a2, voffA);
            PG8_BAR; PG8_WAIT_L(0); PG8_MMA(1, 0, At, B0); PG8_BAR; PG8_SCHED;
            PG8_STAGE(PG8_SB(0, 1), b2 + hstepB, voffB);
            PG8_WAIT_V(6); PG8_BAR; PG8_MMA(1, 1, At, B1); PG8_BAR;
            PG8_LDB(B0, 1, 0); PG8_SCHED; PG8_LDA(At, 1, 0); PG8_STAGE(PG8_SA(0, 1), a2 + hstepA, voffA);
            PG8_WAIT_L(8); PG8_BAR; PG8_WAIT_L(0); PG8_MMA(0, 0, At, B0); PG8_BAR; PG8_SCHED;
            PG8_LDB(B1, 1, 1); PG8_STAGE(PG8_SB(1, 0), b3, voffB);
            PG8_BAR; PG8_WAIT_L(0); PG8_MMA(0, 1, At, B1); PG8_BAR;
            PG8_LDA(At, 1, 1); PG8_STAGE(PG8_SA(1, 0), a3, voffA);
            PG8_BAR; PG8_WAIT_L(0); PG8_MMA(1, 0, At, B0); PG8_BAR; PG8_SCHED;
            PG8_STAGE(PG8_SB(1, 1), b3 + hstepB, voffB);
            PG8_WAIT_V(6); PG8_BAR; PG8_MMA(1, 1, At, B1); PG8_BAR;
            }
        }
        if constexpr (ALIGN_EPI) { if (wr == 0) PG8_BAR; }
        if constexpr (FP8) asm volatile("s_nop 15\n\ts_nop 15" ::: "memory");
        if constexpr (!Epi::AFTER_DRAIN) { int fr_ = fr, fq_ = fq; asm volatile("" : "+v"(fr_), "+v"(fq_));
            E(acc, cur, wr, wc, fr_, fq_); S.done(cur); }
        if (!has_next) break;
#pragma unroll
        for (int a = 0; a < 2; ++a)
#pragma unroll
            for (int b = 0; b < 2; ++b)
#pragma unroll
                for (int m = 0; m < 4; ++m)
#pragma unroll
                    for (int n = 0; n < 2; ++n) acc[a][b][m][n] = (f32x4){0.f, 0.f, 0.f, 0.f};
        cur = nxt; cA = nA; cB = nB; ++ui;
        if constexpr (ALIGN_EPI) { if (wr == 1) PG8_BAR; }
    }
    PG8_WAIT_V(0);
    if constexpr (!ALIGN_EPI) { if (wr == 0) PG8_BAR; }
    PG8_BAR;
    if constexpr (Epi::AFTER_DRAIN) { E.fused(acc, cur, wr, wc, fr, fq, lds, wid, lane); S.done(cur); }
#undef PG8_SA
#undef PG8_SB
#undef PG8_STAGE
#undef PG8_LDA
#undef PG8_RDA
#undef PG8_RDB
#undef PG8_LDB
#undef PG8_MMA
#undef PG8_WAIT_V
#undef PG8_WAIT_L
#undef PG8_BAR
#undef PG8_SCHED
}
}

#include <hip/hip_bf16.h>
#include <cmath>
namespace attn_body {
using bf16=__hip_bfloat16;
using bf16x8=__attribute__((ext_vector_type(8)))short;
using s16x4=__attribute__((ext_vector_type(4)))short;
using f32x16=__attribute__((ext_vector_type(16)))float;
using u32x4=__attribute__((ext_vector_type(4)))unsigned;
constexpr int BATCH=2,NHEAD=16,SEQ=8192,D=64,DM=NHEAD*D;
constexpr int NW=8,QBLK=32,QB=QBLK*NW,KVBLK=64,NQB=SEQ/QB;
constexpr int ATTN_PITCH=DM, ATTN_UNIT_ROWS=QB;
__device__ __forceinline__ int crow(int r,int hi){return (r&3)+8*(r>>2)+4*hi;}
#define SBAR() __builtin_amdgcn_sched_barrier(0)
__device__ __forceinline__ void cmask(f32x16&p0,f32x16&p1,int jb,int qrel,int hi){
  const float NEG=-INFINITY; int kb=64*jb+4*hi;
  #pragma unroll
  for(int r=0;r<16;++r){int kv=kb+(r&3)+8*(r>>2); if(kv>qrel)p0[r]=NEG; if(kv+32>qrel)p1[r]=NEG;}
}

constexpr int NSLOT=3, SLOTB=8192;
constexpr int LDS_K=0, LDS_V=NSLOT*SLOTB, LDS_WS=2*NSLOT*SLOTB, LDS_OST=LDS_WS+NW*64*4, LDS_NB=LDS_OST+NW*4096  , LDS_PK=LDS_NB+32768+64  , LDS_BYTES=LDS_PK+1024;
constexpr float C2=0.125f*1.4426950408889634f;
__device__ __forceinline__ void glds16(const void*gsrc,unsigned lds_dst){unsigned keep;
  asm volatile("s_mov_b32 %0, m0\n\ts_mov_b32 m0, %2\n\ts_nop 0\n\tglobal_load_lds_dwordx4 %1, off\n\ts_mov_b32 m0, %0":"=&s"(keep):"v"(gsrc),"s"(lds_dst):"memory");}
__device__ __forceinline__ float max3f(float a,float b,float c){float r;asm("v_max3_f32 %0, %1, %2, %3":"=v"(r):"v"(a),"v"(b),"v"(c));return r;}
__device__ __forceinline__ float max2f(float a,float b){float r;asm("v_max_f32_e32 %0, %1, %2":"=v"(r):"v"(a),"v"(b));return r;}
__device__ __forceinline__ float fadd_s(float a,float b){float r;asm("v_add_f32_e32 %0, %1, %2":"=v"(r):"v"(a),"v"(b));return r;}
__device__ __forceinline__ float fsub_s(float a,float b){float r;asm("v_sub_f32_e32 %0, %1, %2":"=v"(r):"v"(a),"v"(b));return r;}
typedef float f32x2_t __attribute__((ext_vector_type(2))); typedef __bf16 bf16x2_t __attribute__((ext_vector_type(2)));
__device__ __forceinline__ unsigned cvtpk_s(float lo,float hi){f32x2_t v={lo,hi};bf16x2_t b=__builtin_convertvector(v,bf16x2_t);return __builtin_bit_cast(unsigned,b);}
#define WAIT_BAR(N) asm volatile("s_waitcnt vmcnt(" #N ") lgkmcnt(0)\n\ts_barrier":::"memory")

__device__ __forceinline__ void qkt(f32x16&p0,f32x16&p1,const char*Kslot,const bf16x8*qr,const f32x16&negm,int r32,int hi){
  const char*kb=Kslot+hi*1024+r32*16;
  #pragma unroll
  for(int d0=0;d0<4;++d0){
    const bf16x8 b0=*reinterpret_cast<const bf16x8*>(kb+d0*2048);
    const bf16x8 b1=*reinterpret_cast<const bf16x8*>(kb+d0*2048+512);
    if(d0==0){p0=__builtin_amdgcn_mfma_f32_32x32x16_bf16(b0,qr[0],negm,0,0,0);p1=__builtin_amdgcn_mfma_f32_32x32x16_bf16(b1,qr[0],negm,0,0,0);}
    else{p0=__builtin_amdgcn_mfma_f32_32x32x16_bf16(b0,qr[d0],p0,0,0,0);p1=__builtin_amdgcn_mfma_f32_32x32x16_bf16(b1,qr[d0],p1,0,0,0);}}
}
typedef __attribute__((address_space(3))) const char* lds_cptr;
typedef short v4i16_t __attribute__((ext_vector_type(4)));
__device__ __forceinline__ void kload8(bf16x8*kf,lds_cptr kp){
  kf[0]=*(const __attribute__((address_space(3))) bf16x8*)(kp);      kf[1]=*(const __attribute__((address_space(3))) bf16x8*)(kp+512);
  kf[2]=*(const __attribute__((address_space(3))) bf16x8*)(kp+2048); kf[3]=*(const __attribute__((address_space(3))) bf16x8*)(kp+2560);
  kf[4]=*(const __attribute__((address_space(3))) bf16x8*)(kp+4096); kf[5]=*(const __attribute__((address_space(3))) bf16x8*)(kp+4608);
  kf[6]=*(const __attribute__((address_space(3))) bf16x8*)(kp+6144); kf[7]=*(const __attribute__((address_space(3))) bf16x8*)(kp+6656);
}
__device__ __forceinline__ void kload2(bf16x8*kf,lds_cptr kp,int j){ kf[2*j]=*(const __attribute__((address_space(3))) bf16x8*)(kp+j*2048); kf[2*j+1]=*(const __attribute__((address_space(3))) bf16x8*)(kp+j*2048+512); }
__device__ __forceinline__ s16x4 vtr(lds_cptr p){ return __builtin_bit_cast(s16x4,__builtin_amdgcn_ds_read_tr16_b64_v4i16((__attribute__((address_space(3))) v4i16_t*)p)); }
__device__ __forceinline__ float rowmax(const f32x16&p0,const f32x16&p1){
  float a=max3f(p0[0],p0[1],p1[0]),b=max3f(p0[2],p0[3],p1[1]);a=max3f(a,p1[2],p1[3]);
  #pragma unroll
  for(int r=4;r<16;r+=4){a=max3f(a,p0[r],p0[r+1]);b=max3f(b,p0[r+2],p0[r+3]);a=max3f(a,p1[r],p1[r+1]);b=max3f(b,p1[r+2],p1[r+3]);}
  const float m=max2f(a,b);
  auto rr=__builtin_amdgcn_permlane32_swap(__float_as_uint(m),__float_as_uint(m),false,false);
  return max2f(__uint_as_float(rr[0]),__uint_as_float(rr[1]));
}
__device__ __forceinline__ void pv(f32x16*o,int vb,bf16x8 pa0,bf16x8 pa1,bf16x8 pa2,bf16x8 pa3){
  #pragma unroll
  for(int d0=0;d0<2;++d0){s16x4 lo[4],hi[4];
    #pragma unroll
    for(int ks=0;ks<4;++ks){
      asm volatile("ds_read_b64_tr_b16 %0,%1 offset:%c2":"=&v"(lo[ks]):"v"(vb),"i"(d0*4096+ks*1024):"memory");
      asm volatile("ds_read_b64_tr_b16 %0,%1 offset:%c2":"=&v"(hi[ks]):"v"(vb),"i"(d0*4096+ks*1024+512):"memory");}
    asm volatile("s_waitcnt lgkmcnt(0)":::"memory");SBAR();
    #define PK(k) (bf16x8){lo[k][0],lo[k][1],lo[k][2],lo[k][3],hi[k][0],hi[k][1],hi[k][2],hi[k][3]}
    o[d0]=__builtin_amdgcn_mfma_f32_32x32x16_bf16(pa0,PK(0),o[d0],0,0,0);
    o[d0]=__builtin_amdgcn_mfma_f32_32x32x16_bf16(pa1,PK(1),o[d0],0,0,0);
    o[d0]=__builtin_amdgcn_mfma_f32_32x32x16_bf16(pa2,PK(2),o[d0],0,0,0);
    o[d0]=__builtin_amdgcn_mfma_f32_32x32x16_bf16(pa3,PK(3),o[d0],0,0,0);
    #undef PK
  }
}

typedef float f32x4_t __attribute__((ext_vector_type(4)));
__device__ __forceinline__ void fox_negcum(const float*logf,__attribute__((address_space(3))) float*ncum,__attribute__((address_space(3))) float*wtot,int tid){
  float loc[16];float s=0.f; const f32x4_t*lp=(const f32x4_t*)(logf+tid*16);
  #pragma unroll
  for(int j=0;j<4;++j){const f32x4_t v=lp[j]; s+=v[0];loc[4*j]=s; s+=v[1];loc[4*j+1]=s; s+=v[2];loc[4*j+2]=s; s+=v[3];loc[4*j+3]=s;}
  float inc=s;
  #pragma unroll
  for(int o=1;o<64;o<<=1){const float v=__shfl_up(inc,o); if((tid&63)>=o)inc+=v;}
  if((tid&63)==63)wtot[tid>>6]=inc;
  __syncthreads();
  float base=inc-s; for(int w=0;w<(tid>>6);++w)base+=wtot[w];
  #pragma unroll
  for(int j=0;j<4;++j){ f32x4_t o4; o4[0]=-(base+loc[4*j]);o4[1]=-(base+loc[4*j+1]);o4[2]=-(base+loc[4*j+2]);o4[3]=-(base+loc[4*j+3]); *(__attribute__((address_space(3))) f32x4_t*)(ncum+tid*16+4*j)=o4; }
  __syncthreads();
}
#ifndef ATTN_STORE16
#define ATTN_STORE16(p,v) (*(u32x4*)(p)=(v))
#endif
template<int THRL> __device__ __forceinline__ void attn_unit(int b,int h,int qb,const bf16*Q,const bf16*__restrict__ K,const bf16*__restrict__ V,bf16*O,char*shm,const float*logf_bh,const unsigned*kn_bh){
  int tid_=threadIdx.x; asm volatile("":"+v"(tid_)); const int tid=tid_,lane=tid&63,r32=lane&31,hi=lane>>5; const int wid=__builtin_amdgcn_readfirstlane(tid>>6);
  const long rowbase=(long)b*SEQ; const int q0=qb*QB;
  const bf16*Qw=Q+(rowbase+q0+wid*QBLK)*DM+h*D;
  const bf16*Kh=K+rowbase*DM+h*D,*Vh=V+rowbase*DM+h*D;
  const unsigned lds0=(unsigned)(uintptr_t)shm;
  float*wsf=(float*)(shm+LDS_WS)+wid*64;
  const bf16*ksrc=Kh+(long)lane*DM+wid*8;
  const bf16*vsrc=Vh+(long)(16*(wid&3)+(lane>>2))*DM+(wid>>2)*32+(lane&3)*8;
  const unsigned kdst=lds0+LDS_K+wid*1024, vdst=lds0+LDS_V+wid*1024;
  #define TIDX(t) (NTR-1-(t))
  #define DMA_K(t,slot) glds16(ksrc+(long)TIDX(t)*KVBLK*DM,(unsigned)__builtin_amdgcn_readfirstlane(kdst+(slot)))
  #define DMA_V(t,slot) glds16(vsrc+(long)TIDX(t)*KVBLK*DM,(unsigned)__builtin_amdgcn_readfirstlane(vdst+(slot)))
  const int vb0=(int)(lds0+LDS_V)+((lane>>4)&1)*32+(lane&3)*8+(4*hi+((lane&15)>>2))*64;
  const char*Kbase=shm+LDS_K; bf16x8 kf[8];
  const lds_cptr shm3=(lds_cptr)shm; const lds_cptr kp0=shm3+LDS_K+hi*1024+r32*16; const lds_cptr vp0=shm3+LDS_V+((lane>>4)&1)*32+(lane&3)*8+(4*hi+((lane&15)>>2))*64;
  const int NTR=(q0+QB)/KVBLK;
  const lds_cptr shm3b=(lds_cptr)shm;
  const __attribute__((address_space(3))) float* nb3=(const __attribute__((address_space(3))) float*)(shm3b+LDS_NB);
  fox_negcum(logf_bh,(__attribute__((address_space(3))) float*)(shm3b+LDS_NB),(__attribute__((address_space(3))) float*)(shm3b+LDS_NB+32768),tid);
  int NT;
  { __attribute__((address_space(3))) float* PK=(__attribute__((address_space(3))) float*)(shm3b+LDS_PK);
    __attribute__((address_space(3))) int* JX=(__attribute__((address_space(3))) int*)(shm3b+LDS_PK+512);
    float pk=0.f;
    if(tid<128){ const float a=__uint_as_float(kn_bh[2*tid]),c=__uint_as_float(kn_bh[2*tid+1]); pk=__builtin_sqrtf(a+c)*1.001f; }
    #pragma unroll
    for(int o_=1;o_<64;o_<<=1){const float v=__shfl_up(pk,o_); if((tid&63)>=o_)pk=__builtin_fmaxf(pk,v);}
    if(tid==63)PK[128]=pk;
    __syncthreads();
    if(tid>=64&&tid<128)pk=__builtin_fmaxf(pk,PK[128]);
    if(tid<128)PK[tid]=pk;
    const bf16*Krow=Kh+(long)(q0+wid*QBLK+r32)*DM+hi*8; const bf16*Qrow=Qw+(long)r32*DM+hi*8; float qq=0.f,qk=0.f;
    #pragma unroll
    for(int d0=0;d0<4;++d0){ const u32x4 qa=*reinterpret_cast<const u32x4*>(Qrow+d0*16), ka=*reinterpret_cast<const u32x4*>(Krow+d0*16);
      #pragma unroll
      for(int e=0;e<4;++e){ const float q0f=__uint_as_float(qa[e]<<16),q1f=__uint_as_float(qa[e]&0xffff0000u),k0f=__uint_as_float(ka[e]<<16),k1f=__uint_as_float(ka[e]&0xffff0000u);
        qq+=q0f*q0f+q1f*q1f; qk+=q0f*k0f+q1f*k1f; } }
    { auto r1=__builtin_amdgcn_permlane32_swap(__float_as_uint(qq),__float_as_uint(qq),false,false); qq=__uint_as_float(r1[0])+__uint_as_float(r1[1]);
      auto r2=__builtin_amdgcn_permlane32_swap(__float_as_uint(qk),__float_as_uint(qk),false,false); qk=__uint_as_float(r2[0])+__uint_as_float(r2[1]); }
    __syncthreads();
    const float qn=__builtin_sqrtf(qq)*1.001f, thr=qk+nb3[q0+wid*QBLK+r32]-152.f;
    int lo_=0,hi_=NTR;
    #pragma unroll 1
    for(int it=0;it<8;++it){ if(lo_<hi_){ const int mid=(lo_+hi_)>>1; const float f=qn*PK[mid]+nb3[64*mid+63]; if(f>=thr)hi_=mid; else lo_=mid+1; } }
    #pragma unroll
    for(int o_=1;o_<64;o_<<=1){const int v=__shfl_xor(lo_,o_); lo_=v<lo_?v:lo_;}
    if(lane==0)JX[wid]=lo_;
    __syncthreads();
    int j0=JX[0];
    #pragma unroll
    for(int w=1;w<8;++w){const int v=JX[w]; j0=v<j0?v:j0;}
    j0=__builtin_amdgcn_readfirstlane(j0);
    int nte=(NTR-j0+1)&~1; NT=nte<4?4:nte;
    __syncthreads();
  }
  #define BIASADD(P0,P1,t) do{ const __attribute__((address_space(3))) f32x4_t* bp_=(const __attribute__((address_space(3))) f32x4_t*)(nb3+TIDX(t)*64+4*hi); \
    const f32x4_t nm4_={-mhat,-mhat,-mhat,-mhat}; \
    _Pragma("unroll") for(int g_=0;g_<4;++g_){ const f32x4_t b0_=bp_[2*g_]+nm4_,b1_=bp_[2*g_+8]+nm4_; \
      P0[4*g_]+=b0_[0];P0[4*g_+1]+=b0_[1];P0[4*g_+2]+=b0_[2];P0[4*g_+3]+=b0_[3]; P1[4*g_]+=b1_[0];P1[4*g_+1]+=b1_[1];P1[4*g_+2]+=b1_[2];P1[4*g_+3]+=b1_[3]; } }while(0)
  DMA_K(0,0);DMA_V(0,0);DMA_K(1,SLOTB);
  bf16x8 qr[4];
  #pragma unroll
  for(int d0=0;d0<4;++d0)qr[d0]=*reinterpret_cast<const bf16x8*>(&Qw[(long)r32*DM+d0*16+hi*8]);
  float mhat=0.f,l_reg=0.f;f32x16 o[2];o[0]=f32x16{};o[1]=f32x16{};const f32x16 negm=f32x16{};
  const int qrel=wid*QBLK+r32;
  #define CMASK(P0,P1,t) do{ if((t)<4){ cmask(P0,P1,3-(t),qrel,hi); } }while(0)
  bool resc=false;
  #define START(P0,P1) do{ const float rm=rowmax(P0,P1); resc=false; \
    { const float dl=(rm>-3.0e38f)?rm:0.f; mhat=fadd_s(mhat,dl);     \
      _Pragma("unroll") for(int r=0;r<16;++r){P0[r]=fsub_s(P0[r],dl);P1[r]=fsub_s(P1[r],dl);} \
      } \
    _Pragma("unroll") for(int r=0;r<16;++r)P0[r]=__builtin_amdgcn_exp2f(P0[r]); }while(0)
  #define RESC() do{ if(resc){ asm volatile("s_waitcnt lgkmcnt(0)":::"memory"); \
      _Pragma("unroll") for(int d_=0;d_<2;++d_) _Pragma("unroll") for(int r=0;r<16;++r)o[d_][r]*=wsf[crow(r,hi)]; } }while(0)
  f32x16 pA0,pA1,pB0,pB1;
  int sl_prev=0,sl_cur=0,sl_next=SLOTB;
  #define ROT() do{sl_prev=sl_cur;sl_cur=sl_next;sl_next=(sl_next==(NSLOT-1)*SLOTB)?0:sl_next+SLOTB;}while(0)
  DMA_K(2,2*SLOTB);
  WAIT_BAR(3);
  qkt(pA0,pA1,Kbase,qr,negm,r32,hi);asm volatile("s_nop 15\n\ts_nop 7":"+v"(pA0),"+v"(pA1));BIASADD(pA0,pA1,0);CMASK(pA0,pA1,0);
  START(pA0,pA1);
  _Pragma("unroll") for(int r=0;r<16;++r)pA1[r]=__builtin_amdgcn_exp2f(pA1[r]);
  WAIT_BAR(0);
  DMA_K(3,0);DMA_V(1,SLOTB);
  ROT();
  kload8(kf,kp0+sl_cur);
  WAIT_BAR(2);
  s16x4 vlo[8],vhi[8]; u32x4 pw0,pw1,pw2,pw3;
  #define PKW(P,B) cvtpk_s(P[B],P[B+1])
  #define PAF(k) __builtin_bit_cast(bf16x8,pw##k)
  #define VFR(i) (bf16x8){vlo[i][0],vlo[i][1],vlo[i][2],vlo[i][3],vhi[i][0],vhi[i][1],vhi[i][2],vhi[i][3]}
  #define PIN(x) asm volatile("":"+v"(x))
  #define MX3(a,b,c) __builtin_fmaxf(__builtin_fmaxf((a),(b)),(c))
  #define GAPA(MF,A0,A1,A2,A3,W0,W1,PW) do{ MF; sacc+=A0; sacc+=A1; sacc+=A2; sacc+=A3; PIN(sacc); W0; W1; PIN(PW); SBAR(); }while(0)
  #define EX(v) __builtin_amdgcn_exp2f(v)
  #define GAPB(MF,X,B) do{ MF; X[B]=EX(X[B]); X[B+1]=EX(X[B+1]); X[B+2]=EX(X[B+2]); X[B+3]=EX(X[B+3]); PIN(X); SBAR(); }while(0)
  #define VRD(i) do{ vlo[i]=vtr(vp_+(((i)>>2)*4096+((i)&3)*1024)); vhi[i]=vtr(vp_+(((i)>>2)*4096+((i)&3)*1024+512)); }while(0)
  #define KRD(G,j) do{ if(G){ kload2(kf,kp0+sl_next,j); SBAR(); } }while(0)
  #define STEP(C0,C1,P0,P1,t,GK,GV,GL) do{ SBAR(); \
    const lds_cptr vp_=vp0+sl_prev; \
    VRD(0); SBAR(); float sacc=(P0[0]+P0[1]); \
    GAPA(C0=__builtin_amdgcn_mfma_f32_32x32x16_bf16(kf[0],qr[0],negm,0,0,0), P0[2],P0[3],P0[4],P0[5],     pw0[0]=PKW(P0,0), pw0[1]=PKW(P0,2), pw0); \
    VRD(4); SBAR(); GAPA(C1=__builtin_amdgcn_mfma_f32_32x32x16_bf16(kf[1],qr[0],negm,0,0,0), P0[6],P0[7],P0[8],P0[9],     pw0[2]=PKW(P0,4), pw0[3]=PKW(P0,6), pw0); \
    VRD(1); SBAR(); GAPA(C0=__builtin_amdgcn_mfma_f32_32x32x16_bf16(kf[2],qr[1],C0,0,0,0),   P0[10],P0[11],P0[12],P0[13], pw1[0]=PKW(P0,8), pw1[1]=PKW(P0,10), pw1); \
    VRD(5); SBAR(); GAPA(C1=__builtin_amdgcn_mfma_f32_32x32x16_bf16(kf[3],qr[1],C1,0,0,0),   P0[14],P0[15],P1[0],P1[1],   pw1[2]=PKW(P0,12),pw1[3]=PKW(P0,14), pw1); \
    VRD(2); SBAR(); GAPA(C0=__builtin_amdgcn_mfma_f32_32x32x16_bf16(kf[4],qr[2],C0,0,0,0),   P1[2],P1[3],P1[4],P1[5],     pw2[0]=PKW(P1,0), pw2[1]=PKW(P1,2), pw2); \
    VRD(6); SBAR(); GAPA(C1=__builtin_amdgcn_mfma_f32_32x32x16_bf16(kf[5],qr[2],C1,0,0,0),   P1[6],P1[7],P1[8],P1[9],     pw2[2]=PKW(P1,4), pw2[3]=PKW(P1,6), pw2); \
    VRD(3); SBAR(); GAPA(C0=__builtin_amdgcn_mfma_f32_32x32x16_bf16(kf[6],qr[3],C0,0,0,0),   P1[10],P1[11],P1[12],P1[13], pw3[0]=PKW(P1,8), pw3[1]=PKW(P1,10), pw3); \
    VRD(7); SBAR(); GAPA(C1=__builtin_amdgcn_mfma_f32_32x32x16_bf16(kf[7],qr[3],C1,0,0,0),   P1[14],P1[15],0.f,0.f,       pw3[2]=PKW(P1,12),pw3[3]=PKW(P1,14), pw3); \
    l_reg+=sacc; \
    if(GK){DMA_K((t)+3,sl_cur);} if(GV){DMA_V((t)+1,sl_next);} \
    BIASADD(C0,C1,t); CMASK(C0,C1,t); \
    { float a=MX3(C0[0],C0[1],C1[0]),b=MX3(C0[2],C0[3],C1[1]); a=MX3(a,C1[2],C1[3]); \
      _Pragma("unroll") for(int r=4;r<16;r+=4){a=MX3(a,C0[r],C0[r+1]);b=MX3(b,C0[r+2],C0[r+3]);a=MX3(a,C1[r],C1[r+1]);b=MX3(b,C1[r+2],C1[r+3]);} \
      float rm=__builtin_fmaxf(a,b); { auto rr=__builtin_amdgcn_permlane32_swap(__float_as_uint(rm),__float_as_uint(rm),false,false); rm=__builtin_fmaxf(__uint_as_float(rr[0]),__uint_as_float(rr[1])); } \
      resc=false; \
      if(__builtin_expect(__any(rm>(float)THRL),0)){ const float dl=__builtin_fmaxf(rm,0.f); mhat+=dl; \
        _Pragma("unroll") for(int r=0;r<16;++r){C0[r]-=dl;C1[r]-=dl;} \
        const float f=__builtin_amdgcn_exp2f(-dl); l_reg*=f; if(hi==0)wsf[r32]=f; resc=true; } } \
    SBAR(); \
    GAPB(o[0]=__builtin_amdgcn_mfma_f32_32x32x16_bf16(PAF(0),VFR(0),o[0],0,0,0), C0,0); \
    GAPB(o[1]=__builtin_amdgcn_mfma_f32_32x32x16_bf16(PAF(0),VFR(4),o[1],0,0,0), C0,4); \
    KRD(GL,0); GAPB(o[0]=__builtin_amdgcn_mfma_f32_32x32x16_bf16(PAF(1),VFR(1),o[0],0,0,0), C0,8); \
    KRD(GL,1); GAPB(o[1]=__builtin_amdgcn_mfma_f32_32x32x16_bf16(PAF(1),VFR(5),o[1],0,0,0), C0,12); \
    KRD(GL,2); GAPB(o[0]=__builtin_amdgcn_mfma_f32_32x32x16_bf16(PAF(2),VFR(2),o[0],0,0,0), C1,0); \
    KRD(GL,3); GAPB(o[1]=__builtin_amdgcn_mfma_f32_32x32x16_bf16(PAF(2),VFR(6),o[1],0,0,0), C1,4); \
    GAPB(o[0]=__builtin_amdgcn_mfma_f32_32x32x16_bf16(PAF(3),VFR(3),o[0],0,0,0), C1,8); \
    GAPB(o[1]=__builtin_amdgcn_mfma_f32_32x32x16_bf16(PAF(3),VFR(7),o[1],0,0,0), C1,12); \
    }while(0)
  int t=1;
  for(int it_=0;it_<2&&t+5<NT;++it_,t+=2){
    STEP(pB0,pB1,pA0,pA1,t,true,true,true);     WAIT_BAR(2); RESC(); ROT();
    STEP(pA0,pA1,pB0,pB1,t+1,true,true,true);   WAIT_BAR(2); RESC(); ROT();
  }
  #undef CMASK
  #define CMASK(P0,P1,t) do{}while(0)
  for(;t+5<NT;t+=2){
    STEP(pB0,pB1,pA0,pA1,t,true,true,true);     WAIT_BAR(2); RESC(); ROT();
    STEP(pA0,pA1,pB0,pB1,t+1,true,true,true);   WAIT_BAR(2); RESC(); ROT();
  }
  #undef CMASK
  #define CMASK(P0,P1,t) do{ if((t)<4){ cmask(P0,P1,3-(t),qrel,hi); } }while(0)
  #define ENDW(tt) do{ if((tt)+3<NT){WAIT_BAR(2);} else if((tt)+2<NT){WAIT_BAR(1);} else {WAIT_BAR(0);} }while(0)
  for(;t+1<NT;t+=2){
    STEP(pB0,pB1,pA0,pA1,t,(t+3<NT),(t+1<NT),(t+1<NT));       ENDW(t);   RESC(); ROT();
    STEP(pA0,pA1,pB0,pB1,t+1,(t+4<NT),(t+2<NT),(t+2<NT));     ENDW(t+1); RESC(); ROT();
  }
  STEP(pB0,pB1,pA0,pA1,NT-1,false,false,false); RESC();
  { float sacc=pB0[0]+pB0[1]; _Pragma("unroll") for(int r=2;r<16;++r)sacc+=pB0[r]; _Pragma("unroll") for(int r=0;r<16;++r)sacc+=pB1[r]; l_reg+=sacc;
    pw0=(u32x4){PKW(pB0,0),PKW(pB0,2),PKW(pB0,4),PKW(pB0,6)};pw1=(u32x4){PKW(pB0,8),PKW(pB0,10),PKW(pB0,12),PKW(pB0,14)};pw2=(u32x4){PKW(pB1,0),PKW(pB1,2),PKW(pB1,4),PKW(pB1,6)};pw3=(u32x4){PKW(pB1,8),PKW(pB1,10),PKW(pB1,12),PKW(pB1,14)};
    SBAR(); pv(o,vb0+sl_cur,PAF(0),PAF(1),PAF(2),PAF(3)); }
  #undef PKW
  #undef PAF
  #undef VFR
  #undef PIN
  #undef MX3
  #undef GAPA
  #undef GAPB
  #undef EX
  #undef VRD
  #undef KRD
  #undef STEP
  #undef ENDW
  {auto rr=__builtin_amdgcn_permlane32_swap(__float_as_uint(l_reg),__float_as_uint(l_reg),false,false);l_reg=__uint_as_float(rr[0])+__uint_as_float(rr[1]);}
  if(hi==0)wsf[32+r32]=l_reg;asm volatile("s_waitcnt lgkmcnt(0)":::"memory");
  float rli[16];
  #pragma unroll
  for(int r=0;r<16;++r)rli[r]=__builtin_amdgcn_rcpf(wsf[32+crow(r,hi)]);
  bf16*Ow=O+(rowbase+q0+wid*QBLK)*DM+h*D;
  { bf16*stg=(bf16*)(shm+LDS_OST)+wid*2048;
    #pragma unroll
    for(int r=0;r<16;++r){const int orow=crow(r,hi);
      #pragma unroll
      for(int d0=0;d0<2;++d0)stg[orow*64+d0*32+r32]=__float2bfloat16(o[d0][r]*rli[r]);}
    asm volatile("s_waitcnt lgkmcnt(0)":::"memory");
    #pragma unroll
    for(int i=0;i<4;++i){const int row=i*8+(lane>>3),ch=lane&7; const u32x4 v=*(const u32x4*)(stg+row*64+ch*8); ATTN_STORE16(Ow+(long)row*DM+ch*8,v);} }
  asm volatile("s_waitcnt lgkmcnt(0)\n\ts_barrier":::"memory");
  #undef BIASADD
  #undef TIDX
  #undef DMA_K
  #undef DMA_V
  #undef CMASK
  #undef START
  #undef RESC
  #undef ROT
}

template<int PITCH> __device__ __forceinline__ void sb_unit(int b,int h,int qb,const bf16*Q,const bf16*__restrict__ K,const bf16*__restrict__ V,bf16*O  ,char*shm){
  int tid_=threadIdx.x; asm volatile("":"+v"(tid_)); const int tid=tid_,lane=tid&63,r32=lane&31,hi=lane>>5; const int wid=__builtin_amdgcn_readfirstlane(tid>>6);
  const long rowbase=(long)b*SEQ; const int q0=qb*QB;
  const bf16*Qw=Q+(rowbase+q0+wid*QBLK)*PITCH+h*D;
  const bf16*Kh=K+rowbase*PITCH+h*D,*Vh=V+rowbase*PITCH+h*D;
  const unsigned lds0=(unsigned)(uintptr_t)shm;
  const bf16*ksrc=Kh+(long)lane*PITCH+wid*8;
  const bf16*vsrc=Vh+(long)(16*(wid&3)+(lane>>2))*PITCH+(wid>>2)*32+(lane&3)*8;
  const unsigned kdst=lds0+LDS_K+wid*1024, vdst=lds0+LDS_V+wid*1024;
  #define SB_DMA(t,slot) do{ glds16(ksrc+(long)(t)*KVBLK*PITCH,(unsigned)__builtin_amdgcn_readfirstlane(kdst+(slot))); glds16(vsrc+(long)(t)*KVBLK*PITCH,(unsigned)__builtin_amdgcn_readfirstlane(vdst+(slot))); }while(0)
  const int vb0=(int)(lds0+LDS_V)+((lane>>4)&1)*32+(lane&3)*8+(4*hi+((lane&15)>>2))*64;
  volatile __attribute__((address_space(3))) unsigned* fl=(volatile __attribute__((address_space(3))) unsigned*)((lds_cptr)shm+LDS_WS);
  const int NT=(q0+QB)/KVBLK; const int qrel=wid*QBLK+r32;
  SB_DMA(NT-1,0);
  bf16x8 qr[4];
  #pragma unroll
  for(int d0=0;d0<4;++d0)qr[d0]=*reinterpret_cast<const bf16x8*>(&Qw[(long)r32*PITCH+d0*16+hi*8]);
  f32x16 o[2];o[0]=f32x16{};o[1]=f32x16{}; const f32x16 zero16=f32x16{};
  float carry=0.f; const float m0=(hi==0)?1.f:0.f;
  int slot=0;
  for(int t=NT-1;t>=0;--t){
    WAIT_BAR(0);
    if(t<NT-1){ const int pb=((t+1)&1)*8; const unsigned a=fl[pb]&fl[pb+1]&fl[pb+2]&fl[pb+3]&fl[pb+4]&fl[pb+5]&fl[pb+6]&fl[pb+7]; if(__builtin_amdgcn_readfirstlane(a)!=0u)break; }
    if(t>0)SB_DMA(t-1,slot^SLOTB);
    f32x16 p0,p1; qkt(p0,p1,shm+LDS_K+slot,qr,zero16,r32,hi);
    if(t>=NT-4){ const int kb=64*(t-(NT-4))+4*hi;
      #pragma unroll
      for(int r=0;r<16;++r){const int kv=kb+(r&3)+8*(r>>2); if(kv>=qrel)p0[r]=-INFINITY; if(kv+32>=qrel)p1[r]=-INFINITY;} }
    f32x16 s0,s1;
    #pragma unroll
    for(int r=0;r<16;++r){ const float z=p0[r]; const float sp=__builtin_fmaxf(z,0.f)+__builtin_amdgcn_logf(1.f+__builtin_amdgcn_exp2f(-__builtin_fabsf(z))); s0[r]=sp; p0[r]=z-sp;
                           const float y=p1[r]; const float sq=__builtin_fmaxf(y,0.f)+__builtin_amdgcn_logf(1.f+__builtin_amdgcn_exp2f(-__builtin_fabsf(y))); s1[r]=sq; p1[r]=y-sq; }
    float lo[8],hv[8];
    #pragma unroll
    for(int i=0;i<8;++i){ const float mine=(i<4)?((s0[4*i]+s0[4*i+1])+(s0[4*i+2]+s0[4*i+3])):((s1[4*i-16]+s1[4*i-15])+(s1[4*i-14]+s1[4*i-13]));
      auto rr=__builtin_amdgcn_permlane32_swap(__float_as_uint(mine),__float_as_uint(mine),false,false); lo[i]=__uint_as_float(rr[0]); hv[i]=__uint_as_float(rr[1]); }
    float sp_=0.f;
    #pragma unroll
    for(int i=7;i>=0;--i){ const float base=carry-(sp_+m0*hv[i]);
      if(i<4){ float a=base; p0[4*i+3]=__builtin_amdgcn_exp2f(p0[4*i+3]+a); a-=s0[4*i+3]; p0[4*i+2]=__builtin_amdgcn_exp2f(p0[4*i+2]+a); a-=s0[4*i+2]; p0[4*i+1]=__builtin_amdgcn_exp2f(p0[4*i+1]+a); a-=s0[4*i+1]; p0[4*i]=__builtin_amdgcn_exp2f(p0[4*i]+a); }
      else   { const int j=4*i-16; float a=base; p1[j+3]=__builtin_amdgcn_exp2f(p1[j+3]+a); a-=s1[j+3]; p1[j+2]=__builtin_amdgcn_exp2f(p1[j+2]+a); a-=s1[j+2]; p1[j+1]=__builtin_amdgcn_exp2f(p1[j+1]+a); a-=s1[j+1]; p1[j]=__builtin_amdgcn_exp2f(p1[j]+a); }
      sp_+=lo[i]+hv[i]; }
    carry-=sp_;
    { u32x4 pw0,pw1,pw2,pw3;
      pw0=(u32x4){cvtpk_s(p0[0],p0[1]),cvtpk_s(p0[2],p0[3]),cvtpk_s(p0[4],p0[5]),cvtpk_s(p0[6],p0[7])}; pw1=(u32x4){cvtpk_s(p0[8],p0[9]),cvtpk_s(p0[10],p0[11]),cvtpk_s(p0[12],p0[13]),cvtpk_s(p0[14],p0[15])};
      pw2=(u32x4){cvtpk_s(p1[0],p1[1]),cvtpk_s(p1[2],p1[3]),cvtpk_s(p1[4],p1[5]),cvtpk_s(p1[6],p1[7])}; pw3=(u32x4){cvtpk_s(p1[8],p1[9]),cvtpk_s(p1[10],p1[11]),cvtpk_s(p1[12],p1[13]),cvtpk_s(p1[14],p1[15])};
      pv(o,vb0+slot,__builtin_bit_cast(bf16x8,pw0),__builtin_bit_cast(bf16x8,pw1),__builtin_bit_cast(bf16x8,pw2),__builtin_bit_cast(bf16x8,pw3)); }
    { const bool done_=__all(carry<-150.f); if(lane==0)fl[(t&1)*8+wid]=done_?1u:0u; }
    slot^=SLOTB;
  }
  asm volatile("s_waitcnt vmcnt(0) lgkmcnt(0)":::"memory");
  bf16*Ow=O+(rowbase+q0+wid*QBLK)*1024+h*D;
  { bf16*stg=(bf16*)(shm+LDS_OST)+wid*2048;
    #pragma unroll
    for(int r=0;r<16;++r){const int orow=crow(r,hi);
      #pragma unroll
      for(int d0=0;d0<2;++d0)stg[orow*64+d0*32+r32]=__float2bfloat16(o[d0][r]);}
    asm volatile("s_waitcnt lgkmcnt(0)":::"memory");
    #pragma unroll
    for(int i=0;i<4;++i){const int row=i*8+(lane>>3),ch=lane&7; const u32x4 v=*(const u32x4*)(stg+row*64+ch*8); ATTN_STORE16(Ow+(long)row*1024+ch*8,v);} }
  asm volatile("s_waitcnt vmcnt(0) lgkmcnt(0)\n\ts_barrier":::"memory");
  #undef SB_DMA
}
constexpr int ATTN_LDS_BYTES=LDS_BYTES;
struct AttnTensors { const bf16* Q; const bf16* K; const bf16* V; bf16* O; const float* logf;   const unsigned* kn;   };
struct AttnUnit { int bh; int qb; };
struct StaticOrder {
  int vcu;
  __device__ __forceinline__ explicit StaticOrder(int grid,int block):vcu((block%8)*(grid/8)+block/8){}
  __device__ __forceinline__ bool next(int i,AttnUnit&u)const{ if(i>=4)return false; const int s=vcu&7; u.bh=vcu>>3; u.qb=(i==0)?s:(i==1)?15-s:(i==2)?16+s:31-s; return true; }
  __device__ __forceinline__ void a_ready(const AttnUnit&)const{}
  __device__ __forceinline__ void done(const AttnUnit&)const{}
};
template<class Sched,int THRL=8> __device__ __forceinline__ void attn_phase(char*lds,const AttnTensors&T,const Sched&S){
  AttnUnit u;
  for(int i=0;S.next(i,u);++i){ S.a_ready(u); attn_unit<THRL>(u.bh/NHEAD,u.bh%NHEAD,u.qb,T.Q,T.K,T.V,T.O,lds,T.logf+(size_t)u.bh*SEQ,T.kn+(size_t)u.bh*256); S.done(u); }
}
#undef SBAR
#undef WAIT_BAR
}
constexpr int NWAVES = 8, NTHREADS = NWAVES * 64;
constexpr int BATCH = 2, SEQ = 8192, D = 1024, M = BATCH * SEQ;
constexpr int S5G = 32, S5H = 16, S5P = 64, S5T = 32  , S5NC = M / S5T  , S5KX = 640  ;
constexpr int SBH = 8, FOXH = 16, HD = 64;
constexpr int EVEN_IN = 2048, ODD_IN = 3088, DFF = 2816, NEXP = 8, DFE = 3584;
constexpr float C2 = 0.125f * 1.4426950408889634f;
constexpr int MOE_CHUNK_PANELS = 68, MOE_MAX_PANELS = 136, MOE_MAX_SLOTS = MOE_MAX_PANELS * 256;

constexpr size_t MiB = 1u << 20;
constexpr size_t WS_CTL = 0, CTL_ZERO_BYTES = 1 * MiB;
constexpr size_t WS_WMOE_GU = 1 * MiB;
constexpr size_t WS_WMOE_D = 57 * MiB;
constexpr size_t WS_WIN0 = 85 * MiB;
constexpr size_t WS_WGLU = 89 * MiB;
constexpr size_t WS_WOUT0 = 90 * MiB;
constexpr size_t WS_WGU0 = 92 * MiB;
constexpr size_t WS_WD0 = 103 * MiB;
constexpr size_t WS_WIN1 = 109 * MiB;
constexpr size_t WS_WF1 = 115 * MiB;
constexpr size_t WS_WOUT1 = 116 * MiB;
constexpr size_t WS_S5WA = 118 * MiB;
constexpr size_t WS_S5WC = 126 * MiB;
constexpr size_t WS_XB = 146 * MiB;
constexpr size_t WS_SSP = 178 * MiB;
constexpr size_t WS_META = 182 * MiB;
constexpr size_t WS_LOGF = 183 * MiB;
constexpr size_t WS_QKV0 = 184 * MiB;
constexpr size_t WS_UEXT = 232 * MiB;
constexpr size_t WS_SLOC = 252 * MiB;
constexpr size_t WS_YG = 260 * MiB;
constexpr size_t WS_MIXB = 276 * MiB;
constexpr size_t WS_HID0 = 184 * MiB;
constexpr size_t WS_QKV1 = 184 * MiB;
constexpr size_t WS_XG = 184 * MiB;
constexpr size_t WS_HMOE = 218 * MiB;
constexpr size_t WS_Y = 85 * MiB;
constexpr size_t WS_END = 337 * MiB;
static_assert(WS_XG + (size_t)MOE_MAX_SLOTS * 1024 <= WS_HMOE && WS_HMOE + (size_t)MOE_MAX_SLOTS * DFE <= WS_END && WS_Y + (size_t)MOE_MAX_SLOTS * 1024 * 2 <= WS_XB + 32 * MiB && WS_MIXB + 32 * MiB <= WS_END, "ws map");
constexpr size_t MT_RSTD = 0, MT_TOKE = 65536, MT_TOKP = 131072, MT_TOKG = 262144, MT_TOKSLOT = 393216, MT_RSS = 524288;
constexpr int CW_TMO = 0, CW_CODE = 1, CW_BAR = 4096, CW_CNT = 8192  , CW_QUEUE = 12288  , CW_QUEUE2 = 12352  , CW_KN = 16384  , CW_SS = 32768  ;

constexpr int RING_OFF = 0, RING_BYTES = 131072;
constexpr int LDSCTL_OFF = 133120  , MISC_OFF = LDSCTL_OFF + 320;
constexpr int LDS_BYTES = 147456;

#define GAS __attribute__((address_space(1)))
#define LAS __attribute__((address_space(3)))
typedef unsigned short bf16;
typedef unsigned v4u __attribute__((ext_vector_type(4)));
typedef unsigned v2u __attribute__((ext_vector_type(2)));
typedef float f32x4 __attribute__((ext_vector_type(4)));
typedef short bf16x8 __attribute__((ext_vector_type(8)));
typedef GAS unsigned gu32;
#define RLX_AGENT __ATOMIC_RELAXED, __HIP_MEMORY_SCOPE_AGENT
#define LDS_WAIT() asm volatile("s_waitcnt lgkmcnt(0)" ::: "memory")
#define VM_WAIT() asm volatile("s_waitcnt vmcnt(0)" ::: "memory")
__device__ __forceinline__ unsigned f2bf(float f) { unsigned u = __builtin_bit_cast(unsigned, f); return (u + 0x7fffu + ((u >> 16) & 1u)) >> 16; }
__device__ __forceinline__ unsigned pk2(float lo, float hi) { return f2bf(lo) | (f2bf(hi) << 16); }
__device__ __forceinline__ float bflo(unsigned w) { return __uint_as_float(w << 16); }
__device__ __forceinline__ float bfhi(unsigned w) { return __uint_as_float(w & 0xffff0000u); }

#define XB_TMO      128
#define XB_XCNT(j)  (256  + 64 * (j))
#define XB_XSUB(j)  (1280 + 64 * (j))
#define XB_XGEN(j)  (2304 + 64 * (j))
#define XB_TOP      3328
#define XB_TOPGEN   3392
#define XCD_BAR_WORDS 3456
#define XB_SPIN_CAP (1u << 18)
__device__ __forceinline__ unsigned xb_ld(unsigned* p)              { return __hip_atomic_load(p, __ATOMIC_RELAXED, __HIP_MEMORY_SCOPE_AGENT); }
__device__ __forceinline__ unsigned xb_add(unsigned* p, unsigned v) { return __hip_atomic_fetch_add(p, v, __ATOMIC_RELAXED, __HIP_MEMORY_SCOPE_AGENT); }
__device__ __forceinline__ unsigned xb_xcc_id() { return (unsigned)__builtin_amdgcn_s_getreg((3 << 11) | 20) & 0xFu; }
#define XB_SPIN(cond, bar) do { unsigned _sp = 0; while (cond) { __builtin_amdgcn_s_sleep(1); \
    if ((++_sp & 255u) == 0u) { if (xb_ld(&(bar)[XB_TMO])) break; if (_sp > XB_SPIN_CAP) { atomicAdd(&(bar)[XB_TMO], 1u); break; } } } } while (0)
struct XcdBarrier { unsigned* bar; unsigned x; volatile LAS unsigned* st; };
__device__ __forceinline__ XcdBarrier xcd_barrier_post(unsigned* bar, volatile LAS unsigned* st) {
    XcdBarrier b; b.bar = bar; b.x = xb_xcc_id(); b.st = st;
    if (threadIdx.x == 0) (void)xb_add(&bar[XB_XCNT(b.x)], 1u);
    return b;
}
__device__ __forceinline__ void xcd_barrier_complete(unsigned* bar, unsigned x, unsigned& nloc, unsigned& nx) {
    const unsigned G = gridDim.x * gridDim.y * gridDim.z;
    unsigned sum, cnt, mine, sp = 0u;
    for (;;) {
        sum = 0u; cnt = 0u; mine = 0u;
#pragma unroll
        for (unsigned j = 0; j < 16; ++j) { const unsigned c = xb_ld(&bar[XB_XCNT(j)]); sum += c; cnt += (c > 0u) ? 1u : 0u; mine = (j == x) ? c : mine; }
        if (sum == G) break;
        __builtin_amdgcn_s_sleep(1);
        if ((++sp & 255u) == 0u) { if (xb_ld(&bar[XB_TMO])) break; if (sp > XB_SPIN_CAP) { atomicAdd(&bar[XB_TMO], 1u); break; } }
    }
    nloc = mine > 0u ? mine : 1u; nx = cnt > 0u ? cnt : 1u;
}
__device__ __forceinline__ void xcd_barrier(const XcdBarrier& b) {
    asm volatile("s_waitcnt vmcnt(0)" ::: "memory");
    __syncthreads();
    if (threadIdx.x == 0) {
        unsigned* bar = b.bar;
        __builtin_amdgcn_s_waitcnt(0);
        unsigned nloc = b.st[0], nx = b.st[1];
        if (nloc == 0u) { xcd_barrier_complete(bar, b.x, nloc, nx); b.st[0] = nloc; b.st[1] = nx; }
        const unsigned old = xb_add(&bar[XB_XSUB(b.x)], 1u);
        const unsigned gen = old / nloc;
        if (old + 1u == (gen + 1u) * nloc) {
            __builtin_amdgcn_fence(__ATOMIC_RELEASE, "agent");
            asm volatile("s_waitcnt vmcnt(0)" ::: "memory");
            const unsigned og = xb_add(&bar[XB_TOP], 1u);
            const unsigned tg = og / nx;
            if (og + 1u == (tg + 1u) * nx) xb_add(&bar[XB_TOPGEN], 1u);
            else XB_SPIN(xb_ld(&bar[XB_TOPGEN]) == tg, bar);
            __builtin_amdgcn_fence(__ATOMIC_ACQUIRE, "agent");
            xb_add(&bar[XB_XGEN(b.x)], 1u);
            asm volatile("s_waitcnt vmcnt(0)" ::: "memory");
        } else {
            XB_SPIN(xb_ld(&bar[XB_XGEN(b.x)]) == gen, bar);
            __builtin_amdgcn_fence(__ATOMIC_ACQUIRE, "agent");
            asm volatile("s_waitcnt vmcnt(0)" ::: "memory");
        }
    }
    __syncthreads();
}

__device__ __forceinline__ float wave_sum(float v) {
#pragma unroll
    for (int o = 1; o < 64; o <<= 1) v += __shfl_xor(v, o);
    return v;
}
constexpr int XP = 65, XSCR_BYTES = 64 * XP * 4;
__device__ __forceinline__ unsigned cvtpk(float lo, float hi) { unsigned r; asm volatile("v_cvt_pk_bf16_f32 %0, %1, %2" : "=v"(r) : "v"(lo), "v"(hi)); return r; }
__device__ __forceinline__ void p0_transpose_item(const float* W, int ldw, int k0, int n0, const float* gs, bf16* dst, int ldd, LAS float* scr, int lane) {
    const int lr = lane >> 4, lc = (lane & 15) * 4;
    const float* src = W + (size_t)(k0 + lr) * ldw + n0 + lc;
    f32x4 v[16];
#pragma unroll
    for (int i = 0; i < 16; ++i) v[i] = *(const GAS f32x4*)(src + (size_t)(4 * i) * ldw);
    if (gs) {
#pragma unroll
        for (int i = 0; i < 16; ++i) v[i] = v[i] * gs[k0 + 4 * i + lr]; }
#pragma unroll
    for (int i = 0; i < 16; ++i) { LAS float* p = scr + (4 * i + lr) * XP + lc; p[0] = v[i][0]; p[1] = v[i][1]; p[2] = v[i][2]; p[3] = v[i][3]; }
    LDS_WAIT(); asm volatile("" ::: "memory");
    const int c = lane & 7, nn = lane >> 3;
#pragma unroll
    for (int j = 0; j < 8; ++j) { const int n = nn + 8 * j; const LAS float* sp = scr + (8 * c) * XP + n;
        v4u o; o.x = cvtpk(sp[0 * XP], sp[1 * XP]); o.y = cvtpk(sp[2 * XP], sp[3 * XP]); o.z = cvtpk(sp[4 * XP], sp[5 * XP]); o.w = cvtpk(sp[6 * XP], sp[7 * XP]);
        *(GAS v4u*)(dst + (size_t)n * ldd + k0 + 8 * c) = o; }
    LDS_WAIT(); asm volatile("" ::: "memory");
}
struct XTile { const float* src; const float* gs; unsigned char* dst; int ldw, ldd, k0; };
__device__ __forceinline__ XTile xtile_fp8(int item, const float* W, int ldw, int N, const float* gs, unsigned char* dst, int ldd, int mode, int lane) {
    const int nblk = N / 64, kb = item / nblk, nb = item % nblk, n0 = 64 * nb, k0 = 64 * kb;
    const int row = mode == 0 ? n0 : ((n0 >> 7) * 256 + (n0 & 127) + (mode == 2 ? 128 : 0));
    XTile t; t.src = W + (size_t)(k0 + (lane >> 4)) * ldw + n0 + (lane & 15) * 4; t.gs = gs; t.dst = dst + (size_t)row * ldd; t.ldw = ldw; t.ldd = ldd; t.k0 = k0; return t;
}
__device__ __forceinline__ void xtile_load(const XTile& t, f32x4 (&v)[16]) {
#pragma unroll
    for (int i = 0; i < 16; ++i) v[i] = *(const GAS f32x4*)(t.src + (size_t)(4 * i) * t.ldw);
}
__device__ __forceinline__ void xtile_finish_fp8(const XTile& t, f32x4 (&v)[16], float wscale, LAS float* scr, int lane) {
    const int lr = lane >> 4, lc = (lane & 15) * 4;
#pragma unroll
    for (int i = 0; i < 16; ++i) v[i] = v[i] * (t.gs ? t.gs[t.k0 + 4 * i + lr] * wscale : wscale);
#pragma unroll
    for (int i = 0; i < 16; ++i) { LAS float* p = scr + (4 * i + lr) * XP + lc; p[0] = v[i][0]; p[1] = v[i][1]; p[2] = v[i][2]; p[3] = v[i][3]; }
    LDS_WAIT(); asm volatile("" ::: "memory");
    const int c = lane & 3, nn = lane >> 2;
#pragma unroll
    for (int j = 0; j < 4; ++j) { const int n = nn + 16 * j; const LAS float* sp = scr + (16 * c) * XP + n;
        v4u o; o.x = pg8::pk_fp8x4(sp[0 * XP], sp[1 * XP], sp[2 * XP], sp[3 * XP]); o.y = pg8::pk_fp8x4(sp[4 * XP], sp[5 * XP], sp[6 * XP], sp[7 * XP]);
        o.z = pg8::pk_fp8x4(sp[8 * XP], sp[9 * XP], sp[10 * XP], sp[11 * XP]); o.w = pg8::pk_fp8x4(sp[12 * XP], sp[13 * XP], sp[14 * XP], sp[15 * XP]);
        *(GAS v4u*)(t.dst + (size_t)n * t.ldd + t.k0 + 16 * c) = o; }
    LDS_WAIT(); asm volatile("" ::: "memory");
}
__device__ __forceinline__ void xpose_mat(int item, const float* W, int ldw, int N, const float* gs, bf16* dst, int ldd, int mode, LAS float* scr, int lane) {
    const int nblk = N / 64, kb = item / nblk, nb = item % nblk, n0 = 64 * nb;
    const int row = mode == 0 ? n0 : ((n0 >> 7) * 256 + (n0 & 127) + (mode == 2 ? 128 : 0));
    p0_transpose_item(W, ldw, 64 * kb, n0, gs, dst + (size_t)row * ldd, ldd, scr, lane);
}

struct Args { const float* in[28]; float* out; unsigned char* ws; };

__device__ __forceinline__ void s5_tables(const Args& a, int g, int q, LAS unsigned char* lds, int tid) {
    LAS float* POWr = (LAS float*)lds;
    LAS float* POWi = POWr + 33 * 64;
    LAS float* BBr = POWi + 33 * 64;
    LAS float* BBi = BBr + 1024;
    LAS float* CCr = BBi + 1024;
    LAS float* CCi = CCr + 1024;
    LAS float* KT = CCi + 1024;
    LAS float* DD = KT + 2048;
    const float* a_re = a.in[3]; const float* a_im = a.in[4]; const float* b_re = a.in[5]; const float* b_im = a.in[6];
    const float* c_re = a.in[7]; const float* c_im = a.in[8]; const float* dsk = a.in[9]; const float* log_step = a.in[10];
    const float step = expf(log_step[g]);
    __syncthreads();
    for (int e = tid; e < 33 * 64; e += NTHREADS) { const int n = e >> 6, p = e & 63; const float lr = a_re[g * 64 + p], li = a_im[g * 64 + p];
        const float mag = expf((float)n * step * lr); float sn, cs; sincosf((float)n * (step * li), &sn, &cs); POWr[e] = mag * cs; POWi[e] = mag * sn; }
    for (int e = tid; e < 1024; e += NTHREADS) { const int p = e >> 4, h = e & 15; const float lr = a_re[g * 64 + p], li = a_im[g * 64 + p];
        const float er = expf(lr * step); float sn, cs; sincosf(li * step, &sn, &cs); const float nr = er * cs - 1.f, ni = er * sn, den = lr * lr + li * li;
        const float fr = (nr * lr + ni * li) / den, fi = (ni * lr - nr * li) / den;
        const float br = b_re[(g * 64 + p) * 16 + h], bi = b_im[(g * 64 + p) * 16 + h];
        BBr[e] = fr * br - fi * bi; BBi[e] = fr * bi + fi * br;
        CCr[e] = c_re[g * 1024 + e]; CCi[e] = c_im[g * 1024 + e]; }
    if (tid < 16) DD[tid] = dsk[g * 16 + tid];
    __syncthreads();
    for (int e = tid; e < 2048; e += NTHREADS) { const int tau = e >> 6, hl = (e >> 4) & 3, hi = e & 15, ho = 4 * q + hl; float sacc = 0.f;
        for (int p = 0; p < 64; ++p) { const float cr = CCr[ho * 64 + p], ci = CCi[ho * 64 + p], pr = POWr[tau * 64 + p], pi = POWi[tau * 64 + p];
            const float xr = cr * pr - ci * pi, xi = cr * pi + ci * pr; sacc += xr * BBr[p * 16 + hi] - xi * BBi[p * 16 + hi]; }
        if (tau == 0 && ho == hi) sacc += DD[ho];
        KT[e] = sacc; }
    __syncthreads();
    bf16* WA = (bf16*)(a.ws + WS_S5WA) + (size_t)g * 256 * 512;
    for (int pc = tid; pc < 64 * 64; pc += NTHREADS) { const int p = pc >> 6, k0 = (pc & 63) * 8; v4u o = (v4u){0u, 0u, 0u, 0u};
        if (q < 2) { const int j = k0 >> 4, h0 = k0 & 15; const float pr = POWr[(31 - j) * 64 + p], pi = POWi[(31 - j) * 64 + p]; float v[8];
#pragma unroll
            for (int w = 0; w < 8; ++w) { const float br = BBr[p * 16 + h0 + w], bi = BBi[p * 16 + h0 + w]; v[w] = (q == 0) ? (pr * br - pi * bi) : (pr * bi + pi * br); }
            o.x = cvtpk(v[0], v[1]); o.y = cvtpk(v[2], v[3]); o.z = cvtpk(v[4], v[5]); o.w = cvtpk(v[6], v[7]); }
        *(GAS v4u*)(WA + (size_t)(64 * q + p) * 512 + k0) = o; }
    bf16* WC = (bf16*)(a.ws + WS_S5WC) + (size_t)g * 512 * 640;
    for (int pc = tid; pc < 128 * 80; pc += NTHREADS) { const int rl = pc / 80, k0 = (pc % 80) * 8, i = rl >> 2, hl = rl & 3, ho = 4 * q + hl; float v[8];
        if (k0 < 512) { const int j = k0 >> 4, h0 = k0 & 15;
#pragma unroll
            for (int w = 0; w < 8; ++w) v[w] = (j <= i) ? KT[((i - j) * 4 + hl) * 16 + h0 + w] : 0.f; }
        else { const int p0 = (k0 - 512) & 63; const bool im = k0 >= 576;
#pragma unroll
            for (int w = 0; w < 8; ++w) { const int p = p0 + w; const float cr = CCr[ho * 64 + p], ci = CCi[ho * 64 + p], pr = POWr[(i + 1) * 64 + p], pi = POWi[(i + 1) * 64 + p];
                v[w] = im ? -(cr * pi + ci * pr) : (cr * pr - ci * pi); } }
        v4u o; o.x = cvtpk(v[0], v[1]); o.y = cvtpk(v[2], v[3]); o.z = cvtpk(v[4], v[5]); o.w = cvtpk(v[6], v[7]);
        *(GAS v4u*)(WC + (size_t)(i * 16 + ho) * 640 + k0) = o; }
    __syncthreads();
}

constexpr int MOE_XITEMS = 24 * 896;
__device__ __forceinline__ XTile moe_xtile(const Args& a, int r, int lane) {
    unsigned char* ws = a.ws;
    const int mat = r / 896, e = mat / 3, which = mat % 3; r -= mat * 896;
    if (which == 0) return xtile_fp8(r, a.in[24] + (size_t)e * D * DFE, DFE, DFE, a.in[22], ws + WS_WMOE_GU + (size_t)e * 7168 * 1024, D, 1, lane);
    if (which == 1) return xtile_fp8(r, a.in[25] + (size_t)e * D * DFE, DFE, DFE, a.in[22], ws + WS_WMOE_GU + (size_t)e * 7168 * 1024, D, 2, lane);
    return xtile_fp8(r, a.in[26] + (size_t)e * DFE * D, D, D, nullptr, ws + WS_WMOE_D + (size_t)e * 1024 * 3584, DFE, 0, lane);
}
__device__ __forceinline__ void p0_prologue(const Args& a, LAS unsigned char* lds, int tid, int lane, int wave, int vcu, int G) {
    for (int it = vcu; it < 4 * S5G; it += G) s5_tables(a, it >> 2, it & 3, lds, tid);
    LAS float* scr = (LAS float*)(lds + wave * XSCR_BYTES);
    const int gw = vcu * NWAVES + wave, NGW = G * NWAVES;
    constexpr int I_IN0 = 16 * 32, I_GLU = 8 * 8, I_OUT = 16 * 16, I_GU0 = 16 * 44, I_D0 = 44 * 16, I_IN1 = 16 * 48, I_MOE = 896;
    constexpr int NITEMS = I_IN0 + I_GLU + I_OUT + 2 * I_GU0 + I_D0 + I_IN1 + I_OUT;
    unsigned char* ws = a.ws;
    for (int it = NITEMS - 1 - gw; it >= 0; it -= NGW) {
        int r = it;
        if (r < I_IN0) { xpose_mat(r, a.in[2], EVEN_IN, EVEN_IN, a.in[1], (bf16*)(ws + WS_WIN0), D, 0, scr, lane); continue; } r -= I_IN0;
        if (r < I_GLU) { xpose_mat(r, a.in[11], 512, 512, nullptr, (bf16*)(ws + WS_WGLU), 512, 0, scr, lane); continue; } r -= I_GLU;
        if (r < I_OUT) { xpose_mat(r, a.in[13], D, D, nullptr, (bf16*)(ws + WS_WOUT0), D, 0, scr, lane); continue; } r -= I_OUT;
        if (r < I_GU0) { xpose_mat(r, a.in[15], DFF, DFF, a.in[14], (bf16*)(ws + WS_WGU0), D, 1, scr, lane); continue; } r -= I_GU0;
        if (r < I_GU0) { xpose_mat(r, a.in[16], DFF, DFF, a.in[14], (bf16*)(ws + WS_WGU0), D, 2, scr, lane); continue; } r -= I_GU0;
        if (r < I_D0) { xpose_mat(r, a.in[17], D, D, nullptr, (bf16*)(ws + WS_WD0), DFF, 0, scr, lane); continue; } r -= I_D0;
        if (r < I_IN1) { xpose_mat(r, a.in[19], ODD_IN, 3072, a.in[18], (bf16*)(ws + WS_WIN1), D, 0, scr, lane); continue; } r -= I_IN1;
        xpose_mat(r, a.in[21], D, D, nullptr, (bf16*)(ws + WS_WOUT1), D, 0, scr, lane);
    }
    { const int gt = vcu * NTHREADS + tid; if (gt < 16 * 1024) { const int h = gt >> 10, k = gt & 1023; ((bf16*)(ws + WS_WF1))[gt] = (bf16)f2bf(a.in[19][(size_t)k * ODD_IN + 3072 + h] * a.in[18][k]); } }
    float* ss0 = (float*)(ws + WS_SSP);
    for (int m = gw; m < M; m += NGW) {
        const GAS f32x4* xr = (const GAS f32x4*)(a.in[0] + (size_t)m * D) + lane; GAS v2u* o8 = (GAS v2u*)((bf16*)(ws + WS_XB) + (size_t)m * D) + lane; float s = 0.f;
#pragma unroll
        for (int j = 0; j < 4; ++j) { const f32x4 v = xr[64 * j]; s += (v.x * v.x + v.y * v.y) + (v.z * v.z + v.w * v.w); v2u w; w.x = pk2(v.x, v.y); w.y = pk2(v.z, v.w); o8[64 * j] = w; }
        s = wave_sum(s); if (lane < 16) ss0[(size_t)m * 16 + lane] = (lane == 0) ? s : 0.f;
    }
}

__device__ __forceinline__ void s5_scan(const Args& a, int gt  ) {
    if (gt >= BATCH * S5G * S5P) return;
    const int b = gt / (S5G * S5P), g = (gt / S5P) % S5G, p = gt % S5P;
    const float step = expf(a.in[10][g]); const float lr = a.in[3][g * 64 + p], li = a.in[4][g * 64 + p];
    const float mag = expf((float)S5T * step * lr); float sn, cs; sincosf((float)S5T * (step * li), &sn, &cs); const float ar = mag * cs, ai = mag * sn;
    const float* sl = (const float*)(a.ws + WS_SLOC) + ((size_t)g * S5NC + b * 256) * 128 + p;
    bf16* ue = (bf16*)(a.ws + WS_UEXT) + ((size_t)g * S5NC + b * 256) * S5KX + 512 + p;
    float sr = 0.f, si = 0.f;
#pragma unroll 8
    for (int c = 0; c < 256; ++c) {
        ue[(size_t)c * S5KX] = (bf16)f2bf(sr); ue[(size_t)c * S5KX + 64] = (bf16)f2bf(si);
        const float lr_ = sl[(size_t)c * 128], li_ = sl[(size_t)c * 128 + 64];
        const float nr = ar * sr - ai * si + lr_, ni = ar * si + ai * sr + li_; sr = nr; si = ni;
    }
}

__device__ __forceinline__ float softplus2(float z) { return fmaxf(z, 0.f) + __builtin_amdgcn_logf(1.0f + __builtin_amdgcn_exp2f(-fabsf(z))); }
__device__ __forceinline__ void stage_kv32(const bf16* kp, const bf16* vp, size_t pitch, LAS float* sK, LAS float* sV, int tid) {
    const int r = tid >> 4, c = (tid & 15) * 4;
    const v2u kw = *(const v2u*)(kp + (size_t)r * pitch + c), vw = *(const v2u*)(vp + (size_t)r * pitch + c);
    *(LAS f32x4*)(sK + r * 64 + c) = (f32x4){bflo(kw.x), bfhi(kw.x), bflo(kw.y), bfhi(kw.y)};
    *(LAS f32x4*)(sV + r * 64 + c) = (f32x4){bflo(vw.x), bfhi(vw.x), bflo(vw.y), bfhi(vw.y)};
}
__device__ __forceinline__ void sb_simple_unit(const bf16* qkv  , bf16* mix  , int b, int h, int blk, LAS unsigned char* lds, int tid) {
    const int lane = tid & 63, wave_ = tid >> 6;
    LAS float* sK = (LAS float*)lds; LAS float* sV = sK + 32 * 64;
    const int t = blk * 512 + tid; const size_t rb = (size_t)b * SEQ;
    float q[HD], acc[HD];
    { const v4u* qp = (const v4u*)(qkv + (rb + t) * 1536 + h * HD);
#pragma unroll
      for (int i = 0; i < 8; ++i) { const v4u w = qp[i]; q[8 * i] = bflo(w.x); q[8 * i + 1] = bfhi(w.x); q[8 * i + 2] = bflo(w.y); q[8 * i + 3] = bfhi(w.y); q[8 * i + 4] = bflo(w.z); q[8 * i + 5] = bfhi(w.z); q[8 * i + 6] = bflo(w.w); q[8 * i + 7] = bfhi(w.w); }
#pragma unroll
      for (int i = 0; i < HD; ++i) acc[i] = 0.f; }
    float carry = 0.f;
    for (int c0 = blk * 512 + 480; c0 >= 0; c0 -= 32) {
        __syncthreads();
        stage_kv32(qkv + (rb + c0) * 1536 + 512 + h * HD, qkv + (rb + c0) * 1536 + 1024 + h * HD, 1536, sK, sV, tid);
        __syncthreads();
        for (int r = 31; r >= 0; --r) { const int s = c0 + r;
            if (s < t) { float z = 0.f;
#pragma unroll
                for (int i = 0; i < HD; ++i) z = fmaf(q[i], sK[r * 64 + i], z);
                const float sp = softplus2(z); const float w = __builtin_amdgcn_exp2f(z - sp + carry); carry -= sp;
#pragma unroll
                for (int i = 0; i < HD; ++i) acc[i] = fmaf(w, sV[r * 64 + i], acc[i]); } }
        { LAS unsigned* fl = (LAS unsigned*)(lds + 16384); if (lane == 0) fl[wave_] = __all(carry < -150.f) ? 1u : 0u; __syncthreads();
          if ((fl[0] & fl[1] & fl[2] & fl[3] & fl[4] & fl[5] & fl[6] & fl[7]) != 0u) break; }
    }
    v4u* op = (v4u*)(mix + (rb + t) * 1024 + 512 + h * HD);
#pragma unroll
    for (int i = 0; i < 8; ++i) { v4u w; w.x = pk2(acc[8 * i], acc[8 * i + 1]); w.y = pk2(acc[8 * i + 2], acc[8 * i + 3]); w.z = pk2(acc[8 * i + 4], acc[8 * i + 5]); w.w = pk2(acc[8 * i + 6], acc[8 * i + 7]); op[i] = w; }
}
__device__ __forceinline__ void fgate_rows16(const bf16* xb, const bf16* wf, const float* ss, const float* bfv, float* logf, int r0, int lane) {
    const int fr = lane & 15, fq = lane >> 4;
    const bf16x8* ap = (const bf16x8*)(xb + (size_t)(r0 + fr) * D + fq * 8);
    const bf16x8* bp = (const bf16x8*)(wf + (size_t)fr * D + fq * 8);
    f32x4 acc = (f32x4){0.f, 0.f, 0.f, 0.f};
#pragma unroll 8
    for (int kk = 0; kk < 32; ++kk) acc = __builtin_amdgcn_mfma_f32_16x16x32_bf16(ap[kk * 4], bp[kk * 4], acc, 0, 0, 0);
    const float bias = bfv[fr];
#pragma unroll
    for (int j = 0; j < 4; ++j) { const int row = r0 + fq * 4 + j; const float rs = pg8::rstd16(ss, row);
        const float z = acc[j] * rs + bias;
        const float lf = -(fmaxf(-z, 0.f) + log1pf(expf(-fabsf(z)))) * 1.4426950408889634f;
        const int b = row >> 13, t = row & 8191; logf[((size_t)b * FOXH + fr) * SEQ + t] = lf; }
}

struct MoeOrder {
    pg8::StaticOrder S; int lo; int pref[NEXP + 1];
    __device__ __forceinline__ bool next(int i, pg8::Unit& u) const {
        if (!S.next(i, u)) return false;
        u.pm += lo; int e = 0;
#pragma unroll
        for (int k = 1; k < NEXP; ++k) e += (u.pm >= pref[k]) ? 1 : 0;
        u.zb = e; return true;
    }
    __device__ __forceinline__ void a_ready(const pg8::Unit&) const {}
    __device__ __forceinline__ void done(const pg8::Unit&) const {}
};

__global__ void __launch_bounds__(NTHREADS, 2) mk_fwd(Args args) {
    extern __shared__ __attribute__((aligned(16))) unsigned char lds_raw[];
    LAS unsigned char* lds = (LAS unsigned char*)lds_raw;
    volatile LAS unsigned* MISC = (volatile LAS unsigned*)(lds + MISC_OFF);
    const int tid = threadIdx.x, lane = tid & 63, wave = __builtin_amdgcn_readfirstlane(tid >> 6);
    const int G = gridDim.x; const int bx = blockIdx.x; const int vcu = (G % 8 == 0) ? (bx % 8) * (G / 8) + bx / 8 : bx;
    unsigned char* ws = args.ws;
    gu32* ctl = (gu32*)(ws + WS_CTL);
    for (int u = tid; u < (LDS_BYTES - LDSCTL_OFF) / 4; u += NTHREADS) ((LAS unsigned*)(lds + LDSCTL_OFF))[u] = 0u;
    __syncthreads();
    XcdBarrier bar = xcd_barrier_post((unsigned*)(ctl + CW_BAR), MISC + 8);
    const int gw = vcu * NWAVES + wave, NGW = G * NWAVES;
    float* SS = (float*)(ws + WS_SSP);
    float* X = args.out;
    bf16* XB = (bf16*)(ws + WS_XB);
#define GRID_BAR() xcd_barrier(bar)
#define GEMM_PHASE(EPI, SCHED, lds_, g_, S_, E_) pg8::gemm_phase<EPI, SCHED, true, true>(lds_, g_, S_, E_)

    p0_prologue(args, lds, tid, lane, wave, vcu, G);
    GRID_BAR();
    { pg8::Gemm g{XB, (const bf16*)(ws + WS_WIN0), D, D, D, 0, 0}; pg8::StaticOrder S; S.init(M, EVEN_IN, 1, G, bx);
      pg8::EpiInProj0 E{SS, (bf16*)(ws + WS_UEXT), (bf16*)(ws + WS_QKV0), C2};
      GEMM_PHASE(pg8::EpiInProj0, pg8::StaticOrder, lds + RING_OFF, g, S, E); }
    GRID_BAR();
#define SB_PULL_ONE(more_) do { if (tid == 0) MISC[17] = __hip_atomic_fetch_add(ctl + CW_QUEUE2, 1u, RLX_AGENT); __syncthreads(); const unsigned uq_ = __builtin_amdgcn_readfirstlane(MISC[17]); __syncthreads(); \
        more_ = uq_ < (unsigned)(BATCH * SBH * 32); if (more_) { const int bh_ = (int)(uq_ >> 5), qb_ = (int)(uq_ & 31u); \
            attn_body::sb_unit<1536>(bh_ >> 3, bh_ & 7, qb_, (const attn_body::bf16*)(ws + WS_QKV0), (const attn_body::bf16*)(ws + WS_QKV0) + 512, (const attn_body::bf16*)(ws + WS_QKV0) + 1024, (attn_body::bf16*)(ws + WS_MIXB) + 512, (char*)lds_raw + RING_OFF); } } while (0)
    bool sb_more = true;
    { pg8::Gemm g{(const bf16*)(ws + WS_UEXT), (const bf16*)(ws + WS_S5WA), S5KX, 512, 512, (size_t)S5NC * S5KX * 2, (size_t)256 * 512 * 2}; pg8::StaticOrder S; S.init(S5NC, 256, S5G, G, bx);
      pg8::EpiS5State E{(float*)(ws + WS_SLOC)};
      GEMM_PHASE(pg8::EpiS5State, pg8::StaticOrder, lds + RING_OFF, g, S, E);
      if (bx >= S.nwg) SB_PULL_ONE(sb_more); }
    GRID_BAR();
    s5_scan(args, vcu * NTHREADS + tid);
    if (vcu * NTHREADS >= BATCH * S5G * S5P) SB_PULL_ONE(sb_more);
    GRID_BAR();
    { pg8::Gemm g{(const bf16*)(ws + WS_UEXT), (const bf16*)(ws + WS_S5WC), S5KX, S5KX, S5KX, (size_t)S5NC * S5KX * 2, (size_t)512 * S5KX * 2}; pg8::StaticOrder S; S.init(S5NC, 512, S5G, G, bx);
      pg8::EpiS5Y E{(bf16*)(ws + WS_YG)};
      GEMM_PHASE(pg8::EpiS5Y, pg8::StaticOrder, lds + RING_OFF, g, S, E);
      if (bx >= S.nwg) SB_PULL_ONE(sb_more); }
    GRID_BAR();
    { pg8::Gemm g{(const bf16*)(ws + WS_YG), (const bf16*)(ws + WS_WGLU), 512, 512, 512, 0, 0}; pg8::StaticOrder S; S.init(M, 512, 1, G, bx);
      pg8::EpiGlu E{(const bf16*)(ws + WS_YG), args.in[12], (bf16*)(ws + WS_MIXB)};
      GEMM_PHASE(pg8::EpiGlu, pg8::StaticOrder, lds + RING_OFF, g, S, E); }
    __syncthreads();
    sb_more = true;
#pragma unroll 1
    while (sb_more) SB_PULL_ONE(sb_more);
    GRID_BAR();
#undef SB_PULL_ONE
    { pg8::Gemm g{(const bf16*)(ws + WS_MIXB), (const bf16*)(ws + WS_WOUT0), D, D, D, 0, 0}; pg8::StaticOrder S; S.init(M, D, 1, G, bx);
      pg8::EpiResid E{args.in[0], X, XB, SS + 16 * M};
      GEMM_PHASE(pg8::EpiResid, pg8::StaticOrder, lds + RING_OFF, g, S, E); }
    GRID_BAR();
    { pg8::Gemm g{XB, (const bf16*)(ws + WS_WGU0), D, D, D, 0, 0}; pg8::StaticOrder S; S.init(M, 2 * DFF, 1, G, bx);
      pg8::EpiSwiGlu<true> E{SS + 16 * M, (bf16*)(ws + WS_HID0), DFF};
      GEMM_PHASE(pg8::EpiSwiGlu<true>, pg8::StaticOrder, lds + RING_OFF, g, S, E); }
    GRID_BAR();
    { pg8::Gemm g{(const bf16*)(ws + WS_HID0), (const bf16*)(ws + WS_WD0), DFF, DFF, DFF, 0, 0}; pg8::StaticOrder S; S.init(M, D, 1, G, bx);
      pg8::EpiResid E{X, X, XB, SS + 32 * M};
      GEMM_PHASE(pg8::EpiResid, pg8::StaticOrder, lds + RING_OFF, g, S, E); }
    GRID_BAR();
    { pg8::Gemm g{XB, (const bf16*)(ws + WS_WIN1), D, D, D, 0, 0}; pg8::StaticOrder S; S.init(M, 3072, 1, G, bx);
      pg8::EpiInProj1 E{SS + 32 * M, (bf16*)(ws + WS_QKV1), C2, (unsigned*)(ctl + CW_KN)};
      GEMM_PHASE(pg8::EpiInProj1, pg8::StaticOrder, lds + RING_OFF, g, S, E); }
    for (int r = gw; r < M / 16; r += NGW) fgate_rows16(XB, (const bf16*)(ws + WS_WF1), SS + 32 * M, args.in[20], (float*)(ws + WS_LOGF), r * 16, lane);
    GRID_BAR();
    { const attn_body::AttnTensors AT{(const attn_body::bf16*)(ws + WS_QKV1), (const attn_body::bf16*)(ws + WS_QKV1 + 32 * MiB), (const attn_body::bf16*)(ws + WS_QKV1 + 64 * MiB), (attn_body::bf16*)(ws + WS_QKV1), (const float*)(ws + WS_LOGF), (const unsigned*)(ctl + CW_KN)};
      constexpr int N_ATT = 1024, N_CVB = MOE_XITEMS / 32, N_GRP = (N_ATT + 2) / 3 > (N_CVB + 1) / 2 ? (N_ATT + 2) / 3 : (N_CVB + 1) / 2;
      for (;;) {
          if (tid == 0) MISC[16] = __hip_atomic_fetch_add(ctl + CW_QUEUE, 1u, RLX_AGENT);
          __syncthreads();
          const unsigned uq = __builtin_amdgcn_readfirstlane(MISC[16]);
          __syncthreads();
          if (uq >= 5u * N_GRP) break;
          const int grp = (int)(uq / 5u), rr = (int)(uq % 5u);
          if (rr & 1) { const int cb = 2 * grp + (rr >> 1);
              if (cb < N_CVB) { int lane_ = threadIdx.x & 63; asm volatile("" : "+v"(lane_));
                  LAS float* scr = (LAS float*)(lds + wave * XSCR_BYTES);
#pragma unroll 1
                  for (int j = 0; j < 4; j += 2) { const XTile t0 = moe_xtile(args, cb * 32 + wave * 4 + j, lane_), t1 = moe_xtile(args, cb * 32 + wave * 4 + j + 1, lane_);
                      f32x4 v0[16], v1[16]; xtile_load(t0, v0); xtile_load(t1, v1);
                      xtile_finish_fp8(t0, v0, 64.f, scr, lane_); xtile_finish_fp8(t1, v1, 64.f, scr, lane_); } }
          } else { const int au = 3 * grp + (rr >> 1);
              if (au < N_ATT) { const int bh = au & 31, qb = 31 - (au >> 5);
                  attn_body::attn_unit<8>(bh >> 4, bh & 15, qb, AT.Q, AT.K, AT.V, AT.O, (char*)lds_raw + RING_OFF, AT.logf + (size_t)bh * SEQ, AT.kn + (size_t)bh * 256); } }
      } }
    GRID_BAR();
    { pg8::Gemm g{(const bf16*)(ws + WS_QKV1), (const bf16*)(ws + WS_WOUT1), D, D, D, 0, 0}; pg8::StaticOrder S; S.init(M, D, 1, G, bx);
      pg8::EpiResid E{X, X, XB, SS + 48 * M};
      GEMM_PHASE(pg8::EpiResid, pg8::StaticOrder, lds + RING_OFF, g, S, E); }
    GRID_BAR();
    unsigned char* meta = ws + WS_META;
    {
        const float* wr = args.in[23]; const float* gn = args.in[22];
        for (int tok = gw; tok < M; tok += NGW) {
            const GAS f32x4* xr = (const GAS f32x4*)(X + (size_t)tok * D) + lane; float lg[NEXP]; float s = 0.f;
#pragma unroll
            for (int e = 0; e < NEXP; ++e) lg[e] = 0.f;
#pragma unroll
            for (int j = 0; j < 4; ++j) { const f32x4 v = xr[64 * j]; s += (v.x * v.x + v.y * v.y) + (v.z * v.z + v.w * v.w); const int k0 = 4 * lane + 256 * j; const f32x4 gv = *(const f32x4*)(gn + k0);
#pragma unroll
                for (int q = 0; q < 4; ++q) { const float xv = v[q] * gv[q]; const f32x4 w0 = *(const f32x4*)(wr + (size_t)(k0 + q) * NEXP), w1 = *(const f32x4*)(wr + (size_t)(k0 + q) * NEXP + 4);
                    lg[0] = fmaf(xv, w0.x, lg[0]); lg[1] = fmaf(xv, w0.y, lg[1]); lg[2] = fmaf(xv, w0.z, lg[2]); lg[3] = fmaf(xv, w0.w, lg[3]);
                    lg[4] = fmaf(xv, w1.x, lg[4]); lg[5] = fmaf(xv, w1.y, lg[5]); lg[6] = fmaf(xv, w1.z, lg[6]); lg[7] = fmaf(xv, w1.w, lg[7]); } }
            s = wave_sum(s);
#pragma unroll
            for (int e = 0; e < NEXP; ++e) lg[e] = wave_sum(lg[e]);
            if (lane == 0) {
                const float rs = 1.0f / sqrtf(s * (1.0f / 1024.0f) + pg8::RMS_EPS);
                int i1 = 0; float v1 = lg[0];
#pragma unroll
                for (int e = 1; e < NEXP; ++e) if (lg[e] > v1) { v1 = lg[e]; i1 = e; }
                int i2 = -1; float v2 = -INFINITY;
#pragma unroll
                for (int e = 0; e < NEXP; ++e) if (e != i1 && lg[e] > v2) { v2 = lg[e]; i2 = e; }
                const float g1 = 1.f / (1.f + expf((v2 - v1) * rs)), g2 = 1.f - g1;
                const unsigned p1 = __hip_atomic_fetch_add(ctl + CW_CNT + 64 * i1, 1u, RLX_AGENT), p2 = __hip_atomic_fetch_add(ctl + CW_CNT + 64 * i2, 1u, RLX_AGENT);
                ((float*)(meta + MT_RSTD))[tok] = rs; ((unsigned*)(meta + MT_TOKE))[tok] = (unsigned)i1 | ((unsigned)i2 << 8);
                ((unsigned*)(meta + MT_TOKP))[2 * tok] = p1; ((unsigned*)(meta + MT_TOKP))[2 * tok + 1] = p2;
                ((float*)(meta + MT_TOKG))[2 * tok] = g1; ((float*)(meta + MT_TOKG))[2 * tok + 1] = g2;
            }
        }
    }
    GRID_BAR();
    int pref[NEXP + 1], cnt[NEXP];
    { pref[0] = 0;
#pragma unroll
      for (int e = 0; e < NEXP; ++e) { cnt[e] = (int)__builtin_amdgcn_readfirstlane(__hip_atomic_load(ctl + CW_CNT + 64 * e, RLX_AGENT)); pref[e + 1] = pref[e] + (cnt[e] + 255) / 256; } }
    const int NP = pref[NEXP];
    unsigned char* XG = ws + WS_XG; float* RSS = (float*)(meta + MT_RSS);
    {
        for (int tok = gw; tok < M; tok += NGW) {
            const unsigned ee = ((const unsigned*)(meta + MT_TOKE))[tok]; const float rs = ((const float*)(meta + MT_RSTD))[tok];
            const GAS f32x4* xr = (const GAS f32x4*)(X + (size_t)tok * D) + lane; unsigned w[4];
#pragma unroll
            for (int j = 0; j < 4; ++j) { const f32x4 v = xr[64 * j]; w[j] = pg8::pk_fp8x4(v.x, v.y, v.z, v.w); }
#pragma unroll
            for (int k = 0; k < 2; ++k) { const int e = (ee >> (8 * k)) & 0xff; int pe = 0;
#pragma unroll
                for (int q = 0; q < NEXP; ++q) pe = (q == e) ? pref[q] : pe;
                const int slot = pe * 256 + (int)((const unsigned*)(meta + MT_TOKP))[2 * tok + k];
#pragma unroll
                for (int j = 0; j < 4; ++j) *(unsigned*)(XG + (size_t)slot * D + 4 * lane + 256 * j) = w[j];
                if (lane == 0) { RSS[slot] = rs; ((unsigned*)(meta + MT_TOKSLOT))[2 * tok + k] = (unsigned)slot; } }
        }
#pragma unroll
        for (int e = 0; e < NEXP; ++e) for (int r = pref[e] * 256 + cnt[e] + gw; r < pref[e + 1] * 256; r += NGW) {
            *(v4u*)(XG + (size_t)r * D + lane * 16) = (v4u){0u, 0u, 0u, 0u}; if (lane == 0) RSS[r] = 0.f; }
    }
    GRID_BAR();
    bf16* YS = (bf16*)(ws + WS_Y);
    { pg8::Gemm g{(const bf16*)XG, (const bf16*)(ws + WS_WMOE_GU), D / 2, D / 2, D / 2, 0, (size_t)7168 * 1024}; MoeOrder S; S.S.nM = NP; S.S.nN = 28; S.S.nZ = 1; S.S.nwg = NP * 28; S.S.G = G; S.S.c = bx; S.lo = 0;
#pragma unroll
      for (int e = 0; e <= NEXP; ++e) S.pref[e] = pref[e];
      pg8::EpiSwiGluFp8 E{RSS, ws + WS_HMOE, DFE};
      pg8::gemm_phase<pg8::EpiSwiGluFp8, MoeOrder, true, true, true>(lds + RING_OFF, g, S, E); }
    GRID_BAR();
    { pg8::Gemm g{(const bf16*)(ws + WS_HMOE), (const bf16*)(ws + WS_WMOE_D), DFE / 2, DFE / 2, DFE / 2, 0, (size_t)1024 * 3584}; MoeOrder S; S.S.nM = NP; S.S.nN = 4; S.S.nZ = 1; S.S.nwg = NP * 4; S.S.G = G; S.S.c = bx; S.lo = 0;
#pragma unroll
      for (int e = 0; e <= NEXP; ++e) S.pref[e] = pref[e];
      pg8::EpiStoreBf16 E{YS, D};
      pg8::gemm_phase<pg8::EpiStoreBf16, MoeOrder, true, true, true>(lds + RING_OFF, g, S, E); }
    GRID_BAR();
    {
        const float* gf = args.in[27];
        for (int tok = gw; tok < M; tok += NGW) {
            const unsigned s0 = ((const unsigned*)(meta + MT_TOKSLOT))[2 * tok], s1 = ((const unsigned*)(meta + MT_TOKSLOT))[2 * tok + 1];
            const float g0 = ((const float*)(meta + MT_TOKG))[2 * tok], g1 = ((const float*)(meta + MT_TOKG))[2 * tok + 1];
            GAS f32x4* xr = (GAS f32x4*)(X + (size_t)tok * D) + lane; f32x4 v[4]; float s = 0.f;
#pragma unroll
            for (int j = 0; j < 4; ++j) { v[j] = xr[64 * j]; const int k0 = 4 * lane + 256 * j;
                const v2u a = *(const v2u*)(YS + (size_t)s0 * D + k0), b2 = *(const v2u*)(YS + (size_t)s1 * D + k0);
                v[j].x += g0 * bflo(a.x) + g1 * bflo(b2.x); v[j].y += g0 * bfhi(a.x) + g1 * bfhi(b2.x); v[j].z += g0 * bflo(a.y) + g1 * bflo(b2.y); v[j].w += g0 * bfhi(a.y) + g1 * bfhi(b2.y);
                s += (v[j].x * v[j].x + v[j].y * v[j].y) + (v[j].z * v[j].z + v[j].w * v[j].w); }
            s = wave_sum(s); const float rs = 1.0f / sqrtf(s * (1.0f / 1024.0f) + pg8::RMS_EPS);
#pragma unroll
            for (int j = 0; j < 4; ++j) { const f32x4 gv = *(const f32x4*)(gf + 4 * lane + 256 * j); xr[64 * j] = v[j] * rs * gv; }
        }
    }
}

extern "C" void kernel_launch(void* const* d_in, const int* in_sizes, int n_in, void* d_out, int out_size, void* d_ws, size_t ws_size, hipStream_t stream) {
    static int grid = 0;
    if (grid == 0) {
        if (n_in != 28 || in_sizes[0] != M * D || out_size != M * D || ws_size < WS_END) { fprintf(stderr, "kernel_launch: unexpected problem: n_in %d in0 %d out %d ws %zu (need %zu)\n", n_in, n_in > 0 ? in_sizes[0] : -1, out_size, ws_size, (size_t)WS_END); grid = -1; return; }
        int dev = 0, cus = 0, per_cu = 0;
        if (hipGetDevice(&dev) != hipSuccess || hipDeviceGetAttribute(&cus, hipDeviceAttributeMultiprocessorCount, dev) != hipSuccess) { grid = -1; return; }
        if (hipFuncSetAttribute((const void*)mk_fwd, hipFuncAttributeMaxDynamicSharedMemorySize, LDS_BYTES) != hipSuccess) { fprintf(stderr, "kernel_launch: hipFuncSetAttribute failed\n"); grid = -1; return; }
        if (hipOccupancyMaxActiveBlocksPerMultiprocessor(&per_cu, (const void*)mk_fwd, NTHREADS, LDS_BYTES) != hipSuccess || per_cu < 1) fprintf(stderr, "kernel_launch: occupancy query says %d\n", per_cu);
        (void)hipGetLastError();
        grid = cus;
        if (grid != 256) fprintf(stderr, "kernel_launch: built for the 256-CU MI355X; device reports %d CUs\n", cus);
    }
    if (grid < 0) return;
    if (hipMemsetAsync((char*)d_ws + WS_CTL, 0, CTL_ZERO_BYTES, stream) != hipSuccess) return;
    Args a{};
    for (int i = 0; i < 28; ++i) a.in[i] = (const float*)d_in[i];
    a.out = (float*)d_out; a.ws = (unsigned char*)d_ws;
    hipLaunchKernelGGL(mk_fwd, dim3(grid), dim3(NTHREADS), LDS_BYTES, stream, a);
}
```

```cpp
#include <hip/hip_runtime.h>
#include <cstdio>
#include <cstdint>

namespace pg8 {
#define PG8_LAS __attribute__((address_space(3)))
typedef unsigned short bf16_t;
typedef short bf16x8 __attribute__((ext_vector_type(8)));
typedef float f32x4 __attribute__((ext_vector_type(4)));
typedef unsigned u32x4 __attribute__((ext_vector_type(4)));
typedef unsigned u32x2 __attribute__((ext_vector_type(2)));
constexpr int BM = 256, BK = 64, HALF = 128, HTB = HALF * BK * 2  , STAGE_BYTES = 8 * HTB, NXCD = 8, WGM = 8;

__host__ __device__ __forceinline__ int lds_byte(int r, int c) { const int st = (r >> 4) * 2 + (c >> 5), rr = r & 15, cc = c & 31, ob = rr * 64 + cc * 2; return st * 1024 + (ob ^ (((ob >> 9) & 1) << 5)); }
__host__ __device__ __forceinline__ void stage_rc(int b, int& R, int& C) { const int st = b / 1024, sb = b % 1024, swz = sb ^ (((sb >> 9) & 1) << 5); R = (st >> 1) * 16 + swz / 64; C = (st & 1) * 32 + (swz % 64) / 2; }
__host__ __device__ __forceinline__ int perm32(int rho) { const int n = rho >> 4, i = rho & 15; return 8 * (i >> 2) + 4 * n + (i & 3); }

struct Unit { int pm, pn, zb, pa; };
struct Gemm { const bf16_t* A; const bf16_t* Bt; int lda, ldb, K; size_t zA, zB; };

struct StaticOrder {
    int nM, nN, nZ, nwg, G, c;
    __host__ __device__ void init(int M, int N, int Z, int G_, int c_) { nM = M / BM; nN = N / BM; nZ = Z; nwg = nM * nN * nZ; G = G_; c = c_; }
    __host__ __device__ bool next(int i, Unit& u) const {
        const long L = (long)i * G + c; if (L >= nwg) return false;
        int wgid = (int)L; { const int q = nwg / NXCD, r = nwg % NXCD, xcd = wgid % NXCD, off = wgid / NXCD; wgid = (xcd < r ? xcd * (q + 1) : r * (q + 1) + (xcd - r) * q) + off; }
        const int per = nM * nN; u.zb = wgid / per; wgid -= u.zb * per;
        const int nig = WGM * nN, gid = wgid / nig, fm = gid * WGM, gsz = (nM - fm) < WGM ? (nM - fm) : WGM;
        u.pm = fm + ((wgid % nig) % gsz); u.pn = (wgid % nig) / gsz; u.pa = u.pm; return true;
    }
    __device__ __forceinline__ void a_ready(const Unit&) const {}
    __device__ __forceinline__ void done(const Unit&) const {}
};

__device__ __forceinline__ unsigned cvt_pk_bf16(float lo, float hi) { unsigned r; asm volatile("v_cvt_pk_bf16_f32 %0, %1, %2" : "=v"(r) : "v"(lo), "v"(hi)); return r; }
typedef int v4i_t __attribute__((ext_vector_type(4))); typedef int v8i_t __attribute__((ext_vector_type(8)));
__device__ __forceinline__ v8i_t cat8(bf16x8 a, bf16x8 b) { return __builtin_shufflevector(__builtin_bit_cast(v4i_t, a), __builtin_bit_cast(v4i_t, b), 0, 1, 2, 3, 4, 5, 6, 7); }
__device__ __forceinline__ unsigned pk_fp8x4(float a, float b, float c, float d) { int r = 0; r = __builtin_amdgcn_cvt_pk_fp8_f32(a, b, r, false); r = __builtin_amdgcn_cvt_pk_fp8_f32(c, d, r, true); return (unsigned)r; }
__device__ __forceinline__ float bf_lo(unsigned w) { return __uint_as_float(w << 16); }
__device__ __forceinline__ float bf_hi(unsigned w) { return __uint_as_float(w & 0xffff0000u); }
__device__ __forceinline__ float fast_sigmoid(float z) { return __builtin_amdgcn_rcpf(1.0f + __builtin_amdgcn_exp2f(-1.4426950408889634f * z)); }
constexpr float RMS_EPS = 1e-6f;
__device__ __forceinline__ float rstd16(const float* ssp, int row) { const f32x4* p = (const f32x4*)(ssp + (size_t)row * 16); const f32x4 a = p[0], b = p[1], c = p[2], d = p[3];
    const float s = (((a[0] + a[1]) + (a[2] + a[3])) + ((b[0] + b[1]) + (b[2] + b[3]))) + (((c[0] + c[1]) + (c[2] + c[3])) + ((d[0] + d[1]) + (d[2] + d[3])));
    return __builtin_amdgcn_rsqf(s * (1.0f / 1024.0f) + RMS_EPS); }

__device__ __forceinline__ void rstd8(const float* ssp, int row0, int fq, float (&rs)[8]) {
    f32x4 p[8];
#pragma unroll
    for (int i = 0; i < 8; ++i) p[i] = *(const f32x4*)(ssp + (size_t)(row0 + (i >> 2) * HALF + (i & 3) * 16) * 16 + 4 * fq);
#pragma unroll
    for (int i = 0; i < 8; ++i) { float q = (p[i][0] + p[i][1]) + (p[i][2] + p[i][3]); q += __shfl_xor(q, 16); q += __shfl_xor(q, 32); rs[i] = __builtin_amdgcn_rsqf(q * (1.0f / 1024.0f) + RMS_EPS); }
}
__device__ __forceinline__ u32x4 pack8(const f32x4 v0, const f32x4 v1) { u32x4 w; w.x = cvt_pk_bf16(v0[0], v0[1]); w.y = cvt_pk_bf16(v0[2], v0[3]); w.z = cvt_pk_bf16(v1[0], v1[1]); w.w = cvt_pk_bf16(v1[2], v1[3]); return w; }

struct EpiInProj0 {
    static constexpr bool PERM = true, AFTER_DRAIN = false;
    const float* ss; bf16_t* uext; bf16_t* qkv; float qscale;
    __device__ __forceinline__ void operator()(const f32x4 (&acc)[2][2][4][2], const Unit& u, int wr, int wc, int fr, int fq) const {
        const int row0 = u.pm * BM + wr * 64 + fr; float rsa[8]; rstd8(ss, row0, fq, rsa);
#pragma unroll
        for (int ai = 0; ai < 2; ++ai)
#pragma unroll
            for (int m = 0; m < 4; ++m) { const int row = row0 + ai * HALF + m * 16; const float rs = rsa[ai * 4 + m];
#pragma unroll
                for (int bj = 0; bj < 2; ++bj) { const int col0 = u.pn * BM + bj * HALF + wc * 32 + 8 * fq;
                    float sc = rs; bf16_t* dst;
                    if (u.pn < 2) dst = uext + ((size_t)(col0 >> 4) * 512 + (row >> 5)) * 640 + (row & 31) * 16 + (col0 & 15);
                    else { const int c = col0 - 512; if (c < 512) sc *= qscale; dst = qkv + (size_t)row * 1536 + c; }
                    *(u32x4*)dst = pack8(acc[ai][bj][m][0] * sc, acc[ai][bj][m][1] * sc); } }
    }
};
struct EpiS5State {
    static constexpr bool PERM = false, AFTER_DRAIN = false;
    float* sloc;
    __device__ __forceinline__ void operator()(const f32x4 (&acc)[2][2][4][2], const Unit& u, int wr, int wc, int fr, int fq) const {
        const int row0 = u.pm * BM + wr * 64 + fr, col0 = wc * 32 + 4 * fq;
#pragma unroll
        for (int ai = 0; ai < 2; ++ai)
#pragma unroll
            for (int m = 0; m < 4; ++m) { float* rowp = sloc + ((size_t)u.zb * 512 + row0 + ai * HALF + m * 16) * 128 + col0;
#pragma unroll
                for (int n = 0; n < 2; ++n) *(f32x4*)(rowp + n * 16) = acc[ai][0][m][n]; }
    }
};
__device__ __forceinline__ float gelu_tanh(float x) { const float a = x * (1.0f + 0.044715f * x * x); return x * __builtin_amdgcn_rcpf(1.0f + __builtin_amdgcn_exp2f(-2.302208198f * a)); }
struct EpiS5Y {
    static constexpr bool PERM = true, AFTER_DRAIN = false;
    bf16_t* yg;
    __device__ __forceinline__ void operator()(const f32x4 (&acc)[2][2][4][2], const Unit& u, int wr, int wc, int fr, int fq) const {
        const int row0 = u.pm * BM + wr * 64 + fr;
#pragma unroll
        for (int ai = 0; ai < 2; ++ai)
#pragma unroll
            for (int m = 0; m < 4; ++m) { const int chunk = row0 + ai * HALF + m * 16;
#pragma unroll
                for (int bj = 0; bj < 2; ++bj) { const int col0 = u.pn * BM + bj * HALF + wc * 32 + 8 * fq; const int i = col0 >> 4, h0 = col0 & 15;
                    f32x4 v0 = acc[ai][bj][m][0], v1 = acc[ai][bj][m][1];
#pragma unroll
                    for (int e = 0; e < 4; ++e) { v0[e] = gelu_tanh(v0[e]); v1[e] = gelu_tanh(v1[e]); }
                    *(u32x4*)(yg + ((size_t)chunk * 32 + i) * 512 + u.zb * 16 + h0) = pack8(v0, v1); } }
    }
};
struct EpiGlu {
    static constexpr bool PERM = true, AFTER_DRAIN = false;
    const bf16_t* yg; const float* bias; bf16_t* mix;
    __device__ __forceinline__ void operator()(const f32x4 (&acc)[2][2][4][2], const Unit& u, int wr, int wc, int fr, int fq) const {
        const int row0 = u.pm * BM + wr * 64 + fr; u32x4 ywa[2][8];
#pragma unroll
        for (int bj = 0; bj < 2; ++bj)
#pragma unroll
            for (int i = 0; i < 8; ++i) ywa[bj][i] = *(const u32x4*)(yg + (size_t)(row0 + (i >> 2) * HALF + (i & 3) * 16) * 512 + u.pn * BM + bj * HALF + wc * 32 + 8 * fq);
#pragma unroll
        for (int bj = 0; bj < 2; ++bj) { const int col0 = u.pn * BM + bj * HALF + wc * 32 + 8 * fq;
            const f32x4 b0 = *(const f32x4*)(bias + col0), b1 = *(const f32x4*)(bias + col0 + 4);
#pragma unroll
            for (int ai = 0; ai < 2; ++ai)
#pragma unroll
                for (int m = 0; m < 4; ++m) { const int row = row0 + ai * HALF + m * 16;
                    const u32x4 yw = ywa[bj][ai * 4 + m];
                    f32x4 z0 = acc[ai][bj][m][0] + b0, z1 = acc[ai][bj][m][1] + b1, o0, o1;
                    o0[0] = bf_lo(yw.x) * fast_sigmoid(z0[0]); o0[1] = bf_hi(yw.x) * fast_sigmoid(z0[1]); o0[2] = bf_lo(yw.y) * fast_sigmoid(z0[2]); o0[3] = bf_hi(yw.y) * fast_sigmoid(z0[3]);
                    o1[0] = bf_lo(yw.z) * fast_sigmoid(z1[0]); o1[1] = bf_hi(yw.z) * fast_sigmoid(z1[1]); o1[2] = bf_lo(yw.w) * fast_sigmoid(z1[2]); o1[3] = bf_hi(yw.w) * fast_sigmoid(z1[3]);
                    *(u32x4*)(mix + (size_t)row * 1024 + col0) = pack8(o0, o1); } }
    }
};
struct EpiResid {
    static constexpr bool PERM = false, AFTER_DRAIN = false;
    const float* R; float* X; bf16_t* xb; float* ssq;
    __device__ __forceinline__ void operator()(const f32x4 (&acc)[2][2][4][2], const Unit& u, int wr, int wc, int fr, int fq) const {
        const int row0 = u.pm * BM + wr * 64 + fr, col0 = u.pn * BM + wc * 32 + 4 * fq;
#pragma unroll
        for (int ai = 0; ai < 2; ++ai) {
            f32x4 rv[4][2][2];
#pragma unroll
            for (int m = 0; m < 4; ++m)
#pragma unroll
                for (int bj = 0; bj < 2; ++bj)
#pragma unroll
                    for (int n = 0; n < 2; ++n) rv[m][bj][n] = *(const f32x4*)(R + (size_t)(row0 + ai * HALF + m * 16) * 1024 + col0 + bj * HALF + n * 16);
            asm volatile("" ::: "memory");
#pragma unroll
            for (int m = 0; m < 4; ++m) { const int row = row0 + ai * HALF + m * 16; const size_t off = (size_t)row * 1024 + col0; float s = 0.f;
#pragma unroll
                for (int bj = 0; bj < 2; ++bj)
#pragma unroll
                    for (int n = 0; n < 2; ++n) { const f32x4 x = rv[m][bj][n] + acc[ai][bj][m][n];
                        *(f32x4*)(X + off + bj * HALF + n * 16) = x; s += (x[0] * x[0] + x[1] * x[1]) + (x[2] * x[2] + x[3] * x[3]);
                        u32x2 w; w.x = cvt_pk_bf16(x[0], x[1]); w.y = cvt_pk_bf16(x[2], x[3]); *(u32x2*)(xb + off + bj * HALF + n * 16) = w; }
                s += __shfl_xor(s, 16); s += __shfl_xor(s, 32);
                if (fq == 0) ssq[(size_t)row * 16 + u.pn * 4 + wc] = s; }
            asm volatile("" ::: "memory"); }
    }
};
template <bool RS_IS_SSQ> struct EpiSwiGlu {
    static constexpr bool PERM = true, AFTER_DRAIN = false;
    const float* rsv; bf16_t* H; int ldh;
    __device__ __forceinline__ void operator()(const f32x4 (&acc)[2][2][4][2], const Unit& u, int wr, int wc, int fr, int fq) const {
        const int row0 = u.pm * BM + wr * 64 + fr, col0 = u.pn * HALF + wc * 32 + 8 * fq; float rsa[8];
        if (RS_IS_SSQ) rstd8(rsv, row0, fq, rsa);
        else {
#pragma unroll
            for (int i = 0; i < 8; ++i) rsa[i] = rsv[row0 + (i >> 2) * HALF + (i & 3) * 16]; }
#pragma unroll
        for (int ai = 0; ai < 2; ++ai)
#pragma unroll
            for (int m = 0; m < 4; ++m) { const int row = row0 + ai * HALF + m * 16; const float rs = rsa[ai * 4 + m];
                f32x4 o[2];
#pragma unroll
                for (int n = 0; n < 2; ++n)
#pragma unroll
                    for (int e = 0; e < 4; ++e) { const float g = acc[ai][0][m][n][e] * rs, up = acc[ai][1][m][n][e] * rs; o[n][e] = g * fast_sigmoid(g) * up; }
                *(u32x4*)(H + (size_t)row * ldh + col0) = pack8(o[0], o[1]); }
    }
};
struct EpiSwiGluFp8 {
    static constexpr bool PERM = true, AFTER_DRAIN = false;
    const float* rsv; unsigned char* H; int ldh;
    __device__ __forceinline__ void operator()(const f32x4 (&acc)[2][2][4][2], const Unit& u, int wr, int wc, int fr, int fq) const {
        const int row0 = u.pm * BM + wr * 64 + fr, col0 = u.pn * HALF + wc * 32 + 8 * fq; float rsa[8];
#pragma unroll
        for (int i = 0; i < 8; ++i) rsa[i] = rsv[u.pa * BM + wr * 64 + fr + (i >> 2) * HALF + (i & 3) * 16];
#pragma unroll
        for (int ai = 0; ai < 2; ++ai)
#pragma unroll
            for (int m = 0; m < 4; ++m) { const int row = row0 + ai * HALF + m * 16; const float rs = rsa[ai * 4 + m];
                f32x4 o[2];
#pragma unroll
                for (int n = 0; n < 2; ++n)
#pragma unroll
                    for (int e = 0; e < 4; ++e) { const float g = acc[ai][0][m][n][e] * rs, up = acc[ai][1][m][n][e] * rs; o[n][e] = g * fast_sigmoid(g) * up; }
                u32x2 w; w.x = pk_fp8x4(o[0][0], o[0][1], o[0][2], o[0][3]); w.y = pk_fp8x4(o[1][0], o[1][1], o[1][2], o[1][3]);
                *(u32x2*)(H + (size_t)row * ldh + col0) = w; }
    }
};
struct EpiInProj1 {
    static constexpr bool PERM = true, AFTER_DRAIN = false;
    const float* ss; bf16_t* qkv; float qscale;
    unsigned* kn;
    __device__ __forceinline__ void operator()(const f32x4 (&acc)[2][2][4][2], const Unit& u, int wr, int wc, int fr, int fq) const {
        const int row0 = u.pm * BM + wr * 64 + fr; const float qs = (u.pn < 4) ? qscale : 1.0f; float rsa[8]; rstd8(ss, row0, fq, rsa);
#pragma unroll
        for (int ai = 0; ai < 2; ++ai)
#pragma unroll
            for (int m = 0; m < 4; ++m) { const int row = row0 + ai * HALF + m * 16; const float sc = rsa[ai * 4 + m] * qs;
#pragma unroll
                for (int bj = 0; bj < 2; ++bj) { const int col0 = (u.pn & 3) * BM + bj * HALF + wc * 32 + 8 * fq;
                    const f32x4 v0 = acc[ai][bj][m][0] * sc, v1 = acc[ai][bj][m][1] * sc;
                    *(u32x4*)(qkv + (size_t)(u.pn >> 2) * (16384 * 1024) + (size_t)row * 1024 + col0) = pack8(v0, v1);
                    if ((u.pn >> 2) == 1) {
                        float q = ((v0[0] * v0[0] + v0[1] * v0[1]) + (v0[2] * v0[2] + v0[3] * v0[3])) + ((v1[0] * v1[0] + v1[1] * v1[1]) + (v1[2] * v1[2] + v1[3] * v1[3]));
                        q += __shfl_xor(q, 16); q += __shfl_xor(q, 32);
                        q = fmaxf(q, __shfl_xor(q, 1)); q = fmaxf(q, __shfl_xor(q, 2)); q = fmaxf(q, __shfl_xor(q, 4)); q = fmaxf(q, __shfl_xor(q, 8));
                        if (fr == 0 && fq == 0) { const int head = (u.pn & 3) * 4 + bj * 2 + (wc >> 1), bb = row >> 13, tile = (row & 8191) >> 6;
                            atomicMax(kn + ((size_t)(bb * 16 + head) * 128 + tile) * 2 + (wc & 1), __float_as_uint(q * 1.01f)); } } } }
    }
};
struct EpiStoreBf16 {
    static constexpr bool PERM = true, AFTER_DRAIN = false;
    bf16_t* O; int ldc;
    __device__ __forceinline__ void operator()(const f32x4 (&acc)[2][2][4][2], const Unit& u, int wr, int wc, int fr, int fq) const {
        const int row0 = u.pm * BM + wr * 64 + fr;
#pragma unroll
        for (int ai = 0; ai < 2; ++ai)
#pragma unroll
            for (int m = 0; m < 4; ++m) { const int row = row0 + ai * HALF + m * 16;
#pragma unroll
                for (int bj = 0; bj < 2; ++bj) { const int col0 = u.pn * BM + bj * HALF + wc * 32 + 8 * fq;
                    *(u32x4*)(O + (size_t)row * ldc + col0) = pack8(acc[ai][bj][m][0], acc[ai][bj][m][1]); } }
    }
};

template <bool F8> struct Frag { bf16x8 k[2]; };
template <> struct Frag<true> { v8i_t v; };
template <class Epi, class Sched, bool ALIGN_EPI = false, bool SP2 = false, bool FP8 = false>
__device__ __forceinline__ void gemm_phase(PG8_LAS unsigned char* lds, const Gemm g, const Sched& S, const Epi& E) {
    int tid_ = threadIdx.x; asm volatile("" : "+v"(tid_));
    const int tid = tid_, wid = __builtin_amdgcn_readfirstlane(tid >> 6), lane = tid & 63, wr = wid >> 2, wc = wid & 3, fr = lane & 15, fq = lane >> 4;
    const int K = g.K, nt = K / BK;
    unsigned voffA[2], voffB[2];
#pragma unroll
    for (int i = 0; i < 2; ++i) { int R, C; stage_rc(tid * 16 + i * 8192, R, C); const int Rb = Epi::PERM ? ((R & ~31) + perm32(R & 31)) : R;
        voffA[i] = (unsigned)(R * g.lda + C) * 2u; voffB[i] = (unsigned)(Rb * g.ldb + C) * 2u; }
    const size_t kstep = (size_t)(BK * 2);
    const size_t hstepA = (size_t)HALF * g.lda * 2, hstepB = (size_t)HALF * g.ldb * 2;
    const size_t tstepA = 2 * hstepA, tstepB = 2 * hstepB;
    const unsigned ldsw = (unsigned)wid * 1024u;
    const int aoff = lds_byte(wr * 64 + fr, fq * 8), boff = lds_byte(wc * 32 + fr, fq * 8);
#define PG8_SA(b, h) (((b) * 2 + (h)) * HTB)
#define PG8_SB(b, h) ((4 + (b) * 2 + (h)) * HTB)
#define PG8_STAGE(bufoff, gbase, voff) do { _Pragma("unroll") for (int _i = 0; _i < 2; ++_i) \
        __builtin_amdgcn_global_load_lds((const unsigned*)((const char*)(gbase) + (voff)[_i]), (PG8_LAS unsigned*)(lds + (bufoff) + ldsw + _i * 8192), 16, 0, 0); } while (0)
    const PG8_LAS unsigned char* ldsA_ = lds + aoff; const PG8_LAS unsigned char* ldsB_ = lds + 4 * HTB + boff; asm volatile("" : "+v"(ldsA_), "+v"(ldsB_));
#define PG8_RDA(off) (*(const PG8_LAS bf16x8*)(ldsA_ + (off)))
#define PG8_RDB(off) (*(const PG8_LAS bf16x8*)(ldsB_ + (off)))
#define PG8_LDA(dst, b, h) do { _Pragma("unroll") for (int m = 0; m < 4; ++m) { if constexpr (FP8) dst[m].v = cat8(PG8_RDA(PG8_SA(b, h) + m * 2048), PG8_RDA(PG8_SA(b, h) + m * 2048 + 1024)); \
        else { dst[m].k[0] = PG8_RDA(PG8_SA(b, h) + m * 2048); dst[m].k[1] = PG8_RDA(PG8_SA(b, h) + m * 2048 + 1024); } } } while (0)
#define PG8_LDB(dst, b, h) do { _Pragma("unroll") for (int n = 0; n < 2; ++n) { if constexpr (FP8) dst[n].v = cat8(PG8_RDB(PG8_SB(b, h) - 4 * HTB + n * 2048), PG8_RDB(PG8_SB(b, h) - 4 * HTB + n * 2048 + 1024)); \
        else { dst[n].k[0] = PG8_RDB(PG8_SB(b, h) - 4 * HTB + n * 2048); dst[n].k[1] = PG8_RDB(PG8_SB(b, h) - 4 * HTB + n * 2048 + 1024); } } } while (0)
#define PG8_MMA(ai, bj, At, Bt) do { __builtin_amdgcn_s_setprio(1); _Pragma("unroll") for (int m = 0; m < 4; ++m) _Pragma("unroll") for (int n = 0; n < 2; ++n) { \
        if constexpr (FP8) { asm volatile("v_mfma_scale_f32_16x16x128_f8f6f4 %0, %1, %2, %0, %3, %4 op_sel_hi:[0,0,0]" : "+v"(acc[ai][bj][m][n]) : "v"(Bt[n].v), "v"(At[m].v), "v"(sclB_), "v"(sclA_)); } \
        else { _Pragma("unroll") for (int k = 0; k < 2; ++k) acc[ai][bj][m][n] = __builtin_amdgcn_mfma_f32_16x16x32_bf16(Bt[n].k[k], At[m].k[k], acc[ai][bj][m][n], 0, 0, 0); } } __builtin_amdgcn_s_setprio(0); } while (0)
#define PG8_WAIT_V(n) asm volatile("s_waitcnt vmcnt(" #n ")" ::: "memory")
#define PG8_WAIT_L(n) asm volatile("s_waitcnt lgkmcnt(" #n ")" ::: "memory")
#define PG8_BAR __builtin_amdgcn_s_barrier()
#define PG8_SCHED __builtin_amdgcn_sched_barrier(0)
    Unit cur, nxt; int ui = 0;
    if (!S.next(0, cur)) return;
    f32x4 acc[2][2][4][2];
#pragma unroll
    for (int a = 0; a < 2; ++a)
#pragma unroll
        for (int b = 0; b < 2; ++b)
#pragma unroll
            for (int m = 0; m < 4; ++m)
#pragma unroll
                for (int n = 0; n < 2; ++n) acc[a][b][m][n] = (f32x4){0.f, 0.f, 0.f, 0.f};
    Frag<FP8> At[4], B0[2], B1[2];
    int sclB_ = 0x79797979, sclA_ = 0x7f7f7f7f; asm volatile("" : "+v"(sclB_), "+v"(sclA_));
    const char* cA = (const char*)g.A + (size_t)cur.zb * g.zA + (size_t)cur.pa * tstepA; const char* cB = (const char*)g.Bt + (size_t)cur.zb * g.zB + (size_t)cur.pn * tstepB;
    S.a_ready(cur);
    if constexpr (SP2) {
        PG8_STAGE(PG8_SB(0, 0), cB, voffB); PG8_STAGE(PG8_SB(0, 1), cB + hstepB, voffB); PG8_STAGE(PG8_SA(0, 0), cA, voffA); PG8_STAGE(PG8_SA(0, 1), cA + hstepA, voffA);
        if (wr == 1) PG8_BAR;
        PG8_WAIT_V(2); PG8_BAR;
        PG8_STAGE(PG8_SB(1, 0), cB + kstep, voffB); PG8_STAGE(PG8_SA(1, 0), cA + kstep, voffA); PG8_STAGE(PG8_SB(1, 1), cB + hstepB + kstep, voffB);
        PG8_WAIT_V(6); PG8_BAR;
    } else {
        PG8_STAGE(PG8_SB(0, 0), cB, voffB); PG8_STAGE(PG8_SA(0, 0), cA, voffA); PG8_STAGE(PG8_SB(0, 1), cB + hstepB, voffB); PG8_STAGE(PG8_SA(0, 1), cA + hstepA, voffA);
        if (wr == 1) PG8_BAR;
        PG8_WAIT_V(4); PG8_BAR;
        PG8_STAGE(PG8_SB(1, 0), cB + kstep, voffB); PG8_STAGE(PG8_SA(1, 0), cA + kstep, voffA); PG8_STAGE(PG8_SB(1, 1), cB + hstepB + kstep, voffB);
        PG8_WAIT_V(6); PG8_BAR;
    }
    for (;;) {
        const bool has_next = S.next(ui + 1, nxt);
        const char* nA = has_next ? (const char*)g.A + (size_t)nxt.zb * g.zA + (size_t)nxt.pa * tstepA : cA; const char* nB = has_next ? (const char*)g.Bt + (size_t)nxt.zb * g.zB + (size_t)nxt.pn * tstepB : cB;
#pragma unroll 1
        for (int t = 0; t < nt; t += 2) {
            const bool last = (t == nt - 2);
            const char* a1 = cA + (size_t)(t + 1) * kstep;
            const char* a2 = last ? nA : cA + (size_t)(t + 2) * kstep; const char* b2 = last ? nB : cB + (size_t)(t + 2) * kstep;
            const char* a3 = a2 + kstep; const char* b3 = b2 + kstep;
            if (last && has_next) S.a_ready(nxt);
            if constexpr (SP2) {
            PG8_LDB(B0, 0, 0); PG8_LDB(B1, 0, 1); PG8_SCHED; PG8_LDA(At, 0, 0); PG8_STAGE(PG8_SA(1, 1), a1 + hstepA, voffA);
            PG8_WAIT_V(8); PG8_WAIT_L(0); PG8_BAR; PG8_MMA(0, 0, At, B0); PG8_MMA(0, 1, At, B1); PG8_BAR; PG8_SCHED;
            PG8_LDA(At, 0, 1); PG8_STAGE(PG8_SB(0, 0), b2, voffB); PG8_STAGE(PG8_SB(0, 1), b2 + hstepB, voffB); PG8_STAGE(PG8_SA(0, 0), a2, voffA);
            PG8_WAIT_V(8); PG8_WAIT_L(0); PG8_BAR; PG8_MMA(1, 0, At, B0); PG8_MMA(1, 1, At, B1); PG8_BAR; PG8_SCHED;
            PG8_LDB(B0, 1, 0); PG8_LDB(B1, 1, 1); PG8_SCHED; PG8_LDA(At, 1, 0); PG8_STAGE(PG8_SA(0, 1), a2 + hstepA, voffA);
            PG8_WAIT_V(8); PG8_WAIT_L(0); PG8_BAR; PG8_MMA(0, 0, At, B0); PG8_MMA(0, 1, At, B1); PG8_BAR; PG8_SCHED;
            PG8_LDA(At, 1, 1); PG8_STAGE(PG8_SB(1, 0), b3, voffB); PG8_STAGE(PG8_SB(1, 1), b3 + hstepB, voffB); PG8_STAGE(PG8_SA(1, 0), a3, voffA);
            PG8_WAIT_V(8); PG8_WAIT_L(0); PG8_BAR; PG8_MMA(1, 0, At, B0); PG8_MMA(1, 1, At, B1); PG8_BAR; PG8_SCHED;
            } else {
            PG8_LDB(B0, 0, 0); PG8_SCHED; PG8_LDA(At, 0, 0); PG8_STAGE(PG8_SA(1, 1), a1 + hstepA, voffA);
            PG8_WAIT_L(8); PG8_BAR; PG8_WAIT_L(0); PG8_MMA(0, 0, At, B0); PG8_BAR; PG8_SCHED;
            PG8_LDB(B1, 0, 1); PG8_STAGE(PG8_SB(0, 0), b2, voffB);
            PG8_BAR; PG8_WAIT_L(0); PG8_MMA(0, 1, At, B1); PG8_BAR;
            PG8_LDA(At, 0, 1); PG8_STAGE(PG8_SA(0, 0), a2, voffA);
            PG8_BAR; PG8_WAIT_L(0); PG8_MMA(1, 0, At, B0); PG8_BAR; PG8_SCHED;
            PG8_STAGE(PG8_SB(0, 1), b2 + hstepB, voffB);
            PG8_WAIT_V(6); PG8_BAR; PG8_MMA(1, 1, At, B1); PG8_BAR;
            PG8_LDB(B0, 1, 0); PG8_SCHED; PG8_LDA(At, 1, 0); PG8_STAGE(PG8_SA(0, 1), a2 + hstepA, voffA);
            PG8_WAIT_L(8); PG8_BAR; PG8_WAIT_L(0); PG8_MMA(0, 0, At, B0); PG8_BAR; PG8_SCHED;
            PG8_LDB(B1, 1, 1); PG8_STAGE(PG8_SB(1, 0), b3, voffB);
            PG8_BAR; PG8_WAIT_L(0); PG8_MMA(0, 1, At, B1); PG8_BAR;
            PG8_LDA(At, 1, 1); PG8_STAGE(PG8_SA(1, 0), a3, voffA);
            PG8_BAR; PG8_WAIT_L(0); PG8_MMA(1, 0, At, B0); PG8_BAR; PG8_SCHED;
            PG8_STAGE(PG8_SB(1, 1), b3 + hstepB, voffB);
            PG8_WAIT_V(6); PG8_BAR; PG8_MMA(1, 1, At, B1); PG8_BAR;
            }
        }
        if constexpr (ALIGN_EPI) { if (wr == 0) PG8_BAR; }
        if constexpr (FP8) asm volatile("s_nop 15\n\ts_nop 15" ::: "memory");
        if constexpr (!Epi::AFTER_DRAIN) { int fr_ = fr, fq_ = fq; asm volatile("" : "+v"(fr_), "+v"(fq_));
            E(acc, cur, wr, wc, fr_, fq_); S.done(cur); }
        if (!has_next) break;
#pragma unroll
        for (int a = 0; a < 2; ++a)
#pragma unroll
            for (int b = 0; b < 2; ++b)
#pragma unroll
                for (int m = 0; m < 4; ++m)
#pragma unroll
                    for (int n = 0; n < 2; ++n) acc[a][b][m][n] = (f32x4){0.f, 0.f, 0.f, 0.f};
        cur = nxt; cA = nA; cB = nB; ++ui;
        if constexpr (ALIGN_EPI) { if (wr == 1) PG8_BAR; }
    }
    PG8_WAIT_V(0);
    if constexpr (!ALIGN_EPI) { if (wr == 0) PG8_BAR; }
    PG8_BAR;
    if constexpr (Epi::AFTER_DRAIN) { E.fused(acc, cur, wr, wc, fr, fq, lds, wid, lane); S.done(cur); }
#undef PG8_SA
#undef PG8_SB
#undef PG8_STAGE
#undef PG8_LDA
#undef PG8_RDA
#undef PG8_RDB
#undef PG8_LDB
#undef PG8_MMA
#undef PG8_WAIT_V
#undef PG8_WAIT_L
#undef PG8_BAR
#undef PG8_SCHED
}
}

#include <hip/hip_bf16.h>
#include <cmath>
namespace attn_body {
using bf16=__hip_bfloat16;
using bf16x8=__attribute__((ext_vector_type(8)))short;
using s16x4=__attribute__((ext_vector_type(4)))short;
using f32x16=__attribute__((ext_vector_type(16)))float;
using u32x4=__attribute__((ext_vector_type(4)))unsigned;
constexpr int BATCH=2,NHEAD=16,SEQ=8192,D=64,DM=NHEAD*D;
constexpr int NW=8,QBLK=32,QB=QBLK*NW,KVBLK=64,NQB=SEQ/QB;
constexpr int ATTN_PITCH=DM, ATTN_UNIT_ROWS=QB;
__device__ __forceinline__ int crow(int r,int hi){return (r&3)+8*(r>>2)+4*hi;}
#define SBAR() __builtin_amdgcn_sched_barrier(0)
__device__ __forceinline__ void cmask(f32x16&p0,f32x16&p1,int jb,int qrel,int hi){
  const float NEG=-INFINITY; int kb=64*jb+4*hi;
  #pragma unroll
  for(int r=0;r<16;++r){int kv=kb+(r&3)+8*(r>>2); if(kv>qrel)p0[r]=NEG; if(kv+32>qrel)p1[r]=NEG;}
}

constexpr int NSLOT=3, SLOTB=8192;
constexpr int LDS_K=0, LDS_V=NSLOT*SLOTB, LDS_WS=2*NSLOT*SLOTB, LDS_OST=LDS_WS+NW*64*4, LDS_NB=LDS_OST+NW*4096  , LDS_PK=LDS_NB+32768+64  , LDS_BYTES=LDS_PK+1024;
constexpr float C2=0.125f*1.4426950408889634f;
__device__ __forceinline__ void glds16(const void*gsrc,unsigned lds_dst){unsigned keep;
  asm volatile("s_mov_b32 %0, m0\n\ts_mov_b32 m0, %2\n\ts_nop 0\n\tglobal_load_lds_dwordx4 %1, off\n\ts_mov_b32 m0, %0":"=&s"(keep):"v"(gsrc),"s"(lds_dst):"memory");}
__device__ __forceinline__ float max3f(float a,float b,float c){float r;asm("v_max3_f32 %0, %1, %2, %3":"=v"(r):"v"(a),"v"(b),"v"(c));return r;}
__device__ __forceinline__ float max2f(float a,float b){float r;asm("v_max_f32_e32 %0, %1, %2":"=v"(r):"v"(a),"v"(b));return r;}
__device__ __forceinline__ float fadd_s(float a,float b){float r;asm("v_add_f32_e32 %0, %1, %2":"=v"(r):"v"(a),"v"(b));return r;}
__device__ __forceinline__ float fsub_s(float a,float b){float r;asm("v_sub_f32_e32 %0, %1, %2":"=v"(r):"v"(a),"v"(b));return r;}
typedef float f32x2_t __attribute__((ext_vector_type(2))); typedef __bf16 bf16x2_t __attribute__((ext_vector_type(2)));
__device__ __forceinline__ unsigned cvtpk_s(float lo,float hi){f32x2_t v={lo,hi};bf16x2_t b=__builtin_convertvector(v,bf16x2_t);return __builtin_bit_cast(unsigned,b);}
#define WAIT_BAR(N) asm volatile("s_waitcnt vmcnt(" #N ") lgkmcnt(0)\n\ts_barrier":::"memory")

__device__ __forceinline__ void qkt(f32x16&p0,f32x16&p1,const char*Kslot,const bf16x8*qr,const f32x16&negm,int r32,int hi){
  const char*kb=Kslot+hi*1024+r32*16;
  #pragma unroll
  for(int d0=0;d0<4;++d0){
    const bf16x8 b0=*reinterpret_cast<const bf16x8*>(kb+d0*2048);
    const bf16x8 b1=*reinterpret_cast<const bf16x8*>(kb+d0*2048+512);
    if(d0==0){p0=__builtin_amdgcn_mfma_f32_32x32x16_bf16(b0,qr[0],negm,0,0,0);p1=__builtin_amdgcn_mfma_f32_32x32x16_bf16(b1,qr[0],negm,0,0,0);}
    else{p0=__builtin_amdgcn_mfma_f32_32x32x16_bf16(b0,qr[d0],p0,0,0,0);p1=__builtin_amdgcn_mfma_f32_32x32x16_bf16(b1,qr[d0],p1,0,0,0);}}
}
typedef __attribute__((address_space(3))) const char* lds_cptr;
typedef short v4i16_t __attribute__((ext_vector_type(4)));
__device__ __forceinline__ void kload8(bf16x8*kf,lds_cptr kp){
  kf[0]=*(const __attribute__((address_space(3))) bf16x8*)(kp);      kf[1]=*(const __attribute__((address_space(3))) bf16x8*)(kp+512);
  kf[2]=*(const __attribute__((address_space(3))) bf16x8*)(kp+2048); kf[3]=*(const __attribute__((address_space(3))) bf16x8*)(kp+2560);
  kf[4]=*(const __attribute__((address_space(3))) bf16x8*)(kp+4096); kf[5]=*(const __attribute__((address_space(3))) bf16x8*)(kp+4608);
  kf[6]=*(const __attribute__((address_space(3))) bf16x8*)(kp+6144); kf[7]=*(const __attribute__((address_space(3))) bf16x8*)(kp+6656);
}
__device__ __forceinline__ void kload2(bf16x8*kf,lds_cptr kp,int j){ kf[2*j]=*(const __attribute__((address_space(3))) bf16x8*)(kp+j*2048); kf[2*j+1]=*(const __attribute__((address_space(3))) bf16x8*)(kp+j*2048+512); }
__device__ __forceinline__ s16x4 vtr(lds_cptr p){ return __builtin_bit_cast(s16x4,__builtin_amdgcn_ds_read_tr16_b64_v4i16((__attribute__((address_space(3))) v4i16_t*)p)); }
__device__ __forceinline__ float rowmax(const f32x16&p0,const f32x16&p1){
  float a=max3f(p0[0],p0[1],p1[0]),b=max3f(p0[2],p0[3],p1[1]);a=max3f(a,p1[2],p1[3]);
  #pragma unroll
  for(int r=4;r<16;r+=4){a=max3f(a,p0[r],p0[r+1]);b=max3f(b,p0[r+2],p0[r+3]);a=max3f(a,p1[r],p1[r+1]);b=max3f(b,p1[r+2],p1[r+3]);}
  const float m=max2f(a,b);
  auto rr=__builtin_amdgcn_permlane32_swap(__float_as_uint(m),__float_as_uint(m),false,false);
  return max2f(__uint_as_float(rr[0]),__uint_as_float(rr[1]));
}
__device__ __forceinline__ void pv(f32x16*o,int vb,bf16x8 pa0,bf16x8 pa1,bf16x8 pa2,bf16x8 pa3){
  #pragma unroll
  for(int d0=0;d0<2;++d0){s16x4 lo[4],hi[4];
    #pragma unroll
    for(int ks=0;ks<4;++ks){
      asm volatile("ds_read_b64_tr_b16 %0,%1 offset:%c2":"=&v"(lo[ks]):"v"(vb),"i"(d0*4096+ks*1024):"memory");
      asm volatile("ds_read_b64_tr_b16 %0,%1 offset:%c2":"=&v"(hi[ks]):"v"(vb),"i"(d0*4096+ks*1024+512):"memory");}
    asm volatile("s_waitcnt lgkmcnt(0)":::"memory");SBAR();
    #define PK(k) (bf16x8){lo[k][0],lo[k][1],lo[k][2],lo[k][3],hi[k][0],hi[k][1],hi[k][2],hi[k][3]}
    o[d0]=__builtin_amdgcn_mfma_f32_32x32x16_bf16(pa0,PK(0),o[d0],0,0,0);
    o[d0]=__builtin_amdgcn_mfma_f32_32x32x16_bf16(pa1,PK(1),o[d0],0,0,0);
    o[d0]=__builtin_amdgcn_mfma_f32_32x32x16_bf16(pa2,PK(2),o[d0],0,0,0);
    o[d0]=__builtin_amdgcn_mfma_f32_32x32x16_bf16(pa3,PK(3),o[d0],0,0,0);
    #undef PK
  }
}

typedef float f32x4_t __attribute__((ext_vector_type(4)));
__device__ __forceinline__ void fox_negcum(const float*logf,__attribute__((address_space(3))) float*ncum,__attribute__((address_space(3))) float*wtot,int tid){
  float loc[16];float s=0.f; const f32x4_t*lp=(const f32x4_t*)(logf+tid*16);
  #pragma unroll
  for(int j=0;j<4;++j){const f32x4_t v=lp[j]; s+=v[0];loc[4*j]=s; s+=v[1];loc[4*j+1]=s; s+=v[2];loc[4*j+2]=s; s+=v[3];loc[4*j+3]=s;}
  float inc=s;
  #pragma unroll
  for(int o=1;o<64;o<<=1){const float v=__shfl_up(inc,o); if((tid&63)>=o)inc+=v;}
  if((tid&63)==63)wtot[tid>>6]=inc;
  __syncthreads();
  float base=inc-s; for(int w=0;w<(tid>>6);++w)base+=wtot[w];
  #pragma unroll
  for(int j=0;j<4;++j){ f32x4_t o4; o4[0]=-(base+loc[4*j]);o4[1]=-(base+loc[4*j+1]);o4[2]=-(base+loc[4*j+2]);o4[3]=-(base+loc[4*j+3]); *(__attribute__((address_space(3))) f32x4_t*)(ncum+tid*16+4*j)=o4; }
  __syncthreads();
}
#ifndef ATTN_STORE16
#define ATTN_STORE16(p,v) (*(u32x4*)(p)=(v))
#endif
template<int THRL> __device__ __forceinline__ void attn_unit(int b,int h,int qb,const bf16*Q,const bf16*__restrict__ K,const bf16*__restrict__ V,bf16*O,char*shm,const float*logf_bh,const unsigned*kn_bh){
  int tid_=threadIdx.x; asm volatile("":"+v"(tid_)); const int tid=tid_,lane=tid&63,r32=lane&31,hi=lane>>5; const int wid=__builtin_amdgcn_readfirstlane(tid>>6);
  const long rowbase=(long)b*SEQ; const int q0=qb*QB;
  const bf16*Qw=Q+(rowbase+q0+wid*QBLK)*DM+h*D;
  const bf16*Kh=K+rowbase*DM+h*D,*Vh=V+rowbase*DM+h*D;
  const unsigned lds0=(unsigned)(uintptr_t)shm;
  float*wsf=(float*)(shm+LDS_WS)+wid*64;
  const bf16*ksrc=Kh+(long)lane*DM+wid*8;
  const bf16*vsrc=Vh+(long)(16*(wid&3)+(lane>>2))*DM+(wid>>2)*32+(lane&3)*8;
  const unsigned kdst=lds0+LDS_K+wid*1024, vdst=lds0+LDS_V+wid*1024;
  #define TIDX(t) (NTR-1-(t))
  #define DMA_K(t,slot) glds16(ksrc+(long)TIDX(t)*KVBLK*DM,(unsigned)__builtin_amdgcn_readfirstlane(kdst+(slot)))
  #define DMA_V(t,slot) glds16(vsrc+(long)TIDX(t)*KVBLK*DM,(unsigned)__builtin_amdgcn_readfirstlane(vdst+(slot)))
  const int vb0=(int)(lds0+LDS_V)+((lane>>4)&1)*32+(lane&3)*8+(4*hi+((lane&15)>>2))*64;
  const char*Kbase=shm+LDS_K; bf16x8 kf[8];
  const lds_cptr shm3=(lds_cptr)shm; const lds_cptr kp0=shm3+LDS_K+hi*1024+r32*16; const lds_cptr vp0=shm3+LDS_V+((lane>>4)&1)*32+(lane&3)*8+(4*hi+((lane&15)>>2))*64;
  const int NTR=(q0+QB)/KVBLK;
  const lds_cptr shm3b=(lds_cptr)shm;
  const __attribute__((address_space(3))) float* nb3=(const __attribute__((address_space(3))) float*)(shm3b+LDS_NB);
  fox_negcum(logf_bh,(__attribute__((address_space(3))) float*)(shm3b+LDS_NB),(__attribute__((address_space(3))) float*)(shm3b+LDS_NB+32768),tid);
  int NT;
  { __attribute__((address_space(3))) float* PK=(__attribute__((address_space(3))) float*)(shm3b+LDS_PK);
    __attribute__((address_space(3))) int* JX=(__attribute__((address_space(3))) int*)(shm3b+LDS_PK+512);
    float pk=0.f;
    if(tid<128){ const float a=__uint_as_float(kn_bh[2*tid]),c=__uint_as_float(kn_bh[2*tid+1]); pk=__builtin_sqrtf(a+c)*1.001f; }
    #pragma unroll
    for(int o_=1;o_<64;o_<<=1){const float v=__shfl_up(pk,o_); if((tid&63)>=o_)pk=__builtin_fmaxf(pk,v);}
    if(tid==63)PK[128]=pk;
    __syncthreads();
    if(tid>=64&&tid<128)pk=__builtin_fmaxf(pk,PK[128]);
    if(tid<128)PK[tid]=pk;
    const bf16*Krow=Kh+(long)(q0+wid*QBLK+r32)*DM+hi*8; const bf16*Qrow=Qw+(long)r32*DM+hi*8; float qq=0.f,qk=0.f;
    #pragma unroll
    for(int d0=0;d0<4;++d0){ const u32x4 qa=*reinterpret_cast<const u32x4*>(Qrow+d0*16), ka=*reinterpret_cast<const u32x4*>(Krow+d0*16);
      #pragma unroll
      for(int e=0;e<4;++e){ const float q0f=__uint_as_float(qa[e]<<16),q1f=__uint_as_float(qa[e]&0xffff0000u),k0f=__uint_as_float(ka[e]<<16),k1f=__uint_as_float(ka[e]&0xffff0000u);
        qq+=q0f*q0f+q1f*q1f; qk+=q0f*k0f+q1f*k1f; } }
    { auto r1=__builtin_amdgcn_permlane32_swap(__float_as_uint(qq),__float_as_uint(qq),false,false); qq=__uint_as_float(r1[0])+__uint_as_float(r1[1]);
      auto r2=__builtin_amdgcn_permlane32_swap(__float_as_uint(qk),__float_as_uint(qk),false,false); qk=__uint_as_float(r2[0])+__uint_as_float(r2[1]); }
    __syncthreads();
    const float qn=__builtin_sqrtf(qq)*1.001f, thr=qk+nb3[q0+wid*QBLK+r32]-152.f;
    int lo_=0,hi_=NTR;
    #pragma unroll 1
    for(int it=0;it<8;++it){ if(lo_<hi_){ const int mid=(lo_+hi_)>>1; const float f=qn*PK[mid]+nb3[64*mid+63]; if(f>=thr)hi_=mid; else lo_=mid+1; } }
    #pragma unroll
    for(int o_=1;o_<64;o_<<=1){const int v=__shfl_xor(lo_,o_); lo_=v<lo_?v:lo_;}
    if(lane==0)JX[wid]=lo_;
    __syncthreads();
    int j0=JX[0];
    #pragma unroll
    for(int w=1;w<8;++w){const int v=JX[w]; j0=v<j0?v:j0;}
    j0=__builtin_amdgcn_readfirstlane(j0);
    int nte=(NTR-j0+1)&~1; NT=nte<4?4:nte;
    __syncthreads();
  }
  #define BIASADD(P0,P1,t) do{ const __attribute__((address_space(3))) f32x4_t* bp_=(const __attribute__((address_space(3))) f32x4_t*)(nb3+TIDX(t)*64+4*hi); \
    const f32x4_t nm4_={-mhat,-mhat,-mhat,-mhat}; \
    _Pragma("unroll") for(int g_=0;g_<4;++g_){ const f32x4_t b0_=bp_[2*g_]+nm4_,b1_=bp_[2*g_+8]+nm4_; \
      P0[4*g_]+=b0_[0];P0[4*g_+1]+=b0_[1];P0[4*g_+2]+=b0_[2];P0[4*g_+3]+=b0_[3]; P1[4*g_]+=b1_[0];P1[4*g_+1]+=b1_[1];P1[4*g_+2]+=b1_[2];P1[4*g_+3]+=b1_[3]; } }while(0)
  DMA_K(0,0);DMA_V(0,0);DMA_K(1,SLOTB);
  bf16x8 qr[4];
  #pragma unroll
  for(int d0=0;d0<4;++d0)qr[d0]=*reinterpret_cast<const bf16x8*>(&Qw[(long)r32*DM+d0*16+hi*8]);
  float mhat=0.f,l_reg=0.f;f32x16 o[2];o[0]=f32x16{};o[1]=f32x16{};const f32x16 negm=f32x16{};
  const int qrel=wid*QBLK+r32;
  #define CMASK(P0,P1,t) do{ if((t)<4){ cmask(P0,P1,3-(t),qrel,hi); } }while(0)
  bool resc=false;
  #define START(P0,P1) do{ const float rm=rowmax(P0,P1); resc=false; \
    { const float dl=(rm>-3.0e38f)?rm:0.f; mhat=fadd_s(mhat,dl);     \
      _Pragma("unroll") for(int r=0;r<16;++r){P0[r]=fsub_s(P0[r],dl);P1[r]=fsub_s(P1[r],dl);} \
      } \
    _Pragma("unroll") for(int r=0;r<16;++r)P0[r]=__builtin_amdgcn_exp2f(P0[r]); }while(0)
  #define RESC() do{ if(resc){ asm volatile("s_waitcnt lgkmcnt(0)":::"memory"); \
      _Pragma("unroll") for(int d_=0;d_<2;++d_) _Pragma("unroll") for(int r=0;r<16;++r)o[d_][r]*=wsf[crow(r,hi)]; } }while(0)
  f32x16 pA0,pA1,pB0,pB1;
  int sl_prev=0,sl_cur=0,sl_next=SLOTB;
  #define ROT() do{sl_prev=sl_cur;sl_cur=sl_next;sl_next=(sl_next==(NSLOT-1)*SLOTB)?0:sl_next+SLOTB;}while(0)
  DMA_K(2,2*SLOTB);
  WAIT_BAR(3);
  qkt(pA0,pA1,Kbase,qr,negm,r32,hi);asm volatile("s_nop 15\n\ts_nop 7":"+v"(pA0),"+v"(pA1));BIASADD(pA0,pA1,0);CMASK(pA0,pA1,0);
  START(pA0,pA1);
  _Pragma("unroll") for(int r=0;r<16;++r)pA1[r]=__builtin_amdgcn_exp2f(pA1[r]);
  WAIT_BAR(0);
  DMA_K(3,0);DMA_V(1,SLOTB);
  ROT();
  kload8(kf,kp0+sl_cur);
  WAIT_BAR(2);
  s16x4 vlo[8],vhi[8]; u32x4 pw0,pw1,pw2,pw3;
  #define PKW(P,B) cvtpk_s(P[B],P[B+1])
  #define PAF(k) __builtin_bit_cast(bf16x8,pw##k)
  #define VFR(i) (bf16x8){vlo[i][0],vlo[i][1],vlo[i][2],vlo[i][3],vhi[i][0],vhi[i][1],vhi[i][2],vhi[i][3]}
  #define PIN(x) asm volatile("":"+v"(x))
  #define MX3(a,b,c) __builtin_fmaxf(__builtin_fmaxf((a),(b)),(c))
  #define GAPA(MF,A0,A1,A2,A3,W0,W1,PW) do{ MF; sacc+=A0; sacc+=A1; sacc+=A2; sacc+=A3; PIN(sacc); W0; W1; PIN(PW); SBAR(); }while(0)
  #define EX(v) __builtin_amdgcn_exp2f(v)
  #define GAPB(MF,X,B) do{ MF; X[B]=EX(X[B]); X[B+1]=EX(X[B+1]); X[B+2]=EX(X[B+2]); X[B+3]=EX(X[B+3]); PIN(X); SBAR(); }while(0)
  #define VRD(i) do{ vlo[i]=vtr(vp_+(((i)>>2)*4096+((i)&3)*1024)); vhi[i]=vtr(vp_+(((i)>>2)*4096+((i)&3)*1024+512)); }while(0)
  #define KRD(G,j) do{ if(G){ kload2(kf,kp0+sl_next,j); SBAR(); } }while(0)
  #define STEP(C0,C1,P0,P1,t,GK,GV,GL) do{ SBAR(); \
    const lds_cptr vp_=vp0+sl_prev; \
    VRD(0); SBAR(); float sacc=(P0[0]+P0[1]); \
    GAPA(C0=__builtin_amdgcn_mfma_f32_32x32x16_bf16(kf[0],qr[0],negm,0,0,0), P0[2],P0[3],P0[4],P0[5],     pw0[0]=PKW(P0,0), pw0[1]=PKW(P0,2), pw0); \
    VRD(4); SBAR(); GAPA(C1=__builtin_amdgcn_mfma_f32_32x32x16_bf16(kf[1],qr[0],negm,0,0,0), P0[6],P0[7],P0[8],P0[9],     pw0[2]=PKW(P0,4), pw0[3]=PKW(P0,6), pw0); \
    VRD(1); SBAR(); GAPA(C0=__builtin_amdgcn_mfma_f32_32x32x16_bf16(kf[2],qr[1],C0,0,0,0),   P0[10],P0[11],P0[12],P0[13], pw1[0]=PKW(P0,8), pw1[1]=PKW(P0,10), pw1); \
    VRD(5); SBAR(); GAPA(C1=__builtin_amdgcn_mfma_f32_32x32x16_bf16(kf[3],qr[1],C1,0,0,0),   P0[14],P0[15],P1[0],P1[1],   pw1[2]=PKW(P0,12),pw1[3]=PKW(P0,14), pw1); \
    VRD(2); SBAR(); GAPA(C0=__builtin_amdgcn_mfma_f32_32x32x16_bf16(kf[4],qr[2],C0,0,0,0),   P1[2],P1[3],P1[4],P1[5],     pw2[0]=PKW(P1,0), pw2[1]=PKW(P1,2), pw2); \
    VRD(6); SBAR(); GAPA(C1=__builtin_amdgcn_mfma_f32_32x32x16_bf16(kf[5],qr[2],C1,0,0,0),   P1[6],P1[7],P1[8],P1[9],     pw2[2]=PKW(P1,4), pw2[3]=PKW(P1,6), pw2); \
    VRD(3); SBAR(); GAPA(C0=__builtin_amdgcn_mfma_f32_32x32x16_bf16(kf[6],qr[3],C0,0,0,0),   P1[10],P1[11],P1[12],P1[13], pw3[0]=PKW(P1,8), pw3[1]=PKW(P1,10), pw3); \
    VRD(7); SBAR(); GAPA(C1=__builtin_amdgcn_mfma_f32_32x32x16_bf16(kf[7],qr[3],C1,0,0,0),   P1[14],P1[15],0.f,0.f,       pw3[2]=PKW(P1,12),pw3[3]=PKW(P1,14), pw3); \
    l_reg+=sacc; \
    if(GK){DMA_K((t)+3,sl_cur);} if(GV){DMA_V((t)+1,sl_next);} \
    BIASADD(C0,C1,t); CMASK(C0,C1,t); \
    { float a=MX3(C0[0],C0[1],C1[0]),b=MX3(C0[2],C0[3],C1[1]); a=MX3(a,C1[2],C1[3]); \
      _Pragma("unroll") for(int r=4;r<16;r+=4){a=MX3(a,C0[r],C0[r+1]);b=MX3(b,C0[r+2],C0[r+3]);a=MX3(a,C1[r],C1[r+1]);b=MX3(b,C1[r+2],C1[r+3]);} \
      float rm=__builtin_fmaxf(a,b); { auto rr=__builtin_amdgcn_permlane32_swap(__float_as_uint(rm),__float_as_uint(rm),false,false); rm=__builtin_fmaxf(__uint_as_float(rr[0]),__uint_as_float(rr[1])); } \
      resc=false; \
      if(__builtin_expect(__any(rm>(float)THRL),0)){ const float dl=__builtin_fmaxf(rm,0.f); mhat+=dl; \
        _Pragma("unroll") for(int r=0;r<16;++r){C0[r]-=dl;C1[r]-=dl;} \
        const float f=__builtin_amdgcn_exp2f(-dl); l_reg*=f; if(hi==0)wsf[r32]=f; resc=true; } } \
    SBAR(); \
    GAPB(o[0]=__builtin_amdgcn_mfma_f32_32x32x16_bf16(PAF(0),VFR(0),o[0],0,0,0), C0,0); \
    GAPB(o[1]=__builtin_amdgcn_mfma_f32_32x32x16_bf16(PAF(0),VFR(4),o[1],0,0,0), C0,4); \
    KRD(GL,0); GAPB(o[0]=__builtin_amdgcn_mfma_f32_32x32x16_bf16(PAF(1),VFR(1),o[0],0,0,0), C0,8); \
    KRD(GL,1); GAPB(o[1]=__builtin_amdgcn_mfma_f32_32x32x16_bf16(PAF(1),VFR(5),o[1],0,0,0), C0,12); \
    KRD(GL,2); GAPB(o[0]=__builtin_amdgcn_mfma_f32_32x32x16_bf16(PAF(2),VFR(2),o[0],0,0,0), C1,0); \
    KRD(GL,3); GAPB(o[1]=__builtin_amdgcn_mfma_f32_32x32x16_bf16(PAF(2),VFR(6),o[1],0,0,0), C1,4); \
    GAPB(o[0]=__builtin_amdgcn_mfma_f32_32x32x16_bf16(PAF(3),VFR(3),o[0],0,0,0), C1,8); \
    GAPB(o[1]=__builtin_amdgcn_mfma_f32_32x32x16_bf16(PAF(3),VFR(7),o[1],0,0,0), C1,12); \
    }while(0)
  int t=1;
  for(int it_=0;it_<2&&t+5<NT;++it_,t+=2){
    STEP(pB0,pB1,pA0,pA1,t,true,true,true);     WAIT_BAR(2); RESC(); ROT();
    STEP(pA0,pA1,pB0,pB1,t+1,true,true,true);   WAIT_BAR(2); RESC(); ROT();
  }
  #undef CMASK
  #define CMASK(P0,P1,t) do{}while(0)
  for(;t+5<NT;t+=2){
    STEP(pB0,pB1,pA0,pA1,t,true,true,true);     WAIT_BAR(2); RESC(); ROT();
    STEP(pA0,pA1,pB0,pB1,t+1,true,true,true);   WAIT_BAR(2); RESC(); ROT();
  }
  #undef CMASK
  #define CMASK(P0,P1,t) do{ if((t)<4){ cmask(P0,P1,3-(t),qrel,hi); } }while(0)
  #define ENDW(tt) do{ if((tt)+3<NT){WAIT_BAR(2);} else if((tt)+2<NT){WAIT_BAR(1);} else {WAIT_BAR(0);} }while(0)
  for(;t+1<NT;t+=2){
    STEP(pB0,pB1,pA0,pA1,t,(t+3<NT),(t+1<NT),(t+1<NT));       ENDW(t);   RESC(); ROT();
    STEP(pA0,pA1,pB0,pB1,t+1,(t+4<NT),(t+2<NT),(t+2<NT));     ENDW(t+1); RESC(); ROT();
  }
  STEP(pB0,pB1,pA0,pA1,NT-1,false,false,false); RESC();
  { float sacc=pB0[0]+pB0[1]; _Pragma("unroll") for(int r=2;r<16;++r)sacc+=pB0[r]; _Pragma("unroll") for(int r=0;r<16;++r)sacc+=pB1[r]; l_reg+=sacc;
    pw0=(u32x4){PKW(pB0,0),PKW(pB0,2),PKW(pB0,4),PKW(pB0,6)};pw1=(u32x4){PKW(pB0,8),PKW(pB0,10),PKW(pB0,12),PKW(pB0,14)};pw2=(u32x4){PKW(pB1,0),PKW(pB1,2),PKW(pB1,4),PKW(pB1,6)};pw3=(u32x4){PKW(pB1,8),PKW(pB1,10),PKW(pB1,12),PKW(pB1,14)};
    SBAR(); pv(o,vb0+sl_cur,PAF(0),PAF(1),PAF(2),PAF(3)); }
  #undef PKW
  #undef PAF
  #undef VFR
  #undef PIN
  #undef MX3
  #undef GAPA
  #undef GAPB
  #undef EX
  #undef VRD
  #undef KRD
  #undef STEP
  #undef ENDW
  {auto rr=__builtin_amdgcn_permlane32_swap(__float_as_uint(l_reg),__float_as_uint(l_reg),false,false);l_reg=__uint_as_float(rr[0])+__uint_as_float(rr[1]);}
  if(hi==0)wsf[32+r32]=l_reg;asm volatile("s_waitcnt lgkmcnt(0)":::"memory");
  float rli[16];
  #pragma unroll
  for(int r=0;r<16;++r)rli[r]=__builtin_amdgcn_rcpf(wsf[32+crow(r,hi)]);
  bf16*Ow=O+(rowbase+q0+wid*QBLK)*DM+h*D;
  { bf16*stg=(bf16*)(shm+LDS_OST)+wid*2048;
    #pragma unroll
    for(int r=0;r<16;++r){const int orow=crow(r,hi);
      #pragma unroll
      for(int d0=0;d0<2;++d0)stg[orow*64+d0*32+r32]=__float2bfloat16(o[d0][r]*rli[r]);}
    asm volatile("s_waitcnt lgkmcnt(0)":::"memory");
    #pragma unroll
    for(int i=0;i<4;++i){const int row=i*8+(lane>>3),ch=lane&7; const u32x4 v=*(const u32x4*)(stg+row*64+ch*8); ATTN_STORE16(Ow+(long)row*DM+ch*8,v);} }
  asm volatile("s_waitcnt lgkmcnt(0)\n\ts_barrier":::"memory");
  #undef BIASADD
  #undef TIDX
  #undef DMA_K
  #undef DMA_V
  #undef CMASK
  #undef START
  #undef RESC
  #undef ROT
}

template<int PITCH> __device__ __forceinline__ void sb_unit(int b,int h,int qb,const bf16*Q,const bf16*__restrict__ K,const bf16*__restrict__ V,bf16*O  ,char*shm){
  int tid_=threadIdx.x; asm volatile("":"+v"(tid_)); const int tid=tid_,lane=tid&63,r32=lane&31,hi=lane>>5; const int wid=__builtin_amdgcn_readfirstlane(tid>>6);
  const long rowbase=(long)b*SEQ; const int q0=qb*QB;
  const bf16*Qw=Q+(rowbase+q0+wid*QBLK)*PITCH+h*D;
  const bf16*Kh=K+rowbase*PITCH+h*D,*Vh=V+rowbase*PITCH+h*D;
  const unsigned lds0=(unsigned)(uintptr_t)shm;
  const bf16*ksrc=Kh+(long)lane*PITCH+wid*8;
  const bf16*vsrc=Vh+(long)(16*(wid&3)+(lane>>2))*PITCH+(wid>>2)*32+(lane&3)*8;
  const unsigned kdst=lds0+LDS_K+wid*1024, vdst=lds0+LDS_V+wid*1024;
  #define SB_DMA(t,slot) do{ glds16(ksrc+(long)(t)*KVBLK*PITCH,(unsigned)__builtin_amdgcn_readfirstlane(kdst+(slot))); glds16(vsrc+(long)(t)*KVBLK*PITCH,(unsigned)__builtin_amdgcn_readfirstlane(vdst+(slot))); }while(0)
  const int vb0=(int)(lds0+LDS_V)+((lane>>4)&1)*32+(lane&3)*8+(4*hi+((lane&15)>>2))*64;
  volatile __attribute__((address_space(3))) unsigned* fl=(volatile __attribute__((address_space(3))) unsigned*)((lds_cptr)shm+LDS_WS);
  const int NT=(q0+QB)/KVBLK; const int qrel=wid*QBLK+r32;
  SB_DMA(NT-1,0);
  bf16x8 qr[4];
  #pragma unroll
  for(int d0=0;d0<4;++d0)qr[d0]=*reinterpret_cast<const bf16x8*>(&Qw[(long)r32*PITCH+d0*16+hi*8]);
  f32x16 o[2];o[0]=f32x16{};o[1]=f32x16{}; const f32x16 zero16=f32x16{};
  float carry=0.f; const float m0=(hi==0)?1.f:0.f;
  int slot=0;
  for(int t=NT-1;t>=0;--t){
    WAIT_BAR(0);
    if(t<NT-1){ const int pb=((t+1)&1)*8; const unsigned a=fl[pb]&fl[pb+1]&fl[pb+2]&fl[pb+3]&fl[pb+4]&fl[pb+5]&fl[pb+6]&fl[pb+7]; if(__builtin_amdgcn_readfirstlane(a)!=0u)break; }
    if(t>0)SB_DMA(t-1,slot^SLOTB);
    f32x16 p0,p1; qkt(p0,p1,shm+LDS_K+slot,qr,zero16,r32,hi);
    if(t>=NT-4){ const int kb=64*(t-(NT-4))+4*hi;
      #pragma unroll
      for(int r=0;r<16;++r){const int kv=kb+(r&3)+8*(r>>2); if(kv>=qrel)p0[r]=-INFINITY; if(kv+32>=qrel)p1[r]=-INFINITY;} }
    f32x16 s0,s1;
    #pragma unroll
    for(int r=0;r<16;++r){ const float z=p0[r]; const float sp=__builtin_fmaxf(z,0.f)+__builtin_amdgcn_logf(1.f+__builtin_amdgcn_exp2f(-__builtin_fabsf(z))); s0[r]=sp; p0[r]=z-sp;
                           const float y=p1[r]; const float sq=__builtin_fmaxf(y,0.f)+__builtin_amdgcn_logf(1.f+__builtin_amdgcn_exp2f(-__builtin_fabsf(y))); s1[r]=sq; p1[r]=y-sq; }
    float lo[8],hv[8];
    #pragma unroll
    for(int i=0;i<8;++i){ const float mine=(i<4)?((s0[4*i]+s0[4*i+1])+(s0[4*i+2]+s0[4*i+3])):((s1[4*i-16]+s1[4*i-15])+(s1[4*i-14]+s1[4*i-13]));
      auto rr=__builtin_amdgcn_permlane32_swap(__float_as_uint(mine),__float_as_uint(mine),false,false); lo[i]=__uint_as_float(rr[0]); hv[i]=__uint_as_float(rr[1]); }
    float sp_=0.f;
    #pragma unroll
    for(int i=7;i>=0;--i){ const float base=carry-(sp_+m0*hv[i]);
      if(i<4){ float a=base; p0[4*i+3]=__builtin_amdgcn_exp2f(p0[4*i+3]+a); a-=s0[4*i+3]; p0[4*i+2]=__builtin_amdgcn_exp2f(p0[4*i+2]+a); a-=s0[4*i+2]; p0[4*i+1]=__builtin_amdgcn_exp2f(p0[4*i+1]+a); a-=s0[4*i+1]; p0[4*i]=__builtin_amdgcn_exp2f(p0[4*i]+a); }
      else   { const int j=4*i-16; float a=base; p1[j+3]=__builtin_amdgcn_exp2f(p1[j+3]+a); a-=s1[j+3]; p1[j+2]=__builtin_amdgcn_exp2f(p1[j+2]+a); a-=s1[j+2]; p1[j+1]=__builtin_amdgcn_exp2f(p1[j+1]+a); a-=s1[j+1]; p1[j]=__builtin_amdgcn_exp2f(p1[j]+a); }
      sp_+=lo[i]+hv[i]; }
    carry-=sp_;
    { u32x4 pw0,pw1,pw2,pw3;
      pw0=(u32x4){cvtpk_s(p0[0],p0[1]),cvtpk_s(p0[2],p0[3]),cvtpk_s(p0[4],p0[5]),cvtpk_s(p0[6],p0[7])}; pw1=(u32x4){cvtpk_s(p0[8],p0[9]),cvtpk_s(p0[10],p0[11]),cvtpk_s(p0[12],p0[13]),cvtpk_s(p0[14],p0[15])};
      pw2=(u32x4){cvtpk_s(p1[0],p1[1]),cvtpk_s(p1[2],p1[3]),cvtpk_s(p1[4],p1[5]),cvtpk_s(p1[6],p1[7])}; pw3=(u32x4){cvtpk_s(p1[8],p1[9]),cvtpk_s(p1[10],p1[11]),cvtpk_s(p1[12],p1[13]),cvtpk_s(p1[14],p1[15])};
      pv(o,vb0+slot,__builtin_bit_cast(bf16x8,pw0),__builtin_bit_cast(bf16x8,pw1),__builtin_bit_cast(bf16x8,pw2),__builtin_bit_cast(bf16x8,pw3)); }
    { const bool done_=__all(carry<-150.f); if(lane==0)fl[(t&1)*8+wid]=done_?1u:0u; }
    slot^=SLOTB;
  }
  asm volatile("s_waitcnt vmcnt(0) lgkmcnt(0)":::"memory");
  bf16*Ow=O+(rowbase+q0+wid*QBLK)*1024+h*D;
  { bf16*stg=(bf16*)(shm+LDS_OST)+wid*2048;
    #pragma unroll
    for(int r=0;r<16;++r){const int orow=crow(r,hi);
      #pragma unroll
      for(int d0=0;d0<2;++d0)stg[orow*64+d0*32+r32]=__float2bfloat16(o[d0][r]);}
    asm volatile("s_waitcnt lgkmcnt(0)":::"memory");
    #pragma unroll
    for(int i=0;i<4;++i){const int row=i*8+(lane>>3),ch=lane&7; const u32x4 v=*(const u32x4*)(stg+row*64+ch*8); ATTN_STORE16(Ow+(long)row*1024+ch*8,v);} }
  asm volatile("s_waitcnt vmcnt(0) lgkmcnt(0)\n\ts_barrier":::"memory");
  #undef SB_DMA
}
constexpr int ATTN_LDS_BYTES=LDS_BYTES;
struct AttnTensors { const bf16* Q; const bf16* K; const bf16* V; bf16* O; const float* logf;   const unsigned* kn;   };
struct AttnUnit { int bh; int qb; };
struct StaticOrder {
  int vcu;
  __device__ __forceinline__ explicit StaticOrder(int grid,int block):vcu((block%8)*(grid/8)+block/8){}
  __device__ __forceinline__ bool next(int i,AttnUnit&u)const{ if(i>=4)return false; const int s=vcu&7; u.bh=vcu>>3; u.qb=(i==0)?s:(i==1)?15-s:(i==2)?16+s:31-s; return true; }
  __device__ __forceinline__ void a_ready(const AttnUnit&)const{}
  __device__ __forceinline__ void done(const AttnUnit&)const{}
};
template<class Sched,int THRL=8> __device__ __forceinline__ void attn_phase(char*lds,const AttnTensors&T,const Sched&S){
  AttnUnit u;
  for(int i=0;S.next(i,u);++i){ S.a_ready(u); attn_unit<THRL>(u.bh/NHEAD,u.bh%NHEAD,u.qb,T.Q,T.K,T.V,T.O,lds,T.logf+(size_t)u.bh*SEQ,T.kn+(size_t)u.bh*256); S.done(u); }
}
#undef SBAR
#undef WAIT_BAR
}
constexpr int NWAVES = 8, NTHREADS = NWAVES * 64;
constexpr int BATCH = 2, SEQ = 8192, D = 1024, M = BATCH * SEQ;
constexpr int S5G = 32, S5H = 16, S5P = 64, S5T = 32  , S5NC = M / S5T  , S5KX = 640  ;
constexpr int SBH = 8, FOXH = 16, HD = 64;
constexpr int EVEN_IN = 2048, ODD_IN = 3088, DFF = 2816, NEXP = 8, DFE = 3584;
constexpr float C2 = 0.125f * 1.4426950408889634f;
constexpr int MOE_CHUNK_PANELS = 68, MOE_MAX_PANELS = 136, MOE_MAX_SLOTS = MOE_MAX_PANELS * 256, MOE_CAP = 16384  ;

constexpr size_t MiB = 1u << 20;
constexpr size_t WS_CTL = 0, CTL_ZERO_BYTES = 1 * MiB;
constexpr size_t WS_WMOE_GU = 1 * MiB;
constexpr size_t WS_WMOE_D = 57 * MiB;
constexpr size_t WS_WIN0 = 85 * MiB;
constexpr size_t WS_WGLU = 89 * MiB;
constexpr size_t WS_WOUT0 = 90 * MiB;
constexpr size_t WS_WGU0 = 92 * MiB;
constexpr size_t WS_WD0 = 103 * MiB;
constexpr size_t WS_WIN1 = 109 * MiB;
constexpr size_t WS_WF1 = 115 * MiB;
constexpr size_t WS_WOUT1 = 116 * MiB;
constexpr size_t WS_S5WA = 118 * MiB;
constexpr size_t WS_S5WC = 126 * MiB;
constexpr size_t WS_XB = 146 * MiB;
constexpr size_t WS_SSP = 178 * MiB;
constexpr size_t WS_META = 182 * MiB;
constexpr size_t WS_LOGF = 183 * MiB;
constexpr size_t WS_QKV0 = 184 * MiB;
constexpr size_t WS_UEXT = 232 * MiB;
constexpr size_t WS_SLOC = 252 * MiB;
constexpr size_t WS_YG = 260 * MiB;
constexpr size_t WS_MIXB = 276 * MiB;
constexpr size_t WS_HID0 = 184 * MiB;
constexpr size_t WS_QKV1 = 184 * MiB;
constexpr size_t WS_XG = 184 * MiB;
constexpr size_t WS_HMOE = 312 * MiB;
constexpr size_t WS_Y = 85 * MiB;
constexpr size_t WS_END = 431 * MiB;
static_assert(WS_XG + (size_t)8 * MOE_CAP * 1024 <= WS_HMOE && WS_HMOE + (size_t)MOE_MAX_SLOTS * DFE <= WS_END && WS_Y + (size_t)MOE_MAX_SLOTS * 1024 * 2 <= WS_XB + 32 * MiB && WS_MIXB + 32 * MiB <= WS_END, "ws map");
constexpr size_t MT_RSTD = 0, MT_TOKE = 65536, MT_TOKP = 131072, MT_TOKG = 262144, MT_TOKSLOT = 393216, MT_RSS = 524288;
constexpr int CW_TMO = 0, CW_CODE = 1, CW_BAR = 4096, CW_CNT = 8192  , CW_QUEUE = 12288  , CW_QUEUE2 = 12352  , CW_KN = 16384  , CW_SS = 32768  ;

constexpr int RING_OFF = 0, RING_BYTES = 131072;
constexpr int LDSCTL_OFF = 133120  , MISC_OFF = LDSCTL_OFF + 320;
constexpr int LDS_BYTES = 147456;

#define GAS __attribute__((address_space(1)))
#define LAS __attribute__((address_space(3)))
typedef unsigned short bf16;
typedef unsigned v4u __attribute__((ext_vector_type(4)));
typedef unsigned v2u __attribute__((ext_vector_type(2)));
typedef float f32x4 __attribute__((ext_vector_type(4)));
typedef short bf16x8 __attribute__((ext_vector_type(8)));
typedef GAS unsigned gu32;
#define RLX_AGENT __ATOMIC_RELAXED, __HIP_MEMORY_SCOPE_AGENT
#define LDS_WAIT() asm volatile("s_waitcnt lgkmcnt(0)" ::: "memory")
#define VM_WAIT() asm volatile("s_waitcnt vmcnt(0)" ::: "memory")
__device__ __forceinline__ unsigned f2bf(float f) { unsigned u = __builtin_bit_cast(unsigned, f); return (u + 0x7fffu + ((u >> 16) & 1u)) >> 16; }
__device__ __forceinline__ unsigned pk2(float lo, float hi) { return f2bf(lo) | (f2bf(hi) << 16); }
__device__ __forceinline__ float bflo(unsigned w) { return __uint_as_float(w << 16); }
__device__ __forceinline__ float bfhi(unsigned w) { return __uint_as_float(w & 0xffff0000u); }

#define XB_TMO      128
#define XB_XCNT(j)  (256  + 64 * (j))
#define XB_XSUB(j)  (1280 + 64 * (j))
#define XB_XGEN(j)  (2304 + 64 * (j))
#define XB_TOP      3328
#define XB_TOPGEN   3392
#define XCD_BAR_WORDS 3456
#define XB_SPIN_CAP (1u << 18)
__device__ __forceinline__ unsigned xb_ld(unsigned* p)              { return __hip_atomic_load(p, __ATOMIC_RELAXED, __HIP_MEMORY_SCOPE_AGENT); }
__device__ __forceinline__ unsigned xb_add(unsigned* p, unsigned v) { return __hip_atomic_fetch_add(p, v, __ATOMIC_RELAXED, __HIP_MEMORY_SCOPE_AGENT); }
__device__ __forceinline__ unsigned xb_xcc_id() { return (unsigned)__builtin_amdgcn_s_getreg((3 << 11) | 20) & 0xFu; }
#define XB_SPIN(cond, bar) do { unsigned _sp = 0; while (cond) { __builtin_amdgcn_s_sleep(1); \
    if ((++_sp & 255u) == 0u) { if (xb_ld(&(bar)[XB_TMO])) break; if (_sp > XB_SPIN_CAP) { atomicAdd(&(bar)[XB_TMO], 1u); break; } } } } while (0)
struct XcdBarrier { unsigned* bar; unsigned x; volatile LAS unsigned* st; };
__device__ __forceinline__ XcdBarrier xcd_barrier_post(unsigned* bar, volatile LAS unsigned* st) {
    XcdBarrier b; b.bar = bar; b.x = xb_xcc_id(); b.st = st;
    if (threadIdx.x == 0) (void)xb_add(&bar[XB_XCNT(b.x)], 1u);
    return b;
}
__device__ __forceinline__ void xcd_barrier_complete(unsigned* bar, unsigned x, unsigned& nloc, unsigned& nx) {
    const unsigned G = gridDim.x * gridDim.y * gridDim.z;
    unsigned sum, cnt, mine, sp = 0u;
    for (;;) {
        sum = 0u; cnt = 0u; mine = 0u;
#pragma unroll
        for (unsigned j = 0; j < 16; ++j) { const unsigned c = xb_ld(&bar[XB_XCNT(j)]); sum += c; cnt += (c > 0u) ? 1u : 0u; mine = (j == x) ? c : mine; }
        if (sum == G) break;
        __builtin_amdgcn_s_sleep(1);
        if ((++sp & 255u) == 0u) { if (xb_ld(&bar[XB_TMO])) break; if (sp > XB_SPIN_CAP) { atomicAdd(&bar[XB_TMO], 1u); break; } }
    }
    nloc = mine > 0u ? mine : 1u; nx = cnt > 0u ? cnt : 1u;
}
__device__ __forceinline__ void xcd_barrier(const XcdBarrier& b) {
    asm volatile("s_waitcnt vmcnt(0)" ::: "memory");
    __syncthreads();
    if (threadIdx.x == 0) {
        unsigned* bar = b.bar;
        __builtin_amdgcn_s_waitcnt(0);
        unsigned nloc = b.st[0], nx = b.st[1];
        if (nloc == 0u) { xcd_barrier_complete(bar, b.x, nloc, nx); b.st[0] = nloc; b.st[1] = nx; }
        const unsigned old = xb_add(&bar[XB_XSUB(b.x)], 1u);
        const unsigned gen = old / nloc;
        if (old + 1u == (gen + 1u) * nloc) {
            __builtin_amdgcn_fence(__ATOMIC_RELEASE, "agent");
            asm volatile("s_waitcnt vmcnt(0)" ::: "memory");
            const unsigned og = xb_add(&bar[XB_TOP], 1u);
            const unsigned tg = og / nx;
            if (og + 1u == (tg + 1u) * nx) xb_add(&bar[XB_TOPGEN], 1u);
            else XB_SPIN(xb_ld(&bar[XB_TOPGEN]) == tg, bar);
            __builtin_amdgcn_fence(__ATOMIC_ACQUIRE, "agent");
            xb_add(&bar[XB_XGEN(b.x)], 1u);
            asm volatile("s_waitcnt vmcnt(0)" ::: "memory");
        } else {
            XB_SPIN(xb_ld(&bar[XB_XGEN(b.x)]) == gen, bar);
            __builtin_amdgcn_fence(__ATOMIC_ACQUIRE, "agent");
            asm volatile("s_waitcnt vmcnt(0)" ::: "memory");
        }
    }
    __syncthreads();
}

__device__ __forceinline__ float wave_sum(float v) {
#pragma unroll
    for (int o = 1; o < 64; o <<= 1) v += __shfl_xor(v, o);
    return v;
}
constexpr int XP = 65, XSCR_BYTES = 64 * XP * 4;
__device__ __forceinline__ unsigned cvtpk(float lo, float hi) { unsigned r; asm volatile("v_cvt_pk_bf16_f32 %0, %1, %2" : "=v"(r) : "v"(lo), "v"(hi)); return r; }
__device__ __forceinline__ void p0_transpose_item(const float* W, int ldw, int k0, int n0, const float* gs, bf16* dst, int ldd, LAS float* scr, int lane) {
    const int lr = lane >> 4, lc = (lane & 15) * 4;
    const float* src = W + (size_t)(k0 + lr) * ldw + n0 + lc;
    f32x4 v[16];
#pragma unroll
    for (int i = 0; i < 16; ++i) v[i] = *(const GAS f32x4*)(src + (size_t)(4 * i) * ldw);
    if (gs) {
#pragma unroll
        for (int i = 0; i < 16; ++i) v[i] = v[i] * gs[k0 + 4 * i + lr]; }
#pragma unroll
    for (int i = 0; i < 16; ++i) { LAS float* p = scr + (4 * i + lr) * XP + lc; p[0] = v[i][0]; p[1] = v[i][1]; p[2] = v[i][2]; p[3] = v[i][3]; }
    LDS_WAIT(); asm volatile("" ::: "memory");
    const int c = lane & 7, nn = lane >> 3;
#pragma unroll
    for (int j = 0; j < 8; ++j) { const int n = nn + 8 * j; const LAS float* sp = scr + (8 * c) * XP + n;
        v4u o; o.x = cvtpk(sp[0 * XP], sp[1 * XP]); o.y = cvtpk(sp[2 * XP], sp[3 * XP]); o.z = cvtpk(sp[4 * XP], sp[5 * XP]); o.w = cvtpk(sp[6 * XP], sp[7 * XP]);
        *(GAS v4u*)(dst + (size_t)n * ldd + k0 + 8 * c) = o; }
    LDS_WAIT(); asm volatile("" ::: "memory");
}
struct XTile { const float* src; const float* gs; unsigned char* dst; int ldw, ldd, k0; };
__device__ __forceinline__ XTile xtile_fp8(int item, const float* W, int ldw, int N, const float* gs, unsigned char* dst, int ldd, int mode, int lane) {
    const int nblk = N / 64, kb = item / nblk, nb = item % nblk, n0 = 64 * nb, k0 = 64 * kb;
    const int row = mode == 0 ? n0 : ((n0 >> 7) * 256 + (n0 & 127) + (mode == 2 ? 128 : 0));
    XTile t; t.src = W + (size_t)(k0 + (lane >> 4)) * ldw + n0 + (lane & 15) * 4; t.gs = gs; t.dst = dst + (size_t)row * ldd; t.ldw = ldw; t.ldd = ldd; t.k0 = k0; return t;
}
__device__ __forceinline__ void xtile_load(const XTile& t, f32x4 (&v)[16]) {
#pragma unroll
    for (int i = 0; i < 16; ++i) v[i] = *(const GAS f32x4*)(t.src + (size_t)(4 * i) * t.ldw);
}
__device__ __forceinline__ void xtile_finish_fp8(const XTile& t, f32x4 (&v)[16], float wscale, LAS float* scr, int lane) {
    const int lr = lane >> 4, lc = (lane & 15) * 4;
#pragma unroll
    for (int i = 0; i < 16; ++i) v[i] = v[i] * (t.gs ? t.gs[t.k0 + 4 * i + lr] * wscale : wscale);
#pragma unroll
    for (int i = 0; i < 16; ++i) { LAS float* p = scr + (4 * i + lr) * XP + lc; p[0] = v[i][0]; p[1] = v[i][1]; p[2] = v[i][2]; p[3] = v[i][3]; }
    LDS_WAIT(); asm volatile("" ::: "memory");
    const int c = lane & 3, nn = lane >> 2;
#pragma unroll
    for (int j = 0; j < 4; ++j) { const int n = nn + 16 * j; const LAS float* sp = scr + (16 * c) * XP + n;
        v4u o; o.x = pg8::pk_fp8x4(sp[0 * XP], sp[1 * XP], sp[2 * XP], sp[3 * XP]); o.y = pg8::pk_fp8x4(sp[4 * XP], sp[5 * XP], sp[6 * XP], sp[7 * XP]);
        o.z = pg8::pk_fp8x4(sp[8 * XP], sp[9 * XP], sp[10 * XP], sp[11 * XP]); o.w = pg8::pk_fp8x4(sp[12 * XP], sp[13 * XP], sp[14 * XP], sp[15 * XP]);
        *(GAS v4u*)(t.dst + (size_t)n * t.ldd + t.k0 + 16 * c) = o; }
    LDS_WAIT(); asm volatile("" ::: "memory");
}
__device__ __forceinline__ void xpose_mat(int item, const float* W, int ldw, int N, const float* gs, bf16* dst, int ldd, int mode, LAS float* scr, int lane) {
    const int nblk = N / 64, kb = item / nblk, nb = item % nblk, n0 = 64 * nb;
    const int row = mode == 0 ? n0 : ((n0 >> 7) * 256 + (n0 & 127) + (mode == 2 ? 128 : 0));
    p0_transpose_item(W, ldw, 64 * kb, n0, gs, dst + (size_t)row * ldd, ldd, scr, lane);
}

struct Args { const float* in[28]; float* out; unsigned char* ws; };

__device__ __forceinline__ void s5_tables(const Args& a, int g, int q, LAS unsigned char* lds, int tid) {
    LAS float* POWr = (LAS float*)lds;
    LAS float* POWi = POWr + 33 * 64;
    LAS float* BBr = POWi + 33 * 64;
    LAS float* BBi = BBr + 1024;
    LAS float* CCr = BBi + 1024;
    LAS float* CCi = CCr + 1024;
    LAS float* KT = CCi + 1024;
    LAS float* DD = KT + 2048;
    const float* a_re = a.in[3]; const float* a_im = a.in[4]; const float* b_re = a.in[5]; const float* b_im = a.in[6];
    const float* c_re = a.in[7]; const float* c_im = a.in[8]; const float* dsk = a.in[9]; const float* log_step = a.in[10];
    const float step = expf(log_step[g]);
    __syncthreads();
    for (int e = tid; e < 33 * 64; e += NTHREADS) { const int n = e >> 6, p = e & 63; const float lr = a_re[g * 64 + p], li = a_im[g * 64 + p];
        const float mag = expf((float)n * step * lr); float sn, cs; sincosf((float)n * (step * li), &sn, &cs); POWr[e] = mag * cs; POWi[e] = mag * sn; }
    for (int e = tid; e < 1024; e += NTHREADS) { const int p = e >> 4, h = e & 15; const float lr = a_re[g * 64 + p], li = a_im[g * 64 + p];
        const float er = expf(lr * step); float sn, cs; sincosf(li * step, &sn, &cs); const float nr = er * cs - 1.f, ni = er * sn, den = lr * lr + li * li;
        const float fr = (nr * lr + ni * li) / den, fi = (ni * lr - nr * li) / den;
        const float br = b_re[(g * 64 + p) * 16 + h], bi = b_im[(g * 64 + p) * 16 + h];
        BBr[e] = fr * br - fi * bi; BBi[e] = fr * bi + fi * br;
        CCr[e] = c_re[g * 1024 + e]; CCi[e] = c_im[g * 1024 + e]; }
    if (tid < 16) DD[tid] = dsk[g * 16 + tid];
    __syncthreads();
    for (int e = tid; e < 2048; e += NTHREADS) { const int tau = e >> 6, hl = (e >> 4) & 3, hi = e & 15, ho = 4 * q + hl; float sacc = 0.f;
        for (int p = 0; p < 64; ++p) { const float cr = CCr[ho * 64 + p], ci = CCi[ho * 64 + p], pr = POWr[tau * 64 + p], pi = POWi[tau * 64 + p];
            const float xr = cr * pr - ci * pi, xi = cr * pi + ci * pr; sacc += xr * BBr[p * 16 + hi] - xi * BBi[p * 16 + hi]; }
        if (tau == 0 && ho == hi) sacc += DD[ho];
        KT[e] = sacc; }
    __syncthreads();
    bf16* WA = (bf16*)(a.ws + WS_S5WA) + (size_t)g * 256 * 512;
    for (int pc = tid; pc < 64 * 64; pc += NTHREADS) { const int p = pc >> 6, k0 = (pc & 63) * 8; v4u o = (v4u){0u, 0u, 0u, 0u};
        if (q < 2) { const int j = k0 >> 4, h0 = k0 & 15; const float pr = POWr[(31 - j) * 64 + p], pi = POWi[(31 - j) * 64 + p]; float v[8];
#pragma unroll
            for (int w = 0; w < 8; ++w) { const float br = BBr[p * 16 + h0 + w], bi = BBi[p * 16 + h0 + w]; v[w] = (q == 0) ? (pr * br - pi * bi) : (pr * bi + pi * br); }
            o.x = cvtpk(v[0], v[1]); o.y = cvtpk(v[2], v[3]); o.z = cvtpk(v[4], v[5]); o.w = cvtpk(v[6], v[7]); }
        *(GAS v4u*)(WA + (size_t)(64 * q + p) * 512 + k0) = o; }
    bf16* WC = (bf16*)(a.ws + WS_S5WC) + (size_t)g * 512 * 640;
    for (int pc = tid; pc < 128 * 80; pc += NTHREADS) { const int rl = pc / 80, k0 = (pc % 80) * 8, i = rl >> 2, hl = rl & 3, ho = 4 * q + hl; float v[8];
        if (k0 < 512) { const int j = k0 >> 4, h0 = k0 & 15;
#pragma unroll
            for (int w = 0; w < 8; ++w) v[w] = (j <= i) ? KT[((i - j) * 4 + hl) * 16 + h0 + w] : 0.f; }
        else { const int p0 = (k0 - 512) & 63; const bool im = k0 >= 576;
#pragma unroll
            for (int w = 0; w < 8; ++w) { const int p = p0 + w; const float cr = CCr[ho * 64 + p], ci = CCi[ho * 64 + p], pr = POWr[(i + 1) * 64 + p], pi = POWi[(i + 1) * 64 + p];
                v[w] = im ? -(cr * pi + ci * pr) : (cr * pr - ci * pi); } }
        v4u o; o.x = cvtpk(v[0], v[1]); o.y = cvtpk(v[2], v[3]); o.z = cvtpk(v[4], v[5]); o.w = cvtpk(v[6], v[7]);
        *(GAS v4u*)(WC + (size_t)(i * 16 + ho) * 640 + k0) = o; }
    __syncthreads();
}

constexpr int MOE_XITEMS = 24 * 896;
__device__ __forceinline__ XTile moe_xtile(const Args& a, int r, int lane) {
    unsigned char* ws = a.ws;
    const int mat = r / 896, e = mat / 3, which = mat % 3; r -= mat * 896;
    if (which == 0) return xtile_fp8(r, a.in[24] + (size_t)e * D * DFE, DFE, DFE, a.in[22], ws + WS_WMOE_GU + (size_t)e * 7168 * 1024, D, 1, lane);
    if (which == 1) return xtile_fp8(r, a.in[25] + (size_t)e * D * DFE, DFE, DFE, a.in[22], ws + WS_WMOE_GU + (size_t)e * 7168 * 1024, D, 2, lane);
    return xtile_fp8(r, a.in[26] + (size_t)e * DFE * D, D, D, nullptr, ws + WS_WMOE_D + (size_t)e * 1024 * 3584, DFE, 0, lane);
}
__device__ __forceinline__ void p0_prologue(const Args& a, LAS unsigned char* lds, int tid, int lane, int wave, int vcu, int G) {
    for (int it = vcu; it < 4 * S5G; it += G) s5_tables(a, it >> 2, it & 3, lds, tid);
    LAS float* scr = (LAS float*)(lds + wave * XSCR_BYTES);
    const int gw = vcu * NWAVES + wave, NGW = G * NWAVES;
    constexpr int I_IN0 = 16 * 32, I_GLU = 8 * 8, I_OUT = 16 * 16, I_GU0 = 16 * 44, I_D0 = 44 * 16, I_IN1 = 16 * 48, I_MOE = 896;
    constexpr int NITEMS = I_IN0 + I_GLU + I_OUT + 2 * I_GU0 + I_D0 + I_IN1 + I_OUT;
    unsigned char* ws = a.ws;
    for (int it = NITEMS - 1 - gw; it >= 0; it -= NGW) {
        int r = it;
        if (r < I_IN0) { xpose_mat(r, a.in[2], EVEN_IN, EVEN_IN, a.in[1], (bf16*)(ws + WS_WIN0), D, 0, scr, lane); continue; } r -= I_IN0;
        if (r < I_GLU) { xpose_mat(r, a.in[11], 512, 512, nullptr, (bf16*)(ws + WS_WGLU), 512, 0, scr, lane); continue; } r -= I_GLU;
        if (r < I_OUT) { xpose_mat(r, a.in[13], D, D, nullptr, (bf16*)(ws + WS_WOUT0), D, 0, scr, lane); continue; } r -= I_OUT;
        if (r < I_GU0) { xpose_mat(r, a.in[15], DFF, DFF, a.in[14], (bf16*)(ws + WS_WGU0), D, 1, scr, lane); continue; } r -= I_GU0;
        if (r < I_GU0) { xpose_mat(r, a.in[16], DFF, DFF, a.in[14], (bf16*)(ws + WS_WGU0), D, 2, scr, lane); continue; } r -= I_GU0;
        if (r < I_D0) { xpose_mat(r, a.in[17], D, D, nullptr, (bf16*)(ws + WS_WD0), DFF, 0, scr, lane); continue; } r -= I_D0;
        if (r < I_IN1) { xpose_mat(r, a.in[19], ODD_IN, 3072, a.in[18], (bf16*)(ws + WS_WIN1), D, 0, scr, lane); continue; } r -= I_IN1;
        xpose_mat(r, a.in[21], D, D, nullptr, (bf16*)(ws + WS_WOUT1), D, 0, scr, lane);
    }
    { const int gt = vcu * NTHREADS + tid; if (gt < 16 * 1024) { const int h = gt >> 10, k = gt & 1023; ((bf16*)(ws + WS_WF1))[gt] = (bf16)f2bf(a.in[19][(size_t)k * ODD_IN + 3072 + h] * a.in[18][k]); } }
    float* ss0 = (float*)(ws + WS_SSP);
    for (int m = gw; m < M; m += NGW) {
        const GAS f32x4* xr = (const GAS f32x4*)(a.in[0] + (size_t)m * D) + lane; GAS v2u* o8 = (GAS v2u*)((bf16*)(ws + WS_XB) + (size_t)m * D) + lane; float s = 0.f;
#pragma unroll
        for (int j = 0; j < 4; ++j) { const f32x4 v = xr[64 * j]; s += (v.x * v.x + v.y * v.y) + (v.z * v.z + v.w * v.w); v2u w; w.x = pk2(v.x, v.y); w.y = pk2(v.z, v.w); o8[64 * j] = w; }
        s = wave_sum(s); if (lane < 16) ss0[(size_t)m * 16 + lane] = (lane == 0) ? s : 0.f;
    }
}

__device__ __forceinline__ void s5_scan(const Args& a, int gt  ) {
    if (gt >= BATCH * S5G * S5P) return;
    const int b = gt / (S5G * S5P), g = (gt / S5P) % S5G, p = gt % S5P;
    const float step = expf(a.in[10][g]); const float lr = a.in[3][g * 64 + p], li = a.in[4][g * 64 + p];
    const float mag = expf((float)S5T * step * lr); float sn, cs; sincosf((float)S5T * (step * li), &sn, &cs); const float ar = mag * cs, ai = mag * sn;
    const float* sl = (const float*)(a.ws + WS_SLOC) + ((size_t)g * S5NC + b * 256) * 128 + p;
    bf16* ue = (bf16*)(a.ws + WS_UEXT) + ((size_t)g * S5NC + b * 256) * S5KX + 512 + p;
    float sr = 0.f, si = 0.f;
#pragma unroll 8
    for (int c = 0; c < 256; ++c) {
        ue[(size_t)c * S5KX] = (bf16)f2bf(sr); ue[(size_t)c * S5KX + 64] = (bf16)f2bf(si);
        const float lr_ = sl[(size_t)c * 128], li_ = sl[(size_t)c * 128 + 64];
        const float nr = ar * sr - ai * si + lr_, ni = ar * si + ai * sr + li_; sr = nr; si = ni;
    }
}

__device__ __forceinline__ float softplus2(float z) { return fmaxf(z, 0.f) + __builtin_amdgcn_logf(1.0f + __builtin_amdgcn_exp2f(-fabsf(z))); }
__device__ __forceinline__ void stage_kv32(const bf16* kp, const bf16* vp, size_t pitch, LAS float* sK, LAS float* sV, int tid) {
    const int r = tid >> 4, c = (tid & 15) * 4;
    const v2u kw = *(const v2u*)(kp + (size_t)r * pitch + c), vw = *(const v2u*)(vp + (size_t)r * pitch + c);
    *(LAS f32x4*)(sK + r * 64 + c) = (f32x4){bflo(kw.x), bfhi(kw.x), bflo(kw.y), bfhi(kw.y)};
    *(LAS f32x4*)(sV + r * 64 + c) = (f32x4){bflo(vw.x), bfhi(vw.x), bflo(vw.y), bfhi(vw.y)};
}
__device__ __forceinline__ void sb_simple_unit(const bf16* qkv  , bf16* mix  , int b, int h, int blk, LAS unsigned char* lds, int tid) {
    const int lane = tid & 63, wave_ = tid >> 6;
    LAS float* sK = (LAS float*)lds; LAS float* sV = sK + 32 * 64;
    const int t = blk * 512 + tid; const size_t rb = (size_t)b * SEQ;
    float q[HD], acc[HD];
    { const v4u* qp = (const v4u*)(qkv + (rb + t) * 1536 + h * HD);
#pragma unroll
      for (int i = 0; i < 8; ++i) { const v4u w = qp[i]; q[8 * i] = bflo(w.x); q[8 * i + 1] = bfhi(w.x); q[8 * i + 2] = bflo(w.y); q[8 * i + 3] = bfhi(w.y); q[8 * i + 4] = bflo(w.z); q[8 * i + 5] = bfhi(w.z); q[8 * i + 6] = bflo(w.w); q[8 * i + 7] = bfhi(w.w); }
#pragma unroll
      for (int i = 0; i < HD; ++i) acc[i] = 0.f; }
    float carry = 0.f;
    for (int c0 = blk * 512 + 480; c0 >= 0; c0 -= 32) {
        __syncthreads();
        stage_kv32(qkv + (rb + c0) * 1536 + 512 + h * HD, qkv + (rb + c0) * 1536 + 1024 + h * HD, 1536, sK, sV, tid);
        __syncthreads();
        for (int r = 31; r >= 0; --r) { const int s = c0 + r;
            if (s < t) { float z = 0.f;
#pragma unroll
                for (int i = 0; i < HD; ++i) z = fmaf(q[i], sK[r * 64 + i], z);
                const float sp = softplus2(z); const float w = __builtin_amdgcn_exp2f(z - sp + carry); carry -= sp;
#pragma unroll
                for (int i = 0; i < HD; ++i) acc[i] = fmaf(w, sV[r * 64 + i], acc[i]); } }
        { LAS unsigned* fl = (LAS unsigned*)(lds + 16384); if (lane == 0) fl[wave_] = __all(carry < -150.f) ? 1u : 0u; __syncthreads();
          if ((fl[0] & fl[1] & fl[2] & fl[3] & fl[4] & fl[5] & fl[6] & fl[7]) != 0u) break; }
    }
    v4u* op = (v4u*)(mix + (rb + t) * 1024 + 512 + h * HD);
#pragma unroll
    for (int i = 0; i < 8; ++i) { v4u w; w.x = pk2(acc[8 * i], acc[8 * i + 1]); w.y = pk2(acc[8 * i + 2], acc[8 * i + 3]); w.z = pk2(acc[8 * i + 4], acc[8 * i + 5]); w.w = pk2(acc[8 * i + 6], acc[8 * i + 7]); op[i] = w; }
}
__device__ __forceinline__ void fgate_rows16(const bf16* xb, const bf16* wf, const float* ss, const float* bfv, float* logf, int r0, int lane) {
    const int fr = lane & 15, fq = lane >> 4;
    const bf16x8* ap = (const bf16x8*)(xb + (size_t)(r0 + fr) * D + fq * 8);
    const bf16x8* bp = (const bf16x8*)(wf + (size_t)fr * D + fq * 8);
    f32x4 acc = (f32x4){0.f, 0.f, 0.f, 0.f};
#pragma unroll 8
    for (int kk = 0; kk < 32; ++kk) acc = __builtin_amdgcn_mfma_f32_16x16x32_bf16(ap[kk * 4], bp[kk * 4], acc, 0, 0, 0);
    const float bias = bfv[fr];
#pragma unroll
    for (int j = 0; j < 4; ++j) { const int row = r0 + fq * 4 + j; const float rs = pg8::rstd16(ss, row);
        const float z = acc[j] * rs + bias;
        const float lf = -(fmaxf(-z, 0.f) + log1pf(expf(-fabsf(z)))) * 1.4426950408889634f;
        const int b = row >> 13, t = row & 8191; logf[((size_t)b * FOXH + fr) * SEQ + t] = lf; }
}

struct MoeOrder {
    pg8::StaticOrder S; int lo; int pref[NEXP + 1]; bool cap_rows;
    __device__ __forceinline__ bool next(int i, pg8::Unit& u) const {
        if (!S.next(i, u)) return false;
        u.pm += lo; int e = 0, pe = 0;
#pragma unroll
        for (int k = 1; k < NEXP; ++k) { const bool ge = u.pm >= pref[k]; e += ge ? 1 : 0; pe = ge ? pref[k] : pe; }
        u.zb = e; u.pa = cap_rows ? e * (MOE_CAP / 256) + (u.pm - pe) : u.pm; return true;
    }
    __device__ __forceinline__ void a_ready(const pg8::Unit&) const {}
    __device__ __forceinline__ void done(const pg8::Unit&) const {}
};

__global__ void __launch_bounds__(NTHREADS, 2) mk_fwd(Args args) {
    extern __shared__ __attribute__((aligned(16))) unsigned char lds_raw[];
    LAS unsigned char* lds = (LAS unsigned char*)lds_raw;
    volatile LAS unsigned* MISC = (volatile LAS unsigned*)(lds + MISC_OFF);
    const int tid = threadIdx.x, lane = tid & 63, wave = __builtin_amdgcn_readfirstlane(tid >> 6);
    const int G = gridDim.x; const int bx = blockIdx.x; const int vcu = (G % 8 == 0) ? (bx % 8) * (G / 8) + bx / 8 : bx;
    unsigned char* ws = args.ws;
    gu32* ctl = (gu32*)(ws + WS_CTL);
    for (int u = tid; u < (LDS_BYTES - LDSCTL_OFF) / 4; u += NTHREADS) ((LAS unsigned*)(lds + LDSCTL_OFF))[u] = 0u;
    __syncthreads();
    XcdBarrier bar = xcd_barrier_post((unsigned*)(ctl + CW_BAR), MISC + 8);
    const int gw = vcu * NWAVES + wave, NGW = G * NWAVES;
    float* SS = (float*)(ws + WS_SSP);
    float* X = args.out;
    bf16* XB = (bf16*)(ws + WS_XB);
#define GRID_BAR() xcd_barrier(bar)
#define GEMM_PHASE(EPI, SCHED, lds_, g_, S_, E_) pg8::gemm_phase<EPI, SCHED, true, true>(lds_, g_, S_, E_)

    p0_prologue(args, lds, tid, lane, wave, vcu, G);
    GRID_BAR();
    { pg8::Gemm g{XB, (const bf16*)(ws + WS_WIN0), D, D, D, 0, 0}; pg8::StaticOrder S; S.init(M, EVEN_IN, 1, G, bx);
      pg8::EpiInProj0 E{SS, (bf16*)(ws + WS_UEXT), (bf16*)(ws + WS_QKV0), C2};
      GEMM_PHASE(pg8::EpiInProj0, pg8::StaticOrder, lds + RING_OFF, g, S, E); }
    GRID_BAR();
#define SB_PULL_ONE(more_) do { if (tid == 0) MISC[17] = __hip_atomic_fetch_add(ctl + CW_QUEUE2, 1u, RLX_AGENT); __syncthreads(); const unsigned uq_ = __builtin_amdgcn_readfirstlane(MISC[17]); __syncthreads(); \
        more_ = uq_ < (unsigned)(BATCH * SBH * 32); if (more_) { const int bh_ = (int)(uq_ >> 5), qb_ = (int)(uq_ & 31u); \
            attn_body::sb_unit<1536>(bh_ >> 3, bh_ & 7, qb_, (const attn_body::bf16*)(ws + WS_QKV0), (const attn_body::bf16*)(ws + WS_QKV0) + 512, (const attn_body::bf16*)(ws + WS_QKV0) + 1024, (attn_body::bf16*)(ws + WS_MIXB) + 512, (char*)lds_raw + RING_OFF); } } while (0)
    bool sb_more = true;
    { pg8::Gemm g{(const bf16*)(ws + WS_UEXT), (const bf16*)(ws + WS_S5WA), S5KX, 512, 512, (size_t)S5NC * S5KX * 2, (size_t)256 * 512 * 2}; pg8::StaticOrder S; S.init(S5NC, 256, S5G, G, bx);
      pg8::EpiS5State E{(float*)(ws + WS_SLOC)};
      GEMM_PHASE(pg8::EpiS5State, pg8::StaticOrder, lds + RING_OFF, g, S, E);
      if (bx >= S.nwg) SB_PULL_ONE(sb_more); }
    GRID_BAR();
    s5_scan(args, vcu * NTHREADS + tid);
    if (vcu * NTHREADS >= BATCH * S5G * S5P) SB_PULL_ONE(sb_more);
    GRID_BAR();
    { pg8::Gemm g{(const bf16*)(ws + WS_UEXT), (const bf16*)(ws + WS_S5WC), S5KX, S5KX, S5KX, (size_t)S5NC * S5KX * 2, (size_t)512 * S5KX * 2}; pg8::StaticOrder S; S.init(S5NC, 512, S5G, G, bx);
      pg8::EpiS5Y E{(bf16*)(ws + WS_YG)};
      GEMM_PHASE(pg8::EpiS5Y, pg8::StaticOrder, lds + RING_OFF, g, S, E);
      if (bx >= S.nwg) SB_PULL_ONE(sb_more); }
    GRID_BAR();
    { pg8::Gemm g{(const bf16*)(ws + WS_YG), (const bf16*)(ws + WS_WGLU), 512, 512, 512, 0, 0}; pg8::StaticOrder S; S.init(M, 512, 1, G, bx);
      pg8::EpiGlu E{(const bf16*)(ws + WS_YG), args.in[12], (bf16*)(ws + WS_MIXB)};
      GEMM_PHASE(pg8::EpiGlu, pg8::StaticOrder, lds + RING_OFF, g, S, E); }
    __syncthreads();
    sb_more = true;
#pragma unroll 1
    while (sb_more) SB_PULL_ONE(sb_more);
    GRID_BAR();
#undef SB_PULL_ONE
    { pg8::Gemm g{(const bf16*)(ws + WS_MIXB), (const bf16*)(ws + WS_WOUT0), D, D, D, 0, 0}; pg8::StaticOrder S; S.init(M, D, 1, G, bx);
      pg8::EpiResid E{args.in[0], X, XB, SS + 16 * M};
      GEMM_PHASE(pg8::EpiResid, pg8::StaticOrder, lds + RING_OFF, g, S, E); }
    GRID_BAR();
    { pg8::Gemm g{XB, (const bf16*)(ws + WS_WGU0), D, D, D, 0, 0}; pg8::StaticOrder S; S.init(M, 2 * DFF, 1, G, bx);
      pg8::EpiSwiGlu<true> E{SS + 16 * M, (bf16*)(ws + WS_HID0), DFF};
      GEMM_PHASE(pg8::EpiSwiGlu<true>, pg8::StaticOrder, lds + RING_OFF, g, S, E); }
    GRID_BAR();
    { pg8::Gemm g{(const bf16*)(ws + WS_HID0), (const bf16*)(ws + WS_WD0), DFF, DFF, DFF, 0, 0}; pg8::StaticOrder S; S.init(M, D, 1, G, bx);
      pg8::EpiResid E{X, X, XB, SS + 32 * M};
      GEMM_PHASE(pg8::EpiResid, pg8::StaticOrder, lds + RING_OFF, g, S, E); }
    GRID_BAR();
    { pg8::Gemm g{XB, (const bf16*)(ws + WS_WIN1), D, D, D, 0, 0}; pg8::StaticOrder S; S.init(M, 3072, 1, G, bx);
      pg8::EpiInProj1 E{SS + 32 * M, (bf16*)(ws + WS_QKV1), C2, (unsigned*)(ctl + CW_KN)};
      GEMM_PHASE(pg8::EpiInProj1, pg8::StaticOrder, lds + RING_OFF, g, S, E); }
    for (int r = gw; r < M / 16; r += NGW) fgate_rows16(XB, (const bf16*)(ws + WS_WF1), SS + 32 * M, args.in[20], (float*)(ws + WS_LOGF), r * 16, lane);
    GRID_BAR();
    { const attn_body::AttnTensors AT{(const attn_body::bf16*)(ws + WS_QKV1), (const attn_body::bf16*)(ws + WS_QKV1 + 32 * MiB), (const attn_body::bf16*)(ws + WS_QKV1 + 64 * MiB), (attn_body::bf16*)(ws + WS_QKV1), (const float*)(ws + WS_LOGF), (const unsigned*)(ctl + CW_KN)};
      constexpr int N_ATT = 1024, N_CVB = MOE_XITEMS / 32, N_GRP = (N_ATT + 2) / 3 > (N_CVB + 1) / 2 ? (N_ATT + 2) / 3 : (N_CVB + 1) / 2;
      for (;;) {
          if (tid == 0) MISC[16] = __hip_atomic_fetch_add(ctl + CW_QUEUE, 1u, RLX_AGENT);
          __syncthreads();
          const unsigned uq = __builtin_amdgcn_readfirstlane(MISC[16]);
          __syncthreads();
          if (uq >= 5u * N_GRP) break;
          const int grp = (int)(uq / 5u), rr = (int)(uq % 5u);
          if (rr & 1) { const int cb = 2 * grp + (rr >> 1);
              if (cb < N_CVB) { int lane_ = threadIdx.x & 63; asm volatile("" : "+v"(lane_));
                  LAS float* scr = (LAS float*)(lds + wave * XSCR_BYTES);
#pragma unroll 1
                  for (int j = 0; j < 4; j += 2) { const XTile t0 = moe_xtile(args, cb * 32 + wave * 4 + j, lane_), t1 = moe_xtile(args, cb * 32 + wave * 4 + j + 1, lane_);
                      f32x4 v0[16], v1[16]; xtile_load(t0, v0); xtile_load(t1, v1);
                      xtile_finish_fp8(t0, v0, 64.f, scr, lane_); xtile_finish_fp8(t1, v1, 64.f, scr, lane_); } }
          } else { const int au = 3 * grp + (rr >> 1);
              if (au < N_ATT) { const int bh = au & 31, qb = 31 - (au >> 5);
                  attn_body::attn_unit<8>(bh >> 4, bh & 15, qb, AT.Q, AT.K, AT.V, AT.O, (char*)lds_raw + RING_OFF, AT.logf + (size_t)bh * SEQ, AT.kn + (size_t)bh * 256); } }
      } }
    GRID_BAR();
    { pg8::Gemm g{(const bf16*)(ws + WS_QKV1), (const bf16*)(ws + WS_WOUT1), D, D, D, 0, 0}; pg8::StaticOrder S; S.init(M, D, 1, G, bx);
      pg8::EpiResid E{X, X, XB, SS + 48 * M};
      GEMM_PHASE(pg8::EpiResid, pg8::StaticOrder, lds + RING_OFF, g, S, E); }
    GRID_BAR();
    unsigned char* meta = ws + WS_META; unsigned char* XG = ws + WS_XG; float* RSS = (float*)(meta + MT_RSS);
    {
        const float* wr = args.in[23]; const float* gn = args.in[22];
        for (int tok = gw; tok < M; tok += NGW) {
            const GAS f32x4* xr = (const GAS f32x4*)(X + (size_t)tok * D) + lane; float lg[NEXP]; float s = 0.f; unsigned w[4];
#pragma unroll
            for (int e = 0; e < NEXP; ++e) lg[e] = 0.f;
#pragma unroll
            for (int j = 0; j < 4; ++j) { const f32x4 v = xr[64 * j]; s += (v.x * v.x + v.y * v.y) + (v.z * v.z + v.w * v.w); const int k0 = 4 * lane + 256 * j; const f32x4 gv = *(const f32x4*)(gn + k0);
                w[j] = pg8::pk_fp8x4(v.x, v.y, v.z, v.w);
#pragma unroll
                for (int q = 0; q < 4; ++q) { const float xv = v[q] * gv[q]; const f32x4 w0 = *(const f32x4*)(wr + (size_t)(k0 + q) * NEXP), w1 = *(const f32x4*)(wr + (size_t)(k0 + q) * NEXP + 4);
                    lg[0] = fmaf(xv, w0.x, lg[0]); lg[1] = fmaf(xv, w0.y, lg[1]); lg[2] = fmaf(xv, w0.z, lg[2]); lg[3] = fmaf(xv, w0.w, lg[3]);
                    lg[4] = fmaf(xv, w1.x, lg[4]); lg[5] = fmaf(xv, w1.y, lg[5]); lg[6] = fmaf(xv, w1.z, lg[6]); lg[7] = fmaf(xv, w1.w, lg[7]); } }
            s = wave_sum(s);
#pragma unroll
            for (int e = 0; e < NEXP; ++e) lg[e] = wave_sum(lg[e]);
            const float rs = 1.0f / sqrtf(s * (1.0f / 1024.0f) + pg8::RMS_EPS);
            int i1 = 0; float v1 = lg[0];
#pragma unroll
            for (int e = 1; e < NEXP; ++e) if (lg[e] > v1) { v1 = lg[e]; i1 = e; }
            int i2 = -1; float v2 = -INFINITY;
#pragma unroll
            for (int e = 0; e < NEXP; ++e) if (e != i1 && lg[e] > v2) { v2 = lg[e]; i2 = e; }
            unsigned p1 = 0u, p2 = 0u;
            if (lane == 0) { p1 = __hip_atomic_fetch_add(ctl + CW_CNT + 64 * i1, 1u, RLX_AGENT); p2 = __hip_atomic_fetch_add(ctl + CW_CNT + 64 * i2, 1u, RLX_AGENT); }
            p1 = (unsigned)__builtin_amdgcn_readfirstlane((int)p1); p2 = (unsigned)__builtin_amdgcn_readfirstlane((int)p2);
            const size_t r1 = (size_t)i1 * MOE_CAP + p1, r2 = (size_t)i2 * MOE_CAP + p2;
#pragma unroll
            for (int j = 0; j < 4; ++j) { *(unsigned*)(XG + r1 * D + 4 * lane + 256 * j) = w[j]; *(unsigned*)(XG + r2 * D + 4 * lane + 256 * j) = w[j]; }
            if (lane == 0) {
                const float g1 = 1.f / (1.f + expf((v2 - v1) * rs)), g2 = 1.f - g1;
                RSS[r1] = rs; RSS[r2] = rs; ((unsigned*)(meta + MT_TOKE))[tok] = (unsigned)i1 | ((unsigned)i2 << 8);
                ((unsigned*)(meta + MT_TOKP))[2 * tok] = p1; ((unsigned*)(meta + MT_TOKP))[2 * tok + 1] = p2;
                ((float*)(meta + MT_TOKG))[2 * tok] = g1; ((float*)(meta + MT_TOKG))[2 * tok + 1] = g2;
            }
        }
    }
    GRID_BAR();
    int pref[NEXP + 1], cnt[NEXP];
    { pref[0] = 0;
#pragma unroll
      for (int e = 0; e < NEXP; ++e) { cnt[e] = (int)__builtin_amdgcn_readfirstlane(__hip_atomic_load(ctl + CW_CNT + 64 * e, RLX_AGENT)); pref[e + 1] = pref[e] + (cnt[e] + 255) / 256; } }
    const int NP = pref[NEXP];
    bf16* YS = (bf16*)(ws + WS_Y);
    { pg8::Gemm g{(const bf16*)XG, (const bf16*)(ws + WS_WMOE_GU), D / 2, D / 2, D / 2, 0, (size_t)7168 * 1024}; MoeOrder S; S.S.nM = NP; S.S.nN = 28; S.S.nZ = 1; S.S.nwg = NP * 28; S.S.G = G; S.S.c = bx; S.lo = 0; S.cap_rows = true;
#pragma unroll
      for (int e = 0; e <= NEXP; ++e) S.pref[e] = pref[e];
      pg8::EpiSwiGluFp8 E{RSS, ws + WS_HMOE, DFE};
      pg8::gemm_phase<pg8::EpiSwiGluFp8, MoeOrder, true, true, true>(lds + RING_OFF, g, S, E); }
    GRID_BAR();
    { pg8::Gemm g{(const bf16*)(ws + WS_HMOE), (const bf16*)(ws + WS_WMOE_D), DFE / 2, DFE / 2, DFE / 2, 0, (size_t)1024 * 3584}; MoeOrder S; S.S.nM = NP; S.S.nN = 4; S.S.nZ = 1; S.S.nwg = NP * 4; S.S.G = G; S.S.c = bx; S.lo = 0; S.cap_rows = false;
#pragma unroll
      for (int e = 0; e <= NEXP; ++e) S.pref[e] = pref[e];
      pg8::EpiStoreBf16 E{YS, D};
      pg8::gemm_phase<pg8::EpiStoreBf16, MoeOrder, true, true, true>(lds + RING_OFF, g, S, E); }
    GRID_BAR();
    {
        const float* gf = args.in[27];
        for (int tok = gw; tok < M; tok += NGW) {
            const unsigned ee = ((const unsigned*)(meta + MT_TOKE))[tok]; int pe0 = 0, pe1 = 0;
#pragma unroll
            for (int q = 0; q < NEXP; ++q) { pe0 = (q == (int)(ee & 0xffu)) ? pref[q] : pe0; pe1 = (q == (int)((ee >> 8) & 0xffu)) ? pref[q] : pe1; }
            const unsigned s0 = (unsigned)pe0 * 256u + ((const unsigned*)(meta + MT_TOKP))[2 * tok], s1 = (unsigned)pe1 * 256u + ((const unsigned*)(meta + MT_TOKP))[2 * tok + 1];
            const float g0 = ((const float*)(meta + MT_TOKG))[2 * tok], g1 = ((const float*)(meta + MT_TOKG))[2 * tok + 1];
            GAS f32x4* xr = (GAS f32x4*)(X + (size_t)tok * D) + lane; f32x4 v[4]; float s = 0.f;
#pragma unroll
            for (int j = 0; j < 4; ++j) { v[j] = xr[64 * j]; const int k0 = 4 * lane + 256 * j;
                const v2u a = *(const v2u*)(YS + (size_t)s0 * D + k0), b2 = *(const v2u*)(YS + (size_t)s1 * D + k0);
                v[j].x += g0 * bflo(a.x) + g1 * bflo(b2.x); v[j].y += g0 * bfhi(a.x) + g1 * bfhi(b2.x); v[j].z += g0 * bflo(a.y) + g1 * bflo(b2.y); v[j].w += g0 * bfhi(a.y) + g1 * bfhi(b2.y);
                s += (v[j].x * v[j].x + v[j].y * v[j].y) + (v[j].z * v[j].z + v[j].w * v[j].w); }
            s = wave_sum(s); const float rs = 1.0f / sqrtf(s * (1.0f / 1024.0f) + pg8::RMS_EPS);
#pragma unroll
            for (int j = 0; j < 4; ++j) { const f32x4 gv = *(const f32x4*)(gf + 4 * lane + 256 * j); xr[64 * j] = v[j] * rs * gv; }
        }
    }
}

extern "C" void kernel_launch(void* const* d_in, const int* in_sizes, int n_in, void* d_out, int out_size, void* d_ws, size_t ws_size, hipStream_t stream) {
    static int grid = 0;
    if (grid == 0) {
        if (n_in != 28 || in_sizes[0] != M * D || out_size != M * D || ws_size < WS_END) { fprintf(stderr, "kernel_launch: unexpected problem: n_in %d in0 %d out %d ws %zu (need %zu)\n", n_in, n_in > 0 ? in_sizes[0] : -1, out_size, ws_size, (size_t)WS_END); grid = -1; return; }
        int dev = 0, cus = 0, per_cu = 0;
        if (hipGetDevice(&dev) != hipSuccess || hipDeviceGetAttribute(&cus, hipDeviceAttributeMultiprocessorCount, dev) != hipSuccess) { grid = -1; return; }
        if (hipFuncSetAttribute((const void*)mk_fwd, hipFuncAttributeMaxDynamicSharedMemorySize, LDS_BYTES) != hipSuccess) { fprintf(stderr, "kernel_launch: hipFuncSetAttribute failed\n"); grid = -1; return; }
        if (hipOccupancyMaxActiveBlocksPerMultiprocessor(&per_cu, (const void*)mk_fwd, NTHREADS, LDS_BYTES) != hipSuccess || per_cu < 1) fprintf(stderr, "kernel_launch: occupancy query says %d\n", per_cu);
        (void)hipGetLastError();
        grid = cus;
        if (grid != 256) fprintf(stderr, "kernel_launch: built for the 256-CU MI355X; device reports %d CUs\n", cus);
    }
    if (grid < 0) return;
    if (hipMemsetAsync((char*)d_ws + WS_CTL, 0, CTL_ZERO_BYTES, stream) != hipSuccess) return;
    Args a{};
    for (int i = 0; i < 28; ++i) a.in[i] = (const float*)d_in[i];
    a.out = (float*)d_out; a.ws = (unsigned char*)d_ws;
    hipLaunchKernelGGL(mk_fwd, dim3(grid), dim3(NTHREADS), LDS_BYTES, stream, a);
}
```

```cpp
#include <hip/hip_runtime.h>
#include <cstdio>
#include <cstdint>

namespace pg8 {
#define PG8_LAS __attribute__((address_space(3)))
typedef unsigned short bf16_t;
typedef short bf16x8 __attribute__((ext_vector_type(8)));
typedef float f32x4 __attribute__((ext_vector_type(4)));
typedef unsigned u32x4 __attribute__((ext_vector_type(4)));
typedef unsigned u32x2 __attribute__((ext_vector_type(2)));
constexpr int BM = 256, BK = 64, HALF = 128, HTB = HALF * BK * 2  , STAGE_BYTES = 8 * HTB, NXCD = 8, WGM = 8;

__host__ __device__ __forceinline__ int lds_byte(int r, int c) { const int st = (r >> 4) * 2 + (c >> 5), rr = r & 15, cc = c & 31, ob = rr * 64 + cc * 2; return st * 1024 + (ob ^ (((ob >> 9) & 1) << 5)); }
__host__ __device__ __forceinline__ void stage_rc(int b, int& R, int& C) { const int st = b / 1024, sb = b % 1024, swz = sb ^ (((sb >> 9) & 1) << 5); R = (st >> 1) * 16 + swz / 64; C = (st & 1) * 32 + (swz % 64) / 2; }
__host__ __device__ __forceinline__ int perm32(int rho) { const int n = rho >> 4, i = rho & 15; return 8 * (i >> 2) + 4 * n + (i & 3); }

struct Unit { int pm, pn, zb, pa; };
struct Gemm { const bf16_t* A; const bf16_t* Bt; int lda, ldb, K; size_t zA, zB; };

struct StaticOrder {
    int nM, nN, nZ, nwg, G, c;
    __host__ __device__ void init(int M, int N, int Z, int G_, int c_) { nM = M / BM; nN = N / BM; nZ = Z; nwg = nM * nN * nZ; G = G_; c = c_; }
    __host__ __device__ bool next(int i, Unit& u) const {
        const long L = (long)i * G + c; if (L >= nwg) return false;
        int wgid = (int)L; { const int q = nwg / NXCD, r = nwg % NXCD, xcd = wgid % NXCD, off = wgid / NXCD; wgid = (xcd < r ? xcd * (q + 1) : r * (q + 1) + (xcd - r) * q) + off; }
        const int per = nM * nN; u.zb = wgid / per; wgid -= u.zb * per;
        const int nig = WGM * nN, gid = wgid / nig, fm = gid * WGM, gsz = (nM - fm) < WGM ? (nM - fm) : WGM;
        u.pm = fm + ((wgid % nig) % gsz); u.pn = (wgid % nig) / gsz; u.pa = u.pm; return true;
    }
    __device__ __forceinline__ void a_ready(const Unit&) const {}
    __device__ __forceinline__ void done(const Unit&) const {}
};

__device__ __forceinline__ unsigned cvt_pk_bf16(float lo, float hi) { unsigned r; asm volatile("v_cvt_pk_bf16_f32 %0, %1, %2" : "=v"(r) : "v"(lo), "v"(hi)); return r; }
typedef int v4i_t __attribute__((ext_vector_type(4))); typedef int v8i_t __attribute__((ext_vector_type(8)));
__device__ __forceinline__ v8i_t cat8(bf16x8 a, bf16x8 b) { return __builtin_shufflevector(__builtin_bit_cast(v4i_t, a), __builtin_bit_cast(v4i_t, b), 0, 1, 2, 3, 4, 5, 6, 7); }
__device__ __forceinline__ unsigned pk_fp8x4(float a, float b, float c, float d) { int r = 0; r = __builtin_amdgcn_cvt_pk_fp8_f32(a, b, r, false); r = __builtin_amdgcn_cvt_pk_fp8_f32(c, d, r, true); return (unsigned)r; }
__device__ __forceinline__ float bf_lo(unsigned w) { return __uint_as_float(w << 16); }
__device__ __forceinline__ float bf_hi(unsigned w) { return __uint_as_float(w & 0xffff0000u); }
__device__ __forceinline__ float fast_sigmoid(float z) { return __builtin_amdgcn_rcpf(1.0f + __builtin_amdgcn_exp2f(-1.4426950408889634f * z)); }
constexpr float RMS_EPS = 1e-6f;
__device__ __forceinline__ float rstd16(const float* ssp, int row) { const f32x4* p = (const f32x4*)(ssp + (size_t)row * 16); const f32x4 a = p[0], b = p[1], c = p[2], d = p[3];
    const float s = (((a[0] + a[1]) + (a[2] + a[3])) + ((b[0] + b[1]) + (b[2] + b[3]))) + (((c[0] + c[1]) + (c[2] + c[3])) + ((d[0] + d[1]) + (d[2] + d[3])));
    return __builtin_amdgcn_rsqf(s * (1.0f / 1024.0f) + RMS_EPS); }

__device__ __forceinline__ void rstd8(const float* ssp, int row0, int fq, float (&rs)[8]) {
    f32x4 p[8];
#pragma unroll
    for (int i = 0; i < 8; ++i) p[i] = *(const f32x4*)(ssp + (size_t)(row0 + (i >> 2) * HALF + (i & 3) * 16) * 16 + 4 * fq);
#pragma unroll
    for (int i = 0; i < 8; ++i) { float q = (p[i][0] + p[i][1]) + (p[i][2] + p[i][3]); q += __shfl_xor(q, 16); q += __shfl_xor(q, 32); rs[i] = __builtin_amdgcn_rsqf(q * (1.0f / 1024.0f) + RMS_EPS); }
}
__device__ __forceinline__ u32x4 pack8(const f32x4 v0, const f32x4 v1) { u32x4 w; w.x = cvt_pk_bf16(v0[0], v0[1]); w.y = cvt_pk_bf16(v0[2], v0[3]); w.z = cvt_pk_bf16(v1[0], v1[1]); w.w = cvt_pk_bf16(v1[2], v1[3]); return w; }

struct EpiInProj0 {
    static constexpr bool PERM = true, AFTER_DRAIN = false;
    const float* ss; bf16_t* uext; bf16_t* qkv; float qscale;
    __device__ __forceinline__ void operator()(const f32x4 (&acc)[2][2][4][2], const Unit& u, int wr, int wc, int fr, int fq) const {
        const int row0 = u.pm * BM + wr * 64 + fr; float rsa[8]; rstd8(ss, row0, fq, rsa);
#pragma unroll
        for (int ai = 0; ai < 2; ++ai)
#pragma unroll
            for (int m = 0; m < 4; ++m) { const int row = row0 + ai * HALF + m * 16; const float rs = rsa[ai * 4 + m];
#pragma unroll
                for (int bj = 0; bj < 2; ++bj) { const int col0 = u.pn * BM + bj * HALF + wc * 32 + 8 * fq;
                    float sc = rs; bf16_t* dst;
                    if (u.pn < 2) dst = uext + ((size_t)(col0 >> 4) * 512 + (row >> 5)) * 640 + (row & 31) * 16 + (col0 & 15);
                    else { const int c = col0 - 512; if (c < 512) sc *= qscale; dst = qkv + (size_t)row * 1536 + c; }
                    *(u32x4*)dst = pack8(acc[ai][bj][m][0] * sc, acc[ai][bj][m][1] * sc); } }
    }
};
struct EpiS5State {
    static constexpr bool PERM = false, AFTER_DRAIN = false;
    float* sloc;
    __device__ __forceinline__ void operator()(const f32x4 (&acc)[2][2][4][2], const Unit& u, int wr, int wc, int fr, int fq) const {
        const int row0 = u.pm * BM + wr * 64 + fr, col0 = wc * 32 + 4 * fq;
#pragma unroll
        for (int ai = 0; ai < 2; ++ai)
#pragma unroll
            for (int m = 0; m < 4; ++m) { float* rowp = sloc + ((size_t)u.zb * 512 + row0 + ai * HALF + m * 16) * 128 + col0;
#pragma unroll
                for (int n = 0; n < 2; ++n) *(f32x4*)(rowp + n * 16) = acc[ai][0][m][n]; }
    }
};
__device__ __forceinline__ float gelu_tanh(float x) { const float a = x * (1.0f + 0.044715f * x * x); return x * __builtin_amdgcn_rcpf(1.0f + __builtin_amdgcn_exp2f(-2.302208198f * a)); }
struct EpiS5Y {
    static constexpr bool PERM = true, AFTER_DRAIN = false;
    bf16_t* yg;
    __device__ __forceinline__ void operator()(const f32x4 (&acc)[2][2][4][2], const Unit& u, int wr, int wc, int fr, int fq) const {
        const int row0 = u.pm * BM + wr * 64 + fr;
#pragma unroll
        for (int ai = 0; ai < 2; ++ai)
#pragma unroll
            for (int m = 0; m < 4; ++m) { const int chunk = row0 + ai * HALF + m * 16;
#pragma unroll
                for (int bj = 0; bj < 2; ++bj) { const int col0 = u.pn * BM + bj * HALF + wc * 32 + 8 * fq; const int i = col0 >> 4, h0 = col0 & 15;
                    f32x4 v0 = acc[ai][bj][m][0], v1 = acc[ai][bj][m][1];
#pragma unroll
                    for (int e = 0; e < 4; ++e) { v0[e] = gelu_tanh(v0[e]); v1[e] = gelu_tanh(v1[e]); }
                    *(u32x4*)(yg + ((size_t)chunk * 32 + i) * 512 + u.zb * 16 + h0) = pack8(v0, v1); } }
    }
};
struct EpiGlu {
    static constexpr bool PERM = true, AFTER_DRAIN = false;
    const bf16_t* yg; const float* bias; bf16_t* mix;
    __device__ __forceinline__ void operator()(const f32x4 (&acc)[2][2][4][2], const Unit& u, int wr, int wc, int fr, int fq) const {
        const int row0 = u.pm * BM + wr * 64 + fr; u32x4 ywa[2][8];
#pragma unroll
        for (int bj = 0; bj < 2; ++bj)
#pragma unroll
            for (int i = 0; i < 8; ++i) ywa[bj][i] = *(const u32x4*)(yg + (size_t)(row0 + (i >> 2) * HALF + (i & 3) * 16) * 512 + u.pn * BM + bj * HALF + wc * 32 + 8 * fq);
#pragma unroll
        for (int bj = 0; bj < 2; ++bj) { const int col0 = u.pn * BM + bj * HALF + wc * 32 + 8 * fq;
            const f32x4 b0 = *(const f32x4*)(bias + col0), b1 = *(const f32x4*)(bias + col0 + 4);
#pragma unroll
            for (int ai = 0; ai < 2; ++ai)
#pragma unroll
                for (int m = 0; m < 4; ++m) { const int row = row0 + ai * HALF + m * 16;
                    const u32x4 yw = ywa[bj][ai * 4 + m];
                    f32x4 z0 = acc[ai][bj][m][0] + b0, z1 = acc[ai][bj][m][1] + b1, o0, o1;
                    o0[0] = bf_lo(yw.x) * fast_sigmoid(z0[0]); o0[1] = bf_hi(yw.x) * fast_sigmoid(z0[1]); o0[2] = bf_lo(yw.y) * fast_sigmoid(z0[2]); o0[3] = bf_hi(yw.y) * fast_sigmoid(z0[3]);
                    o1[0] = bf_lo(yw.z) * fast_sigmoid(z1[0]); o1[1] = bf_hi(yw.z) * fast_sigmoid(z1[1]); o1[2] = bf_lo(yw.w) * fast_sigmoid(z1[2]); o1[3] = bf_hi(yw.w) * fast_sigmoid(z1[3]);
                    *(u32x4*)(mix + (size_t)row * 1024 + col0) = pack8(o0, o1); } }
    }
};
struct EpiResid {
    static constexpr bool PERM = false, AFTER_DRAIN = false;
    const float* R; float* X; bf16_t* xb; float* ssq;
    __device__ __forceinline__ void operator()(const f32x4 (&acc)[2][2][4][2], const Unit& u, int wr, int wc, int fr, int fq) const {
        const int row0 = u.pm * BM + wr * 64 + fr, col0 = u.pn * BM + wc * 32 + 4 * fq;
#pragma unroll
        for (int ai = 0; ai < 2; ++ai) {
            f32x4 rv[4][2][2];
#pragma unroll
            for (int m = 0; m < 4; ++m)
#pragma unroll
                for (int bj = 0; bj < 2; ++bj)
#pragma unroll
                    for (int n = 0; n < 2; ++n) rv[m][bj][n] = *(const f32x4*)(R + (size_t)(row0 + ai * HALF + m * 16) * 1024 + col0 + bj * HALF + n * 16);
            asm volatile("" ::: "memory");
#pragma unroll
            for (int m = 0; m < 4; ++m) { const int row = row0 + ai * HALF + m * 16; const size_t off = (size_t)row * 1024 + col0; float s = 0.f;
#pragma unroll
                for (int bj = 0; bj < 2; ++bj)
#pragma unroll
                    for (int n = 0; n < 2; ++n) { const f32x4 x = rv[m][bj][n] + acc[ai][bj][m][n];
                        *(f32x4*)(X + off + bj * HALF + n * 16) = x; s += (x[0] * x[0] + x[1] * x[1]) + (x[2] * x[2] + x[3] * x[3]);
                        u32x2 w; w.x = cvt_pk_bf16(x[0], x[1]); w.y = cvt_pk_bf16(x[2], x[3]); *(u32x2*)(xb + off + bj * HALF + n * 16) = w; }
                s += __shfl_xor(s, 16); s += __shfl_xor(s, 32);
                if (fq == 0) ssq[(size_t)row * 16 + u.pn * 4 + wc] = s; }
            asm volatile("" ::: "memory"); }
    }
};
template <bool RS_IS_SSQ> struct EpiSwiGlu {
    static constexpr bool PERM = true, AFTER_DRAIN = false;
    const float* rsv; bf16_t* H; int ldh;
    __device__ __forceinline__ void operator()(const f32x4 (&acc)[2][2][4][2], const Unit& u, int wr, int wc, int fr, int fq) const {
        const int row0 = u.pm * BM + wr * 64 + fr, col0 = u.pn * HALF + wc * 32 + 8 * fq; float rsa[8];
        if (RS_IS_SSQ) rstd8(rsv, row0, fq, rsa);
        else {
#pragma unroll
            for (int i = 0; i < 8; ++i) rsa[i] = rsv[row0 + (i >> 2) * HALF + (i & 3) * 16]; }
#pragma unroll
        for (int ai = 0; ai < 2; ++ai)
#pragma unroll
            for (int m = 0; m < 4; ++m) { const int row = row0 + ai * HALF + m * 16; const float rs = rsa[ai * 4 + m];
                f32x4 o[2];
#pragma unroll
                for (int n = 0; n < 2; ++n)
#pragma unroll
                    for (int e = 0; e < 4; ++e) { const float g = acc[ai][0][m][n][e] * rs, up = acc[ai][1][m][n][e] * rs; o[n][e] = g * fast_sigmoid(g) * up; }
                *(u32x4*)(H + (size_t)row * ldh + col0) = pack8(o[0], o[1]); }
    }
};
struct EpiSwiGluFp8 {
    static constexpr bool PERM = true, AFTER_DRAIN = false;
    const float* rsv; unsigned char* H; int ldh;
    __device__ __forceinline__ void operator()(const f32x4 (&acc)[2][2][4][2], const Unit& u, int wr, int wc, int fr, int fq) const {
        const int row0 = u.pm * BM + wr * 64 + fr, col0 = u.pn * HALF + wc * 32 + 8 * fq; float rsa[8];
#pragma unroll
        for (int i = 0; i < 8; ++i) rsa[i] = rsv[u.pa * BM + wr * 64 + fr + (i >> 2) * HALF + (i & 3) * 16];
#pragma unroll
        for (int ai = 0; ai < 2; ++ai)
#pragma unroll
            for (int m = 0; m < 4; ++m) { const int row = row0 + ai * HALF + m * 16; const float rs = rsa[ai * 4 + m];
                f32x4 o[2];
#pragma unroll
                for (int n = 0; n < 2; ++n)
#pragma unroll
                    for (int e = 0; e < 4; ++e) { const float g = acc[ai][0][m][n][e] * rs, up = acc[ai][1][m][n][e] * rs; o[n][e] = g * fast_sigmoid(g) * up; }
                u32x2 w; w.x = pk_fp8x4(o[0][0], o[0][1], o[0][2], o[0][3]); w.y = pk_fp8x4(o[1][0], o[1][1], o[1][2], o[1][3]);
                *(u32x2*)(H + (size_t)row * ldh + col0) = w; }
    }
};
struct EpiInProj1 {
    static constexpr bool PERM = true, AFTER_DRAIN = false;
    const float* ss; bf16_t* qkv; float qscale;
    unsigned* kn;
    __device__ __forceinline__ void operator()(const f32x4 (&acc)[2][2][4][2], const Unit& u, int wr, int wc, int fr, int fq) const {
        const int row0 = u.pm * BM + wr * 64 + fr; const float qs = (u.pn < 4) ? qscale : 1.0f; float rsa[8]; rstd8(ss, row0, fq, rsa);
#pragma unroll
        for (int ai = 0; ai < 2; ++ai)
#pragma unroll
            for (int m = 0; m < 4; ++m) { const int row = row0 + ai * HALF + m * 16; const float sc = rsa[ai * 4 + m] * qs;
#pragma unroll
                for (int bj = 0; bj < 2; ++bj) { const int col0 = (u.pn & 3) * BM + bj * HALF + wc * 32 + 8 * fq;
                    const f32x4 v0 = acc[ai][bj][m][0] * sc, v1 = acc[ai][bj][m][1] * sc;
                    *(u32x4*)(qkv + (size_t)(u.pn >> 2) * (16384 * 1024) + (size_t)row * 1024 + col0) = pack8(v0, v1);
                    if ((u.pn >> 2) == 1) {
                        float q = ((v0[0] * v0[0] + v0[1] * v0[1]) + (v0[2] * v0[2] + v0[3] * v0[3])) + ((v1[0] * v1[0] + v1[1] * v1[1]) + (v1[2] * v1[2] + v1[3] * v1[3]));
                        q += __shfl_xor(q, 16); q += __shfl_xor(q, 32);
                        q = fmaxf(q, __shfl_xor(q, 1)); q = fmaxf(q, __shfl_xor(q, 2)); q = fmaxf(q, __shfl_xor(q, 4)); q = fmaxf(q, __shfl_xor(q, 8));
                        if (fr == 0 && fq == 0) { const int head = (u.pn & 3) * 4 + bj * 2 + (wc >> 1), bb = row >> 13, tile = (row & 8191) >> 6;
                            atomicMax(kn + ((size_t)(bb * 16 + head) * 128 + tile) * 2 + (wc & 1), __float_as_uint(q * 1.01f)); } } } }
    }
};
struct EpiStoreBf16 {
    static constexpr bool PERM = true, AFTER_DRAIN = false;
    bf16_t* O; int ldc;
    __device__ __forceinline__ void operator()(const f32x4 (&acc)[2][2][4][2], const Unit& u, int wr, int wc, int fr, int fq) const {
        const int row0 = u.pm * BM + wr * 64 + fr;
#pragma unroll
        for (int ai = 0; ai < 2; ++ai)
#pragma unroll
            for (int m = 0; m < 4; ++m) { const int row = row0 + ai * HALF + m * 16;
#pragma unroll
                for (int bj = 0; bj < 2; ++bj) { const int col0 = u.pn * BM + bj * HALF + wc * 32 + 8 * fq;
                    *(u32x4*)(O + (size_t)row * ldc + col0) = pack8(acc[ai][bj][m][0], acc[ai][bj][m][1]); } }
    }
};

template <bool F8> struct Frag { bf16x8 k[2]; };
template <> struct Frag<true> { v8i_t v; };
template <class Epi, class Sched, bool ALIGN_EPI = false, bool SP2 = false, bool FP8 = false>
__device__ __forceinline__ void gemm_phase(PG8_LAS unsigned char* lds, const Gemm g, const Sched& S, const Epi& E) {
    int tid_ = threadIdx.x; asm volatile("" : "+v"(tid_));
    const int tid = tid_, wid = __builtin_amdgcn_readfirstlane(tid >> 6), lane = tid & 63, wr = wid >> 2, wc = wid & 3, fr = lane & 15, fq = lane >> 4;
    const int K = g.K, nt = K / BK;
    unsigned voffA[2], voffB[2];
#pragma unroll
    for (int i = 0; i < 2; ++i) { int R, C; stage_rc(tid * 16 + i * 8192, R, C); const int Rb = Epi::PERM ? ((R & ~31) + perm32(R & 31)) : R;
        voffA[i] = (unsigned)(R * g.lda + C) * 2u; voffB[i] = (unsigned)(Rb * g.ldb + C) * 2u; }
    const size_t kstep = (size_t)(BK * 2);
    const size_t hstepA = (size_t)HALF * g.lda * 2, hstepB = (size_t)HALF * g.ldb * 2;
    const size_t tstepA = 2 * hstepA, tstepB = 2 * hstepB;
    const unsigned ldsw = (unsigned)wid * 1024u;
    const int aoff = lds_byte(wr * 64 + fr, fq * 8), boff = lds_byte(wc * 32 + fr, fq * 8);
#define PG8_SA(b, h) (((b) * 2 + (h)) * HTB)
#define PG8_SB(b, h) ((4 + (b) * 2 + (h)) * HTB)
#define PG8_STAGE(bufoff, gbase, voff) do { _Pragma("unroll") for (int _i = 0; _i < 2; ++_i) \
        __builtin_amdgcn_global_load_lds((const unsigned*)((const char*)(gbase) + (voff)[_i]), (PG8_LAS unsigned*)(lds + (bufoff) + ldsw + _i * 8192), 16, 0, 0); } while (0)
    const PG8_LAS unsigned char* ldsA_ = lds + aoff; const PG8_LAS unsigned char* ldsB_ = lds + 4 * HTB + boff; asm volatile("" : "+v"(ldsA_), "+v"(ldsB_));
#define PG8_RDA(off) (*(const PG8_LAS bf16x8*)(ldsA_ + (off)))
#define PG8_RDB(off) (*(const PG8_LAS bf16x8*)(ldsB_ + (off)))
#define PG8_LDA(dst, b, h) do { _Pragma("unroll") for (int m = 0; m < 4; ++m) { if constexpr (FP8) dst[m].v = cat8(PG8_RDA(PG8_SA(b, h) + m * 2048), PG8_RDA(PG8_SA(b, h) + m * 2048 + 1024)); \
        else { dst[m].k[0] = PG8_RDA(PG8_SA(b, h) + m * 2048); dst[m].k[1] = PG8_RDA(PG8_SA(b, h) + m * 2048 + 1024); } } } while (0)
#define PG8_LDB(dst, b, h) do { _Pragma("unroll") for (int n = 0; n < 2; ++n) { if constexpr (FP8) dst[n].v = cat8(PG8_RDB(PG8_SB(b, h) - 4 * HTB + n * 2048), PG8_RDB(PG8_SB(b, h) - 4 * HTB + n * 2048 + 1024)); \
        else { dst[n].k[0] = PG8_RDB(PG8_SB(b, h) - 4 * HTB + n * 2048); dst[n].k[1] = PG8_RDB(PG8_SB(b, h) - 4 * HTB + n * 2048 + 1024); } } } while (0)
#define PG8_MMA(ai, bj, At, Bt) do { __builtin_amdgcn_s_setprio(1); _Pragma("unroll") for (int m = 0; m < 4; ++m) _Pragma("unroll") for (int n = 0; n < 2; ++n) { \
        if constexpr (FP8) { asm volatile("v_mfma_scale_f32_16x16x128_f8f6f4 %0, %1, %2, %0, %3, %4 op_sel_hi:[0,0,0]" : "+v"(acc[ai][bj][m][n]) : "v"(Bt[n].v), "v"(At[m].v), "v"(sclB_), "v"(sclA_)); } \
        else { _Pragma("unroll") for (int k = 0; k < 2; ++k) acc[ai][bj][m][n] = __builtin_amdgcn_mfma_f32_16x16x32_bf16(Bt[n].k[k], At[m].k[k], acc[ai][bj][m][n], 0, 0, 0); } } __builtin_amdgcn_s_setprio(0); } while (0)
#define PG8_WAIT_V(n) asm volatile("s_waitcnt vmcnt(" #n ")" ::: "memory")
#define PG8_WAIT_L(n) asm volatile("s_waitcnt lgkmcnt(" #n ")" ::: "memory")
#define PG8_BAR __builtin_amdgcn_s_barrier()
#define PG8_SCHED __builtin_amdgcn_sched_barrier(0)
    Unit cur, nxt; int ui = 0;
    if (!S.next(0, cur)) return;
    f32x4 acc[2][2][4][2];
#pragma unroll
    for (int a = 0; a < 2; ++a)
#pragma unroll
        for (int b = 0; b < 2; ++b)
#pragma unroll
            for (int m = 0; m < 4; ++m)
#pragma unroll
                for (int n = 0; n < 2; ++n) acc[a][b][m][n] = (f32x4){0.f, 0.f, 0.f, 0.f};
    Frag<FP8> At[4], B0[2], B1[2];
    int sclB_ = 0x79797979, sclA_ = 0x7f7f7f7f; asm volatile("" : "+v"(sclB_), "+v"(sclA_));
    const char* cA = (const char*)g.A + (size_t)cur.zb * g.zA + (size_t)cur.pa * tstepA; const char* cB = (const char*)g.Bt + (size_t)cur.zb * g.zB + (size_t)cur.pn * tstepB;
    S.a_ready(cur);
    if constexpr (SP2) {
        PG8_STAGE(PG8_SB(0, 0), cB, voffB); PG8_STAGE(PG8_SB(0, 1), cB + hstepB, voffB); PG8_STAGE(PG8_SA(0, 0), cA, voffA); PG8_STAGE(PG8_SA(0, 1), cA + hstepA, voffA);
        if (wr == 1) PG8_BAR;
        PG8_WAIT_V(2); PG8_BAR;
        PG8_STAGE(PG8_SB(1, 0), cB + kstep, voffB); PG8_STAGE(PG8_SA(1, 0), cA + kstep, voffA); PG8_STAGE(PG8_SB(1, 1), cB + hstepB + kstep, voffB);
        PG8_WAIT_V(6); PG8_BAR;
    } else {
        PG8_STAGE(PG8_SB(0, 0), cB, voffB); PG8_STAGE(PG8_SA(0, 0), cA, voffA); PG8_STAGE(PG8_SB(0, 1), cB + hstepB, voffB); PG8_STAGE(PG8_SA(0, 1), cA + hstepA, voffA);
        if (wr == 1) PG8_BAR;
        PG8_WAIT_V(4); PG8_BAR;
        PG8_STAGE(PG8_SB(1, 0), cB + kstep, voffB); PG8_STAGE(PG8_SA(1, 0), cA + kstep, voffA); PG8_STAGE(PG8_SB(1, 1), cB + hstepB + kstep, voffB);
        PG8_WAIT_V(6); PG8_BAR;
    }
    for (;;) {
        const bool has_next = S.next(ui + 1, nxt);
        const char* nA = has_next ? (const char*)g.A + (size_t)nxt.zb * g.zA + (size_t)nxt.pa * tstepA : cA; const char* nB = has_next ? (const char*)g.Bt + (size_t)nxt.zb * g.zB + (size_t)nxt.pn * tstepB : cB;
#pragma unroll 1
        for (int t = 0; t < nt; t += 2) {
            const bool last = (t == nt - 2);
            const char* a1 = cA + (size_t)(t + 1) * kstep;
            const char* a2 = last ? nA : cA + (size_t)(t + 2) * kstep; const char* b2 = last ? nB : cB + (size_t)(t + 2) * kstep;
            const char* a3 = a2 + kstep; const char* b3 = b2 + kstep;
            if (last && has_next) S.a_ready(nxt);
            if constexpr (SP2) {
            PG8_LDB(B0, 0, 0); PG8_LDB(B1, 0, 1); PG8_SCHED; PG8_LDA(At, 0, 0); PG8_STAGE(PG8_SA(1, 1), a1 + hstepA, voffA);
            PG8_WAIT_V(8); PG8_WAIT_L(0); PG8_BAR; PG8_MMA(0, 0, At, B0); PG8_MMA(0, 1, At, B1); PG8_BAR; PG8_SCHED;
            PG8_LDA(At, 0, 1); PG8_STAGE(PG8_SB(0, 0), b2, voffB); PG8_STAGE(PG8_SB(0, 1), b2 + hstepB, voffB); PG8_STAGE(PG8_SA(0, 0), a2, voffA);
            PG8_WAIT_V(8); PG8_WAIT_L(0); PG8_BAR; PG8_MMA(1, 0, At, B0); PG8_MMA(1, 1, At, B1); PG8_BAR; PG8_SCHED;
            PG8_LDB(B0, 1, 0); PG8_LDB(B1, 1, 1); PG8_SCHED; PG8_LDA(At, 1, 0); PG8_STAGE(PG8_SA(0, 1), a2 + hstepA, voffA);
            PG8_WAIT_V(8); PG8_WAIT_L(0); PG8_BAR; PG8_MMA(0, 0, At, B0); PG8_MMA(0, 1, At, B1); PG8_BAR; PG8_SCHED;
            PG8_LDA(At, 1, 1); PG8_STAGE(PG8_SB(1, 0), b3, voffB); PG8_STAGE(PG8_SB(1, 1), b3 + hstepB, voffB); PG8_STAGE(PG8_SA(1, 0), a3, voffA);
            PG8_WAIT_V(8); PG8_WAIT_L(0); PG8_BAR; PG8_MMA(1, 0, At, B0); PG8_MMA(1, 1, At, B1); PG8_BAR; PG8_SCHED;
            } else {
            PG8_LDB(B0, 0, 0); PG8_SCHED; PG8_LDA(At, 0, 0); PG8_STAGE(PG8_SA(1, 1), a1 + hstepA, voffA);
            PG8_WAIT_L(8); PG8_BAR; PG8_WAIT_L(0); PG8_MMA(0, 0, At, B0); PG8_BAR; PG8_SCHED;
            PG8_LDB(B1, 0, 1); PG8_STAGE(PG8_SB(0, 0), b2, voffB);
            PG8_BAR; PG8_WAIT_L(0); PG8_MMA(0, 1, At, B1); PG8_BAR;
            PG8_LDA(At, 0, 1); PG8_STAGE(PG8_SA(0, 0), a2, voffA);
            PG8_BAR; PG8_WAIT_L(0); PG8_MMA(1, 0, At, B0); PG8_BAR; PG8_SCHED;
            PG8_STAGE(PG8_SB(0, 1), b2 + hstepB, voffB);
            PG8_WAIT_V(6); PG8_BAR; PG8_MMA(1, 1, At, B1); PG8_BAR;
            PG8_LDB(B0, 1, 0); PG8_SCHED; PG8_LDA(At, 1, 0); PG8_STAGE(PG8_SA(0, 1), a2 + hstepA, voffA);
            PG8_WAIT_L(8); PG8_BAR; PG8_WAIT_L(0); PG8_MMA(0, 0, At, B0); PG8_BAR; PG8_SCHED;
            PG8_LDB(B1, 1, 1); PG8_STAGE(PG8_SB(1, 0), b3, voffB);
            PG8_BAR; PG8_WAIT_L(0); PG8_MMA(0, 1, At, B1); PG8_BAR;
            PG8_LDA(At, 1, 1); PG8_STAGE(PG8_SA(1, 0), a3, voffA);
            PG8_BAR; PG8_WAIT_L(0); PG8_MMA(1, 0, At, B0); PG8_BAR; PG8_SCHED;
            PG8_STAGE(PG8_SB(1, 1), b3 + hstepB, voffB);
            PG8_WAIT_V(6); PG8_BAR; PG8_MMA(1, 1, At, B1); PG8_BAR;
            }
        }
        if constexpr (ALIGN_EPI) { if (wr == 0) PG8_BAR; }
        if constexpr (FP8) asm volatile("s_nop 15\n\ts_nop 15" ::: "memory");
        if constexpr (!Epi::AFTER_DRAIN) { int fr_ = fr, fq_ = fq; asm volatile("" : "+v"(fr_), "+v"(fq_));
            E(acc, cur, wr, wc, fr_, fq_); S.done(cur); }
        if (!has_next) break;
#pragma unroll
        for (int a = 0; a < 2; ++a)
#pragma unroll
            for (int b = 0; b < 2; ++b)
#pragma unroll
                for (int m = 0; m < 4; ++m)
#pragma unroll
                    for (int n = 0; n < 2; ++n) acc[a][b][m][n] = (f32x4){0.f, 0.f, 0.f, 0.f};
        cur = nxt; cA = nA; cB = nB; ++ui;
        if constexpr (ALIGN_EPI) { if (wr == 1) PG8_BAR; }
    }
    PG8_WAIT_V(0);
    if constexpr (!ALIGN_EPI) { if (wr == 0) PG8_BAR; }
    PG8_BAR;
    if constexpr (Epi::AFTER_DRAIN) { E.fused(acc, cur, wr, wc, fr, fq, lds, wid, lane); S.done(cur); }
#undef PG8_SA
#undef PG8_SB
#undef PG8_STAGE
#undef PG8_LDA
#undef PG8_RDA
#undef PG8_RDB
#undef PG8_LDB
#undef PG8_MMA
#undef PG8_WAIT_V
#undef PG8_WAIT_L
#undef PG8_BAR
#undef PG8_SCHED
}
}

#include <hip/hip_bf16.h>
#include <cmath>
namespace attn_body {
using bf16=__hip_bfloat16;
using bf16x8=__attribute__((ext_vector_type(8)))short;
using s16x4=__attribute__((ext_vector_type(4)))short;
using f32x16=__attribute__((ext_vector_type(16)))float;
using u32x4=__attribute__((ext_vector_type(4)))unsigned;
constexpr int BATCH=2,NHEAD=16,SEQ=8192,D=64,DM=NHEAD*D;
constexpr int NW=8,QBLK=32,QB=QBLK*NW,KVBLK=64,NQB=SEQ/QB;
constexpr int ATTN_PITCH=DM, ATTN_UNIT_ROWS=QB;
__device__ __forceinline__ int crow(int r,int hi){return (r&3)+8*(r>>2)+4*hi;}
#define SBAR() __builtin_amdgcn_sched_barrier(0)
__device__ __forceinline__ void cmask(f32x16&p0,f32x16&p1,int jb,int qrel,int hi){
  const float NEG=-INFINITY; int kb=64*jb+4*hi;
  #pragma unroll
  for(int r=0;r<16;++r){int kv=kb+(r&3)+8*(r>>2); if(kv>qrel)p0[r]=NEG; if(kv+32>qrel)p1[r]=NEG;}
}

constexpr int NSLOT=3, SLOTB=8192;
constexpr int LDS_K=0, LDS_V=NSLOT*SLOTB, LDS_WS=2*NSLOT*SLOTB, LDS_OST=LDS_WS+NW*64*4, LDS_NB=LDS_OST+NW*4096  , LDS_PK=LDS_NB+32768+64  , LDS_BYTES=LDS_PK+1024;
constexpr float C2=0.125f*1.4426950408889634f;
__device__ __forceinline__ void glds16(const void*gsrc,unsigned lds_dst){unsigned keep;
  asm volatile("s_mov_b32 %0, m0\n\ts_mov_b32 m0, %2\n\ts_nop 0\n\tglobal_load_lds_dwordx4 %1, off\n\ts_mov_b32 m0, %0":"=&s"(keep):"v"(gsrc),"s"(lds_dst):"memory");}
__device__ __forceinline__ float max3f(float a,float b,float c){float r;asm("v_max3_f32 %0, %1, %2, %3":"=v"(r):"v"(a),"v"(b),"v"(c));return r;}
__device__ __forceinline__ float max2f(float a,float b){float r;asm("v_max_f32_e32 %0, %1, %2":"=v"(r):"v"(a),"v"(b));return r;}
__device__ __forceinline__ float fadd_s(float a,float b){float r;asm("v_add_f32_e32 %0, %1, %2":"=v"(r):"v"(a),"v"(b));return r;}
__device__ __forceinline__ float fsub_s(float a,float b){float r;asm("v_sub_f32_e32 %0, %1, %2":"=v"(r):"v"(a),"v"(b));return r;}
typedef float f32x2_t __attribute__((ext_vector_type(2))); typedef __bf16 bf16x2_t __attribute__((ext_vector_type(2)));
__device__ __forceinline__ unsigned cvtpk_s(float lo,float hi){f32x2_t v={lo,hi};bf16x2_t b=__builtin_convertvector(v,bf16x2_t);return __builtin_bit_cast(unsigned,b);}
#define WAIT_BAR(N) asm volatile("s_waitcnt vmcnt(" #N ") lgkmcnt(0)\n\ts_barrier":::"memory")

__device__ __forceinline__ void qkt(f32x16&p0,f32x16&p1,const char*Kslot,const bf16x8*qr,const f32x16&negm,int r32,int hi){
  const char*kb=Kslot+hi*1024+r32*16;
  #pragma unroll
  for(int d0=0;d0<4;++d0){
    const bf16x8 b0=*reinterpret_cast<const bf16x8*>(kb+d0*2048);
    const bf16x8 b1=*reinterpret_cast<const bf16x8*>(kb+d0*2048+512);
    if(d0==0){p0=__builtin_amdgcn_mfma_f32_32x32x16_bf16(b0,qr[0],negm,0,0,0);p1=__builtin_amdgcn_mfma_f32_32x32x16_bf16(b1,qr[0],negm,0,0,0);}
    else{p0=__builtin_amdgcn_mfma_f32_32x32x16_bf16(b0,qr[d0],p0,0,0,0);p1=__builtin_amdgcn_mfma_f32_32x32x16_bf16(b1,qr[d0],p1,0,0,0);}}
}
typedef __attribute__((address_space(3))) const char* lds_cptr;
typedef short v4i16_t __attribute__((ext_vector_type(4)));
__device__ __forceinline__ void kload8(bf16x8*kf,lds_cptr kp){
  kf[0]=*(const __attribute__((address_space(3))) bf16x8*)(kp);      kf[1]=*(const __attribute__((address_space(3))) bf16x8*)(kp+512);
  kf[2]=*(const __attribute__((address_space(3))) bf16x8*)(kp+2048); kf[3]=*(const __attribute__((address_space(3))) bf16x8*)(kp+2560);
  kf[4]=*(const __attribute__((address_space(3))) bf16x8*)(kp+4096); kf[5]=*(const __attribute__((address_space(3))) bf16x8*)(kp+4608);
  kf[6]=*(const __attribute__((address_space(3))) bf16x8*)(kp+6144); kf[7]=*(const __attribute__((address_space(3))) bf16x8*)(kp+6656);
}
__device__ __forceinline__ void kload2(bf16x8*kf,lds_cptr kp,int j){ kf[2*j]=*(const __attribute__((address_space(3))) bf16x8*)(kp+j*2048); kf[2*j+1]=*(const __attribute__((address_space(3))) bf16x8*)(kp+j*2048+512); }
__device__ __forceinline__ s16x4 vtr(lds_cptr p){ return __builtin_bit_cast(s16x4,__builtin_amdgcn_ds_read_tr16_b64_v4i16((__attribute__((address_space(3))) v4i16_t*)p)); }
__device__ __forceinline__ float rowmax(const f32x16&p0,const f32x16&p1){
  float a=max3f(p0[0],p0[1],p1[0]),b=max3f(p0[2],p0[3],p1[1]);a=max3f(a,p1[2],p1[3]);
  #pragma unroll
  for(int r=4;r<16;r+=4){a=max3f(a,p0[r],p0[r+1]);b=max3f(b,p0[r+2],p0[r+3]);a=max3f(a,p1[r],p1[r+1]);b=max3f(b,p1[r+2],p1[r+3]);}
  const float m=max2f(a,b);
  auto rr=__builtin_amdgcn_permlane32_swap(__float_as_uint(m),__float_as_uint(m),false,false);
  return max2f(__uint_as_float(rr[0]),__uint_as_float(rr[1]));
}
__device__ __forceinline__ void pv(f32x16*o,int vb,bf16x8 pa0,bf16x8 pa1,bf16x8 pa2,bf16x8 pa3){
  #pragma unroll
  for(int d0=0;d0<2;++d0){s16x4 lo[4],hi[4];
    #pragma unroll
    for(int ks=0;ks<4;++ks){
      asm volatile("ds_read_b64_tr_b16 %0,%1 offset:%c2":"=&v"(lo[ks]):"v"(vb),"i"(d0*4096+ks*1024):"memory");
      asm volatile("ds_read_b64_tr_b16 %0,%1 offset:%c2":"=&v"(hi[ks]):"v"(vb),"i"(d0*4096+ks*1024+512):"memory");}
    asm volatile("s_waitcnt lgkmcnt(0)":::"memory");SBAR();
    #define PK(k) (bf16x8){lo[k][0],lo[k][1],lo[k][2],lo[k][3],hi[k][0],hi[k][1],hi[k][2],hi[k][3]}
    o[d0]=__builtin_amdgcn_mfma_f32_32x32x16_bf16(pa0,PK(0),o[d0],0,0,0);
    o[d0]=__builtin_amdgcn_mfma_f32_32x32x16_bf16(pa1,PK(1),o[d0],0,0,0);
    o[d0]=__builtin_amdgcn_mfma_f32_32x32x16_bf16(pa2,PK(2),o[d0],0,0,0);
    o[d0]=__builtin_amdgcn_mfma_f32_32x32x16_bf16(pa3,PK(3),o[d0],0,0,0);
    #undef PK
  }
}

typedef float f32x4_t __attribute__((ext_vector_type(4)));
__device__ __forceinline__ void fox_negcum(const float*logf,__attribute__((address_space(3))) float*ncum,__attribute__((address_space(3))) float*wtot,int tid){
  float loc[16];float s=0.f; const f32x4_t*lp=(const f32x4_t*)(logf+tid*16);
  #pragma unroll
  for(int j=0;j<4;++j){const f32x4_t v=lp[j]; s+=v[0];loc[4*j]=s; s+=v[1];loc[4*j+1]=s; s+=v[2];loc[4*j+2]=s; s+=v[3];loc[4*j+3]=s;}
  float inc=s;
  #pragma unroll
  for(int o=1;o<64;o<<=1){const float v=__shfl_up(inc,o); if((tid&63)>=o)inc+=v;}
  if((tid&63)==63)wtot[tid>>6]=inc;
  __syncthreads();
  float base=inc-s; for(int w=0;w<(tid>>6);++w)base+=wtot[w];
  #pragma unroll
  for(int j=0;j<4;++j){ f32x4_t o4; o4[0]=-(base+loc[4*j]);o4[1]=-(base+loc[4*j+1]);o4[2]=-(base+loc[4*j+2]);o4[3]=-(base+loc[4*j+3]); *(__attribute__((address_space(3))) f32x4_t*)(ncum+tid*16+4*j)=o4; }
  __syncthreads();
}
#ifndef ATTN_STORE16
#define ATTN_STORE16(p,v) (*(u32x4*)(p)=(v))
#endif
template<int THRL> __device__ __forceinline__ void attn_unit(int b,int h,int qb,const bf16*Q,const bf16*__restrict__ K,const bf16*__restrict__ V,bf16*O,char*shm,const float*logf_bh,const unsigned*kn_bh){
  int tid_=threadIdx.x; asm volatile("":"+v"(tid_)); const int tid=tid_,lane=tid&63,r32=lane&31,hi=lane>>5; const int wid=__builtin_amdgcn_readfirstlane(tid>>6);
  const long rowbase=(long)b*SEQ; const int q0=qb*QB;
  const bf16*Qw=Q+(rowbase+q0+wid*QBLK)*DM+h*D;
  const bf16*Kh=K+rowbase*DM+h*D,*Vh=V+rowbase*DM+h*D;
  const unsigned lds0=(unsigned)(uintptr_t)shm;
  float*wsf=(float*)(shm+LDS_WS)+wid*64;
  const bf16*ksrc=Kh+(long)lane*DM+wid*8;
  const bf16*vsrc=Vh+(long)(16*(wid&3)+(lane>>2))*DM+(wid>>2)*32+(lane&3)*8;
  const unsigned kdst=lds0+LDS_K+wid*1024, vdst=lds0+LDS_V+wid*1024;
  #define TIDX(t) (NTR-1-(t))
  #define DMA_K(t,slot) glds16(ksrc+(long)TIDX(t)*KVBLK*DM,(unsigned)__builtin_amdgcn_readfirstlane(kdst+(slot)))
  #define DMA_V(t,slot) glds16(vsrc+(long)TIDX(t)*KVBLK*DM,(unsigned)__builtin_amdgcn_readfirstlane(vdst+(slot)))
  const int vb0=(int)(lds0+LDS_V)+((lane>>4)&1)*32+(lane&3)*8+(4*hi+((lane&15)>>2))*64;
  const char*Kbase=shm+LDS_K; bf16x8 kf[8];
  const lds_cptr shm3=(lds_cptr)shm; const lds_cptr kp0=shm3+LDS_K+hi*1024+r32*16; const lds_cptr vp0=shm3+LDS_V+((lane>>4)&1)*32+(lane&3)*8+(4*hi+((lane&15)>>2))*64;
  const int NTR=(q0+QB)/KVBLK;
  const lds_cptr shm3b=(lds_cptr)shm;
  const __attribute__((address_space(3))) float* nb3=(const __attribute__((address_space(3))) float*)(shm3b+LDS_NB);
  fox_negcum(logf_bh,(__attribute__((address_space(3))) float*)(shm3b+LDS_NB),(__attribute__((address_space(3))) float*)(shm3b+LDS_NB+32768),tid);
  int NT;
  { __attribute__((address_space(3))) float* PK=(__attribute__((address_space(3))) float*)(shm3b+LDS_PK);
    __attribute__((address_space(3))) int* JX=(__attribute__((address_space(3))) int*)(shm3b+LDS_PK+512);
    float pk=0.f;
    if(tid<128){ const float a=__uint_as_float(kn_bh[2*tid]),c=__uint_as_float(kn_bh[2*tid+1]); pk=__builtin_sqrtf(a+c)*1.001f; }
    #pragma unroll
    for(int o_=1;o_<64;o_<<=1){const float v=__shfl_up(pk,o_); if((tid&63)>=o_)pk=__builtin_fmaxf(pk,v);}
    if(tid==63)PK[128]=pk;
    __syncthreads();
    if(tid>=64&&tid<128)pk=__builtin_fmaxf(pk,PK[128]);
    if(tid<128)PK[tid]=pk;
    const bf16*Krow=Kh+(long)(q0+wid*QBLK+r32)*DM+hi*8; const bf16*Qrow=Qw+(long)r32*DM+hi*8; float qq=0.f,qk=0.f;
    #pragma unroll
    for(int d0=0;d0<4;++d0){ const u32x4 qa=*reinterpret_cast<const u32x4*>(Qrow+d0*16), ka=*reinterpret_cast<const u32x4*>(Krow+d0*16);
      #pragma unroll
      for(int e=0;e<4;++e){ const float q0f=__uint_as_float(qa[e]<<16),q1f=__uint_as_float(qa[e]&0xffff0000u),k0f=__uint_as_float(ka[e]<<16),k1f=__uint_as_float(ka[e]&0xffff0000u);
        qq+=q0f*q0f+q1f*q1f; qk+=q0f*k0f+q1f*k1f; } }
    { auto r1=__builtin_amdgcn_permlane32_swap(__float_as_uint(qq),__float_as_uint(qq),false,false); qq=__uint_as_float(r1[0])+__uint_as_float(r1[1]);
      auto r2=__builtin_amdgcn_permlane32_swap(__float_as_uint(qk),__float_as_uint(qk),false,false); qk=__uint_as_float(r2[0])+__uint_as_float(r2[1]); }
    __syncthreads();
    const float qn=__builtin_sqrtf(qq)*1.001f, thr=qk+nb3[q0+wid*QBLK+r32]-152.f;
    int lo_=0,hi_=NTR;
    #pragma unroll 1
    for(int it=0;it<8;++it){ if(lo_<hi_){ const int mid=(lo_+hi_)>>1; const float f=qn*PK[mid]+nb3[64*mid+63]; if(f>=thr)hi_=mid; else lo_=mid+1; } }
    #pragma unroll
    for(int o_=1;o_<64;o_<<=1){const int v=__shfl_xor(lo_,o_); lo_=v<lo_?v:lo_;}
    if(lane==0)JX[wid]=lo_;
    __syncthreads();
    int j0=JX[0];
    #pragma unroll
    for(int w=1;w<8;++w){const int v=JX[w]; j0=v<j0?v:j0;}
    j0=__builtin_amdgcn_readfirstlane(j0);
    int nte=(NTR-j0+1)&~1; NT=nte<4?4:nte;
    __syncthreads();
  }
  #define BIASADD(P0,P1,t) do{ const __attribute__((address_space(3))) f32x4_t* bp_=(const __attribute__((address_space(3))) f32x4_t*)(nb3+TIDX(t)*64+4*hi); \
    const f32x4_t nm4_={-mhat,-mhat,-mhat,-mhat}; \
    _Pragma("unroll") for(int g_=0;g_<4;++g_){ const f32x4_t b0_=bp_[2*g_]+nm4_,b1_=bp_[2*g_+8]+nm4_; \
      P0[4*g_]+=b0_[0];P0[4*g_+1]+=b0_[1];P0[4*g_+2]+=b0_[2];P0[4*g_+3]+=b0_[3]; P1[4*g_]+=b1_[0];P1[4*g_+1]+=b1_[1];P1[4*g_+2]+=b1_[2];P1[4*g_+3]+=b1_[3]; } }while(0)
  DMA_K(0,0);DMA_V(0,0);DMA_K(1,SLOTB);
  bf16x8 qr[4];
  #pragma unroll
  for(int d0=0;d0<4;++d0)qr[d0]=*reinterpret_cast<const bf16x8*>(&Qw[(long)r32*DM+d0*16+hi*8]);
  float mhat=0.f,l_reg=0.f;f32x16 o[2];o[0]=f32x16{};o[1]=f32x16{};const f32x16 negm=f32x16{};
  const int qrel=wid*QBLK+r32;
  #define CMASK(P0,P1,t) do{ if((t)<4){ cmask(P0,P1,3-(t),qrel,hi); } }while(0)
  bool resc=false;
  #define START(P0,P1) do{ const float rm=rowmax(P0,P1); resc=false; \
    { const float dl=(rm>-3.0e38f)?rm:0.f; mhat=fadd_s(mhat,dl);     \
      _Pragma("unroll") for(int r=0;r<16;++r){P0[r]=fsub_s(P0[r],dl);P1[r]=fsub_s(P1[r],dl);} \
      } \
    _Pragma("unroll") for(int r=0;r<16;++r)P0[r]=__builtin_amdgcn_exp2f(P0[r]); }while(0)
  #define RESC() do{ if(resc){ asm volatile("s_waitcnt lgkmcnt(0)":::"memory"); \
      _Pragma("unroll") for(int d_=0;d_<2;++d_) _Pragma("unroll") for(int r=0;r<16;++r)o[d_][r]*=wsf[crow(r,hi)]; } }while(0)
  f32x16 pA0,pA1,pB0,pB1;
  int sl_prev=0,sl_cur=0,sl_next=SLOTB;
  #define ROT() do{sl_prev=sl_cur;sl_cur=sl_next;sl_next=(sl_next==(NSLOT-1)*SLOTB)?0:sl_next+SLOTB;}while(0)
  DMA_K(2,2*SLOTB);
  WAIT_BAR(3);
  qkt(pA0,pA1,Kbase,qr,negm,r32,hi);asm volatile("s_nop 15\n\ts_nop 7":"+v"(pA0),"+v"(pA1));BIASADD(pA0,pA1,0);CMASK(pA0,pA1,0);
  START(pA0,pA1);
  _Pragma("unroll") for(int r=0;r<16;++r)pA1[r]=__builtin_amdgcn_exp2f(pA1[r]);
  WAIT_BAR(0);
  DMA_K(3,0);DMA_V(1,SLOTB);
  ROT();
  kload8(kf,kp0+sl_cur);
  WAIT_BAR(2);
  s16x4 vlo[8],vhi[8]; u32x4 pw0,pw1,pw2,pw3;
  #define PKW(P,B) cvtpk_s(P[B],P[B+1])
  #define PAF(k) __builtin_bit_cast(bf16x8,pw##k)
  #define VFR(i) (bf16x8){vlo[i][0],vlo[i][1],vlo[i][2],vlo[i][3],vhi[i][0],vhi[i][1],vhi[i][2],vhi[i][3]}
  #define PIN(x) asm volatile("":"+v"(x))
  #define MX3(a,b,c) __builtin_fmaxf(__builtin_fmaxf((a),(b)),(c))
  #define GAPA(MF,A0,A1,A2,A3,W0,W1,PW) do{ MF; sacc+=A0; sacc+=A1; sacc+=A2; sacc+=A3; PIN(sacc); W0; W1; PIN(PW); SBAR(); }while(0)
  #define EX(v) __builtin_amdgcn_exp2f(v)
  #define GAPB(MF,X,B) do{ MF; X[B]=EX(X[B]); X[B+1]=EX(X[B+1]); X[B+2]=EX(X[B+2]); X[B+3]=EX(X[B+3]); PIN(X); SBAR(); }while(0)
  #define VRD(i) do{ vlo[i]=vtr(vp_+(((i)>>2)*4096+((i)&3)*1024)); vhi[i]=vtr(vp_+(((i)>>2)*4096+((i)&3)*1024+512)); }while(0)
  #define KRD(G,j) do{ if(G){ kload2(kf,kp0+sl_next,j); SBAR(); } }while(0)
  #define STEP(C0,C1,P0,P1,t,GK,GV,GL) do{ SBAR(); \
    const lds_cptr vp_=vp0+sl_prev; \
    VRD(0); SBAR(); float sacc=(P0[0]+P0[1]); \
    GAPA(C0=__builtin_amdgcn_mfma_f32_32x32x16_bf16(kf[0],qr[0],negm,0,0,0), P0[2],P0[3],P0[4],P0[5],     pw0[0]=PKW(P0,0), pw0[1]=PKW(P0,2), pw0); \
    VRD(4); SBAR(); GAPA(C1=__builtin_amdgcn_mfma_f32_32x32x16_bf16(kf[1],qr[0],negm,0,0,0), P0[6],P0[7],P0[8],P0[9],     pw0[2]=PKW(P0,4), pw0[3]=PKW(P0,6), pw0); \
    VRD(1); SBAR(); GAPA(C0=__builtin_amdgcn_mfma_f32_32x32x16_bf16(kf[2],qr[1],C0,0,0,0),   P0[10],P0[11],P0[12],P0[13], pw1[0]=PKW(P0,8), pw1[1]=PKW(P0,10), pw1); \
    VRD(5); SBAR(); GAPA(C1=__builtin_amdgcn_mfma_f32_32x32x16_bf16(kf[3],qr[1],C1,0,0,0),   P0[14],P0[15],P1[0],P1[1],   pw1[2]=PKW(P0,12),pw1[3]=PKW(P0,14), pw1); \
    VRD(2); SBAR(); GAPA(C0=__builtin_amdgcn_mfma_f32_32x32x16_bf16(kf[4],qr[2],C0,0,0,0),   P1[2],P1[3],P1[4],P1[5],     pw2[0]=PKW(P1,0), pw2[1]=PKW(P1,2), pw2); \
    VRD(6); SBAR(); GAPA(C1=__builtin_amdgcn_mfma_f32_32x32x16_bf16(kf[5],qr[2],C1,0,0,0),   P1[6],P1[7],P1[8],P1[9],     pw2[2]=PKW(P1,4), pw2[3]=PKW(P1,6), pw2); \
    VRD(3); SBAR(); GAPA(C0=__builtin_amdgcn_mfma_f32_32x32x16_bf16(kf[6],qr[3],C0,0,0,0),   P1[10],P1[11],P1[12],P1[13], pw3[0]=PKW(P1,8), pw3[1]=PKW(P1,10), pw3); \
    VRD(7); SBAR(); GAPA(C1=__builtin_amdgcn_mfma_f32_32x32x16_bf16(kf[7],qr[3],C1,0,0,0),   P1[14],P1[15],0.f,0.f,       pw3[2]=PKW(P1,12),pw3[3]=PKW(P1,14), pw3); \
    l_reg+=sacc; \
    if(GK){DMA_K((t)+3,sl_cur);} if(GV){DMA_V((t)+1,sl_next);} \
    BIASADD(C0,C1,t); CMASK(C0,C1,t); \
    { float a=MX3(C0[0],C0[1],C1[0]),b=MX3(C0[2],C0[3],C1[1]); a=MX3(a,C1[2],C1[3]); \
      _Pragma("unroll") for(int r=4;r<16;r+=4){a=MX3(a,C0[r],C0[r+1]);b=MX3(b,C0[r+2],C0[r+3]);a=MX3(a,C1[r],C1[r+1]);b=MX3(b,C1[r+2],C1[r+3]);} \
      float rm=__builtin_fmaxf(a,b); { auto rr=__builtin_amdgcn_permlane32_swap(__float_as_uint(rm),__float_as_uint(rm),false,false); rm=__builtin_fmaxf(__uint_as_float(rr[0]),__uint_as_float(rr[1])); } \
      resc=false; \
      if(__builtin_expect(__any(rm>(float)THRL),0)){ const float dl=__builtin_fmaxf(rm,0.f); mhat+=dl; \
        _Pragma("unroll") for(int r=0;r<16;++r){C0[r]-=dl;C1[r]-=dl;} \
        const float f=__builtin_amdgcn_exp2f(-dl); l_reg*=f; if(hi==0)wsf[r32]=f; resc=true; } } \
    SBAR(); \
    GAPB(o[0]=__builtin_amdgcn_mfma_f32_32x32x16_bf16(PAF(0),VFR(0),o[0],0,0,0), C0,0); \
    GAPB(o[1]=__builtin_amdgcn_mfma_f32_32x32x16_bf16(PAF(0),VFR(4),o[1],0,0,0), C0,4); \
    KRD(GL,0); GAPB(o[0]=__builtin_amdgcn_mfma_f32_32x32x16_bf16(PAF(1),VFR(1),o[0],0,0,0), C0,8); \
    KRD(GL,1); GAPB(o[1]=__builtin_amdgcn_mfma_f32_32x32x16_bf16(PAF(1),VFR(5),o[1],0,0,0), C0,12); \
    KRD(GL,2); GAPB(o[0]=__builtin_amdgcn_mfma_f32_32x32x16_bf16(PAF(2),VFR(2),o[0],0,0,0), C1,0); \
    KRD(GL,3); GAPB(o[1]=__builtin_amdgcn_mfma_f32_32x32x16_bf16(PAF(2),VFR(6),o[1],0,0,0), C1,4); \
    GAPB(o[0]=__builtin_amdgcn_mfma_f32_32x32x16_bf16(PAF(3),VFR(3),o[0],0,0,0), C1,8); \
    GAPB(o[1]=__builtin_amdgcn_mfma_f32_32x32x16_bf16(PAF(3),VFR(7),o[1],0,0,0), C1,12); \
    }while(0)
  int t=1;
  for(int it_=0;it_<2&&t+5<NT;++it_,t+=2){
    STEP(pB0,pB1,pA0,pA1,t,true,true,true);     WAIT_BAR(2); RESC(); ROT();
    STEP(pA0,pA1,pB0,pB1,t+1,true,true,true);   WAIT_BAR(2); RESC(); ROT();
  }
  #undef CMASK
  #define CMASK(P0,P1,t) do{}while(0)
  for(;t+5<NT;t+=2){
    STEP(pB0,pB1,pA0,pA1,t,true,true,true);     WAIT_BAR(2); RESC(); ROT();
    STEP(pA0,pA1,pB0,pB1,t+1,true,true,true);   WAIT_BAR(2); RESC(); ROT();
  }
  #undef CMASK
  #define CMASK(P0,P1,t) do{ if((t)<4){ cmask(P0,P1,3-(t),qrel,hi); } }while(0)
  #define ENDW(tt) do{ if((tt)+3<NT){WAIT_BAR(2);} else if((tt)+2<NT){WAIT_BAR(1);} else {WAIT_BAR(0);} }while(0)
  for(;t+1<NT;t+=2){
    STEP(pB0,pB1,pA0,pA1,t,(t+3<NT),(t+1<NT),(t+1<NT));       ENDW(t);   RESC(); ROT();
    STEP(pA0,pA1,pB0,pB1,t+1,(t+4<NT),(t+2<NT),(t+2<NT));     ENDW(t+1); RESC(); ROT();
  }
  STEP(pB0,pB1,pA0,pA1,NT-1,false,false,false); RESC();
  { float sacc=pB0[0]+pB0[1]; _Pragma("unroll") for(int r=2;r<16;++r)sacc+=pB0[r]; _Pragma("unroll") for(int r=0;r<16;++r)sacc+=pB1[r]; l_reg+=sacc;
    pw0=(u32x4){PKW(pB0,0),PKW(pB0,2),PKW(pB0,4),PKW(pB0,6)};pw1=(u32x4){PKW(pB0,8),PKW(pB0,10),PKW(pB0,12),PKW(pB0,14)};pw2=(u32x4){PKW(pB1,0),PKW(pB1,2),PKW(pB1,4),PKW(pB1,6)};pw3=(u32x4){PKW(pB1,8),PKW(pB1,10),PKW(pB1,12),PKW(pB1,14)};
    SBAR(); pv(o,vb0+sl_cur,PAF(0),PAF(1),PAF(2),PAF(3)); }
  #undef PKW
  #undef PAF
  #undef VFR
  #undef PIN
  #undef MX3
  #undef GAPA
  #undef GAPB
  #undef EX
  #undef VRD
  #undef KRD
  #undef STEP
  #undef ENDW
  {auto rr=__builtin_amdgcn_permlane32_swap(__float_as_uint(l_reg),__float_as_uint(l_reg),false,false);l_reg=__uint_as_float(rr[0])+__uint_as_float(rr[1]);}
  if(hi==0)wsf[32+r32]=l_reg;asm volatile("s_waitcnt lgkmcnt(0)":::"memory");
  float rli[16];
  #pragma unroll
  for(int r=0;r<16;++r)rli[r]=__builtin_amdgcn_rcpf(wsf[32+crow(r,hi)]);
  bf16*Ow=O+(rowbase+q0+wid*QBLK)*DM+h*D;
  { bf16*stg=(bf16*)(shm+LDS_OST)+wid*2048;
    #pragma unroll
    for(int r=0;r<16;++r){const int orow=crow(r,hi);
      #pragma unroll
      for(int d0=0;d0<2;++d0)stg[orow*64+d0*32+r32]=__float2bfloat16(o[d0][r]*rli[r]);}
    asm volatile("s_waitcnt lgkmcnt(0)":::"memory");
    #pragma unroll
    for(int i=0;i<4;++i){const int row=i*8+(lane>>3),ch=lane&7; const u32x4 v=*(const u32x4*)(stg+row*64+ch*8); ATTN_STORE16(Ow+(long)row*DM+ch*8,v);} }
  asm volatile("s_waitcnt lgkmcnt(0)\n\ts_barrier":::"memory");
  #undef BIASADD
  #undef TIDX
  #undef DMA_K
  #undef DMA_V
  #undef CMASK
  #undef START
  #undef RESC
  #undef ROT
}

template<int PITCH> __device__ __forceinline__ void sb_unit(int b,int h,int qb,const bf16*Q,const bf16*__restrict__ K,const bf16*__restrict__ V,bf16*O  ,char*shm){
  int tid_=threadIdx.x; asm volatile("":"+v"(tid_)); const int tid=tid_,lane=tid&63,r32=lane&31,hi=lane>>5; const int wid=__builtin_amdgcn_readfirstlane(tid>>6);
  const long rowbase=(long)b*SEQ; const int q0=qb*QB;
  const bf16*Qw=Q+(rowbase+q0+wid*QBLK)*PITCH+h*D;
  const bf16*Kh=K+rowbase*PITCH+h*D,*Vh=V+rowbase*PITCH+h*D;
  const unsigned lds0=(unsigned)(uintptr_t)shm;
  const bf16*ksrc=Kh+(long)lane*PITCH+wid*8;
  const bf16*vsrc=Vh+(long)(16*(wid&3)+(lane>>2))*PITCH+(wid>>2)*32+(lane&3)*8;
  const unsigned kdst=lds0+LDS_K+wid*1024, vdst=lds0+LDS_V+wid*1024;
  #define SB_DMA(t,slot) do{ glds16(ksrc+(long)(t)*KVBLK*PITCH,(unsigned)__builtin_amdgcn_readfirstlane(kdst+(slot))); glds16(vsrc+(long)(t)*KVBLK*PITCH,(unsigned)__builtin_amdgcn_readfirstlane(vdst+(slot))); }while(0)
  const int vb0=(int)(lds0+LDS_V)+((lane>>4)&1)*32+(lane&3)*8+(4*hi+((lane&15)>>2))*64;
  volatile __attribute__((address_space(3))) unsigned* fl=(volatile __attribute__((address_space(3))) unsigned*)((lds_cptr)shm+LDS_WS);
  const int NT=(q0+QB)/KVBLK; const int qrel=wid*QBLK+r32;
  SB_DMA(NT-1,0);
  bf16x8 qr[4];
  #pragma unroll
  for(int d0=0;d0<4;++d0)qr[d0]=*reinterpret_cast<const bf16x8*>(&Qw[(long)r32*PITCH+d0*16+hi*8]);
  f32x16 o[2];o[0]=f32x16{};o[1]=f32x16{}; const f32x16 zero16=f32x16{};
  float carry=0.f; const float m0=(hi==0)?1.f:0.f;
  int slot=0;
  for(int t=NT-1;t>=0;--t){
    WAIT_BAR(0);
    if(t<NT-1){ const int pb=((t+1)&1)*8; const unsigned a=fl[pb]&fl[pb+1]&fl[pb+2]&fl[pb+3]&fl[pb+4]&fl[pb+5]&fl[pb+6]&fl[pb+7]; if(__builtin_amdgcn_readfirstlane(a)!=0u)break; }
    if(t>0)SB_DMA(t-1,slot^SLOTB);
    f32x16 p0,p1; qkt(p0,p1,shm+LDS_K+slot,qr,zero16,r32,hi);
    if(t>=NT-4){ const int kb=64*(t-(NT-4))+4*hi;
      #pragma unroll
      for(int r=0;r<16;++r){const int kv=kb+(r&3)+8*(r>>2); if(kv>=qrel)p0[r]=-INFINITY; if(kv+32>=qrel)p1[r]=-INFINITY;} }
    f32x16 s0,s1;
    #pragma unroll
    for(int r=0;r<16;++r){ const float z=p0[r]; const float sp=__builtin_fmaxf(z,0.f)+__builtin_amdgcn_logf(1.f+__builtin_amdgcn_exp2f(-__builtin_fabsf(z))); s0[r]=sp; p0[r]=z-sp;
                           const float y=p1[r]; const float sq=__builtin_fmaxf(y,0.f)+__builtin_amdgcn_logf(1.f+__builtin_amdgcn_exp2f(-__builtin_fabsf(y))); s1[r]=sq; p1[r]=y-sq; }
    float lo[8],hv[8];
    #pragma unroll
    for(int i=0;i<8;++i){ const float mine=(i<4)?((s0[4*i]+s0[4*i+1])+(s0[4*i+2]+s0[4*i+3])):((s1[4*i-16]+s1[4*i-15])+(s1[4*i-14]+s1[4*i-13]));
      auto rr=__builtin_amdgcn_permlane32_swap(__float_as_uint(mine),__float_as_uint(mine),false,false); lo[i]=__uint_as_float(rr[0]); hv[i]=__uint_as_float(rr[1]); }
    float sp_=0.f;
    #pragma unroll
    for(int i=7;i>=0;--i){ const float base=carry-(sp_+m0*hv[i]);
      if(i<4){ float a=base; p0[4*i+3]=__builtin_amdgcn_exp2f(p0[4*i+3]+a); a-=s0[4*i+3]; p0[4*i+2]=__builtin_amdgcn_exp2f(p0[4*i+2]+a); a-=s0[4*i+2]; p0[4*i+1]=__builtin_amdgcn_exp2f(p0[4*i+1]+a); a-=s0[4*i+1]; p0[4*i]=__builtin_amdgcn_exp2f(p0[4*i]+a); }
      else   { const int j=4*i-16; float a=base; p1[j+3]=__builtin_amdgcn_exp2f(p1[j+3]+a); a-=s1[j+3]; p1[j+2]=__builtin_amdgcn_exp2f(p1[j+2]+a); a-=s1[j+2]; p1[j+1]=__builtin_amdgcn_exp2f(p1[j+1]+a); a-=s1[j+1]; p1[j]=__builtin_amdgcn_exp2f(p1[j]+a); }
      sp_+=lo[i]+hv[i]; }
    carry-=sp_;
    { u32x4 pw0,pw1,pw2,pw3;
      pw0=(u32x4){cvtpk_s(p0[0],p0[1]),cvtpk_s(p0[2],p0[3]),cvtpk_s(p0[4],p0[5]),cvtpk_s(p0[6],p0[7])}; pw1=(u32x4){cvtpk_s(p0[8],p0[9]),cvtpk_s(p0[10],p0[11]),cvtpk_s(p0[12],p0[13]),cvtpk_s(p0[14],p0[15])};
      pw2=(u32x4){cvtpk_s(p1[0],p1[1]),cvtpk_s(p1[2],p1[3]),cvtpk_s(p1[4],p1[5]),cvtpk_s(p1[6],p1[7])}; pw3=(u32x4){cvtpk_s(p1[8],p1[9]),cvtpk_s(p1[10],p1[11]),cvtpk_s(p1[12],p1[13]),cvtpk_s(p1[14],p1[15])};
      pv(o,vb0+slot,__builtin_bit_cast(bf16x8,pw0),__builtin_bit_cast(bf16x8,pw1),__builtin_bit_cast(bf16x8,pw2),__builtin_bit_cast(bf16x8,pw3)); }
    { const bool done_=__all(carry<-150.f); if(lane==0)fl[(t&1)*8+wid]=done_?1u:0u; }
    slot^=SLOTB;
  }
  asm volatile("s_waitcnt vmcnt(0) lgkmcnt(0)":::"memory");
  bf16*Ow=O+(rowbase+q0+wid*QBLK)*1024+h*D;
  { bf16*stg=(bf16*)(shm+LDS_OST)+wid*2048;
    #pragma unroll
    for(int r=0;r<16;++r){const int orow=crow(r,hi);
      #pragma unroll
      for(int d0=0;d0<2;++d0)stg[orow*64+d0*32+r32]=__float2bfloat16(o[d0][r]);}
    asm volatile("s_waitcnt lgkmcnt(0)":::"memory");
    #pragma unroll
    for(int i=0;i<4;++i){const int row=i*8+(lane>>3),ch=lane&7; const u32x4 v=*(const u32x4*)(stg+row*64+ch*8); ATTN_STORE16(Ow+(long)row*1024+ch*8,v);} }
  asm volatile("s_waitcnt vmcnt(0) lgkmcnt(0)\n\ts_barrier":::"memory");
  #undef SB_DMA
}
constexpr int ATTN_LDS_BYTES=LDS_BYTES;
struct AttnTensors { const bf16* Q; const bf16* K; const bf16* V; bf16* O; const float* logf;   const unsigned* kn;   };
struct AttnUnit { int bh; int qb; };
struct StaticOrder {
  int vcu;
  __device__ __forceinline__ explicit StaticOrder(int grid,int block):vcu((block%8)*(grid/8)+block/8){}
  __device__ __forceinline__ bool next(int i,AttnUnit&u)const{ if(i>=4)return false; const int s=vcu&7; u.bh=vcu>>3; u.qb=(i==0)?s:(i==1)?15-s:(i==2)?16+s:31-s; return true; }
  __device__ __forceinline__ void a_ready(const AttnUnit&)const{}
  __device__ __forceinline__ void done(const AttnUnit&)const{}
};
template<class Sched,int THRL=8> __device__ __forceinline__ void attn_phase(char*lds,const AttnTensors&T,const Sched&S){
  AttnUnit u;
  for(int i=0;S.next(i,u);++i){ S.a_ready(u); attn_unit<THRL>(u.bh/NHEAD,u.bh%NHEAD,u.qb,T.Q,T.K,T.V,T.O,lds,T.logf+(size_t)u.bh*SEQ,T.kn+(size_t)u.bh*256); S.done(u); }
}
#undef SBAR
#undef WAIT_BAR
}
constexpr int NWAVES = 8, NTHREADS = NWAVES * 64;
constexpr int BATCH = 2, SEQ = 8192, D = 1024, M = BATCH * SEQ;
constexpr int S5G = 32, S5H = 16, S5P = 64, S5T = 32  , S5NC = M / S5T  , S5KX = 640  ;
constexpr int SBH = 8, FOXH = 16, HD = 64;
constexpr int EVEN_IN = 2048, ODD_IN = 3088, DFF = 2816, NEXP = 8, DFE = 3584;
constexpr float C2 = 0.125f * 1.4426950408889634f;
constexpr int MOE_CHUNK_PANELS = 68, MOE_MAX_PANELS = 136, MOE_MAX_SLOTS = MOE_MAX_PANELS * 256, MOE_CAP = 16384  ;

constexpr size_t MiB = 1u << 20;
constexpr size_t WS_CTL = 0, CTL_ZERO_BYTES = 1 * MiB;
constexpr size_t WS_WMOE_GU = 1 * MiB;
constexpr size_t WS_WMOE_D = 57 * MiB;
constexpr size_t WS_WIN0 = 85 * MiB;
constexpr size_t WS_WGLU = 89 * MiB;
constexpr size_t WS_WOUT0 = 90 * MiB;
constexpr size_t WS_WGU0 = 92 * MiB;
constexpr size_t WS_WD0 = 103 * MiB;
constexpr size_t WS_WIN1 = 109 * MiB;
constexpr size_t WS_WF1 = 115 * MiB;
constexpr size_t WS_WOUT1 = 116 * MiB;
constexpr size_t WS_S5WA = 118 * MiB;
constexpr size_t WS_S5WC = 126 * MiB;
constexpr size_t WS_XB = 146 * MiB;
constexpr size_t WS_SSP = 178 * MiB;
constexpr size_t WS_META = 182 * MiB;
constexpr size_t WS_LOGF = 183 * MiB;
constexpr size_t WS_QKV0 = 184 * MiB;
constexpr size_t WS_UEXT = 232 * MiB;
constexpr size_t WS_SLOC = 252 * MiB;
constexpr size_t WS_YG = 260 * MiB;
constexpr size_t WS_MIXB = 276 * MiB;
constexpr size_t WS_HID0 = 184 * MiB;
constexpr size_t WS_QKV1 = 184 * MiB;
constexpr size_t WS_XG = 184 * MiB;
constexpr size_t WS_HMOE = 312 * MiB;
constexpr size_t WS_Y = 85 * MiB;
constexpr size_t WS_END = 431 * MiB;
static_assert(WS_XG + (size_t)8 * MOE_CAP * 1024 <= WS_HMOE && WS_HMOE + (size_t)MOE_MAX_SLOTS * DFE <= WS_END && WS_Y + (size_t)MOE_MAX_SLOTS * 1024 * 2 <= WS_XB + 32 * MiB && WS_MIXB + 32 * MiB <= WS_END, "ws map");
constexpr size_t MT_RSTD = 0, MT_TOKE = 65536, MT_TOKP = 131072, MT_TOKG = 262144, MT_TOKSLOT = 393216, MT_RSS = 524288;
constexpr int CW_TMO = 0, CW_CODE = 1, CW_BAR = 4096, CW_CNT = 8192  , CW_QUEUE = 12288  , CW_QUEUE2 = 12352  , CW_KN = 16384  , CW_SS = 32768  ;

constexpr int RING_OFF = 0, RING_BYTES = 131072;
constexpr int LDSCTL_OFF = 133120  , MISC_OFF = LDSCTL_OFF + 320;
constexpr int LDS_BYTES = 147456;

#define GAS __attribute__((address_space(1)))
#define LAS __attribute__((address_space(3)))
typedef unsigned short bf16;
typedef unsigned v4u __attribute__((ext_vector_type(4)));
typedef unsigned v2u __attribute__((ext_vector_type(2)));
typedef float f32x4 __attribute__((ext_vector_type(4)));
typedef short bf16x8 __attribute__((ext_vector_type(8)));
typedef GAS unsigned gu32;
#define RLX_AGENT __ATOMIC_RELAXED, __HIP_MEMORY_SCOPE_AGENT
#define LDS_WAIT() asm volatile("s_waitcnt lgkmcnt(0)" ::: "memory")
#define VM_WAIT() asm volatile("s_waitcnt vmcnt(0)" ::: "memory")
__device__ __forceinline__ unsigned f2bf(float f) { unsigned u = __builtin_bit_cast(unsigned, f); return (u + 0x7fffu + ((u >> 16) & 1u)) >> 16; }
__device__ __forceinline__ unsigned pk2(float lo, float hi) { return f2bf(lo) | (f2bf(hi) << 16); }
__device__ __forceinline__ float bflo(unsigned w) { return __uint_as_float(w << 16); }
__device__ __forceinline__ float bfhi(unsigned w) { return __uint_as_float(w & 0xffff0000u); }

#define XB_TMO      128
#define XB_XCNT(j)  (256  + 64 * (j))
#define XB_XSUB(j)  (1280 + 64 * (j))
#define XB_XGEN(j)  (2304 + 64 * (j))
#define XB_TOP      3328
#define XB_TOPGEN   3392
#define XCD_BAR_WORDS 3456
#define XB_SPIN_CAP (1u << 18)
__device__ __forceinline__ unsigned xb_ld(unsigned* p)              { return __hip_atomic_load(p, __ATOMIC_RELAXED, __HIP_MEMORY_SCOPE_AGENT); }
__device__ __forceinline__ unsigned xb_add(unsigned* p, unsigned v) { return __hip_atomic_fetch_add(p, v, __ATOMIC_RELAXED, __HIP_MEMORY_SCOPE_AGENT); }
__device__ __forceinline__ unsigned xb_xcc_id() { return (unsigned)__builtin_amdgcn_s_getreg((3 << 11) | 20) & 0xFu; }
#define XB_SPIN(cond, bar) do { unsigned _sp = 0; while (cond) { __builtin_amdgcn_s_sleep(1); \
    if ((++_sp & 255u) == 0u) { if (xb_ld(&(bar)[XB_TMO])) break; if (_sp > XB_SPIN_CAP) { atomicAdd(&(bar)[XB_TMO], 1u); break; } } } } while (0)
struct XcdBarrier { unsigned* bar; unsigned x; volatile LAS unsigned* st; };
__device__ __forceinline__ XcdBarrier xcd_barrier_post(unsigned* bar, volatile LAS unsigned* st) {
    XcdBarrier b; b.bar = bar; b.x = xb_xcc_id(); b.st = st;
    if (threadIdx.x == 0) (void)xb_add(&bar[XB_XCNT(b.x)], 1u);
    return b;
}
__device__ __forceinline__ void xcd_barrier_complete(unsigned* bar, unsigned x, unsigned& nloc, unsigned& nx) {
    const unsigned G = gridDim.x * gridDim.y * gridDim.z;
    unsigned sum, cnt, mine, sp = 0u;
    for (;;) {
        sum = 0u; cnt = 0u; mine = 0u;
#pragma unroll
        for (unsigned j = 0; j < 16; ++j) { const unsigned c = xb_ld(&bar[XB_XCNT(j)]); sum += c; cnt += (c > 0u) ? 1u : 0u; mine = (j == x) ? c : mine; }
        if (sum == G) break;
        __builtin_amdgcn_s_sleep(1);
        if ((++sp & 255u) == 0u) { if (xb_ld(&bar[XB_TMO])) break; if (sp > XB_SPIN_CAP) { atomicAdd(&bar[XB_TMO], 1u); break; } }
    }
    nloc = mine > 0u ? mine : 1u; nx = cnt > 0u ? cnt : 1u;
}
__device__ __forceinline__ void xcd_barrier(const XcdBarrier& b) {
    asm volatile("s_waitcnt vmcnt(0)" ::: "memory");
    __syncthreads();
    if (threadIdx.x == 0) {
        unsigned* bar = b.bar;
        __builtin_amdgcn_s_waitcnt(0);
        unsigned nloc = b.st[0], nx = b.st[1];
        if (nloc == 0u) { xcd_barrier_complete(bar, b.x, nloc, nx); b.st[0] = nloc; b.st[1] = nx; }
        const unsigned old = xb_add(&bar[XB_XSUB(b.x)], 1u);
        const unsigned gen = old / nloc;
        if (old + 1u == (gen + 1u) * nloc) {
            __builtin_amdgcn_fence(__ATOMIC_RELEASE, "agent");
            asm volatile("s_waitcnt vmcnt(0)" ::: "memory");
            const unsigned og = xb_add(&bar[XB_TOP], 1u);
            const unsigned tg = og / nx;
            if (og + 1u == (tg + 1u) * nx) xb_add(&bar[XB_TOPGEN], 1u);
            else XB_SPIN(xb_ld(&bar[XB_TOPGEN]) == tg, bar);
            __builtin_amdgcn_fence(__ATOMIC_ACQUIRE, "agent");
            xb_add(&bar[XB_XGEN(b.x)], 1u);
            asm volatile("s_waitcnt vmcnt(0)" ::: "memory");
        } else {
            XB_SPIN(xb_ld(&bar[XB_XGEN(b.x)]) == gen, bar);
            __builtin_amdgcn_fence(__ATOMIC_ACQUIRE, "agent");
            asm volatile("s_waitcnt vmcnt(0)" ::: "memory");
        }
    }
    __syncthreads();
}

__device__ __forceinline__ float wave_sum(float v) {
#pragma unroll
    for (int o = 1; o < 64; o <<= 1) v += __shfl_xor(v, o);
    return v;
}
constexpr int XP = 65, XSCR_BYTES = 64 * XP * 4;
__device__ __forceinline__ unsigned cvtpk(float lo, float hi) { unsigned r; asm volatile("v_cvt_pk_bf16_f32 %0, %1, %2" : "=v"(r) : "v"(lo), "v"(hi)); return r; }
__device__ __forceinline__ void p0_transpose_item(const float* W, int ldw, int k0, int n0, const float* gs, bf16* dst, int ldd, LAS float* scr, int lane) {
    const int lr = lane >> 4, lc = (lane & 15) * 4;
    const float* src = W + (size_t)(k0 + lr) * ldw + n0 + lc;
    f32x4 v[16];
#pragma unroll
    for (int i = 0; i < 16; ++i) v[i] = *(const GAS f32x4*)(src + (size_t)(4 * i) * ldw);
    if (gs) {
#pragma unroll
        for (int i = 0; i < 16; ++i) v[i] = v[i] * gs[k0 + 4 * i + lr]; }
#pragma unroll
    for (int i = 0; i < 16; ++i) { LAS float* p = scr + (4 * i + lr) * XP + lc; p[0] = v[i][0]; p[1] = v[i][1]; p[2] = v[i][2]; p[3] = v[i][3]; }
    LDS_WAIT(); asm volatile("" ::: "memory");
    const int c = lane & 7, nn = lane >> 3;
#pragma unroll
    for (int j = 0; j < 8; ++j) { const int n = nn + 8 * j; const LAS float* sp = scr + (8 * c) * XP + n;
        v4u o; o.x = cvtpk(sp[0 * XP], sp[1 * XP]); o.y = cvtpk(sp[2 * XP], sp[3 * XP]); o.z = cvtpk(sp[4 * XP], sp[5 * XP]); o.w = cvtpk(sp[6 * XP], sp[7 * XP]);
        *(GAS v4u*)(dst + (size_t)n * ldd + k0 + 8 * c) = o; }
    LDS_WAIT(); asm volatile("" ::: "memory");
}
struct XTile { const float* src; const float* gs; unsigned char* dst; int ldw, ldd, k0; };
__device__ __forceinline__ XTile xtile_fp8(int item, const float* W, int ldw, int N, const float* gs, unsigned char* dst, int ldd, int mode, int lane) {
    const int nblk = N / 64, kb = item / nblk, nb = item % nblk, n0 = 64 * nb, k0 = 64 * kb;
    const int row = mode == 0 ? n0 : ((n0 >> 7) * 256 + (n0 & 127) + (mode == 2 ? 128 : 0));
    XTile t; t.src = W + (size_t)(k0 + (lane >> 4)) * ldw + n0 + (lane & 15) * 4; t.gs = gs; t.dst = dst + (size_t)row * ldd; t.ldw = ldw; t.ldd = ldd; t.k0 = k0; return t;
}
__device__ __forceinline__ void xtile_load(const XTile& t, f32x4 (&v)[16]) {
#pragma unroll
    for (int i = 0; i < 16; ++i) v[i] = *(const GAS f32x4*)(t.src + (size_t)(4 * i) * t.ldw);
}
__device__ __forceinline__ void xtile_finish_fp8(const XTile& t, f32x4 (&v)[16], float wscale, LAS float* scr, int lane) {
    const int lr = lane >> 4, lc = (lane & 15) * 4;
#pragma unroll
    for (int i = 0; i < 16; ++i) v[i] = v[i] * (t.gs ? t.gs[t.k0 + 4 * i + lr] * wscale : wscale);
#pragma unroll
    for (int i = 0; i < 16; ++i) { LAS float* p = scr + (4 * i + lr) * XP + lc; p[0] = v[i][0]; p[1] = v[i][1]; p[2] = v[i][2]; p[3] = v[i][3]; }
    LDS_WAIT(); asm volatile("" ::: "memory");
    const int c = lane & 3, nn = lane >> 2;
#pragma unroll
    for (int j = 0; j < 4; ++j) { const int n = nn + 16 * j; const LAS float* sp = scr + (16 * c) * XP + n;
        v4u o; o.x = pg8::pk_fp8x4(sp[0 * XP], sp[1 * XP], sp[2 * XP], sp[3 * XP]); o.y = pg8::pk_fp8x4(sp[4 * XP], sp[5 * XP], sp[6 * XP], sp[7 * XP]);
        o.z = pg8::pk_fp8x4(sp[8 * XP], sp[9 * XP], sp[10 * XP], sp[11 * XP]); o.w = pg8::pk_fp8x4(sp[12 * XP], sp[13 * XP], sp[14 * XP], sp[15 * XP]);
        *(GAS v4u*)(t.dst + (size_t)n * t.ldd + t.k0 + 16 * c) = o; }
    LDS_WAIT(); asm volatile("" ::: "memory");
}
__device__ __forceinline__ void xpose_mat(int item, const float* W, int ldw, int N, const float* gs, bf16* dst, int ldd, int mode, LAS float* scr, int lane) {
    const int nblk = N / 64, kb = item / nblk, nb = item % nblk, n0 = 64 * nb;
    const int row = mode == 0 ? n0 : ((n0 >> 7) * 256 + (n0 & 127) + (mode == 2 ? 128 : 0));
    p0_transpose_item(W, ldw, 64 * kb, n0, gs, dst + (size_t)row * ldd, ldd, scr, lane);
}

struct Args { const float* in[28]; float* out; unsigned char* ws; };

__device__ __forceinline__ void s5_tables(const Args& a, int g, int q, LAS unsigned char* lds, int tid) {
    LAS float* POWr = (LAS float*)lds;
    LAS float* POWi = POWr + 33 * 64;
    LAS float* BBr = POWi + 33 * 64;
    LAS float* BBi = BBr + 1024;
    LAS float* CCr = BBi + 1024;
    LAS float* CCi = CCr + 1024;
    LAS float* KT = CCi + 1024;
    LAS float* DD = KT + 2048;
    const float* a_re = a.in[3]; const float* a_im = a.in[4]; const float* b_re = a.in[5]; const float* b_im = a.in[6];
    const float* c_re = a.in[7]; const float* c_im = a.in[8]; const float* dsk = a.in[9]; const float* log_step = a.in[10];
    const float step = expf(log_step[g]);
    __syncthreads();
    for (int e = tid; e < 33 * 64; e += NTHREADS) { const int n = e >> 6, p = e & 63; const float lr = a_re[g * 64 + p], li = a_im[g * 64 + p];
        const float mag = expf((float)n * step * lr); float sn, cs; sincosf((float)n * (step * li), &sn, &cs); POWr[e] = mag * cs; POWi[e] = mag * sn; }
    for (int e = tid; e < 1024; e += NTHREADS) { const int p = e >> 4, h = e & 15; const float lr = a_re[g * 64 + p], li = a_im[g * 64 + p];
        const float er = expf(lr * step); float sn, cs; sincosf(li * step, &sn, &cs); const float nr = er * cs - 1.f, ni = er * sn, den = lr * lr + li * li;
        const float fr = (nr * lr + ni * li) / den, fi = (ni * lr - nr * li) / den;
        const float br = b_re[(g * 64 + p) * 16 + h], bi = b_im[(g * 64 + p) * 16 + h];
        BBr[e] = fr * br - fi * bi; BBi[e] = fr * bi + fi * br;
        CCr[e] = c_re[g * 1024 + e]; CCi[e] = c_im[g * 1024 + e]; }
    if (tid < 16) DD[tid] = dsk[g * 16 + tid];
    __syncthreads();
    for (int e = tid; e < 2048; e += NTHREADS) { const int tau = e >> 6, hl = (e >> 4) & 3, hi = e & 15, ho = 4 * q + hl; float sacc = 0.f;
        for (int p = 0; p < 64; ++p) { const float cr = CCr[ho * 64 + p], ci = CCi[ho * 64 + p], pr = POWr[tau * 64 + p], pi = POWi[tau * 64 + p];
            const float xr = cr * pr - ci * pi, xi = cr * pi + ci * pr; sacc += xr * BBr[p * 16 + hi] - xi * BBi[p * 16 + hi]; }
        if (tau == 0 && ho == hi) sacc += DD[ho];
        KT[e] = sacc; }
    __syncthreads();
    bf16* WA = (bf16*)(a.ws + WS_S5WA) + (size_t)g * 256 * 512;
    for (int pc = tid; pc < 64 * 64; pc += NTHREADS) { const int p = pc >> 6, k0 = (pc & 63) * 8; v4u o = (v4u){0u, 0u, 0u, 0u};
        if (q < 2) { const int j = k0 >> 4, h0 = k0 & 15; const float pr = POWr[(31 - j) * 64 + p], pi = POWi[(31 - j) * 64 + p]; float v[8];
#pragma unroll
            for (int w = 0; w < 8; ++w) { const float br = BBr[p * 16 + h0 + w], bi = BBi[p * 16 + h0 + w]; v[w] = (q == 0) ? (pr * br - pi * bi) : (pr * bi + pi * br); }
            o.x = cvtpk(v[0], v[1]); o.y = cvtpk(v[2], v[3]); o.z = cvtpk(v[4], v[5]); o.w = cvtpk(v[6], v[7]); }
        *(GAS v4u*)(WA + (size_t)(64 * q + p) * 512 + k0) = o; }
    bf16* WC = (bf16*)(a.ws + WS_S5WC) + (size_t)g * 512 * 640;
    for (int pc = tid; pc < 128 * 80; pc += NTHREADS) { const int rl = pc / 80, k0 = (pc % 80) * 8, i = rl >> 2, hl = rl & 3, ho = 4 * q + hl; float v[8];
        if (k0 < 512) { const int j = k0 >> 4, h0 = k0 & 15;
#pragma unroll
            for (int w = 0; w < 8; ++w) v[w] = (j <= i) ? KT[((i - j) * 4 + hl) * 16 + h0 + w] : 0.f; }
        else { const int p0 = (k0 - 512) & 63; const bool im = k0 >= 576;
#pragma unroll
            for (int w = 0; w < 8; ++w) { const int p = p0 + w; const float cr = CCr[ho * 64 + p], ci = CCi[ho * 64 + p], pr = POWr[(i + 1) * 64 + p], pi = POWi[(i + 1) * 64 + p];
                v[w] = im ? -(cr * pi + ci * pr) : (cr * pr - ci * pi); } }
        v4u o; o.x = cvtpk(v[0], v[1]); o.y = cvtpk(v[2], v[3]); o.z = cvtpk(v[4], v[5]); o.w = cvtpk(v[6], v[7]);
        *(GAS v4u*)(WC + (size_t)(i * 16 + ho) * 640 + k0) = o; }
    __syncthreads();
}

constexpr int MOE_XITEMS = 24 * 896;
__device__ __forceinline__ XTile moe_xtile(const Args& a, int r, int lane) {
    unsigned char* ws = a.ws;
    const int mat = r / 896, e = mat / 3, which = mat % 3; r -= mat * 896;
    if (which == 0) return xtile_fp8(r, a.in[24] + (size_t)e * D * DFE, DFE, DFE, a.in[22], ws + WS_WMOE_GU + (size_t)e * 7168 * 1024, D, 1, lane);
    if (which == 1) return xtile_fp8(r, a.in[25] + (size_t)e * D * DFE, DFE, DFE, a.in[22], ws + WS_WMOE_GU + (size_t)e * 7168 * 1024, D, 2, lane);
    return xtile_fp8(r, a.in[26] + (size_t)e * DFE * D, D, D, nullptr, ws + WS_WMOE_D + (size_t)e * 1024 * 3584, DFE, 0, lane);
}
__device__ __forceinline__ void p0_prologue(const Args& a, LAS unsigned char* lds, int tid, int lane, int wave, int vcu, int G) {
    for (int it = vcu; it < 4 * S5G; it += G) s5_tables(a, it >> 2, it & 3, lds, tid);
    LAS float* scr = (LAS float*)(lds + wave * XSCR_BYTES);
    const int gw = vcu * NWAVES + wave, NGW = G * NWAVES;
    constexpr int I_IN0 = 16 * 32, I_GLU = 8 * 8, I_OUT = 16 * 16, I_GU0 = 16 * 44, I_D0 = 44 * 16, I_IN1 = 16 * 48, I_MOE = 896;
    constexpr int NITEMS = I_IN0 + I_GLU + I_OUT + 2 * I_GU0 + I_D0 + I_IN1 + I_OUT;
    unsigned char* ws = a.ws;
    for (int it = NITEMS - 1 - gw; it >= 0; it -= NGW) {
        int r = it;
        if (r < I_IN0) { xpose_mat(r, a.in[2], EVEN_IN, EVEN_IN, a.in[1], (bf16*)(ws + WS_WIN0), D, 0, scr, lane); continue; } r -= I_IN0;
        if (r < I_GLU) { xpose_mat(r, a.in[11], 512, 512, nullptr, (bf16*)(ws + WS_WGLU), 512, 0, scr, lane); continue; } r -= I_GLU;
        if (r < I_OUT) { xpose_mat(r, a.in[13], D, D, nullptr, (bf16*)(ws + WS_WOUT0), D, 0, scr, lane); continue; } r -= I_OUT;
        if (r < I_GU0) { xpose_mat(r, a.in[15], DFF, DFF, a.in[14], (bf16*)(ws + WS_WGU0), D, 1, scr, lane); continue; } r -= I_GU0;
        if (r < I_GU0) { xpose_mat(r, a.in[16], DFF, DFF, a.in[14], (bf16*)(ws + WS_WGU0), D, 2, scr, lane); continue; } r -= I_GU0;
        if (r < I_D0) { xpose_mat(r, a.in[17], D, D, nullptr, (bf16*)(ws + WS_WD0), DFF, 0, scr, lane); continue; } r -= I_D0;
        if (r < I_IN1) { xpose_mat(r, a.in[19], ODD_IN, 3072, a.in[18], (bf16*)(ws + WS_WIN1), D, 0, scr, lane); continue; } r -= I_IN1;
        xpose_mat(r, a.in[21], D, D, nullptr, (bf16*)(ws + WS_WOUT1), D, 0, scr, lane);
    }
    { const int gt = vcu * NTHREADS + tid; if (gt < 16 * 1024) { const int h = gt >> 10, k = gt & 1023; ((bf16*)(ws + WS_WF1))[gt] = (bf16)f2bf(a.in[19][(size_t)k * ODD_IN + 3072 + h] * a.in[18][k]); } }
    float* ss0 = (float*)(ws + WS_SSP);
    for (int m = gw; m < M; m += NGW) {
        const GAS f32x4* xr = (const GAS f32x4*)(a.in[0] + (size_t)m * D) + lane; GAS v2u* o8 = (GAS v2u*)((bf16*)(ws + WS_XB) + (size_t)m * D) + lane; float s = 0.f;
#pragma unroll
        for (int j = 0; j < 4; ++j) { const f32x4 v = xr[64 * j]; s += (v.x * v.x + v.y * v.y) + (v.z * v.z + v.w * v.w); v2u w; w.x = pk2(v.x, v.y); w.y = pk2(v.z, v.w); o8[64 * j] = w; }
        s = wave_sum(s); if (lane < 16) ss0[(size_t)m * 16 + lane] = (lane == 0) ? s : 0.f;
    }
}

__device__ __forceinline__ void s5_scan(const Args& a, int gt  ) {
    if (gt >= BATCH * S5G * S5P) return;
    const int b = gt / (S5G * S5P), g = (gt / S5P) % S5G, p = gt % S5P;
    const float step = expf(a.in[10][g]); const float lr = a.in[3][g * 64 + p], li = a.in[4][g * 64 + p];
    const float mag = expf((float)S5T * step * lr); float sn, cs; sincosf((float)S5T * (step * li), &sn, &cs); const float ar = mag * cs, ai = mag * sn;
    const float* sl = (const float*)(a.ws + WS_SLOC) + ((size_t)g * S5NC + b * 256) * 128 + p;
    bf16* ue = (bf16*)(a.ws + WS_UEXT) + ((size_t)g * S5NC + b * 256) * S5KX + 512 + p;
    float sr = 0.f, si = 0.f;
#pragma unroll 8
    for (int c = 0; c < 256; ++c) {
        ue[(size_t)c * S5KX] = (bf16)f2bf(sr); ue[(size_t)c * S5KX + 64] = (bf16)f2bf(si);
        const float lr_ = sl[(size_t)c * 128], li_ = sl[(size_t)c * 128 + 64];
        const float nr = ar * sr - ai * si + lr_, ni = ar * si + ai * sr + li_; sr = nr; si = ni;
    }
}

__device__ __forceinline__ float softplus2(float z) { return fmaxf(z, 0.f) + __builtin_amdgcn_logf(1.0f + __builtin_amdgcn_exp2f(-fabsf(z))); }
__device__ __forceinline__ void stage_kv32(const bf16* kp, const bf16* vp, size_t pitch, LAS float* sK, LAS float* sV, int tid) {
    const int r = tid >> 4, c = (tid & 15) * 4;
    const v2u kw = *(const v2u*)(kp + (size_t)r * pitch + c), vw = *(const v2u*)(vp + (size_t)r * pitch + c);
    *(LAS f32x4*)(sK + r * 64 + c) = (f32x4){bflo(kw.x), bfhi(kw.x), bflo(kw.y), bfhi(kw.y)};
    *(LAS f32x4*)(sV + r * 64 + c) = (f32x4){bflo(vw.x), bfhi(vw.x), bflo(vw.y), bfhi(vw.y)};
}
__device__ __forceinline__ void sb_simple_unit(const bf16* qkv  , bf16* mix  , int b, int h, int blk, LAS unsigned char* lds, int tid) {
    const int lane = tid & 63, wave_ = tid >> 6;
    LAS float* sK = (LAS float*)lds; LAS float* sV = sK + 32 * 64;
    const int t = blk * 512 + tid; const size_t rb = (size_t)b * SEQ;
    float q[HD], acc[HD];
    { const v4u* qp = (const v4u*)(qkv + (rb + t) * 1536 + h * HD);
#pragma unroll
      for (int i = 0; i < 8; ++i) { const v4u w = qp[i]; q[8 * i] = bflo(w.x); q[8 * i + 1] = bfhi(w.x); q[8 * i + 2] = bflo(w.y); q[8 * i + 3] = bfhi(w.y); q[8 * i + 4] = bflo(w.z); q[8 * i + 5] = bfhi(w.z); q[8 * i + 6] = bflo(w.w); q[8 * i + 7] = bfhi(w.w); }
#pragma unroll
      for (int i = 0; i < HD; ++i) acc[i] = 0.f; }
    float carry = 0.f;
    for (int c0 = blk * 512 + 480; c0 >= 0; c0 -= 32) {
        __syncthreads();
        stage_kv32(qkv + (rb + c0) * 1536 + 512 + h * HD, qkv + (rb + c0) * 1536 + 1024 + h * HD, 1536, sK, sV, tid);
        __syncthreads();
        for (int r = 31; r >= 0; --r) { const int s = c0 + r;
            if (s < t) { float z = 0.f;
#pragma unroll
                for (int i = 0; i < HD; ++i) z = fmaf(q[i], sK[r * 64 + i], z);
                const float sp = softplus2(z); const float w = __builtin_amdgcn_exp2f(z - sp + carry); carry -= sp;
#pragma unroll
                for (int i = 0; i < HD; ++i) acc[i] = fmaf(w, sV[r * 64 + i], acc[i]); } }
        { LAS unsigned* fl = (LAS unsigned*)(lds + 16384); if (lane == 0) fl[wave_] = __all(carry < -150.f) ? 1u : 0u; __syncthreads();
          if ((fl[0] & fl[1] & fl[2] & fl[3] & fl[4] & fl[5] & fl[6] & fl[7]) != 0u) break; }
    }
    v4u* op = (v4u*)(mix + (rb + t) * 1024 + 512 + h * HD);
#pragma unroll
    for (int i = 0; i < 8; ++i) { v4u w; w.x = pk2(acc[8 * i], acc[8 * i + 1]); w.y = pk2(acc[8 * i + 2], acc[8 * i + 3]); w.z = pk2(acc[8 * i + 4], acc[8 * i + 5]); w.w = pk2(acc[8 * i + 6], acc[8 * i + 7]); op[i] = w; }
}
__device__ __forceinline__ void fgate_rows16(const bf16* xb, const bf16* wf, const float* ss, const float* bfv, float* logf, int r0, int lane) {
    const int fr = lane & 15, fq = lane >> 4;
    const bf16x8* ap = (const bf16x8*)(xb + (size_t)(r0 + fr) * D + fq * 8);
    const bf16x8* bp = (const bf16x8*)(wf + (size_t)fr * D + fq * 8);
    f32x4 acc = (f32x4){0.f, 0.f, 0.f, 0.f};
#pragma unroll 8
    for (int kk = 0; kk < 32; ++kk) acc = __builtin_amdgcn_mfma_f32_16x16x32_bf16(ap[kk * 4], bp[kk * 4], acc, 0, 0, 0);
    const float bias = bfv[fr];
#pragma unroll
    for (int j = 0; j < 4; ++j) { const int row = r0 + fq * 4 + j; const float rs = pg8::rstd16(ss, row);
        const float z = acc[j] * rs + bias;
        const float lf = -(fmaxf(-z, 0.f) + log1pf(expf(-fabsf(z)))) * 1.4426950408889634f;
        const int b = row >> 13, t = row & 8191; logf[((size_t)b * FOXH + fr) * SEQ + t] = lf; }
}

struct MoeOrder {
    pg8::StaticOrder S; int lo; int pref[NEXP + 1]; bool cap_rows;
    __device__ __forceinline__ bool next(int i, pg8::Unit& u) const {
        if (!S.next(i, u)) return false;
        u.pm += lo; int e = 0, pe = 0;
#pragma unroll
        for (int k = 1; k < NEXP; ++k) { const bool ge = u.pm >= pref[k]; e += ge ? 1 : 0; pe = ge ? pref[k] : pe; }
        u.zb = e; u.pa = cap_rows ? e * (MOE_CAP / 256) + (u.pm - pe) : u.pm; return true;
    }
    __device__ __forceinline__ void a_ready(const pg8::Unit&) const {}
    __device__ __forceinline__ void done(const pg8::Unit&) const {}
};

__global__ void __launch_bounds__(NTHREADS, 2) mk_fwd(Args args) {
    extern __shared__ __attribute__((aligned(16))) unsigned char lds_raw[];
    LAS unsigned char* lds = (LAS unsigned char*)lds_raw;
    volatile LAS unsigned* MISC = (volatile LAS unsigned*)(lds + MISC_OFF);
    const int tid = threadIdx.x, lane = tid & 63, wave = __builtin_amdgcn_readfirstlane(tid >> 6);
    const int G = gridDim.x; const int bx = blockIdx.x; const int vcu = (G % 8 == 0) ? (bx % 8) * (G / 8) + bx / 8 : bx;
    unsigned char* ws = args.ws;
    gu32* ctl = (gu32*)(ws + WS_CTL);
    for (int u = tid; u < (LDS_BYTES - LDSCTL_OFF) / 4; u += NTHREADS) ((LAS unsigned*)(lds + LDSCTL_OFF))[u] = 0u;
    __syncthreads();
    XcdBarrier bar = xcd_barrier_post((unsigned*)(ctl + CW_BAR), MISC + 8);
    const int gw = vcu * NWAVES + wave, NGW = G * NWAVES;
    float* SS = (float*)(ws + WS_SSP);
    float* X = args.out;
    bf16* XB = (bf16*)(ws + WS_XB);
#define GRID_BAR() xcd_barrier(bar)
#define GEMM_PHASE(EPI, SCHED, lds_, g_, S_, E_) pg8::gemm_phase<EPI, SCHED, true, true>(lds_, g_, S_, E_)

    p0_prologue(args, lds, tid, lane, wave, vcu, G);
    GRID_BAR();
    { pg8::Gemm g{XB, (const bf16*)(ws + WS_WIN0), D, D, D, 0, 0}; pg8::StaticOrder S; S.init(M, EVEN_IN, 1, G, bx);
      pg8::EpiInProj0 E{SS, (bf16*)(ws + WS_UEXT), (bf16*)(ws + WS_QKV0), C2};
      GEMM_PHASE(pg8::EpiInProj0, pg8::StaticOrder, lds + RING_OFF, g, S, E); }
    GRID_BAR();
#define SB_PULL_ONE(more_) do { if (tid == 0) MISC[17] = __hip_atomic_fetch_add(ctl + CW_QUEUE2, 1u, RLX_AGENT); __syncthreads(); const unsigned uq_ = __builtin_amdgcn_readfirstlane(MISC[17]); __syncthreads(); \
        more_ = uq_ < (unsigned)(BATCH * SBH * 32); if (more_) { const int bh_ = (int)(uq_ >> 5), qb_ = (int)(uq_ & 31u); \
            attn_body::sb_unit<1536>(bh_ >> 3, bh_ & 7, qb_, (const attn_body::bf16*)(ws + WS_QKV0), (const attn_body::bf16*)(ws + WS_QKV0) + 512, (const attn_body::bf16*)(ws + WS_QKV0) + 1024, (attn_body::bf16*)(ws + WS_MIXB) + 512, (char*)lds_raw + RING_OFF); } } while (0)
    bool sb_more = true;
    { pg8::Gemm g{(const bf16*)(ws + WS_UEXT), (const bf16*)(ws + WS_S5WA), S5KX, 512, 512, (size_t)S5NC * S5KX * 2, (size_t)256 * 512 * 2}; pg8::StaticOrder S; S.init(S5NC, 256, S5G, G, bx);
      pg8::EpiS5State E{(float*)(ws + WS_SLOC)};
      GEMM_PHASE(pg8::EpiS5State, pg8::StaticOrder, lds + RING_OFF, g, S, E);
      if (bx >= S.nwg) SB_PULL_ONE(sb_more); }
    GRID_BAR();
    s5_scan(args, vcu * NTHREADS + tid);
    if (vcu * NTHREADS >= BATCH * S5G * S5P) SB_PULL_ONE(sb_more);
    GRID_BAR();
    { pg8::Gemm g{(const bf16*)(ws + WS_UEXT), (const bf16*)(ws + WS_S5WC), S5KX, S5KX, S5KX, (size_t)S5NC * S5KX * 2, (size_t)512 * S5KX * 2}; pg8::StaticOrder S; S.init(S5NC, 512, S5G, G, bx);
      pg8::EpiS5Y E{(bf16*)(ws + WS_YG)};
      GEMM_PHASE(pg8::EpiS5Y, pg8::StaticOrder, lds + RING_OFF, g, S, E);
      if (bx >= S.nwg) SB_PULL_ONE(sb_more); }
    GRID_BAR();
    { pg8::Gemm g{(const bf16*)(ws + WS_YG), (const bf16*)(ws + WS_WGLU), 512, 512, 512, 0, 0}; pg8::StaticOrder S; S.init(M, 512, 1, G, bx);
      pg8::EpiGlu E{(const bf16*)(ws + WS_YG), args.in[12], (bf16*)(ws + WS_MIXB)};
      GEMM_PHASE(pg8::EpiGlu, pg8::StaticOrder, lds + RING_OFF, g, S, E); }
    __syncthreads();
    sb_more = true;
#pragma unroll 1
    while (sb_more) SB_PULL_ONE(sb_more);
    GRID_BAR();
#undef SB_PULL_ONE
    { pg8::Gemm g{(const bf16*)(ws + WS_MIXB), (const bf16*)(ws + WS_WOUT0), D, D, D, 0, 0}; pg8::StaticOrder S; S.init(M, D, 1, G, bx);
      pg8::EpiResid E{args.in[0], X, XB, SS + 16 * M};
      GEMM_PHASE(pg8::EpiResid, pg8::StaticOrder, lds + RING_OFF, g, S, E); }
    GRID_BAR();
    { pg8::Gemm g{XB, (const bf16*)(ws + WS_WGU0), D, D, D, 0, 0}; pg8::StaticOrder S; S.init(M, 2 * DFF, 1, G, bx);
      pg8::EpiSwiGlu<true> E{SS + 16 * M, (bf16*)(ws + WS_HID0), DFF};
      GEMM_PHASE(pg8::EpiSwiGlu<true>, pg8::StaticOrder, lds + RING_OFF, g, S, E); }
    GRID_BAR();
    { pg8::Gemm g{(const bf16*)(ws + WS_HID0), (const bf16*)(ws + WS_WD0), DFF, DFF, DFF, 0, 0}; pg8::StaticOrder S; S.init(M, D, 1, G, bx);
      pg8::EpiResid E{X, X, XB, SS + 32 * M};
      GEMM_PHASE(pg8::EpiResid, pg8::StaticOrder, lds + RING_OFF, g, S, E); }
    GRID_BAR();
    { pg8::Gemm g{XB, (const bf16*)(ws + WS_WIN1), D, D, D, 0, 0}; pg8::StaticOrder S; S.init(M, 3072, 1, G, bx);
      pg8::EpiInProj1 E{SS + 32 * M, (bf16*)(ws + WS_QKV1), C2, (unsigned*)(ctl + CW_KN)};
      GEMM_PHASE(pg8::EpiInProj1, pg8::StaticOrder, lds + RING_OFF, g, S, E); }
    for (int r = gw; r < M / 16; r += NGW) fgate_rows16(XB, (const bf16*)(ws + WS_WF1), SS + 32 * M, args.in[20], (float*)(ws + WS_LOGF), r * 16, lane);
    GRID_BAR();
    { const attn_body::AttnTensors AT{(const attn_body::bf16*)(ws + WS_QKV1), (const attn_body::bf16*)(ws + WS_QKV1 + 32 * MiB), (const attn_body::bf16*)(ws + WS_QKV1 + 64 * MiB), (attn_body::bf16*)(ws + WS_QKV1), (const float*)(ws + WS_LOGF), (const unsigned*)(ctl + CW_KN)};
      constexpr int N_ATT = 1024, N_CVB = MOE_XITEMS / 32, N_GRP = (N_ATT + 2) / 3 > (N_CVB + 1) / 2 ? (N_ATT + 2) / 3 : (N_CVB + 1) / 2;
      for (;;) {
          if (tid == 0) MISC[16] = __hip_atomic_fetch_add(ctl + CW_QUEUE, 1u, RLX_AGENT);
          __syncthreads();
          const unsigned uq = __builtin_amdgcn_readfirstlane(MISC[16]);
          __syncthreads();
          if (uq >= 5u * N_GRP) break;
          const int grp = (int)(uq / 5u), rr = (int)(uq % 5u);
          if (rr & 1) { const int cb = 2 * grp + (rr >> 1);
              if (cb < N_CVB) { int lane_ = threadIdx.x & 63; asm volatile("" : "+v"(lane_));
                  LAS float* scr = (LAS float*)(lds + wave * XSCR_BYTES);
#pragma unroll 1
                  for (int j = 0; j < 4; j += 2) { const XTile t0 = moe_xtile(args, cb * 32 + wave * 4 + j, lane_), t1 = moe_xtile(args, cb * 32 + wave * 4 + j + 1, lane_);
                      f32x4 v0[16], v1[16]; xtile_load(t0, v0); xtile_load(t1, v1);
                      xtile_finish_fp8(t0, v0, 64.f, scr, lane_); xtile_finish_fp8(t1, v1, 64.f, scr, lane_); } }
          } else { const int au = 3 * grp + (rr >> 1);
              if (au < N_ATT) { const int bh = au & 31, qb = 31 - (au >> 5);
                  attn_body::attn_unit<8>(bh >> 4, bh & 15, qb, AT.Q, AT.K, AT.V, AT.O, (char*)lds_raw + RING_OFF, AT.logf + (size_t)bh * SEQ, AT.kn + (size_t)bh * 256); } }
      } }
    GRID_BAR();
    { pg8::Gemm g{(const bf16*)(ws + WS_QKV1), (const bf16*)(ws + WS_WOUT1), D, D, D, 0, 0}; pg8::StaticOrder S; S.init(M, D, 1, G, bx);
      pg8::EpiResid E{X, X, XB, SS + 48 * M};
      GEMM_PHASE(pg8::EpiResid, pg8::StaticOrder, lds + RING_OFF, g, S, E); }
    GRID_BAR();
    unsigned char* meta = ws + WS_META; unsigned char* XG = ws + WS_XG; float* RSS = (float*)(meta + MT_RSS);
    {
        const float* wr = args.in[23]; const float* gn = args.in[22];
        LAS unsigned* lcnt = (LAS unsigned*)(lds + 1024);
        if (tid < 16) lcnt[tid] = 0u;
        __syncthreads();
        for (int tok = gw; tok < M; tok += NGW) {
            const GAS f32x4* xr = (const GAS f32x4*)(X + (size_t)tok * D) + lane; float lg[NEXP]; float s = 0.f;
#pragma unroll
            for (int e = 0; e < NEXP; ++e) lg[e] = 0.f;
#pragma unroll
            for (int j = 0; j < 4; ++j) { const f32x4 v = xr[64 * j]; s += (v.x * v.x + v.y * v.y) + (v.z * v.z + v.w * v.w); const int k0 = 4 * lane + 256 * j; const f32x4 gv = *(const f32x4*)(gn + k0);
#pragma unroll
                for (int q = 0; q < 4; ++q) { const float xv = v[q] * gv[q]; const f32x4 w0 = *(const f32x4*)(wr + (size_t)(k0 + q) * NEXP), w1 = *(const f32x4*)(wr + (size_t)(k0 + q) * NEXP + 4);
                    lg[0] = fmaf(xv, w0.x, lg[0]); lg[1] = fmaf(xv, w0.y, lg[1]); lg[2] = fmaf(xv, w0.z, lg[2]); lg[3] = fmaf(xv, w0.w, lg[3]);
                    lg[4] = fmaf(xv, w1.x, lg[4]); lg[5] = fmaf(xv, w1.y, lg[5]); lg[6] = fmaf(xv, w1.z, lg[6]); lg[7] = fmaf(xv, w1.w, lg[7]); } }
            s = wave_sum(s);
#pragma unroll
            for (int e = 0; e < NEXP; ++e) lg[e] = wave_sum(lg[e]);
            if (lane == 0) {
                const float rs = 1.0f / sqrtf(s * (1.0f / 1024.0f) + pg8::RMS_EPS);
                int i1 = 0; float v1 = lg[0];
#pragma unroll
                for (int e = 1; e < NEXP; ++e) if (lg[e] > v1) { v1 = lg[e]; i1 = e; }
                int i2 = -1; float v2 = -INFINITY;
#pragma unroll
                for (int e = 0; e < NEXP; ++e) if (e != i1 && lg[e] > v2) { v2 = lg[e]; i2 = e; }
                const float g1 = 1.f / (1.f + expf((v2 - v1) * rs)), g2 = 1.f - g1;
                const unsigned p1 = __hip_atomic_fetch_add(lcnt + i1, 1u, __ATOMIC_RELAXED, __HIP_MEMORY_SCOPE_WORKGROUP), p2 = __hip_atomic_fetch_add(lcnt + i2, 1u, __ATOMIC_RELAXED, __HIP_MEMORY_SCOPE_WORKGROUP);
                ((float*)(meta + MT_RSTD))[tok] = rs; ((unsigned*)(meta + MT_TOKE))[tok] = (unsigned)i1 | ((unsigned)i2 << 8);
                ((unsigned*)(meta + MT_TOKP))[2 * tok] = p1; ((unsigned*)(meta + MT_TOKP))[2 * tok + 1] = p2;
                ((float*)(meta + MT_TOKG))[2 * tok] = g1; ((float*)(meta + MT_TOKG))[2 * tok + 1] = g2;
            }
        }
        __syncthreads();
        if (tid < NEXP) lcnt[8 + tid] = __hip_atomic_fetch_add(ctl + CW_CNT + 64 * tid, lcnt[tid], RLX_AGENT);
        VM_WAIT();
        __syncthreads();
        for (int tok = gw; tok < M; tok += NGW) {
            const unsigned ee = ((const unsigned*)(meta + MT_TOKE))[tok]; const float rs = ((const float*)(meta + MT_RSTD))[tok];
            const int e1 = (int)(ee & 0xffu), e2 = (int)((ee >> 8) & 0xffu);
            const unsigned p1 = ((const unsigned*)(meta + MT_TOKP))[2 * tok] + lcnt[8 + e1], p2 = ((const unsigned*)(meta + MT_TOKP))[2 * tok + 1] + lcnt[8 + e2];
            const GAS f32x4* xr = (const GAS f32x4*)(X + (size_t)tok * D) + lane; const size_t r1 = (size_t)e1 * MOE_CAP + p1, r2 = (size_t)e2 * MOE_CAP + p2;
#pragma unroll
            for (int j = 0; j < 4; ++j) { const f32x4 v = xr[64 * j]; const unsigned w = pg8::pk_fp8x4(v.x, v.y, v.z, v.w);
                *(unsigned*)(XG + r1 * D + 4 * lane + 256 * j) = w; *(unsigned*)(XG + r2 * D + 4 * lane + 256 * j) = w; }
            if (lane == 0) { RSS[r1] = rs; RSS[r2] = rs; ((unsigned*)(meta + MT_TOKP))[2 * tok] = p1; ((unsigned*)(meta + MT_TOKP))[2 * tok + 1] = p2; }
        }
    }
    GRID_BAR();
    int pref[NEXP + 1], cnt[NEXP];
    { pref[0] = 0;
#pragma unroll
      for (int e = 0; e < NEXP; ++e) { cnt[e] = (int)__builtin_amdgcn_readfirstlane(__hip_atomic_load(ctl + CW_CNT + 64 * e, RLX_AGENT)); pref[e + 1] = pref[e] + (cnt[e] + 255) / 256; } }
    const int NP = pref[NEXP];
    bf16* YS = (bf16*)(ws + WS_Y);
    { pg8::Gemm g{(const bf16*)XG, (const bf16*)(ws + WS_WMOE_GU), D / 2, D / 2, D / 2, 0, (size_t)7168 * 1024}; MoeOrder S; S.S.nM = NP; S.S.nN = 28; S.S.nZ = 1; S.S.nwg = NP * 28; S.S.G = G; S.S.c = bx; S.lo = 0; S.cap_rows = true;
#pragma unroll
      for (int e = 0; e <= NEXP; ++e) S.pref[e] = pref[e];
      pg8::EpiSwiGluFp8 E{RSS, ws + WS_HMOE, DFE};
      pg8::gemm_phase<pg8::EpiSwiGluFp8, MoeOrder, true, true, true>(lds + RING_OFF, g, S, E); }
    GRID_BAR();
    { pg8::Gemm g{(const bf16*)(ws + WS_HMOE), (const bf16*)(ws + WS_WMOE_D), DFE / 2, DFE / 2, DFE / 2, 0, (size_t)1024 * 3584}; MoeOrder S; S.S.nM = NP; S.S.nN = 4; S.S.nZ = 1; S.S.nwg = NP * 4; S.S.G = G; S.S.c = bx; S.lo = 0; S.cap_rows = false;
#pragma unroll
      for (int e = 0; e <= NEXP; ++e) S.pref[e] = pref[e];
      pg8::EpiStoreBf16 E{YS, D};
      pg8::gemm_phase<pg8::EpiStoreBf16, MoeOrder, true, true, true>(lds + RING_OFF, g, S, E); }
    GRID_BAR();
    {
        const float* gf = args.in[27];
        for (int tok = gw; tok < M; tok += NGW) {
            const unsigned ee = ((const unsigned*)(meta + MT_TOKE))[tok]; int pe0 = 0, pe1 = 0;
#pragma unroll
            for (int q = 0; q < NEXP; ++q) { pe0 = (q == (int)(ee & 0xffu)) ? pref[q] : pe0; pe1 = (q == (int)((ee >> 8) & 0xffu)) ? pref[q] : pe1; }
            const unsigned s0 = (unsigned)pe0 * 256u + ((const unsigned*)(meta + MT_TOKP))[2 * tok], s1 = (unsigned)pe1 * 256u + ((const unsigned*)(meta + MT_TOKP))[2 * tok + 1];
            const float g0 = ((const float*)(meta + MT_TOKG))[2 * tok], g1 = ((const float*)(meta + MT_TOKG))[2 * tok + 1];
            GAS f32x4* xr = (GAS f32x4*)(X + (size_t)tok * D) + lane; f32x4 v[4]; float s = 0.f;
#pragma unroll
            for (int j = 0; j < 4; ++j) { v[j] = xr[64 * j]; const int k0 = 4 * lane + 256 * j;
                const v2u a = *(const v2u*)(YS + (size_t)s0 * D + k0), b2 = *(const v2u*)(YS + (size_t)s1 * D + k0);
                v[j].x += g0 * bflo(a.x) + g1 * bflo(b2.x); v[j].y += g0 * bfhi(a.x) + g1 * bfhi(b2.x); v[j].z += g0 * bflo(a.y) + g1 * bflo(b2.y); v[j].w += g0 * bfhi(a.y) + g1 * bfhi(b2.y);
                s += (v[j].x * v[j].x + v[j].y * v[j].y) + (v[j].z * v[j].z + v[j].w * v[j].w); }
            s = wave_sum(s); const float rs = 1.0f / sqrtf(s * (1.0f / 1024.0f) + pg8::RMS_EPS);
#pragma unroll
            for (int j = 0; j < 4; ++j) { const f32x4 gv = *(const f32x4*)(gf + 4 * lane + 256 * j); xr[64 * j] = v[j] * rs * gv; }
        }
    }
}

extern "C" void kernel_launch(void* const* d_in, const int* in_sizes, int n_in, void* d_out, int out_size, void* d_ws, size_t ws_size, hipStream_t stream) {
    static int grid = 0;
    if (grid == 0) {
        if (n_in != 28 || in_sizes[0] != M * D || out_size != M * D || ws_size < WS_END) { fprintf(stderr, "kernel_launch: unexpected problem: n_in %d in0 %d out %d ws %zu (need %zu)\n", n_in, n_in > 0 ? in_sizes[0] : -1, out_size, ws_size, (size_t)WS_END); grid = -1; return; }
        int dev = 0, cus = 0, per_cu = 0;
        if (hipGetDevice(&dev) != hipSuccess || hipDeviceGetAttribute(&cus, hipDeviceAttributeMultiprocessorCount, dev) != hipSuccess) { grid = -1; return; }
        if (hipFuncSetAttribute((const void*)mk_fwd, hipFuncAttributeMaxDynamicSharedMemorySize, LDS_BYTES) != hipSuccess) { fprintf(stderr, "kernel_launch: hipFuncSetAttribute failed\n"); grid = -1; return; }
        if (hipOccupancyMaxActiveBlocksPerMultiprocessor(&per_cu, (const void*)mk_fwd, NTHREADS, LDS_BYTES) != hipSuccess || per_cu < 1) fprintf(stderr, "kernel_launch: occupancy query says %d\n", per_cu);
        (void)hipGetLastError();
        grid = cus;
        if (grid != 256) fprintf(stderr, "kernel_launch: built for the 256-CU MI355X; device reports %d CUs\n", cus);
    }
    if (grid < 0) return;
    if (hipMemsetAsync((char*)d_ws + WS_CTL, 0, CTL_ZERO_BYTES, stream) != hipSuccess) return;
    Args a{};
    for (int i = 0; i < 28; ++i) a.in[i] = (const float*)d_in[i];
    a.out = (float*)d_out; a.ws = (unsigned char*)d_ws;
    hipLaunchKernelGGL(mk_fwd, dim3(grid), dim3(NTHREADS), LDS_BYTES, stream, a);
}
```

```cpp
#include <hip/hip_runtime.h>
#include <cstdio>
#include <cstdint>

namespace pg8 {
#define PG8_LAS __attribute__((address_space(3)))
typedef unsigned short bf16_t;
typedef short bf16x8 __attribute__((ext_vector_type(8)));
typedef float f32x4 __attribute__((ext_vector_type(4)));
typedef unsigned u32x4 __attribute__((ext_vector_type(4)));
typedef unsigned u32x2 __attribute__((ext_vector_type(2)));
constexpr int BM = 256, BK = 64, HALF = 128, HTB = HALF * BK * 2  , STAGE_BYTES = 8 * HTB, NXCD = 8, WGM = 8;

__host__ __device__ __forceinline__ int lds_byte(int r, int c) { const int st = (r >> 4) * 2 + (c >> 5), rr = r & 15, cc = c & 31, ob = rr * 64 + cc * 2; return st * 1024 + (ob ^ (((ob >> 9) & 1) << 5)); }
__host__ __device__ __forceinline__ void stage_rc(int b, int& R, int& C) { const int st = b / 1024, sb = b % 1024, swz = sb ^ (((sb >> 9) & 1) << 5); R = (st >> 1) * 16 + swz / 64; C = (st & 1) * 32 + (swz % 64) / 2; }
__host__ __device__ __forceinline__ int perm32(int rho) { const int n = rho >> 4, i = rho & 15; return 8 * (i >> 2) + 4 * n + (i & 3); }

struct Unit { int pm, pn, zb, pa; };
struct Gemm { const bf16_t* A; const bf16_t* Bt; int lda, ldb, K; size_t zA, zB; };

struct StaticOrder {
    int nM, nN, nZ, nwg, G, c;
    __host__ __device__ void init(int M, int N, int Z, int G_, int c_) { nM = M / BM; nN = N / BM; nZ = Z; nwg = nM * nN * nZ; G = G_; c = c_; }
    __host__ __device__ bool next(int i, Unit& u) const {
        const long L = (long)i * G + c; if (L >= nwg) return false;
        int wgid = (int)L; { const int q = nwg / NXCD, r = nwg % NXCD, xcd = wgid % NXCD, off = wgid / NXCD; wgid = (xcd < r ? xcd * (q + 1) : r * (q + 1) + (xcd - r) * q) + off; }
        const int per = nM * nN; u.zb = wgid / per; wgid -= u.zb * per;
        const int nig = WGM * nN, gid = wgid / nig, fm = gid * WGM, gsz = (nM - fm) < WGM ? (nM - fm) : WGM;
        u.pm = fm + ((wgid % nig) % gsz); u.pn = (wgid % nig) / gsz; u.pa = u.pm; return true;
    }
    __device__ __forceinline__ void a_ready(const Unit&) const {}
    __device__ __forceinline__ void done(const Unit&) const {}
};

__device__ __forceinline__ unsigned cvt_pk_bf16(float lo, float hi) { unsigned r; asm volatile("v_cvt_pk_bf16_f32 %0, %1, %2" : "=v"(r) : "v"(lo), "v"(hi)); return r; }
typedef int v4i_t __attribute__((ext_vector_type(4))); typedef int v8i_t __attribute__((ext_vector_type(8)));
__device__ __forceinline__ v8i_t cat8(bf16x8 a, bf16x8 b) { return __builtin_shufflevector(__builtin_bit_cast(v4i_t, a), __builtin_bit_cast(v4i_t, b), 0, 1, 2, 3, 4, 5, 6, 7); }
__device__ __forceinline__ unsigned pk_fp8x4(float a, float b, float c, float d) { int r = 0; r = __builtin_amdgcn_cvt_pk_fp8_f32(a, b, r, false); r = __builtin_amdgcn_cvt_pk_fp8_f32(c, d, r, true); return (unsigned)r; }
__device__ __forceinline__ float bf_lo(unsigned w) { return __uint_as_float(w << 16); }
__device__ __forceinline__ float bf_hi(unsigned w) { return __uint_as_float(w & 0xffff0000u); }
__device__ __forceinline__ float fast_sigmoid(float z) { return __builtin_amdgcn_rcpf(1.0f + __builtin_amdgcn_exp2f(-1.4426950408889634f * z)); }
constexpr float RMS_EPS = 1e-6f;
__device__ __forceinline__ float rstd16(const float* ssp, int row) { const f32x4* p = (const f32x4*)(ssp + (size_t)row * 16); const f32x4 a = p[0], b = p[1], c = p[2], d = p[3];
    const float s = (((a[0] + a[1]) + (a[2] + a[3])) + ((b[0] + b[1]) + (b[2] + b[3]))) + (((c[0] + c[1]) + (c[2] + c[3])) + ((d[0] + d[1]) + (d[2] + d[3])));
    return __builtin_amdgcn_rsqf(s * (1.0f / 1024.0f) + RMS_EPS); }

__device__ __forceinline__ void rstd8(const float* ssp, int row0, int fq, float (&rs)[8]) {
    f32x4 p[8];
#pragma unroll
    for (int i = 0; i < 8; ++i) p[i] = *(const f32x4*)(ssp + (size_t)(row0 + (i >> 2) * HALF + (i & 3) * 16) * 16 + 4 * fq);
#pragma unroll
    for (int i = 0; i < 8; ++i) { float q = (p[i][0] + p[i][1]) + (p[i][2] + p[i][3]); q += __shfl_xor(q, 16); q += __shfl_xor(q, 32); rs[i] = __builtin_amdgcn_rsqf(q * (1.0f / 1024.0f) + RMS_EPS); }
}
__device__ __forceinline__ u32x4 pack8(const f32x4 v0, const f32x4 v1) { u32x4 w; w.x = cvt_pk_bf16(v0[0], v0[1]); w.y = cvt_pk_bf16(v0[2], v0[3]); w.z = cvt_pk_bf16(v1[0], v1[1]); w.w = cvt_pk_bf16(v1[2], v1[3]); return w; }

struct EpiInProj0 {
    static constexpr bool PERM = true, AFTER_DRAIN = false;
    const float* ss; bf16_t* uext; bf16_t* qkv; float qscale;
    __device__ __forceinline__ void operator()(const f32x4 (&acc)[2][2][4][2], const Unit& u, int wr, int wc, int fr, int fq) const {
        const int row0 = u.pm * BM + wr * 64 + fr; float rsa[8]; rstd8(ss, row0, fq, rsa);
#pragma unroll
        for (int ai = 0; ai < 2; ++ai)
#pragma unroll
            for (int m = 0; m < 4; ++m) { const int row = row0 + ai * HALF + m * 16; const float rs = rsa[ai * 4 + m];
#pragma unroll
                for (int bj = 0; bj < 2; ++bj) { const int col0 = u.pn * BM + bj * HALF + wc * 32 + 8 * fq;
                    float sc = rs; bf16_t* dst;
                    if (u.pn < 2) dst = uext + ((size_t)(col0 >> 4) * 512 + (row >> 5)) * 640 + (row & 31) * 16 + (col0 & 15);
                    else { const int c = col0 - 512; if (c < 512) sc *= qscale; dst = qkv + (size_t)row * 1536 + c; }
                    *(u32x4*)dst = pack8(acc[ai][bj][m][0] * sc, acc[ai][bj][m][1] * sc); } }
    }
};
struct EpiS5State {
    static constexpr bool PERM = false, AFTER_DRAIN = false;
    float* sloc;
    __device__ __forceinline__ void operator()(const f32x4 (&acc)[2][2][4][2], const Unit& u, int wr, int wc, int fr, int fq) const {
        const int row0 = u.pm * BM + wr * 64 + fr, col0 = wc * 32 + 4 * fq;
#pragma unroll
        for (int ai = 0; ai < 2; ++ai)
#pragma unroll
            for (int m = 0; m < 4; ++m) { float* rowp = sloc + ((size_t)u.zb * 512 + row0 + ai * HALF + m * 16) * 128 + col0;
#pragma unroll
                for (int n = 0; n < 2; ++n) *(f32x4*)(rowp + n * 16) = acc[ai][0][m][n]; }
    }
};
__device__ __forceinline__ float gelu_tanh(float x) { const float a = x * (1.0f + 0.044715f * x * x); return x * __builtin_amdgcn_rcpf(1.0f + __builtin_amdgcn_exp2f(-2.302208198f * a)); }
struct EpiS5Y {
    static constexpr bool PERM = true, AFTER_DRAIN = false;
    bf16_t* yg;
    __device__ __forceinline__ void operator()(const f32x4 (&acc)[2][2][4][2], const Unit& u, int wr, int wc, int fr, int fq) const {
        const int row0 = u.pm * BM + wr * 64 + fr;
#pragma unroll
        for (int ai = 0; ai < 2; ++ai)
#pragma unroll
            for (int m = 0; m < 4; ++m) { const int chunk = row0 + ai * HALF + m * 16;
#pragma unroll
                for (int bj = 0; bj < 2; ++bj) { const int col0 = u.pn * BM + bj * HALF + wc * 32 + 8 * fq; const int i = col0 >> 4, h0 = col0 & 15;
                    f32x4 v0 = acc[ai][bj][m][0], v1 = acc[ai][bj][m][1];
#pragma unroll
                    for (int e = 0; e < 4; ++e) { v0[e] = gelu_tanh(v0[e]); v1[e] = gelu_tanh(v1[e]); }
                    *(u32x4*)(yg + ((size_t)chunk * 32 + i) * 512 + u.zb * 16 + h0) = pack8(v0, v1); } }
    }
};
struct EpiGlu {
    static constexpr bool PERM = true, AFTER_DRAIN = false;
    const bf16_t* yg; const float* bias; bf16_t* mix;
    __device__ __forceinline__ void operator()(const f32x4 (&acc)[2][2][4][2], const Unit& u, int wr, int wc, int fr, int fq) const {
        const int row0 = u.pm * BM + wr * 64 + fr; u32x4 ywa[2][8];
#pragma unroll
        for (int bj = 0; bj < 2; ++bj)
#pragma unroll
            for (int i = 0; i < 8; ++i) ywa[bj][i] = *(const u32x4*)(yg + (size_t)(row0 + (i >> 2) * HALF + (i & 3) * 16) * 512 + u.pn * BM + bj * HALF + wc * 32 + 8 * fq);
#pragma unroll
        for (int bj = 0; bj < 2; ++bj) { const int col0 = u.pn * BM + bj * HALF + wc * 32 + 8 * fq;
            const f32x4 b0 = *(const f32x4*)(bias + col0), b1 = *(const f32x4*)(bias + col0 + 4);
#pragma unroll
            for (int ai = 0; ai < 2; ++ai)
#pragma unroll
                for (int m = 0; m < 4; ++m) { const int row = row0 + ai * HALF + m * 16;
                    const u32x4 yw = ywa[bj][ai * 4 + m];
                    f32x4 z0 = acc[ai][bj][m][0] + b0, z1 = acc[ai][bj][m][1] + b1, o0, o1;
                    o0[0] = bf_lo(yw.x) * fast_sigmoid(z0[0]); o0[1] = bf_hi(yw.x) * fast_sigmoid(z0[1]); o0[2] = bf_lo(yw.y) * fast_sigmoid(z0[2]); o0[3] = bf_hi(yw.y) * fast_sigmoid(z0[3]);
                    o1[0] = bf_lo(yw.z) * fast_sigmoid(z1[0]); o1[1] = bf_hi(yw.z) * fast_sigmoid(z1[1]); o1[2] = bf_lo(yw.w) * fast_sigmoid(z1[2]); o1[3] = bf_hi(yw.w) * fast_sigmoid(z1[3]);
                    *(u32x4*)(mix + (size_t)row * 1024 + col0) = pack8(o0, o1); } }
    }
};
struct EpiResid {
    static constexpr bool PERM = false, AFTER_DRAIN = false;
    const float* R; float* X; bf16_t* xb; float* ssq;
    __device__ __forceinline__ void operator()(const f32x4 (&acc)[2][2][4][2], const Unit& u, int wr, int wc, int fr, int fq) const {
        const int row0 = u.pm * BM + wr * 64 + fr, col0 = u.pn * BM + wc * 32 + 4 * fq;
#pragma unroll
        for (int ai = 0; ai < 2; ++ai) {
            f32x4 rv[4][2][2];
#pragma unroll
            for (int m = 0; m < 4; ++m)
#pragma unroll
                for (int bj = 0; bj < 2; ++bj)
#pragma unroll
                    for (int n = 0; n < 2; ++n) rv[m][bj][n] = *(const f32x4*)(R + (size_t)(row0 + ai * HALF + m * 16) * 1024 + col0 + bj * HALF + n * 16);
            asm volatile("" ::: "memory");
#pragma unroll
            for (int m = 0; m < 4; ++m) { const int row = row0 + ai * HALF + m * 16; const size_t off = (size_t)row * 1024 + col0; float s = 0.f;
#pragma unroll
                for (int bj = 0; bj < 2; ++bj)
#pragma unroll
                    for (int n = 0; n < 2; ++n) { const f32x4 x = rv[m][bj][n] + acc[ai][bj][m][n];
                        *(f32x4*)(X + off + bj * HALF + n * 16) = x; s += (x[0] * x[0] + x[1] * x[1]) + (x[2] * x[2] + x[3] * x[3]);
                        u32x2 w; w.x = cvt_pk_bf16(x[0], x[1]); w.y = cvt_pk_bf16(x[2], x[3]); *(u32x2*)(xb + off + bj * HALF + n * 16) = w; }
                s += __shfl_xor(s, 16); s += __shfl_xor(s, 32);
                if (fq == 0) ssq[(size_t)row * 16 + u.pn * 4 + wc] = s; }
            asm volatile("" ::: "memory"); }
    }
};
template <bool RS_IS_SSQ> struct EpiSwiGlu {
    static constexpr bool PERM = true, AFTER_DRAIN = false;
    const float* rsv; bf16_t* H; int ldh;
    __device__ __forceinline__ void operator()(const f32x4 (&acc)[2][2][4][2], const Unit& u, int wr, int wc, int fr, int fq) const {
        const int row0 = u.pm * BM + wr * 64 + fr, col0 = u.pn * HALF + wc * 32 + 8 * fq; float rsa[8];
        if (RS_IS_SSQ) rstd8(rsv, row0, fq, rsa);
        else {
#pragma unroll
            for (int i = 0; i < 8; ++i) rsa[i] = rsv[row0 + (i >> 2) * HALF + (i & 3) * 16]; }
#pragma unroll
        for (int ai = 0; ai < 2; ++ai)
#pragma unroll
            for (int m = 0; m < 4; ++m) { const int row = row0 + ai * HALF + m * 16; const float rs = rsa[ai * 4 + m];
                f32x4 o[2];
#pragma unroll
                for (int n = 0; n < 2; ++n)
#pragma unroll
                    for (int e = 0; e < 4; ++e) { const float g = acc[ai][0][m][n][e] * rs, up = acc[ai][1][m][n][e] * rs; o[n][e] = g * fast_sigmoid(g) * up; }
                *(u32x4*)(H + (size_t)row * ldh + col0) = pack8(o[0], o[1]); }
    }
};
struct EpiSwiGluFp8 {
    static constexpr bool PERM = true, AFTER_DRAIN = false;
    const float* rsv; unsigned char* H; int ldh;
    __device__ __forceinline__ void operator()(const f32x4 (&acc)[2][2][4][2], const Unit& u, int wr, int wc, int fr, int fq) const {
        const int row0 = u.pm * BM + wr * 64 + fr, col0 = u.pn * HALF + wc * 32 + 8 * fq; float rsa[8];
#pragma unroll
        for (int i = 0; i < 8; ++i) rsa[i] = rsv[u.pa * BM + wr * 64 + fr + (i >> 2) * HALF + (i & 3) * 16];
#pragma unroll
        for (int ai = 0; ai < 2; ++ai)
#pragma unroll
            for (int m = 0; m < 4; ++m) { const int row = row0 + ai * HALF + m * 16; const float rs = rsa[ai * 4 + m];
                f32x4 o[2];
#pragma unroll
                for (int n = 0; n < 2; ++n)
#pragma unroll
                    for (int e = 0; e < 4; ++e) { const float g = acc[ai][0][m][n][e] * rs, up = acc[ai][1][m][n][e] * rs; o[n][e] = g * fast_sigmoid(g) * up; }
                u32x2 w; w.x = pk_fp8x4(o[0][0], o[0][1], o[0][2], o[0][3]); w.y = pk_fp8x4(o[1][0], o[1][1], o[1][2], o[1][3]);
                *(u32x2*)(H + (size_t)row * ldh + col0) = w; }
    }
};
struct EpiInProj1 {
    static constexpr bool PERM = true, AFTER_DRAIN = false;
    const float* ss; bf16_t* qkv; float qscale;
    unsigned* kn;
    __device__ __forceinline__ void operator()(const f32x4 (&acc)[2][2][4][2], const Unit& u, int wr, int wc, int fr, int fq) const {
        const int row0 = u.pm * BM + wr * 64 + fr; const float qs = (u.pn < 4) ? qscale : 1.0f; float rsa[8]; rstd8(ss, row0, fq, rsa);
#pragma unroll
        for (int ai = 0; ai < 2; ++ai)
#pragma unroll
            for (int m = 0; m < 4; ++m) { const int row = row0 + ai * HALF + m * 16; const float sc = rsa[ai * 4 + m] * qs;
#pragma unroll
                for (int bj = 0; bj < 2; ++bj) { const int col0 = (u.pn & 3) * BM + bj * HALF + wc * 32 + 8 * fq;
                    const f32x4 v0 = acc[ai][bj][m][0] * sc, v1 = acc[ai][bj][m][1] * sc;
                    *(u32x4*)(qkv + (size_t)(u.pn >> 2) * (16384 * 1024) + (size_t)row * 1024 + col0) = pack8(v0, v1);
                    if ((u.pn >> 2) == 1) {
                        float q = ((v0[0] * v0[0] + v0[1] * v0[1]) + (v0[2] * v0[2] + v0[3] * v0[3])) + ((v1[0] * v1[0] + v1[1] * v1[1]) + (v1[2] * v1[2] + v1[3] * v1[3]));
                        q += __shfl_xor(q, 16); q += __shfl_xor(q, 32);
                        q = fmaxf(q, __shfl_xor(q, 1)); q = fmaxf(q, __shfl_xor(q, 2)); q = fmaxf(q, __shfl_xor(q, 4)); q = fmaxf(q, __shfl_xor(q, 8));
                        if (fr == 0 && fq == 0) { const int head = (u.pn & 3) * 4 + bj * 2 + (wc >> 1), bb = row >> 13, tile = (row & 8191) >> 6;
                            atomicMax(kn + ((size_t)(bb * 16 + head) * 128 + tile) * 2 + (wc & 1), __float_as_uint(q * 1.01f)); } } } }
    }
};
struct EpiStoreBf16 {
    static constexpr bool PERM = true, AFTER_DRAIN = false;
    bf16_t* O; int ldc;
    __device__ __forceinline__ void operator()(const f32x4 (&acc)[2][2][4][2], const Unit& u, int wr, int wc, int fr, int fq) const {
        const int row0 = u.pm * BM + wr * 64 + fr;
#pragma unroll
        for (int ai = 0; ai < 2; ++ai)
#pragma unroll
            for (int m = 0; m < 4; ++m) { const int row = row0 + ai * HALF + m * 16;
#pragma unroll
                for (int bj = 0; bj < 2; ++bj) { const int col0 = u.pn * BM + bj * HALF + wc * 32 + 8 * fq;
                    *(u32x4*)(O + (size_t)row * ldc + col0) = pack8(acc[ai][bj][m][0], acc[ai][bj][m][1]); } }
    }
};

template <bool F8> struct Frag { bf16x8 k[2]; };
template <> struct Frag<true> { v8i_t v; };
template <class Epi, class Sched, bool ALIGN_EPI = false, bool SP2 = false, bool FP8 = false>
__device__ __forceinline__ void gemm_phase(PG8_LAS unsigned char* lds, const Gemm g, const Sched& S, const Epi& E) {
    int tid_ = threadIdx.x; asm volatile("" : "+v"(tid_));
    const int tid = tid_, wid = __builtin_amdgcn_readfirstlane(tid >> 6), lane = tid & 63, wr = wid >> 2, wc = wid & 3, fr = lane & 15, fq = lane >> 4;
    const int K = g.K, nt = K / BK;
    unsigned voffA[2], voffB[2];
#pragma unroll
    for (int i = 0; i < 2; ++i) { int R, C; stage_rc(tid * 16 + i * 8192, R, C); const int Rb = Epi::PERM ? ((R & ~31) + perm32(R & 31)) : R;
        voffA[i] = (unsigned)(R * g.lda + C) * 2u; voffB[i] = (unsigned)(Rb * g.ldb + C) * 2u; }
    const size_t kstep = (size_t)(BK * 2);
    const size_t hstepA = (size_t)HALF * g.lda * 2, hstepB = (size_t)HALF * g.ldb * 2;
    const size_t tstepA = 2 * hstepA, tstepB = 2 * hstepB;
    const unsigned ldsw = (unsigned)wid * 1024u;
    const int aoff = lds_byte(wr * 64 + fr, fq * 8), boff = lds_byte(wc * 32 + fr, fq * 8);
#define PG8_SA(b, h) (((b) * 2 + (h)) * HTB)
#define PG8_SB(b, h) ((4 + (b) * 2 + (h)) * HTB)
#define PG8_STAGE(bufoff, gbase, voff) do { _Pragma("unroll") for (int _i = 0; _i < 2; ++_i) \
        __builtin_amdgcn_global_load_lds((const unsigned*)((const char*)(gbase) + (voff)[_i]), (PG8_LAS unsigned*)(lds + (bufoff) + ldsw + _i * 8192), 16, 0, 0); } while (0)
    const PG8_LAS unsigned char* ldsA_ = lds + aoff; const PG8_LAS unsigned char* ldsB_ = lds + 4 * HTB + boff; asm volatile("" : "+v"(ldsA_), "+v"(ldsB_));
#define PG8_RDA(off) (*(const PG8_LAS bf16x8*)(ldsA_ + (off)))
#define PG8_RDB(off) (*(const PG8_LAS bf16x8*)(ldsB_ + (off)))
#define PG8_LDA(dst, b, h) do { _Pragma("unroll") for (int m = 0; m < 4; ++m) { if constexpr (FP8) dst[m].v = cat8(PG8_RDA(PG8_SA(b, h) + m * 2048), PG8_RDA(PG8_SA(b, h) + m * 2048 + 1024)); \
        else { dst[m].k[0] = PG8_RDA(PG8_SA(b, h) + m * 2048); dst[m].k[1] = PG8_RDA(PG8_SA(b, h) + m * 2048 + 1024); } } } while (0)
#define PG8_LDB(dst, b, h) do { _Pragma("unroll") for (int n = 0; n < 2; ++n) { if constexpr (FP8) dst[n].v = cat8(PG8_RDB(PG8_SB(b, h) - 4 * HTB + n * 2048), PG8_RDB(PG8_SB(b, h) - 4 * HTB + n * 2048 + 1024)); \
        else { dst[n].k[0] = PG8_RDB(PG8_SB(b, h) - 4 * HTB + n * 2048); dst[n].k[1] = PG8_RDB(PG8_SB(b, h) - 4 * HTB + n * 2048 + 1024); } } } while (0)
#define PG8_MMA(ai, bj, At, Bt) do { __builtin_amdgcn_s_setprio(1); _Pragma("unroll") for (int m = 0; m < 4; ++m) _Pragma("unroll") for (int n = 0; n < 2; ++n) { \
        if constexpr (FP8) { asm volatile("v_mfma_scale_f32_16x16x128_f8f6f4 %0, %1, %2, %0, %3, %4 op_sel_hi:[0,0,0]" : "+v"(acc[ai][bj][m][n]) : "v"(Bt[n].v), "v"(At[m].v), "v"(sclB_), "v"(sclA_)); } \
        else { _Pragma("unroll") for (int k = 0; k < 2; ++k) acc[ai][bj][m][n] = __builtin_amdgcn_mfma_f32_16x16x32_bf16(Bt[n].k[k], At[m].k[k], acc[ai][bj][m][n], 0, 0, 0); } } __builtin_amdgcn_s_setprio(0); } while (0)
#define PG8_WAIT_V(n) asm volatile("s_waitcnt vmcnt(" #n ")" ::: "memory")
#define PG8_WAIT_L(n) asm volatile("s_waitcnt lgkmcnt(" #n ")" ::: "memory")
#define PG8_BAR __builtin_amdgcn_s_barrier()
#define PG8_SCHED __builtin_amdgcn_sched_barrier(0)
    Unit cur, nxt; int ui = 0;
    if (!S.next(0, cur)) return;
    f32x4 acc[2][2][4][2];
#pragma unroll
    for (int a = 0; a < 2; ++a)
#pragma unroll
        for (int b = 0; b < 2; ++b)
#pragma unroll
            for (int m = 0; m < 4; ++m)
#pragma unroll
                for (int n = 0; n < 2; ++n) acc[a][b][m][n] = (f32x4){0.f, 0.f, 0.f, 0.f};
    Frag<FP8> At[4], B0[2], B1[2];
    int sclB_ = 0x79797979, sclA_ = 0x7f7f7f7f; asm volatile("" : "+v"(sclB_), "+v"(sclA_));
    const char* cA = (const char*)g.A + (size_t)cur.zb * g.zA + (size_t)cur.pa * tstepA; const char* cB = (const char*)g.Bt + (size_t)cur.zb * g.zB + (size_t)cur.pn * tstepB;
    S.a_ready(cur);
    if constexpr (SP2) {
        PG8_STAGE(PG8_SB(0, 0), cB, voffB); PG8_STAGE(PG8_SB(0, 1), cB + hstepB, voffB); PG8_STAGE(PG8_SA(0, 0), cA, voffA); PG8_STAGE(PG8_SA(0, 1), cA + hstepA, voffA);
        if (wr == 1) PG8_BAR;
        PG8_WAIT_V(2); PG8_BAR;
        PG8_STAGE(PG8_SB(1, 0), cB + kstep, voffB); PG8_STAGE(PG8_SA(1, 0), cA + kstep, voffA); PG8_STAGE(PG8_SB(1, 1), cB + hstepB + kstep, voffB);
        PG8_WAIT_V(6); PG8_BAR;
    } else {
        PG8_STAGE(PG8_SB(0, 0), cB, voffB); PG8_STAGE(PG8_SA(0, 0), cA, voffA); PG8_STAGE(PG8_SB(0, 1), cB + hstepB, voffB); PG8_STAGE(PG8_SA(0, 1), cA + hstepA, voffA);
        if (wr == 1) PG8_BAR;
        PG8_WAIT_V(4); PG8_BAR;
        PG8_STAGE(PG8_SB(1, 0), cB + kstep, voffB); PG8_STAGE(PG8_SA(1, 0), cA + kstep, voffA); PG8_STAGE(PG8_SB(1, 1), cB + hstepB + kstep, voffB);
        PG8_WAIT_V(6); PG8_BAR;
    }
    for (;;) {
        const bool has_next = S.next(ui + 1, nxt);
        const char* nA = has_next ? (const char*)g.A + (size_t)nxt.zb * g.zA + (size_t)nxt.pa * tstepA : cA; const char* nB = has_next ? (const char*)g.Bt + (size_t)nxt.zb * g.zB + (size_t)nxt.pn * tstepB : cB;
#pragma unroll 1
        for (int t = 0; t < nt; t += 2) {
            const bool last = (t == nt - 2);
            const char* a1 = cA + (size_t)(t + 1) * kstep;
            const char* a2 = last ? nA : cA + (size_t)(t + 2) * kstep; const char* b2 = last ? nB : cB + (size_t)(t + 2) * kstep;
            const char* a3 = a2 + kstep; const char* b3 = b2 + kstep;
            if (last && has_next) S.a_ready(nxt);
            if constexpr (SP2) {
            PG8_LDB(B0, 0, 0); PG8_LDB(B1, 0, 1); PG8_SCHED; PG8_LDA(At, 0, 0); PG8_STAGE(PG8_SA(1, 1), a1 + hstepA, voffA);
            PG8_WAIT_V(8); PG8_WAIT_L(0); PG8_BAR; PG8_MMA(0, 0, At, B0); PG8_MMA(0, 1, At, B1); PG8_BAR; PG8_SCHED;
            PG8_LDA(At, 0, 1); PG8_STAGE(PG8_SB(0, 0), b2, voffB); PG8_STAGE(PG8_SB(0, 1), b2 + hstepB, voffB); PG8_STAGE(PG8_SA(0, 0), a2, voffA);
            PG8_WAIT_V(8); PG8_WAIT_L(0); PG8_BAR; PG8_MMA(1, 0, At, B0); PG8_MMA(1, 1, At, B1); PG8_BAR; PG8_SCHED;
            PG8_LDB(B0, 1, 0); PG8_LDB(B1, 1, 1); PG8_SCHED; PG8_LDA(At, 1, 0); PG8_STAGE(PG8_SA(0, 1), a2 + hstepA, voffA);
            PG8_WAIT_V(8); PG8_WAIT_L(0); PG8_BAR; PG8_MMA(0, 0, At, B0); PG8_MMA(0, 1, At, B1); PG8_BAR; PG8_SCHED;
            PG8_LDA(At, 1, 1); PG8_STAGE(PG8_SB(1, 0), b3, voffB); PG8_STAGE(PG8_SB(1, 1), b3 + hstepB, voffB); PG8_STAGE(PG8_SA(1, 0), a3, voffA);
            PG8_WAIT_V(8); PG8_WAIT_L(0); PG8_BAR; PG8_MMA(1, 0, At, B0); PG8_MMA(1, 1, At, B1); PG8_BAR; PG8_SCHED;
            } else {
            PG8_LDB(B0, 0, 0); PG8_SCHED; PG8_LDA(At, 0, 0); PG8_STAGE(PG8_SA(1, 1), a1 + hstepA, voffA);
            PG8_WAIT_L(8); PG8_BAR; PG8_WAIT_L(0); PG8_MMA(0, 0, At, B0); PG8_BAR; PG8_SCHED;
            PG8_LDB(B1, 0, 1); PG8_STAGE(PG8_SB(0, 0), b2, voffB);
            PG8_BAR; PG8_WAIT_L(0); PG8_MMA(0, 1, At, B1); PG8_BAR;
            PG8_LDA(At, 0, 1); PG8_STAGE(PG8_SA(0, 0), a2, voffA);
            PG8_BAR; PG8_WAIT_L(0); PG8_MMA(1, 0, At, B0); PG8_BAR; PG8_SCHED;
            PG8_STAGE(PG8_SB(0, 1), b2 + hstepB, voffB);
            PG8_WAIT_V(6); PG8_BAR; PG8_MMA(1, 1, At, B1); PG8_BAR;
            PG8_LDB(B0, 1, 0); PG8_SCHED; PG8_LDA(At, 1, 0); PG8_STAGE(PG8_SA(0, 1), a2 + hstepA, voffA);
            PG8_WAIT_L(8); PG8_BAR; PG8_WAIT_L(0); PG8_MMA(0, 0, At, B0); PG8_BAR; PG8_SCHED;
            PG8_LDB(B1, 1, 1); PG8_STAGE(PG8_SB(1, 0), b3, voffB);
            PG8_BAR; PG8_WAIT_L(0); PG8_MMA(0, 1, At, B1); PG8_BAR;
            PG8_LDA(At, 1, 1); PG8_STAGE(PG8_SA(1, 0), a3, voffA);
            PG8_BAR; PG8_WAIT_L(0); PG8_MMA(1, 0, At, B0); PG8_BAR; PG8_SCHED;
            PG8_STAGE(PG8_SB(1, 1), b3 + hstepB, voffB);
            PG8_WAIT_V(6); PG8_BAR; PG8_MMA(1, 1, At, B1); PG8_BAR;
            }
        }
        if constexpr (ALIGN_EPI) { if (wr == 0) PG8_BAR; }
        if constexpr (FP8) asm volatile("s_nop 15\n\ts_nop 15" ::: "memory");
        if constexpr (!Epi::AFTER_DRAIN) { int fr_ = fr, fq_ = fq; asm volatile("" : "+v"(fr_), "+v"(fq_));
            E(acc, cur, wr, wc, fr_, fq_); S.done(cur); }
        if (!has_next) break;
#pragma unroll
        for (int a = 0; a < 2; ++a)
#pragma unroll
            for (int b = 0; b < 2; ++b)
#pragma unroll
                for (int m = 0; m < 4; ++m)
#pragma unroll
                    for (int n = 0; n < 2; ++n) acc[a][b][m][n] = (f32x4){0.f, 0.f, 0.f, 0.f};
        cur = nxt; cA = nA; cB = nB; ++ui;
        if constexpr (ALIGN_EPI) { if (wr == 1) PG8_BAR; }
    }
    PG8_WAIT_V(0);
    if constexpr (!ALIGN_EPI) { if (wr == 0) PG8_BAR; }
    PG8_BAR;
    if constexpr (Epi::AFTER_DRAIN) { E.fused(acc, cur, wr, wc, fr, fq, lds, wid, lane); S.done(cur); }
#undef PG8_SA
#undef PG8_SB
#undef PG8_STAGE
#undef PG8_LDA
#undef PG8_RDA
#undef PG8_RDB
#undef PG8_LDB
#undef PG8_MMA
#undef PG8_WAIT_V
#undef PG8_WAIT_L
#undef PG8_BAR
#undef PG8_SCHED
}
}

#include <hip/hip_bf16.h>
#include <cmath>
namespace attn_body {
using bf16=__hip_bfloat16;
using bf16x8=__attribute__((ext_vector_type(8)))short;
using s16x4=__attribute__((ext_vector_type(4)))short;
using f32x16=__attribute__((ext_vector_type(16)))float;
using u32x4=__attribute__((ext_vector_type(4)))unsigned;
constexpr int BATCH=2,NHEAD=16,SEQ=8192,D=64,DM=NHEAD*D;
constexpr int NW=8,QBLK=32,QB=QBLK*NW,KVBLK=64,NQB=SEQ/QB;
constexpr int ATTN_PITCH=DM, ATTN_UNIT_ROWS=QB;
__device__ __forceinline__ int crow(int r,int hi){return (r&3)+8*(r>>2)+4*hi;}
#define SBAR() __builtin_amdgcn_sched_barrier(0)
__device__ __forceinline__ void cmask(f32x16&p0,f32x16&p1,int jb,int qrel,int hi){
  const float NEG=-INFINITY; int kb=64*jb+4*hi;
  #pragma unroll
  for(int r=0;r<16;++r){int kv=kb+(r&3)+8*(r>>2); if(kv>qrel)p0[r]=NEG; if(kv+32>qrel)p1[r]=NEG;}
}

constexpr int NSLOT=3, SLOTB=8192;
constexpr int LDS_K=0, LDS_V=NSLOT*SLOTB, LDS_WS=2*NSLOT*SLOTB, LDS_OST=LDS_WS+NW*64*4, LDS_NB=LDS_OST+NW*4096  , LDS_PK=LDS_NB+32768+64  , LDS_BYTES=LDS_PK+1024;
constexpr float C2=0.125f*1.4426950408889634f;
__device__ __forceinline__ void glds16(const void*gsrc,unsigned lds_dst){unsigned keep;
  asm volatile("s_mov_b32 %0, m0\n\ts_mov_b32 m0, %2\n\ts_nop 0\n\tglobal_load_lds_dwordx4 %1, off\n\ts_mov_b32 m0, %0":"=&s"(keep):"v"(gsrc),"s"(lds_dst):"memory");}
__device__ __forceinline__ float max3f(float a,float b,float c){float r;asm("v_max3_f32 %0, %1, %2, %3":"=v"(r):"v"(a),"v"(b),"v"(c));return r;}
__device__ __forceinline__ float max2f(float a,float b){float r;asm("v_max_f32_e32 %0, %1, %2":"=v"(r):"v"(a),"v"(b));return r;}
__device__ __forceinline__ float fadd_s(float a,float b){float r;asm("v_add_f32_e32 %0, %1, %2":"=v"(r):"v"(a),"v"(b));return r;}
__device__ __forceinline__ float fsub_s(float a,float b){float r;asm("v_sub_f32_e32 %0, %1, %2":"=v"(r):"v"(a),"v"(b));return r;}
typedef float f32x2_t __attribute__((ext_vector_type(2))); typedef __bf16 bf16x2_t __attribute__((ext_vector_type(2)));
__device__ __forceinline__ unsigned cvtpk_s(float lo,float hi){f32x2_t v={lo,hi};bf16x2_t b=__builtin_convertvector(v,bf16x2_t);return __builtin_bit_cast(unsigned,b);}
#define WAIT_BAR(N) asm volatile("s_waitcnt vmcnt(" #N ") lgkmcnt(0)\n\ts_barrier":::"memory")

__device__ __forceinline__ void qkt(f32x16&p0,f32x16&p1,const char*Kslot,const bf16x8*qr,const f32x16&negm,int r32,int hi){
  const char*kb=Kslot+hi*1024+r32*16;
  #pragma unroll
  for(int d0=0;d0<4;++d0){
    const bf16x8 b0=*reinterpret_cast<const bf16x8*>(kb+d0*2048);
    const bf16x8 b1=*reinterpret_cast<const bf16x8*>(kb+d0*2048+512);
    if(d0==0){p0=__builtin_amdgcn_mfma_f32_32x32x16_bf16(b0,qr[0],negm,0,0,0);p1=__builtin_amdgcn_mfma_f32_32x32x16_bf16(b1,qr[0],negm,0,0,0);}
    else{p0=__builtin_amdgcn_mfma_f32_32x32x16_bf16(b0,qr[d0],p0,0,0,0);p1=__builtin_amdgcn_mfma_f32_32x32x16_bf16(b1,qr[d0],p1,0,0,0);}}
}
typedef __attribute__((address_space(3))) const char* lds_cptr;
typedef short v4i16_t __attribute__((ext_vector_type(4)));
__device__ __forceinline__ void kload8(bf16x8*kf,lds_cptr kp){
  kf[0]=*(const __attribute__((address_space(3))) bf16x8*)(kp);      kf[1]=*(const __attribute__((address_space(3))) bf16x8*)(kp+512);
  kf[2]=*(const __attribute__((address_space(3))) bf16x8*)(kp+2048); kf[3]=*(const __attribute__((address_space(3))) bf16x8*)(kp+2560);
  kf[4]=*(const __attribute__((address_space(3))) bf16x8*)(kp+4096); kf[5]=*(const __attribute__((address_space(3))) bf16x8*)(kp+4608);
  kf[6]=*(const __attribute__((address_space(3))) bf16x8*)(kp+6144); kf[7]=*(const __attribute__((address_space(3))) bf16x8*)(kp+6656);
}
__device__ __forceinline__ void kload2(bf16x8*kf,lds_cptr kp,int j){ kf[2*j]=*(const __attribute__((address_space(3))) bf16x8*)(kp+j*2048); kf[2*j+1]=*(const __attribute__((address_space(3))) bf16x8*)(kp+j*2048+512); }
__device__ __forceinline__ s16x4 vtr(lds_cptr p){ return __builtin_bit_cast(s16x4,__builtin_amdgcn_ds_read_tr16_b64_v4i16((__attribute__((address_space(3))) v4i16_t*)p)); }
__device__ __forceinline__ float rowmax(const f32x16&p0,const f32x16&p1){
  float a=max3f(p0[0],p0[1],p1[0]),b=max3f(p0[2],p0[3],p1[1]);a=max3f(a,p1[2],p1[3]);
  #pragma unroll
  for(int r=4;r<16;r+=4){a=max3f(a,p0[r],p0[r+1]);b=max3f(b,p0[r+2],p0[r+3]);a=max3f(a,p1[r],p1[r+1]);b=max3f(b,p1[r+2],p1[r+3]);}
  const float m=max2f(a,b);
  auto rr=__builtin_amdgcn_permlane32_swap(__float_as_uint(m),__float_as_uint(m),false,false);
  return max2f(__uint_as_float(rr[0]),__uint_as_float(rr[1]));
}
__device__ __forceinline__ void pv(f32x16*o,int vb,bf16x8 pa0,bf16x8 pa1,bf16x8 pa2,bf16x8 pa3){
  #pragma unroll
  for(int d0=0;d0<2;++d0){s16x4 lo[4],hi[4];
    #pragma unroll
    for(int ks=0;ks<4;++ks){
      asm volatile("ds_read_b64_tr_b16 %0,%1 offset:%c2":"=&v"(lo[ks]):"v"(vb),"i"(d0*4096+ks*1024):"memory");
      asm volatile("ds_read_b64_tr_b16 %0,%1 offset:%c2":"=&v"(hi[ks]):"v"(vb),"i"(d0*4096+ks*1024+512):"memory");}
    asm volatile("s_waitcnt lgkmcnt(0)":::"memory");SBAR();
    #define PK(k) (bf16x8){lo[k][0],lo[k][1],lo[k][2],lo[k][3],hi[k][0],hi[k][1],hi[k][2],hi[k][3]}
    o[d0]=__builtin_amdgcn_mfma_f32_32x32x16_bf16(pa0,PK(0),o[d0],0,0,0);
    o[d0]=__builtin_amdgcn_mfma_f32_32x32x16_bf16(pa1,PK(1),o[d0],0,0,0);
    o[d0]=__builtin_amdgcn_mfma_f32_32x32x16_bf16(pa2,PK(2),o[d0],0,0,0);
    o[d0]=__builtin_amdgcn_mfma_f32_32x32x16_bf16(pa3,PK(3),o[d0],0,0,0);
    #undef PK
  }
}

typedef float f32x4_t __attribute__((ext_vector_type(4)));
__device__ __forceinline__ void fox_negcum(const float*logf,__attribute__((address_space(3))) float*ncum,__attribute__((address_space(3))) float*wtot,int tid){
  float loc[16];float s=0.f; const f32x4_t*lp=(const f32x4_t*)(logf+tid*16);
  #pragma unroll
  for(int j=0;j<4;++j){const f32x4_t v=lp[j]; s+=v[0];loc[4*j]=s; s+=v[1];loc[4*j+1]=s; s+=v[2];loc[4*j+2]=s; s+=v[3];loc[4*j+3]=s;}
  float inc=s;
  #pragma unroll
  for(int o=1;o<64;o<<=1){const float v=__shfl_up(inc,o); if((tid&63)>=o)inc+=v;}
  if((tid&63)==63)wtot[tid>>6]=inc;
  __syncthreads();
  float base=inc-s; for(int w=0;w<(tid>>6);++w)base+=wtot[w];
  #pragma unroll
  for(int j=0;j<4;++j){ f32x4_t o4; o4[0]=-(base+loc[4*j]);o4[1]=-(base+loc[4*j+1]);o4[2]=-(base+loc[4*j+2]);o4[3]=-(base+loc[4*j+3]); *(__attribute__((address_space(3))) f32x4_t*)(ncum+tid*16+4*j)=o4; }
  __syncthreads();
}
#ifndef ATTN_STORE16
#define ATTN_STORE16(p,v) (*(u32x4*)(p)=(v))
#endif
template<int THRL> __device__ __forceinline__ void attn_unit(int b,int h,int qb,const bf16*Q,const bf16*__restrict__ K,const bf16*__restrict__ V,bf16*O,char*shm,const float*logf_bh,const unsigned*kn_bh){
  int tid_=threadIdx.x; asm volatile("":"+v"(tid_)); const int tid=tid_,lane=tid&63,r32=lane&31,hi=lane>>5; const int wid=__builtin_amdgcn_readfirstlane(tid>>6);
  const long rowbase=(long)b*SEQ; const int q0=qb*QB;
  const bf16*Qw=Q+(rowbase+q0+wid*QBLK)*DM+h*D;
  const bf16*Kh=K+rowbase*DM+h*D,*Vh=V+rowbase*DM+h*D;
  const unsigned lds0=(unsigned)(uintptr_t)shm;
  float*wsf=(float*)(shm+LDS_WS)+wid*64;
  const bf16*ksrc=Kh+(long)lane*DM+wid*8;
  const bf16*vsrc=Vh+(long)(16*(wid&3)+(lane>>2))*DM+(wid>>2)*32+(lane&3)*8;
  const unsigned kdst=lds0+LDS_K+wid*1024, vdst=lds0+LDS_V+wid*1024;
  #define TIDX(t) (NTR-1-(t))
  #define DMA_K(t,slot) glds16(ksrc+(long)TIDX(t)*KVBLK*DM,(unsigned)__builtin_amdgcn_readfirstlane(kdst+(slot)))
  #define DMA_V(t,slot) glds16(vsrc+(long)TIDX(t)*KVBLK*DM,(unsigned)__builtin_amdgcn_readfirstlane(vdst+(slot)))
  const int vb0=(int)(lds0+LDS_V)+((lane>>4)&1)*32+(lane&3)*8+(4*hi+((lane&15)>>2))*64;
  const char*Kbase=shm+LDS_K; bf16x8 kf[8];
  const lds_cptr shm3=(lds_cptr)shm; const lds_cptr kp0=shm3+LDS_K+hi*1024+r32*16; const lds_cptr vp0=shm3+LDS_V+((lane>>4)&1)*32+(lane&3)*8+(4*hi+((lane&15)>>2))*64;
  const int NTR=(q0+QB)/KVBLK;
  const lds_cptr shm3b=(lds_cptr)shm;
  const __attribute__((address_space(3))) float* nb3=(const __attribute__((address_space(3))) float*)(shm3b+LDS_NB);
  fox_negcum(logf_bh,(__attribute__((address_space(3))) float*)(shm3b+LDS_NB),(__attribute__((address_space(3))) float*)(shm3b+LDS_NB+32768),tid);
  int NT;
  { __attribute__((address_space(3))) float* PK=(__attribute__((address_space(3))) float*)(shm3b+LDS_PK);
    __attribute__((address_space(3))) int* JX=(__attribute__((address_space(3))) int*)(shm3b+LDS_PK+512);
    float pk=0.f;
    if(tid<128){ const float a=__uint_as_float(kn_bh[2*tid]),c=__uint_as_float(kn_bh[2*tid+1]); pk=__builtin_sqrtf(a+c)*1.001f; }
    #pragma unroll
    for(int o_=1;o_<64;o_<<=1){const float v=__shfl_up(pk,o_); if((tid&63)>=o_)pk=__builtin_fmaxf(pk,v);}
    if(tid==63)PK[128]=pk;
    __syncthreads();
    if(tid>=64&&tid<128)pk=__builtin_fmaxf(pk,PK[128]);
    if(tid<128)PK[tid]=pk;
    const bf16*Krow=Kh+(long)(q0+wid*QBLK+r32)*DM+hi*8; const bf16*Qrow=Qw+(long)r32*DM+hi*8; float qq=0.f,qk=0.f;
    #pragma unroll
    for(int d0=0;d0<4;++d0){ const u32x4 qa=*reinterpret_cast<const u32x4*>(Qrow+d0*16), ka=*reinterpret_cast<const u32x4*>(Krow+d0*16);
      #pragma unroll
      for(int e=0;e<4;++e){ const float q0f=__uint_as_float(qa[e]<<16),q1f=__uint_as_float(qa[e]&0xffff0000u),k0f=__uint_as_float(ka[e]<<16),k1f=__uint_as_float(ka[e]&0xffff0000u);
        qq+=q0f*q0f+q1f*q1f; qk+=q0f*k0f+q1f*k1f; } }
    { auto r1=__builtin_amdgcn_permlane32_swap(__float_as_uint(qq),__float_as_uint(qq),false,false); qq=__uint_as_float(r1[0])+__uint_as_float(r1[1]);
      auto r2=__builtin_amdgcn_permlane32_swap(__float_as_uint(qk),__float_as_uint(qk),false,false); qk=__uint_as_float(r2[0])+__uint_as_float(r2[1]); }
    __syncthreads();
    const float qn=__builtin_sqrtf(qq)*1.001f, thr=qk+nb3[q0+wid*QBLK+r32]-152.f;
    int lo_=0,hi_=NTR;
    #pragma unroll 1
    for(int it=0;it<8;++it){ if(lo_<hi_){ const int mid=(lo_+hi_)>>1; const float f=qn*PK[mid]+nb3[64*mid+63]; if(f>=thr)hi_=mid; else lo_=mid+1; } }
    #pragma unroll
    for(int o_=1;o_<64;o_<<=1){const int v=__shfl_xor(lo_,o_); lo_=v<lo_?v:lo_;}
    if(lane==0)JX[wid]=lo_;
    __syncthreads();
    int j0=JX[0];
    #pragma unroll
    for(int w=1;w<8;++w){const int v=JX[w]; j0=v<j0?v:j0;}
    j0=__builtin_amdgcn_readfirstlane(j0);
    int nte=(NTR-j0+1)&~1; NT=nte<4?4:nte;
    __syncthreads();
  }
  #define BIASADD(P0,P1,t) do{ const __attribute__((address_space(3))) f32x4_t* bp_=(const __attribute__((address_space(3))) f32x4_t*)(nb3+TIDX(t)*64+4*hi); \
    const f32x4_t nm4_={-mhat,-mhat,-mhat,-mhat}; \
    _Pragma("unroll") for(int g_=0;g_<4;++g_){ const f32x4_t b0_=bp_[2*g_]+nm4_,b1_=bp_[2*g_+8]+nm4_; \
      P0[4*g_]+=b0_[0];P0[4*g_+1]+=b0_[1];P0[4*g_+2]+=b0_[2];P0[4*g_+3]+=b0_[3]; P1[4*g_]+=b1_[0];P1[4*g_+1]+=b1_[1];P1[4*g_+2]+=b1_[2];P1[4*g_+3]+=b1_[3]; } }while(0)
  DMA_K(0,0);DMA_V(0,0);DMA_K(1,SLOTB);
  bf16x8 qr[4];
  #pragma unroll
  for(int d0=0;d0<4;++d0)qr[d0]=*reinterpret_cast<const bf16x8*>(&Qw[(long)r32*DM+d0*16+hi*8]);
  float mhat=0.f,l_reg=0.f;f32x16 o[2];o[0]=f32x16{};o[1]=f32x16{};const f32x16 negm=f32x16{};
  const int qrel=wid*QBLK+r32;
  #define CMASK(P0,P1,t) do{ if((t)<4){ cmask(P0,P1,3-(t),qrel,hi); } }while(0)
  bool resc=false;
  #define START(P0,P1) do{ const float rm=rowmax(P0,P1); resc=false; \
    { const float dl=(rm>-3.0e38f)?rm:0.f; mhat=fadd_s(mhat,dl);     \
      _Pragma("unroll") for(int r=0;r<16;++r){P0[r]=fsub_s(P0[r],dl);P1[r]=fsub_s(P1[r],dl);} \
      } \
    _Pragma("unroll") for(int r=0;r<16;++r)P0[r]=__builtin_amdgcn_exp2f(P0[r]); }while(0)
  #define RESC() do{ if(resc){ asm volatile("s_waitcnt lgkmcnt(0)":::"memory"); \
      _Pragma("unroll") for(int d_=0;d_<2;++d_) _Pragma("unroll") for(int r=0;r<16;++r)o[d_][r]*=wsf[crow(r,hi)]; } }while(0)
  f32x16 pA0,pA1,pB0,pB1;
  int sl_prev=0,sl_cur=0,sl_next=SLOTB;
  #define ROT() do{sl_prev=sl_cur;sl_cur=sl_next;sl_next=(sl_next==(NSLOT-1)*SLOTB)?0:sl_next+SLOTB;}while(0)
  DMA_K(2,2*SLOTB);
  WAIT_BAR(3);
  qkt(pA0,pA1,Kbase,qr,negm,r32,hi);asm volatile("s_nop 15\n\ts_nop 7":"+v"(pA0),"+v"(pA1));BIASADD(pA0,pA1,0);CMASK(pA0,pA1,0);
  START(pA0,pA1);
  _Pragma("unroll") for(int r=0;r<16;++r)pA1[r]=__builtin_amdgcn_exp2f(pA1[r]);
  WAIT_BAR(0);
  DMA_K(3,0);DMA_V(1,SLOTB);
  ROT();
  kload8(kf,kp0+sl_cur);
  WAIT_BAR(2);
  s16x4 vlo[8],vhi[8]; u32x4 pw0,pw1,pw2,pw3;
  #define PKW(P,B) cvtpk_s(P[B],P[B+1])
  #define PAF(k) __builtin_bit_cast(bf16x8,pw##k)
  #define VFR(i) (bf16x8){vlo[i][0],vlo[i][1],vlo[i][2],vlo[i][3],vhi[i][0],vhi[i][1],vhi[i][2],vhi[i][3]}
  #define PIN(x) asm volatile("":"+v"(x))
  #define MX3(a,b,c) __builtin_fmaxf(__builtin_fmaxf((a),(b)),(c))
  #define GAPA(MF,A0,A1,A2,A3,W0,W1,PW) do{ MF; sacc+=A0; sacc+=A1; sacc+=A2; sacc+=A3; PIN(sacc); W0; W1; PIN(PW); SBAR(); }while(0)
  #define EX(v) __builtin_amdgcn_exp2f(v)
  #define GAPB(MF,X,B) do{ MF; X[B]=EX(X[B]); X[B+1]=EX(X[B+1]); X[B+2]=EX(X[B+2]); X[B+3]=EX(X[B+3]); PIN(X); SBAR(); }while(0)
  #define VRD(i) do{ vlo[i]=vtr(vp_+(((i)>>2)*4096+((i)&3)*1024)); vhi[i]=vtr(vp_+(((i)>>2)*4096+((i)&3)*1024+512)); }while(0)
  #define KRD(G,j) do{ if(G){ kload2(kf,kp0+sl_next,j); SBAR(); } }while(0)
  #define STEP(C0,C1,P0,P1,t,GK,GV,GL) do{ SBAR(); \
    const lds_cptr vp_=vp0+sl_prev; \
    VRD(0); SBAR(); float sacc=(P0[0]+P0[1]); \
    GAPA(C0=__builtin_amdgcn_mfma_f32_32x32x16_bf16(kf[0],qr[0],negm,0,0,0), P0[2],P0[3],P0[4],P0[5],     pw0[0]=PKW(P0,0), pw0[1]=PKW(P0,2), pw0); \
    VRD(4); SBAR(); GAPA(C1=__builtin_amdgcn_mfma_f32_32x32x16_bf16(kf[1],qr[0],negm,0,0,0), P0[6],P0[7],P0[8],P0[9],     pw0[2]=PKW(P0,4), pw0[3]=PKW(P0,6), pw0); \
    VRD(1); SBAR(); GAPA(C0=__builtin_amdgcn_mfma_f32_32x32x16_bf16(kf[2],qr[1],C0,0,0,0),   P0[10],P0[11],P0[12],P0[13], pw1[0]=PKW(P0,8), pw1[1]=PKW(P0,10), pw1); \
    VRD(5); SBAR(); GAPA(C1=__builtin_amdgcn_mfma_f32_32x32x16_bf16(kf[3],qr[1],C1,0,0,0),   P0[14],P0[15],P1[0],P1[1],   pw1[2]=PKW(P0,12),pw1[3]=PKW(P0,14), pw1); \
    VRD(2); SBAR(); GAPA(C0=__builtin_amdgcn_mfma_f32_32x32x16_bf16(kf[4],qr[2],C0,0,0,0),   P1[2],P1[3],P1[4],P1[5],     pw2[0]=PKW(P1,0), pw2[1]=PKW(P1,2), pw2); \
    VRD(6); SBAR(); GAPA(C1=__builtin_amdgcn_mfma_f32_32x32x16_bf16(kf[5],qr[2],C1,0,0,0),   P1[6],P1[7],P1[8],P1[9],     pw2[2]=PKW(P1,4), pw2[3]=PKW(P1,6), pw2); \
    VRD(3); SBAR(); GAPA(C0=__builtin_amdgcn_mfma_f32_32x32x16_bf16(kf[6],qr[3],C0,0,0,0),   P1[10],P1[11],P1[12],P1[13], pw3[0]=PKW(P1,8), pw3[1]=PKW(P1,10), pw3); \
    VRD(7); SBAR(); GAPA(C1=__builtin_amdgcn_mfma_f32_32x32x16_bf16(kf[7],qr[3],C1,0,0,0),   P1[14],P1[15],0.f,0.f,       pw3[2]=PKW(P1,12),pw3[3]=PKW(P1,14), pw3); \
    l_reg+=sacc; \
    if(GK){DMA_K((t)+3,sl_cur);} if(GV){DMA_V((t)+1,sl_next);} \
    BIASADD(C0,C1,t); CMASK(C0,C1,t); \
    { float a=MX3(C0[0],C0[1],C1[0]),b=MX3(C0[2],C0[3],C1[1]); a=MX3(a,C1[2],C1[3]); \
      _Pragma("unroll") for(int r=4;r<16;r+=4){a=MX3(a,C0[r],C0[r+1]);b=MX3(b,C0[r+2],C0[r+3]);a=MX3(a,C1[r],C1[r+1]);b=MX3(b,C1[r+2],C1[r+3]);} \
      float rm=__builtin_fmaxf(a,b); { auto rr=__builtin_amdgcn_permlane32_swap(__float_as_uint(rm),__float_as_uint(rm),false,false); rm=__builtin_fmaxf(__uint_as_float(rr[0]),__uint_as_float(rr[1])); } \
      resc=false; \
      if(__builtin_expect(__any(rm>(float)THRL),0)){ const float dl=__builtin_fmaxf(rm,0.f); mhat+=dl; \
        _Pragma("unroll") for(int r=0;r<16;++r){C0[r]-=dl;C1[r]-=dl;} \
        const float f=__builtin_amdgcn_exp2f(-dl); l_reg*=f; if(hi==0)wsf[r32]=f; resc=true; } } \
    SBAR(); \
    GAPB(o[0]=__builtin_amdgcn_mfma_f32_32x32x16_bf16(PAF(0),VFR(0),o[0],0,0,0), C0,0); \
    GAPB(o[1]=__builtin_amdgcn_mfma_f32_32x32x16_bf16(PAF(0),VFR(4),o[1],0,0,0), C0,4); \
    KRD(GL,0); GAPB(o[0]=__builtin_amdgcn_mfma_f32_32x32x16_bf16(PAF(1),VFR(1),o[0],0,0,0), C0,8); \
    KRD(GL,1); GAPB(o[1]=__builtin_amdgcn_mfma_f32_32x32x16_bf16(PAF(1),VFR(5),o[1],0,0,0), C0,12); \
    KRD(GL,2); GAPB(o[0]=__builtin_amdgcn_mfma_f32_32x32x16_bf16(PAF(2),VFR(2),o[0],0,0,0), C1,0); \
    KRD(GL,3); GAPB(o[1]=__builtin_amdgcn_mfma_f32_32x32x16_bf16(PAF(2),VFR(6),o[1],0,0,0), C1,4); \
    GAPB(o[0]=__builtin_amdgcn_mfma_f32_32x32x16_bf16(PAF(3),VFR(3),o[0],0,0,0), C1,8); \
    GAPB(o[1]=__builtin_amdgcn_mfma_f32_32x32x16_bf16(PAF(3),VFR(7),o[1],0,0,0), C1,12); \
    }while(0)
  int t=1;
  for(int it_=0;it_<2&&t+5<NT;++it_,t+=2){
    STEP(pB0,pB1,pA0,pA1,t,true,true,true);     WAIT_BAR(2); RESC(); ROT();
    STEP(pA0,pA1,pB0,pB1,t+1,true,true,true);   WAIT_BAR(2); RESC(); ROT();
  }
  #undef CMASK
  #define CMASK(P0,P1,t) do{}while(0)
  for(;t+5<NT;t+=2){
    STEP(pB0,pB1,pA0,pA1,t,true,true,true);     WAIT_BAR(2); RESC(); ROT();
    STEP(pA0,pA1,pB0,pB1,t+1,true,true,true);   WAIT_BAR(2); RESC(); ROT();
  }
  #undef CMASK
  #define CMASK(P0,P1,t) do{ if((t)<4){ cmask(P0,P1,3-(t),qrel,hi); } }while(0)
  #define ENDW(tt) do{ if((tt)+3<NT){WAIT_BAR(2);} else if((tt)+2<NT){WAIT_BAR(1);} else {WAIT_BAR(0);} }while(0)
  for(;t+1<NT;t+=2){
    STEP(pB0,pB1,pA0,pA1,t,(t+3<NT),(t+1<NT),(t+1<NT));       ENDW(t);   RESC(); ROT();
    STEP(pA0,pA1,pB0,pB1,t+1,(t+4<NT),(t+2<NT),(t+2<NT));     ENDW(t+1); RESC(); ROT();
  }
  STEP(pB0,pB1,pA0,pA1,NT-1,false,false,false); RESC();
  { float sacc=pB0[0]+pB0[1]; _Pragma("unroll") for(int r=2;r<16;++r)sacc+=pB0[r]; _Pragma("unroll") for(int r=0;r<16;++r)sacc+=pB1[r]; l_reg+=sacc;
    pw0=(u32x4){PKW(pB0,0),PKW(pB0,2),PKW(pB0,4),PKW(pB0,6)};pw1=(u32x4){PKW(pB0,8),PKW(pB0,10),PKW(pB0,12),PKW(pB0,14)};pw2=(u32x4){PKW(pB1,0),PKW(pB1,2),PKW(pB1,4),PKW(pB1,6)};pw3=(u32x4){PKW(pB1,8),PKW(pB1,10),PKW(pB1,12),PKW(pB1,14)};
    SBAR(); pv(o,vb0+sl_cur,PAF(0),PAF(1),PAF(2),PAF(3)); }
  #undef PKW
  #undef PAF
  #undef VFR
  #undef PIN
  #undef MX3
  #undef GAPA
  #undef GAPB
  #undef EX
  #undef VRD
  #undef KRD
  #undef STEP
  #undef ENDW
  {auto rr=__builtin_amdgcn_permlane32_swap(__float_as_uint(l_reg),__float_as_uint(l_reg),false,false);l_reg=__uint_as_float(rr[0])+__uint_as_float(rr[1]);}
  if(hi==0)wsf[32+r32]=l_reg;asm volatile("s_waitcnt lgkmcnt(0)":::"memory");
  float rli[16];
  #pragma unroll
  for(int r=0;r<16;++r)rli[r]=__builtin_amdgcn_rcpf(wsf[32+crow(r,hi)]);
  bf16*Ow=O+(rowbase+q0+wid*QBLK)*DM+h*D;
  { bf16*stg=(bf16*)(shm+LDS_OST)+wid*2048;
    #pragma unroll
    for(int r=0;r<16;++r){const int orow=crow(r,hi);
      #pragma unroll
      for(int d0=0;d0<2;++d0)stg[orow*64+d0*32+r32]=__float2bfloat16(o[d0][r]*rli[r]);}
    asm volatile("s_waitcnt lgkmcnt(0)":::"memory");
    #pragma unroll
    for(int i=0;i<4;++i){const int row=i*8+(lane>>3),ch=lane&7; const u32x4 v=*(const u32x4*)(stg+row*64+ch*8); ATTN_STORE16(Ow+(long)row*DM+ch*8,v);} }
  asm volatile("s_waitcnt lgkmcnt(0)\n\ts_barrier":::"memory");
  #undef BIASADD
  #undef TIDX
  #undef DMA_K
  #undef DMA_V
  #undef CMASK
  #undef START
  #undef RESC
  #undef ROT
}

template<int PITCH> __device__ __forceinline__ void sb_unit(int b,int h,int qb,const bf16*Q,const bf16*__restrict__ K,const bf16*__restrict__ V,bf16*O  ,char*shm){
  int tid_=threadIdx.x; asm volatile("":"+v"(tid_)); const int tid=tid_,lane=tid&63,r32=lane&31,hi=lane>>5; const int wid=__builtin_amdgcn_readfirstlane(tid>>6);
  const long rowbase=(long)b*SEQ; const int q0=qb*QB;
  const bf16*Qw=Q+(rowbase+q0+wid*QBLK)*PITCH+h*D;
  const bf16*Kh=K+rowbase*PITCH+h*D,*Vh=V+rowbase*PITCH+h*D;
  const unsigned lds0=(unsigned)(uintptr_t)shm;
  const bf16*ksrc=Kh+(long)lane*PITCH+wid*8;
  const bf16*vsrc=Vh+(long)(16*(wid&3)+(lane>>2))*PITCH+(wid>>2)*32+(lane&3)*8;
  const unsigned kdst=lds0+LDS_K+wid*1024, vdst=lds0+LDS_V+wid*1024;
  #define SB_DMA(t,slot) do{ glds16(ksrc+(long)(t)*KVBLK*PITCH,(unsigned)__builtin_amdgcn_readfirstlane(kdst+(slot))); glds16(vsrc+(long)(t)*KVBLK*PITCH,(unsigned)__builtin_amdgcn_readfirstlane(vdst+(slot))); }while(0)
  const int vb0=(int)(lds0+LDS_V)+((lane>>4)&1)*32+(lane&3)*8+(4*hi+((lane&15)>>2))*64;
  volatile __attribute__((address_space(3))) unsigned* fl=(volatile __attribute__((address_space(3))) unsigned*)((lds_cptr)shm+LDS_WS);
  const int NT=(q0+QB)/KVBLK; const int qrel=wid*QBLK+r32;
  SB_DMA(NT-1,0);
  bf16x8 qr[4];
  #pragma unroll
  for(int d0=0;d0<4;++d0)qr[d0]=*reinterpret_cast<const bf16x8*>(&Qw[(long)r32*PITCH+d0*16+hi*8]);
  f32x16 o[2];o[0]=f32x16{};o[1]=f32x16{}; const f32x16 zero16=f32x16{};
  float carry=0.f; const float m0=(hi==0)?1.f:0.f;
  int slot=0;
  for(int t=NT-1;t>=0;--t){
    WAIT_BAR(0);
    if(t<NT-1){ const int pb=((t+1)&1)*8; const unsigned a=fl[pb]&fl[pb+1]&fl[pb+2]&fl[pb+3]&fl[pb+4]&fl[pb+5]&fl[pb+6]&fl[pb+7]; if(__builtin_amdgcn_readfirstlane(a)!=0u)break; }
    if(t>0)SB_DMA(t-1,slot^SLOTB);
    f32x16 p0,p1; qkt(p0,p1,shm+LDS_K+slot,qr,zero16,r32,hi);
    if(t>=NT-4){ const int kb=64*(t-(NT-4))+4*hi;
      #pragma unroll
      for(int r=0;r<16;++r){const int kv=kb+(r&3)+8*(r>>2); if(kv>=qrel)p0[r]=-INFINITY; if(kv+32>=qrel)p1[r]=-INFINITY;} }
    f32x16 s0,s1;
    #pragma unroll
    for(int r=0;r<16;++r){ const float z=p0[r]; const float sp=__builtin_fmaxf(z,0.f)+__builtin_amdgcn_logf(1.f+__builtin_amdgcn_exp2f(-__builtin_fabsf(z))); s0[r]=sp; p0[r]=z-sp;
                           const float y=p1[r]; const float sq=__builtin_fmaxf(y,0.f)+__builtin_amdgcn_logf(1.f+__builtin_amdgcn_exp2f(-__builtin_fabsf(y))); s1[r]=sq; p1[r]=y-sq; }
    float lo[8],hv[8];
    #pragma unroll
    for(int i=0;i<8;++i){ const float mine=(i<4)?((s0[4*i]+s0[4*i+1])+(s0[4*i+2]+s0[4*i+3])):((s1[4*i-16]+s1[4*i-15])+(s1[4*i-14]+s1[4*i-13]));
      auto rr=__builtin_amdgcn_permlane32_swap(__float_as_uint(mine),__float_as_uint(mine),false,false); lo[i]=__uint_as_float(rr[0]); hv[i]=__uint_as_float(rr[1]); }
    float sp_=0.f;
    #pragma unroll
    for(int i=7;i>=0;--i){ const float base=carry-(sp_+m0*hv[i]);
      if(i<4){ float a=base; p0[4*i+3]=__builtin_amdgcn_exp2f(p0[4*i+3]+a); a-=s0[4*i+3]; p0[4*i+2]=__builtin_amdgcn_exp2f(p0[4*i+2]+a); a-=s0[4*i+2]; p0[4*i+1]=__builtin_amdgcn_exp2f(p0[4*i+1]+a); a-=s0[4*i+1]; p0[4*i]=__builtin_amdgcn_exp2f(p0[4*i]+a); }
      else   { const int j=4*i-16; float a=base; p1[j+3]=__builtin_amdgcn_exp2f(p1[j+3]+a); a-=s1[j+3]; p1[j+2]=__builtin_amdgcn_exp2f(p1[j+2]+a); a-=s1[j+2]; p1[j+1]=__builtin_amdgcn_exp2f(p1[j+1]+a); a-=s1[j+1]; p1[j]=__builtin_amdgcn_exp2f(p1[j]+a); }
      sp_+=lo[i]+hv[i]; }
    carry-=sp_;
    { u32x4 pw0,pw1,pw2,pw3;
      pw0=(u32x4){cvtpk_s(p0[0],p0[1]),cvtpk_s(p0[2],p0[3]),cvtpk_s(p0[4],p0[5]),cvtpk_s(p0[6],p0[7])}; pw1=(u32x4){cvtpk_s(p0[8],p0[9]),cvtpk_s(p0[10],p0[11]),cvtpk_s(p0[12],p0[13]),cvtpk_s(p0[14],p0[15])};
      pw2=(u32x4){cvtpk_s(p1[0],p1[1]),cvtpk_s(p1[2],p1[3]),cvtpk_s(p1[4],p1[5]),cvtpk_s(p1[6],p1[7])}; pw3=(u32x4){cvtpk_s(p1[8],p1[9]),cvtpk_s(p1[10],p1[11]),cvtpk_s(p1[12],p1[13]),cvtpk_s(p1[14],p1[15])};
      pv(o,vb0+slot,__builtin_bit_cast(bf16x8,pw0),__builtin_bit_cast(bf16x8,pw1),__builtin_bit_cast(bf16x8,pw2),__builtin_bit_cast(bf16x8,pw3)); }
    { const bool done_=__all(carry<-150.f); if(lane==0)fl[(t&1)*8+wid]=done_?1u:0u; }
    slot^=SLOTB;
  }
  asm volatile("s_waitcnt vmcnt(0) lgkmcnt(0)":::"memory");
  bf16*Ow=O+(rowbase+q0+wid*QBLK)*1024+h*D;
  { bf16*stg=(bf16*)(shm+LDS_OST)+wid*2048;
    #pragma unroll
    for(int r=0;r<16;++r){const int orow=crow(r,hi);
      #pragma unroll
      for(int d0=0;d0<2;++d0)stg[orow*64+d0*32+r32]=__float2bfloat16(o[d0][r]);}
    asm volatile("s_waitcnt lgkmcnt(0)":::"memory");
    #pragma unroll
    for(int i=0;i<4;++i){const int row=i*8+(lane>>3),ch=lane&7; const u32x4 v=*(const u32x4*)(stg+row*64+ch*8); ATTN_STORE16(Ow+(long)row*1024+ch*8,v);} }
  asm volatile("s_waitcnt vmcnt(0) lgkmcnt(0)\n\ts_barrier":::"memory");
  #undef SB_DMA
}
constexpr int ATTN_LDS_BYTES=LDS_BYTES;
struct AttnTensors { const bf16* Q; const bf16* K; const bf16* V; bf16* O; const float* logf;   const unsigned* kn;   };
struct AttnUnit { int bh; int qb; };
struct StaticOrder {
  int vcu;
  __device__ __forceinline__ explicit StaticOrder(int grid,int block):vcu((block%8)*(grid/8)+block/8){}
  __device__ __forceinline__ bool next(int i,AttnUnit&u)const{ if(i>=4)return false; const int s=vcu&7; u.bh=vcu>>3; u.qb=(i==0)?s:(i==1)?15-s:(i==2)?16+s:31-s; return true; }
  __device__ __forceinline__ void a_ready(const AttnUnit&)const{}
  __device__ __forceinline__ void done(const AttnUnit&)const{}
};
template<class Sched,int THRL=8> __device__ __forceinline__ void attn_phase(char*lds,const AttnTensors&T,const Sched&S){
  AttnUnit u;
  for(int i=0;S.next(i,u);++i){ S.a_ready(u); attn_unit<THRL>(u.bh/NHEAD,u.bh%NHEAD,u.qb,T.Q,T.K,T.V,T.O,lds,T.logf+(size_t)u.bh*SEQ,T.kn+(size_t)u.bh*256); S.done(u); }
}
#undef SBAR
#undef WAIT_BAR
}
constexpr int NWAVES = 8, NTHREADS = NWAVES * 64;
constexpr int BATCH = 2, SEQ = 8192, D = 1024, M = BATCH * SEQ;
constexpr int S5G = 32, S5H = 16, S5P = 64, S5T = 32  , S5NC = M / S5T  , S5KX = 640  ;
constexpr int SBH = 8, FOXH = 16, HD = 64;
constexpr int EVEN_IN = 2048, ODD_IN = 3088, DFF = 2816, NEXP = 8, DFE = 3584;
constexpr float C2 = 0.125f * 1.4426950408889634f;
constexpr int MOE_CHUNK_PANELS = 68, MOE_MAX_PANELS = 136, MOE_MAX_SLOTS = MOE_MAX_PANELS * 256, MOE_CAP = 16384  ;

constexpr size_t MiB = 1u << 20;
constexpr size_t WS_CTL = 0, CTL_ZERO_BYTES = 1 * MiB;
constexpr size_t WS_WMOE_GU = 1 * MiB;
constexpr size_t WS_WMOE_D = 57 * MiB;
constexpr size_t WS_WIN0 = 85 * MiB;
constexpr size_t WS_WGLU = 89 * MiB;
constexpr size_t WS_WOUT0 = 90 * MiB;
constexpr size_t WS_WGU0 = 92 * MiB;
constexpr size_t WS_WD0 = 103 * MiB;
constexpr size_t WS_WIN1 = 109 * MiB;
constexpr size_t WS_WF1 = 115 * MiB;
constexpr size_t WS_WOUT1 = 116 * MiB;
constexpr size_t WS_S5WA = 118 * MiB;
constexpr size_t WS_S5WC = 126 * MiB;
constexpr size_t WS_XB = 146 * MiB;
constexpr size_t WS_SSP = 178 * MiB;
constexpr size_t WS_META = 182 * MiB;
constexpr size_t WS_LOGF = 183 * MiB;
constexpr size_t WS_QKV0 = 184 * MiB;
constexpr size_t WS_UEXT = 232 * MiB;
constexpr size_t WS_SLOC = 252 * MiB;
constexpr size_t WS_YG = 260 * MiB;
constexpr size_t WS_MIXB = 276 * MiB;
constexpr size_t WS_HID0 = 184 * MiB;
constexpr size_t WS_QKV1 = 184 * MiB;
constexpr size_t WS_XG = 184 * MiB;
constexpr size_t WS_HMOE = 312 * MiB;
constexpr size_t WS_Y = 85 * MiB;
constexpr size_t WS_END = 431 * MiB;
static_assert(WS_XG + (size_t)8 * MOE_CAP * 1024 <= WS_HMOE && WS_HMOE + (size_t)MOE_MAX_SLOTS * DFE <= WS_END && WS_Y + (size_t)MOE_MAX_SLOTS * 1024 * 2 <= WS_XB + 32 * MiB && WS_MIXB + 32 * MiB <= WS_END, "ws map");
constexpr size_t MT_RSTD = 0, MT_TOKE = 65536, MT_TOKP = 131072, MT_TOKG = 262144, MT_TOKSLOT = 393216, MT_RSS = 524288;
constexpr int CW_TMO = 0, CW_CODE = 1, CW_BAR = 4096, CW_CNT = 8192  , CW_QUEUE = 12288  , CW_QUEUE2 = 12352  , CW_KN = 16384  , CW_SS = 32768  ;

constexpr int RING_OFF = 0, RING_BYTES = 131072;
constexpr int LDSCTL_OFF = 133120  , MISC_OFF = LDSCTL_OFF + 320;
constexpr int LDS_BYTES = 147456;

#define GAS __attribute__((address_space(1)))
#define LAS __attribute__((address_space(3)))
typedef unsigned short bf16;
typedef unsigned v4u __attribute__((ext_vector_type(4)));
typedef unsigned v2u __attribute__((ext_vector_type(2)));
typedef float f32x4 __attribute__((ext_vector_type(4)));
typedef short bf16x8 __attribute__((ext_vector_type(8)));
typedef GAS unsigned gu32;
#define RLX_AGENT __ATOMIC_RELAXED, __HIP_MEMORY_SCOPE_AGENT
#define LDS_WAIT() asm volatile("s_waitcnt lgkmcnt(0)" ::: "memory")
#define VM_WAIT() asm volatile("s_waitcnt vmcnt(0)" ::: "memory")
__device__ __forceinline__ unsigned f2bf(float f) { unsigned u = __builtin_bit_cast(unsigned, f); return (u + 0x7fffu + ((u >> 16) & 1u)) >> 16; }
__device__ __forceinline__ unsigned pk2(float lo, float hi) { return f2bf(lo) | (f2bf(hi) << 16); }
__device__ __forceinline__ float bflo(unsigned w) { return __uint_as_float(w << 16); }
__device__ __forceinline__ float bfhi(unsigned w) { return __uint_as_float(w & 0xffff0000u); }

#define XB_TMO      128
#define XB_XCNT(j)  (256  + 64 * (j))
#define XB_XSUB(j)  (1280 + 64 * (j))
#define XB_XGEN(j)  (2304 + 64 * (j))
#define XB_TOP      3328
#define XB_TOPGEN   3392
#define XCD_BAR_WORDS 3456
#define XB_SPIN_CAP (1u << 18)
__device__ __forceinline__ unsigned xb_ld(unsigned* p)              { return __hip_atomic_load(p, __ATOMIC_RELAXED, __HIP_MEMORY_SCOPE_AGENT); }
__device__ __forceinline__ unsigned xb_add(unsigned* p, unsigned v) { return __hip_atomic_fetch_add(p, v, __ATOMIC_RELAXED, __HIP_MEMORY_SCOPE_AGENT); }
__device__ __forceinline__ unsigned xb_xcc_id() { return (unsigned)__builtin_amdgcn_s_getreg((3 << 11) | 20) & 0xFu; }
#define XB_SPIN(cond, bar) do { unsigned _sp = 0; while (cond) { __builtin_amdgcn_s_sleep(1); \
    if ((++_sp & 255u) == 0u) { if (xb_ld(&(bar)[XB_TMO])) break; if (_sp > XB_SPIN_CAP) { atomicAdd(&(bar)[XB_TMO], 1u); break; } } } } while (0)
struct XcdBarrier { unsigned* bar; unsigned x; volatile LAS unsigned* st; };
__device__ __forceinline__ XcdBarrier xcd_barrier_post(unsigned* bar, volatile LAS unsigned* st) {
    XcdBarrier b; b.bar = bar; b.x = xb_xcc_id(); b.st = st;
    if (threadIdx.x == 0) (void)xb_add(&bar[XB_XCNT(b.x)], 1u);
    return b;
}
__device__ __forceinline__ void xcd_barrier_complete(unsigned* bar, unsigned x, unsigned& nloc, unsigned& nx) {
    const unsigned G = gridDim.x * gridDim.y * gridDim.z;
    unsigned sum, cnt, mine, sp = 0u;
    for (;;) {
        sum = 0u; cnt = 0u; mine = 0u;
#pragma unroll
        for (unsigned j = 0; j < 16; ++j) { const unsigned c = xb_ld(&bar[XB_XCNT(j)]); sum += c; cnt += (c > 0u) ? 1u : 0u; mine = (j == x) ? c : mine; }
        if (sum == G) break;
        __builtin_amdgcn_s_sleep(1);
        if ((++sp & 255u) == 0u) { if (xb_ld(&bar[XB_TMO])) break; if (sp > XB_SPIN_CAP) { atomicAdd(&bar[XB_TMO], 1u); break; } }
    }
    nloc = mine > 0u ? mine : 1u; nx = cnt > 0u ? cnt : 1u;
}
__device__ __forceinline__ void xcd_barrier(const XcdBarrier& b) {
    asm volatile("s_waitcnt vmcnt(0)" ::: "memory");
    __syncthreads();
    if (threadIdx.x == 0) {
        unsigned* bar = b.bar;
        __builtin_amdgcn_s_waitcnt(0);
        unsigned nloc = b.st[0], nx = b.st[1];
        if (nloc == 0u) { xcd_barrier_complete(bar, b.x, nloc, nx); b.st[0] = nloc; b.st[1] = nx; }
        const unsigned old = xb_add(&bar[XB_XSUB(b.x)], 1u);
        const unsigned gen = old / nloc;
        if (old + 1u == (gen + 1u) * nloc) {
            __builtin_amdgcn_fence(__ATOMIC_RELEASE, "agent");
            asm volatile("s_waitcnt vmcnt(0)" ::: "memory");
            const unsigned og = xb_add(&bar[XB_TOP], 1u);
            const unsigned tg = og / nx;
            if (og + 1u == (tg + 1u) * nx) xb_add(&bar[XB_TOPGEN], 1u);
            else XB_SPIN(xb_ld(&bar[XB_TOPGEN]) == tg, bar);
            __builtin_amdgcn_fence(__ATOMIC_ACQUIRE, "agent");
            xb_add(&bar[XB_XGEN(b.x)], 1u);
            asm volatile("s_waitcnt vmcnt(0)" ::: "memory");
        } else {
            XB_SPIN(xb_ld(&bar[XB_XGEN(b.x)]) == gen, bar);
            __builtin_amdgcn_fence(__ATOMIC_ACQUIRE, "agent");
            asm volatile("s_waitcnt vmcnt(0)" ::: "memory");
        }
    }
    __syncthreads();
}

__device__ __forceinline__ float wave_sum(float v) {
#pragma unroll
    for (int o = 1; o < 64; o <<= 1) v += __shfl_xor(v, o);
    return v;
}
constexpr int XP = 65, XSCR_BYTES = 64 * XP * 4;
__device__ __forceinline__ unsigned cvtpk(float lo, float hi) { unsigned r; asm volatile("v_cvt_pk_bf16_f32 %0, %1, %2" : "=v"(r) : "v"(lo), "v"(hi)); return r; }
__device__ __forceinline__ void p0_transpose_item(const float* W, int ldw, int k0, int n0, const float* gs, bf16* dst, int ldd, LAS float* scr, int lane) {
    const int lr = lane >> 4, lc = (lane & 15) * 4;
    const float* src = W + (size_t)(k0 + lr) * ldw + n0 + lc;
    f32x4 v[16];
#pragma unroll
    for (int i = 0; i < 16; ++i) v[i] = *(const GAS f32x4*)(src + (size_t)(4 * i) * ldw);
    if (gs) {
#pragma unroll
        for (int i = 0; i < 16; ++i) v[i] = v[i] * gs[k0 + 4 * i + lr]; }
#pragma unroll
    for (int i = 0; i < 16; ++i) { LAS float* p = scr + (4 * i + lr) * XP + lc; p[0] = v[i][0]; p[1] = v[i][1]; p[2] = v[i][2]; p[3] = v[i][3]; }
    LDS_WAIT(); asm volatile("" ::: "memory");
    const int c = lane & 7, nn = lane >> 3;
#pragma unroll
    for (int j = 0; j < 8; ++j) { const int n = nn + 8 * j; const LAS float* sp = scr + (8 * c) * XP + n;
        v4u o; o.x = cvtpk(sp[0 * XP], sp[1 * XP]); o.y = cvtpk(sp[2 * XP], sp[3 * XP]); o.z = cvtpk(sp[4 * XP], sp[5 * XP]); o.w = cvtpk(sp[6 * XP], sp[7 * XP]);
        *(GAS v4u*)(dst + (size_t)n * ldd + k0 + 8 * c) = o; }
    LDS_WAIT(); asm volatile("" ::: "memory");
}
struct XTile { const float* src; const float* gs; unsigned char* dst; int ldw, ldd, k0; };
__device__ __forceinline__ XTile xtile_fp8(int item, const float* W, int ldw, int N, const float* gs, unsigned char* dst, int ldd, int mode, int lane) {
    const int nblk = N / 64, kb = item / nblk, nb = item % nblk, n0 = 64 * nb, k0 = 64 * kb;
    const int row = mode == 0 ? n0 : ((n0 >> 7) * 256 + (n0 & 127) + (mode == 2 ? 128 : 0));
    XTile t; t.src = W + (size_t)(k0 + (lane >> 4)) * ldw + n0 + (lane & 15) * 4; t.gs = gs; t.dst = dst + (size_t)row * ldd; t.ldw = ldw; t.ldd = ldd; t.k0 = k0; return t;
}
__device__ __forceinline__ void xtile_load(const XTile& t, f32x4 (&v)[16]) {
#pragma unroll
    for (int i = 0; i < 16; ++i) v[i] = *(const GAS f32x4*)(t.src + (size_t)(4 * i) * t.ldw);
}
__device__ __forceinline__ void xtile_finish_fp8(const XTile& t, f32x4 (&v)[16], float wscale, LAS float* scr, int lane) {
    const int lr = lane >> 4, lc = (lane & 15) * 4;
#pragma unroll
    for (int i = 0; i < 16; ++i) v[i] = v[i] * (t.gs ? t.gs[t.k0 + 4 * i + lr] * wscale : wscale);
#pragma unroll
    for (int i = 0; i < 16; ++i) { LAS float* p = scr + (4 * i + lr) * XP + lc; p[0] = v[i][0]; p[1] = v[i][1]; p[2] = v[i][2]; p[3] = v[i][3]; }
    LDS_WAIT(); asm volatile("" ::: "memory");
    const int c = lane & 3, nn = lane >> 2;
#pragma unroll
    for (int j = 0; j < 4; ++j) { const int n = nn + 16 * j; const LAS float* sp = scr + (16 * c) * XP + n;
        v4u o; o.x = pg8::pk_fp8x4(sp[0 * XP], sp[1 * XP], sp[2 * XP], sp[3 * XP]); o.y = pg8::pk_fp8x4(sp[4 * XP], sp[5 * XP], sp[6 * XP], sp[7 * XP]);
        o.z = pg8::pk_fp8x4(sp[8 * XP], sp[9 * XP], sp[10 * XP], sp[11 * XP]); o.w = pg8::pk_fp8x4(sp[12 * XP], sp[13 * XP], sp[14 * XP], sp[15 * XP]);
        *(GAS v4u*)(t.dst + (size_t)n * t.ldd + t.k0 + 16 * c) = o; }
    LDS_WAIT(); asm volatile("" ::: "memory");
}
__device__ __forceinline__ void xpose_mat(int item, const float* W, int ldw, int N, const float* gs, bf16* dst, int ldd, int mode, LAS float* scr, int lane) {
    const int nblk = N / 64, kb = item / nblk, nb = item % nblk, n0 = 64 * nb;
    const int row = mode == 0 ? n0 : ((n0 >> 7) * 256 + (n0 & 127) + (mode == 2 ? 128 : 0));
    p0_transpose_item(W, ldw, 64 * kb, n0, gs, dst + (size_t)row * ldd, ldd, scr, lane);
}

struct Args { const float* in[28]; float* out; unsigned char* ws; };

__device__ __forceinline__ void s5_tables(const Args& a, int g, int q, LAS unsigned char* lds, int tid) {
    LAS float* POWr = (LAS float*)lds;
    LAS float* POWi = POWr + 33 * 64;
    LAS float* BBr = POWi + 33 * 64;
    LAS float* BBi = BBr + 1024;
    LAS float* CCr = BBi + 1024;
    LAS float* CCi = CCr + 1024;
    LAS float* KT = CCi + 1024;
    LAS float* DD = KT + 2048;
    const float* a_re = a.in[3]; const float* a_im = a.in[4]; const float* b_re = a.in[5]; const float* b_im = a.in[6];
    const float* c_re = a.in[7]; const float* c_im = a.in[8]; const float* dsk = a.in[9]; const float* log_step = a.in[10];
    const float step = expf(log_step[g]);
    __syncthreads();
    for (int e = tid; e < 33 * 64; e += NTHREADS) { const int n = e >> 6, p = e & 63; const float lr = a_re[g * 64 + p], li = a_im[g * 64 + p];
        const float mag = expf((float)n * step * lr); float sn, cs; sincosf((float)n * (step * li), &sn, &cs); POWr[e] = mag * cs; POWi[e] = mag * sn; }
    for (int e = tid; e < 1024; e += NTHREADS) { const int p = e >> 4, h = e & 15; const float lr = a_re[g * 64 + p], li = a_im[g * 64 + p];
        const float er = expf(lr * step); float sn, cs; sincosf(li * step, &sn, &cs); const float nr = er * cs - 1.f, ni = er * sn, den = lr * lr + li * li;
        const float fr = (nr * lr + ni * li) / den, fi = (ni * lr - nr * li) / den;
        const float br = b_re[(g * 64 + p) * 16 + h], bi = b_im[(g * 64 + p) * 16 + h];
        BBr[e] = fr * br - fi * bi; BBi[e] = fr * bi + fi * br;
        CCr[e] = c_re[g * 1024 + e]; CCi[e] = c_im[g * 1024 + e]; }
    if (tid < 16) DD[tid] = dsk[g * 16 + tid];
    __syncthreads();
    for (int e = tid; e < 2048; e += NTHREADS) { const int tau = e >> 6, hl = (e >> 4) & 3, hi = e & 15, ho = 4 * q + hl; float sacc = 0.f;
        for (int p = 0; p < 64; ++p) { const float cr = CCr[ho * 64 + p], ci = CCi[ho * 64 + p], pr = POWr[tau * 64 + p], pi = POWi[tau * 64 + p];
            const float xr = cr * pr - ci * pi, xi = cr * pi + ci * pr; sacc += xr * BBr[p * 16 + hi] - xi * BBi[p * 16 + hi]; }
        if (tau == 0 && ho == hi) sacc += DD[ho];
        KT[e] = sacc; }
    __syncthreads();
    bf16* WA = (bf16*)(a.ws + WS_S5WA) + (size_t)g * 256 * 512;
    for (int pc = tid; pc < 64 * 64; pc += NTHREADS) { const int p = pc >> 6, k0 = (pc & 63) * 8; v4u o = (v4u){0u, 0u, 0u, 0u};
        if (q < 2) { const int j = k0 >> 4, h0 = k0 & 15; const float pr = POWr[(31 - j) * 64 + p], pi = POWi[(31 - j) * 64 + p]; float v[8];
#pragma unroll
            for (int w = 0; w < 8; ++w) { const float br = BBr[p * 16 + h0 + w], bi = BBi[p * 16 + h0 + w]; v[w] = (q == 0) ? (pr * br - pi * bi) : (pr * bi + pi * br); }
            o.x = cvtpk(v[0], v[1]); o.y = cvtpk(v[2], v[3]); o.z = cvtpk(v[4], v[5]); o.w = cvtpk(v[6], v[7]); }
        *(GAS v4u*)(WA + (size_t)(64 * q + p) * 512 + k0) = o; }
    bf16* WC = (bf16*)(a.ws + WS_S5WC) + (size_t)g * 512 * 640;
    for (int pc = tid; pc < 128 * 80; pc += NTHREADS) { const int rl = pc / 80, k0 = (pc % 80) * 8, i = rl >> 2, hl = rl & 3, ho = 4 * q + hl; float v[8];
        if (k0 < 512) { const int j = k0 >> 4, h0 = k0 & 15;
#pragma unroll
            for (int w = 0; w < 8; ++w) v[w] = (j <= i) ? KT[((i - j) * 4 + hl) * 16 + h0 + w] : 0.f; }
        else { const int p0 = (k0 - 512) & 63; const bool im = k0 >= 576;
#pragma unroll
            for (int w = 0; w < 8; ++w) { const int p = p0 + w; const float cr = CCr[ho * 64 + p], ci = CCi[ho * 64 + p], pr = POWr[(i + 1) * 64 + p], pi = POWi[(i + 1) * 64 + p];
                v[w] = im ? -(cr * pi + ci * pr) : (cr * pr - ci * pi); } }
        v4u o; o.x = cvtpk(v[0], v[1]); o.y = cvtpk(v[2], v[3]); o.z = cvtpk(v[4], v[5]); o.w = cvtpk(v[6], v[7]);
        *(GAS v4u*)(WC + (size_t)(i * 16 + ho) * 640 + k0) = o; }
    __syncthreads();
}

constexpr int MOE_XITEMS = 24 * 896;
__device__ __forceinline__ XTile moe_xtile(const Args& a, int r, int lane) {
    unsigned char* ws = a.ws;
    const int mat = r / 896, e = mat / 3, which = mat % 3; r -= mat * 896;
    if (which == 0) return xtile_fp8(r, a.in[24] + (size_t)e * D * DFE, DFE, DFE, a.in[22], ws + WS_WMOE_GU + (size_t)e * 7168 * 1024, D, 1, lane);
    if (which == 1) return xtile_fp8(r, a.in[25] + (size_t)e * D * DFE, DFE, DFE, a.in[22], ws + WS_WMOE_GU + (size_t)e * 7168 * 1024, D, 2, lane);
    return xtile_fp8(r, a.in[26] + (size_t)e * DFE * D, D, D, nullptr, ws + WS_WMOE_D + (size_t)e * 1024 * 3584, DFE, 0, lane);
}
__device__ __forceinline__ void p0_prologue(const Args& a, LAS unsigned char* lds, int tid, int lane, int wave, int vcu, int G) {
    for (int it = vcu; it < 4 * S5G; it += G) s5_tables(a, it >> 2, it & 3, lds, tid);
    LAS float* scr = (LAS float*)(lds + wave * XSCR_BYTES);
    const int gw = vcu * NWAVES + wave, NGW = G * NWAVES;
    constexpr int I_IN0 = 16 * 32, I_GLU = 8 * 8, I_OUT = 16 * 16, I_GU0 = 16 * 44, I_D0 = 44 * 16, I_IN1 = 16 * 48, I_MOE = 896;
    constexpr int NITEMS = I_IN0 + I_GLU + I_OUT + 2 * I_GU0 + I_D0 + I_IN1 + I_OUT;
    unsigned char* ws = a.ws;
    for (int it = NITEMS - 1 - gw; it >= 0; it -= NGW) {
        int r = it;
        if (r < I_IN0) { xpose_mat(r, a.in[2], EVEN_IN, EVEN_IN, a.in[1], (bf16*)(ws + WS_WIN0), D, 0, scr, lane); continue; } r -= I_IN0;
        if (r < I_GLU) { xpose_mat(r, a.in[11], 512, 512, nullptr, (bf16*)(ws + WS_WGLU), 512, 0, scr, lane); continue; } r -= I_GLU;
        if (r < I_OUT) { xpose_mat(r, a.in[13], D, D, nullptr, (bf16*)(ws + WS_WOUT0), D, 0, scr, lane); continue; } r -= I_OUT;
        if (r < I_GU0) { xpose_mat(r, a.in[15], DFF, DFF, a.in[14], (bf16*)(ws + WS_WGU0), D, 1, scr, lane); continue; } r -= I_GU0;
        if (r < I_GU0) { xpose_mat(r, a.in[16], DFF, DFF, a.in[14], (bf16*)(ws + WS_WGU0), D, 2, scr, lane); continue; } r -= I_GU0;
        if (r < I_D0) { xpose_mat(r, a.in[17], D, D, nullptr, (bf16*)(ws + WS_WD0), DFF, 0, scr, lane); continue; } r -= I_D0;
        if (r < I_IN1) { xpose_mat(r, a.in[19], ODD_IN, 3072, a.in[18], (bf16*)(ws + WS_WIN1), D, 0, scr, lane); continue; } r -= I_IN1;
        xpose_mat(r, a.in[21], D, D, nullptr, (bf16*)(ws + WS_WOUT1), D, 0, scr, lane);
    }
    { const int gt = vcu * NTHREADS + tid; if (gt < 16 * 1024) { const int h = gt >> 10, k = gt & 1023; ((bf16*)(ws + WS_WF1))[gt] = (bf16)f2bf(a.in[19][(size_t)k * ODD_IN + 3072 + h] * a.in[18][k]); } }
    float* ss0 = (float*)(ws + WS_SSP);
    f32x4 xnx[4];
    if (gw < M) {
#pragma unroll
        for (int j = 0; j < 4; ++j) xnx[j] = ((const GAS f32x4*)(a.in[0] + (size_t)gw * D) + lane)[64 * j]; }
    for (int m = gw; m < M; m += NGW) {
        GAS v2u* o8 = (GAS v2u*)((bf16*)(ws + WS_XB) + (size_t)m * D) + lane; float s = 0.f; f32x4 xc[4];
#pragma unroll
        for (int j = 0; j < 4; ++j) xc[j] = xnx[j];
        if (m + NGW < M) {
#pragma unroll
            for (int j = 0; j < 4; ++j) xnx[j] = ((const GAS f32x4*)(a.in[0] + (size_t)(m + NGW) * D) + lane)[64 * j]; }
#pragma unroll
        for (int j = 0; j < 4; ++j) { const f32x4 v = xc[j]; s += (v.x * v.x + v.y * v.y) + (v.z * v.z + v.w * v.w); v2u w; w.x = cvtpk(v.x, v.y); w.y = cvtpk(v.z, v.w); o8[64 * j] = w; }
        s = wave_sum(s); if (lane < 16) ss0[(size_t)m * 16 + lane] = (lane == 0) ? s : 0.f;
    }
}

__device__ __forceinline__ void s5_scan(const Args& a, int gt  ) {
    if (gt >= BATCH * S5G * S5P) return;
    const int b = gt / (S5G * S5P), g = (gt / S5P) % S5G, p = gt % S5P;
    const float step = expf(a.in[10][g]); const float lr = a.in[3][g * 64 + p], li = a.in[4][g * 64 + p];
    const float mag = expf((float)S5T * step * lr); float sn, cs; sincosf((float)S5T * (step * li), &sn, &cs); const float ar = mag * cs, ai = mag * sn;
    const float* sl = (const float*)(a.ws + WS_SLOC) + ((size_t)g * S5NC + b * 256) * 128 + p;
    bf16* ue = (bf16*)(a.ws + WS_UEXT) + ((size_t)g * S5NC + b * 256) * S5KX + 512 + p;
    float sr = 0.f, si = 0.f;
#pragma unroll 8
    for (int c = 0; c < 256; ++c) {
        ue[(size_t)c * S5KX] = (bf16)f2bf(sr); ue[(size_t)c * S5KX + 64] = (bf16)f2bf(si);
        const float lr_ = sl[(size_t)c * 128], li_ = sl[(size_t)c * 128 + 64];
        const float nr = ar * sr - ai * si + lr_, ni = ar * si + ai * sr + li_; sr = nr; si = ni;
    }
}

__device__ __forceinline__ float softplus2(float z) { return fmaxf(z, 0.f) + __builtin_amdgcn_logf(1.0f + __builtin_amdgcn_exp2f(-fabsf(z))); }
__device__ __forceinline__ void stage_kv32(const bf16* kp, const bf16* vp, size_t pitch, LAS float* sK, LAS float* sV, int tid) {
    const int r = tid >> 4, c = (tid & 15) * 4;
    const v2u kw = *(const v2u*)(kp + (size_t)r * pitch + c), vw = *(const v2u*)(vp + (size_t)r * pitch + c);
    *(LAS f32x4*)(sK + r * 64 + c) = (f32x4){bflo(kw.x), bfhi(kw.x), bflo(kw.y), bfhi(kw.y)};
    *(LAS f32x4*)(sV + r * 64 + c) = (f32x4){bflo(vw.x), bfhi(vw.x), bflo(vw.y), bfhi(vw.y)};
}
__device__ __forceinline__ void sb_simple_unit(const bf16* qkv  , bf16* mix  , int b, int h, int blk, LAS unsigned char* lds, int tid) {
    const int lane = tid & 63, wave_ = tid >> 6;
    LAS float* sK = (LAS float*)lds; LAS float* sV = sK + 32 * 64;
    const int t = blk * 512 + tid; const size_t rb = (size_t)b * SEQ;
    float q[HD], acc[HD];
    { const v4u* qp = (const v4u*)(qkv + (rb + t) * 1536 + h * HD);
#pragma unroll
      for (int i = 0; i < 8; ++i) { const v4u w = qp[i]; q[8 * i] = bflo(w.x); q[8 * i + 1] = bfhi(w.x); q[8 * i + 2] = bflo(w.y); q[8 * i + 3] = bfhi(w.y); q[8 * i + 4] = bflo(w.z); q[8 * i + 5] = bfhi(w.z); q[8 * i + 6] = bflo(w.w); q[8 * i + 7] = bfhi(w.w); }
#pragma unroll
      for (int i = 0; i < HD; ++i) acc[i] = 0.f; }
    float carry = 0.f;
    for (int c0 = blk * 512 + 480; c0 >= 0; c0 -= 32) {
        __syncthreads();
        stage_kv32(qkv + (rb + c0) * 1536 + 512 + h * HD, qkv + (rb + c0) * 1536 + 1024 + h * HD, 1536, sK, sV, tid);
        __syncthreads();
        for (int r = 31; r >= 0; --r) { const int s = c0 + r;
            if (s < t) { float z = 0.f;
#pragma unroll
                for (int i = 0; i < HD; ++i) z = fmaf(q[i], sK[r * 64 + i], z);
                const float sp = softplus2(z); const float w = __builtin_amdgcn_exp2f(z - sp + carry); carry -= sp;
#pragma unroll
                for (int i = 0; i < HD; ++i) acc[i] = fmaf(w, sV[r * 64 + i], acc[i]); } }
        { LAS unsigned* fl = (LAS unsigned*)(lds + 16384); if (lane == 0) fl[wave_] = __all(carry < -150.f) ? 1u : 0u; __syncthreads();
          if ((fl[0] & fl[1] & fl[2] & fl[3] & fl[4] & fl[5] & fl[6] & fl[7]) != 0u) break; }
    }
    v4u* op = (v4u*)(mix + (rb + t) * 1024 + 512 + h * HD);
#pragma unroll
    for (int i = 0; i < 8; ++i) { v4u w; w.x = pk2(acc[8 * i], acc[8 * i + 1]); w.y = pk2(acc[8 * i + 2], acc[8 * i + 3]); w.z = pk2(acc[8 * i + 4], acc[8 * i + 5]); w.w = pk2(acc[8 * i + 6], acc[8 * i + 7]); op[i] = w; }
}
__device__ __forceinline__ void fgate_rows16(const bf16* xb, const bf16* wf, const float* ss, const float* bfv, float* logf, int r0, int lane) {
    const int fr = lane & 15, fq = lane >> 4;
    const bf16x8* ap = (const bf16x8*)(xb + (size_t)(r0 + fr) * D + fq * 8);
    const bf16x8* bp = (const bf16x8*)(wf + (size_t)fr * D + fq * 8);
    f32x4 acc = (f32x4){0.f, 0.f, 0.f, 0.f};
#pragma unroll 8
    for (int kk = 0; kk < 32; ++kk) acc = __builtin_amdgcn_mfma_f32_16x16x32_bf16(ap[kk * 4], bp[kk * 4], acc, 0, 0, 0);
    const float bias = bfv[fr];
#pragma unroll
    for (int j = 0; j < 4; ++j) { const int row = r0 + fq * 4 + j; const float rs = pg8::rstd16(ss, row);
        const float z = acc[j] * rs + bias;
        const float lf = -(fmaxf(-z, 0.f) + log1pf(expf(-fabsf(z)))) * 1.4426950408889634f;
        const int b = row >> 13, t = row & 8191; logf[((size_t)b * FOXH + fr) * SEQ + t] = lf; }
}

struct MoeOrder {
    pg8::StaticOrder S; int lo; int pref[NEXP + 1]; bool cap_rows;
    __device__ __forceinline__ bool next(int i, pg8::Unit& u) const {
        if (!S.next(i, u)) return false;
        u.pm += lo; int e = 0, pe = 0;
#pragma unroll
        for (int k = 1; k < NEXP; ++k) { const bool ge = u.pm >= pref[k]; e += ge ? 1 : 0; pe = ge ? pref[k] : pe; }
        u.zb = e; u.pa = cap_rows ? e * (MOE_CAP / 256) + (u.pm - pe) : u.pm; return true;
    }
    __device__ __forceinline__ void a_ready(const pg8::Unit&) const {}
    __device__ __forceinline__ void done(const pg8::Unit&) const {}
};

__global__ void __launch_bounds__(NTHREADS, 2) mk_fwd(Args args) {
    extern __shared__ __attribute__((aligned(16))) unsigned char lds_raw[];
    LAS unsigned char* lds = (LAS unsigned char*)lds_raw;
    volatile LAS unsigned* MISC = (volatile LAS unsigned*)(lds + MISC_OFF);
    const int tid = threadIdx.x, lane = tid & 63, wave = __builtin_amdgcn_readfirstlane(tid >> 6);
    const int G = gridDim.x; const int bx = blockIdx.x; const int vcu = (G % 8 == 0) ? (bx % 8) * (G / 8) + bx / 8 : bx;
    unsigned char* ws = args.ws;
    gu32* ctl = (gu32*)(ws + WS_CTL);
    for (int u = tid; u < (LDS_BYTES - LDSCTL_OFF) / 4; u += NTHREADS) ((LAS unsigned*)(lds + LDSCTL_OFF))[u] = 0u;
    __syncthreads();
    XcdBarrier bar = xcd_barrier_post((unsigned*)(ctl + CW_BAR), MISC + 8);
    const int gw = vcu * NWAVES + wave, NGW = G * NWAVES;
    float* SS = (float*)(ws + WS_SSP);
    float* X = args.out;
    bf16* XB = (bf16*)(ws + WS_XB);
#define GRID_BAR() xcd_barrier(bar)
#define GEMM_PHASE(EPI, SCHED, lds_, g_, S_, E_) pg8::gemm_phase<EPI, SCHED, true, true>(lds_, g_, S_, E_)

    p0_prologue(args, lds, tid, lane, wave, vcu, G);
    GRID_BAR();
    { pg8::Gemm g{XB, (const bf16*)(ws + WS_WIN0), D, D, D, 0, 0}; pg8::StaticOrder S; S.init(M, EVEN_IN, 1, G, bx);
      pg8::EpiInProj0 E{SS, (bf16*)(ws + WS_UEXT), (bf16*)(ws + WS_QKV0), C2};
      GEMM_PHASE(pg8::EpiInProj0, pg8::StaticOrder, lds + RING_OFF, g, S, E); }
    GRID_BAR();
#define SB_PULL_ONE(more_) do { if (tid == 0) MISC[17] = __hip_atomic_fetch_add(ctl + CW_QUEUE2, 1u, RLX_AGENT); __syncthreads(); const unsigned uq_ = __builtin_amdgcn_readfirstlane(MISC[17]); __syncthreads(); \
        more_ = uq_ < (unsigned)(BATCH * SBH * 32); if (more_) { const int bh_ = (int)(uq_ >> 5), qb_ = (int)(uq_ & 31u); \
            attn_body::sb_unit<1536>(bh_ >> 3, bh_ & 7, qb_, (const attn_body::bf16*)(ws + WS_QKV0), (const attn_body::bf16*)(ws + WS_QKV0) + 512, (const attn_body::bf16*)(ws + WS_QKV0) + 1024, (attn_body::bf16*)(ws + WS_MIXB) + 512, (char*)lds_raw + RING_OFF); } } while (0)
    bool sb_more = true;
    { pg8::Gemm g{(const bf16*)(ws + WS_UEXT), (const bf16*)(ws + WS_S5WA), S5KX, 512, 512, (size_t)S5NC * S5KX * 2, (size_t)256 * 512 * 2}; pg8::StaticOrder S; S.init(S5NC, 256, S5G, G, bx);
      pg8::EpiS5State E{(float*)(ws + WS_SLOC)};
      GEMM_PHASE(pg8::EpiS5State, pg8::StaticOrder, lds + RING_OFF, g, S, E);
      if (bx >= S.nwg) SB_PULL_ONE(sb_more); }
    GRID_BAR();
    s5_scan(args, vcu * NTHREADS + tid);
    if (vcu * NTHREADS >= BATCH * S5G * S5P) SB_PULL_ONE(sb_more);
    GRID_BAR();
    { pg8::Gemm g{(const bf16*)(ws + WS_UEXT), (const bf16*)(ws + WS_S5WC), S5KX, S5KX, S5KX, (size_t)S5NC * S5KX * 2, (size_t)512 * S5KX * 2}; pg8::StaticOrder S; S.init(S5NC, 512, S5G, G, bx);
      pg8::EpiS5Y E{(bf16*)(ws + WS_YG)};
      GEMM_PHASE(pg8::EpiS5Y, pg8::StaticOrder, lds + RING_OFF, g, S, E);
      if (bx >= S.nwg) SB_PULL_ONE(sb_more); }
    GRID_BAR();
    { pg8::Gemm g{(const bf16*)(ws + WS_YG), (const bf16*)(ws + WS_WGLU), 512, 512, 512, 0, 0}; pg8::StaticOrder S; S.init(M, 512, 1, G, bx);
      pg8::EpiGlu E{(const bf16*)(ws + WS_YG), args.in[12], (bf16*)(ws + WS_MIXB)};
      GEMM_PHASE(pg8::EpiGlu, pg8::StaticOrder, lds + RING_OFF, g, S, E); }
    __syncthreads();
    sb_more = true;
#pragma unroll 1
    while (sb_more) SB_PULL_ONE(sb_more);
    GRID_BAR();
#undef SB_PULL_ONE
    { pg8::Gemm g{(const bf16*)(ws + WS_MIXB), (const bf16*)(ws + WS_WOUT0), D, D, D, 0, 0}; pg8::StaticOrder S; S.init(M, D, 1, G, bx);
      pg8::EpiResid E{args.in[0], X, XB, SS + 16 * M};
      GEMM_PHASE(pg8::EpiResid, pg8::StaticOrder, lds + RING_OFF, g, S, E); }
    GRID_BAR();
    { pg8::Gemm g{XB, (const bf16*)(ws + WS_WGU0), D, D, D, 0, 0}; pg8::StaticOrder S; S.init(M, 2 * DFF, 1, G, bx);
      pg8::EpiSwiGlu<true> E{SS + 16 * M, (bf16*)(ws + WS_HID0), DFF};
      GEMM_PHASE(pg8::EpiSwiGlu<true>, pg8::StaticOrder, lds + RING_OFF, g, S, E); }
    GRID_BAR();
    { pg8::Gemm g{(const bf16*)(ws + WS_HID0), (const bf16*)(ws + WS_WD0), DFF, DFF, DFF, 0, 0}; pg8::StaticOrder S; S.init(M, D, 1, G, bx);
      pg8::EpiResid E{X, X, XB, SS + 32 * M};
      GEMM_PHASE(pg8::EpiResid, pg8::StaticOrder, lds + RING_OFF, g, S, E); }
    GRID_BAR();
    { pg8::Gemm g{XB, (const bf16*)(ws + WS_WIN1), D, D, D, 0, 0}; pg8::StaticOrder S; S.init(M, 3072, 1, G, bx);
      pg8::EpiInProj1 E{SS + 32 * M, (bf16*)(ws + WS_QKV1), C2, (unsigned*)(ctl + CW_KN)};
      GEMM_PHASE(pg8::EpiInProj1, pg8::StaticOrder, lds + RING_OFF, g, S, E); }
    for (int r = gw; r < M / 16; r += NGW) fgate_rows16(XB, (const bf16*)(ws + WS_WF1), SS + 32 * M, args.in[20], (float*)(ws + WS_LOGF), r * 16, lane);
    GRID_BAR();
    { const attn_body::AttnTensors AT{(const attn_body::bf16*)(ws + WS_QKV1), (const attn_body::bf16*)(ws + WS_QKV1 + 32 * MiB), (const attn_body::bf16*)(ws + WS_QKV1 + 64 * MiB), (attn_body::bf16*)(ws + WS_QKV1), (const float*)(ws + WS_LOGF), (const unsigned*)(ctl + CW_KN)};
      constexpr int N_ATT = 1024, N_CVB = MOE_XITEMS / 32, N_GRP = (N_ATT + 2) / 3 > (N_CVB + 1) / 2 ? (N_ATT + 2) / 3 : (N_CVB + 1) / 2;
      for (;;) {
          if (tid == 0) MISC[16] = __hip_atomic_fetch_add(ctl + CW_QUEUE, 1u, RLX_AGENT);
          __syncthreads();
          const unsigned uq = __builtin_amdgcn_readfirstlane(MISC[16]);
          __syncthreads();
          if (uq >= 5u * N_GRP) break;
          const int grp = (int)(uq / 5u), rr = (int)(uq % 5u);
          if (rr & 1) { const int cb = 2 * grp + (rr >> 1);
              if (cb < N_CVB) { int lane_ = threadIdx.x & 63; asm volatile("" : "+v"(lane_));
                  LAS float* scr = (LAS float*)(lds + wave * XSCR_BYTES);
#pragma unroll 1
                  for (int j = 0; j < 4; j += 2) { const XTile t0 = moe_xtile(args, cb * 32 + wave * 4 + j, lane_), t1 = moe_xtile(args, cb * 32 + wave * 4 + j + 1, lane_);
                      f32x4 v0[16], v1[16]; xtile_load(t0, v0); xtile_load(t1, v1);
                      xtile_finish_fp8(t0, v0, 64.f, scr, lane_); xtile_finish_fp8(t1, v1, 64.f, scr, lane_); } }
          } else { const int au = 3 * grp + (rr >> 1);
              if (au < N_ATT) { const int bh = au & 31, qb = 31 - (au >> 5);
                  attn_body::attn_unit<8>(bh >> 4, bh & 15, qb, AT.Q, AT.K, AT.V, AT.O, (char*)lds_raw + RING_OFF, AT.logf + (size_t)bh * SEQ, AT.kn + (size_t)bh * 256); } }
      } }
    GRID_BAR();
    { pg8::Gemm g{(const bf16*)(ws + WS_QKV1), (const bf16*)(ws + WS_WOUT1), D, D, D, 0, 0}; pg8::StaticOrder S; S.init(M, D, 1, G, bx);
      pg8::EpiResid E{X, X, XB, SS + 48 * M};
      GEMM_PHASE(pg8::EpiResid, pg8::StaticOrder, lds + RING_OFF, g, S, E); }
    GRID_BAR();
    unsigned char* meta = ws + WS_META; unsigned char* XG = ws + WS_XG; float* RSS = (float*)(meta + MT_RSS);
    {
        const float* wr = args.in[23]; const float* gn = args.in[22];
        LAS unsigned* lcnt = (LAS unsigned*)(lds + 1024);
        if (tid < 16) lcnt[tid] = 0u;
        __syncthreads();
        float wl[16][NEXP];
#pragma unroll
        for (int j = 0; j < 4; ++j) { const int k0 = 4 * lane + 256 * j; const f32x4 gv = *(const f32x4*)(gn + k0);
#pragma unroll
            for (int q = 0; q < 4; ++q) { const f32x4 w0 = *(const f32x4*)(wr + (size_t)(k0 + q) * NEXP), w1 = *(const f32x4*)(wr + (size_t)(k0 + q) * NEXP + 4);
                wl[4 * j + q][0] = gv[q] * w0.x; wl[4 * j + q][1] = gv[q] * w0.y; wl[4 * j + q][2] = gv[q] * w0.z; wl[4 * j + q][3] = gv[q] * w0.w;
                wl[4 * j + q][4] = gv[q] * w1.x; wl[4 * j + q][5] = gv[q] * w1.y; wl[4 * j + q][6] = gv[q] * w1.z; wl[4 * j + q][7] = gv[q] * w1.w; } }
        f32x4 xn[4];
        if (gw < M) {
#pragma unroll
            for (int j = 0; j < 4; ++j) xn[j] = ((const GAS f32x4*)(X + (size_t)gw * D) + lane)[64 * j]; }
        const bool hb5 = (lane & 32) != 0, hb4 = (lane & 16) != 0, hb3 = (lane & 8) != 0;
        for (int tok = gw; tok < M; tok += NGW) {
            f32x4 xv[4];
#pragma unroll
            for (int j = 0; j < 4; ++j) xv[j] = xn[j];
            if (tok + NGW < M) {
#pragma unroll
                for (int j = 0; j < 4; ++j) xn[j] = ((const GAS f32x4*)(X + (size_t)(tok + NGW) * D) + lane)[64 * j]; }
            float lg[NEXP]; float s = 0.f;
#pragma unroll
            for (int e = 0; e < NEXP; ++e) lg[e] = 0.f;
#pragma unroll
            for (int j = 0; j < 4; ++j) { const f32x4 v = xv[j]; s += (v.x * v.x + v.y * v.y) + (v.z * v.z + v.w * v.w);
#pragma unroll
                for (int q = 0; q < 4; ++q)
#pragma unroll
                    for (int e = 0; e < NEXP; ++e) lg[e] = fmaf(v[q], wl[4 * j + q][e], lg[e]); }
            s = wave_sum(s);
            float a4[4], a2[2], a1;
#pragma unroll
            for (int i = 0; i < 4; ++i) { const float snd = hb5 ? lg[i] : lg[i + 4], kp = hb5 ? lg[i + 4] : lg[i]; a4[i] = kp + __shfl_xor(snd, 32); }
#pragma unroll
            for (int i = 0; i < 2; ++i) { const float snd = hb4 ? a4[i] : a4[i + 2], kp = hb4 ? a4[i + 2] : a4[i]; a2[i] = kp + __shfl_xor(snd, 16); }
            { const float snd = hb3 ? a2[0] : a2[1], kp = hb3 ? a2[1] : a2[0]; a1 = kp + __shfl_xor(snd, 8); }
            a1 += __shfl_xor(a1, 4); a1 += __shfl_xor(a1, 2); a1 += __shfl_xor(a1, 1);
#pragma unroll
            for (int e = 0; e < NEXP; ++e) lg[e] = __builtin_bit_cast(float, __builtin_amdgcn_readlane(__builtin_bit_cast(int, a1), 8 * e));
            if (lane == 0) {
                const float rs = 1.0f / sqrtf(s * (1.0f / 1024.0f) + pg8::RMS_EPS);
                int i1 = 0; float v1 = lg[0];
#pragma unroll
                for (int e = 1; e < NEXP; ++e) if (lg[e] > v1) { v1 = lg[e]; i1 = e; }
                int i2 = -1; float v2 = -INFINITY;
#pragma unroll
                for (int e = 0; e < NEXP; ++e) if (e != i1 && lg[e] > v2) { v2 = lg[e]; i2 = e; }
                const float g1 = 1.f / (1.f + expf((v2 - v1) * rs)), g2 = 1.f - g1;
                const unsigned p1 = __hip_atomic_fetch_add(lcnt + i1, 1u, __ATOMIC_RELAXED, __HIP_MEMORY_SCOPE_WORKGROUP), p2 = __hip_atomic_fetch_add(lcnt + i2, 1u, __ATOMIC_RELAXED, __HIP_MEMORY_SCOPE_WORKGROUP);
                ((float*)(meta + MT_RSTD))[tok] = rs; ((unsigned*)(meta + MT_TOKE))[tok] = (unsigned)i1 | ((unsigned)i2 << 8);
                ((unsigned*)(meta + MT_TOKP))[2 * tok] = p1; ((unsigned*)(meta + MT_TOKP))[2 * tok + 1] = p2;
                ((float*)(meta + MT_TOKG))[2 * tok] = g1; ((float*)(meta + MT_TOKG))[2 * tok + 1] = g2;
            }
        }
        __syncthreads();
        if (tid < NEXP) lcnt[8 + tid] = __hip_atomic_fetch_add(ctl + CW_CNT + 64 * tid, lcnt[tid], RLX_AGENT);
        VM_WAIT();
        __syncthreads();
        if (gw < M) {
#pragma unroll
            for (int j = 0; j < 4; ++j) xn[j] = ((const GAS f32x4*)(X + (size_t)gw * D) + lane)[64 * j]; }
        for (int tok = gw; tok < M; tok += NGW) {
            const unsigned ee = ((const unsigned*)(meta + MT_TOKE))[tok]; const float rs = ((const float*)(meta + MT_RSTD))[tok];
            const unsigned q1 = ((const unsigned*)(meta + MT_TOKP))[2 * tok], q2 = ((const unsigned*)(meta + MT_TOKP))[2 * tok + 1];
            f32x4 xv[4];
#pragma unroll
            for (int j = 0; j < 4; ++j) xv[j] = xn[j];
            if (tok + NGW < M) {
#pragma unroll
                for (int j = 0; j < 4; ++j) xn[j] = ((const GAS f32x4*)(X + (size_t)(tok + NGW) * D) + lane)[64 * j]; }
            const int e1 = (int)(ee & 0xffu), e2 = (int)((ee >> 8) & 0xffu);
            const unsigned p1 = q1 + lcnt[8 + e1], p2 = q2 + lcnt[8 + e2];
            const size_t r1 = (size_t)e1 * MOE_CAP + p1, r2 = (size_t)e2 * MOE_CAP + p2;
#pragma unroll
            for (int j = 0; j < 4; ++j) { const f32x4 v = xv[j]; const unsigned w = pg8::pk_fp8x4(v.x, v.y, v.z, v.w);
                *(unsigned*)(XG + r1 * D + 4 * lane + 256 * j) = w; *(unsigned*)(XG + r2 * D + 4 * lane + 256 * j) = w; }
            if (lane == 0) { RSS[r1] = rs; RSS[r2] = rs; ((unsigned*)(meta + MT_TOKP))[2 * tok] = p1; ((unsigned*)(meta + MT_TOKP))[2 * tok + 1] = p2; }
        }
    }
    GRID_BAR();
    int pref[NEXP + 1], cnt[NEXP];
    { pref[0] = 0;
#pragma unroll
      for (int e = 0; e < NEXP; ++e) { cnt[e] = (int)__builtin_amdgcn_readfirstlane(__hip_atomic_load(ctl + CW_CNT + 64 * e, RLX_AGENT)); pref[e + 1] = pref[e] + (cnt[e] + 255) / 256; } }
    const int NP = pref[NEXP];
    bf16* YS = (bf16*)(ws + WS_Y);
    { pg8::Gemm g{(const bf16*)XG, (const bf16*)(ws + WS_WMOE_GU), D / 2, D / 2, D / 2, 0, (size_t)7168 * 1024}; MoeOrder S; S.S.nM = NP; S.S.nN = 28; S.S.nZ = 1; S.S.nwg = NP * 28; S.S.G = G; S.S.c = bx; S.lo = 0; S.cap_rows = true;
#pragma unroll
      for (int e = 0; e <= NEXP; ++e) S.pref[e] = pref[e];
      pg8::EpiSwiGluFp8 E{RSS, ws + WS_HMOE, DFE};
      pg8::gemm_phase<pg8::EpiSwiGluFp8, MoeOrder, true, true, true>(lds + RING_OFF, g, S, E); }
    GRID_BAR();
    { pg8::Gemm g{(const bf16*)(ws + WS_HMOE), (const bf16*)(ws + WS_WMOE_D), DFE / 2, DFE / 2, DFE / 2, 0, (size_t)1024 * 3584}; MoeOrder S; S.S.nM = NP; S.S.nN = 4; S.S.nZ = 1; S.S.nwg = NP * 4; S.S.G = G; S.S.c = bx; S.lo = 0; S.cap_rows = false;
#pragma unroll
      for (int e = 0; e <= NEXP; ++e) S.pref[e] = pref[e];
      pg8::EpiStoreBf16 E{YS, D};
      pg8::gemm_phase<pg8::EpiStoreBf16, MoeOrder, true, true, true>(lds + RING_OFF, g, S, E); }
    GRID_BAR();
    {
        const float* gf = args.in[27];
        for (int tok = gw; tok < M; tok += NGW) {
            const unsigned ee = ((const unsigned*)(meta + MT_TOKE))[tok]; int pe0 = 0, pe1 = 0;
#pragma unroll
            for (int q = 0; q < NEXP; ++q) { pe0 = (q == (int)(ee & 0xffu)) ? pref[q] : pe0; pe1 = (q == (int)((ee >> 8) & 0xffu)) ? pref[q] : pe1; }
            const unsigned s0 = (unsigned)pe0 * 256u + ((const unsigned*)(meta + MT_TOKP))[2 * tok], s1 = (unsigned)pe1 * 256u + ((const unsigned*)(meta + MT_TOKP))[2 * tok + 1];
            const float g0 = ((const float*)(meta + MT_TOKG))[2 * tok], g1 = ((const float*)(meta + MT_TOKG))[2 * tok + 1];
            GAS f32x4* xr = (GAS f32x4*)(X + (size_t)tok * D) + lane; f32x4 v[4]; float s = 0.f;
#pragma unroll
            for (int j = 0; j < 4; ++j) { v[j] = xr[64 * j]; const int k0 = 4 * lane + 256 * j;
                const v2u a = *(const v2u*)(YS + (size_t)s0 * D + k0), b2 = *(const v2u*)(YS + (size_t)s1 * D + k0);
                v[j].x += g0 * bflo(a.x) + g1 * bflo(b2.x); v[j].y += g0 * bfhi(a.x) + g1 * bfhi(b2.x); v[j].z += g0 * bflo(a.y) + g1 * bflo(b2.y); v[j].w += g0 * bfhi(a.y) + g1 * bfhi(b2.y);
                s += (v[j].x * v[j].x + v[j].y * v[j].y) + (v[j].z * v[j].z + v[j].w * v[j].w); }
            s = wave_sum(s); const float rs = 1.0f / sqrtf(s * (1.0f / 1024.0f) + pg8::RMS_EPS);
#pragma unroll
            for (int j = 0; j < 4; ++j) { const f32x4 gv = *(const f32x4*)(gf + 4 * lane + 256 * j); xr[64 * j] = v[j] * rs * gv; }
        }
    }
}

extern "C" void kernel_launch(void* const* d_in, const int* in_sizes, int n_in, void* d_out, int out_size, void* d_ws, size_t ws_size, hipStream_t stream) {
    static int grid = 0;
    if (grid == 0) {
        if (n_in != 28 || in_sizes[0] != M * D || out_size != M * D || ws_size < WS_END) { fprintf(stderr, "kernel_launch: unexpected problem: n_in %d in0 %d out %d ws %zu (need %zu)\n", n_in, n_in > 0 ? in_sizes[0] : -1, out_size, ws_size, (size_t)WS_END); grid = -1; return; }
        int dev = 0, cus = 0, per_cu = 0;
        if (hipGetDevice(&dev) != hipSuccess || hipDeviceGetAttribute(&cus, hipDeviceAttributeMultiprocessorCount, dev) != hipSuccess) { grid = -1; return; }
        if (hipFuncSetAttribute((const void*)mk_fwd, hipFuncAttributeMaxDynamicSharedMemorySize, LDS_BYTES) != hipSuccess) { fprintf(stderr, "kernel_launch: hipFuncSetAttribute failed\n"); grid = -1; return; }
        if (hipOccupancyMaxActiveBlocksPerMultiprocessor(&per_cu, (const void*)mk_fwd, NTHREADS, LDS_BYTES) != hipSuccess || per_cu < 1) fprintf(stderr, "kernel_launch: occupancy query says %d\n", per_cu);
        (void)hipGetLastError();
        grid = cus;
        if (grid != 256) fprintf(stderr, "kernel_launch: built for the 256-CU MI355X; device reports %d CUs\n", cus);
    }
    if (grid < 0) return;
    if (hipMemsetAsync((char*)d_ws + WS_CTL, 0, CTL_ZERO_BYTES, stream) != hipSuccess) return;
    Args a{};
    for (int i = 0; i < 28; ++i) a.in[i] = (const float*)d_in[i];
    a.out = (float*)d_out; a.ws = (unsigned char*)d_ws;
    hipLaunchKernelGGL(mk_fwd, dim3(grid), dim3(NTHREADS), LDS_BYTES, stream, a);
}
```

```cpp
#include <hip/hip_runtime.h>
#include <cstdio>
#include <cstdint>

namespace pg8 {
#define PG8_LAS __attribute__((address_space(3)))
typedef unsigned short bf16_t;
typedef short bf16x8 __attribute__((ext_vector_type(8)));
typedef float f32x4 __attribute__((ext_vector_type(4)));
typedef unsigned u32x4 __attribute__((ext_vector_type(4)));
typedef unsigned u32x2 __attribute__((ext_vector_type(2)));
constexpr int BM = 256, BK = 64, HALF = 128, HTB = HALF * BK * 2  , STAGE_BYTES = 8 * HTB, NXCD = 8, WGM = 8;

__host__ __device__ __forceinline__ int lds_byte(int r, int c) { const int st = (r >> 4) * 2 + (c >> 5), rr = r & 15, cc = c & 31, ob = rr * 64 + cc * 2; return st * 1024 + (ob ^ (((ob >> 9) & 1) << 5)); }
__host__ __device__ __forceinline__ void stage_rc(int b, int& R, int& C) { const int st = b / 1024, sb = b % 1024, swz = sb ^ (((sb >> 9) & 1) << 5); R = (st >> 1) * 16 + swz / 64; C = (st & 1) * 32 + (swz % 64) / 2; }
__host__ __device__ __forceinline__ int perm32(int rho) { const int n = rho >> 4, i = rho & 15; return 8 * (i >> 2) + 4 * n + (i & 3); }

struct Unit { int pm, pn, zb, pa; };
struct Gemm { const bf16_t* A; const bf16_t* Bt; int lda, ldb, K; size_t zA, zB; };

struct StaticOrder {
    int nM, nN, nZ, nwg, G, c;
    __host__ __device__ void init(int M, int N, int Z, int G_, int c_) { nM = M / BM; nN = N / BM; nZ = Z; nwg = nM * nN * nZ; G = G_; c = c_; }
    __host__ __device__ bool next(int i, Unit& u) const {
        const long L = (long)i * G + c; if (L >= nwg) return false;
        int wgid = (int)L; { const int q = nwg / NXCD, r = nwg % NXCD, xcd = wgid % NXCD, off = wgid / NXCD; wgid = (xcd < r ? xcd * (q + 1) : r * (q + 1) + (xcd - r) * q) + off; }
        const int per = nM * nN; u.zb = wgid / per; wgid -= u.zb * per;
        const int nig = WGM * nN, gid = wgid / nig, fm = gid * WGM, gsz = (nM - fm) < WGM ? (nM - fm) : WGM;
        u.pm = fm + ((wgid % nig) % gsz); u.pn = (wgid % nig) / gsz; u.pa = u.pm; return true;
    }
    __device__ __forceinline__ void a_ready(const Unit&) const {}
    __device__ __forceinline__ void done(const Unit&) const {}
};

__device__ __forceinline__ unsigned cvt_pk_bf16(float lo, float hi) { unsigned r; asm volatile("v_cvt_pk_bf16_f32 %0, %1, %2" : "=v"(r) : "v"(lo), "v"(hi)); return r; }
typedef int v4i_t __attribute__((ext_vector_type(4))); typedef int v8i_t __attribute__((ext_vector_type(8)));
__device__ __forceinline__ v8i_t cat8(bf16x8 a, bf16x8 b) { return __builtin_shufflevector(__builtin_bit_cast(v4i_t, a), __builtin_bit_cast(v4i_t, b), 0, 1, 2, 3, 4, 5, 6, 7); }
__device__ __forceinline__ unsigned pk_fp8x4(float a, float b, float c, float d) { int r = 0; r = __builtin_amdgcn_cvt_pk_fp8_f32(a, b, r, false); r = __builtin_amdgcn_cvt_pk_fp8_f32(c, d, r, true); return (unsigned)r; }
__device__ __forceinline__ float bf_lo(unsigned w) { return __uint_as_float(w << 16); }
__device__ __forceinline__ float bf_hi(unsigned w) { return __uint_as_float(w & 0xffff0000u); }
__device__ __forceinline__ float fast_sigmoid(float z) { return __builtin_amdgcn_rcpf(1.0f + __builtin_amdgcn_exp2f(-1.4426950408889634f * z)); }
constexpr float RMS_EPS = 1e-6f;
__device__ __forceinline__ float rstd16(const float* ssp, int row) { const f32x4* p = (const f32x4*)(ssp + (size_t)row * 16); const f32x4 a = p[0], b = p[1], c = p[2], d = p[3];
    const float s = (((a[0] + a[1]) + (a[2] + a[3])) + ((b[0] + b[1]) + (b[2] + b[3]))) + (((c[0] + c[1]) + (c[2] + c[3])) + ((d[0] + d[1]) + (d[2] + d[3])));
    return __builtin_amdgcn_rsqf(s * (1.0f / 1024.0f) + RMS_EPS); }

__device__ __forceinline__ void rstd8(const float* ssp, int row0, int fq, float (&rs)[8]) {
    f32x4 p[8];
#pragma unroll
    for (int i = 0; i < 8; ++i) p[i] = *(const f32x4*)(ssp + (size_t)(row0 + (i >> 2) * HALF + (i & 3) * 16) * 16 + 4 * fq);
#pragma unroll
    for (int i = 0; i < 8; ++i) { float q = (p[i][0] + p[i][1]) + (p[i][2] + p[i][3]); q += __shfl_xor(q, 16); q += __shfl_xor(q, 32); rs[i] = __builtin_amdgcn_rsqf(q * (1.0f / 1024.0f) + RMS_EPS); }
}
__device__ __forceinline__ u32x4 pack8(const f32x4 v0, const f32x4 v1) { u32x4 w; w.x = cvt_pk_bf16(v0[0], v0[1]); w.y = cvt_pk_bf16(v0[2], v0[3]); w.z = cvt_pk_bf16(v1[0], v1[1]); w.w = cvt_pk_bf16(v1[2], v1[3]); return w; }

struct EpiInProj0 {
    static constexpr bool PERM = true, AFTER_DRAIN = false;
    const float* ss; bf16_t* uext; bf16_t* qkv; float qscale;
    __device__ __forceinline__ void operator()(const f32x4 (&acc)[2][2][4][2], const Unit& u, int wr, int wc, int fr, int fq) const {
        const int row0 = u.pm * BM + wr * 64 + fr; float rsa[8]; rstd8(ss, row0, fq, rsa);
#pragma unroll
        for (int ai = 0; ai < 2; ++ai)
#pragma unroll
            for (int m = 0; m < 4; ++m) { const int row = row0 + ai * HALF + m * 16; const float rs = rsa[ai * 4 + m];
#pragma unroll
                for (int bj = 0; bj < 2; ++bj) { const int col0 = u.pn * BM + bj * HALF + wc * 32 + 8 * fq;
                    float sc = rs; bf16_t* dst;
                    if (u.pn < 2) dst = uext + ((size_t)(col0 >> 4) * 512 + (row >> 5)) * 640 + (row & 31) * 16 + (col0 & 15);
                    else { const int c = col0 - 512; if (c < 512) sc *= qscale; dst = qkv + (size_t)row * 1536 + c; }
                    *(u32x4*)dst = pack8(acc[ai][bj][m][0] * sc, acc[ai][bj][m][1] * sc); } }
    }
};
struct EpiS5State {
    static constexpr bool PERM = false, AFTER_DRAIN = false;
    float* sloc;
    __device__ __forceinline__ void operator()(const f32x4 (&acc)[2][2][4][2], const Unit& u, int wr, int wc, int fr, int fq) const {
        const int row0 = u.pm * BM + wr * 64 + fr, col0 = wc * 32 + 4 * fq;
#pragma unroll
        for (int ai = 0; ai < 2; ++ai)
#pragma unroll
            for (int m = 0; m < 4; ++m) { float* rowp = sloc + ((size_t)u.zb * 512 + row0 + ai * HALF + m * 16) * 128 + col0;
#pragma unroll
                for (int n = 0; n < 2; ++n) *(f32x4*)(rowp + n * 16) = acc[ai][0][m][n]; }
    }
};
__device__ __forceinline__ float gelu_tanh(float x) { const float a = x * (1.0f + 0.044715f * x * x); return x * __builtin_amdgcn_rcpf(1.0f + __builtin_amdgcn_exp2f(-2.302208198f * a)); }
struct EpiS5Y {
    static constexpr bool PERM = true, AFTER_DRAIN = false;
    bf16_t* yg;
    __device__ __forceinline__ void operator()(const f32x4 (&acc)[2][2][4][2], const Unit& u, int wr, int wc, int fr, int fq) const {
        const int row0 = u.pm * BM + wr * 64 + fr;
#pragma unroll
        for (int ai = 0; ai < 2; ++ai)
#pragma unroll
            for (int m = 0; m < 4; ++m) { const int chunk = row0 + ai * HALF + m * 16;
#pragma unroll
                for (int bj = 0; bj < 2; ++bj) { const int col0 = u.pn * BM + bj * HALF + wc * 32 + 8 * fq; const int i = col0 >> 4, h0 = col0 & 15;
                    f32x4 v0 = acc[ai][bj][m][0], v1 = acc[ai][bj][m][1];
#pragma unroll
                    for (int e = 0; e < 4; ++e) { v0[e] = gelu_tanh(v0[e]); v1[e] = gelu_tanh(v1[e]); }
                    *(u32x4*)(yg + ((size_t)chunk * 32 + i) * 512 + u.zb * 16 + h0) = pack8(v0, v1); } }
    }
};
struct EpiGlu {
    static constexpr bool PERM = true, AFTER_DRAIN = false;
    const bf16_t* yg; const float* bias; bf16_t* mix;
    __device__ __forceinline__ void operator()(const f32x4 (&acc)[2][2][4][2], const Unit& u, int wr, int wc, int fr, int fq) const {
        const int row0 = u.pm * BM + wr * 64 + fr; u32x4 ywa[2][8];
#pragma unroll
        for (int bj = 0; bj < 2; ++bj)
#pragma unroll
            for (int i = 0; i < 8; ++i) ywa[bj][i] = *(const u32x4*)(yg + (size_t)(row0 + (i >> 2) * HALF + (i & 3) * 16) * 512 + u.pn * BM + bj * HALF + wc * 32 + 8 * fq);
#pragma unroll
        for (int bj = 0; bj < 2; ++bj) { const int col0 = u.pn * BM + bj * HALF + wc * 32 + 8 * fq;
            const f32x4 b0 = *(const f32x4*)(bias + col0), b1 = *(const f32x4*)(bias + col0 + 4);
#pragma unroll
            for (int ai = 0; ai < 2; ++ai)
#pragma unroll
                for (int m = 0; m < 4; ++m) { const int row = row0 + ai * HALF + m * 16;
                    const u32x4 yw = ywa[bj][ai * 4 + m];
                    f32x4 z0 = acc[ai][bj][m][0] + b0, z1 = acc[ai][bj][m][1] + b1, o0, o1;
                    o0[0] = bf_lo(yw.x) * fast_sigmoid(z0[0]); o0[1] = bf_hi(yw.x) * fast_sigmoid(z0[1]); o0[2] = bf_lo(yw.y) * fast_sigmoid(z0[2]); o0[3] = bf_hi(yw.y) * fast_sigmoid(z0[3]);
                    o1[0] = bf_lo(yw.z) * fast_sigmoid(z1[0]); o1[1] = bf_hi(yw.z) * fast_sigmoid(z1[1]); o1[2] = bf_lo(yw.w) * fast_sigmoid(z1[2]); o1[3] = bf_hi(yw.w) * fast_sigmoid(z1[3]);
                    *(u32x4*)(mix + (size_t)row * 1024 + col0) = pack8(o0, o1); } }
    }
};
struct EpiResid {
    static constexpr bool PERM = false, AFTER_DRAIN = false;
    const float* R; float* X; bf16_t* xb; float* ssq;
    __device__ __forceinline__ void operator()(const f32x4 (&acc)[2][2][4][2], const Unit& u, int wr, int wc, int fr, int fq) const {
        const int row0 = u.pm * BM + wr * 64 + fr, col0 = u.pn * BM + wc * 32 + 4 * fq;
#pragma unroll
        for (int ai = 0; ai < 2; ++ai) {
            f32x4 rv[4][2][2];
#pragma unroll
            for (int m = 0; m < 4; ++m)
#pragma unroll
                for (int bj = 0; bj < 2; ++bj)
#pragma unroll
                    for (int n = 0; n < 2; ++n) rv[m][bj][n] = *(const f32x4*)(R + (size_t)(row0 + ai * HALF + m * 16) * 1024 + col0 + bj * HALF + n * 16);
            asm volatile("" ::: "memory");
#pragma unroll
            for (int m = 0; m < 4; ++m) { const int row = row0 + ai * HALF + m * 16; const size_t off = (size_t)row * 1024 + col0; float s = 0.f;
#pragma unroll
                for (int bj = 0; bj < 2; ++bj)
#pragma unroll
                    for (int n = 0; n < 2; ++n) { const f32x4 x = rv[m][bj][n] + acc[ai][bj][m][n];
                        *(f32x4*)(X + off + bj * HALF + n * 16) = x; s += (x[0] * x[0] + x[1] * x[1]) + (x[2] * x[2] + x[3] * x[3]);
                        u32x2 w; w.x = cvt_pk_bf16(x[0], x[1]); w.y = cvt_pk_bf16(x[2], x[3]); *(u32x2*)(xb + off + bj * HALF + n * 16) = w; }
                s += __shfl_xor(s, 16); s += __shfl_xor(s, 32);
                if (fq == 0) ssq[(size_t)row * 16 + u.pn * 4 + wc] = s; }
            asm volatile("" ::: "memory"); }
    }
};
template <bool RS_IS_SSQ> struct EpiSwiGlu {
    static constexpr bool PERM = true, AFTER_DRAIN = false;
    const float* rsv; bf16_t* H; int ldh;
    __device__ __forceinline__ void operator()(const f32x4 (&acc)[2][2][4][2], const Unit& u, int wr, int wc, int fr, int fq) const {
        const int row0 = u.pm * BM + wr * 64 + fr, col0 = u.pn * HALF + wc * 32 + 8 * fq; float rsa[8];
        if (RS_IS_SSQ) rstd8(rsv, row0, fq, rsa);
        else {
#pragma unroll
            for (int i = 0; i < 8; ++i) rsa[i] = rsv[row0 + (i >> 2) * HALF + (i & 3) * 16]; }
#pragma unroll
        for (int ai = 0; ai < 2; ++ai)
#pragma unroll
            for (int m = 0; m < 4; ++m) { const int row = row0 + ai * HALF + m * 16; const float rs = rsa[ai * 4 + m];
                f32x4 o[2];
#pragma unroll
                for (int n = 0; n < 2; ++n)
#pragma unroll
                    for (int e = 0; e < 4; ++e) { const float g = acc[ai][0][m][n][e] * rs, up = acc[ai][1][m][n][e] * rs; o[n][e] = g * fast_sigmoid(g) * up; }
                *(u32x4*)(H + (size_t)row * ldh + col0) = pack8(o[0], o[1]); }
    }
};
struct EpiSwiGluFp8 {
    static constexpr bool PERM = true, AFTER_DRAIN = false;
    const float* rsv; unsigned char* H; int ldh;
    __device__ __forceinline__ void operator()(const f32x4 (&acc)[2][2][4][2], const Unit& u, int wr, int wc, int fr, int fq) const {
        const int row0 = u.pm * BM + wr * 64 + fr, col0 = u.pn * HALF + wc * 32 + 8 * fq; float rsa[8];
#pragma unroll
        for (int i = 0; i < 8; ++i) rsa[i] = rsv[u.pa * BM + wr * 64 + fr + (i >> 2) * HALF + (i & 3) * 16];
#pragma unroll
        for (int ai = 0; ai < 2; ++ai)
#pragma unroll
            for (int m = 0; m < 4; ++m) { const int row = row0 + ai * HALF + m * 16; const float rs = rsa[ai * 4 + m];
                f32x4 o[2];
#pragma unroll
                for (int n = 0; n < 2; ++n)
#pragma unroll
                    for (int e = 0; e < 4; ++e) { const float g = acc[ai][0][m][n][e] * rs, up = acc[ai][1][m][n][e] * rs; o[n][e] = g * fast_sigmoid(g) * up; }
                u32x2 w; w.x = pk_fp8x4(o[0][0], o[0][1], o[0][2], o[0][3]); w.y = pk_fp8x4(o[1][0], o[1][1], o[1][2], o[1][3]);
                *(u32x2*)(H + (size_t)row * ldh + col0) = w; }
    }
};
struct EpiInProj1 {
    static constexpr bool PERM = true, AFTER_DRAIN = false;
    const float* ss; bf16_t* qkv; float qscale;
    unsigned* kn;
    __device__ __forceinline__ void operator()(const f32x4 (&acc)[2][2][4][2], const Unit& u, int wr, int wc, int fr, int fq) const {
        const int row0 = u.pm * BM + wr * 64 + fr; const float qs = (u.pn < 4) ? qscale : 1.0f; float rsa[8]; rstd8(ss, row0, fq, rsa);
#pragma unroll
        for (int ai = 0; ai < 2; ++ai)
#pragma unroll
            for (int m = 0; m < 4; ++m) { const int row = row0 + ai * HALF + m * 16; const float sc = rsa[ai * 4 + m] * qs;
#pragma unroll
                for (int bj = 0; bj < 2; ++bj) { const int col0 = (u.pn & 3) * BM + bj * HALF + wc * 32 + 8 * fq;
                    const f32x4 v0 = acc[ai][bj][m][0] * sc, v1 = acc[ai][bj][m][1] * sc;
                    *(u32x4*)(qkv + (size_t)(u.pn >> 2) * (16384 * 1024) + (size_t)row * 1024 + col0) = pack8(v0, v1);
                    if ((u.pn >> 2) == 1) {
                        float q = ((v0[0] * v0[0] + v0[1] * v0[1]) + (v0[2] * v0[2] + v0[3] * v0[3])) + ((v1[0] * v1[0] + v1[1] * v1[1]) + (v1[2] * v1[2] + v1[3] * v1[3]));
                        q += __shfl_xor(q, 16); q += __shfl_xor(q, 32);
                        q = fmaxf(q, __shfl_xor(q, 1)); q = fmaxf(q, __shfl_xor(q, 2)); q = fmaxf(q, __shfl_xor(q, 4)); q = fmaxf(q, __shfl_xor(q, 8));
                        if (fr == 0 && fq == 0) { const int head = (u.pn & 3) * 4 + bj * 2 + (wc >> 1), bb = row >> 13, tile = (row & 8191) >> 6;
                            atomicMax(kn + ((size_t)(bb * 16 + head) * 128 + tile) * 2 + (wc & 1), __float_as_uint(q * 1.01f)); } } } }
    }
};
struct EpiStoreBf16 {
    static constexpr bool PERM = true, AFTER_DRAIN = false;
    bf16_t* O; int ldc;
    __device__ __forceinline__ void operator()(const f32x4 (&acc)[2][2][4][2], const Unit& u, int wr, int wc, int fr, int fq) const {
        const int row0 = u.pm * BM + wr * 64 + fr;
#pragma unroll
        for (int ai = 0; ai < 2; ++ai)
#pragma unroll
            for (int m = 0; m < 4; ++m) { const int row = row0 + ai * HALF + m * 16;
#pragma unroll
                for (int bj = 0; bj < 2; ++bj) { const int col0 = u.pn * BM + bj * HALF + wc * 32 + 8 * fq;
                    *(u32x4*)(O + (size_t)row * ldc + col0) = pack8(acc[ai][bj][m][0], acc[ai][bj][m][1]); } }
    }
};

template <bool F8> struct Frag { bf16x8 k[2]; };
template <> struct Frag<true> { v8i_t v; };
template <class Epi, class Sched, bool ALIGN_EPI = false, bool SP2 = false, bool FP8 = false>
__device__ __forceinline__ void gemm_phase(PG8_LAS unsigned char* lds, const Gemm g, const Sched& S, const Epi& E) {
    int tid_ = threadIdx.x; asm volatile("" : "+v"(tid_));
    const int tid = tid_, wid = __builtin_amdgcn_readfirstlane(tid >> 6), lane = tid & 63, wr = wid >> 2, wc = wid & 3, fr = lane & 15, fq = lane >> 4;
    const int K = g.K, nt = K / BK;
    unsigned voffA[2], voffB[2];
#pragma unroll
    for (int i = 0; i < 2; ++i) { int R, C; stage_rc(tid * 16 + i * 8192, R, C); const int Rb = Epi::PERM ? ((R & ~31) + perm32(R & 31)) : R;
        voffA[i] = (unsigned)(R * g.lda + C) * 2u; voffB[i] = (unsigned)(Rb * g.ldb + C) * 2u; }
    const size_t kstep = (size_t)(BK * 2);
    const size_t hstepA = (size_t)HALF * g.lda * 2, hstepB = (size_t)HALF * g.ldb * 2;
    const size_t tstepA = 2 * hstepA, tstepB = 2 * hstepB;
    const unsigned ldsw = (unsigned)wid * 1024u;
    const int aoff = lds_byte(wr * 64 + fr, fq * 8), boff = lds_byte(wc * 32 + fr, fq * 8);
#define PG8_SA(b, h) (((b) * 2 + (h)) * HTB)
#define PG8_SB(b, h) ((4 + (b) * 2 + (h)) * HTB)
#define PG8_STAGE(bufoff, gbase, voff) do { _Pragma("unroll") for (int _i = 0; _i < 2; ++_i) \
        __builtin_amdgcn_global_load_lds((const unsigned*)((const char*)(gbase) + (voff)[_i]), (PG8_LAS unsigned*)(lds + (bufoff) + ldsw + _i * 8192), 16, 0, 0); } while (0)
    const PG8_LAS unsigned char* ldsA_ = lds + aoff; const PG8_LAS unsigned char* ldsB_ = lds + 4 * HTB + boff; asm volatile("" : "+v"(ldsA_), "+v"(ldsB_));
#define PG8_RDA(off) (*(const PG8_LAS bf16x8*)(ldsA_ + (off)))
#define PG8_RDB(off) (*(const PG8_LAS bf16x8*)(ldsB_ + (off)))
#define PG8_LDA(dst, b, h) do { _Pragma("unroll") for (int m = 0; m < 4; ++m) { if constexpr (FP8) dst[m].v = cat8(PG8_RDA(PG8_SA(b, h) + m * 2048), PG8_RDA(PG8_SA(b, h) + m * 2048 + 1024)); \
        else { dst[m].k[0] = PG8_RDA(PG8_SA(b, h) + m * 2048); dst[m].k[1] = PG8_RDA(PG8_SA(b, h) + m * 2048 + 1024); } } } while (0)
#define PG8_LDB(dst, b, h) do { _Pragma("unroll") for (int n = 0; n < 2; ++n) { if constexpr (FP8) dst[n].v = cat8(PG8_RDB(PG8_SB(b, h) - 4 * HTB + n * 2048), PG8_RDB(PG8_SB(b, h) - 4 * HTB + n * 2048 + 1024)); \
        else { dst[n].k[0] = PG8_RDB(PG8_SB(b, h) - 4 * HTB + n * 2048); dst[n].k[1] = PG8_RDB(PG8_SB(b, h) - 4 * HTB + n * 2048 + 1024); } } } while (0)
#define PG8_MMA(ai, bj, At, Bt) do { __builtin_amdgcn_s_setprio(1); _Pragma("unroll") for (int m = 0; m < 4; ++m) _Pragma("unroll") for (int n = 0; n < 2; ++n) { \
        if constexpr (FP8) { asm volatile("v_mfma_scale_f32_16x16x128_f8f6f4 %0, %1, %2, %0, %3, %4 op_sel_hi:[0,0,0]" : "+v"(acc[ai][bj][m][n]) : "v"(Bt[n].v), "v"(At[m].v), "v"(sclB_), "v"(sclA_)); } \
        else { _Pragma("unroll") for (int k = 0; k < 2; ++k) acc[ai][bj][m][n] = __builtin_amdgcn_mfma_f32_16x16x32_bf16(Bt[n].k[k], At[m].k[k], acc[ai][bj][m][n], 0, 0, 0); } } __builtin_amdgcn_s_setprio(0); } while (0)
#define PG8_WAIT_V(n) asm volatile("s_waitcnt vmcnt(" #n ")" ::: "memory")
#define PG8_WAIT_L(n) asm volatile("s_waitcnt lgkmcnt(" #n ")" ::: "memory")
#define PG8_BAR __builtin_amdgcn_s_barrier()
#define PG8_SCHED __builtin_amdgcn_sched_barrier(0)
    Unit cur, nxt; int ui = 0;
    if (!S.next(0, cur)) return;
    f32x4 acc[2][2][4][2];
#pragma unroll
    for (int a = 0; a < 2; ++a)
#pragma unroll
        for (int b = 0; b < 2; ++b)
#pragma unroll
            for (int m = 0; m < 4; ++m)
#pragma unroll
                for (int n = 0; n < 2; ++n) acc[a][b][m][n] = (f32x4){0.f, 0.f, 0.f, 0.f};
    Frag<FP8> At[4], B0[2], B1[2];
    int sclB_ = 0x79797979, sclA_ = 0x7f7f7f7f; asm volatile("" : "+v"(sclB_), "+v"(sclA_));
    const char* cA = (const char*)g.A + (size_t)cur.zb * g.zA + (size_t)cur.pa * tstepA; const char* cB = (const char*)g.Bt + (size_t)cur.zb * g.zB + (size_t)cur.pn * tstepB;
    S.a_ready(cur);
    if constexpr (SP2) {
        PG8_STAGE(PG8_SB(0, 0), cB, voffB); PG8_STAGE(PG8_SB(0, 1), cB + hstepB, voffB); PG8_STAGE(PG8_SA(0, 0), cA, voffA); PG8_STAGE(PG8_SA(0, 1), cA + hstepA, voffA);
        if (wr == 1) PG8_BAR;
        PG8_WAIT_V(2); PG8_BAR;
        PG8_STAGE(PG8_SB(1, 0), cB + kstep, voffB); PG8_STAGE(PG8_SA(1, 0), cA + kstep, voffA); PG8_STAGE(PG8_SB(1, 1), cB + hstepB + kstep, voffB);
        PG8_WAIT_V(6); PG8_BAR;
    } else {
        PG8_STAGE(PG8_SB(0, 0), cB, voffB); PG8_STAGE(PG8_SA(0, 0), cA, voffA); PG8_STAGE(PG8_SB(0, 1), cB + hstepB, voffB); PG8_STAGE(PG8_SA(0, 1), cA + hstepA, voffA);
        if (wr == 1) PG8_BAR;
        PG8_WAIT_V(4); PG8_BAR;
        PG8_STAGE(PG8_SB(1, 0), cB + kstep, voffB); PG8_STAGE(PG8_SA(1, 0), cA + kstep, voffA); PG8_STAGE(PG8_SB(1, 1), cB + hstepB + kstep, voffB);
        PG8_WAIT_V(6); PG8_BAR;
    }
    for (;;) {
        const bool has_next = S.next(ui + 1, nxt);
        const char* nA = has_next ? (const char*)g.A + (size_t)nxt.zb * g.zA + (size_t)nxt.pa * tstepA : cA; const char* nB = has_next ? (const char*)g.Bt + (size_t)nxt.zb * g.zB + (size_t)nxt.pn * tstepB : cB;
#pragma unroll 1
        for (int t = 0; t < nt; t += 2) {
            const bool last = (t == nt - 2);
            const char* a1 = cA + (size_t)(t + 1) * kstep;
            const char* a2 = last ? nA : cA + (size_t)(t + 2) * kstep; const char* b2 = last ? nB : cB + (size_t)(t + 2) * kstep;
            const char* a3 = a2 + kstep; const char* b3 = b2 + kstep;
            if (last && has_next) S.a_ready(nxt);
            if constexpr (SP2) {
            PG8_LDB(B0, 0, 0); PG8_LDB(B1, 0, 1); PG8_SCHED; PG8_LDA(At, 0, 0); PG8_STAGE(PG8_SA(1, 1), a1 + hstepA, voffA);
            PG8_WAIT_V(8); PG8_WAIT_L(0); PG8_BAR; PG8_MMA(0, 0, At, B0); PG8_MMA(0, 1, At, B1); PG8_BAR; PG8_SCHED;
            PG8_LDA(At, 0, 1); PG8_STAGE(PG8_SB(0, 0), b2, voffB); PG8_STAGE(PG8_SB(0, 1), b2 + hstepB, voffB); PG8_STAGE(PG8_SA(0, 0), a2, voffA);
            PG8_WAIT_V(8); PG8_WAIT_L(0); PG8_BAR; PG8_MMA(1, 0, At, B0); PG8_MMA(1, 1, At, B1); PG8_BAR; PG8_SCHED;
            PG8_LDB(B0, 1, 0); PG8_LDB(B1, 1, 1); PG8_SCHED; PG8_LDA(At, 1, 0); PG8_STAGE(PG8_SA(0, 1), a2 + hstepA, voffA);
            PG8_WAIT_V(8); PG8_WAIT_L(0); PG8_BAR; PG8_MMA(0, 0, At, B0); PG8_MMA(0, 1, At, B1); PG8_BAR; PG8_SCHED;
            PG8_LDA(At, 1, 1); PG8_STAGE(PG8_SB(1, 0), b3, voffB); PG8_STAGE(PG8_SB(1, 1), b3 + hstepB, voffB); PG8_STAGE(PG8_SA(1, 0), a3, voffA);
            PG8_WAIT_V(8); PG8_WAIT_L(0); PG8_BAR; PG8_MMA(1, 0, At, B0); PG8_MMA(1, 1, At, B1); PG8_BAR; PG8_SCHED;
            } else {
            PG8_LDB(B0, 0, 0); PG8_SCHED; PG8_LDA(At, 0, 0); PG8_STAGE(PG8_SA(1, 1), a1 + hstepA, voffA);
            PG8_WAIT_L(8); PG8_BAR; PG8_WAIT_L(0); PG8_MMA(0, 0, At, B0); PG8_BAR; PG8_SCHED;
            PG8_LDB(B1, 0, 1); PG8_STAGE(PG8_SB(0, 0), b2, voffB);
            PG8_BAR; PG8_WAIT_L(0); PG8_MMA(0, 1, At, B1); PG8_BAR;
            PG8_LDA(At, 0, 1); PG8_STAGE(PG8_SA(0, 0), a2, voffA);
            PG8_BAR; PG8_WAIT_L(0); PG8_MMA(1, 0, At, B0); PG8_BAR; PG8_SCHED;
            PG8_STAGE(PG8_SB(0, 1), b2 + hstepB, voffB);
            PG8_WAIT_V(6); PG8_BAR; PG8_MMA(1, 1, At, B1); PG8_BAR;
            PG8_LDB(B0, 1, 0); PG8_SCHED; PG8_LDA(At, 1, 0); PG8_STAGE(PG8_SA(0, 1), a2 + hstepA, voffA);
            PG8_WAIT_L(8); PG8_BAR; PG8_WAIT_L(0); PG8_MMA(0, 0, At, B0); PG8_BAR; PG8_SCHED;
            PG8_LDB(B1, 1, 1); PG8_STAGE(PG8_SB(1, 0), b3, voffB);
            PG8_BAR; PG8_WAIT_L(0); PG8_MMA(0, 1, At, B1); PG8_BAR;
            PG8_LDA(At, 1, 1); PG8_STAGE(PG8_SA(1, 0), a3, voffA);
            PG8_BAR; PG8_WAIT_L(0); PG8_MMA(1, 0, At, B0); PG8_BAR; PG8_SCHED;
            PG8_STAGE(PG8_SB(1, 1), b3 + hstepB, voffB);
            PG8_WAIT_V(6); PG8_BAR; PG8_MMA(1, 1, At, B1); PG8_BAR;
            }
        }
        if constexpr (ALIGN_EPI) { if (wr == 0) PG8_BAR; }
        if constexpr (FP8) asm volatile("s_nop 15\n\ts_nop 15" ::: "memory");
        if constexpr (!Epi::AFTER_DRAIN) { int fr_ = fr, fq_ = fq; asm volatile("" : "+v"(fr_), "+v"(fq_));
            E(acc, cur, wr, wc, fr_, fq_); S.done(cur); }
        if (!has_next) break;
#pragma unroll
        for (int a = 0; a < 2; ++a)
#pragma unroll
            for (int b = 0; b < 2; ++b)
#pragma unroll
                for (int m = 0; m < 4; ++m)
#pragma unroll
                    for (int n = 0; n < 2; ++n) acc[a][b][m][n] = (f32x4){0.f, 0.f, 0.f, 0.f};
        cur = nxt; cA = nA; cB = nB; ++ui;
        if constexpr (ALIGN_EPI) { if (wr == 1) PG8_BAR; }
    }
    PG8_WAIT_V(0);
    if constexpr (!ALIGN_EPI) { if (wr == 0) PG8_BAR; }
    PG8_BAR;
    if constexpr (Epi::AFTER_DRAIN) { E.fused(acc, cur, wr, wc, fr, fq, lds, wid, lane); S.done(cur); }
#undef PG8_SA
#undef PG8_SB
#undef PG8_STAGE
#undef PG8_LDA
#undef PG8_RDA
#undef PG8_RDB
#undef PG8_LDB
#undef PG8_MMA
#undef PG8_WAIT_V
#undef PG8_WAIT_L
#undef PG8_BAR
#undef PG8_SCHED
}
}

#include <hip/hip_bf16.h>
#include <cmath>
namespace attn_body {
using bf16=__hip_bfloat16;
using bf16x8=__attribute__((ext_vector_type(8)))short;
using s16x4=__attribute__((ext_vector_type(4)))short;
using f32x16=__attribute__((ext_vector_type(16)))float;
using u32x4=__attribute__((ext_vector_type(4)))unsigned;
constexpr int BATCH=2,NHEAD=16,SEQ=8192,D=64,DM=NHEAD*D;
constexpr int NW=8,QBLK=32,QB=QBLK*NW,KVBLK=64,NQB=SEQ/QB;
constexpr int ATTN_PITCH=DM, ATTN_UNIT_ROWS=QB;
__device__ __forceinline__ int crow(int r,int hi){return (r&3)+8*(r>>2)+4*hi;}
#define SBAR() __builtin_amdgcn_sched_barrier(0)
__device__ __forceinline__ void cmask(f32x16&p0,f32x16&p1,int jb,int qrel,int hi){
  const float NEG=-INFINITY; int kb=64*jb+4*hi;
  #pragma unroll
  for(int r=0;r<16;++r){int kv=kb+(r&3)+8*(r>>2); if(kv>qrel)p0[r]=NEG; if(kv+32>qrel)p1[r]=NEG;}
}

constexpr int NSLOT=3, SLOTB=8192;
constexpr int LDS_K=0, LDS_V=NSLOT*SLOTB, LDS_WS=2*NSLOT*SLOTB, LDS_OST=LDS_WS+NW*64*4, LDS_NB=LDS_OST+NW*4096  , LDS_PK=LDS_NB+32768+64  , LDS_BYTES=LDS_PK+1024;
constexpr float C2=0.125f*1.4426950408889634f;
__device__ __forceinline__ void glds16(const void*gsrc,unsigned lds_dst){unsigned keep;
  asm volatile("s_mov_b32 %0, m0\n\ts_mov_b32 m0, %2\n\ts_nop 0\n\tglobal_load_lds_dwordx4 %1, off\n\ts_mov_b32 m0, %0":"=&s"(keep):"v"(gsrc),"s"(lds_dst):"memory");}
__device__ __forceinline__ float max3f(float a,float b,float c){float r;asm("v_max3_f32 %0, %1, %2, %3":"=v"(r):"v"(a),"v"(b),"v"(c));return r;}
__device__ __forceinline__ float max2f(float a,float b){float r;asm("v_max_f32_e32 %0, %1, %2":"=v"(r):"v"(a),"v"(b));return r;}
__device__ __forceinline__ float fadd_s(float a,float b){float r;asm("v_add_f32_e32 %0, %1, %2":"=v"(r):"v"(a),"v"(b));return r;}
__device__ __forceinline__ float fsub_s(float a,float b){float r;asm("v_sub_f32_e32 %0, %1, %2":"=v"(r):"v"(a),"v"(b));return r;}
typedef float f32x2_t __attribute__((ext_vector_type(2))); typedef __bf16 bf16x2_t __attribute__((ext_vector_type(2)));
__device__ __forceinline__ unsigned cvtpk_s(float lo,float hi){f32x2_t v={lo,hi};bf16x2_t b=__builtin_convertvector(v,bf16x2_t);return __builtin_bit_cast(unsigned,b);}
#define WAIT_BAR(N) asm volatile("s_waitcnt vmcnt(" #N ") lgkmcnt(0)\n\ts_barrier":::"memory")

__device__ __forceinline__ void qkt(f32x16&p0,f32x16&p1,const char*Kslot,const bf16x8*qr,const f32x16&negm,int r32,int hi){
  const char*kb=Kslot+hi*1024+r32*16;
  #pragma unroll
  for(int d0=0;d0<4;++d0){
    const bf16x8 b0=*reinterpret_cast<const bf16x8*>(kb+d0*2048);
    const bf16x8 b1=*reinterpret_cast<const bf16x8*>(kb+d0*2048+512);
    if(d0==0){p0=__builtin_amdgcn_mfma_f32_32x32x16_bf16(b0,qr[0],negm,0,0,0);p1=__builtin_amdgcn_mfma_f32_32x32x16_bf16(b1,qr[0],negm,0,0,0);}
    else{p0=__builtin_amdgcn_mfma_f32_32x32x16_bf16(b0,qr[d0],p0,0,0,0);p1=__builtin_amdgcn_mfma_f32_32x32x16_bf16(b1,qr[d0],p1,0,0,0);}}
}
typedef __attribute__((address_space(3))) const char* lds_cptr;
typedef short v4i16_t __attribute__((ext_vector_type(4)));
__device__ __forceinline__ void kload8(bf16x8*kf,lds_cptr kp){
  kf[0]=*(const __attribute__((address_space(3))) bf16x8*)(kp);      kf[1]=*(const __attribute__((address_space(3))) bf16x8*)(kp+512);
  kf[2]=*(const __attribute__((address_space(3))) bf16x8*)(kp+2048); kf[3]=*(const __attribute__((address_space(3))) bf16x8*)(kp+2560);
  kf[4]=*(const __attribute__((address_space(3))) bf16x8*)(kp+4096); kf[5]=*(const __attribute__((address_space(3))) bf16x8*)(kp+4608);
  kf[6]=*(const __attribute__((address_space(3))) bf16x8*)(kp+6144); kf[7]=*(const __attribute__((address_space(3))) bf16x8*)(kp+6656);
}
__device__ __forceinline__ void kload2(bf16x8*kf,lds_cptr kp,int j){ kf[2*j]=*(const __attribute__((address_space(3))) bf16x8*)(kp+j*2048); kf[2*j+1]=*(const __attribute__((address_space(3))) bf16x8*)(kp+j*2048+512); }
__device__ __forceinline__ s16x4 vtr(lds_cptr p){ return __builtin_bit_cast(s16x4,__builtin_amdgcn_ds_read_tr16_b64_v4i16((__attribute__((address_space(3))) v4i16_t*)p)); }
__device__ __forceinline__ float rowmax(const f32x16&p0,const f32x16&p1){
  float a=max3f(p0[0],p0[1],p1[0]),b=max3f(p0[2],p0[3],p1[1]);a=max3f(a,p1[2],p1[3]);
  #pragma unroll
  for(int r=4;r<16;r+=4){a=max3f(a,p0[r],p0[r+1]);b=max3f(b,p0[r+2],p0[r+3]);a=max3f(a,p1[r],p1[r+1]);b=max3f(b,p1[r+2],p1[r+3]);}
  const float m=max2f(a,b);
  auto rr=__builtin_amdgcn_permlane32_swap(__float_as_uint(m),__float_as_uint(m),false,false);
  return max2f(__uint_as_float(rr[0]),__uint_as_float(rr[1]));
}
__device__ __forceinline__ void pv(f32x16*o,int vb,bf16x8 pa0,bf16x8 pa1,bf16x8 pa2,bf16x8 pa3){
  #pragma unroll
  for(int d0=0;d0<2;++d0){s16x4 lo[4],hi[4];
    #pragma unroll
    for(int ks=0;ks<4;++ks){
      asm volatile("ds_read_b64_tr_b16 %0,%1 offset:%c2":"=&v"(lo[ks]):"v"(vb),"i"(d0*4096+ks*1024):"memory");
      asm volatile("ds_read_b64_tr_b16 %0,%1 offset:%c2":"=&v"(hi[ks]):"v"(vb),"i"(d0*4096+ks*1024+512):"memory");}
    asm volatile("s_waitcnt lgkmcnt(0)":::"memory");SBAR();
    #define PK(k) (bf16x8){lo[k][0],lo[k][1],lo[k][2],lo[k][3],hi[k][0],hi[k][1],hi[k][2],hi[k][3]}
    o[d0]=__builtin_amdgcn_mfma_f32_32x32x16_bf16(pa0,PK(0),o[d0],0,0,0);
    o[d0]=__builtin_amdgcn_mfma_f32_32x32x16_bf16(pa1,PK(1),o[d0],0,0,0);
    o[d0]=__builtin_amdgcn_mfma_f32_32x32x16_bf16(pa2,PK(2),o[d0],0,0,0);
    o[d0]=__builtin_amdgcn_mfma_f32_32x32x16_bf16(pa3,PK(3),o[d0],0,0,0);
    #undef PK
  }
}

typedef float f32x4_t __attribute__((ext_vector_type(4)));
__device__ __forceinline__ void fox_negcum(const float*logf,__attribute__((address_space(3))) float*ncum,__attribute__((address_space(3))) float*wtot,int tid){
  float loc[16];float s=0.f; const f32x4_t*lp=(const f32x4_t*)(logf+tid*16);
  #pragma unroll
  for(int j=0;j<4;++j){const f32x4_t v=lp[j]; s+=v[0];loc[4*j]=s; s+=v[1];loc[4*j+1]=s; s+=v[2];loc[4*j+2]=s; s+=v[3];loc[4*j+3]=s;}
  float inc=s;
  #pragma unroll
  for(int o=1;o<64;o<<=1){const float v=__shfl_up(inc,o); if((tid&63)>=o)inc+=v;}
  if((tid&63)==63)wtot[tid>>6]=inc;
  __syncthreads();
  float base=inc-s; for(int w=0;w<(tid>>6);++w)base+=wtot[w];
  #pragma unroll
  for(int j=0;j<4;++j){ f32x4_t o4; o4[0]=-(base+loc[4*j]);o4[1]=-(base+loc[4*j+1]);o4[2]=-(base+loc[4*j+2]);o4[3]=-(base+loc[4*j+3]); *(__attribute__((address_space(3))) f32x4_t*)(ncum+tid*16+4*j)=o4; }
  __syncthreads();
}
#ifndef ATTN_STORE16
#define ATTN_STORE16(p,v) (*(u32x4*)(p)=(v))
#endif
template<int THRL> __device__ __forceinline__ void attn_unit(int b,int h,int qb,const bf16*Q,const bf16*__restrict__ K,const bf16*__restrict__ V,bf16*O,char*shm,const float*logf_bh,const unsigned*kn_bh){
  int tid_=threadIdx.x; asm volatile("":"+v"(tid_)); const int tid=tid_,lane=tid&63,r32=lane&31,hi=lane>>5; const int wid=__builtin_amdgcn_readfirstlane(tid>>6);
  const long rowbase=(long)b*SEQ; const int q0=qb*QB;
  const bf16*Qw=Q+(rowbase+q0+wid*QBLK)*DM+h*D;
  const bf16*Kh=K+rowbase*DM+h*D,*Vh=V+rowbase*DM+h*D;
  const unsigned lds0=(unsigned)(uintptr_t)shm;
  float*wsf=(float*)(shm+LDS_WS)+wid*64;
  const bf16*ksrc=Kh+(long)lane*DM+wid*8;
  const bf16*vsrc=Vh+(long)(16*(wid&3)+(lane>>2))*DM+(wid>>2)*32+(lane&3)*8;
  const unsigned kdst=lds0+LDS_K+wid*1024, vdst=lds0+LDS_V+wid*1024;
  #define TIDX(t) (NTR-1-(t))
  #define DMA_K(t,slot) glds16(ksrc+(long)TIDX(t)*KVBLK*DM,(unsigned)__builtin_amdgcn_readfirstlane(kdst+(slot)))
  #define DMA_V(t,slot) glds16(vsrc+(long)TIDX(t)*KVBLK*DM,(unsigned)__builtin_amdgcn_readfirstlane(vdst+(slot)))
  const int vb0=(int)(lds0+LDS_V)+((lane>>4)&1)*32+(lane&3)*8+(4*hi+((lane&15)>>2))*64;
  const char*Kbase=shm+LDS_K; bf16x8 kf[8];
  const lds_cptr shm3=(lds_cptr)shm; const lds_cptr kp0=shm3+LDS_K+hi*1024+r32*16; const lds_cptr vp0=shm3+LDS_V+((lane>>4)&1)*32+(lane&3)*8+(4*hi+((lane&15)>>2))*64;
  const int NTR=(q0+QB)/KVBLK;
  const lds_cptr shm3b=(lds_cptr)shm;
  const __attribute__((address_space(3))) float* nb3=(const __attribute__((address_space(3))) float*)(shm3b+LDS_NB);
  fox_negcum(logf_bh,(__attribute__((address_space(3))) float*)(shm3b+LDS_NB),(__attribute__((address_space(3))) float*)(shm3b+LDS_NB+32768),tid);
  int NT;
  { __attribute__((address_space(3))) float* PK=(__attribute__((address_space(3))) float*)(shm3b+LDS_PK);
    __attribute__((address_space(3))) int* JX=(__attribute__((address_space(3))) int*)(shm3b+LDS_PK+512);
    float pk=0.f;
    if(tid<128){ const float a=__uint_as_float(kn_bh[2*tid]),c=__uint_as_float(kn_bh[2*tid+1]); pk=__builtin_sqrtf(a+c)*1.001f; }
    #pragma unroll
    for(int o_=1;o_<64;o_<<=1){const float v=__shfl_up(pk,o_); if((tid&63)>=o_)pk=__builtin_fmaxf(pk,v);}
    if(tid==63)PK[128]=pk;
    __syncthreads();
    if(tid>=64&&tid<128)pk=__builtin_fmaxf(pk,PK[128]);
    if(tid<128)PK[tid]=pk;
    const bf16*Krow=Kh+(long)(q0+wid*QBLK+r32)*DM+hi*8; const bf16*Qrow=Qw+(long)r32*DM+hi*8; float qq=0.f,qk=0.f;
    #pragma unroll
    for(int d0=0;d0<4;++d0){ const u32x4 qa=*reinterpret_cast<const u32x4*>(Qrow+d0*16), ka=*reinterpret_cast<const u32x4*>(Krow+d0*16);
      #pragma unroll
      for(int e=0;e<4;++e){ const float q0f=__uint_as_float(qa[e]<<16),q1f=__uint_as_float(qa[e]&0xffff0000u),k0f=__uint_as_float(ka[e]<<16),k1f=__uint_as_float(ka[e]&0xffff0000u);
        qq+=q0f*q0f+q1f*q1f; qk+=q0f*k0f+q1f*k1f; } }
    { auto r1=__builtin_amdgcn_permlane32_swap(__float_as_uint(qq),__float_as_uint(qq),false,false); qq=__uint_as_float(r1[0])+__uint_as_float(r1[1]);
      auto r2=__builtin_amdgcn_permlane32_swap(__float_as_uint(qk),__float_as_uint(qk),false,false); qk=__uint_as_float(r2[0])+__uint_as_float(r2[1]); }
    __syncthreads();
    const float qn=__builtin_sqrtf(qq)*1.001f, thr=qk+nb3[q0+wid*QBLK+r32]-152.f;
    int lo_=0,hi_=NTR;
    #pragma unroll 1
    for(int it=0;it<8;++it){ if(lo_<hi_){ const int mid=(lo_+hi_)>>1; const float f=qn*PK[mid]+nb3[64*mid+63]; if(f>=thr)hi_=mid; else lo_=mid+1; } }
    #pragma unroll
    for(int o_=1;o_<64;o_<<=1){const int v=__shfl_xor(lo_,o_); lo_=v<lo_?v:lo_;}
    if(lane==0)JX[wid]=lo_;
    __syncthreads();
    int j0=JX[0];
    #pragma unroll
    for(int w=1;w<8;++w){const int v=JX[w]; j0=v<j0?v:j0;}
    j0=__builtin_amdgcn_readfirstlane(j0);
    int nte=(NTR-j0+1)&~1; NT=nte<4?4:nte;
    __syncthreads();
  }
  { __attribute__((address_space(3))) float* nbw=(__attribute__((address_space(3))) float*)(shm3b+LDS_NB);
    const float ref_=nbw[q0+QB-1];
    __syncthreads();
    #pragma unroll
    for(int j=0;j<16;++j){ const float v=nbw[tid*16+j]-ref_; const unsigned h_=cvtpk_s(v,0.f)&0xffffu; const float hf_=__uint_as_float(h_<<16); const unsigned l_=cvtpk_s(v-hf_,0.f)&0xffffu;
      ((__attribute__((address_space(3))) unsigned*)nbw)[tid*16+j]=h_|(l_<<16); }
    __syncthreads();
  }
  const __attribute__((address_space(3))) unsigned* nbp=(const __attribute__((address_space(3))) unsigned*)(shm3b+LDS_NB);
  const unsigned mh0=(hi==0)?0xffffffffu:0u, onesm=0x3f803f80u&mh0;
  u32x4 qxw={onesm,0u,0u,0u};
  #define QX_SET() do{ const float nm_=-mhat; const unsigned h_=cvtpk_s(nm_,0.f)&0xffffu; const unsigned l_=cvtpk_s(nm_-__uint_as_float(h_<<16),0.f)&0xffffu; qxw[1]=(h_|(l_<<16))&mh0; }while(0)
  #define KXF(pr) __builtin_bit_cast(bf16x8,(u32x4){(pr)&mh0,onesm,0u,0u})
  #define BIASMMA(C0,C1,t) do{ const unsigned pr0_=nbp[64*TIDX(t)+r32],pr1_=nbp[64*TIDX(t)+32+r32]; \
    C0=__builtin_amdgcn_mfma_f32_32x32x16_bf16(KXF(pr0_),__builtin_bit_cast(bf16x8,qxw),C0,0,0,0); C1=__builtin_amdgcn_mfma_f32_32x32x16_bf16(KXF(pr1_),__builtin_bit_cast(bf16x8,qxw),C1,0,0,0); }while(0)
  DMA_K(0,0);DMA_V(0,0);DMA_K(1,SLOTB);
  bf16x8 qr[4];
  #pragma unroll
  for(int d0=0;d0<4;++d0)qr[d0]=*reinterpret_cast<const bf16x8*>(&Qw[(long)r32*DM+d0*16+hi*8]);
  float mhat=0.f,l_reg=0.f;f32x16 o[2];o[0]=f32x16{};o[1]=f32x16{};const f32x16 negm=f32x16{};
  const int qrel=wid*QBLK+r32;
  #define CMASK(P0,P1,t) do{ if((t)<4){ cmask(P0,P1,3-(t),qrel,hi); } }while(0)
  bool resc=false;
  #define START(P0,P1) do{ const float rm=rowmax(P0,P1); resc=false; \
    { const float dl=(rm>-3.0e38f)?__builtin_ceilf(rm*16.f)*0.0625f:0.f; mhat=fadd_s(mhat,dl);     \
      _Pragma("unroll") for(int r=0;r<16;++r){P0[r]=fsub_s(P0[r],dl);P1[r]=fsub_s(P1[r],dl);} \
      QX_SET(); } \
    _Pragma("unroll") for(int r=0;r<16;++r)P0[r]=__builtin_amdgcn_exp2f(P0[r]); }while(0)
  #define RESC() do{ if(resc){ asm volatile("s_waitcnt lgkmcnt(0)":::"memory"); \
      _Pragma("unroll") for(int d_=0;d_<2;++d_) _Pragma("unroll") for(int r=0;r<16;++r)o[d_][r]*=wsf[crow(r,hi)]; } }while(0)
  f32x16 pA0,pA1,pB0,pB1;
  int sl_prev=0,sl_cur=0,sl_next=SLOTB;
  #define ROT() do{sl_prev=sl_cur;sl_cur=sl_next;sl_next=(sl_next==(NSLOT-1)*SLOTB)?0:sl_next+SLOTB;}while(0)
  DMA_K(2,2*SLOTB);
  WAIT_BAR(3);
  qkt(pA0,pA1,Kbase,qr,negm,r32,hi);BIASMMA(pA0,pA1,0);asm volatile("s_nop 15\n\ts_nop 7":"+v"(pA0),"+v"(pA1));CMASK(pA0,pA1,0);
  START(pA0,pA1);
  _Pragma("unroll") for(int r=0;r<16;++r)pA1[r]=__builtin_amdgcn_exp2f(pA1[r]);
  WAIT_BAR(0);
  DMA_K(3,0);DMA_V(1,SLOTB);
  ROT();
  kload8(kf,kp0+sl_cur);
  WAIT_BAR(2);
  s16x4 vlo[8],vhi[8]; u32x4 pw0,pw1,pw2,pw3;
  #define PKW(P,B) cvtpk_s(P[B],P[B+1])
  #define PAF(k) __builtin_bit_cast(bf16x8,pw##k)
  #define VFR(i) (bf16x8){vlo[i][0],vlo[i][1],vlo[i][2],vlo[i][3],vhi[i][0],vhi[i][1],vhi[i][2],vhi[i][3]}
  #define PIN(x) asm volatile("":"+v"(x))
  #define MX3(a,b,c) __builtin_fmaxf(__builtin_fmaxf((a),(b)),(c))
  #define GAPA(MF,A0,A1,A2,A3,W0,W1,PW) do{ MF; sacc+=A0; sacc+=A1; sacc+=A2; sacc+=A3; PIN(sacc); W0; W1; PIN(PW); SBAR(); }while(0)
  #define EX(v) __builtin_amdgcn_exp2f(v)
  #define GAPB(MF,X,B) do{ MF; X[B]=EX(X[B]); X[B+1]=EX(X[B+1]); X[B+2]=EX(X[B+2]); X[B+3]=EX(X[B+3]); PIN(X); SBAR(); }while(0)
  #define VRD(i) do{ vlo[i]=vtr(vp_+(((i)>>2)*4096+((i)&3)*1024)); vhi[i]=vtr(vp_+(((i)>>2)*4096+((i)&3)*1024+512)); }while(0)
  #define KRD(G,j) do{ if(G){ kload2(kf,kp0+sl_next,j); SBAR(); } }while(0)
  #define STEP(C0,C1,P0,P1,t,GK,GV,GL) do{ SBAR(); \
    const lds_cptr vp_=vp0+sl_prev; \
    VRD(0); SBAR(); float sacc=(P0[0]+P0[1]); \
    GAPA(C0=__builtin_amdgcn_mfma_f32_32x32x16_bf16(kf[0],qr[0],negm,0,0,0), P0[2],P0[3],P0[4],P0[5],     pw0[0]=PKW(P0,0), pw0[1]=PKW(P0,2), pw0); \
    VRD(4); SBAR(); GAPA(C1=__builtin_amdgcn_mfma_f32_32x32x16_bf16(kf[1],qr[0],negm,0,0,0), P0[6],P0[7],P0[8],P0[9],     pw0[2]=PKW(P0,4), pw0[3]=PKW(P0,6), pw0); \
    VRD(1); SBAR(); GAPA(C0=__builtin_amdgcn_mfma_f32_32x32x16_bf16(kf[2],qr[1],C0,0,0,0),   P0[10],P0[11],P0[12],P0[13], pw1[0]=PKW(P0,8), pw1[1]=PKW(P0,10), pw1); \
    VRD(5); SBAR(); GAPA(C1=__builtin_amdgcn_mfma_f32_32x32x16_bf16(kf[3],qr[1],C1,0,0,0),   P0[14],P0[15],P1[0],P1[1],   pw1[2]=PKW(P0,12),pw1[3]=PKW(P0,14), pw1); \
    VRD(2); SBAR(); GAPA(C0=__builtin_amdgcn_mfma_f32_32x32x16_bf16(kf[4],qr[2],C0,0,0,0),   P1[2],P1[3],P1[4],P1[5],     pw2[0]=PKW(P1,0), pw2[1]=PKW(P1,2), pw2); \
    VRD(6); SBAR(); GAPA(C1=__builtin_amdgcn_mfma_f32_32x32x16_bf16(kf[5],qr[2],C1,0,0,0),   P1[6],P1[7],P1[8],P1[9],     pw2[2]=PKW(P1,4), pw2[3]=PKW(P1,6), pw2); \
    VRD(3); SBAR(); GAPA(C0=__builtin_amdgcn_mfma_f32_32x32x16_bf16(kf[6],qr[3],C0,0,0,0),   P1[10],P1[11],P1[12],P1[13], pw3[0]=PKW(P1,8), pw3[1]=PKW(P1,10), pw3); \
    VRD(7); SBAR(); GAPA(C1=__builtin_amdgcn_mfma_f32_32x32x16_bf16(kf[7],qr[3],C1,0,0,0),   P1[14],P1[15],0.f,0.f,       pw3[2]=PKW(P1,12),pw3[3]=PKW(P1,14), pw3); \
    l_reg+=sacc; \
    if(GK){DMA_K((t)+3,sl_cur);} if(GV){DMA_V((t)+1,sl_next);} \
    BIASMMA(C0,C1,t); CMASK(C0,C1,t); \
    { float a=MX3(C0[0],C0[1],C1[0]),b=MX3(C0[2],C0[3],C1[1]); a=MX3(a,C1[2],C1[3]); \
      _Pragma("unroll") for(int r=4;r<16;r+=4){a=MX3(a,C0[r],C0[r+1]);b=MX3(b,C0[r+2],C0[r+3]);a=MX3(a,C1[r],C1[r+1]);b=MX3(b,C1[r+2],C1[r+3]);} \
      float rm=__builtin_fmaxf(a,b); { auto rr=__builtin_amdgcn_permlane32_swap(__float_as_uint(rm),__float_as_uint(rm),false,false); rm=__builtin_fmaxf(__uint_as_float(rr[0]),__uint_as_float(rr[1])); } \
      resc=false; \
      if(__builtin_expect(__any(rm>(float)THRL),0)){ const float dl=__builtin_fmaxf(__builtin_ceilf(rm*16.f)*0.0625f,0.f); mhat+=dl; QX_SET(); \
        _Pragma("unroll") for(int r=0;r<16;++r){C0[r]-=dl;C1[r]-=dl;} \
        const float f=__builtin_amdgcn_exp2f(-dl); l_reg*=f; if(hi==0)wsf[r32]=f; resc=true; } } \
    SBAR(); \
    GAPB(o[0]=__builtin_amdgcn_mfma_f32_32x32x16_bf16(PAF(0),VFR(0),o[0],0,0,0), C0,0); \
    GAPB(o[1]=__builtin_amdgcn_mfma_f32_32x32x16_bf16(PAF(0),VFR(4),o[1],0,0,0), C0,4); \
    KRD(GL,0); GAPB(o[0]=__builtin_amdgcn_mfma_f32_32x32x16_bf16(PAF(1),VFR(1),o[0],0,0,0), C0,8); \
    KRD(GL,1); GAPB(o[1]=__builtin_amdgcn_mfma_f32_32x32x16_bf16(PAF(1),VFR(5),o[1],0,0,0), C0,12); \
    KRD(GL,2); GAPB(o[0]=__builtin_amdgcn_mfma_f32_32x32x16_bf16(PAF(2),VFR(2),o[0],0,0,0), C1,0); \
    KRD(GL,3); GAPB(o[1]=__builtin_amdgcn_mfma_f32_32x32x16_bf16(PAF(2),VFR(6),o[1],0,0,0), C1,4); \
    GAPB(o[0]=__builtin_amdgcn_mfma_f32_32x32x16_bf16(PAF(3),VFR(3),o[0],0,0,0), C1,8); \
    GAPB(o[1]=__builtin_amdgcn_mfma_f32_32x32x16_bf16(PAF(3),VFR(7),o[1],0,0,0), C1,12); \
    }while(0)
  int t=1;
  for(int it_=0;it_<2&&t+5<NT;++it_,t+=2){
    STEP(pB0,pB1,pA0,pA1,t,true,true,true);     WAIT_BAR(2); RESC(); ROT();
    STEP(pA0,pA1,pB0,pB1,t+1,true,true,true);   WAIT_BAR(2); RESC(); ROT();
  }
  #undef CMASK
  #define CMASK(P0,P1,t) do{}while(0)
  for(;t+5<NT;t+=2){
    STEP(pB0,pB1,pA0,pA1,t,true,true,true);     WAIT_BAR(2); RESC(); ROT();
    STEP(pA0,pA1,pB0,pB1,t+1,true,true,true);   WAIT_BAR(2); RESC(); ROT();
  }
  #undef CMASK
  #define CMASK(P0,P1,t) do{ if((t)<4){ cmask(P0,P1,3-(t),qrel,hi); } }while(0)
  #define ENDW(tt) do{ if((tt)+3<NT){WAIT_BAR(2);} else if((tt)+2<NT){WAIT_BAR(1);} else {WAIT_BAR(0);} }while(0)
  for(;t+1<NT;t+=2){
    STEP(pB0,pB1,pA0,pA1,t,(t+3<NT),(t+1<NT),(t+1<NT));       ENDW(t);   RESC(); ROT();
    STEP(pA0,pA1,pB0,pB1,t+1,(t+4<NT),(t+2<NT),(t+2<NT));     ENDW(t+1); RESC(); ROT();
  }
  STEP(pB0,pB1,pA0,pA1,NT-1,false,false,false); RESC();
  { float sacc=pB0[0]+pB0[1]; _Pragma("unroll") for(int r=2;r<16;++r)sacc+=pB0[r]; _Pragma("unroll") for(int r=0;r<16;++r)sacc+=pB1[r]; l_reg+=sacc;
    pw0=(u32x4){PKW(pB0,0),PKW(pB0,2),PKW(pB0,4),PKW(pB0,6)};pw1=(u32x4){PKW(pB0,8),PKW(pB0,10),PKW(pB0,12),PKW(pB0,14)};pw2=(u32x4){PKW(pB1,0),PKW(pB1,2),PKW(pB1,4),PKW(pB1,6)};pw3=(u32x4){PKW(pB1,8),PKW(pB1,10),PKW(pB1,12),PKW(pB1,14)};
    SBAR(); pv(o,vb0+sl_cur,PAF(0),PAF(1),PAF(2),PAF(3)); }
  #undef PKW
  #undef PAF
  #undef VFR
  #undef PIN
  #undef MX3
  #undef GAPA
  #undef GAPB
  #undef EX
  #undef VRD
  #undef KRD
  #undef STEP
  #undef ENDW
  {auto rr=__builtin_amdgcn_permlane32_swap(__float_as_uint(l_reg),__float_as_uint(l_reg),false,false);l_reg=__uint_as_float(rr[0])+__uint_as_float(rr[1]);}
  if(hi==0)wsf[32+r32]=l_reg;asm volatile("s_waitcnt lgkmcnt(0)":::"memory");
  float rli[16];
  #pragma unroll
  for(int r=0;r<16;++r)rli[r]=__builtin_amdgcn_rcpf(wsf[32+crow(r,hi)]);
  bf16*Ow=O+(rowbase+q0+wid*QBLK)*DM+h*D;
  { bf16*stg=(bf16*)(shm+LDS_OST)+wid*2048;
    #pragma unroll
    for(int r=0;r<16;++r){const int orow=crow(r,hi);
      #pragma unroll
      for(int d0=0;d0<2;++d0)stg[orow*64+d0*32+r32]=__float2bfloat16(o[d0][r]*rli[r]);}
    asm volatile("s_waitcnt lgkmcnt(0)":::"memory");
    #pragma unroll
    for(int i=0;i<4;++i){const int row=i*8+(lane>>3),ch=lane&7; const u32x4 v=*(const u32x4*)(stg+row*64+ch*8); ATTN_STORE16(Ow+(long)row*DM+ch*8,v);} }
  asm volatile("s_waitcnt lgkmcnt(0)\n\ts_barrier":::"memory");
  #undef BIASMMA
  #undef KXF
  #undef QX_SET
  #undef TIDX
  #undef DMA_K
  #undef DMA_V
  #undef CMASK
  #undef START
  #undef RESC
  #undef ROT
}

template<int PITCH> __device__ __forceinline__ void sb_unit(int b,int h,int qb,const bf16*Q,const bf16*__restrict__ K,const bf16*__restrict__ V,bf16*O  ,char*shm){
  int tid_=threadIdx.x; asm volatile("":"+v"(tid_)); const int tid=tid_,lane=tid&63,r32=lane&31,hi=lane>>5; const int wid=__builtin_amdgcn_readfirstlane(tid>>6);
  const long rowbase=(long)b*SEQ; const int q0=qb*QB;
  const bf16*Qw=Q+(rowbase+q0+wid*QBLK)*PITCH+h*D;
  const bf16*Kh=K+rowbase*PITCH+h*D,*Vh=V+rowbase*PITCH+h*D;
  const unsigned lds0=(unsigned)(uintptr_t)shm;
  const bf16*ksrc=Kh+(long)lane*PITCH+wid*8;
  const bf16*vsrc=Vh+(long)(16*(wid&3)+(lane>>2))*PITCH+(wid>>2)*32+(lane&3)*8;
  const unsigned kdst=lds0+LDS_K+wid*1024, vdst=lds0+LDS_V+wid*1024;
  #define SB_DMA(t,slot) do{ glds16(ksrc+(long)(t)*KVBLK*PITCH,(unsigned)__builtin_amdgcn_readfirstlane(kdst+(slot))); glds16(vsrc+(long)(t)*KVBLK*PITCH,(unsigned)__builtin_amdgcn_readfirstlane(vdst+(slot))); }while(0)
  const int vb0=(int)(lds0+LDS_V)+((lane>>4)&1)*32+(lane&3)*8+(4*hi+((lane&15)>>2))*64;
  volatile __attribute__((address_space(3))) unsigned* fl=(volatile __attribute__((address_space(3))) unsigned*)((lds_cptr)shm+LDS_WS);
  const int NT=(q0+QB)/KVBLK; const int qrel=wid*QBLK+r32;
  SB_DMA(NT-1,0);
  bf16x8 qr[4];
  #pragma unroll
  for(int d0=0;d0<4;++d0)qr[d0]=*reinterpret_cast<const bf16x8*>(&Qw[(long)r32*PITCH+d0*16+hi*8]);
  f32x16 o[2];o[0]=f32x16{};o[1]=f32x16{}; const f32x16 zero16=f32x16{};
  float carry=0.f; const float m0=(hi==0)?1.f:0.f;
  int slot=0;
  for(int t=NT-1;t>=0;--t){
    WAIT_BAR(0);
    if(t<NT-1){ const int pb=((t+1)&1)*8; const unsigned a=fl[pb]&fl[pb+1]&fl[pb+2]&fl[pb+3]&fl[pb+4]&fl[pb+5]&fl[pb+6]&fl[pb+7]; if(__builtin_amdgcn_readfirstlane(a)!=0u)break; }
    if(t>0)SB_DMA(t-1,slot^SLOTB);
    f32x16 p0,p1; qkt(p0,p1,shm+LDS_K+slot,qr,zero16,r32,hi);
    if(t>=NT-4){ const int kb=64*(t-(NT-4))+4*hi;
      #pragma unroll
      for(int r=0;r<16;++r){const int kv=kb+(r&3)+8*(r>>2); if(kv>=qrel)p0[r]=-INFINITY; if(kv+32>=qrel)p1[r]=-INFINITY;} }
    f32x16 s0,s1;
    #pragma unroll
    for(int r=0;r<16;++r){ const float z=p0[r]; const float sp=__builtin_fmaxf(z,0.f)+__builtin_amdgcn_logf(1.f+__builtin_amdgcn_exp2f(-__builtin_fabsf(z))); s0[r]=sp; p0[r]=z-sp;
                           const float y=p1[r]; const float sq=__builtin_fmaxf(y,0.f)+__builtin_amdgcn_logf(1.f+__builtin_amdgcn_exp2f(-__builtin_fabsf(y))); s1[r]=sq; p1[r]=y-sq; }
    float lo[8],hv[8];
    #pragma unroll
    for(int i=0;i<8;++i){ const float mine=(i<4)?((s0[4*i]+s0[4*i+1])+(s0[4*i+2]+s0[4*i+3])):((s1[4*i-16]+s1[4*i-15])+(s1[4*i-14]+s1[4*i-13]));
      auto rr=__builtin_amdgcn_permlane32_swap(__float_as_uint(mine),__float_as_uint(mine),false,false); lo[i]=__uint_as_float(rr[0]); hv[i]=__uint_as_float(rr[1]); }
    float sp_=0.f;
    #pragma unroll
    for(int i=7;i>=0;--i){ const float base=carry-(sp_+m0*hv[i]);
      if(i<4){ float a=base; p0[4*i+3]=__builtin_amdgcn_exp2f(p0[4*i+3]+a); a-=s0[4*i+3]; p0[4*i+2]=__builtin_amdgcn_exp2f(p0[4*i+2]+a); a-=s0[4*i+2]; p0[4*i+1]=__builtin_amdgcn_exp2f(p0[4*i+1]+a); a-=s0[4*i+1]; p0[4*i]=__builtin_amdgcn_exp2f(p0[4*i]+a); }
      else   { const int j=4*i-16; float a=base; p1[j+3]=__builtin_amdgcn_exp2f(p1[j+3]+a); a-=s1[j+3]; p1[j+2]=__builtin_amdgcn_exp2f(p1[j+2]+a); a-=s1[j+2]; p1[j+1]=__builtin_amdgcn_exp2f(p1[j+1]+a); a-=s1[j+1]; p1[j]=__builtin_amdgcn_exp2f(p1[j]+a); }
      sp_+=lo[i]+hv[i]; }
    carry-=sp_;
    { u32x4 pw0,pw1,pw2,pw3;
      pw0=(u32x4){cvtpk_s(p0[0],p0[1]),cvtpk_s(p0[2],p0[3]),cvtpk_s(p0[4],p0[5]),cvtpk_s(p0[6],p0[7])}; pw1=(u32x4){cvtpk_s(p0[8],p0[9]),cvtpk_s(p0[10],p0[11]),cvtpk_s(p0[12],p0[13]),cvtpk_s(p0[14],p0[15])};
      pw2=(u32x4){cvtpk_s(p1[0],p1[1]),cvtpk_s(p1[2],p1[3]),cvtpk_s(p1[4],p1[5]),cvtpk_s(p1[6],p1[7])}; pw3=(u32x4){cvtpk_s(p1[8],p1[9]),cvtpk_s(p1[10],p1[11]),cvtpk_s(p1[12],p1[13]),cvtpk_s(p1[14],p1[15])};
      pv(o,vb0+slot,__builtin_bit_cast(bf16x8,pw0),__builtin_bit_cast(bf16x8,pw1),__builtin_bit_cast(bf16x8,pw2),__builtin_bit_cast(bf16x8,pw3)); }
    { const bool done_=__all(carry<-150.f); if(lane==0)fl[(t&1)*8+wid]=done_?1u:0u; }
    slot^=SLOTB;
  }
  asm volatile("s_waitcnt vmcnt(0) lgkmcnt(0)":::"memory");
  bf16*Ow=O+(rowbase+q0+wid*QBLK)*1024+h*D;
  { bf16*stg=(bf16*)(shm+LDS_OST)+wid*2048;
    #pragma unroll
    for(int r=0;r<16;++r){const int orow=crow(r,hi);
      #pragma unroll
      for(int d0=0;d0<2;++d0)stg[orow*64+d0*32+r32]=__float2bfloat16(o[d0][r]);}
    asm volatile("s_waitcnt lgkmcnt(0)":::"memory");
    #pragma unroll
    for(int i=0;i<4;++i){const int row=i*8+(lane>>3),ch=lane&7; const u32x4 v=*(const u32x4*)(stg+row*64+ch*8); ATTN_STORE16(Ow+(long)row*1024+ch*8,v);} }
  asm volatile("s_waitcnt vmcnt(0) lgkmcnt(0)\n\ts_barrier":::"memory");
  #undef SB_DMA
}
constexpr int ATTN_LDS_BYTES=LDS_BYTES;
struct AttnTensors { const bf16* Q; const bf16* K; const bf16* V; bf16* O; const float* logf;   const unsigned* kn;   };
struct AttnUnit { int bh; int qb; };
struct StaticOrder {
  int vcu;
  __device__ __forceinline__ explicit StaticOrder(int grid,int block):vcu((block%8)*(grid/8)+block/8){}
  __device__ __forceinline__ bool next(int i,AttnUnit&u)const{ if(i>=4)return false; const int s=vcu&7; u.bh=vcu>>3; u.qb=(i==0)?s:(i==1)?15-s:(i==2)?16+s:31-s; return true; }
  __device__ __forceinline__ void a_ready(const AttnUnit&)const{}
  __device__ __forceinline__ void done(const AttnUnit&)const{}
};
template<class Sched,int THRL=8> __device__ __forceinline__ void attn_phase(char*lds,const AttnTensors&T,const Sched&S){
  AttnUnit u;
  for(int i=0;S.next(i,u);++i){ S.a_ready(u); attn_unit<THRL>(u.bh/NHEAD,u.bh%NHEAD,u.qb,T.Q,T.K,T.V,T.O,lds,T.logf+(size_t)u.bh*SEQ,T.kn+(size_t)u.bh*256); S.done(u); }
}
#undef SBAR
#undef WAIT_BAR
}
constexpr int NWAVES = 8, NTHREADS = NWAVES * 64;
constexpr int BATCH = 2, SEQ = 8192, D = 1024, M = BATCH * SEQ;
constexpr int S5G = 32, S5H = 16, S5P = 64, S5T = 32  , S5NC = M / S5T  , S5KX = 640  ;
constexpr int SBH = 8, FOXH = 16, HD = 64;
constexpr int EVEN_IN = 2048, ODD_IN = 3088, DFF = 2816, NEXP = 8, DFE = 3584;
constexpr float C2 = 0.125f * 1.4426950408889634f;
constexpr int MOE_CHUNK_PANELS = 68, MOE_MAX_PANELS = 136, MOE_MAX_SLOTS = MOE_MAX_PANELS * 256, MOE_CAP = 16384  ;

constexpr size_t MiB = 1u << 20;
constexpr size_t WS_CTL = 0, CTL_ZERO_BYTES = 1 * MiB;
constexpr size_t WS_WMOE_GU = 1 * MiB;
constexpr size_t WS_WMOE_D = 57 * MiB;
constexpr size_t WS_WIN0 = 85 * MiB;
constexpr size_t WS_WGLU = 89 * MiB;
constexpr size_t WS_WOUT0 = 90 * MiB;
constexpr size_t WS_WGU0 = 92 * MiB;
constexpr size_t WS_WD0 = 103 * MiB;
constexpr size_t WS_WIN1 = 109 * MiB;
constexpr size_t WS_WF1 = 115 * MiB;
constexpr size_t WS_WOUT1 = 116 * MiB;
constexpr size_t WS_S5WA = 118 * MiB;
constexpr size_t WS_S5WC = 126 * MiB;
constexpr size_t WS_XB = 146 * MiB;
constexpr size_t WS_SSP = 178 * MiB;
constexpr size_t WS_META = 182 * MiB;
constexpr size_t WS_LOGF = 183 * MiB;
constexpr size_t WS_QKV0 = 184 * MiB;
constexpr size_t WS_UEXT = 232 * MiB;
constexpr size_t WS_SLOC = 252 * MiB;
constexpr size_t WS_YG = 260 * MiB;
constexpr size_t WS_MIXB = 276 * MiB;
constexpr size_t WS_HID0 = 184 * MiB;
constexpr size_t WS_QKV1 = 184 * MiB;
constexpr size_t WS_XG = 184 * MiB;
constexpr size_t WS_HMOE = 312 * MiB;
constexpr size_t WS_Y = 85 * MiB;
constexpr size_t WS_END = 431 * MiB;
static_assert(WS_XG + (size_t)8 * MOE_CAP * 1024 <= WS_HMOE && WS_HMOE + (size_t)MOE_MAX_SLOTS * DFE <= WS_END && WS_Y + (size_t)MOE_MAX_SLOTS * 1024 * 2 <= WS_XB + 32 * MiB && WS_MIXB + 32 * MiB <= WS_END, "ws map");
constexpr size_t MT_RSTD = 0, MT_TOKE = 65536, MT_TOKP = 131072, MT_TOKG = 262144, MT_TOKSLOT = 393216, MT_RSS = 524288;
constexpr int CW_TMO = 0, CW_CODE = 1, CW_BAR = 4096, CW_CNT = 8192  , CW_QUEUE = 12288  , CW_QUEUE2 = 12352  , CW_KN = 16384  , CW_SS = 32768  ;

constexpr int RING_OFF = 0, RING_BYTES = 131072;
constexpr int LDSCTL_OFF = 133120  , MISC_OFF = LDSCTL_OFF + 320;
constexpr int LDS_BYTES = 147456;

#define GAS __attribute__((address_space(1)))
#define LAS __attribute__((address_space(3)))
typedef unsigned short bf16;
typedef unsigned v4u __attribute__((ext_vector_type(4)));
typedef unsigned v2u __attribute__((ext_vector_type(2)));
typedef float f32x4 __attribute__((ext_vector_type(4)));
typedef short bf16x8 __attribute__((ext_vector_type(8)));
typedef GAS unsigned gu32;
#define RLX_AGENT __ATOMIC_RELAXED, __HIP_MEMORY_SCOPE_AGENT
#define LDS_WAIT() asm volatile("s_waitcnt lgkmcnt(0)" ::: "memory")
#define VM_WAIT() asm volatile("s_waitcnt vmcnt(0)" ::: "memory")
__device__ __forceinline__ unsigned f2bf(float f) { unsigned u = __builtin_bit_cast(unsigned, f); return (u + 0x7fffu + ((u >> 16) & 1u)) >> 16; }
__device__ __forceinline__ unsigned pk2(float lo, float hi) { return f2bf(lo) | (f2bf(hi) << 16); }
__device__ __forceinline__ float bflo(unsigned w) { return __uint_as_float(w << 16); }
__device__ __forceinline__ float bfhi(unsigned w) { return __uint_as_float(w & 0xffff0000u); }

#define XB_TMO      128
#define XB_XCNT(j)  (256  + 64 * (j))
#define XB_XSUB(j)  (1280 + 64 * (j))
#define XB_XGEN(j)  (2304 + 64 * (j))
#define XB_TOP      3328
#define XB_TOPGEN   3392
#define XCD_BAR_WORDS 3456
#define XB_SPIN_CAP (1u << 18)
__device__ __forceinline__ unsigned xb_ld(unsigned* p)              { return __hip_atomic_load(p, __ATOMIC_RELAXED, __HIP_MEMORY_SCOPE_AGENT); }
__device__ __forceinline__ unsigned xb_add(unsigned* p, unsigned v) { return __hip_atomic_fetch_add(p, v, __ATOMIC_RELAXED, __HIP_MEMORY_SCOPE_AGENT); }
__device__ __forceinline__ unsigned xb_xcc_id() { return (unsigned)__builtin_amdgcn_s_getreg((3 << 11) | 20) & 0xFu; }
#define XB_SPIN(cond, bar) do { unsigned _sp = 0; while (cond) { __builtin_amdgcn_s_sleep(1); \
    if ((++_sp & 255u) == 0u) { if (xb_ld(&(bar)[XB_TMO])) break; if (_sp > XB_SPIN_CAP) { atomicAdd(&(bar)[XB_TMO], 1u); break; } } } } while (0)
struct XcdBarrier { unsigned* bar; unsigned x; volatile LAS unsigned* st; };
__device__ __forceinline__ XcdBarrier xcd_barrier_post(unsigned* bar, volatile LAS unsigned* st) {
    XcdBarrier b; b.bar = bar; b.x = xb_xcc_id(); b.st = st;
    if (threadIdx.x == 0) (void)xb_add(&bar[XB_XCNT(b.x)], 1u);
    return b;
}
__device__ __forceinline__ void xcd_barrier_complete(unsigned* bar, unsigned x, unsigned& nloc, unsigned& nx) {
    const unsigned G = gridDim.x * gridDim.y * gridDim.z;
    unsigned sum, cnt, mine, sp = 0u;
    for (;;) {
        sum = 0u; cnt = 0u; mine = 0u;
#pragma unroll
        for (unsigned j = 0; j < 16; ++j) { const unsigned c = xb_ld(&bar[XB_XCNT(j)]); sum += c; cnt += (c > 0u) ? 1u : 0u; mine = (j == x) ? c : mine; }
        if (sum == G) break;
        __builtin_amdgcn_s_sleep(1);
        if ((++sp & 255u) == 0u) { if (xb_ld(&bar[XB_TMO])) break; if (sp > XB_SPIN_CAP) { atomicAdd(&bar[XB_TMO], 1u); break; } }
    }
    nloc = mine > 0u ? mine : 1u; nx = cnt > 0u ? cnt : 1u;
}
__device__ __forceinline__ void xcd_barrier(const XcdBarrier& b) {
    asm volatile("s_waitcnt vmcnt(0)" ::: "memory");
    __syncthreads();
    if (threadIdx.x == 0) {
        unsigned* bar = b.bar;
        __builtin_amdgcn_s_waitcnt(0);
        unsigned nloc = b.st[0], nx = b.st[1];
        if (nloc == 0u) { xcd_barrier_complete(bar, b.x, nloc, nx); b.st[0] = nloc; b.st[1] = nx; }
        const unsigned old = xb_add(&bar[XB_XSUB(b.x)], 1u);
        const unsigned gen = old / nloc;
        if (old + 1u == (gen + 1u) * nloc) {
            __builtin_amdgcn_fence(__ATOMIC_RELEASE, "agent");
            asm volatile("s_waitcnt vmcnt(0)" ::: "memory");
            const unsigned og = xb_add(&bar[XB_TOP], 1u);
            const unsigned tg = og / nx;
            if (og + 1u == (tg + 1u) * nx) xb_add(&bar[XB_TOPGEN], 1u);
            else XB_SPIN(xb_ld(&bar[XB_TOPGEN]) == tg, bar);
            __builtin_amdgcn_fence(__ATOMIC_ACQUIRE, "agent");
            xb_add(&bar[XB_XGEN(b.x)], 1u);
            asm volatile("s_waitcnt vmcnt(0)" ::: "memory");
        } else {
            XB_SPIN(xb_ld(&bar[XB_XGEN(b.x)]) == gen, bar);
            __builtin_amdgcn_fence(__ATOMIC_ACQUIRE, "agent");
            asm volatile("s_waitcnt vmcnt(0)" ::: "memory");
        }
    }
    __syncthreads();
}

__device__ __forceinline__ float wave_sum(float v) {
#pragma unroll
    for (int o = 1; o < 64; o <<= 1) v += __shfl_xor(v, o);
    return v;
}
constexpr int XP = 65, XSCR_BYTES = 64 * XP * 4;
__device__ __forceinline__ unsigned cvtpk(float lo, float hi) { unsigned r; asm volatile("v_cvt_pk_bf16_f32 %0, %1, %2" : "=v"(r) : "v"(lo), "v"(hi)); return r; }
__device__ __forceinline__ void p0_transpose_item(const float* W, int ldw, int k0, int n0, const float* gs, bf16* dst, int ldd, LAS float* scr, int lane) {
    const int lr = lane >> 4, lc = (lane & 15) * 4;
    const float* src = W + (size_t)(k0 + lr) * ldw + n0 + lc;
    f32x4 v[16];
#pragma unroll
    for (int i = 0; i < 16; ++i) v[i] = *(const GAS f32x4*)(src + (size_t)(4 * i) * ldw);
    if (gs) {
#pragma unroll
        for (int i = 0; i < 16; ++i) v[i] = v[i] * gs[k0 + 4 * i + lr]; }
#pragma unroll
    for (int i = 0; i < 16; ++i) { LAS float* p = scr + (4 * i + lr) * XP + lc; p[0] = v[i][0]; p[1] = v[i][1]; p[2] = v[i][2]; p[3] = v[i][3]; }
    LDS_WAIT(); asm volatile("" ::: "memory");
    const int c = lane & 7, nn = lane >> 3;
#pragma unroll
    for (int j = 0; j < 8; ++j) { const int n = nn + 8 * j; const LAS float* sp = scr + (8 * c) * XP + n;
        v4u o; o.x = cvtpk(sp[0 * XP], sp[1 * XP]); o.y = cvtpk(sp[2 * XP], sp[3 * XP]); o.z = cvtpk(sp[4 * XP], sp[5 * XP]); o.w = cvtpk(sp[6 * XP], sp[7 * XP]);
        *(GAS v4u*)(dst + (size_t)n * ldd + k0 + 8 * c) = o; }
    LDS_WAIT(); asm volatile("" ::: "memory");
}
struct XTile { const float* src; const float* gs; unsigned char* dst; int ldw, ldd, k0; };
__device__ __forceinline__ XTile xtile_fp8(int item, const float* W, int ldw, int N, const float* gs, unsigned char* dst, int ldd, int mode, int lane) {
    const int nblk = N / 64, kb = item / nblk, nb = item % nblk, n0 = 64 * nb, k0 = 64 * kb;
    const int row = mode == 0 ? n0 : ((n0 >> 7) * 256 + (n0 & 127) + (mode == 2 ? 128 : 0));
    XTile t; t.src = W + (size_t)(k0 + (lane >> 4)) * ldw + n0 + (lane & 15) * 4; t.gs = gs; t.dst = dst + (size_t)row * ldd; t.ldw = ldw; t.ldd = ldd; t.k0 = k0; return t;
}
__device__ __forceinline__ void xtile_load(const XTile& t, f32x4 (&v)[16]) {
#pragma unroll
    for (int i = 0; i < 16; ++i) v[i] = *(const GAS f32x4*)(t.src + (size_t)(4 * i) * t.ldw);
}
__device__ __forceinline__ void xtile_finish_fp8(const XTile& t, f32x4 (&v)[16], float wscale, LAS float* scr, int lane) {
    const int lr = lane >> 4, lc = (lane & 15) * 4;
#pragma unroll
    for (int i = 0; i < 16; ++i) v[i] = v[i] * (t.gs ? t.gs[t.k0 + 4 * i + lr] * wscale : wscale);
#pragma unroll
    for (int i = 0; i < 16; ++i) { LAS float* p = scr + (4 * i + lr) * XP + lc; p[0] = v[i][0]; p[1] = v[i][1]; p[2] = v[i][2]; p[3] = v[i][3]; }
    LDS_WAIT(); asm volatile("" ::: "memory");
    const int c = lane & 3, nn = lane >> 2;
#pragma unroll
    for (int j = 0; j < 4; ++j) { const int n = nn + 16 * j; const LAS float* sp = scr + (16 * c) * XP + n;
        v4u o; o.x = pg8::pk_fp8x4(sp[0 * XP], sp[1 * XP], sp[2 * XP], sp[3 * XP]); o.y = pg8::pk_fp8x4(sp[4 * XP], sp[5 * XP], sp[6 * XP], sp[7 * XP]);
        o.z = pg8::pk_fp8x4(sp[8 * XP], sp[9 * XP], sp[10 * XP], sp[11 * XP]); o.w = pg8::pk_fp8x4(sp[12 * XP], sp[13 * XP], sp[14 * XP], sp[15 * XP]);
        *(GAS v4u*)(t.dst + (size_t)n * t.ldd + t.k0 + 16 * c) = o; }
    LDS_WAIT(); asm volatile("" ::: "memory");
}
__device__ __forceinline__ void xpose_mat(int item, const float* W, int ldw, int N, const float* gs, bf16* dst, int ldd, int mode, LAS float* scr, int lane) {
    const int nblk = N / 64, kb = item / nblk, nb = item % nblk, n0 = 64 * nb;
    const int row = mode == 0 ? n0 : ((n0 >> 7) * 256 + (n0 & 127) + (mode == 2 ? 128 : 0));
    p0_transpose_item(W, ldw, 64 * kb, n0, gs, dst + (size_t)row * ldd, ldd, scr, lane);
}

struct Args { const float* in[28]; float* out; unsigned char* ws; };

__device__ __forceinline__ void s5_tables(const Args& a, int g, int q, LAS unsigned char* lds, int tid) {
    LAS float* POWr = (LAS float*)lds;
    LAS float* POWi = POWr + 33 * 64;
    LAS float* BBr = POWi + 33 * 64;
    LAS float* BBi = BBr + 1024;
    LAS float* CCr = BBi + 1024;
    LAS float* CCi = CCr + 1024;
    LAS float* KT = CCi + 1024;
    LAS float* DD = KT + 2048;
    const float* a_re = a.in[3]; const float* a_im = a.in[4]; const float* b_re = a.in[5]; const float* b_im = a.in[6];
    const float* c_re = a.in[7]; const float* c_im = a.in[8]; const float* dsk = a.in[9]; const float* log_step = a.in[10];
    const float step = expf(log_step[g]);
    __syncthreads();
    for (int e = tid; e < 33 * 64; e += NTHREADS) { const int n = e >> 6, p = e & 63; const float lr = a_re[g * 64 + p], li = a_im[g * 64 + p];
        const float mag = expf((float)n * step * lr); float sn, cs; sincosf((float)n * (step * li), &sn, &cs); POWr[e] = mag * cs; POWi[e] = mag * sn; }
    for (int e = tid; e < 1024; e += NTHREADS) { const int p = e >> 4, h = e & 15; const float lr = a_re[g * 64 + p], li = a_im[g * 64 + p];
        const float er = expf(lr * step); float sn, cs; sincosf(li * step, &sn, &cs); const float nr = er * cs - 1.f, ni = er * sn, den = lr * lr + li * li;
        const float fr = (nr * lr + ni * li) / den, fi = (ni * lr - nr * li) / den;
        const float br = b_re[(g * 64 + p) * 16 + h], bi = b_im[(g * 64 + p) * 16 + h];
        BBr[e] = fr * br - fi * bi; BBi[e] = fr * bi + fi * br;
        CCr[e] = c_re[g * 1024 + e]; CCi[e] = c_im[g * 1024 + e]; }
    if (tid < 16) DD[tid] = dsk[g * 16 + tid];
    __syncthreads();
    for (int e = tid; e < 2048; e += NTHREADS) { const int tau = e >> 6, hl = (e >> 4) & 3, hi = e & 15, ho = 4 * q + hl; float sacc = 0.f;
        for (int p = 0; p < 64; ++p) { const float cr = CCr[ho * 64 + p], ci = CCi[ho * 64 + p], pr = POWr[tau * 64 + p], pi = POWi[tau * 64 + p];
            const float xr = cr * pr - ci * pi, xi = cr * pi + ci * pr; sacc += xr * BBr[p * 16 + hi] - xi * BBi[p * 16 + hi]; }
        if (tau == 0 && ho == hi) sacc += DD[ho];
        KT[e] = sacc; }
    __syncthreads();
    bf16* WA = (bf16*)(a.ws + WS_S5WA) + (size_t)g * 256 * 512;
    for (int pc = tid; pc < 64 * 64; pc += NTHREADS) { const int p = pc >> 6, k0 = (pc & 63) * 8; v4u o = (v4u){0u, 0u, 0u, 0u};
        if (q < 2) { const int j = k0 >> 4, h0 = k0 & 15; const float pr = POWr[(31 - j) * 64 + p], pi = POWi[(31 - j) * 64 + p]; float v[8];
#pragma unroll
            for (int w = 0; w < 8; ++w) { const float br = BBr[p * 16 + h0 + w], bi = BBi[p * 16 + h0 + w]; v[w] = (q == 0) ? (pr * br - pi * bi) : (pr * bi + pi * br); }
            o.x = cvtpk(v[0], v[1]); o.y = cvtpk(v[2], v[3]); o.z = cvtpk(v[4], v[5]); o.w = cvtpk(v[6], v[7]); }
        *(GAS v4u*)(WA + (size_t)(64 * q + p) * 512 + k0) = o; }
    bf16* WC = (bf16*)(a.ws + WS_S5WC) + (size_t)g * 512 * 640;
    for (int pc = tid; pc < 128 * 80; pc += NTHREADS) { const int rl = pc / 80, k0 = (pc % 80) * 8, i = rl >> 2, hl = rl & 3, ho = 4 * q + hl; float v[8];
        if (k0 < 512) { const int j = k0 >> 4, h0 = k0 & 15;
#pragma unroll
            for (int w = 0; w < 8; ++w) v[w] = (j <= i) ? KT[((i - j) * 4 + hl) * 16 + h0 + w] : 0.f; }
        else { const int p0 = (k0 - 512) & 63; const bool im = k0 >= 576;
#pragma unroll
            for (int w = 0; w < 8; ++w) { const int p = p0 + w; const float cr = CCr[ho * 64 + p], ci = CCi[ho * 64 + p], pr = POWr[(i + 1) * 64 + p], pi = POWi[(i + 1) * 64 + p];
                v[w] = im ? -(cr * pi + ci * pr) : (cr * pr - ci * pi); } }
        v4u o; o.x = cvtpk(v[0], v[1]); o.y = cvtpk(v[2], v[3]); o.z = cvtpk(v[4], v[5]); o.w = cvtpk(v[6], v[7]);
        *(GAS v4u*)(WC + (size_t)(i * 16 + ho) * 640 + k0) = o; }
    __syncthreads();
}

constexpr int MOE_XITEMS = 24 * 896;
__device__ __forceinline__ XTile moe_xtile(const Args& a, int r, int lane) {
    unsigned char* ws = a.ws;
    const int mat = r / 896, e = mat / 3, which = mat % 3; r -= mat * 896;
    if (which == 0) return xtile_fp8(r, a.in[24] + (size_t)e * D * DFE, DFE, DFE, a.in[22], ws + WS_WMOE_GU + (size_t)e * 7168 * 1024, D, 1, lane);
    if (which == 1) return xtile_fp8(r, a.in[25] + (size_t)e * D * DFE, DFE, DFE, a.in[22], ws + WS_WMOE_GU + (size_t)e * 7168 * 1024, D, 2, lane);
    return xtile_fp8(r, a.in[26] + (size_t)e * DFE * D, D, D, nullptr, ws + WS_WMOE_D + (size_t)e * 1024 * 3584, DFE, 0, lane);
}
__device__ __forceinline__ void p0_prologue(const Args& a, LAS unsigned char* lds, int tid, int lane, int wave, int vcu, int G) {
    for (int it = vcu; it < 4 * S5G; it += G) s5_tables(a, it >> 2, it & 3, lds, tid);
    LAS float* scr = (LAS float*)(lds + wave * XSCR_BYTES);
    const int gw = vcu * NWAVES + wave, NGW = G * NWAVES;
    constexpr int I_IN0 = 16 * 32, I_GLU = 8 * 8, I_OUT = 16 * 16, I_GU0 = 16 * 44, I_D0 = 44 * 16, I_IN1 = 16 * 48, I_MOE = 896;
    constexpr int NITEMS = I_IN0 + I_GLU + I_OUT + 2 * I_GU0 + I_D0 + I_IN1 + I_OUT;
    unsigned char* ws = a.ws;
    for (int it = NITEMS - 1 - gw; it >= 0; it -= NGW) {
        int r = it;
        if (r < I_IN0) { xpose_mat(r, a.in[2], EVEN_IN, EVEN_IN, a.in[1], (bf16*)(ws + WS_WIN0), D, 0, scr, lane); continue; } r -= I_IN0;
        if (r < I_GLU) { xpose_mat(r, a.in[11], 512, 512, nullptr, (bf16*)(ws + WS_WGLU), 512, 0, scr, lane); continue; } r -= I_GLU;
        if (r < I_OUT) { xpose_mat(r, a.in[13], D, D, nullptr, (bf16*)(ws + WS_WOUT0), D, 0, scr, lane); continue; } r -= I_OUT;
        if (r < I_GU0) { xpose_mat(r, a.in[15], DFF, DFF, a.in[14], (bf16*)(ws + WS_WGU0), D, 1, scr, lane); continue; } r -= I_GU0;
        if (r < I_GU0) { xpose_mat(r, a.in[16], DFF, DFF, a.in[14], (bf16*)(ws + WS_WGU0), D, 2, scr, lane); continue; } r -= I_GU0;
        if (r < I_D0) { xpose_mat(r, a.in[17], D, D, nullptr, (bf16*)(ws + WS_WD0), DFF, 0, scr, lane); continue; } r -= I_D0;
        if (r < I_IN1) { xpose_mat(r, a.in[19], ODD_IN, 3072, a.in[18], (bf16*)(ws + WS_WIN1), D, 0, scr, lane); continue; } r -= I_IN1;
        xpose_mat(r, a.in[21], D, D, nullptr, (bf16*)(ws + WS_WOUT1), D, 0, scr, lane);
    }
    { const int gt = vcu * NTHREADS + tid; if (gt < 16 * 1024) { const int h = gt >> 10, k = gt & 1023; ((bf16*)(ws + WS_WF1))[gt] = (bf16)f2bf(a.in[19][(size_t)k * ODD_IN + 3072 + h] * a.in[18][k]); } }
    float* ss0 = (float*)(ws + WS_SSP);
    f32x4 xnx[4];
    if (gw < M) {
#pragma unroll
        for (int j = 0; j < 4; ++j) xnx[j] = ((const GAS f32x4*)(a.in[0] + (size_t)gw * D) + lane)[64 * j]; }
    for (int m = gw; m < M; m += NGW) {
        GAS v2u* o8 = (GAS v2u*)((bf16*)(ws + WS_XB) + (size_t)m * D) + lane; float s = 0.f; f32x4 xc[4];
#pragma unroll
        for (int j = 0; j < 4; ++j) xc[j] = xnx[j];
        if (m + NGW < M) {
#pragma unroll
            for (int j = 0; j < 4; ++j) xnx[j] = ((const GAS f32x4*)(a.in[0] + (size_t)(m + NGW) * D) + lane)[64 * j]; }
#pragma unroll
        for (int j = 0; j < 4; ++j) { const f32x4 v = xc[j]; s += (v.x * v.x + v.y * v.y) + (v.z * v.z + v.w * v.w); v2u w; w.x = cvtpk(v.x, v.y); w.y = cvtpk(v.z, v.w); o8[64 * j] = w; }
        s = wave_sum(s); if (lane < 16) ss0[(size_t)m * 16 + lane] = (lane == 0) ? s : 0.f;
    }
}

__device__ __forceinline__ void s5_scan(const Args& a, int gt  ) {
    if (gt >= BATCH * S5G * S5P) return;
    const int b = gt / (S5G * S5P), g = (gt / S5P) % S5G, p = gt % S5P;
    const float step = expf(a.in[10][g]); const float lr = a.in[3][g * 64 + p], li = a.in[4][g * 64 + p];
    const float mag = expf((float)S5T * step * lr); float sn, cs; sincosf((float)S5T * (step * li), &sn, &cs); const float ar = mag * cs, ai = mag * sn;
    const float* sl = (const float*)(a.ws + WS_SLOC) + ((size_t)g * S5NC + b * 256) * 128 + p;
    bf16* ue = (bf16*)(a.ws + WS_UEXT) + ((size_t)g * S5NC + b * 256) * S5KX + 512 + p;
    float sr = 0.f, si = 0.f;
#pragma unroll 8
    for (int c = 0; c < 256; ++c) {
        ue[(size_t)c * S5KX] = (bf16)f2bf(sr); ue[(size_t)c * S5KX + 64] = (bf16)f2bf(si);
        const float lr_ = sl[(size_t)c * 128], li_ = sl[(size_t)c * 128 + 64];
        const float nr = ar * sr - ai * si + lr_, ni = ar * si + ai * sr + li_; sr = nr; si = ni;
    }
}

__device__ __forceinline__ float softplus2(float z) { return fmaxf(z, 0.f) + __builtin_amdgcn_logf(1.0f + __builtin_amdgcn_exp2f(-fabsf(z))); }
__device__ __forceinline__ void stage_kv32(const bf16* kp, const bf16* vp, size_t pitch, LAS float* sK, LAS float* sV, int tid) {
    const int r = tid >> 4, c = (tid & 15) * 4;
    const v2u kw = *(const v2u*)(kp + (size_t)r * pitch + c), vw = *(const v2u*)(vp + (size_t)r * pitch + c);
    *(LAS f32x4*)(sK + r * 64 + c) = (f32x4){bflo(kw.x), bfhi(kw.x), bflo(kw.y), bfhi(kw.y)};
    *(LAS f32x4*)(sV + r * 64 + c) = (f32x4){bflo(vw.x), bfhi(vw.x), bflo(vw.y), bfhi(vw.y)};
}
__device__ __forceinline__ void sb_simple_unit(const bf16* qkv  , bf16* mix  , int b, int h, int blk, LAS unsigned char* lds, int tid) {
    const int lane = tid & 63, wave_ = tid >> 6;
    LAS float* sK = (LAS float*)lds; LAS float* sV = sK + 32 * 64;
    const int t = blk * 512 + tid; const size_t rb = (size_t)b * SEQ;
    float q[HD], acc[HD];
    { const v4u* qp = (const v4u*)(qkv + (rb + t) * 1536 + h * HD);
#pragma unroll
      for (int i = 0; i < 8; ++i) { const v4u w = qp[i]; q[8 * i] = bflo(w.x); q[8 * i + 1] = bfhi(w.x); q[8 * i + 2] = bflo(w.y); q[8 * i + 3] = bfhi(w.y); q[8 * i + 4] = bflo(w.z); q[8 * i + 5] = bfhi(w.z); q[8 * i + 6] = bflo(w.w); q[8 * i + 7] = bfhi(w.w); }
#pragma unroll
      for (int i = 0; i < HD; ++i) acc[i] = 0.f; }
    float carry = 0.f;
    for (int c0 = blk * 512 + 480; c0 >= 0; c0 -= 32) {
        __syncthreads();
        stage_kv32(qkv + (rb + c0) * 1536 + 512 + h * HD, qkv + (rb + c0) * 1536 + 1024 + h * HD, 1536, sK, sV, tid);
        __syncthreads();
        for (int r = 31; r >= 0; --r) { const int s = c0 + r;
            if (s < t) { float z = 0.f;
#pragma unroll
                for (int i = 0; i < HD; ++i) z = fmaf(q[i], sK[r * 64 + i], z);
                const float sp = softplus2(z); const float w = __builtin_amdgcn_exp2f(z - sp + carry); carry -= sp;
#pragma unroll
                for (int i = 0; i < HD; ++i) acc[i] = fmaf(w, sV[r * 64 + i], acc[i]); } }
        { LAS unsigned* fl = (LAS unsigned*)(lds + 16384); if (lane == 0) fl[wave_] = __all(carry < -150.f) ? 1u : 0u; __syncthreads();
          if ((fl[0] & fl[1] & fl[2] & fl[3] & fl[4] & fl[5] & fl[6] & fl[7]) != 0u) break; }
    }
    v4u* op = (v4u*)(mix + (rb + t) * 1024 + 512 + h * HD);
#pragma unroll
    for (int i = 0; i < 8; ++i) { v4u w; w.x = pk2(acc[8 * i], acc[8 * i + 1]); w.y = pk2(acc[8 * i + 2], acc[8 * i + 3]); w.z = pk2(acc[8 * i + 4], acc[8 * i + 5]); w.w = pk2(acc[8 * i + 6], acc[8 * i + 7]); op[i] = w; }
}
__device__ __forceinline__ void fgate_rows16(const bf16* xb, const bf16* wf, const float* ss, const float* bfv, float* logf, int r0, int lane) {
    const int fr = lane & 15, fq = lane >> 4;
    const bf16x8* ap = (const bf16x8*)(xb + (size_t)(r0 + fr) * D + fq * 8);
    const bf16x8* bp = (const bf16x8*)(wf + (size_t)fr * D + fq * 8);
    f32x4 acc0 = (f32x4){0.f, 0.f, 0.f, 0.f}, acc1 = (f32x4){0.f, 0.f, 0.f, 0.f};
#pragma unroll
    for (int half = 0; half < 2; ++half) {
        bf16x8 av[16], bv[16];
#pragma unroll
        for (int kk = 0; kk < 16; ++kk) { av[kk] = ap[(half * 16 + kk) * 4]; bv[kk] = bp[(half * 16 + kk) * 4]; }
#pragma unroll
        for (int kk = 0; kk < 16; kk += 2) { acc0 = __builtin_amdgcn_mfma_f32_16x16x32_bf16(av[kk], bv[kk], acc0, 0, 0, 0); acc1 = __builtin_amdgcn_mfma_f32_16x16x32_bf16(av[kk + 1], bv[kk + 1], acc1, 0, 0, 0); }
    }
    const f32x4 acc = acc0 + acc1;
    const float bias = bfv[fr];
    float rsq[4];
#pragma unroll
    for (int j = 0; j < 4; ++j) rsq[j] = pg8::rstd16(ss, r0 + fq * 4 + j);
#pragma unroll
    for (int j = 0; j < 4; ++j) { const int row = r0 + fq * 4 + j;
        const float z = acc[j] * rsq[j] + bias;
        const float lf = -(fmaxf(-z, 0.f) + log1pf(expf(-fabsf(z)))) * 1.4426950408889634f;
        const int b = row >> 13, t = row & 8191; logf[((size_t)b * FOXH + fr) * SEQ + t] = lf; }
}

struct MoeOrder {
    pg8::StaticOrder S; int lo; int pref[NEXP + 1]; bool cap_rows;
    __device__ __forceinline__ bool next(int i, pg8::Unit& u) const {
        if (!S.next(i, u)) return false;
        u.pm += lo; int e = 0, pe = 0;
#pragma unroll
        for (int k = 1; k < NEXP; ++k) { const bool ge = u.pm >= pref[k]; e += ge ? 1 : 0; pe = ge ? pref[k] : pe; }
        u.zb = e; u.pa = cap_rows ? e * (MOE_CAP / 256) + (u.pm - pe) : u.pm; return true;
    }
    __device__ __forceinline__ void a_ready(const pg8::Unit&) const {}
    __device__ __forceinline__ void done(const pg8::Unit&) const {}
};

__global__ void __launch_bounds__(NTHREADS, 2) mk_fwd(Args args) {
    extern __shared__ __attribute__((aligned(16))) unsigned char lds_raw[];
    LAS unsigned char* lds = (LAS unsigned char*)lds_raw;
    volatile LAS unsigned* MISC = (volatile LAS unsigned*)(lds + MISC_OFF);
    const int tid = threadIdx.x, lane = tid & 63, wave = __builtin_amdgcn_readfirstlane(tid >> 6);
    const int G = gridDim.x; const int bx = blockIdx.x; const int vcu = (G % 8 == 0) ? (bx % 8) * (G / 8) + bx / 8 : bx;
    unsigned char* ws = args.ws;
    gu32* ctl = (gu32*)(ws + WS_CTL);
    for (int u = tid; u < (LDS_BYTES - LDSCTL_OFF) / 4; u += NTHREADS) ((LAS unsigned*)(lds + LDSCTL_OFF))[u] = 0u;
    __syncthreads();
    XcdBarrier bar = xcd_barrier_post((unsigned*)(ctl + CW_BAR), MISC + 8);
    const int gw = vcu * NWAVES + wave, NGW = G * NWAVES;
    float* SS = (float*)(ws + WS_SSP);
    float* X = args.out;
    bf16* XB = (bf16*)(ws + WS_XB);
#define GRID_BAR() xcd_barrier(bar)
#define GEMM_PHASE(EPI, SCHED, lds_, g_, S_, E_) pg8::gemm_phase<EPI, SCHED, true, true>(lds_, g_, S_, E_)

    p0_prologue(args, lds, tid, lane, wave, vcu, G);
    GRID_BAR();
    { pg8::Gemm g{XB, (const bf16*)(ws + WS_WIN0), D, D, D, 0, 0}; pg8::StaticOrder S; S.init(M, EVEN_IN, 1, G, bx);
      pg8::EpiInProj0 E{SS, (bf16*)(ws + WS_UEXT), (bf16*)(ws + WS_QKV0), C2};
      GEMM_PHASE(pg8::EpiInProj0, pg8::StaticOrder, lds + RING_OFF, g, S, E); }
    GRID_BAR();
#define SB_PULL_ONE(more_) do { if (tid == 0) MISC[17] = __hip_atomic_fetch_add(ctl + CW_QUEUE2, 1u, RLX_AGENT); __syncthreads(); const unsigned uq_ = __builtin_amdgcn_readfirstlane(MISC[17]); __syncthreads(); \
        more_ = uq_ < (unsigned)(BATCH * SBH * 32); if (more_) { const int bh_ = (int)(uq_ >> 5), qb_ = (int)(uq_ & 31u); \
            attn_body::sb_unit<1536>(bh_ >> 3, bh_ & 7, qb_, (const attn_body::bf16*)(ws + WS_QKV0), (const attn_body::bf16*)(ws + WS_QKV0) + 512, (const attn_body::bf16*)(ws + WS_QKV0) + 1024, (attn_body::bf16*)(ws + WS_MIXB) + 512, (char*)lds_raw + RING_OFF); } } while (0)
    bool sb_more = true;
    { pg8::Gemm g{(const bf16*)(ws + WS_UEXT), (const bf16*)(ws + WS_S5WA), S5KX, 512, 512, (size_t)S5NC * S5KX * 2, (size_t)256 * 512 * 2}; pg8::StaticOrder S; S.init(S5NC, 256, S5G, G, bx);
      pg8::EpiS5State E{(float*)(ws + WS_SLOC)};
      GEMM_PHASE(pg8::EpiS5State, pg8::StaticOrder, lds + RING_OFF, g, S, E);
      if (bx >= S.nwg) SB_PULL_ONE(sb_more); }
    GRID_BAR();
    s5_scan(args, vcu * NTHREADS + tid);
    if (vcu * NTHREADS >= BATCH * S5G * S5P) SB_PULL_ONE(sb_more);
    GRID_BAR();
    { pg8::Gemm g{(const bf16*)(ws + WS_UEXT), (const bf16*)(ws + WS_S5WC), S5KX, S5KX, S5KX, (size_t)S5NC * S5KX * 2, (size_t)512 * S5KX * 2}; pg8::StaticOrder S; S.init(S5NC, 512, S5G, G, bx);
      pg8::EpiS5Y E{(bf16*)(ws + WS_YG)};
      GEMM_PHASE(pg8::EpiS5Y, pg8::StaticOrder, lds + RING_OFF, g, S, E);
      if (bx >= S.nwg) SB_PULL_ONE(sb_more); }
    GRID_BAR();
    { pg8::Gemm g{(const bf16*)(ws + WS_YG), (const bf16*)(ws + WS_WGLU), 512, 512, 512, 0, 0}; pg8::StaticOrder S; S.init(M, 512, 1, G, bx);
      pg8::EpiGlu E{(const bf16*)(ws + WS_YG), args.in[12], (bf16*)(ws + WS_MIXB)};
      GEMM_PHASE(pg8::EpiGlu, pg8::StaticOrder, lds + RING_OFF, g, S, E); }
    __syncthreads();
    sb_more = true;
#pragma unroll 1
    while (sb_more) SB_PULL_ONE(sb_more);
    GRID_BAR();
#undef SB_PULL_ONE
    { pg8::Gemm g{(const bf16*)(ws + WS_MIXB), (const bf16*)(ws + WS_WOUT0), D, D, D, 0, 0}; pg8::StaticOrder S; S.init(M, D, 1, G, bx);
      pg8::EpiResid E{args.in[0], X, XB, SS + 16 * M};
      GEMM_PHASE(pg8::EpiResid, pg8::StaticOrder, lds + RING_OFF, g, S, E); }
    GRID_BAR();
    { pg8::Gemm g{XB, (const bf16*)(ws + WS_WGU0), D, D, D, 0, 0}; pg8::StaticOrder S; S.init(M, 2 * DFF, 1, G, bx);
      pg8::EpiSwiGlu<true> E{SS + 16 * M, (bf16*)(ws + WS_HID0), DFF};
      GEMM_PHASE(pg8::EpiSwiGlu<true>, pg8::StaticOrder, lds + RING_OFF, g, S, E); }
    GRID_BAR();
    { pg8::Gemm g{(const bf16*)(ws + WS_HID0), (const bf16*)(ws + WS_WD0), DFF, DFF, DFF, 0, 0}; pg8::StaticOrder S; S.init(M, D, 1, G, bx);
      pg8::EpiResid E{X, X, XB, SS + 32 * M};
      GEMM_PHASE(pg8::EpiResid, pg8::StaticOrder, lds + RING_OFF, g, S, E); }
    GRID_BAR();
    { pg8::Gemm g{XB, (const bf16*)(ws + WS_WIN1), D, D, D, 0, 0}; pg8::StaticOrder S; S.init(M, 3072, 1, G, bx);
      pg8::EpiInProj1 E{SS + 32 * M, (bf16*)(ws + WS_QKV1), C2, (unsigned*)(ctl + CW_KN)};
      GEMM_PHASE(pg8::EpiInProj1, pg8::StaticOrder, lds + RING_OFF, g, S, E); }
    for (int r = gw; r < M / 16; r += NGW) fgate_rows16(XB, (const bf16*)(ws + WS_WF1), SS + 32 * M, args.in[20], (float*)(ws + WS_LOGF), r * 16, lane);
    GRID_BAR();
    { const attn_body::AttnTensors AT{(const attn_body::bf16*)(ws + WS_QKV1), (const attn_body::bf16*)(ws + WS_QKV1 + 32 * MiB), (const attn_body::bf16*)(ws + WS_QKV1 + 64 * MiB), (attn_body::bf16*)(ws + WS_QKV1), (const float*)(ws + WS_LOGF), (const unsigned*)(ctl + CW_KN)};
      constexpr int N_ATT = 1024, N_CVB = MOE_XITEMS / 32, N_GRP = (N_ATT + 2) / 3 > (N_CVB + 1) / 2 ? (N_ATT + 2) / 3 : (N_CVB + 1) / 2;
      for (;;) {
          if (tid == 0) MISC[16] = __hip_atomic_fetch_add(ctl + CW_QUEUE, 1u, RLX_AGENT);
          __syncthreads();
          const unsigned uq = __builtin_amdgcn_readfirstlane(MISC[16]);
          __syncthreads();
          if (uq >= 5u * N_GRP) break;
          const int grp = (int)(uq / 5u), rr = (int)(uq % 5u);
          if (rr & 1) { const int cb = 2 * grp + (rr >> 1);
              if (cb < N_CVB) { int lane_ = threadIdx.x & 63; asm volatile("" : "+v"(lane_));
                  LAS float* scr = (LAS float*)(lds + wave * XSCR_BYTES);
#pragma unroll 1
                  for (int j = 0; j < 4; j += 2) { const XTile t0 = moe_xtile(args, cb * 32 + wave * 4 + j, lane_), t1 = moe_xtile(args, cb * 32 + wave * 4 + j + 1, lane_);
                      f32x4 v0[16], v1[16]; xtile_load(t0, v0); xtile_load(t1, v1);
                      xtile_finish_fp8(t0, v0, 64.f, scr, lane_); xtile_finish_fp8(t1, v1, 64.f, scr, lane_); } }
          } else { const int au = 3 * grp + (rr >> 1);
              if (au < N_ATT) { const int bh = au & 31, qb = 31 - (au >> 5);
                  attn_body::attn_unit<8>(bh >> 4, bh & 15, qb, AT.Q, AT.K, AT.V, AT.O, (char*)lds_raw + RING_OFF, AT.logf + (size_t)bh * SEQ, AT.kn + (size_t)bh * 256); } }
      } }
    GRID_BAR();
    { pg8::Gemm g{(const bf16*)(ws + WS_QKV1), (const bf16*)(ws + WS_WOUT1), D, D, D, 0, 0}; pg8::StaticOrder S; S.init(M, D, 1, G, bx);
      pg8::EpiResid E{X, X, XB, SS + 48 * M};
      GEMM_PHASE(pg8::EpiResid, pg8::StaticOrder, lds + RING_OFF, g, S, E); }
    GRID_BAR();
    unsigned char* meta = ws + WS_META; unsigned char* XG = ws + WS_XG; float* RSS = (float*)(meta + MT_RSS);
    {
        const float* wr = args.in[23]; const float* gn = args.in[22];
        LAS unsigned* lcnt = (LAS unsigned*)(lds + 1024);
        if (tid < 16) lcnt[tid] = 0u;
        __syncthreads();
        float wl[16][NEXP];
#pragma unroll
        for (int j = 0; j < 4; ++j) { const int k0 = 4 * lane + 256 * j; const f32x4 gv = *(const f32x4*)(gn + k0);
#pragma unroll
            for (int q = 0; q < 4; ++q) { const f32x4 w0 = *(const f32x4*)(wr + (size_t)(k0 + q) * NEXP), w1 = *(const f32x4*)(wr + (size_t)(k0 + q) * NEXP + 4);
                wl[4 * j + q][0] = gv[q] * w0.x; wl[4 * j + q][1] = gv[q] * w0.y; wl[4 * j + q][2] = gv[q] * w0.z; wl[4 * j + q][3] = gv[q] * w0.w;
                wl[4 * j + q][4] = gv[q] * w1.x; wl[4 * j + q][5] = gv[q] * w1.y; wl[4 * j + q][6] = gv[q] * w1.z; wl[4 * j + q][7] = gv[q] * w1.w; } }
        f32x4 xn[4];
        if (gw < M) {
#pragma unroll
            for (int j = 0; j < 4; ++j) xn[j] = ((const GAS f32x4*)(X + (size_t)gw * D) + lane)[64 * j]; }
        const bool hb5 = (lane & 32) != 0, hb4 = (lane & 16) != 0, hb3 = (lane & 8) != 0;
        for (int tok = gw; tok < M; tok += NGW) {
            f32x4 xv[4];
#pragma unroll
            for (int j = 0; j < 4; ++j) xv[j] = xn[j];
            if (tok + NGW < M) {
#pragma unroll
                for (int j = 0; j < 4; ++j) xn[j] = ((const GAS f32x4*)(X + (size_t)(tok + NGW) * D) + lane)[64 * j]; }
            float lg[NEXP]; float s = 0.f;
#pragma unroll
            for (int e = 0; e < NEXP; ++e) lg[e] = 0.f;
#pragma unroll
            for (int j = 0; j < 4; ++j) { const f32x4 v = xv[j]; s += (v.x * v.x + v.y * v.y) + (v.z * v.z + v.w * v.w);
#pragma unroll
                for (int q = 0; q < 4; ++q)
#pragma unroll
                    for (int e = 0; e < NEXP; ++e) lg[e] = fmaf(v[q], wl[4 * j + q][e], lg[e]); }
            s = wave_sum(s);
            float a4[4], a2[2], a1;
#pragma unroll
            for (int i = 0; i < 4; ++i) { const float snd = hb5 ? lg[i] : lg[i + 4], kp = hb5 ? lg[i + 4] : lg[i]; a4[i] = kp + __shfl_xor(snd, 32); }
#pragma unroll
            for (int i = 0; i < 2; ++i) { const float snd = hb4 ? a4[i] : a4[i + 2], kp = hb4 ? a4[i + 2] : a4[i]; a2[i] = kp + __shfl_xor(snd, 16); }
            { const float snd = hb3 ? a2[0] : a2[1], kp = hb3 ? a2[1] : a2[0]; a1 = kp + __shfl_xor(snd, 8); }
            a1 += __shfl_xor(a1, 4); a1 += __shfl_xor(a1, 2); a1 += __shfl_xor(a1, 1);
#pragma unroll
            for (int e = 0; e < NEXP; ++e) lg[e] = __builtin_bit_cast(float, __builtin_amdgcn_readlane(__builtin_bit_cast(int, a1), 8 * e));
            if (lane == 0) {
                const float rs = 1.0f / sqrtf(s * (1.0f / 1024.0f) + pg8::RMS_EPS);
                int i1 = 0; float v1 = lg[0];
#pragma unroll
                for (int e = 1; e < NEXP; ++e) if (lg[e] > v1) { v1 = lg[e]; i1 = e; }
                int i2 = -1; float v2 = -INFINITY;
#pragma unroll
                for (int e = 0; e < NEXP; ++e) if (e != i1 && lg[e] > v2) { v2 = lg[e]; i2 = e; }
                const float g1 = 1.f / (1.f + expf((v2 - v1) * rs)), g2 = 1.f - g1;
                const unsigned p1 = __hip_atomic_fetch_add(lcnt + i1, 1u, __ATOMIC_RELAXED, __HIP_MEMORY_SCOPE_WORKGROUP), p2 = __hip_atomic_fetch_add(lcnt + i2, 1u, __ATOMIC_RELAXED, __HIP_MEMORY_SCOPE_WORKGROUP);
                ((float*)(meta + MT_RSTD))[tok] = rs; ((unsigned*)(meta + MT_TOKE))[tok] = (unsigned)i1 | ((unsigned)i2 << 8);
                ((unsigned*)(meta + MT_TOKP))[2 * tok] = p1; ((unsigned*)(meta + MT_TOKP))[2 * tok + 1] = p2;
                ((float*)(meta + MT_TOKG))[2 * tok] = g1; ((float*)(meta + MT_TOKG))[2 * tok + 1] = g2;
            }
        }
        __syncthreads();
        if (tid < NEXP) lcnt[8 + tid] = __hip_atomic_fetch_add(ctl + CW_CNT + 64 * tid, lcnt[tid], RLX_AGENT);
        VM_WAIT();
        __syncthreads();
        if (gw < M) {
#pragma unroll
            for (int j = 0; j < 4; ++j) xn[j] = ((const GAS f32x4*)(X + (size_t)gw * D) + lane)[64 * j]; }
        for (int tok = gw; tok < M; tok += NGW) {
            const unsigned ee = ((const unsigned*)(meta + MT_TOKE))[tok]; const float rs = ((const float*)(meta + MT_RSTD))[tok];
            const unsigned q1 = ((const unsigned*)(meta + MT_TOKP))[2 * tok], q2 = ((const unsigned*)(meta + MT_TOKP))[2 * tok + 1];
            f32x4 xv[4];
#pragma unroll
            for (int j = 0; j < 4; ++j) xv[j] = xn[j];
            if (tok + NGW < M) {
#pragma unroll
                for (int j = 0; j < 4; ++j) xn[j] = ((const GAS f32x4*)(X + (size_t)(tok + NGW) * D) + lane)[64 * j]; }
            const int e1 = (int)(ee & 0xffu), e2 = (int)((ee >> 8) & 0xffu);
            const unsigned p1 = q1 + lcnt[8 + e1], p2 = q2 + lcnt[8 + e2];
            const size_t r1 = (size_t)e1 * MOE_CAP + p1, r2 = (size_t)e2 * MOE_CAP + p2;
#pragma unroll
            for (int j = 0; j < 4; ++j) { const f32x4 v = xv[j]; const unsigned w = pg8::pk_fp8x4(v.x, v.y, v.z, v.w);
                *(unsigned*)(XG + r1 * D + 4 * lane + 256 * j) = w; *(unsigned*)(XG + r2 * D + 4 * lane + 256 * j) = w; }
            if (lane == 0) { RSS[r1] = rs; RSS[r2] = rs; ((unsigned*)(meta + MT_TOKP))[2 * tok] = p1; ((unsigned*)(meta + MT_TOKP))[2 * tok + 1] = p2; }
        }
    }
    GRID_BAR();
    int pref[NEXP + 1], cnt[NEXP];
    { pref[0] = 0;
#pragma unroll
      for (int e = 0; e < NEXP; ++e) { cnt[e] = (int)__builtin_amdgcn_readfirstlane(__hip_atomic_load(ctl + CW_CNT + 64 * e, RLX_AGENT)); pref[e + 1] = pref[e] + (cnt[e] + 255) / 256; } }
    const int NP = pref[NEXP];
    bf16* YS = (bf16*)(ws + WS_Y);
    { pg8::Gemm g{(const bf16*)XG, (const bf16*)(ws + WS_WMOE_GU), D / 2, D / 2, D / 2, 0, (size_t)7168 * 1024}; MoeOrder S; S.S.nM = NP; S.S.nN = 28; S.S.nZ = 1; S.S.nwg = NP * 28; S.S.G = G; S.S.c = bx; S.lo = 0; S.cap_rows = true;
#pragma unroll
      for (int e = 0; e <= NEXP; ++e) S.pref[e] = pref[e];
      pg8::EpiSwiGluFp8 E{RSS, ws + WS_HMOE, DFE};
      pg8::gemm_phase<pg8::EpiSwiGluFp8, MoeOrder, true, true, true>(lds + RING_OFF, g, S, E); }
    GRID_BAR();
    { pg8::Gemm g{(const bf16*)(ws + WS_HMOE), (const bf16*)(ws + WS_WMOE_D), DFE / 2, DFE / 2, DFE / 2, 0, (size_t)1024 * 3584}; MoeOrder S; S.S.nM = NP; S.S.nN = 4; S.S.nZ = 1; S.S.nwg = NP * 4; S.S.G = G; S.S.c = bx; S.lo = 0; S.cap_rows = false;
#pragma unroll
      for (int e = 0; e <= NEXP; ++e) S.pref[e] = pref[e];
      pg8::EpiStoreBf16 E{YS, D};
      pg8::gemm_phase<pg8::EpiStoreBf16, MoeOrder, true, true, true>(lds + RING_OFF, g, S, E); }
    GRID_BAR();
    {
        const float* gf = args.in[27];
        for (int tok = gw; tok < M; tok += NGW) {
            const unsigned ee = ((const unsigned*)(meta + MT_TOKE))[tok]; int pe0 = 0, pe1 = 0;
#pragma unroll
            for (int q = 0; q < NEXP; ++q) { pe0 = (q == (int)(ee & 0xffu)) ? pref[q] : pe0; pe1 = (q == (int)((ee >> 8) & 0xffu)) ? pref[q] : pe1; }
            const unsigned s0 = (unsigned)pe0 * 256u + ((const unsigned*)(meta + MT_TOKP))[2 * tok], s1 = (unsigned)pe1 * 256u + ((const unsigned*)(meta + MT_TOKP))[2 * tok + 1];
            const float g0 = ((const float*)(meta + MT_TOKG))[2 * tok], g1 = ((const float*)(meta + MT_TOKG))[2 * tok + 1];
            GAS f32x4* xr = (GAS f32x4*)(X + (size_t)tok * D) + lane; f32x4 v[4]; float s = 0.f;
#pragma unroll
            for (int j = 0; j < 4; ++j) { v[j] = xr[64 * j]; const int k0 = 4 * lane + 256 * j;
                const v2u a = *(const v2u*)(YS + (size_t)s0 * D + k0), b2 = *(const v2u*)(YS + (size_t)s1 * D + k0);
                v[j].x += g0 * bflo(a.x) + g1 * bflo(b2.x); v[j].y += g0 * bfhi(a.x) + g1 * bfhi(b2.x); v[j].z += g0 * bflo(a.y) + g1 * bflo(b2.y); v[j].w += g0 * bfhi(a.y) + g1 * bfhi(b2.y);
                s += (v[j].x * v[j].x + v[j].y * v[j].y) + (v[j].z * v[j].z + v[j].w * v[j].w); }
            s = wave_sum(s); const float rs = 1.0f / sqrtf(s * (1.0f / 1024.0f) + pg8::RMS_EPS);
#pragma unroll
            for (int j = 0; j < 4; ++j) { const f32x4 gv = *(const f32x4*)(gf + 4 * lane + 256 * j); xr[64 * j] = v[j] * rs * gv; }
        }
    }
}

extern "C" void kernel_launch(void* const* d_in, const int* in_sizes, int n_in, void* d_out, int out_size, void* d_ws, size_t ws_size, hipStream_t stream) {
    static int grid = 0;
    if (grid == 0) {
        if (n_in != 28 || in_sizes[0] != M * D || out_size != M * D || ws_size < WS_END) { fprintf(stderr, "kernel_launch: unexpected problem: n_in %d in0 %d out %d ws %zu (need %zu)\n", n_in, n_in > 0 ? in_sizes[0] : -1, out_size, ws_size, (size_t)WS_END); grid = -1; return; }
        int dev = 0, cus = 0, per_cu = 0;
        if (hipGetDevice(&dev) != hipSuccess || hipDeviceGetAttribute(&cus, hipDeviceAttributeMultiprocessorCount, dev) != hipSuccess) { grid = -1; return; }
        if (hipFuncSetAttribute((const void*)mk_fwd, hipFuncAttributeMaxDynamicSharedMemorySize, LDS_BYTES) != hipSuccess) { fprintf(stderr, "kernel_launch: hipFuncSetAttribute failed\n"); grid = -1; return; }
        if (hipOccupancyMaxActiveBlocksPerMultiprocessor(&per_cu, (const void*)mk_fwd, NTHREADS, LDS_BYTES) != hipSuccess || per_cu < 1) fprintf(stderr, "kernel_launch: occupancy query says %d\n", per_cu);
        (void)hipGetLastError();
        grid = cus;
        if (grid != 256) fprintf(stderr, "kernel_launch: built for the 256-CU MI355X; device reports %d CUs\n", cus);
    }
    if (grid < 0) return;
    if (hipMemsetAsync((char*)d_ws + WS_CTL, 0, CTL_ZERO_BYTES, stream) != hipSuccess) return;
    Args a{};
    for (int i = 0; i < 28; ++i) a.in[i] = (const float*)d_in[i];
    a.out = (float*)d_out; a.ws = (unsigned char*)d_ws;
    hipLaunchKernelGGL(mk_fwd, dim3(grid), dim3(NTHREADS), LDS_BYTES, stream, a);
}
```

```cpp
#include <hip/hip_runtime.h>
#include <cstdio>
#include <cstdint>

namespace pg8 {
#define PG8_LAS __attribute__((address_space(3)))
typedef unsigned short bf16_t;
typedef short bf16x8 __attribute__((ext_vector_type(8)));
typedef float f32x4 __attribute__((ext_vector_type(4)));
typedef unsigned u32x4 __attribute__((ext_vector_type(4)));
typedef unsigned u32x2 __attribute__((ext_vector_type(2)));
constexpr int BM = 256, BK = 64, HALF = 128, HTB = HALF * BK * 2  , STAGE_BYTES = 8 * HTB, NXCD = 8, WGM = 8;

__host__ __device__ __forceinline__ int lds_byte(int r, int c) { const int st = (r >> 4) * 2 + (c >> 5), rr = r & 15, cc = c & 31, ob = rr * 64 + cc * 2; return st * 1024 + (ob ^ (((ob >> 9) & 1) << 5)); }
__host__ __device__ __forceinline__ void stage_rc(int b, int& R, int& C) { const int st = b / 1024, sb = b % 1024, swz = sb ^ (((sb >> 9) & 1) << 5); R = (st >> 1) * 16 + swz / 64; C = (st & 1) * 32 + (swz % 64) / 2; }
__host__ __device__ __forceinline__ int perm32(int rho) { const int n = rho >> 4, i = rho & 15; return 8 * (i >> 2) + 4 * n + (i & 3); }

struct Unit { int pm, pn, zb, pa, qa, qb; };
struct Gemm { const bf16_t* A; const bf16_t* Bt; int lda, ldb, K; size_t zA, zB; };

struct StaticOrder {
    int nM, nN, nZ, nwg, G, c;
    __host__ __device__ void init(int M, int N, int Z, int G_, int c_) { nM = M / BM; nN = N / BM; nZ = Z; nwg = nM * nN * nZ; G = G_; c = c_; }
    __host__ __device__ bool next(int i, Unit& u) const {
        const long L = (long)i * G + c; if (L >= nwg) return false;
        int wgid = (int)L; { const int q = nwg / NXCD, r = nwg % NXCD, xcd = wgid % NXCD, off = wgid / NXCD; wgid = (xcd < r ? xcd * (q + 1) : r * (q + 1) + (xcd - r) * q) + off; }
        const int per = nM * nN; u.zb = wgid / per; wgid -= u.zb * per;
        const int nig = WGM * nN, gid = wgid / nig, fm = gid * WGM, gsz = (nM - fm) < WGM ? (nM - fm) : WGM;
        u.pm = fm + ((wgid % nig) % gsz); u.pn = (wgid % nig) / gsz; u.pa = u.pm; u.qa = 0; u.qb = 0; return true;
    }
    __device__ __forceinline__ void a_ready(const Unit&) const {}
    __device__ __forceinline__ void done(const Unit&) const {}
};

__device__ __forceinline__ unsigned cvt_pk_bf16(float lo, float hi) { unsigned r; asm volatile("v_cvt_pk_bf16_f32 %0, %1, %2" : "=v"(r) : "v"(lo), "v"(hi)); return r; }
typedef int v4i_t __attribute__((ext_vector_type(4))); typedef int v8i_t __attribute__((ext_vector_type(8)));
__device__ __forceinline__ v8i_t cat8(bf16x8 a, bf16x8 b) { return __builtin_shufflevector(__builtin_bit_cast(v4i_t, a), __builtin_bit_cast(v4i_t, b), 0, 1, 2, 3, 4, 5, 6, 7); }
__device__ __forceinline__ unsigned pk_fp8x4(float a, float b, float c, float d) { int r = 0; r = __builtin_amdgcn_cvt_pk_fp8_f32(a, b, r, false); r = __builtin_amdgcn_cvt_pk_fp8_f32(c, d, r, true); return (unsigned)r; }
__device__ __forceinline__ float bf_lo(unsigned w) { return __uint_as_float(w << 16); }
__device__ __forceinline__ float bf_hi(unsigned w) { return __uint_as_float(w & 0xffff0000u); }
__device__ __forceinline__ float fast_sigmoid(float z) { return __builtin_amdgcn_rcpf(1.0f + __builtin_amdgcn_exp2f(-1.4426950408889634f * z)); }
__device__ __forceinline__ f32x4 swiglu4(const f32x4 g, const f32x4 u, const float c1, const float rs2) {
    const f32x4 t = g * c1; f32x4 e;
#pragma unroll
    for (int i = 0; i < 4; ++i) e[i] = __builtin_amdgcn_exp2f(t[i]);
    const f32x4 d = e + 1.0f; f32x4 r;
#pragma unroll
    for (int i = 0; i < 4; ++i) r[i] = __builtin_amdgcn_rcpf(d[i]);
    return (g * u) * (r * rs2);
}
constexpr float RMS_EPS = 1e-6f;
__device__ __forceinline__ float rstd16(const float* ssp, int row) { const f32x4* p = (const f32x4*)(ssp + (size_t)row * 16); const f32x4 a = p[0], b = p[1], c = p[2], d = p[3];
    const float s = (((a[0] + a[1]) + (a[2] + a[3])) + ((b[0] + b[1]) + (b[2] + b[3]))) + (((c[0] + c[1]) + (c[2] + c[3])) + ((d[0] + d[1]) + (d[2] + d[3])));
    return __builtin_amdgcn_rsqf(s * (1.0f / 1024.0f) + RMS_EPS); }

__device__ __forceinline__ void rstd8(const float* ssp, int row0, int fq, float (&rs)[8]) {
    f32x4 p[8];
#pragma unroll
    for (int i = 0; i < 8; ++i) p[i] = *(const f32x4*)(ssp + (size_t)(row0 + (i >> 2) * HALF + (i & 3) * 16) * 16 + 4 * fq);
#pragma unroll
    for (int i = 0; i < 8; ++i) { float q = (p[i][0] + p[i][1]) + (p[i][2] + p[i][3]); q += __shfl_xor(q, 16); q += __shfl_xor(q, 32); rs[i] = __builtin_amdgcn_rsqf(q * (1.0f / 1024.0f) + RMS_EPS); }
}
__device__ __forceinline__ u32x4 pack8(const f32x4 v0, const f32x4 v1) { u32x4 w; w.x = cvt_pk_bf16(v0[0], v0[1]); w.y = cvt_pk_bf16(v0[2], v0[3]); w.z = cvt_pk_bf16(v1[0], v1[1]); w.w = cvt_pk_bf16(v1[2], v1[3]); return w; }

struct EpiInProj0 {
    static constexpr bool PERM = true, AFTER_DRAIN = false;
    const float* ss; bf16_t* uext; bf16_t* qkv; float qscale;
    __device__ __forceinline__ void operator()(const f32x4 (&acc)[2][2][4][2], const Unit& u, int wr, int wc, int fr, int fq) const {
        const int row0 = u.pm * BM + wr * 64 + fr; float rsa[8]; rstd8(ss, row0, fq, rsa);
#pragma unroll
        for (int ai = 0; ai < 2; ++ai)
#pragma unroll
            for (int m = 0; m < 4; ++m) { const int row = row0 + ai * HALF + m * 16; const float rs = rsa[ai * 4 + m];
#pragma unroll
                for (int bj = 0; bj < 2; ++bj) { const int col0 = u.pn * BM + bj * HALF + wc * 32 + 8 * fq;
                    float sc = rs; bf16_t* dst;
                    if (u.pn < 2) dst = uext + ((size_t)(col0 >> 4) * 512 + (row >> 5)) * 640 + (row & 31) * 16 + (col0 & 15);
                    else { const int c = col0 - 512; if (c < 512) sc *= qscale; dst = qkv + (size_t)row * 1536 + c; }
                    *(u32x4*)dst = pack8(acc[ai][bj][m][0] * sc, acc[ai][bj][m][1] * sc); } }
    }
};
struct EpiS5State {
    static constexpr bool PERM = false, AFTER_DRAIN = false;
    float* sloc;
    __device__ __forceinline__ void operator()(const f32x4 (&acc)[2][2][4][2], const Unit& u, int wr, int wc, int fr, int fq) const {
        const int row0 = u.pm * BM + wr * 64 + fr, col0 = wc * 32 + 4 * fq;
#pragma unroll
        for (int ai = 0; ai < 2; ++ai)
#pragma unroll
            for (int m = 0; m < 4; ++m) { float* rowp = sloc + ((size_t)u.zb * 512 + row0 + ai * HALF + m * 16) * 128 + col0;
#pragma unroll
                for (int n = 0; n < 2; ++n) *(f32x4*)(rowp + n * 16) = acc[ai][0][m][n]; }
    }
};
__device__ __forceinline__ float gelu_tanh(float x) { const float a = x * (1.0f + 0.044715f * x * x); return x * __builtin_amdgcn_rcpf(1.0f + __builtin_amdgcn_exp2f(-2.302208198f * a)); }
struct EpiS5Y {
    static constexpr bool PERM = true, AFTER_DRAIN = false;
    bf16_t* yg;
    __device__ __forceinline__ void operator()(const f32x4 (&acc)[2][2][4][2], const Unit& u, int wr, int wc, int fr, int fq) const {
        const int row0 = u.pm * BM + wr * 64 + fr;
#pragma unroll
        for (int ai = 0; ai < 2; ++ai)
#pragma unroll
            for (int m = 0; m < 4; ++m) { const int chunk = row0 + ai * HALF + m * 16;
#pragma unroll
                for (int bj = 0; bj < 2; ++bj) { const int col0 = u.pn * BM + bj * HALF + wc * 32 + 8 * fq; const int i = col0 >> 4, h0 = col0 & 15;
                    f32x4 v0 = acc[ai][bj][m][0], v1 = acc[ai][bj][m][1];
#pragma unroll
                    for (int e = 0; e < 4; ++e) { v0[e] = gelu_tanh(v0[e]); v1[e] = gelu_tanh(v1[e]); }
                    *(u32x4*)(yg + ((size_t)chunk * 32 + i) * 512 + u.zb * 16 + h0) = pack8(v0, v1); } }
    }
};
struct EpiGlu {
    static constexpr bool PERM = true, AFTER_DRAIN = false;
    const bf16_t* yg; const float* bias; bf16_t* mix;
    __device__ __forceinline__ void operator()(const f32x4 (&acc)[2][2][4][2], const Unit& u, int wr, int wc, int fr, int fq) const {
        const int row0 = u.pm * BM + wr * 64 + fr; u32x4 ywa[2][8];
#pragma unroll
        for (int bj = 0; bj < 2; ++bj)
#pragma unroll
            for (int i = 0; i < 8; ++i) ywa[bj][i] = *(const u32x4*)(yg + (size_t)(row0 + (i >> 2) * HALF + (i & 3) * 16) * 512 + u.pn * BM + bj * HALF + wc * 32 + 8 * fq);
#pragma unroll
        for (int bj = 0; bj < 2; ++bj) { const int col0 = u.pn * BM + bj * HALF + wc * 32 + 8 * fq;
            const f32x4 b0 = *(const f32x4*)(bias + col0), b1 = *(const f32x4*)(bias + col0 + 4);
#pragma unroll
            for (int ai = 0; ai < 2; ++ai)
#pragma unroll
                for (int m = 0; m < 4; ++m) { const int row = row0 + ai * HALF + m * 16;
                    const u32x4 yw = ywa[bj][ai * 4 + m];
                    f32x4 z0 = acc[ai][bj][m][0] + b0, z1 = acc[ai][bj][m][1] + b1, o0, o1;
                    o0[0] = bf_lo(yw.x) * fast_sigmoid(z0[0]); o0[1] = bf_hi(yw.x) * fast_sigmoid(z0[1]); o0[2] = bf_lo(yw.y) * fast_sigmoid(z0[2]); o0[3] = bf_hi(yw.y) * fast_sigmoid(z0[3]);
                    o1[0] = bf_lo(yw.z) * fast_sigmoid(z1[0]); o1[1] = bf_hi(yw.z) * fast_sigmoid(z1[1]); o1[2] = bf_lo(yw.w) * fast_sigmoid(z1[2]); o1[3] = bf_hi(yw.w) * fast_sigmoid(z1[3]);
                    *(u32x4*)(mix + (size_t)row * 1024 + col0) = pack8(o0, o1); } }
    }
};
template <bool XBOUT> struct EpiResid {
    static constexpr bool PERM = false, AFTER_DRAIN = false;
    const float* R; float* X; bf16_t* xb; float* ssq; unsigned char* xq = nullptr;
    __device__ __forceinline__ void operator()(const f32x4 (&acc)[2][2][4][2], const Unit& u, int wr, int wc, int fr, int fq) const {
        const int row0 = u.pm * BM + wr * 64 + fr, col0 = u.pn * BM + wc * 32 + 4 * fq;
#pragma unroll
        for (int ai = 0; ai < 2; ++ai) {
            f32x4 rv[4][2][2];
#pragma unroll
            for (int m = 0; m < 4; ++m)
#pragma unroll
                for (int bj = 0; bj < 2; ++bj)
#pragma unroll
                    for (int n = 0; n < 2; ++n) rv[m][bj][n] = *(const f32x4*)(R + (size_t)(row0 + ai * HALF + m * 16) * 1024 + col0 + bj * HALF + n * 16);
            asm volatile("" ::: "memory");
#pragma unroll
            for (int m = 0; m < 4; ++m) { const int row = row0 + ai * HALF + m * 16; const size_t off = (size_t)row * 1024 + col0; float s = 0.f;
#pragma unroll
                for (int bj = 0; bj < 2; ++bj)
#pragma unroll
                    for (int n = 0; n < 2; ++n) { const f32x4 x = rv[m][bj][n] + acc[ai][bj][m][n];
                        *(f32x4*)(X + off + bj * HALF + n * 16) = x; s += (x[0] * x[0] + x[1] * x[1]) + (x[2] * x[2] + x[3] * x[3]);
                        if (XBOUT) { u32x2 w; w.x = cvt_pk_bf16(x[0], x[1]); w.y = cvt_pk_bf16(x[2], x[3]); *(u32x2*)(xb + off + bj * HALF + n * 16) = w;
                            if (xq) *(unsigned*)(xq + off + bj * HALF + n * 16) = pk_fp8x4(x[0], x[1], x[2], x[3]); } }
                s += __shfl_xor(s, 16); s += __shfl_xor(s, 32);
                if (XBOUT && fq == 0) ssq[(size_t)row * 16 + u.pn * 4 + wc] = s; }
            asm volatile("" ::: "memory"); }
    }
};
template <bool RS_IS_SSQ> struct EpiSwiGlu {
    static constexpr bool PERM = true, AFTER_DRAIN = false;
    const float* rsv; bf16_t* H; int ldh;
    __device__ __forceinline__ void operator()(const f32x4 (&acc)[2][2][4][2], const Unit& u, int wr, int wc, int fr, int fq) const {
        const int row0 = u.pm * BM + wr * 64 + fr, col0 = u.pn * HALF + wc * 32 + 8 * fq; float rsa[8];
        if (RS_IS_SSQ) rstd8(rsv, row0, fq, rsa);
        else {
#pragma unroll
            for (int i = 0; i < 8; ++i) rsa[i] = rsv[row0 + (i >> 2) * HALF + (i & 3) * 16]; }
#pragma unroll
        for (int ai = 0; ai < 2; ++ai)
#pragma unroll
            for (int m = 0; m < 4; ++m) { const int row = row0 + ai * HALF + m * 16; const float rs = rsa[ai * 4 + m], c1 = -1.4426950408889634f * rs, rs2 = rs * rs;
                f32x4 o[2];
#pragma unroll
                for (int n = 0; n < 2; ++n) o[n] = swiglu4(acc[ai][0][m][n], acc[ai][1][m][n], c1, rs2);
                __builtin_nontemporal_store(pack8(o[0], o[1]), (u32x4*)(H + (size_t)row * ldh + col0)); }
    }
};
struct EpiSwiGluFp8 {
    static constexpr bool PERM = true, AFTER_DRAIN = false;
    const float* rsv; unsigned char* H; int ldh;
    __device__ __forceinline__ void operator()(const f32x4 (&acc)[2][2][4][2], const Unit& u, int wr, int wc, int fr, int fq) const {
        const int row0 = u.pm * BM + wr * 64 + fr, col0 = u.pn * HALF + wc * 32 + 8 * fq; float rsa[8];
#pragma unroll
        for (int i = 0; i < 8; ++i) rsa[i] = rsv[u.pa * BM + wr * 64 + fr + (i >> 2) * HALF + (i & 3) * 16];
#pragma unroll
        for (int ai = 0; ai < 2; ++ai)
#pragma unroll
            for (int m = 0; m < 4; ++m) { const int row = row0 + ai * HALF + m * 16; const float rs = rsa[ai * 4 + m], c1 = -1.4426950408889634f * rs, rs2 = rs * rs;
                f32x4 o[2];
#pragma unroll
                for (int n = 0; n < 2; ++n) o[n] = swiglu4(acc[ai][0][m][n], acc[ai][1][m][n], c1, rs2);
                u32x2 w; w.x = pk_fp8x4(o[0][0], o[0][1], o[0][2], o[0][3]); w.y = pk_fp8x4(o[1][0], o[1][1], o[1][2], o[1][3]);
                __builtin_nontemporal_store(w, (u32x2*)(H + (size_t)row * ldh + col0)); }
    }
};
struct EpiInProj1 {
    static constexpr bool PERM = true, AFTER_DRAIN = false;
    const float* ss; bf16_t* qkv; float qscale;
    unsigned* kn;
    __device__ __forceinline__ void operator()(const f32x4 (&acc)[2][2][4][2], const Unit& u, int wr, int wc, int fr, int fq) const {
        const int row0 = u.pm * BM + wr * 64 + fr; const float qs = (u.pn < 4) ? qscale : 1.0f; float rsa[8]; rstd8(ss, row0, fq, rsa);
#pragma unroll
        for (int ai = 0; ai < 2; ++ai)
#pragma unroll
            for (int m = 0; m < 4; ++m) { const int row = row0 + ai * HALF + m * 16; const float sc = rsa[ai * 4 + m] * qs;
#pragma unroll
                for (int bj = 0; bj < 2; ++bj) { const int col0 = (u.pn & 3) * BM + bj * HALF + wc * 32 + 8 * fq;
                    const f32x4 v0 = acc[ai][bj][m][0] * sc, v1 = acc[ai][bj][m][1] * sc;
                    __builtin_nontemporal_store(pack8(v0, v1), (u32x4*)(qkv + (size_t)(u.pn >> 2) * (16384 * 1024) + (size_t)row * 1024 + col0));
                    if ((u.pn >> 2) == 1) {
                        float q = ((v0[0] * v0[0] + v0[1] * v0[1]) + (v0[2] * v0[2] + v0[3] * v0[3])) + ((v1[0] * v1[0] + v1[1] * v1[1]) + (v1[2] * v1[2] + v1[3] * v1[3]));
                        q += __shfl_xor(q, 16); q += __shfl_xor(q, 32);
                        q = fmaxf(q, __shfl_xor(q, 1)); q = fmaxf(q, __shfl_xor(q, 2)); q = fmaxf(q, __shfl_xor(q, 4)); q = fmaxf(q, __shfl_xor(q, 8));
                        if (fr == 0 && fq == 0) { const int head = (u.pn & 3) * 4 + bj * 2 + (wc >> 1), bb = row >> 13, tile = (row & 8191) >> 6;
                            atomicMax(kn + ((size_t)(bb * 16 + head) * 128 + tile) * 2 + (wc & 1), __float_as_uint(q * 1.01f)); } } } }
    }
};
struct EpiStoreBf16 {
    static constexpr bool PERM = true, AFTER_DRAIN = false;
    bf16_t* O; int ldc;
    __device__ __forceinline__ void operator()(const f32x4 (&acc)[2][2][4][2], const Unit& u, int wr, int wc, int fr, int fq) const {
        const int row0 = u.pm * BM + wr * 64 + fr;
#pragma unroll
        for (int ai = 0; ai < 2; ++ai)
#pragma unroll
            for (int m = 0; m < 4; ++m) { const int row = row0 + ai * HALF + m * 16;
#pragma unroll
                for (int bj = 0; bj < 2; ++bj) { const int col0 = u.pn * BM + bj * HALF + wc * 32 + 8 * fq;
                    __builtin_nontemporal_store(pack8(acc[ai][bj][m][0], acc[ai][bj][m][1]), (u32x4*)(O + (size_t)row * ldc + col0)); } }
    }
};

struct EpiStoreQuad {
    static constexpr bool PERM = true, AFTER_DRAIN = false;
    bf16_t* O; int ldc;
    __device__ __forceinline__ void operator()(const f32x4 (&acc)[2][2][4][2], const Unit& u, int wr, int wc, int fr, int fq) const {
        const int row0 = u.pm * BM + u.qa * HALF + wr * 64 + fr, col0 = u.pn * BM + u.qb * HALF + wc * 32 + 8 * fq;
#pragma unroll
        for (int m = 0; m < 4; ++m) __builtin_nontemporal_store(pack8(acc[0][0][m][0], acc[0][0][m][1]), (u32x4*)(O + (size_t)(row0 + m * 16) * ldc + col0));
    }
};

typedef float f32x2z __attribute__((ext_vector_type(2)));
__device__ __forceinline__ f32x4 zero4_b64() { f32x2z a, b; asm volatile("v_mov_b64 %0, 0" : "=v"(a)); asm volatile("v_mov_b64 %0, 0" : "=v"(b)); return (f32x4){a[0], a[1], b[0], b[1]}; }
template <bool F8> struct Frag { bf16x8 k[2]; };
template <> struct Frag<true> { v8i_t v; };
template <class Epi, class Sched, bool ALIGN_EPI = false, bool SP2 = false, bool FP8 = false, bool QUAD = false>
__device__ __forceinline__ void gemm_phase(PG8_LAS unsigned char* lds, const Gemm g, const Sched& S, const Epi& E) {
    int tid_ = threadIdx.x; asm volatile("" : "+v"(tid_));
    const int tid = tid_, wid = __builtin_amdgcn_readfirstlane(tid >> 6), lane = tid & 63, wr = wid >> 2, wc = wid & 3, fr = lane & 15, fq = lane >> 4;
    const int K = g.K, nt = K / BK;
    unsigned voffA[2], voffB[2];
#pragma unroll
    for (int i = 0; i < 2; ++i) { int R, C; stage_rc(tid * 16 + i * 8192, R, C); const int Rb = Epi::PERM ? ((R & ~31) + perm32(R & 31)) : R;
        voffA[i] = (unsigned)(R * g.lda + C) * 2u; voffB[i] = (unsigned)(Rb * g.ldb + C) * 2u; }
    const size_t kstep = (size_t)(BK * 2);
    const size_t hstepA = (size_t)HALF * g.lda * 2, hstepB = (size_t)HALF * g.ldb * 2;
    const size_t tstepA = 2 * hstepA, tstepB = 2 * hstepB;
    const unsigned ldsw = (unsigned)wid * 1024u;
    const int aoff = lds_byte(wr * 64 + fr, fq * 8), boff = lds_byte(wc * 32 + fr, fq * 8);
#define PG8_SA(b, h) (((b) * 2 + (h)) * HTB)
#define PG8_SB(b, h) ((4 + (b) * 2 + (h)) * HTB)
#define PG8_STAGE(bufoff, gbase, voff) do { _Pragma("unroll") for (int _i = 0; _i < 2; ++_i) \
        __builtin_amdgcn_global_load_lds((const unsigned*)((const char*)(gbase) + (voff)[_i]), (PG8_LAS unsigned*)(lds + (bufoff) + ldsw + _i * 8192), 16, 0, 0); } while (0)
    const PG8_LAS unsigned char* ldsA_ = lds + aoff; const PG8_LAS unsigned char* ldsB_ = lds + 4 * HTB + boff; asm volatile("" : "+v"(ldsA_), "+v"(ldsB_));
#define PG8_RDA(off) (*(const PG8_LAS bf16x8*)(ldsA_ + (off)))
#define PG8_RDB(off) (*(const PG8_LAS bf16x8*)(ldsB_ + (off)))
#define PG8_LDA(dst, b, h) do { _Pragma("unroll") for (int m = 0; m < 4; ++m) { if constexpr (FP8) dst[m].v = cat8(PG8_RDA(PG8_SA(b, h) + m * 2048), PG8_RDA(PG8_SA(b, h) + m * 2048 + 1024)); \
        else { dst[m].k[0] = PG8_RDA(PG8_SA(b, h) + m * 2048); dst[m].k[1] = PG8_RDA(PG8_SA(b, h) + m * 2048 + 1024); } } } while (0)
#define PG8_LDB(dst, b, h) do { _Pragma("unroll") for (int n = 0; n < 2; ++n) { if constexpr (FP8) dst[n].v = cat8(PG8_RDB(PG8_SB(b, h) - 4 * HTB + n * 2048), PG8_RDB(PG8_SB(b, h) - 4 * HTB + n * 2048 + 1024)); \
        else { dst[n].k[0] = PG8_RDB(PG8_SB(b, h) - 4 * HTB + n * 2048); dst[n].k[1] = PG8_RDB(PG8_SB(b, h) - 4 * HTB + n * 2048 + 1024); } } } while (0)
#define PG8_MMA(ai, bj, At, Bt) do { if constexpr (!(QUAD && (((ai) | (bj)) != 0))) { __builtin_amdgcn_s_setprio(1); _Pragma("unroll") for (int m = 0; m < 4; ++m) _Pragma("unroll") for (int n = 0; n < 2; ++n) { \
        if constexpr (FP8) { asm volatile("v_mfma_scale_f32_16x16x128_f8f6f4 %0, %1, %2, %0, %3, %4 op_sel_hi:[0,0,0]" : "+v"(acc[ai][bj][m][n]) : "v"(Bt[n].v), "v"(At[m].v), "v"(sclB_), "v"(sclA_)); } \
        else { _Pragma("unroll") for (int k = 0; k < 2; ++k) acc[ai][bj][m][n] = __builtin_amdgcn_mfma_f32_16x16x32_bf16(Bt[n].k[k], At[m].k[k], acc[ai][bj][m][n], 0, 0, 0); } } __builtin_amdgcn_s_setprio(0); } } while (0)
#define PG8_WAIT_V(n) asm volatile("s_waitcnt vmcnt(" #n ")" ::: "memory")
#define PG8_WAIT_L(n) asm volatile("s_waitcnt lgkmcnt(" #n ")" ::: "memory")
#define PG8_BAR __builtin_amdgcn_s_barrier()
#define PG8_SCHED __builtin_amdgcn_sched_barrier(0)
    Unit cur, nxt; int ui = 0;
    if (!S.next(0, cur)) return;
    f32x4 acc[2][2][4][2];
#pragma unroll
    for (int a = 0; a < 2; ++a)
#pragma unroll
        for (int b = 0; b < 2; ++b)
#pragma unroll
            for (int m = 0; m < 4; ++m)
#pragma unroll
                for (int n = 0; n < 2; ++n) acc[a][b][m][n] = zero4_b64();
    Frag<FP8> At[4], B0[2], B1[2];
    int sclB_ = 0x79797979, sclA_ = 0x7f7f7f7f; asm volatile("" : "+v"(sclB_), "+v"(sclA_));
    const char* cA = (const char*)g.A + (size_t)cur.zb * g.zA + (size_t)cur.pa * tstepA + (QUAD ? (size_t)cur.qa * hstepA : 0); const char* cB = (const char*)g.Bt + (size_t)cur.zb * g.zB + (size_t)cur.pn * tstepB + (QUAD ? (size_t)cur.qb * hstepB : 0);
    S.a_ready(cur);
    if constexpr (SP2) {
        PG8_STAGE(PG8_SB(0, 0), cB, voffB); PG8_STAGE(PG8_SB(0, 1), cB + hstepB, voffB); PG8_STAGE(PG8_SA(0, 0), cA, voffA); PG8_STAGE(PG8_SA(0, 1), cA + hstepA, voffA);
        if (wr == 1) PG8_BAR;
        PG8_WAIT_V(2); PG8_BAR;
        PG8_STAGE(PG8_SB(1, 0), cB + kstep, voffB); PG8_STAGE(PG8_SA(1, 0), cA + kstep, voffA); PG8_STAGE(PG8_SB(1, 1), cB + hstepB + kstep, voffB);
        PG8_WAIT_V(6); PG8_BAR;
    } else {
        PG8_STAGE(PG8_SB(0, 0), cB, voffB); PG8_STAGE(PG8_SA(0, 0), cA, voffA); PG8_STAGE(PG8_SB(0, 1), cB + hstepB, voffB); PG8_STAGE(PG8_SA(0, 1), cA + hstepA, voffA);
        if (wr == 1) PG8_BAR;
        PG8_WAIT_V(4); PG8_BAR;
        PG8_STAGE(PG8_SB(1, 0), cB + kstep, voffB); PG8_STAGE(PG8_SA(1, 0), cA + kstep, voffA); PG8_STAGE(PG8_SB(1, 1), cB + hstepB + kstep, voffB);
        PG8_WAIT_V(6); PG8_BAR;
    }
    for (;;) {
        const bool has_next = S.next(ui + 1, nxt);
        const char* nA = has_next ? (const char*)g.A + (size_t)nxt.zb * g.zA + (size_t)nxt.pa * tstepA + (QUAD ? (size_t)nxt.qa * hstepA : 0) : cA; const char* nB = has_next ? (const char*)g.Bt + (size_t)nxt.zb * g.zB + (size_t)nxt.pn * tstepB + (QUAD ? (size_t)nxt.qb * hstepB : 0) : cB;
#pragma unroll 1
        for (int t = 0; t < nt; t += 2) {
            const bool last = (t == nt - 2);
            const char* a1 = cA + (size_t)(t + 1) * kstep;
            const char* a2 = last ? nA : cA + (size_t)(t + 2) * kstep; const char* b2 = last ? nB : cB + (size_t)(t + 2) * kstep;
            const char* a3 = a2 + kstep; const char* b3 = b2 + kstep;
            if (last && has_next) S.a_ready(nxt);
            if constexpr (SP2) {
            PG8_LDB(B0, 0, 0); PG8_LDB(B1, 0, 1); PG8_SCHED; PG8_LDA(At, 0, 0); PG8_STAGE(PG8_SA(1, 1), a1 + hstepA, voffA);
            PG8_WAIT_V(8); PG8_WAIT_L(0); PG8_BAR; PG8_MMA(0, 0, At, B0); PG8_MMA(0, 1, At, B1); PG8_BAR; PG8_SCHED;
            PG8_LDA(At, 0, 1); PG8_STAGE(PG8_SB(0, 0), b2, voffB); PG8_STAGE(PG8_SB(0, 1), b2 + hstepB, voffB); PG8_STAGE(PG8_SA(0, 0), a2, voffA);
            PG8_WAIT_V(8); PG8_WAIT_L(0); PG8_BAR; PG8_MMA(1, 0, At, B0); PG8_MMA(1, 1, At, B1); PG8_BAR; PG8_SCHED;
            PG8_LDB(B0, 1, 0); PG8_LDB(B1, 1, 1); PG8_SCHED; PG8_LDA(At, 1, 0); PG8_STAGE(PG8_SA(0, 1), a2 + hstepA, voffA);
            PG8_WAIT_V(8); PG8_WAIT_L(0); PG8_BAR; PG8_MMA(0, 0, At, B0); PG8_MMA(0, 1, At, B1); PG8_BAR; PG8_SCHED;
            PG8_LDA(At, 1, 1); PG8_STAGE(PG8_SB(1, 0), b3, voffB); PG8_STAGE(PG8_SB(1, 1), b3 + hstepB, voffB); PG8_STAGE(PG8_SA(1, 0), a3, voffA);
            PG8_WAIT_V(8); PG8_WAIT_L(0); PG8_BAR; PG8_MMA(1, 0, At, B0); PG8_MMA(1, 1, At, B1); PG8_BAR; PG8_SCHED;
            } else {
            PG8_LDB(B0, 0, 0); PG8_SCHED; PG8_LDA(At, 0, 0); PG8_STAGE(PG8_SA(1, 1), a1 + hstepA, voffA);
            PG8_WAIT_L(8); PG8_BAR; PG8_WAIT_L(0); PG8_MMA(0, 0, At, B0); PG8_BAR; PG8_SCHED;
            PG8_LDB(B1, 0, 1); PG8_STAGE(PG8_SB(0, 0), b2, voffB);
            PG8_BAR; PG8_WAIT_L(0); PG8_MMA(0, 1, At, B1); PG8_BAR;
            PG8_LDA(At, 0, 1); PG8_STAGE(PG8_SA(0, 0), a2, voffA);
            PG8_BAR; PG8_WAIT_L(0); PG8_MMA(1, 0, At, B0); PG8_BAR; PG8_SCHED;
            PG8_STAGE(PG8_SB(0, 1), b2 + hstepB, voffB);
            PG8_WAIT_V(6); PG8_BAR; PG8_MMA(1, 1, At, B1); PG8_BAR;
            PG8_LDB(B0, 1, 0); PG8_SCHED; PG8_LDA(At, 1, 0); PG8_STAGE(PG8_SA(0, 1), a2 + hstepA, voffA);
            PG8_WAIT_L(8); PG8_BAR; PG8_WAIT_L(0); PG8_MMA(0, 0, At, B0); PG8_BAR; PG8_SCHED;
            PG8_LDB(B1, 1, 1); PG8_STAGE(PG8_SB(1, 0), b3, voffB);
            PG8_BAR; PG8_WAIT_L(0); PG8_MMA(0, 1, At, B1); PG8_BAR;
            PG8_LDA(At, 1, 1); PG8_STAGE(PG8_SA(1, 0), a3, voffA);
            PG8_BAR; PG8_WAIT_L(0); PG8_MMA(1, 0, At, B0); PG8_BAR; PG8_SCHED;
            PG8_STAGE(PG8_SB(1, 1), b3 + hstepB, voffB);
            PG8_WAIT_V(6); PG8_BAR; PG8_MMA(1, 1, At, B1); PG8_BAR;
            }
        }
        if constexpr (ALIGN_EPI) { if (wr == 0) PG8_BAR; }
        if constexpr (FP8) asm volatile("s_nop 15\n\ts_nop 15" ::: "memory");
        if constexpr (!Epi::AFTER_DRAIN) { int fr_ = fr, fq_ = fq; asm volatile("" : "+v"(fr_), "+v"(fq_));
            E(acc, cur, wr, wc, fr_, fq_); S.done(cur); }
        if (!has_next) break;
#pragma unroll
        for (int a = 0; a < 2; ++a)
#pragma unroll
            for (int b = 0; b < 2; ++b)
#pragma unroll
                for (int m = 0; m < 4; ++m)
#pragma unroll
                    for (int n = 0; n < 2; ++n) acc[a][b][m][n] = zero4_b64();
        cur = nxt; cA = nA; cB = nB; ++ui;
        if constexpr (ALIGN_EPI) { if (wr == 1) PG8_BAR; }
    }
    PG8_WAIT_V(0);
    if constexpr (!ALIGN_EPI) { if (wr == 0) PG8_BAR; }
    PG8_BAR;
    if constexpr (Epi::AFTER_DRAIN) { E.fused(acc, cur, wr, wc, fr, fq, lds, wid, lane); S.done(cur); }
#undef PG8_SA
#undef PG8_SB
#undef PG8_STAGE
#undef PG8_LDA
#undef PG8_RDA
#undef PG8_RDB
#undef PG8_LDB
#undef PG8_MMA
#undef PG8_WAIT_V
#undef PG8_WAIT_L
#undef PG8_BAR
#undef PG8_SCHED
}
}

#include <hip/hip_bf16.h>
#include <cmath>
namespace attn_body {
using bf16=__hip_bfloat16;
using bf16x8=__attribute__((ext_vector_type(8)))short;
using s16x4=__attribute__((ext_vector_type(4)))short;
using f32x16=__attribute__((ext_vector_type(16)))float;
using u32x4=__attribute__((ext_vector_type(4)))unsigned;
constexpr int BATCH=2,NHEAD=16,SEQ=8192,D=64,DM=NHEAD*D;
constexpr int NW=8,QBLK=32,QB=QBLK*NW,KVBLK=64,NQB=SEQ/QB;
constexpr int ATTN_PITCH=DM, ATTN_UNIT_ROWS=QB;
__device__ __forceinline__ int crow(int r,int hi){return (r&3)+8*(r>>2)+4*hi;}
#define SBAR() __builtin_amdgcn_sched_barrier(0)
__device__ __forceinline__ void cmask(f32x16&p0,f32x16&p1,int jb,int qrel,int hi){
  const float NEG=-INFINITY; int kb=64*jb+4*hi;
  #pragma unroll
  for(int r=0;r<16;++r){int kv=kb+(r&3)+8*(r>>2); if(kv>qrel)p0[r]=NEG; if(kv+32>qrel)p1[r]=NEG;}
}

constexpr int NSLOT=3, SLOTB=8192;
constexpr int LDS_K=0, LDS_V=NSLOT*SLOTB, LDS_WS=2*NSLOT*SLOTB, LDS_OST=LDS_WS+NW*64*4, LDS_NB=LDS_OST+NW*4096  , LDS_PK=LDS_NB+32768+64  , LDS_BYTES=LDS_PK+1024;
constexpr float C2=0.125f*1.4426950408889634f;
__device__ __forceinline__ void glds16(const void*gsrc,unsigned lds_dst){unsigned keep;
  asm volatile("s_mov_b32 %0, m0\n\ts_mov_b32 m0, %2\n\ts_nop 0\n\tglobal_load_lds_dwordx4 %1, off\n\ts_mov_b32 m0, %0":"=&s"(keep):"v"(gsrc),"s"(lds_dst):"memory");}
__device__ __forceinline__ float max3f(float a,float b,float c){float r;asm("v_max3_f32 %0, %1, %2, %3":"=v"(r):"v"(a),"v"(b),"v"(c));return r;}
__device__ __forceinline__ float max2f(float a,float b){float r;asm("v_max_f32_e32 %0, %1, %2":"=v"(r):"v"(a),"v"(b));return r;}
__device__ __forceinline__ float fadd_s(float a,float b){float r;asm("v_add_f32_e32 %0, %1, %2":"=v"(r):"v"(a),"v"(b));return r;}
__device__ __forceinline__ float fsub_s(float a,float b){float r;asm("v_sub_f32_e32 %0, %1, %2":"=v"(r):"v"(a),"v"(b));return r;}
typedef float f32x2_t __attribute__((ext_vector_type(2))); typedef __bf16 bf16x2_t __attribute__((ext_vector_type(2)));
__device__ __forceinline__ unsigned cvtpk_s(float lo,float hi){f32x2_t v={lo,hi};bf16x2_t b=__builtin_convertvector(v,bf16x2_t);return __builtin_bit_cast(unsigned,b);}
#define WAIT_BAR(N) asm volatile("s_waitcnt vmcnt(" #N ") lgkmcnt(0)\n\ts_barrier":::"memory")

__device__ __forceinline__ void qkt(f32x16&p0,f32x16&p1,const char*Kslot,const bf16x8*qr,const f32x16&negm,int r32,int hi){
  const char*kb=Kslot+hi*1024+r32*16;
  #pragma unroll
  for(int d0=0;d0<4;++d0){
    const bf16x8 b0=*reinterpret_cast<const bf16x8*>(kb+d0*2048);
    const bf16x8 b1=*reinterpret_cast<const bf16x8*>(kb+d0*2048+512);
    if(d0==0){p0=__builtin_amdgcn_mfma_f32_32x32x16_bf16(b0,qr[0],negm,0,0,0);p1=__builtin_amdgcn_mfma_f32_32x32x16_bf16(b1,qr[0],negm,0,0,0);}
    else{p0=__builtin_amdgcn_mfma_f32_32x32x16_bf16(b0,qr[d0],p0,0,0,0);p1=__builtin_amdgcn_mfma_f32_32x32x16_bf16(b1,qr[d0],p1,0,0,0);}}
}
typedef __attribute__((address_space(3))) const char* lds_cptr;
typedef short v4i16_t __attribute__((ext_vector_type(4)));
__device__ __forceinline__ void kload8(bf16x8*kf,lds_cptr kp){
  kf[0]=*(const __attribute__((address_space(3))) bf16x8*)(kp);      kf[1]=*(const __attribute__((address_space(3))) bf16x8*)(kp+512);
  kf[2]=*(const __attribute__((address_space(3))) bf16x8*)(kp+2048); kf[3]=*(const __attribute__((address_space(3))) bf16x8*)(kp+2560);
  kf[4]=*(const __attribute__((address_space(3))) bf16x8*)(kp+4096); kf[5]=*(const __attribute__((address_space(3))) bf16x8*)(kp+4608);
  kf[6]=*(const __attribute__((address_space(3))) bf16x8*)(kp+6144); kf[7]=*(const __attribute__((address_space(3))) bf16x8*)(kp+6656);
}
__device__ __forceinline__ void kload2(bf16x8*kf,lds_cptr kp,int j){ kf[2*j]=*(const __attribute__((address_space(3))) bf16x8*)(kp+j*2048); kf[2*j+1]=*(const __attribute__((address_space(3))) bf16x8*)(kp+j*2048+512); }
__device__ __forceinline__ s16x4 vtr(lds_cptr p){ return __builtin_bit_cast(s16x4,__builtin_amdgcn_ds_read_tr16_b64_v4i16((__attribute__((address_space(3))) v4i16_t*)p)); }
__device__ __forceinline__ float rowmax(const f32x16&p0,const f32x16&p1){
  float a=max3f(p0[0],p0[1],p1[0]),b=max3f(p0[2],p0[3],p1[1]);a=max3f(a,p1[2],p1[3]);
  #pragma unroll
  for(int r=4;r<16;r+=4){a=max3f(a,p0[r],p0[r+1]);b=max3f(b,p0[r+2],p0[r+3]);a=max3f(a,p1[r],p1[r+1]);b=max3f(b,p1[r+2],p1[r+3]);}
  const float m=max2f(a,b);
  auto rr=__builtin_amdgcn_permlane32_swap(__float_as_uint(m),__float_as_uint(m),false,false);
  return max2f(__uint_as_float(rr[0]),__uint_as_float(rr[1]));
}
__device__ __forceinline__ void pv(f32x16*o,int vb,bf16x8 pa0,bf16x8 pa1,bf16x8 pa2,bf16x8 pa3){
  #pragma unroll
  for(int d0=0;d0<2;++d0){s16x4 lo[4],hi[4];
    #pragma unroll
    for(int ks=0;ks<4;++ks){
      asm volatile("ds_read_b64_tr_b16 %0,%1 offset:%c2":"=&v"(lo[ks]):"v"(vb),"i"(d0*4096+ks*1024):"memory");
      asm volatile("ds_read_b64_tr_b16 %0,%1 offset:%c2":"=&v"(hi[ks]):"v"(vb),"i"(d0*4096+ks*1024+512):"memory");}
    asm volatile("s_waitcnt lgkmcnt(0)":::"memory");SBAR();
    #define PK(k) (bf16x8){lo[k][0],lo[k][1],lo[k][2],lo[k][3],hi[k][0],hi[k][1],hi[k][2],hi[k][3]}
    o[d0]=__builtin_amdgcn_mfma_f32_32x32x16_bf16(pa0,PK(0),o[d0],0,0,0);
    o[d0]=__builtin_amdgcn_mfma_f32_32x32x16_bf16(pa1,PK(1),o[d0],0,0,0);
    o[d0]=__builtin_amdgcn_mfma_f32_32x32x16_bf16(pa2,PK(2),o[d0],0,0,0);
    o[d0]=__builtin_amdgcn_mfma_f32_32x32x16_bf16(pa3,PK(3),o[d0],0,0,0);
    #undef PK
  }
}

typedef float f32x4_t __attribute__((ext_vector_type(4)));
__device__ __forceinline__ void fox_negcum(const float*logf,__attribute__((address_space(3))) float*ncum,__attribute__((address_space(3))) float*wtot,int tid){
  float loc[16];float s=0.f; const f32x4_t*lp=(const f32x4_t*)(logf+tid*16);
  #pragma unroll
  for(int j=0;j<4;++j){const f32x4_t v=lp[j]; s+=v[0];loc[4*j]=s; s+=v[1];loc[4*j+1]=s; s+=v[2];loc[4*j+2]=s; s+=v[3];loc[4*j+3]=s;}
  float inc=s;
  #pragma unroll
  for(int o=1;o<64;o<<=1){const float v=__shfl_up(inc,o); if((tid&63)>=o)inc+=v;}
  if((tid&63)==63)wtot[tid>>6]=inc;
  __syncthreads();
  float base=inc-s; for(int w=0;w<(tid>>6);++w)base+=wtot[w];
  #pragma unroll
  for(int j=0;j<4;++j){ f32x4_t o4; o4[0]=-(base+loc[4*j]);o4[1]=-(base+loc[4*j+1]);o4[2]=-(base+loc[4*j+2]);o4[3]=-(base+loc[4*j+3]); *(__attribute__((address_space(3))) f32x4_t*)(ncum+tid*16+4*j)=o4; }
  __syncthreads();
}
#ifndef ATTN_STORE16
#define ATTN_STORE16(p,v) (*(u32x4*)(p)=(v))
#endif
template<int THRL> __device__ __forceinline__ void attn_unit(int b,int h,int qb,const bf16*Q,const bf16*__restrict__ K,const bf16*__restrict__ V,bf16*O,char*shm,const float*logf_bh,const unsigned*kn_bh,unsigned char*O8=nullptr){
  int tid_=threadIdx.x; asm volatile("":"+v"(tid_)); const int tid=tid_,lane=tid&63,r32=lane&31,hi=lane>>5; const int wid=__builtin_amdgcn_readfirstlane(tid>>6);
  const long rowbase=(long)b*SEQ; const int q0=qb*QB;
  const bf16*Qw=Q+(rowbase+q0+wid*QBLK)*DM+h*D;
  const bf16*Kh=K+rowbase*DM+h*D,*Vh=V+rowbase*DM+h*D;
  const unsigned lds0=(unsigned)(uintptr_t)shm;
  float*wsf=(float*)(shm+LDS_WS)+wid*64;
  const bf16*ksrc=Kh+(long)lane*DM+wid*8;
  const bf16*vsrc=Vh+(long)(16*(wid&3)+(lane>>2))*DM+(wid>>2)*32+(lane&3)*8;
  const unsigned kdst=lds0+LDS_K+wid*1024, vdst=lds0+LDS_V+wid*1024;
  #define TIDX(t) (NTR-1-(t))
  #define DMA_K(t,slot) glds16(ksrc+(long)TIDX(t)*KVBLK*DM,(unsigned)__builtin_amdgcn_readfirstlane(kdst+(slot)))
  #define DMA_V(t,slot) glds16(vsrc+(long)TIDX(t)*KVBLK*DM,(unsigned)__builtin_amdgcn_readfirstlane(vdst+(slot)))
  const int vb0=(int)(lds0+LDS_V)+((lane>>4)&1)*32+(lane&3)*8+(4*hi+((lane&15)>>2))*64;
  const char*Kbase=shm+LDS_K; bf16x8 kf[8];
  const lds_cptr shm3=(lds_cptr)shm; const lds_cptr kp0=shm3+LDS_K+hi*1024+r32*16; const lds_cptr vp0=shm3+LDS_V+((lane>>4)&1)*32+(lane&3)*8+(4*hi+((lane&15)>>2))*64;
  const int NTR=(q0+QB)/KVBLK;
  const lds_cptr shm3b=(lds_cptr)shm;
  const __attribute__((address_space(3))) float* nb3=(const __attribute__((address_space(3))) float*)(shm3b+LDS_NB);
  fox_negcum(logf_bh,(__attribute__((address_space(3))) float*)(shm3b+LDS_NB),(__attribute__((address_space(3))) float*)(shm3b+LDS_NB+32768),tid);
  int NT;
  { __attribute__((address_space(3))) float* PK=(__attribute__((address_space(3))) float*)(shm3b+LDS_PK);
    __attribute__((address_space(3))) int* JX=(__attribute__((address_space(3))) int*)(shm3b+LDS_PK+512);
    float pk=0.f;
    if(tid<128){ const float a=__uint_as_float(kn_bh[2*tid]),c=__uint_as_float(kn_bh[2*tid+1]); pk=__builtin_sqrtf(a+c)*1.001f; }
    #pragma unroll
    for(int o_=1;o_<64;o_<<=1){const float v=__shfl_up(pk,o_); if((tid&63)>=o_)pk=__builtin_fmaxf(pk,v);}
    if(tid==63)PK[128]=pk;
    __syncthreads();
    if(tid>=64&&tid<128)pk=__builtin_fmaxf(pk,PK[128]);
    if(tid<128)PK[tid]=pk;
    const bf16*Krow=Kh+(long)(q0+wid*QBLK+r32)*DM+hi*8; const bf16*Qrow=Qw+(long)r32*DM+hi*8; float qq=0.f,qk=0.f;
    #pragma unroll
    for(int d0=0;d0<4;++d0){ const u32x4 qa=*reinterpret_cast<const u32x4*>(Qrow+d0*16), ka=*reinterpret_cast<const u32x4*>(Krow+d0*16);
      #pragma unroll
      for(int e=0;e<4;++e){ const float q0f=__uint_as_float(qa[e]<<16),q1f=__uint_as_float(qa[e]&0xffff0000u),k0f=__uint_as_float(ka[e]<<16),k1f=__uint_as_float(ka[e]&0xffff0000u);
        qq+=q0f*q0f+q1f*q1f; qk+=q0f*k0f+q1f*k1f; } }
    { auto r1=__builtin_amdgcn_permlane32_swap(__float_as_uint(qq),__float_as_uint(qq),false,false); qq=__uint_as_float(r1[0])+__uint_as_float(r1[1]);
      auto r2=__builtin_amdgcn_permlane32_swap(__float_as_uint(qk),__float_as_uint(qk),false,false); qk=__uint_as_float(r2[0])+__uint_as_float(r2[1]); }
    __syncthreads();
    const float qn=__builtin_sqrtf(qq)*1.001f, thr=qk+nb3[q0+wid*QBLK+r32]-152.f;
    int lo_=0,hi_=NTR;
    #pragma unroll 1
    for(int it=0;it<8;++it){ if(lo_<hi_){ const int mid=(lo_+hi_)>>1; const float f=qn*PK[mid]+nb3[64*mid+63]; if(f>=thr)hi_=mid; else lo_=mid+1; } }
    #pragma unroll
    for(int o_=1;o_<64;o_<<=1){const int v=__shfl_xor(lo_,o_); lo_=v<lo_?v:lo_;}
    if(lane==0)JX[wid]=lo_;
    __syncthreads();
    int j0=JX[0];
    #pragma unroll
    for(int w=1;w<8;++w){const int v=JX[w]; j0=v<j0?v:j0;}
    j0=__builtin_amdgcn_readfirstlane(j0);
    int nte=(NTR-j0+1)&~1; NT=nte<4?4:nte;
    __syncthreads();
  }
  { __attribute__((address_space(3))) float* nbw=(__attribute__((address_space(3))) float*)(shm3b+LDS_NB);
    const float ref_=nbw[q0+QB-1];
    __syncthreads();
    #pragma unroll
    for(int j=0;j<16;++j){ const float v=nbw[tid*16+j]-ref_; const unsigned h_=cvtpk_s(v,0.f)&0xffffu; const float hf_=__uint_as_float(h_<<16); const unsigned l_=cvtpk_s(v-hf_,0.f)&0xffffu;
      ((__attribute__((address_space(3))) unsigned*)nbw)[tid*16+j]=h_|(l_<<16); }
    __syncthreads();
  }
  const __attribute__((address_space(3))) unsigned* nbp=(const __attribute__((address_space(3))) unsigned*)(shm3b+LDS_NB);
  const unsigned mh0=(hi==0)?0xffffffffu:0u, onesm=0x3f803f80u&mh0;
  u32x4 qxw={onesm,0u,0u,0u};
  #define QX_SET() do{ const float nm_=-mhat; const unsigned h_=cvtpk_s(nm_,0.f)&0xffffu; const unsigned l_=cvtpk_s(nm_-__uint_as_float(h_<<16),0.f)&0xffffu; qxw[1]=(h_|(l_<<16))&mh0; }while(0)
  #define KXF(pr) __builtin_bit_cast(bf16x8,(u32x4){(pr)&mh0,onesm,0u,0u})
  #define BIASMMA(C0,C1,t) do{ const unsigned pr0_=nbp[64*TIDX(t)+r32],pr1_=nbp[64*TIDX(t)+32+r32]; \
    C0=__builtin_amdgcn_mfma_f32_32x32x16_bf16(KXF(pr0_),__builtin_bit_cast(bf16x8,qxw),C0,0,0,0); C1=__builtin_amdgcn_mfma_f32_32x32x16_bf16(KXF(pr1_),__builtin_bit_cast(bf16x8,qxw),C1,0,0,0); }while(0)
  DMA_K(0,0);DMA_V(0,0);DMA_K(1,SLOTB);
  bf16x8 qr[4];
  #pragma unroll
  for(int d0=0;d0<4;++d0)qr[d0]=*reinterpret_cast<const bf16x8*>(&Qw[(long)r32*DM+d0*16+hi*8]);
  float mhat=0.f,l_reg=0.f;f32x16 o[2];o[0]=f32x16{};o[1]=f32x16{};const f32x16 negm=f32x16{};
  const int qrel=wid*QBLK+r32;
  #define CMASK(P0,P1,t) do{ if((t)<4){ cmask(P0,P1,3-(t),qrel,hi); } }while(0)
  bool resc=false;
  #define START(P0,P1) do{ const float rm=rowmax(P0,P1); resc=false; \
    { const float dl=(rm>-3.0e38f)?__builtin_ceilf(rm*16.f)*0.0625f:0.f; mhat=fadd_s(mhat,dl);     \
      _Pragma("unroll") for(int r=0;r<16;++r){P0[r]=fsub_s(P0[r],dl);P1[r]=fsub_s(P1[r],dl);} \
      QX_SET(); } \
    _Pragma("unroll") for(int r=0;r<16;++r)P0[r]=__builtin_amdgcn_exp2f(P0[r]); }while(0)
  #define RESC() do{ if(resc){ asm volatile("s_waitcnt lgkmcnt(0)":::"memory"); \
      _Pragma("unroll") for(int d_=0;d_<2;++d_) _Pragma("unroll") for(int r=0;r<16;++r)o[d_][r]*=wsf[crow(r,hi)]; } }while(0)
  f32x16 pA0,pA1,pB0,pB1;
  int sl_prev=0,sl_cur=0,sl_next=SLOTB;
  #define ROT() do{sl_prev=sl_cur;sl_cur=sl_next;sl_next=(sl_next==(NSLOT-1)*SLOTB)?0:sl_next+SLOTB;}while(0)
  DMA_K(2,2*SLOTB);
  WAIT_BAR(3);
  qkt(pA0,pA1,Kbase,qr,negm,r32,hi);BIASMMA(pA0,pA1,0);asm volatile("s_nop 15\n\ts_nop 7":"+v"(pA0),"+v"(pA1));CMASK(pA0,pA1,0);
  START(pA0,pA1);
  _Pragma("unroll") for(int r=0;r<16;++r)pA1[r]=__builtin_amdgcn_exp2f(pA1[r]);
  WAIT_BAR(0);
  DMA_K(3,0);DMA_V(1,SLOTB);
  ROT();
  kload8(kf,kp0+sl_cur);
  WAIT_BAR(2);
  s16x4 vlo[8],vhi[8]; u32x4 pw0,pw1,pw2,pw3;
  #define PKW(P,B) cvtpk_s(P[B],P[B+1])
  #define PAF(k) __builtin_bit_cast(bf16x8,pw##k)
  #define VFR(i) (bf16x8){vlo[i][0],vlo[i][1],vlo[i][2],vlo[i][3],vhi[i][0],vhi[i][1],vhi[i][2],vhi[i][3]}
  #define PIN(x) asm volatile("":"+v"(x))
  #define MX3(a,b,c) __builtin_fmaxf(__builtin_fmaxf((a),(b)),(c))
  #define GAPA(MF,A0,A1,A2,A3,W0,W1,PW) do{ MF; sacc+=A0; sacc+=A1; sacc+=A2; sacc+=A3; PIN(sacc); W0; W1; PIN(PW); SBAR(); }while(0)
  #define EX(v) __builtin_amdgcn_exp2f(v)
  #define GAPB(MF,X,B) do{ MF; X[B]=EX(X[B]); X[B+1]=EX(X[B+1]); X[B+2]=EX(X[B+2]); X[B+3]=EX(X[B+3]); PIN(X); SBAR(); }while(0)
  #define VRD(i) do{ vlo[i]=vtr(vp_+(((i)>>2)*4096+((i)&3)*1024)); vhi[i]=vtr(vp_+(((i)>>2)*4096+((i)&3)*1024+512)); }while(0)
  #define KRD(G,j) do{ if(G){ kload2(kf,kp0+sl_next,j); SBAR(); } }while(0)
  #define STEP(C0,C1,P0,P1,t,GK,GV,GL) do{ SBAR(); \
    const lds_cptr vp_=vp0+sl_prev; \
    VRD(0); SBAR(); float sacc=(P0[0]+P0[1]); \
    GAPA(C0=__builtin_amdgcn_mfma_f32_32x32x16_bf16(kf[0],qr[0],negm,0,0,0), P0[2],P0[3],P0[4],P0[5],     pw0[0]=PKW(P0,0), pw0[1]=PKW(P0,2), pw0); \
    VRD(4); SBAR(); GAPA(C1=__builtin_amdgcn_mfma_f32_32x32x16_bf16(kf[1],qr[0],negm,0,0,0), P0[6],P0[7],P0[8],P0[9],     pw0[2]=PKW(P0,4), pw0[3]=PKW(P0,6), pw0); \
    VRD(1); SBAR(); GAPA(C0=__builtin_amdgcn_mfma_f32_32x32x16_bf16(kf[2],qr[1],C0,0,0,0),   P0[10],P0[11],P0[12],P0[13], pw1[0]=PKW(P0,8), pw1[1]=PKW(P0,10), pw1); \
    VRD(5); SBAR(); GAPA(C1=__builtin_amdgcn_mfma_f32_32x32x16_bf16(kf[3],qr[1],C1,0,0,0),   P0[14],P0[15],P1[0],P1[1],   pw1[2]=PKW(P0,12),pw1[3]=PKW(P0,14), pw1); \
    VRD(2); SBAR(); GAPA(C0=__builtin_amdgcn_mfma_f32_32x32x16_bf16(kf[4],qr[2],C0,0,0,0),   P1[2],P1[3],P1[4],P1[5],     pw2[0]=PKW(P1,0), pw2[1]=PKW(P1,2), pw2); \
    VRD(6); SBAR(); GAPA(C1=__builtin_amdgcn_mfma_f32_32x32x16_bf16(kf[5],qr[2],C1,0,0,0),   P1[6],P1[7],P1[8],P1[9],     pw2[2]=PKW(P1,4), pw2[3]=PKW(P1,6), pw2); \
    VRD(3); SBAR(); GAPA(C0=__builtin_amdgcn_mfma_f32_32x32x16_bf16(kf[6],qr[3],C0,0,0,0),   P1[10],P1[11],P1[12],P1[13], pw3[0]=PKW(P1,8), pw3[1]=PKW(P1,10), pw3); \
    VRD(7); SBAR(); GAPA(C1=__builtin_amdgcn_mfma_f32_32x32x16_bf16(kf[7],qr[3],C1,0,0,0),   P1[14],P1[15],0.f,0.f,       pw3[2]=PKW(P1,12),pw3[3]=PKW(P1,14), pw3); \
    l_reg+=sacc; \
    if(GK){DMA_K((t)+3,sl_cur);} if(GV){DMA_V((t)+1,sl_next);} \
    BIASMMA(C0,C1,t); CMASK(C0,C1,t); \
    { float a=MX3(C0[0],C0[1],C1[0]),b=MX3(C0[2],C0[3],C1[1]); a=MX3(a,C1[2],C1[3]); \
      _Pragma("unroll") for(int r=4;r<16;r+=4){a=MX3(a,C0[r],C0[r+1]);b=MX3(b,C0[r+2],C0[r+3]);a=MX3(a,C1[r],C1[r+1]);b=MX3(b,C1[r+2],C1[r+3]);} \
      float rm=__builtin_fmaxf(a,b); { auto rr=__builtin_amdgcn_permlane32_swap(__float_as_uint(rm),__float_as_uint(rm),false,false); rm=__builtin_fmaxf(__uint_as_float(rr[0]),__uint_as_float(rr[1])); } \
      resc=false; \
      if(__builtin_expect(__any(rm>(float)THRL),0)){ const float dl=__builtin_fmaxf(__builtin_ceilf(rm*16.f)*0.0625f,0.f); mhat+=dl; QX_SET(); \
        _Pragma("unroll") for(int r=0;r<16;++r){C0[r]-=dl;C1[r]-=dl;} \
        const float f=__builtin_amdgcn_exp2f(-dl); l_reg*=f; if(hi==0)wsf[r32]=f; resc=true; } } \
    SBAR(); \
    GAPB(o[0]=__builtin_amdgcn_mfma_f32_32x32x16_bf16(PAF(0),VFR(0),o[0],0,0,0), C0,0); \
    GAPB(o[1]=__builtin_amdgcn_mfma_f32_32x32x16_bf16(PAF(0),VFR(4),o[1],0,0,0), C0,4); \
    KRD(GL,0); GAPB(o[0]=__builtin_amdgcn_mfma_f32_32x32x16_bf16(PAF(1),VFR(1),o[0],0,0,0), C0,8); \
    KRD(GL,1); GAPB(o[1]=__builtin_amdgcn_mfma_f32_32x32x16_bf16(PAF(1),VFR(5),o[1],0,0,0), C0,12); \
    KRD(GL,2); GAPB(o[0]=__builtin_amdgcn_mfma_f32_32x32x16_bf16(PAF(2),VFR(2),o[0],0,0,0), C1,0); \
    KRD(GL,3); GAPB(o[1]=__builtin_amdgcn_mfma_f32_32x32x16_bf16(PAF(2),VFR(6),o[1],0,0,0), C1,4); \
    GAPB(o[0]=__builtin_amdgcn_mfma_f32_32x32x16_bf16(PAF(3),VFR(3),o[0],0,0,0), C1,8); \
    GAPB(o[1]=__builtin_amdgcn_mfma_f32_32x32x16_bf16(PAF(3),VFR(7),o[1],0,0,0), C1,12); \
    }while(0)
  int t=1;
  for(int it_=0;it_<2&&t+5<NT;++it_,t+=2){
    STEP(pB0,pB1,pA0,pA1,t,true,true,true);     WAIT_BAR(2); RESC(); ROT();
    STEP(pA0,pA1,pB0,pB1,t+1,true,true,true);   WAIT_BAR(2); RESC(); ROT();
  }
  #undef CMASK
  #define CMASK(P0,P1,t) do{}while(0)
  for(;t+5<NT;t+=2){
    STEP(pB0,pB1,pA0,pA1,t,true,true,true);     WAIT_BAR(2); RESC(); ROT();
    STEP(pA0,pA1,pB0,pB1,t+1,true,true,true);   WAIT_BAR(2); RESC(); ROT();
  }
  #undef CMASK
  #define CMASK(P0,P1,t) do{ if((t)<4){ cmask(P0,P1,3-(t),qrel,hi); } }while(0)
  #define ENDW(tt) do{ if((tt)+3<NT){WAIT_BAR(2);} else if((tt)+2<NT){WAIT_BAR(1);} else {WAIT_BAR(0);} }while(0)
  for(;t+1<NT;t+=2){
    STEP(pB0,pB1,pA0,pA1,t,(t+3<NT),(t+1<NT),(t+1<NT));       ENDW(t);   RESC(); ROT();
    STEP(pA0,pA1,pB0,pB1,t+1,(t+4<NT),(t+2<NT),(t+2<NT));     ENDW(t+1); RESC(); ROT();
  }
  STEP(pB0,pB1,pA0,pA1,NT-1,false,false,false); RESC();
  { float sacc=pB0[0]+pB0[1]; _Pragma("unroll") for(int r=2;r<16;++r)sacc+=pB0[r]; _Pragma("unroll") for(int r=0;r<16;++r)sacc+=pB1[r]; l_reg+=sacc;
    pw0=(u32x4){PKW(pB0,0),PKW(pB0,2),PKW(pB0,4),PKW(pB0,6)};pw1=(u32x4){PKW(pB0,8),PKW(pB0,10),PKW(pB0,12),PKW(pB0,14)};pw2=(u32x4){PKW(pB1,0),PKW(pB1,2),PKW(pB1,4),PKW(pB1,6)};pw3=(u32x4){PKW(pB1,8),PKW(pB1,10),PKW(pB1,12),PKW(pB1,14)};
    SBAR(); pv(o,vb0+sl_cur,PAF(0),PAF(1),PAF(2),PAF(3)); }
  #undef PKW
  #undef PAF
  #undef VFR
  #undef PIN
  #undef MX3
  #undef GAPA
  #undef GAPB
  #undef EX
  #undef VRD
  #undef KRD
  #undef STEP
  #undef ENDW
  {auto rr=__builtin_amdgcn_permlane32_swap(__float_as_uint(l_reg),__float_as_uint(l_reg),false,false);l_reg=__uint_as_float(rr[0])+__uint_as_float(rr[1]);}
  if(hi==0)wsf[32+r32]=l_reg;asm volatile("s_waitcnt lgkmcnt(0)":::"memory");
  float rli[16];
  #pragma unroll
  for(int r=0;r<16;++r)rli[r]=__builtin_amdgcn_rcpf(wsf[32+crow(r,hi)]);
  if(O8){ unsigned char*stg8=(unsigned char*)(shm+LDS_OST)+wid*4096;
    #pragma unroll
    for(int r=0;r<16;++r){const int orow=crow(r,hi);
      #pragma unroll
      for(int d0=0;d0<2;++d0)stg8[orow*64+d0*32+r32]=(unsigned char)(__builtin_amdgcn_cvt_pk_fp8_f32(o[d0][r]*rli[r],0.f,0,false)&0xff);}
    asm volatile("s_waitcnt lgkmcnt(0)":::"memory");
    unsigned char*Ow8=O8+(rowbase+q0+wid*QBLK)*1024+h*D;
    #pragma unroll
    for(int i=0;i<2;++i){const int row=i*16+(lane>>2),ch=lane&3; const u32x4 v=*(const u32x4*)(stg8+row*64+ch*16); ATTN_STORE16(Ow8+(long)row*1024+ch*16,v);} }
  else{
  bf16*Ow=O+(rowbase+q0+wid*QBLK)*DM+h*D;
  { bf16*stg=(bf16*)(shm+LDS_OST)+wid*2048;
    #pragma unroll
    for(int r=0;r<16;++r){const int orow=crow(r,hi);
      #pragma unroll
      for(int d0=0;d0<2;++d0)stg[orow*64+d0*32+r32]=__float2bfloat16(o[d0][r]*rli[r]);}
    asm volatile("s_waitcnt lgkmcnt(0)":::"memory");
    #pragma unroll
    for(int i=0;i<4;++i){const int row=i*8+(lane>>3),ch=lane&7; const u32x4 v=*(const u32x4*)(stg+row*64+ch*8); ATTN_STORE16(Ow+(long)row*DM+ch*8,v);} } }
  asm volatile("s_waitcnt lgkmcnt(0)\n\ts_barrier":::"memory");
  #undef BIASMMA
  #undef KXF
  #undef QX_SET
  #undef TIDX
  #undef DMA_K
  #undef DMA_V
  #undef CMASK
  #undef START
  #undef RESC
  #undef ROT
}

template<int PITCH> __device__ __forceinline__ void sb_unit(int b,int h,int qb,const bf16*Q,const bf16*__restrict__ K,const bf16*__restrict__ V,bf16*O  ,char*shm){
  int tid_=threadIdx.x; asm volatile("":"+v"(tid_)); const int tid=tid_,lane=tid&63,r32=lane&31,hi=lane>>5; const int wid=__builtin_amdgcn_readfirstlane(tid>>6);
  const long rowbase=(long)b*SEQ; const int q0=qb*QB;
  const bf16*Qw=Q+(rowbase+q0+wid*QBLK)*PITCH+h*D;
  const bf16*Kh=K+rowbase*PITCH+h*D,*Vh=V+rowbase*PITCH+h*D;
  const unsigned lds0=(unsigned)(uintptr_t)shm;
  const bf16*ksrc=Kh+(long)lane*PITCH+wid*8;
  const bf16*vsrc=Vh+(long)(16*(wid&3)+(lane>>2))*PITCH+(wid>>2)*32+(lane&3)*8;
  const unsigned kdst=lds0+LDS_K+wid*1024, vdst=lds0+LDS_V+wid*1024;
  #define SB_DMA(t,slot) do{ glds16(ksrc+(long)(t)*KVBLK*PITCH,(unsigned)__builtin_amdgcn_readfirstlane(kdst+(slot))); glds16(vsrc+(long)(t)*KVBLK*PITCH,(unsigned)__builtin_amdgcn_readfirstlane(vdst+(slot))); }while(0)
  const int vb0=(int)(lds0+LDS_V)+((lane>>4)&1)*32+(lane&3)*8+(4*hi+((lane&15)>>2))*64;
  volatile __attribute__((address_space(3))) unsigned* fl=(volatile __attribute__((address_space(3))) unsigned*)((lds_cptr)shm+LDS_WS);
  const int NT=(q0+QB)/KVBLK; const int qrel=wid*QBLK+r32;
  SB_DMA(NT-1,0);
  bf16x8 qr[4];
  #pragma unroll
  for(int d0=0;d0<4;++d0)qr[d0]=*reinterpret_cast<const bf16x8*>(&Qw[(long)r32*PITCH+d0*16+hi*8]);
  f32x16 o[2];o[0]=f32x16{};o[1]=f32x16{}; const f32x16 zero16=f32x16{};
  float carry=1.f;
  int slot=0;
  #define SB_TILE(BAND) do{ \
    if(!(BAND&&64*(t-(NT-4))>wid*QBLK+QBLK-1)){ \
    f32x16 p0,p1; qkt(p0,p1,shm+LDS_K+slot,qr,zero16,r32,hi); \
    if(BAND){ const int kb=64*(t-(NT-4))+4*hi;                 \
      _Pragma("unroll") for(int r=0;r<16;++r){const int kv=kb+(r&3)+8*(r>>2); if(kv>=qrel)p0[r]=-INFINITY; if(kv+32>=qrel)p1[r]=-INFINITY;} } \
      \
      \
    f32x16 s0,s1;                                                \
    _Pragma("unroll") for(int r=0;r<16;++r){ const float z=p0[r]; const float e=__builtin_amdgcn_exp2f(-__builtin_fmaxf(z,-100.f)); const float rb=__builtin_amdgcn_rcpf(1.f+e); const float y=p1[r]; const float f=__builtin_amdgcn_exp2f(-__builtin_fmaxf(y,-100.f)); const float rc=__builtin_amdgcn_rcpf(1.f+f); \
      if(BAND){ const bool mk=z<-1.0e30f; p0[r]=mk?0.f:rb; s0[r]=mk?1.f:e*rb; const bool mj=y<-1.0e30f; p1[r]=mj?0.f:rc; s1[r]=mj?1.f:f*rc; } \
      else { p0[r]=rb; s0[r]=e*rb; p1[r]=rc; s1[r]=f*rc; } } \
    float lo[8],hv[8];                                          \
    _Pragma("unroll") for(int i=0;i<8;++i){ const float mine=(i<4)?((s0[4*i]*s0[4*i+1])*(s0[4*i+2]*s0[4*i+3])):((s1[4*i-16]*s1[4*i-15])*(s1[4*i-14]*s1[4*i-13])); \
      auto rr=__builtin_amdgcn_permlane32_swap(__float_as_uint(mine),__float_as_uint(mine),false,false); lo[i]=__uint_as_float(rr[0]); hv[i]=__uint_as_float(rr[1]); } \
    float sp_=carry;                                             \
    _Pragma("unroll") for(int i=7;i>=0;--i){ float a=sp_*((hi==0)?hv[i]:1.f);       \
      if(i<4){ p0[4*i+3]*=a; a*=s0[4*i+3]; p0[4*i+2]*=a; a*=s0[4*i+2]; p0[4*i+1]*=a; a*=s0[4*i+1]; p0[4*i]*=a; } \
      else   { const int j=4*i-16; p1[j+3]*=a; a*=s1[j+3]; p1[j+2]*=a; a*=s1[j+2]; p1[j+1]*=a; a*=s1[j+1]; p1[j]*=a; } \
      sp_*=lo[i]*hv[i]; } \
    carry=sp_; \
    { u32x4 pw0,pw1,pw2,pw3; \
      pw0=(u32x4){cvtpk_s(p0[0],p0[1]),cvtpk_s(p0[2],p0[3]),cvtpk_s(p0[4],p0[5]),cvtpk_s(p0[6],p0[7])}; pw1=(u32x4){cvtpk_s(p0[8],p0[9]),cvtpk_s(p0[10],p0[11]),cvtpk_s(p0[12],p0[13]),cvtpk_s(p0[14],p0[15])}; \
      pw2=(u32x4){cvtpk_s(p1[0],p1[1]),cvtpk_s(p1[2],p1[3]),cvtpk_s(p1[4],p1[5]),cvtpk_s(p1[6],p1[7])}; pw3=(u32x4){cvtpk_s(p1[8],p1[9]),cvtpk_s(p1[10],p1[11]),cvtpk_s(p1[12],p1[13]),cvtpk_s(p1[14],p1[15])}; \
      pv(o,vb0+slot,__builtin_bit_cast(bf16x8,pw0),__builtin_bit_cast(bf16x8,pw1),__builtin_bit_cast(bf16x8,pw2),__builtin_bit_cast(bf16x8,pw3)); } \
    } \
    { const bool done_=__all(carry==0.f); if(lane==0)fl[(t&1)*8+wid]=done_?1u:0u; } \
    slot^=SLOTB; }while(0)
  #define SB_HEAD() { WAIT_BAR(0); \
    if(t<NT-1){ const int pb=((t+1)&1)*8; const unsigned a=fl[pb]&fl[pb+1]&fl[pb+2]&fl[pb+3]&fl[pb+4]&fl[pb+5]&fl[pb+6]&fl[pb+7]; if(__builtin_amdgcn_readfirstlane(a)!=0u)break; } \
    if(t>0)SB_DMA(t-1,slot^SLOTB); }
  int t=NT-1; bool live=true;
  for(;t>=NT-4;--t){ live=false; SB_HEAD(); SB_TILE(true); live=true; }
  if(live){ for(;t>=0;--t){ SB_HEAD(); SB_TILE(false); } }
  #undef SB_TILE
  #undef SB_HEAD
  asm volatile("s_waitcnt vmcnt(0) lgkmcnt(0)":::"memory");
  bf16*Ow=O+(rowbase+q0+wid*QBLK)*1024+h*D;
  { bf16*stg=(bf16*)(shm+LDS_OST)+wid*2048;
    #pragma unroll
    for(int r=0;r<16;++r){const int orow=crow(r,hi);
      #pragma unroll
      for(int d0=0;d0<2;++d0)stg[orow*64+d0*32+r32]=__float2bfloat16(o[d0][r]);}
    asm volatile("s_waitcnt lgkmcnt(0)":::"memory");
    #pragma unroll
    for(int i=0;i<4;++i){const int row=i*8+(lane>>3),ch=lane&7; const u32x4 v=*(const u32x4*)(stg+row*64+ch*8); ATTN_STORE16(Ow+(long)row*1024+ch*8,v);} }
  asm volatile("s_waitcnt vmcnt(0) lgkmcnt(0)\n\ts_barrier":::"memory");
  #undef SB_DMA
}
constexpr int ATTN_LDS_BYTES=LDS_BYTES;
struct AttnTensors { const bf16* Q; const bf16* K; const bf16* V; bf16* O; const float* logf;   const unsigned* kn;   };
#undef SBAR
#undef WAIT_BAR
}
constexpr int NWAVES = 8, NTHREADS = NWAVES * 64;
constexpr int BATCH = 2, SEQ = 8192, D = 1024, M = BATCH * SEQ;
constexpr int S5G = 32, S5H = 16, S5P = 64, S5T = 32  , S5NC = M / S5T  , S5KX = 640  ;
constexpr int SBH = 8, FOXH = 16, HD = 64;
constexpr int EVEN_IN = 2048, ODD_IN = 3088, DFF = 2816, NEXP = 8, DFE = 3584;
constexpr float C2 = 0.125f * 1.4426950408889634f;
constexpr int MOE_MAX_PANELS = 136, MOE_MAX_SLOTS = MOE_MAX_PANELS * 256, MOE_CAP = 16384  ;

constexpr size_t MiB = 1u << 20;
constexpr size_t WS_CTL = 0, CTL_ZERO_BYTES = 1 * MiB;
constexpr size_t WS_WMOE_GU = 1 * MiB;
constexpr size_t WS_WMOE_D = 57 * MiB;
constexpr size_t WS_WIN0 = 85 * MiB;
constexpr size_t WS_WGLU = 89 * MiB;
constexpr size_t WS_WOUT0 = 90 * MiB;
constexpr size_t WS_WGU0 = 92 * MiB;
constexpr size_t WS_WD0 = 103 * MiB;
constexpr size_t WS_WIN1 = 109 * MiB;
constexpr size_t WS_WF1 = 115 * MiB;
constexpr size_t WS_WOUT1 = 116 * MiB;
constexpr size_t WS_S5WA = 118 * MiB;
constexpr size_t WS_S5WC = 126 * MiB;
constexpr size_t WS_XB = 146 * MiB;
constexpr size_t WS_SSP = 178 * MiB;
constexpr size_t WS_META = 182 * MiB;
constexpr size_t WS_LOGF = 183 * MiB;
constexpr size_t WS_QKV0 = 184 * MiB;
constexpr size_t WS_UEXT = 232 * MiB;
constexpr size_t WS_SLOC = 252 * MiB;
constexpr size_t WS_YG = 260 * MiB;
constexpr size_t WS_MIXB = 276 * MiB;
constexpr size_t WS_HID0 = 184 * MiB;
constexpr size_t WS_QKV1 = 184 * MiB;
constexpr size_t WS_XG = 184 * MiB;
constexpr size_t WS_HMOE = 312 * MiB;
constexpr size_t WS_Y = 85 * MiB;
constexpr size_t WS_END = 432 * MiB;
static_assert(WS_XG + (size_t)8 * MOE_CAP * 1024 <= WS_HMOE && WS_HMOE + (size_t)MOE_MAX_SLOTS * DFE <= WS_END && WS_Y + (size_t)MOE_MAX_SLOTS * 1024 * 2 <= WS_XB + 32 * MiB && WS_MIXB + 32 * MiB <= WS_END, "ws map");
constexpr size_t MT_RSTD = 0, MT_TOKE = 65536, MT_TOKP = 131072, MT_TOKG = 262144, MT_RSS = 524288;
constexpr int CW_TMO = 0, CW_CODE = 1, CW_BAR = 4096, CW_CNT = 8192  , CW_QUEUE = 12288  , CW_QUEUE2 = 12352  , CW_KN = 16384  ;
constexpr int CW_SUBBAR = 32768;

constexpr int RING_OFF = 0, RING_BYTES = 131072;
constexpr int LDSCTL_OFF = 133120  , MISC_OFF = LDSCTL_OFF + 320;
constexpr int LDS_BYTES = 147456;

#define GAS __attribute__((address_space(1)))
#define LAS __attribute__((address_space(3)))
typedef unsigned short bf16;
typedef unsigned v4u __attribute__((ext_vector_type(4)));
typedef unsigned v2u __attribute__((ext_vector_type(2)));
typedef float f32x4 __attribute__((ext_vector_type(4)));
typedef short bf16x8 __attribute__((ext_vector_type(8)));
typedef GAS unsigned gu32;
#define RLX_AGENT __ATOMIC_RELAXED, __HIP_MEMORY_SCOPE_AGENT
#define LDS_WAIT() asm volatile("s_waitcnt lgkmcnt(0)" ::: "memory")
#define VM_WAIT() asm volatile("s_waitcnt vmcnt(0)" ::: "memory")
__device__ __forceinline__ unsigned f2bf(float f) { unsigned u = __builtin_bit_cast(unsigned, f); return (u + 0x7fffu + ((u >> 16) & 1u)) >> 16; }
__device__ __forceinline__ unsigned pk2(float lo, float hi) { return f2bf(lo) | (f2bf(hi) << 16); }
__device__ __forceinline__ float bflo(unsigned w) { return __uint_as_float(w << 16); }
__device__ __forceinline__ float bfhi(unsigned w) { return __uint_as_float(w & 0xffff0000u); }

#define XB_TMO      128
#define XB_XCNT(j)  (256  + 64 * (j))
#define XB_XSUB(j)  (1280 + 64 * (j))
#define XB_XGEN(j)  (2304 + 64 * (j))
#define XB_TOP      3328
#define XB_TOPGEN   3392
#define XCD_BAR_WORDS 3456
#define XB_SPIN_CAP (1u << 18)
__device__ __forceinline__ unsigned xb_ld(unsigned* p)              { return __hip_atomic_load(p, __ATOMIC_RELAXED, __HIP_MEMORY_SCOPE_AGENT); }
__device__ __forceinline__ unsigned xb_add(unsigned* p, unsigned v) { return __hip_atomic_fetch_add(p, v, __ATOMIC_RELAXED, __HIP_MEMORY_SCOPE_AGENT); }
__device__ __forceinline__ unsigned xb_xcc_id() { return (unsigned)__builtin_amdgcn_s_getreg((3 << 11) | 20) & 0xFu; }
#define XB_SPIN(cond, bar) do { unsigned _sp = 0; while (cond) { __builtin_amdgcn_s_sleep(1); \
    if ((++_sp & 255u) == 0u) { if (xb_ld(&(bar)[XB_TMO])) break; if (_sp > XB_SPIN_CAP) { atomicAdd(&(bar)[XB_TMO], 1u); break; } } } } while (0)
struct XcdBarrier { unsigned* bar; unsigned x; volatile LAS unsigned* st; unsigned total; };
__device__ __forceinline__ XcdBarrier xcd_barrier_post(unsigned* bar, volatile LAS unsigned* st, unsigned total) {
    XcdBarrier b; b.bar = bar; b.x = xb_xcc_id(); b.st = st; b.total = total;
    if (threadIdx.x == 0) (void)xb_add(&bar[XB_XCNT(b.x)], 1u);
    return b;
}
__device__ __forceinline__ void xcd_barrier_complete(unsigned* bar, unsigned x, unsigned G, unsigned& nloc, unsigned& nx) {
    unsigned sum, cnt, mine, sp = 0u;
    for (;;) {
        sum = 0u; cnt = 0u; mine = 0u;
#pragma unroll
        for (unsigned j = 0; j < 16; ++j) { const unsigned c = xb_ld(&bar[XB_XCNT(j)]); sum += c; cnt += (c > 0u) ? 1u : 0u; mine = (j == x) ? c : mine; }
        if (sum == G) break;
        __builtin_amdgcn_s_sleep(1);
        if ((++sp & 255u) == 0u) { if (xb_ld(&bar[XB_TMO])) break; if (sp > XB_SPIN_CAP) { atomicAdd(&bar[XB_TMO], 1u); break; } }
    }
    nloc = mine > 0u ? mine : 1u; nx = cnt > 0u ? cnt : 1u;
}
__device__ __forceinline__ void xcd_barrier(const XcdBarrier& b) {
    asm volatile("s_waitcnt vmcnt(0)" ::: "memory");
    __syncthreads();
    if (threadIdx.x == 0) {
        unsigned* bar = b.bar;
        __builtin_amdgcn_s_waitcnt(0);
        unsigned nloc = b.st[0], nx = b.st[1];
        if (nloc == 0u) { xcd_barrier_complete(bar, b.x, b.total, nloc, nx); b.st[0] = nloc; b.st[1] = nx; }
        const unsigned old = xb_add(&bar[XB_XSUB(b.x)], 1u);
        const unsigned gen = old / nloc;
        if (old + 1u == (gen + 1u) * nloc) {
            __builtin_amdgcn_fence(__ATOMIC_RELEASE, "agent");
            asm volatile("s_waitcnt vmcnt(0)" ::: "memory");
            const unsigned og = xb_add(&bar[XB_TOP], 1u);
            const unsigned tg = og / nx;
            if (og + 1u == (tg + 1u) * nx) xb_add(&bar[XB_TOPGEN], 1u);
            else XB_SPIN(xb_ld(&bar[XB_TOPGEN]) == tg, bar);
            __builtin_amdgcn_fence(__ATOMIC_ACQUIRE, "agent");
            xb_add(&bar[XB_XGEN(b.x)], 1u);
            asm volatile("s_waitcnt vmcnt(0)" ::: "memory");
        } else {
            XB_SPIN(xb_ld(&bar[XB_XGEN(b.x)]) == gen, bar);
            __builtin_amdgcn_fence(__ATOMIC_ACQUIRE, "agent");
            asm volatile("s_waitcnt vmcnt(0)" ::: "memory");
        }
    }
    __syncthreads();
}

__device__ __forceinline__ float wave_sum(float v) {
#pragma unroll
    for (int o = 1; o < 64; o <<= 1) v += __shfl_xor(v, o);
    return v;
}
constexpr int XP = 65, XSCR_BYTES = 64 * XP * 4;
__device__ __forceinline__ unsigned cvtpk(float lo, float hi) { unsigned r; asm volatile("v_cvt_pk_bf16_f32 %0, %1, %2" : "=v"(r) : "v"(lo), "v"(hi)); return r; }
__device__ __forceinline__ void p0_transpose_item(const float* W, int ldw, int k0, int n0, const float* gs, bf16* dst, int ldd, LAS float* scr, int lane) {
    const int lr = lane >> 4, lc = (lane & 15) * 4;
    const float* src = W + (size_t)(k0 + lr) * ldw + n0 + lc;
    f32x4 v[16];
#pragma unroll
    for (int i = 0; i < 16; ++i) v[i] = __builtin_nontemporal_load((const GAS f32x4*)(src + (size_t)(4 * i) * ldw));
    if (gs) {
#pragma unroll
        for (int i = 0; i < 16; ++i) v[i] = v[i] * gs[k0 + 4 * i + lr]; }
#pragma unroll
    for (int i = 0; i < 16; ++i) { LAS float* p = scr + (4 * i + lr) * XP + lc; p[0] = v[i][0]; p[1] = v[i][1]; p[2] = v[i][2]; p[3] = v[i][3]; }
    LDS_WAIT(); asm volatile("" ::: "memory");
    const int c = lane & 7, nn = lane >> 3;
#pragma unroll
    for (int j = 0; j < 8; ++j) { const int n = nn + 8 * j; const LAS float* sp = scr + (8 * c) * XP + n;
        v4u o; o.x = cvtpk(sp[0 * XP], sp[1 * XP]); o.y = cvtpk(sp[2 * XP], sp[3 * XP]); o.z = cvtpk(sp[4 * XP], sp[5 * XP]); o.w = cvtpk(sp[6 * XP], sp[7 * XP]);
        *(GAS v4u*)(dst + (size_t)n * ldd + k0 + 8 * c) = o; }
    LDS_WAIT(); asm volatile("" ::: "memory");
}
struct XTile { const float* src; const float* gs; unsigned char* dst; int ldw, ldd, k0; };
__device__ __forceinline__ XTile xtile_fp8(int item, const float* W, int ldw, int N, const float* gs, unsigned char* dst, int ldd, int mode, int lane) {
    const int nblk = N / 64, kb = item / nblk, nb = item % nblk, n0 = 64 * nb, k0 = 64 * kb;
    const int row = mode == 0 ? n0 : ((n0 >> 7) * 256 + (n0 & 127) + (mode == 2 ? 128 : 0));
    XTile t; t.src = W + (size_t)(k0 + (lane >> 4)) * ldw + n0 + (lane & 15) * 4; t.gs = gs; t.dst = dst + (size_t)row * ldd; t.ldw = ldw; t.ldd = ldd; t.k0 = k0; return t;
}
__device__ __forceinline__ void xtile_load(const XTile& t, f32x4 (&v)[16], float (&g)[16], int lane) {
    const int lr = lane >> 4;
    if (t.gs) {
#pragma unroll
        for (int i = 0; i < 16; ++i) g[i] = t.gs[t.k0 + 4 * i + lr];
    } else {
#pragma unroll
        for (int i = 0; i < 16; ++i) g[i] = 1.0f; }
#pragma unroll
    for (int i = 0; i < 16; ++i) v[i] = __builtin_nontemporal_load((const GAS f32x4*)(t.src + (size_t)(4 * i) * t.ldw));
}
__device__ __forceinline__ void xtile_finish_fp8(const XTile& t, f32x4 (&v)[16], const float (&g)[16], float wscale, LAS float* scr, int lane) {
    const int lr = lane >> 4, lc = (lane & 15) * 4;
#pragma unroll
    for (int i = 0; i < 16; ++i) v[i] = v[i] * (g[i] * wscale);
    constexpr int XR = 64;
#pragma unroll
    for (int i = 0; i < 16; ++i) *(LAS f32x4*)(scr + (4 * i + lr) * XR + (i >> 2) * 16 + lc) = v[i];
    LDS_WAIT(); asm volatile("" ::: "memory");
    const int c = lane & 3, nn = lane >> 2;
#pragma unroll
    for (int j = 0; j < 4; ++j) { const int n = nn + 16 * j; const LAS float* sp = scr + (16 * c) * XR + c * 16 + n;
        v4u o; o.x = pg8::pk_fp8x4(sp[0 * XR], sp[1 * XR], sp[2 * XR], sp[3 * XR]); o.y = pg8::pk_fp8x4(sp[4 * XR], sp[5 * XR], sp[6 * XR], sp[7 * XR]);
        o.z = pg8::pk_fp8x4(sp[8 * XR], sp[9 * XR], sp[10 * XR], sp[11 * XR]); o.w = pg8::pk_fp8x4(sp[12 * XR], sp[13 * XR], sp[14 * XR], sp[15 * XR]);
        __builtin_nontemporal_store(o, (GAS v4u*)(t.dst + (size_t)n * t.ldd + t.k0 + 16 * c)); }
    LDS_WAIT(); asm volatile("" ::: "memory");
}
__device__ __forceinline__ void xpose_mat(int item, const float* W, int ldw, int N, const float* gs, bf16* dst, int ldd, int mode, LAS float* scr, int lane) {
    const int nblk = N / 64, kb = item / nblk, nb = item % nblk, n0 = 64 * nb;
    const int row = mode == 0 ? n0 : ((n0 >> 7) * 256 + (n0 & 127) + (mode == 2 ? 128 : 0));
    p0_transpose_item(W, ldw, 64 * kb, n0, gs, dst + (size_t)row * ldd, ldd, scr, lane);
}

struct Args { const float* in[28]; float* out; unsigned char* ws; };

__device__ __forceinline__ void s5_tables(const Args& a, int g, int q, LAS unsigned char* lds, int tid) {
    LAS float* POWr = (LAS float*)lds;
    LAS float* POWi = POWr + 33 * 64;
    LAS float* BBr = POWi + 33 * 64;
    LAS float* BBi = BBr + 1024;
    LAS float* CCr = BBi + 1024;
    LAS float* CCi = CCr + 1024;
    LAS float* KT = CCi + 1024;
    LAS float* DD = KT + 2048;
    const float* a_re = a.in[3]; const float* a_im = a.in[4]; const float* b_re = a.in[5]; const float* b_im = a.in[6];
    const float* c_re = a.in[7]; const float* c_im = a.in[8]; const float* dsk = a.in[9]; const float* log_step = a.in[10];
    const float step = expf(log_step[g]);
    __syncthreads();
    for (int e = tid; e < 33 * 64; e += NTHREADS) { const int n = e >> 6, p = e & 63; const float lr = a_re[g * 64 + p], li = a_im[g * 64 + p];
        const float mag = expf((float)n * step * lr); float sn, cs; sincosf((float)n * (step * li), &sn, &cs); POWr[e] = mag * cs; POWi[e] = mag * sn; }
    for (int e = tid; e < 1024; e += NTHREADS) { const int p = e >> 4, h = e & 15; const float lr = a_re[g * 64 + p], li = a_im[g * 64 + p];
        const float er = expf(lr * step); float sn, cs; sincosf(li * step, &sn, &cs); const float nr = er * cs - 1.f, ni = er * sn, den = lr * lr + li * li;
        const float fr = (nr * lr + ni * li) / den, fi = (ni * lr - nr * li) / den;
        const float br = b_re[(g * 64 + p) * 16 + h], bi = b_im[(g * 64 + p) * 16 + h];
        BBr[e] = fr * br - fi * bi; BBi[e] = fr * bi + fi * br;
        CCr[e] = c_re[g * 1024 + e]; CCi[e] = c_im[g * 1024 + e]; }
    if (tid < 16) DD[tid] = dsk[g * 16 + tid];
    __syncthreads();
    { const int lane_ = tid & 63, hq = lane_ & 3, hl = (lane_ >> 2) & 3, tau = 4 * (tid >> 6) + (lane_ >> 4), ho = 4 * q + hl, rot = 8 * hl + 2 * (lane_ >> 4);
      f32x4 sa = (f32x4){0.f, 0.f, 0.f, 0.f};
      for (int pp = 0; pp < 64; ++pp) { const int p = (pp + rot) & 63; const float cr = CCr[ho * 64 + p], ci = CCi[ho * 64 + p], pr = POWr[tau * 64 + p], pi = POWi[tau * 64 + p];
          const float xr = cr * pr - ci * pi, xi = cr * pi + ci * pr; const f32x4 br = *(const LAS f32x4*)(BBr + p * 16 + 4 * hq), bi = *(const LAS f32x4*)(BBi + p * 16 + 4 * hq);
          sa += br * xr - bi * xi; }
      if (tau == 0 && (ho >> 2) == hq) sa[ho & 3] += DD[ho];
      *(LAS f32x4*)(KT + (tau * 4 + hl) * 16 + 4 * hq) = sa; }
    __syncthreads();
    bf16* WA = (bf16*)(a.ws + WS_S5WA) + (size_t)g * 256 * 512;
    for (int pc = tid; pc < 64 * 64; pc += NTHREADS) { const int p = pc >> 6, k0 = (pc & 63) * 8; v4u o = (v4u){0u, 0u, 0u, 0u};
        if (q < 2) { const int j = k0 >> 4, h0 = k0 & 15; const float pr = POWr[(31 - j) * 64 + p], pi = POWi[(31 - j) * 64 + p]; float v[8];
#pragma unroll
            for (int w = 0; w < 8; ++w) { const float br = BBr[p * 16 + h0 + w], bi = BBi[p * 16 + h0 + w]; v[w] = (q == 0) ? (pr * br - pi * bi) : (pr * bi + pi * br); }
            o.x = cvtpk(v[0], v[1]); o.y = cvtpk(v[2], v[3]); o.z = cvtpk(v[4], v[5]); o.w = cvtpk(v[6], v[7]); }
        *(GAS v4u*)(WA + (size_t)(64 * q + p) * 512 + k0) = o; }
    bf16* WC = (bf16*)(a.ws + WS_S5WC) + (size_t)g * 512 * 640;
    for (int pc = tid; pc < 128 * 80; pc += NTHREADS) { const int rl = pc / 80, k0 = (pc % 80) * 8, i = rl >> 2, hl = rl & 3, ho = 4 * q + hl; float v[8];
        if (k0 < 512) { const int j = k0 >> 4, h0 = k0 & 15; f32x4 ka = (f32x4){0.f, 0.f, 0.f, 0.f}, kb = ka;
            if (j <= i) { const LAS f32x4* kp = (const LAS f32x4*)(KT + ((i - j) * 4 + hl) * 16 + h0); ka = kp[0]; kb = kp[1]; }
#pragma unroll
            for (int w = 0; w < 4; ++w) { v[w] = ka[w]; v[4 + w] = kb[w]; } }
        else { const int p0 = (k0 - 512) & 63; const bool im = k0 >= 576;
#pragma unroll
            for (int w = 0; w < 8; ++w) { const int p = p0 + w; const float cr = CCr[ho * 64 + p], ci = CCi[ho * 64 + p], pr = POWr[(i + 1) * 64 + p], pi = POWi[(i + 1) * 64 + p];
                v[w] = im ? -(cr * pi + ci * pr) : (cr * pr - ci * pi); } }
        v4u o; o.x = cvtpk(v[0], v[1]); o.y = cvtpk(v[2], v[3]); o.z = cvtpk(v[4], v[5]); o.w = cvtpk(v[6], v[7]);
        *(GAS v4u*)(WC + (size_t)(i * 16 + ho) * 640 + k0) = o; }
    __syncthreads();
}

constexpr int MOE_XITEMS = 24 * 896;
__device__ __forceinline__ XTile moe_xtile(const Args& a, int r, int lane) {
    unsigned char* ws = a.ws;
    const int mat = r / 896, e = mat / 3, which = mat % 3; r -= mat * 896;
    if (which == 0) return xtile_fp8(r, a.in[24] + (size_t)e * D * DFE, DFE, DFE, a.in[22], ws + WS_WMOE_GU + (size_t)e * 7168 * 1024, D, 1, lane);
    if (which == 1) return xtile_fp8(r, a.in[25] + (size_t)e * D * DFE, DFE, DFE, a.in[22], ws + WS_WMOE_GU + (size_t)e * 7168 * 1024, D, 2, lane);
    return xtile_fp8(r, a.in[26] + (size_t)e * DFE * D, D, D, nullptr, ws + WS_WMOE_D + (size_t)e * 1024 * 3584, DFE, 0, lane);
}
constexpr int I_IN0 = 16 * 32, I_GLU = 8 * 8, I_OUT = 16 * 16, I_GU0 = 16 * 44, I_D0 = 44 * 16, I_IN1 = 16 * 48;
constexpr int DW_FIRST = I_IN0 + I_GLU  , DW_EARLY = I_IN0 + I_GLU + I_OUT + 2 * I_GU0, DW_ITEMS = DW_EARLY + I_D0 + I_IN1 + I_OUT;
__device__ __forceinline__ void dense_item(const Args& a, int it, LAS float* scr, int lane) {
    unsigned char* ws = a.ws; int r = it;
    if (r < I_IN0) { xpose_mat(r, a.in[2], EVEN_IN, EVEN_IN, a.in[1], (bf16*)(ws + WS_WIN0), D, 0, scr, lane); return; } r -= I_IN0;
    if (r < I_GLU) { xpose_mat(r, a.in[11], 512, 512, nullptr, (bf16*)(ws + WS_WGLU), 512, 0, scr, lane); return; } r -= I_GLU;
    if (r < I_OUT) { xpose_mat(r, a.in[13], D, D, nullptr, (bf16*)(ws + WS_WOUT0), D, 0, scr, lane); return; } r -= I_OUT;
    if (r < I_GU0) { xpose_mat(r, a.in[15], DFF, DFF, a.in[14], (bf16*)(ws + WS_WGU0), D, 1, scr, lane); return; } r -= I_GU0;
    if (r < I_GU0) { xpose_mat(r, a.in[16], DFF, DFF, a.in[14], (bf16*)(ws + WS_WGU0), D, 2, scr, lane); return; } r -= I_GU0;
    if (r < I_D0) { xpose_mat(r, a.in[17], D, D, nullptr, (bf16*)(ws + WS_WD0), DFF, 0, scr, lane); return; } r -= I_D0;
    if (r < I_IN1) { const XTile t = xtile_fp8(r, a.in[19], ODD_IN, 3072, a.in[18], ws + WS_WIN1, D, 0, lane); f32x4 v[16]; float g[16]; xtile_load(t, v, g, lane); xtile_finish_fp8(t, v, g, 64.f, scr, lane); return; } r -= I_IN1;
    { const XTile t = xtile_fp8(r, a.in[21], D, D, nullptr, ws + WS_WOUT1, D, 0, lane); f32x4 v[16]; float g[16]; xtile_load(t, v, g, lane); xtile_finish_fp8(t, v, g, 64.f, scr, lane); }
}
__device__ __forceinline__ void dense_range(const Args& a, LAS unsigned char* lds, int lane, int wave, int iw, int nwg_, int lo, int hi) {
    LAS float* scr = (LAS float*)(lds + wave * XSCR_BYTES);
    for (int it = hi - 1 - (iw * NWAVES + wave); it >= lo; it -= nwg_ * NWAVES) dense_item(a, it, scr, lane);
}
__device__ __forceinline__ void dense_late(const Args& a, LAS unsigned char* lds, int tid, int lane, int wave, int iw, int nwg_) {
    LAS float* scr = (LAS float*)(lds + wave * XSCR_BYTES);
    for (int it = DW_ITEMS - 1 - (iw * NWAVES + wave); it >= DW_EARLY; it -= nwg_ * NWAVES) dense_item(a, it, scr, lane);
    for (int gt = iw * NTHREADS + tid; gt < 16 * 1024; gt += nwg_ * NTHREADS) { const int h = gt >> 10, k = gt & 1023; ((bf16*)(a.ws + WS_WF1))[gt] = (bf16)f2bf(a.in[19][(size_t)k * ODD_IN + 3072 + h] * a.in[18][k]); }
}
__device__ __forceinline__ void p0_prologue(const Args& a, LAS unsigned char* lds, int tid, int lane, int wave, int vcu, int G) {
    for (int it = vcu; it < 4 * S5G; it += G) s5_tables(a, it >> 2, it & 3, lds, tid);
    LAS float* scr = (LAS float*)(lds + wave * XSCR_BYTES);
    const int gw = vcu * NWAVES + wave, NGW = G * NWAVES;
    unsigned char* ws = a.ws;
    for (int it = DW_FIRST - 1 - gw; it >= 0; it -= NGW) dense_item(a, it, scr, lane);
    float* ss0 = (float*)(ws + WS_SSP);
    int m0, nr, stp;
    if (G == 256) { if (vcu < 128) { m0 = vcu * 48 + wave * 6; nr = 6; } else { m0 = 6144 + (vcu - 128) * 80 + wave * 10; nr = 10; } stp = 1; }
    else { m0 = gw; nr = (M - gw + NGW - 1) / NGW; stp = NGW; }
    f32x4 xnx[4];
    if (nr > 0) {
#pragma unroll
        for (int j = 0; j < 4; ++j) xnx[j] = ((const GAS f32x4*)(a.in[0] + (size_t)m0 * D) + lane)[64 * j]; }
    for (int i = 0; i < nr; ++i) { const int m = m0 + i * stp;
        GAS v2u* o8 = (GAS v2u*)((bf16*)(ws + WS_XB) + (size_t)m * D) + lane; float s = 0.f; f32x4 xc[4];
#pragma unroll
        for (int j = 0; j < 4; ++j) xc[j] = xnx[j];
        if (i + 1 < nr) {
#pragma unroll
            for (int j = 0; j < 4; ++j) xnx[j] = ((const GAS f32x4*)(a.in[0] + (size_t)(m + stp) * D) + lane)[64 * j]; }
#pragma unroll
        for (int j = 0; j < 4; ++j) { const f32x4 v = xc[j]; s += (v.x * v.x + v.y * v.y) + (v.z * v.z + v.w * v.w); v2u w; w.x = cvtpk(v.x, v.y); w.y = cvtpk(v.z, v.w); o8[64 * j] = w; }
        s = wave_sum(s); if (lane < 16) ss0[(size_t)m * 16 + lane] = (lane == 0) ? s : 0.f;
    }
}

__device__ __forceinline__ void s5_scan(const Args& a, int gt  ) {
    if (gt >= BATCH * S5G * S5P) return;
    const int b = gt / (S5G * S5P), g = (gt / S5P) % S5G, p = gt % S5P;
    const float step = expf(a.in[10][g]); const float lr = a.in[3][g * 64 + p], li = a.in[4][g * 64 + p];
    const float mag = expf((float)S5T * step * lr); float sn, cs; sincosf((float)S5T * (step * li), &sn, &cs); const float ar = mag * cs, ai = mag * sn;
    const float* sl = (const float*)(a.ws + WS_SLOC) + ((size_t)g * S5NC + b * 256) * 128 + p;
    bf16* ue = (bf16*)(a.ws + WS_UEXT) + ((size_t)g * S5NC + b * 256) * S5KX + 512 + p;
    float sr = 0.f, si = 0.f;
    float cr[16], ci[16], nr_[16], ni_[16];
#pragma unroll
    for (int j = 0; j < 16; ++j) { cr[j] = sl[(size_t)j * 128]; ci[j] = sl[(size_t)j * 128 + 64]; }
#pragma unroll 1
    for (int c0 = 0; c0 < 256; c0 += 16) {
        if (c0 + 16 < 256) {
#pragma unroll
            for (int j = 0; j < 16; ++j) { nr_[j] = sl[(size_t)(c0 + 16 + j) * 128]; ni_[j] = sl[(size_t)(c0 + 16 + j) * 128 + 64]; } }
#pragma unroll
        for (int j = 0; j < 16; ++j) { const int c = c0 + j;
            ue[(size_t)c * S5KX] = (bf16)f2bf(sr); ue[(size_t)c * S5KX + 64] = (bf16)f2bf(si);
            const float nr = ar * sr - ai * si + cr[j], ni = ar * si + ai * sr + ci[j]; sr = nr; si = ni; }
#pragma unroll
        for (int j = 0; j < 16; ++j) { cr[j] = nr_[j]; ci[j] = ni_[j]; }
    }
}

__device__ __forceinline__ void fgate_rows16(const bf16* xb, const bf16* wf, const float* ss, const float* bfv, float* logf, int r0, int lane) {
    const int fr = lane & 15, fq = lane >> 4;
    const bf16x8* ap = (const bf16x8*)(xb + (size_t)(r0 + fr) * D + fq * 8);
    const bf16x8* bp = (const bf16x8*)(wf + (size_t)fr * D + fq * 8);
    f32x4 acc0 = (f32x4){0.f, 0.f, 0.f, 0.f}, acc1 = (f32x4){0.f, 0.f, 0.f, 0.f};
#pragma unroll
    for (int half = 0; half < 2; ++half) {
        bf16x8 av[16], bv[16];
#pragma unroll
        for (int kk = 0; kk < 16; ++kk) { av[kk] = ap[(half * 16 + kk) * 4]; bv[kk] = bp[(half * 16 + kk) * 4]; }
#pragma unroll
        for (int kk = 0; kk < 16; kk += 2) { acc0 = __builtin_amdgcn_mfma_f32_16x16x32_bf16(av[kk], bv[kk], acc0, 0, 0, 0); acc1 = __builtin_amdgcn_mfma_f32_16x16x32_bf16(av[kk + 1], bv[kk + 1], acc1, 0, 0, 0); }
    }
    const f32x4 acc = acc0 + acc1;
    const float bias = bfv[fr];
    float rsq[4];
#pragma unroll
    for (int j = 0; j < 4; ++j) rsq[j] = pg8::rstd16(ss, r0 + fq * 4 + j);
#pragma unroll
    for (int j = 0; j < 4; ++j) { const int row = r0 + fq * 4 + j;
        const float z = acc[j] * rsq[j] + bias;
        const float lf = -(fmaxf(-z, 0.f) + log1pf(expf(-fabsf(z)))) * 1.4426950408889634f;
        const int b = row >> 13, t = row & 8191; logf[((size_t)b * FOXH + fr) * SEQ + t] = lf; }
}

struct MoeOrder {
    pg8::StaticOrder S; int lo; int pref[NEXP + 1]; bool cap_rows;
    __device__ __forceinline__ bool next(int i, pg8::Unit& u) const {
        if (!S.next(i, u)) return false;
        u.pm += lo; int e = 0, pe = 0;
#pragma unroll
        for (int k = 1; k < NEXP; ++k) { const bool ge = u.pm >= pref[k]; e += ge ? 1 : 0; pe = ge ? pref[k] : pe; }
        u.zb = e; u.pa = cap_rows ? e * (MOE_CAP / 256) + (u.pm - pe) : u.pm; return true;
    }
    __device__ __forceinline__ void a_ready(const pg8::Unit&) const {}
    __device__ __forceinline__ void done(const pg8::Unit&) const {}
};

struct MoeQuadOrder {
    int p0, np, G, c; int pref[NEXP + 1];
    __device__ __forceinline__ bool next(int i, pg8::Unit& u) const {
        const long L = (long)i * G + c; if (L >= (long)np * 16) return false;
        const int q = (int)(L & 3), ul = (int)(L >> 2); u.pn = ul & 3; u.pm = p0 + (ul >> 2); u.qa = q >> 1; u.qb = q & 1; u.pa = u.pm; int e = 0;
#pragma unroll
        for (int k = 1; k < NEXP; ++k) e += (u.pm >= pref[k]) ? 1 : 0;
        u.zb = e; return true;
    }
    __device__ __forceinline__ void a_ready(const pg8::Unit&) const {}
    __device__ __forceinline__ void done(const pg8::Unit&) const {}
};

__global__ void __launch_bounds__(NTHREADS, 2) mk_fwd(Args args) {
    extern __shared__ __attribute__((aligned(16))) unsigned char lds_raw[];
    LAS unsigned char* lds = (LAS unsigned char*)lds_raw;
    volatile LAS unsigned* MISC = (volatile LAS unsigned*)(lds + MISC_OFF);
    const int tid = threadIdx.x, lane = tid & 63, wave = __builtin_amdgcn_readfirstlane(tid >> 6);
    const int G = gridDim.x; const int bx = blockIdx.x; const int vcu = (G % 8 == 0) ? (bx % 8) * (G / 8) + bx / 8 : bx;
    unsigned char* ws = args.ws;
    gu32* ctl = (gu32*)(ws + WS_CTL);
    for (int u = tid; u < (LDS_BYTES - LDSCTL_OFF) / 4; u += NTHREADS) ((LAS unsigned*)(lds + LDSCTL_OFF))[u] = 0u;
    __syncthreads();
    XcdBarrier bar = xcd_barrier_post((unsigned*)(ctl + CW_BAR), MISC + 8, (unsigned)G);
    const int gw = vcu * NWAVES + wave, NGW = G * NWAVES;
    float* SS = (float*)(ws + WS_SSP);
    float* X = args.out;
    bf16* XB = (bf16*)(ws + WS_XB);
#define GRID_BAR() xcd_barrier(bar)
#define GEMM_PHASE(EPI, SCHED, lds_, g_, S_, E_) pg8::gemm_phase<EPI, SCHED, true, true>(lds_, g_, S_, E_)

    p0_prologue(args, lds, tid, lane, wave, vcu, G);
    GRID_BAR();
    { pg8::Gemm g{XB, (const bf16*)(ws + WS_WIN0), D, D, D, 0, 0}; pg8::StaticOrder S; S.init(M, EVEN_IN, 1, G, bx);
      pg8::EpiInProj0 E{SS, (bf16*)(ws + WS_UEXT), (bf16*)(ws + WS_QKV0), C2};
      GEMM_PHASE(pg8::EpiInProj0, pg8::StaticOrder, lds + RING_OFF, g, S, E); }
    GRID_BAR();
#define SB_PULL_ONE(more_) do { if (tid == 0) MISC[17] = __hip_atomic_fetch_add(ctl + CW_QUEUE2, 1u, RLX_AGENT); __syncthreads(); const unsigned uq_ = __builtin_amdgcn_readfirstlane(MISC[17]); __syncthreads(); \
        more_ = uq_ < (unsigned)(BATCH * SBH * 32); if (more_) { const int bh_ = (int)(uq_ >> 5), qb_ = (int)(uq_ & 31u); \
            attn_body::sb_unit<1536>(bh_ >> 3, bh_ & 7, qb_, (const attn_body::bf16*)(ws + WS_QKV0), (const attn_body::bf16*)(ws + WS_QKV0) + 512, (const attn_body::bf16*)(ws + WS_QKV0) + 1024, (attn_body::bf16*)(ws + WS_MIXB) + 512, (char*)lds_raw + RING_OFF); } } while (0)
    { const bool s5g = (G % 16 == 0) ? (((bx >> 3) & 1) == 0) : true; const int Gs = (G % 16 == 0) ? G / 2 : G, gl = (G % 16 == 0) ? (bx & 7) + 8 * (bx >> 4) : bx;
      if (s5g) {
          XcdBarrier sub = xcd_barrier_post((unsigned*)(ctl + CW_SUBBAR), MISC + 12, (unsigned)Gs);
          { pg8::Gemm g{(const bf16*)(ws + WS_UEXT), (const bf16*)(ws + WS_S5WA), S5KX, 512, 512, (size_t)S5NC * S5KX * 2, (size_t)256 * 512 * 2}; pg8::StaticOrder S; S.init(S5NC, 256, S5G, Gs, gl);
            pg8::EpiS5State E{(float*)(ws + WS_SLOC)};
            GEMM_PHASE(pg8::EpiS5State, pg8::StaticOrder, lds + RING_OFF, g, S, E);
            if (Gs > S.nwg) { if (gl >= S.nwg) dense_range(args, lds, lane, wave, gl - S.nwg, Gs - S.nwg, DW_EARLY - I_GU0, DW_EARLY); } else dense_range(args, lds, lane, wave, gl, Gs, DW_EARLY - I_GU0, DW_EARLY); }
          xcd_barrier(sub);
          s5_scan(args, gl * NTHREADS + tid);
          { constexpr int NSCAN = BATCH * S5G * S5P / NTHREADS; if (Gs > NSCAN) { if (gl >= NSCAN) dense_range(args, lds, lane, wave, gl - NSCAN, Gs - NSCAN, DW_FIRST, DW_EARLY - I_GU0); } else dense_range(args, lds, lane, wave, gl, Gs, DW_FIRST, DW_EARLY - I_GU0); }
          xcd_barrier(sub);
          { pg8::Gemm g{(const bf16*)(ws + WS_UEXT), (const bf16*)(ws + WS_S5WC), S5KX, S5KX, S5KX, (size_t)S5NC * S5KX * 2, (size_t)512 * S5KX * 2}; pg8::StaticOrder S; S.init(S5NC, 512, S5G, Gs, gl);
            pg8::EpiS5Y E{(bf16*)(ws + WS_YG)};
            GEMM_PHASE(pg8::EpiS5Y, pg8::StaticOrder, lds + RING_OFF, g, S, E); }
          xcd_barrier(sub);
          { pg8::Gemm g{(const bf16*)(ws + WS_YG), (const bf16*)(ws + WS_WGLU), 512, 512, 512, 0, 0}; pg8::StaticOrder S; S.init(M, 512, 1, Gs, gl);
            pg8::EpiGlu E{(const bf16*)(ws + WS_YG), args.in[12], (bf16*)(ws + WS_MIXB)};
            GEMM_PHASE(pg8::EpiGlu, pg8::StaticOrder, lds + RING_OFF, g, S, E); }
          __syncthreads();
      }
      bool sb_more = true;
#pragma unroll 1
      while (sb_more) SB_PULL_ONE(sb_more);
    }
    GRID_BAR();
#undef SB_PULL_ONE
    { pg8::Gemm g{(const bf16*)(ws + WS_MIXB), (const bf16*)(ws + WS_WOUT0), D, D, D, 0, 0}; pg8::StaticOrder S; S.init(M, D, 1, G, bx);
      pg8::EpiResid<true> E{args.in[0], X, XB, SS + 16 * M};
      GEMM_PHASE(pg8::EpiResid<true>, pg8::StaticOrder, lds + RING_OFF, g, S, E); }
    GRID_BAR();
    { pg8::Gemm g{XB, (const bf16*)(ws + WS_WGU0), D, D, D, 0, 0}; pg8::StaticOrder S; S.init(M, 2 * DFF, 1, G, bx);
      pg8::EpiSwiGlu<true> E{SS + 16 * M, (bf16*)(ws + WS_HID0), DFF};
      GEMM_PHASE(pg8::EpiSwiGlu<true>, pg8::StaticOrder, lds + RING_OFF, g, S, E);
      { const int rem = S.nwg % G; if (rem == 0) dense_late(args, lds, tid, lane, wave, bx, G); else if (bx >= rem) dense_late(args, lds, tid, lane, wave, bx - rem, G - rem); } }
    GRID_BAR();
    { pg8::Gemm g{(const bf16*)(ws + WS_HID0), (const bf16*)(ws + WS_WD0), DFF, DFF, DFF, 0, 0}; pg8::StaticOrder S; S.init(M, D, 1, G, bx);
      pg8::EpiResid<true> E{X, X, XB, SS + 32 * M, ws + WS_HMOE  };
      GEMM_PHASE(pg8::EpiResid<true>, pg8::StaticOrder, lds + RING_OFF, g, S, E); }
    GRID_BAR();
    { pg8::Gemm g{(const bf16*)(ws + WS_HMOE), (const bf16*)(ws + WS_WIN1), D / 2, D / 2, D / 2, 0, 0}; pg8::StaticOrder S; S.init(M, 3072, 1, G, bx);
      pg8::EpiInProj1 E{SS + 32 * M, (bf16*)(ws + WS_QKV1), C2, (unsigned*)(ctl + CW_KN)};
      pg8::gemm_phase<pg8::EpiInProj1, pg8::StaticOrder, true, true, true>(lds + RING_OFF, g, S, E); }
    for (int r = gw; r < M / 16; r += NGW) fgate_rows16(XB, (const bf16*)(ws + WS_WF1), SS + 32 * M, args.in[20], (float*)(ws + WS_LOGF), r * 16, lane);
    GRID_BAR();
    { const attn_body::AttnTensors AT{(const attn_body::bf16*)(ws + WS_QKV1), (const attn_body::bf16*)(ws + WS_QKV1 + 32 * MiB), (const attn_body::bf16*)(ws + WS_QKV1 + 64 * MiB), (attn_body::bf16*)(ws + WS_QKV1), (const float*)(ws + WS_LOGF), (const unsigned*)(ctl + CW_KN)};
      constexpr int N_ATT = 1024, N_CVB = MOE_XITEMS / 32, N_GRP = (N_ATT + 2) / 3 > (N_CVB + 1) / 2 ? (N_ATT + 2) / 3 : (N_CVB + 1) / 2;
      for (;;) {
          if (tid == 0) MISC[16] = __hip_atomic_fetch_add(ctl + CW_QUEUE, 1u, RLX_AGENT);
          __syncthreads();
          const unsigned uq = __builtin_amdgcn_readfirstlane(MISC[16]);
          __syncthreads();
          if (uq >= 5u * N_GRP) break;
          const int grp = (int)(uq / 5u), rr = (int)(uq % 5u);
          if (rr & 1) { const int cb = 2 * grp + (rr >> 1);
              if (cb < N_CVB) { int lane_ = threadIdx.x & 63; asm volatile("" : "+v"(lane_));
                  LAS float* scr = (LAS float*)(lds + wave * XSCR_BYTES);
#pragma unroll 1
                  for (int j = 0; j < 4; j += 2) { const XTile t0 = moe_xtile(args, cb * 32 + wave * 4 + j, lane_), t1 = moe_xtile(args, cb * 32 + wave * 4 + j + 1, lane_);
                      f32x4 v0[16], v1[16]; float g0[16], g1[16]; xtile_load(t0, v0, g0, lane_); xtile_load(t1, v1, g1, lane_);
                      xtile_finish_fp8(t0, v0, g0, 64.f, scr, lane_); xtile_finish_fp8(t1, v1, g1, 64.f, scr, lane_); } }
          } else { const int au = 3 * grp + (rr >> 1);
              if (au < N_ATT) { const int bh = au & 31, qb = 31 - (au >> 5);
                  attn_body::attn_unit<8>(bh >> 4, bh & 15, qb, AT.Q, AT.K, AT.V, AT.O, (char*)lds_raw + RING_OFF, AT.logf + (size_t)bh * SEQ, AT.kn + (size_t)bh * 256, ws + WS_HMOE + 16 * MiB  ); } }
      } }
    GRID_BAR();
    { pg8::Gemm g{(const bf16*)(ws + WS_HMOE + 16 * MiB), (const bf16*)(ws + WS_WOUT1), D / 2, D / 2, D / 2, 0, 0}; pg8::StaticOrder S; S.init(M, D, 1, G, bx);
      pg8::EpiResid<false> E{X, X, XB, SS + 48 * M};
      pg8::gemm_phase<pg8::EpiResid<false>, pg8::StaticOrder, true, true, true>(lds + RING_OFF, g, S, E); }
    GRID_BAR();
    unsigned char* meta = ws + WS_META; unsigned char* XG = ws + WS_XG; float* RSS = (float*)(meta + MT_RSS);
    {
        const float* wr = args.in[23]; const float* gn = args.in[22];
        LAS unsigned* lcnt = (LAS unsigned*)(lds + 1024);
        LAS unsigned* rowst = (LAS unsigned*)(lds + 4096);
        if (tid < 16) lcnt[tid] = 0u;
        __syncthreads();
        float wl[16][NEXP];
#pragma unroll
        for (int j = 0; j < 4; ++j) { const int k0 = 4 * lane + 256 * j; const f32x4 gv = *(const f32x4*)(gn + k0);
#pragma unroll
            for (int q = 0; q < 4; ++q) { const f32x4 w0 = *(const f32x4*)(wr + (size_t)(k0 + q) * NEXP), w1 = *(const f32x4*)(wr + (size_t)(k0 + q) * NEXP + 4);
                wl[4 * j + q][0] = gv[q] * w0.x; wl[4 * j + q][1] = gv[q] * w0.y; wl[4 * j + q][2] = gv[q] * w0.z; wl[4 * j + q][3] = gv[q] * w0.w;
                wl[4 * j + q][4] = gv[q] * w1.x; wl[4 * j + q][5] = gv[q] * w1.y; wl[4 * j + q][6] = gv[q] * w1.z; wl[4 * j + q][7] = gv[q] * w1.w; } }
        f32x4 xn[4];
        if (gw < M) {
#pragma unroll
            for (int j = 0; j < 4; ++j) xn[j] = ((const GAS f32x4*)(X + (size_t)gw * D) + lane)[64 * j]; }
        const bool hb5 = (lane & 32) != 0, hb4 = (lane & 16) != 0, hb3 = (lane & 8) != 0;
        for (int tok = gw; tok < M; tok += NGW) {
            f32x4 xv[4];
#pragma unroll
            for (int j = 0; j < 4; ++j) xv[j] = xn[j];
            if (tok + NGW < M) {
#pragma unroll
                for (int j = 0; j < 4; ++j) xn[j] = ((const GAS f32x4*)(X + (size_t)(tok + NGW) * D) + lane)[64 * j]; }
            float lg[NEXP]; float s = 0.f; const int ti = (tok - gw) / NGW;
#pragma unroll
            for (int e = 0; e < NEXP; ++e) lg[e] = 0.f;
#pragma unroll
            for (int j = 0; j < 4; ++j) { const f32x4 v = xv[j]; s += (v.x * v.x + v.y * v.y) + (v.z * v.z + v.w * v.w);
                if (ti < 8) rowst[((wave * 8 + ti) * 256) + lane + 64 * j] = pg8::pk_fp8x4(v.x, v.y, v.z, v.w);
#pragma unroll
                for (int q = 0; q < 4; ++q)
#pragma unroll
                    for (int e = 0; e < NEXP; ++e) lg[e] = fmaf(v[q], wl[4 * j + q][e], lg[e]); }
            s = wave_sum(s);
            float a4[4], a2[2], a1;
#pragma unroll
            for (int i = 0; i < 4; ++i) { const float snd = hb5 ? lg[i] : lg[i + 4], kp = hb5 ? lg[i + 4] : lg[i]; a4[i] = kp + __shfl_xor(snd, 32); }
#pragma unroll
            for (int i = 0; i < 2; ++i) { const float snd = hb4 ? a4[i] : a4[i + 2], kp = hb4 ? a4[i + 2] : a4[i]; a2[i] = kp + __shfl_xor(snd, 16); }
            { const float snd = hb3 ? a2[0] : a2[1], kp = hb3 ? a2[1] : a2[0]; a1 = kp + __shfl_xor(snd, 8); }
            a1 += __shfl_xor(a1, 4); a1 += __shfl_xor(a1, 2); a1 += __shfl_xor(a1, 1);
#pragma unroll
            for (int e = 0; e < NEXP; ++e) lg[e] = __builtin_bit_cast(float, __builtin_amdgcn_readlane(__builtin_bit_cast(int, a1), 8 * e));
            if (lane == 0) {
                const float rs = 1.0f / sqrtf(s * (1.0f / 1024.0f) + pg8::RMS_EPS);
                int i1 = 0; float v1 = lg[0];
#pragma unroll
                for (int e = 1; e < NEXP; ++e) if (lg[e] > v1) { v1 = lg[e]; i1 = e; }
                int i2 = -1; float v2 = -INFINITY;
#pragma unroll
                for (int e = 0; e < NEXP; ++e) if (e != i1 && lg[e] > v2) { v2 = lg[e]; i2 = e; }
                const float g1 = 1.f / (1.f + expf((v2 - v1) * rs)), g2 = 1.f - g1;
                const unsigned p1 = __hip_atomic_fetch_add(lcnt + i1, 1u, __ATOMIC_RELAXED, __HIP_MEMORY_SCOPE_WORKGROUP), p2 = __hip_atomic_fetch_add(lcnt + i2, 1u, __ATOMIC_RELAXED, __HIP_MEMORY_SCOPE_WORKGROUP);
                ((float*)(meta + MT_RSTD))[tok] = rs; ((unsigned*)(meta + MT_TOKE))[tok] = (unsigned)i1 | ((unsigned)i2 << 8);
                ((unsigned*)(meta + MT_TOKP))[2 * tok] = p1; ((unsigned*)(meta + MT_TOKP))[2 * tok + 1] = p2;
                ((float*)(meta + MT_TOKG))[2 * tok] = g1; ((float*)(meta + MT_TOKG))[2 * tok + 1] = g2;
            }
        }
        __syncthreads();
        if (tid < NEXP) lcnt[8 + tid] = __hip_atomic_fetch_add(ctl + CW_CNT + 64 * tid, lcnt[tid], RLX_AGENT);
        VM_WAIT();
        __syncthreads();
        for (int tok = gw; tok < M; tok += NGW) {
            const unsigned ee = ((const unsigned*)(meta + MT_TOKE))[tok]; const float rs = ((const float*)(meta + MT_RSTD))[tok];
            const unsigned q1 = ((const unsigned*)(meta + MT_TOKP))[2 * tok], q2 = ((const unsigned*)(meta + MT_TOKP))[2 * tok + 1];
            const int ti = (tok - gw) / NGW; unsigned w[4];
            if (ti < 8) {
#pragma unroll
                for (int j = 0; j < 4; ++j) w[j] = rowst[((wave * 8 + ti) * 256) + lane + 64 * j];
            } else {
#pragma unroll
                for (int j = 0; j < 4; ++j) { const f32x4 v = ((const GAS f32x4*)(X + (size_t)tok * D) + lane)[64 * j]; w[j] = pg8::pk_fp8x4(v.x, v.y, v.z, v.w); } }
            const int e1 = (int)(ee & 0xffu), e2 = (int)((ee >> 8) & 0xffu);
            const unsigned p1 = q1 + lcnt[8 + e1], p2 = q2 + lcnt[8 + e2];
            const size_t r1 = (size_t)e1 * MOE_CAP + p1, r2 = (size_t)e2 * MOE_CAP + p2;
#pragma unroll
            for (int j = 0; j < 4; ++j) { *(unsigned*)(XG + r1 * D + 4 * lane + 256 * j) = w[j]; *(unsigned*)(XG + r2 * D + 4 * lane + 256 * j) = w[j]; }
            if (lane == 0) { RSS[r1] = rs; RSS[r2] = rs; ((unsigned*)(meta + MT_TOKP))[2 * tok] = p1; ((unsigned*)(meta + MT_TOKP))[2 * tok + 1] = p2; }
        }
    }
    GRID_BAR();
    int pref[NEXP + 1], cnt[NEXP];
    { pref[0] = 0;
#pragma unroll
      for (int e = 0; e < NEXP; ++e) { cnt[e] = (int)__builtin_amdgcn_readfirstlane(__hip_atomic_load(ctl + CW_CNT + 64 * e, RLX_AGENT)); pref[e + 1] = pref[e] + (cnt[e] + 255) / 256; } }
    const int NP = pref[NEXP];
    bf16* YS = (bf16*)(ws + WS_Y);
    { pg8::Gemm g{(const bf16*)XG, (const bf16*)(ws + WS_WMOE_GU), D / 2, D / 2, D / 2, 0, (size_t)7168 * 1024}; MoeOrder S; S.S.nM = NP; S.S.nN = 28; S.S.nZ = 1; S.S.nwg = NP * 28; S.S.G = G; S.S.c = bx; S.lo = 0; S.cap_rows = true;
#pragma unroll
      for (int e = 0; e <= NEXP; ++e) S.pref[e] = pref[e];
      pg8::EpiSwiGluFp8 E{RSS, ws + WS_HMOE, DFE};
      pg8::gemm_phase<pg8::EpiSwiGluFp8, MoeOrder, true, true, true>(lds + RING_OFF, g, S, E); }
    GRID_BAR();
    { pg8::Gemm g{(const bf16*)(ws + WS_HMOE), (const bf16*)(ws + WS_WMOE_D), DFE / 2, DFE / 2, DFE / 2, 0, (size_t)1024 * 3584}; const int NPM = NP < 2 * G / 4 ? NP : 2 * G / 4;
      MoeOrder S; S.S.nM = NPM; S.S.nN = 4; S.S.nZ = 1; S.S.nwg = NPM * 4; S.S.G = G; S.S.c = bx; S.lo = 0; S.cap_rows = false;
#pragma unroll
      for (int e = 0; e <= NEXP; ++e) S.pref[e] = pref[e];
      pg8::EpiStoreBf16 E{YS, D};
      pg8::gemm_phase<pg8::EpiStoreBf16, MoeOrder, true, true, true>(lds + RING_OFF, g, S, E);
      if (NP > NPM) { MoeQuadOrder Q; Q.p0 = NPM; Q.np = NP - NPM; Q.G = G; Q.c = bx;
#pragma unroll
          for (int e = 0; e <= NEXP; ++e) Q.pref[e] = pref[e];
          pg8::EpiStoreQuad EQ{YS, D};
          pg8::gemm_phase<pg8::EpiStoreQuad, MoeQuadOrder, true, true, true, true>(lds + RING_OFF, g, Q, EQ); } }
    GRID_BAR();
    {
        const float* gf = args.in[27];
        for (int tok = gw; tok < M; tok += NGW) {
            const unsigned ee = ((const unsigned*)(meta + MT_TOKE))[tok]; int pe0 = 0, pe1 = 0;
#pragma unroll
            for (int q = 0; q < NEXP; ++q) { pe0 = (q == (int)(ee & 0xffu)) ? pref[q] : pe0; pe1 = (q == (int)((ee >> 8) & 0xffu)) ? pref[q] : pe1; }
            const unsigned s0 = (unsigned)pe0 * 256u + ((const unsigned*)(meta + MT_TOKP))[2 * tok], s1 = (unsigned)pe1 * 256u + ((const unsigned*)(meta + MT_TOKP))[2 * tok + 1];
            const float g0 = ((const float*)(meta + MT_TOKG))[2 * tok], g1 = ((const float*)(meta + MT_TOKG))[2 * tok + 1];
            GAS f32x4* xr = (GAS f32x4*)(X + (size_t)tok * D) + lane; f32x4 v[4]; float s = 0.f;
#pragma unroll
            for (int j = 0; j < 4; ++j) { v[j] = xr[64 * j]; const int k0 = 4 * lane + 256 * j;
                const v2u a = *(const v2u*)(YS + (size_t)s0 * D + k0), b2 = *(const v2u*)(YS + (size_t)s1 * D + k0);
                v[j].x += g0 * bflo(a.x) + g1 * bflo(b2.x); v[j].y += g0 * bfhi(a.x) + g1 * bfhi(b2.x); v[j].z += g0 * bflo(a.y) + g1 * bflo(b2.y); v[j].w += g0 * bfhi(a.y) + g1 * bfhi(b2.y);
                s += (v[j].x * v[j].x + v[j].y * v[j].y) + (v[j].z * v[j].z + v[j].w * v[j].w); }
            s = wave_sum(s); const float rs = 1.0f / sqrtf(s * (1.0f / 1024.0f) + pg8::RMS_EPS);
#pragma unroll
            for (int j = 0; j < 4; ++j) { const f32x4 gv = *(const f32x4*)(gf + 4 * lane + 256 * j); xr[64 * j] = v[j] * rs * gv; }
        }
    }
}

extern "C" void kernel_launch(void* const* d_in, const int* in_sizes, int n_in, void* d_out, int out_size, void* d_ws, size_t ws_size, hipStream_t stream) {
    static int grid = 0;
    if (grid == 0) {
        if (n_in != 28 || in_sizes[0] != M * D || out_size != M * D || ws_size < WS_END) { fprintf(stderr, "kernel_launch: unexpected problem: n_in %d in0 %d out %d ws %zu (need %zu)\n", n_in, n_in > 0 ? in_sizes[0] : -1, out_size, ws_size, (size_t)WS_END); grid = -1; return; }
        int dev = 0, cus = 0, per_cu = 0;
        if (hipGetDevice(&dev) != hipSuccess || hipDeviceGetAttribute(&cus, hipDeviceAttributeMultiprocessorCount, dev) != hipSuccess) { grid = -1; return; }
        if (hipFuncSetAttribute((const void*)mk_fwd, hipFuncAttributeMaxDynamicSharedMemorySize, LDS_BYTES) != hipSuccess) { fprintf(stderr, "kernel_launch: hipFuncSetAttribute failed\n"); grid = -1; return; }
        if (hipOccupancyMaxActiveBlocksPerMultiprocessor(&per_cu, (const void*)mk_fwd, NTHREADS, LDS_BYTES) != hipSuccess || per_cu < 1) fprintf(stderr, "kernel_launch: occupancy query says %d\n", per_cu);
        (void)hipGetLastError();
        grid = cus;
        if (grid != 256) fprintf(stderr, "kernel_launch: built for the 256-CU MI355X; device reports %d CUs\n", cus);
    }
    if (grid < 0) return;
    if (hipMemsetAsync((char*)d_ws + WS_CTL, 0, CTL_ZERO_BYTES, stream) != hipSuccess) return;
    Args a{};
    for (int i = 0; i < 28; ++i) a.in[i] = (const float*)d_in[i];
    a.out = (float*)d_out; a.ws = (unsigned char*)d_ws;
    hipLaunchKernelGGL(mk_fwd, dim3(grid), dim3(NTHREADS), LDS_BYTES, stream, a);
}
```

```cpp
#include <hip/hip_runtime.h>
#include <cstdio>
#include <cstdint>

namespace pg8 {
#define PG8_LAS __attribute__((address_space(3)))
typedef unsigned short bf16_t;
typedef short bf16x8 __attribute__((ext_vector_type(8)));
typedef float f32x4 __attribute__((ext_vector_type(4)));
typedef unsigned u32x4 __attribute__((ext_vector_type(4)));
typedef unsigned u32x2 __attribute__((ext_vector_type(2)));
constexpr int BM = 256, BK = 64, HALF = 128, HTB = HALF * BK * 2  , STAGE_BYTES = 8 * HTB, NXCD = 8, WGM = 8;

__host__ __device__ __forceinline__ int lds_byte(int r, int c) { const int st = (r >> 4) * 2 + (c >> 5), rr = r & 15, cc = c & 31, ob = rr * 64 + cc * 2; return st * 1024 + (ob ^ (((ob >> 9) & 1) << 5)); }
__host__ __device__ __forceinline__ void stage_rc(int b, int& R, int& C) { const int st = b / 1024, sb = b % 1024, swz = sb ^ (((sb >> 9) & 1) << 5); R = (st >> 1) * 16 + swz / 64; C = (st & 1) * 32 + (swz % 64) / 2; }
__host__ __device__ __forceinline__ int perm32(int rho) { const int n = rho >> 4, i = rho & 15; return 8 * (i >> 2) + 4 * n + (i & 3); }

struct Unit { int pm, pn, zb, pa, qa, qb; };
struct Gemm { const bf16_t* A; const bf16_t* Bt; int lda, ldb, K; size_t zA, zB; };

struct StaticOrder {
    int nM, nN, nZ, nwg, G, c;
    __host__ __device__ void init(int M, int N, int Z, int G_, int c_) { nM = M / BM; nN = N / BM; nZ = Z; nwg = nM * nN * nZ; G = G_; c = c_; }
    __host__ __device__ bool next(int i, Unit& u) const {
        const long L = (long)i * G + c; if (L >= nwg) return false;
        int wgid = (int)L; { const int q = nwg / NXCD, r = nwg % NXCD, xcd = wgid % NXCD, off = wgid / NXCD; wgid = (xcd < r ? xcd * (q + 1) : r * (q + 1) + (xcd - r) * q) + off; }
        const int per = nM * nN; u.zb = wgid / per; wgid -= u.zb * per;
        const int nig = WGM * nN, gid = wgid / nig, fm = gid * WGM, gsz = (nM - fm) < WGM ? (nM - fm) : WGM;
        u.pm = fm + ((wgid % nig) % gsz); u.pn = (wgid % nig) / gsz; u.pa = u.pm; u.qa = 0; u.qb = 0; return true;
    }
    __device__ __forceinline__ void a_ready(const Unit&) const {}
    __device__ __forceinline__ void done(const Unit&) const {}
};

__device__ __forceinline__ unsigned cvt_pk_bf16(float lo, float hi) { unsigned r; asm volatile("v_cvt_pk_bf16_f32 %0, %1, %2" : "=v"(r) : "v"(lo), "v"(hi)); return r; }
typedef int v4i_t __attribute__((ext_vector_type(4))); typedef int v8i_t __attribute__((ext_vector_type(8)));
__device__ __forceinline__ v8i_t cat8(bf16x8 a, bf16x8 b) { return __builtin_shufflevector(__builtin_bit_cast(v4i_t, a), __builtin_bit_cast(v4i_t, b), 0, 1, 2, 3, 4, 5, 6, 7); }
__device__ __forceinline__ unsigned pk_fp8x4(float a, float b, float c, float d) { int r = 0; r = __builtin_amdgcn_cvt_pk_fp8_f32(a, b, r, false); r = __builtin_amdgcn_cvt_pk_fp8_f32(c, d, r, true); return (unsigned)r; }
__device__ __forceinline__ float bf_lo(unsigned w) { return __uint_as_float(w << 16); }
__device__ __forceinline__ float bf_hi(unsigned w) { return __uint_as_float(w & 0xffff0000u); }
__device__ __forceinline__ float fast_sigmoid(float z) { return __builtin_amdgcn_rcpf(1.0f + __builtin_amdgcn_exp2f(-1.4426950408889634f * z)); }
__device__ __forceinline__ f32x4 swiglu4(const f32x4 g, const f32x4 u, const float c1, const float rs2) {
    const f32x4 t = g * c1; f32x4 e;
#pragma unroll
    for (int i = 0; i < 4; ++i) e[i] = __builtin_amdgcn_exp2f(t[i]);
    const f32x4 d = e + 1.0f; f32x4 r;
#pragma unroll
    for (int i = 0; i < 4; ++i) r[i] = __builtin_amdgcn_rcpf(d[i]);
    return (g * u) * (r * rs2);
}
constexpr float RMS_EPS = 1e-6f;
__device__ __forceinline__ float rstd16(const float* ssp, int row) { const f32x4* p = (const f32x4*)(ssp + (size_t)row * 16); const f32x4 a = p[0], b = p[1], c = p[2], d = p[3];
    const float s = (((a[0] + a[1]) + (a[2] + a[3])) + ((b[0] + b[1]) + (b[2] + b[3]))) + (((c[0] + c[1]) + (c[2] + c[3])) + ((d[0] + d[1]) + (d[2] + d[3])));
    return __builtin_amdgcn_rsqf(s * (1.0f / 1024.0f) + RMS_EPS); }

__device__ __forceinline__ void rstd8(const float* ssp, int row0, int fq, float (&rs)[8]) {
    f32x4 p[8];
#pragma unroll
    for (int i = 0; i < 8; ++i) p[i] = *(const f32x4*)(ssp + (size_t)(row0 + (i >> 2) * HALF + (i & 3) * 16) * 16 + 4 * fq);
#pragma unroll
    for (int i = 0; i < 8; ++i) { float q = (p[i][0] + p[i][1]) + (p[i][2] + p[i][3]); q += __shfl_xor(q, 16); q += __shfl_xor(q, 32); rs[i] = __builtin_amdgcn_rsqf(q * (1.0f / 1024.0f) + RMS_EPS); }
}
__device__ __forceinline__ u32x4 pack8(const f32x4 v0, const f32x4 v1) { u32x4 w; w.x = cvt_pk_bf16(v0[0], v0[1]); w.y = cvt_pk_bf16(v0[2], v0[3]); w.z = cvt_pk_bf16(v1[0], v1[1]); w.w = cvt_pk_bf16(v1[2], v1[3]); return w; }

struct EpiInProj0 {
    static constexpr bool PERM = true, AFTER_DRAIN = false;
    const float* ss; bf16_t* uext; bf16_t* qkv; float qscale;
    __device__ __forceinline__ void operator()(const f32x4 (&acc)[2][2][4][2], const Unit& u, int wr, int wc, int fr, int fq) const {
        const int row0 = u.pm * BM + wr * 64 + fr; float rsa[8]; rstd8(ss, row0, fq, rsa);
#pragma unroll
        for (int ai = 0; ai < 2; ++ai)
#pragma unroll
            for (int m = 0; m < 4; ++m) { const int row = row0 + ai * HALF + m * 16; const float rs = rsa[ai * 4 + m];
#pragma unroll
                for (int bj = 0; bj < 2; ++bj) { const int col0 = u.pn * BM + bj * HALF + wc * 32 + 8 * fq;
                    float sc = rs; bf16_t* dst;
                    if (u.pn < 2) dst = uext + ((size_t)(col0 >> 4) * 512 + (row >> 5)) * 640 + (row & 31) * 16 + (col0 & 15);
                    else { const int c = col0 - 512; if (c < 512) sc *= qscale; dst = qkv + (size_t)row * 1536 + c; }
                    *(u32x4*)dst = pack8(acc[ai][bj][m][0] * sc, acc[ai][bj][m][1] * sc); } }
    }
};
struct EpiS5State {
    static constexpr bool PERM = false, AFTER_DRAIN = false;
    float* sloc;
    __device__ __forceinline__ void operator()(const f32x4 (&acc)[2][2][4][2], const Unit& u, int wr, int wc, int fr, int fq) const {
        const int row0 = u.pm * BM + wr * 64 + fr, col0 = wc * 32 + 4 * fq;
#pragma unroll
        for (int ai = 0; ai < 2; ++ai)
#pragma unroll
            for (int m = 0; m < 4; ++m) { float* rowp = sloc + ((size_t)u.zb * 512 + row0 + ai * HALF + m * 16) * 128 + col0;
#pragma unroll
                for (int n = 0; n < 2; ++n) *(f32x4*)(rowp + n * 16) = acc[ai][0][m][n]; }
    }
};
__device__ __forceinline__ float gelu_tanh(float x) { const float a = x * (1.0f + 0.044715f * x * x); return x * __builtin_amdgcn_rcpf(1.0f + __builtin_amdgcn_exp2f(-2.302208198f * a)); }
struct EpiS5Y {
    static constexpr bool PERM = true, AFTER_DRAIN = false;
    bf16_t* yg;
    __device__ __forceinline__ void operator()(const f32x4 (&acc)[2][2][4][2], const Unit& u, int wr, int wc, int fr, int fq) const {
        const int row0 = u.pm * BM + wr * 64 + fr;
#pragma unroll
        for (int ai = 0; ai < 2; ++ai)
#pragma unroll
            for (int m = 0; m < 4; ++m) { const int chunk = row0 + ai * HALF + m * 16;
#pragma unroll
                for (int bj = 0; bj < 2; ++bj) { const int col0 = u.pn * BM + bj * HALF + wc * 32 + 8 * fq; const int i = col0 >> 4, h0 = col0 & 15;
                    f32x4 v0 = acc[ai][bj][m][0], v1 = acc[ai][bj][m][1];
#pragma unroll
                    for (int e = 0; e < 4; ++e) { v0[e] = gelu_tanh(v0[e]); v1[e] = gelu_tanh(v1[e]); }
                    *(u32x4*)(yg + ((size_t)chunk * 32 + i) * 512 + u.zb * 16 + h0) = pack8(v0, v1); } }
    }
};
struct EpiGlu {
    static constexpr bool PERM = true, AFTER_DRAIN = false;
    const bf16_t* yg; const float* bias; bf16_t* mix;
    __device__ __forceinline__ void operator()(const f32x4 (&acc)[2][2][4][2], const Unit& u, int wr, int wc, int fr, int fq) const {
        const int row0 = u.pm * BM + wr * 64 + fr; u32x4 ywa[2][8];
#pragma unroll
        for (int bj = 0; bj < 2; ++bj)
#pragma unroll
            for (int i = 0; i < 8; ++i) ywa[bj][i] = *(const u32x4*)(yg + (size_t)(row0 + (i >> 2) * HALF + (i & 3) * 16) * 512 + u.pn * BM + bj * HALF + wc * 32 + 8 * fq);
#pragma unroll
        for (int bj = 0; bj < 2; ++bj) { const int col0 = u.pn * BM + bj * HALF + wc * 32 + 8 * fq;
            const f32x4 b0 = *(const f32x4*)(bias + col0), b1 = *(const f32x4*)(bias + col0 + 4);
#pragma unroll
            for (int ai = 0; ai < 2; ++ai)
#pragma unroll
                for (int m = 0; m < 4; ++m) { const int row = row0 + ai * HALF + m * 16;
                    const u32x4 yw = ywa[bj][ai * 4 + m];
                    f32x4 z0 = acc[ai][bj][m][0] + b0, z1 = acc[ai][bj][m][1] + b1, o0, o1;
                    o0[0] = bf_lo(yw.x) * fast_sigmoid(z0[0]); o0[1] = bf_hi(yw.x) * fast_sigmoid(z0[1]); o0[2] = bf_lo(yw.y) * fast_sigmoid(z0[2]); o0[3] = bf_hi(yw.y) * fast_sigmoid(z0[3]);
                    o1[0] = bf_lo(yw.z) * fast_sigmoid(z1[0]); o1[1] = bf_hi(yw.z) * fast_sigmoid(z1[1]); o1[2] = bf_lo(yw.w) * fast_sigmoid(z1[2]); o1[3] = bf_hi(yw.w) * fast_sigmoid(z1[3]);
                    *(u32x4*)(mix + (size_t)row * 1024 + col0) = pack8(o0, o1); } }
    }
};
template <bool XBOUT> struct EpiResid {
    static constexpr bool PERM = false, AFTER_DRAIN = false;
    const float* R; float* X; bf16_t* xb; float* ssq; unsigned char* xq = nullptr;
    __device__ __forceinline__ void operator()(const f32x4 (&acc)[2][2][4][2], const Unit& u, int wr, int wc, int fr, int fq) const {
        const int row0 = u.pm * BM + wr * 64 + fr, col0 = u.pn * BM + wc * 32 + 4 * fq;
#pragma unroll
        for (int ai = 0; ai < 2; ++ai) {
            f32x4 rv[4][2][2];
#pragma unroll
            for (int m = 0; m < 4; ++m)
#pragma unroll
                for (int bj = 0; bj < 2; ++bj)
#pragma unroll
                    for (int n = 0; n < 2; ++n) rv[m][bj][n] = *(const f32x4*)(R + (size_t)(row0 + ai * HALF + m * 16) * 1024 + col0 + bj * HALF + n * 16);
            asm volatile("" ::: "memory");
#pragma unroll
            for (int m = 0; m < 4; ++m) { const int row = row0 + ai * HALF + m * 16; const size_t off = (size_t)row * 1024 + col0; float s = 0.f;
#pragma unroll
                for (int bj = 0; bj < 2; ++bj)
#pragma unroll
                    for (int n = 0; n < 2; ++n) { const f32x4 x = rv[m][bj][n] + acc[ai][bj][m][n];
                        *(f32x4*)(X + off + bj * HALF + n * 16) = x; s += (x[0] * x[0] + x[1] * x[1]) + (x[2] * x[2] + x[3] * x[3]);
                        if (XBOUT) { u32x2 w; w.x = cvt_pk_bf16(x[0], x[1]); w.y = cvt_pk_bf16(x[2], x[3]); *(u32x2*)(xb + off + bj * HALF + n * 16) = w;
                            if (xq) *(unsigned*)(xq + off + bj * HALF + n * 16) = pk_fp8x4(x[0], x[1], x[2], x[3]); } }
                s += __shfl_xor(s, 16); s += __shfl_xor(s, 32);
                if (XBOUT && fq == 0) ssq[(size_t)row * 16 + u.pn * 4 + wc] = s; }
            asm volatile("" ::: "memory"); }
    }
};
template <bool RS_IS_SSQ> struct EpiSwiGlu {
    static constexpr bool PERM = true, AFTER_DRAIN = false;
    const float* rsv; bf16_t* H; int ldh;
    __device__ __forceinline__ void operator()(const f32x4 (&acc)[2][2][4][2], const Unit& u, int wr, int wc, int fr, int fq) const {
        const int row0 = u.pm * BM + wr * 64 + fr, col0 = u.pn * HALF + wc * 32 + 8 * fq; float rsa[8];
        if (RS_IS_SSQ) rstd8(rsv, row0, fq, rsa);
        else {
#pragma unroll
            for (int i = 0; i < 8; ++i) rsa[i] = rsv[row0 + (i >> 2) * HALF + (i & 3) * 16]; }
#pragma unroll
        for (int ai = 0; ai < 2; ++ai)
#pragma unroll
            for (int m = 0; m < 4; ++m) { const int row = row0 + ai * HALF + m * 16; const float rs = rsa[ai * 4 + m], c1 = -1.4426950408889634f * rs, rs2 = rs * rs;
                f32x4 o[2];
#pragma unroll
                for (int n = 0; n < 2; ++n) o[n] = swiglu4(acc[ai][0][m][n], acc[ai][1][m][n], c1, rs2);
                *(u32x4*)(H + (size_t)row * ldh + col0) = pack8(o[0], o[1]); }
    }
};
struct EpiSwiGluFp8 {
    static constexpr bool PERM = true, AFTER_DRAIN = false;
    const float* rsv; unsigned char* H; int ldh;
    __device__ __forceinline__ void operator()(const f32x4 (&acc)[2][2][4][2], const Unit& u, int wr, int wc, int fr, int fq) const {
        const int row0 = u.pm * BM + wr * 64 + fr, col0 = u.pn * HALF + wc * 32 + 8 * fq; float rsa[8];
#pragma unroll
        for (int i = 0; i < 8; ++i) rsa[i] = rsv[u.pa * BM + wr * 64 + fr + (i >> 2) * HALF + (i & 3) * 16];
#pragma unroll
        for (int ai = 0; ai < 2; ++ai)
#pragma unroll
            for (int m = 0; m < 4; ++m) { const int row = row0 + ai * HALF + m * 16; const float rs = rsa[ai * 4 + m], c1 = -1.4426950408889634f * rs, rs2 = rs * rs;
                f32x4 o[2];
#pragma unroll
                for (int n = 0; n < 2; ++n) o[n] = swiglu4(acc[ai][0][m][n], acc[ai][1][m][n], c1, rs2);
                u32x2 w; w.x = pk_fp8x4(o[0][0], o[0][1], o[0][2], o[0][3]); w.y = pk_fp8x4(o[1][0], o[1][1], o[1][2], o[1][3]);
                *(u32x2*)(H + (size_t)row * ldh + col0) = w; }
    }
};
struct EpiInProj1 {
    static constexpr bool PERM = true, AFTER_DRAIN = false;
    const float* ss; bf16_t* qkv; float qscale;
    unsigned* kn;
    __device__ __forceinline__ void operator()(const f32x4 (&acc)[2][2][4][2], const Unit& u, int wr, int wc, int fr, int fq) const {
        const int row0 = u.pm * BM + wr * 64 + fr; const float qs = (u.pn < 4) ? qscale : 1.0f; float rsa[8]; rstd8(ss, row0, fq, rsa);
#pragma unroll
        for (int ai = 0; ai < 2; ++ai)
#pragma unroll
            for (int m = 0; m < 4; ++m) { const int row = row0 + ai * HALF + m * 16; const float sc = rsa[ai * 4 + m] * qs;
#pragma unroll
                for (int bj = 0; bj < 2; ++bj) { const int col0 = (u.pn & 3) * BM + bj * HALF + wc * 32 + 8 * fq;
                    const f32x4 v0 = acc[ai][bj][m][0] * sc, v1 = acc[ai][bj][m][1] * sc;
                    *(u32x4*)(qkv + (size_t)(u.pn >> 2) * (16384 * 1024) + (size_t)row * 1024 + col0) = pack8(v0, v1);
                    if ((u.pn >> 2) == 1) {
                        float q = ((v0[0] * v0[0] + v0[1] * v0[1]) + (v0[2] * v0[2] + v0[3] * v0[3])) + ((v1[0] * v1[0] + v1[1] * v1[1]) + (v1[2] * v1[2] + v1[3] * v1[3]));
                        q += __shfl_xor(q, 16); q += __shfl_xor(q, 32);
                        q = fmaxf(q, __shfl_xor(q, 1)); q = fmaxf(q, __shfl_xor(q, 2)); q = fmaxf(q, __shfl_xor(q, 4)); q = fmaxf(q, __shfl_xor(q, 8));
                        if (fr == 0 && fq == 0) { const int head = (u.pn & 3) * 4 + bj * 2 + (wc >> 1), bb = row >> 13, tile = (row & 8191) >> 6;
                            atomicMax(kn + ((size_t)(bb * 16 + head) * 128 + tile) * 2 + (wc & 1), __float_as_uint(q * 1.01f)); } } } }
    }
};
struct EpiStoreBf16 {
    static constexpr bool PERM = true, AFTER_DRAIN = false;
    bf16_t* O; int ldc;
    __device__ __forceinline__ void operator()(const f32x4 (&acc)[2][2][4][2], const Unit& u, int wr, int wc, int fr, int fq) const {
        const int row0 = u.pm * BM + wr * 64 + fr;
#pragma unroll
        for (int ai = 0; ai < 2; ++ai)
#pragma unroll
            for (int m = 0; m < 4; ++m) { const int row = row0 + ai * HALF + m * 16;
#pragma unroll
                for (int bj = 0; bj < 2; ++bj) { const int col0 = u.pn * BM + bj * HALF + wc * 32 + 8 * fq;
                    *(u32x4*)(O + (size_t)row * ldc + col0) = pack8(acc[ai][bj][m][0], acc[ai][bj][m][1]); } }
    }
};

struct EpiStoreQuad {
    static constexpr bool PERM = true, AFTER_DRAIN = false;
    bf16_t* O; int ldc;
    __device__ __forceinline__ void operator()(const f32x4 (&acc)[2][2][4][2], const Unit& u, int wr, int wc, int fr, int fq) const {
        const int row0 = u.pm * BM + u.qa * HALF + wr * 64 + fr, col0 = u.pn * BM + u.qb * HALF + wc * 32 + 8 * fq;
#pragma unroll
        for (int m = 0; m < 4; ++m) *(u32x4*)(O + (size_t)(row0 + m * 16) * ldc + col0) = pack8(acc[0][0][m][0], acc[0][0][m][1]);
    }
};

typedef float f32x2z __attribute__((ext_vector_type(2)));
__device__ __forceinline__ f32x4 zero4_b64() { f32x2z a, b; asm volatile("v_mov_b64 %0, 0" : "=v"(a)); asm volatile("v_mov_b64 %0, 0" : "=v"(b)); return (f32x4){a[0], a[1], b[0], b[1]}; }
template <bool F8> struct Frag { bf16x8 k[2]; };
template <> struct Frag<true> { v8i_t v; };
template <class Epi, class Sched, bool ALIGN_EPI = false, bool SP2 = false, bool FP8 = false, bool QUAD = false>
__device__ __forceinline__ void gemm_phase(PG8_LAS unsigned char* lds, const Gemm g, const Sched& S, const Epi& E) {
    int tid_ = threadIdx.x; asm volatile("" : "+v"(tid_));
    const int tid = tid_, wid = __builtin_amdgcn_readfirstlane(tid >> 6), lane = tid & 63, wr = wid >> 2, wc = wid & 3, fr = lane & 15, fq = lane >> 4;
    const int K = g.K, nt = K / BK;
    unsigned voffA[2], voffB[2];
#pragma unroll
    for (int i = 0; i < 2; ++i) { int R, C; stage_rc(tid * 16 + i * 8192, R, C); const int Rb = Epi::PERM ? ((R & ~31) + perm32(R & 31)) : R;
        voffA[i] = (unsigned)(R * g.lda + C) * 2u; voffB[i] = (unsigned)(Rb * g.ldb + C) * 2u; }
    const size_t kstep = (size_t)(BK * 2);
    const size_t hstepA = (size_t)HALF * g.lda * 2, hstepB = (size_t)HALF * g.ldb * 2;
    const size_t tstepA = 2 * hstepA, tstepB = 2 * hstepB;
    const unsigned ldsw = (unsigned)wid * 1024u;
    const int aoff = lds_byte(wr * 64 + fr, fq * 8), boff = lds_byte(wc * 32 + fr, fq * 8);
#define PG8_SA(b, h) (((b) * 2 + (h)) * HTB)
#define PG8_SB(b, h) ((4 + (b) * 2 + (h)) * HTB)
#define PG8_STAGE(bufoff, gbase, voff) do { _Pragma("unroll") for (int _i = 0; _i < 2; ++_i) \
        __builtin_amdgcn_global_load_lds((const unsigned*)((const char*)(gbase) + (voff)[_i]), (PG8_LAS unsigned*)(lds + (bufoff) + ldsw + _i * 8192), 16, 0, 0); } while (0)
    const PG8_LAS unsigned char* ldsA_ = lds + aoff; const PG8_LAS unsigned char* ldsB_ = lds + 4 * HTB + boff; asm volatile("" : "+v"(ldsA_), "+v"(ldsB_));
#define PG8_RDA(off) (*(const PG8_LAS bf16x8*)(ldsA_ + (off)))
#define PG8_RDB(off) (*(const PG8_LAS bf16x8*)(ldsB_ + (off)))
#define PG8_LDA(dst, b, h) do { _Pragma("unroll") for (int m = 0; m < 4; ++m) { if constexpr (FP8) dst[m].v = cat8(PG8_RDA(PG8_SA(b, h) + m * 2048), PG8_RDA(PG8_SA(b, h) + m * 2048 + 1024)); \
        else { dst[m].k[0] = PG8_RDA(PG8_SA(b, h) + m * 2048); dst[m].k[1] = PG8_RDA(PG8_SA(b, h) + m * 2048 + 1024); } } } while (0)
#define PG8_LDB(dst, b, h) do { _Pragma("unroll") for (int n = 0; n < 2; ++n) { if constexpr (FP8) dst[n].v = cat8(PG8_RDB(PG8_SB(b, h) - 4 * HTB + n * 2048), PG8_RDB(PG8_SB(b, h) - 4 * HTB + n * 2048 + 1024)); \
        else { dst[n].k[0] = PG8_RDB(PG8_SB(b, h) - 4 * HTB + n * 2048); dst[n].k[1] = PG8_RDB(PG8_SB(b, h) - 4 * HTB + n * 2048 + 1024); } } } while (0)
#define PG8_MMA(ai, bj, At, Bt) do { if constexpr (!(QUAD && (((ai) | (bj)) != 0))) { __builtin_amdgcn_s_setprio(1); _Pragma("unroll") for (int m = 0; m < 4; ++m) _Pragma("unroll") for (int n = 0; n < 2; ++n) { \
        if constexpr (FP8) { asm volatile("v_mfma_scale_f32_16x16x128_f8f6f4 %0, %1, %2, %0, %3, %4 op_sel_hi:[0,0,0]" : "+v"(acc[ai][bj][m][n]) : "v"(Bt[n].v), "v"(At[m].v), "v"(sclB_), "v"(sclA_)); } \
        else { _Pragma("unroll") for (int k = 0; k < 2; ++k) acc[ai][bj][m][n] = __builtin_amdgcn_mfma_f32_16x16x32_bf16(Bt[n].k[k], At[m].k[k], acc[ai][bj][m][n], 0, 0, 0); } } __builtin_amdgcn_s_setprio(0); } } while (0)
#define PG8_WAIT_V(n) asm volatile("s_waitcnt vmcnt(" #n ")" ::: "memory")
#define PG8_WAIT_L(n) asm volatile("s_waitcnt lgkmcnt(" #n ")" ::: "memory")
#define PG8_BAR __builtin_amdgcn_s_barrier()
#define PG8_SCHED __builtin_amdgcn_sched_barrier(0)
    Unit cur, nxt; int ui = 0;
    if (!S.next(0, cur)) return;
    f32x4 acc[2][2][4][2];
#pragma unroll
    for (int a = 0; a < 2; ++a)
#pragma unroll
        for (int b = 0; b < 2; ++b)
#pragma unroll
            for (int m = 0; m < 4; ++m)
#pragma unroll
                for (int n = 0; n < 2; ++n) acc[a][b][m][n] = zero4_b64();
    Frag<FP8> At[4], B0[2], B1[2];
    int sclB_ = 0x79797979, sclA_ = 0x7f7f7f7f; asm volatile("" : "+v"(sclB_), "+v"(sclA_));
    const char* cA = (const char*)g.A + (size_t)cur.zb * g.zA + (size_t)cur.pa * tstepA + (QUAD ? (size_t)cur.qa * hstepA : 0); const char* cB = (const char*)g.Bt + (size_t)cur.zb * g.zB + (size_t)cur.pn * tstepB + (QUAD ? (size_t)cur.qb * hstepB : 0);
    S.a_ready(cur);
    if constexpr (SP2) {
        PG8_STAGE(PG8_SB(0, 0), cB, voffB); PG8_STAGE(PG8_SB(0, 1), cB + hstepB, voffB); PG8_STAGE(PG8_SA(0, 0), cA, voffA); PG8_STAGE(PG8_SA(0, 1), cA + hstepA, voffA);
        if (wr == 1) PG8_BAR;
        PG8_WAIT_V(2); PG8_BAR;
        PG8_STAGE(PG8_SB(1, 0), cB + kstep, voffB); PG8_STAGE(PG8_SA(1, 0), cA + kstep, voffA); PG8_STAGE(PG8_SB(1, 1), cB + hstepB + kstep, voffB);
        PG8_WAIT_V(6); PG8_BAR;
    } else {
        PG8_STAGE(PG8_SB(0, 0), cB, voffB); PG8_STAGE(PG8_SA(0, 0), cA, voffA); PG8_STAGE(PG8_SB(0, 1), cB + hstepB, voffB); PG8_STAGE(PG8_SA(0, 1), cA + hstepA, voffA);
        if (wr == 1) PG8_BAR;
        PG8_WAIT_V(4); PG8_BAR;
        PG8_STAGE(PG8_SB(1, 0), cB + kstep, voffB); PG8_STAGE(PG8_SA(1, 0), cA + kstep, voffA); PG8_STAGE(PG8_SB(1, 1), cB + hstepB + kstep, voffB);
        PG8_WAIT_V(6); PG8_BAR;
    }
    for (;;) {
        const bool has_next = S.next(ui + 1, nxt);
        const char* nA = has_next ? (const char*)g.A + (size_t)nxt.zb * g.zA + (size_t)nxt.pa * tstepA + (QUAD ? (size_t)nxt.qa * hstepA : 0) : cA; const char* nB = has_next ? (const char*)g.Bt + (size_t)nxt.zb * g.zB + (size_t)nxt.pn * tstepB + (QUAD ? (size_t)nxt.qb * hstepB : 0) : cB;
#pragma unroll 1
        for (int t = 0; t < nt; t += 2) {
            const bool last = (t == nt - 2);
            const char* a1 = cA + (size_t)(t + 1) * kstep;
            const char* a2 = last ? nA : cA + (size_t)(t + 2) * kstep; const char* b2 = last ? nB : cB + (size_t)(t + 2) * kstep;
            const char* a3 = a2 + kstep; const char* b3 = b2 + kstep;
            if (last && has_next) S.a_ready(nxt);
            if constexpr (SP2) {
            PG8_LDB(B0, 0, 0); PG8_LDB(B1, 0, 1); PG8_SCHED; PG8_LDA(At, 0, 0); PG8_STAGE(PG8_SA(1, 1), a1 + hstepA, voffA);
            PG8_WAIT_V(8); PG8_WAIT_L(0); PG8_BAR; PG8_MMA(0, 0, At, B0); PG8_MMA(0, 1, At, B1); PG8_BAR; PG8_SCHED;
            PG8_LDA(At, 0, 1); PG8_STAGE(PG8_SB(0, 0), b2, voffB); PG8_STAGE(PG8_SB(0, 1), b2 + hstepB, voffB); PG8_STAGE(PG8_SA(0, 0), a2, voffA);
            PG8_WAIT_V(8); PG8_WAIT_L(0); PG8_BAR; PG8_MMA(1, 0, At, B0); PG8_MMA(1, 1, At, B1); PG8_BAR; PG8_SCHED;
            PG8_LDB(B0, 1, 0); PG8_LDB(B1, 1, 1); PG8_SCHED; PG8_LDA(At, 1, 0); PG8_STAGE(PG8_SA(0, 1), a2 + hstepA, voffA);
            PG8_WAIT_V(8); PG8_WAIT_L(0); PG8_BAR; PG8_MMA(0, 0, At, B0); PG8_MMA(0, 1, At, B1); PG8_BAR; PG8_SCHED;
            PG8_LDA(At, 1, 1); PG8_STAGE(PG8_SB(1, 0), b3, voffB); PG8_STAGE(PG8_SB(1, 1), b3 + hstepB, voffB); PG8_STAGE(PG8_SA(1, 0), a3, voffA);
            PG8_WAIT_V(8); PG8_WAIT_L(0); PG8_BAR; PG8_MMA(1, 0, At, B0); PG8_MMA(1, 1, At, B1); PG8_BAR; PG8_SCHED;
            } else {
            PG8_LDB(B0, 0, 0); PG8_SCHED; PG8_LDA(At, 0, 0); PG8_STAGE(PG8_SA(1, 1), a1 + hstepA, voffA);
            PG8_WAIT_L(8); PG8_BAR; PG8_WAIT_L(0); PG8_MMA(0, 0, At, B0); PG8_BAR; PG8_SCHED;
            PG8_LDB(B1, 0, 1); PG8_STAGE(PG8_SB(0, 0), b2, voffB);
            PG8_BAR; PG8_WAIT_L(0); PG8_MMA(0, 1, At, B1); PG8_BAR;
            PG8_LDA(At, 0, 1); PG8_STAGE(PG8_SA(0, 0), a2, voffA);
            PG8_BAR; PG8_WAIT_L(0); PG8_MMA(1, 0, At, B0); PG8_BAR; PG8_SCHED;
            PG8_STAGE(PG8_SB(0, 1), b2 + hstepB, voffB);
            PG8_WAIT_V(6); PG8_BAR; PG8_MMA(1, 1, At, B1); PG8_BAR;
            PG8_LDB(B0, 1, 0); PG8_SCHED; PG8_LDA(At, 1, 0); PG8_STAGE(PG8_SA(0, 1), a2 + hstepA, voffA);
            PG8_WAIT_L(8); PG8_BAR; PG8_WAIT_L(0); PG8_MMA(0, 0, At, B0); PG8_BAR; PG8_SCHED;
            PG8_LDB(B1, 1, 1); PG8_STAGE(PG8_SB(1, 0), b3, voffB);
            PG8_BAR; PG8_WAIT_L(0); PG8_MMA(0, 1, At, B1); PG8_BAR;
            PG8_LDA(At, 1, 1); PG8_STAGE(PG8_SA(1, 0), a3, voffA);
            PG8_BAR; PG8_WAIT_L(0); PG8_MMA(1, 0, At, B0); PG8_BAR; PG8_SCHED;
            PG8_STAGE(PG8_SB(1, 1), b3 + hstepB, voffB);
            PG8_WAIT_V(6); PG8_BAR; PG8_MMA(1, 1, At, B1); PG8_BAR;
            }
        }
        if constexpr (ALIGN_EPI) { if (wr == 0) PG8_BAR; }
        if constexpr (FP8) asm volatile("s_nop 15\n\ts_nop 15" ::: "memory");
        if constexpr (!Epi::AFTER_DRAIN) { int fr_ = fr, fq_ = fq; asm volatile("" : "+v"(fr_), "+v"(fq_));
            E(acc, cur, wr, wc, fr_, fq_); S.done(cur); }
        if (!has_next) break;
#pragma unroll
        for (int a = 0; a < 2; ++a)
#pragma unroll
            for (int b = 0; b < 2; ++b)
#pragma unroll
                for (int m = 0; m < 4; ++m)
#pragma unroll
                    for (int n = 0; n < 2; ++n) acc[a][b][m][n] = zero4_b64();
        cur = nxt; cA = nA; cB = nB; ++ui;
        if constexpr (ALIGN_EPI) { if (wr == 1) PG8_BAR; }
    }
    PG8_WAIT_V(0);
    if constexpr (!ALIGN_EPI) { if (wr == 0) PG8_BAR; }
    PG8_BAR;
    if constexpr (Epi::AFTER_DRAIN) { E.fused(acc, cur, wr, wc, fr, fq, lds, wid, lane); S.done(cur); }
#undef PG8_SA
#undef PG8_SB
#undef PG8_STAGE
#undef PG8_LDA
#undef PG8_RDA
#undef PG8_RDB
#undef PG8_LDB
#undef PG8_MMA
#undef PG8_WAIT_V
#undef PG8_WAIT_L
#undef PG8_BAR
#undef PG8_SCHED
}
}

#include <hip/hip_bf16.h>
#include <cmath>
namespace attn_body {
using bf16=__hip_bfloat16;
using bf16x8=__attribute__((ext_vector_type(8)))short;
using s16x4=__attribute__((ext_vector_type(4)))short;
using f32x16=__attribute__((ext_vector_type(16)))float;
using u32x4=__attribute__((ext_vector_type(4)))unsigned;
constexpr int BATCH=2,NHEAD=16,SEQ=8192,D=64,DM=NHEAD*D;
constexpr int NW=8,QBLK=32,QB=QBLK*NW,KVBLK=64,NQB=SEQ/QB;
constexpr int ATTN_PITCH=DM, ATTN_UNIT_ROWS=QB;
__device__ __forceinline__ int crow(int r,int hi){return (r&3)+8*(r>>2)+4*hi;}
#define SBAR() __builtin_amdgcn_sched_barrier(0)
__device__ __forceinline__ void cmask(f32x16&p0,f32x16&p1,int jb,int qrel,int hi){
  const float NEG=-INFINITY; int kb=64*jb+4*hi;
  #pragma unroll
  for(int r=0;r<16;++r){int kv=kb+(r&3)+8*(r>>2); if(kv>qrel)p0[r]=NEG; if(kv+32>qrel)p1[r]=NEG;}
}

constexpr int NSLOT=3, SLOTB=8192;
constexpr int LDS_K=0, LDS_V=NSLOT*SLOTB, LDS_WS=2*NSLOT*SLOTB, LDS_OST=LDS_WS+NW*64*4, LDS_NB=LDS_OST+NW*4096  , LDS_PK=LDS_NB+32768+64  , LDS_BYTES=LDS_PK+1024;
constexpr float C2=0.125f*1.4426950408889634f;
__device__ __forceinline__ void glds16(const void*gsrc,unsigned lds_dst){unsigned keep;
  asm volatile("s_mov_b32 %0, m0\n\ts_mov_b32 m0, %2\n\ts_nop 0\n\tglobal_load_lds_dwordx4 %1, off\n\ts_mov_b32 m0, %0":"=&s"(keep):"v"(gsrc),"s"(lds_dst):"memory");}
__device__ __forceinline__ float max3f(float a,float b,float c){float r;asm("v_max3_f32 %0, %1, %2, %3":"=v"(r):"v"(a),"v"(b),"v"(c));return r;}
__device__ __forceinline__ float max2f(float a,float b){float r;asm("v_max_f32_e32 %0, %1, %2":"=v"(r):"v"(a),"v"(b));return r;}
__device__ __forceinline__ float fadd_s(float a,float b){float r;asm("v_add_f32_e32 %0, %1, %2":"=v"(r):"v"(a),"v"(b));return r;}
__device__ __forceinline__ float fsub_s(float a,float b){float r;asm("v_sub_f32_e32 %0, %1, %2":"=v"(r):"v"(a),"v"(b));return r;}
typedef float f32x2_t __attribute__((ext_vector_type(2))); typedef __bf16 bf16x2_t __attribute__((ext_vector_type(2)));
__device__ __forceinline__ unsigned cvtpk_s(float lo,float hi){f32x2_t v={lo,hi};bf16x2_t b=__builtin_convertvector(v,bf16x2_t);return __builtin_bit_cast(unsigned,b);}
#define WAIT_BAR(N) asm volatile("s_waitcnt vmcnt(" #N ") lgkmcnt(0)\n\ts_barrier":::"memory")

__device__ __forceinline__ void qkt(f32x16&p0,f32x16&p1,const char*Kslot,const bf16x8*qr,const f32x16&negm,int r32,int hi){
  const char*kb=Kslot+hi*1024+r32*16;
  #pragma unroll
  for(int d0=0;d0<4;++d0){
    const bf16x8 b0=*reinterpret_cast<const bf16x8*>(kb+d0*2048);
    const bf16x8 b1=*reinterpret_cast<const bf16x8*>(kb+d0*2048+512);
    if(d0==0){p0=__builtin_amdgcn_mfma_f32_32x32x16_bf16(b0,qr[0],negm,0,0,0);p1=__builtin_amdgcn_mfma_f32_32x32x16_bf16(b1,qr[0],negm,0,0,0);}
    else{p0=__builtin_amdgcn_mfma_f32_32x32x16_bf16(b0,qr[d0],p0,0,0,0);p1=__builtin_amdgcn_mfma_f32_32x32x16_bf16(b1,qr[d0],p1,0,0,0);}}
}
typedef __attribute__((address_space(3))) const char* lds_cptr;
typedef short v4i16_t __attribute__((ext_vector_type(4)));
__device__ __forceinline__ void kload8(bf16x8*kf,lds_cptr kp){
  kf[0]=*(const __attribute__((address_space(3))) bf16x8*)(kp);      kf[1]=*(const __attribute__((address_space(3))) bf16x8*)(kp+512);
  kf[2]=*(const __attribute__((address_space(3))) bf16x8*)(kp+2048); kf[3]=*(const __attribute__((address_space(3))) bf16x8*)(kp+2560);
  kf[4]=*(const __attribute__((address_space(3))) bf16x8*)(kp+4096); kf[5]=*(const __attribute__((address_space(3))) bf16x8*)(kp+4608);
  kf[6]=*(const __attribute__((address_space(3))) bf16x8*)(kp+6144); kf[7]=*(const __attribute__((address_space(3))) bf16x8*)(kp+6656);
}
__device__ __forceinline__ void kload2(bf16x8*kf,lds_cptr kp,int j){ kf[2*j]=*(const __attribute__((address_space(3))) bf16x8*)(kp+j*2048); kf[2*j+1]=*(const __attribute__((address_space(3))) bf16x8*)(kp+j*2048+512); }
__device__ __forceinline__ s16x4 vtr(lds_cptr p){ return __builtin_bit_cast(s16x4,__builtin_amdgcn_ds_read_tr16_b64_v4i16((__attribute__((address_space(3))) v4i16_t*)p)); }
__device__ __forceinline__ float rowmax(const f32x16&p0,const f32x16&p1){
  float a=max3f(p0[0],p0[1],p1[0]),b=max3f(p0[2],p0[3],p1[1]);a=max3f(a,p1[2],p1[3]);
  #pragma unroll
  for(int r=4;r<16;r+=4){a=max3f(a,p0[r],p0[r+1]);b=max3f(b,p0[r+2],p0[r+3]);a=max3f(a,p1[r],p1[r+1]);b=max3f(b,p1[r+2],p1[r+3]);}
  const float m=max2f(a,b);
  auto rr=__builtin_amdgcn_permlane32_swap(__float_as_uint(m),__float_as_uint(m),false,false);
  return max2f(__uint_as_float(rr[0]),__uint_as_float(rr[1]));
}
__device__ __forceinline__ void pv(f32x16*o,int vb,bf16x8 pa0,bf16x8 pa1,bf16x8 pa2,bf16x8 pa3){
  #pragma unroll
  for(int d0=0;d0<2;++d0){s16x4 lo[4],hi[4];
    #pragma unroll
    for(int ks=0;ks<4;++ks){
      asm volatile("ds_read_b64_tr_b16 %0,%1 offset:%c2":"=&v"(lo[ks]):"v"(vb),"i"(d0*4096+ks*1024):"memory");
      asm volatile("ds_read_b64_tr_b16 %0,%1 offset:%c2":"=&v"(hi[ks]):"v"(vb),"i"(d0*4096+ks*1024+512):"memory");}
    asm volatile("s_waitcnt lgkmcnt(0)":::"memory");SBAR();
    #define PK(k) (bf16x8){lo[k][0],lo[k][1],lo[k][2],lo[k][3],hi[k][0],hi[k][1],hi[k][2],hi[k][3]}
    o[d0]=__builtin_amdgcn_mfma_f32_32x32x16_bf16(pa0,PK(0),o[d0],0,0,0);
    o[d0]=__builtin_amdgcn_mfma_f32_32x32x16_bf16(pa1,PK(1),o[d0],0,0,0);
    o[d0]=__builtin_amdgcn_mfma_f32_32x32x16_bf16(pa2,PK(2),o[d0],0,0,0);
    o[d0]=__builtin_amdgcn_mfma_f32_32x32x16_bf16(pa3,PK(3),o[d0],0,0,0);
    #undef PK
  }
}

typedef float f32x4_t __attribute__((ext_vector_type(4)));
__device__ __forceinline__ void fox_negcum(const float*logf,__attribute__((address_space(3))) float*ncum,__attribute__((address_space(3))) float*wtot,int tid){
  float loc[16];float s=0.f; const f32x4_t*lp=(const f32x4_t*)(logf+tid*16);
  #pragma unroll
  for(int j=0;j<4;++j){const f32x4_t v=lp[j]; s+=v[0];loc[4*j]=s; s+=v[1];loc[4*j+1]=s; s+=v[2];loc[4*j+2]=s; s+=v[3];loc[4*j+3]=s;}
  float inc=s;
  #pragma unroll
  for(int o=1;o<64;o<<=1){const float v=__shfl_up(inc,o); if((tid&63)>=o)inc+=v;}
  if((tid&63)==63)wtot[tid>>6]=inc;
  __syncthreads();
  float base=inc-s; for(int w=0;w<(tid>>6);++w)base+=wtot[w];
  #pragma unroll
  for(int j=0;j<4;++j){ f32x4_t o4; o4[0]=-(base+loc[4*j]);o4[1]=-(base+loc[4*j+1]);o4[2]=-(base+loc[4*j+2]);o4[3]=-(base+loc[4*j+3]); *(__attribute__((address_space(3))) f32x4_t*)(ncum+tid*16+4*j)=o4; }
  __syncthreads();
}
#ifndef ATTN_STORE16
#define ATTN_STORE16(p,v) (*(u32x4*)(p)=(v))
#endif
template<int THRL> __device__ __forceinline__ void attn_unit(int b,int h,int qb,const bf16*Q,const bf16*__restrict__ K,const bf16*__restrict__ V,bf16*O,char*shm,const float*logf_bh,const unsigned*kn_bh,unsigned char*O8=nullptr){
  int tid_=threadIdx.x; asm volatile("":"+v"(tid_)); const int tid=tid_,lane=tid&63,r32=lane&31,hi=lane>>5; const int wid=__builtin_amdgcn_readfirstlane(tid>>6);
  const long rowbase=(long)b*SEQ; const int q0=qb*QB;
  const bf16*Qw=Q+(rowbase+q0+wid*QBLK)*DM+h*D;
  const bf16*Kh=K+rowbase*DM+h*D,*Vh=V+rowbase*DM+h*D;
  const unsigned lds0=(unsigned)(uintptr_t)shm;
  float*wsf=(float*)(shm+LDS_WS)+wid*64;
  const bf16*ksrc=Kh+(long)lane*DM+wid*8;
  const bf16*vsrc=Vh+(long)(16*(wid&3)+(lane>>2))*DM+(wid>>2)*32+(lane&3)*8;
  const unsigned kdst=lds0+LDS_K+wid*1024, vdst=lds0+LDS_V+wid*1024;
  #define TIDX(t) (NTR-1-(t))
  #define DMA_K(t,slot) glds16(ksrc+(long)TIDX(t)*KVBLK*DM,(unsigned)__builtin_amdgcn_readfirstlane(kdst+(slot)))
  #define DMA_V(t,slot) glds16(vsrc+(long)TIDX(t)*KVBLK*DM,(unsigned)__builtin_amdgcn_readfirstlane(vdst+(slot)))
  const int vb0=(int)(lds0+LDS_V)+((lane>>4)&1)*32+(lane&3)*8+(4*hi+((lane&15)>>2))*64;
  const char*Kbase=shm+LDS_K; bf16x8 kf[8];
  const lds_cptr shm3=(lds_cptr)shm; const lds_cptr kp0=shm3+LDS_K+hi*1024+r32*16; const lds_cptr vp0=shm3+LDS_V+((lane>>4)&1)*32+(lane&3)*8+(4*hi+((lane&15)>>2))*64;
  const int NTR=(q0+QB)/KVBLK;
  const lds_cptr shm3b=(lds_cptr)shm;
  const __attribute__((address_space(3))) float* nb3=(const __attribute__((address_space(3))) float*)(shm3b+LDS_NB);
  fox_negcum(logf_bh,(__attribute__((address_space(3))) float*)(shm3b+LDS_NB),(__attribute__((address_space(3))) float*)(shm3b+LDS_NB+32768),tid);
  int NT;
  { __attribute__((address_space(3))) float* PK=(__attribute__((address_space(3))) float*)(shm3b+LDS_PK);
    __attribute__((address_space(3))) int* JX=(__attribute__((address_space(3))) int*)(shm3b+LDS_PK+512);
    float pk=0.f;
    if(tid<128){ const float a=__uint_as_float(kn_bh[2*tid]),c=__uint_as_float(kn_bh[2*tid+1]); pk=__builtin_sqrtf(a+c)*1.001f; }
    #pragma unroll
    for(int o_=1;o_<64;o_<<=1){const float v=__shfl_up(pk,o_); if((tid&63)>=o_)pk=__builtin_fmaxf(pk,v);}
    if(tid==63)PK[128]=pk;
    __syncthreads();
    if(tid>=64&&tid<128)pk=__builtin_fmaxf(pk,PK[128]);
    if(tid<128)PK[tid]=pk;
    const bf16*Krow=Kh+(long)(q0+wid*QBLK+r32)*DM+hi*8; const bf16*Qrow=Qw+(long)r32*DM+hi*8; float qq=0.f,qk=0.f;
    #pragma unroll
    for(int d0=0;d0<4;++d0){ const u32x4 qa=*reinterpret_cast<const u32x4*>(Qrow+d0*16), ka=*reinterpret_cast<const u32x4*>(Krow+d0*16);
      #pragma unroll
      for(int e=0;e<4;++e){ const float q0f=__uint_as_float(qa[e]<<16),q1f=__uint_as_float(qa[e]&0xffff0000u),k0f=__uint_as_float(ka[e]<<16),k1f=__uint_as_float(ka[e]&0xffff0000u);
        qq+=q0f*q0f+q1f*q1f; qk+=q0f*k0f+q1f*k1f; } }
    { auto r1=__builtin_amdgcn_permlane32_swap(__float_as_uint(qq),__float_as_uint(qq),false,false); qq=__uint_as_float(r1[0])+__uint_as_float(r1[1]);
      auto r2=__builtin_amdgcn_permlane32_swap(__float_as_uint(qk),__float_as_uint(qk),false,false); qk=__uint_as_float(r2[0])+__uint_as_float(r2[1]); }
    __syncthreads();
    const float qn=__builtin_sqrtf(qq)*1.001f, thr=qk+nb3[q0+wid*QBLK+r32]-152.f;
    int lo_=0,hi_=NTR;
    #pragma unroll 1
    for(int it=0;it<8;++it){ if(lo_<hi_){ const int mid=(lo_+hi_)>>1; const float f=qn*PK[mid]+nb3[64*mid+63]; if(f>=thr)hi_=mid; else lo_=mid+1; } }
    #pragma unroll
    for(int o_=1;o_<64;o_<<=1){const int v=__shfl_xor(lo_,o_); lo_=v<lo_?v:lo_;}
    if(lane==0)JX[wid]=lo_;
    __syncthreads();
    int j0=JX[0];
    #pragma unroll
    for(int w=1;w<8;++w){const int v=JX[w]; j0=v<j0?v:j0;}
    j0=__builtin_amdgcn_readfirstlane(j0);
    int nte=(NTR-j0+1)&~1; NT=nte<4?4:nte;
    __syncthreads();
  }
  { __attribute__((address_space(3))) float* nbw=(__attribute__((address_space(3))) float*)(shm3b+LDS_NB);
    const float ref_=nbw[q0+QB-1];
    __syncthreads();
    #pragma unroll
    for(int j=0;j<16;++j){ const float v=nbw[tid*16+j]-ref_; const unsigned h_=cvtpk_s(v,0.f)&0xffffu; const float hf_=__uint_as_float(h_<<16); const unsigned l_=cvtpk_s(v-hf_,0.f)&0xffffu;
      ((__attribute__((address_space(3))) unsigned*)nbw)[tid*16+j]=h_|(l_<<16); }
    __syncthreads();
  }
  const __attribute__((address_space(3))) unsigned* nbp=(const __attribute__((address_space(3))) unsigned*)(shm3b+LDS_NB);
  const unsigned mh0=(hi==0)?0xffffffffu:0u, onesm=0x3f803f80u&mh0;
  u32x4 qxw={onesm,0u,0u,0u};
  #define QX_SET() do{ const float nm_=-mhat; const unsigned h_=cvtpk_s(nm_,0.f)&0xffffu; const unsigned l_=cvtpk_s(nm_-__uint_as_float(h_<<16),0.f)&0xffffu; qxw[1]=(h_|(l_<<16))&mh0; }while(0)
  #define KXF(pr) __builtin_bit_cast(bf16x8,(u32x4){(pr)&mh0,onesm,0u,0u})
  #define BIASMMA(C0,C1,t) do{ const unsigned pr0_=nbp[64*TIDX(t)+r32],pr1_=nbp[64*TIDX(t)+32+r32]; \
    C0=__builtin_amdgcn_mfma_f32_32x32x16_bf16(KXF(pr0_),__builtin_bit_cast(bf16x8,qxw),C0,0,0,0); C1=__builtin_amdgcn_mfma_f32_32x32x16_bf16(KXF(pr1_),__builtin_bit_cast(bf16x8,qxw),C1,0,0,0); }while(0)
  DMA_K(0,0);DMA_V(0,0);DMA_K(1,SLOTB);
  bf16x8 qr[4];
  #pragma unroll
  for(int d0=0;d0<4;++d0)qr[d0]=*reinterpret_cast<const bf16x8*>(&Qw[(long)r32*DM+d0*16+hi*8]);
  float mhat=0.f,l_reg=0.f;f32x16 o[2];o[0]=f32x16{};o[1]=f32x16{};const f32x16 negm=f32x16{};
  const int qrel=wid*QBLK+r32;
  #define CMASK(P0,P1,t) do{ if((t)<4){ cmask(P0,P1,3-(t),qrel,hi); } }while(0)
  bool resc=false;
  #define START(P0,P1) do{ const float rm=rowmax(P0,P1); resc=false; \
    { const float dl=(rm>-3.0e38f)?__builtin_ceilf(rm*16.f)*0.0625f:0.f; mhat=fadd_s(mhat,dl);     \
      _Pragma("unroll") for(int r=0;r<16;++r){P0[r]=fsub_s(P0[r],dl);P1[r]=fsub_s(P1[r],dl);} \
      QX_SET(); } \
    _Pragma("unroll") for(int r=0;r<16;++r)P0[r]=__builtin_amdgcn_exp2f(P0[r]); }while(0)
  #define RESC() do{ if(resc){ asm volatile("s_waitcnt lgkmcnt(0)":::"memory"); \
      _Pragma("unroll") for(int d_=0;d_<2;++d_) _Pragma("unroll") for(int r=0;r<16;++r)o[d_][r]*=wsf[crow(r,hi)]; } }while(0)
  f32x16 pA0,pA1,pB0,pB1;
  int sl_prev=0,sl_cur=0,sl_next=SLOTB;
  #define ROT() do{sl_prev=sl_cur;sl_cur=sl_next;sl_next=(sl_next==(NSLOT-1)*SLOTB)?0:sl_next+SLOTB;}while(0)
  DMA_K(2,2*SLOTB);
  WAIT_BAR(3);
  qkt(pA0,pA1,Kbase,qr,negm,r32,hi);BIASMMA(pA0,pA1,0);asm volatile("s_nop 15\n\ts_nop 7":"+v"(pA0),"+v"(pA1));CMASK(pA0,pA1,0);
  START(pA0,pA1);
  _Pragma("unroll") for(int r=0;r<16;++r)pA1[r]=__builtin_amdgcn_exp2f(pA1[r]);
  WAIT_BAR(0);
  DMA_K(3,0);DMA_V(1,SLOTB);
  ROT();
  kload8(kf,kp0+sl_cur);
  WAIT_BAR(2);
  s16x4 vlo[8],vhi[8]; u32x4 pw0,pw1,pw2,pw3;
  #define PKW(P,B) cvtpk_s(P[B],P[B+1])
  #define PAF(k) __builtin_bit_cast(bf16x8,pw##k)
  #define VFR(i) (bf16x8){vlo[i][0],vlo[i][1],vlo[i][2],vlo[i][3],vhi[i][0],vhi[i][1],vhi[i][2],vhi[i][3]}
  #define PIN(x) asm volatile("":"+v"(x))
  #define MX3(a,b,c) __builtin_fmaxf(__builtin_fmaxf((a),(b)),(c))
  #define GAPA(MF,A0,A1,A2,A3,W0,W1,PW) do{ MF; sacc+=A0; sacc+=A1; sacc+=A2; sacc+=A3; PIN(sacc); W0; W1; PIN(PW); SBAR(); }while(0)
  #define EX(v) __builtin_amdgcn_exp2f(v)
  #define GAPB(MF,X,B) do{ MF; X[B]=EX(X[B]); X[B+1]=EX(X[B+1]); X[B+2]=EX(X[B+2]); X[B+3]=EX(X[B+3]); PIN(X); SBAR(); }while(0)
  #define VRD(i) do{ vlo[i]=vtr(vp_+(((i)>>2)*4096+((i)&3)*1024)); vhi[i]=vtr(vp_+(((i)>>2)*4096+((i)&3)*1024+512)); }while(0)
  #define KRD(G,j) do{ if(G){ kload2(kf,kp0+sl_next,j); SBAR(); } }while(0)
  #define STEP(C0,C1,P0,P1,t,GK,GV,GL) do{ SBAR(); \
    const lds_cptr vp_=vp0+sl_prev; \
    VRD(0); SBAR(); float sacc=(P0[0]+P0[1]); \
    GAPA(C0=__builtin_amdgcn_mfma_f32_32x32x16_bf16(kf[0],qr[0],negm,0,0,0), P0[2],P0[3],P0[4],P0[5],     pw0[0]=PKW(P0,0), pw0[1]=PKW(P0,2), pw0); \
    VRD(4); SBAR(); GAPA(C1=__builtin_amdgcn_mfma_f32_32x32x16_bf16(kf[1],qr[0],negm,0,0,0), P0[6],P0[7],P0[8],P0[9],     pw0[2]=PKW(P0,4), pw0[3]=PKW(P0,6), pw0); \
    VRD(1); SBAR(); GAPA(C0=__builtin_amdgcn_mfma_f32_32x32x16_bf16(kf[2],qr[1],C0,0,0,0),   P0[10],P0[11],P0[12],P0[13], pw1[0]=PKW(P0,8), pw1[1]=PKW(P0,10), pw1); \
    VRD(5); SBAR(); GAPA(C1=__builtin_amdgcn_mfma_f32_32x32x16_bf16(kf[3],qr[1],C1,0,0,0),   P0[14],P0[15],P1[0],P1[1],   pw1[2]=PKW(P0,12),pw1[3]=PKW(P0,14), pw1); \
    VRD(2); SBAR(); GAPA(C0=__builtin_amdgcn_mfma_f32_32x32x16_bf16(kf[4],qr[2],C0,0,0,0),   P1[2],P1[3],P1[4],P1[5],     pw2[0]=PKW(P1,0), pw2[1]=PKW(P1,2), pw2); \
    VRD(6); SBAR(); GAPA(C1=__builtin_amdgcn_mfma_f32_32x32x16_bf16(kf[5],qr[2],C1,0,0,0),   P1[6],P1[7],P1[8],P1[9],     pw2[2]=PKW(P1,4), pw2[3]=PKW(P1,6), pw2); \
    VRD(3); SBAR(); GAPA(C0=__builtin_amdgcn_mfma_f32_32x32x16_bf16(kf[6],qr[3],C0,0,0,0),   P1[10],P1[11],P1[12],P1[13], pw3[0]=PKW(P1,8), pw3[1]=PKW(P1,10), pw3); \
    VRD(7); SBAR(); GAPA(C1=__builtin_amdgcn_mfma_f32_32x32x16_bf16(kf[7],qr[3],C1,0,0,0),   P1[14],P1[15],0.f,0.f,       pw3[2]=PKW(P1,12),pw3[3]=PKW(P1,14), pw3); \
    l_reg+=sacc; \
    if(GK){DMA_K((t)+3,sl_cur);} if(GV){DMA_V((t)+1,sl_next);} \
    BIASMMA(C0,C1,t); CMASK(C0,C1,t); \
    { float a=MX3(C0[0],C0[1],C1[0]),b=MX3(C0[2],C0[3],C1[1]); a=MX3(a,C1[2],C1[3]); \
      _Pragma("unroll") for(int r=4;r<16;r+=4){a=MX3(a,C0[r],C0[r+1]);b=MX3(b,C0[r+2],C0[r+3]);a=MX3(a,C1[r],C1[r+1]);b=MX3(b,C1[r+2],C1[r+3]);} \
      float rm=__builtin_fmaxf(a,b); { auto rr=__builtin_amdgcn_permlane32_swap(__float_as_uint(rm),__float_as_uint(rm),false,false); rm=__builtin_fmaxf(__uint_as_float(rr[0]),__uint_as_float(rr[1])); } \
      resc=false; \
      if(__builtin_expect(__any(rm>(float)THRL),0)){ const float dl=__builtin_fmaxf(__builtin_ceilf(rm*16.f)*0.0625f,0.f); mhat+=dl; QX_SET(); \
        _Pragma("unroll") for(int r=0;r<16;++r){C0[r]-=dl;C1[r]-=dl;} \
        const float f=__builtin_amdgcn_exp2f(-dl); l_reg*=f; if(hi==0)wsf[r32]=f; resc=true; } } \
    SBAR(); \
    GAPB(o[0]=__builtin_amdgcn_mfma_f32_32x32x16_bf16(PAF(0),VFR(0),o[0],0,0,0), C0,0); \
    GAPB(o[1]=__builtin_amdgcn_mfma_f32_32x32x16_bf16(PAF(0),VFR(4),o[1],0,0,0), C0,4); \
    KRD(GL,0); GAPB(o[0]=__builtin_amdgcn_mfma_f32_32x32x16_bf16(PAF(1),VFR(1),o[0],0,0,0), C0,8); \
    KRD(GL,1); GAPB(o[1]=__builtin_amdgcn_mfma_f32_32x32x16_bf16(PAF(1),VFR(5),o[1],0,0,0), C0,12); \
    KRD(GL,2); GAPB(o[0]=__builtin_amdgcn_mfma_f32_32x32x16_bf16(PAF(2),VFR(2),o[0],0,0,0), C1,0); \
    KRD(GL,3); GAPB(o[1]=__builtin_amdgcn_mfma_f32_32x32x16_bf16(PAF(2),VFR(6),o[1],0,0,0), C1,4); \
    GAPB(o[0]=__builtin_amdgcn_mfma_f32_32x32x16_bf16(PAF(3),VFR(3),o[0],0,0,0), C1,8); \
    GAPB(o[1]=__builtin_amdgcn_mfma_f32_32x32x16_bf16(PAF(3),VFR(7),o[1],0,0,0), C1,12); \
    }while(0)
  int t=1;
  for(int it_=0;it_<2&&t+5<NT;++it_,t+=2){
    STEP(pB0,pB1,pA0,pA1,t,true,true,true);     WAIT_BAR(2); RESC(); ROT();
    STEP(pA0,pA1,pB0,pB1,t+1,true,true,true);   WAIT_BAR(2); RESC(); ROT();
  }
  #undef CMASK
  #define CMASK(P0,P1,t) do{}while(0)
  for(;t+5<NT;t+=2){
    STEP(pB0,pB1,pA0,pA1,t,true,true,true);     WAIT_BAR(2); RESC(); ROT();
    STEP(pA0,pA1,pB0,pB1,t+1,true,true,true);   WAIT_BAR(2); RESC(); ROT();
  }
  #undef CMASK
  #define CMASK(P0,P1,t) do{ if((t)<4){ cmask(P0,P1,3-(t),qrel,hi); } }while(0)
  #define ENDW(tt) do{ if((tt)+3<NT){WAIT_BAR(2);} else if((tt)+2<NT){WAIT_BAR(1);} else {WAIT_BAR(0);} }while(0)
  for(;t+1<NT;t+=2){
    STEP(pB0,pB1,pA0,pA1,t,(t+3<NT),(t+1<NT),(t+1<NT));       ENDW(t);   RESC(); ROT();
    STEP(pA0,pA1,pB0,pB1,t+1,(t+4<NT),(t+2<NT),(t+2<NT));     ENDW(t+1); RESC(); ROT();
  }
  STEP(pB0,pB1,pA0,pA1,NT-1,false,false,false); RESC();
  { float sacc=pB0[0]+pB0[1]; _Pragma("unroll") for(int r=2;r<16;++r)sacc+=pB0[r]; _Pragma("unroll") for(int r=0;r<16;++r)sacc+=pB1[r]; l_reg+=sacc;
    pw0=(u32x4){PKW(pB0,0),PKW(pB0,2),PKW(pB0,4),PKW(pB0,6)};pw1=(u32x4){PKW(pB0,8),PKW(pB0,10),PKW(pB0,12),PKW(pB0,14)};pw2=(u32x4){PKW(pB1,0),PKW(pB1,2),PKW(pB1,4),PKW(pB1,6)};pw3=(u32x4){PKW(pB1,8),PKW(pB1,10),PKW(pB1,12),PKW(pB1,14)};
    SBAR(); pv(o,vb0+sl_cur,PAF(0),PAF(1),PAF(2),PAF(3)); }
  #undef PKW
  #undef PAF
  #undef VFR
  #undef PIN
  #undef MX3
  #undef GAPA
  #undef GAPB
  #undef EX
  #undef VRD
  #undef KRD
  #undef STEP
  #undef ENDW
  {auto rr=__builtin_amdgcn_permlane32_swap(__float_as_uint(l_reg),__float_as_uint(l_reg),false,false);l_reg=__uint_as_float(rr[0])+__uint_as_float(rr[1]);}
  if(hi==0)wsf[32+r32]=l_reg;asm volatile("s_waitcnt lgkmcnt(0)":::"memory");
  float rli[16];
  #pragma unroll
  for(int r=0;r<16;++r)rli[r]=__builtin_amdgcn_rcpf(wsf[32+crow(r,hi)]);
  if(O8){ unsigned char*stg8=(unsigned char*)(shm+LDS_OST)+wid*4096;
    #pragma unroll
    for(int r=0;r<16;++r){const int orow=crow(r,hi);
      #pragma unroll
      for(int d0=0;d0<2;++d0)stg8[orow*64+d0*32+r32]=(unsigned char)(__builtin_amdgcn_cvt_pk_fp8_f32(o[d0][r]*rli[r],0.f,0,false)&0xff);}
    asm volatile("s_waitcnt lgkmcnt(0)":::"memory");
    unsigned char*Ow8=O8+(rowbase+q0+wid*QBLK)*1024+h*D;
    #pragma unroll
    for(int i=0;i<2;++i){const int row=i*16+(lane>>2),ch=lane&3; const u32x4 v=*(const u32x4*)(stg8+row*64+ch*16); ATTN_STORE16(Ow8+(long)row*1024+ch*16,v);} }
  else{
  bf16*Ow=O+(rowbase+q0+wid*QBLK)*DM+h*D;
  { bf16*stg=(bf16*)(shm+LDS_OST)+wid*2048;
    #pragma unroll
    for(int r=0;r<16;++r){const int orow=crow(r,hi);
      #pragma unroll
      for(int d0=0;d0<2;++d0)stg[orow*64+d0*32+r32]=__float2bfloat16(o[d0][r]*rli[r]);}
    asm volatile("s_waitcnt lgkmcnt(0)":::"memory");
    #pragma unroll
    for(int i=0;i<4;++i){const int row=i*8+(lane>>3),ch=lane&7; const u32x4 v=*(const u32x4*)(stg+row*64+ch*8); ATTN_STORE16(Ow+(long)row*DM+ch*8,v);} } }
  asm volatile("s_waitcnt lgkmcnt(0)\n\ts_barrier":::"memory");
  #undef BIASMMA
  #undef KXF
  #undef QX_SET
  #undef TIDX
  #undef DMA_K
  #undef DMA_V
  #undef CMASK
  #undef START
  #undef RESC
  #undef ROT
}

template<int PITCH> __device__ __forceinline__ void sb_unit(int b,int h,int qb,const bf16*Q,const bf16*__restrict__ K,const bf16*__restrict__ V,bf16*O  ,char*shm){
  int tid_=threadIdx.x; asm volatile("":"+v"(tid_)); const int tid=tid_,lane=tid&63,r32=lane&31,hi=lane>>5; const int wid=__builtin_amdgcn_readfirstlane(tid>>6);
  const long rowbase=(long)b*SEQ; const int q0=qb*QB;
  const bf16*Qw=Q+(rowbase+q0+wid*QBLK)*PITCH+h*D;
  const bf16*Kh=K+rowbase*PITCH+h*D,*Vh=V+rowbase*PITCH+h*D;
  const unsigned lds0=(unsigned)(uintptr_t)shm;
  const bf16*ksrc=Kh+(long)lane*PITCH+wid*8;
  const bf16*vsrc=Vh+(long)(16*(wid&3)+(lane>>2))*PITCH+(wid>>2)*32+(lane&3)*8;
  const unsigned kdst=lds0+LDS_K+wid*1024, vdst=lds0+LDS_V+wid*1024;
  #define SB_DMA(t,slot) do{ glds16(ksrc+(long)(t)*KVBLK*PITCH,(unsigned)__builtin_amdgcn_readfirstlane(kdst+(slot))); glds16(vsrc+(long)(t)*KVBLK*PITCH,(unsigned)__builtin_amdgcn_readfirstlane(vdst+(slot))); }while(0)
  const int vb0=(int)(lds0+LDS_V)+((lane>>4)&1)*32+(lane&3)*8+(4*hi+((lane&15)>>2))*64;
  volatile __attribute__((address_space(3))) unsigned* fl=(volatile __attribute__((address_space(3))) unsigned*)((lds_cptr)shm+LDS_WS);
  const int NT=(q0+QB)/KVBLK; const int qrel=wid*QBLK+r32;
  SB_DMA(NT-1,0);
  bf16x8 qr[4];
  #pragma unroll
  for(int d0=0;d0<4;++d0)qr[d0]=*reinterpret_cast<const bf16x8*>(&Qw[(long)r32*PITCH+d0*16+hi*8]);
  f32x16 o[2];o[0]=f32x16{};o[1]=f32x16{}; const f32x16 zero16=f32x16{};
  float carry=1.f;
  int slot=0;
  #define SB_TILE(BAND) do{ \
    if(!(BAND&&64*(t-(NT-4))>wid*QBLK+QBLK-1)){ \
    f32x16 p0,p1; qkt(p0,p1,shm+LDS_K+slot,qr,zero16,r32,hi); \
    if(BAND){ const int kb=64*(t-(NT-4))+4*hi;                 \
      _Pragma("unroll") for(int r=0;r<16;++r){const int kv=kb+(r&3)+8*(r>>2); if(kv>=qrel)p0[r]=-INFINITY; if(kv+32>=qrel)p1[r]=-INFINITY;} } \
      \
      \
    f32x16 s0,s1;                                                \
    _Pragma("unroll") for(int r=0;r<16;++r){ const float z=p0[r]; const float e=__builtin_amdgcn_exp2f(-__builtin_fmaxf(z,-100.f)); const float rb=__builtin_amdgcn_rcpf(1.f+e); const float y=p1[r]; const float f=__builtin_amdgcn_exp2f(-__builtin_fmaxf(y,-100.f)); const float rc=__builtin_amdgcn_rcpf(1.f+f); \
      if(BAND){ const bool mk=z<-1.0e30f; p0[r]=mk?0.f:rb; s0[r]=mk?1.f:e*rb; const bool mj=y<-1.0e30f; p1[r]=mj?0.f:rc; s1[r]=mj?1.f:f*rc; } \
      else { p0[r]=rb; s0[r]=e*rb; p1[r]=rc; s1[r]=f*rc; } } \
    float lo[8],hv[8];                                          \
    _Pragma("unroll") for(int i=0;i<8;++i){ const float mine=(i<4)?((s0[4*i]*s0[4*i+1])*(s0[4*i+2]*s0[4*i+3])):((s1[4*i-16]*s1[4*i-15])*(s1[4*i-14]*s1[4*i-13])); \
      auto rr=__builtin_amdgcn_permlane32_swap(__float_as_uint(mine),__float_as_uint(mine),false,false); lo[i]=__uint_as_float(rr[0]); hv[i]=__uint_as_float(rr[1]); } \
    float sp_=carry;                                             \
    _Pragma("unroll") for(int i=7;i>=0;--i){ float a=sp_*((hi==0)?hv[i]:1.f);       \
      if(i<4){ p0[4*i+3]*=a; a*=s0[4*i+3]; p0[4*i+2]*=a; a*=s0[4*i+2]; p0[4*i+1]*=a; a*=s0[4*i+1]; p0[4*i]*=a; } \
      else   { const int j=4*i-16; p1[j+3]*=a; a*=s1[j+3]; p1[j+2]*=a; a*=s1[j+2]; p1[j+1]*=a; a*=s1[j+1]; p1[j]*=a; } \
      sp_*=lo[i]*hv[i]; } \
    carry=sp_; \
    { u32x4 pw0,pw1,pw2,pw3; \
      pw0=(u32x4){cvtpk_s(p0[0],p0[1]),cvtpk_s(p0[2],p0[3]),cvtpk_s(p0[4],p0[5]),cvtpk_s(p0[6],p0[7])}; pw1=(u32x4){cvtpk_s(p0[8],p0[9]),cvtpk_s(p0[10],p0[11]),cvtpk_s(p0[12],p0[13]),cvtpk_s(p0[14],p0[15])}; \
      pw2=(u32x4){cvtpk_s(p1[0],p1[1]),cvtpk_s(p1[2],p1[3]),cvtpk_s(p1[4],p1[5]),cvtpk_s(p1[6],p1[7])}; pw3=(u32x4){cvtpk_s(p1[8],p1[9]),cvtpk_s(p1[10],p1[11]),cvtpk_s(p1[12],p1[13]),cvtpk_s(p1[14],p1[15])}; \
      pv(o,vb0+slot,__builtin_bit_cast(bf16x8,pw0),__builtin_bit_cast(bf16x8,pw1),__builtin_bit_cast(bf16x8,pw2),__builtin_bit_cast(bf16x8,pw3)); } \
    } \
    { const bool done_=__all(carry==0.f); if(lane==0)fl[(t&1)*8+wid]=done_?1u:0u; } \
    slot^=SLOTB; }while(0)
  #define SB_HEAD() { WAIT_BAR(0); \
    if(t<NT-1){ const int pb=((t+1)&1)*8; const unsigned a=fl[pb]&fl[pb+1]&fl[pb+2]&fl[pb+3]&fl[pb+4]&fl[pb+5]&fl[pb+6]&fl[pb+7]; if(__builtin_amdgcn_readfirstlane(a)!=0u)break; } \
    if(t>0)SB_DMA(t-1,slot^SLOTB); }
  int t=NT-1; bool live=true;
  for(;t>=NT-4;--t){ live=false; SB_HEAD(); SB_TILE(true); live=true; }
  if(live){ for(;t>=0;--t){ SB_HEAD(); SB_TILE(false); } }
  #undef SB_TILE
  #undef SB_HEAD
  asm volatile("s_waitcnt vmcnt(0) lgkmcnt(0)":::"memory");
  bf16*Ow=O+(rowbase+q0+wid*QBLK)*1024+h*D;
  { bf16*stg=(bf16*)(shm+LDS_OST)+wid*2048;
    #pragma unroll
    for(int r=0;r<16;++r){const int orow=crow(r,hi);
      #pragma unroll
      for(int d0=0;d0<2;++d0)stg[orow*64+d0*32+r32]=__float2bfloat16(o[d0][r]);}
    asm volatile("s_waitcnt lgkmcnt(0)":::"memory");
    #pragma unroll
    for(int i=0;i<4;++i){const int row=i*8+(lane>>3),ch=lane&7; const u32x4 v=*(const u32x4*)(stg+row*64+ch*8); ATTN_STORE16(Ow+(long)row*1024+ch*8,v);} }
  asm volatile("s_waitcnt vmcnt(0) lgkmcnt(0)\n\ts_barrier":::"memory");
  #undef SB_DMA
}
constexpr int ATTN_LDS_BYTES=LDS_BYTES;
struct AttnTensors { const bf16* Q; const bf16* K; const bf16* V; bf16* O; const float* logf;   const unsigned* kn;   };
#undef SBAR
#undef WAIT_BAR
}
constexpr int NWAVES = 8, NTHREADS = NWAVES * 64;
constexpr int BATCH = 2, SEQ = 8192, D = 1024, M = BATCH * SEQ;
constexpr int S5G = 32, S5H = 16, S5P = 64, S5T = 32  , S5NC = M / S5T  , S5KX = 640  ;
constexpr int SBH = 8, FOXH = 16, HD = 64;
constexpr int EVEN_IN = 2048, ODD_IN = 3088, DFF = 2816, NEXP = 8, DFE = 3584;
constexpr float C2 = 0.125f * 1.4426950408889634f;
constexpr int MOE_MAX_PANELS = 136, MOE_MAX_SLOTS = MOE_MAX_PANELS * 256, MOE_CAP = 16384  ;

constexpr size_t MiB = 1u << 20;
constexpr size_t WS_CTL = 0, CTL_ZERO_BYTES = 1 * MiB;
constexpr size_t WS_WMOE_GU = 1 * MiB;
constexpr size_t WS_WMOE_D = 57 * MiB;
constexpr size_t WS_WIN0 = 85 * MiB;
constexpr size_t WS_WGLU = 89 * MiB;
constexpr size_t WS_WOUT0 = 90 * MiB;
constexpr size_t WS_WGU0 = 92 * MiB;
constexpr size_t WS_WD0 = 103 * MiB;
constexpr size_t WS_WIN1 = 109 * MiB;
constexpr size_t WS_WF1 = 115 * MiB;
constexpr size_t WS_WOUT1 = 116 * MiB;
constexpr size_t WS_S5WA = 118 * MiB;
constexpr size_t WS_S5WC = 126 * MiB;
constexpr size_t WS_XB = 146 * MiB;
constexpr size_t WS_SSP = 178 * MiB;
constexpr size_t WS_META = 182 * MiB;
constexpr size_t WS_LOGF = 183 * MiB;
constexpr size_t WS_QKV0 = 184 * MiB;
constexpr size_t WS_UEXT = 232 * MiB;
constexpr size_t WS_SLOC = 252 * MiB;
constexpr size_t WS_YG = 260 * MiB;
constexpr size_t WS_MIXB = 276 * MiB;
constexpr size_t WS_HID0 = 184 * MiB;
constexpr size_t WS_QKV1 = 184 * MiB;
constexpr size_t WS_XG = 184 * MiB;
constexpr size_t WS_HMOE = 312 * MiB;
constexpr size_t WS_Y = 85 * MiB;
constexpr size_t WS_END = 432 * MiB;
static_assert(WS_XG + (size_t)8 * MOE_CAP * 1024 <= WS_HMOE && WS_HMOE + (size_t)MOE_MAX_SLOTS * DFE <= WS_END && WS_Y + (size_t)MOE_MAX_SLOTS * 1024 * 2 <= WS_XB + 32 * MiB && WS_MIXB + 32 * MiB <= WS_END, "ws map");
constexpr size_t MT_RSTD = 0, MT_TOKE = 65536, MT_TOKP = 131072, MT_TOKG = 262144, MT_RSS = 524288;
constexpr int CW_TMO = 0, CW_CODE = 1, CW_BAR = 4096, CW_CNT = 8192  , CW_QUEUE = 12288  , CW_QUEUE2 = 12352  , CW_KN = 16384  ;
constexpr int CW_SUBBAR = 32768;

constexpr int RING_OFF = 0, RING_BYTES = 131072;
constexpr int LDSCTL_OFF = 133120  , MISC_OFF = LDSCTL_OFF + 320;
constexpr int LDS_BYTES = 147456;

#define GAS __attribute__((address_space(1)))
#define LAS __attribute__((address_space(3)))
typedef unsigned short bf16;
typedef unsigned v4u __attribute__((ext_vector_type(4)));
typedef unsigned v2u __attribute__((ext_vector_type(2)));
typedef float f32x4 __attribute__((ext_vector_type(4)));
typedef short bf16x8 __attribute__((ext_vector_type(8)));
typedef GAS unsigned gu32;
#define RLX_AGENT __ATOMIC_RELAXED, __HIP_MEMORY_SCOPE_AGENT
#define LDS_WAIT() asm volatile("s_waitcnt lgkmcnt(0)" ::: "memory")
#define VM_WAIT() asm volatile("s_waitcnt vmcnt(0)" ::: "memory")
__device__ __forceinline__ unsigned f2bf(float f) { unsigned u = __builtin_bit_cast(unsigned, f); return (u + 0x7fffu + ((u >> 16) & 1u)) >> 16; }
__device__ __forceinline__ unsigned pk2(float lo, float hi) { return f2bf(lo) | (f2bf(hi) << 16); }
__device__ __forceinline__ float bflo(unsigned w) { return __uint_as_float(w << 16); }
__device__ __forceinline__ float bfhi(unsigned w) { return __uint_as_float(w & 0xffff0000u); }

#define XB_TMO      128
#define XB_XCNT(j)  (256  + 64 * (j))
#define XB_XSUB(j)  (1280 + 64 * (j))
#define XB_XGEN(j)  (2304 + 64 * (j))
#define XB_TOP      3328
#define XB_TOPGEN   3392
#define XCD_BAR_WORDS 3456
#define XB_SPIN_CAP (1u << 18)
__device__ __forceinline__ unsigned xb_ld(unsigned* p)              { return __hip_atomic_load(p, __ATOMIC_RELAXED, __HIP_MEMORY_SCOPE_AGENT); }
__device__ __forceinline__ unsigned xb_add(unsigned* p, unsigned v) { return __hip_atomic_fetch_add(p, v, __ATOMIC_RELAXED, __HIP_MEMORY_SCOPE_AGENT); }
__device__ __forceinline__ unsigned xb_xcc_id() { return (unsigned)__builtin_amdgcn_s_getreg((3 << 11) | 20) & 0xFu; }
#define XB_SPIN(cond, bar) do { unsigned _sp = 0; while (cond) { __builtin_amdgcn_s_sleep(1); \
    if ((++_sp & 255u) == 0u) { if (xb_ld(&(bar)[XB_TMO])) break; if (_sp > XB_SPIN_CAP) { atomicAdd(&(bar)[XB_TMO], 1u); break; } } } } while (0)
struct XcdBarrier { unsigned* bar; unsigned x; volatile LAS unsigned* st; unsigned total; };
__device__ __forceinline__ XcdBarrier xcd_barrier_post(unsigned* bar, volatile LAS unsigned* st, unsigned total) {
    XcdBarrier b; b.bar = bar; b.x = xb_xcc_id(); b.st = st; b.total = total;
    if (threadIdx.x == 0) (void)xb_add(&bar[XB_XCNT(b.x)], 1u);
    return b;
}
__device__ __forceinline__ void xcd_barrier_complete(unsigned* bar, unsigned x, unsigned G, unsigned& nloc, unsigned& nx) {
    unsigned sum, cnt, mine, sp = 0u;
    for (;;) {
        sum = 0u; cnt = 0u; mine = 0u;
#pragma unroll
        for (unsigned j = 0; j < 16; ++j) { const unsigned c = xb_ld(&bar[XB_XCNT(j)]); sum += c; cnt += (c > 0u) ? 1u : 0u; mine = (j == x) ? c : mine; }
        if (sum == G) break;
        __builtin_amdgcn_s_sleep(1);
        if ((++sp & 255u) == 0u) { if (xb_ld(&bar[XB_TMO])) break; if (sp > XB_SPIN_CAP) { atomicAdd(&bar[XB_TMO], 1u); break; } }
    }
    nloc = mine > 0u ? mine : 1u; nx = cnt > 0u ? cnt : 1u;
}
__device__ __forceinline__ void xcd_barrier(const XcdBarrier& b) {
    asm volatile("s_waitcnt vmcnt(0)" ::: "memory");
    __syncthreads();
    if (threadIdx.x == 0) {
        unsigned* bar = b.bar;
        __builtin_amdgcn_s_waitcnt(0);
        unsigned nloc = b.st[0], nx = b.st[1];
        if (nloc == 0u) { xcd_barrier_complete(bar, b.x, b.total, nloc, nx); b.st[0] = nloc; b.st[1] = nx; }
        const unsigned old = xb_add(&bar[XB_XSUB(b.x)], 1u);
        const unsigned gen = old / nloc;
        if (old + 1u == (gen + 1u) * nloc) {
            __builtin_amdgcn_fence(__ATOMIC_RELEASE, "agent");
            asm volatile("s_waitcnt vmcnt(0)" ::: "memory");
            const unsigned og = xb_add(&bar[XB_TOP], 1u);
            const unsigned tg = og / nx;
            if (og + 1u == (tg + 1u) * nx) xb_add(&bar[XB_TOPGEN], 1u);
            else XB_SPIN(xb_ld(&bar[XB_TOPGEN]) == tg, bar);
            __builtin_amdgcn_fence(__ATOMIC_ACQUIRE, "agent");
            xb_add(&bar[XB_XGEN(b.x)], 1u);
            asm volatile("s_waitcnt vmcnt(0)" ::: "memory");
        } else {
            XB_SPIN(xb_ld(&bar[XB_XGEN(b.x)]) == gen, bar);
            __builtin_amdgcn_fence(__ATOMIC_ACQUIRE, "agent");
            asm volatile("s_waitcnt vmcnt(0)" ::: "memory");
        }
    }
    __syncthreads();
}

__device__ __forceinline__ float wave_sum(float v) {
#pragma unroll
    for (int o = 1; o < 64; o <<= 1) v += __shfl_xor(v, o);
    return v;
}
constexpr int XP = 65, XSCR_BYTES = 64 * XP * 4;
__device__ __forceinline__ unsigned cvtpk(float lo, float hi) { unsigned r; asm volatile("v_cvt_pk_bf16_f32 %0, %1, %2" : "=v"(r) : "v"(lo), "v"(hi)); return r; }
__device__ __forceinline__ void p0_transpose_item(const float* W, int ldw, int k0, int n0, const float* gs, bf16* dst, int ldd, LAS float* scr, int lane) {
    const int lr = lane >> 4, lc = (lane & 15) * 4;
    const float* src = W + (size_t)(k0 + lr) * ldw + n0 + lc;
    f32x4 v[16];
#pragma unroll
    for (int i = 0; i < 16; ++i) v[i] = __builtin_nontemporal_load((const GAS f32x4*)(src + (size_t)(4 * i) * ldw));
    if (gs) {
#pragma unroll
        for (int i = 0; i < 16; ++i) v[i] = v[i] * gs[k0 + 4 * i + lr]; }
#pragma unroll
    for (int i = 0; i < 16; ++i) { LAS float* p = scr + (4 * i + lr) * XP + lc; p[0] = v[i][0]; p[1] = v[i][1]; p[2] = v[i][2]; p[3] = v[i][3]; }
    LDS_WAIT(); asm volatile("" ::: "memory");
    const int c = lane & 7, nn = lane >> 3;
#pragma unroll
    for (int j = 0; j < 8; ++j) { const int n = nn + 8 * j; const LAS float* sp = scr + (8 * c) * XP + n;
        v4u o; o.x = cvtpk(sp[0 * XP], sp[1 * XP]); o.y = cvtpk(sp[2 * XP], sp[3 * XP]); o.z = cvtpk(sp[4 * XP], sp[5 * XP]); o.w = cvtpk(sp[6 * XP], sp[7 * XP]);
        __builtin_nontemporal_store(o, (GAS v4u*)(dst + (size_t)n * ldd + k0 + 8 * c)); }
    LDS_WAIT(); asm volatile("" ::: "memory");
}
struct XTile { const float* src; const float* gs; unsigned char* dst; int ldw, ldd, k0; };
__device__ __forceinline__ XTile xtile_fp8(int item, const float* W, int ldw, int N, const float* gs, unsigned char* dst, int ldd, int mode, int lane) {
    const int nblk = N / 64, kb = item / nblk, nb = item % nblk, n0 = 64 * nb, k0 = 64 * kb;
    const int row = mode == 0 ? n0 : ((n0 >> 7) * 256 + (n0 & 127) + (mode == 2 ? 128 : 0));
    XTile t; t.src = W + (size_t)(k0 + (lane >> 4)) * ldw + n0 + (lane & 15) * 4; t.gs = gs; t.dst = dst + (size_t)row * ldd; t.ldw = ldw; t.ldd = ldd; t.k0 = k0; return t;
}
__device__ __forceinline__ void xtile_load(const XTile& t, f32x4 (&v)[16], float (&g)[16], int lane) {
    const int lr = lane >> 4;
    if (t.gs) {
#pragma unroll
        for (int i = 0; i < 16; ++i) g[i] = t.gs[t.k0 + 4 * i + lr];
    } else {
#pragma unroll
        for (int i = 0; i < 16; ++i) g[i] = 1.0f; }
#pragma unroll
    for (int i = 0; i < 16; ++i) v[i] = __builtin_nontemporal_load((const GAS f32x4*)(t.src + (size_t)(4 * i) * t.ldw));
}
__device__ __forceinline__ void xtile_finish_fp8(const XTile& t, f32x4 (&v)[16], const float (&g)[16], float wscale, LAS float* scr, int lane) {
    const int lr = lane >> 4, lc = (lane & 15) * 4;
#pragma unroll
    for (int i = 0; i < 16; ++i) v[i] = v[i] * (g[i] * wscale);
    constexpr int XR = 64;
#pragma unroll
    for (int i = 0; i < 16; ++i) *(LAS f32x4*)(scr + (4 * i + lr) * XR + (i >> 2) * 16 + lc) = v[i];
    LDS_WAIT(); asm volatile("" ::: "memory");
    const int c = lane & 3, nn = lane >> 2;
#pragma unroll
    for (int j = 0; j < 4; ++j) { const int n = nn + 16 * j; const LAS float* sp = scr + (16 * c) * XR + c * 16 + n;
        v4u o; o.x = pg8::pk_fp8x4(sp[0 * XR], sp[1 * XR], sp[2 * XR], sp[3 * XR]); o.y = pg8::pk_fp8x4(sp[4 * XR], sp[5 * XR], sp[6 * XR], sp[7 * XR]);
        o.z = pg8::pk_fp8x4(sp[8 * XR], sp[9 * XR], sp[10 * XR], sp[11 * XR]); o.w = pg8::pk_fp8x4(sp[12 * XR], sp[13 * XR], sp[14 * XR], sp[15 * XR]);
        __builtin_nontemporal_store(o, (GAS v4u*)(t.dst + (size_t)n * t.ldd + t.k0 + 16 * c)); }
    LDS_WAIT(); asm volatile("" ::: "memory");
}
__device__ __forceinline__ void xpose_mat(int item, const float* W, int ldw, int N, const float* gs, bf16* dst, int ldd, int mode, LAS float* scr, int lane) {
    const int nblk = N / 64, kb = item / nblk, nb = item % nblk, n0 = 64 * nb;
    const int row = mode == 0 ? n0 : ((n0 >> 7) * 256 + (n0 & 127) + (mode == 2 ? 128 : 0));
    p0_transpose_item(W, ldw, 64 * kb, n0, gs, dst + (size_t)row * ldd, ldd, scr, lane);
}

struct Args { const float* in[28]; float* out; unsigned char* ws; };

__device__ __forceinline__ void s5_tables(const Args& a, int g, int q, LAS unsigned char* lds, int tid) {
    LAS float* POWr = (LAS float*)lds;
    LAS float* POWi = POWr + 33 * 64;
    LAS float* BBr = POWi + 33 * 64;
    LAS float* BBi = BBr + 1024;
    LAS float* CCr = BBi + 1024;
    LAS float* CCi = CCr + 1024;
    LAS float* KT = CCi + 1024;
    LAS float* DD = KT + 2048;
    const float* a_re = a.in[3]; const float* a_im = a.in[4]; const float* b_re = a.in[5]; const float* b_im = a.in[6];
    const float* c_re = a.in[7]; const float* c_im = a.in[8]; const float* dsk = a.in[9]; const float* log_step = a.in[10];
    const float step = expf(log_step[g]);
    __syncthreads();
    for (int e = tid; e < 33 * 64; e += NTHREADS) { const int n = e >> 6, p = e & 63; const float lr = a_re[g * 64 + p], li = a_im[g * 64 + p];
        const float mag = expf((float)n * step * lr); float sn, cs; sincosf((float)n * (step * li), &sn, &cs); POWr[e] = mag * cs; POWi[e] = mag * sn; }
    for (int e = tid; e < 1024; e += NTHREADS) { const int p = e >> 4, h = e & 15; const float lr = a_re[g * 64 + p], li = a_im[g * 64 + p];
        const float er = expf(lr * step); float sn, cs; sincosf(li * step, &sn, &cs); const float nr = er * cs - 1.f, ni = er * sn, den = lr * lr + li * li;
        const float fr = (nr * lr + ni * li) / den, fi = (ni * lr - nr * li) / den;
        const float br = b_re[(g * 64 + p) * 16 + h], bi = b_im[(g * 64 + p) * 16 + h];
        BBr[e] = fr * br - fi * bi; BBi[e] = fr * bi + fi * br;
        CCr[e] = c_re[g * 1024 + e]; CCi[e] = c_im[g * 1024 + e]; }
    if (tid < 16) DD[tid] = dsk[g * 16 + tid];
    __syncthreads();
    { const int lane_ = tid & 63, hq = lane_ & 3, hl = (lane_ >> 2) & 3, tau = 4 * (tid >> 6) + (lane_ >> 4), ho = 4 * q + hl, rot = 8 * hl + 2 * (lane_ >> 4);
      f32x4 sa = (f32x4){0.f, 0.f, 0.f, 0.f};
      for (int pp = 0; pp < 64; ++pp) { const int p = (pp + rot) & 63; const float cr = CCr[ho * 64 + p], ci = CCi[ho * 64 + p], pr = POWr[tau * 64 + p], pi = POWi[tau * 64 + p];
          const float xr = cr * pr - ci * pi, xi = cr * pi + ci * pr; const f32x4 br = *(const LAS f32x4*)(BBr + p * 16 + 4 * hq), bi = *(const LAS f32x4*)(BBi + p * 16 + 4 * hq);
          sa += br * xr - bi * xi; }
      if (tau == 0 && (ho >> 2) == hq) sa[ho & 3] += DD[ho];
      *(LAS f32x4*)(KT + (tau * 4 + hl) * 16 + 4 * hq) = sa; }
    __syncthreads();
    bf16* WA = (bf16*)(a.ws + WS_S5WA) + (size_t)g * 256 * 512;
    for (int pc = tid; pc < 64 * 64; pc += NTHREADS) { const int p = pc >> 6, k0 = (pc & 63) * 8; v4u o = (v4u){0u, 0u, 0u, 0u};
        if (q < 2) { const int j = k0 >> 4, h0 = k0 & 15; const float pr = POWr[(31 - j) * 64 + p], pi = POWi[(31 - j) * 64 + p]; float v[8];
#pragma unroll
            for (int w = 0; w < 8; ++w) { const float br = BBr[p * 16 + h0 + w], bi = BBi[p * 16 + h0 + w]; v[w] = (q == 0) ? (pr * br - pi * bi) : (pr * bi + pi * br); }
            o.x = cvtpk(v[0], v[1]); o.y = cvtpk(v[2], v[3]); o.z = cvtpk(v[4], v[5]); o.w = cvtpk(v[6], v[7]); }
        *(GAS v4u*)(WA + (size_t)(64 * q + p) * 512 + k0) = o; }
    bf16* WC = (bf16*)(a.ws + WS_S5WC) + (size_t)g * 512 * 640;
    for (int pc = tid; pc < 128 * 80; pc += NTHREADS) { const int rl = pc / 80, k0 = (pc % 80) * 8, i = rl >> 2, hl = rl & 3, ho = 4 * q + hl; float v[8];
        if (k0 < 512) { const int j = k0 >> 4, h0 = k0 & 15; f32x4 ka = (f32x4){0.f, 0.f, 0.f, 0.f}, kb = ka;
            if (j <= i) { const LAS f32x4* kp = (const LAS f32x4*)(KT + ((i - j) * 4 + hl) * 16 + h0); ka = kp[0]; kb = kp[1]; }
#pragma unroll
            for (int w = 0; w < 4; ++w) { v[w] = ka[w]; v[4 + w] = kb[w]; } }
        else { const int p0 = (k0 - 512) & 63; const bool im = k0 >= 576;
#pragma unroll
            for (int w = 0; w < 8; ++w) { const int p = p0 + w; const float cr = CCr[ho * 64 + p], ci = CCi[ho * 64 + p], pr = POWr[(i + 1) * 64 + p], pi = POWi[(i + 1) * 64 + p];
                v[w] = im ? -(cr * pi + ci * pr) : (cr * pr - ci * pi); } }
        v4u o; o.x = cvtpk(v[0], v[1]); o.y = cvtpk(v[2], v[3]); o.z = cvtpk(v[4], v[5]); o.w = cvtpk(v[6], v[7]);
        *(GAS v4u*)(WC + (size_t)(i * 16 + ho) * 640 + k0) = o; }
    __syncthreads();
}

constexpr int MOE_XITEMS = 24 * 896;
__device__ __forceinline__ XTile moe_xtile(const Args& a, int r, int lane) {
    unsigned char* ws = a.ws;
    const int mat = r / 896, e = mat / 3, which = mat % 3; r -= mat * 896;
    if (which == 0) return xtile_fp8(r, a.in[24] + (size_t)e * D * DFE, DFE, DFE, a.in[22], ws + WS_WMOE_GU + (size_t)e * 7168 * 1024, D, 1, lane);
    if (which == 1) return xtile_fp8(r, a.in[25] + (size_t)e * D * DFE, DFE, DFE, a.in[22], ws + WS_WMOE_GU + (size_t)e * 7168 * 1024, D, 2, lane);
    return xtile_fp8(r, a.in[26] + (size_t)e * DFE * D, D, D, nullptr, ws + WS_WMOE_D + (size_t)e * 1024 * 3584, DFE, 0, lane);
}
constexpr int I_IN0 = 16 * 32, I_GLU = 8 * 8, I_OUT = 16 * 16, I_GU0 = 16 * 44, I_D0 = 44 * 16, I_IN1 = 16 * 48;
constexpr int DW_FIRST = I_IN0 + I_GLU  , DW_EARLY = I_IN0 + I_GLU + I_OUT + 2 * I_GU0, DW_ITEMS = DW_EARLY + I_D0 + I_IN1 + I_OUT;
__device__ __forceinline__ void dense_item(const Args& a, int it, LAS float* scr, int lane) {
    unsigned char* ws = a.ws; int r = it;
    if (r < I_IN0) { xpose_mat(r, a.in[2], EVEN_IN, EVEN_IN, a.in[1], (bf16*)(ws + WS_WIN0), D, 0, scr, lane); return; } r -= I_IN0;
    if (r < I_GLU) { xpose_mat(r, a.in[11], 512, 512, nullptr, (bf16*)(ws + WS_WGLU), 512, 0, scr, lane); return; } r -= I_GLU;
    if (r < I_OUT) { xpose_mat(r, a.in[13], D, D, nullptr, (bf16*)(ws + WS_WOUT0), D, 0, scr, lane); return; } r -= I_OUT;
    if (r < I_GU0) { xpose_mat(r, a.in[15], DFF, DFF, a.in[14], (bf16*)(ws + WS_WGU0), D, 1, scr, lane); return; } r -= I_GU0;
    if (r < I_GU0) { xpose_mat(r, a.in[16], DFF, DFF, a.in[14], (bf16*)(ws + WS_WGU0), D, 2, scr, lane); return; } r -= I_GU0;
    if (r < I_D0) { xpose_mat(r, a.in[17], D, D, nullptr, (bf16*)(ws + WS_WD0), DFF, 0, scr, lane); return; } r -= I_D0;
    if (r < I_IN1) { const XTile t = xtile_fp8(r, a.in[19], ODD_IN, 3072, a.in[18], ws + WS_WIN1, D, 0, lane); f32x4 v[16]; float g[16]; xtile_load(t, v, g, lane); xtile_finish_fp8(t, v, g, 64.f, scr, lane); return; } r -= I_IN1;
    { const XTile t = xtile_fp8(r, a.in[21], D, D, nullptr, ws + WS_WOUT1, D, 0, lane); f32x4 v[16]; float g[16]; xtile_load(t, v, g, lane); xtile_finish_fp8(t, v, g, 64.f, scr, lane); }
}
__device__ __forceinline__ void dense_range(const Args& a, LAS unsigned char* lds, int lane, int wave, int iw, int nwg_, int lo, int hi) {
    LAS float* scr = (LAS float*)(lds + wave * XSCR_BYTES);
    for (int it = hi - 1 - (iw * NWAVES + wave); it >= lo; it -= nwg_ * NWAVES) dense_item(a, it, scr, lane);
}
__device__ __forceinline__ void dense_late(const Args& a, LAS unsigned char* lds, int tid, int lane, int wave, int iw, int nwg_) {
    LAS float* scr = (LAS float*)(lds + wave * XSCR_BYTES);
    for (int it = DW_ITEMS - 1 - (iw * NWAVES + wave); it >= DW_EARLY; it -= nwg_ * NWAVES) dense_item(a, it, scr, lane);
    for (int gt = iw * NTHREADS + tid; gt < 16 * 1024; gt += nwg_ * NTHREADS) { const int h = gt >> 10, k = gt & 1023; ((bf16*)(a.ws + WS_WF1))[gt] = (bf16)f2bf(a.in[19][(size_t)k * ODD_IN + 3072 + h] * a.in[18][k]); }
}
__device__ __forceinline__ void p0_prologue(const Args& a, LAS unsigned char* lds, int tid, int lane, int wave, int vcu, int G) {
    for (int it = vcu; it < 4 * S5G; it += G) s5_tables(a, it >> 2, it & 3, lds, tid);
    LAS float* scr = (LAS float*)(lds + wave * XSCR_BYTES);
    const int gw = vcu * NWAVES + wave, NGW = G * NWAVES;
    unsigned char* ws = a.ws;
    for (int it = DW_FIRST - 1 - gw; it >= 0; it -= NGW) dense_item(a, it, scr, lane);
    float* ss0 = (float*)(ws + WS_SSP);
    int m0, nr, stp;
    if (G == 256) { if (vcu < 128) { m0 = vcu * 48 + wave * 6; nr = 6; } else { m0 = 6144 + (vcu - 128) * 80 + wave * 10; nr = 10; } stp = 1; }
    else { m0 = gw; nr = (M - gw + NGW - 1) / NGW; stp = NGW; }
    f32x4 xnx[4];
    if (nr > 0) {
#pragma unroll
        for (int j = 0; j < 4; ++j) xnx[j] = ((const GAS f32x4*)(a.in[0] + (size_t)m0 * D) + lane)[64 * j]; }
    for (int i = 0; i < nr; ++i) { const int m = m0 + i * stp;
        GAS v2u* o8 = (GAS v2u*)((bf16*)(ws + WS_XB) + (size_t)m * D) + lane; float s = 0.f; f32x4 xc[4];
#pragma unroll
        for (int j = 0; j < 4; ++j) xc[j] = xnx[j];
        if (i + 1 < nr) {
#pragma unroll
            for (int j = 0; j < 4; ++j) xnx[j] = ((const GAS f32x4*)(a.in[0] + (size_t)(m + stp) * D) + lane)[64 * j]; }
#pragma unroll
        for (int j = 0; j < 4; ++j) { const f32x4 v = xc[j]; s += (v.x * v.x + v.y * v.y) + (v.z * v.z + v.w * v.w); v2u w; w.x = cvtpk(v.x, v.y); w.y = cvtpk(v.z, v.w); o8[64 * j] = w; }
        s = wave_sum(s); if (lane < 16) ss0[(size_t)m * 16 + lane] = (lane == 0) ? s : 0.f;
    }
}

__device__ __forceinline__ void s5_scan(const Args& a, int gt  ) {
    if (gt >= BATCH * S5G * S5P) return;
    const int b = gt / (S5G * S5P), g = (gt / S5P) % S5G, p = gt % S5P;
    const float step = expf(a.in[10][g]); const float lr = a.in[3][g * 64 + p], li = a.in[4][g * 64 + p];
    const float mag = expf((float)S5T * step * lr); float sn, cs; sincosf((float)S5T * (step * li), &sn, &cs); const float ar = mag * cs, ai = mag * sn;
    const float* sl = (const float*)(a.ws + WS_SLOC) + ((size_t)g * S5NC + b * 256) * 128 + p;
    bf16* ue = (bf16*)(a.ws + WS_UEXT) + ((size_t)g * S5NC + b * 256) * S5KX + 512 + p;
    float sr = 0.f, si = 0.f;
    float cr[16], ci[16], nr_[16], ni_[16];
#pragma unroll
    for (int j = 0; j < 16; ++j) { cr[j] = sl[(size_t)j * 128]; ci[j] = sl[(size_t)j * 128 + 64]; }
#pragma unroll 1
    for (int c0 = 0; c0 < 256; c0 += 16) {
        if (c0 + 16 < 256) {
#pragma unroll
            for (int j = 0; j < 16; ++j) { nr_[j] = sl[(size_t)(c0 + 16 + j) * 128]; ni_[j] = sl[(size_t)(c0 + 16 + j) * 128 + 64]; } }
#pragma unroll
        for (int j = 0; j < 16; ++j) { const int c = c0 + j;
            ue[(size_t)c * S5KX] = (bf16)f2bf(sr); ue[(size_t)c * S5KX + 64] = (bf16)f2bf(si);
            const float nr = ar * sr - ai * si + cr[j], ni = ar * si + ai * sr + ci[j]; sr = nr; si = ni; }
#pragma unroll
        for (int j = 0; j < 16; ++j) { cr[j] = nr_[j]; ci[j] = ni_[j]; }
    }
}

__device__ __forceinline__ void fgate_rows16(const bf16* xb, const bf16* wf, const float* ss, const float* bfv, float* logf, int r0, int lane) {
    const int fr = lane & 15, fq = lane >> 4;
    const bf16x8* ap = (const bf16x8*)(xb + (size_t)(r0 + fr) * D + fq * 8);
    const bf16x8* bp = (const bf16x8*)(wf + (size_t)fr * D + fq * 8);
    f32x4 acc0 = (f32x4){0.f, 0.f, 0.f, 0.f}, acc1 = (f32x4){0.f, 0.f, 0.f, 0.f};
#pragma unroll
    for (int half = 0; half < 2; ++half) {
        bf16x8 av[16], bv[16];
#pragma unroll
        for (int kk = 0; kk < 16; ++kk) { av[kk] = ap[(half * 16 + kk) * 4]; bv[kk] = bp[(half * 16 + kk) * 4]; }
#pragma unroll
        for (int kk = 0; kk < 16; kk += 2) { acc0 = __builtin_amdgcn_mfma_f32_16x16x32_bf16(av[kk], bv[kk], acc0, 0, 0, 0); acc1 = __builtin_amdgcn_mfma_f32_16x16x32_bf16(av[kk + 1], bv[kk + 1], acc1, 0, 0, 0); }
    }
    const f32x4 acc = acc0 + acc1;
    const float bias = bfv[fr];
    float rsq[4];
#pragma unroll
    for (int j = 0; j < 4; ++j) rsq[j] = pg8::rstd16(ss, r0 + fq * 4 + j);
#pragma unroll
    for (int j = 0; j < 4; ++j) { const int row = r0 + fq * 4 + j;
        const float z = acc[j] * rsq[j] + bias;
        const float lf = -(fmaxf(-z, 0.f) + log1pf(expf(-fabsf(z)))) * 1.4426950408889634f;
        const int b = row >> 13, t = row & 8191; logf[((size_t)b * FOXH + fr) * SEQ + t] = lf; }
}

struct MoeOrder {
    pg8::StaticOrder S; int lo; int pref[NEXP + 1]; bool cap_rows;
    __device__ __forceinline__ bool next(int i, pg8::Unit& u) const {
        if (!S.next(i, u)) return false;
        u.pm += lo; int e = 0, pe = 0;
#pragma unroll
        for (int k = 1; k < NEXP; ++k) { const bool ge = u.pm >= pref[k]; e += ge ? 1 : 0; pe = ge ? pref[k] : pe; }
        u.zb = e; u.pa = cap_rows ? e * (MOE_CAP / 256) + (u.pm - pe) : u.pm; return true;
    }
    __device__ __forceinline__ void a_ready(const pg8::Unit&) const {}
    __device__ __forceinline__ void done(const pg8::Unit&) const {}
};

struct MoeQuadOrder {
    int p0, np, G, c; int pref[NEXP + 1];
    __device__ __forceinline__ bool next(int i, pg8::Unit& u) const {
        const long L = (long)i * G + c; if (L >= (long)np * 16) return false;
        const int q = (int)(L & 3), ul = (int)(L >> 2); u.pn = ul & 3; u.pm = p0 + (ul >> 2); u.qa = q >> 1; u.qb = q & 1; u.pa = u.pm; int e = 0;
#pragma unroll
        for (int k = 1; k < NEXP; ++k) e += (u.pm >= pref[k]) ? 1 : 0;
        u.zb = e; return true;
    }
    __device__ __forceinline__ void a_ready(const pg8::Unit&) const {}
    __device__ __forceinline__ void done(const pg8::Unit&) const {}
};

__global__ void __launch_bounds__(NTHREADS, 2) mk_fwd(Args args) {
    extern __shared__ __attribute__((aligned(16))) unsigned char lds_raw[];
    LAS unsigned char* lds = (LAS unsigned char*)lds_raw;
    volatile LAS unsigned* MISC = (volatile LAS unsigned*)(lds + MISC_OFF);
    const int tid = threadIdx.x, lane = tid & 63, wave = __builtin_amdgcn_readfirstlane(tid >> 6);
    const int G = gridDim.x; const int bx = blockIdx.x; const int vcu = (G % 8 == 0) ? (bx % 8) * (G / 8) + bx / 8 : bx;
    unsigned char* ws = args.ws;
    gu32* ctl = (gu32*)(ws + WS_CTL);
    for (int u = tid; u < (LDS_BYTES - LDSCTL_OFF) / 4; u += NTHREADS) ((LAS unsigned*)(lds + LDSCTL_OFF))[u] = 0u;
    __syncthreads();
    XcdBarrier bar = xcd_barrier_post((unsigned*)(ctl + CW_BAR), MISC + 8, (unsigned)G);
    const int gw = vcu * NWAVES + wave, NGW = G * NWAVES;
    float* SS = (float*)(ws + WS_SSP);
    float* X = args.out;
    bf16* XB = (bf16*)(ws + WS_XB);
#define GRID_BAR() xcd_barrier(bar)
#define GEMM_PHASE(EPI, SCHED, lds_, g_, S_, E_) pg8::gemm_phase<EPI, SCHED, true, true>(lds_, g_, S_, E_)

    p0_prologue(args, lds, tid, lane, wave, vcu, G);
    GRID_BAR();
    { pg8::Gemm g{XB, (const bf16*)(ws + WS_WIN0), D, D, D, 0, 0}; pg8::StaticOrder S; S.init(M, EVEN_IN, 1, G, bx);
      pg8::EpiInProj0 E{SS, (bf16*)(ws + WS_UEXT), (bf16*)(ws + WS_QKV0), C2};
      GEMM_PHASE(pg8::EpiInProj0, pg8::StaticOrder, lds + RING_OFF, g, S, E); }
    GRID_BAR();
#define SB_PULL_ONE(more_) do { if (tid == 0) MISC[17] = __hip_atomic_fetch_add(ctl + CW_QUEUE2, 1u, RLX_AGENT); __syncthreads(); const unsigned uq_ = __builtin_amdgcn_readfirstlane(MISC[17]); __syncthreads(); \
        more_ = uq_ < (unsigned)(BATCH * SBH * 32); if (more_) { const int bh_ = (int)(uq_ >> 5), qb_ = (int)(uq_ & 31u); \
            attn_body::sb_unit<1536>(bh_ >> 3, bh_ & 7, qb_, (const attn_body::bf16*)(ws + WS_QKV0), (const attn_body::bf16*)(ws + WS_QKV0) + 512, (const attn_body::bf16*)(ws + WS_QKV0) + 1024, (attn_body::bf16*)(ws + WS_MIXB) + 512, (char*)lds_raw + RING_OFF); } } while (0)
    { const bool s5g = (G % 16 == 0) ? (((bx >> 3) & 1) == 0) : true; const int Gs = (G % 16 == 0) ? G / 2 : G, gl = (G % 16 == 0) ? (bx & 7) + 8 * (bx >> 4) : bx;
      if (s5g) {
          XcdBarrier sub = xcd_barrier_post((unsigned*)(ctl + CW_SUBBAR), MISC + 12, (unsigned)Gs);
          { pg8::Gemm g{(const bf16*)(ws + WS_UEXT), (const bf16*)(ws + WS_S5WA), S5KX, 512, 512, (size_t)S5NC * S5KX * 2, (size_t)256 * 512 * 2}; pg8::StaticOrder S; S.init(S5NC, 256, S5G, Gs, gl);
            pg8::EpiS5State E{(float*)(ws + WS_SLOC)};
            GEMM_PHASE(pg8::EpiS5State, pg8::StaticOrder, lds + RING_OFF, g, S, E);
            if (Gs > S.nwg) { if (gl >= S.nwg) dense_range(args, lds, lane, wave, gl - S.nwg, Gs - S.nwg, DW_EARLY - I_GU0, DW_EARLY); } else dense_range(args, lds, lane, wave, gl, Gs, DW_EARLY - I_GU0, DW_EARLY); }
          xcd_barrier(sub);
          s5_scan(args, gl * NTHREADS + tid);
          { constexpr int NSCAN = BATCH * S5G * S5P / NTHREADS; if (Gs > NSCAN) { if (gl >= NSCAN) dense_range(args, lds, lane, wave, gl - NSCAN, Gs - NSCAN, DW_FIRST, DW_EARLY - I_GU0); } else dense_range(args, lds, lane, wave, gl, Gs, DW_FIRST, DW_EARLY - I_GU0); }
          xcd_barrier(sub);
          { pg8::Gemm g{(const bf16*)(ws + WS_UEXT), (const bf16*)(ws + WS_S5WC), S5KX, S5KX, S5KX, (size_t)S5NC * S5KX * 2, (size_t)512 * S5KX * 2}; pg8::StaticOrder S; S.init(S5NC, 512, S5G, Gs, gl);
            pg8::EpiS5Y E{(bf16*)(ws + WS_YG)};
            GEMM_PHASE(pg8::EpiS5Y, pg8::StaticOrder, lds + RING_OFF, g, S, E); }
          xcd_barrier(sub);
          { pg8::Gemm g{(const bf16*)(ws + WS_YG), (const bf16*)(ws + WS_WGLU), 512, 512, 512, 0, 0}; pg8::StaticOrder S; S.init(M, 512, 1, Gs, gl);
            pg8::EpiGlu E{(const bf16*)(ws + WS_YG), args.in[12], (bf16*)(ws + WS_MIXB)};
            GEMM_PHASE(pg8::EpiGlu, pg8::StaticOrder, lds + RING_OFF, g, S, E); }
          __syncthreads();
      }
      bool sb_more = true;
#pragma unroll 1
      while (sb_more) SB_PULL_ONE(sb_more);
    }
    GRID_BAR();
#undef SB_PULL_ONE
    { pg8::Gemm g{(const bf16*)(ws + WS_MIXB), (const bf16*)(ws + WS_WOUT0), D, D, D, 0, 0}; pg8::StaticOrder S; S.init(M, D, 1, G, bx);
      pg8::EpiResid<true> E{args.in[0], X, XB, SS + 16 * M};
      GEMM_PHASE(pg8::EpiResid<true>, pg8::StaticOrder, lds + RING_OFF, g, S, E); }
    GRID_BAR();
    { pg8::Gemm g{XB, (const bf16*)(ws + WS_WGU0), D, D, D, 0, 0}; pg8::StaticOrder S; S.init(M, 2 * DFF, 1, G, bx);
      pg8::EpiSwiGlu<true> E{SS + 16 * M, (bf16*)(ws + WS_HID0), DFF};
      GEMM_PHASE(pg8::EpiSwiGlu<true>, pg8::StaticOrder, lds + RING_OFF, g, S, E);
      { const int rem = S.nwg % G; if (rem == 0) dense_late(args, lds, tid, lane, wave, bx, G); else if (bx >= rem) dense_late(args, lds, tid, lane, wave, bx - rem, G - rem); } }
    GRID_BAR();
    { pg8::Gemm g{(const bf16*)(ws + WS_HID0), (const bf16*)(ws + WS_WD0), DFF, DFF, DFF, 0, 0}; pg8::StaticOrder S; S.init(M, D, 1, G, bx);
      pg8::EpiResid<true> E{X, X, XB, SS + 32 * M, ws + WS_HMOE  };
      GEMM_PHASE(pg8::EpiResid<true>, pg8::StaticOrder, lds + RING_OFF, g, S, E); }
    GRID_BAR();
    { pg8::Gemm g{(const bf16*)(ws + WS_HMOE), (const bf16*)(ws + WS_WIN1), D / 2, D / 2, D / 2, 0, 0}; pg8::StaticOrder S; S.init(M, 3072, 1, G, bx);
      pg8::EpiInProj1 E{SS + 32 * M, (bf16*)(ws + WS_QKV1), C2, (unsigned*)(ctl + CW_KN)};
      pg8::gemm_phase<pg8::EpiInProj1, pg8::StaticOrder, true, true, true>(lds + RING_OFF, g, S, E); }
    for (int r = gw; r < M / 16; r += NGW) fgate_rows16(XB, (const bf16*)(ws + WS_WF1), SS + 32 * M, args.in[20], (float*)(ws + WS_LOGF), r * 16, lane);
    GRID_BAR();
    { const attn_body::AttnTensors AT{(const attn_body::bf16*)(ws + WS_QKV1), (const attn_body::bf16*)(ws + WS_QKV1 + 32 * MiB), (const attn_body::bf16*)(ws + WS_QKV1 + 64 * MiB), (attn_body::bf16*)(ws + WS_QKV1), (const float*)(ws + WS_LOGF), (const unsigned*)(ctl + CW_KN)};
      constexpr int N_ATT = 1024, N_CVB = MOE_XITEMS / 32, N_GRP = (N_ATT + 2) / 3 > (N_CVB + 1) / 2 ? (N_ATT + 2) / 3 : (N_CVB + 1) / 2;
      for (;;) {
          if (tid == 0) MISC[16] = __hip_atomic_fetch_add(ctl + CW_QUEUE, 1u, RLX_AGENT);
          __syncthreads();
          const unsigned uq = __builtin_amdgcn_readfirstlane(MISC[16]);
          __syncthreads();
          if (uq >= 5u * N_GRP) break;
          const int grp = (int)(uq / 5u), rr = (int)(uq % 5u);
          if (rr & 1) { const int cb = 2 * grp + (rr >> 1);
              if (cb < N_CVB) { int lane_ = threadIdx.x & 63; asm volatile("" : "+v"(lane_));
                  LAS float* scr = (LAS float*)(lds + wave * XSCR_BYTES);
#pragma unroll 1
                  for (int j = 0; j < 4; j += 2) { const XTile t0 = moe_xtile(args, cb * 32 + wave * 4 + j, lane_), t1 = moe_xtile(args, cb * 32 + wave * 4 + j + 1, lane_);
                      f32x4 v0[16], v1[16]; float g0[16], g1[16]; xtile_load(t0, v0, g0, lane_); xtile_load(t1, v1, g1, lane_);
                      xtile_finish_fp8(t0, v0, g0, 64.f, scr, lane_); xtile_finish_fp8(t1, v1, g1, 64.f, scr, lane_); } }
          } else { const int au = 3 * grp + (rr >> 1);
              if (au < N_ATT) { const int bh = au & 31, qb = 31 - (au >> 5);
                  attn_body::attn_unit<8>(bh >> 4, bh & 15, qb, AT.Q, AT.K, AT.V, AT.O, (char*)lds_raw + RING_OFF, AT.logf + (size_t)bh * SEQ, AT.kn + (size_t)bh * 256, ws + WS_HMOE + 16 * MiB  ); } }
      } }
    GRID_BAR();
    { pg8::Gemm g{(const bf16*)(ws + WS_HMOE + 16 * MiB), (const bf16*)(ws + WS_WOUT1), D / 2, D / 2, D / 2, 0, 0}; pg8::StaticOrder S; S.init(M, D, 1, G, bx);
      pg8::EpiResid<false> E{X, X, XB, SS + 48 * M};
      pg8::gemm_phase<pg8::EpiResid<false>, pg8::StaticOrder, true, true, true>(lds + RING_OFF, g, S, E); }
    GRID_BAR();
    unsigned char* meta = ws + WS_META; unsigned char* XG = ws + WS_XG; float* RSS = (float*)(meta + MT_RSS);
    {
        const float* wr = args.in[23]; const float* gn = args.in[22];
        LAS unsigned* lcnt = (LAS unsigned*)(lds + 1024);
        LAS unsigned* rowst = (LAS unsigned*)(lds + 4096);
        if (tid < 16) lcnt[tid] = 0u;
        __syncthreads();
        float wl[16][NEXP];
#pragma unroll
        for (int j = 0; j < 4; ++j) { const int k0 = 4 * lane + 256 * j; const f32x4 gv = *(const f32x4*)(gn + k0);
#pragma unroll
            for (int q = 0; q < 4; ++q) { const f32x4 w0 = *(const f32x4*)(wr + (size_t)(k0 + q) * NEXP), w1 = *(const f32x4*)(wr + (size_t)(k0 + q) * NEXP + 4);
                wl[4 * j + q][0] = gv[q] * w0.x; wl[4 * j + q][1] = gv[q] * w0.y; wl[4 * j + q][2] = gv[q] * w0.z; wl[4 * j + q][3] = gv[q] * w0.w;
                wl[4 * j + q][4] = gv[q] * w1.x; wl[4 * j + q][5] = gv[q] * w1.y; wl[4 * j + q][6] = gv[q] * w1.z; wl[4 * j + q][7] = gv[q] * w1.w; } }
        f32x4 xn[4];
        if (gw < M) {
#pragma unroll
            for (int j = 0; j < 4; ++j) xn[j] = ((const GAS f32x4*)(X + (size_t)gw * D) + lane)[64 * j]; }
        const bool hb5 = (lane & 32) != 0, hb4 = (lane & 16) != 0, hb3 = (lane & 8) != 0;
        for (int tok = gw; tok < M; tok += NGW) {
            f32x4 xv[4];
#pragma unroll
            for (int j = 0; j < 4; ++j) xv[j] = xn[j];
            if (tok + NGW < M) {
#pragma unroll
                for (int j = 0; j < 4; ++j) xn[j] = ((const GAS f32x4*)(X + (size_t)(tok + NGW) * D) + lane)[64 * j]; }
            float lg[NEXP]; float s = 0.f; const int ti = (tok - gw) / NGW;
#pragma unroll
            for (int e = 0; e < NEXP; ++e) lg[e] = 0.f;
#pragma unroll
            for (int j = 0; j < 4; ++j) { const f32x4 v = xv[j]; s += (v.x * v.x + v.y * v.y) + (v.z * v.z + v.w * v.w);
                if (ti < 8) rowst[((wave * 8 + ti) * 256) + lane + 64 * j] = pg8::pk_fp8x4(v.x, v.y, v.z, v.w);
#pragma unroll
                for (int q = 0; q < 4; ++q)
#pragma unroll
                    for (int e = 0; e < NEXP; ++e) lg[e] = fmaf(v[q], wl[4 * j + q][e], lg[e]); }
            s = wave_sum(s);
            float a4[4], a2[2], a1;
#pragma unroll
            for (int i = 0; i < 4; ++i) { const float snd = hb5 ? lg[i] : lg[i + 4], kp = hb5 ? lg[i + 4] : lg[i]; a4[i] = kp + __shfl_xor(snd, 32); }
#pragma unroll
            for (int i = 0; i < 2; ++i) { const float snd = hb4 ? a4[i] : a4[i + 2], kp = hb4 ? a4[i + 2] : a4[i]; a2[i] = kp + __shfl_xor(snd, 16); }
            { const float snd = hb3 ? a2[0] : a2[1], kp = hb3 ? a2[1] : a2[0]; a1 = kp + __shfl_xor(snd, 8); }
            a1 += __shfl_xor(a1, 4); a1 += __shfl_xor(a1, 2); a1 += __shfl_xor(a1, 1);
#pragma unroll
            for (int e = 0; e < NEXP; ++e) lg[e] = __builtin_bit_cast(float, __builtin_amdgcn_readlane(__builtin_bit_cast(int, a1), 8 * e));
            if (lane == 0) {
                const float rs = 1.0f / sqrtf(s * (1.0f / 1024.0f) + pg8::RMS_EPS);
                int i1 = 0; float v1 = lg[0];
#pragma unroll
                for (int e = 1; e < NEXP; ++e) if (lg[e] > v1) { v1 = lg[e]; i1 = e; }
                int i2 = -1; float v2 = -INFINITY;
#pragma unroll
                for (int e = 0; e < NEXP; ++e) if (e != i1 && lg[e] > v2) { v2 = lg[e]; i2 = e; }
                const float g1 = 1.f / (1.f + expf((v2 - v1) * rs)), g2 = 1.f - g1;
                const unsigned p1 = __hip_atomic_fetch_add(lcnt + i1, 1u, __ATOMIC_RELAXED, __HIP_MEMORY_SCOPE_WORKGROUP), p2 = __hip_atomic_fetch_add(lcnt + i2, 1u, __ATOMIC_RELAXED, __HIP_MEMORY_SCOPE_WORKGROUP);
                ((float*)(meta + MT_RSTD))[tok] = rs; ((unsigned*)(meta + MT_TOKE))[tok] = (unsigned)i1 | ((unsigned)i2 << 8);
                ((unsigned*)(meta + MT_TOKP))[2 * tok] = p1; ((unsigned*)(meta + MT_TOKP))[2 * tok + 1] = p2;
                ((float*)(meta + MT_TOKG))[2 * tok] = g1; ((float*)(meta + MT_TOKG))[2 * tok + 1] = g2;
            }
        }
        __syncthreads();
        if (tid < NEXP) lcnt[8 + tid] = __hip_atomic_fetch_add(ctl + CW_CNT + 64 * tid, lcnt[tid], RLX_AGENT);
        VM_WAIT();
        __syncthreads();
        for (int tok = gw; tok < M; tok += NGW) {
            const unsigned ee = ((const unsigned*)(meta + MT_TOKE))[tok]; const float rs = ((const float*)(meta + MT_RSTD))[tok];
            const unsigned q1 = ((const unsigned*)(meta + MT_TOKP))[2 * tok], q2 = ((const unsigned*)(meta + MT_TOKP))[2 * tok + 1];
            const int ti = (tok - gw) / NGW; unsigned w[4];
            if (ti < 8) {
#pragma unroll
                for (int j = 0; j < 4; ++j) w[j] = rowst[((wave * 8 + ti) * 256) + lane + 64 * j];
            } else {
#pragma unroll
                for (int j = 0; j < 4; ++j) { const f32x4 v = ((const GAS f32x4*)(X + (size_t)tok * D) + lane)[64 * j]; w[j] = pg8::pk_fp8x4(v.x, v.y, v.z, v.w); } }
            const int e1 = (int)(ee & 0xffu), e2 = (int)((ee >> 8) & 0xffu);
            const unsigned p1 = q1 + lcnt[8 + e1], p2 = q2 + lcnt[8 + e2];
            const size_t r1 = (size_t)e1 * MOE_CAP + p1, r2 = (size_t)e2 * MOE_CAP + p2;
#pragma unroll
            for (int j = 0; j < 4; ++j) { *(unsigned*)(XG + r1 * D + 4 * lane + 256 * j) = w[j]; *(unsigned*)(XG + r2 * D + 4 * lane + 256 * j) = w[j]; }
            if (lane == 0) { RSS[r1] = rs; RSS[r2] = rs; ((unsigned*)(meta + MT_TOKP))[2 * tok] = p1; ((unsigned*)(meta + MT_TOKP))[2 * tok + 1] = p2; }
        }
    }
    GRID_BAR();
    int pref[NEXP + 1], cnt[NEXP];
    { pref[0] = 0;
#pragma unroll
      for (int e = 0; e < NEXP; ++e) { cnt[e] = (int)__builtin_amdgcn_readfirstlane(__hip_atomic_load(ctl + CW_CNT + 64 * e, RLX_AGENT)); pref[e + 1] = pref[e] + (cnt[e] + 255) / 256; } }
    const int NP = pref[NEXP];
    bf16* YS = (bf16*)(ws + WS_Y);
    { pg8::Gemm g{(const bf16*)XG, (const bf16*)(ws + WS_WMOE_GU), D / 2, D / 2, D / 2, 0, (size_t)7168 * 1024}; MoeOrder S; S.S.nM = NP; S.S.nN = 28; S.S.nZ = 1; S.S.nwg = NP * 28; S.S.G = G; S.S.c = bx; S.lo = 0; S.cap_rows = true;
#pragma unroll
      for (int e = 0; e <= NEXP; ++e) S.pref[e] = pref[e];
      pg8::EpiSwiGluFp8 E{RSS, ws + WS_HMOE, DFE};
      pg8::gemm_phase<pg8::EpiSwiGluFp8, MoeOrder, true, true, true>(lds + RING_OFF, g, S, E); }
    GRID_BAR();
    { pg8::Gemm g{(const bf16*)(ws + WS_HMOE), (const bf16*)(ws + WS_WMOE_D), DFE / 2, DFE / 2, DFE / 2, 0, (size_t)1024 * 3584}; const int NPM = NP < 2 * G / 4 ? NP : 2 * G / 4;
      MoeOrder S; S.S.nM = NPM; S.S.nN = 4; S.S.nZ = 1; S.S.nwg = NPM * 4; S.S.G = G; S.S.c = bx; S.lo = 0; S.cap_rows = false;
#pragma unroll
      for (int e = 0; e <= NEXP; ++e) S.pref[e] = pref[e];
      pg8::EpiStoreBf16 E{YS, D};
      pg8::gemm_phase<pg8::EpiStoreBf16, MoeOrder, true, true, true>(lds + RING_OFF, g, S, E);
      if (NP > NPM) { MoeQuadOrder Q; Q.p0 = NPM; Q.np = NP - NPM; Q.G = G; Q.c = bx;
#pragma unroll
          for (int e = 0; e <= NEXP; ++e) Q.pref[e] = pref[e];
          pg8::EpiStoreQuad EQ{YS, D};
          pg8::gemm_phase<pg8::EpiStoreQuad, MoeQuadOrder, true, true, true, true>(lds + RING_OFF, g, Q, EQ); } }
    GRID_BAR();
    {
        const float* gf = args.in[27];
        for (int tok = gw; tok < M; tok += NGW) {
            const unsigned ee = ((const unsigned*)(meta + MT_TOKE))[tok]; int pe0 = 0, pe1 = 0;
#pragma unroll
            for (int q = 0; q < NEXP; ++q) { pe0 = (q == (int)(ee & 0xffu)) ? pref[q] : pe0; pe1 = (q == (int)((ee >> 8) & 0xffu)) ? pref[q] : pe1; }
            const unsigned s0 = (unsigned)pe0 * 256u + ((const unsigned*)(meta + MT_TOKP))[2 * tok], s1 = (unsigned)pe1 * 256u + ((const unsigned*)(meta + MT_TOKP))[2 * tok + 1];
            const float g0 = ((const float*)(meta + MT_TOKG))[2 * tok], g1 = ((const float*)(meta + MT_TOKG))[2 * tok + 1];
            GAS f32x4* xr = (GAS f32x4*)(X + (size_t)tok * D) + lane; f32x4 v[4]; float s = 0.f;
#pragma unroll
            for (int j = 0; j < 4; ++j) { v[j] = xr[64 * j]; const int k0 = 4 * lane + 256 * j;
                const v2u a = *(const v2u*)(YS + (size_t)s0 * D + k0), b2 = *(const v2u*)(YS + (size_t)s1 * D + k0);
                v[j].x += g0 * bflo(a.x) + g1 * bflo(b2.x); v[j].y += g0 * bfhi(a.x) + g1 * bfhi(b2.x); v[j].z += g0 * bflo(a.y) + g1 * bflo(b2.y); v[j].w += g0 * bfhi(a.y) + g1 * bfhi(b2.y);
                s += (v[j].x * v[j].x + v[j].y * v[j].y) + (v[j].z * v[j].z + v[j].w * v[j].w); }
            s = wave_sum(s); const float rs = 1.0f / sqrtf(s * (1.0f / 1024.0f) + pg8::RMS_EPS);
#pragma unroll
            for (int j = 0; j < 4; ++j) { const f32x4 gv = *(const f32x4*)(gf + 4 * lane + 256 * j); xr[64 * j] = v[j] * rs * gv; }
        }
    }
}

extern "C" void kernel_launch(void* const* d_in, const int* in_sizes, int n_in, void* d_out, int out_size, void* d_ws, size_t ws_size, hipStream_t stream) {
    static int grid = 0;
    if (grid == 0) {
        if (n_in != 28 || in_sizes[0] != M * D || out_size != M * D || ws_size < WS_END) { fprintf(stderr, "kernel_launch: unexpected problem: n_in %d in0 %d out %d ws %zu (need %zu)\n", n_in, n_in > 0 ? in_sizes[0] : -1, out_size, ws_size, (size_t)WS_END); grid = -1; return; }
        int dev = 0, cus = 0, per_cu = 0;
        if (hipGetDevice(&dev) != hipSuccess || hipDeviceGetAttribute(&cus, hipDeviceAttributeMultiprocessorCount, dev) != hipSuccess) { grid = -1; return; }
        if (hipFuncSetAttribute((const void*)mk_fwd, hipFuncAttributeMaxDynamicSharedMemorySize, LDS_BYTES) != hipSuccess) { fprintf(stderr, "kernel_launch: hipFuncSetAttribute failed\n"); grid = -1; return; }
        if (hipOccupancyMaxActiveBlocksPerMultiprocessor(&per_cu, (const void*)mk_fwd, NTHREADS, LDS_BYTES) != hipSuccess || per_cu < 1) fprintf(stderr, "kernel_launch: occupancy query says %d\n", per_cu);
        (void)hipGetLastError();
        grid = cus;
        if (grid != 256) fprintf(stderr, "kernel_launch: built for the 256-CU MI355X; device reports %d CUs\n", cus);
    }
    if (grid < 0) return;
    if (hipMemsetAsync((char*)d_ws + WS_CTL, 0, CTL_ZERO_BYTES, stream) != hipSuccess) return;
    Args a{};
    for (int i = 0; i < 28; ++i) a.in[i] = (const float*)d_in[i];
    a.out = (float*)d_out; a.ws = (unsigned char*)d_ws;
    hipLaunchKernelGGL(mk_fwd, dim3(grid), dim3(NTHREADS), LDS_BYTES, stream, a);
}
```

```cpp
#include <hip/hip_runtime.h>
#include <cstdio>
#include <cstdint>

namespace pg8 {
#define PG8_LAS __attribute__((address_space(3)))
typedef unsigned short bf16_t;
typedef short bf16x8 __attribute__((ext_vector_type(8)));
typedef float f32x4 __attribute__((ext_vector_type(4)));
typedef unsigned u32x4 __attribute__((ext_vector_type(4)));
typedef unsigned u32x2 __attribute__((ext_vector_type(2)));
constexpr int BM = 256, BK = 64, HALF = 128, HTB = HALF * BK * 2  , STAGE_BYTES = 8 * HTB, NXCD = 8, WGM = 8;

__host__ __device__ __forceinline__ int lds_byte(int r, int c) { const int st = (r >> 4) * 2 + (c >> 5), rr = r & 15, cc = c & 31, ob = rr * 64 + cc * 2; return st * 1024 + (ob ^ (((ob >> 9) & 1) << 5)); }
__host__ __device__ __forceinline__ void stage_rc(int b, int& R, int& C) { const int st = b / 1024, sb = b % 1024, swz = sb ^ (((sb >> 9) & 1) << 5); R = (st >> 1) * 16 + swz / 64; C = (st & 1) * 32 + (swz % 64) / 2; }
__host__ __device__ __forceinline__ int perm32(int rho) { const int n = rho >> 4, i = rho & 15; return 8 * (i >> 2) + 4 * n + (i & 3); }

struct Unit { int pm, pn, zb, pa, qa, qb; };
struct Gemm { const bf16_t* A; const bf16_t* Bt; int lda, ldb, K; size_t zA, zB; };

struct StaticOrder {
    int nM, nN, nZ, nwg, G, c;
    __host__ __device__ void init(int M, int N, int Z, int G_, int c_) { nM = M / BM; nN = N / BM; nZ = Z; nwg = nM * nN * nZ; G = G_; c = c_; }
    __host__ __device__ bool next(int i, Unit& u) const {
        const long L = (long)i * G + c; if (L >= nwg) return false;
        int wgid = (int)L; { const int q = nwg / NXCD, r = nwg % NXCD, xcd = wgid % NXCD, off = wgid / NXCD; wgid = (xcd < r ? xcd * (q + 1) : r * (q + 1) + (xcd - r) * q) + off; }
        const int per = nM * nN; u.zb = wgid / per; wgid -= u.zb * per;
        const int nig = WGM * nN, gid = wgid / nig, fm = gid * WGM, gsz = (nM - fm) < WGM ? (nM - fm) : WGM;
        u.pm = fm + ((wgid % nig) % gsz); u.pn = (wgid % nig) / gsz; u.pa = u.pm; u.qa = 0; u.qb = 0; return true;
    }
    __device__ __forceinline__ void a_ready(const Unit&) const {}
    __device__ __forceinline__ void done(const Unit&) const {}
};

__device__ __forceinline__ unsigned cvt_pk_bf16(float lo, float hi) { unsigned r; asm volatile("v_cvt_pk_bf16_f32 %0, %1, %2" : "=v"(r) : "v"(lo), "v"(hi)); return r; }
typedef int v4i_t __attribute__((ext_vector_type(4))); typedef int v8i_t __attribute__((ext_vector_type(8)));
__device__ __forceinline__ v8i_t cat8(bf16x8 a, bf16x8 b) { return __builtin_shufflevector(__builtin_bit_cast(v4i_t, a), __builtin_bit_cast(v4i_t, b), 0, 1, 2, 3, 4, 5, 6, 7); }
__device__ __forceinline__ unsigned pk_fp8x4(float a, float b, float c, float d) { int r = 0; r = __builtin_amdgcn_cvt_pk_fp8_f32(a, b, r, false); r = __builtin_amdgcn_cvt_pk_fp8_f32(c, d, r, true); return (unsigned)r; }
__device__ __forceinline__ float bf_lo(unsigned w) { return __uint_as_float(w << 16); }
__device__ __forceinline__ float bf_hi(unsigned w) { return __uint_as_float(w & 0xffff0000u); }
__device__ __forceinline__ float fast_sigmoid(float z) { return __builtin_amdgcn_rcpf(1.0f + __builtin_amdgcn_exp2f(-1.4426950408889634f * z)); }
__device__ __forceinline__ f32x4 swiglu4(const f32x4 g, const f32x4 u, const float c1, const float rs2) {
    const f32x4 t = g * c1; f32x4 e;
#pragma unroll
    for (int i = 0; i < 4; ++i) e[i] = __builtin_amdgcn_exp2f(t[i]);
    const f32x4 d = e + 1.0f; f32x4 r;
#pragma unroll
    for (int i = 0; i < 4; ++i) r[i] = __builtin_amdgcn_rcpf(d[i]);
    return (g * u) * (r * rs2);
}
constexpr float RMS_EPS = 1e-6f;
__device__ __forceinline__ float rstd16(const float* ssp, int row) { const f32x4* p = (const f32x4*)(ssp + (size_t)row * 16); const f32x4 a = p[0], b = p[1], c = p[2], d = p[3];
    const float s = (((a[0] + a[1]) + (a[2] + a[3])) + ((b[0] + b[1]) + (b[2] + b[3]))) + (((c[0] + c[1]) + (c[2] + c[3])) + ((d[0] + d[1]) + (d[2] + d[3])));
    return __builtin_amdgcn_rsqf(s * (1.0f / 1024.0f) + RMS_EPS); }

__device__ __forceinline__ void rstd8(const float* ssp, int row0, int fq, float (&rs)[8]) {
    f32x4 p[8];
#pragma unroll
    for (int i = 0; i < 8; ++i) p[i] = *(const f32x4*)(ssp + (size_t)(row0 + (i >> 2) * HALF + (i & 3) * 16) * 16 + 4 * fq);
#pragma unroll
    for (int i = 0; i < 8; ++i) { float q = (p[i][0] + p[i][1]) + (p[i][2] + p[i][3]); q += __shfl_xor(q, 16); q += __shfl_xor(q, 32); rs[i] = __builtin_amdgcn_rsqf(q * (1.0f / 1024.0f) + RMS_EPS); }
}
__device__ __forceinline__ u32x4 pack8(const f32x4 v0, const f32x4 v1) { u32x4 w; w.x = cvt_pk_bf16(v0[0], v0[1]); w.y = cvt_pk_bf16(v0[2], v0[3]); w.z = cvt_pk_bf16(v1[0], v1[1]); w.w = cvt_pk_bf16(v1[2], v1[3]); return w; }

struct EpiInProj0 {
    static constexpr bool PERM = true, AFTER_DRAIN = false;
    const float* ss; bf16_t* uext; bf16_t* qkv; float qscale;
    __device__ __forceinline__ void operator()(const f32x4 (&acc)[2][2][4][2], const Unit& u, int wr, int wc, int fr, int fq) const {
        const int row0 = u.pm * BM + wr * 64 + fr; float rsa[8]; rstd8(ss, row0, fq, rsa);
#pragma unroll
        for (int ai = 0; ai < 2; ++ai)
#pragma unroll
            for (int m = 0; m < 4; ++m) { const int row = row0 + ai * HALF + m * 16; const float rs = rsa[ai * 4 + m];
#pragma unroll
                for (int bj = 0; bj < 2; ++bj) { const int col0 = u.pn * BM + bj * HALF + wc * 32 + 8 * fq;
                    float sc = rs; bf16_t* dst;
                    if (u.pn < 2) dst = uext + ((size_t)(col0 >> 4) * 512 + (row >> 5)) * 640 + (row & 31) * 16 + (col0 & 15);
                    else { const int c = col0 - 512; if (c < 512) sc *= qscale; dst = qkv + (size_t)row * 1536 + c; }
                    *(u32x4*)dst = pack8(acc[ai][bj][m][0] * sc, acc[ai][bj][m][1] * sc); } }
    }
};
struct EpiS5State {
    static constexpr bool PERM = false, AFTER_DRAIN = false;
    float* sloc;
    __device__ __forceinline__ void operator()(const f32x4 (&acc)[2][2][4][2], const Unit& u, int wr, int wc, int fr, int fq) const {
        const int row0 = u.pm * BM + wr * 64 + fr, col0 = wc * 32 + 4 * fq;
#pragma unroll
        for (int ai = 0; ai < 2; ++ai)
#pragma unroll
            for (int m = 0; m < 4; ++m) { float* rowp = sloc + ((size_t)u.zb * 512 + row0 + ai * HALF + m * 16) * 128 + col0;
#pragma unroll
                for (int n = 0; n < 2; ++n) *(f32x4*)(rowp + n * 16) = acc[ai][0][m][n]; }
    }
};
__device__ __forceinline__ float gelu_tanh(float x) { const float a = x * (1.0f + 0.044715f * x * x); return x * __builtin_amdgcn_rcpf(1.0f + __builtin_amdgcn_exp2f(-2.302208198f * a)); }
struct EpiS5Y {
    static constexpr bool PERM = true, AFTER_DRAIN = false;
    bf16_t* yg;
    __device__ __forceinline__ void operator()(const f32x4 (&acc)[2][2][4][2], const Unit& u, int wr, int wc, int fr, int fq) const {
        const int row0 = u.pm * BM + wr * 64 + fr;
#pragma unroll
        for (int ai = 0; ai < 2; ++ai)
#pragma unroll
            for (int m = 0; m < 4; ++m) { const int chunk = row0 + ai * HALF + m * 16;
#pragma unroll
                for (int bj = 0; bj < 2; ++bj) { const int col0 = u.pn * BM + bj * HALF + wc * 32 + 8 * fq; const int i = col0 >> 4, h0 = col0 & 15;
                    f32x4 v0 = acc[ai][bj][m][0], v1 = acc[ai][bj][m][1];
#pragma unroll
                    for (int e = 0; e < 4; ++e) { v0[e] = gelu_tanh(v0[e]); v1[e] = gelu_tanh(v1[e]); }
                    *(u32x4*)(yg + ((size_t)chunk * 32 + i) * 512 + u.zb * 16 + h0) = pack8(v0, v1); } }
    }
};
struct EpiGlu {
    static constexpr bool PERM = true, AFTER_DRAIN = false;
    const bf16_t* yg; const float* bias; bf16_t* mix;
    __device__ __forceinline__ void operator()(const f32x4 (&acc)[2][2][4][2], const Unit& u, int wr, int wc, int fr, int fq) const {
        const int row0 = u.pm * BM + wr * 64 + fr; u32x4 ywa[2][8];
#pragma unroll
        for (int bj = 0; bj < 2; ++bj)
#pragma unroll
            for (int i = 0; i < 8; ++i) ywa[bj][i] = *(const u32x4*)(yg + (size_t)(row0 + (i >> 2) * HALF + (i & 3) * 16) * 512 + u.pn * BM + bj * HALF + wc * 32 + 8 * fq);
#pragma unroll
        for (int bj = 0; bj < 2; ++bj) { const int col0 = u.pn * BM + bj * HALF + wc * 32 + 8 * fq;
            const f32x4 b0 = *(const f32x4*)(bias + col0), b1 = *(const f32x4*)(bias + col0 + 4);
#pragma unroll
            for (int ai = 0; ai < 2; ++ai)
#pragma unroll
                for (int m = 0; m < 4; ++m) { const int row = row0 + ai * HALF + m * 16;
                    const u32x4 yw = ywa[bj][ai * 4 + m];
                    f32x4 z0 = acc[ai][bj][m][0] + b0, z1 = acc[ai][bj][m][1] + b1, o0, o1;
                    o0[0] = bf_lo(yw.x) * fast_sigmoid(z0[0]); o0[1] = bf_hi(yw.x) * fast_sigmoid(z0[1]); o0[2] = bf_lo(yw.y) * fast_sigmoid(z0[2]); o0[3] = bf_hi(yw.y) * fast_sigmoid(z0[3]);
                    o1[0] = bf_lo(yw.z) * fast_sigmoid(z1[0]); o1[1] = bf_hi(yw.z) * fast_sigmoid(z1[1]); o1[2] = bf_lo(yw.w) * fast_sigmoid(z1[2]); o1[3] = bf_hi(yw.w) * fast_sigmoid(z1[3]);
                    *(u32x4*)(mix + (size_t)row * 1024 + col0) = pack8(o0, o1); } }
    }
};
template <bool XBOUT> struct EpiResid {
    static constexpr bool PERM = false, AFTER_DRAIN = false;
    const float* R; float* X; bf16_t* xb; float* ssq; unsigned char* xq = nullptr;
    __device__ __forceinline__ void operator()(const f32x4 (&acc)[2][2][4][2], const Unit& u, int wr, int wc, int fr, int fq) const {
        const int row0 = u.pm * BM + wr * 64 + fr, col0 = u.pn * BM + wc * 32 + 4 * fq;
#pragma unroll
        for (int ai = 0; ai < 2; ++ai) {
            f32x4 rv[4][2][2];
#pragma unroll
            for (int m = 0; m < 4; ++m)
#pragma unroll
                for (int bj = 0; bj < 2; ++bj)
#pragma unroll
                    for (int n = 0; n < 2; ++n) rv[m][bj][n] = *(const f32x4*)(R + (size_t)(row0 + ai * HALF + m * 16) * 1024 + col0 + bj * HALF + n * 16);
            asm volatile("" ::: "memory");
#pragma unroll
            for (int m = 0; m < 4; ++m) { const int row = row0 + ai * HALF + m * 16; const size_t off = (size_t)row * 1024 + col0; float s = 0.f;
#pragma unroll
                for (int bj = 0; bj < 2; ++bj)
#pragma unroll
                    for (int n = 0; n < 2; ++n) { const f32x4 x = rv[m][bj][n] + acc[ai][bj][m][n];
                        *(f32x4*)(X + off + bj * HALF + n * 16) = x; s += (x[0] * x[0] + x[1] * x[1]) + (x[2] * x[2] + x[3] * x[3]);
                        if (XBOUT) { u32x2 w; w.x = cvt_pk_bf16(x[0], x[1]); w.y = cvt_pk_bf16(x[2], x[3]); *(u32x2*)(xb + off + bj * HALF + n * 16) = w;
                            if (xq) *(unsigned*)(xq + off + bj * HALF + n * 16) = pk_fp8x4(x[0], x[1], x[2], x[3]); } }
                s += __shfl_xor(s, 16); s += __shfl_xor(s, 32);
                if (XBOUT && fq == 0) ssq[(size_t)row * 16 + u.pn * 4 + wc] = s; }
            asm volatile("" ::: "memory"); }
    }
};
template <bool RS_IS_SSQ> struct EpiSwiGlu {
    static constexpr bool PERM = true, AFTER_DRAIN = false;
    const float* rsv; bf16_t* H; int ldh;
    __device__ __forceinline__ void operator()(const f32x4 (&acc)[2][2][4][2], const Unit& u, int wr, int wc, int fr, int fq) const {
        const int row0 = u.pm * BM + wr * 64 + fr, col0 = u.pn * HALF + wc * 32 + 8 * fq; float rsa[8];
        if (RS_IS_SSQ) rstd8(rsv, row0, fq, rsa);
        else {
#pragma unroll
            for (int i = 0; i < 8; ++i) rsa[i] = rsv[row0 + (i >> 2) * HALF + (i & 3) * 16]; }
#pragma unroll
        for (int ai = 0; ai < 2; ++ai)
#pragma unroll
            for (int m = 0; m < 4; ++m) { const int row = row0 + ai * HALF + m * 16; const float rs = rsa[ai * 4 + m], c1 = -1.4426950408889634f * rs, rs2 = rs * rs;
                f32x4 o[2];
#pragma unroll
                for (int n = 0; n < 2; ++n) o[n] = swiglu4(acc[ai][0][m][n], acc[ai][1][m][n], c1, rs2);
                *(u32x4*)(H + (size_t)row * ldh + col0) = pack8(o[0], o[1]); }
    }
};
struct EpiSwiGluFp8 {
    static constexpr bool PERM = true, AFTER_DRAIN = false;
    const float* rsv; unsigned char* H; int ldh;
    __device__ __forceinline__ void operator()(const f32x4 (&acc)[2][2][4][2], const Unit& u, int wr, int wc, int fr, int fq) const {
        const int row0 = u.pm * BM + wr * 64 + fr, col0 = u.pn * HALF + wc * 32 + 8 * fq; float rsa[8];
#pragma unroll
        for (int i = 0; i < 8; ++i) rsa[i] = rsv[u.pa * BM + wr * 64 + fr + (i >> 2) * HALF + (i & 3) * 16];
#pragma unroll
        for (int ai = 0; ai < 2; ++ai)
#pragma unroll
            for (int m = 0; m < 4; ++m) { const int row = row0 + ai * HALF + m * 16; const float rs = rsa[ai * 4 + m], c1 = -1.4426950408889634f * rs, rs2 = rs * rs;
                f32x4 o[2];
#pragma unroll
                for (int n = 0; n < 2; ++n) o[n] = swiglu4(acc[ai][0][m][n], acc[ai][1][m][n], c1, rs2);
                u32x2 w; w.x = pk_fp8x4(o[0][0], o[0][1], o[0][2], o[0][3]); w.y = pk_fp8x4(o[1][0], o[1][1], o[1][2], o[1][3]);
                *(u32x2*)(H + (size_t)row * ldh + col0) = w; }
    }
};
struct EpiInProj1 {
    static constexpr bool PERM = true, AFTER_DRAIN = false;
    const float* ss; bf16_t* qkv; float qscale;
    unsigned* kn;
    __device__ __forceinline__ void operator()(const f32x4 (&acc)[2][2][4][2], const Unit& u, int wr, int wc, int fr, int fq) const {
        const int row0 = u.pm * BM + wr * 64 + fr; const float qs = (u.pn < 4) ? qscale : 1.0f; float rsa[8]; rstd8(ss, row0, fq, rsa);
#pragma unroll
        for (int ai = 0; ai < 2; ++ai)
#pragma unroll
            for (int m = 0; m < 4; ++m) { const int row = row0 + ai * HALF + m * 16; const float sc = rsa[ai * 4 + m] * qs;
#pragma unroll
                for (int bj = 0; bj < 2; ++bj) { const int col0 = (u.pn & 3) * BM + bj * HALF + wc * 32 + 8 * fq;
                    const f32x4 v0 = acc[ai][bj][m][0] * sc, v1 = acc[ai][bj][m][1] * sc;
                    *(u32x4*)(qkv + (size_t)(u.pn >> 2) * (16384 * 1024) + (size_t)row * 1024 + col0) = pack8(v0, v1);
                    if ((u.pn >> 2) == 1) {
                        float q = ((v0[0] * v0[0] + v0[1] * v0[1]) + (v0[2] * v0[2] + v0[3] * v0[3])) + ((v1[0] * v1[0] + v1[1] * v1[1]) + (v1[2] * v1[2] + v1[3] * v1[3]));
                        q += __shfl_xor(q, 16); q += __shfl_xor(q, 32);
                        q = fmaxf(q, __shfl_xor(q, 1)); q = fmaxf(q, __shfl_xor(q, 2)); q = fmaxf(q, __shfl_xor(q, 4)); q = fmaxf(q, __shfl_xor(q, 8));
                        if (fr == 0 && fq == 0) { const int head = (u.pn & 3) * 4 + bj * 2 + (wc >> 1), bb = row >> 13, tile = (row & 8191) >> 6;
                            atomicMax(kn + ((size_t)(bb * 16 + head) * 128 + tile) * 2 + (wc & 1), __float_as_uint(q * 1.01f)); } } } }
    }
};
struct EpiStoreBf16 {
    static constexpr bool PERM = true, AFTER_DRAIN = false;
    bf16_t* O; int ldc;
    __device__ __forceinline__ void operator()(const f32x4 (&acc)[2][2][4][2], const Unit& u, int wr, int wc, int fr, int fq) const {
        const int row0 = u.pm * BM + wr * 64 + fr;
#pragma unroll
        for (int ai = 0; ai < 2; ++ai)
#pragma unroll
            for (int m = 0; m < 4; ++m) { const int row = row0 + ai * HALF + m * 16;
#pragma unroll
                for (int bj = 0; bj < 2; ++bj) { const int col0 = u.pn * BM + bj * HALF + wc * 32 + 8 * fq;
                    *(u32x4*)(O + (size_t)row * ldc + col0) = pack8(acc[ai][bj][m][0], acc[ai][bj][m][1]); } }
    }
};

struct EpiStoreQuad {
    static constexpr bool PERM = true, AFTER_DRAIN = false;
    bf16_t* O; int ldc;
    __device__ __forceinline__ void operator()(const f32x4 (&acc)[2][2][4][2], const Unit& u, int wr, int wc, int fr, int fq) const {
        const int row0 = u.pm * BM + u.qa * HALF + wr * 64 + fr, col0 = u.pn * BM + u.qb * HALF + wc * 32 + 8 * fq;
#pragma unroll
        for (int m = 0; m < 4; ++m) *(u32x4*)(O + (size_t)(row0 + m * 16) * ldc + col0) = pack8(acc[0][0][m][0], acc[0][0][m][1]);
    }
};

typedef float f32x2z __attribute__((ext_vector_type(2)));
__device__ __forceinline__ f32x4 zero4_b64() { f32x2z a, b; asm volatile("v_mov_b64 %0, 0" : "=v"(a)); asm volatile("v_mov_b64 %0, 0" : "=v"(b)); return (f32x4){a[0], a[1], b[0], b[1]}; }
template <bool F8> struct Frag { bf16x8 k[2]; };
template <> struct Frag<true> { v8i_t v; };
template <class Epi, class Sched, bool ALIGN_EPI = false, bool SP2 = false, bool FP8 = false, bool QUAD = false>
__device__ __forceinline__ void gemm_phase(PG8_LAS unsigned char* lds, const Gemm g, const Sched& S, const Epi& E) {
    int tid_ = threadIdx.x; asm volatile("" : "+v"(tid_));
    const int tid = tid_, wid = __builtin_amdgcn_readfirstlane(tid >> 6), lane = tid & 63, wr = wid >> 2, wc = wid & 3, fr = lane & 15, fq = lane >> 4;
    const int K = g.K, nt = K / BK;
    unsigned voffA[2], voffB[2];
#pragma unroll
    for (int i = 0; i < 2; ++i) { int R, C; stage_rc(tid * 16 + i * 8192, R, C); const int Rb = Epi::PERM ? ((R & ~31) + perm32(R & 31)) : R;
        voffA[i] = (unsigned)(R * g.lda + C) * 2u; voffB[i] = (unsigned)(Rb * g.ldb + C) * 2u; }
    const size_t kstep = (size_t)(BK * 2);
    const size_t hstepA = (size_t)HALF * g.lda * 2, hstepB = (size_t)HALF * g.ldb * 2;
    const size_t tstepA = 2 * hstepA, tstepB = 2 * hstepB;
    const unsigned ldsw = (unsigned)wid * 1024u;
    const int aoff = lds_byte(wr * 64 + fr, fq * 8), boff = lds_byte(wc * 32 + fr, fq * 8);
#define PG8_SA(b, h) (((b) * 2 + (h)) * HTB)
#define PG8_SB(b, h) ((4 + (b) * 2 + (h)) * HTB)
#define PG8_STAGE(bufoff, gbase, voff) do { _Pragma("unroll") for (int _i = 0; _i < 2; ++_i) \
        __builtin_amdgcn_global_load_lds((const unsigned*)((const char*)(gbase) + (voff)[_i]), (PG8_LAS unsigned*)(lds + (bufoff) + ldsw + _i * 8192), 16, 0, 0); } while (0)
    const PG8_LAS unsigned char* ldsA_ = lds + aoff; const PG8_LAS unsigned char* ldsB_ = lds + 4 * HTB + boff; asm volatile("" : "+v"(ldsA_), "+v"(ldsB_));
#define PG8_RDA(off) (*(const PG8_LAS bf16x8*)(ldsA_ + (off)))
#define PG8_RDB(off) (*(const PG8_LAS bf16x8*)(ldsB_ + (off)))
#define PG8_LDA(dst, b, h) do { _Pragma("unroll") for (int m = 0; m < 4; ++m) { if constexpr (FP8) dst[m].v = cat8(PG8_RDA(PG8_SA(b, h) + m * 2048), PG8_RDA(PG8_SA(b, h) + m * 2048 + 1024)); \
        else { dst[m].k[0] = PG8_RDA(PG8_SA(b, h) + m * 2048); dst[m].k[1] = PG8_RDA(PG8_SA(b, h) + m * 2048 + 1024); } } } while (0)
#define PG8_LDB(dst, b, h) do { _Pragma("unroll") for (int n = 0; n < 2; ++n) { if constexpr (FP8) dst[n].v = cat8(PG8_RDB(PG8_SB(b, h) - 4 * HTB + n * 2048), PG8_RDB(PG8_SB(b, h) - 4 * HTB + n * 2048 + 1024)); \
        else { dst[n].k[0] = PG8_RDB(PG8_SB(b, h) - 4 * HTB + n * 2048); dst[n].k[1] = PG8_RDB(PG8_SB(b, h) - 4 * HTB + n * 2048 + 1024); } } } while (0)
#define PG8_MMA(ai, bj, At, Bt) do { if constexpr (!(QUAD && (((ai) | (bj)) != 0))) { __builtin_amdgcn_s_setprio(1); _Pragma("unroll") for (int m = 0; m < 4; ++m) _Pragma("unroll") for (int n = 0; n < 2; ++n) { \
        if constexpr (FP8) { asm volatile("v_mfma_scale_f32_16x16x128_f8f6f4 %0, %1, %2, %0, %3, %4 op_sel_hi:[0,0,0]" : "+v"(acc[ai][bj][m][n]) : "v"(Bt[n].v), "v"(At[m].v), "v"(sclB_), "v"(sclA_)); } \
        else { _Pragma("unroll") for (int k = 0; k < 2; ++k) acc[ai][bj][m][n] = __builtin_amdgcn_mfma_f32_16x16x32_bf16(Bt[n].k[k], At[m].k[k], acc[ai][bj][m][n], 0, 0, 0); } } __builtin_amdgcn_s_setprio(0); } } while (0)
#define PG8_WAIT_V(n) asm volatile("s_waitcnt vmcnt(" #n ")" ::: "memory")
#define PG8_WAIT_L(n) asm volatile("s_waitcnt lgkmcnt(" #n ")" ::: "memory")
#define PG8_BAR __builtin_amdgcn_s_barrier()
#define PG8_SCHED __builtin_amdgcn_sched_barrier(0)
    Unit cur, nxt; int ui = 0;
    if (!S.next(0, cur)) return;
    f32x4 acc[2][2][4][2];
#pragma unroll
    for (int a = 0; a < 2; ++a)
#pragma unroll
        for (int b = 0; b < 2; ++b)
#pragma unroll
            for (int m = 0; m < 4; ++m)
#pragma unroll
                for (int n = 0; n < 2; ++n) acc[a][b][m][n] = zero4_b64();
    Frag<FP8> At[4], B0[2], B1[2];
    int sclB_ = 0x79797979, sclA_ = 0x7f7f7f7f; asm volatile("" : "+v"(sclB_), "+v"(sclA_));
    const char* cA = (const char*)g.A + (size_t)cur.zb * g.zA + (size_t)cur.pa * tstepA + (QUAD ? (size_t)cur.qa * hstepA : 0); const char* cB = (const char*)g.Bt + (size_t)cur.zb * g.zB + (size_t)cur.pn * tstepB + (QUAD ? (size_t)cur.qb * hstepB : 0);
    S.a_ready(cur);
    if constexpr (SP2) {
        PG8_STAGE(PG8_SB(0, 0), cB, voffB); PG8_STAGE(PG8_SB(0, 1), cB + hstepB, voffB); PG8_STAGE(PG8_SA(0, 0), cA, voffA); PG8_STAGE(PG8_SA(0, 1), cA + hstepA, voffA);
        if (wr == 1) PG8_BAR;
        PG8_WAIT_V(2); PG8_BAR;
        PG8_STAGE(PG8_SB(1, 0), cB + kstep, voffB); PG8_STAGE(PG8_SA(1, 0), cA + kstep, voffA); PG8_STAGE(PG8_SB(1, 1), cB + hstepB + kstep, voffB);
        PG8_WAIT_V(6); PG8_BAR;
    } else {
        PG8_STAGE(PG8_SB(0, 0), cB, voffB); PG8_STAGE(PG8_SA(0, 0), cA, voffA); PG8_STAGE(PG8_SB(0, 1), cB + hstepB, voffB); PG8_STAGE(PG8_SA(0, 1), cA + hstepA, voffA);
        if (wr == 1) PG8_BAR;
        PG8_WAIT_V(4); PG8_BAR;
        PG8_STAGE(PG8_SB(1, 0), cB + kstep, voffB); PG8_STAGE(PG8_SA(1, 0), cA + kstep, voffA); PG8_STAGE(PG8_SB(1, 1), cB + hstepB + kstep, voffB);
        PG8_WAIT_V(6); PG8_BAR;
    }
    for (;;) {
        const bool has_next = S.next(ui + 1, nxt);
        const char* nA = has_next ? (const char*)g.A + (size_t)nxt.zb * g.zA + (size_t)nxt.pa * tstepA + (QUAD ? (size_t)nxt.qa * hstepA : 0) : cA; const char* nB = has_next ? (const char*)g.Bt + (size_t)nxt.zb * g.zB + (size_t)nxt.pn * tstepB + (QUAD ? (size_t)nxt.qb * hstepB : 0) : cB;
#pragma unroll 1
        for (int t = 0; t < nt; t += 2) {
            const bool last = (t == nt - 2);
            const char* a1 = cA + (size_t)(t + 1) * kstep;
            const char* a2 = last ? nA : cA + (size_t)(t + 2) * kstep; const char* b2 = last ? nB : cB + (size_t)(t + 2) * kstep;
            const char* a3 = a2 + kstep; const char* b3 = b2 + kstep;
            if (last && has_next) S.a_ready(nxt);
            if constexpr (SP2) {
            PG8_LDB(B0, 0, 0); PG8_LDB(B1, 0, 1); PG8_SCHED; PG8_LDA(At, 0, 0); PG8_STAGE(PG8_SA(1, 1), a1 + hstepA, voffA);
            PG8_WAIT_V(8); PG8_WAIT_L(0); PG8_BAR; PG8_MMA(0, 0, At, B0); PG8_MMA(0, 1, At, B1); PG8_BAR; PG8_SCHED;
            PG8_LDA(At, 0, 1); PG8_STAGE(PG8_SB(0, 0), b2, voffB); PG8_STAGE(PG8_SB(0, 1), b2 + hstepB, voffB); PG8_STAGE(PG8_SA(0, 0), a2, voffA);
            PG8_WAIT_V(8); PG8_WAIT_L(0); PG8_BAR; PG8_MMA(1, 0, At, B0); PG8_MMA(1, 1, At, B1); PG8_BAR; PG8_SCHED;
            PG8_LDB(B0, 1, 0); PG8_LDB(B1, 1, 1); PG8_SCHED; PG8_LDA(At, 1, 0); PG8_STAGE(PG8_SA(0, 1), a2 + hstepA, voffA);
            PG8_WAIT_V(8); PG8_WAIT_L(0); PG8_BAR; PG8_MMA(0, 0, At, B0); PG8_MMA(0, 1, At, B1); PG8_BAR; PG8_SCHED;
            PG8_LDA(At, 1, 1); PG8_STAGE(PG8_SB(1, 0), b3, voffB); PG8_STAGE(PG8_SB(1, 1), b3 + hstepB, voffB); PG8_STAGE(PG8_SA(1, 0), a3, voffA);
            PG8_WAIT_V(8); PG8_WAIT_L(0); PG8_BAR; PG8_MMA(1, 0, At, B0); PG8_MMA(1, 1, At, B1); PG8_BAR; PG8_SCHED;
            } else {
            PG8_LDB(B0, 0, 0); PG8_SCHED; PG8_LDA(At, 0, 0); PG8_STAGE(PG8_SA(1, 1), a1 + hstepA, voffA);
            PG8_WAIT_L(8); PG8_BAR; PG8_WAIT_L(0); PG8_MMA(0, 0, At, B0); PG8_BAR; PG8_SCHED;
            PG8_LDB(B1, 0, 1); PG8_STAGE(PG8_SB(0, 0), b2, voffB);
            PG8_BAR; PG8_WAIT_L(0); PG8_MMA(0, 1, At, B1); PG8_BAR;
            PG8_LDA(At, 0, 1); PG8_STAGE(PG8_SA(0, 0), a2, voffA);
            PG8_BAR; PG8_WAIT_L(0); PG8_MMA(1, 0, At, B0); PG8_BAR; PG8_SCHED;
            PG8_STAGE(PG8_SB(0, 1), b2 + hstepB, voffB);
            PG8_WAIT_V(6); PG8_BAR; PG8_MMA(1, 1, At, B1); PG8_BAR;
            PG8_LDB(B0, 1, 0); PG8_SCHED; PG8_LDA(At, 1, 0); PG8_STAGE(PG8_SA(0, 1), a2 + hstepA, voffA);
            PG8_WAIT_L(8); PG8_BAR; PG8_WAIT_L(0); PG8_MMA(0, 0, At, B0); PG8_BAR; PG8_SCHED;
            PG8_LDB(B1, 1, 1); PG8_STAGE(PG8_SB(1, 0), b3, voffB);
            PG8_BAR; PG8_WAIT_L(0); PG8_MMA(0, 1, At, B1); PG8_BAR;
            PG8_LDA(At, 1, 1); PG8_STAGE(PG8_SA(1, 0), a3, voffA);
            PG8_BAR; PG8_WAIT_L(0); PG8_MMA(1, 0, At, B0); PG8_BAR; PG8_SCHED;
            PG8_STAGE(PG8_SB(1, 1), b3 + hstepB, voffB);
            PG8_WAIT_V(6); PG8_BAR; PG8_MMA(1, 1, At, B1); PG8_BAR;
            }
        }
        if constexpr (ALIGN_EPI) { if (wr == 0) PG8_BAR; }
        if constexpr (FP8) asm volatile("s_nop 15\n\ts_nop 15" ::: "memory");
        if constexpr (!Epi::AFTER_DRAIN) { int fr_ = fr, fq_ = fq; asm volatile("" : "+v"(fr_), "+v"(fq_));
            E(acc, cur, wr, wc, fr_, fq_); S.done(cur); }
        if (!has_next) break;
#pragma unroll
        for (int a = 0; a < 2; ++a)
#pragma unroll
            for (int b = 0; b < 2; ++b)
#pragma unroll
                for (int m = 0; m < 4; ++m)
#pragma unroll
                    for (int n = 0; n < 2; ++n) acc[a][b][m][n] = zero4_b64();
        cur = nxt; cA = nA; cB = nB; ++ui;
        if constexpr (ALIGN_EPI) { if (wr == 1) PG8_BAR; }
    }
    PG8_WAIT_V(0);
    if constexpr (!ALIGN_EPI) { if (wr == 0) PG8_BAR; }
    PG8_BAR;
    if constexpr (Epi::AFTER_DRAIN) { E.fused(acc, cur, wr, wc, fr, fq, lds, wid, lane); S.done(cur); }
#undef PG8_SA
#undef PG8_SB
#undef PG8_STAGE
#undef PG8_LDA
#undef PG8_RDA
#undef PG8_RDB
#undef PG8_LDB
#undef PG8_MMA
#undef PG8_WAIT_V
#undef PG8_WAIT_L
#undef PG8_BAR
#undef PG8_SCHED
}
}

#include <hip/hip_bf16.h>
#include <cmath>
namespace attn_body {
using bf16=__hip_bfloat16;
using bf16x8=__attribute__((ext_vector_type(8)))short;
using s16x4=__attribute__((ext_vector_type(4)))short;
using f32x16=__attribute__((ext_vector_type(16)))float;
using u32x4=__attribute__((ext_vector_type(4)))unsigned;
constexpr int BATCH=2,NHEAD=16,SEQ=8192,D=64,DM=NHEAD*D;
constexpr int NW=8,QBLK=32,QB=QBLK*NW,KVBLK=64,NQB=SEQ/QB;
constexpr int ATTN_PITCH=DM, ATTN_UNIT_ROWS=QB;
__device__ __forceinline__ int crow(int r,int hi){return (r&3)+8*(r>>2)+4*hi;}
#define SBAR() __builtin_amdgcn_sched_barrier(0)
__device__ __forceinline__ void cmask(f32x16&p0,f32x16&p1,int jb,int qrel,int hi){
  const float NEG=-INFINITY; int kb=64*jb+4*hi;
  #pragma unroll
  for(int r=0;r<16;++r){int kv=kb+(r&3)+8*(r>>2); if(kv>qrel)p0[r]=NEG; if(kv+32>qrel)p1[r]=NEG;}
}

constexpr int NSLOT=3, SLOTB=8192;
constexpr int LDS_K=0, LDS_V=NSLOT*SLOTB, LDS_WS=2*NSLOT*SLOTB, LDS_OST=LDS_WS+NW*64*4, LDS_NB=LDS_OST+NW*4096  , LDS_PK=LDS_NB+32768+64  , LDS_BYTES=LDS_PK+1024;
constexpr float C2=0.125f*1.4426950408889634f;
__device__ __forceinline__ void glds16(const void*gsrc,unsigned lds_dst){unsigned keep;
  asm volatile("s_mov_b32 %0, m0\n\ts_mov_b32 m0, %2\n\ts_nop 0\n\tglobal_load_lds_dwordx4 %1, off\n\ts_mov_b32 m0, %0":"=&s"(keep):"v"(gsrc),"s"(lds_dst):"memory");}
__device__ __forceinline__ float max3f(float a,float b,float c){float r;asm("v_max3_f32 %0, %1, %2, %3":"=v"(r):"v"(a),"v"(b),"v"(c));return r;}
__device__ __forceinline__ float max2f(float a,float b){float r;asm("v_max_f32_e32 %0, %1, %2":"=v"(r):"v"(a),"v"(b));return r;}
__device__ __forceinline__ float fadd_s(float a,float b){float r;asm("v_add_f32_e32 %0, %1, %2":"=v"(r):"v"(a),"v"(b));return r;}
__device__ __forceinline__ float fsub_s(float a,float b){float r;asm("v_sub_f32_e32 %0, %1, %2":"=v"(r):"v"(a),"v"(b));return r;}
typedef float f32x2_t __attribute__((ext_vector_type(2))); typedef __bf16 bf16x2_t __attribute__((ext_vector_type(2)));
__device__ __forceinline__ unsigned cvtpk_s(float lo,float hi){f32x2_t v={lo,hi};bf16x2_t b=__builtin_convertvector(v,bf16x2_t);return __builtin_bit_cast(unsigned,b);}
#define WAIT_BAR(N) asm volatile("s_waitcnt vmcnt(" #N ") lgkmcnt(0)\n\ts_barrier":::"memory")

__device__ __forceinline__ void qkt(f32x16&p0,f32x16&p1,const char*Kslot,const bf16x8*qr,const f32x16&negm,int r32,int hi){
  const char*kb=Kslot+hi*1024+r32*16;
  #pragma unroll
  for(int d0=0;d0<4;++d0){
    const bf16x8 b0=*reinterpret_cast<const bf16x8*>(kb+d0*2048);
    const bf16x8 b1=*reinterpret_cast<const bf16x8*>(kb+d0*2048+512);
    if(d0==0){p0=__builtin_amdgcn_mfma_f32_32x32x16_bf16(b0,qr[0],negm,0,0,0);p1=__builtin_amdgcn_mfma_f32_32x32x16_bf16(b1,qr[0],negm,0,0,0);}
    else{p0=__builtin_amdgcn_mfma_f32_32x32x16_bf16(b0,qr[d0],p0,0,0,0);p1=__builtin_amdgcn_mfma_f32_32x32x16_bf16(b1,qr[d0],p1,0,0,0);}}
}
typedef __attribute__((address_space(3))) const char* lds_cptr;
typedef short v4i16_t __attribute__((ext_vector_type(4)));
__device__ __forceinline__ void kload8(bf16x8*kf,lds_cptr kp){
  kf[0]=*(const __attribute__((address_space(3))) bf16x8*)(kp);      kf[1]=*(const __attribute__((address_space(3))) bf16x8*)(kp+512);
  kf[2]=*(const __attribute__((address_space(3))) bf16x8*)(kp+2048); kf[3]=*(const __attribute__((address_space(3))) bf16x8*)(kp+2560);
  kf[4]=*(const __attribute__((address_space(3))) bf16x8*)(kp+4096); kf[5]=*(const __attribute__((address_space(3))) bf16x8*)(kp+4608);
  kf[6]=*(const __attribute__((address_space(3))) bf16x8*)(kp+6144); kf[7]=*(const __attribute__((address_space(3))) bf16x8*)(kp+6656);
}
__device__ __forceinline__ void kload2(bf16x8*kf,lds_cptr kp,int j){ kf[2*j]=*(const __attribute__((address_space(3))) bf16x8*)(kp+j*2048); kf[2*j+1]=*(const __attribute__((address_space(3))) bf16x8*)(kp+j*2048+512); }
__device__ __forceinline__ s16x4 vtr(lds_cptr p){ return __builtin_bit_cast(s16x4,__builtin_amdgcn_ds_read_tr16_b64_v4i16((__attribute__((address_space(3))) v4i16_t*)p)); }
__device__ __forceinline__ float rowmax(const f32x16&p0,const f32x16&p1){
  float a=max3f(p0[0],p0[1],p1[0]),b=max3f(p0[2],p0[3],p1[1]);a=max3f(a,p1[2],p1[3]);
  #pragma unroll
  for(int r=4;r<16;r+=4){a=max3f(a,p0[r],p0[r+1]);b=max3f(b,p0[r+2],p0[r+3]);a=max3f(a,p1[r],p1[r+1]);b=max3f(b,p1[r+2],p1[r+3]);}
  const float m=max2f(a,b);
  auto rr=__builtin_amdgcn_permlane32_swap(__float_as_uint(m),__float_as_uint(m),false,false);
  return max2f(__uint_as_float(rr[0]),__uint_as_float(rr[1]));
}
__device__ __forceinline__ void pv(f32x16*o,int vb,bf16x8 pa0,bf16x8 pa1,bf16x8 pa2,bf16x8 pa3){
  #pragma unroll
  for(int d0=0;d0<2;++d0){s16x4 lo[4],hi[4];
    #pragma unroll
    for(int ks=0;ks<4;++ks){
      asm volatile("ds_read_b64_tr_b16 %0,%1 offset:%c2":"=&v"(lo[ks]):"v"(vb),"i"(d0*4096+ks*1024):"memory");
      asm volatile("ds_read_b64_tr_b16 %0,%1 offset:%c2":"=&v"(hi[ks]):"v"(vb),"i"(d0*4096+ks*1024+512):"memory");}
    asm volatile("s_waitcnt lgkmcnt(0)":::"memory");SBAR();
    #define PK(k) (bf16x8){lo[k][0],lo[k][1],lo[k][2],lo[k][3],hi[k][0],hi[k][1],hi[k][2],hi[k][3]}
    o[d0]=__builtin_amdgcn_mfma_f32_32x32x16_bf16(pa0,PK(0),o[d0],0,0,0);
    o[d0]=__builtin_amdgcn_mfma_f32_32x32x16_bf16(pa1,PK(1),o[d0],0,0,0);
    o[d0]=__builtin_amdgcn_mfma_f32_32x32x16_bf16(pa2,PK(2),o[d0],0,0,0);
    o[d0]=__builtin_amdgcn_mfma_f32_32x32x16_bf16(pa3,PK(3),o[d0],0,0,0);
    #undef PK
  }
}

typedef float f32x4_t __attribute__((ext_vector_type(4)));
__device__ __forceinline__ void fox_negcum(const float*logf,__attribute__((address_space(3))) float*ncum,__attribute__((address_space(3))) float*wtot,int tid){
  float loc[16];float s=0.f; const f32x4_t*lp=(const f32x4_t*)(logf+tid*16);
  #pragma unroll
  for(int j=0;j<4;++j){const f32x4_t v=lp[j]; s+=v[0];loc[4*j]=s; s+=v[1];loc[4*j+1]=s; s+=v[2];loc[4*j+2]=s; s+=v[3];loc[4*j+3]=s;}
  float inc=s;
  #pragma unroll
  for(int o=1;o<64;o<<=1){const float v=__shfl_up(inc,o); if((tid&63)>=o)inc+=v;}
  if((tid&63)==63)wtot[tid>>6]=inc;
  __syncthreads();
  float base=inc-s; for(int w=0;w<(tid>>6);++w)base+=wtot[w];
  #pragma unroll
  for(int j=0;j<4;++j){ f32x4_t o4; o4[0]=-(base+loc[4*j]);o4[1]=-(base+loc[4*j+1]);o4[2]=-(base+loc[4*j+2]);o4[3]=-(base+loc[4*j+3]); *(__attribute__((address_space(3))) f32x4_t*)(ncum+tid*16+4*j)=o4; }
  __syncthreads();
}
#ifndef ATTN_STORE16
#define ATTN_STORE16(p,v) (*(u32x4*)(p)=(v))
#endif
template<int THRL> __device__ __forceinline__ void attn_unit(int b,int h,int qb,const bf16*Q,const bf16*__restrict__ K,const bf16*__restrict__ V,bf16*O,char*shm,const float*logf_bh,const unsigned*kn_bh,unsigned char*O8=nullptr){
  int tid_=threadIdx.x; asm volatile("":"+v"(tid_)); const int tid=tid_,lane=tid&63,r32=lane&31,hi=lane>>5; const int wid=__builtin_amdgcn_readfirstlane(tid>>6);
  const long rowbase=(long)b*SEQ; const int q0=qb*QB;
  const bf16*Qw=Q+(rowbase+q0+wid*QBLK)*DM+h*D;
  const bf16*Kh=K+rowbase*DM+h*D,*Vh=V+rowbase*DM+h*D;
  const unsigned lds0=(unsigned)(uintptr_t)shm;
  float*wsf=(float*)(shm+LDS_WS)+wid*64;
  const bf16*ksrc=Kh+(long)lane*DM+wid*8;
  const bf16*vsrc=Vh+(long)(16*(wid&3)+(lane>>2))*DM+(wid>>2)*32+(lane&3)*8;
  const unsigned kdst=lds0+LDS_K+wid*1024, vdst=lds0+LDS_V+wid*1024;
  #define TIDX(t) (NTR-1-(t))
  #define DMA_K(t,slot) glds16(ksrc+(long)TIDX(t)*KVBLK*DM,(unsigned)__builtin_amdgcn_readfirstlane(kdst+(slot)))
  #define DMA_V(t,slot) glds16(vsrc+(long)TIDX(t)*KVBLK*DM,(unsigned)__builtin_amdgcn_readfirstlane(vdst+(slot)))
  const int vb0=(int)(lds0+LDS_V)+((lane>>4)&1)*32+(lane&3)*8+(4*hi+((lane&15)>>2))*64;
  const char*Kbase=shm+LDS_K; bf16x8 kf[8];
  const lds_cptr shm3=(lds_cptr)shm; const lds_cptr kp0=shm3+LDS_K+hi*1024+r32*16; const lds_cptr vp0=shm3+LDS_V+((lane>>4)&1)*32+(lane&3)*8+(4*hi+((lane&15)>>2))*64;
  const int NTR=(q0+QB)/KVBLK;
  const lds_cptr shm3b=(lds_cptr)shm;
  const __attribute__((address_space(3))) float* nb3=(const __attribute__((address_space(3))) float*)(shm3b+LDS_NB);
  fox_negcum(logf_bh,(__attribute__((address_space(3))) float*)(shm3b+LDS_NB),(__attribute__((address_space(3))) float*)(shm3b+LDS_NB+32768),tid);
  int NT;
  { __attribute__((address_space(3))) float* PK=(__attribute__((address_space(3))) float*)(shm3b+LDS_PK);
    __attribute__((address_space(3))) int* JX=(__attribute__((address_space(3))) int*)(shm3b+LDS_PK+512);
    float pk=0.f;
    if(tid<128){ const float a=__uint_as_float(kn_bh[2*tid]),c=__uint_as_float(kn_bh[2*tid+1]); pk=__builtin_sqrtf(a+c)*1.001f; }
    #pragma unroll
    for(int o_=1;o_<64;o_<<=1){const float v=__shfl_up(pk,o_); if((tid&63)>=o_)pk=__builtin_fmaxf(pk,v);}
    if(tid==63)PK[128]=pk;
    __syncthreads();
    if(tid>=64&&tid<128)pk=__builtin_fmaxf(pk,PK[128]);
    if(tid<128)PK[tid]=pk;
    const bf16*Krow=Kh+(long)(q0+wid*QBLK+r32)*DM+hi*8; const bf16*Qrow=Qw+(long)r32*DM+hi*8; float qq=0.f,qk=0.f;
    #pragma unroll
    for(int d0=0;d0<4;++d0){ const u32x4 qa=*reinterpret_cast<const u32x4*>(Qrow+d0*16), ka=*reinterpret_cast<const u32x4*>(Krow+d0*16);
      #pragma unroll
      for(int e=0;e<4;++e){ const float q0f=__uint_as_float(qa[e]<<16),q1f=__uint_as_float(qa[e]&0xffff0000u),k0f=__uint_as_float(ka[e]<<16),k1f=__uint_as_float(ka[e]&0xffff0000u);
        qq+=q0f*q0f+q1f*q1f; qk+=q0f*k0f+q1f*k1f; } }
    { auto r1=__builtin_amdgcn_permlane32_swap(__float_as_uint(qq),__float_as_uint(qq),false,false); qq=__uint_as_float(r1[0])+__uint_as_float(r1[1]);
      auto r2=__builtin_amdgcn_permlane32_swap(__float_as_uint(qk),__float_as_uint(qk),false,false); qk=__uint_as_float(r2[0])+__uint_as_float(r2[1]); }
    __syncthreads();
    const float qn=__builtin_sqrtf(qq)*1.001f, thr=qk+nb3[q0+wid*QBLK+r32]-152.f;
    int lo_=0,hi_=NTR;
    #pragma unroll 1
    for(int it=0;it<8;++it){ if(lo_<hi_){ const int mid=(lo_+hi_)>>1; const float f=qn*PK[mid]+nb3[64*mid+63]; if(f>=thr)hi_=mid; else lo_=mid+1; } }
    #pragma unroll
    for(int o_=1;o_<64;o_<<=1){const int v=__shfl_xor(lo_,o_); lo_=v<lo_?v:lo_;}
    if(lane==0)JX[wid]=lo_;
    __syncthreads();
    int j0=JX[0];
    #pragma unroll
    for(int w=1;w<8;++w){const int v=JX[w]; j0=v<j0?v:j0;}
    j0=__builtin_amdgcn_readfirstlane(j0);
    int nte=(NTR-j0+1)&~1; NT=nte<4?4:nte;
    __syncthreads();
  }
  { __attribute__((address_space(3))) float* nbw=(__attribute__((address_space(3))) float*)(shm3b+LDS_NB);
    const float ref_=nbw[q0+QB-1];
    __syncthreads();
    #pragma unroll
    for(int j=0;j<16;++j){ const float v=nbw[tid*16+j]-ref_; const unsigned h_=cvtpk_s(v,0.f)&0xffffu; const float hf_=__uint_as_float(h_<<16); const unsigned l_=cvtpk_s(v-hf_,0.f)&0xffffu;
      ((__attribute__((address_space(3))) unsigned*)nbw)[tid*16+j]=h_|(l_<<16); }
    __syncthreads();
  }
  const __attribute__((address_space(3))) unsigned* nbp=(const __attribute__((address_space(3))) unsigned*)(shm3b+LDS_NB);
  const unsigned mh0=(hi==0)?0xffffffffu:0u, onesm=0x3f803f80u&mh0;
  u32x4 qxw={onesm,0u,0u,0u};
  #define QX_SET() do{ const float nm_=-mhat; const unsigned h_=cvtpk_s(nm_,0.f)&0xffffu; const unsigned l_=cvtpk_s(nm_-__uint_as_float(h_<<16),0.f)&0xffffu; qxw[1]=(h_|(l_<<16))&mh0; }while(0)
  #define KXF(pr) __builtin_bit_cast(bf16x8,(u32x4){(pr)&mh0,onesm,0u,0u})
  #define BIASMMA(C0,C1,t) do{ const unsigned pr0_=nbp[64*TIDX(t)+r32],pr1_=nbp[64*TIDX(t)+32+r32]; \
    C0=__builtin_amdgcn_mfma_f32_32x32x16_bf16(KXF(pr0_),__builtin_bit_cast(bf16x8,qxw),C0,0,0,0); C1=__builtin_amdgcn_mfma_f32_32x32x16_bf16(KXF(pr1_),__builtin_bit_cast(bf16x8,qxw),C1,0,0,0); }while(0)
  DMA_K(0,0);DMA_V(0,0);DMA_K(1,SLOTB);
  bf16x8 qr[4];
  #pragma unroll
  for(int d0=0;d0<4;++d0)qr[d0]=*reinterpret_cast<const bf16x8*>(&Qw[(long)r32*DM+d0*16+hi*8]);
  float mhat=0.f,l_reg=0.f;f32x16 o[2];o[0]=f32x16{};o[1]=f32x16{};const f32x16 negm=f32x16{};
  const int qrel=wid*QBLK+r32;
  #define CMASK(P0,P1,t) do{ if((t)<4){ cmask(P0,P1,3-(t),qrel,hi); } }while(0)
  bool resc=false;
  #define START(P0,P1) do{ const float rm=rowmax(P0,P1); resc=false; \
    { const float dl=(rm>-3.0e38f)?__builtin_ceilf(rm*16.f)*0.0625f:0.f; mhat=fadd_s(mhat,dl);     \
      _Pragma("unroll") for(int r=0;r<16;++r){P0[r]=fsub_s(P0[r],dl);P1[r]=fsub_s(P1[r],dl);} \
      QX_SET(); } \
    _Pragma("unroll") for(int r=0;r<16;++r)P0[r]=__builtin_amdgcn_exp2f(P0[r]); }while(0)
  #define RESC() do{ if(resc){ asm volatile("s_waitcnt lgkmcnt(0)":::"memory"); \
      _Pragma("unroll") for(int d_=0;d_<2;++d_) _Pragma("unroll") for(int r=0;r<16;++r)o[d_][r]*=wsf[crow(r,hi)]; } }while(0)
  f32x16 pA0,pA1,pB0,pB1;
  int sl_prev=0,sl_cur=0,sl_next=SLOTB;
  #define ROT() do{sl_prev=sl_cur;sl_cur=sl_next;sl_next=(sl_next==(NSLOT-1)*SLOTB)?0:sl_next+SLOTB;}while(0)
  DMA_K(2,2*SLOTB);
  WAIT_BAR(3);
  qkt(pA0,pA1,Kbase,qr,negm,r32,hi);BIASMMA(pA0,pA1,0);asm volatile("s_nop 15\n\ts_nop 7":"+v"(pA0),"+v"(pA1));CMASK(pA0,pA1,0);
  START(pA0,pA1);
  _Pragma("unroll") for(int r=0;r<16;++r)pA1[r]=__builtin_amdgcn_exp2f(pA1[r]);
  WAIT_BAR(0);
  DMA_K(3,0);DMA_V(1,SLOTB);
  ROT();
  kload8(kf,kp0+sl_cur);
  WAIT_BAR(2);
  s16x4 vlo[8],vhi[8]; u32x4 pw0,pw1,pw2,pw3;
  #define PKW(P,B) cvtpk_s(P[B],P[B+1])
  #define PAF(k) __builtin_bit_cast(bf16x8,pw##k)
  #define VFR(i) (bf16x8){vlo[i][0],vlo[i][1],vlo[i][2],vlo[i][3],vhi[i][0],vhi[i][1],vhi[i][2],vhi[i][3]}
  #define PIN(x) asm volatile("":"+v"(x))
  #define MX3(a,b,c) __builtin_fmaxf(__builtin_fmaxf((a),(b)),(c))
  #define GAPA(MF,A0,A1,A2,A3,W0,W1,PW) do{ MF; sacc+=A0; sacc+=A1; sacc+=A2; sacc+=A3; PIN(sacc); W0; W1; PIN(PW); SBAR(); }while(0)
  #define EX(v) __builtin_amdgcn_exp2f(v)
  #define GAPB(MF,X,B) do{ MF; X[B]=EX(X[B]); X[B+1]=EX(X[B+1]); X[B+2]=EX(X[B+2]); X[B+3]=EX(X[B+3]); PIN(X); SBAR(); }while(0)
  #define VRD(i) do{ vlo[i]=vtr(vp_+(((i)>>2)*4096+((i)&3)*1024)); vhi[i]=vtr(vp_+(((i)>>2)*4096+((i)&3)*1024+512)); }while(0)
  #define KRD(G,j) do{ if(G){ kload2(kf,kp0+sl_next,j); SBAR(); } }while(0)
  #define STEP(C0,C1,P0,P1,t,GK,GV,GL) do{ SBAR(); \
    const lds_cptr vp_=vp0+sl_prev; \
    VRD(0); SBAR(); float sacc=(P0[0]+P0[1]); \
    GAPA(C0=__builtin_amdgcn_mfma_f32_32x32x16_bf16(kf[0],qr[0],negm,0,0,0), P0[2],P0[3],P0[4],P0[5],     pw0[0]=PKW(P0,0), pw0[1]=PKW(P0,2), pw0); \
    VRD(4); SBAR(); GAPA(C1=__builtin_amdgcn_mfma_f32_32x32x16_bf16(kf[1],qr[0],negm,0,0,0), P0[6],P0[7],P0[8],P0[9],     pw0[2]=PKW(P0,4), pw0[3]=PKW(P0,6), pw0); \
    VRD(1); SBAR(); GAPA(C0=__builtin_amdgcn_mfma_f32_32x32x16_bf16(kf[2],qr[1],C0,0,0,0),   P0[10],P0[11],P0[12],P0[13], pw1[0]=PKW(P0,8), pw1[1]=PKW(P0,10), pw1); \
    VRD(5); SBAR(); GAPA(C1=__builtin_amdgcn_mfma_f32_32x32x16_bf16(kf[3],qr[1],C1,0,0,0),   P0[14],P0[15],P1[0],P1[1],   pw1[2]=PKW(P0,12),pw1[3]=PKW(P0,14), pw1); \
    VRD(2); SBAR(); GAPA(C0=__builtin_amdgcn_mfma_f32_32x32x16_bf16(kf[4],qr[2],C0,0,0,0),   P1[2],P1[3],P1[4],P1[5],     pw2[0]=PKW(P1,0), pw2[1]=PKW(P1,2), pw2); \
    VRD(6); SBAR(); GAPA(C1=__builtin_amdgcn_mfma_f32_32x32x16_bf16(kf[5],qr[2],C1,0,0,0),   P1[6],P1[7],P1[8],P1[9],     pw2[2]=PKW(P1,4), pw2[3]=PKW(P1,6), pw2); \
    VRD(3); SBAR(); GAPA(C0=__builtin_amdgcn_mfma_f32_32x32x16_bf16(kf[6],qr[3],C0,0,0,0),   P1[10],P1[11],P1[12],P1[13], pw3[0]=PKW(P1,8), pw3[1]=PKW(P1,10), pw3); \
    VRD(7); SBAR(); GAPA(C1=__builtin_amdgcn_mfma_f32_32x32x16_bf16(kf[7],qr[3],C1,0,0,0),   P1[14],P1[15],0.f,0.f,       pw3[2]=PKW(P1,12),pw3[3]=PKW(P1,14), pw3); \
    l_reg+=sacc; \
    if(GK){DMA_K((t)+3,sl_cur);} if(GV){DMA_V((t)+1,sl_next);} \
    BIASMMA(C0,C1,t); CMASK(C0,C1,t); \
    { float a=MX3(C0[0],C0[1],C1[0]),b=MX3(C0[2],C0[3],C1[1]); a=MX3(a,C1[2],C1[3]); \
      _Pragma("unroll") for(int r=4;r<16;r+=4){a=MX3(a,C0[r],C0[r+1]);b=MX3(b,C0[r+2],C0[r+3]);a=MX3(a,C1[r],C1[r+1]);b=MX3(b,C1[r+2],C1[r+3]);} \
      float rm=__builtin_fmaxf(a,b); { auto rr=__builtin_amdgcn_permlane32_swap(__float_as_uint(rm),__float_as_uint(rm),false,false); rm=__builtin_fmaxf(__uint_as_float(rr[0]),__uint_as_float(rr[1])); } \
      resc=false; \
      if(__builtin_expect(__any(rm>(float)THRL),0)){ const float dl=__builtin_fmaxf(__builtin_ceilf(rm*16.f)*0.0625f,0.f); mhat+=dl; QX_SET(); \
        _Pragma("unroll") for(int r=0;r<16;++r){C0[r]-=dl;C1[r]-=dl;} \
        const float f=__builtin_amdgcn_exp2f(-dl); l_reg*=f; if(hi==0)wsf[r32]=f; resc=true; } } \
    SBAR(); \
    GAPB(o[0]=__builtin_amdgcn_mfma_f32_32x32x16_bf16(PAF(0),VFR(0),o[0],0,0,0), C0,0); \
    GAPB(o[1]=__builtin_amdgcn_mfma_f32_32x32x16_bf16(PAF(0),VFR(4),o[1],0,0,0), C0,4); \
    KRD(GL,0); GAPB(o[0]=__builtin_amdgcn_mfma_f32_32x32x16_bf16(PAF(1),VFR(1),o[0],0,0,0), C0,8); \
    KRD(GL,1); GAPB(o[1]=__builtin_amdgcn_mfma_f32_32x32x16_bf16(PAF(1),VFR(5),o[1],0,0,0), C0,12); \
    KRD(GL,2); GAPB(o[0]=__builtin_amdgcn_mfma_f32_32x32x16_bf16(PAF(2),VFR(2),o[0],0,0,0), C1,0); \
    KRD(GL,3); GAPB(o[1]=__builtin_amdgcn_mfma_f32_32x32x16_bf16(PAF(2),VFR(6),o[1],0,0,0), C1,4); \
    GAPB(o[0]=__builtin_amdgcn_mfma_f32_32x32x16_bf16(PAF(3),VFR(3),o[0],0,0,0), C1,8); \
    GAPB(o[1]=__builtin_amdgcn_mfma_f32_32x32x16_bf16(PAF(3),VFR(7),o[1],0,0,0), C1,12); \
    }while(0)
  int t=1;
  for(int it_=0;it_<2&&t+5<NT;++it_,t+=2){
    STEP(pB0,pB1,pA0,pA1,t,true,true,true);     WAIT_BAR(2); RESC(); ROT();
    STEP(pA0,pA1,pB0,pB1,t+1,true,true,true);   WAIT_BAR(2); RESC(); ROT();
  }
  #undef CMASK
  #define CMASK(P0,P1,t) do{}while(0)
  for(;t+5<NT;t+=2){
    STEP(pB0,pB1,pA0,pA1,t,true,true,true);     WAIT_BAR(2); RESC(); ROT();
    STEP(pA0,pA1,pB0,pB1,t+1,true,true,true);   WAIT_BAR(2); RESC(); ROT();
  }
  #undef CMASK
  #define CMASK(P0,P1,t) do{ if((t)<4){ cmask(P0,P1,3-(t),qrel,hi); } }while(0)
  #define ENDW(tt) do{ if((tt)+3<NT){WAIT_BAR(2);} else if((tt)+2<NT){WAIT_BAR(1);} else {WAIT_BAR(0);} }while(0)
  for(;t+1<NT;t+=2){
    STEP(pB0,pB1,pA0,pA1,t,(t+3<NT),(t+1<NT),(t+1<NT));       ENDW(t);   RESC(); ROT();
    STEP(pA0,pA1,pB0,pB1,t+1,(t+4<NT),(t+2<NT),(t+2<NT));     ENDW(t+1); RESC(); ROT();
  }
  STEP(pB0,pB1,pA0,pA1,NT-1,false,false,false); RESC();
  { float sacc=pB0[0]+pB0[1]; _Pragma("unroll") for(int r=2;r<16;++r)sacc+=pB0[r]; _Pragma("unroll") for(int r=0;r<16;++r)sacc+=pB1[r]; l_reg+=sacc;
    pw0=(u32x4){PKW(pB0,0),PKW(pB0,2),PKW(pB0,4),PKW(pB0,6)};pw1=(u32x4){PKW(pB0,8),PKW(pB0,10),PKW(pB0,12),PKW(pB0,14)};pw2=(u32x4){PKW(pB1,0),PKW(pB1,2),PKW(pB1,4),PKW(pB1,6)};pw3=(u32x4){PKW(pB1,8),PKW(pB1,10),PKW(pB1,12),PKW(pB1,14)};
    SBAR(); pv(o,vb0+sl_cur,PAF(0),PAF(1),PAF(2),PAF(3)); }
  #undef PKW
  #undef PAF
  #undef VFR
  #undef PIN
  #undef MX3
  #undef GAPA
  #undef GAPB
  #undef EX
  #undef VRD
  #undef KRD
  #undef STEP
  #undef ENDW
  {auto rr=__builtin_amdgcn_permlane32_swap(__float_as_uint(l_reg),__float_as_uint(l_reg),false,false);l_reg=__uint_as_float(rr[0])+__uint_as_float(rr[1]);}
  if(hi==0)wsf[32+r32]=l_reg;asm volatile("s_waitcnt lgkmcnt(0)":::"memory");
  float rli[16];
  #pragma unroll
  for(int r=0;r<16;++r)rli[r]=__builtin_amdgcn_rcpf(wsf[32+crow(r,hi)]);
  if(O8){ unsigned char*stg8=(unsigned char*)(shm+LDS_OST)+wid*4096;
    #pragma unroll
    for(int r=0;r<16;++r){const int orow=crow(r,hi);
      #pragma unroll
      for(int d0=0;d0<2;++d0)stg8[orow*64+d0*32+r32]=(unsigned char)(__builtin_amdgcn_cvt_pk_fp8_f32(o[d0][r]*rli[r],0.f,0,false)&0xff);}
    asm volatile("s_waitcnt lgkmcnt(0)":::"memory");
    unsigned char*Ow8=O8+(rowbase+q0+wid*QBLK)*1024+h*D;
    #pragma unroll
    for(int i=0;i<2;++i){const int row=i*16+(lane>>2),ch=lane&3; const u32x4 v=*(const u32x4*)(stg8+row*64+ch*16); ATTN_STORE16(Ow8+(long)row*1024+ch*16,v);} }
  else{
  bf16*Ow=O+(rowbase+q0+wid*QBLK)*DM+h*D;
  { bf16*stg=(bf16*)(shm+LDS_OST)+wid*2048;
    #pragma unroll
    for(int r=0;r<16;++r){const int orow=crow(r,hi);
      #pragma unroll
      for(int d0=0;d0<2;++d0)stg[orow*64+d0*32+r32]=__float2bfloat16(o[d0][r]*rli[r]);}
    asm volatile("s_waitcnt lgkmcnt(0)":::"memory");
    #pragma unroll
    for(int i=0;i<4;++i){const int row=i*8+(lane>>3),ch=lane&7; const u32x4 v=*(const u32x4*)(stg+row*64+ch*8); ATTN_STORE16(Ow+(long)row*DM+ch*8,v);} } }
  asm volatile("s_waitcnt lgkmcnt(0)\n\ts_barrier":::"memory");
  #undef BIASMMA
  #undef KXF
  #undef QX_SET
  #undef TIDX
  #undef DMA_K
  #undef DMA_V
  #undef CMASK
  #undef START
  #undef RESC
  #undef ROT
}

template<int PITCH> __device__ __forceinline__ void sb_unit(int b,int h,int qb,const bf16*Q,const bf16*__restrict__ K,const bf16*__restrict__ V,bf16*O  ,char*shm){
  int tid_=threadIdx.x; asm volatile("":"+v"(tid_)); const int tid=tid_,lane=tid&63,r32=lane&31,hi=lane>>5; const int wid=__builtin_amdgcn_readfirstlane(tid>>6);
  const long rowbase=(long)b*SEQ; const int q0=qb*QB;
  const bf16*Qw=Q+(rowbase+q0+wid*QBLK)*PITCH+h*D;
  const bf16*Kh=K+rowbase*PITCH+h*D,*Vh=V+rowbase*PITCH+h*D;
  const unsigned lds0=(unsigned)(uintptr_t)shm;
  const bf16*ksrc=Kh+(long)lane*PITCH+wid*8;
  const bf16*vsrc=Vh+(long)(16*(wid&3)+(lane>>2))*PITCH+(wid>>2)*32+(lane&3)*8;
  const unsigned kdst=lds0+LDS_K+wid*1024, vdst=lds0+LDS_V+wid*1024;
  #define SB_DMA(t,slot) do{ glds16(ksrc+(long)(t)*KVBLK*PITCH,(unsigned)__builtin_amdgcn_readfirstlane(kdst+(slot))); glds16(vsrc+(long)(t)*KVBLK*PITCH,(unsigned)__builtin_amdgcn_readfirstlane(vdst+(slot))); }while(0)
  const int vb0=(int)(lds0+LDS_V)+((lane>>4)&1)*32+(lane&3)*8+(4*hi+((lane&15)>>2))*64;
  volatile __attribute__((address_space(3))) unsigned* fl=(volatile __attribute__((address_space(3))) unsigned*)((lds_cptr)shm+LDS_WS);
  const int NT=(q0+QB)/KVBLK; const int qrel=wid*QBLK+r32;
  SB_DMA(NT-1,0);
  bf16x8 qr[4];
  #pragma unroll
  for(int d0=0;d0<4;++d0)qr[d0]=*reinterpret_cast<const bf16x8*>(&Qw[(long)r32*PITCH+d0*16+hi*8]);
  f32x16 o[2];o[0]=f32x16{};o[1]=f32x16{}; const f32x16 zero16=f32x16{};
  float carry=1.f;
  int slot=0;
  #define SB_TILE(BAND) do{ \
    if(!(BAND&&64*(t-(NT-4))>wid*QBLK+QBLK-1)){ \
    f32x16 p0,p1; qkt(p0,p1,shm+LDS_K+slot,qr,zero16,r32,hi); \
    if(BAND){ const int kb=64*(t-(NT-4))+4*hi;                 \
      _Pragma("unroll") for(int r=0;r<16;++r){const int kv=kb+(r&3)+8*(r>>2); if(kv>=qrel)p0[r]=-INFINITY; if(kv+32>=qrel)p1[r]=-INFINITY;} } \
      \
      \
    f32x16 s0,s1;                                                \
    _Pragma("unroll") for(int r=0;r<16;++r){ const float z=p0[r]; const float e=__builtin_amdgcn_exp2f(-__builtin_fmaxf(z,-100.f)); const float rb=__builtin_amdgcn_rcpf(1.f+e); const float y=p1[r]; const float f=__builtin_amdgcn_exp2f(-__builtin_fmaxf(y,-100.f)); const float rc=__builtin_amdgcn_rcpf(1.f+f); \
      if(BAND){ const bool mk=z<-1.0e30f; p0[r]=mk?0.f:rb; s0[r]=mk?1.f:e*rb; const bool mj=y<-1.0e30f; p1[r]=mj?0.f:rc; s1[r]=mj?1.f:f*rc; } \
      else { p0[r]=rb; s0[r]=e*rb; p1[r]=rc; s1[r]=f*rc; } } \
    float lo[8],hv[8];                                          \
    _Pragma("unroll") for(int i=0;i<8;++i){ const float mine=(i<4)?((s0[4*i]*s0[4*i+1])*(s0[4*i+2]*s0[4*i+3])):((s1[4*i-16]*s1[4*i-15])*(s1[4*i-14]*s1[4*i-13])); \
      auto rr=__builtin_amdgcn_permlane32_swap(__float_as_uint(mine),__float_as_uint(mine),false,false); lo[i]=__uint_as_float(rr[0]); hv[i]=__uint_as_float(rr[1]); } \
    float sp_=carry;                                             \
    _Pragma("unroll") for(int i=7;i>=0;--i){ float a=sp_*((hi==0)?hv[i]:1.f);       \
      if(i<4){ p0[4*i+3]*=a; a*=s0[4*i+3]; p0[4*i+2]*=a; a*=s0[4*i+2]; p0[4*i+1]*=a; a*=s0[4*i+1]; p0[4*i]*=a; } \
      else   { const int j=4*i-16; p1[j+3]*=a; a*=s1[j+3]; p1[j+2]*=a; a*=s1[j+2]; p1[j+1]*=a; a*=s1[j+1]; p1[j]*=a; } \
      sp_*=lo[i]*hv[i]; } \
    carry=sp_; \
    { u32x4 pw0,pw1,pw2,pw3; \
      pw0=(u32x4){cvtpk_s(p0[0],p0[1]),cvtpk_s(p0[2],p0[3]),cvtpk_s(p0[4],p0[5]),cvtpk_s(p0[6],p0[7])}; pw1=(u32x4){cvtpk_s(p0[8],p0[9]),cvtpk_s(p0[10],p0[11]),cvtpk_s(p0[12],p0[13]),cvtpk_s(p0[14],p0[15])}; \
      pw2=(u32x4){cvtpk_s(p1[0],p1[1]),cvtpk_s(p1[2],p1[3]),cvtpk_s(p1[4],p1[5]),cvtpk_s(p1[6],p1[7])}; pw3=(u32x4){cvtpk_s(p1[8],p1[9]),cvtpk_s(p1[10],p1[11]),cvtpk_s(p1[12],p1[13]),cvtpk_s(p1[14],p1[15])}; \
      pv(o,vb0+slot,__builtin_bit_cast(bf16x8,pw0),__builtin_bit_cast(bf16x8,pw1),__builtin_bit_cast(bf16x8,pw2),__builtin_bit_cast(bf16x8,pw3)); } \
    } \
    { const bool done_=__all(carry==0.f); if(lane==0)fl[(t&1)*8+wid]=done_?1u:0u; } \
    slot^=SLOTB; }while(0)
  #define SB_HEAD() { WAIT_BAR(0); \
    if(t<NT-1){ const int pb=((t+1)&1)*8; const unsigned a=fl[pb]&fl[pb+1]&fl[pb+2]&fl[pb+3]&fl[pb+4]&fl[pb+5]&fl[pb+6]&fl[pb+7]; if(__builtin_amdgcn_readfirstlane(a)!=0u)break; } \
    if(t>0)SB_DMA(t-1,slot^SLOTB); }
  int t=NT-1; bool live=true;
  for(;t>=NT-4;--t){ live=false; SB_HEAD(); SB_TILE(true); live=true; }
  if(live){ for(;t>=0;--t){ SB_HEAD(); SB_TILE(false); } }
  #undef SB_TILE
  #undef SB_HEAD
  asm volatile("s_waitcnt vmcnt(0) lgkmcnt(0)":::"memory");
  bf16*Ow=O+(rowbase+q0+wid*QBLK)*1024+h*D;
  { bf16*stg=(bf16*)(shm+LDS_OST)+wid*2048;
    #pragma unroll
    for(int r=0;r<16;++r){const int orow=crow(r,hi);
      #pragma unroll
      for(int d0=0;d0<2;++d0)stg[orow*64+d0*32+r32]=__float2bfloat16(o[d0][r]);}
    asm volatile("s_waitcnt lgkmcnt(0)":::"memory");
    #pragma unroll
    for(int i=0;i<4;++i){const int row=i*8+(lane>>3),ch=lane&7; const u32x4 v=*(const u32x4*)(stg+row*64+ch*8); ATTN_STORE16(Ow+(long)row*1024+ch*8,v);} }
  asm volatile("s_waitcnt vmcnt(0) lgkmcnt(0)\n\ts_barrier":::"memory");
  #undef SB_DMA
}
constexpr int ATTN_LDS_BYTES=LDS_BYTES;
struct AttnTensors { const bf16* Q; const bf16* K; const bf16* V; bf16* O; const float* logf;   const unsigned* kn;   };
#undef SBAR
#undef WAIT_BAR
}
constexpr int NWAVES = 8, NTHREADS = NWAVES * 64;
constexpr int BATCH = 2, SEQ = 8192, D = 1024, M = BATCH * SEQ;
constexpr int S5G = 32, S5H = 16, S5P = 64, S5T = 32  , S5NC = M / S5T  , S5KX = 640  ;
constexpr int SBH = 8, FOXH = 16, HD = 64;
constexpr int EVEN_IN = 2048, ODD_IN = 3088, DFF = 2816, NEXP = 8, DFE = 3584;
constexpr float C2 = 0.125f * 1.4426950408889634f;
constexpr int MOE_MAX_PANELS = 136, MOE_MAX_SLOTS = MOE_MAX_PANELS * 256, MOE_CAP = 16384  ;

constexpr size_t MiB = 1u << 20;
constexpr size_t WS_CTL = 0, CTL_ZERO_BYTES = 1 * MiB;
constexpr size_t WS_WMOE_GU = 1 * MiB;
constexpr size_t WS_WMOE_D = 57 * MiB;
constexpr size_t WS_WIN0 = 85 * MiB;
constexpr size_t WS_WGLU = 89 * MiB;
constexpr size_t WS_WOUT0 = 90 * MiB;
constexpr size_t WS_WGU0 = 92 * MiB;
constexpr size_t WS_WD0 = 103 * MiB;
constexpr size_t WS_WIN1 = 109 * MiB;
constexpr size_t WS_WF1 = 115 * MiB;
constexpr size_t WS_WOUT1 = 116 * MiB;
constexpr size_t WS_S5WA = 118 * MiB;
constexpr size_t WS_S5WC = 126 * MiB;
constexpr size_t WS_XB = 146 * MiB;
constexpr size_t WS_SSP = 178 * MiB;
constexpr size_t WS_META = 182 * MiB;
constexpr size_t WS_LOGF = 183 * MiB;
constexpr size_t WS_QKV0 = 184 * MiB;
constexpr size_t WS_UEXT = 232 * MiB;
constexpr size_t WS_SLOC = 252 * MiB;
constexpr size_t WS_YG = 260 * MiB;
constexpr size_t WS_MIXB = 276 * MiB;
constexpr size_t WS_HID0 = 184 * MiB;
constexpr size_t WS_QKV1 = 184 * MiB;
constexpr size_t WS_XG = 184 * MiB;
constexpr size_t WS_HMOE = 312 * MiB;
constexpr size_t WS_Y = 85 * MiB;
constexpr size_t WS_END = 432 * MiB;
static_assert(WS_XG + (size_t)8 * MOE_CAP * 1024 <= WS_HMOE && WS_HMOE + (size_t)MOE_MAX_SLOTS * DFE <= WS_END && WS_Y + (size_t)MOE_MAX_SLOTS * 1024 * 2 <= WS_XB + 32 * MiB && WS_MIXB + 32 * MiB <= WS_END, "ws map");
constexpr size_t MT_RSTD = 0, MT_TOKE = 65536, MT_TOKP = 131072, MT_TOKG = 262144, MT_RSS = 524288;
constexpr int CW_TMO = 0, CW_CODE = 1, CW_BAR = 4096, CW_CNT = 8192  , CW_QUEUE = 12288  , CW_QUEUE2 = 12352  , CW_KN = 16384  ;
constexpr int CW_SUBBAR = 32768;

constexpr int RING_OFF = 0, RING_BYTES = 131072;
constexpr int LDSCTL_OFF = 133120  , MISC_OFF = LDSCTL_OFF + 320;
constexpr int LDS_BYTES = 147456;

#define GAS __attribute__((address_space(1)))
#define LAS __attribute__((address_space(3)))
typedef unsigned short bf16;
typedef unsigned v4u __attribute__((ext_vector_type(4)));
typedef unsigned v2u __attribute__((ext_vector_type(2)));
typedef float f32x4 __attribute__((ext_vector_type(4)));
typedef short bf16x8 __attribute__((ext_vector_type(8)));
typedef GAS unsigned gu32;
#define RLX_AGENT __ATOMIC_RELAXED, __HIP_MEMORY_SCOPE_AGENT
#define LDS_WAIT() asm volatile("s_waitcnt lgkmcnt(0)" ::: "memory")
#define VM_WAIT() asm volatile("s_waitcnt vmcnt(0)" ::: "memory")
__device__ __forceinline__ unsigned f2bf(float f) { unsigned u = __builtin_bit_cast(unsigned, f); return (u + 0x7fffu + ((u >> 16) & 1u)) >> 16; }
__device__ __forceinline__ unsigned pk2(float lo, float hi) { return f2bf(lo) | (f2bf(hi) << 16); }
__device__ __forceinline__ float bflo(unsigned w) { return __uint_as_float(w << 16); }
__device__ __forceinline__ float bfhi(unsigned w) { return __uint_as_float(w & 0xffff0000u); }

#define XB_TMO      128
#define XB_XCNT(j)  (256  + 64 * (j))
#define XB_XSUB(j)  (1280 + 64 * (j))
#define XB_XGEN(j)  (2304 + 64 * (j))
#define XB_TOP      3328
#define XB_TOPGEN   3392
#define XCD_BAR_WORDS 3456
#define XB_SPIN_CAP (1u << 18)
__device__ __forceinline__ unsigned xb_ld(unsigned* p)              { return __hip_atomic_load(p, __ATOMIC_RELAXED, __HIP_MEMORY_SCOPE_AGENT); }
__device__ __forceinline__ unsigned xb_add(unsigned* p, unsigned v) { return __hip_atomic_fetch_add(p, v, __ATOMIC_RELAXED, __HIP_MEMORY_SCOPE_AGENT); }
__device__ __forceinline__ unsigned xb_xcc_id() { return (unsigned)__builtin_amdgcn_s_getreg((3 << 11) | 20) & 0xFu; }
#define XB_SPIN(cond, bar) do { unsigned _sp = 0; while (cond) { __builtin_amdgcn_s_sleep(1); \
    if ((++_sp & 255u) == 0u) { if (xb_ld(&(bar)[XB_TMO])) break; if (_sp > XB_SPIN_CAP) { atomicAdd(&(bar)[XB_TMO], 1u); break; } } } } while (0)
struct XcdBarrier { unsigned* bar; unsigned x; volatile LAS unsigned* st; unsigned total; };
__device__ __forceinline__ XcdBarrier xcd_barrier_post(unsigned* bar, volatile LAS unsigned* st, unsigned total) {
    XcdBarrier b; b.bar = bar; b.x = xb_xcc_id(); b.st = st; b.total = total;
    if (threadIdx.x == 0) (void)xb_add(&bar[XB_XCNT(b.x)], 1u);
    return b;
}
__device__ __forceinline__ void xcd_barrier_complete(unsigned* bar, unsigned x, unsigned G, unsigned& nloc, unsigned& nx) {
    unsigned sum, cnt, mine, sp = 0u;
    for (;;) {
        sum = 0u; cnt = 0u; mine = 0u;
#pragma unroll
        for (unsigned j = 0; j < 16; ++j) { const unsigned c = xb_ld(&bar[XB_XCNT(j)]); sum += c; cnt += (c > 0u) ? 1u : 0u; mine = (j == x) ? c : mine; }
        if (sum == G) break;
        __builtin_amdgcn_s_sleep(1);
        if ((++sp & 255u) == 0u) { if (xb_ld(&bar[XB_TMO])) break; if (sp > XB_SPIN_CAP) { atomicAdd(&bar[XB_TMO], 1u); break; } }
    }
    nloc = mine > 0u ? mine : 1u; nx = cnt > 0u ? cnt : 1u;
}
__device__ __forceinline__ void xcd_barrier(const XcdBarrier& b) {
    asm volatile("s_waitcnt vmcnt(0)" ::: "memory");
    __syncthreads();
    if (threadIdx.x == 0) {
        unsigned* bar = b.bar;
        __builtin_amdgcn_s_waitcnt(0);
        unsigned nloc = b.st[0], nx = b.st[1];
        if (nloc == 0u) { xcd_barrier_complete(bar, b.x, b.total, nloc, nx); b.st[0] = nloc; b.st[1] = nx; }
        const unsigned old = xb_add(&bar[XB_XSUB(b.x)], 1u);
        const unsigned gen = old / nloc;
        if (old + 1u == (gen + 1u) * nloc) {
            __builtin_amdgcn_fence(__ATOMIC_RELEASE, "agent");
            asm volatile("s_waitcnt vmcnt(0)" ::: "memory");
            const unsigned og = xb_add(&bar[XB_TOP], 1u);
            const unsigned tg = og / nx;
            if (og + 1u == (tg + 1u) * nx) xb_add(&bar[XB_TOPGEN], 1u);
            else XB_SPIN(xb_ld(&bar[XB_TOPGEN]) == tg, bar);
            __builtin_amdgcn_fence(__ATOMIC_ACQUIRE, "agent");
            xb_add(&bar[XB_XGEN(b.x)], 1u);
            asm volatile("s_waitcnt vmcnt(0)" ::: "memory");
        } else {
            XB_SPIN(xb_ld(&bar[XB_XGEN(b.x)]) == gen, bar);
            __builtin_amdgcn_fence(__ATOMIC_ACQUIRE, "agent");
            asm volatile("s_waitcnt vmcnt(0)" ::: "memory");
        }
    }
    __syncthreads();
}

__device__ __forceinline__ float wave_sum(float v) {
#pragma unroll
    for (int o = 1; o < 64; o <<= 1) v += __shfl_xor(v, o);
    return v;
}
constexpr int XP = 65, XSCR_BYTES = 64 * XP * 4;
__device__ __forceinline__ unsigned cvtpk(float lo, float hi) { unsigned r; asm volatile("v_cvt_pk_bf16_f32 %0, %1, %2" : "=v"(r) : "v"(lo), "v"(hi)); return r; }
__device__ __forceinline__ void p0_transpose_item(const float* W, int ldw, int k0, int n0, const float* gs, bf16* dst, int ldd, LAS float* scr, int lane) {
    const int lr = lane >> 4, lc = (lane & 15) * 4;
    const float* src = W + (size_t)(k0 + lr) * ldw + n0 + lc;
    f32x4 v[16];
#pragma unroll
    for (int i = 0; i < 16; ++i) v[i] = __builtin_nontemporal_load((const GAS f32x4*)(src + (size_t)(4 * i) * ldw));
    if (gs) {
#pragma unroll
        for (int i = 0; i < 16; ++i) v[i] = v[i] * gs[k0 + 4 * i + lr]; }
#pragma unroll
    for (int i = 0; i < 16; ++i) { LAS float* p = scr + (4 * i + lr) * XP + lc; p[0] = v[i][0]; p[1] = v[i][1]; p[2] = v[i][2]; p[3] = v[i][3]; }
    LDS_WAIT(); asm volatile("" ::: "memory");
    const int c = lane & 7, nn = lane >> 3;
#pragma unroll
    for (int j = 0; j < 8; ++j) { const int n = nn + 8 * j; const LAS float* sp = scr + (8 * c) * XP + n;
        v4u o; o.x = cvtpk(sp[0 * XP], sp[1 * XP]); o.y = cvtpk(sp[2 * XP], sp[3 * XP]); o.z = cvtpk(sp[4 * XP], sp[5 * XP]); o.w = cvtpk(sp[6 * XP], sp[7 * XP]);
        *(GAS v4u*)(dst + (size_t)n * ldd + k0 + 8 * c) = o; }
    LDS_WAIT(); asm volatile("" ::: "memory");
}
struct XTile { const float* src; const float* gs; unsigned char* dst; int ldw, ldd, k0; };
__device__ __forceinline__ XTile xtile_fp8(int item, const float* W, int ldw, int N, const float* gs, unsigned char* dst, int ldd, int mode, int lane) {
    const int nblk = N / 64, kb = item / nblk, nb = item % nblk, n0 = 64 * nb, k0 = 64 * kb;
    const int row = mode == 0 ? n0 : ((n0 >> 7) * 256 + (n0 & 127) + (mode == 2 ? 128 : 0));
    XTile t; t.src = W + (size_t)(k0 + (lane >> 4)) * ldw + n0 + (lane & 15) * 4; t.gs = gs; t.dst = dst + (size_t)row * ldd; t.ldw = ldw; t.ldd = ldd; t.k0 = k0; return t;
}
__device__ __forceinline__ void xtile_load(const XTile& t, f32x4 (&v)[16], float (&g)[16], int lane) {
    const int lr = lane >> 4;
    if (t.gs) {
#pragma unroll
        for (int i = 0; i < 16; ++i) g[i] = t.gs[t.k0 + 4 * i + lr];
    } else {
#pragma unroll
        for (int i = 0; i < 16; ++i) g[i] = 1.0f; }
#pragma unroll
    for (int i = 0; i < 16; ++i) v[i] = __builtin_nontemporal_load((const GAS f32x4*)(t.src + (size_t)(4 * i) * t.ldw));
}
__device__ __forceinline__ void xtile_finish_fp8(const XTile& t, f32x4 (&v)[16], const float (&g)[16], float wscale, LAS float* scr, int lane) {
    const int lr = lane >> 4, lc = (lane & 15) * 4;
#pragma unroll
    for (int i = 0; i < 16; ++i) v[i] = v[i] * (g[i] * wscale);
    constexpr int XR = 64;
#pragma unroll
    for (int i = 0; i < 16; ++i) *(LAS f32x4*)(scr + (4 * i + lr) * XR + (i >> 2) * 16 + lc) = v[i];
    LDS_WAIT(); asm volatile("" ::: "memory");
    const int c = lane & 3, nn = lane >> 2;
#pragma unroll
    for (int j = 0; j < 4; ++j) { const int n = nn + 16 * j; const LAS float* sp = scr + (16 * c) * XR + c * 16 + n;
        v4u o; o.x = pg8::pk_fp8x4(sp[0 * XR], sp[1 * XR], sp[2 * XR], sp[3 * XR]); o.y = pg8::pk_fp8x4(sp[4 * XR], sp[5 * XR], sp[6 * XR], sp[7 * XR]);
        o.z = pg8::pk_fp8x4(sp[8 * XR], sp[9 * XR], sp[10 * XR], sp[11 * XR]); o.w = pg8::pk_fp8x4(sp[12 * XR], sp[13 * XR], sp[14 * XR], sp[15 * XR]);
        __builtin_nontemporal_store(o, (GAS v4u*)(t.dst + (size_t)n * t.ldd + t.k0 + 16 * c)); }
    LDS_WAIT(); asm volatile("" ::: "memory");
}
__device__ __forceinline__ void xpose_mat(int item, const float* W, int ldw, int N, const float* gs, bf16* dst, int ldd, int mode, LAS float* scr, int lane) {
    const int nblk = N / 64, kb = item / nblk, nb = item % nblk, n0 = 64 * nb;
    const int row = mode == 0 ? n0 : ((n0 >> 7) * 256 + (n0 & 127) + (mode == 2 ? 128 : 0));
    p0_transpose_item(W, ldw, 64 * kb, n0, gs, dst + (size_t)row * ldd, ldd, scr, lane);
}

struct Args { const float* in[28]; float* out; unsigned char* ws; };

__device__ __forceinline__ void s5_tables(const Args& a, int g, int q, LAS unsigned char* lds, int tid) {
    LAS float* POWr = (LAS float*)lds;
    LAS float* POWi = POWr + 33 * 64;
    LAS float* BBr = POWi + 33 * 64;
    LAS float* BBi = BBr + 1024;
    LAS float* CCr = BBi + 1024;
    LAS float* CCi = CCr + 1024;
    LAS float* KT = CCi + 1024;
    LAS float* DD = KT + 2048;
    const float* a_re = a.in[3]; const float* a_im = a.in[4]; const float* b_re = a.in[5]; const float* b_im = a.in[6];
    const float* c_re = a.in[7]; const float* c_im = a.in[8]; const float* dsk = a.in[9]; const float* log_step = a.in[10];
    const float step = expf(log_step[g]);
    __syncthreads();
    for (int e = tid; e < 33 * 64; e += NTHREADS) { const int n = e >> 6, p = e & 63; const float lr = a_re[g * 64 + p], li = a_im[g * 64 + p];
        const float mag = expf((float)n * step * lr); float sn, cs; sincosf((float)n * (step * li), &sn, &cs); POWr[e] = mag * cs; POWi[e] = mag * sn; }
    for (int e = tid; e < 1024; e += NTHREADS) { const int p = e >> 4, h = e & 15; const float lr = a_re[g * 64 + p], li = a_im[g * 64 + p];
        const float er = expf(lr * step); float sn, cs; sincosf(li * step, &sn, &cs); const float nr = er * cs - 1.f, ni = er * sn, den = lr * lr + li * li;
        const float fr = (nr * lr + ni * li) / den, fi = (ni * lr - nr * li) / den;
        const float br = b_re[(g * 64 + p) * 16 + h], bi = b_im[(g * 64 + p) * 16 + h];
        BBr[e] = fr * br - fi * bi; BBi[e] = fr * bi + fi * br;
        CCr[e] = c_re[g * 1024 + e]; CCi[e] = c_im[g * 1024 + e]; }
    if (tid < 16) DD[tid] = dsk[g * 16 + tid];
    __syncthreads();
    { const int lane_ = tid & 63, hq = lane_ & 3, hl = (lane_ >> 2) & 3, tau = 4 * (tid >> 6) + (lane_ >> 4), ho = 4 * q + hl, rot = 8 * hl + 2 * (lane_ >> 4);
      f32x4 sa = (f32x4){0.f, 0.f, 0.f, 0.f};
      for (int pp = 0; pp < 64; ++pp) { const int p = (pp + rot) & 63; const float cr = CCr[ho * 64 + p], ci = CCi[ho * 64 + p], pr = POWr[tau * 64 + p], pi = POWi[tau * 64 + p];
          const float xr = cr * pr - ci * pi, xi = cr * pi + ci * pr; const f32x4 br = *(const LAS f32x4*)(BBr + p * 16 + 4 * hq), bi = *(const LAS f32x4*)(BBi + p * 16 + 4 * hq);
          sa += br * xr - bi * xi; }
      if (tau == 0 && (ho >> 2) == hq) sa[ho & 3] += DD[ho];
      *(LAS f32x4*)(KT + (tau * 4 + hl) * 16 + 4 * hq) = sa; }
    __syncthreads();
    bf16* WA = (bf16*)(a.ws + WS_S5WA) + (size_t)g * 256 * 512;
    for (int pc = tid; pc < 64 * 64; pc += NTHREADS) { const int p = pc >> 6, k0 = (pc & 63) * 8; v4u o = (v4u){0u, 0u, 0u, 0u};
        if (q < 2) { const int j = k0 >> 4, h0 = k0 & 15; const float pr = POWr[(31 - j) * 64 + p], pi = POWi[(31 - j) * 64 + p]; float v[8];
#pragma unroll
            for (int w = 0; w < 8; ++w) { const float br = BBr[p * 16 + h0 + w], bi = BBi[p * 16 + h0 + w]; v[w] = (q == 0) ? (pr * br - pi * bi) : (pr * bi + pi * br); }
            o.x = cvtpk(v[0], v[1]); o.y = cvtpk(v[2], v[3]); o.z = cvtpk(v[4], v[5]); o.w = cvtpk(v[6], v[7]); }
        *(GAS v4u*)(WA + (size_t)(64 * q + p) * 512 + k0) = o; }
    bf16* WC = (bf16*)(a.ws + WS_S5WC) + (size_t)g * 512 * 640;
    for (int pc = tid; pc < 128 * 80; pc += NTHREADS) { const int rl = pc / 80, k0 = (pc % 80) * 8, i = rl >> 2, hl = rl & 3, ho = 4 * q + hl; float v[8];
        if (k0 < 512) { const int j = k0 >> 4, h0 = k0 & 15; f32x4 ka = (f32x4){0.f, 0.f, 0.f, 0.f}, kb = ka;
            if (j <= i) { const LAS f32x4* kp = (const LAS f32x4*)(KT + ((i - j) * 4 + hl) * 16 + h0); ka = kp[0]; kb = kp[1]; }
#pragma unroll
            for (int w = 0; w < 4; ++w) { v[w] = ka[w]; v[4 + w] = kb[w]; } }
        else { const int p0 = (k0 - 512) & 63; const bool im = k0 >= 576;
#pragma unroll
            for (int w = 0; w < 8; ++w) { const int p = p0 + w; const float cr = CCr[ho * 64 + p], ci = CCi[ho * 64 + p], pr = POWr[(i + 1) * 64 + p], pi = POWi[(i + 1) * 64 + p];
                v[w] = im ? -(cr * pi + ci * pr) : (cr * pr - ci * pi); } }
        v4u o; o.x = cvtpk(v[0], v[1]); o.y = cvtpk(v[2], v[3]); o.z = cvtpk(v[4], v[5]); o.w = cvtpk(v[6], v[7]);
        *(GAS v4u*)(WC + (size_t)(i * 16 + ho) * 640 + k0) = o; }
    __syncthreads();
}

constexpr int MOE_XITEMS = 24 * 896;
__device__ __forceinline__ XTile moe_xtile(const Args& a, int r, int lane) {
    unsigned char* ws = a.ws;
    const int mat = r / 896, e = mat / 3, which = mat % 3; r -= mat * 896;
    if (which == 0) return xtile_fp8(r, a.in[24] + (size_t)e * D * DFE, DFE, DFE, a.in[22], ws + WS_WMOE_GU + (size_t)e * 7168 * 1024, D, 1, lane);
    if (which == 1) return xtile_fp8(r, a.in[25] + (size_t)e * D * DFE, DFE, DFE, a.in[22], ws + WS_WMOE_GU + (size_t)e * 7168 * 1024, D, 2, lane);
    return xtile_fp8(r, a.in[26] + (size_t)e * DFE * D, D, D, nullptr, ws + WS_WMOE_D + (size_t)e * 1024 * 3584, DFE, 0, lane);
}
constexpr int I_IN0 = 16 * 32, I_GLU = 8 * 8, I_OUT = 16 * 16, I_GU0 = 16 * 44, I_D0 = 44 * 16, I_IN1 = 16 * 48;
constexpr int DW_FIRST = I_IN0 + I_GLU  , DW_EARLY = I_IN0 + I_GLU + I_OUT + 2 * I_GU0, DW_ITEMS = DW_EARLY + I_D0 + I_IN1 + I_OUT;
__device__ __forceinline__ void dense_item(const Args& a, int it, LAS float* scr, int lane) {
    unsigned char* ws = a.ws; int r = it;
    if (r < I_IN0) { xpose_mat(r, a.in[2], EVEN_IN, EVEN_IN, a.in[1], (bf16*)(ws + WS_WIN0), D, 0, scr, lane); return; } r -= I_IN0;
    if (r < I_GLU) { xpose_mat(r, a.in[11], 512, 512, nullptr, (bf16*)(ws + WS_WGLU), 512, 0, scr, lane); return; } r -= I_GLU;
    if (r < I_OUT) { xpose_mat(r, a.in[13], D, D, nullptr, (bf16*)(ws + WS_WOUT0), D, 0, scr, lane); return; } r -= I_OUT;
    if (r < I_GU0) { xpose_mat(r, a.in[15], DFF, DFF, a.in[14], (bf16*)(ws + WS_WGU0), D, 1, scr, lane); return; } r -= I_GU0;
    if (r < I_GU0) { xpose_mat(r, a.in[16], DFF, DFF, a.in[14], (bf16*)(ws + WS_WGU0), D, 2, scr, lane); return; } r -= I_GU0;
    if (r < I_D0) { xpose_mat(r, a.in[17], D, D, nullptr, (bf16*)(ws + WS_WD0), DFF, 0, scr, lane); return; } r -= I_D0;
    if (r < I_IN1) { const XTile t = xtile_fp8(r, a.in[19], ODD_IN, 3072, a.in[18], ws + WS_WIN1, D, 0, lane); f32x4 v[16]; float g[16]; xtile_load(t, v, g, lane); xtile_finish_fp8(t, v, g, 64.f, scr, lane); return; } r -= I_IN1;
    { const XTile t = xtile_fp8(r, a.in[21], D, D, nullptr, ws + WS_WOUT1, D, 0, lane); f32x4 v[16]; float g[16]; xtile_load(t, v, g, lane); xtile_finish_fp8(t, v, g, 64.f, scr, lane); }
}
__device__ __forceinline__ void dense_range(const Args& a, LAS unsigned char* lds, int lane, int wave, int iw, int nwg_, int lo, int hi) {
    LAS float* scr = (LAS float*)(lds + wave * XSCR_BYTES);
    for (int it = hi - 1 - (iw * NWAVES + wave); it >= lo; it -= nwg_ * NWAVES) dense_item(a, it, scr, lane);
}
__device__ __forceinline__ void dense_late(const Args& a, LAS unsigned char* lds, int tid, int lane, int wave, int iw, int nwg_) {
    LAS float* scr = (LAS float*)(lds + wave * XSCR_BYTES);
    for (int it = DW_ITEMS - 1 - (iw * NWAVES + wave); it >= DW_EARLY; it -= nwg_ * NWAVES) dense_item(a, it, scr, lane);
    for (int gt = iw * NTHREADS + tid; gt < 16 * 1024; gt += nwg_ * NTHREADS) { const int h = gt >> 10, k = gt & 1023; ((bf16*)(a.ws + WS_WF1))[gt] = (bf16)f2bf(a.in[19][(size_t)k * ODD_IN + 3072 + h] * a.in[18][k]); }
}
__device__ __forceinline__ void p0_prologue(const Args& a, LAS unsigned char* lds, int tid, int lane, int wave, int vcu, int G) {
    for (int it = vcu; it < 4 * S5G; it += G) s5_tables(a, it >> 2, it & 3, lds, tid);
    LAS float* scr = (LAS float*)(lds + wave * XSCR_BYTES);
    const int gw = vcu * NWAVES + wave, NGW = G * NWAVES;
    unsigned char* ws = a.ws;
    for (int it = DW_FIRST - 1 - gw; it >= 0; it -= NGW) dense_item(a, it, scr, lane);
    float* ss0 = (float*)(ws + WS_SSP);
    int m0, nr, stp;
    if (G == 256) { if (vcu < 128) { m0 = vcu * 48 + wave * 6; nr = 6; } else { m0 = 6144 + (vcu - 128) * 80 + wave * 10; nr = 10; } stp = 1; }
    else { m0 = gw; nr = (M - gw + NGW - 1) / NGW; stp = NGW; }
    f32x4 xnx[4];
    if (nr > 0) {
#pragma unroll
        for (int j = 0; j < 4; ++j) xnx[j] = ((const GAS f32x4*)(a.in[0] + (size_t)m0 * D) + lane)[64 * j]; }
    for (int i = 0; i < nr; ++i) { const int m = m0 + i * stp;
        GAS v2u* o8 = (GAS v2u*)((bf16*)(ws + WS_XB) + (size_t)m * D) + lane; float s = 0.f; f32x4 xc[4];
#pragma unroll
        for (int j = 0; j < 4; ++j) xc[j] = xnx[j];
        if (i + 1 < nr) {
#pragma unroll
            for (int j = 0; j < 4; ++j) xnx[j] = ((const GAS f32x4*)(a.in[0] + (size_t)(m + stp) * D) + lane)[64 * j]; }
#pragma unroll
        for (int j = 0; j < 4; ++j) { const f32x4 v = xc[j]; s += (v.x * v.x + v.y * v.y) + (v.z * v.z + v.w * v.w); v2u w; w.x = cvtpk(v.x, v.y); w.y = cvtpk(v.z, v.w); o8[64 * j] = w; }
        s = wave_sum(s); if (lane < 16) ss0[(size_t)m * 16 + lane] = (lane == 0) ? s : 0.f;
    }
}

__device__ __forceinline__ void s5_scan(const Args& a, int gt  ) {
    if (gt >= BATCH * S5G * S5P) return;
    const int b = gt / (S5G * S5P), g = (gt / S5P) % S5G, p = gt % S5P;
    const float step = expf(a.in[10][g]); const float lr = a.in[3][g * 64 + p], li = a.in[4][g * 64 + p];
    const float mag = expf((float)S5T * step * lr); float sn, cs; sincosf((float)S5T * (step * li), &sn, &cs); const float ar = mag * cs, ai = mag * sn;
    const float* sl = (const float*)(a.ws + WS_SLOC) + ((size_t)g * S5NC + b * 256) * 128 + p;
    bf16* ue = (bf16*)(a.ws + WS_UEXT) + ((size_t)g * S5NC + b * 256) * S5KX + 512 + p;
    float sr = 0.f, si = 0.f;
    float cr[16], ci[16], nr_[16], ni_[16];
#pragma unroll
    for (int j = 0; j < 16; ++j) { cr[j] = sl[(size_t)j * 128]; ci[j] = sl[(size_t)j * 128 + 64]; }
#pragma unroll 1
    for (int c0 = 0; c0 < 256; c0 += 16) {
        if (c0 + 16 < 256) {
#pragma unroll
            for (int j = 0; j < 16; ++j) { nr_[j] = sl[(size_t)(c0 + 16 + j) * 128]; ni_[j] = sl[(size_t)(c0 + 16 + j) * 128 + 64]; } }
#pragma unroll
        for (int j = 0; j < 16; ++j) { const int c = c0 + j;
            ue[(size_t)c * S5KX] = (bf16)f2bf(sr); ue[(size_t)c * S5KX + 64] = (bf16)f2bf(si);
            const float nr = ar * sr - ai * si + cr[j], ni = ar * si + ai * sr + ci[j]; sr = nr; si = ni; }
#pragma unroll
        for (int j = 0; j < 16; ++j) { cr[j] = nr_[j]; ci[j] = ni_[j]; }
    }
}

__device__ __forceinline__ void fgate_rows16(const bf16* xb, const bf16* wf, const float* ss, const float* bfv, float* logf, int r0, int lane) {
    const int fr = lane & 15, fq = lane >> 4;
    const bf16x8* ap = (const bf16x8*)(xb + (size_t)(r0 + fr) * D + fq * 8);
    const bf16x8* bp = (const bf16x8*)(wf + (size_t)fr * D + fq * 8);
    f32x4 acc0 = (f32x4){0.f, 0.f, 0.f, 0.f}, acc1 = (f32x4){0.f, 0.f, 0.f, 0.f};
#pragma unroll
    for (int half = 0; half < 2; ++half) {
        bf16x8 av[16], bv[16];
#pragma unroll
        for (int kk = 0; kk < 16; ++kk) { av[kk] = ap[(half * 16 + kk) * 4]; bv[kk] = bp[(half * 16 + kk) * 4]; }
#pragma unroll
        for (int kk = 0; kk < 16; kk += 2) { acc0 = __builtin_amdgcn_mfma_f32_16x16x32_bf16(av[kk], bv[kk], acc0, 0, 0, 0); acc1 = __builtin_amdgcn_mfma_f32_16x16x32_bf16(av[kk + 1], bv[kk + 1], acc1, 0, 0, 0); }
    }
    const f32x4 acc = acc0 + acc1;
    const float bias = bfv[fr];
    float rsq[4];
#pragma unroll
    for (int j = 0; j < 4; ++j) rsq[j] = pg8::rstd16(ss, r0 + fq * 4 + j);
#pragma unroll
    for (int j = 0; j < 4; ++j) { const int row = r0 + fq * 4 + j;
        const float z = acc[j] * rsq[j] + bias;
        const float lf = -(fmaxf(-z, 0.f) + log1pf(expf(-fabsf(z)))) * 1.4426950408889634f;
        const int b = row >> 13, t = row & 8191; logf[((size_t)b * FOXH + fr) * SEQ + t] = lf; }
}

struct MoeOrder {
    pg8::StaticOrder S; int lo; int pref[NEXP + 1]; bool cap_rows;
    __device__ __forceinline__ bool next(int i, pg8::Unit& u) const {
        if (!S.next(i, u)) return false;
        u.pm += lo; int e = 0, pe = 0;
#pragma unroll
        for (int k = 1; k < NEXP; ++k) { const bool ge = u.pm >= pref[k]; e += ge ? 1 : 0; pe = ge ? pref[k] : pe; }
        u.zb = e; u.pa = cap_rows ? e * (MOE_CAP / 256) + (u.pm - pe) : u.pm; return true;
    }
    __device__ __forceinline__ void a_ready(const pg8::Unit&) const {}
    __device__ __forceinline__ void done(const pg8::Unit&) const {}
};

struct MoeQuadOrder {
    int p0, np, G, c; int pref[NEXP + 1];
    __device__ __forceinline__ bool next(int i, pg8::Unit& u) const {
        const long L = (long)i * G + c; if (L >= (long)np * 16) return false;
        const int q = (int)(L & 3), ul = (int)(L >> 2); u.pn = ul & 3; u.pm = p0 + (ul >> 2); u.qa = q >> 1; u.qb = q & 1; u.pa = u.pm; int e = 0;
#pragma unroll
        for (int k = 1; k < NEXP; ++k) e += (u.pm >= pref[k]) ? 1 : 0;
        u.zb = e; return true;
    }
    __device__ __forceinline__ void a_ready(const pg8::Unit&) const {}
    __device__ __forceinline__ void done(const pg8::Unit&) const {}
};

__global__ void __launch_bounds__(NTHREADS, 2) mk_fwd(Args args) {
    extern __shared__ __attribute__((aligned(16))) unsigned char lds_raw[];
    LAS unsigned char* lds = (LAS unsigned char*)lds_raw;
    volatile LAS unsigned* MISC = (volatile LAS unsigned*)(lds + MISC_OFF);
    const int tid = threadIdx.x, lane = tid & 63, wave = __builtin_amdgcn_readfirstlane(tid >> 6);
    const int G = gridDim.x; const int bx = blockIdx.x; const int vcu = (G % 8 == 0) ? (bx % 8) * (G / 8) + bx / 8 : bx;
    unsigned char* ws = args.ws;
    gu32* ctl = (gu32*)(ws + WS_CTL);
    for (int u = tid; u < (LDS_BYTES - LDSCTL_OFF) / 4; u += NTHREADS) ((LAS unsigned*)(lds + LDSCTL_OFF))[u] = 0u;
    __syncthreads();
    XcdBarrier bar = xcd_barrier_post((unsigned*)(ctl + CW_BAR), MISC + 8, (unsigned)G);
    const int gw = vcu * NWAVES + wave, NGW = G * NWAVES;
    float* SS = (float*)(ws + WS_SSP);
    float* X = args.out;
    bf16* XB = (bf16*)(ws + WS_XB);
#define GRID_BAR() xcd_barrier(bar)
#define GEMM_PHASE(EPI, SCHED, lds_, g_, S_, E_) pg8::gemm_phase<EPI, SCHED, true, true>(lds_, g_, S_, E_)

    p0_prologue(args, lds, tid, lane, wave, vcu, G);
    GRID_BAR();
    { pg8::Gemm g{XB, (const bf16*)(ws + WS_WIN0), D, D, D, 0, 0}; pg8::StaticOrder S; S.init(M, EVEN_IN, 1, G, bx);
      pg8::EpiInProj0 E{SS, (bf16*)(ws + WS_UEXT), (bf16*)(ws + WS_QKV0), C2};
      GEMM_PHASE(pg8::EpiInProj0, pg8::StaticOrder, lds + RING_OFF, g, S, E); }
    GRID_BAR();
#define SB_PULL_ONE(more_) do { if (tid == 0) MISC[17] = __hip_atomic_fetch_add(ctl + CW_QUEUE2, 1u, RLX_AGENT); __syncthreads(); const unsigned uq_ = __builtin_amdgcn_readfirstlane(MISC[17]); __syncthreads(); \
        more_ = uq_ < (unsigned)(BATCH * SBH * 32); if (more_) { const int bh_ = (int)(uq_ >> 5), qb_ = (int)(uq_ & 31u); \
            attn_body::sb_unit<1536>(bh_ >> 3, bh_ & 7, qb_, (const attn_body::bf16*)(ws + WS_QKV0), (const attn_body::bf16*)(ws + WS_QKV0) + 512, (const attn_body::bf16*)(ws + WS_QKV0) + 1024, (attn_body::bf16*)(ws + WS_MIXB) + 512, (char*)lds_raw + RING_OFF); } } while (0)
    { const bool s5g = (G % 16 == 0) ? (((bx >> 3) & 1) == 0) : true; const int Gs = (G % 16 == 0) ? G / 2 : G, gl = (G % 16 == 0) ? (bx & 7) + 8 * (bx >> 4) : bx;
      if (s5g) {
          XcdBarrier sub = xcd_barrier_post((unsigned*)(ctl + CW_SUBBAR), MISC + 12, (unsigned)Gs);
          { pg8::Gemm g{(const bf16*)(ws + WS_UEXT), (const bf16*)(ws + WS_S5WA), S5KX, 512, 512, (size_t)S5NC * S5KX * 2, (size_t)256 * 512 * 2}; pg8::StaticOrder S; S.init(S5NC, 256, S5G, Gs, gl);
            pg8::EpiS5State E{(float*)(ws + WS_SLOC)};
            GEMM_PHASE(pg8::EpiS5State, pg8::StaticOrder, lds + RING_OFF, g, S, E);
            if (Gs > S.nwg) { if (gl >= S.nwg) dense_range(args, lds, lane, wave, gl - S.nwg, Gs - S.nwg, DW_EARLY - I_GU0, DW_EARLY); } else dense_range(args, lds, lane, wave, gl, Gs, DW_EARLY - I_GU0, DW_EARLY); }
          xcd_barrier(sub);
          s5_scan(args, gl * NTHREADS + tid);
          { constexpr int NSCAN = BATCH * S5G * S5P / NTHREADS; if (Gs > NSCAN) { if (gl >= NSCAN) dense_range(args, lds, lane, wave, gl - NSCAN, Gs - NSCAN, DW_FIRST, DW_EARLY - I_GU0); } else dense_range(args, lds, lane, wave, gl, Gs, DW_FIRST, DW_EARLY - I_GU0); }
          xcd_barrier(sub);
          { pg8::Gemm g{(const bf16*)(ws + WS_UEXT), (const bf16*)(ws + WS_S5WC), S5KX, S5KX, S5KX, (size_t)S5NC * S5KX * 2, (size_t)512 * S5KX * 2}; pg8::StaticOrder S; S.init(S5NC, 512, S5G, Gs, gl);
            pg8::EpiS5Y E{(bf16*)(ws + WS_YG)};
            GEMM_PHASE(pg8::EpiS5Y, pg8::StaticOrder, lds + RING_OFF, g, S, E); }
          xcd_barrier(sub);
          { pg8::Gemm g{(const bf16*)(ws + WS_YG), (const bf16*)(ws + WS_WGLU), 512, 512, 512, 0, 0}; pg8::StaticOrder S; S.init(M, 512, 1, Gs, gl);
            pg8::EpiGlu E{(const bf16*)(ws + WS_YG), args.in[12], (bf16*)(ws + WS_MIXB)};
            GEMM_PHASE(pg8::EpiGlu, pg8::StaticOrder, lds + RING_OFF, g, S, E); }
          __syncthreads();
      }
      bool sb_more = true;
#pragma unroll 1
      while (sb_more) SB_PULL_ONE(sb_more);
    }
    GRID_BAR();
#undef SB_PULL_ONE
    { pg8::Gemm g{(const bf16*)(ws + WS_MIXB), (const bf16*)(ws + WS_WOUT0), D, D, D, 0, 0}; pg8::StaticOrder S; S.init(M, D, 1, G, bx);
      pg8::EpiResid<true> E{args.in[0], X, XB, SS + 16 * M};
      GEMM_PHASE(pg8::EpiResid<true>, pg8::StaticOrder, lds + RING_OFF, g, S, E); }
    GRID_BAR();
    { pg8::Gemm g{XB, (const bf16*)(ws + WS_WGU0), D, D, D, 0, 0}; pg8::StaticOrder S; S.init(M, 2 * DFF, 1, G, bx);
      pg8::EpiSwiGlu<true> E{SS + 16 * M, (bf16*)(ws + WS_HID0), DFF};
      GEMM_PHASE(pg8::EpiSwiGlu<true>, pg8::StaticOrder, lds + RING_OFF, g, S, E);
      { const int rem = S.nwg % G; if (rem == 0) dense_late(args, lds, tid, lane, wave, bx, G); else if (bx >= rem) dense_late(args, lds, tid, lane, wave, bx - rem, G - rem); } }
    GRID_BAR();
    { pg8::Gemm g{(const bf16*)(ws + WS_HID0), (const bf16*)(ws + WS_WD0), DFF, DFF, DFF, 0, 0}; pg8::StaticOrder S; S.init(M, D, 1, G, bx);
      pg8::EpiResid<true> E{X, X, XB, SS + 32 * M, ws + WS_HMOE  };
      GEMM_PHASE(pg8::EpiResid<true>, pg8::StaticOrder, lds + RING_OFF, g, S, E); }
    GRID_BAR();
    { pg8::Gemm g{(const bf16*)(ws + WS_HMOE), (const bf16*)(ws + WS_WIN1), D / 2, D / 2, D / 2, 0, 0}; pg8::StaticOrder S; S.init(M, 3072, 1, G, bx);
      pg8::EpiInProj1 E{SS + 32 * M, (bf16*)(ws + WS_QKV1), C2, (unsigned*)(ctl + CW_KN)};
      pg8::gemm_phase<pg8::EpiInProj1, pg8::StaticOrder, true, true, true>(lds + RING_OFF, g, S, E); }
    for (int r = gw; r < M / 16; r += NGW) fgate_rows16(XB, (const bf16*)(ws + WS_WF1), SS + 32 * M, args.in[20], (float*)(ws + WS_LOGF), r * 16, lane);
    GRID_BAR();
    { const attn_body::AttnTensors AT{(const attn_body::bf16*)(ws + WS_QKV1), (const attn_body::bf16*)(ws + WS_QKV1 + 32 * MiB), (const attn_body::bf16*)(ws + WS_QKV1 + 64 * MiB), (attn_body::bf16*)(ws + WS_QKV1), (const float*)(ws + WS_LOGF), (const unsigned*)(ctl + CW_KN)};
      constexpr int N_ATT = 1024, N_CVB = MOE_XITEMS / 32, N_GRP = (N_ATT + 2) / 3 > (N_CVB + 1) / 2 ? (N_ATT + 2) / 3 : (N_CVB + 1) / 2;
      for (;;) {
          if (tid == 0) MISC[16] = __hip_atomic_fetch_add(ctl + CW_QUEUE, 1u, RLX_AGENT);
          __syncthreads();
          const unsigned uq = __builtin_amdgcn_readfirstlane(MISC[16]);
          __syncthreads();
          if (uq >= 5u * N_GRP) break;
          const int grp = (int)(uq / 5u), rr = (int)(uq % 5u);
          if (rr & 1) { const int cb = 2 * grp + (rr >> 1);
              if (cb < N_CVB) { int lane_ = threadIdx.x & 63; asm volatile("" : "+v"(lane_));
                  LAS float* scr = (LAS float*)(lds + wave * XSCR_BYTES);
#pragma unroll 1
                  for (int j = 0; j < 4; j += 2) { const XTile t0 = moe_xtile(args, cb * 32 + wave * 4 + j, lane_), t1 = moe_xtile(args, cb * 32 + wave * 4 + j + 1, lane_);
                      f32x4 v0[16], v1[16]; float g0[16], g1[16]; xtile_load(t0, v0, g0, lane_); xtile_load(t1, v1, g1, lane_);
                      xtile_finish_fp8(t0, v0, g0, 64.f, scr, lane_); xtile_finish_fp8(t1, v1, g1, 64.f, scr, lane_); } }
          } else { const int au = 3 * grp + (rr >> 1);
              if (au < N_ATT) { const int bh = au & 31, qb = 31 - (au >> 5);
                  attn_body::attn_unit<8>(bh >> 4, bh & 15, qb, AT.Q, AT.K, AT.V, AT.O, (char*)lds_raw + RING_OFF, AT.logf + (size_t)bh * SEQ, AT.kn + (size_t)bh * 256, ws + WS_HMOE + 16 * MiB  ); } }
      } }
    GRID_BAR();
    { pg8::Gemm g{(const bf16*)(ws + WS_HMOE + 16 * MiB), (const bf16*)(ws + WS_WOUT1), D / 2, D / 2, D / 2, 0, 0}; pg8::StaticOrder S; S.init(M, D, 1, G, bx);
      pg8::EpiResid<false> E{X, X, XB, SS + 48 * M};
      pg8::gemm_phase<pg8::EpiResid<false>, pg8::StaticOrder, true, true, true>(lds + RING_OFF, g, S, E); }
    GRID_BAR();
    unsigned char* meta = ws + WS_META; unsigned char* XG = ws + WS_XG; float* RSS = (float*)(meta + MT_RSS);
    {
        const float* wr = args.in[23]; const float* gn = args.in[22];
        LAS unsigned* lcnt = (LAS unsigned*)(lds + 1024);
        LAS unsigned* mst = (LAS unsigned*)(lds + 2048);
        LAS unsigned* rowst = (LAS unsigned*)(lds + 4096);
        if (tid < 16) lcnt[tid] = 0u;
        __syncthreads();
        float wl[16][NEXP];
#pragma unroll
        for (int j = 0; j < 4; ++j) { const int k0 = 4 * lane + 256 * j; const f32x4 gv = *(const f32x4*)(gn + k0);
#pragma unroll
            for (int q = 0; q < 4; ++q) { const f32x4 w0 = *(const f32x4*)(wr + (size_t)(k0 + q) * NEXP), w1 = *(const f32x4*)(wr + (size_t)(k0 + q) * NEXP + 4);
                wl[4 * j + q][0] = gv[q] * w0.x; wl[4 * j + q][1] = gv[q] * w0.y; wl[4 * j + q][2] = gv[q] * w0.z; wl[4 * j + q][3] = gv[q] * w0.w;
                wl[4 * j + q][4] = gv[q] * w1.x; wl[4 * j + q][5] = gv[q] * w1.y; wl[4 * j + q][6] = gv[q] * w1.z; wl[4 * j + q][7] = gv[q] * w1.w; } }
        f32x4 xn[4];
        if (gw < M) {
#pragma unroll
            for (int j = 0; j < 4; ++j) xn[j] = ((const GAS f32x4*)(X + (size_t)gw * D) + lane)[64 * j]; }
        const bool hb5 = (lane & 32) != 0, hb4 = (lane & 16) != 0, hb3 = (lane & 8) != 0;
        for (int tok = gw; tok < M; tok += NGW) {
            f32x4 xv[4];
#pragma unroll
            for (int j = 0; j < 4; ++j) xv[j] = xn[j];
            if (tok + NGW < M) {
#pragma unroll
                for (int j = 0; j < 4; ++j) xn[j] = ((const GAS f32x4*)(X + (size_t)(tok + NGW) * D) + lane)[64 * j]; }
            float lg[NEXP]; float s = 0.f; const int ti = (tok - gw) / NGW;
#pragma unroll
            for (int e = 0; e < NEXP; ++e) lg[e] = 0.f;
#pragma unroll
            for (int j = 0; j < 4; ++j) { const f32x4 v = xv[j]; s += (v.x * v.x + v.y * v.y) + (v.z * v.z + v.w * v.w);
                if (ti < 8) rowst[((wave * 8 + ti) * 256) + lane + 64 * j] = pg8::pk_fp8x4(v.x, v.y, v.z, v.w);
#pragma unroll
                for (int q = 0; q < 4; ++q)
#pragma unroll
                    for (int e = 0; e < NEXP; ++e) lg[e] = fmaf(v[q], wl[4 * j + q][e], lg[e]); }
            s = wave_sum(s);
            float a4[4], a2[2], a1;
#pragma unroll
            for (int i = 0; i < 4; ++i) { const float snd = hb5 ? lg[i] : lg[i + 4], kp = hb5 ? lg[i + 4] : lg[i]; a4[i] = kp + __shfl_xor(snd, 32); }
#pragma unroll
            for (int i = 0; i < 2; ++i) { const float snd = hb4 ? a4[i] : a4[i + 2], kp = hb4 ? a4[i + 2] : a4[i]; a2[i] = kp + __shfl_xor(snd, 16); }
            { const float snd = hb3 ? a2[0] : a2[1], kp = hb3 ? a2[1] : a2[0]; a1 = kp + __shfl_xor(snd, 8); }
            a1 += __shfl_xor(a1, 4); a1 += __shfl_xor(a1, 2); a1 += __shfl_xor(a1, 1);
#pragma unroll
            for (int e = 0; e < NEXP; ++e) lg[e] = __builtin_bit_cast(float, __builtin_amdgcn_readlane(__builtin_bit_cast(int, a1), 8 * e));
            if (lane == 0) {
                const float rs = 1.0f / sqrtf(s * (1.0f / 1024.0f) + pg8::RMS_EPS);
                int i1 = 0; float v1 = lg[0];
#pragma unroll
                for (int e = 1; e < NEXP; ++e) if (lg[e] > v1) { v1 = lg[e]; i1 = e; }
                int i2 = -1; float v2 = -INFINITY;
#pragma unroll
                for (int e = 0; e < NEXP; ++e) if (e != i1 && lg[e] > v2) { v2 = lg[e]; i2 = e; }
                const float g1 = 1.f / (1.f + expf((v2 - v1) * rs)), g2 = 1.f - g1;
                const unsigned p1 = __hip_atomic_fetch_add(lcnt + i1, 1u, __ATOMIC_RELAXED, __HIP_MEMORY_SCOPE_WORKGROUP), p2 = __hip_atomic_fetch_add(lcnt + i2, 1u, __ATOMIC_RELAXED, __HIP_MEMORY_SCOPE_WORKGROUP);
                ((float*)(meta + MT_RSTD))[tok] = rs; ((unsigned*)(meta + MT_TOKE))[tok] = (unsigned)i1 | ((unsigned)i2 << 8);
                ((unsigned*)(meta + MT_TOKP))[2 * tok] = p1; ((unsigned*)(meta + MT_TOKP))[2 * tok + 1] = p2;
                ((float*)(meta + MT_TOKG))[2 * tok] = g1; ((float*)(meta + MT_TOKG))[2 * tok + 1] = g2;
                if (ti < 8) { LAS unsigned* ms = mst + (wave * 8 + ti) * 4; ms[0] = (unsigned)i1 | ((unsigned)i2 << 8); ms[1] = __float_as_uint(rs); ms[2] = p1; ms[3] = p2; }
            }
        }
        __syncthreads();
        if (tid < NEXP) lcnt[8 + tid] = __hip_atomic_fetch_add(ctl + CW_CNT + 64 * tid, lcnt[tid], RLX_AGENT);
        VM_WAIT();
        __syncthreads();
        for (int tok = gw; tok < M; tok += NGW) {
            const int ti = (tok - gw) / NGW; unsigned w[4]; unsigned ee, q1, q2; float rs;
            if (ti < 8) { const LAS unsigned* ms = mst + (wave * 8 + ti) * 4; ee = ms[0]; rs = __uint_as_float(ms[1]); q1 = ms[2]; q2 = ms[3]; }
            else { ee = ((const unsigned*)(meta + MT_TOKE))[tok]; rs = ((const float*)(meta + MT_RSTD))[tok]; q1 = ((const unsigned*)(meta + MT_TOKP))[2 * tok]; q2 = ((const unsigned*)(meta + MT_TOKP))[2 * tok + 1]; }
            if (ti < 8) {
#pragma unroll
                for (int j = 0; j < 4; ++j) w[j] = rowst[((wave * 8 + ti) * 256) + lane + 64 * j];
            } else {
#pragma unroll
                for (int j = 0; j < 4; ++j) { const f32x4 v = ((const GAS f32x4*)(X + (size_t)tok * D) + lane)[64 * j]; w[j] = pg8::pk_fp8x4(v.x, v.y, v.z, v.w); } }
            const int e1 = (int)(ee & 0xffu), e2 = (int)((ee >> 8) & 0xffu);
            const unsigned p1 = q1 + lcnt[8 + e1], p2 = q2 + lcnt[8 + e2];
            const size_t r1 = (size_t)e1 * MOE_CAP + p1, r2 = (size_t)e2 * MOE_CAP + p2;
#pragma unroll
            for (int j = 0; j < 4; ++j) { *(unsigned*)(XG + r1 * D + 4 * lane + 256 * j) = w[j]; *(unsigned*)(XG + r2 * D + 4 * lane + 256 * j) = w[j]; }
            if (lane == 0) { RSS[r1] = rs; RSS[r2] = rs; ((unsigned*)(meta + MT_TOKP))[2 * tok] = p1; ((unsigned*)(meta + MT_TOKP))[2 * tok + 1] = p2; }
        }
    }
    GRID_BAR();
    int pref[NEXP + 1], cnt[NEXP];
    { pref[0] = 0;
#pragma unroll
      for (int e = 0; e < NEXP; ++e) { cnt[e] = (int)__builtin_amdgcn_readfirstlane(__hip_atomic_load(ctl + CW_CNT + 64 * e, RLX_AGENT)); pref[e + 1] = pref[e] + (cnt[e] + 255) / 256; } }
    const int NP = pref[NEXP];
    bf16* YS = (bf16*)(ws + WS_Y);
    { pg8::Gemm g{(const bf16*)XG, (const bf16*)(ws + WS_WMOE_GU), D / 2, D / 2, D / 2, 0, (size_t)7168 * 1024}; MoeOrder S; S.S.nM = NP; S.S.nN = 28; S.S.nZ = 1; S.S.nwg = NP * 28; S.S.G = G; S.S.c = bx; S.lo = 0; S.cap_rows = true;
#pragma unroll
      for (int e = 0; e <= NEXP; ++e) S.pref[e] = pref[e];
      pg8::EpiSwiGluFp8 E{RSS, ws + WS_HMOE, DFE};
      pg8::gemm_phase<pg8::EpiSwiGluFp8, MoeOrder, true, true, true>(lds + RING_OFF, g, S, E); }
    GRID_BAR();
    { pg8::Gemm g{(const bf16*)(ws + WS_HMOE), (const bf16*)(ws + WS_WMOE_D), DFE / 2, DFE / 2, DFE / 2, 0, (size_t)1024 * 3584}; const int NPM = NP < 2 * G / 4 ? NP : 2 * G / 4;
      MoeOrder S; S.S.nM = NPM; S.S.nN = 4; S.S.nZ = 1; S.S.nwg = NPM * 4; S.S.G = G; S.S.c = bx; S.lo = 0; S.cap_rows = false;
#pragma unroll
      for (int e = 0; e <= NEXP; ++e) S.pref[e] = pref[e];
      pg8::EpiStoreBf16 E{YS, D};
      pg8::gemm_phase<pg8::EpiStoreBf16, MoeOrder, true, true, true>(lds + RING_OFF, g, S, E);
      if (NP > NPM) { MoeQuadOrder Q; Q.p0 = NPM; Q.np = NP - NPM; Q.G = G; Q.c = bx;
#pragma unroll
          for (int e = 0; e <= NEXP; ++e) Q.pref[e] = pref[e];
          pg8::EpiStoreQuad EQ{YS, D};
          pg8::gemm_phase<pg8::EpiStoreQuad, MoeQuadOrder, true, true, true, true>(lds + RING_OFF, g, Q, EQ); } }
    GRID_BAR();
    {
        const float* gf = args.in[27];
        for (int tok = gw; tok < M; tok += NGW) {
            const unsigned ee = ((const unsigned*)(meta + MT_TOKE))[tok]; int pe0 = 0, pe1 = 0;
#pragma unroll
            for (int q = 0; q < NEXP; ++q) { pe0 = (q == (int)(ee & 0xffu)) ? pref[q] : pe0; pe1 = (q == (int)((ee >> 8) & 0xffu)) ? pref[q] : pe1; }
            const unsigned s0 = (unsigned)pe0 * 256u + ((const unsigned*)(meta + MT_TOKP))[2 * tok], s1 = (unsigned)pe1 * 256u + ((const unsigned*)(meta + MT_TOKP))[2 * tok + 1];
            const float g0 = ((const float*)(meta + MT_TOKG))[2 * tok], g1 = ((const float*)(meta + MT_TOKG))[2 * tok + 1];
            GAS f32x4* xr = (GAS f32x4*)(X + (size_t)tok * D) + lane; f32x4 v[4]; float s = 0.f;
#pragma unroll
            for (int j = 0; j < 4; ++j) { v[j] = xr[64 * j]; const int k0 = 4 * lane + 256 * j;
                const v2u a = *(const v2u*)(YS + (size_t)s0 * D + k0), b2 = *(const v2u*)(YS + (size_t)s1 * D + k0);
                v[j].x += g0 * bflo(a.x) + g1 * bflo(b2.x); v[j].y += g0 * bfhi(a.x) + g1 * bfhi(b2.x); v[j].z += g0 * bflo(a.y) + g1 * bflo(b2.y); v[j].w += g0 * bfhi(a.y) + g1 * bfhi(b2.y);
                s += (v[j].x * v[j].x + v[j].y * v[j].y) + (v[j].z * v[j].z + v[j].w * v[j].w); }
            s = wave_sum(s); const float rs = 1.0f / sqrtf(s * (1.0f / 1024.0f) + pg8::RMS_EPS);
#pragma unroll
            for (int j = 0; j < 4; ++j) { const f32x4 gv = *(const f32x4*)(gf + 4 * lane + 256 * j); xr[64 * j] = v[j] * rs * gv; }
        }
    }
}

extern "C" void kernel_launch(void* const* d_in, const int* in_sizes, int n_in, void* d_out, int out_size, void* d_ws, size_t ws_size, hipStream_t stream) {
    static int grid = 0;
    if (grid == 0) {
        if (n_in != 28 || in_sizes[0] != M * D || out_size != M * D || ws_size < WS_END) { fprintf(stderr, "kernel_launch: unexpected problem: n_in %d in0 %d out %d ws %zu (need %zu)\n", n_in, n_in > 0 ? in_sizes[0] : -1, out_size, ws_size, (size_t)WS_END); grid = -1; return; }
        int dev = 0, cus = 0, per_cu = 0;
        if (hipGetDevice(&dev) != hipSuccess || hipDeviceGetAttribute(&cus, hipDeviceAttributeMultiprocessorCount, dev) != hipSuccess) { grid = -1; return; }
        if (hipFuncSetAttribute((const void*)mk_fwd, hipFuncAttributeMaxDynamicSharedMemorySize, LDS_BYTES) != hipSuccess) { fprintf(stderr, "kernel_launch: hipFuncSetAttribute failed\n"); grid = -1; return; }
        if (hipOccupancyMaxActiveBlocksPerMultiprocessor(&per_cu, (const void*)mk_fwd, NTHREADS, LDS_BYTES) != hipSuccess || per_cu < 1) fprintf(stderr, "kernel_launch: occupancy query says %d\n", per_cu);
        (void)hipGetLastError();
        grid = cus;
        if (grid != 256) fprintf(stderr, "kernel_launch: built for the 256-CU MI355X; device reports %d CUs\n", cus);
    }
    if (grid < 0) return;
    if (hipMemsetAsync((char*)d_ws + WS_CTL, 0, CTL_ZERO_BYTES, stream) != hipSuccess) return;
    Args a{};
    for (int i = 0; i < 28; ++i) a.in[i] = (const float*)d_in[i];
    a.out = (float*)d_out; a.ws = (unsigned char*)d_ws;
    hipLaunchKernelGGL(mk_fwd, dim3(grid), dim3(NTHREADS), LDS_BYTES, stream, a);
}
```

```cpp
#include <hip/hip_runtime.h>
#include <cstdio>
#include <cstdint>

namespace pg8 {
#define PG8_LAS __attribute__((address_space(3)))
typedef unsigned short bf16_t;
typedef short bf16x8 __attribute__((ext_vector_type(8)));
typedef float f32x4 __attribute__((ext_vector_type(4)));
typedef unsigned u32x4 __attribute__((ext_vector_type(4)));
typedef unsigned u32x2 __attribute__((ext_vector_type(2)));
constexpr int BM = 256, BK = 64, HALF = 128, HTB = HALF * BK * 2  , STAGE_BYTES = 8 * HTB, NXCD = 8, WGM = 8;

__host__ __device__ __forceinline__ int lds_byte(int r, int c) { const int st = (r >> 4) * 2 + (c >> 5), rr = r & 15, cc = c & 31, ob = rr * 64 + cc * 2; return st * 1024 + (ob ^ (((ob >> 9) & 1) << 5)); }
__host__ __device__ __forceinline__ void stage_rc(int b, int& R, int& C) { const int st = b / 1024, sb = b % 1024, swz = sb ^ (((sb >> 9) & 1) << 5); R = (st >> 1) * 16 + swz / 64; C = (st & 1) * 32 + (swz % 64) / 2; }
__host__ __device__ __forceinline__ int perm32(int rho) { const int n = rho >> 4, i = rho & 15; return 8 * (i >> 2) + 4 * n + (i & 3); }

struct Unit { int pm, pn, zb, pa, qa, qb; };
struct Gemm { const bf16_t* A; const bf16_t* Bt; int lda, ldb, K; size_t zA, zB; };

struct StaticOrder {
    int nM, nN, nZ, nwg, G, c;
    __host__ __device__ void init(int M, int N, int Z, int G_, int c_) { nM = M / BM; nN = N / BM; nZ = Z; nwg = nM * nN * nZ; G = G_; c = c_; }
    __host__ __device__ bool next(int i, Unit& u) const {
        const long L = (long)i * G + c; if (L >= nwg) return false;
        int wgid = (int)L; { const int q = nwg / NXCD, r = nwg % NXCD, xcd = wgid % NXCD, off = wgid / NXCD; wgid = (xcd < r ? xcd * (q + 1) : r * (q + 1) + (xcd - r) * q) + off; }
        const int per = nM * nN; u.zb = wgid / per; wgid -= u.zb * per;
        const int nig = WGM * nN, gid = wgid / nig, fm = gid * WGM, gsz = (nM - fm) < WGM ? (nM - fm) : WGM;
        u.pm = fm + ((wgid % nig) % gsz); u.pn = (wgid % nig) / gsz; u.pa = u.pm; u.qa = 0; u.qb = 0; return true;
    }
    __device__ __forceinline__ void a_ready(const Unit&) const {}
    __device__ __forceinline__ void done(const Unit&) const {}
};

__device__ __forceinline__ unsigned cvt_pk_bf16(float lo, float hi) { unsigned r; asm volatile("v_cvt_pk_bf16_f32 %0, %1, %2" : "=v"(r) : "v"(lo), "v"(hi)); return r; }
typedef int v4i_t __attribute__((ext_vector_type(4))); typedef int v8i_t __attribute__((ext_vector_type(8)));
__device__ __forceinline__ v8i_t cat8(bf16x8 a, bf16x8 b) { return __builtin_shufflevector(__builtin_bit_cast(v4i_t, a), __builtin_bit_cast(v4i_t, b), 0, 1, 2, 3, 4, 5, 6, 7); }
__device__ __forceinline__ unsigned pk_fp8x4(float a, float b, float c, float d) { int r = 0; r = __builtin_amdgcn_cvt_pk_fp8_f32(a, b, r, false); r = __builtin_amdgcn_cvt_pk_fp8_f32(c, d, r, true); return (unsigned)r; }
__device__ __forceinline__ float bf_lo(unsigned w) { return __uint_as_float(w << 16); }
__device__ __forceinline__ float bf_hi(unsigned w) { return __uint_as_float(w & 0xffff0000u); }
__device__ __forceinline__ float fast_sigmoid(float z) { return __builtin_amdgcn_rcpf(1.0f + __builtin_amdgcn_exp2f(-1.4426950408889634f * z)); }
__device__ __forceinline__ f32x4 swiglu4(const f32x4 g, const f32x4 u, const float c1, const float rs2) {
    const f32x4 t = g * c1; f32x4 e;
#pragma unroll
    for (int i = 0; i < 4; ++i) e[i] = __builtin_amdgcn_exp2f(t[i]);
    const f32x4 d = e + 1.0f; f32x4 r;
#pragma unroll
    for (int i = 0; i < 4; ++i) r[i] = __builtin_amdgcn_rcpf(d[i]);
    return (g * u) * (r * rs2);
}
constexpr float RMS_EPS = 1e-6f;
__device__ __forceinline__ float rstd16(const float* ssp, int row) { const f32x4* p = (const f32x4*)(ssp + (size_t)row * 16); const f32x4 a = p[0], b = p[1], c = p[2], d = p[3];
    const float s = (((a[0] + a[1]) + (a[2] + a[3])) + ((b[0] + b[1]) + (b[2] + b[3]))) + (((c[0] + c[1]) + (c[2] + c[3])) + ((d[0] + d[1]) + (d[2] + d[3])));
    return __builtin_amdgcn_rsqf(s * (1.0f / 1024.0f) + RMS_EPS); }

__device__ __forceinline__ void rstd8(const float* ssp, int row0, int fq, float (&rs)[8]) {
    f32x4 p[8];
#pragma unroll
    for (int i = 0; i < 8; ++i) p[i] = *(const f32x4*)(ssp + (size_t)(row0 + (i >> 2) * HALF + (i & 3) * 16) * 16 + 4 * fq);
#pragma unroll
    for (int i = 0; i < 8; ++i) { float q = (p[i][0] + p[i][1]) + (p[i][2] + p[i][3]); q += __shfl_xor(q, 16); q += __shfl_xor(q, 32); rs[i] = __builtin_amdgcn_rsqf(q * (1.0f / 1024.0f) + RMS_EPS); }
}
__device__ __forceinline__ u32x4 pack8(const f32x4 v0, const f32x4 v1) { u32x4 w; w.x = cvt_pk_bf16(v0[0], v0[1]); w.y = cvt_pk_bf16(v0[2], v0[3]); w.z = cvt_pk_bf16(v1[0], v1[1]); w.w = cvt_pk_bf16(v1[2], v1[3]); return w; }

struct EpiInProj0 {
    static constexpr bool PERM = true, AFTER_DRAIN = false;
    const float* ss; bf16_t* uext; bf16_t* qkv; float qscale;
    __device__ __forceinline__ void operator()(const f32x4 (&acc)[2][2][4][2], const Unit& u, int wr, int wc, int fr, int fq) const {
        const int row0 = u.pm * BM + wr * 64 + fr; float rsa[8]; rstd8(ss, row0, fq, rsa);
#pragma unroll
        for (int ai = 0; ai < 2; ++ai)
#pragma unroll
            for (int m = 0; m < 4; ++m) { const int row = row0 + ai * HALF + m * 16; const float rs = rsa[ai * 4 + m];
#pragma unroll
                for (int bj = 0; bj < 2; ++bj) { const int col0 = u.pn * BM + bj * HALF + wc * 32 + 8 * fq;
                    float sc = rs; bf16_t* dst;
                    if (u.pn < 2) dst = uext + ((size_t)(col0 >> 4) * 512 + (row >> 5)) * 640 + (row & 31) * 16 + (col0 & 15);
                    else { const int c = col0 - 512; if (c < 512) sc *= qscale; dst = qkv + (size_t)row * 1536 + c; }
                    *(u32x4*)dst = pack8(acc[ai][bj][m][0] * sc, acc[ai][bj][m][1] * sc); } }
    }
};
struct EpiS5State {
    static constexpr bool PERM = false, AFTER_DRAIN = false;
    float* sloc;
    __device__ __forceinline__ void operator()(const f32x4 (&acc)[2][2][4][2], const Unit& u, int wr, int wc, int fr, int fq) const {
        const int row0 = u.pm * BM + wr * 64 + fr, col0 = wc * 32 + 4 * fq;
#pragma unroll
        for (int ai = 0; ai < 2; ++ai)
#pragma unroll
            for (int m = 0; m < 4; ++m) { float* rowp = sloc + ((size_t)u.zb * 512 + row0 + ai * HALF + m * 16) * 128 + col0;
#pragma unroll
                for (int n = 0; n < 2; ++n) *(f32x4*)(rowp + n * 16) = acc[ai][0][m][n]; }
    }
};
__device__ __forceinline__ float gelu_tanh(float x) { const float a = x * (1.0f + 0.044715f * x * x); return x * __builtin_amdgcn_rcpf(1.0f + __builtin_amdgcn_exp2f(-2.302208198f * a)); }
struct EpiS5Y {
    static constexpr bool PERM = true, AFTER_DRAIN = false;
    bf16_t* yg;
    __device__ __forceinline__ void operator()(const f32x4 (&acc)[2][2][4][2], const Unit& u, int wr, int wc, int fr, int fq) const {
        const int row0 = u.pm * BM + wr * 64 + fr;
#pragma unroll
        for (int ai = 0; ai < 2; ++ai)
#pragma unroll
            for (int m = 0; m < 4; ++m) { const int chunk = row0 + ai * HALF + m * 16;
#pragma unroll
                for (int bj = 0; bj < 2; ++bj) { const int col0 = u.pn * BM + bj * HALF + wc * 32 + 8 * fq; const int i = col0 >> 4, h0 = col0 & 15;
                    f32x4 v0 = acc[ai][bj][m][0], v1 = acc[ai][bj][m][1];
#pragma unroll
                    for (int e = 0; e < 4; ++e) { v0[e] = gelu_tanh(v0[e]); v1[e] = gelu_tanh(v1[e]); }
                    *(u32x4*)(yg + ((size_t)chunk * 32 + i) * 512 + u.zb * 16 + h0) = pack8(v0, v1); } }
    }
};
struct EpiGlu {
    static constexpr bool PERM = true, AFTER_DRAIN = false;
    const bf16_t* yg; const float* bias; bf16_t* mix;
    __device__ __forceinline__ void operator()(const f32x4 (&acc)[2][2][4][2], const Unit& u, int wr, int wc, int fr, int fq) const {
        const int row0 = u.pm * BM + wr * 64 + fr; u32x4 ywa[2][8];
#pragma unroll
        for (int bj = 0; bj < 2; ++bj)
#pragma unroll
            for (int i = 0; i < 8; ++i) ywa[bj][i] = *(const u32x4*)(yg + (size_t)(row0 + (i >> 2) * HALF + (i & 3) * 16) * 512 + u.pn * BM + bj * HALF + wc * 32 + 8 * fq);
#pragma unroll
        for (int bj = 0; bj < 2; ++bj) { const int col0 = u.pn * BM + bj * HALF + wc * 32 + 8 * fq;
            const f32x4 b0 = *(const f32x4*)(bias + col0), b1 = *(const f32x4*)(bias + col0 + 4);
#pragma unroll
            for (int ai = 0; ai < 2; ++ai)
#pragma unroll
                for (int m = 0; m < 4; ++m) { const int row = row0 + ai * HALF + m * 16;
                    const u32x4 yw = ywa[bj][ai * 4 + m];
                    f32x4 z0 = acc[ai][bj][m][0] + b0, z1 = acc[ai][bj][m][1] + b1, o0, o1;
                    o0[0] = bf_lo(yw.x) * fast_sigmoid(z0[0]); o0[1] = bf_hi(yw.x) * fast_sigmoid(z0[1]); o0[2] = bf_lo(yw.y) * fast_sigmoid(z0[2]); o0[3] = bf_hi(yw.y) * fast_sigmoid(z0[3]);
                    o1[0] = bf_lo(yw.z) * fast_sigmoid(z1[0]); o1[1] = bf_hi(yw.z) * fast_sigmoid(z1[1]); o1[2] = bf_lo(yw.w) * fast_sigmoid(z1[2]); o1[3] = bf_hi(yw.w) * fast_sigmoid(z1[3]);
                    *(u32x4*)(mix + (size_t)row * 1024 + col0) = pack8(o0, o1); } }
    }
};
template <bool XBOUT> struct EpiResid {
    static constexpr bool PERM = false, AFTER_DRAIN = false;
    const float* R; float* X; bf16_t* xb; float* ssq; unsigned char* xq = nullptr;
    __device__ __forceinline__ void operator()(const f32x4 (&acc)[2][2][4][2], const Unit& u, int wr, int wc, int fr, int fq) const {
        const int row0 = u.pm * BM + wr * 64 + fr, col0 = u.pn * BM + wc * 32 + 4 * fq;
#pragma unroll
        for (int ai = 0; ai < 2; ++ai) {
            f32x4 rv[4][2][2];
#pragma unroll
            for (int m = 0; m < 4; ++m)
#pragma unroll
                for (int bj = 0; bj < 2; ++bj)
#pragma unroll
                    for (int n = 0; n < 2; ++n) rv[m][bj][n] = *(const f32x4*)(R + (size_t)(row0 + ai * HALF + m * 16) * 1024 + col0 + bj * HALF + n * 16);
            asm volatile("" ::: "memory");
#pragma unroll
            for (int m = 0; m < 4; ++m) { const int row = row0 + ai * HALF + m * 16; const size_t off = (size_t)row * 1024 + col0; float s = 0.f;
#pragma unroll
                for (int bj = 0; bj < 2; ++bj)
#pragma unroll
                    for (int n = 0; n < 2; ++n) { const f32x4 x = rv[m][bj][n] + acc[ai][bj][m][n];
                        *(f32x4*)(X + off + bj * HALF + n * 16) = x; s += (x[0] * x[0] + x[1] * x[1]) + (x[2] * x[2] + x[3] * x[3]);
                        if (XBOUT) { u32x2 w; w.x = cvt_pk_bf16(x[0], x[1]); w.y = cvt_pk_bf16(x[2], x[3]); *(u32x2*)(xb + off + bj * HALF + n * 16) = w;
                            if (xq) *(unsigned*)(xq + off + bj * HALF + n * 16) = pk_fp8x4(x[0], x[1], x[2], x[3]); } }
                s += __shfl_xor(s, 16); s += __shfl_xor(s, 32);
                if (XBOUT && fq == 0) ssq[(size_t)row * 16 + u.pn * 4 + wc] = s; }
            asm volatile("" ::: "memory"); }
    }
};
template <bool RS_IS_SSQ> struct EpiSwiGlu {
    static constexpr bool PERM = true, AFTER_DRAIN = false;
    const float* rsv; bf16_t* H; int ldh;
    __device__ __forceinline__ void operator()(const f32x4 (&acc)[2][2][4][2], const Unit& u, int wr, int wc, int fr, int fq) const {
        const int row0 = u.pm * BM + wr * 64 + fr, col0 = u.pn * HALF + wc * 32 + 8 * fq; float rsa[8];
        if (RS_IS_SSQ) rstd8(rsv, row0, fq, rsa);
        else {
#pragma unroll
            for (int i = 0; i < 8; ++i) rsa[i] = rsv[row0 + (i >> 2) * HALF + (i & 3) * 16]; }
#pragma unroll
        for (int ai = 0; ai < 2; ++ai)
#pragma unroll
            for (int m = 0; m < 4; ++m) { const int row = row0 + ai * HALF + m * 16; const float rs = rsa[ai * 4 + m], c1 = -1.4426950408889634f * rs, rs2 = rs * rs;
                f32x4 o[2];
#pragma unroll
                for (int n = 0; n < 2; ++n) o[n] = swiglu4(acc[ai][0][m][n], acc[ai][1][m][n], c1, rs2);
                *(u32x4*)(H + (size_t)row * ldh + col0) = pack8(o[0], o[1]); }
    }
};
struct EpiSwiGluFp8 {
    static constexpr bool PERM = true, AFTER_DRAIN = false;
    const float* rsv; unsigned char* H; int ldh;
    __device__ __forceinline__ void operator()(const f32x4 (&acc)[2][2][4][2], const Unit& u, int wr, int wc, int fr, int fq) const {
        const int row0 = u.pm * BM + wr * 64 + fr, col0 = u.pn * HALF + wc * 32 + 8 * fq; float rsa[8];
#pragma unroll
        for (int i = 0; i < 8; ++i) rsa[i] = rsv[u.pa * BM + wr * 64 + fr + (i >> 2) * HALF + (i & 3) * 16];
#pragma unroll
        for (int ai = 0; ai < 2; ++ai)
#pragma unroll
            for (int m = 0; m < 4; ++m) { const int row = row0 + ai * HALF + m * 16; const float rs = rsa[ai * 4 + m], c1 = -1.4426950408889634f * rs, rs2 = rs * rs;
                f32x4 o[2];
#pragma unroll
                for (int n = 0; n < 2; ++n) o[n] = swiglu4(acc[ai][0][m][n], acc[ai][1][m][n], c1, rs2);
                u32x2 w; w.x = pk_fp8x4(o[0][0], o[0][1], o[0][2], o[0][3]); w.y = pk_fp8x4(o[1][0], o[1][1], o[1][2], o[1][3]);
                *(u32x2*)(H + (size_t)row * ldh + col0) = w; }
    }
};
struct EpiInProj1 {
    static constexpr bool PERM = true, AFTER_DRAIN = false;
    const float* ss; bf16_t* qkv; float qscale;
    unsigned* kn;
    __device__ __forceinline__ void operator()(const f32x4 (&acc)[2][2][4][2], const Unit& u, int wr, int wc, int fr, int fq) const {
        const int row0 = u.pm * BM + wr * 64 + fr; const float qs = (u.pn < 4) ? qscale : 1.0f; float rsa[8]; rstd8(ss, row0, fq, rsa);
#pragma unroll
        for (int ai = 0; ai < 2; ++ai)
#pragma unroll
            for (int m = 0; m < 4; ++m) { const int row = row0 + ai * HALF + m * 16; const float sc = rsa[ai * 4 + m] * qs;
#pragma unroll
                for (int bj = 0; bj < 2; ++bj) { const int col0 = (u.pn & 3) * BM + bj * HALF + wc * 32 + 8 * fq;
                    const f32x4 v0 = acc[ai][bj][m][0] * sc, v1 = acc[ai][bj][m][1] * sc;
                    *(u32x4*)(qkv + (size_t)(u.pn >> 2) * (16384 * 1024) + (size_t)row * 1024 + col0) = pack8(v0, v1);
                    if ((u.pn >> 2) == 1) {
                        float q = ((v0[0] * v0[0] + v0[1] * v0[1]) + (v0[2] * v0[2] + v0[3] * v0[3])) + ((v1[0] * v1[0] + v1[1] * v1[1]) + (v1[2] * v1[2] + v1[3] * v1[3]));
                        q += __shfl_xor(q, 16); q += __shfl_xor(q, 32);
                        q = fmaxf(q, __shfl_xor(q, 1)); q = fmaxf(q, __shfl_xor(q, 2)); q = fmaxf(q, __shfl_xor(q, 4)); q = fmaxf(q, __shfl_xor(q, 8));
                        if (fr == 0 && fq == 0) { const int head = (u.pn & 3) * 4 + bj * 2 + (wc >> 1), bb = row >> 13, tile = (row & 8191) >> 6;
                            atomicMax(kn + ((size_t)(bb * 16 + head) * 128 + tile) * 2 + (wc & 1), __float_as_uint(q * 1.01f)); } } } }
    }
};
struct EpiStoreBf16 {
    static constexpr bool PERM = true, AFTER_DRAIN = false;
    bf16_t* O; int ldc;
    __device__ __forceinline__ void operator()(const f32x4 (&acc)[2][2][4][2], const Unit& u, int wr, int wc, int fr, int fq) const {
        const int row0 = u.pm * BM + wr * 64 + fr;
#pragma unroll
        for (int ai = 0; ai < 2; ++ai)
#pragma unroll
            for (int m = 0; m < 4; ++m) { const int row = row0 + ai * HALF + m * 16;
#pragma unroll
                for (int bj = 0; bj < 2; ++bj) { const int col0 = u.pn * BM + bj * HALF + wc * 32 + 8 * fq;
                    *(u32x4*)(O + (size_t)row * ldc + col0) = pack8(acc[ai][bj][m][0], acc[ai][bj][m][1]); } }
    }
};

struct EpiStoreQuad {
    static constexpr bool PERM = true, AFTER_DRAIN = false;
    bf16_t* O; int ldc;
    __device__ __forceinline__ void operator()(const f32x4 (&acc)[2][2][4][2], const Unit& u, int wr, int wc, int fr, int fq) const {
        const int row0 = u.pm * BM + u.qa * HALF + wr * 64 + fr, col0 = u.pn * BM + u.qb * HALF + wc * 32 + 8 * fq;
#pragma unroll
        for (int m = 0; m < 4; ++m) *(u32x4*)(O + (size_t)(row0 + m * 16) * ldc + col0) = pack8(acc[0][0][m][0], acc[0][0][m][1]);
    }
};

typedef float f32x2z __attribute__((ext_vector_type(2)));
__device__ __forceinline__ f32x4 zero4_b64() { f32x2z a, b; asm volatile("v_mov_b64 %0, 0" : "=v"(a)); asm volatile("v_mov_b64 %0, 0" : "=v"(b)); return (f32x4){a[0], a[1], b[0], b[1]}; }
template <bool F8> struct Frag { bf16x8 k[2]; };
template <> struct Frag<true> { v8i_t v; };
template <class Epi, class Sched, bool ALIGN_EPI = false, bool SP2 = false, bool FP8 = false, bool QUAD = false>
__device__ __forceinline__ void gemm_phase(PG8_LAS unsigned char* lds, const Gemm g, const Sched& S, const Epi& E) {
    int tid_ = threadIdx.x; asm volatile("" : "+v"(tid_));
    const int tid = tid_, wid = __builtin_amdgcn_readfirstlane(tid >> 6), lane = tid & 63, wr = wid >> 2, wc = wid & 3, fr = lane & 15, fq = lane >> 4;
    const int K = g.K, nt = K / BK;
    unsigned voffA[2], voffB[2];
#pragma unroll
    for (int i = 0; i < 2; ++i) { int R, C; stage_rc(tid * 16 + i * 8192, R, C); const int Rb = Epi::PERM ? ((R & ~31) + perm32(R & 31)) : R;
        voffA[i] = (unsigned)(R * g.lda + C) * 2u; voffB[i] = (unsigned)(Rb * g.ldb + C) * 2u; }
    const size_t kstep = (size_t)(BK * 2);
    const size_t hstepA = (size_t)HALF * g.lda * 2, hstepB = (size_t)HALF * g.ldb * 2;
    const size_t tstepA = 2 * hstepA, tstepB = 2 * hstepB;
    const unsigned ldsw = (unsigned)wid * 1024u;
    const int aoff = lds_byte(wr * 64 + fr, fq * 8), boff = lds_byte(wc * 32 + fr, fq * 8);
#define PG8_SA(b, h) (((b) * 2 + (h)) * HTB)
#define PG8_SB(b, h) ((4 + (b) * 2 + (h)) * HTB)
#define PG8_STAGE(bufoff, gbase, voff) do { _Pragma("unroll") for (int _i = 0; _i < 2; ++_i) \
        __builtin_amdgcn_global_load_lds((const unsigned*)((const char*)(gbase) + (voff)[_i]), (PG8_LAS unsigned*)(lds + (bufoff) + ldsw + _i * 8192), 16, 0, 0); } while (0)
    const PG8_LAS unsigned char* ldsA_ = lds + aoff; const PG8_LAS unsigned char* ldsB_ = lds + 4 * HTB + boff; asm volatile("" : "+v"(ldsA_), "+v"(ldsB_));
#define PG8_RDA(off) (*(const PG8_LAS bf16x8*)(ldsA_ + (off)))
#define PG8_RDB(off) (*(const PG8_LAS bf16x8*)(ldsB_ + (off)))
#define PG8_LDA(dst, b, h) do { _Pragma("unroll") for (int m = 0; m < 4; ++m) { if constexpr (FP8) dst[m].v = cat8(PG8_RDA(PG8_SA(b, h) + m * 2048), PG8_RDA(PG8_SA(b, h) + m * 2048 + 1024)); \
        else { dst[m].k[0] = PG8_RDA(PG8_SA(b, h) + m * 2048); dst[m].k[1] = PG8_RDA(PG8_SA(b, h) + m * 2048 + 1024); } } } while (0)
#define PG8_LDB(dst, b, h) do { _Pragma("unroll") for (int n = 0; n < 2; ++n) { if constexpr (FP8) dst[n].v = cat8(PG8_RDB(PG8_SB(b, h) - 4 * HTB + n * 2048), PG8_RDB(PG8_SB(b, h) - 4 * HTB + n * 2048 + 1024)); \
        else { dst[n].k[0] = PG8_RDB(PG8_SB(b, h) - 4 * HTB + n * 2048); dst[n].k[1] = PG8_RDB(PG8_SB(b, h) - 4 * HTB + n * 2048 + 1024); } } } while (0)
#define PG8_MMA(ai, bj, At, Bt) do { if constexpr (!(QUAD && (((ai) | (bj)) != 0))) { __builtin_amdgcn_s_setprio(1); _Pragma("unroll") for (int m = 0; m < 4; ++m) _Pragma("unroll") for (int n = 0; n < 2; ++n) { \
        if constexpr (FP8) { asm volatile("v_mfma_scale_f32_16x16x128_f8f6f4 %0, %1, %2, %0, %3, %4 op_sel_hi:[0,0,0]" : "+v"(acc[ai][bj][m][n]) : "v"(Bt[n].v), "v"(At[m].v), "v"(sclB_), "v"(sclA_)); } \
        else { _Pragma("unroll") for (int k = 0; k < 2; ++k) acc[ai][bj][m][n] = __builtin_amdgcn_mfma_f32_16x16x32_bf16(Bt[n].k[k], At[m].k[k], acc[ai][bj][m][n], 0, 0, 0); } } __builtin_amdgcn_s_setprio(0); } } while (0)
#define PG8_WAIT_V(n) asm volatile("s_waitcnt vmcnt(" #n ")" ::: "memory")
#define PG8_WAIT_L(n) asm volatile("s_waitcnt lgkmcnt(" #n ")" ::: "memory")
#define PG8_BAR __builtin_amdgcn_s_barrier()
#define PG8_SCHED __builtin_amdgcn_sched_barrier(0)
    Unit cur, nxt; int ui = 0;
    if (!S.next(0, cur)) return;
    f32x4 acc[2][2][4][2];
#pragma unroll
    for (int a = 0; a < 2; ++a)
#pragma unroll
        for (int b = 0; b < 2; ++b)
#pragma unroll
            for (int m = 0; m < 4; ++m)
#pragma unroll
                for (int n = 0; n < 2; ++n) acc[a][b][m][n] = zero4_b64();
    Frag<FP8> At[4], B0[2], B1[2];
    int sclB_ = 0x79797979, sclA_ = 0x7f7f7f7f; asm volatile("" : "+v"(sclB_), "+v"(sclA_));
    const char* cA = (const char*)g.A + (size_t)cur.zb * g.zA + (size_t)cur.pa * tstepA + (QUAD ? (size_t)cur.qa * hstepA : 0); const char* cB = (const char*)g.Bt + (size_t)cur.zb * g.zB + (size_t)cur.pn * tstepB + (QUAD ? (size_t)cur.qb * hstepB : 0);
    S.a_ready(cur);
    if constexpr (SP2) {
        PG8_STAGE(PG8_SB(0, 0), cB, voffB); PG8_STAGE(PG8_SB(0, 1), cB + hstepB, voffB); PG8_STAGE(PG8_SA(0, 0), cA, voffA); PG8_STAGE(PG8_SA(0, 1), cA + hstepA, voffA);
        if (wr == 1) PG8_BAR;
        PG8_WAIT_V(2); PG8_BAR;
        PG8_STAGE(PG8_SB(1, 0), cB + kstep, voffB); PG8_STAGE(PG8_SA(1, 0), cA + kstep, voffA); PG8_STAGE(PG8_SB(1, 1), cB + hstepB + kstep, voffB);
        PG8_WAIT_V(6); PG8_BAR;
    } else {
        PG8_STAGE(PG8_SB(0, 0), cB, voffB); PG8_STAGE(PG8_SA(0, 0), cA, voffA); PG8_STAGE(PG8_SB(0, 1), cB + hstepB, voffB); PG8_STAGE(PG8_SA(0, 1), cA + hstepA, voffA);
        if (wr == 1) PG8_BAR;
        PG8_WAIT_V(4); PG8_BAR;
        PG8_STAGE(PG8_SB(1, 0), cB + kstep, voffB); PG8_STAGE(PG8_SA(1, 0), cA + kstep, voffA); PG8_STAGE(PG8_SB(1, 1), cB + hstepB + kstep, voffB);
        PG8_WAIT_V(6); PG8_BAR;
    }
    for (;;) {
        const bool has_next = S.next(ui + 1, nxt);
        const char* nA = has_next ? (const char*)g.A + (size_t)nxt.zb * g.zA + (size_t)nxt.pa * tstepA + (QUAD ? (size_t)nxt.qa * hstepA : 0) : cA; const char* nB = has_next ? (const char*)g.Bt + (size_t)nxt.zb * g.zB + (size_t)nxt.pn * tstepB + (QUAD ? (size_t)nxt.qb * hstepB : 0) : cB;
#pragma unroll 1
        for (int t = 0; t < nt; t += 2) {
            const bool last = (t == nt - 2);
            const char* a1 = cA + (size_t)(t + 1) * kstep;
            const char* a2 = last ? nA : cA + (size_t)(t + 2) * kstep; const char* b2 = last ? nB : cB + (size_t)(t + 2) * kstep;
            const char* a3 = a2 + kstep; const char* b3 = b2 + kstep;
            if (last && has_next) S.a_ready(nxt);
            if constexpr (SP2) {
            PG8_LDB(B0, 0, 0); PG8_LDB(B1, 0, 1); PG8_SCHED; PG8_LDA(At, 0, 0); PG8_STAGE(PG8_SA(1, 1), a1 + hstepA, voffA);
            PG8_WAIT_V(8); PG8_WAIT_L(0); PG8_BAR; PG8_MMA(0, 0, At, B0); PG8_MMA(0, 1, At, B1); PG8_BAR; PG8_SCHED;
            PG8_LDA(At, 0, 1); PG8_STAGE(PG8_SB(0, 0), b2, voffB); PG8_STAGE(PG8_SB(0, 1), b2 + hstepB, voffB); PG8_STAGE(PG8_SA(0, 0), a2, voffA);
            PG8_WAIT_V(8); PG8_WAIT_L(0); PG8_BAR; PG8_MMA(1, 0, At, B0); PG8_MMA(1, 1, At, B1); PG8_BAR; PG8_SCHED;
            PG8_LDB(B0, 1, 0); PG8_LDB(B1, 1, 1); PG8_SCHED; PG8_LDA(At, 1, 0); PG8_STAGE(PG8_SA(0, 1), a2 + hstepA, voffA);
            PG8_WAIT_V(8); PG8_WAIT_L(0); PG8_BAR; PG8_MMA(0, 0, At, B0); PG8_MMA(0, 1, At, B1); PG8_BAR; PG8_SCHED;
            PG8_LDA(At, 1, 1); PG8_STAGE(PG8_SB(1, 0), b3, voffB); PG8_STAGE(PG8_SB(1, 1), b3 + hstepB, voffB); PG8_STAGE(PG8_SA(1, 0), a3, voffA);
            PG8_WAIT_V(8); PG8_WAIT_L(0); PG8_BAR; PG8_MMA(1, 0, At, B0); PG8_MMA(1, 1, At, B1); PG8_BAR; PG8_SCHED;
            } else {
            PG8_LDB(B0, 0, 0); PG8_SCHED; PG8_LDA(At, 0, 0); PG8_STAGE(PG8_SA(1, 1), a1 + hstepA, voffA);
            PG8_WAIT_L(8); PG8_BAR; PG8_WAIT_L(0); PG8_MMA(0, 0, At, B0); PG8_BAR; PG8_SCHED;
            PG8_LDB(B1, 0, 1); PG8_STAGE(PG8_SB(0, 0), b2, voffB);
            PG8_BAR; PG8_WAIT_L(0); PG8_MMA(0, 1, At, B1); PG8_BAR;
            PG8_LDA(At, 0, 1); PG8_STAGE(PG8_SA(0, 0), a2, voffA);
            PG8_BAR; PG8_WAIT_L(0); PG8_MMA(1, 0, At, B0); PG8_BAR; PG8_SCHED;
            PG8_STAGE(PG8_SB(0, 1), b2 + hstepB, voffB);
            PG8_WAIT_V(6); PG8_BAR; PG8_MMA(1, 1, At, B1); PG8_BAR;
            PG8_LDB(B0, 1, 0); PG8_SCHED; PG8_LDA(At, 1, 0); PG8_STAGE(PG8_SA(0, 1), a2 + hstepA, voffA);
            PG8_WAIT_L(8); PG8_BAR; PG8_WAIT_L(0); PG8_MMA(0, 0, At, B0); PG8_BAR; PG8_SCHED;
            PG8_LDB(B1, 1, 1); PG8_STAGE(PG8_SB(1, 0), b3, voffB);
            PG8_BAR; PG8_WAIT_L(0); PG8_MMA(0, 1, At, B1); PG8_BAR;
            PG8_LDA(At, 1, 1); PG8_STAGE(PG8_SA(1, 0), a3, voffA);
            PG8_BAR; PG8_WAIT_L(0); PG8_MMA(1, 0, At, B0); PG8_BAR; PG8_SCHED;
            PG8_STAGE(PG8_SB(1, 1), b3 + hstepB, voffB);
            PG8_WAIT_V(6); PG8_BAR; PG8_MMA(1, 1, At, B1); PG8_BAR;
            }
        }
        if constexpr (ALIGN_EPI) { if (wr == 0) PG8_BAR; }
        if constexpr (FP8) asm volatile("s_nop 15\n\ts_nop 15" ::: "memory");
        if constexpr (!Epi::AFTER_DRAIN) { int fr_ = fr, fq_ = fq; asm volatile("" : "+v"(fr_), "+v"(fq_));
            E(acc, cur, wr, wc, fr_, fq_); S.done(cur); }
        if (!has_next) break;
#pragma unroll
        for (int a = 0; a < 2; ++a)
#pragma unroll
            for (int b = 0; b < 2; ++b)
#pragma unroll
                for (int m = 0; m < 4; ++m)
#pragma unroll
                    for (int n = 0; n < 2; ++n) acc[a][b][m][n] = zero4_b64();
        cur = nxt; cA = nA; cB = nB; ++ui;
        if constexpr (ALIGN_EPI) { if (wr == 1) PG8_BAR; }
    }
    PG8_WAIT_V(0);
    if constexpr (!ALIGN_EPI) { if (wr == 0) PG8_BAR; }
    PG8_BAR;
    if constexpr (Epi::AFTER_DRAIN) { E.fused(acc, cur, wr, wc, fr, fq, lds, wid, lane); S.done(cur); }
#undef PG8_SA
#undef PG8_SB
#undef PG8_STAGE
#undef PG8_LDA
#undef PG8_RDA
#undef PG8_RDB
#undef PG8_LDB
#undef PG8_MMA
#undef PG8_WAIT_V
#undef PG8_WAIT_L
#undef PG8_BAR
#undef PG8_SCHED
}
}

#include <hip/hip_bf16.h>
#include <cmath>
namespace attn_body {
using bf16=__hip_bfloat16;
using bf16x8=__attribute__((ext_vector_type(8)))short;
using s16x4=__attribute__((ext_vector_type(4)))short;
using f32x16=__attribute__((ext_vector_type(16)))float;
using u32x4=__attribute__((ext_vector_type(4)))unsigned;
constexpr int BATCH=2,NHEAD=16,SEQ=8192,D=64,DM=NHEAD*D;
constexpr int NW=8,QBLK=32,QB=QBLK*NW,KVBLK=64,NQB=SEQ/QB;
constexpr int ATTN_PITCH=DM, ATTN_UNIT_ROWS=QB;
__device__ __forceinline__ int crow(int r,int hi){return (r&3)+8*(r>>2)+4*hi;}
#define SBAR() __builtin_amdgcn_sched_barrier(0)
__device__ __forceinline__ void cmask(f32x16&p0,f32x16&p1,int jb,int qrel,int hi){
  const float NEG=-INFINITY; int kb=64*jb+4*hi;
  #pragma unroll
  for(int r=0;r<16;++r){int kv=kb+(r&3)+8*(r>>2); if(kv>qrel)p0[r]=NEG; if(kv+32>qrel)p1[r]=NEG;}
}

constexpr int NSLOT=3, SLOTB=8192;
constexpr int LDS_K=0, LDS_V=NSLOT*SLOTB, LDS_WS=2*NSLOT*SLOTB, LDS_OST=LDS_WS+NW*64*4, LDS_NB=LDS_OST+NW*4096  , LDS_PK=LDS_NB+32768+64  , LDS_BYTES=LDS_PK+1024;
constexpr float C2=0.125f*1.4426950408889634f;
__device__ __forceinline__ void glds16(const void*gsrc,unsigned lds_dst){unsigned keep;
  asm volatile("s_mov_b32 %0, m0\n\ts_mov_b32 m0, %2\n\ts_nop 0\n\tglobal_load_lds_dwordx4 %1, off\n\ts_mov_b32 m0, %0":"=&s"(keep):"v"(gsrc),"s"(lds_dst):"memory");}
__device__ __forceinline__ float max3f(float a,float b,float c){float r;asm("v_max3_f32 %0, %1, %2, %3":"=v"(r):"v"(a),"v"(b),"v"(c));return r;}
__device__ __forceinline__ float max2f(float a,float b){float r;asm("v_max_f32_e32 %0, %1, %2":"=v"(r):"v"(a),"v"(b));return r;}
__device__ __forceinline__ float fadd_s(float a,float b){float r;asm("v_add_f32_e32 %0, %1, %2":"=v"(r):"v"(a),"v"(b));return r;}
__device__ __forceinline__ float fsub_s(float a,float b){float r;asm("v_sub_f32_e32 %0, %1, %2":"=v"(r):"v"(a),"v"(b));return r;}
typedef float f32x2_t __attribute__((ext_vector_type(2))); typedef __bf16 bf16x2_t __attribute__((ext_vector_type(2)));
__device__ __forceinline__ unsigned cvtpk_s(float lo,float hi){f32x2_t v={lo,hi};bf16x2_t b=__builtin_convertvector(v,bf16x2_t);return __builtin_bit_cast(unsigned,b);}
#define WAIT_BAR(N) asm volatile("s_waitcnt vmcnt(" #N ") lgkmcnt(0)\n\ts_barrier":::"memory")

__device__ __forceinline__ void qkt(f32x16&p0,f32x16&p1,const char*Kslot,const bf16x8*qr,const f32x16&negm,int r32,int hi){
  const char*kb=Kslot+hi*1024+r32*16;
  #pragma unroll
  for(int d0=0;d0<4;++d0){
    const bf16x8 b0=*reinterpret_cast<const bf16x8*>(kb+d0*2048);
    const bf16x8 b1=*reinterpret_cast<const bf16x8*>(kb+d0*2048+512);
    if(d0==0){p0=__builtin_amdgcn_mfma_f32_32x32x16_bf16(b0,qr[0],negm,0,0,0);p1=__builtin_amdgcn_mfma_f32_32x32x16_bf16(b1,qr[0],negm,0,0,0);}
    else{p0=__builtin_amdgcn_mfma_f32_32x32x16_bf16(b0,qr[d0],p0,0,0,0);p1=__builtin_amdgcn_mfma_f32_32x32x16_bf16(b1,qr[d0],p1,0,0,0);}}
}
typedef __attribute__((address_space(3))) const char* lds_cptr;
typedef short v4i16_t __attribute__((ext_vector_type(4)));
__device__ __forceinline__ void kload8(bf16x8*kf,lds_cptr kp){
  kf[0]=*(const __attribute__((address_space(3))) bf16x8*)(kp);      kf[1]=*(const __attribute__((address_space(3))) bf16x8*)(kp+512);
  kf[2]=*(const __attribute__((address_space(3))) bf16x8*)(kp+2048); kf[3]=*(const __attribute__((address_space(3))) bf16x8*)(kp+2560);
  kf[4]=*(const __attribute__((address_space(3))) bf16x8*)(kp+4096); kf[5]=*(const __attribute__((address_space(3))) bf16x8*)(kp+4608);
  kf[6]=*(const __attribute__((address_space(3))) bf16x8*)(kp+6144); kf[7]=*(const __attribute__((address_space(3))) bf16x8*)(kp+6656);
}
__device__ __forceinline__ void kload2(bf16x8*kf,lds_cptr kp,int j){ kf[2*j]=*(const __attribute__((address_space(3))) bf16x8*)(kp+j*2048); kf[2*j+1]=*(const __attribute__((address_space(3))) bf16x8*)(kp+j*2048+512); }
__device__ __forceinline__ s16x4 vtr(lds_cptr p){ return __builtin_bit_cast(s16x4,__builtin_amdgcn_ds_read_tr16_b64_v4i16((__attribute__((address_space(3))) v4i16_t*)p)); }
__device__ __forceinline__ float rowmax(const f32x16&p0,const f32x16&p1){
  float a=max3f(p0[0],p0[1],p1[0]),b=max3f(p0[2],p0[3],p1[1]);a=max3f(a,p1[2],p1[3]);
  #pragma unroll
  for(int r=4;r<16;r+=4){a=max3f(a,p0[r],p0[r+1]);b=max3f(b,p0[r+2],p0[r+3]);a=max3f(a,p1[r],p1[r+1]);b=max3f(b,p1[r+2],p1[r+3]);}
  const float m=max2f(a,b);
  auto rr=__builtin_amdgcn_permlane32_swap(__float_as_uint(m),__float_as_uint(m),false,false);
  return max2f(__uint_as_float(rr[0]),__uint_as_float(rr[1]));
}
__device__ __forceinline__ void pv(f32x16*o,int vb,bf16x8 pa0,bf16x8 pa1,bf16x8 pa2,bf16x8 pa3){
  #pragma unroll
  for(int d0=0;d0<2;++d0){s16x4 lo[4],hi[4];
    #pragma unroll
    for(int ks=0;ks<4;++ks){
      asm volatile("ds_read_b64_tr_b16 %0,%1 offset:%c2":"=&v"(lo[ks]):"v"(vb),"i"(d0*4096+ks*1024):"memory");
      asm volatile("ds_read_b64_tr_b16 %0,%1 offset:%c2":"=&v"(hi[ks]):"v"(vb),"i"(d0*4096+ks*1024+512):"memory");}
    asm volatile("s_waitcnt lgkmcnt(0)":::"memory");SBAR();
    #define PK(k) (bf16x8){lo[k][0],lo[k][1],lo[k][2],lo[k][3],hi[k][0],hi[k][1],hi[k][2],hi[k][3]}
    o[d0]=__builtin_amdgcn_mfma_f32_32x32x16_bf16(pa0,PK(0),o[d0],0,0,0);
    o[d0]=__builtin_amdgcn_mfma_f32_32x32x16_bf16(pa1,PK(1),o[d0],0,0,0);
    o[d0]=__builtin_amdgcn_mfma_f32_32x32x16_bf16(pa2,PK(2),o[d0],0,0,0);
    o[d0]=__builtin_amdgcn_mfma_f32_32x32x16_bf16(pa3,PK(3),o[d0],0,0,0);
    #undef PK
  }
}

typedef float f32x4_t __attribute__((ext_vector_type(4)));
__device__ __forceinline__ void fox_negcum(const float*logf,__attribute__((address_space(3))) float*ncum,__attribute__((address_space(3))) float*wtot,int tid){
  float loc[16];float s=0.f; const f32x4_t*lp=(const f32x4_t*)(logf+tid*16);
  #pragma unroll
  for(int j=0;j<4;++j){const f32x4_t v=lp[j]; s+=v[0];loc[4*j]=s; s+=v[1];loc[4*j+1]=s; s+=v[2];loc[4*j+2]=s; s+=v[3];loc[4*j+3]=s;}
  float inc=s;
  #pragma unroll
  for(int o=1;o<64;o<<=1){const float v=__shfl_up(inc,o); if((tid&63)>=o)inc+=v;}
  if((tid&63)==63)wtot[tid>>6]=inc;
  __syncthreads();
  float base=inc-s; for(int w=0;w<(tid>>6);++w)base+=wtot[w];
  #pragma unroll
  for(int j=0;j<4;++j){ f32x4_t o4; o4[0]=-(base+loc[4*j]);o4[1]=-(base+loc[4*j+1]);o4[2]=-(base+loc[4*j+2]);o4[3]=-(base+loc[4*j+3]); *(__attribute__((address_space(3))) f32x4_t*)(ncum+tid*16+4*j)=o4; }
  __syncthreads();
}
#ifndef ATTN_STORE16
#define ATTN_STORE16(p,v) (*(u32x4*)(p)=(v))
#endif
template<int THRL> __device__ __forceinline__ void attn_unit(int b,int h,int qb,const bf16*Q,const bf16*__restrict__ K,const bf16*__restrict__ V,bf16*O,char*shm,const float*logf_bh,const unsigned*kn_bh,unsigned char*O8=nullptr){
  int tid_=threadIdx.x; asm volatile("":"+v"(tid_)); const int tid=tid_,lane=tid&63,r32=lane&31,hi=lane>>5; const int wid=__builtin_amdgcn_readfirstlane(tid>>6);
  const long rowbase=(long)b*SEQ; const int q0=qb*QB;
  const bf16*Qw=Q+(rowbase+q0+wid*QBLK)*DM+h*D;
  const bf16*Kh=K+rowbase*DM+h*D,*Vh=V+rowbase*DM+h*D;
  const unsigned lds0=(unsigned)(uintptr_t)shm;
  float*wsf=(float*)(shm+LDS_WS)+wid*64;
  const bf16*ksrc=Kh+(long)lane*DM+wid*8;
  const bf16*vsrc=Vh+(long)(16*(wid&3)+(lane>>2))*DM+(wid>>2)*32+(lane&3)*8;
  const unsigned kdst=lds0+LDS_K+wid*1024, vdst=lds0+LDS_V+wid*1024;
  #define TIDX(t) (NTR-1-(t))
  #define DMA_K(t,slot) glds16(ksrc+(long)TIDX(t)*KVBLK*DM,(unsigned)__builtin_amdgcn_readfirstlane(kdst+(slot)))
  #define DMA_V(t,slot) glds16(vsrc+(long)TIDX(t)*KVBLK*DM,(unsigned)__builtin_amdgcn_readfirstlane(vdst+(slot)))
  const int vb0=(int)(lds0+LDS_V)+((lane>>4)&1)*32+(lane&3)*8+(4*hi+((lane&15)>>2))*64;
  const char*Kbase=shm+LDS_K; bf16x8 kf[8];
  const lds_cptr shm3=(lds_cptr)shm; const lds_cptr kp0=shm3+LDS_K+hi*1024+r32*16; const lds_cptr vp0=shm3+LDS_V+((lane>>4)&1)*32+(lane&3)*8+(4*hi+((lane&15)>>2))*64;
  const int NTR=(q0+QB)/KVBLK;
  const lds_cptr shm3b=(lds_cptr)shm;
  const __attribute__((address_space(3))) float* nb3=(const __attribute__((address_space(3))) float*)(shm3b+LDS_NB);
  fox_negcum(logf_bh,(__attribute__((address_space(3))) float*)(shm3b+LDS_NB),(__attribute__((address_space(3))) float*)(shm3b+LDS_NB+32768),tid);
  int NT;
  { __attribute__((address_space(3))) float* PK=(__attribute__((address_space(3))) float*)(shm3b+LDS_PK);
    __attribute__((address_space(3))) int* JX=(__attribute__((address_space(3))) int*)(shm3b+LDS_PK+512);
    float pk=0.f;
    if(tid<128){ const float a=__uint_as_float(kn_bh[2*tid]),c=__uint_as_float(kn_bh[2*tid+1]); pk=__builtin_sqrtf(a+c)*1.001f; }
    #pragma unroll
    for(int o_=1;o_<64;o_<<=1){const float v=__shfl_up(pk,o_); if((tid&63)>=o_)pk=__builtin_fmaxf(pk,v);}
    if(tid==63)PK[128]=pk;
    __syncthreads();
    if(tid>=64&&tid<128)pk=__builtin_fmaxf(pk,PK[128]);
    if(tid<128)PK[tid]=pk;
    const bf16*Krow=Kh+(long)(q0+wid*QBLK+r32)*DM+hi*8; const bf16*Qrow=Qw+(long)r32*DM+hi*8; float qq=0.f,qk=0.f;
    #pragma unroll
    for(int d0=0;d0<4;++d0){ const u32x4 qa=*reinterpret_cast<const u32x4*>(Qrow+d0*16), ka=*reinterpret_cast<const u32x4*>(Krow+d0*16);
      #pragma unroll
      for(int e=0;e<4;++e){ const float q0f=__uint_as_float(qa[e]<<16),q1f=__uint_as_float(qa[e]&0xffff0000u),k0f=__uint_as_float(ka[e]<<16),k1f=__uint_as_float(ka[e]&0xffff0000u);
        qq+=q0f*q0f+q1f*q1f; qk+=q0f*k0f+q1f*k1f; } }
    { auto r1=__builtin_amdgcn_permlane32_swap(__float_as_uint(qq),__float_as_uint(qq),false,false); qq=__uint_as_float(r1[0])+__uint_as_float(r1[1]);
      auto r2=__builtin_amdgcn_permlane32_swap(__float_as_uint(qk),__float_as_uint(qk),false,false); qk=__uint_as_float(r2[0])+__uint_as_float(r2[1]); }
    __syncthreads();
    const float qn=__builtin_sqrtf(qq)*1.001f, thr=qk+nb3[q0+wid*QBLK+r32]-72.f;
    int lo_=0,hi_=NTR;
    #pragma unroll 1
    for(int it=0;it<8;++it){ if(lo_<hi_){ const int mid=(lo_+hi_)>>1; const float f=qn*PK[mid]+nb3[64*mid+63]; if(f>=thr)hi_=mid; else lo_=mid+1; } }
    #pragma unroll
    for(int o_=1;o_<64;o_<<=1){const int v=__shfl_xor(lo_,o_); lo_=v<lo_?v:lo_;}
    if(lane==0)JX[wid]=lo_;
    __syncthreads();
    int j0=JX[0];
    #pragma unroll
    for(int w=1;w<8;++w){const int v=JX[w]; j0=v<j0?v:j0;}
    j0=__builtin_amdgcn_readfirstlane(j0);
    int nte=(NTR-j0+1)&~1; NT=nte<4?4:nte;
    __syncthreads();
  }
  { __attribute__((address_space(3))) float* nbw=(__attribute__((address_space(3))) float*)(shm3b+LDS_NB);
    const float ref_=nbw[q0+QB-1];
    __syncthreads();
    #pragma unroll
    for(int j=0;j<16;++j){ const float v=nbw[tid*16+j]-ref_; const unsigned h_=cvtpk_s(v,0.f)&0xffffu; const float hf_=__uint_as_float(h_<<16); const unsigned l_=cvtpk_s(v-hf_,0.f)&0xffffu;
      ((__attribute__((address_space(3))) unsigned*)nbw)[tid*16+j]=h_|(l_<<16); }
    __syncthreads();
  }
  const __attribute__((address_space(3))) unsigned* nbp=(const __attribute__((address_space(3))) unsigned*)(shm3b+LDS_NB);
  const unsigned mh0=(hi==0)?0xffffffffu:0u, onesm=0x3f803f80u&mh0;
  u32x4 qxw={onesm,0u,0u,0u};
  #define QX_SET() do{ const float nm_=-mhat; const unsigned h_=cvtpk_s(nm_,0.f)&0xffffu; const unsigned l_=cvtpk_s(nm_-__uint_as_float(h_<<16),0.f)&0xffffu; qxw[1]=(h_|(l_<<16))&mh0; }while(0)
  #define KXF(pr) __builtin_bit_cast(bf16x8,(u32x4){(pr)&mh0,onesm,0u,0u})
  #define BIASMMA(C0,C1,t) do{ const unsigned pr0_=nbp[64*TIDX(t)+r32],pr1_=nbp[64*TIDX(t)+32+r32]; \
    C0=__builtin_amdgcn_mfma_f32_32x32x16_bf16(KXF(pr0_),__builtin_bit_cast(bf16x8,qxw),C0,0,0,0); C1=__builtin_amdgcn_mfma_f32_32x32x16_bf16(KXF(pr1_),__builtin_bit_cast(bf16x8,qxw),C1,0,0,0); }while(0)
  DMA_K(0,0);DMA_V(0,0);DMA_K(1,SLOTB);
  bf16x8 qr[4];
  #pragma unroll
  for(int d0=0;d0<4;++d0)qr[d0]=*reinterpret_cast<const bf16x8*>(&Qw[(long)r32*DM+d0*16+hi*8]);
  float mhat=0.f,l_reg=0.f;f32x16 o[2];o[0]=f32x16{};o[1]=f32x16{};const f32x16 negm=f32x16{};
  const int qrel=wid*QBLK+r32;
  #define CMASK(P0,P1,t) do{ if((t)<4){ cmask(P0,P1,3-(t),qrel,hi); } }while(0)
  bool resc=false;
  #define START(P0,P1) do{ const float rm=rowmax(P0,P1); resc=false; \
    { const float dl=(rm>-3.0e38f)?__builtin_ceilf(rm*16.f)*0.0625f:0.f; mhat=fadd_s(mhat,dl);     \
      _Pragma("unroll") for(int r=0;r<16;++r){P0[r]=fsub_s(P0[r],dl);P1[r]=fsub_s(P1[r],dl);} \
      QX_SET(); } \
    _Pragma("unroll") for(int r=0;r<16;++r)P0[r]=__builtin_amdgcn_exp2f(P0[r]); }while(0)
  #define RESC() do{ if(resc){ asm volatile("s_waitcnt lgkmcnt(0)":::"memory"); \
      _Pragma("unroll") for(int d_=0;d_<2;++d_) _Pragma("unroll") for(int r=0;r<16;++r)o[d_][r]*=wsf[crow(r,hi)]; } }while(0)
  f32x16 pA0,pA1,pB0,pB1;
  int sl_prev=0,sl_cur=0,sl_next=SLOTB;
  #define ROT() do{sl_prev=sl_cur;sl_cur=sl_next;sl_next=(sl_next==(NSLOT-1)*SLOTB)?0:sl_next+SLOTB;}while(0)
  DMA_K(2,2*SLOTB);
  WAIT_BAR(3);
  qkt(pA0,pA1,Kbase,qr,negm,r32,hi);BIASMMA(pA0,pA1,0);asm volatile("s_nop 15\n\ts_nop 7":"+v"(pA0),"+v"(pA1));CMASK(pA0,pA1,0);
  START(pA0,pA1);
  _Pragma("unroll") for(int r=0;r<16;++r)pA1[r]=__builtin_amdgcn_exp2f(pA1[r]);
  WAIT_BAR(0);
  DMA_K(3,0);DMA_V(1,SLOTB);
  ROT();
  kload8(kf,kp0+sl_cur);
  WAIT_BAR(2);
  s16x4 vlo[8],vhi[8]; u32x4 pw0,pw1,pw2,pw3;
  #define PKW(P,B) cvtpk_s(P[B],P[B+1])
  #define PAF(k) __builtin_bit_cast(bf16x8,pw##k)
  #define VFR(i) (bf16x8){vlo[i][0],vlo[i][1],vlo[i][2],vlo[i][3],vhi[i][0],vhi[i][1],vhi[i][2],vhi[i][3]}
  #define PIN(x) asm volatile("":"+v"(x))
  #define MX3(a,b,c) __builtin_fmaxf(__builtin_fmaxf((a),(b)),(c))
  #define GAPA(MF,A0,A1,A2,A3,W0,W1,PW) do{ MF; sacc+=A0; sacc+=A1; sacc+=A2; sacc+=A3; PIN(sacc); W0; W1; PIN(PW); SBAR(); }while(0)
  #define EX(v) __builtin_amdgcn_exp2f(v)
  #define GAPB(MF,X,B) do{ MF; X[B]=EX(X[B]); X[B+1]=EX(X[B+1]); X[B+2]=EX(X[B+2]); X[B+3]=EX(X[B+3]); PIN(X); SBAR(); }while(0)
  #define VRD(i) do{ vlo[i]=vtr(vp_+(((i)>>2)*4096+((i)&3)*1024)); vhi[i]=vtr(vp_+(((i)>>2)*4096+((i)&3)*1024+512)); }while(0)
  #define KRD(G,j) do{ if(G){ kload2(kf,kp0+sl_next,j); SBAR(); } }while(0)
  #define STEP(C0,C1,P0,P1,t,GK,GV,GL) do{ SBAR(); \
    const lds_cptr vp_=vp0+sl_prev; \
    VRD(0); SBAR(); float sacc=(P0[0]+P0[1]); \
    GAPA(C0=__builtin_amdgcn_mfma_f32_32x32x16_bf16(kf[0],qr[0],negm,0,0,0), P0[2],P0[3],P0[4],P0[5],     pw0[0]=PKW(P0,0), pw0[1]=PKW(P0,2), pw0); \
    VRD(4); SBAR(); GAPA(C1=__builtin_amdgcn_mfma_f32_32x32x16_bf16(kf[1],qr[0],negm,0,0,0), P0[6],P0[7],P0[8],P0[9],     pw0[2]=PKW(P0,4), pw0[3]=PKW(P0,6), pw0); \
    VRD(1); SBAR(); GAPA(C0=__builtin_amdgcn_mfma_f32_32x32x16_bf16(kf[2],qr[1],C0,0,0,0),   P0[10],P0[11],P0[12],P0[13], pw1[0]=PKW(P0,8), pw1[1]=PKW(P0,10), pw1); \
    VRD(5); SBAR(); GAPA(C1=__builtin_amdgcn_mfma_f32_32x32x16_bf16(kf[3],qr[1],C1,0,0,0),   P0[14],P0[15],P1[0],P1[1],   pw1[2]=PKW(P0,12),pw1[3]=PKW(P0,14), pw1); \
    VRD(2); SBAR(); GAPA(C0=__builtin_amdgcn_mfma_f32_32x32x16_bf16(kf[4],qr[2],C0,0,0,0),   P1[2],P1[3],P1[4],P1[5],     pw2[0]=PKW(P1,0), pw2[1]=PKW(P1,2), pw2); \
    VRD(6); SBAR(); GAPA(C1=__builtin_amdgcn_mfma_f32_32x32x16_bf16(kf[5],qr[2],C1,0,0,0),   P1[6],P1[7],P1[8],P1[9],     pw2[2]=PKW(P1,4), pw2[3]=PKW(P1,6), pw2); \
    VRD(3); SBAR(); GAPA(C0=__builtin_amdgcn_mfma_f32_32x32x16_bf16(kf[6],qr[3],C0,0,0,0),   P1[10],P1[11],P1[12],P1[13], pw3[0]=PKW(P1,8), pw3[1]=PKW(P1,10), pw3); \
    VRD(7); SBAR(); GAPA(C1=__builtin_amdgcn_mfma_f32_32x32x16_bf16(kf[7],qr[3],C1,0,0,0),   P1[14],P1[15],0.f,0.f,       pw3[2]=PKW(P1,12),pw3[3]=PKW(P1,14), pw3); \
    l_reg+=sacc; \
    if(GK){DMA_K((t)+3,sl_cur);} if(GV){DMA_V((t)+1,sl_next);} \
    BIASMMA(C0,C1,t); CMASK(C0,C1,t); \
    { float a=MX3(C0[0],C0[1],C1[0]),b=MX3(C0[2],C0[3],C1[1]); a=MX3(a,C1[2],C1[3]); \
      _Pragma("unroll") for(int r=4;r<16;r+=4){a=MX3(a,C0[r],C0[r+1]);b=MX3(b,C0[r+2],C0[r+3]);a=MX3(a,C1[r],C1[r+1]);b=MX3(b,C1[r+2],C1[r+3]);} \
      float rm=__builtin_fmaxf(a,b); { auto rr=__builtin_amdgcn_permlane32_swap(__float_as_uint(rm),__float_as_uint(rm),false,false); rm=__builtin_fmaxf(__uint_as_float(rr[0]),__uint_as_float(rr[1])); } \
      resc=false; \
      if(__builtin_expect(__any(rm>(float)THRL),0)){ const float dl=__builtin_fmaxf(__builtin_ceilf(rm*16.f)*0.0625f,0.f); mhat+=dl; QX_SET(); \
        _Pragma("unroll") for(int r=0;r<16;++r){C0[r]-=dl;C1[r]-=dl;} \
        const float f=__builtin_amdgcn_exp2f(-dl); l_reg*=f; if(hi==0)wsf[r32]=f; resc=true; } } \
    SBAR(); \
    GAPB(o[0]=__builtin_amdgcn_mfma_f32_32x32x16_bf16(PAF(0),VFR(0),o[0],0,0,0), C0,0); \
    GAPB(o[1]=__builtin_amdgcn_mfma_f32_32x32x16_bf16(PAF(0),VFR(4),o[1],0,0,0), C0,4); \
    KRD(GL,0); GAPB(o[0]=__builtin_amdgcn_mfma_f32_32x32x16_bf16(PAF(1),VFR(1),o[0],0,0,0), C0,8); \
    KRD(GL,1); GAPB(o[1]=__builtin_amdgcn_mfma_f32_32x32x16_bf16(PAF(1),VFR(5),o[1],0,0,0), C0,12); \
    KRD(GL,2); GAPB(o[0]=__builtin_amdgcn_mfma_f32_32x32x16_bf16(PAF(2),VFR(2),o[0],0,0,0), C1,0); \
    KRD(GL,3); GAPB(o[1]=__builtin_amdgcn_mfma_f32_32x32x16_bf16(PAF(2),VFR(6),o[1],0,0,0), C1,4); \
    GAPB(o[0]=__builtin_amdgcn_mfma_f32_32x32x16_bf16(PAF(3),VFR(3),o[0],0,0,0), C1,8); \
    GAPB(o[1]=__builtin_amdgcn_mfma_f32_32x32x16_bf16(PAF(3),VFR(7),o[1],0,0,0), C1,12); \
    }while(0)
  int t=1;
  for(int it_=0;it_<2&&t+5<NT;++it_,t+=2){
    STEP(pB0,pB1,pA0,pA1,t,true,true,true);     WAIT_BAR(2); RESC(); ROT();
    STEP(pA0,pA1,pB0,pB1,t+1,true,true,true);   WAIT_BAR(2); RESC(); ROT();
  }
  #undef CMASK
  #define CMASK(P0,P1,t) do{}while(0)
  for(;t+5<NT;t+=2){
    STEP(pB0,pB1,pA0,pA1,t,true,true,true);     WAIT_BAR(2); RESC(); ROT();
    STEP(pA0,pA1,pB0,pB1,t+1,true,true,true);   WAIT_BAR(2); RESC(); ROT();
  }
  #undef CMASK
  #define CMASK(P0,P1,t) do{ if((t)<4){ cmask(P0,P1,3-(t),qrel,hi); } }while(0)
  #define ENDW(tt) do{ if((tt)+3<NT){WAIT_BAR(2);} else if((tt)+2<NT){WAIT_BAR(1);} else {WAIT_BAR(0);} }while(0)
  for(;t+1<NT;t+=2){
    STEP(pB0,pB1,pA0,pA1,t,(t+3<NT),(t+1<NT),(t+1<NT));       ENDW(t);   RESC(); ROT();
    STEP(pA0,pA1,pB0,pB1,t+1,(t+4<NT),(t+2<NT),(t+2<NT));     ENDW(t+1); RESC(); ROT();
  }
  STEP(pB0,pB1,pA0,pA1,NT-1,false,false,false); RESC();
  { float sacc=pB0[0]+pB0[1]; _Pragma("unroll") for(int r=2;r<16;++r)sacc+=pB0[r]; _Pragma("unroll") for(int r=0;r<16;++r)sacc+=pB1[r]; l_reg+=sacc;
    pw0=(u32x4){PKW(pB0,0),PKW(pB0,2),PKW(pB0,4),PKW(pB0,6)};pw1=(u32x4){PKW(pB0,8),PKW(pB0,10),PKW(pB0,12),PKW(pB0,14)};pw2=(u32x4){PKW(pB1,0),PKW(pB1,2),PKW(pB1,4),PKW(pB1,6)};pw3=(u32x4){PKW(pB1,8),PKW(pB1,10),PKW(pB1,12),PKW(pB1,14)};
    SBAR(); pv(o,vb0+sl_cur,PAF(0),PAF(1),PAF(2),PAF(3)); }
  #undef PKW
  #undef PAF
  #undef VFR
  #undef PIN
  #undef MX3
  #undef GAPA
  #undef GAPB
  #undef EX
  #undef VRD
  #undef KRD
  #undef STEP
  #undef ENDW
  {auto rr=__builtin_amdgcn_permlane32_swap(__float_as_uint(l_reg),__float_as_uint(l_reg),false,false);l_reg=__uint_as_float(rr[0])+__uint_as_float(rr[1]);}
  if(hi==0)wsf[32+r32]=l_reg;asm volatile("s_waitcnt lgkmcnt(0)":::"memory");
  float rli[16];
  #pragma unroll
  for(int r=0;r<16;++r)rli[r]=__builtin_amdgcn_rcpf(wsf[32+crow(r,hi)]);
  if(O8){ unsigned char*stg8=(unsigned char*)(shm+LDS_OST)+wid*4096;
    #pragma unroll
    for(int r=0;r<16;++r){const int orow=crow(r,hi);
      #pragma unroll
      for(int d0=0;d0<2;++d0)stg8[orow*64+d0*32+r32]=(unsigned char)(__builtin_amdgcn_cvt_pk_fp8_f32(o[d0][r]*rli[r],0.f,0,false)&0xff);}
    asm volatile("s_waitcnt lgkmcnt(0)":::"memory");
    unsigned char*Ow8=O8+(rowbase+q0+wid*QBLK)*1024+h*D;
    #pragma unroll
    for(int i=0;i<2;++i){const int row=i*16+(lane>>2),ch=lane&3; const u32x4 v=*(const u32x4*)(stg8+row*64+ch*16); ATTN_STORE16(Ow8+(long)row*1024+ch*16,v);} }
  else{
  bf16*Ow=O+(rowbase+q0+wid*QBLK)*DM+h*D;
  { bf16*stg=(bf16*)(shm+LDS_OST)+wid*2048;
    #pragma unroll
    for(int r=0;r<16;++r){const int orow=crow(r,hi);
      #pragma unroll
      for(int d0=0;d0<2;++d0)stg[orow*64+d0*32+r32]=__float2bfloat16(o[d0][r]*rli[r]);}
    asm volatile("s_waitcnt lgkmcnt(0)":::"memory");
    #pragma unroll
    for(int i=0;i<4;++i){const int row=i*8+(lane>>3),ch=lane&7; const u32x4 v=*(const u32x4*)(stg+row*64+ch*8); ATTN_STORE16(Ow+(long)row*DM+ch*8,v);} } }
  asm volatile("s_waitcnt lgkmcnt(0)\n\ts_barrier":::"memory");
  #undef BIASMMA
  #undef KXF
  #undef QX_SET
  #undef TIDX
  #undef DMA_K
  #undef DMA_V
  #undef CMASK
  #undef START
  #undef RESC
  #undef ROT
}

template<int PITCH> __device__ __forceinline__ void sb_unit(int b,int h,int qb,const bf16*Q,const bf16*__restrict__ K,const bf16*__restrict__ V,bf16*O  ,char*shm){
  int tid_=threadIdx.x; asm volatile("":"+v"(tid_)); const int tid=tid_,lane=tid&63,r32=lane&31,hi=lane>>5; const int wid=__builtin_amdgcn_readfirstlane(tid>>6);
  const long rowbase=(long)b*SEQ; const int q0=qb*QB;
  const bf16*Qw=Q+(rowbase+q0+wid*QBLK)*PITCH+h*D;
  const bf16*Kh=K+rowbase*PITCH+h*D,*Vh=V+rowbase*PITCH+h*D;
  const unsigned lds0=(unsigned)(uintptr_t)shm;
  const bf16*ksrc=Kh+(long)lane*PITCH+wid*8;
  const bf16*vsrc=Vh+(long)(16*(wid&3)+(lane>>2))*PITCH+(wid>>2)*32+(lane&3)*8;
  const unsigned kdst=lds0+LDS_K+wid*1024, vdst=lds0+LDS_V+wid*1024;
  #define SB_DMA(t,slot) do{ glds16(ksrc+(long)(t)*KVBLK*PITCH,(unsigned)__builtin_amdgcn_readfirstlane(kdst+(slot))); glds16(vsrc+(long)(t)*KVBLK*PITCH,(unsigned)__builtin_amdgcn_readfirstlane(vdst+(slot))); }while(0)
  const int vb0=(int)(lds0+LDS_V)+((lane>>4)&1)*32+(lane&3)*8+(4*hi+((lane&15)>>2))*64;
  volatile __attribute__((address_space(3))) unsigned* fl=(volatile __attribute__((address_space(3))) unsigned*)((lds_cptr)shm+LDS_WS);
  const int NT=(q0+QB)/KVBLK; const int qrel=wid*QBLK+r32;
  SB_DMA(NT-1,0);
  bf16x8 qr[4];
  #pragma unroll
  for(int d0=0;d0<4;++d0)qr[d0]=*reinterpret_cast<const bf16x8*>(&Qw[(long)r32*PITCH+d0*16+hi*8]);
  f32x16 o[2];o[0]=f32x16{};o[1]=f32x16{}; const f32x16 zero16=f32x16{};
  float carry=1.f;
  int slot=0;
  #define SB_TILE(BAND) do{ \
    if(!(BAND&&64*(t-(NT-4))>wid*QBLK+QBLK-1)){ \
    f32x16 p0,p1; qkt(p0,p1,shm+LDS_K+slot,qr,zero16,r32,hi); \
    if(BAND){ const int kb=64*(t-(NT-4))+4*hi;                 \
      _Pragma("unroll") for(int r=0;r<16;++r){const int kv=kb+(r&3)+8*(r>>2); if(kv>=qrel)p0[r]=-INFINITY; if(kv+32>=qrel)p1[r]=-INFINITY;} } \
      \
      \
    f32x16 s0,s1;                                                \
    _Pragma("unroll") for(int r=0;r<16;++r){ const float z=p0[r]; const float e=__builtin_amdgcn_exp2f(-__builtin_fmaxf(z,-100.f)); const float rb=__builtin_amdgcn_rcpf(1.f+e); const float y=p1[r]; const float f=__builtin_amdgcn_exp2f(-__builtin_fmaxf(y,-100.f)); const float rc=__builtin_amdgcn_rcpf(1.f+f); \
      if(BAND){ const bool mk=z<-1.0e30f; p0[r]=mk?0.f:rb; s0[r]=mk?1.f:e*rb; const bool mj=y<-1.0e30f; p1[r]=mj?0.f:rc; s1[r]=mj?1.f:f*rc; } \
      else { p0[r]=rb; s0[r]=e*rb; p1[r]=rc; s1[r]=f*rc; } } \
    float lo[8],hv[8];                                          \
    _Pragma("unroll") for(int i=0;i<8;++i){ const float mine=(i<4)?((s0[4*i]*s0[4*i+1])*(s0[4*i+2]*s0[4*i+3])):((s1[4*i-16]*s1[4*i-15])*(s1[4*i-14]*s1[4*i-13])); \
      auto rr=__builtin_amdgcn_permlane32_swap(__float_as_uint(mine),__float_as_uint(mine),false,false); lo[i]=__uint_as_float(rr[0]); hv[i]=__uint_as_float(rr[1]); } \
    float sp_=carry;                                             \
    _Pragma("unroll") for(int i=7;i>=0;--i){ float a=sp_*((hi==0)?hv[i]:1.f);       \
      if(i<4){ p0[4*i+3]*=a; a*=s0[4*i+3]; p0[4*i+2]*=a; a*=s0[4*i+2]; p0[4*i+1]*=a; a*=s0[4*i+1]; p0[4*i]*=a; } \
      else   { const int j=4*i-16; p1[j+3]*=a; a*=s1[j+3]; p1[j+2]*=a; a*=s1[j+2]; p1[j+1]*=a; a*=s1[j+1]; p1[j]*=a; } \
      sp_*=lo[i]*hv[i]; } \
    carry=sp_; \
    { u32x4 pw0,pw1,pw2,pw3; \
      pw0=(u32x4){cvtpk_s(p0[0],p0[1]),cvtpk_s(p0[2],p0[3]),cvtpk_s(p0[4],p0[5]),cvtpk_s(p0[6],p0[7])}; pw1=(u32x4){cvtpk_s(p0[8],p0[9]),cvtpk_s(p0[10],p0[11]),cvtpk_s(p0[12],p0[13]),cvtpk_s(p0[14],p0[15])}; \
      pw2=(u32x4){cvtpk_s(p1[0],p1[1]),cvtpk_s(p1[2],p1[3]),cvtpk_s(p1[4],p1[5]),cvtpk_s(p1[6],p1[7])}; pw3=(u32x4){cvtpk_s(p1[8],p1[9]),cvtpk_s(p1[10],p1[11]),cvtpk_s(p1[12],p1[13]),cvtpk_s(p1[14],p1[15])}; \
      pv(o,vb0+slot,__builtin_bit_cast(bf16x8,pw0),__builtin_bit_cast(bf16x8,pw1),__builtin_bit_cast(bf16x8,pw2),__builtin_bit_cast(bf16x8,pw3)); } \
    } \
    { const bool done_=__all(carry==0.f); if(lane==0)fl[(t&1)*8+wid]=done_?1u:0u; } \
    slot^=SLOTB; }while(0)
  #define SB_HEAD() { WAIT_BAR(0); \
    if(t<NT-1){ const int pb=((t+1)&1)*8; const unsigned a=fl[pb]&fl[pb+1]&fl[pb+2]&fl[pb+3]&fl[pb+4]&fl[pb+5]&fl[pb+6]&fl[pb+7]; if(__builtin_amdgcn_readfirstlane(a)!=0u)break; } \
    if(t>0)SB_DMA(t-1,slot^SLOTB); }
  int t=NT-1; bool live=true;
  for(;t>=NT-4;--t){ live=false; SB_HEAD(); SB_TILE(true); live=true; }
  if(live){ for(;t>=0;--t){ SB_HEAD(); SB_TILE(false); } }
  #undef SB_TILE
  #undef SB_HEAD
  asm volatile("s_waitcnt vmcnt(0) lgkmcnt(0)":::"memory");
  bf16*Ow=O+(rowbase+q0+wid*QBLK)*1024+h*D;
  { bf16*stg=(bf16*)(shm+LDS_OST)+wid*2048;
    #pragma unroll
    for(int r=0;r<16;++r){const int orow=crow(r,hi);
      #pragma unroll
      for(int d0=0;d0<2;++d0)stg[orow*64+d0*32+r32]=__float2bfloat16(o[d0][r]);}
    asm volatile("s_waitcnt lgkmcnt(0)":::"memory");
    #pragma unroll
    for(int i=0;i<4;++i){const int row=i*8+(lane>>3),ch=lane&7; const u32x4 v=*(const u32x4*)(stg+row*64+ch*8); ATTN_STORE16(Ow+(long)row*1024+ch*8,v);} }
  asm volatile("s_waitcnt vmcnt(0) lgkmcnt(0)\n\ts_barrier":::"memory");
  #undef SB_DMA
}
constexpr int ATTN_LDS_BYTES=LDS_BYTES;
struct AttnTensors { const bf16* Q; const bf16* K; const bf16* V; bf16* O; const float* logf;   const unsigned* kn;   };
#undef SBAR
#undef WAIT_BAR
}
constexpr int NWAVES = 8, NTHREADS = NWAVES * 64;
constexpr int BATCH = 2, SEQ = 8192, D = 1024, M = BATCH * SEQ;
constexpr int S5G = 32, S5H = 16, S5P = 64, S5T = 32  , S5NC = M / S5T  , S5KX = 640  ;
constexpr int SBH = 8, FOXH = 16, HD = 64;
constexpr int EVEN_IN = 2048, ODD_IN = 3088, DFF = 2816, NEXP = 8, DFE = 3584;
constexpr float C2 = 0.125f * 1.4426950408889634f;
constexpr int MOE_MAX_PANELS = 136, MOE_MAX_SLOTS = MOE_MAX_PANELS * 256, MOE_CAP = 16384  ;

constexpr size_t MiB = 1u << 20;
constexpr size_t WS_CTL = 0, CTL_ZERO_BYTES = 1 * MiB;
constexpr size_t WS_WMOE_GU = 1 * MiB;
constexpr size_t WS_WMOE_D = 57 * MiB;
constexpr size_t WS_WIN0 = 85 * MiB;
constexpr size_t WS_WGLU = 89 * MiB;
constexpr size_t WS_WOUT0 = 90 * MiB;
constexpr size_t WS_WGU0 = 92 * MiB;
constexpr size_t WS_WD0 = 103 * MiB;
constexpr size_t WS_WIN1 = 109 * MiB;
constexpr size_t WS_WF1 = 115 * MiB;
constexpr size_t WS_WOUT1 = 116 * MiB;
constexpr size_t WS_S5WA = 118 * MiB;
constexpr size_t WS_S5WC = 126 * MiB;
constexpr size_t WS_XB = 146 * MiB;
constexpr size_t WS_SSP = 178 * MiB;
constexpr size_t WS_META = 182 * MiB;
constexpr size_t WS_LOGF = 183 * MiB;
constexpr size_t WS_QKV0 = 184 * MiB;
constexpr size_t WS_UEXT = 232 * MiB;
constexpr size_t WS_SLOC = 252 * MiB;
constexpr size_t WS_YG = 260 * MiB;
constexpr size_t WS_MIXB = 276 * MiB;
constexpr size_t WS_HID0 = 184 * MiB;
constexpr size_t WS_QKV1 = 184 * MiB;
constexpr size_t WS_XG = 184 * MiB;
constexpr size_t WS_HMOE = 312 * MiB;
constexpr size_t WS_Y = 85 * MiB;
constexpr size_t WS_END = 432 * MiB;
static_assert(WS_XG + (size_t)8 * MOE_CAP * 1024 <= WS_HMOE && WS_HMOE + (size_t)MOE_MAX_SLOTS * DFE <= WS_END && WS_Y + (size_t)MOE_MAX_SLOTS * 1024 * 2 <= WS_XB + 32 * MiB && WS_MIXB + 32 * MiB <= WS_END, "ws map");
constexpr size_t MT_RSTD = 0, MT_TOKE = 65536, MT_TOKP = 131072, MT_TOKG = 262144, MT_RSS = 524288;
constexpr int CW_TMO = 0, CW_CODE = 1, CW_BAR = 4096, CW_CNT = 8192  , CW_QUEUE = 12288  , CW_QUEUE2 = 12352  , CW_KN = 16384  ;
constexpr int CW_SUBBAR = 32768;

constexpr int RING_OFF = 0, RING_BYTES = 131072;
constexpr int LDSCTL_OFF = 133120  , MISC_OFF = LDSCTL_OFF + 320;
constexpr int LDS_BYTES = 147456;

#define GAS __attribute__((address_space(1)))
#define LAS __attribute__((address_space(3)))
typedef unsigned short bf16;
typedef unsigned v4u __attribute__((ext_vector_type(4)));
typedef unsigned v2u __attribute__((ext_vector_type(2)));
typedef float f32x4 __attribute__((ext_vector_type(4)));
typedef short bf16x8 __attribute__((ext_vector_type(8)));
typedef GAS unsigned gu32;
#define RLX_AGENT __ATOMIC_RELAXED, __HIP_MEMORY_SCOPE_AGENT
#define LDS_WAIT() asm volatile("s_waitcnt lgkmcnt(0)" ::: "memory")
#define VM_WAIT() asm volatile("s_waitcnt vmcnt(0)" ::: "memory")
__device__ __forceinline__ unsigned f2bf(float f) { unsigned u = __builtin_bit_cast(unsigned, f); return (u + 0x7fffu + ((u >> 16) & 1u)) >> 16; }
__device__ __forceinline__ unsigned pk2(float lo, float hi) { return f2bf(lo) | (f2bf(hi) << 16); }
__device__ __forceinline__ float bflo(unsigned w) { return __uint_as_float(w << 16); }
__device__ __forceinline__ float bfhi(unsigned w) { return __uint_as_float(w & 0xffff0000u); }

#define XB_TMO      128
#define XB_XCNT(j)  (256  + 64 * (j))
#define XB_XSUB(j)  (1280 + 64 * (j))
#define XB_XGEN(j)  (2304 + 64 * (j))
#define XB_TOP      3328
#define XB_TOPGEN   3392
#define XCD_BAR_WORDS 3456
#define XB_SPIN_CAP (1u << 18)
__device__ __forceinline__ unsigned xb_ld(unsigned* p)              { return __hip_atomic_load(p, __ATOMIC_RELAXED, __HIP_MEMORY_SCOPE_AGENT); }
__device__ __forceinline__ unsigned xb_add(unsigned* p, unsigned v) { return __hip_atomic_fetch_add(p, v, __ATOMIC_RELAXED, __HIP_MEMORY_SCOPE_AGENT); }
__device__ __forceinline__ unsigned xb_xcc_id() { return (unsigned)__builtin_amdgcn_s_getreg((3 << 11) | 20) & 0xFu; }
#define XB_SPIN(cond, bar) do { unsigned _sp = 0; while (cond) { __builtin_amdgcn_s_sleep(1); \
    if ((++_sp & 255u) == 0u) { if (xb_ld(&(bar)[XB_TMO])) break; if (_sp > XB_SPIN_CAP) { atomicAdd(&(bar)[XB_TMO], 1u); break; } } } } while (0)
struct XcdBarrier { unsigned* bar; unsigned x; volatile LAS unsigned* st; unsigned total; };
__device__ __forceinline__ XcdBarrier xcd_barrier_post(unsigned* bar, volatile LAS unsigned* st, unsigned total) {
    XcdBarrier b; b.bar = bar; b.x = xb_xcc_id(); b.st = st; b.total = total;
    if (threadIdx.x == 0) (void)xb_add(&bar[XB_XCNT(b.x)], 1u);
    return b;
}
__device__ __forceinline__ void xcd_barrier_complete(unsigned* bar, unsigned x, unsigned G, unsigned& nloc, unsigned& nx) {
    unsigned sum, cnt, mine, sp = 0u;
    for (;;) {
        sum = 0u; cnt = 0u; mine = 0u;
#pragma unroll
        for (unsigned j = 0; j < 16; ++j) { const unsigned c = xb_ld(&bar[XB_XCNT(j)]); sum += c; cnt += (c > 0u) ? 1u : 0u; mine = (j == x) ? c : mine; }
        if (sum == G) break;
        __builtin_amdgcn_s_sleep(1);
        if ((++sp & 255u) == 0u) { if (xb_ld(&bar[XB_TMO])) break; if (sp > XB_SPIN_CAP) { atomicAdd(&bar[XB_TMO], 1u); break; } }
    }
    nloc = mine > 0u ? mine : 1u; nx = cnt > 0u ? cnt : 1u;
}
__device__ __forceinline__ void xcd_barrier(const XcdBarrier& b) {
    asm volatile("s_waitcnt vmcnt(0)" ::: "memory");
    __syncthreads();
    if (threadIdx.x == 0) {
        unsigned* bar = b.bar;
        __builtin_amdgcn_s_waitcnt(0);
        unsigned nloc = b.st[0], nx = b.st[1];
        if (nloc == 0u) { xcd_barrier_complete(bar, b.x, b.total, nloc, nx); b.st[0] = nloc; b.st[1] = nx; }
        const unsigned old = xb_add(&bar[XB_XSUB(b.x)], 1u);
        const unsigned gen = old / nloc;
        if (old + 1u == (gen + 1u) * nloc) {
            __builtin_amdgcn_fence(__ATOMIC_RELEASE, "agent");
            asm volatile("s_waitcnt vmcnt(0)" ::: "memory");
            const unsigned og = xb_add(&bar[XB_TOP], 1u);
            const unsigned tg = og / nx;
            if (og + 1u == (tg + 1u) * nx) xb_add(&bar[XB_TOPGEN], 1u);
            else XB_SPIN(xb_ld(&bar[XB_TOPGEN]) == tg, bar);
            __builtin_amdgcn_fence(__ATOMIC_ACQUIRE, "agent");
            xb_add(&bar[XB_XGEN(b.x)], 1u);
            asm volatile("s_waitcnt vmcnt(0)" ::: "memory");
        } else {
            XB_SPIN(xb_ld(&bar[XB_XGEN(b.x)]) == gen, bar);
            __builtin_amdgcn_fence(__ATOMIC_ACQUIRE, "agent");
            asm volatile("s_waitcnt vmcnt(0)" ::: "memory");
        }
    }
    __syncthreads();
}

__device__ __forceinline__ float wave_sum(float v) {
#pragma unroll
    for (int o = 1; o < 64; o <<= 1) v += __shfl_xor(v, o);
    return v;
}
constexpr int XP = 65, XSCR_BYTES = 64 * XP * 4;
__device__ __forceinline__ unsigned cvtpk(float lo, float hi) { unsigned r; asm volatile("v_cvt_pk_bf16_f32 %0, %1, %2" : "=v"(r) : "v"(lo), "v"(hi)); return r; }
__device__ __forceinline__ void p0_transpose_item(const float* W, int ldw, int k0, int n0, const float* gs, bf16* dst, int ldd, LAS float* scr, int lane) {
    const int lr = lane >> 4, lc = (lane & 15) * 4;
    const float* src = W + (size_t)(k0 + lr) * ldw + n0 + lc;
    f32x4 v[16];
#pragma unroll
    for (int i = 0; i < 16; ++i) v[i] = __builtin_nontemporal_load((const GAS f32x4*)(src + (size_t)(4 * i) * ldw));
    if (gs) {
#pragma unroll
        for (int i = 0; i < 16; ++i) v[i] = v[i] * gs[k0 + 4 * i + lr]; }
#pragma unroll
    for (int i = 0; i < 16; ++i) { LAS float* p = scr + (4 * i + lr) * XP + lc; p[0] = v[i][0]; p[1] = v[i][1]; p[2] = v[i][2]; p[3] = v[i][3]; }
    LDS_WAIT(); asm volatile("" ::: "memory");
    const int c = lane & 7, nn = lane >> 3;
#pragma unroll
    for (int j = 0; j < 8; ++j) { const int n = nn + 8 * j; const LAS float* sp = scr + (8 * c) * XP + n;
        v4u o; o.x = cvtpk(sp[0 * XP], sp[1 * XP]); o.y = cvtpk(sp[2 * XP], sp[3 * XP]); o.z = cvtpk(sp[4 * XP], sp[5 * XP]); o.w = cvtpk(sp[6 * XP], sp[7 * XP]);
        *(GAS v4u*)(dst + (size_t)n * ldd + k0 + 8 * c) = o; }
    LDS_WAIT(); asm volatile("" ::: "memory");
}
struct XTile { const float* src; const float* gs; unsigned char* dst; int ldw, ldd, k0; };
__device__ __forceinline__ XTile xtile_fp8(int item, const float* W, int ldw, int N, const float* gs, unsigned char* dst, int ldd, int mode, int lane) {
    const int nblk = N / 64, kb = item / nblk, nb = item % nblk, n0 = 64 * nb, k0 = 64 * kb;
    const int row = mode == 0 ? n0 : ((n0 >> 7) * 256 + (n0 & 127) + (mode == 2 ? 128 : 0));
    XTile t; t.src = W + (size_t)(k0 + (lane >> 4)) * ldw + n0 + (lane & 15) * 4; t.gs = gs; t.dst = dst + (size_t)row * ldd; t.ldw = ldw; t.ldd = ldd; t.k0 = k0; return t;
}
__device__ __forceinline__ void xtile_load(const XTile& t, f32x4 (&v)[16], float (&g)[16], int lane) {
    const int lr = lane >> 4;
    if (t.gs) {
#pragma unroll
        for (int i = 0; i < 16; ++i) g[i] = t.gs[t.k0 + 4 * i + lr];
    } else {
#pragma unroll
        for (int i = 0; i < 16; ++i) g[i] = 1.0f; }
#pragma unroll
    for (int i = 0; i < 16; ++i) v[i] = __builtin_nontemporal_load((const GAS f32x4*)(t.src + (size_t)(4 * i) * t.ldw));
}
__device__ __forceinline__ void xtile_finish_fp8(const XTile& t, f32x4 (&v)[16], const float (&g)[16], float wscale, LAS float* scr, int lane) {
    const int lr = lane >> 4, lc = (lane & 15) * 4;
#pragma unroll
    for (int i = 0; i < 16; ++i) v[i] = v[i] * (g[i] * wscale);
    constexpr int XR = 64;
#pragma unroll
    for (int i = 0; i < 16; ++i) *(LAS f32x4*)(scr + (4 * i + lr) * XR + (i >> 2) * 16 + lc) = v[i];
    LDS_WAIT(); asm volatile("" ::: "memory");
    const int c = lane & 3, nn = lane >> 2;
#pragma unroll
    for (int j = 0; j < 4; ++j) { const int n = nn + 16 * j; const LAS float* sp = scr + (16 * c) * XR + c * 16 + n;
        v4u o; o.x = pg8::pk_fp8x4(sp[0 * XR], sp[1 * XR], sp[2 * XR], sp[3 * XR]); o.y = pg8::pk_fp8x4(sp[4 * XR], sp[5 * XR], sp[6 * XR], sp[7 * XR]);
        o.z = pg8::pk_fp8x4(sp[8 * XR], sp[9 * XR], sp[10 * XR], sp[11 * XR]); o.w = pg8::pk_fp8x4(sp[12 * XR], sp[13 * XR], sp[14 * XR], sp[15 * XR]);
        __builtin_nontemporal_store(o, (GAS v4u*)(t.dst + (size_t)n * t.ldd + t.k0 + 16 * c)); }
    LDS_WAIT(); asm volatile("" ::: "memory");
}
__device__ __forceinline__ void xpose_mat(int item, const float* W, int ldw, int N, const float* gs, bf16* dst, int ldd, int mode, LAS float* scr, int lane) {
    const int nblk = N / 64, kb = item / nblk, nb = item % nblk, n0 = 64 * nb;
    const int row = mode == 0 ? n0 : ((n0 >> 7) * 256 + (n0 & 127) + (mode == 2 ? 128 : 0));
    p0_transpose_item(W, ldw, 64 * kb, n0, gs, dst + (size_t)row * ldd, ldd, scr, lane);
}

struct Args { const float* in[28]; float* out; unsigned char* ws; };

__device__ __forceinline__ void s5_tables(const Args& a, int g, int q, LAS unsigned char* lds, int tid) {
    LAS float* POWr = (LAS float*)lds;
    LAS float* POWi = POWr + 33 * 64;
    LAS float* BBr = POWi + 33 * 64;
    LAS float* BBi = BBr + 1024;
    LAS float* CCr = BBi + 1024;
    LAS float* CCi = CCr + 1024;
    LAS float* KT = CCi + 1024;
    LAS float* DD = KT + 2048;
    const float* a_re = a.in[3]; const float* a_im = a.in[4]; const float* b_re = a.in[5]; const float* b_im = a.in[6];
    const float* c_re = a.in[7]; const float* c_im = a.in[8]; const float* dsk = a.in[9]; const float* log_step = a.in[10];
    const float step = expf(log_step[g]);
    __syncthreads();
    for (int e = tid; e < 33 * 64; e += NTHREADS) { const int n = e >> 6, p = e & 63; const float lr = a_re[g * 64 + p], li = a_im[g * 64 + p];
        const float mag = expf((float)n * step * lr); float sn, cs; sincosf((float)n * (step * li), &sn, &cs); POWr[e] = mag * cs; POWi[e] = mag * sn; }
    for (int e = tid; e < 1024; e += NTHREADS) { const int p = e >> 4, h = e & 15; const float lr = a_re[g * 64 + p], li = a_im[g * 64 + p];
        const float er = expf(lr * step); float sn, cs; sincosf(li * step, &sn, &cs); const float nr = er * cs - 1.f, ni = er * sn, den = lr * lr + li * li;
        const float fr = (nr * lr + ni * li) / den, fi = (ni * lr - nr * li) / den;
        const float br = b_re[(g * 64 + p) * 16 + h], bi = b_im[(g * 64 + p) * 16 + h];
        BBr[e] = fr * br - fi * bi; BBi[e] = fr * bi + fi * br;
        CCr[e] = c_re[g * 1024 + e]; CCi[e] = c_im[g * 1024 + e]; }
    if (tid < 16) DD[tid] = dsk[g * 16 + tid];
    __syncthreads();
    { const int lane_ = tid & 63, hq = lane_ & 3, hl = (lane_ >> 2) & 3, tau = 4 * (tid >> 6) + (lane_ >> 4), ho = 4 * q + hl, rot = 8 * hl + 2 * (lane_ >> 4);
      f32x4 sa = (f32x4){0.f, 0.f, 0.f, 0.f};
      for (int pp = 0; pp < 64; ++pp) { const int p = (pp + rot) & 63; const float cr = CCr[ho * 64 + p], ci = CCi[ho * 64 + p], pr = POWr[tau * 64 + p], pi = POWi[tau * 64 + p];
          const float xr = cr * pr - ci * pi, xi = cr * pi + ci * pr; const f32x4 br = *(const LAS f32x4*)(BBr + p * 16 + 4 * hq), bi = *(const LAS f32x4*)(BBi + p * 16 + 4 * hq);
          sa += br * xr - bi * xi; }
      if (tau == 0 && (ho >> 2) == hq) sa[ho & 3] += DD[ho];
      *(LAS f32x4*)(KT + (tau * 4 + hl) * 16 + 4 * hq) = sa; }
    __syncthreads();
    bf16* WA = (bf16*)(a.ws + WS_S5WA) + (size_t)g * 256 * 512;
    for (int pc = tid; pc < 64 * 64; pc += NTHREADS) { const int p = pc >> 6, k0 = (pc & 63) * 8; v4u o = (v4u){0u, 0u, 0u, 0u};
        if (q < 2) { const int j = k0 >> 4, h0 = k0 & 15; const float pr = POWr[(31 - j) * 64 + p], pi = POWi[(31 - j) * 64 + p]; float v[8];
#pragma unroll
            for (int w = 0; w < 8; ++w) { const float br = BBr[p * 16 + h0 + w], bi = BBi[p * 16 + h0 + w]; v[w] = (q == 0) ? (pr * br - pi * bi) : (pr * bi + pi * br); }
            o.x = cvtpk(v[0], v[1]); o.y = cvtpk(v[2], v[3]); o.z = cvtpk(v[4], v[5]); o.w = cvtpk(v[6], v[7]); }
        *(GAS v4u*)(WA + (size_t)(64 * q + p) * 512 + k0) = o; }
    bf16* WC = (bf16*)(a.ws + WS_S5WC) + (size_t)g * 512 * 640;
    for (int pc = tid; pc < 128 * 80; pc += NTHREADS) { const int rl = pc / 80, k0 = (pc % 80) * 8, i = rl >> 2, hl = rl & 3, ho = 4 * q + hl; float v[8];
        if (k0 < 512) { const int j = k0 >> 4, h0 = k0 & 15; f32x4 ka = (f32x4){0.f, 0.f, 0.f, 0.f}, kb = ka;
            if (j <= i) { const LAS f32x4* kp = (const LAS f32x4*)(KT + ((i - j) * 4 + hl) * 16 + h0); ka = kp[0]; kb = kp[1]; }
#pragma unroll
            for (int w = 0; w < 4; ++w) { v[w] = ka[w]; v[4 + w] = kb[w]; } }
        else { const int p0 = (k0 - 512) & 63; const bool im = k0 >= 576;
#pragma unroll
            for (int w = 0; w < 8; ++w) { const int p = p0 + w; const float cr = CCr[ho * 64 + p], ci = CCi[ho * 64 + p], pr = POWr[(i + 1) * 64 + p], pi = POWi[(i + 1) * 64 + p];
                v[w] = im ? -(cr * pi + ci * pr) : (cr * pr - ci * pi); } }
        v4u o; o.x = cvtpk(v[0], v[1]); o.y = cvtpk(v[2], v[3]); o.z = cvtpk(v[4], v[5]); o.w = cvtpk(v[6], v[7]);
        *(GAS v4u*)(WC + (size_t)(i * 16 + ho) * 640 + k0) = o; }
    __syncthreads();
}

constexpr int MOE_XITEMS = 24 * 896;
__device__ __forceinline__ XTile moe_xtile(const Args& a, int r, int lane) {
    unsigned char* ws = a.ws;
    const int mat = r / 896, e = mat / 3, which = mat % 3; r -= mat * 896;
    if (which == 0) return xtile_fp8(r, a.in[24] + (size_t)e * D * DFE, DFE, DFE, a.in[22], ws + WS_WMOE_GU + (size_t)e * 7168 * 1024, D, 1, lane);
    if (which == 1) return xtile_fp8(r, a.in[25] + (size_t)e * D * DFE, DFE, DFE, a.in[22], ws + WS_WMOE_GU + (size_t)e * 7168 * 1024, D, 2, lane);
    return xtile_fp8(r, a.in[26] + (size_t)e * DFE * D, D, D, nullptr, ws + WS_WMOE_D + (size_t)e * 1024 * 3584, DFE, 0, lane);
}
constexpr int I_IN0 = 16 * 32, I_GLU = 8 * 8, I_OUT = 16 * 16, I_GU0 = 16 * 44, I_D0 = 44 * 16, I_IN1 = 16 * 48;
constexpr int DW_FIRST = I_IN0 + I_GLU  , DW_EARLY = I_IN0 + I_GLU + I_OUT + 2 * I_GU0, DW_ITEMS = DW_EARLY + I_D0 + I_IN1 + I_OUT;
__device__ __forceinline__ void dense_item(const Args& a, int it, LAS float* scr, int lane) {
    unsigned char* ws = a.ws; int r = it;
    if (r < I_IN0) { xpose_mat(r, a.in[2], EVEN_IN, EVEN_IN, a.in[1], (bf16*)(ws + WS_WIN0), D, 0, scr, lane); return; } r -= I_IN0;
    if (r < I_GLU) { xpose_mat(r, a.in[11], 512, 512, nullptr, (bf16*)(ws + WS_WGLU), 512, 0, scr, lane); return; } r -= I_GLU;
    if (r < I_OUT) { xpose_mat(r, a.in[13], D, D, nullptr, (bf16*)(ws + WS_WOUT0), D, 0, scr, lane); return; } r -= I_OUT;
    if (r < I_GU0) { xpose_mat(r, a.in[15], DFF, DFF, a.in[14], (bf16*)(ws + WS_WGU0), D, 1, scr, lane); return; } r -= I_GU0;
    if (r < I_GU0) { xpose_mat(r, a.in[16], DFF, DFF, a.in[14], (bf16*)(ws + WS_WGU0), D, 2, scr, lane); return; } r -= I_GU0;
    if (r < I_D0) { xpose_mat(r, a.in[17], D, D, nullptr, (bf16*)(ws + WS_WD0), DFF, 0, scr, lane); return; } r -= I_D0;
    if (r < I_IN1) { const XTile t = xtile_fp8(r, a.in[19], ODD_IN, 3072, a.in[18], ws + WS_WIN1, D, 0, lane); f32x4 v[16]; float g[16]; xtile_load(t, v, g, lane); xtile_finish_fp8(t, v, g, 64.f, scr, lane); return; } r -= I_IN1;
    { const XTile t = xtile_fp8(r, a.in[21], D, D, nullptr, ws + WS_WOUT1, D, 0, lane); f32x4 v[16]; float g[16]; xtile_load(t, v, g, lane); xtile_finish_fp8(t, v, g, 64.f, scr, lane); }
}
__device__ __forceinline__ void dense_range(const Args& a, LAS unsigned char* lds, int lane, int wave, int iw, int nwg_, int lo, int hi) {
    LAS float* scr = (LAS float*)(lds + wave * XSCR_BYTES);
    for (int it = hi - 1 - (iw * NWAVES + wave); it >= lo; it -= nwg_ * NWAVES) dense_item(a, it, scr, lane);
}
__device__ __forceinline__ void dense_late(const Args& a, LAS unsigned char* lds, int tid, int lane, int wave, int iw, int nwg_) {
    LAS float* scr = (LAS float*)(lds + wave * XSCR_BYTES);
    for (int it = DW_ITEMS - 1 - (iw * NWAVES + wave); it >= DW_EARLY; it -= nwg_ * NWAVES) dense_item(a, it, scr, lane);
    for (int gt = iw * NTHREADS + tid; gt < 16 * 1024; gt += nwg_ * NTHREADS) { const int h = gt >> 10, k = gt & 1023; ((bf16*)(a.ws + WS_WF1))[gt] = (bf16)f2bf(a.in[19][(size_t)k * ODD_IN + 3072 + h] * a.in[18][k]); }
}
__device__ __forceinline__ void p0_prologue(const Args& a, LAS unsigned char* lds, int tid, int lane, int wave, int vcu, int G) {
    for (int it = vcu; it < 4 * S5G; it += G) s5_tables(a, it >> 2, it & 3, lds, tid);
    LAS float* scr = (LAS float*)(lds + wave * XSCR_BYTES);
    const int gw = vcu * NWAVES + wave, NGW = G * NWAVES;
    unsigned char* ws = a.ws;
    for (int it = DW_FIRST - 1 - gw; it >= 0; it -= NGW) dense_item(a, it, scr, lane);
    float* ss0 = (float*)(ws + WS_SSP);
    int m0, nr, stp;
    if (G == 256) { if (vcu < 128) { m0 = vcu * 48 + wave * 6; nr = 6; } else { m0 = 6144 + (vcu - 128) * 80 + wave * 10; nr = 10; } stp = 1; }
    else { m0 = gw; nr = (M - gw + NGW - 1) / NGW; stp = NGW; }
    f32x4 xnx[4];
    if (nr > 0) {
#pragma unroll
        for (int j = 0; j < 4; ++j) xnx[j] = ((const GAS f32x4*)(a.in[0] + (size_t)m0 * D) + lane)[64 * j]; }
    for (int i = 0; i < nr; ++i) { const int m = m0 + i * stp;
        GAS v2u* o8 = (GAS v2u*)((bf16*)(ws + WS_XB) + (size_t)m * D) + lane; float s = 0.f; f32x4 xc[4];
#pragma unroll
        for (int j = 0; j < 4; ++j) xc[j] = xnx[j];
        if (i + 1 < nr) {
#pragma unroll
            for (int j = 0; j < 4; ++j) xnx[j] = ((const GAS f32x4*)(a.in[0] + (size_t)(m + stp) * D) + lane)[64 * j]; }
#pragma unroll
        for (int j = 0; j < 4; ++j) { const f32x4 v = xc[j]; s += (v.x * v.x + v.y * v.y) + (v.z * v.z + v.w * v.w); v2u w; w.x = cvtpk(v.x, v.y); w.y = cvtpk(v.z, v.w); o8[64 * j] = w; }
        s = wave_sum(s); if (lane < 16) ss0[(size_t)m * 16 + lane] = (lane == 0) ? s : 0.f;
    }
}

__device__ __forceinline__ void s5_scan(const Args& a, int gt  ) {
    if (gt >= BATCH * S5G * S5P) return;
    const int b = gt / (S5G * S5P), g = (gt / S5P) % S5G, p = gt % S5P;
    const float step = expf(a.in[10][g]); const float lr = a.in[3][g * 64 + p], li = a.in[4][g * 64 + p];
    const float mag = expf((float)S5T * step * lr); float sn, cs; sincosf((float)S5T * (step * li), &sn, &cs); const float ar = mag * cs, ai = mag * sn;
    const float* sl = (const float*)(a.ws + WS_SLOC) + ((size_t)g * S5NC + b * 256) * 128 + p;
    bf16* ue = (bf16*)(a.ws + WS_UEXT) + ((size_t)g * S5NC + b * 256) * S5KX + 512 + p;
    float sr = 0.f, si = 0.f;
    float cr[16], ci[16], nr_[16], ni_[16];
#pragma unroll
    for (int j = 0; j < 16; ++j) { cr[j] = sl[(size_t)j * 128]; ci[j] = sl[(size_t)j * 128 + 64]; }
#pragma unroll 1
    for (int c0 = 0; c0 < 256; c0 += 16) {
        if (c0 + 16 < 256) {
#pragma unroll
            for (int j = 0; j < 16; ++j) { nr_[j] = sl[(size_t)(c0 + 16 + j) * 128]; ni_[j] = sl[(size_t)(c0 + 16 + j) * 128 + 64]; } }
#pragma unroll
        for (int j = 0; j < 16; ++j) { const int c = c0 + j;
            ue[(size_t)c * S5KX] = (bf16)f2bf(sr); ue[(size_t)c * S5KX + 64] = (bf16)f2bf(si);
            const float nr = ar * sr - ai * si + cr[j], ni = ar * si + ai * sr + ci[j]; sr = nr; si = ni; }
#pragma unroll
        for (int j = 0; j < 16; ++j) { cr[j] = nr_[j]; ci[j] = ni_[j]; }
    }
}

__device__ __forceinline__ void fgate_rows16(const bf16* xb, const bf16* wf, const float* ss, const float* bfv, float* logf, int r0, int lane) {
    const int fr = lane & 15, fq = lane >> 4;
    const bf16x8* ap = (const bf16x8*)(xb + (size_t)(r0 + fr) * D + fq * 8);
    const bf16x8* bp = (const bf16x8*)(wf + (size_t)fr * D + fq * 8);
    f32x4 acc0 = (f32x4){0.f, 0.f, 0.f, 0.f}, acc1 = (f32x4){0.f, 0.f, 0.f, 0.f};
#pragma unroll
    for (int half = 0; half < 2; ++half) {
        bf16x8 av[16], bv[16];
#pragma unroll
        for (int kk = 0; kk < 16; ++kk) { av[kk] = ap[(half * 16 + kk) * 4]; bv[kk] = bp[(half * 16 + kk) * 4]; }
#pragma unroll
        for (int kk = 0; kk < 16; kk += 2) { acc0 = __builtin_amdgcn_mfma_f32_16x16x32_bf16(av[kk], bv[kk], acc0, 0, 0, 0); acc1 = __builtin_amdgcn_mfma_f32_16x16x32_bf16(av[kk + 1], bv[kk + 1], acc1, 0, 0, 0); }
    }
    const f32x4 acc = acc0 + acc1;
    const float bias = bfv[fr];
    float rsq[4];
#pragma unroll
    for (int j = 0; j < 4; ++j) rsq[j] = pg8::rstd16(ss, r0 + fq * 4 + j);
#pragma unroll
    for (int j = 0; j < 4; ++j) { const int row = r0 + fq * 4 + j;
        const float z = acc[j] * rsq[j] + bias;
        const float lf = -(fmaxf(-z, 0.f) + log1pf(expf(-fabsf(z)))) * 1.4426950408889634f;
        const int b = row >> 13, t = row & 8191; logf[((size_t)b * FOXH + fr) * SEQ + t] = lf; }
}

struct MoeOrder {
    pg8::StaticOrder S; int lo; int pref[NEXP + 1]; bool cap_rows;
    __device__ __forceinline__ bool next(int i, pg8::Unit& u) const {
        if (!S.next(i, u)) return false;
        u.pm += lo; int e = 0, pe = 0;
#pragma unroll
        for (int k = 1; k < NEXP; ++k) { const bool ge = u.pm >= pref[k]; e += ge ? 1 : 0; pe = ge ? pref[k] : pe; }
        u.zb = e; u.pa = cap_rows ? e * (MOE_CAP / 256) + (u.pm - pe) : u.pm; return true;
    }
    __device__ __forceinline__ void a_ready(const pg8::Unit&) const {}
    __device__ __forceinline__ void done(const pg8::Unit&) const {}
};

struct MoeQuadOrder {
    int p0, np, G, c; int pref[NEXP + 1];
    __device__ __forceinline__ bool next(int i, pg8::Unit& u) const {
        const long L = (long)i * G + c; if (L >= (long)np * 16) return false;
        const int q = (int)(L & 3), ul = (int)(L >> 2); u.pn = ul & 3; u.pm = p0 + (ul >> 2); u.qa = q >> 1; u.qb = q & 1; u.pa = u.pm; int e = 0;
#pragma unroll
        for (int k = 1; k < NEXP; ++k) e += (u.pm >= pref[k]) ? 1 : 0;
        u.zb = e; return true;
    }
    __device__ __forceinline__ void a_ready(const pg8::Unit&) const {}
    __device__ __forceinline__ void done(const pg8::Unit&) const {}
};

__global__ void __launch_bounds__(NTHREADS, 2) mk_fwd(Args args) {
    extern __shared__ __attribute__((aligned(16))) unsigned char lds_raw[];
    LAS unsigned char* lds = (LAS unsigned char*)lds_raw;
    volatile LAS unsigned* MISC = (volatile LAS unsigned*)(lds + MISC_OFF);
    const int tid = threadIdx.x, lane = tid & 63, wave = __builtin_amdgcn_readfirstlane(tid >> 6);
    const int G = gridDim.x; const int bx = blockIdx.x; const int vcu = (G % 8 == 0) ? (bx % 8) * (G / 8) + bx / 8 : bx;
    unsigned char* ws = args.ws;
    gu32* ctl = (gu32*)(ws + WS_CTL);
    for (int u = tid; u < (LDS_BYTES - LDSCTL_OFF) / 4; u += NTHREADS) ((LAS unsigned*)(lds + LDSCTL_OFF))[u] = 0u;
    __syncthreads();
    XcdBarrier bar = xcd_barrier_post((unsigned*)(ctl + CW_BAR), MISC + 8, (unsigned)G);
    const int gw = vcu * NWAVES + wave, NGW = G * NWAVES;
    float* SS = (float*)(ws + WS_SSP);
    float* X = args.out;
    bf16* XB = (bf16*)(ws + WS_XB);
#define GRID_BAR() xcd_barrier(bar)
#define GEMM_PHASE(EPI, SCHED, lds_, g_, S_, E_) pg8::gemm_phase<EPI, SCHED, true, true>(lds_, g_, S_, E_)

    p0_prologue(args, lds, tid, lane, wave, vcu, G);
    GRID_BAR();
    { pg8::Gemm g{XB, (const bf16*)(ws + WS_WIN0), D, D, D, 0, 0}; pg8::StaticOrder S; S.init(M, EVEN_IN, 1, G, bx);
      pg8::EpiInProj0 E{SS, (bf16*)(ws + WS_UEXT), (bf16*)(ws + WS_QKV0), C2};
      GEMM_PHASE(pg8::EpiInProj0, pg8::StaticOrder, lds + RING_OFF, g, S, E); }
    GRID_BAR();
#define SB_PULL_ONE(more_) do { if (tid == 0) MISC[17] = __hip_atomic_fetch_add(ctl + CW_QUEUE2, 1u, RLX_AGENT); __syncthreads(); const unsigned uq_ = __builtin_amdgcn_readfirstlane(MISC[17]); __syncthreads(); \
        more_ = uq_ < (unsigned)(BATCH * SBH * 32); if (more_) { const int bh_ = (int)(uq_ >> 5), qb_ = (int)(uq_ & 31u); \
            attn_body::sb_unit<1536>(bh_ >> 3, bh_ & 7, qb_, (const attn_body::bf16*)(ws + WS_QKV0), (const attn_body::bf16*)(ws + WS_QKV0) + 512, (const attn_body::bf16*)(ws + WS_QKV0) + 1024, (attn_body::bf16*)(ws + WS_MIXB) + 512, (char*)lds_raw + RING_OFF); } } while (0)
    { const bool s5g = (G % 16 == 0) ? (((bx >> 3) & 1) == 0) : true; const int Gs = (G % 16 == 0) ? G / 2 : G, gl = (G % 16 == 0) ? (bx & 7) + 8 * (bx >> 4) : bx;
      if (s5g) {
          XcdBarrier sub = xcd_barrier_post((unsigned*)(ctl + CW_SUBBAR), MISC + 12, (unsigned)Gs);
          { pg8::Gemm g{(const bf16*)(ws + WS_UEXT), (const bf16*)(ws + WS_S5WA), S5KX, 512, 512, (size_t)S5NC * S5KX * 2, (size_t)256 * 512 * 2}; pg8::StaticOrder S; S.init(S5NC, 256, S5G, Gs, gl);
            pg8::EpiS5State E{(float*)(ws + WS_SLOC)};
            GEMM_PHASE(pg8::EpiS5State, pg8::StaticOrder, lds + RING_OFF, g, S, E);
            if (Gs > S.nwg) { if (gl >= S.nwg) dense_range(args, lds, lane, wave, gl - S.nwg, Gs - S.nwg, DW_EARLY - I_GU0, DW_EARLY); } else dense_range(args, lds, lane, wave, gl, Gs, DW_EARLY - I_GU0, DW_EARLY); }
          xcd_barrier(sub);
          s5_scan(args, gl * NTHREADS + tid);
          { constexpr int NSCAN = BATCH * S5G * S5P / NTHREADS; if (Gs > NSCAN) { if (gl >= NSCAN) dense_range(args, lds, lane, wave, gl - NSCAN, Gs - NSCAN, DW_FIRST, DW_EARLY - I_GU0); } else dense_range(args, lds, lane, wave, gl, Gs, DW_FIRST, DW_EARLY - I_GU0); }
          xcd_barrier(sub);
          { pg8::Gemm g{(const bf16*)(ws + WS_UEXT), (const bf16*)(ws + WS_S5WC), S5KX, S5KX, S5KX, (size_t)S5NC * S5KX * 2, (size_t)512 * S5KX * 2}; pg8::StaticOrder S; S.init(S5NC, 512, S5G, Gs, gl);
            pg8::EpiS5Y E{(bf16*)(ws + WS_YG)};
            GEMM_PHASE(pg8::EpiS5Y, pg8::StaticOrder, lds + RING_OFF, g, S, E); }
          xcd_barrier(sub);
          { pg8::Gemm g{(const bf16*)(ws + WS_YG), (const bf16*)(ws + WS_WGLU), 512, 512, 512, 0, 0}; pg8::StaticOrder S; S.init(M, 512, 1, Gs, gl);
            pg8::EpiGlu E{(const bf16*)(ws + WS_YG), args.in[12], (bf16*)(ws + WS_MIXB)};
            GEMM_PHASE(pg8::EpiGlu, pg8::StaticOrder, lds + RING_OFF, g, S, E); }
          __syncthreads();
      }
      bool sb_more = true;
#pragma unroll 1
      while (sb_more) SB_PULL_ONE(sb_more);
    }
    GRID_BAR();
#undef SB_PULL_ONE
    { pg8::Gemm g{(const bf16*)(ws + WS_MIXB), (const bf16*)(ws + WS_WOUT0), D, D, D, 0, 0}; pg8::StaticOrder S; S.init(M, D, 1, G, bx);
      pg8::EpiResid<true> E{args.in[0], X, XB, SS + 16 * M};
      GEMM_PHASE(pg8::EpiResid<true>, pg8::StaticOrder, lds + RING_OFF, g, S, E); }
    GRID_BAR();
    { pg8::Gemm g{XB, (const bf16*)(ws + WS_WGU0), D, D, D, 0, 0}; pg8::StaticOrder S; S.init(M, 2 * DFF, 1, G, bx);
      pg8::EpiSwiGlu<true> E{SS + 16 * M, (bf16*)(ws + WS_HID0), DFF};
      GEMM_PHASE(pg8::EpiSwiGlu<true>, pg8::StaticOrder, lds + RING_OFF, g, S, E);
      { const int rem = S.nwg % G; if (rem == 0) dense_late(args, lds, tid, lane, wave, bx, G); else if (bx >= rem) dense_late(args, lds, tid, lane, wave, bx - rem, G - rem); } }
    GRID_BAR();
    { pg8::Gemm g{(const bf16*)(ws + WS_HID0), (const bf16*)(ws + WS_WD0), DFF, DFF, DFF, 0, 0}; pg8::StaticOrder S; S.init(M, D, 1, G, bx);
      pg8::EpiResid<true> E{X, X, XB, SS + 32 * M, ws + WS_HMOE  };
      GEMM_PHASE(pg8::EpiResid<true>, pg8::StaticOrder, lds + RING_OFF, g, S, E); }
    GRID_BAR();
    { pg8::Gemm g{(const bf16*)(ws + WS_HMOE), (const bf16*)(ws + WS_WIN1), D / 2, D / 2, D / 2, 0, 0}; pg8::StaticOrder S; S.init(M, 3072, 1, G, bx);
      pg8::EpiInProj1 E{SS + 32 * M, (bf16*)(ws + WS_QKV1), C2, (unsigned*)(ctl + CW_KN)};
      pg8::gemm_phase<pg8::EpiInProj1, pg8::StaticOrder, true, true, true>(lds + RING_OFF, g, S, E); }
    for (int r = gw; r < M / 16; r += NGW) fgate_rows16(XB, (const bf16*)(ws + WS_WF1), SS + 32 * M, args.in[20], (float*)(ws + WS_LOGF), r * 16, lane);
    GRID_BAR();
    { const attn_body::AttnTensors AT{(const attn_body::bf16*)(ws + WS_QKV1), (const attn_body::bf16*)(ws + WS_QKV1 + 32 * MiB), (const attn_body::bf16*)(ws + WS_QKV1 + 64 * MiB), (attn_body::bf16*)(ws + WS_QKV1), (const float*)(ws + WS_LOGF), (const unsigned*)(ctl + CW_KN)};
      constexpr int N_ATT = 1024, N_CVB = MOE_XITEMS / 32, N_GRP = (N_ATT + 2) / 3 > (N_CVB + 1) / 2 ? (N_ATT + 2) / 3 : (N_CVB + 1) / 2;
      for (;;) {
          if (tid == 0) MISC[16] = __hip_atomic_fetch_add(ctl + CW_QUEUE, 1u, RLX_AGENT);
          __syncthreads();
          const unsigned uq = __builtin_amdgcn_readfirstlane(MISC[16]);
          __syncthreads();
          if (uq >= 5u * N_GRP) break;
          const int grp = (int)(uq / 5u), rr = (int)(uq % 5u);
          if (rr & 1) { const int cb = 2 * grp + (rr >> 1);
              if (cb < N_CVB) { int lane_ = threadIdx.x & 63; asm volatile("" : "+v"(lane_));
                  LAS float* scr = (LAS float*)(lds + wave * XSCR_BYTES);
#pragma unroll 1
                  for (int j = 0; j < 4; j += 2) { const XTile t0 = moe_xtile(args, cb * 32 + wave * 4 + j, lane_), t1 = moe_xtile(args, cb * 32 + wave * 4 + j + 1, lane_);
                      f32x4 v0[16], v1[16]; float g0[16], g1[16]; xtile_load(t0, v0, g0, lane_); xtile_load(t1, v1, g1, lane_);
                      xtile_finish_fp8(t0, v0, g0, 64.f, scr, lane_); xtile_finish_fp8(t1, v1, g1, 64.f, scr, lane_); } }
          } else { const int au = 3 * grp + (rr >> 1);
              if (au < N_ATT) { const int bh = au & 31, qb = 31 - (au >> 5);
                  attn_body::attn_unit<8>(bh >> 4, bh & 15, qb, AT.Q, AT.K, AT.V, AT.O, (char*)lds_raw + RING_OFF, AT.logf + (size_t)bh * SEQ, AT.kn + (size_t)bh * 256, ws + WS_HMOE + 16 * MiB  ); } }
      } }
    GRID_BAR();
    { pg8::Gemm g{(const bf16*)(ws + WS_HMOE + 16 * MiB), (const bf16*)(ws + WS_WOUT1), D / 2, D / 2, D / 2, 0, 0}; pg8::StaticOrder S; S.init(M, D, 1, G, bx);
      pg8::EpiResid<false> E{X, X, XB, SS + 48 * M};
      pg8::gemm_phase<pg8::EpiResid<false>, pg8::StaticOrder, true, true, true>(lds + RING_OFF, g, S, E); }
    GRID_BAR();
    unsigned char* meta = ws + WS_META; unsigned char* XG = ws + WS_XG; float* RSS = (float*)(meta + MT_RSS);
    {
        const float* wr = args.in[23]; const float* gn = args.in[22];
        LAS unsigned* lcnt = (LAS unsigned*)(lds + 1024);
        LAS unsigned* rowst = (LAS unsigned*)(lds + 4096);
        if (tid < 16) lcnt[tid] = 0u;
        __syncthreads();
        float wl[16][NEXP];
#pragma unroll
        for (int j = 0; j < 4; ++j) { const int k0 = 4 * lane + 256 * j; const f32x4 gv = *(const f32x4*)(gn + k0);
#pragma unroll
            for (int q = 0; q < 4; ++q) { const f32x4 w0 = *(const f32x4*)(wr + (size_t)(k0 + q) * NEXP), w1 = *(const f32x4*)(wr + (size_t)(k0 + q) * NEXP + 4);
                wl[4 * j + q][0] = gv[q] * w0.x; wl[4 * j + q][1] = gv[q] * w0.y; wl[4 * j + q][2] = gv[q] * w0.z; wl[4 * j + q][3] = gv[q] * w0.w;
                wl[4 * j + q][4] = gv[q] * w1.x; wl[4 * j + q][5] = gv[q] * w1.y; wl[4 * j + q][6] = gv[q] * w1.z; wl[4 * j + q][7] = gv[q] * w1.w; } }
        f32x4 xn[4];
        if (gw < M) {
#pragma unroll
            for (int j = 0; j < 4; ++j) xn[j] = ((const GAS f32x4*)(X + (size_t)gw * D) + lane)[64 * j]; }
        const bool hb5 = (lane & 32) != 0, hb4 = (lane & 16) != 0, hb3 = (lane & 8) != 0;
        for (int tok = gw; tok < M; tok += NGW) {
            f32x4 xv[4];
#pragma unroll
            for (int j = 0; j < 4; ++j) xv[j] = xn[j];
            if (tok + NGW < M) {
#pragma unroll
                for (int j = 0; j < 4; ++j) xn[j] = ((const GAS f32x4*)(X + (size_t)(tok + NGW) * D) + lane)[64 * j]; }
            float lg[NEXP]; float s = 0.f; const int ti = (tok - gw) / NGW;
#pragma unroll
            for (int e = 0; e < NEXP; ++e) lg[e] = 0.f;
#pragma unroll
            for (int j = 0; j < 4; ++j) { const f32x4 v = xv[j]; s += (v.x * v.x + v.y * v.y) + (v.z * v.z + v.w * v.w);
                if (ti < 8) rowst[((wave * 8 + ti) * 256) + lane + 64 * j] = pg8::pk_fp8x4(v.x, v.y, v.z, v.w);
#pragma unroll
                for (int q = 0; q < 4; ++q)
#pragma unroll
                    for (int e = 0; e < NEXP; ++e) lg[e] = fmaf(v[q], wl[4 * j + q][e], lg[e]); }
            s = wave_sum(s);
            float a4[4], a2[2], a1;
#pragma unroll
            for (int i = 0; i < 4; ++i) { const float snd = hb5 ? lg[i] : lg[i + 4], kp = hb5 ? lg[i + 4] : lg[i]; a4[i] = kp + __shfl_xor(snd, 32); }
#pragma unroll
            for (int i = 0; i < 2; ++i) { const float snd = hb4 ? a4[i] : a4[i + 2], kp = hb4 ? a4[i + 2] : a4[i]; a2[i] = kp + __shfl_xor(snd, 16); }
            { const float snd = hb3 ? a2[0] : a2[1], kp = hb3 ? a2[1] : a2[0]; a1 = kp + __shfl_xor(snd, 8); }
            a1 += __shfl_xor(a1, 4); a1 += __shfl_xor(a1, 2); a1 += __shfl_xor(a1, 1);
#pragma unroll
            for (int e = 0; e < NEXP; ++e) lg[e] = __builtin_bit_cast(float, __builtin_amdgcn_readlane(__builtin_bit_cast(int, a1), 8 * e));
            if (lane == 0) {
                const float rs = 1.0f / sqrtf(s * (1.0f / 1024.0f) + pg8::RMS_EPS);
                int i1 = 0; float v1 = lg[0];
#pragma unroll
                for (int e = 1; e < NEXP; ++e) if (lg[e] > v1) { v1 = lg[e]; i1 = e; }
                int i2 = -1; float v2 = -INFINITY;
#pragma unroll
                for (int e = 0; e < NEXP; ++e) if (e != i1 && lg[e] > v2) { v2 = lg[e]; i2 = e; }
                const float g1 = 1.f / (1.f + expf((v2 - v1) * rs)), g2 = 1.f - g1;
                const unsigned p1 = __hip_atomic_fetch_add(lcnt + i1, 1u, __ATOMIC_RELAXED, __HIP_MEMORY_SCOPE_WORKGROUP), p2 = __hip_atomic_fetch_add(lcnt + i2, 1u, __ATOMIC_RELAXED, __HIP_MEMORY_SCOPE_WORKGROUP);
                ((float*)(meta + MT_RSTD))[tok] = rs; ((unsigned*)(meta + MT_TOKE))[tok] = (unsigned)i1 | ((unsigned)i2 << 8);
                ((unsigned*)(meta + MT_TOKP))[2 * tok] = p1; ((unsigned*)(meta + MT_TOKP))[2 * tok + 1] = p2;
                ((float*)(meta + MT_TOKG))[2 * tok] = g1; ((float*)(meta + MT_TOKG))[2 * tok + 1] = g2;
            }
        }
        __syncthreads();
        if (tid < NEXP) lcnt[8 + tid] = __hip_atomic_fetch_add(ctl + CW_CNT + 64 * tid, lcnt[tid], RLX_AGENT);
        VM_WAIT();
        __syncthreads();
        for (int tok = gw; tok < M; tok += NGW) {
            const unsigned ee = ((const unsigned*)(meta + MT_TOKE))[tok]; const float rs = ((const float*)(meta + MT_RSTD))[tok];
            const unsigned q1 = ((const unsigned*)(meta + MT_TOKP))[2 * tok], q2 = ((const unsigned*)(meta + MT_TOKP))[2 * tok + 1];
            const int ti = (tok - gw) / NGW; unsigned w[4];
            if (ti < 8) {
#pragma unroll
                for (int j = 0; j < 4; ++j) w[j] = rowst[((wave * 8 + ti) * 256) + lane + 64 * j];
            } else {
#pragma unroll
                for (int j = 0; j < 4; ++j) { const f32x4 v = ((const GAS f32x4*)(X + (size_t)tok * D) + lane)[64 * j]; w[j] = pg8::pk_fp8x4(v.x, v.y, v.z, v.w); } }
            const int e1 = (int)(ee & 0xffu), e2 = (int)((ee >> 8) & 0xffu);
            const unsigned p1 = q1 + lcnt[8 + e1], p2 = q2 + lcnt[8 + e2];
            const size_t r1 = (size_t)e1 * MOE_CAP + p1, r2 = (size_t)e2 * MOE_CAP + p2;
#pragma unroll
            for (int j = 0; j < 4; ++j) { *(unsigned*)(XG + r1 * D + 4 * lane + 256 * j) = w[j]; *(unsigned*)(XG + r2 * D + 4 * lane + 256 * j) = w[j]; }
            if (lane == 0) { RSS[r1] = rs; RSS[r2] = rs; ((unsigned*)(meta + MT_TOKP))[2 * tok] = p1; ((unsigned*)(meta + MT_TOKP))[2 * tok + 1] = p2; }
        }
    }
    GRID_BAR();
    int pref[NEXP + 1], cnt[NEXP];
    { pref[0] = 0;
#pragma unroll
      for (int e = 0; e < NEXP; ++e) { cnt[e] = (int)__builtin_amdgcn_readfirstlane(__hip_atomic_load(ctl + CW_CNT + 64 * e, RLX_AGENT)); pref[e + 1] = pref[e] + (cnt[e] + 255) / 256; } }
    const int NP = pref[NEXP];
    bf16* YS = (bf16*)(ws + WS_Y);
    { pg8::Gemm g{(const bf16*)XG, (const bf16*)(ws + WS_WMOE_GU), D / 2, D / 2, D / 2, 0, (size_t)7168 * 1024}; MoeOrder S; S.S.nM = NP; S.S.nN = 28; S.S.nZ = 1; S.S.nwg = NP * 28; S.S.G = G; S.S.c = bx; S.lo = 0; S.cap_rows = true;
#pragma unroll
      for (int e = 0; e <= NEXP; ++e) S.pref[e] = pref[e];
      pg8::EpiSwiGluFp8 E{RSS, ws + WS_HMOE, DFE};
      pg8::gemm_phase<pg8::EpiSwiGluFp8, MoeOrder, true, true, true>(lds + RING_OFF, g, S, E); }
    GRID_BAR();
    { pg8::Gemm g{(const bf16*)(ws + WS_HMOE), (const bf16*)(ws + WS_WMOE_D), DFE / 2, DFE / 2, DFE / 2, 0, (size_t)1024 * 3584}; const int NPM = NP < 2 * G / 4 ? NP : 2 * G / 4;
      MoeOrder S; S.S.nM = NPM; S.S.nN = 4; S.S.nZ = 1; S.S.nwg = NPM * 4; S.S.G = G; S.S.c = bx; S.lo = 0; S.cap_rows = false;
#pragma unroll
      for (int e = 0; e <= NEXP; ++e) S.pref[e] = pref[e];
      pg8::EpiStoreBf16 E{YS, D};
      pg8::gemm_phase<pg8::EpiStoreBf16, MoeOrder, true, true, true>(lds + RING_OFF, g, S, E);
      if (NP > NPM) { MoeQuadOrder Q; Q.p0 = NPM; Q.np = NP - NPM; Q.G = G; Q.c = bx;
#pragma unroll
          for (int e = 0; e <= NEXP; ++e) Q.pref[e] = pref[e];
          pg8::EpiStoreQuad EQ{YS, D};
          pg8::gemm_phase<pg8::EpiStoreQuad, MoeQuadOrder, true, true, true, true>(lds + RING_OFF, g, Q, EQ); } }
    GRID_BAR();
    {
        const float* gf = args.in[27];
        for (int tok = gw; tok < M; tok += NGW) {
            const unsigned ee = ((const unsigned*)(meta + MT_TOKE))[tok]; int pe0 = 0, pe1 = 0;
#pragma unroll
            for (int q = 0; q < NEXP; ++q) { pe0 = (q == (int)(ee & 0xffu)) ? pref[q] : pe0; pe1 = (q == (int)((ee >> 8) & 0xffu)) ? pref[q] : pe1; }
            const unsigned s0 = (unsigned)pe0 * 256u + ((const unsigned*)(meta + MT_TOKP))[2 * tok], s1 = (unsigned)pe1 * 256u + ((const unsigned*)(meta + MT_TOKP))[2 * tok + 1];
            const float g0 = ((const float*)(meta + MT_TOKG))[2 * tok], g1 = ((const float*)(meta + MT_TOKG))[2 * tok + 1];
            GAS f32x4* xr = (GAS f32x4*)(X + (size_t)tok * D) + lane; f32x4 v[4]; float s = 0.f;
#pragma unroll
            for (int j = 0; j < 4; ++j) { v[j] = xr[64 * j]; const int k0 = 4 * lane + 256 * j;
                const v2u a = *(const v2u*)(YS + (size_t)s0 * D + k0), b2 = *(const v2u*)(YS + (size_t)s1 * D + k0);
                v[j].x += g0 * bflo(a.x) + g1 * bflo(b2.x); v[j].y += g0 * bfhi(a.x) + g1 * bfhi(b2.x); v[j].z += g0 * bflo(a.y) + g1 * bflo(b2.y); v[j].w += g0 * bfhi(a.y) + g1 * bfhi(b2.y);
                s += (v[j].x * v[j].x + v[j].y * v[j].y) + (v[j].z * v[j].z + v[j].w * v[j].w); }
            s = wave_sum(s); const float rs = 1.0f / sqrtf(s * (1.0f / 1024.0f) + pg8::RMS_EPS);
#pragma unroll
            for (int j = 0; j < 4; ++j) { const f32x4 gv = *(const f32x4*)(gf + 4 * lane + 256 * j); xr[64 * j] = v[j] * rs * gv; }
        }
    }
}

extern "C" void kernel_launch(void* const* d_in, const int* in_sizes, int n_in, void* d_out, int out_size, void* d_ws, size_t ws_size, hipStream_t stream) {
    static int grid = 0;
    if (grid == 0) {
        if (n_in != 28 || in_sizes[0] != M * D || out_size != M * D || ws_size < WS_END) { fprintf(stderr, "kernel_launch: unexpected problem: n_in %d in0 %d out %d ws %zu (need %zu)\n", n_in, n_in > 0 ? in_sizes[0] : -1, out_size, ws_size, (size_t)WS_END); grid = -1; return; }
        int dev = 0, cus = 0, per_cu = 0;
        if (hipGetDevice(&dev) != hipSuccess || hipDeviceGetAttribute(&cus, hipDeviceAttributeMultiprocessorCount, dev) != hipSuccess) { grid = -1; return; }
        if (hipFuncSetAttribute((const void*)mk_fwd, hipFuncAttributeMaxDynamicSharedMemorySize, LDS_BYTES) != hipSuccess) { fprintf(stderr, "kernel_launch: hipFuncSetAttribute failed\n"); grid = -1; return; }
        if (hipOccupancyMaxActiveBlocksPerMultiprocessor(&per_cu, (const void*)mk_fwd, NTHREADS, LDS_BYTES) != hipSuccess || per_cu < 1) fprintf(stderr, "kernel_launch: occupancy query says %d\n", per_cu);
        (void)hipGetLastError();
        grid = cus;
        if (grid != 256) fprintf(stderr, "kernel_launch: built for the 256-CU MI355X; device reports %d CUs\n", cus);
    }
    if (grid < 0) return;
    if (hipMemsetAsync((char*)d_ws + WS_CTL, 0, CTL_ZERO_BYTES, stream) != hipSuccess) return;
    Args a{};
    for (int i = 0; i < 28; ++i) a.in[i] = (const float*)d_in[i];
    a.out = (float*)d_out; a.ws = (unsigned char*)d_ws;
    hipLaunchKernelGGL(mk_fwd, dim3(grid), dim3(NTHREADS), LDS_BYTES, stream, a);
}
```

```cpp
#include <hip/hip_runtime.h>
#include <cstdio>
#include <cstdint>

namespace pg8 {
#define PG8_LAS __attribute__((address_space(3)))
typedef unsigned short bf16_t;
typedef short bf16x8 __attribute__((ext_vector_type(8)));
typedef float f32x4 __attribute__((ext_vector_type(4)));
typedef unsigned u32x4 __attribute__((ext_vector_type(4)));
typedef unsigned u32x2 __attribute__((ext_vector_type(2)));
constexpr int BM = 256, BK = 64, HALF = 128, HTB = HALF * BK * 2  , STAGE_BYTES = 8 * HTB, NXCD = 8, WGM = 8;

__host__ __device__ __forceinline__ int lds_byte(int r, int c) { const int st = (r >> 4) * 2 + (c >> 5), rr = r & 15, cc = c & 31, ob = rr * 64 + cc * 2; return st * 1024 + (ob ^ (((ob >> 9) & 1) << 5)); }
__host__ __device__ __forceinline__ void stage_rc(int b, int& R, int& C) { const int st = b / 1024, sb = b % 1024, swz = sb ^ (((sb >> 9) & 1) << 5); R = (st >> 1) * 16 + swz / 64; C = (st & 1) * 32 + (swz % 64) / 2; }
__host__ __device__ __forceinline__ int perm32(int rho) { const int n = rho >> 4, i = rho & 15; return 8 * (i >> 2) + 4 * n + (i & 3); }

struct Unit { int pm, pn, zb, pa, qa, qb; };
struct Gemm { const bf16_t* A; const bf16_t* Bt; int lda, ldb, K; size_t zA, zB; };

struct StaticOrder {
    int nM, nN, nZ, nwg, G, c;
    __host__ __device__ void init(int M, int N, int Z, int G_, int c_) { nM = M / BM; nN = N / BM; nZ = Z; nwg = nM * nN * nZ; G = G_; c = c_; }
    __host__ __device__ bool next(int i, Unit& u) const {
        const long L = (long)i * G + c; if (L >= nwg) return false;
        int wgid = (int)L; { const int q = nwg / NXCD, r = nwg % NXCD, xcd = wgid % NXCD, off = wgid / NXCD; wgid = (xcd < r ? xcd * (q + 1) : r * (q + 1) + (xcd - r) * q) + off; }
        const int per = nM * nN; u.zb = wgid / per; wgid -= u.zb * per;
        const int nig = WGM * nN, gid = wgid / nig, fm = gid * WGM, gsz = (nM - fm) < WGM ? (nM - fm) : WGM;
        u.pm = fm + ((wgid % nig) % gsz); u.pn = (wgid % nig) / gsz; u.pa = u.pm; u.qa = 0; u.qb = 0; return true;
    }
    __device__ __forceinline__ void a_ready(const Unit&) const {}
    __device__ __forceinline__ void done(const Unit&) const {}
};

__device__ __forceinline__ unsigned cvt_pk_bf16(float lo, float hi) { unsigned r; asm volatile("v_cvt_pk_bf16_f32 %0, %1, %2" : "=v"(r) : "v"(lo), "v"(hi)); return r; }
typedef int v4i_t __attribute__((ext_vector_type(4))); typedef int v8i_t __attribute__((ext_vector_type(8)));
__device__ __forceinline__ v8i_t cat8(bf16x8 a, bf16x8 b) { return __builtin_shufflevector(__builtin_bit_cast(v4i_t, a), __builtin_bit_cast(v4i_t, b), 0, 1, 2, 3, 4, 5, 6, 7); }
__device__ __forceinline__ unsigned pk_fp8x4(float a, float b, float c, float d) { int r = 0; r = __builtin_amdgcn_cvt_pk_fp8_f32(a, b, r, false); r = __builtin_amdgcn_cvt_pk_fp8_f32(c, d, r, true); return (unsigned)r; }
__device__ __forceinline__ float bf_lo(unsigned w) { return __uint_as_float(w << 16); }
__device__ __forceinline__ float bf_hi(unsigned w) { return __uint_as_float(w & 0xffff0000u); }
__device__ __forceinline__ float fast_sigmoid(float z) { return __builtin_amdgcn_rcpf(1.0f + __builtin_amdgcn_exp2f(-1.4426950408889634f * z)); }
__device__ __forceinline__ f32x4 swiglu4(const f32x4 g, const f32x4 u, const float c1, const float rs2) {
    const f32x4 t = g * c1; f32x4 e;
#pragma unroll
    for (int i = 0; i < 4; ++i) e[i] = __builtin_amdgcn_exp2f(t[i]);
    const f32x4 d = e + 1.0f; f32x4 r;
#pragma unroll
    for (int i = 0; i < 4; ++i) r[i] = __builtin_amdgcn_rcpf(d[i]);
    return (g * u) * (r * rs2);
}
constexpr float RMS_EPS = 1e-6f;
__device__ __forceinline__ float rstd16(const float* ssp, int row) { const f32x4* p = (const f32x4*)(ssp + (size_t)row * 16); const f32x4 a = p[0], b = p[1], c = p[2], d = p[3];
    const float s = (((a[0] + a[1]) + (a[2] + a[3])) + ((b[0] + b[1]) + (b[2] + b[3]))) + (((c[0] + c[1]) + (c[2] + c[3])) + ((d[0] + d[1]) + (d[2] + d[3])));
    return __builtin_amdgcn_rsqf(s * (1.0f / 1024.0f) + RMS_EPS); }

__device__ __forceinline__ void rstd8(const float* ssp, int row0, int fq, float (&rs)[8]) {
    f32x4 p[8];
#pragma unroll
    for (int i = 0; i < 8; ++i) p[i] = *(const f32x4*)(ssp + (size_t)(row0 + (i >> 2) * HALF + (i & 3) * 16) * 16 + 4 * fq);
#pragma unroll
    for (int i = 0; i < 8; ++i) { float q = (p[i][0] + p[i][1]) + (p[i][2] + p[i][3]); q += __shfl_xor(q, 16); q += __shfl_xor(q, 32); rs[i] = __builtin_amdgcn_rsqf(q * (1.0f / 1024.0f) + RMS_EPS); }
}
__device__ __forceinline__ u32x4 pack8(const f32x4 v0, const f32x4 v1) { u32x4 w; w.x = cvt_pk_bf16(v0[0], v0[1]); w.y = cvt_pk_bf16(v0[2], v0[3]); w.z = cvt_pk_bf16(v1[0], v1[1]); w.w = cvt_pk_bf16(v1[2], v1[3]); return w; }

struct EpiInProj0 {
    static constexpr bool PERM = true, AFTER_DRAIN = false;
    const float* ss; bf16_t* uext; bf16_t* qkv; float qscale;
    __device__ __forceinline__ void operator()(const f32x4 (&acc)[2][2][4][2], const Unit& u, int wr, int wc, int fr, int fq) const {
        const int row0 = u.pm * BM + wr * 64 + fr; float rsa[8]; rstd8(ss, row0, fq, rsa);
#pragma unroll
        for (int ai = 0; ai < 2; ++ai)
#pragma unroll
            for (int m = 0; m < 4; ++m) { const int row = row0 + ai * HALF + m * 16; const float rs = rsa[ai * 4 + m];
#pragma unroll
                for (int bj = 0; bj < 2; ++bj) { const int col0 = u.pn * BM + bj * HALF + wc * 32 + 8 * fq;
                    float sc = rs; bf16_t* dst;
                    if (u.pn < 2) dst = uext + ((size_t)(col0 >> 4) * 512 + (row >> 5)) * 640 + (row & 31) * 16 + (col0 & 15);
                    else { const int c = col0 - 512; if (c < 512) sc *= qscale; dst = qkv + (size_t)row * 1536 + c; }
                    *(u32x4*)dst = pack8(acc[ai][bj][m][0] * sc, acc[ai][bj][m][1] * sc); } }
    }
};
struct EpiS5State {
    static constexpr bool PERM = false, AFTER_DRAIN = false;
    float* sloc;
    __device__ __forceinline__ void operator()(const f32x4 (&acc)[2][2][4][2], const Unit& u, int wr, int wc, int fr, int fq) const {
        const int row0 = u.pm * BM + wr * 64 + fr, col0 = wc * 32 + 4 * fq;
#pragma unroll
        for (int ai = 0; ai < 2; ++ai)
#pragma unroll
            for (int m = 0; m < 4; ++m) { float* rowp = sloc + ((size_t)u.zb * 512 + row0 + ai * HALF + m * 16) * 128 + col0;
#pragma unroll
                for (int n = 0; n < 2; ++n) *(f32x4*)(rowp + n * 16) = acc[ai][0][m][n]; }
    }
};
__device__ __forceinline__ float gelu_tanh(float x) { const float a = x * (1.0f + 0.044715f * x * x); return x * __builtin_amdgcn_rcpf(1.0f + __builtin_amdgcn_exp2f(-2.302208198f * a)); }
struct EpiS5Y {
    static constexpr bool PERM = true, AFTER_DRAIN = false;
    bf16_t* yg;
    __device__ __forceinline__ void operator()(const f32x4 (&acc)[2][2][4][2], const Unit& u, int wr, int wc, int fr, int fq) const {
        const int row0 = u.pm * BM + wr * 64 + fr;
#pragma unroll
        for (int ai = 0; ai < 2; ++ai)
#pragma unroll
            for (int m = 0; m < 4; ++m) { const int chunk = row0 + ai * HALF + m * 16;
#pragma unroll
                for (int bj = 0; bj < 2; ++bj) { const int col0 = u.pn * BM + bj * HALF + wc * 32 + 8 * fq; const int i = col0 >> 4, h0 = col0 & 15;
                    f32x4 v0 = acc[ai][bj][m][0], v1 = acc[ai][bj][m][1];
#pragma unroll
                    for (int e = 0; e < 4; ++e) { v0[e] = gelu_tanh(v0[e]); v1[e] = gelu_tanh(v1[e]); }
                    *(u32x4*)(yg + ((size_t)chunk * 32 + i) * 512 + u.zb * 16 + h0) = pack8(v0, v1); } }
    }
};
struct EpiGlu {
    static constexpr bool PERM = true, AFTER_DRAIN = false;
    const bf16_t* yg; const float* bias; bf16_t* mix;
    __device__ __forceinline__ void operator()(const f32x4 (&acc)[2][2][4][2], const Unit& u, int wr, int wc, int fr, int fq) const {
        const int row0 = u.pm * BM + wr * 64 + fr; u32x4 ywa[2][8];
#pragma unroll
        for (int bj = 0; bj < 2; ++bj)
#pragma unroll
            for (int i = 0; i < 8; ++i) ywa[bj][i] = *(const u32x4*)(yg + (size_t)(row0 + (i >> 2) * HALF + (i & 3) * 16) * 512 + u.pn * BM + bj * HALF + wc * 32 + 8 * fq);
#pragma unroll
        for (int bj = 0; bj < 2; ++bj) { const int col0 = u.pn * BM + bj * HALF + wc * 32 + 8 * fq;
            const f32x4 b0 = *(const f32x4*)(bias + col0), b1 = *(const f32x4*)(bias + col0 + 4);
#pragma unroll
            for (int ai = 0; ai < 2; ++ai)
#pragma unroll
                for (int m = 0; m < 4; ++m) { const int row = row0 + ai * HALF + m * 16;
                    const u32x4 yw = ywa[bj][ai * 4 + m];
                    f32x4 z0 = acc[ai][bj][m][0] + b0, z1 = acc[ai][bj][m][1] + b1, o0, o1;
                    o0[0] = bf_lo(yw.x) * fast_sigmoid(z0[0]); o0[1] = bf_hi(yw.x) * fast_sigmoid(z0[1]); o0[2] = bf_lo(yw.y) * fast_sigmoid(z0[2]); o0[3] = bf_hi(yw.y) * fast_sigmoid(z0[3]);
                    o1[0] = bf_lo(yw.z) * fast_sigmoid(z1[0]); o1[1] = bf_hi(yw.z) * fast_sigmoid(z1[1]); o1[2] = bf_lo(yw.w) * fast_sigmoid(z1[2]); o1[3] = bf_hi(yw.w) * fast_sigmoid(z1[3]);
                    *(u32x4*)(mix + (size_t)row * 1024 + col0) = pack8(o0, o1); } }
    }
};
template <bool XBOUT> struct EpiResid {
    static constexpr bool PERM = false, AFTER_DRAIN = false;
    const float* R; float* X; bf16_t* xb; float* ssq; unsigned char* xq = nullptr;
    __device__ __forceinline__ void operator()(const f32x4 (&acc)[2][2][4][2], const Unit& u, int wr, int wc, int fr, int fq) const {
        const int row0 = u.pm * BM + wr * 64 + fr, col0 = u.pn * BM + wc * 32 + 4 * fq;
#pragma unroll
        for (int ai = 0; ai < 2; ++ai) {
            f32x4 rv[4][2][2];
#pragma unroll
            for (int m = 0; m < 4; ++m)
#pragma unroll
                for (int bj = 0; bj < 2; ++bj)
#pragma unroll
                    for (int n = 0; n < 2; ++n) rv[m][bj][n] = *(const f32x4*)(R + (size_t)(row0 + ai * HALF + m * 16) * 1024 + col0 + bj * HALF + n * 16);
            asm volatile("" ::: "memory");
#pragma unroll
            for (int m = 0; m < 4; ++m) { const int row = row0 + ai * HALF + m * 16; const size_t off = (size_t)row * 1024 + col0; float s = 0.f;
#pragma unroll
                for (int bj = 0; bj < 2; ++bj)
#pragma unroll
                    for (int n = 0; n < 2; ++n) { const f32x4 x = rv[m][bj][n] + acc[ai][bj][m][n];
                        *(f32x4*)(X + off + bj * HALF + n * 16) = x; s += (x[0] * x[0] + x[1] * x[1]) + (x[2] * x[2] + x[3] * x[3]);
                        if (XBOUT) { u32x2 w; w.x = cvt_pk_bf16(x[0], x[1]); w.y = cvt_pk_bf16(x[2], x[3]); *(u32x2*)(xb + off + bj * HALF + n * 16) = w;
                            if (xq) *(unsigned*)(xq + off + bj * HALF + n * 16) = pk_fp8x4(x[0], x[1], x[2], x[3]); } }
                s += __shfl_xor(s, 16); s += __shfl_xor(s, 32);
                if (XBOUT && fq == 0) ssq[(size_t)row * 16 + u.pn * 4 + wc] = s; }
            asm volatile("" ::: "memory"); }
    }
};
template <bool RS_IS_SSQ> struct EpiSwiGlu {
    static constexpr bool PERM = true, AFTER_DRAIN = false;
    const float* rsv; bf16_t* H; int ldh;
    __device__ __forceinline__ void operator()(const f32x4 (&acc)[2][2][4][2], const Unit& u, int wr, int wc, int fr, int fq) const {
        const int row0 = u.pm * BM + wr * 64 + fr, col0 = u.pn * HALF + wc * 32 + 8 * fq; float rsa[8];
        if (RS_IS_SSQ) rstd8(rsv, row0, fq, rsa);
        else {
#pragma unroll
            for (int i = 0; i < 8; ++i) rsa[i] = rsv[row0 + (i >> 2) * HALF + (i & 3) * 16]; }
#pragma unroll
        for (int ai = 0; ai < 2; ++ai)
#pragma unroll
            for (int m = 0; m < 4; ++m) { const int row = row0 + ai * HALF + m * 16; const float rs = rsa[ai * 4 + m], c1 = -1.4426950408889634f * rs, rs2 = rs * rs;
                f32x4 o[2];
#pragma unroll
                for (int n = 0; n < 2; ++n) o[n] = swiglu4(acc[ai][0][m][n], acc[ai][1][m][n], c1, rs2);
                *(u32x4*)(H + (size_t)row * ldh + col0) = pack8(o[0], o[1]); }
    }
};
struct EpiSwiGluFp8 {
    static constexpr bool PERM = true, AFTER_DRAIN = false;
    const float* rsv; unsigned char* H; int ldh;
    __device__ __forceinline__ void operator()(const f32x4 (&acc)[2][2][4][2], const Unit& u, int wr, int wc, int fr, int fq) const {
        const int row0 = u.pm * BM + wr * 64 + fr, col0 = u.pn * HALF + wc * 32 + 8 * fq; float rsa[8];
#pragma unroll
        for (int i = 0; i < 8; ++i) rsa[i] = rsv[u.pa * BM + wr * 64 + fr + (i >> 2) * HALF + (i & 3) * 16];
#pragma unroll
        for (int ai = 0; ai < 2; ++ai)
#pragma unroll
            for (int m = 0; m < 4; ++m) { const int row = row0 + ai * HALF + m * 16; const float rs = rsa[ai * 4 + m], c1 = -1.4426950408889634f * rs, rs2 = rs * rs;
                f32x4 o[2];
#pragma unroll
                for (int n = 0; n < 2; ++n) o[n] = swiglu4(acc[ai][0][m][n], acc[ai][1][m][n], c1, rs2);
                u32x2 w; w.x = pk_fp8x4(o[0][0], o[0][1], o[0][2], o[0][3]); w.y = pk_fp8x4(o[1][0], o[1][1], o[1][2], o[1][3]);
                *(u32x2*)(H + (size_t)row * ldh + col0) = w; }
    }
};
struct EpiInProj1 {
    static constexpr bool PERM = true, AFTER_DRAIN = false;
    const float* ss; bf16_t* qkv; float qscale;
    unsigned* kn;
    __device__ __forceinline__ void operator()(const f32x4 (&acc)[2][2][4][2], const Unit& u, int wr, int wc, int fr, int fq) const {
        const int row0 = u.pm * BM + wr * 64 + fr; const float qs = (u.pn < 4) ? qscale : 1.0f; float rsa[8]; rstd8(ss, row0, fq, rsa);
#pragma unroll
        for (int ai = 0; ai < 2; ++ai)
#pragma unroll
            for (int m = 0; m < 4; ++m) { const int row = row0 + ai * HALF + m * 16; const float sc = rsa[ai * 4 + m] * qs;
#pragma unroll
                for (int bj = 0; bj < 2; ++bj) { const int col0 = (u.pn & 3) * BM + bj * HALF + wc * 32 + 8 * fq;
                    const f32x4 v0 = acc[ai][bj][m][0] * sc, v1 = acc[ai][bj][m][1] * sc;
                    *(u32x4*)(qkv + (size_t)(u.pn >> 2) * (16384 * 1024) + (size_t)row * 1024 + col0) = pack8(v0, v1);
                    if ((u.pn >> 2) == 1) {
                        float q = ((v0[0] * v0[0] + v0[1] * v0[1]) + (v0[2] * v0[2] + v0[3] * v0[3])) + ((v1[0] * v1[0] + v1[1] * v1[1]) + (v1[2] * v1[2] + v1[3] * v1[3]));
                        q += __shfl_xor(q, 16); q += __shfl_xor(q, 32);
                        q = fmaxf(q, __shfl_xor(q, 1)); q = fmaxf(q, __shfl_xor(q, 2)); q = fmaxf(q, __shfl_xor(q, 4)); q = fmaxf(q, __shfl_xor(q, 8));
                        if (fr == 0 && fq == 0) { const int head = (u.pn & 3) * 4 + bj * 2 + (wc >> 1), bb = row >> 13, tile = (row & 8191) >> 6;
                            atomicMax(kn + ((size_t)(bb * 16 + head) * 128 + tile) * 2 + (wc & 1), __float_as_uint(q * 1.01f)); } } } }
    }
};
struct EpiStoreBf16 {
    static constexpr bool PERM = true, AFTER_DRAIN = false;
    bf16_t* O; int ldc;
    __device__ __forceinline__ void operator()(const f32x4 (&acc)[2][2][4][2], const Unit& u, int wr, int wc, int fr, int fq) const {
        const int row0 = u.pm * BM + wr * 64 + fr;
#pragma unroll
        for (int ai = 0; ai < 2; ++ai)
#pragma unroll
            for (int m = 0; m < 4; ++m) { const int row = row0 + ai * HALF + m * 16;
#pragma unroll
                for (int bj = 0; bj < 2; ++bj) { const int col0 = u.pn * BM + bj * HALF + wc * 32 + 8 * fq;
                    *(u32x4*)(O + (size_t)row * ldc + col0) = pack8(acc[ai][bj][m][0], acc[ai][bj][m][1]); } }
    }
};

struct EpiStoreQuad {
    static constexpr bool PERM = true, AFTER_DRAIN = false;
    bf16_t* O; int ldc;
    __device__ __forceinline__ void operator()(const f32x4 (&acc)[2][2][4][2], const Unit& u, int wr, int wc, int fr, int fq) const {
        const int row0 = u.pm * BM + u.qa * HALF + wr * 64 + fr, col0 = u.pn * BM + u.qb * HALF + wc * 32 + 8 * fq;
#pragma unroll
        for (int m = 0; m < 4; ++m) *(u32x4*)(O + (size_t)(row0 + m * 16) * ldc + col0) = pack8(acc[0][0][m][0], acc[0][0][m][1]);
    }
};

typedef float f32x2z __attribute__((ext_vector_type(2)));
__device__ __forceinline__ f32x4 zero4_b64() { f32x2z a, b; asm volatile("v_mov_b64 %0, 0" : "=v"(a)); asm volatile("v_mov_b64 %0, 0" : "=v"(b)); return (f32x4){a[0], a[1], b[0], b[1]}; }
template <bool F8> struct Frag { bf16x8 k[2]; };
template <> struct Frag<true> { v8i_t v; };
template <class Epi, class Sched, bool ALIGN_EPI = false, bool SP2 = false, bool FP8 = false, bool QUAD = false>
__device__ __forceinline__ void gemm_phase(PG8_LAS unsigned char* lds, const Gemm g, const Sched& S, const Epi& E) {
    int tid_ = threadIdx.x; asm volatile("" : "+v"(tid_));
    const int tid = tid_, wid = __builtin_amdgcn_readfirstlane(tid >> 6), lane = tid & 63, wr = wid >> 2, wc = wid & 3, fr = lane & 15, fq = lane >> 4;
    const int K = g.K, nt = K / BK;
    unsigned voffA[2], voffB[2];
#pragma unroll
    for (int i = 0; i < 2; ++i) { int R, C; stage_rc(tid * 16 + i * 8192, R, C); const int Rb = Epi::PERM ? ((R & ~31) + perm32(R & 31)) : R;
        voffA[i] = (unsigned)(R * g.lda + C) * 2u; voffB[i] = (unsigned)(Rb * g.ldb + C) * 2u; }
    const size_t kstep = (size_t)(BK * 2);
    const size_t hstepA = (size_t)HALF * g.lda * 2, hstepB = (size_t)HALF * g.ldb * 2;
    const size_t tstepA = 2 * hstepA, tstepB = 2 * hstepB;
    const unsigned ldsw = (unsigned)wid * 1024u;
    const int aoff = lds_byte(wr * 64 + fr, fq * 8), boff = lds_byte(wc * 32 + fr, fq * 8);
#define PG8_SA(b, h) (((b) * 2 + (h)) * HTB)
#define PG8_SB(b, h) ((4 + (b) * 2 + (h)) * HTB)
#define PG8_STAGE(bufoff, gbase, voff) do { _Pragma("unroll") for (int _i = 0; _i < 2; ++_i) \
        __builtin_amdgcn_global_load_lds((const unsigned*)((const char*)(gbase) + (voff)[_i]), (PG8_LAS unsigned*)(lds + (bufoff) + ldsw + _i * 8192), 16, 0, 0); } while (0)
    const PG8_LAS unsigned char* ldsA_ = lds + aoff; const PG8_LAS unsigned char* ldsB_ = lds + 4 * HTB + boff; asm volatile("" : "+v"(ldsA_), "+v"(ldsB_));
#define PG8_RDA(off) (*(const PG8_LAS bf16x8*)(ldsA_ + (off)))
#define PG8_RDB(off) (*(const PG8_LAS bf16x8*)(ldsB_ + (off)))
#define PG8_LDA(dst, b, h) do { _Pragma("unroll") for (int m = 0; m < 4; ++m) { if constexpr (FP8) dst[m].v = cat8(PG8_RDA(PG8_SA(b, h) + m * 2048), PG8_RDA(PG8_SA(b, h) + m * 2048 + 1024)); \
        else { dst[m].k[0] = PG8_RDA(PG8_SA(b, h) + m * 2048); dst[m].k[1] = PG8_RDA(PG8_SA(b, h) + m * 2048 + 1024); } } } while (0)
#define PG8_LDB(dst, b, h) do { _Pragma("unroll") for (int n = 0; n < 2; ++n) { if constexpr (FP8) dst[n].v = cat8(PG8_RDB(PG8_SB(b, h) - 4 * HTB + n * 2048), PG8_RDB(PG8_SB(b, h) - 4 * HTB + n * 2048 + 1024)); \
        else { dst[n].k[0] = PG8_RDB(PG8_SB(b, h) - 4 * HTB + n * 2048); dst[n].k[1] = PG8_RDB(PG8_SB(b, h) - 4 * HTB + n * 2048 + 1024); } } } while (0)
#define PG8_MMA(ai, bj, At, Bt) do { if constexpr (!(QUAD && (((ai) | (bj)) != 0))) { __builtin_amdgcn_s_setprio(1); _Pragma("unroll") for (int m = 0; m < 4; ++m) _Pragma("unroll") for (int n = 0; n < 2; ++n) { \
        if constexpr (FP8) { asm volatile("v_mfma_scale_f32_16x16x128_f8f6f4 %0, %1, %2, %0, %3, %4 op_sel_hi:[0,0,0]" : "+v"(acc[ai][bj][m][n]) : "v"(Bt[n].v), "v"(At[m].v), "v"(sclB_), "v"(sclA_)); } \
        else { _Pragma("unroll") for (int k = 0; k < 2; ++k) acc[ai][bj][m][n] = __builtin_amdgcn_mfma_f32_16x16x32_bf16(Bt[n].k[k], At[m].k[k], acc[ai][bj][m][n], 0, 0, 0); } } __builtin_amdgcn_s_setprio(0); } } while (0)
#define PG8_WAIT_V(n) asm volatile("s_waitcnt vmcnt(" #n ")" ::: "memory")
#define PG8_WAIT_L(n) asm volatile("s_waitcnt lgkmcnt(" #n ")" ::: "memory")
#define PG8_BAR __builtin_amdgcn_s_barrier()
#define PG8_SCHED __builtin_amdgcn_sched_barrier(0)
    Unit cur, nxt; int ui = 0;
    if (!S.next(0, cur)) return;
    f32x4 acc[2][2][4][2];
#pragma unroll
    for (int a = 0; a < 2; ++a)
#pragma unroll
        for (int b = 0; b < 2; ++b)
#pragma unroll
            for (int m = 0; m < 4; ++m)
#pragma unroll
                for (int n = 0; n < 2; ++n) acc[a][b][m][n] = zero4_b64();
    Frag<FP8> At[4], B0[2], B1[2];
    int sclB_ = 0x79797979, sclA_ = 0x7f7f7f7f; asm volatile("" : "+v"(sclB_), "+v"(sclA_));
    const char* cA = (const char*)g.A + (size_t)cur.zb * g.zA + (size_t)cur.pa * tstepA + (QUAD ? (size_t)cur.qa * hstepA : 0); const char* cB = (const char*)g.Bt + (size_t)cur.zb * g.zB + (size_t)cur.pn * tstepB + (QUAD ? (size_t)cur.qb * hstepB : 0);
    S.a_ready(cur);
    if constexpr (SP2) {
        PG8_STAGE(PG8_SB(0, 0), cB, voffB); PG8_STAGE(PG8_SB(0, 1), cB + hstepB, voffB); PG8_STAGE(PG8_SA(0, 0), cA, voffA); PG8_STAGE(PG8_SA(0, 1), cA + hstepA, voffA);
        if (wr == 1) PG8_BAR;
        PG8_WAIT_V(2); PG8_BAR;
        PG8_STAGE(PG8_SB(1, 0), cB + kstep, voffB); PG8_STAGE(PG8_SA(1, 0), cA + kstep, voffA); PG8_STAGE(PG8_SB(1, 1), cB + hstepB + kstep, voffB);
        PG8_WAIT_V(6); PG8_BAR;
    } else {
        PG8_STAGE(PG8_SB(0, 0), cB, voffB); PG8_STAGE(PG8_SA(0, 0), cA, voffA); PG8_STAGE(PG8_SB(0, 1), cB + hstepB, voffB); PG8_STAGE(PG8_SA(0, 1), cA + hstepA, voffA);
        if (wr == 1) PG8_BAR;
        PG8_WAIT_V(4); PG8_BAR;
        PG8_STAGE(PG8_SB(1, 0), cB + kstep, voffB); PG8_STAGE(PG8_SA(1, 0), cA + kstep, voffA); PG8_STAGE(PG8_SB(1, 1), cB + hstepB + kstep, voffB);
        PG8_WAIT_V(6); PG8_BAR;
    }
    for (;;) {
        const bool has_next = S.next(ui + 1, nxt);
        const char* nA = has_next ? (const char*)g.A + (size_t)nxt.zb * g.zA + (size_t)nxt.pa * tstepA + (QUAD ? (size_t)nxt.qa * hstepA : 0) : cA; const char* nB = has_next ? (const char*)g.Bt + (size_t)nxt.zb * g.zB + (size_t)nxt.pn * tstepB + (QUAD ? (size_t)nxt.qb * hstepB : 0) : cB;
#pragma unroll 1
        for (int t = 0; t < nt; t += 2) {
            const bool last = (t == nt - 2);
            const char* a1 = cA + (size_t)(t + 1) * kstep;
            const char* a2 = last ? nA : cA + (size_t)(t + 2) * kstep; const char* b2 = last ? nB : cB + (size_t)(t + 2) * kstep;
            const char* a3 = a2 + kstep; const char* b3 = b2 + kstep;
            if (last && has_next) S.a_ready(nxt);
            if constexpr (SP2) {
            PG8_LDB(B0, 0, 0); PG8_LDB(B1, 0, 1); PG8_SCHED; PG8_LDA(At, 0, 0); PG8_STAGE(PG8_SA(1, 1), a1 + hstepA, voffA);
            PG8_WAIT_V(8); PG8_WAIT_L(0); PG8_BAR; PG8_MMA(0, 0, At, B0); PG8_MMA(0, 1, At, B1); PG8_BAR; PG8_SCHED;
            PG8_LDA(At, 0, 1); PG8_STAGE(PG8_SB(0, 0), b2, voffB); PG8_STAGE(PG8_SB(0, 1), b2 + hstepB, voffB); PG8_STAGE(PG8_SA(0, 0), a2, voffA);
            PG8_WAIT_V(8); PG8_WAIT_L(0); PG8_BAR; PG8_MMA(1, 0, At, B0); PG8_MMA(1, 1, At, B1); PG8_BAR; PG8_SCHED;
            PG8_LDB(B0, 1, 0); PG8_LDB(B1, 1, 1); PG8_SCHED; PG8_LDA(At, 1, 0); PG8_STAGE(PG8_SA(0, 1), a2 + hstepA, voffA);
            PG8_WAIT_V(8); PG8_WAIT_L(0); PG8_BAR; PG8_MMA(0, 0, At, B0); PG8_MMA(0, 1, At, B1); PG8_BAR; PG8_SCHED;
            PG8_LDA(At, 1, 1); PG8_STAGE(PG8_SB(1, 0), b3, voffB); PG8_STAGE(PG8_SB(1, 1), b3 + hstepB, voffB); PG8_STAGE(PG8_SA(1, 0), a3, voffA);
            PG8_WAIT_V(8); PG8_WAIT_L(0); PG8_BAR; PG8_MMA(1, 0, At, B0); PG8_MMA(1, 1, At, B1); PG8_BAR; PG8_SCHED;
            } else {
            PG8_LDB(B0, 0, 0); PG8_SCHED; PG8_LDA(At, 0, 0); PG8_STAGE(PG8_SA(1, 1), a1 + hstepA, voffA);
            PG8_WAIT_L(8); PG8_BAR; PG8_WAIT_L(0); PG8_MMA(0, 0, At, B0); PG8_BAR; PG8_SCHED;
            PG8_LDB(B1, 0, 1); PG8_STAGE(PG8_SB(0, 0), b2, voffB);
            PG8_BAR; PG8_WAIT_L(0); PG8_MMA(0, 1, At, B1); PG8_BAR;
            PG8_LDA(At, 0, 1); PG8_STAGE(PG8_SA(0, 0), a2, voffA);
            PG8_BAR; PG8_WAIT_L(0); PG8_MMA(1, 0, At, B0); PG8_BAR; PG8_SCHED;
            PG8_STAGE(PG8_SB(0, 1), b2 + hstepB, voffB);
            PG8_WAIT_V(6); PG8_BAR; PG8_MMA(1, 1, At, B1); PG8_BAR;
            PG8_LDB(B0, 1, 0); PG8_SCHED; PG8_LDA(At, 1, 0); PG8_STAGE(PG8_SA(0, 1), a2 + hstepA, voffA);
            PG8_WAIT_L(8); PG8_BAR; PG8_WAIT_L(0); PG8_MMA(0, 0, At, B0); PG8_BAR; PG8_SCHED;
            PG8_LDB(B1, 1, 1); PG8_STAGE(PG8_SB(1, 0), b3, voffB);
            PG8_BAR; PG8_WAIT_L(0); PG8_MMA(0, 1, At, B1); PG8_BAR;
            PG8_LDA(At, 1, 1); PG8_STAGE(PG8_SA(1, 0), a3, voffA);
            PG8_BAR; PG8_WAIT_L(0); PG8_MMA(1, 0, At, B0); PG8_BAR; PG8_SCHED;
            PG8_STAGE(PG8_SB(1, 1), b3 + hstepB, voffB);
            PG8_WAIT_V(6); PG8_BAR; PG8_MMA(1, 1, At, B1); PG8_BAR;
            }
        }
        if constexpr (ALIGN_EPI) { if (wr == 0) PG8_BAR; }
        if constexpr (FP8) asm volatile("s_nop 15\n\ts_nop 15" ::: "memory");
        if constexpr (!Epi::AFTER_DRAIN) { int fr_ = fr, fq_ = fq; asm volatile("" : "+v"(fr_), "+v"(fq_));
            E(acc, cur, wr, wc, fr_, fq_); S.done(cur); }
        if (!has_next) break;
#pragma unroll
        for (int a = 0; a < 2; ++a)
#pragma unroll
            for (int b = 0; b < 2; ++b)
#pragma unroll
                for (int m = 0; m < 4; ++m)
#pragma unroll
                    for (int n = 0; n < 2; ++n) acc[a][b][m][n] = zero4_b64();
        cur = nxt; cA = nA; cB = nB; ++ui;
        if constexpr (ALIGN_EPI) { if (wr == 1) PG8_BAR; }
    }
    PG8_WAIT_V(0);
    if constexpr (!ALIGN_EPI) { if (wr == 0) PG8_BAR; }
    PG8_BAR;
    if constexpr (Epi::AFTER_DRAIN) { E.fused(acc, cur, wr, wc, fr, fq, lds, wid, lane); S.done(cur); }
#undef PG8_SA
#undef PG8_SB
#undef PG8_STAGE
#undef PG8_LDA
#undef PG8_RDA
#undef PG8_RDB
#undef PG8_LDB
#undef PG8_MMA
#undef PG8_WAIT_V
#undef PG8_WAIT_L
#undef PG8_BAR
#undef PG8_SCHED
}
}

#include <hip/hip_bf16.h>
#include <cmath>
namespace attn_body {
using bf16=__hip_bfloat16;
using bf16x8=__attribute__((ext_vector_type(8)))short;
using s16x4=__attribute__((ext_vector_type(4)))short;
using f32x16=__attribute__((ext_vector_type(16)))float;
using u32x4=__attribute__((ext_vector_type(4)))unsigned;
constexpr int BATCH=2,NHEAD=16,SEQ=8192,D=64,DM=NHEAD*D;
constexpr int NW=8,QBLK=32,QB=QBLK*NW,KVBLK=64,NQB=SEQ/QB;
constexpr int ATTN_PITCH=DM, ATTN_UNIT_ROWS=QB;
__device__ __forceinline__ int crow(int r,int hi){return (r&3)+8*(r>>2)+4*hi;}
#define SBAR() __builtin_amdgcn_sched_barrier(0)
__device__ __forceinline__ void cmask(f32x16&p0,f32x16&p1,int jb,int qrel,int hi){
  const float NEG=-INFINITY; int kb=64*jb+4*hi;
  #pragma unroll
  for(int r=0;r<16;++r){int kv=kb+(r&3)+8*(r>>2); if(kv>qrel)p0[r]=NEG; if(kv+32>qrel)p1[r]=NEG;}
}

constexpr int NSLOT=3, SLOTB=8192;
constexpr int LDS_K=0, LDS_V=NSLOT*SLOTB, LDS_WS=2*NSLOT*SLOTB, LDS_OST=LDS_WS+NW*64*4, LDS_NB=LDS_OST+NW*4096  , LDS_PK=LDS_NB+32768+64  , LDS_BYTES=LDS_PK+1024;
constexpr float C2=0.125f*1.4426950408889634f;
__device__ __forceinline__ void glds16(const void*gsrc,unsigned lds_dst){unsigned keep;
  asm volatile("s_mov_b32 %0, m0\n\ts_mov_b32 m0, %2\n\ts_nop 0\n\tglobal_load_lds_dwordx4 %1, off\n\ts_mov_b32 m0, %0":"=&s"(keep):"v"(gsrc),"s"(lds_dst):"memory");}
__device__ __forceinline__ float max3f(float a,float b,float c){float r;asm("v_max3_f32 %0, %1, %2, %3":"=v"(r):"v"(a),"v"(b),"v"(c));return r;}
__device__ __forceinline__ float max2f(float a,float b){float r;asm("v_max_f32_e32 %0, %1, %2":"=v"(r):"v"(a),"v"(b));return r;}
__device__ __forceinline__ float fadd_s(float a,float b){float r;asm("v_add_f32_e32 %0, %1, %2":"=v"(r):"v"(a),"v"(b));return r;}
__device__ __forceinline__ float fsub_s(float a,float b){float r;asm("v_sub_f32_e32 %0, %1, %2":"=v"(r):"v"(a),"v"(b));return r;}
typedef float f32x2_t __attribute__((ext_vector_type(2))); typedef __bf16 bf16x2_t __attribute__((ext_vector_type(2)));
__device__ __forceinline__ unsigned cvtpk_s(float lo,float hi){f32x2_t v={lo,hi};bf16x2_t b=__builtin_convertvector(v,bf16x2_t);return __builtin_bit_cast(unsigned,b);}
#define WAIT_BAR(N) asm volatile("s_waitcnt vmcnt(" #N ") lgkmcnt(0)\n\ts_barrier":::"memory")

__device__ __forceinline__ void qkt(f32x16&p0,f32x16&p1,const char*Kslot,const bf16x8*qr,const f32x16&negm,int r32,int hi){
  const char*kb=Kslot+hi*1024+r32*16;
  #pragma unroll
  for(int d0=0;d0<4;++d0){
    const bf16x8 b0=*reinterpret_cast<const bf16x8*>(kb+d0*2048);
    const bf16x8 b1=*reinterpret_cast<const bf16x8*>(kb+d0*2048+512);
    if(d0==0){p0=__builtin_amdgcn_mfma_f32_32x32x16_bf16(b0,qr[0],negm,0,0,0);p1=__builtin_amdgcn_mfma_f32_32x32x16_bf16(b1,qr[0],negm,0,0,0);}
    else{p0=__builtin_amdgcn_mfma_f32_32x32x16_bf16(b0,qr[d0],p0,0,0,0);p1=__builtin_amdgcn_mfma_f32_32x32x16_bf16(b1,qr[d0],p1,0,0,0);}}
}
typedef __attribute__((address_space(3))) const char* lds_cptr;
typedef short v4i16_t __attribute__((ext_vector_type(4)));
__device__ __forceinline__ void kload8(bf16x8*kf,lds_cptr kp){
  kf[0]=*(const __attribute__((address_space(3))) bf16x8*)(kp);      kf[1]=*(const __attribute__((address_space(3))) bf16x8*)(kp+512);
  kf[2]=*(const __attribute__((address_space(3))) bf16x8*)(kp+2048); kf[3]=*(const __attribute__((address_space(3))) bf16x8*)(kp+2560);
  kf[4]=*(const __attribute__((address_space(3))) bf16x8*)(kp+4096); kf[5]=*(const __attribute__((address_space(3))) bf16x8*)(kp+4608);
  kf[6]=*(const __attribute__((address_space(3))) bf16x8*)(kp+6144); kf[7]=*(const __attribute__((address_space(3))) bf16x8*)(kp+6656);
}
__device__ __forceinline__ void kload2(bf16x8*kf,lds_cptr kp,int j){ kf[2*j]=*(const __attribute__((address_space(3))) bf16x8*)(kp+j*2048); kf[2*j+1]=*(const __attribute__((address_space(3))) bf16x8*)(kp+j*2048+512); }
__device__ __forceinline__ s16x4 vtr(lds_cptr p){ return __builtin_bit_cast(s16x4,__builtin_amdgcn_ds_read_tr16_b64_v4i16((__attribute__((address_space(3))) v4i16_t*)p)); }
__device__ __forceinline__ float rowmax(const f32x16&p0,const f32x16&p1){
  float a=max3f(p0[0],p0[1],p1[0]),b=max3f(p0[2],p0[3],p1[1]);a=max3f(a,p1[2],p1[3]);
  #pragma unroll
  for(int r=4;r<16;r+=4){a=max3f(a,p0[r],p0[r+1]);b=max3f(b,p0[r+2],p0[r+3]);a=max3f(a,p1[r],p1[r+1]);b=max3f(b,p1[r+2],p1[r+3]);}
  const float m=max2f(a,b);
  auto rr=__builtin_amdgcn_permlane32_swap(__float_as_uint(m),__float_as_uint(m),false,false);
  return max2f(__uint_as_float(rr[0]),__uint_as_float(rr[1]));
}
__device__ __forceinline__ void pv(f32x16*o,int vb,bf16x8 pa0,bf16x8 pa1,bf16x8 pa2,bf16x8 pa3){
  #pragma unroll
  for(int d0=0;d0<2;++d0){s16x4 lo[4],hi[4];
    #pragma unroll
    for(int ks=0;ks<4;++ks){
      asm volatile("ds_read_b64_tr_b16 %0,%1 offset:%c2":"=&v"(lo[ks]):"v"(vb),"i"(d0*4096+ks*1024):"memory");
      asm volatile("ds_read_b64_tr_b16 %0,%1 offset:%c2":"=&v"(hi[ks]):"v"(vb),"i"(d0*4096+ks*1024+512):"memory");}
    asm volatile("s_waitcnt lgkmcnt(0)":::"memory");SBAR();
    #define PK(k) (bf16x8){lo[k][0],lo[k][1],lo[k][2],lo[k][3],hi[k][0],hi[k][1],hi[k][2],hi[k][3]}
    o[d0]=__builtin_amdgcn_mfma_f32_32x32x16_bf16(pa0,PK(0),o[d0],0,0,0);
    o[d0]=__builtin_amdgcn_mfma_f32_32x32x16_bf16(pa1,PK(1),o[d0],0,0,0);
    o[d0]=__builtin_amdgcn_mfma_f32_32x32x16_bf16(pa2,PK(2),o[d0],0,0,0);
    o[d0]=__builtin_amdgcn_mfma_f32_32x32x16_bf16(pa3,PK(3),o[d0],0,0,0);
    #undef PK
  }
}

typedef float f32x4_t __attribute__((ext_vector_type(4)));
__device__ __forceinline__ void fox_negcum(const float*logf,__attribute__((address_space(3))) float*ncum,__attribute__((address_space(3))) float*wtot,int tid){
  float loc[16];float s=0.f; const f32x4_t*lp=(const f32x4_t*)(logf+tid*16);
  #pragma unroll
  for(int j=0;j<4;++j){const f32x4_t v=lp[j]; s+=v[0];loc[4*j]=s; s+=v[1];loc[4*j+1]=s; s+=v[2];loc[4*j+2]=s; s+=v[3];loc[4*j+3]=s;}
  float inc=s;
  #pragma unroll
  for(int o=1;o<64;o<<=1){const float v=__shfl_up(inc,o); if((tid&63)>=o)inc+=v;}
  if((tid&63)==63)wtot[tid>>6]=inc;
  __syncthreads();
  float base=inc-s; for(int w=0;w<(tid>>6);++w)base+=wtot[w];
  #pragma unroll
  for(int j=0;j<4;++j){ f32x4_t o4; o4[0]=-(base+loc[4*j]);o4[1]=-(base+loc[4*j+1]);o4[2]=-(base+loc[4*j+2]);o4[3]=-(base+loc[4*j+3]); *(__attribute__((address_space(3))) f32x4_t*)(ncum+tid*16+4*j)=o4; }
  __syncthreads();
}
#ifndef ATTN_STORE16
#define ATTN_STORE16(p,v) (*(u32x4*)(p)=(v))
#endif
template<int THRL> __device__ __forceinline__ void attn_unit(int b,int h,int qb,const bf16*Q,const bf16*__restrict__ K,const bf16*__restrict__ V,bf16*O,char*shm,const float*logf_bh,const unsigned*kn_bh,unsigned char*O8=nullptr){
  int tid_=threadIdx.x; asm volatile("":"+v"(tid_)); const int tid=tid_,lane=tid&63,r32=lane&31,hi=lane>>5; const int wid=__builtin_amdgcn_readfirstlane(tid>>6);
  const long rowbase=(long)b*SEQ; const int q0=qb*QB;
  const bf16*Qw=Q+(rowbase+q0+wid*QBLK)*DM+h*D;
  const bf16*Kh=K+rowbase*DM+h*D,*Vh=V+rowbase*DM+h*D;
  const unsigned lds0=(unsigned)(uintptr_t)shm;
  float*wsf=(float*)(shm+LDS_WS)+wid*64;
  const bf16*ksrc=Kh+(long)lane*DM+wid*8;
  const bf16*vsrc=Vh+(long)(16*(wid&3)+(lane>>2))*DM+(wid>>2)*32+(lane&3)*8;
  const unsigned kdst=lds0+LDS_K+wid*1024, vdst=lds0+LDS_V+wid*1024;
  #define TIDX(t) (NTR-1-(t))
  #define DMA_K(t,slot) glds16(ksrc+(long)TIDX(t)*KVBLK*DM,(unsigned)__builtin_amdgcn_readfirstlane(kdst+(slot)))
  #define DMA_V(t,slot) glds16(vsrc+(long)TIDX(t)*KVBLK*DM,(unsigned)__builtin_amdgcn_readfirstlane(vdst+(slot)))
  const int vb0=(int)(lds0+LDS_V)+((lane>>4)&1)*32+(lane&3)*8+(4*hi+((lane&15)>>2))*64;
  const char*Kbase=shm+LDS_K; bf16x8 kf[8];
  const lds_cptr shm3=(lds_cptr)shm; const lds_cptr kp0=shm3+LDS_K+hi*1024+r32*16; const lds_cptr vp0=shm3+LDS_V+((lane>>4)&1)*32+(lane&3)*8+(4*hi+((lane&15)>>2))*64;
  const int NTR=(q0+QB)/KVBLK;
  const lds_cptr shm3b=(lds_cptr)shm;
  const __attribute__((address_space(3))) float* nb3=(const __attribute__((address_space(3))) float*)(shm3b+LDS_NB);
  fox_negcum(logf_bh,(__attribute__((address_space(3))) float*)(shm3b+LDS_NB),(__attribute__((address_space(3))) float*)(shm3b+LDS_NB+32768),tid);
  int NT;
  { __attribute__((address_space(3))) float* PK=(__attribute__((address_space(3))) float*)(shm3b+LDS_PK);
    __attribute__((address_space(3))) int* JX=(__attribute__((address_space(3))) int*)(shm3b+LDS_PK+512);
    float pk=0.f;
    if(tid<128){ const float a=__uint_as_float(kn_bh[2*tid]),c=__uint_as_float(kn_bh[2*tid+1]); pk=__builtin_sqrtf(a+c)*1.001f; }
    #pragma unroll
    for(int o_=1;o_<64;o_<<=1){const float v=__shfl_up(pk,o_); if((tid&63)>=o_)pk=__builtin_fmaxf(pk,v);}
    if(tid==63)PK[128]=pk;
    __syncthreads();
    if(tid>=64&&tid<128)pk=__builtin_fmaxf(pk,PK[128]);
    if(tid<128)PK[tid]=pk;
    const bf16*Krow=Kh+(long)(q0+wid*QBLK+r32)*DM+hi*8; const bf16*Qrow=Qw+(long)r32*DM+hi*8; float qq=0.f,qk=0.f;
    #pragma unroll
    for(int d0=0;d0<4;++d0){ const u32x4 qa=*reinterpret_cast<const u32x4*>(Qrow+d0*16), ka=*reinterpret_cast<const u32x4*>(Krow+d0*16);
      #pragma unroll
      for(int e=0;e<4;++e){ const float q0f=__uint_as_float(qa[e]<<16),q1f=__uint_as_float(qa[e]&0xffff0000u),k0f=__uint_as_float(ka[e]<<16),k1f=__uint_as_float(ka[e]&0xffff0000u);
        qq+=q0f*q0f+q1f*q1f; qk+=q0f*k0f+q1f*k1f; } }
    { auto r1=__builtin_amdgcn_permlane32_swap(__float_as_uint(qq),__float_as_uint(qq),false,false); qq=__uint_as_float(r1[0])+__uint_as_float(r1[1]);
      auto r2=__builtin_amdgcn_permlane32_swap(__float_as_uint(qk),__float_as_uint(qk),false,false); qk=__uint_as_float(r2[0])+__uint_as_float(r2[1]); }
    __syncthreads();
    const float qn=__builtin_sqrtf(qq)*1.001f, thr=qk+nb3[q0+wid*QBLK+r32]-72.f;
    int lo_=0,hi_=NTR;
    #pragma unroll 1
    for(int it=0;it<8;++it){ if(lo_<hi_){ const int mid=(lo_+hi_)>>1; const float f=qn*PK[mid]+nb3[64*mid+63]; if(f>=thr)hi_=mid; else lo_=mid+1; } }
    #pragma unroll
    for(int o_=1;o_<64;o_<<=1){const int v=__shfl_xor(lo_,o_); lo_=v<lo_?v:lo_;}
    if(lane==0)JX[wid]=lo_;
    __syncthreads();
    int j0=JX[0];
    #pragma unroll
    for(int w=1;w<8;++w){const int v=JX[w]; j0=v<j0?v:j0;}
    j0=__builtin_amdgcn_readfirstlane(j0);
    int nte=(NTR-j0+1)&~1; NT=nte<4?4:nte;
    __syncthreads();
  }
  { __attribute__((address_space(3))) float* nbw=(__attribute__((address_space(3))) float*)(shm3b+LDS_NB);
    const float ref_=nbw[q0+QB-1];
    __syncthreads();
    #pragma unroll
    for(int j=0;j<16;++j){ const float v=nbw[tid*16+j]-ref_; const unsigned h_=cvtpk_s(v,0.f)&0xffffu; const float hf_=__uint_as_float(h_<<16); const unsigned l_=cvtpk_s(v-hf_,0.f)&0xffffu;
      ((__attribute__((address_space(3))) unsigned*)nbw)[tid*16+j]=h_|(l_<<16); }
    __syncthreads();
  }
  const __attribute__((address_space(3))) unsigned* nbp=(const __attribute__((address_space(3))) unsigned*)(shm3b+LDS_NB);
  const unsigned mh0=(hi==0)?0xffffffffu:0u, onesm=0x3f803f80u&mh0;
  u32x4 qxw={onesm,0u,0u,0u};
  #define QX_SET() do{ const float nm_=-mhat; const unsigned h_=cvtpk_s(nm_,0.f)&0xffffu; const unsigned l_=cvtpk_s(nm_-__uint_as_float(h_<<16),0.f)&0xffffu; qxw[1]=(h_|(l_<<16))&mh0; }while(0)
  #define KXF(pr) __builtin_bit_cast(bf16x8,(u32x4){(pr)&mh0,onesm,0u,0u})
  #define BIASMMA(C0,C1,t) do{ const unsigned pr0_=nbp[64*TIDX(t)+r32],pr1_=nbp[64*TIDX(t)+32+r32]; \
    C0=__builtin_amdgcn_mfma_f32_32x32x16_bf16(KXF(pr0_),__builtin_bit_cast(bf16x8,qxw),C0,0,0,0); C1=__builtin_amdgcn_mfma_f32_32x32x16_bf16(KXF(pr1_),__builtin_bit_cast(bf16x8,qxw),C1,0,0,0); }while(0)
  DMA_K(0,0);DMA_V(0,0);DMA_K(1,SLOTB);
  bf16x8 qr[4];
  #pragma unroll
  for(int d0=0;d0<4;++d0)qr[d0]=*reinterpret_cast<const bf16x8*>(&Qw[(long)r32*DM+d0*16+hi*8]);
  float mhat=0.f,l_reg=0.f;f32x16 o[2];o[0]=f32x16{};o[1]=f32x16{};const f32x16 negm=f32x16{};
  const int qrel=wid*QBLK+r32;
  #define CMASK(P0,P1,t) do{ if((t)<4){ cmask(P0,P1,3-(t),qrel,hi); } }while(0)
  bool resc=false;
  #define START(P0,P1) do{ const float rm=rowmax(P0,P1); resc=false; \
    { const float dl=(rm>-3.0e38f)?__builtin_ceilf(rm*16.f)*0.0625f:0.f; mhat=fadd_s(mhat,dl);     \
      _Pragma("unroll") for(int r=0;r<16;++r){P0[r]=fsub_s(P0[r],dl);P1[r]=fsub_s(P1[r],dl);} \
      QX_SET(); } \
    _Pragma("unroll") for(int r=0;r<16;++r)P0[r]=__builtin_amdgcn_exp2f(P0[r]); }while(0)
  #define RESC() do{ if(resc){ asm volatile("s_waitcnt lgkmcnt(0)":::"memory"); \
      _Pragma("unroll") for(int d_=0;d_<2;++d_) _Pragma("unroll") for(int r=0;r<16;++r)o[d_][r]*=wsf[crow(r,hi)]; } }while(0)
  f32x16 pA0,pA1,pB0,pB1;
  int sl_prev=0,sl_cur=0,sl_next=SLOTB;
  #define ROT() do{sl_prev=sl_cur;sl_cur=sl_next;sl_next=(sl_next==(NSLOT-1)*SLOTB)?0:sl_next+SLOTB;}while(0)
  DMA_K(2,2*SLOTB);
  WAIT_BAR(3);
  qkt(pA0,pA1,Kbase,qr,negm,r32,hi);BIASMMA(pA0,pA1,0);asm volatile("s_nop 15\n\ts_nop 7":"+v"(pA0),"+v"(pA1));CMASK(pA0,pA1,0);
  START(pA0,pA1);
  _Pragma("unroll") for(int r=0;r<16;++r)pA1[r]=__builtin_amdgcn_exp2f(pA1[r]);
  WAIT_BAR(0);
  DMA_K(3,0);DMA_V(1,SLOTB);
  ROT();
  kload8(kf,kp0+sl_cur);
  WAIT_BAR(2);
  s16x4 vlo[8],vhi[8]; u32x4 pw0,pw1,pw2,pw3;
  #define PKW(P,B) cvtpk_s(P[B],P[B+1])
  #define PAF(k) __builtin_bit_cast(bf16x8,pw##k)
  #define VFR(i) (bf16x8){vlo[i][0],vlo[i][1],vlo[i][2],vlo[i][3],vhi[i][0],vhi[i][1],vhi[i][2],vhi[i][3]}
  #define PIN(x) asm volatile("":"+v"(x))
  #define MX3(a,b,c) __builtin_fmaxf(__builtin_fmaxf((a),(b)),(c))
  #define GAPA(MF,A0,A1,A2,A3,W0,W1,PW) do{ MF; sacc+=A0; sacc+=A1; sacc+=A2; sacc+=A3; PIN(sacc); W0; W1; PIN(PW); SBAR(); }while(0)
  #define EX(v) __builtin_amdgcn_exp2f(v)
  #define GAPB(MF,X,B) do{ MF; X[B]=EX(X[B]); X[B+1]=EX(X[B+1]); X[B+2]=EX(X[B+2]); X[B+3]=EX(X[B+3]); PIN(X); SBAR(); }while(0)
  #define VRD(i) do{ vlo[i]=vtr(vp_+(((i)>>2)*4096+((i)&3)*1024)); vhi[i]=vtr(vp_+(((i)>>2)*4096+((i)&3)*1024+512)); }while(0)
  #define KRD(G,j) do{ if(G){ kload2(kf,kp0+sl_next,j); SBAR(); } }while(0)
  #define STEP(C0,C1,P0,P1,t,GK,GV,GL) do{ SBAR(); \
    const lds_cptr vp_=vp0+sl_prev; \
    VRD(0); SBAR(); float sacc=(P0[0]+P0[1]); \
    GAPA(C0=__builtin_amdgcn_mfma_f32_32x32x16_bf16(kf[0],qr[0],negm,0,0,0), P0[2],P0[3],P0[4],P0[5],     pw0[0]=PKW(P0,0), pw0[1]=PKW(P0,2), pw0); \
    VRD(4); SBAR(); GAPA(C1=__builtin_amdgcn_mfma_f32_32x32x16_bf16(kf[1],qr[0],negm,0,0,0), P0[6],P0[7],P0[8],P0[9],     pw0[2]=PKW(P0,4), pw0[3]=PKW(P0,6), pw0); \
    VRD(1); SBAR(); GAPA(C0=__builtin_amdgcn_mfma_f32_32x32x16_bf16(kf[2],qr[1],C0,0,0,0),   P0[10],P0[11],P0[12],P0[13], pw1[0]=PKW(P0,8), pw1[1]=PKW(P0,10), pw1); \
    VRD(5); SBAR(); GAPA(C1=__builtin_amdgcn_mfma_f32_32x32x16_bf16(kf[3],qr[1],C1,0,0,0),   P0[14],P0[15],P1[0],P1[1],   pw1[2]=PKW(P0,12),pw1[3]=PKW(P0,14), pw1); \
    VRD(2); SBAR(); GAPA(C0=__builtin_amdgcn_mfma_f32_32x32x16_bf16(kf[4],qr[2],C0,0,0,0),   P1[2],P1[3],P1[4],P1[5],     pw2[0]=PKW(P1,0), pw2[1]=PKW(P1,2), pw2); \
    VRD(6); SBAR(); GAPA(C1=__builtin_amdgcn_mfma_f32_32x32x16_bf16(kf[5],qr[2],C1,0,0,0),   P1[6],P1[7],P1[8],P1[9],     pw2[2]=PKW(P1,4), pw2[3]=PKW(P1,6), pw2); \
    VRD(3); SBAR(); GAPA(C0=__builtin_amdgcn_mfma_f32_32x32x16_bf16(kf[6],qr[3],C0,0,0,0),   P1[10],P1[11],P1[12],P1[13], pw3[0]=PKW(P1,8), pw3[1]=PKW(P1,10), pw3); \
    VRD(7); SBAR(); GAPA(C1=__builtin_amdgcn_mfma_f32_32x32x16_bf16(kf[7],qr[3],C1,0,0,0),   P1[14],P1[15],0.f,0.f,       pw3[2]=PKW(P1,12),pw3[3]=PKW(P1,14), pw3); \
    l_reg+=sacc; \
    if(GK){DMA_K((t)+3,sl_cur);} if(GV){DMA_V((t)+1,sl_next);} \
    BIASMMA(C0,C1,t); CMASK(C0,C1,t); \
    { float a=MX3(C0[0],C0[1],C1[0]),b=MX3(C0[2],C0[3],C1[1]); a=MX3(a,C1[2],C1[3]); \
      _Pragma("unroll") for(int r=4;r<16;r+=4){a=MX3(a,C0[r],C0[r+1]);b=MX3(b,C0[r+2],C0[r+3]);a=MX3(a,C1[r],C1[r+1]);b=MX3(b,C1[r+2],C1[r+3]);} \
      float rm=__builtin_fmaxf(a,b); { auto rr=__builtin_amdgcn_permlane32_swap(__float_as_uint(rm),__float_as_uint(rm),false,false); rm=__builtin_fmaxf(__uint_as_float(rr[0]),__uint_as_float(rr[1])); } \
      resc=false; \
      if(__builtin_expect(__any(rm>(float)THRL),0)){ const float dl=__builtin_fmaxf(__builtin_ceilf(rm*16.f)*0.0625f,0.f); mhat+=dl; QX_SET(); \
        _Pragma("unroll") for(int r=0;r<16;++r){C0[r]-=dl;C1[r]-=dl;} \
        const float f=__builtin_amdgcn_exp2f(-dl); l_reg*=f; if(hi==0)wsf[r32]=f; resc=true; } } \
    SBAR(); \
    GAPB(o[0]=__builtin_amdgcn_mfma_f32_32x32x16_bf16(PAF(0),VFR(0),o[0],0,0,0), C0,0); \
    GAPB(o[1]=__builtin_amdgcn_mfma_f32_32x32x16_bf16(PAF(0),VFR(4),o[1],0,0,0), C0,4); \
    KRD(GL,0); GAPB(o[0]=__builtin_amdgcn_mfma_f32_32x32x16_bf16(PAF(1),VFR(1),o[0],0,0,0), C0,8); \
    KRD(GL,1); GAPB(o[1]=__builtin_amdgcn_mfma_f32_32x32x16_bf16(PAF(1),VFR(5),o[1],0,0,0), C0,12); \
    KRD(GL,2); GAPB(o[0]=__builtin_amdgcn_mfma_f32_32x32x16_bf16(PAF(2),VFR(2),o[0],0,0,0), C1,0); \
    KRD(GL,3); GAPB(o[1]=__builtin_amdgcn_mfma_f32_32x32x16_bf16(PAF(2),VFR(6),o[1],0,0,0), C1,4); \
    GAPB(o[0]=__builtin_amdgcn_mfma_f32_32x32x16_bf16(PAF(3),VFR(3),o[0],0,0,0), C1,8); \
    GAPB(o[1]=__builtin_amdgcn_mfma_f32_32x32x16_bf16(PAF(3),VFR(7),o[1],0,0,0), C1,12); \
    }while(0)
  int t=1;
  for(int it_=0;it_<2&&t+5<NT;++it_,t+=2){
    STEP(pB0,pB1,pA0,pA1,t,true,true,true);     WAIT_BAR(2); RESC(); ROT();
    STEP(pA0,pA1,pB0,pB1,t+1,true,true,true);   WAIT_BAR(2); RESC(); ROT();
  }
  #undef CMASK
  #define CMASK(P0,P1,t) do{}while(0)
  for(;t+5<NT;t+=2){
    STEP(pB0,pB1,pA0,pA1,t,true,true,true);     WAIT_BAR(2); RESC(); ROT();
    STEP(pA0,pA1,pB0,pB1,t+1,true,true,true);   WAIT_BAR(2); RESC(); ROT();
  }
  #undef CMASK
  #define CMASK(P0,P1,t) do{ if((t)<4){ cmask(P0,P1,3-(t),qrel,hi); } }while(0)
  #define ENDW(tt) do{ if((tt)+3<NT){WAIT_BAR(2);} else if((tt)+2<NT){WAIT_BAR(1);} else {WAIT_BAR(0);} }while(0)
  for(;t+1<NT;t+=2){
    STEP(pB0,pB1,pA0,pA1,t,(t+3<NT),(t+1<NT),(t+1<NT));       ENDW(t);   RESC(); ROT();
    STEP(pA0,pA1,pB0,pB1,t+1,(t+4<NT),(t+2<NT),(t+2<NT));     ENDW(t+1); RESC(); ROT();
  }
  STEP(pB0,pB1,pA0,pA1,NT-1,false,false,false); RESC();
  { float sacc=pB0[0]+pB0[1]; _Pragma("unroll") for(int r=2;r<16;++r)sacc+=pB0[r]; _Pragma("unroll") for(int r=0;r<16;++r)sacc+=pB1[r]; l_reg+=sacc;
    pw0=(u32x4){PKW(pB0,0),PKW(pB0,2),PKW(pB0,4),PKW(pB0,6)};pw1=(u32x4){PKW(pB0,8),PKW(pB0,10),PKW(pB0,12),PKW(pB0,14)};pw2=(u32x4){PKW(pB1,0),PKW(pB1,2),PKW(pB1,4),PKW(pB1,6)};pw3=(u32x4){PKW(pB1,8),PKW(pB1,10),PKW(pB1,12),PKW(pB1,14)};
    SBAR(); pv(o,vb0+sl_cur,PAF(0),PAF(1),PAF(2),PAF(3)); }
  #undef PKW
  #undef PAF
  #undef VFR
  #undef PIN
  #undef MX3
  #undef GAPA
  #undef GAPB
  #undef EX
  #undef VRD
  #undef KRD
  #undef STEP
  #undef ENDW
  {auto rr=__builtin_amdgcn_permlane32_swap(__float_as_uint(l_reg),__float_as_uint(l_reg),false,false);l_reg=__uint_as_float(rr[0])+__uint_as_float(rr[1]);}
  if(hi==0)wsf[32+r32]=l_reg;asm volatile("s_waitcnt lgkmcnt(0)":::"memory");
  float rli[16];
  #pragma unroll
  for(int r=0;r<16;++r)rli[r]=__builtin_amdgcn_rcpf(wsf[32+crow(r,hi)]);
  if(O8){ unsigned char*stg8=(unsigned char*)(shm+LDS_OST)+wid*4096;
    #pragma unroll
    for(int r=0;r<16;++r){const int orow=crow(r,hi);
      #pragma unroll
      for(int d0=0;d0<2;++d0)stg8[orow*64+d0*32+r32]=(unsigned char)(__builtin_amdgcn_cvt_pk_fp8_f32(o[d0][r]*rli[r],0.f,0,false)&0xff);}
    asm volatile("s_waitcnt lgkmcnt(0)":::"memory");
    unsigned char*Ow8=O8+(rowbase+q0+wid*QBLK)*1024+h*D;
    #pragma unroll
    for(int i=0;i<2;++i){const int row=i*16+(lane>>2),ch=lane&3; const u32x4 v=*(const u32x4*)(stg8+row*64+ch*16); ATTN_STORE16(Ow8+(long)row*1024+ch*16,v);} }
  else{
  bf16*Ow=O+(rowbase+q0+wid*QBLK)*DM+h*D;
  { bf16*stg=(bf16*)(shm+LDS_OST)+wid*2048;
    #pragma unroll
    for(int r=0;r<16;++r){const int orow=crow(r,hi);
      #pragma unroll
      for(int d0=0;d0<2;++d0)stg[orow*64+d0*32+r32]=__float2bfloat16(o[d0][r]*rli[r]);}
    asm volatile("s_waitcnt lgkmcnt(0)":::"memory");
    #pragma unroll
    for(int i=0;i<4;++i){const int row=i*8+(lane>>3),ch=lane&7; const u32x4 v=*(const u32x4*)(stg+row*64+ch*8); ATTN_STORE16(Ow+(long)row*DM+ch*8,v);} } }
  asm volatile("s_waitcnt lgkmcnt(0)\n\ts_barrier":::"memory");
  #undef BIASMMA
  #undef KXF
  #undef QX_SET
  #undef TIDX
  #undef DMA_K
  #undef DMA_V
  #undef CMASK
  #undef START
  #undef RESC
  #undef ROT
}

template<int PITCH> __device__ __forceinline__ void sb_unit(int b,int h,int qb,const bf16*Q,const bf16*__restrict__ K,const bf16*__restrict__ V,bf16*O  ,char*shm){
  int tid_=threadIdx.x; asm volatile("":"+v"(tid_)); const int tid=tid_,lane=tid&63,r32=lane&31,hi=lane>>5; const int wid=__builtin_amdgcn_readfirstlane(tid>>6);
  const long rowbase=(long)b*SEQ; const int q0=qb*QB;
  const bf16*Qw=Q+(rowbase+q0+wid*QBLK)*PITCH+h*D;
  const bf16*Kh=K+rowbase*PITCH+h*D,*Vh=V+rowbase*PITCH+h*D;
  const unsigned lds0=(unsigned)(uintptr_t)shm;
  const bf16*ksrc=Kh+(long)lane*PITCH+wid*8;
  const bf16*vsrc=Vh+(long)(16*(wid&3)+(lane>>2))*PITCH+(wid>>2)*32+(lane&3)*8;
  const unsigned kdst=lds0+LDS_K+wid*1024, vdst=lds0+LDS_V+wid*1024;
  #define SB_DMA(t,slot) do{ glds16(ksrc+(long)(t)*KVBLK*PITCH,(unsigned)__builtin_amdgcn_readfirstlane(kdst+(slot))); glds16(vsrc+(long)(t)*KVBLK*PITCH,(unsigned)__builtin_amdgcn_readfirstlane(vdst+(slot))); }while(0)
  const int vb0=(int)(lds0+LDS_V)+((lane>>4)&1)*32+(lane&3)*8+(4*hi+((lane&15)>>2))*64;
  volatile __attribute__((address_space(3))) unsigned* fl=(volatile __attribute__((address_space(3))) unsigned*)((lds_cptr)shm+LDS_WS);
  const int NT=(q0+QB)/KVBLK; const int qrel=wid*QBLK+r32;
  SB_DMA(NT-1,0);
  bf16x8 qr[4];
  #pragma unroll
  for(int d0=0;d0<4;++d0)qr[d0]=*reinterpret_cast<const bf16x8*>(&Qw[(long)r32*PITCH+d0*16+hi*8]);
  f32x16 o[2];o[0]=f32x16{};o[1]=f32x16{}; const f32x16 zero16=f32x16{};
  float carry=1.f;
  int slot=0;
  #define SB_TILE(BAND) do{ \
    if(!(BAND&&64*(t-(NT-4))>wid*QBLK+QBLK-1)){ \
    f32x16 p0,p1; qkt(p0,p1,shm+LDS_K+slot,qr,zero16,r32,hi); \
    if(BAND){ const int kb=64*(t-(NT-4))+4*hi;                 \
      _Pragma("unroll") for(int r=0;r<16;++r){const int kv=kb+(r&3)+8*(r>>2); if(kv>=qrel)p0[r]=-INFINITY; if(kv+32>=qrel)p1[r]=-INFINITY;} } \
      \
      \
    f32x16 s0,s1;                                                \
    _Pragma("unroll") for(int r=0;r<16;++r){ const float z=p0[r]; const float e=__builtin_amdgcn_exp2f(-__builtin_fmaxf(z,-100.f)); const float rb=__builtin_amdgcn_rcpf(1.f+e); const float y=p1[r]; const float f=__builtin_amdgcn_exp2f(-__builtin_fmaxf(y,-100.f)); const float rc=__builtin_amdgcn_rcpf(1.f+f); \
      if(BAND){ const bool mk=z<-1.0e30f; p0[r]=mk?0.f:rb; s0[r]=mk?1.f:e*rb; const bool mj=y<-1.0e30f; p1[r]=mj?0.f:rc; s1[r]=mj?1.f:f*rc; } \
      else { p0[r]=rb; s0[r]=e*rb; p1[r]=rc; s1[r]=f*rc; } } \
    float lo[8],hv[8];                                          \
    _Pragma("unroll") for(int i=0;i<8;++i){ const float mine=(i<4)?((s0[4*i]*s0[4*i+1])*(s0[4*i+2]*s0[4*i+3])):((s1[4*i-16]*s1[4*i-15])*(s1[4*i-14]*s1[4*i-13])); \
      auto rr=__builtin_amdgcn_permlane32_swap(__float_as_uint(mine),__float_as_uint(mine),false,false); lo[i]=__uint_as_float(rr[0]); hv[i]=__uint_as_float(rr[1]); } \
    float sp_=carry;                                             \
    _Pragma("unroll") for(int i=7;i>=0;--i){ float a=sp_*((hi==0)?hv[i]:1.f);       \
      if(i<4){ p0[4*i+3]*=a; a*=s0[4*i+3]; p0[4*i+2]*=a; a*=s0[4*i+2]; p0[4*i+1]*=a; a*=s0[4*i+1]; p0[4*i]*=a; } \
      else   { const int j=4*i-16; p1[j+3]*=a; a*=s1[j+3]; p1[j+2]*=a; a*=s1[j+2]; p1[j+1]*=a; a*=s1[j+1]; p1[j]*=a; } \
      sp_*=lo[i]*hv[i]; } \
    carry=sp_; \
    { u32x4 pw0,pw1,pw2,pw3; \
      pw0=(u32x4){cvtpk_s(p0[0],p0[1]),cvtpk_s(p0[2],p0[3]),cvtpk_s(p0[4],p0[5]),cvtpk_s(p0[6],p0[7])}; pw1=(u32x4){cvtpk_s(p0[8],p0[9]),cvtpk_s(p0[10],p0[11]),cvtpk_s(p0[12],p0[13]),cvtpk_s(p0[14],p0[15])}; \
      pw2=(u32x4){cvtpk_s(p1[0],p1[1]),cvtpk_s(p1[2],p1[3]),cvtpk_s(p1[4],p1[5]),cvtpk_s(p1[6],p1[7])}; pw3=(u32x4){cvtpk_s(p1[8],p1[9]),cvtpk_s(p1[10],p1[11]),cvtpk_s(p1[12],p1[13]),cvtpk_s(p1[14],p1[15])}; \
      pv(o,vb0+slot,__builtin_bit_cast(bf16x8,pw0),__builtin_bit_cast(bf16x8,pw1),__builtin_bit_cast(bf16x8,pw2),__builtin_bit_cast(bf16x8,pw3)); } \
    } \
    { const bool done_=__all(carry<0x1p-70f); if(lane==0)fl[(t&1)*8+wid]=done_?1u:0u; } \
    slot^=SLOTB; }while(0)
  #define SB_HEAD() { WAIT_BAR(0); \
    if(t<NT-1){ const int pb=((t+1)&1)*8; const unsigned a=fl[pb]&fl[pb+1]&fl[pb+2]&fl[pb+3]&fl[pb+4]&fl[pb+5]&fl[pb+6]&fl[pb+7]; if(__builtin_amdgcn_readfirstlane(a)!=0u)break; } \
    if(t>0)SB_DMA(t-1,slot^SLOTB); }
  int t=NT-1; bool live=true;
  for(;t>=NT-4;--t){ live=false; SB_HEAD(); SB_TILE(true); live=true; }
  if(live){ for(;t>=0;--t){ SB_HEAD(); SB_TILE(false); } }
  #undef SB_TILE
  #undef SB_HEAD
  asm volatile("s_waitcnt vmcnt(0) lgkmcnt(0)":::"memory");
  bf16*Ow=O+(rowbase+q0+wid*QBLK)*1024+h*D;
  { bf16*stg=(bf16*)(shm+LDS_OST)+wid*2048;
    #pragma unroll
    for(int r=0;r<16;++r){const int orow=crow(r,hi);
      #pragma unroll
      for(int d0=0;d0<2;++d0)stg[orow*64+d0*32+r32]=__float2bfloat16(o[d0][r]);}
    asm volatile("s_waitcnt lgkmcnt(0)":::"memory");
    #pragma unroll
    for(int i=0;i<4;++i){const int row=i*8+(lane>>3),ch=lane&7; const u32x4 v=*(const u32x4*)(stg+row*64+ch*8); ATTN_STORE16(Ow+(long)row*1024+ch*8,v);} }
  asm volatile("s_waitcnt vmcnt(0) lgkmcnt(0)\n\ts_barrier":::"memory");
  #undef SB_DMA
}
constexpr int ATTN_LDS_BYTES=LDS_BYTES;
struct AttnTensors { const bf16* Q; const bf16* K; const bf16* V; bf16* O; const float* logf;   const unsigned* kn;   };
#undef SBAR
#undef WAIT_BAR
}
constexpr int NWAVES = 8, NTHREADS = NWAVES * 64;
constexpr int BATCH = 2, SEQ = 8192, D = 1024, M = BATCH * SEQ;
constexpr int S5G = 32, S5H = 16, S5P = 64, S5T = 32  , S5NC = M / S5T  , S5KX = 640  ;
constexpr int SBH = 8, FOXH = 16, HD = 64;
constexpr int EVEN_IN = 2048, ODD_IN = 3088, DFF = 2816, NEXP = 8, DFE = 3584;
constexpr float C2 = 0.125f * 1.4426950408889634f;
constexpr int MOE_MAX_PANELS = 136, MOE_MAX_SLOTS = MOE_MAX_PANELS * 256, MOE_CAP = 16384  ;

constexpr size_t MiB = 1u << 20;
constexpr size_t WS_CTL = 0, CTL_ZERO_BYTES = 1 * MiB;
constexpr size_t WS_WMOE_GU = 1 * MiB;
constexpr size_t WS_WMOE_D = 57 * MiB;
constexpr size_t WS_WIN0 = 85 * MiB;
constexpr size_t WS_WGLU = 89 * MiB;
constexpr size_t WS_WOUT0 = 90 * MiB;
constexpr size_t WS_WGU0 = 92 * MiB;
constexpr size_t WS_WD0 = 103 * MiB;
constexpr size_t WS_WIN1 = 109 * MiB;
constexpr size_t WS_WF1 = 115 * MiB;
constexpr size_t WS_WOUT1 = 116 * MiB;
constexpr size_t WS_S5WA = 118 * MiB;
constexpr size_t WS_S5WC = 126 * MiB;
constexpr size_t WS_XB = 146 * MiB;
constexpr size_t WS_SSP = 178 * MiB;
constexpr size_t WS_META = 182 * MiB;
constexpr size_t WS_LOGF = 183 * MiB;
constexpr size_t WS_QKV0 = 184 * MiB;
constexpr size_t WS_UEXT = 232 * MiB;
constexpr size_t WS_SLOC = 252 * MiB;
constexpr size_t WS_YG = 260 * MiB;
constexpr size_t WS_MIXB = 276 * MiB;
constexpr size_t WS_HID0 = 184 * MiB;
constexpr size_t WS_QKV1 = 184 * MiB;
constexpr size_t WS_XG = 184 * MiB;
constexpr size_t WS_HMOE = 312 * MiB;
constexpr size_t WS_Y = 85 * MiB;
constexpr size_t WS_END = 432 * MiB;
static_assert(WS_XG + (size_t)8 * MOE_CAP * 1024 <= WS_HMOE && WS_HMOE + (size_t)MOE_MAX_SLOTS * DFE <= WS_END && WS_Y + (size_t)MOE_MAX_SLOTS * 1024 * 2 <= WS_XB + 32 * MiB && WS_MIXB + 32 * MiB <= WS_END, "ws map");
constexpr size_t MT_RSTD = 0, MT_TOKE = 65536, MT_TOKP = 131072, MT_TOKG = 262144, MT_RSS = 524288;
constexpr int CW_TMO = 0, CW_CODE = 1, CW_BAR = 4096, CW_CNT = 8192  , CW_QUEUE = 12288  , CW_QUEUE2 = 12352  , CW_KN = 16384  ;
constexpr int CW_SUBBAR = 32768;

constexpr int RING_OFF = 0, RING_BYTES = 131072;
constexpr int LDSCTL_OFF = 133120  , MISC_OFF = LDSCTL_OFF + 320;
constexpr int LDS_BYTES = 147456;

#define GAS __attribute__((address_space(1)))
#define LAS __attribute__((address_space(3)))
typedef unsigned short bf16;
typedef unsigned v4u __attribute__((ext_vector_type(4)));
typedef unsigned v2u __attribute__((ext_vector_type(2)));
typedef float f32x4 __attribute__((ext_vector_type(4)));
typedef short bf16x8 __attribute__((ext_vector_type(8)));
typedef GAS unsigned gu32;
#define RLX_AGENT __ATOMIC_RELAXED, __HIP_MEMORY_SCOPE_AGENT
#define LDS_WAIT() asm volatile("s_waitcnt lgkmcnt(0)" ::: "memory")
#define VM_WAIT() asm volatile("s_waitcnt vmcnt(0)" ::: "memory")
__device__ __forceinline__ unsigned f2bf(float f) { unsigned u = __builtin_bit_cast(unsigned, f); return (u + 0x7fffu + ((u >> 16) & 1u)) >> 16; }
__device__ __forceinline__ unsigned pk2(float lo, float hi) { return f2bf(lo) | (f2bf(hi) << 16); }
__device__ __forceinline__ float bflo(unsigned w) { return __uint_as_float(w << 16); }
__device__ __forceinline__ float bfhi(unsigned w) { return __uint_as_float(w & 0xffff0000u); }

#define XB_TMO      128
#define XB_XCNT(j)  (256  + 64 * (j))
#define XB_XSUB(j)  (1280 + 64 * (j))
#define XB_XGEN(j)  (2304 + 64 * (j))
#define XB_TOP      3328
#define XB_TOPGEN   3392
#define XCD_BAR_WORDS 3456
#define XB_SPIN_CAP (1u << 18)
__device__ __forceinline__ unsigned xb_ld(unsigned* p)              { return __hip_atomic_load(p, __ATOMIC_RELAXED, __HIP_MEMORY_SCOPE_AGENT); }
__device__ __forceinline__ unsigned xb_add(unsigned* p, unsigned v) { return __hip_atomic_fetch_add(p, v, __ATOMIC_RELAXED, __HIP_MEMORY_SCOPE_AGENT); }
__device__ __forceinline__ unsigned xb_xcc_id() { return (unsigned)__builtin_amdgcn_s_getreg((3 << 11) | 20) & 0xFu; }
#define XB_SPIN(cond, bar) do { unsigned _sp = 0; while (cond) { __builtin_amdgcn_s_sleep(1); \
    if ((++_sp & 255u) == 0u) { if (xb_ld(&(bar)[XB_TMO])) break; if (_sp > XB_SPIN_CAP) { atomicAdd(&(bar)[XB_TMO], 1u); break; } } } } while (0)
struct XcdBarrier { unsigned* bar; unsigned x; volatile LAS unsigned* st; unsigned total; };
__device__ __forceinline__ XcdBarrier xcd_barrier_post(unsigned* bar, volatile LAS unsigned* st, unsigned total) {
    XcdBarrier b; b.bar = bar; b.x = xb_xcc_id(); b.st = st; b.total = total;
    if (threadIdx.x == 0) (void)xb_add(&bar[XB_XCNT(b.x)], 1u);
    return b;
}
__device__ __forceinline__ void xcd_barrier_complete(unsigned* bar, unsigned x, unsigned G, unsigned& nloc, unsigned& nx) {
    unsigned sum, cnt, mine, sp = 0u;
    for (;;) {
        sum = 0u; cnt = 0u; mine = 0u;
#pragma unroll
        for (unsigned j = 0; j < 16; ++j) { const unsigned c = xb_ld(&bar[XB_XCNT(j)]); sum += c; cnt += (c > 0u) ? 1u : 0u; mine = (j == x) ? c : mine; }
        if (sum == G) break;
        __builtin_amdgcn_s_sleep(1);
        if ((++sp & 255u) == 0u) { if (xb_ld(&bar[XB_TMO])) break; if (sp > XB_SPIN_CAP) { atomicAdd(&bar[XB_TMO], 1u); break; } }
    }
    nloc = mine > 0u ? mine : 1u; nx = cnt > 0u ? cnt : 1u;
}
__device__ __forceinline__ void xcd_barrier(const XcdBarrier& b) {
    asm volatile("s_waitcnt vmcnt(0)" ::: "memory");
    __syncthreads();
    if (threadIdx.x == 64) { __builtin_amdgcn_fence(__ATOMIC_ACQUIRE, "agent"); asm volatile("s_waitcnt vmcnt(0)" ::: "memory"); }
    if (threadIdx.x == 0) {
        unsigned* bar = b.bar;
        __builtin_amdgcn_s_waitcnt(0);
        unsigned nloc = b.st[0], nx = b.st[1];
        if (nloc == 0u) { xcd_barrier_complete(bar, b.x, b.total, nloc, nx); b.st[0] = nloc; b.st[1] = nx; }
        const unsigned old = xb_add(&bar[XB_XSUB(b.x)], 1u);
        const unsigned gen = old / nloc;
        if (old + 1u == (gen + 1u) * nloc) {
            __builtin_amdgcn_fence(__ATOMIC_RELEASE, "agent");
            asm volatile("s_waitcnt vmcnt(0)" ::: "memory");
            const unsigned og = xb_add(&bar[XB_TOP], 1u);
            const unsigned tg = og / nx;
            if (og + 1u != (tg + 1u) * nx) XB_SPIN(xb_ld(&bar[XB_TOP]) < (tg + 1u) * nx, bar);
            xb_add(&bar[XB_XGEN(b.x)], 1u);
            asm volatile("s_waitcnt vmcnt(0)" ::: "memory");
        } else {
            XB_SPIN(xb_ld(&bar[XB_XGEN(b.x)]) == gen, bar);
            asm volatile("s_waitcnt vmcnt(0)" ::: "memory");
        }
    }
    __syncthreads();
}

__device__ __forceinline__ float wave_sum(float v) {
#pragma unroll
    for (int o = 1; o < 64; o <<= 1) v += __shfl_xor(v, o);
    return v;
}
constexpr int XP = 65, XSCR_BYTES = 64 * XP * 4;
__device__ __forceinline__ unsigned cvtpk(float lo, float hi) { unsigned r; asm volatile("v_cvt_pk_bf16_f32 %0, %1, %2" : "=v"(r) : "v"(lo), "v"(hi)); return r; }
__device__ __forceinline__ void p0_transpose_item(const float* W, int ldw, int k0, int n0, const float* gs, bf16* dst, int ldd, LAS float* scr, int lane) {
    const int lr = lane >> 4, lc = (lane & 15) * 4;
    const float* src = W + (size_t)(k0 + lr) * ldw + n0 + lc;
    f32x4 v[16];
#pragma unroll
    for (int i = 0; i < 16; ++i) v[i] = __builtin_nontemporal_load((const GAS f32x4*)(src + (size_t)(4 * i) * ldw));
    if (gs) {
#pragma unroll
        for (int i = 0; i < 16; ++i) v[i] = v[i] * gs[k0 + 4 * i + lr]; }
#pragma unroll
    for (int i = 0; i < 16; ++i) { LAS float* p = scr + (4 * i + lr) * XP + lc; p[0] = v[i][0]; p[1] = v[i][1]; p[2] = v[i][2]; p[3] = v[i][3]; }
    LDS_WAIT(); asm volatile("" ::: "memory");
    const int c = lane & 7, nn = lane >> 3;
#pragma unroll
    for (int j = 0; j < 8; ++j) { const int n = nn + 8 * j; const LAS float* sp = scr + (8 * c) * XP + n;
        v4u o; o.x = cvtpk(sp[0 * XP], sp[1 * XP]); o.y = cvtpk(sp[2 * XP], sp[3 * XP]); o.z = cvtpk(sp[4 * XP], sp[5 * XP]); o.w = cvtpk(sp[6 * XP], sp[7 * XP]);
        *(GAS v4u*)(dst + (size_t)n * ldd + k0 + 8 * c) = o; }
    LDS_WAIT(); asm volatile("" ::: "memory");
}
struct XTile { const float* src; const float* gs; unsigned char* dst; int ldw, ldd, k0; };
__device__ __forceinline__ XTile xtile_fp8(int item, const float* W, int ldw, int N, const float* gs, unsigned char* dst, int ldd, int mode, int lane) {
    const int nblk = N / 64, kb = item / nblk, nb = item % nblk, n0 = 64 * nb, k0 = 64 * kb;
    const int row = mode == 0 ? n0 : ((n0 >> 7) * 256 + (n0 & 127) + (mode == 2 ? 128 : 0));
    XTile t; t.src = W + (size_t)(k0 + (lane >> 4)) * ldw + n0 + (lane & 15) * 4; t.gs = gs; t.dst = dst + (size_t)row * ldd; t.ldw = ldw; t.ldd = ldd; t.k0 = k0; return t;
}
__device__ __forceinline__ void xtile_load(const XTile& t, f32x4 (&v)[16], float (&g)[16], int lane) {
    const int lr = lane >> 4;
    if (t.gs) {
#pragma unroll
        for (int i = 0; i < 16; ++i) g[i] = t.gs[t.k0 + 4 * i + lr];
    } else {
#pragma unroll
        for (int i = 0; i < 16; ++i) g[i] = 1.0f; }
#pragma unroll
    for (int i = 0; i < 16; ++i) v[i] = __builtin_nontemporal_load((const GAS f32x4*)(t.src + (size_t)(4 * i) * t.ldw));
}
__device__ __forceinline__ void xtile_finish_fp8(const XTile& t, f32x4 (&v)[16], const float (&g)[16], float wscale, LAS float* scr, int lane) {
    const int lr = lane >> 4, lc = (lane & 15) * 4;
#pragma unroll
    for (int i = 0; i < 16; ++i) v[i] = v[i] * (g[i] * wscale);
    constexpr int XR = 64;
#pragma unroll
    for (int i = 0; i < 16; ++i) *(LAS f32x4*)(scr + (4 * i + lr) * XR + (i >> 2) * 16 + lc) = v[i];
    LDS_WAIT(); asm volatile("" ::: "memory");
    const int c = lane & 3, nn = lane >> 2;
#pragma unroll
    for (int j = 0; j < 4; ++j) { const int n = nn + 16 * j; const LAS float* sp = scr + (16 * c) * XR + c * 16 + n;
        v4u o; o.x = pg8::pk_fp8x4(sp[0 * XR], sp[1 * XR], sp[2 * XR], sp[3 * XR]); o.y = pg8::pk_fp8x4(sp[4 * XR], sp[5 * XR], sp[6 * XR], sp[7 * XR]);
        o.z = pg8::pk_fp8x4(sp[8 * XR], sp[9 * XR], sp[10 * XR], sp[11 * XR]); o.w = pg8::pk_fp8x4(sp[12 * XR], sp[13 * XR], sp[14 * XR], sp[15 * XR]);
        __builtin_nontemporal_store(o, (GAS v4u*)(t.dst + (size_t)n * t.ldd + t.k0 + 16 * c)); }
    LDS_WAIT(); asm volatile("" ::: "memory");
}
__device__ __forceinline__ void xpose_mat(int item, const float* W, int ldw, int N, const float* gs, bf16* dst, int ldd, int mode, LAS float* scr, int lane) {
    const int nblk = N / 64, kb = item / nblk, nb = item % nblk, n0 = 64 * nb;
    const int row = mode == 0 ? n0 : ((n0 >> 7) * 256 + (n0 & 127) + (mode == 2 ? 128 : 0));
    p0_transpose_item(W, ldw, 64 * kb, n0, gs, dst + (size_t)row * ldd, ldd, scr, lane);
}

struct Args { const float* in[28]; float* out; unsigned char* ws; };

__device__ __forceinline__ void s5_tables(const Args& a, int g, int q, LAS unsigned char* lds, int tid) {
    LAS float* POWr = (LAS float*)lds;
    LAS float* POWi = POWr + 33 * 64;
    LAS float* BBr = POWi + 33 * 64;
    LAS float* BBi = BBr + 1024;
    LAS float* CCr = BBi + 1024;
    LAS float* CCi = CCr + 1024;
    LAS float* KT = CCi + 1024;
    LAS float* DD = KT + 2048;
    const float* a_re = a.in[3]; const float* a_im = a.in[4]; const float* b_re = a.in[5]; const float* b_im = a.in[6];
    const float* c_re = a.in[7]; const float* c_im = a.in[8]; const float* dsk = a.in[9]; const float* log_step = a.in[10];
    const float step = expf(log_step[g]);
    __syncthreads();
    for (int e = tid; e < 33 * 64; e += NTHREADS) { const int n = e >> 6, p = e & 63; const float lr = a_re[g * 64 + p], li = a_im[g * 64 + p];
        const float mag = expf((float)n * step * lr); float sn, cs; sincosf((float)n * (step * li), &sn, &cs); POWr[e] = mag * cs; POWi[e] = mag * sn; }
    for (int e = tid; e < 1024; e += NTHREADS) { const int p = e >> 4, h = e & 15; const float lr = a_re[g * 64 + p], li = a_im[g * 64 + p];
        const float er = expf(lr * step); float sn, cs; sincosf(li * step, &sn, &cs); const float nr = er * cs - 1.f, ni = er * sn, den = lr * lr + li * li;
        const float fr = (nr * lr + ni * li) / den, fi = (ni * lr - nr * li) / den;
        const float br = b_re[(g * 64 + p) * 16 + h], bi = b_im[(g * 64 + p) * 16 + h];
        BBr[e] = fr * br - fi * bi; BBi[e] = fr * bi + fi * br;
        CCr[e] = c_re[g * 1024 + e]; CCi[e] = c_im[g * 1024 + e]; }
    if (tid < 16) DD[tid] = dsk[g * 16 + tid];
    __syncthreads();
    { const int lane_ = tid & 63, hq = lane_ & 3, hl = (lane_ >> 2) & 3, tau = 4 * (tid >> 6) + (lane_ >> 4), ho = 4 * q + hl, rot = 8 * hl + 2 * (lane_ >> 4);
      f32x4 sa = (f32x4){0.f, 0.f, 0.f, 0.f};
      for (int pp = 0; pp < 64; ++pp) { const int p = (pp + rot) & 63; const float cr = CCr[ho * 64 + p], ci = CCi[ho * 64 + p], pr = POWr[tau * 64 + p], pi = POWi[tau * 64 + p];
          const float xr = cr * pr - ci * pi, xi = cr * pi + ci * pr; const f32x4 br = *(const LAS f32x4*)(BBr + p * 16 + 4 * hq), bi = *(const LAS f32x4*)(BBi + p * 16 + 4 * hq);
          sa += br * xr - bi * xi; }
      if (tau == 0 && (ho >> 2) == hq) sa[ho & 3] += DD[ho];
      *(LAS f32x4*)(KT + (tau * 4 + hl) * 16 + 4 * hq) = sa; }
    __syncthreads();
    bf16* WA = (bf16*)(a.ws + WS_S5WA) + (size_t)g * 256 * 512;
    for (int pc = tid; pc < 64 * 64; pc += NTHREADS) { const int p = pc >> 6, k0 = (pc & 63) * 8; v4u o = (v4u){0u, 0u, 0u, 0u};
        if (q < 2) { const int j = k0 >> 4, h0 = k0 & 15; const float pr = POWr[(31 - j) * 64 + p], pi = POWi[(31 - j) * 64 + p]; float v[8];
#pragma unroll
            for (int w = 0; w < 8; ++w) { const float br = BBr[p * 16 + h0 + w], bi = BBi[p * 16 + h0 + w]; v[w] = (q == 0) ? (pr * br - pi * bi) : (pr * bi + pi * br); }
            o.x = cvtpk(v[0], v[1]); o.y = cvtpk(v[2], v[3]); o.z = cvtpk(v[4], v[5]); o.w = cvtpk(v[6], v[7]); }
        *(GAS v4u*)(WA + (size_t)(64 * q + p) * 512 + k0) = o; }
    bf16* WC = (bf16*)(a.ws + WS_S5WC) + (size_t)g * 512 * 640;
    for (int pc = tid; pc < 128 * 80; pc += NTHREADS) { const int rl = pc / 80, k0 = (pc % 80) * 8, i = rl >> 2, hl = rl & 3, ho = 4 * q + hl; float v[8];
        if (k0 < 512) { const int j = k0 >> 4, h0 = k0 & 15; f32x4 ka = (f32x4){0.f, 0.f, 0.f, 0.f}, kb = ka;
            if (j <= i) { const LAS f32x4* kp = (const LAS f32x4*)(KT + ((i - j) * 4 + hl) * 16 + h0); ka = kp[0]; kb = kp[1]; }
#pragma unroll
            for (int w = 0; w < 4; ++w) { v[w] = ka[w]; v[4 + w] = kb[w]; } }
        else { const int p0 = (k0 - 512) & 63; const bool im = k0 >= 576;
#pragma unroll
            for (int w = 0; w < 8; ++w) { const int p = p0 + w; const float cr = CCr[ho * 64 + p], ci = CCi[ho * 64 + p], pr = POWr[(i + 1) * 64 + p], pi = POWi[(i + 1) * 64 + p];
                v[w] = im ? -(cr * pi + ci * pr) : (cr * pr - ci * pi); } }
        v4u o; o.x = cvtpk(v[0], v[1]); o.y = cvtpk(v[2], v[3]); o.z = cvtpk(v[4], v[5]); o.w = cvtpk(v[6], v[7]);
        *(GAS v4u*)(WC + (size_t)(i * 16 + ho) * 640 + k0) = o; }
    __syncthreads();
}

constexpr int MOE_XITEMS = 24 * 896;
__device__ __forceinline__ XTile moe_xtile(const Args& a, int r, int lane) {
    unsigned char* ws = a.ws;
    const int mat = r / 896, e = mat / 3, which = mat % 3; r -= mat * 896;
    if (which == 0) return xtile_fp8(r, a.in[24] + (size_t)e * D * DFE, DFE, DFE, a.in[22], ws + WS_WMOE_GU + (size_t)e * 7168 * 1024, D, 1, lane);
    if (which == 1) return xtile_fp8(r, a.in[25] + (size_t)e * D * DFE, DFE, DFE, a.in[22], ws + WS_WMOE_GU + (size_t)e * 7168 * 1024, D, 2, lane);
    return xtile_fp8(r, a.in[26] + (size_t)e * DFE * D, D, D, nullptr, ws + WS_WMOE_D + (size_t)e * 1024 * 3584, DFE, 0, lane);
}
constexpr int I_IN0 = 16 * 32, I_GLU = 8 * 8, I_OUT = 16 * 16, I_GU0 = 16 * 44, I_D0 = 44 * 16, I_IN1 = 16 * 48;
constexpr int DW_FIRST = I_IN0 + I_GLU  , DW_EARLY = I_IN0 + I_GLU + I_OUT + 2 * I_GU0, DW_ITEMS = DW_EARLY + I_D0 + I_IN1 + I_OUT;
__device__ __forceinline__ void dense_item(const Args& a, int it, LAS float* scr, int lane) {
    unsigned char* ws = a.ws; int r = it;
    if (r < I_IN0) { xpose_mat(r, a.in[2], EVEN_IN, EVEN_IN, a.in[1], (bf16*)(ws + WS_WIN0), D, 0, scr, lane); return; } r -= I_IN0;
    if (r < I_GLU) { xpose_mat(r, a.in[11], 512, 512, nullptr, (bf16*)(ws + WS_WGLU), 512, 0, scr, lane); return; } r -= I_GLU;
    if (r < I_OUT) { xpose_mat(r, a.in[13], D, D, nullptr, (bf16*)(ws + WS_WOUT0), D, 0, scr, lane); return; } r -= I_OUT;
    if (r < I_GU0) { xpose_mat(r, a.in[15], DFF, DFF, a.in[14], (bf16*)(ws + WS_WGU0), D, 1, scr, lane); return; } r -= I_GU0;
    if (r < I_GU0) { xpose_mat(r, a.in[16], DFF, DFF, a.in[14], (bf16*)(ws + WS_WGU0), D, 2, scr, lane); return; } r -= I_GU0;
    if (r < I_D0) { xpose_mat(r, a.in[17], D, D, nullptr, (bf16*)(ws + WS_WD0), DFF, 0, scr, lane); return; } r -= I_D0;
    if (r < I_IN1) { const XTile t = xtile_fp8(r, a.in[19], ODD_IN, 3072, a.in[18], ws + WS_WIN1, D, 0, lane); f32x4 v[16]; float g[16]; xtile_load(t, v, g, lane); xtile_finish_fp8(t, v, g, 64.f, scr, lane); return; } r -= I_IN1;
    { const XTile t = xtile_fp8(r, a.in[21], D, D, nullptr, ws + WS_WOUT1, D, 0, lane); f32x4 v[16]; float g[16]; xtile_load(t, v, g, lane); xtile_finish_fp8(t, v, g, 64.f, scr, lane); }
}
__device__ __forceinline__ void dense_range(const Args& a, LAS unsigned char* lds, int lane, int wave, int iw, int nwg_, int lo, int hi) {
    LAS float* scr = (LAS float*)(lds + wave * XSCR_BYTES);
    for (int it = hi - 1 - (iw * NWAVES + wave); it >= lo; it -= nwg_ * NWAVES) dense_item(a, it, scr, lane);
}
__device__ __forceinline__ void dense_late(const Args& a, LAS unsigned char* lds, int tid, int lane, int wave, int iw, int nwg_) {
    LAS float* scr = (LAS float*)(lds + wave * XSCR_BYTES);
    for (int it = DW_ITEMS - 1 - (iw * NWAVES + wave); it >= DW_EARLY; it -= nwg_ * NWAVES) dense_item(a, it, scr, lane);
    for (int gt = iw * NTHREADS + tid; gt < 16 * 1024; gt += nwg_ * NTHREADS) { const int h = gt >> 10, k = gt & 1023; ((bf16*)(a.ws + WS_WF1))[gt] = (bf16)f2bf(a.in[19][(size_t)k * ODD_IN + 3072 + h] * a.in[18][k]); }
}
__device__ __forceinline__ void p0_prologue(const Args& a, LAS unsigned char* lds, int tid, int lane, int wave, int vcu, int G) {
    for (int it = vcu; it < 4 * S5G; it += G) s5_tables(a, it >> 2, it & 3, lds, tid);
    LAS float* scr = (LAS float*)(lds + wave * XSCR_BYTES);
    const int gw = vcu * NWAVES + wave, NGW = G * NWAVES;
    unsigned char* ws = a.ws;
    for (int it = DW_FIRST - 1 - gw; it >= 0; it -= NGW) dense_item(a, it, scr, lane);
    float* ss0 = (float*)(ws + WS_SSP);
    int m0, nr, stp;
    if (G == 256) { if (vcu < 128) { m0 = vcu * 48 + wave * 6; nr = 6; } else { m0 = 6144 + (vcu - 128) * 80 + wave * 10; nr = 10; } stp = 1; }
    else { m0 = gw; nr = (M - gw + NGW - 1) / NGW; stp = NGW; }
    f32x4 xnx[4];
    if (nr > 0) {
#pragma unroll
        for (int j = 0; j < 4; ++j) xnx[j] = ((const GAS f32x4*)(a.in[0] + (size_t)m0 * D) + lane)[64 * j]; }
    for (int i = 0; i < nr; ++i) { const int m = m0 + i * stp;
        GAS v2u* o8 = (GAS v2u*)((bf16*)(ws + WS_XB) + (size_t)m * D) + lane; float s = 0.f; f32x4 xc[4];
#pragma unroll
        for (int j = 0; j < 4; ++j) xc[j] = xnx[j];
        if (i + 1 < nr) {
#pragma unroll
            for (int j = 0; j < 4; ++j) xnx[j] = ((const GAS f32x4*)(a.in[0] + (size_t)(m + stp) * D) + lane)[64 * j]; }
#pragma unroll
        for (int j = 0; j < 4; ++j) { const f32x4 v = xc[j]; s += (v.x * v.x + v.y * v.y) + (v.z * v.z + v.w * v.w); v2u w; w.x = cvtpk(v.x, v.y); w.y = cvtpk(v.z, v.w); o8[64 * j] = w; }
        s = wave_sum(s); if (lane < 16) ss0[(size_t)m * 16 + lane] = (lane == 0) ? s : 0.f;
    }
}

__device__ __forceinline__ void s5_scan(const Args& a, int gt  ) {
    if (gt >= BATCH * S5G * S5P) return;
    const int b = gt / (S5G * S5P), g = (gt / S5P) % S5G, p = gt % S5P;
    const float step = expf(a.in[10][g]); const float lr = a.in[3][g * 64 + p], li = a.in[4][g * 64 + p];
    const float mag = expf((float)S5T * step * lr); float sn, cs; sincosf((float)S5T * (step * li), &sn, &cs); const float ar = mag * cs, ai = mag * sn;
    const float* sl = (const float*)(a.ws + WS_SLOC) + ((size_t)g * S5NC + b * 256) * 128 + p;
    bf16* ue = (bf16*)(a.ws + WS_UEXT) + ((size_t)g * S5NC + b * 256) * S5KX + 512 + p;
    float sr = 0.f, si = 0.f;
    float cr[16], ci[16], nr_[16], ni_[16];
#pragma unroll
    for (int j = 0; j < 16; ++j) { cr[j] = sl[(size_t)j * 128]; ci[j] = sl[(size_t)j * 128 + 64]; }
#pragma unroll 1
    for (int c0 = 0; c0 < 256; c0 += 16) {
        if (c0 + 16 < 256) {
#pragma unroll
            for (int j = 0; j < 16; ++j) { nr_[j] = sl[(size_t)(c0 + 16 + j) * 128]; ni_[j] = sl[(size_t)(c0 + 16 + j) * 128 + 64]; } }
#pragma unroll
        for (int j = 0; j < 16; ++j) { const int c = c0 + j;
            ue[(size_t)c * S5KX] = (bf16)f2bf(sr); ue[(size_t)c * S5KX + 64] = (bf16)f2bf(si);
            const float nr = ar * sr - ai * si + cr[j], ni = ar * si + ai * sr + ci[j]; sr = nr; si = ni; }
#pragma unroll
        for (int j = 0; j < 16; ++j) { cr[j] = nr_[j]; ci[j] = ni_[j]; }
    }
}

__device__ __forceinline__ void s5_scan_seg(const Args& a, int bg, int tid, LAS unsigned char* lds) {
    const int b = bg >> 5, g = bg & 31, p = tid & 63, seg = tid >> 6;
    const float step = expf(a.in[10][g]); const float lr = a.in[3][g * 64 + p], li = a.in[4][g * 64 + p];
    const float mag = expf((float)S5T * step * lr); float sn, cs; sincosf((float)S5T * (step * li), &sn, &cs); const float ar = mag * cs, ai = mag * sn;
    const float* sl = (const float*)(a.ws + WS_SLOC) + ((size_t)g * S5NC + b * 256 + seg * 32) * 128 + p;
    bf16* ue = (bf16*)(a.ws + WS_UEXT) + ((size_t)g * S5NC + b * 256 + seg * 32) * S5KX + 512 + p;
    float tr[32], ti[32];
#pragma unroll
    for (int j = 0; j < 32; ++j) { tr[j] = sl[(size_t)j * 128]; ti[j] = sl[(size_t)j * 128 + 64]; }
    float sr = 0.f, si = 0.f;
#pragma unroll
    for (int j = 0; j < 32; ++j) { const float lr_ = tr[j], li_ = ti[j]; tr[j] = sr; ti[j] = si; const float nr = ar * sr - ai * si + lr_, ni = ar * si + ai * sr + li_; sr = nr; si = ni; }
    LAS float* Er = (LAS float*)lds; LAS float* Ei = Er + 512;
    Er[tid] = sr; Ei[tid] = si;
    __syncthreads();
    float pr = ar, pi = ai;
#pragma unroll
    for (int k = 0; k < 5; ++k) { const float nr = pr * pr - pi * pi, ni = 2.f * pr * pi; pr = nr; pi = ni; }
    float Sr = 0.f, Si = 0.f;
    for (int k = 0; k < seg; ++k) { const float er = Er[k * 64 + p], ei = Ei[k * 64 + p]; const float nr = pr * Sr - pi * Si + er, ni = pr * Si + pi * Sr + ei; Sr = nr; Si = ni; }
    float wr = Sr, wi = Si;
#pragma unroll
    for (int j = 0; j < 32; ++j) { ue[(size_t)j * S5KX] = (bf16)f2bf(tr[j] + wr); ue[(size_t)j * S5KX + 64] = (bf16)f2bf(ti[j] + wi); const float nr = ar * wr - ai * wi, ni = ar * wi + ai * wr; wr = nr; wi = ni; }
    __syncthreads();
}

__device__ __forceinline__ void fgate_rows16(const bf16* xb, const bf16* wf, const float* ss, const float* bfv, float* logf, int r0, int lane) {
    const int fr = lane & 15, fq = lane >> 4;
    const bf16x8* ap = (const bf16x8*)(xb + (size_t)(r0 + fr) * D + fq * 8);
    const bf16x8* bp = (const bf16x8*)(wf + (size_t)fr * D + fq * 8);
    f32x4 acc0 = (f32x4){0.f, 0.f, 0.f, 0.f}, acc1 = (f32x4){0.f, 0.f, 0.f, 0.f};
#pragma unroll
    for (int half = 0; half < 2; ++half) {
        bf16x8 av[16], bv[16];
#pragma unroll
        for (int kk = 0; kk < 16; ++kk) { av[kk] = ap[(half * 16 + kk) * 4]; bv[kk] = bp[(half * 16 + kk) * 4]; }
#pragma unroll
        for (int kk = 0; kk < 16; kk += 2) { acc0 = __builtin_amdgcn_mfma_f32_16x16x32_bf16(av[kk], bv[kk], acc0, 0, 0, 0); acc1 = __builtin_amdgcn_mfma_f32_16x16x32_bf16(av[kk + 1], bv[kk + 1], acc1, 0, 0, 0); }
    }
    const f32x4 acc = acc0 + acc1;
    const float bias = bfv[fr];
    float rsq[4];
#pragma unroll
    for (int j = 0; j < 4; ++j) rsq[j] = pg8::rstd16(ss, r0 + fq * 4 + j);
#pragma unroll
    for (int j = 0; j < 4; ++j) { const int row = r0 + fq * 4 + j;
        const float z = acc[j] * rsq[j] + bias;
        const float lf = -(fmaxf(-z, 0.f) + log1pf(expf(-fabsf(z)))) * 1.4426950408889634f;
        const int b = row >> 13, t = row & 8191; logf[((size_t)b * FOXH + fr) * SEQ + t] = lf; }
}

struct MoeOrder {
    pg8::StaticOrder S; int lo; int pref[NEXP + 1]; bool cap_rows;
    __device__ __forceinline__ bool next(int i, pg8::Unit& u) const {
        if (!S.next(i, u)) return false;
        u.pm += lo; int e = 0, pe = 0;
#pragma unroll
        for (int k = 1; k < NEXP; ++k) { const bool ge = u.pm >= pref[k]; e += ge ? 1 : 0; pe = ge ? pref[k] : pe; }
        u.zb = e; u.pa = cap_rows ? e * (MOE_CAP / 256) + (u.pm - pe) : u.pm; return true;
    }
    __device__ __forceinline__ void a_ready(const pg8::Unit&) const {}
    __device__ __forceinline__ void done(const pg8::Unit&) const {}
};

struct MoeQuadOrder {
    int p0, np, G, c; int pref[NEXP + 1];
    __device__ __forceinline__ bool next(int i, pg8::Unit& u) const {
        const long L = (long)i * G + c; if (L >= (long)np * 16) return false;
        const int q = (int)(L & 3), ul = (int)(L >> 2); u.pn = ul & 3; u.pm = p0 + (ul >> 2); u.qa = q >> 1; u.qb = q & 1; u.pa = u.pm; int e = 0;
#pragma unroll
        for (int k = 1; k < NEXP; ++k) e += (u.pm >= pref[k]) ? 1 : 0;
        u.zb = e; return true;
    }
    __device__ __forceinline__ void a_ready(const pg8::Unit&) const {}
    __device__ __forceinline__ void done(const pg8::Unit&) const {}
};

__global__ void __launch_bounds__(NTHREADS, 2) mk_fwd(Args args) {
    extern __shared__ __attribute__((aligned(16))) unsigned char lds_raw[];
    LAS unsigned char* lds = (LAS unsigned char*)lds_raw;
    volatile LAS unsigned* MISC = (volatile LAS unsigned*)(lds + MISC_OFF);
    const int tid = threadIdx.x, lane = tid & 63, wave = __builtin_amdgcn_readfirstlane(tid >> 6);
    const int G = gridDim.x; const int bx = blockIdx.x; const int vcu = (G % 8 == 0) ? (bx % 8) * (G / 8) + bx / 8 : bx;
    unsigned char* ws = args.ws;
    gu32* ctl = (gu32*)(ws + WS_CTL);
    for (int u = tid; u < (LDS_BYTES - LDSCTL_OFF) / 4; u += NTHREADS) ((LAS unsigned*)(lds + LDSCTL_OFF))[u] = 0u;
    __syncthreads();
    XcdBarrier bar = xcd_barrier_post((unsigned*)(ctl + CW_BAR), MISC + 8, (unsigned)G);
    const int gw = vcu * NWAVES + wave, NGW = G * NWAVES;
    float* SS = (float*)(ws + WS_SSP);
    float* X = args.out;
    bf16* XB = (bf16*)(ws + WS_XB);
#define GRID_BAR() xcd_barrier(bar)
#define GEMM_PHASE(EPI, SCHED, lds_, g_, S_, E_) pg8::gemm_phase<EPI, SCHED, true, true>(lds_, g_, S_, E_)

    p0_prologue(args, lds, tid, lane, wave, vcu, G);
    GRID_BAR();
    { pg8::Gemm g{XB, (const bf16*)(ws + WS_WIN0), D, D, D, 0, 0}; pg8::StaticOrder S; S.init(M, EVEN_IN, 1, G, bx);
      pg8::EpiInProj0 E{SS, (bf16*)(ws + WS_UEXT), (bf16*)(ws + WS_QKV0), C2};
      GEMM_PHASE(pg8::EpiInProj0, pg8::StaticOrder, lds + RING_OFF, g, S, E); }
    GRID_BAR();
#define SB_PULL_ONE(more_) do { if (tid == 0) MISC[17] = __hip_atomic_fetch_add(ctl + CW_QUEUE2, 1u, RLX_AGENT); __syncthreads(); const unsigned uq_ = __builtin_amdgcn_readfirstlane(MISC[17]); __syncthreads(); \
        more_ = uq_ < (unsigned)(BATCH * SBH * 32); if (more_) { const int bh_ = (int)(uq_ >> 5), qb_ = (int)(uq_ & 31u); \
            attn_body::sb_unit<1536>(bh_ >> 3, bh_ & 7, qb_, (const attn_body::bf16*)(ws + WS_QKV0), (const attn_body::bf16*)(ws + WS_QKV0) + 512, (const attn_body::bf16*)(ws + WS_QKV0) + 1024, (attn_body::bf16*)(ws + WS_MIXB) + 512, (char*)lds_raw + RING_OFF); } } while (0)
    { const bool s5g = (G % 16 == 0) ? (((bx >> 3) & 1) == 0) : true; const int Gs = (G % 16 == 0) ? G / 2 : G, gl = (G % 16 == 0) ? (bx & 7) + 8 * (bx >> 4) : bx;
      if (s5g) {
          XcdBarrier sub = xcd_barrier_post((unsigned*)(ctl + CW_SUBBAR), MISC + 12, (unsigned)Gs);
          { pg8::Gemm g{(const bf16*)(ws + WS_UEXT), (const bf16*)(ws + WS_S5WA), S5KX, 512, 512, (size_t)S5NC * S5KX * 2, (size_t)256 * 512 * 2}; pg8::StaticOrder S; S.init(S5NC, 256, S5G, Gs, gl);
            pg8::EpiS5State E{(float*)(ws + WS_SLOC)};
            GEMM_PHASE(pg8::EpiS5State, pg8::StaticOrder, lds + RING_OFF, g, S, E);
            if (Gs > S.nwg) { if (gl >= S.nwg) dense_range(args, lds, lane, wave, gl - S.nwg, Gs - S.nwg, DW_EARLY - I_GU0, DW_EARLY); } else dense_range(args, lds, lane, wave, gl, Gs, DW_EARLY - I_GU0, DW_EARLY); }
          xcd_barrier(sub);
          for (int bg = gl; bg < BATCH * S5G; bg += Gs) s5_scan_seg(args, bg, tid, lds);
          { constexpr int NSCAN = BATCH * S5G; if (Gs > NSCAN) { if (gl >= NSCAN) dense_range(args, lds, lane, wave, gl - NSCAN, Gs - NSCAN, DW_FIRST, DW_EARLY - I_GU0); } else dense_range(args, lds, lane, wave, gl, Gs, DW_FIRST, DW_EARLY - I_GU0); }
          xcd_barrier(sub);
          { pg8::Gemm g{(const bf16*)(ws + WS_UEXT), (const bf16*)(ws + WS_S5WC), S5KX, S5KX, S5KX, (size_t)S5NC * S5KX * 2, (size_t)512 * S5KX * 2}; pg8::StaticOrder S; S.init(S5NC, 512, S5G, Gs, gl);
            pg8::EpiS5Y E{(bf16*)(ws + WS_YG)};
            GEMM_PHASE(pg8::EpiS5Y, pg8::StaticOrder, lds + RING_OFF, g, S, E); }
          xcd_barrier(sub);
          { pg8::Gemm g{(const bf16*)(ws + WS_YG), (const bf16*)(ws + WS_WGLU), 512, 512, 512, 0, 0}; pg8::StaticOrder S; S.init(M, 512, 1, Gs, gl);
            pg8::EpiGlu E{(const bf16*)(ws + WS_YG), args.in[12], (bf16*)(ws + WS_MIXB)};
            GEMM_PHASE(pg8::EpiGlu, pg8::StaticOrder, lds + RING_OFF, g, S, E); }
          __syncthreads();
      }
      bool sb_more = true;
#pragma unroll 1
      while (sb_more) SB_PULL_ONE(sb_more);
    }
    GRID_BAR();
#undef SB_PULL_ONE
    { pg8::Gemm g{(const bf16*)(ws + WS_MIXB), (const bf16*)(ws + WS_WOUT0), D, D, D, 0, 0}; pg8::StaticOrder S; S.init(M, D, 1, G, bx);
      pg8::EpiResid<true> E{args.in[0], X, XB, SS + 16 * M};
      GEMM_PHASE(pg8::EpiResid<true>, pg8::StaticOrder, lds + RING_OFF, g, S, E); }
    GRID_BAR();
    { pg8::Gemm g{XB, (const bf16*)(ws + WS_WGU0), D, D, D, 0, 0}; pg8::StaticOrder S; S.init(M, 2 * DFF, 1, G, bx);
      pg8::EpiSwiGlu<true> E{SS + 16 * M, (bf16*)(ws + WS_HID0), DFF};
      GEMM_PHASE(pg8::EpiSwiGlu<true>, pg8::StaticOrder, lds + RING_OFF, g, S, E);
      { const int rem = S.nwg % G; if (rem == 0) dense_late(args, lds, tid, lane, wave, bx, G); else if (bx >= rem) dense_late(args, lds, tid, lane, wave, bx - rem, G - rem); } }
    GRID_BAR();
    { pg8::Gemm g{(const bf16*)(ws + WS_HID0), (const bf16*)(ws + WS_WD0), DFF, DFF, DFF, 0, 0}; pg8::StaticOrder S; S.init(M, D, 1, G, bx);
      pg8::EpiResid<true> E{X, X, XB, SS + 32 * M, ws + WS_HMOE  };
      GEMM_PHASE(pg8::EpiResid<true>, pg8::StaticOrder, lds + RING_OFF, g, S, E); }
    GRID_BAR();
    { pg8::Gemm g{(const bf16*)(ws + WS_HMOE), (const bf16*)(ws + WS_WIN1), D / 2, D / 2, D / 2, 0, 0}; pg8::StaticOrder S; S.init(M, 3072, 1, G, bx);
      pg8::EpiInProj1 E{SS + 32 * M, (bf16*)(ws + WS_QKV1), C2, (unsigned*)(ctl + CW_KN)};
      pg8::gemm_phase<pg8::EpiInProj1, pg8::StaticOrder, true, true, true>(lds + RING_OFF, g, S, E); }
    for (int r = gw; r < M / 16; r += NGW) fgate_rows16(XB, (const bf16*)(ws + WS_WF1), SS + 32 * M, args.in[20], (float*)(ws + WS_LOGF), r * 16, lane);
    GRID_BAR();
    { const attn_body::AttnTensors AT{(const attn_body::bf16*)(ws + WS_QKV1), (const attn_body::bf16*)(ws + WS_QKV1 + 32 * MiB), (const attn_body::bf16*)(ws + WS_QKV1 + 64 * MiB), (attn_body::bf16*)(ws + WS_QKV1), (const float*)(ws + WS_LOGF), (const unsigned*)(ctl + CW_KN)};
      constexpr int N_ATT = 1024, N_CVB = MOE_XITEMS / 32, N_GRP = (N_ATT + 2) / 3 > (N_CVB + 1) / 2 ? (N_ATT + 2) / 3 : (N_CVB + 1) / 2;
      for (;;) {
          if (tid == 0) MISC[16] = __hip_atomic_fetch_add(ctl + CW_QUEUE, 1u, RLX_AGENT);
          __syncthreads();
          const unsigned uq = __builtin_amdgcn_readfirstlane(MISC[16]);
          __syncthreads();
          if (uq >= 5u * N_GRP) break;
          const int grp = (int)(uq / 5u), rr = (int)(uq % 5u);
          if (rr & 1) { const int cb = 2 * grp + (rr >> 1);
              if (cb < N_CVB) { int lane_ = threadIdx.x & 63; asm volatile("" : "+v"(lane_));
                  LAS float* scr = (LAS float*)(lds + wave * XSCR_BYTES);
#pragma unroll 1
                  for (int j = 0; j < 4; j += 2) { const XTile t0 = moe_xtile(args, cb * 32 + wave * 4 + j, lane_), t1 = moe_xtile(args, cb * 32 + wave * 4 + j + 1, lane_);
                      f32x4 v0[16], v1[16]; float g0[16], g1[16]; xtile_load(t0, v0, g0, lane_); xtile_load(t1, v1, g1, lane_);
                      xtile_finish_fp8(t0, v0, g0, 64.f, scr, lane_); xtile_finish_fp8(t1, v1, g1, 64.f, scr, lane_); } }
          } else { const int au = 3 * grp + (rr >> 1);
              if (au < N_ATT) { const int bh = au & 31, qb = 31 - (au >> 5);
                  attn_body::attn_unit<8>(bh >> 4, bh & 15, qb, AT.Q, AT.K, AT.V, AT.O, (char*)lds_raw + RING_OFF, AT.logf + (size_t)bh * SEQ, AT.kn + (size_t)bh * 256, ws + WS_HMOE + 16 * MiB  ); } }
      } }
    GRID_BAR();
    { pg8::Gemm g{(const bf16*)(ws + WS_HMOE + 16 * MiB), (const bf16*)(ws + WS_WOUT1), D / 2, D / 2, D / 2, 0, 0}; pg8::StaticOrder S; S.init(M, D, 1, G, bx);
      pg8::EpiResid<false> E{X, X, XB, SS + 48 * M};
      pg8::gemm_phase<pg8::EpiResid<false>, pg8::StaticOrder, true, true, true>(lds + RING_OFF, g, S, E); }
    GRID_BAR();
    unsigned char* meta = ws + WS_META; unsigned char* XG = ws + WS_XG; float* RSS = (float*)(meta + MT_RSS);
    {
        const float* wr = args.in[23]; const float* gn = args.in[22];
        LAS unsigned* lcnt = (LAS unsigned*)(lds + 1024);
        LAS unsigned* rowst = (LAS unsigned*)(lds + 4096);
        if (tid < 16) lcnt[tid] = 0u;
        __syncthreads();
        float wl[16][NEXP];
#pragma unroll
        for (int j = 0; j < 4; ++j) { const int k0 = 4 * lane + 256 * j; const f32x4 gv = *(const f32x4*)(gn + k0);
#pragma unroll
            for (int q = 0; q < 4; ++q) { const f32x4 w0 = *(const f32x4*)(wr + (size_t)(k0 + q) * NEXP), w1 = *(const f32x4*)(wr + (size_t)(k0 + q) * NEXP + 4);
                wl[4 * j + q][0] = gv[q] * w0.x; wl[4 * j + q][1] = gv[q] * w0.y; wl[4 * j + q][2] = gv[q] * w0.z; wl[4 * j + q][3] = gv[q] * w0.w;
                wl[4 * j + q][4] = gv[q] * w1.x; wl[4 * j + q][5] = gv[q] * w1.y; wl[4 * j + q][6] = gv[q] * w1.z; wl[4 * j + q][7] = gv[q] * w1.w; } }
        f32x4 xn[4];
        if (gw < M) {
#pragma unroll
            for (int j = 0; j < 4; ++j) xn[j] = ((const GAS f32x4*)(X + (size_t)gw * D) + lane)[64 * j]; }
        const bool hb5 = (lane & 32) != 0, hb4 = (lane & 16) != 0, hb3 = (lane & 8) != 0;
        for (int tok = gw; tok < M; tok += NGW) {
            f32x4 xv[4];
#pragma unroll
            for (int j = 0; j < 4; ++j) xv[j] = xn[j];
            if (tok + NGW < M) {
#pragma unroll
                for (int j = 0; j < 4; ++j) xn[j] = ((const GAS f32x4*)(X + (size_t)(tok + NGW) * D) + lane)[64 * j]; }
            float lg[NEXP]; float s = 0.f; const int ti = (tok - gw) / NGW;
#pragma unroll
            for (int e = 0; e < NEXP; ++e) lg[e] = 0.f;
#pragma unroll
            for (int j = 0; j < 4; ++j) { const f32x4 v = xv[j]; s += (v.x * v.x + v.y * v.y) + (v.z * v.z + v.w * v.w);
                if (ti < 8) rowst[((wave * 8 + ti) * 256) + lane + 64 * j] = pg8::pk_fp8x4(v.x, v.y, v.z, v.w);
#pragma unroll
                for (int q = 0; q < 4; ++q)
#pragma unroll
                    for (int e = 0; e < NEXP; ++e) lg[e] = fmaf(v[q], wl[4 * j + q][e], lg[e]); }
            s = wave_sum(s);
            float a4[4], a2[2], a1;
#pragma unroll
            for (int i = 0; i < 4; ++i) { const float snd = hb5 ? lg[i] : lg[i + 4], kp = hb5 ? lg[i + 4] : lg[i]; a4[i] = kp + __shfl_xor(snd, 32); }
#pragma unroll
            for (int i = 0; i < 2; ++i) { const float snd = hb4 ? a4[i] : a4[i + 2], kp = hb4 ? a4[i + 2] : a4[i]; a2[i] = kp + __shfl_xor(snd, 16); }
            { const float snd = hb3 ? a2[0] : a2[1], kp = hb3 ? a2[1] : a2[0]; a1 = kp + __shfl_xor(snd, 8); }
            a1 += __shfl_xor(a1, 4); a1 += __shfl_xor(a1, 2); a1 += __shfl_xor(a1, 1);
#pragma unroll
            for (int e = 0; e < NEXP; ++e) lg[e] = __builtin_bit_cast(float, __builtin_amdgcn_readlane(__builtin_bit_cast(int, a1), 8 * e));
            if (lane == 0) {
                const float rs = 1.0f / sqrtf(s * (1.0f / 1024.0f) + pg8::RMS_EPS);
                int i1 = 0; float v1 = lg[0];
#pragma unroll
                for (int e = 1; e < NEXP; ++e) if (lg[e] > v1) { v1 = lg[e]; i1 = e; }
                int i2 = -1; float v2 = -INFINITY;
#pragma unroll
                for (int e = 0; e < NEXP; ++e) if (e != i1 && lg[e] > v2) { v2 = lg[e]; i2 = e; }
                const float g1 = 1.f / (1.f + expf((v2 - v1) * rs)), g2 = 1.f - g1;
                const unsigned p1 = __hip_atomic_fetch_add(lcnt + i1, 1u, __ATOMIC_RELAXED, __HIP_MEMORY_SCOPE_WORKGROUP), p2 = __hip_atomic_fetch_add(lcnt + i2, 1u, __ATOMIC_RELAXED, __HIP_MEMORY_SCOPE_WORKGROUP);
                ((float*)(meta + MT_RSTD))[tok] = rs; ((unsigned*)(meta + MT_TOKE))[tok] = (unsigned)i1 | ((unsigned)i2 << 8);
                ((unsigned*)(meta + MT_TOKP))[2 * tok] = p1; ((unsigned*)(meta + MT_TOKP))[2 * tok + 1] = p2;
                ((float*)(meta + MT_TOKG))[2 * tok] = g1; ((float*)(meta + MT_TOKG))[2 * tok + 1] = g2;
            }
        }
        __syncthreads();
        if (tid < NEXP) lcnt[8 + tid] = __hip_atomic_fetch_add(ctl + CW_CNT + 64 * tid, lcnt[tid], RLX_AGENT);
        VM_WAIT();
        __syncthreads();
        for (int tok = gw; tok < M; tok += NGW) {
            const unsigned ee = ((const unsigned*)(meta + MT_TOKE))[tok]; const float rs = ((const float*)(meta + MT_RSTD))[tok];
            const unsigned q1 = ((const unsigned*)(meta + MT_TOKP))[2 * tok], q2 = ((const unsigned*)(meta + MT_TOKP))[2 * tok + 1];
            const int ti = (tok - gw) / NGW; unsigned w[4];
            if (ti < 8) {
#pragma unroll
                for (int j = 0; j < 4; ++j) w[j] = rowst[((wave * 8 + ti) * 256) + lane + 64 * j];
            } else {
#pragma unroll
                for (int j = 0; j < 4; ++j) { const f32x4 v = ((const GAS f32x4*)(X + (size_t)tok * D) + lane)[64 * j]; w[j] = pg8::pk_fp8x4(v.x, v.y, v.z, v.w); } }
            const int e1 = (int)(ee & 0xffu), e2 = (int)((ee >> 8) & 0xffu);
            const unsigned p1 = q1 + lcnt[8 + e1], p2 = q2 + lcnt[8 + e2];
            const size_t r1 = (size_t)e1 * MOE_CAP + p1, r2 = (size_t)e2 * MOE_CAP + p2;
#pragma unroll
            for (int j = 0; j < 4; ++j) { *(unsigned*)(XG + r1 * D + 4 * lane + 256 * j) = w[j]; *(unsigned*)(XG + r2 * D + 4 * lane + 256 * j) = w[j]; }
            if (lane == 0) { RSS[r1] = rs; RSS[r2] = rs; ((unsigned*)(meta + MT_TOKP))[2 * tok] = p1; ((unsigned*)(meta + MT_TOKP))[2 * tok + 1] = p2; }
        }
    }
    GRID_BAR();
    int pref[NEXP + 1], cnt[NEXP];
    { pref[0] = 0;
#pragma unroll
      for (int e = 0; e < NEXP; ++e) { cnt[e] = (int)__builtin_amdgcn_readfirstlane(__hip_atomic_load(ctl + CW_CNT + 64 * e, RLX_AGENT)); pref[e + 1] = pref[e] + (cnt[e] + 255) / 256; } }
    const int NP = pref[NEXP];
    bf16* YS = (bf16*)(ws + WS_Y);
    { pg8::Gemm g{(const bf16*)XG, (const bf16*)(ws + WS_WMOE_GU), D / 2, D / 2, D / 2, 0, (size_t)7168 * 1024}; MoeOrder S; S.S.nM = NP; S.S.nN = 28; S.S.nZ = 1; S.S.nwg = NP * 28; S.S.G = G; S.S.c = bx; S.lo = 0; S.cap_rows = true;
#pragma unroll
      for (int e = 0; e <= NEXP; ++e) S.pref[e] = pref[e];
      pg8::EpiSwiGluFp8 E{RSS, ws + WS_HMOE, DFE};
      pg8::gemm_phase<pg8::EpiSwiGluFp8, MoeOrder, true, true, true>(lds + RING_OFF, g, S, E); }
    GRID_BAR();
    { pg8::Gemm g{(const bf16*)(ws + WS_HMOE), (const bf16*)(ws + WS_WMOE_D), DFE / 2, DFE / 2, DFE / 2, 0, (size_t)1024 * 3584}; const int NPM = NP < 2 * G / 4 ? NP : 2 * G / 4;
      MoeOrder S; S.S.nM = NPM; S.S.nN = 4; S.S.nZ = 1; S.S.nwg = NPM * 4; S.S.G = G; S.S.c = bx; S.lo = 0; S.cap_rows = false;
#pragma unroll
      for (int e = 0; e <= NEXP; ++e) S.pref[e] = pref[e];
      pg8::EpiStoreBf16 E{YS, D};
      pg8::gemm_phase<pg8::EpiStoreBf16, MoeOrder, true, true, true>(lds + RING_OFF, g, S, E);
      if (NP > NPM) { MoeQuadOrder Q; Q.p0 = NPM; Q.np = NP - NPM; Q.G = G; Q.c = bx;
#pragma unroll
          for (int e = 0; e <= NEXP; ++e) Q.pref[e] = pref[e];
          pg8::EpiStoreQuad EQ{YS, D};
          pg8::gemm_phase<pg8::EpiStoreQuad, MoeQuadOrder, true, true, true, true>(lds + RING_OFF, g, Q, EQ); } }
    GRID_BAR();
    {
        const float* gf = args.in[27];
        for (int tok = gw; tok < M; tok += NGW) {
            const unsigned ee = ((const unsigned*)(meta + MT_TOKE))[tok]; int pe0 = 0, pe1 = 0;
#pragma unroll
            for (int q = 0; q < NEXP; ++q) { pe0 = (q == (int)(ee & 0xffu)) ? pref[q] : pe0; pe1 = (q == (int)((ee >> 8) & 0xffu)) ? pref[q] : pe1; }
            const unsigned s0 = (unsigned)pe0 * 256u + ((const unsigned*)(meta + MT_TOKP))[2 * tok], s1 = (unsigned)pe1 * 256u + ((const unsigned*)(meta + MT_TOKP))[2 * tok + 1];
            const float g0 = ((const float*)(meta + MT_TOKG))[2 * tok], g1 = ((const float*)(meta + MT_TOKG))[2 * tok + 1];
            GAS f32x4* xr = (GAS f32x4*)(X + (size_t)tok * D) + lane; f32x4 v[4]; float s = 0.f;
#pragma unroll
            for (int j = 0; j < 4; ++j) { v[j] = xr[64 * j]; const int k0 = 4 * lane + 256 * j;
                const v2u a = *(const v2u*)(YS + (size_t)s0 * D + k0), b2 = *(const v2u*)(YS + (size_t)s1 * D + k0);
                v[j].x += g0 * bflo(a.x) + g1 * bflo(b2.x); v[j].y += g0 * bfhi(a.x) + g1 * bfhi(b2.x); v[j].z += g0 * bflo(a.y) + g1 * bflo(b2.y); v[j].w += g0 * bfhi(a.y) + g1 * bfhi(b2.y);
                s += (v[j].x * v[j].x + v[j].y * v[j].y) + (v[j].z * v[j].z + v[j].w * v[j].w); }
            s = wave_sum(s); const float rs = 1.0f / sqrtf(s * (1.0f / 1024.0f) + pg8::RMS_EPS);
#pragma unroll
            for (int j = 0; j < 4; ++j) { const f32x4 gv = *(const f32x4*)(gf + 4 * lane + 256 * j); xr[64 * j] = v[j] * rs * gv; }
        }
    }
}

extern "C" void kernel_launch(void* const* d_in, const int* in_sizes, int n_in, void* d_out, int out_size, void* d_ws, size_t ws_size, hipStream_t stream) {
    static int grid = 0;
    if (grid == 0) {
        if (n_in != 28 || in_sizes[0] != M * D || out_size != M * D || ws_size < WS_END) { fprintf(stderr, "kernel_launch: unexpected problem: n_in %d in0 %d out %d ws %zu (need %zu)\n", n_in, n_in > 0 ? in_sizes[0] : -1, out_size, ws_size, (size_t)WS_END); grid = -1; return; }
        int dev = 0, cus = 0, per_cu = 0;
        if (hipGetDevice(&dev) != hipSuccess || hipDeviceGetAttribute(&cus, hipDeviceAttributeMultiprocessorCount, dev) != hipSuccess) { grid = -1; return; }
        if (hipFuncSetAttribute((const void*)mk_fwd, hipFuncAttributeMaxDynamicSharedMemorySize, LDS_BYTES) != hipSuccess) { fprintf(stderr, "kernel_launch: hipFuncSetAttribute failed\n"); grid = -1; return; }
        if (hipOccupancyMaxActiveBlocksPerMultiprocessor(&per_cu, (const void*)mk_fwd, NTHREADS, LDS_BYTES) != hipSuccess || per_cu < 1) fprintf(stderr, "kernel_launch: occupancy query says %d\n", per_cu);
        (void)hipGetLastError();
        grid = cus;
        if (grid != 256) fprintf(stderr, "kernel_launch: built for the 256-CU MI355X; device reports %d CUs\n", cus);
    }
    if (grid < 0) return;
    if (hipMemsetAsync((char*)d_ws + WS_CTL, 0, CTL_ZERO_BYTES, stream) != hipSuccess) return;
    Args a{};
    for (int i = 0; i < 28; ++i) a.in[i] = (const float*)d_in[i];
    a.out = (float*)d_out; a.ws = (unsigned char*)d_ws;
    hipLaunchKernelGGL(mk_fwd, dim3(grid), dim3(NTHREADS), LDS_BYTES, stream, a);
}
```
